# Optimizing an MI355X kernel written in HIP

```python
import math
import jax, jax.numpy as jnp
from jax import lax
import numpy as np

D_MODEL = 1024
BATCH = 8
SEQ = 2048
DEPTH = 4
DEC_BATCH = 128
DEC_SEQ = 4
PAST_LEN = 16384
PAGE_SIZE = 128

MIX_WIDTH = D_MODEL
DN_HEADS = 4
DN_HEAD_DIM = MIX_WIDTH // 8
DN_WIDTH = DN_HEADS * DN_HEAD_DIM
DN_CONV = 4
DN_CHUNK = 64
SSM_WIDTH = MIX_WIDTH // 4
SSM_GROUP = 16
SSM_GROUPS = SSM_WIDTH // SSM_GROUP
SSM_STATE = 64
POOL_WIDTH = MIX_WIDTH - DN_WIDTH - SSM_WIDTH
POOL_WINDOWS = (2, 4, 8, 16)
POOL_GROUPS = len(POOL_WINDOWS)
POOL_GROUP = POOL_WIDTH // POOL_GROUPS
POOL_BUF = max(POOL_WINDOWS) - 1
D_FF = -(-8 * D_MODEL // (3 * 256)) * 256
EPS = 1e-6

QKV_WIDTH = 3 * DN_WIDTH
OFF_A = QKV_WIDTH
OFF_B = OFF_A + DN_HEADS
OFF_G = OFF_B + DN_HEADS
OFF_SSM = OFF_G + DN_WIDTH
OFF_POOL = OFF_SSM + SSM_WIDTH
IN_WIDTH = OFF_POOL + POOL_WIDTH

F32 = jnp.float32

kernel_name = 'hybrid_deltanet_s5_pool_decoder_step'


def rms_norm(x, w):
    x32 = x.astype(F32)
    y = x32 * lax.rsqrt(jnp.mean(x32 * x32, axis=-1, keepdims=True) + EPS)
    return (y * w.astype(F32)).astype(x.dtype)


def l2_norm(x):
    return x * lax.rsqrt(jnp.sum(x * x, axis=-1, keepdims=True) + EPS)


def causal_dwconv(u, buf, w):
    T = u.shape[1]
    ext = jnp.concatenate([buf.astype(u.dtype), u], axis=1)
    ext32 = ext.astype(F32)
    w32 = w.astype(F32)
    y = ext32[:, 0:T] * w32[0]
    for j in range(1, DN_CONV):
        y = y + ext32[:, j:j + T] * w32[j]
    return y, ext[:, -(DN_CONV - 1):]


def gated_delta_rule(q, k, v, beta, log_g, s0):
    B, T, H, Dk = q.shape
    Dv = v.shape[-1]
    C = math.gcd(T, DN_CHUNK)
    N = T // C

    def chunk(t):
        t = t.reshape((B, N, C, H) + t.shape[3:])
        return jnp.moveaxis(t, (1, 3), (0, 2))

    qc, kc, vc = chunk(q), chunk(k), chunk(v)
    bc, gc = chunk(beta), chunk(log_g)
    gam = jnp.cumsum(gc, axis=-1)
    idx = jnp.arange(C)
    incl = idx[:, None] >= idx[None, :]
    strict = idx[:, None] > idx[None, :]
    diff = gam[..., :, None] - gam[..., None, :]
    decay = jnp.where(incl, jnp.exp(jnp.where(incl, diff, 0.0)), 0.0)
    kb = kc * bc[..., None]
    a_mat = jnp.where(strict, jnp.einsum('nbhtd,nbhsd->nbhts', kb, kc) * decay, 0.0)
    rhs = jnp.concatenate([vc * bc[..., None], kb * jnp.exp(gam)[..., None]], axis=-1)
    sol = lax.linalg.triangular_solve(a_mat, rhs, left_side=True, lower=True, unit_diagonal=True)
    w_val, k_cum = sol[..., :Dv], sol[..., Dv:]
    qk = jnp.einsum('nbhtd,nbhsd->nbhts', qc, kc) * decay
    q_dec = qc * jnp.exp(gam)[..., None]
    k_dec = kc * jnp.exp(gam[..., -1:] - gam)[..., None]
    g_last = jnp.exp(gam[..., -1])[..., None, None]

    def step(s, xs):
        w_n, kcum_n, qk_n, qdec_n, kdec_n, gl_n = xs
        u = w_n - jnp.einsum('bhck,bhkv->bhcv', kcum_n, s)
        o = jnp.einsum('bhck,bhkv->bhcv', qdec_n, s) + jnp.einsum('bhts,bhsv->bhtv', qk_n, u)
        s = s * gl_n + jnp.einsum('bhck,bhcv->bhkv', kdec_n, u)
        return s, o

    s_fin, o = lax.scan(step, s0, (w_val, k_cum, qk, q_dec, k_dec, g_last))
    o = jnp.moveaxis(o, (0, 2), (1, 3)).reshape(B, T, H, Dv)
    return o, s_fin


def delta_mixer(proj, conv_buf, s0, conv_w, a_log, dt_bias, out_norm):
    B, T, _ = proj.shape
    qkv, conv_new = causal_dwconv(proj[..., :QKV_WIDTH], conv_buf, conv_w)
    qkv = jax.nn.silu(qkv).reshape(B, T, 3, DN_HEADS, DN_HEAD_DIM)
    q = l2_norm(qkv[:, :, 0]) * (DN_HEAD_DIM ** -0.5)
    k = l2_norm(qkv[:, :, 1])
    v = qkv[:, :, 2]
    a = proj[..., OFF_A:OFF_B].astype(F32)
    b = proj[..., OFF_B:OFF_G].astype(F32)
    log_g = -jnp.exp(a_log.astype(F32)) * jax.nn.softplus(a + dt_bias.astype(F32))
    beta = jax.nn.sigmoid(b)
    o, s_new = gated_delta_rule(q, k, v, beta, log_g, s0.astype(F32))
    gate = proj[..., OFF_G:OFF_SSM].astype(F32).reshape(B, T, DN_HEADS, DN_HEAD_DIM)
    o = o * lax.rsqrt(jnp.mean(o * o, axis=-1, keepdims=True) + EPS) * out_norm.astype(F32) * jax.nn.silu(gate)
    return o.reshape(B, T, DN_WIDTH), conv_new, s_new


def ssm_mixer(u, h0_re, h0_im, a_re, a_im, log_dt, b_re, b_im, c_re, c_im, d_skip, glu_w, glu_b):
    B, T, _ = u.shape
    u32 = u.astype(F32).reshape(B, T, SSM_GROUPS, SSM_GROUP)
    lam = lax.complex(a_re.astype(F32), a_im.astype(F32))
    dt = jnp.exp(log_dt.astype(F32))[:, None]
    lam_bar = jnp.exp(lam * dt)
    b_c = lax.complex(b_re.astype(F32), b_im.astype(F32))
    b_bar = ((lam_bar - 1.0) / lam)[..., None] * b_c
    bu = jnp.einsum('gph,btgh->btgp', b_bar, u32.astype(jnp.complex64))
    a_seq = jnp.broadcast_to(lam_bar, bu.shape)

    def combine(e1, e2):
        a1, x1 = e1
        a2, x2 = e2
        return a2 * a1, a2 * x1 + x2

    a_cum, h = lax.associative_scan(combine, (a_seq, bu), axis=1)
    h0 = lax.complex(h0_re.astype(F32), h0_im.astype(F32))
    h = h + a_cum * h0[:, None]
    c_c = lax.complex(c_re.astype(F32), c_im.astype(F32))
    y = jnp.real(jnp.einsum('ghp,btgp->btgh', c_c, h)) + d_skip.astype(F32).reshape(SSM_GROUPS, SSM_GROUP) * u32
    y = jax.nn.gelu(y.reshape(B, T, SSM_WIDTH))
    y = y * jax.nn.sigmoid(y @ glu_w.astype(F32) + glu_b.astype(F32))
    h_last = h[:, -1]
    return y, jnp.real(h_last), jnp.imag(h_last)


def pool_mixer(u, buf, pos0, pool_w, pool_scale):
    B, T, _ = u.shape
    u32 = u.astype(F32)
    ext = jnp.concatenate([buf.astype(u.dtype), u], axis=1)
    cs = jnp.concatenate([jnp.zeros((B, 1, POOL_WIDTH), F32), jnp.cumsum(ext.astype(F32), axis=1)], axis=1)
    pos = pos0 + jnp.arange(T)
    outs = []
    for g, w in enumerate(POOL_WINDOWS):
        lo, hi = g * POOL_GROUP, (g + 1) * POOL_GROUP
        win_sum = cs[:, POOL_BUF + 1:POOL_BUF + 1 + T, lo:hi] - cs[:, POOL_BUF + 1 - w:POOL_BUF + 1 - w + T, lo:hi]
        cnt = jnp.minimum(pos + 1, w).astype(F32)[None, :, None]
        r = win_sum / cnt - u32[..., lo:hi]
        outs.append(r @ pool_w[g].astype(F32))
    y = jnp.concatenate(outs, axis=-1) * pool_scale.astype(F32)
    return y, ext[:, -POOL_BUF:]


def layer(x, st, pos0, lp):
    s_delta, s_conv, s_re, s_im, s_pool = st
    h = rms_norm(x, lp['norm_mix_pre'])
    proj = h @ lp['w_in']
    o_dn, conv_new, delta_new = delta_mixer(proj, s_conv, s_delta, lp['conv_w'], lp['dn_a_log'],
                                            lp['dn_dt_bias'], lp['dn_out_norm'])
    o_ssm, re_new, im_new = ssm_mixer(proj[..., OFF_SSM:OFF_POOL], s_re, s_im, lp['ssm_a_re'], lp['ssm_a_im'],
                                      lp['ssm_log_dt'], lp['ssm_b_re'], lp['ssm_b_im'], lp['ssm_c_re'],
                                      lp['ssm_c_im'], lp['ssm_d'], lp['ssm_glu_w'], lp['ssm_glu_b'])
    o_pool, pool_new = pool_mixer(proj[..., OFF_POOL:], s_pool, pos0, lp['pool_w'], lp['pool_scale'])
    mix = jnp.concatenate([o_dn, o_ssm, o_pool], axis=-1).astype(x.dtype) @ lp['w_out']
    x = x + rms_norm(mix, lp['norm_mix_post'])
    h = rms_norm(x, lp['norm_ffn_pre'])
    f = (jax.nn.silu(h @ lp['ffn_w_gate']) * (h @ lp['ffn_w_up'])) @ lp['ffn_w_down']
    x = x + rms_norm(f, lp['norm_ffn_post'])
    return x, (delta_new, conv_new, re_new, im_new, pool_new)


def setup_inputs(seed: int = 0) -> dict:
    key = jax.random.key(seed)
    ks = iter(jax.random.split(key, 40))

    def nrm(shape, scale):
        return jax.random.normal(next(ks), shape, F32) * scale

    def gain(shape):
        return 1.0 + nrm(shape, 0.01)

    dn_dt = jnp.exp(jax.random.uniform(next(ks), (DEPTH, DN_HEADS), F32, math.log(1e-3), math.log(1e-1)))
    return {
        'x_prompt': nrm((BATCH, SEQ, D_MODEL), 1.0),
        'x_sample': nrm((DEC_BATCH, DEC_SEQ, D_MODEL), 1.0),
        'state_delta': nrm((DEPTH, DEC_BATCH, DN_HEADS, DN_HEAD_DIM, DN_HEAD_DIM), 0.05),
        'state_conv': nrm((DEPTH, DEC_BATCH, DN_CONV - 1, QKV_WIDTH), 1.0),
        'state_ssm_re': nrm((DEPTH, DEC_BATCH, SSM_GROUPS, SSM_STATE), 0.1),
        'state_ssm_im': nrm((DEPTH, DEC_BATCH, SSM_GROUPS, SSM_STATE), 0.1),
        'state_pool': nrm((DEPTH, DEC_BATCH, POOL_BUF, POOL_WIDTH), 1.0),
        'norm_mix_pre': gain((DEPTH, D_MODEL)),
        'norm_mix_post': gain((DEPTH, D_MODEL)),
        'norm_ffn_pre': gain((DEPTH, D_MODEL)),
        'norm_ffn_post': gain((DEPTH, D_MODEL)),
        'w_in': nrm((DEPTH, D_MODEL, IN_WIDTH), D_MODEL ** -0.5),
        'conv_w': nrm((DEPTH, DN_CONV, QKV_WIDTH), DN_CONV ** -0.5),
        'dn_a_log': jnp.log(jax.random.uniform(next(ks), (DEPTH, DN_HEADS), F32, 1.0, 16.0)),
        'dn_dt_bias': dn_dt + jnp.log(-jnp.expm1(-dn_dt)),
        'dn_out_norm': gain((DEPTH, DN_HEAD_DIM)),
        'ssm_a_re': -0.5 + nrm((DEPTH, SSM_GROUPS, SSM_STATE), 0.01),
        'ssm_a_im': jnp.pi * jnp.arange(SSM_STATE, dtype=F32) + nrm((DEPTH, SSM_GROUPS, SSM_STATE), 0.01),
        'ssm_log_dt': jax.random.uniform(next(ks), (DEPTH, SSM_GROUPS), F32, math.log(1e-3), math.log(1e-1)),
        'ssm_b_re': nrm((DEPTH, SSM_GROUPS, SSM_STATE, SSM_GROUP), (2 * SSM_GROUP) ** -0.5),
        'ssm_b_im': nrm((DEPTH, SSM_GROUPS, SSM_STATE, SSM_GROUP), (2 * SSM_GROUP) ** -0.5),
        'ssm_c_re': nrm((DEPTH, SSM_GROUPS, SSM_GROUP, SSM_STATE), SSM_STATE ** -0.5),
        'ssm_c_im': nrm((DEPTH, SSM_GROUPS, SSM_GROUP, SSM_STATE), SSM_STATE ** -0.5),
        'ssm_d': nrm((DEPTH, SSM_WIDTH), 1.0),
        'ssm_glu_w': nrm((DEPTH, SSM_WIDTH, SSM_WIDTH), SSM_WIDTH ** -0.5),
        'ssm_glu_b': nrm((DEPTH, SSM_WIDTH), 0.01),
        'pool_w': nrm((DEPTH, POOL_GROUPS, POOL_GROUP, POOL_GROUP), POOL_GROUP ** -0.5),
        'pool_scale': gain((DEPTH, POOL_WIDTH)),
        'w_out': nrm((DEPTH, MIX_WIDTH, D_MODEL), MIX_WIDTH ** -0.5),
        'ffn_w_gate': nrm((DEPTH, D_MODEL, D_FF), D_MODEL ** -0.5),
        'ffn_w_up': nrm((DEPTH, D_MODEL, D_FF), D_MODEL ** -0.5),
        'ffn_w_down': nrm((DEPTH, D_FF, D_MODEL), D_FF ** -0.5),
    }


def reference(x_prompt, x_sample, state_delta, state_conv, state_ssm_re, state_ssm_im, state_pool,
              norm_mix_pre, norm_mix_post, norm_ffn_pre, norm_ffn_post, w_in, conv_w, dn_a_log, dn_dt_bias,
              dn_out_norm, ssm_a_re, ssm_a_im, ssm_log_dt, ssm_b_re, ssm_b_im, ssm_c_re, ssm_c_im, ssm_d,
              ssm_glu_w, ssm_glu_b, pool_w, pool_scale, w_out, ffn_w_gate, ffn_w_up, ffn_w_down):
    B = x_prompt.shape[0]
    zero_state = (
        jnp.zeros((B, DN_HEADS, DN_HEAD_DIM, DN_HEAD_DIM), F32),
        jnp.zeros((B, DN_CONV - 1, QKV_WIDTH), x_prompt.dtype),
        jnp.zeros((B, SSM_GROUPS, SSM_STATE), F32),
        jnp.zeros((B, SSM_GROUPS, SSM_STATE), F32),
        jnp.zeros((B, POOL_BUF, POOL_WIDTH), x_prompt.dtype),
    )
    xp, xs = x_prompt, x_sample
    new_p, new_s = [], []
    for l in range(DEPTH):
        lp = {
            'norm_mix_pre': norm_mix_pre[l], 'norm_mix_post': norm_mix_post[l],
            'norm_ffn_pre': norm_ffn_pre[l], 'norm_ffn_post': norm_ffn_post[l],
            'w_in': w_in[l], 'conv_w': conv_w[l], 'dn_a_log': dn_a_log[l], 'dn_dt_bias': dn_dt_bias[l],
            'dn_out_norm': dn_out_norm[l], 'ssm_a_re': ssm_a_re[l], 'ssm_a_im': ssm_a_im[l],
            'ssm_log_dt': ssm_log_dt[l], 'ssm_b_re': ssm_b_re[l], 'ssm_b_im': ssm_b_im[l],
            'ssm_c_re': ssm_c_re[l], 'ssm_c_im': ssm_c_im[l], 'ssm_d': ssm_d[l],
            'ssm_glu_w': ssm_glu_w[l], 'ssm_glu_b': ssm_glu_b[l], 'pool_w': pool_w[l],
            'pool_scale': pool_scale[l], 'w_out': w_out[l], 'ffn_w_gate': ffn_w_gate[l],
            'ffn_w_up': ffn_w_up[l], 'ffn_w_down': ffn_w_down[l],
        }
        xp, sp = layer(xp, zero_state, 0, lp)
        st_l = (state_delta[l], state_conv[l], state_ssm_re[l], state_ssm_im[l], state_pool[l])
        xs, ss = layer(xs, st_l, PAST_LEN, lp)
        new_p.append(sp)
        new_s.append(ss)
    delta_p = jnp.stack([s[0] for s in new_p])
    conv_p = jnp.stack([s[1] for s in new_p])
    ssm_re_p = jnp.stack([s[2] for s in new_p])
    ssm_im_p = jnp.stack([s[3] for s in new_p])
    pool_p = jnp.stack([s[4] for s in new_p])
    delta_s = jnp.stack([s[0] for s in new_s])
    conv_s = jnp.stack([s[1] for s in new_s])
    ssm_re_s = jnp.stack([s[2] for s in new_s])
    ssm_im_s = jnp.stack([s[3] for s in new_s])
    pool_s = jnp.stack([s[4] for s in new_s])
    return (xp, xs, delta_p, conv_p, ssm_re_p, ssm_im_p, pool_p, delta_s, conv_s, ssm_re_s, ssm_im_s, pool_s)
```

```cpp
#include <hip/hip_runtime.h>
#include <hip/hip_cooperative_groups.h>
#include <cstdio>
#include <cstdint>
namespace cg = cooperative_groups;
#ifndef MK_COOP
#define MK_COOP 1
#endif
namespace pg8 {
#define PG8_LAS __attribute__((address_space(3)))
typedef unsigned short bf16_t;
typedef short bf16x8 __attribute__((ext_vector_type(8)));
typedef float f32x4 __attribute__((ext_vector_type(4)));
typedef unsigned u32x4 __attribute__((ext_vector_type(4)));
constexpr int BM = 256, BK = 64, HALF = 128, HTB = HALF * BK * 2  , STAGE_BYTES = 8 * HTB, NXCD = 8, WGM = 8;

__host__ __device__ __forceinline__ int lds_byte(int r, int c) { const int st = (r >> 4) * 2 + (c >> 5), rr = r & 15, cc = c & 31, ob = rr * 64 + cc * 2; return st * 1024 + (ob ^ (((ob >> 9) & 1) << 5)); }
__host__ __device__ __forceinline__ void stage_rc(int b, int& R, int& C) { const int st = b / 1024, sb = b % 1024, swz = sb ^ (((sb >> 9) & 1) << 5); R = (st >> 1) * 16 + swz / 64; C = (st & 1) * 32 + (swz % 64) / 2; }
__host__ __device__ __forceinline__ int perm32(int rho) { const int n = rho >> 4, i = rho & 15; return 8 * (i >> 2) + 4 * n + (i & 3); }

struct Unit { int pm, pn; };
struct Gemm { const bf16_t* A; const bf16_t* Bt; int M, N, K; };

struct StaticOrder {
    int nM, nN, nwg, G, c;
    __host__ __device__ void init(int M, int N, int G_, int c_) { nM = M / BM; nN = N / BM; nwg = nM * nN; G = G_; c = c_; }
    __host__ __device__ bool next(int i, Unit& u) const {
        const long L = (long)i * G + c; if (L >= nwg) return false;
        int wgid = (int)L; { const int q = nwg / NXCD, r = nwg % NXCD, xcd = wgid % NXCD, off = wgid / NXCD; wgid = (xcd < r ? xcd * (q + 1) : r * (q + 1) + (xcd - r) * q) + off; }
        const int nig = WGM * nN, gid = wgid / nig, fm = gid * WGM, gsz = (nM - fm) < WGM ? (nM - fm) : WGM;
        u.pm = fm + ((wgid % nig) % gsz); u.pn = (wgid % nig) / gsz; return true;
    }
    __device__ __forceinline__ void a_ready(const Unit&) const {}
    __device__ __forceinline__ void done(const Unit&) const {}
};
__device__ __forceinline__ unsigned cvt_pk_bf16(float lo, float hi) { unsigned r; asm volatile("v_cvt_pk_bf16_f32 %0, %1, %2" : "=v"(r) : "v"(lo), "v"(hi)); return r; }
typedef float f32x2 __attribute__((ext_vector_type(2)));
__device__ __forceinline__ f32x2 gelu_pk(f32x2 v) {
    const f32x2 av = __builtin_elementwise_abs(v), d = av * 0.2316418882f + 1.0f;
    f32x2 t; t.x = __builtin_amdgcn_rcpf(d.x); t.y = __builtin_amdgcn_rcpf(d.y);
    f32x2 q = t * 0.5307027145f + (-0.7265760135f); q = q * t + 0.7107068705f; q = q * t + (-0.142248368f); q = q * t + 0.127414796f; q = q * t;
    const f32x2 s = (v * v) * (-0.72134752044f);
    f32x2 e; e.x = __builtin_amdgcn_exp2f(s.x); e.y = __builtin_amdgcn_exp2f(s.y);
    const f32x2 m = v * (q * e), r = v - m;
    f32x2 o; o.x = v.x < 0.f ? m.x : r.x; o.y = v.y < 0.f ? m.y : r.y; return o;
}

struct EpiF32 {
    static constexpr bool PERM = false, AFTER_DRAIN = false;
    float* C; int ldc; const float* bias;
    __device__ __forceinline__ void operator()(const f32x4 (&acc)[2][2][4][2], const Unit& u, int wr, int wc, int fr, int fq) const {
        const int row0 = u.pm * BM + wr * 64 + fr, col0 = u.pn * BM + wc * 32 + 4 * fq;
        f32x4 bv[2][2];
#pragma unroll
        for (int bj = 0; bj < 2; ++bj)
#pragma unroll
            for (int n = 0; n < 2; ++n) bv[bj][n] = bias ? *(const f32x4*)(bias + col0 + bj * HALF + n * 16) : (f32x4){0.f, 0.f, 0.f, 0.f};
#pragma unroll
        for (int ai = 0; ai < 2; ++ai)
#pragma unroll
            for (int m = 0; m < 4; ++m) { float* rowp = C + (size_t)(row0 + ai * HALF + m * 16) * ldc + col0;
#pragma unroll
                for (int bj = 0; bj < 2; ++bj)
#pragma unroll
                    for (int n = 0; n < 2; ++n) *(f32x4*)(rowp + bj * HALF + n * 16) = acc[ai][bj][m][n] + bv[bj][n]; }
    }
};
template <int ACT  > struct EpiBf16 {
    static constexpr bool PERM = true, AFTER_DRAIN = false;
    bf16_t* O; int ldc; const float* bias; int split_cols; size_t split_stride;
    __device__ __forceinline__ void operator()(const f32x4 (&acc)[2][2][4][2], const Unit& u, int wr, int wc, int fr, int fq) const {
        const int row0 = u.pm * BM + wr * 64 + fr; int colt = u.pn * BM; bf16_t* base = O;
        if (split_cols) { const int t = colt / split_cols; base += (size_t)t * split_stride; colt -= t * split_cols; }
        const int col0 = colt + wc * 32 + 8 * fq, bcol0 = u.pn * BM + wc * 32 + 8 * fq;
        f32x4 bv[2][2];
#pragma unroll
        for (int bj = 0; bj < 2; ++bj)
#pragma unroll
            for (int n = 0; n < 2; ++n) bv[bj][n] = bias ? *(const f32x4*)(bias + bcol0 + bj * HALF + 4 * n) : (f32x4){0.f, 0.f, 0.f, 0.f};
#pragma unroll
        for (int ai = 0; ai < 2; ++ai)
#pragma unroll
            for (int m = 0; m < 4; ++m) { bf16_t* rowp = base + (size_t)(row0 + ai * HALF + m * 16) * ldc + col0;
#pragma unroll
                for (int bj = 0; bj < 2; ++bj) { f32x4 v0 = acc[ai][bj][m][0] + bv[bj][0], v1 = acc[ai][bj][m][1] + bv[bj][1];
                    if (ACT == 1) { f32x2 a = gelu_pk((f32x2){v0[0], v0[1]}), b = gelu_pk((f32x2){v0[2], v0[3]}), c = gelu_pk((f32x2){v1[0], v1[1]}), d = gelu_pk((f32x2){v1[2], v1[3]});
                        v0 = (f32x4){a.x, a.y, b.x, b.y}; v1 = (f32x4){c.x, c.y, d.x, d.y}; }
                    if (ACT == 2) {
#pragma unroll
                        for (int j = 0; j < 4; ++j) { v0[j] = 0.5f * v0[j] * (1.0f + erff(v0[j] * 0.70710678f)); v1[j] = 0.5f * v1[j] * (1.0f + erff(v1[j] * 0.70710678f)); } }
                    u32x4 w; w.x = cvt_pk_bf16(v0[0], v0[1]); w.y = cvt_pk_bf16(v0[2], v0[3]); w.z = cvt_pk_bf16(v1[0], v1[1]); w.w = cvt_pk_bf16(v1[2], v1[3]);
                    *(u32x4*)(rowp + bj * HALF) = w; } }
    }
};
template <class Epi, class Sched, bool STAMP = false>
__device__ __forceinline__ void gemm_phase(PG8_LAS unsigned char* lds, const Gemm g, const Sched& S, const Epi& E, unsigned long long* stamps) {
    int tid_ = threadIdx.x; asm volatile("" : "+v"(tid_));
    const int tid = tid_, wid = __builtin_amdgcn_readfirstlane(tid >> 6), lane = tid & 63, wr = wid >> 2, wc = wid & 3, fr = lane & 15, fq = lane >> 4;
    const int K = g.K, nt = K / BK;
    int ts_lo = 0, ts_hi = 0, nts = 0; const unsigned long long rt_entry = STAMP ? (unsigned long long)wall_clock64() : 0ull;
#define PG8_STAMP() do { if (STAMP && wid == 0 && nts < 64) { const unsigned long long _c = (unsigned long long)clock64(); \
        ts_lo = (lane == nts) ? (int)(unsigned)_c : ts_lo; ts_hi = (lane == nts) ? (int)(unsigned)(_c >> 32) : ts_hi; ++nts; } } while (0)
    PG8_STAMP();
    unsigned voffA[2], voffB[2];
#pragma unroll
    for (int i = 0; i < 2; ++i) { int R, C; stage_rc(tid * 16 + i * 8192, R, C); const int Rb = Epi::PERM ? ((R & ~31) + perm32(R & 31)) : R;
        voffA[i] = (unsigned)(R * K + C) * 2u; voffB[i] = (unsigned)(Rb * K + C) * 2u; }
    const size_t kstep = (size_t)(BK * 2);
    const size_t hstep = (size_t)HALF * K * 2;
    const size_t tstep = 2 * hstep;
    const unsigned ldsw = (unsigned)wid * 1024u;
    const int aoff = lds_byte(wr * 64 + fr, fq * 8), boff = lds_byte(wc * 32 + fr, fq * 8);
#define PG8_SA(b, h) (((b) * 2 + (h)) * HTB)
#define PG8_SB(b, h) ((4 + (b) * 2 + (h)) * HTB)
#define PG8_STAGE(bufoff, gbase, voff) do { _Pragma("unroll") for (int _i = 0; _i < 2; ++_i) \
        __builtin_amdgcn_global_load_lds((const unsigned*)((const char*)(gbase) + (voff)[_i]), (PG8_LAS unsigned*)(lds + (bufoff) + ldsw + _i * 8192), 16, 0, 0); } while (0)
#define PG8_LDA(dst, b, h) do { _Pragma("unroll") for (int m = 0; m < 4; ++m) _Pragma("unroll") for (int k = 0; k < 2; ++k) dst[m][k] = *(const PG8_LAS bf16x8*)(lds + PG8_SA(b, h) + aoff + m * 2048 + k * 1024); } while (0)
#define PG8_LDB(dst, b, h) do { _Pragma("unroll") for (int n = 0; n < 2; ++n) _Pragma("unroll") for (int k = 0; k < 2; ++k) dst[n][k] = *(const PG8_LAS bf16x8*)(lds + PG8_SB(b, h) + boff + n * 2048 + k * 1024); } while (0)
#define PG8_MMA(ai, bj, At, Bt) do { __builtin_amdgcn_s_setprio(1); _Pragma("unroll") for (int m = 0; m < 4; ++m) _Pragma("unroll") for (int n = 0; n < 2; ++n) _Pragma("unroll") for (int k = 0; k < 2; ++k) \
        acc[ai][bj][m][n] = __builtin_amdgcn_mfma_f32_16x16x32_bf16(Bt[n][k], At[m][k], acc[ai][bj][m][n], 0, 0, 0); __builtin_amdgcn_s_setprio(0); } while (0)
#define PG8_WAIT_V(n) asm volatile("s_waitcnt vmcnt(" #n ")" ::: "memory")
#define PG8_WAIT_L(n) asm volatile("s_waitcnt lgkmcnt(" #n ")" ::: "memory")
#define PG8_BAR __builtin_amdgcn_s_barrier()
#define PG8_SCHED __builtin_amdgcn_sched_barrier(0)
    Unit cur, nxt; int ui = 0;
    if (!S.next(0, cur)) return;
    f32x4 acc[2][2][4][2];
#pragma unroll
    for (int a = 0; a < 2; ++a)
#pragma unroll
        for (int b = 0; b < 2; ++b)
#pragma unroll
            for (int m = 0; m < 4; ++m)
#pragma unroll
                for (int n = 0; n < 2; ++n) acc[a][b][m][n] = (f32x4){0.f, 0.f, 0.f, 0.f};
    bf16x8 At[4][2], B0[2][2], B1[2][2];
    const char* cA = (const char*)g.A + (size_t)cur.pm * tstep; const char* cB = (const char*)g.Bt + (size_t)cur.pn * tstep;
    S.a_ready(cur);
    PG8_STAGE(PG8_SB(0, 0), cB, voffB); PG8_STAGE(PG8_SA(0, 0), cA, voffA); PG8_STAGE(PG8_SB(0, 1), cB + hstep, voffB); PG8_STAGE(PG8_SA(0, 1), cA + hstep, voffA);
    if (wr == 1) PG8_BAR;
    PG8_WAIT_V(4); PG8_BAR;
    PG8_STAGE(PG8_SB(1, 0), cB + kstep, voffB); PG8_STAGE(PG8_SA(1, 0), cA + kstep, voffA); PG8_STAGE(PG8_SB(1, 1), cB + hstep + kstep, voffB);
    PG8_WAIT_V(6); PG8_BAR;
    PG8_STAMP();
    for (;;) {
        const bool has_next = S.next(ui + 1, nxt);
        const char* nA = has_next ? (const char*)g.A + (size_t)nxt.pm * tstep : cA; const char* nB = has_next ? (const char*)g.Bt + (size_t)nxt.pn * tstep : cB;
        for (int t = 0; t < nt; t += 2) {
            const bool last = (t == nt - 2);
            const char* a1 = cA + (size_t)(t + 1) * kstep;
            const char* a2 = last ? nA : cA + (size_t)(t + 2) * kstep; const char* b2 = last ? nB : cB + (size_t)(t + 2) * kstep;
            const char* a3 = a2 + kstep; const char* b3 = b2 + kstep;
            if (last && has_next) S.a_ready(nxt);
            PG8_LDB(B0, 0, 0); PG8_SCHED; PG8_LDA(At, 0, 0); PG8_STAGE(PG8_SA(1, 1), a1 + hstep, voffA);
            PG8_WAIT_L(8); PG8_BAR; PG8_WAIT_L(0); PG8_MMA(0, 0, At, B0); PG8_BAR; PG8_SCHED;
            PG8_LDB(B1, 0, 1); PG8_STAGE(PG8_SB(0, 0), b2, voffB);
            PG8_BAR; PG8_WAIT_L(0); PG8_MMA(0, 1, At, B1); PG8_BAR;
            PG8_LDA(At, 0, 1); PG8_STAGE(PG8_SA(0, 0), a2, voffA);
            PG8_BAR; PG8_WAIT_L(0); PG8_MMA(1, 0, At, B0); PG8_BAR; PG8_SCHED;
            PG8_STAGE(PG8_SB(0, 1), b2 + hstep, voffB);
            PG8_WAIT_V(6); PG8_BAR; PG8_MMA(1, 1, At, B1); PG8_BAR;
            PG8_LDB(B0, 1, 0); PG8_SCHED; PG8_LDA(At, 1, 0); PG8_STAGE(PG8_SA(0, 1), a2 + hstep, voffA);
            PG8_WAIT_L(8); PG8_BAR; PG8_WAIT_L(0); PG8_MMA(0, 0, At, B0); PG8_BAR; PG8_SCHED;
            PG8_LDB(B1, 1, 1); PG8_STAGE(PG8_SB(1, 0), b3, voffB);
            PG8_BAR; PG8_WAIT_L(0); PG8_MMA(0, 1, At, B1); PG8_BAR;
            PG8_LDA(At, 1, 1); PG8_STAGE(PG8_SA(1, 0), a3, voffA);
            PG8_BAR; PG8_WAIT_L(0); PG8_MMA(1, 0, At, B0); PG8_BAR; PG8_SCHED;
            PG8_STAGE(PG8_SB(1, 1), b3 + hstep, voffB);
            PG8_WAIT_V(6); PG8_BAR; PG8_MMA(1, 1, At, B1); PG8_BAR;
        }
        PG8_STAMP();
        if constexpr (!Epi::AFTER_DRAIN) { E(acc, cur, wr, wc, fr, fq); S.done(cur); }
        PG8_STAMP();
        if (!has_next) break;
#pragma unroll
        for (int a = 0; a < 2; ++a)
#pragma unroll
            for (int b = 0; b < 2; ++b)
#pragma unroll
                for (int m = 0; m < 4; ++m)
#pragma unroll
                    for (int n = 0; n < 2; ++n) acc[a][b][m][n] = (f32x4){0.f, 0.f, 0.f, 0.f};
        cur = nxt; cA = nA; cB = nB; ++ui;
    }
    PG8_WAIT_V(0);
    if (wr == 0) PG8_BAR;
    PG8_BAR;
    if constexpr (Epi::AFTER_DRAIN) { E.fused(acc, cur, wr, wc, fr, fq, lds, wid, lane); S.done(cur); }
    PG8_STAMP();
    if (STAMP && wid == 0) { stamps[lane] = lane < nts ? (((unsigned long long)(unsigned)ts_hi << 32) | (unsigned)ts_lo) : 0ull;
        if (lane == 62) stamps[62] = rt_entry; if (lane == 63) stamps[63] = (unsigned long long)wall_clock64(); }
#undef PG8_STAMP
#undef PG8_SA
#undef PG8_SB
#undef PG8_STAGE
#undef PG8_LDA
#undef PG8_LDB
#undef PG8_MMA
#undef PG8_WAIT_V
#undef PG8_WAIT_L
#undef PG8_BAR
#undef PG8_SCHED
}
}

#define LAS __attribute__((address_space(3)))
typedef unsigned short bf16_t;
typedef short bf16x8 __attribute__((ext_vector_type(8)));
typedef float f32x4 __attribute__((ext_vector_type(4)));
typedef float f32x2 __attribute__((ext_vector_type(2)));
typedef unsigned u32x4 __attribute__((ext_vector_type(4)));
typedef unsigned u32x2 __attribute__((ext_vector_type(2)));

constexpr int D = 1024, NP = 16384, NS = 512, NTOK = NP + NS, SEQ = 2048, NB = 8, NSB = 128, DEPTH = 4;
constexpr int INW = 2568, NPROJ = 2560, DFF = 2816, NGU = 5632;
constexpr int PC_G = 1536, PC_SSM = 2048, PC_POOL = 2304;
constexpr float EPS = 1e-6f;
constexpr int LDS_BYTES = 147456;

constexpr size_t SZ_WIN = (size_t)NPROJ * D * 2, SZ_WOUT = (size_t)D * D * 2, SZ_WGU = (size_t)NGU * D * 2, SZ_WDN = (size_t)D * DFF * 2;
constexpr size_t SZ_WAB = 8 * D * 4, SZ_GLUT = 256 * 256 * 2, SZ_POOLT = 4 * 64 * 64 * 2, SZ_SSMK = 16 * 64 * 4 * 4, SZ_BBAR = 16 * 64 * 32 * 4;
constexpr size_t WS_WIN = 0;
constexpr size_t WS_WOUT = WS_WIN + DEPTH * SZ_WIN;
constexpr size_t WS_WGU = WS_WOUT + DEPTH * SZ_WOUT;
constexpr size_t WS_WDN = WS_WGU + DEPTH * SZ_WGU;
constexpr size_t WS_WAB = WS_WDN + DEPTH * SZ_WDN;
constexpr size_t WS_GLUT = WS_WAB + DEPTH * SZ_WAB;
constexpr size_t WS_POOLT = WS_GLUT + DEPTH * SZ_GLUT;
constexpr size_t WS_SSMK = WS_POOLT + DEPTH * SZ_POOLT;
constexpr size_t WS_BBAR = WS_SSMK + DEPTH * SZ_SSMK;
constexpr size_t WS_H = WS_BBAR + DEPTH * SZ_BBAR;
constexpr size_t WS_AB = WS_H + (size_t)NTOK * D * 2;
constexpr size_t WS_MIX = WS_AB + (size_t)NTOK * 8 * 4;
constexpr size_t WS_MIXO = WS_MIX + (size_t)NTOK * D * 2;
constexpr size_t WS_SSME = WS_MIXO + (size_t)NTOK * D * 4;
constexpr size_t WS_PROJ = WS_SSME + (size_t)8 * 32 * 16 * 64 * 2 * 4;
constexpr size_t WS_DW = WS_PROJ + (size_t)NTOK * NPROJ * 2;
constexpr size_t WS_DKC = WS_DW + (size_t)1024 * 8192 * 4;
constexpr size_t WS_DQD = WS_DKC + (size_t)1024 * 8192 * 2;
constexpr size_t WS_DQK = WS_DQD + (size_t)1024 * 8192 * 2;
constexpr size_t WS_DKT = WS_DQK + (size_t)1024 * 4096 * 2;
constexpr size_t WS_DGL = WS_DKT + (size_t)1024 * 8192 * 2;
constexpr size_t WS_END = WS_DGL + 4096;
constexpr size_t WS_HID = WS_PROJ;
static_assert(WS_HID + (size_t)NTOK * DFF * 2 <= WS_END, "HID overlay");
static_assert(WS_H % 256 == 0 && WS_PROJ % 256 == 0 && WS_DW % 256 == 0, "align");

constexpr size_t O_YP = 0, O_YS = O_YP + (size_t)NP * D, O_DP = O_YS + (size_t)NS * D, O_CP = O_DP + (size_t)DEPTH * 8 * 4 * 16384,
                 O_REP = O_CP + (size_t)DEPTH * 8 * 3 * 1536, O_IMP = O_REP + (size_t)DEPTH * 8 * 1024, O_PP = O_IMP + (size_t)DEPTH * 8 * 1024,
                 O_DS = O_PP + (size_t)DEPTH * 8 * 15 * 256, O_CS = O_DS + (size_t)DEPTH * 128 * 4 * 16384, O_RES = O_CS + (size_t)DEPTH * 128 * 3 * 1536,
                 O_IMS = O_RES + (size_t)DEPTH * 128 * 1024, O_PS = O_IMS + (size_t)DEPTH * 128 * 1024, O_END = O_PS + (size_t)DEPTH * 128 * 15 * 256;

struct Args { const float* in[32]; float* out; unsigned char* ws; int ph_lo, ph_hi; };
typedef const float* cfp_t;
typedef __attribute__((address_space(4))) const unsigned char* kptr_t;
struct InProxy { __device__ __forceinline__ const float* operator[](int i) const {
    kptr_t p = (kptr_t)__builtin_amdgcn_kernarg_segment_ptr(); asm volatile("" : "+s"(p)); return *(__attribute__((address_space(4))) const cfp_t*)(p + 8 * i); } };
struct DevArgs { InProxy in; float* out; unsigned char* ws; int ph_lo, ph_hi; };
enum { I_XP = 0, I_XS, I_SDELTA, I_SCONV, I_SRE, I_SIM, I_SPOOL, I_NMPRE, I_NMPOST, I_NFPRE, I_NFPOST, I_WIN, I_CONVW, I_ALOG, I_DTB, I_ONORM,
       I_ARE, I_AIM, I_LOGDT, I_BRE, I_BIM, I_CRE, I_CIM, I_SSMD, I_GLUW, I_GLUB, I_POOLW, I_POOLS, I_WOUT, I_WG, I_WU, I_WD };

__device__ __forceinline__ unsigned f2bf(float f) { unsigned u = __float_as_uint(f); return (u + 0x7fffu + ((u >> 16) & 1u)) >> 16; }
__device__ __forceinline__ float bf2f(unsigned b) { return __uint_as_float(b << 16); }
__device__ __forceinline__ unsigned pk2(float lo, float hi) { return f2bf(lo) | (f2bf(hi) << 16); }
__device__ __forceinline__ float wave_sum(float v) {
#pragma unroll
    for (int o = 1; o < 64; o <<= 1) v += __shfl_xor(v, o);
    return v;
}
__device__ __forceinline__ float silu_f(float y) { return y / (1.f + __expf(-y)); }
__device__ __forceinline__ float sigmoid_f(float y) { return 1.f / (1.f + __expf(-y)); }
__device__ __forceinline__ float gelu_tanh_f(float x) { const float t = tanhf(0.7978845608028654f * (x + 0.044715f * x * x * x)); return 0.5f * x * (1.f + t); }
__device__ __forceinline__ f32x4 mfma16(bf16x8 a, bf16x8 b, f32x4 c) { return __builtin_amdgcn_mfma_f32_16x16x32_bf16(a, b, c, 0, 0, 0); }
#define LDS_FENCE() asm volatile("s_waitcnt lgkmcnt(0)" ::: "memory")

struct EpiSwiGLU {
    static constexpr bool PERM = false, AFTER_DRAIN = false;
    bf16_t* O; int ldc;
    __device__ __forceinline__ void operator()(const pg8::f32x4 (&acc)[2][2][4][2], const pg8::Unit& u, int wr, int wc, int fr, int fq) const {
        const int row0 = u.pm * 256 + wr * 64 + fr, hid0 = u.pn * 128 + wc * 16 + 4 * fq;
#pragma unroll
        for (int ai = 0; ai < 2; ++ai)
#pragma unroll
            for (int m = 0; m < 4; ++m) { bf16_t* rowp = O + (size_t)(row0 + ai * 128 + m * 16) * ldc + hid0;
#pragma unroll
                for (int bj = 0; bj < 2; ++bj) { const pg8::f32x4 g = acc[ai][bj][m][0], v = acc[ai][bj][m][1];
                    u32x2 w; w.x = pk2(silu_f(g[0]) * v[0], silu_f(g[1]) * v[1]); w.y = pk2(silu_f(g[2]) * v[2], silu_f(g[3]) * v[3]);
                    *(u32x2*)(rowp + bj * 64) = w; } }
    }
};

struct SrcIn { const float* w; __device__ __forceinline__ float operator()(int k, int n) const { return w[(size_t)k * INW + (n < 1536 ? n : n + 8)]; } };
struct SrcPlain { const float* w; int N; __device__ __forceinline__ float operator()(int k, int n) const { return w[(size_t)k * N + n]; } };
struct SrcGU { const float* g; const float* u; __device__ __forceinline__ float operator()(int k, int n) const { const int r = n & 31, hid = (n >> 5) * 16 + (r & 15); const long long du = (r < 16) ? 0ll : (long long)(u - g); return g[du + (long long)k * DFF + hid]; } };
template <class Src> __device__ __forceinline__ void transpose_item(const Src& src, int K, bf16_t* WT, int nblk, LAS float* scr, int item, int lane) {
    const int kb = item / nblk, nb = item % nblk, k0 = 64 * kb, n0 = 32 * nb;
#pragma unroll 8
    for (int i = 0; i < 32; ++i) { const int kk = 2 * i + (lane >> 5); scr[kk * 33 + (lane & 31)] = src(k0 + kk, n0 + (lane & 31)); }
    LDS_FENCE();
    const int c = lane & 7;
#pragma unroll
    for (int j = 0; j < 4; ++j) { const int n = (lane >> 3) + 8 * j; const LAS float* s = scr + (8 * c) * 33 + n;
        u32x4 o; o.x = pk2(s[0 * 33], s[1 * 33]); o.y = pk2(s[2 * 33], s[3 * 33]); o.z = pk2(s[4 * 33], s[5 * 33]); o.w = pk2(s[6 * 33], s[7 * 33]);
        *(u32x4*)(WT + (size_t)(n0 + n) * K + k0 + 8 * c) = o; }
    LDS_FENCE();
}

__device__ __forceinline__ void norm_rows(const float* T, const float* wt, const float* X0, const float* X1, float* Xout, const float* wh, bf16_t* H,
                                          const float* Wab, float* AB, int gw, int NGW, int lane) {
    for (int m = gw; m < NTOK; m += NGW) {
        const float* xr = (X1 && m >= NP) ? X1 + (size_t)(m - NP) * D : X0 + (size_t)m * D;
        f32x4 x[4];
#pragma unroll
        for (int j = 0; j < 4; ++j) x[j] = ((const f32x4*)xr)[lane + 64 * j];
        if (T) {
            f32x4 t[4]; float ss = 0.f;
#pragma unroll
            for (int j = 0; j < 4; ++j) { t[j] = ((const f32x4*)(T + (size_t)m * D))[lane + 64 * j]; ss += (t[j].x * t[j].x + t[j].y * t[j].y) + (t[j].z * t[j].z + t[j].w * t[j].w); }
            ss = wave_sum(ss); const float r = rsqrtf(ss * (1.f / D) + EPS);
#pragma unroll
            for (int j = 0; j < 4; ++j) { const f32x4 w = ((const f32x4*)wt)[lane + 64 * j]; x[j] += t[j] * r * w; }
        }
        if (Xout) {
#pragma unroll
            for (int j = 0; j < 4; ++j) ((f32x4*)(Xout + (size_t)m * D))[lane + 64 * j] = x[j];
        }
        if (H) {
            float ss = 0.f;
#pragma unroll
            for (int j = 0; j < 4; ++j) ss += (x[j].x * x[j].x + x[j].y * x[j].y) + (x[j].z * x[j].z + x[j].w * x[j].w);
            ss = wave_sum(ss); const float r = rsqrtf(ss * (1.f / D) + EPS);
            f32x4 hv[4];
#pragma unroll
            for (int j = 0; j < 4; ++j) { const f32x4 w = ((const f32x4*)wh)[lane + 64 * j]; hv[j] = x[j] * r * w;
                u32x2 o; o.x = pk2(hv[j].x, hv[j].y); o.y = pk2(hv[j].z, hv[j].w); ((u32x2*)(H + (size_t)m * D))[lane + 64 * j] = o; }
            if (Wab) {
#pragma unroll
                for (int c = 0; c < 8; ++c) { float d = 0.f;
#pragma unroll
                    for (int j = 0; j < 4; ++j) { const f32x4 w = ((const f32x4*)(Wab + c * D))[lane + 64 * j]; d += (hv[j].x * w.x + hv[j].y * w.y) + (hv[j].z * w.z + hv[j].w * w.w); }
                    d = wave_sum(d); if (lane == 0) AB[(size_t)m * 8 + c] = d; }
            }
        }
    }
}

__device__ __forceinline__ void prologue(const DevArgs& A, LAS unsigned char* lds, int wave, int lane, int gw, int NGW) {
    LAS float* scr = (LAS float*)(lds + wave * 8704);
    constexpr int I_IN = 16 * 80, I_OUT = 16 * 32, I_GU = 16 * 176, I_DN = 44 * 32, I_GLU = 4 * 8, I_POOL = 8, PER = I_IN + I_OUT + I_GU + I_DN + I_GLU + I_POOL;
    for (int it = gw; it < DEPTH * PER; it += NGW) {
        const int l = it / PER; int r = it % PER;
        if (r < I_IN) { SrcIn s{A.in[I_WIN] + (size_t)l * D * INW}; transpose_item(s, D, (bf16_t*)(A.ws + WS_WIN + l * SZ_WIN), NPROJ / 32, scr, r, lane); continue; } r -= I_IN;
        if (r < I_OUT) { SrcPlain s{A.in[I_WOUT] + (size_t)l * D * D, D}; transpose_item(s, D, (bf16_t*)(A.ws + WS_WOUT + l * SZ_WOUT), D / 32, scr, r, lane); continue; } r -= I_OUT;
        if (r < I_GU) { SrcGU s{A.in[I_WG] + (size_t)l * D * DFF, A.in[I_WU] + (size_t)l * D * DFF}; transpose_item(s, D, (bf16_t*)(A.ws + WS_WGU + l * SZ_WGU), NGU / 32, scr, r, lane); continue; } r -= I_GU;
        if (r < I_DN) { SrcPlain s{A.in[I_WD] + (size_t)l * DFF * D, D}; transpose_item(s, DFF, (bf16_t*)(A.ws + WS_WDN + l * SZ_WDN), D / 32, scr, r, lane); continue; } r -= I_DN;
        if (r < I_GLU) { SrcPlain s{A.in[I_GLUW] + (size_t)l * 65536, 256}; transpose_item(s, 256, (bf16_t*)(A.ws + WS_GLUT + l * SZ_GLUT), 8, scr, r, lane); continue; } r -= I_GLU;
        { const int g = r >> 1; SrcPlain s{A.in[I_POOLW] + (size_t)(l * 4 + g) * 4096, 64}; transpose_item(s, 64, (bf16_t*)(A.ws + WS_POOLT + l * SZ_POOLT) + g * 4096, 2, scr, r & 1, lane); }
    }
    const int gt = gw * 64 + lane, NT = NGW * 64;
    float* wab = (float*)(A.ws + WS_WAB);
    for (int i = gt; i < DEPTH * 8 * D; i += NT) { const int l = i / (8 * D), j = (i / D) & 7, k = i % D; wab[i] = A.in[I_WIN][((size_t)l * D + k) * INW + 1536 + j]; }
    float* ssmk = (float*)(A.ws + WS_SSMK); float* bbar = (float*)(A.ws + WS_BBAR);
    for (int i = gt; i < DEPTH * 16 * 64; i += NT) {
        const int lg = i >> 6;
        const float dt = expf(A.in[I_LOGDT][lg]), ar = A.in[I_ARE][i], ai = A.in[I_AIM][i];
        const float mag = expf(ar * dt);
        float rev = ai * dt * 0.15915494309189535f; rev -= floorf(rev);
        const float sn = __builtin_amdgcn_sinf(rev), cs = __builtin_amdgcn_cosf(rev);
        const float lr = mag * cs, li = mag * sn;
        float pr = lr, pi = li;
#pragma unroll
        for (int q = 0; q < 6; ++q) { const float nr2 = pr * pr - pi * pi, ni2 = 2.f * pr * pi; pr = nr2; pi = ni2; }
        ssmk[i * 4 + 0] = lr; ssmk[i * 4 + 1] = li; ssmk[i * 4 + 2] = pr; ssmk[i * 4 + 3] = pi;
        const float nr = lr - 1.f, ni = li, d2 = ar * ar + ai * ai;
        const float cre = (nr * ar + ni * ai) / d2, cim = (ni * ar - nr * ai) / d2;
#pragma unroll
        for (int h = 0; h < 16; ++h) { const float br = A.in[I_BRE][(size_t)i * 16 + h], bi = A.in[I_BIM][(size_t)i * 16 + h];
            bbar[(size_t)i * 32 + h] = cre * br - cim * bi; bbar[(size_t)i * 32 + 16 + h] = cre * bi + cim * br; }
    }
}

__device__ __forceinline__ void delta_prep_item(const DevArgs& A, int l, LAS unsigned char* lds, int item, int tid, int wave, int lane) {
    const int bh = item >> 5, n = item & 31, b = bh >> 2, h = bh & 3;
    const int tok0 = b * SEQ + n * 64;
    LAS bf16_t* QS = (LAS bf16_t*)(lds); LAS bf16_t* KS = (LAS bf16_t*)(lds + 17408);
    LAS float* RHS = (LAS float*)(lds + 34816);
    LAS float* AM = (LAS float*)(lds + 100352); LAS float* PM = (LAS float*)(lds + 117760);
    LAS float* GAM = (LAS float*)(lds + 135168); LAS float* BETA = GAM + 64; LAS float* RQ = GAM + 128; LAS float* RK = GAM + 192;
    const bf16_t* PROJ = (const bf16_t*)(A.ws + WS_PROJ);
    const float* AB = (const float*)(A.ws + WS_AB);
    if (tid < 384) {
        const int part = tid >> 7, c = tid & 127, col = part * 512 + h * 128 + c;
        const float* cw = A.in[I_CONVW] + (size_t)l * 4 * 1536;
        const float w0 = cw[col], w1 = cw[1536 + col], w2 = cw[3072 + col], w3 = cw[4608 + col];
        const bf16_t* pp = PROJ + (size_t)tok0 * NPROJ + col;
        float x0 = 0.f, x1 = 0.f, x2 = 0.f;
        if (n > 0) { x0 = bf2f(pp[-3 * NPROJ]); x1 = bf2f(pp[-2 * NPROJ]); x2 = bf2f(pp[-NPROJ]); }
#pragma unroll 4
        for (int t = 0; t < 64; ++t) {
            const float x3 = bf2f(pp[(size_t)t * NPROJ]);
            const float y = w0 * x0 + w1 * x1 + w2 * x2 + w3 * x3;
            const float s = silu_f(y);
            if (part == 0) QS[t * 136 + c] = (bf16_t)f2bf(s);
            else if (part == 1) KS[t * 136 + c] = (bf16_t)f2bf(s);
            else RHS[t * 256 + c] = s;
            x0 = x1; x1 = x2; x2 = x3;
        }
    } else if (tid < 448) {
        const int t = tid - 384;
        const float a = AB[(size_t)(tok0 + t) * 8 + h], bb = AB[(size_t)(tok0 + t) * 8 + 4 + h];
        const float xx = a + A.in[I_DTB][l * 4 + h];
        const float sp = xx > 20.f ? xx : log1pf(expf(xx));
        float lg = -expf(A.in[I_ALOG][l * 4 + h]) * sp;
#pragma unroll
        for (int off = 1; off < 64; off <<= 1) { const float v = __shfl_up(lg, off); if (lane >= off) lg += v; }
        GAM[t] = lg; BETA[t] = 1.f / (1.f + expf(-bb));
    }
    __syncthreads();
    {
        const int t = tid >> 3, part = tid & 7; float sq = 0.f, sk = 0.f;
#pragma unroll
        for (int j = 0; j < 16; ++j) { const float q = bf2f(QS[t * 136 + part * 16 + j]), k = bf2f(KS[t * 136 + part * 16 + j]); sq += q * q; sk += k * k; }
        sq += __shfl_xor(sq, 1); sq += __shfl_xor(sq, 2); sq += __shfl_xor(sq, 4);
        sk += __shfl_xor(sk, 1); sk += __shfl_xor(sk, 2); sk += __shfl_xor(sk, 4);
        if (part == 0) { RQ[t] = rsqrtf(sq + EPS) * 0.08838834764831845f; RK[t] = rsqrtf(sk + EPS); }
    }
    {
        const int prod = wave >> 2, mt = wave & 3, fr = lane & 15, quad = lane >> 4;
        LAS bf16_t* Aop = prod ? QS : KS; LAS float* dst = prod ? PM : AM;
        bf16x8 a[4];
#pragma unroll
        for (int kk = 0; kk < 4; ++kk) a[kk] = *(LAS bf16x8*)(Aop + (mt * 16 + fr) * 136 + kk * 32 + quad * 8);
#pragma unroll
        for (int nt = 0; nt < 4; ++nt) { f32x4 acc = {0.f, 0.f, 0.f, 0.f};
#pragma unroll
            for (int kk = 0; kk < 4; ++kk) { const bf16x8 bq = *(LAS bf16x8*)(KS + (nt * 16 + fr) * 136 + kk * 32 + quad * 8); acc = mfma16(a[kk], bq, acc); }
#pragma unroll
            for (int i = 0; i < 4; ++i) dst[(mt * 16 + quad * 4 + i) * 68 + nt * 16 + fr] = acc[i]; }
    }
    __syncthreads();
    bf16_t* DQK = (bf16_t*)(A.ws + WS_DQK) + (size_t)item * 4096;
    bf16_t* DQD = (bf16_t*)(A.ws + WS_DQD) + (size_t)item * 8192;
    bf16_t* DKT = (bf16_t*)(A.ws + WS_DKT) + (size_t)item * 8192;
    for (int idx = tid; idx < 4096; idx += 512) { const int t = idx >> 6, s = idx & 63;
        const float dec = (s <= t) ? __expf(GAM[t] - GAM[s]) : 0.f;
        const float am = AM[t * 68 + s], pm = PM[t * 68 + s];
        AM[t * 68 + s] = (s < t) ? BETA[t] * RK[t] * RK[s] * am * dec : 0.f;
        DQK[idx] = (bf16_t)f2bf(RQ[t] * RK[s] * pm * dec); }
    for (int idx = tid; idx < 8192; idx += 512) { const int t = idx >> 7, c = idx & 127; const float bt = BETA[t], eg = __expf(GAM[t]);
        const float kraw = bf2f(KS[t * 136 + c]), qraw = bf2f(QS[t * 136 + c]);
        RHS[t * 256 + c] *= bt; RHS[t * 256 + 128 + c] = bt * eg * RK[t] * kraw;
        DQD[idx] = (bf16_t)f2bf(qraw * RQ[t] * eg); }
    { const float g63 = GAM[63];
      for (int idx = tid; idx < 8192; idx += 512) { const int c = idx >> 6, t = idx & 63; DKT[idx] = (bf16_t)f2bf(bf2f(KS[t * 136 + c]) * RK[t] * __expf(g63 - GAM[t])); }
      if (tid == 0) ((float*)(A.ws + WS_DGL))[item] = __expf(g63); }
    __syncthreads();
    if (tid < 256) {
        float sol[64];
        LAS float* amp = AM; asm volatile("" : "+v"(amp));
        LAS float* rhp = RHS + tid; asm volatile("" : "+v"(rhp));
#pragma unroll
        for (int t = 0; t < 64; ++t) { float acc = rhp[t * 256];
#pragma unroll
            for (int s = 0; s < t; ++s) acc = fmaf(-amp[t * 68 + s], sol[s], acc);
            sol[t] = acc; __builtin_amdgcn_sched_barrier(0); }
        if (tid < 128) { float* DW = (float*)(A.ws + WS_DW) + (size_t)item * 8192 + tid;
#pragma unroll
            for (int t = 0; t < 64; ++t) DW[t * 128] = sol[t]; }
        else { bf16_t* DKC = (bf16_t*)(A.ws + WS_DKC) + (size_t)item * 8192 + (tid - 128);
#pragma unroll
            for (int t = 0; t < 64; ++t) DKC[t * 128] = (bf16_t)f2bf(-sol[t]); }
    }
    __syncthreads();
}

__device__ __forceinline__ void delta_scan_item(const DevArgs& A, int l, LAS unsigned char* lds, int bh, int tid_in, int wave, int lane_in) {
    const int b = bh >> 2, h = bh & 3;
    LAS unsigned char* KCs = lds; LAS unsigned char* QDs = lds + 17408; LAS unsigned char* QKs = lds + 34816; LAS unsigned char* KDTs = lds + 44032;
    LAS unsigned char* SS = lds + 62464 + wave * 4352; LAS unsigned char* US = lds + 97280 + wave * 2304;
    LAS float* PART = (LAS float*)(lds + 115712);
    const unsigned char* gKC = A.ws + WS_DKC; const unsigned char* gQD = A.ws + WS_DQD; const unsigned char* gQK = A.ws + WS_DQK; const unsigned char* gKT = A.ws + WS_DKT;
    const float* DGL = (const float*)(A.ws + WS_DGL);
    f32x4 S[8];
#pragma unroll
    for (int mt = 0; mt < 8; ++mt) S[mt] = (f32x4){0.f, 0.f, 0.f, 0.f};
    u32x4 r[7];
#define DS_LOAD(itn, toff) do { const size_t _i = (size_t)(itn); const unsigned char* _kc = gKC + _i * 16384; const unsigned char* _qd = gQD + _i * 16384; \
        const unsigned char* _qk = gQK + _i * 8192; const unsigned char* _kt = gKT + _i * 16384; \
        r[0] = *(const u32x4*)(_kc + (toff)); r[1] = *(const u32x4*)(_kc + (toff) + 8192u); \
        r[2] = *(const u32x4*)(_qd + (toff)); r[3] = *(const u32x4*)(_qd + (toff) + 8192u); \
        r[4] = *(const u32x4*)(_qk + (toff)); \
        r[5] = *(const u32x4*)(_kt + (toff)); r[6] = *(const u32x4*)(_kt + (toff) + 8192u); } while (0)
    { const unsigned t0 = (unsigned)tid_in * 16u; DS_LOAD(bh * 32, t0); }
#pragma unroll 1
    for (int n = 0; n < 32; ++n) {
        int tid = tid_in; asm volatile("" : "+v"(tid));
        const int lane = tid & 63, fr = lane & 15, quad = lane >> 4, vcol = 16 * wave + fr;
        const unsigned toff = (unsigned)tid * 16u;
        const int it = bh * 32 + n, tokb = b * SEQ + n * 64;
        __syncthreads();
        { const int i0 = tid, i1 = tid + 512;
          *(LAS u32x4*)(KCs + (i0 >> 4) * 272 + (i0 & 15) * 16) = r[0]; *(LAS u32x4*)(KCs + (i1 >> 4) * 272 + (i1 & 15) * 16) = r[1];
          *(LAS u32x4*)(QDs + (i0 >> 4) * 272 + (i0 & 15) * 16) = r[2]; *(LAS u32x4*)(QDs + (i1 >> 4) * 272 + (i1 & 15) * 16) = r[3];
          *(LAS u32x4*)(QKs + (i0 >> 3) * 144 + (i0 & 7) * 16) = r[4];
          *(LAS u32x4*)(KDTs + (i0 >> 3) * 144 + (i0 & 7) * 16) = r[5]; *(LAS u32x4*)(KDTs + (i1 >> 3) * 144 + (i1 & 7) * 16) = r[6]; }
        __syncthreads();
        const float glast = DGL[it];
        const float* dwb = (const float*)(A.ws + WS_DW) + (size_t)it * 8192;
        const unsigned woff = (unsigned)(quad * 4 * 128 + vcol);
#pragma unroll
        for (int mt = 0; mt < 8; ++mt) { u32x2 p; p.x = pk2(S[mt][0], S[mt][1]); p.y = pk2(S[mt][2], S[mt][3]); *(LAS u32x2*)(SS + fr * 272 + (mt * 16 + quad * 4) * 2) = p; }
        LDS_FENCE();
        bf16x8 Sb[4];
#pragma unroll
        for (int kk = 0; kk < 4; ++kk) Sb[kk] = *(LAS bf16x8*)(SS + fr * 272 + (kk * 32 + quad * 8) * 2);
        f32x4 U[4], O[4];
#pragma unroll
        for (int mt = 0; mt < 4; ++mt) { f32x4 au, ao = {0.f, 0.f, 0.f, 0.f};
#pragma unroll
            for (int i = 0; i < 4; ++i) au[i] = dwb[woff + (unsigned)((mt * 16 + i) * 128)];
#pragma unroll
            for (int kk = 0; kk < 4; ++kk) { const bf16x8 a1 = *(LAS bf16x8*)(KCs + (mt * 16 + fr) * 272 + (kk * 32 + quad * 8) * 2); au = mfma16(a1, Sb[kk], au);
                const bf16x8 a2 = *(LAS bf16x8*)(QDs + (mt * 16 + fr) * 272 + (kk * 32 + quad * 8) * 2); ao = mfma16(a2, Sb[kk], ao); }
            U[mt] = au; O[mt] = ao; __builtin_amdgcn_sched_barrier(0); }
        if (n + 1 < 32) DS_LOAD(it + 1, toff);
#pragma unroll
        for (int mt = 0; mt < 4; ++mt) { u32x2 p; p.x = pk2(U[mt][0], U[mt][1]); p.y = pk2(U[mt][2], U[mt][3]); *(LAS u32x2*)(US + fr * 144 + (mt * 16 + quad * 4) * 2) = p; }
        LDS_FENCE();
        bf16x8 Ub[2];
#pragma unroll
        for (int kk = 0; kk < 2; ++kk) Ub[kk] = *(LAS bf16x8*)(US + fr * 144 + (kk * 32 + quad * 8) * 2);
#pragma unroll
        for (int mt = 0; mt < 4; ++mt)
#pragma unroll
            for (int kk = 0; kk < 2; ++kk) { const bf16x8 a = *(LAS bf16x8*)(QKs + (mt * 16 + fr) * 144 + (kk * 32 + quad * 8) * 2); O[mt] = mfma16(a, Ub[kk], O[mt]); }
        __builtin_amdgcn_sched_barrier(0);
#pragma unroll
        for (int mt = 0; mt < 8; ++mt) { S[mt] *= glast;
#pragma unroll
            for (int kk = 0; kk < 2; ++kk) { const bf16x8 a = *(LAS bf16x8*)(KDTs + (mt * 16 + fr) * 144 + (kk * 32 + quad * 8) * 2); S[mt] = mfma16(a, Ub[kk], S[mt]); }
            if (mt & 1) __builtin_amdgcn_sched_barrier(0); }
#pragma unroll
        for (int mt = 0; mt < 4; ++mt)
#pragma unroll
            for (int i = 0; i < 4; ++i) { float p = O[mt][i] * O[mt][i]; p += __shfl_xor(p, 1); p += __shfl_xor(p, 2); p += __shfl_xor(p, 4); p += __shfl_xor(p, 8);
                if (fr == 0) PART[wave * 64 + mt * 16 + quad * 4 + i] = p; }
        __syncthreads();
        const float onorm = A.in[I_ONORM][l * 128 + vcol];
        const bf16_t* gateb = (const bf16_t*)(A.ws + WS_PROJ) + (size_t)tokb * NPROJ + PC_G + h * 128;
        bf16_t* mixb = (bf16_t*)(A.ws + WS_MIX) + (size_t)tokb * D + h * 128;
#pragma unroll
        for (int mt = 0; mt < 4; ++mt)
#pragma unroll
            for (int i = 0; i < 4; ++i) { const int t = mt * 16 + quad * 4 + i; float tot = 0.f;
#pragma unroll
                for (int w = 0; w < 8; ++w) tot += PART[w * 64 + t];
                const float sc = rsqrtf(tot * (1.f / 128.f) + EPS) * onorm;
                const float gtv = bf2f(gateb[(unsigned)(t * NPROJ + vcol)]);
                mixb[(unsigned)(t * D + vcol)] = (bf16_t)f2bf(O[mt][i] * sc * silu_f(gtv)); }
    }
#undef DS_LOAD
    { const int lane = lane_in, fr = lane & 15, quad = lane >> 4, vcol = 16 * wave + fr;
      float* dp = A.out + O_DP + (size_t)((l * 8 + b) * 4 + h) * 16384;
#pragma unroll
      for (int mt = 0; mt < 8; ++mt)
#pragma unroll
          for (int i = 0; i < 4; ++i) dp[(mt * 16 + quad * 4 + i) * 128 + vcol] = S[mt][i]; }
    __syncthreads();
}

__device__ __forceinline__ void delta_sample_item(const DevArgs& A, int l, LAS unsigned char* lds, int item, int tid, int wave, int lane) {
    const int b = item >> 2, h = item & 3, tokS = NP + b * 4;
    LAS float* RAW = (LAS float*)lds; LAS float* RED = RAW + 1536; LAS float* OB = RED + 512; LAS float* SC = OB + 512;
    const bf16_t* PROJ = (const bf16_t*)(A.ws + WS_PROJ); const float* AB = (const float*)(A.ws + WS_AB); bf16_t* MIX = (bf16_t*)(A.ws + WS_MIX);
    const float* cw = A.in[I_CONVW] + (size_t)l * 4 * 1536;
    for (int idx = tid; idx < 1536; idx += 512) { const int part = idx >> 9, t = (idx >> 7) & 3, c = idx & 127, col = part * 512 + h * 128 + c;
        float acc = 0.f;
#pragma unroll
        for (int j = 0; j < 4; ++j) { const int tt = t - 3 + j;
            const float x = (tt >= 0) ? bf2f(PROJ[(size_t)(tokS + tt) * NPROJ + col]) : A.in[I_SCONV][((size_t)(l * 128 + b) * 3 + (3 + tt)) * 1536 + col];
            acc += cw[j * 1536 + col] * x; }
        RAW[idx] = silu_f(acc); }
    if (tid < 4) { const float a = AB[(size_t)(tokS + tid) * 8 + h], bb = AB[(size_t)(tokS + tid) * 8 + 4 + h];
        const float xx = a + A.in[I_DTB][l * 4 + h]; const float sp = xx > 20.f ? xx : log1pf(expf(xx));
        SC[8 + tid] = 1.f / (1.f + expf(-bb)); SC[12 + tid] = expf(-expf(A.in[I_ALOG][l * 4 + h]) * sp); }
    const int v = tid & 127, kq = tid >> 7;
    float S[32];
    { const float* sp = A.in[I_SDELTA] + (size_t)((l * 128 + b) * 4 + h) * 16384;
#pragma unroll
      for (int i = 0; i < 32; ++i) S[i] = sp[(kq * 32 + i) * 128 + v]; }
    __syncthreads();
    { const int part = wave >> 2, t = wave & 3; const float x0 = RAW[part * 512 + t * 128 + lane], x1 = RAW[part * 512 + t * 128 + 64 + lane];
      const float ss = wave_sum(x0 * x0 + x1 * x1); if (lane == 0) SC[part * 4 + t] = rsqrtf(ss + EPS) * (part == 0 ? 0.08838834764831845f : 1.f); }
    __syncthreads();
    for (int t = 0; t < 4; ++t) {
        const float rq = SC[t], rk = SC[4 + t], beta = SC[8 + t], g = SC[12 + t];
        float pr = 0.f;
#pragma unroll
        for (int i = 0; i < 32; ++i) pr += S[i] * RAW[512 + t * 128 + kq * 32 + i];
        RED[kq * 128 + v] = pr * rk;
        __syncthreads();
        const float rr = (RED[v] + RED[128 + v]) + (RED[256 + v] + RED[384 + v]);
        const float u = beta * (RAW[1024 + t * 128 + v] - g * rr);
        float po = 0.f;
#pragma unroll
        for (int i = 0; i < 32; ++i) { const float kh = RAW[512 + t * 128 + kq * 32 + i] * rk; S[i] = g * S[i] + kh * u; po += S[i] * RAW[t * 128 + kq * 32 + i]; }
        __syncthreads();
        RED[kq * 128 + v] = po * rq;
        __syncthreads();
        if (kq == 0) OB[t * 128 + v] = (RED[v] + RED[128 + v]) + (RED[256 + v] + RED[384 + v]);
        __syncthreads();
    }
    if (wave < 4) { const int t = wave; const float x0 = OB[t * 128 + lane], x1 = OB[t * 128 + 64 + lane];
        const float ss = wave_sum(x0 * x0 + x1 * x1); const float sc = rsqrtf(ss * (1.f / 128.f) + EPS);
        const float g0 = bf2f(PROJ[(size_t)(tokS + t) * NPROJ + PC_G + h * 128 + lane]), g1 = bf2f(PROJ[(size_t)(tokS + t) * NPROJ + PC_G + h * 128 + 64 + lane]);
        MIX[(size_t)(tokS + t) * D + h * 128 + lane] = (bf16_t)f2bf(x0 * sc * A.in[I_ONORM][l * 128 + lane] * silu_f(g0));
        MIX[(size_t)(tokS + t) * D + h * 128 + 64 + lane] = (bf16_t)f2bf(x1 * sc * A.in[I_ONORM][l * 128 + 64 + lane] * silu_f(g1)); }
    { float* dsp = A.out + O_DS + (size_t)((l * 128 + b) * 4 + h) * 16384;
#pragma unroll
      for (int i = 0; i < 32; ++i) dsp[(kq * 32 + i) * 128 + v] = S[i]; }
    __syncthreads();
}

#define SSM_BCAST_U(t) do { unsigned _w[8]; \
        _w[0] = __builtin_amdgcn_readlane(ua.x, t); _w[1] = __builtin_amdgcn_readlane(ua.y, t); _w[2] = __builtin_amdgcn_readlane(ua.z, t); _w[3] = __builtin_amdgcn_readlane(ua.w, t); \
        _w[4] = __builtin_amdgcn_readlane(ub.x, t); _w[5] = __builtin_amdgcn_readlane(ub.y, t); _w[6] = __builtin_amdgcn_readlane(ub.z, t); _w[7] = __builtin_amdgcn_readlane(ub.w, t); \
        _Pragma("unroll") for (int _d = 0; _d < 8; ++_d) { uu[2 * _d] = __uint_as_float(_w[_d] << 16); uu[2 * _d + 1] = __uint_as_float(_w[_d] & 0xffff0000u); } } while (0)
#define SSM_STEP() do { float _br = 0.f, _bi = 0.f; \
        _Pragma("unroll") for (int _h = 0; _h < 16; ++_h) { _br = fmaf(Br[_h], uu[_h], _br); _bi = fmaf(Bi[_h], uu[_h], _bi); } \
        const float _nr = lr * hr - li * hi + _br, _ni = lr * hi + li * hr + _bi; hr = _nr; hi = _ni; } while (0)

__device__ __forceinline__ void ssm_part1_item(const DevArgs& A, int l, int it, int lane) {
    const int g = it & 15, bc = it >> 4, b = bc / 31, c = bc % 31;
    const float* bb = (const float*)(A.ws + WS_BBAR) + ((size_t)(l * 16 + g) * 64 + lane) * 32;
    float Br[16], Bi[16];
#pragma unroll
    for (int q = 0; q < 4; ++q) { const f32x4 x = ((const f32x4*)bb)[q], y = ((const f32x4*)bb)[4 + q];
        Br[4 * q] = x.x; Br[4 * q + 1] = x.y; Br[4 * q + 2] = x.z; Br[4 * q + 3] = x.w; Bi[4 * q] = y.x; Bi[4 * q + 1] = y.y; Bi[4 * q + 2] = y.z; Bi[4 * q + 3] = y.w; }
    const f32x4 lk = ((const f32x4*)(A.ws + WS_SSMK))[(l * 16 + g) * 64 + lane]; const float lr = lk.x, li = lk.y;
    const bf16_t* up = (const bf16_t*)(A.ws + WS_PROJ) + (size_t)(b * SEQ + c * 64 + lane) * NPROJ + PC_SSM + g * 16;
    const u32x4 ua = *(const u32x4*)up, ub = *(const u32x4*)(up + 8);
    float hr = 0.f, hi = 0.f, uu[16];
#pragma unroll 1
    for (int t = 0; t < 64; ++t) { SSM_BCAST_U(t); SSM_STEP(); }
    f32x2 e; e.x = hr; e.y = hi;
    ((f32x2*)(A.ws + WS_SSME))[((size_t)(b * 32 + c) * 16 + g) * 64 + lane] = e;
}

__device__ __forceinline__ void ssm_part2_item(const DevArgs& A, int l, LAS unsigned char* lds, int it, int tid, int wave, int lane) {
    const int tok0 = it * 64, fr = lane & 15, quad = lane >> 4;
    const bool samp = it >= 256; const int b = it >> 5, c = it & 31;
    LAS unsigned char* YS = lds; LAS unsigned char* HS = lds + 33792 + wave * 4352;
    const bf16_t* PROJ = (const bf16_t*)(A.ws + WS_PROJ); bf16_t* MIX = (bf16_t*)(A.ws + WS_MIX);
#pragma unroll 1
    for (int gi = 0; gi < 2; ++gi) {
        const int g = wave * 2 + gi;
        const float* bb = (const float*)(A.ws + WS_BBAR) + ((size_t)(l * 16 + g) * 64 + lane) * 32;
        float Br[16], Bi[16];
#pragma unroll
        for (int q = 0; q < 4; ++q) { const f32x4 x = ((const f32x4*)bb)[q], y = ((const f32x4*)bb)[4 + q];
            Br[4 * q] = x.x; Br[4 * q + 1] = x.y; Br[4 * q + 2] = x.z; Br[4 * q + 3] = x.w; Bi[4 * q] = y.x; Bi[4 * q + 1] = y.y; Bi[4 * q + 2] = y.z; Bi[4 * q + 3] = y.w; }
        const f32x4 lk = ((const f32x4*)(A.ws + WS_SSMK))[(l * 16 + g) * 64 + lane]; const float lr = lk.x, li = lk.y, Lr = lk.z, Li = lk.w;
        bf16x8 Cb[4];
#pragma unroll
        for (int kk = 0; kk < 4; ++kk) { const float* cp = A.in[kk < 2 ? I_CRE : I_CIM] + ((size_t)(l * 16 + g) * 16 + fr) * 64 + (kk & 1) * 32 + quad * 8;
            const f32x4 c0 = *(const f32x4*)cp, c1 = *(const f32x4*)(cp + 4); const float sg = kk < 2 ? 1.f : -1.f;
            u32x4 pk; pk.x = pk2(sg * c0.x, sg * c0.y); pk.y = pk2(sg * c0.z, sg * c0.w); pk.z = pk2(sg * c1.x, sg * c1.y); pk.w = pk2(sg * c1.z, sg * c1.w);
            Cb[kk] = __builtin_bit_cast(bf16x8, pk); }
        const bf16_t* up = PROJ + (size_t)(tok0 + lane) * NPROJ + PC_SSM + g * 16;
        const u32x4 ua = *(const u32x4*)up, ub = *(const u32x4*)(up + 8);
        float hr = 0.f, hi = 0.f, uu[16];
        if (!samp) { const f32x2* E = (const f32x2*)(A.ws + WS_SSME);
            for (int cc = 0; cc < c; ++cc) { const f32x2 e = E[((size_t)(b * 32 + cc) * 16 + g) * 64 + lane]; const float nr = Lr * hr - Li * hi + e.x, ni = Lr * hi + Li * hr + e.y; hr = nr; hi = ni; } }
        const float dsk = A.in[I_SSMD][l * 256 + g * 16 + fr];
#pragma unroll 1
        for (int sub = 0; sub < 4; ++sub) {
#pragma unroll 1
            for (int tt = 0; tt < 16; ++tt) { const int t = sub * 16 + tt;
                const int sb = (it - 256) * 16 + (t >> 2);
                if (samp && (t & 3) == 0) { hr = A.in[I_SRE][((size_t)(l * 128 + sb) * 16 + g) * 64 + lane]; hi = A.in[I_SIM][((size_t)(l * 128 + sb) * 16 + g) * 64 + lane]; }
                SSM_BCAST_U(t); SSM_STEP();
                *(LAS bf16_t*)(HS + tt * 272 + lane * 2) = (bf16_t)f2bf(hr); *(LAS bf16_t*)(HS + tt * 272 + (64 + lane) * 2) = (bf16_t)f2bf(hi);
                if (samp && (t & 3) == 3) { A.out[O_RES + ((size_t)(l * 128 + sb) * 16 + g) * 64 + lane] = hr; A.out[O_IMS + ((size_t)(l * 128 + sb) * 16 + g) * 64 + lane] = hi; }
            }
            LDS_FENCE();
            f32x4 acc = {0.f, 0.f, 0.f, 0.f};
#pragma unroll
            for (int kk = 0; kk < 4; ++kk) { const bf16x8 a = *(LAS bf16x8*)(HS + fr * 272 + (kk * 32 + quad * 8) * 2); acc = mfma16(a, Cb[kk], acc); }
#pragma unroll
            for (int i = 0; i < 4; ++i) { const int t = sub * 16 + quad * 4 + i; const float uv = bf2f(PROJ[(size_t)(tok0 + t) * NPROJ + PC_SSM + g * 16 + fr]);
                *(LAS bf16_t*)(YS + t * 528 + (g * 16 + fr) * 2) = (bf16_t)f2bf(gelu_tanh_f(acc[i] + dsk * uv)); }
            LDS_FENCE();
        }
        if (!samp && c == 31) { A.out[O_REP + ((size_t)(l * 8 + b) * 16 + g) * 64 + lane] = hr; A.out[O_IMP + ((size_t)(l * 8 + b) * 16 + g) * 64 + lane] = hi; }
    }
    __syncthreads();
    {
        const bf16_t* GT = (const bf16_t*)(A.ws + WS_GLUT + l * SZ_GLUT);
        f32x4 acc[4][2];
#pragma unroll
        for (int mt = 0; mt < 4; ++mt) { acc[mt][0] = (f32x4){0.f, 0.f, 0.f, 0.f}; acc[mt][1] = (f32x4){0.f, 0.f, 0.f, 0.f}; }
#pragma unroll
        for (int kk = 0; kk < 8; ++kk) { bf16x8 bfr[2];
#pragma unroll
            for (int nt = 0; nt < 2; ++nt) bfr[nt] = *(const bf16x8*)(GT + (size_t)(32 * wave + nt * 16 + fr) * 256 + kk * 32 + quad * 8);
#pragma unroll
            for (int mt = 0; mt < 4; ++mt) { const bf16x8 a = *(LAS bf16x8*)(YS + (mt * 16 + fr) * 528 + (kk * 32 + quad * 8) * 2);
                acc[mt][0] = mfma16(a, bfr[0], acc[mt][0]); acc[mt][1] = mfma16(a, bfr[1], acc[mt][1]); } }
#pragma unroll
        for (int nt = 0; nt < 2; ++nt) { const int ncol = 32 * wave + nt * 16 + fr; const float gb = A.in[I_GLUB][l * 256 + ncol];
#pragma unroll
            for (int mt = 0; mt < 4; ++mt)
#pragma unroll
                for (int i = 0; i < 4; ++i) { const int t = mt * 16 + quad * 4 + i; const float y = bf2f(*(LAS bf16_t*)(YS + t * 528 + ncol * 2));
                    MIX[(size_t)(tok0 + t) * D + 512 + ncol] = (bf16_t)f2bf(y * sigmoid_f(acc[mt][nt][i] + gb)); } }
    }
    __syncthreads();
}

__device__ __forceinline__ void pool_item(const DevArgs& A, int l, LAS unsigned char* lds, int it, int tid, int wave, int lane) {
    const int tok0 = it * 64, fr = lane & 15, quad = lane >> 4; const bool samp = it >= 256;
    LAS unsigned char* RS = lds;
    const bf16_t* PROJ = (const bf16_t*)(A.ws + WS_PROJ); bf16_t* MIX = (bf16_t*)(A.ws + WS_MIX);
    { const int ch = tid & 255, half = tid >> 8, g = ch >> 6, w = 2 << g;
      for (int rr = 0; rr < 32; ++rr) { const int r = half * 32 + rr; float sum = 0.f, u, cnt;
          if (!samp) { const int b = it >> 5, tl = (it & 31) * 64 + r; const bf16_t* base = PROJ + (size_t)(b * SEQ) * NPROJ + PC_POOL + ch;
              for (int j = 0; j < w; ++j) { const int tt = tl - j; if (tt >= 0) sum += bf2f(base[(size_t)tt * NPROJ]); }
              cnt = (float)((tl + 1 < w) ? tl + 1 : w); u = bf2f(base[(size_t)tl * NPROJ]); }
          else { const int sb = (it - 256) * 16 + (r >> 2), tl = r & 3; const bf16_t* base = PROJ + (size_t)(NP + sb * 4) * NPROJ + PC_POOL + ch;
              const float* sbuf = A.in[I_SPOOL] + (size_t)(l * 128 + sb) * 15 * 256 + ch;
              for (int j = 0; j < w; ++j) { const int tt = tl - j; sum += (tt >= 0) ? bf2f(base[(size_t)tt * NPROJ]) : sbuf[(15 + tt) * 256]; }
              cnt = (float)w; u = bf2f(base[(size_t)tl * NPROJ]); }
          *(LAS bf16_t*)(RS + r * 528 + ch * 2) = (bf16_t)f2bf(sum / cnt - u); } }
    __syncthreads();
    { const int g2 = wave >> 1; const bf16_t* PT = (const bf16_t*)(A.ws + WS_POOLT + l * SZ_POOLT) + g2 * 4096;
      f32x4 acc[4][2];
#pragma unroll
      for (int mt = 0; mt < 4; ++mt) { acc[mt][0] = (f32x4){0.f, 0.f, 0.f, 0.f}; acc[mt][1] = (f32x4){0.f, 0.f, 0.f, 0.f}; }
#pragma unroll
      for (int kk = 0; kk < 2; ++kk) { bf16x8 bfr[2];
#pragma unroll
          for (int nt = 0; nt < 2; ++nt) bfr[nt] = *(const bf16x8*)(PT + (size_t)((wave & 1) * 32 + nt * 16 + fr) * 64 + kk * 32 + quad * 8);
#pragma unroll
          for (int mt = 0; mt < 4; ++mt) { const bf16x8 a = *(LAS bf16x8*)(RS + (mt * 16 + fr) * 528 + (g2 * 64 + kk * 32 + quad * 8) * 2);
              acc[mt][0] = mfma16(a, bfr[0], acc[mt][0]); acc[mt][1] = mfma16(a, bfr[1], acc[mt][1]); } }
#pragma unroll
      for (int nt = 0; nt < 2; ++nt) { const int col = 32 * wave + nt * 16 + fr; const float ps = A.in[I_POOLS][l * 256 + col];
#pragma unroll
          for (int mt = 0; mt < 4; ++mt)
#pragma unroll
              for (int i = 0; i < 4; ++i) { const int t = mt * 16 + quad * 4 + i; MIX[(size_t)(tok0 + t) * D + 768 + col] = (bf16_t)f2bf(acc[mt][nt][i] * ps); } } }
    __syncthreads();
}

__device__ __forceinline__ void state_copies(const DevArgs& A, int l, int gt, int NT) {
    const bf16_t* PROJ = (const bf16_t*)(A.ws + WS_PROJ);
    for (int i = gt; i < 8 * 3 * 1536; i += NT) { const int col = i % 1536, j = (i / 1536) % 3, b = i / 4608;
        A.out[O_CP + (size_t)l * 8 * 4608 + i] = bf2f(PROJ[(size_t)(b * SEQ + SEQ - 3 + j) * NPROJ + col]); }
    for (int i = gt; i < 128 * 3 * 1536; i += NT) { const int col = i % 1536, j = (i / 1536) % 3, b = i / 4608;
        A.out[O_CS + (size_t)l * 128 * 4608 + i] = bf2f(PROJ[(size_t)(NP + b * 4 + 1 + j) * NPROJ + col]); }
    for (int i = gt; i < 8 * 15 * 256; i += NT) { const int ch = i & 255, j = (i >> 8) % 15, b = i / 3840;
        A.out[O_PP + (size_t)l * 8 * 3840 + i] = bf2f(PROJ[(size_t)(b * SEQ + SEQ - 15 + j) * NPROJ + PC_POOL + ch]); }
    for (int i = gt; i < 128 * 15 * 256; i += NT) { const int ch = i & 255, j = (i >> 8) % 15, b = i / 3840;
        A.out[O_PS + (size_t)l * 128 * 3840 + i] = (j < 11) ? A.in[I_SPOOL][((size_t)(l * 128 + b) * 15 + 4 + j) * 256 + ch]
                                                             : bf2f(PROJ[(size_t)(NP + b * 4 + (j - 11)) * NPROJ + PC_POOL + ch]); }
}

constexpr int NPH = 2 + DEPTH * 8;
__global__ void __launch_bounds__(512, 2) mega_fwd(Args KA) {
    DevArgs A; A.out = KA.out; A.ws = KA.ws; A.ph_lo = KA.ph_lo; A.ph_hi = KA.ph_hi;
    extern __shared__ __attribute__((aligned(16))) unsigned char lds_raw[];
    LAS unsigned char* lds = (LAS unsigned char*)lds_raw;
    cg::grid_group grid = cg::this_grid();
    const int G = gridDim.x, NGW = G * 8, NT = G * 512;
    int ph = 0;
#define PH_BEGIN if (A.ph_lo <= ph && ph < A.ph_hi) { int tid = threadIdx.x; asm volatile("" : "+v"(tid)); const int wave = __builtin_amdgcn_readfirstlane(tid >> 6), lane = tid & 63, gw = blockIdx.x * 8 + wave, gt = blockIdx.x * 512 + tid; (void)gw; (void)gt; (void)lane;
#define PH_END   if (ph + 1 < A.ph_hi) grid.sync(); } ++ph;
    bf16_t* Hb = (bf16_t*)(A.ws + WS_H); float* AB = (float*)(A.ws + WS_AB); float* MIXO = (float*)(A.ws + WS_MIXO);
    bf16_t* PROJ = (bf16_t*)(A.ws + WS_PROJ); bf16_t* MIX = (bf16_t*)(A.ws + WS_MIX); bf16_t* HID = (bf16_t*)(A.ws + WS_HID);

#ifndef NO_PRO
    PH_BEGIN prologue(A, lds, wave, lane, gw, NGW); __syncthreads(); PH_END
#endif
#ifndef NO_N0
    PH_BEGIN norm_rows(nullptr, nullptr, A.in[I_XP], A.in[I_XS], nullptr, A.in[I_NMPRE], Hb, (const float*)(A.ws + WS_WAB), AB, gw, NGW, lane); PH_END
#endif

#pragma unroll 1
    for (int l = 0; l < DEPTH; ++l) {
#ifndef NO_G1
        PH_BEGIN { pg8::Gemm g{Hb, (const bf16_t*)(A.ws + WS_WIN + l * SZ_WIN), NTOK, NPROJ, D}; pg8::StaticOrder S; S.init(NTOK, NPROJ, G, (int)blockIdx.x);
            pg8::EpiBf16<0> E{PROJ, NPROJ, nullptr, 0, 0}; pg8::gemm_phase<pg8::EpiBf16<0>, pg8::StaticOrder>(lds, g, S, E, nullptr); } PH_END
#endif
        PH_BEGIN {
            #ifndef NO_DPREP
            for (int it = blockIdx.x; it < 1024; it += G) delta_prep_item(A, l, lds, it, tid, wave, lane);
#endif
            #ifndef NO_DSAMP
            for (int it = blockIdx.x; it < 512; it += G) delta_sample_item(A, l, lds, it, tid, wave, lane);
#endif
            #ifndef NO_SSM1
            for (int it = gw; it < 8 * 31 * 16; it += NGW) ssm_part1_item(A, l, it, lane);
#endif
            #ifndef NO_POOL
            for (int it = blockIdx.x; it < 264; it += G) pool_item(A, l, lds, it, tid, wave, lane);
#endif
            state_copies(A, l, gt, NT);
        } PH_END
        PH_BEGIN {
#ifndef NO_P3
            const int nd = (G > 64) ? 32 : 0;
#ifndef NO_DSCAN
            if (nd == 0 || (int)blockIdx.x < nd) for (int it = blockIdx.x; it < 32; it += G) delta_scan_item(A, l, lds, it, tid, wave, lane);
#endif
#ifndef NO_SSM2
            if (nd == 0 || (int)blockIdx.x >= nd) for (int it = blockIdx.x - nd; it < 264; it += G - nd) ssm_part2_item(A, l, lds, it, tid, wave, lane);
#endif
#endif
        } PH_END
#ifndef NO_G2
        PH_BEGIN { pg8::Gemm g{MIX, (const bf16_t*)(A.ws + WS_WOUT + l * SZ_WOUT), NTOK, D, D}; pg8::StaticOrder S; S.init(NTOK, D, G, (int)blockIdx.x);
            pg8::EpiF32 E{MIXO, D, nullptr}; pg8::gemm_phase<pg8::EpiF32, pg8::StaticOrder>(lds, g, S, E, nullptr); } PH_END
#endif
#ifndef NO_N5
        PH_BEGIN norm_rows(MIXO, A.in[I_NMPOST] + l * D, l == 0 ? A.in[I_XP] : A.out, l == 0 ? A.in[I_XS] : nullptr, A.out, A.in[I_NFPRE] + l * D, Hb, nullptr, nullptr, gw, NGW, lane); PH_END
#endif
#ifndef NO_G3
        PH_BEGIN { pg8::Gemm g{Hb, (const bf16_t*)(A.ws + WS_WGU + l * SZ_WGU), NTOK, NGU, D}; pg8::StaticOrder S; S.init(NTOK, NGU, G, (int)blockIdx.x);
            EpiSwiGLU E{HID, DFF}; pg8::gemm_phase<EpiSwiGLU, pg8::StaticOrder>(lds, g, S, E, nullptr); } PH_END
#endif
#ifndef NO_G4
        PH_BEGIN { pg8::Gemm g{HID, (const bf16_t*)(A.ws + WS_WDN + l * SZ_WDN), NTOK, D, DFF}; pg8::StaticOrder S; S.init(NTOK, D, G, (int)blockIdx.x);
            pg8::EpiF32 E{MIXO, D, nullptr}; pg8::gemm_phase<pg8::EpiF32, pg8::StaticOrder>(lds, g, S, E, nullptr); } PH_END
#endif
#ifndef NO_N8
        PH_BEGIN norm_rows(MIXO, A.in[I_NFPOST] + l * D, A.out, nullptr, A.out, l + 1 < DEPTH ? A.in[I_NMPRE] + (l + 1) * D : nullptr, l + 1 < DEPTH ? Hb : nullptr,
                           l + 1 < DEPTH ? (const float*)(A.ws + WS_WAB + (l + 1) * SZ_WAB) : nullptr, AB, gw, NGW, lane); PH_END
#endif
    }
#undef PH_BEGIN
#undef PH_END
}

extern "C" void kernel_launch(void* const* d_in, const int* in_sizes, int n_in, void* d_out, int out_size, void* d_ws, size_t ws_size, hipStream_t stream) {
    static int grid = 0;
    if (grid == 0) {
        if (n_in != 32 || (size_t)out_size != O_END || ws_size < WS_END) fprintf(stderr, "kernel_launch: unexpected sizes: n_in %d out %d (want %zu) ws %zu (want >= %zu)\n", n_in, out_size, (size_t)O_END, ws_size, (size_t)WS_END);
        int dev = 0, cus = 0, per_cu = 0;
        (void)hipGetDevice(&dev); (void)hipDeviceGetAttribute(&cus, hipDeviceAttributeMultiprocessorCount, dev);
        if (hipFuncSetAttribute((const void*)mega_fwd, hipFuncAttributeMaxDynamicSharedMemorySize, LDS_BYTES) != hipSuccess) fprintf(stderr, "kernel_launch: hipFuncSetAttribute failed\n");
        if (hipOccupancyMaxActiveBlocksPerMultiprocessor(&per_cu, (const void*)mega_fwd, 512, LDS_BYTES) != hipSuccess || per_cu < 1) { fprintf(stderr, "kernel_launch: occupancy query gave %d\n", per_cu); per_cu = 1; (void)hipGetLastError(); }
        grid = cus * per_cu; if (grid <= 0) grid = 256;
        fprintf(stderr, "kernel_launch: grid %d (cus %d x %d)\n", grid, cus, per_cu);
    }
    Args a{};
    for (int i = 0; i < 32; ++i) a.in[i] = (const float*)d_in[i];
    a.out = (float*)d_out; a.ws = (unsigned char*)d_ws;
#if MK_COOP
    a.ph_lo = 0; a.ph_hi = NPH;
    void* args[] = {&a};
    const hipError_t e = hipLaunchCooperativeKernel((const void*)mega_fwd, dim3(grid), dim3(512), args, LDS_BYTES, stream);
    if (e != hipSuccess) fprintf(stderr, "kernel_launch: cooperative launch failed: %s (grid %d)\n", hipGetErrorString(e), grid);
#else
    for (int p = 0; p < NPH; ++p) { a.ph_lo = p; a.ph_hi = p + 1; hipLaunchKernelGGL(mega_fwd, dim3(grid), dim3(512), LDS_BYTES, stream, a); }
#endif
}
```

```cpp
#include <hip/hip_runtime.h>
#include <hip/hip_cooperative_groups.h>
#include <cstdio>
#include <cstdint>
namespace cg = cooperative_groups;
#ifndef MK_COOP
#define MK_COOP 1
#endif
namespace pg8 {
#define PG8_LAS __attribute__((address_space(3)))
typedef unsigned short bf16_t;
typedef short bf16x8 __attribute__((ext_vector_type(8)));
typedef float f32x4 __attribute__((ext_vector_type(4)));
typedef unsigned u32x4 __attribute__((ext_vector_type(4)));
constexpr int BM = 256, BK = 64, HALF = 128, HTB = HALF * BK * 2  , STAGE_BYTES = 8 * HTB, NXCD = 8, WGM = 8;

__host__ __device__ __forceinline__ int lds_byte(int r, int c) { const int st = (r >> 4) * 2 + (c >> 5), rr = r & 15, cc = c & 31, ob = rr * 64 + cc * 2; return st * 1024 + (ob ^ (((ob >> 9) & 1) << 5)); }
__host__ __device__ __forceinline__ void stage_rc(int b, int& R, int& C) { const int st = b / 1024, sb = b % 1024, swz = sb ^ (((sb >> 9) & 1) << 5); R = (st >> 1) * 16 + swz / 64; C = (st & 1) * 32 + (swz % 64) / 2; }
__host__ __device__ __forceinline__ int perm32(int rho) { const int n = rho >> 4, i = rho & 15; return 8 * (i >> 2) + 4 * n + (i & 3); }

struct Unit { int pm, pn; };
struct Gemm { const bf16_t* A; const bf16_t* Bt; int M, N, K; };

struct StaticOrder {
    int nM, nN, nwg, G, c;
    __host__ __device__ void init(int M, int N, int G_, int c_) { nM = M / BM; nN = N / BM; nwg = nM * nN; G = G_; c = c_; }
    __host__ __device__ bool next(int i, Unit& u) const {
        const long L = (long)i * G + c; if (L >= nwg) return false;
        int wgid = (int)L; { const int q = nwg / NXCD, r = nwg % NXCD, xcd = wgid % NXCD, off = wgid / NXCD; wgid = (xcd < r ? xcd * (q + 1) : r * (q + 1) + (xcd - r) * q) + off; }
        const int nig = WGM * nN, gid = wgid / nig, fm = gid * WGM, gsz = (nM - fm) < WGM ? (nM - fm) : WGM;
        u.pm = fm + ((wgid % nig) % gsz); u.pn = (wgid % nig) / gsz; return true;
    }
    __device__ __forceinline__ void a_ready(const Unit&) const {}
    __device__ __forceinline__ void done(const Unit&) const {}
};
__device__ __forceinline__ unsigned cvt_pk_bf16(float lo, float hi) { unsigned r; asm volatile("v_cvt_pk_bf16_f32 %0, %1, %2" : "=v"(r) : "v"(lo), "v"(hi)); return r; }
typedef float f32x2 __attribute__((ext_vector_type(2)));
__device__ __forceinline__ f32x2 gelu_pk(f32x2 v) {
    const f32x2 av = __builtin_elementwise_abs(v), d = av * 0.2316418882f + 1.0f;
    f32x2 t; t.x = __builtin_amdgcn_rcpf(d.x); t.y = __builtin_amdgcn_rcpf(d.y);
    f32x2 q = t * 0.5307027145f + (-0.7265760135f); q = q * t + 0.7107068705f; q = q * t + (-0.142248368f); q = q * t + 0.127414796f; q = q * t;
    const f32x2 s = (v * v) * (-0.72134752044f);
    f32x2 e; e.x = __builtin_amdgcn_exp2f(s.x); e.y = __builtin_amdgcn_exp2f(s.y);
    const f32x2 m = v * (q * e), r = v - m;
    f32x2 o; o.x = v.x < 0.f ? m.x : r.x; o.y = v.y < 0.f ? m.y : r.y; return o;
}

struct EpiF32 {
    static constexpr bool PERM = false, AFTER_DRAIN = false;
    float* C; int ldc; const float* bias;
    __device__ __forceinline__ void operator()(const f32x4 (&acc)[2][2][4][2], const Unit& u, int wr, int wc, int fr, int fq) const {
        const int row0 = u.pm * BM + wr * 64 + fr, col0 = u.pn * BM + wc * 32 + 4 * fq;
        f32x4 bv[2][2];
#pragma unroll
        for (int bj = 0; bj < 2; ++bj)
#pragma unroll
            for (int n = 0; n < 2; ++n) bv[bj][n] = bias ? *(const f32x4*)(bias + col0 + bj * HALF + n * 16) : (f32x4){0.f, 0.f, 0.f, 0.f};
#pragma unroll
        for (int ai = 0; ai < 2; ++ai)
#pragma unroll
            for (int m = 0; m < 4; ++m) { float* rowp = C + (size_t)(row0 + ai * HALF + m * 16) * ldc + col0;
#pragma unroll
                for (int bj = 0; bj < 2; ++bj)
#pragma unroll
                    for (int n = 0; n < 2; ++n) *(f32x4*)(rowp + bj * HALF + n * 16) = acc[ai][bj][m][n] + bv[bj][n]; }
    }
};
template <int ACT  > struct EpiBf16 {
    static constexpr bool PERM = true, AFTER_DRAIN = false;
    bf16_t* O; int ldc; const float* bias; int split_cols; size_t split_stride;
    __device__ __forceinline__ void operator()(const f32x4 (&acc)[2][2][4][2], const Unit& u, int wr, int wc, int fr, int fq) const {
        const int row0 = u.pm * BM + wr * 64 + fr; int colt = u.pn * BM; bf16_t* base = O;
        if (split_cols) { const int t = colt / split_cols; base += (size_t)t * split_stride; colt -= t * split_cols; }
        const int col0 = colt + wc * 32 + 8 * fq, bcol0 = u.pn * BM + wc * 32 + 8 * fq;
        f32x4 bv[2][2];
#pragma unroll
        for (int bj = 0; bj < 2; ++bj)
#pragma unroll
            for (int n = 0; n < 2; ++n) bv[bj][n] = bias ? *(const f32x4*)(bias + bcol0 + bj * HALF + 4 * n) : (f32x4){0.f, 0.f, 0.f, 0.f};
#pragma unroll
        for (int ai = 0; ai < 2; ++ai)
#pragma unroll
            for (int m = 0; m < 4; ++m) { bf16_t* rowp = base + (size_t)(row0 + ai * HALF + m * 16) * ldc + col0;
#pragma unroll
                for (int bj = 0; bj < 2; ++bj) { f32x4 v0 = acc[ai][bj][m][0] + bv[bj][0], v1 = acc[ai][bj][m][1] + bv[bj][1];
                    if (ACT == 1) { f32x2 a = gelu_pk((f32x2){v0[0], v0[1]}), b = gelu_pk((f32x2){v0[2], v0[3]}), c = gelu_pk((f32x2){v1[0], v1[1]}), d = gelu_pk((f32x2){v1[2], v1[3]});
                        v0 = (f32x4){a.x, a.y, b.x, b.y}; v1 = (f32x4){c.x, c.y, d.x, d.y}; }
                    if (ACT == 2) {
#pragma unroll
                        for (int j = 0; j < 4; ++j) { v0[j] = 0.5f * v0[j] * (1.0f + erff(v0[j] * 0.70710678f)); v1[j] = 0.5f * v1[j] * (1.0f + erff(v1[j] * 0.70710678f)); } }
                    u32x4 w; w.x = cvt_pk_bf16(v0[0], v0[1]); w.y = cvt_pk_bf16(v0[2], v0[3]); w.z = cvt_pk_bf16(v1[0], v1[1]); w.w = cvt_pk_bf16(v1[2], v1[3]);
                    *(u32x4*)(rowp + bj * HALF) = w; } }
    }
};
template <class Epi, class Sched, bool STAMP = false>
__device__ __forceinline__ void gemm_phase(PG8_LAS unsigned char* lds, const Gemm g, const Sched& S, const Epi& E, unsigned long long* stamps) {
    int tid_ = threadIdx.x; asm volatile("" : "+v"(tid_));
    const int tid = tid_, wid = __builtin_amdgcn_readfirstlane(tid >> 6), lane = tid & 63, wr = wid >> 2, wc = wid & 3, fr = lane & 15, fq = lane >> 4;
    const int K = g.K, nt = K / BK;
    int ts_lo = 0, ts_hi = 0, nts = 0; const unsigned long long rt_entry = STAMP ? (unsigned long long)wall_clock64() : 0ull;
#define PG8_STAMP() do { if (STAMP && wid == 0 && nts < 64) { const unsigned long long _c = (unsigned long long)clock64(); \
        ts_lo = (lane == nts) ? (int)(unsigned)_c : ts_lo; ts_hi = (lane == nts) ? (int)(unsigned)(_c >> 32) : ts_hi; ++nts; } } while (0)
    PG8_STAMP();
    unsigned voffA[2], voffB[2];
#pragma unroll
    for (int i = 0; i < 2; ++i) { int R, C; stage_rc(tid * 16 + i * 8192, R, C); const int Rb = Epi::PERM ? ((R & ~31) + perm32(R & 31)) : R;
        voffA[i] = (unsigned)(R * K + C) * 2u; voffB[i] = (unsigned)(Rb * K + C) * 2u; }
    const size_t kstep = (size_t)(BK * 2);
    const size_t hstep = (size_t)HALF * K * 2;
    const size_t tstep = 2 * hstep;
    const unsigned ldsw = (unsigned)wid * 1024u;
    const int aoff = lds_byte(wr * 64 + fr, fq * 8), boff = lds_byte(wc * 32 + fr, fq * 8);
#define PG8_SA(b, h) (((b) * 2 + (h)) * HTB)
#define PG8_SB(b, h) ((4 + (b) * 2 + (h)) * HTB)
#define PG8_STAGE(bufoff, gbase, voff) do { _Pragma("unroll") for (int _i = 0; _i < 2; ++_i) \
        __builtin_amdgcn_global_load_lds((const unsigned*)((const char*)(gbase) + (voff)[_i]), (PG8_LAS unsigned*)(lds + (bufoff) + ldsw + _i * 8192), 16, 0, 0); } while (0)
#define PG8_LDA(dst, b, h) do { _Pragma("unroll") for (int m = 0; m < 4; ++m) _Pragma("unroll") for (int k = 0; k < 2; ++k) dst[m][k] = *(const PG8_LAS bf16x8*)(lds + PG8_SA(b, h) + aoff + m * 2048 + k * 1024); } while (0)
#define PG8_LDB(dst, b, h) do { _Pragma("unroll") for (int n = 0; n < 2; ++n) _Pragma("unroll") for (int k = 0; k < 2; ++k) dst[n][k] = *(const PG8_LAS bf16x8*)(lds + PG8_SB(b, h) + boff + n * 2048 + k * 1024); } while (0)
#define PG8_MMA(ai, bj, At, Bt) do { __builtin_amdgcn_s_setprio(1); _Pragma("unroll") for (int m = 0; m < 4; ++m) _Pragma("unroll") for (int n = 0; n < 2; ++n) _Pragma("unroll") for (int k = 0; k < 2; ++k) \
        acc[ai][bj][m][n] = __builtin_amdgcn_mfma_f32_16x16x32_bf16(Bt[n][k], At[m][k], acc[ai][bj][m][n], 0, 0, 0); __builtin_amdgcn_s_setprio(0); } while (0)
#define PG8_WAIT_V(n) asm volatile("s_waitcnt vmcnt(" #n ")" ::: "memory")
#define PG8_WAIT_L(n) asm volatile("s_waitcnt lgkmcnt(" #n ")" ::: "memory")
#define PG8_BAR __builtin_amdgcn_s_barrier()
#define PG8_SCHED __builtin_amdgcn_sched_barrier(0)
    Unit cur, nxt; int ui = 0;
    if (!S.next(0, cur)) return;
    f32x4 acc[2][2][4][2];
#pragma unroll
    for (int a = 0; a < 2; ++a)
#pragma unroll
        for (int b = 0; b < 2; ++b)
#pragma unroll
            for (int m = 0; m < 4; ++m)
#pragma unroll
                for (int n = 0; n < 2; ++n) acc[a][b][m][n] = (f32x4){0.f, 0.f, 0.f, 0.f};
    bf16x8 At[4][2], B0[2][2], B1[2][2];
    const char* cA = (const char*)g.A + (size_t)cur.pm * tstep; const char* cB = (const char*)g.Bt + (size_t)cur.pn * tstep;
    S.a_ready(cur);
    PG8_STAGE(PG8_SB(0, 0), cB, voffB); PG8_STAGE(PG8_SA(0, 0), cA, voffA); PG8_STAGE(PG8_SB(0, 1), cB + hstep, voffB); PG8_STAGE(PG8_SA(0, 1), cA + hstep, voffA);
    if (wr == 1) PG8_BAR;
    PG8_WAIT_V(4); PG8_BAR;
    PG8_STAGE(PG8_SB(1, 0), cB + kstep, voffB); PG8_STAGE(PG8_SA(1, 0), cA + kstep, voffA); PG8_STAGE(PG8_SB(1, 1), cB + hstep + kstep, voffB);
    PG8_WAIT_V(6); PG8_BAR;
    PG8_STAMP();
    for (;;) {
        const bool has_next = S.next(ui + 1, nxt);
        const char* nA = has_next ? (const char*)g.A + (size_t)nxt.pm * tstep : cA; const char* nB = has_next ? (const char*)g.Bt + (size_t)nxt.pn * tstep : cB;
        for (int t = 0; t < nt; t += 2) {
            const bool last = (t == nt - 2);
            const char* a1 = cA + (size_t)(t + 1) * kstep;
            const char* a2 = last ? nA : cA + (size_t)(t + 2) * kstep; const char* b2 = last ? nB : cB + (size_t)(t + 2) * kstep;
            const char* a3 = a2 + kstep; const char* b3 = b2 + kstep;
            if (last && has_next) S.a_ready(nxt);
            PG8_LDB(B0, 0, 0); PG8_SCHED; PG8_LDA(At, 0, 0); PG8_STAGE(PG8_SA(1, 1), a1 + hstep, voffA);
            PG8_WAIT_L(8); PG8_BAR; PG8_WAIT_L(0); PG8_MMA(0, 0, At, B0); PG8_BAR; PG8_SCHED;
            PG8_LDB(B1, 0, 1); PG8_STAGE(PG8_SB(0, 0), b2, voffB);
            PG8_BAR; PG8_WAIT_L(0); PG8_MMA(0, 1, At, B1); PG8_BAR;
            PG8_LDA(At, 0, 1); PG8_STAGE(PG8_SA(0, 0), a2, voffA);
            PG8_BAR; PG8_WAIT_L(0); PG8_MMA(1, 0, At, B0); PG8_BAR; PG8_SCHED;
            PG8_STAGE(PG8_SB(0, 1), b2 + hstep, voffB);
            PG8_WAIT_V(6); PG8_BAR; PG8_MMA(1, 1, At, B1); PG8_BAR;
            PG8_LDB(B0, 1, 0); PG8_SCHED; PG8_LDA(At, 1, 0); PG8_STAGE(PG8_SA(0, 1), a2 + hstep, voffA);
            PG8_WAIT_L(8); PG8_BAR; PG8_WAIT_L(0); PG8_MMA(0, 0, At, B0); PG8_BAR; PG8_SCHED;
            PG8_LDB(B1, 1, 1); PG8_STAGE(PG8_SB(1, 0), b3, voffB);
            PG8_BAR; PG8_WAIT_L(0); PG8_MMA(0, 1, At, B1); PG8_BAR;
            PG8_LDA(At, 1, 1); PG8_STAGE(PG8_SA(1, 0), a3, voffA);
            PG8_BAR; PG8_WAIT_L(0); PG8_MMA(1, 0, At, B0); PG8_BAR; PG8_SCHED;
            PG8_STAGE(PG8_SB(1, 1), b3 + hstep, voffB);
            PG8_WAIT_V(6); PG8_BAR; PG8_MMA(1, 1, At, B1); PG8_BAR;
        }
        PG8_STAMP();
        if constexpr (!Epi::AFTER_DRAIN) { E(acc, cur, wr, wc, fr, fq); S.done(cur); }
        PG8_STAMP();
        if (!has_next) break;
#pragma unroll
        for (int a = 0; a < 2; ++a)
#pragma unroll
            for (int b = 0; b < 2; ++b)
#pragma unroll
                for (int m = 0; m < 4; ++m)
#pragma unroll
                    for (int n = 0; n < 2; ++n) acc[a][b][m][n] = (f32x4){0.f, 0.f, 0.f, 0.f};
        cur = nxt; cA = nA; cB = nB; ++ui;
    }
    PG8_WAIT_V(0);
    if (wr == 0) PG8_BAR;
    PG8_BAR;
    if constexpr (Epi::AFTER_DRAIN) { E.fused(acc, cur, wr, wc, fr, fq, lds, wid, lane); S.done(cur); }
    PG8_STAMP();
    if (STAMP && wid == 0) { stamps[lane] = lane < nts ? (((unsigned long long)(unsigned)ts_hi << 32) | (unsigned)ts_lo) : 0ull;
        if (lane == 62) stamps[62] = rt_entry; if (lane == 63) stamps[63] = (unsigned long long)wall_clock64(); }
#undef PG8_STAMP
#undef PG8_SA
#undef PG8_SB
#undef PG8_STAGE
#undef PG8_LDA
#undef PG8_LDB
#undef PG8_MMA
#undef PG8_WAIT_V
#undef PG8_WAIT_L
#undef PG8_BAR
#undef PG8_SCHED
}
}

#define LAS __attribute__((address_space(3)))
typedef unsigned short bf16_t;
typedef short bf16x8 __attribute__((ext_vector_type(8)));
typedef float f32x4 __attribute__((ext_vector_type(4)));
typedef float f32x2 __attribute__((ext_vector_type(2)));
typedef unsigned u32x4 __attribute__((ext_vector_type(4)));
typedef unsigned u32x2 __attribute__((ext_vector_type(2)));

constexpr int D = 1024, NP = 16384, NS = 512, NTOK = NP + NS, SEQ = 2048, NB = 8, NSB = 128, DEPTH = 4;
constexpr int INW = 2568, NPROJ = 2560, DFF = 2816, NGU = 5632;
constexpr int PC_G = 1536, PC_SSM = 2048, PC_POOL = 2304;
constexpr float EPS = 1e-6f;
constexpr int LDS_BYTES = 147456;

constexpr size_t SZ_WIN = (size_t)NPROJ * D * 2, SZ_WOUT = (size_t)D * D * 2, SZ_WGU = (size_t)NGU * D * 2, SZ_WDN = (size_t)D * DFF * 2;
constexpr size_t SZ_WAB = 8 * D * 4, SZ_GLUT = 256 * 256 * 2, SZ_POOLT = 4 * 64 * 64 * 2, SZ_SSMK = 16 * 64 * 4 * 4, SZ_BBAR = 16 * 64 * 32 * 4;
constexpr size_t WS_WIN = 0;
constexpr size_t WS_WOUT = WS_WIN + DEPTH * SZ_WIN;
constexpr size_t WS_WGU = WS_WOUT + DEPTH * SZ_WOUT;
constexpr size_t WS_WDN = WS_WGU + DEPTH * SZ_WGU;
constexpr size_t WS_WAB = WS_WDN + DEPTH * SZ_WDN;
constexpr size_t WS_GLUT = WS_WAB + DEPTH * SZ_WAB;
constexpr size_t WS_POOLT = WS_GLUT + DEPTH * SZ_GLUT;
constexpr size_t WS_SSMK = WS_POOLT + DEPTH * SZ_POOLT;
constexpr size_t WS_BBAR = WS_SSMK + DEPTH * SZ_SSMK;
constexpr size_t WS_H = WS_BBAR + DEPTH * SZ_BBAR;
constexpr size_t WS_AB = WS_H + (size_t)NTOK * D * 2;
constexpr size_t WS_MIX = WS_AB + (size_t)NTOK * 8 * 4;
constexpr size_t WS_MIXO = WS_MIX + (size_t)NTOK * D * 2;
constexpr size_t WS_SSME = WS_MIXO + (size_t)NTOK * D * 4;
constexpr size_t WS_PROJ = WS_SSME + (size_t)8 * 32 * 16 * 64 * 2 * 4;
constexpr size_t WS_DW = WS_PROJ + (size_t)NTOK * NPROJ * 2;
constexpr size_t WS_DKC = WS_DW + (size_t)1024 * 8192 * 4;
constexpr size_t WS_DQD = WS_DKC + (size_t)1024 * 8192 * 2;
constexpr size_t WS_DQK = WS_DQD + (size_t)1024 * 8192 * 2;
constexpr size_t WS_DKT = WS_DQK + (size_t)1024 * 4096 * 2;
constexpr size_t WS_DGL = WS_DKT + (size_t)1024 * 8192 * 2;
constexpr size_t WS_END = WS_DGL + 4096;
constexpr size_t WS_HID = WS_PROJ;
static_assert(WS_HID + (size_t)NTOK * DFF * 2 <= WS_END, "HID overlay");
static_assert(WS_H % 256 == 0 && WS_PROJ % 256 == 0 && WS_DW % 256 == 0, "align");

constexpr size_t O_YP = 0, O_YS = O_YP + (size_t)NP * D, O_DP = O_YS + (size_t)NS * D, O_CP = O_DP + (size_t)DEPTH * 8 * 4 * 16384,
                 O_REP = O_CP + (size_t)DEPTH * 8 * 3 * 1536, O_IMP = O_REP + (size_t)DEPTH * 8 * 1024, O_PP = O_IMP + (size_t)DEPTH * 8 * 1024,
                 O_DS = O_PP + (size_t)DEPTH * 8 * 15 * 256, O_CS = O_DS + (size_t)DEPTH * 128 * 4 * 16384, O_RES = O_CS + (size_t)DEPTH * 128 * 3 * 1536,
                 O_IMS = O_RES + (size_t)DEPTH * 128 * 1024, O_PS = O_IMS + (size_t)DEPTH * 128 * 1024, O_END = O_PS + (size_t)DEPTH * 128 * 15 * 256;

struct Args { const float* in[32]; float* out; unsigned char* ws; int ph_lo, ph_hi; };
typedef const float* cfp_t;
typedef __attribute__((address_space(4))) const unsigned char* kptr_t;
struct InProxy { __device__ __forceinline__ const float* operator[](int i) const {
    kptr_t p = (kptr_t)__builtin_amdgcn_kernarg_segment_ptr(); asm volatile("" : "+s"(p)); return *(__attribute__((address_space(4))) const cfp_t*)(p + 8 * i); } };
struct DevArgs { InProxy in; float* out; unsigned char* ws; int ph_lo, ph_hi; };
enum { I_XP = 0, I_XS, I_SDELTA, I_SCONV, I_SRE, I_SIM, I_SPOOL, I_NMPRE, I_NMPOST, I_NFPRE, I_NFPOST, I_WIN, I_CONVW, I_ALOG, I_DTB, I_ONORM,
       I_ARE, I_AIM, I_LOGDT, I_BRE, I_BIM, I_CRE, I_CIM, I_SSMD, I_GLUW, I_GLUB, I_POOLW, I_POOLS, I_WOUT, I_WG, I_WU, I_WD };

__device__ __forceinline__ unsigned f2bf(float f) { unsigned u = __float_as_uint(f); return (u + 0x7fffu + ((u >> 16) & 1u)) >> 16; }
__device__ __forceinline__ float bf2f(unsigned b) { return __uint_as_float(b << 16); }
__device__ __forceinline__ unsigned pk2(float lo, float hi) { return f2bf(lo) | (f2bf(hi) << 16); }
__device__ __forceinline__ float wave_sum(float v) {
#pragma unroll
    for (int o = 1; o < 64; o <<= 1) v += __shfl_xor(v, o);
    return v;
}
__device__ __forceinline__ float silu_f(float y) { return y / (1.f + __expf(-y)); }
__device__ __forceinline__ float sigmoid_f(float y) { return 1.f / (1.f + __expf(-y)); }
__device__ __forceinline__ float gelu_tanh_f(float x) { const float t = tanhf(0.7978845608028654f * (x + 0.044715f * x * x * x)); return 0.5f * x * (1.f + t); }
__device__ __forceinline__ f32x4 mfma16(bf16x8 a, bf16x8 b, f32x4 c) { return __builtin_amdgcn_mfma_f32_16x16x32_bf16(a, b, c, 0, 0, 0); }
#define LDS_FENCE() asm volatile("s_waitcnt lgkmcnt(0)" ::: "memory")

struct EpiSwiGLU {
    static constexpr bool PERM = false, AFTER_DRAIN = false;
    bf16_t* O; int ldc;
    __device__ __forceinline__ void operator()(const pg8::f32x4 (&acc)[2][2][4][2], const pg8::Unit& u, int wr, int wc, int fr, int fq) const {
        const int row0 = u.pm * 256 + wr * 64 + fr, hid0 = u.pn * 128 + wc * 16 + 4 * fq;
#pragma unroll
        for (int ai = 0; ai < 2; ++ai)
#pragma unroll
            for (int m = 0; m < 4; ++m) { bf16_t* rowp = O + (size_t)(row0 + ai * 128 + m * 16) * ldc + hid0;
#pragma unroll
                for (int bj = 0; bj < 2; ++bj) { const pg8::f32x4 g = acc[ai][bj][m][0], v = acc[ai][bj][m][1];
                    u32x2 w; w.x = pk2(silu_f(g[0]) * v[0], silu_f(g[1]) * v[1]); w.y = pk2(silu_f(g[2]) * v[2], silu_f(g[3]) * v[3]);
                    *(u32x2*)(rowp + bj * 64) = w; } }
    }
};

struct SrcIn { const float* w; __device__ __forceinline__ float operator()(int k, int n) const { return w[(size_t)k * INW + (n < 1536 ? n : n + 8)]; } };
struct SrcPlain { const float* w; int N; __device__ __forceinline__ float operator()(int k, int n) const { return w[(size_t)k * N + n]; } };
struct SrcGU { const float* g; const float* u; __device__ __forceinline__ float operator()(int k, int n) const { const int r = n & 31, hid = (n >> 5) * 16 + (r & 15); const long long du = (r < 16) ? 0ll : (long long)(u - g); return g[du + (long long)k * DFF + hid]; } };
template <class Src> __device__ __forceinline__ void transpose_item(const Src& src, int K, bf16_t* WT, int nblk, LAS float* scr, int item, int lane) {
    const int kb = item / nblk, nb = item % nblk, k0 = 64 * kb, n0 = 32 * nb;
#pragma unroll 8
    for (int i = 0; i < 32; ++i) { const int kk = 2 * i + (lane >> 5); scr[kk * 33 + (lane & 31)] = src(k0 + kk, n0 + (lane & 31)); }
    LDS_FENCE();
    const int c = lane & 7;
#pragma unroll
    for (int j = 0; j < 4; ++j) { const int n = (lane >> 3) + 8 * j; const LAS float* s = scr + (8 * c) * 33 + n;
        u32x4 o; o.x = pk2(s[0 * 33], s[1 * 33]); o.y = pk2(s[2 * 33], s[3 * 33]); o.z = pk2(s[4 * 33], s[5 * 33]); o.w = pk2(s[6 * 33], s[7 * 33]);
        *(u32x4*)(WT + (size_t)(n0 + n) * K + k0 + 8 * c) = o; }
    LDS_FENCE();
}

__device__ __forceinline__ void norm_rows(const float* T, const float* wt, const float* X0, const float* X1, float* Xout, const float* wh, bf16_t* H,
                                          const float* Wab, float* AB, int gw, int NGW, int lane) {
    for (int m = gw; m < NTOK; m += NGW) {
        const float* xr = (X1 && m >= NP) ? X1 + (size_t)(m - NP) * D : X0 + (size_t)m * D;
        f32x4 x[4];
#pragma unroll
        for (int j = 0; j < 4; ++j) x[j] = ((const f32x4*)xr)[lane + 64 * j];
        if (T) {
            f32x4 t[4]; float ss = 0.f;
#pragma unroll
            for (int j = 0; j < 4; ++j) { t[j] = ((const f32x4*)(T + (size_t)m * D))[lane + 64 * j]; ss += (t[j].x * t[j].x + t[j].y * t[j].y) + (t[j].z * t[j].z + t[j].w * t[j].w); }
            ss = wave_sum(ss); const float r = rsqrtf(ss * (1.f / D) + EPS);
#pragma unroll
            for (int j = 0; j < 4; ++j) { const f32x4 w = ((const f32x4*)wt)[lane + 64 * j]; x[j] += t[j] * r * w; }
        }
        if (Xout) {
#pragma unroll
            for (int j = 0; j < 4; ++j) ((f32x4*)(Xout + (size_t)m * D))[lane + 64 * j] = x[j];
        }
        if (H) {
            float ss = 0.f;
#pragma unroll
            for (int j = 0; j < 4; ++j) ss += (x[j].x * x[j].x + x[j].y * x[j].y) + (x[j].z * x[j].z + x[j].w * x[j].w);
            ss = wave_sum(ss); const float r = rsqrtf(ss * (1.f / D) + EPS);
            f32x4 hv[4];
#pragma unroll
            for (int j = 0; j < 4; ++j) { const f32x4 w = ((const f32x4*)wh)[lane + 64 * j]; hv[j] = x[j] * r * w;
                u32x2 o; o.x = pk2(hv[j].x, hv[j].y); o.y = pk2(hv[j].z, hv[j].w); ((u32x2*)(H + (size_t)m * D))[lane + 64 * j] = o; }
            if (Wab) {
#pragma unroll
                for (int c = 0; c < 8; ++c) { float d = 0.f;
#pragma unroll
                    for (int j = 0; j < 4; ++j) { const f32x4 w = ((const f32x4*)(Wab + c * D))[lane + 64 * j]; d += (hv[j].x * w.x + hv[j].y * w.y) + (hv[j].z * w.z + hv[j].w * w.w); }
                    d = wave_sum(d); if (lane == 0) AB[(size_t)m * 8 + c] = d; }
            }
        }
    }
}

__device__ __forceinline__ void prologue(const DevArgs& A, LAS unsigned char* lds, int wave, int lane, int gw, int NGW) {
    LAS float* scr = (LAS float*)(lds + wave * 8704);
    constexpr int I_IN = 16 * 80, I_OUT = 16 * 32, I_GU = 16 * 176, I_DN = 44 * 32, I_GLU = 4 * 8, I_POOL = 8, PER = I_IN + I_OUT + I_GU + I_DN + I_GLU + I_POOL;
    for (int it = gw; it < DEPTH * PER; it += NGW) {
        const int l = it / PER; int r = it % PER;
        if (r < I_IN) { SrcIn s{A.in[I_WIN] + (size_t)l * D * INW}; transpose_item(s, D, (bf16_t*)(A.ws + WS_WIN + l * SZ_WIN), NPROJ / 32, scr, r, lane); continue; } r -= I_IN;
        if (r < I_OUT) { SrcPlain s{A.in[I_WOUT] + (size_t)l * D * D, D}; transpose_item(s, D, (bf16_t*)(A.ws + WS_WOUT + l * SZ_WOUT), D / 32, scr, r, lane); continue; } r -= I_OUT;
        if (r < I_GU) { SrcGU s{A.in[I_WG] + (size_t)l * D * DFF, A.in[I_WU] + (size_t)l * D * DFF}; transpose_item(s, D, (bf16_t*)(A.ws + WS_WGU + l * SZ_WGU), NGU / 32, scr, r, lane); continue; } r -= I_GU;
        if (r < I_DN) { SrcPlain s{A.in[I_WD] + (size_t)l * DFF * D, D}; transpose_item(s, DFF, (bf16_t*)(A.ws + WS_WDN + l * SZ_WDN), D / 32, scr, r, lane); continue; } r -= I_DN;
        if (r < I_GLU) { SrcPlain s{A.in[I_GLUW] + (size_t)l * 65536, 256}; transpose_item(s, 256, (bf16_t*)(A.ws + WS_GLUT + l * SZ_GLUT), 8, scr, r, lane); continue; } r -= I_GLU;
        { const int g = r >> 1; SrcPlain s{A.in[I_POOLW] + (size_t)(l * 4 + g) * 4096, 64}; transpose_item(s, 64, (bf16_t*)(A.ws + WS_POOLT + l * SZ_POOLT) + g * 4096, 2, scr, r & 1, lane); }
    }
    const int gt = gw * 64 + lane, NT = NGW * 64;
    float* wab = (float*)(A.ws + WS_WAB);
    for (int i = gt; i < DEPTH * 8 * D; i += NT) { const int l = i / (8 * D), j = (i / D) & 7, k = i % D; wab[i] = A.in[I_WIN][((size_t)l * D + k) * INW + 1536 + j]; }
    float* ssmk = (float*)(A.ws + WS_SSMK); float* bbar = (float*)(A.ws + WS_BBAR);
    for (int i = gt; i < DEPTH * 16 * 64; i += NT) {
        const int lg = i >> 6;
        const float dt = expf(A.in[I_LOGDT][lg]), ar = A.in[I_ARE][i], ai = A.in[I_AIM][i];
        const float mag = expf(ar * dt);
        float rev = ai * dt * 0.15915494309189535f; rev -= floorf(rev);
        const float sn = __builtin_amdgcn_sinf(rev), cs = __builtin_amdgcn_cosf(rev);
        const float lr = mag * cs, li = mag * sn;
        float pr = lr, pi = li;
#pragma unroll
        for (int q = 0; q < 6; ++q) { const float nr2 = pr * pr - pi * pi, ni2 = 2.f * pr * pi; pr = nr2; pi = ni2; }
        ssmk[i * 4 + 0] = lr; ssmk[i * 4 + 1] = li; ssmk[i * 4 + 2] = pr; ssmk[i * 4 + 3] = pi;
        const float nr = lr - 1.f, ni = li, d2 = ar * ar + ai * ai;
        const float cre = (nr * ar + ni * ai) / d2, cim = (ni * ar - nr * ai) / d2;
#pragma unroll
        for (int h = 0; h < 16; ++h) { const float br = A.in[I_BRE][(size_t)i * 16 + h], bi = A.in[I_BIM][(size_t)i * 16 + h];
            bbar[(size_t)i * 32 + h] = cre * br - cim * bi; bbar[(size_t)i * 32 + 16 + h] = cre * bi + cim * br; }
    }
}

__device__ __forceinline__ void delta_prep_item(const DevArgs& A, int l, LAS unsigned char* lds, int item, int tid, int wave, int lane) {
    const int bh = item >> 5, n = item & 31, b = bh >> 2, h = bh & 3;
    const int tok0 = b * SEQ + n * 64;
    LAS bf16_t* QS = (LAS bf16_t*)(lds); LAS bf16_t* KS = (LAS bf16_t*)(lds + 17408);
    LAS float* RHS = (LAS float*)(lds + 34816);
    LAS float* AM = (LAS float*)(lds + 100352); LAS float* PM = (LAS float*)(lds + 117760);
    LAS float* GAM = (LAS float*)(lds + 135168); LAS float* BETA = GAM + 64; LAS float* RQ = GAM + 128; LAS float* RK = GAM + 192;
    const bf16_t* PROJ = (const bf16_t*)(A.ws + WS_PROJ);
    const float* AB = (const float*)(A.ws + WS_AB);
    if (tid < 384) {
        const int part = tid >> 7, c = tid & 127, col = part * 512 + h * 128 + c;
        const float* cw = A.in[I_CONVW] + (size_t)l * 4 * 1536;
        const float w0 = cw[col], w1 = cw[1536 + col], w2 = cw[3072 + col], w3 = cw[4608 + col];
        const bf16_t* pp = PROJ + (size_t)tok0 * NPROJ + col;
        float xr[67];
#pragma unroll
        for (int t = 0; t < 67; ++t) xr[t] = (n > 0 || t >= 3) ? bf2f(pp[(long)(t - 3) * NPROJ]) : 0.f;
#pragma unroll
        for (int t = 0; t < 64; ++t) {
            const float y = w0 * xr[t] + w1 * xr[t + 1] + w2 * xr[t + 2] + w3 * xr[t + 3];
            const float s = silu_f(y);
            if (part == 0) QS[t * 136 + c] = (bf16_t)f2bf(s);
            else if (part == 1) KS[t * 136 + c] = (bf16_t)f2bf(s);
            else RHS[t * 256 + c] = s;
        }
    } else if (tid < 448) {
        const int t = tid - 384;
        const float a = AB[(size_t)(tok0 + t) * 8 + h], bb = AB[(size_t)(tok0 + t) * 8 + 4 + h];
        const float xx = a + A.in[I_DTB][l * 4 + h];
        const float sp = xx > 20.f ? xx : log1pf(expf(xx));
        float lg = -expf(A.in[I_ALOG][l * 4 + h]) * sp;
#pragma unroll
        for (int off = 1; off < 64; off <<= 1) { const float v = __shfl_up(lg, off); if (lane >= off) lg += v; }
        GAM[t] = lg; BETA[t] = 1.f / (1.f + expf(-bb));
    }
    __syncthreads();
    {
        const int t = tid >> 3, part = tid & 7; float sq = 0.f, sk = 0.f;
#pragma unroll
        for (int j = 0; j < 16; ++j) { const float q = bf2f(QS[t * 136 + part * 16 + j]), k = bf2f(KS[t * 136 + part * 16 + j]); sq += q * q; sk += k * k; }
        sq += __shfl_xor(sq, 1); sq += __shfl_xor(sq, 2); sq += __shfl_xor(sq, 4);
        sk += __shfl_xor(sk, 1); sk += __shfl_xor(sk, 2); sk += __shfl_xor(sk, 4);
        if (part == 0) { RQ[t] = rsqrtf(sq + EPS) * 0.08838834764831845f; RK[t] = rsqrtf(sk + EPS); }
    }
    {
        const int prod = wave >> 2, mt = wave & 3, fr = lane & 15, quad = lane >> 4;
        LAS bf16_t* Aop = prod ? QS : KS; LAS float* dst = prod ? PM : AM;
        bf16x8 a[4];
#pragma unroll
        for (int kk = 0; kk < 4; ++kk) a[kk] = *(LAS bf16x8*)(Aop + (mt * 16 + fr) * 136 + kk * 32 + quad * 8);
#pragma unroll
        for (int nt = 0; nt < 4; ++nt) { f32x4 acc = {0.f, 0.f, 0.f, 0.f};
#pragma unroll
            for (int kk = 0; kk < 4; ++kk) { const bf16x8 bq = *(LAS bf16x8*)(KS + (nt * 16 + fr) * 136 + kk * 32 + quad * 8); acc = mfma16(a[kk], bq, acc); }
#pragma unroll
            for (int i = 0; i < 4; ++i) dst[(mt * 16 + quad * 4 + i) * 68 + nt * 16 + fr] = acc[i]; }
    }
    __syncthreads();
    bf16_t* DQK = (bf16_t*)(A.ws + WS_DQK) + (size_t)item * 4096;
    bf16_t* DQD = (bf16_t*)(A.ws + WS_DQD) + (size_t)item * 8192;
    bf16_t* DKT = (bf16_t*)(A.ws + WS_DKT) + (size_t)item * 8192;
    for (int idx = tid; idx < 4096; idx += 512) { const int t = idx >> 6, s = idx & 63;
        const float dec = (s <= t) ? __expf(GAM[t] - GAM[s]) : 0.f;
        const float am = AM[t * 68 + s], pm = PM[t * 68 + s];
        AM[t * 68 + s] = (s < t) ? BETA[t] * RK[t] * RK[s] * am * dec : 0.f;
        DQK[idx] = (bf16_t)f2bf(RQ[t] * RK[s] * pm * dec); }
    for (int idx = tid; idx < 8192; idx += 512) { const int t = idx >> 7, c = idx & 127; const float bt = BETA[t], eg = __expf(GAM[t]);
        const float kraw = bf2f(KS[t * 136 + c]), qraw = bf2f(QS[t * 136 + c]);
        RHS[t * 256 + c] *= bt; RHS[t * 256 + 128 + c] = bt * eg * RK[t] * kraw;
        DQD[idx] = (bf16_t)f2bf(qraw * RQ[t] * eg); }
    { const float g63 = GAM[63];
      for (int idx = tid; idx < 8192; idx += 512) { const int c = idx >> 6, t = idx & 63; DKT[idx] = (bf16_t)f2bf(bf2f(KS[t * 136 + c]) * RK[t] * __expf(g63 - GAM[t])); }
      if (tid == 0) ((float*)(A.ws + WS_DGL))[item] = __expf(g63); }
    __syncthreads();
    if (tid < 256) {
        float sol[64];
        LAS float* amp = AM; asm volatile("" : "+v"(amp));
        LAS float* rhp = RHS + tid; asm volatile("" : "+v"(rhp));
#pragma unroll
        for (int t = 0; t < 64; ++t) { float acc = rhp[t * 256];
#pragma unroll
            for (int s = 0; s < t; ++s) acc = fmaf(-amp[t * 68 + s], sol[s], acc);
            sol[t] = acc; __builtin_amdgcn_sched_barrier(0); }
        if (tid < 128) { bf16_t* DW = (bf16_t*)(A.ws + WS_DW) + (size_t)item * 8192 + tid;
#pragma unroll
            for (int t = 0; t < 64; ++t) DW[t * 128] = (bf16_t)f2bf(sol[t]); }
        else { bf16_t* DKC = (bf16_t*)(A.ws + WS_DKC) + (size_t)item * 8192 + (tid - 128);
#pragma unroll
            for (int t = 0; t < 64; ++t) DKC[t * 128] = (bf16_t)f2bf(-sol[t]); }
    }
    __syncthreads();
}

__device__ __forceinline__ void delta_scan_item(const DevArgs& A, int l, LAS unsigned char* lds, int bh, int tid_in, int wave, int lane_in) {
    const int b = bh >> 2, h = bh & 3;
    LAS unsigned char* KCs = lds; LAS unsigned char* QDs = lds + 17408; LAS unsigned char* QKs = lds + 34816; LAS unsigned char* KDTs = lds + 44032;
    LAS unsigned char* Ws = lds + 62464;
    LAS unsigned char* SS = lds + 79872 + wave * 4352; LAS unsigned char* US = lds + 114688 + wave * 2304;
    LAS float* PART = (LAS float*)(lds + 133120);
    const unsigned char* gW = A.ws + WS_DW;
    const unsigned char* gKC = A.ws + WS_DKC; const unsigned char* gQD = A.ws + WS_DQD; const unsigned char* gQK = A.ws + WS_DQK; const unsigned char* gKT = A.ws + WS_DKT;
    const float* DGL = (const float*)(A.ws + WS_DGL);
    f32x4 S[8];
#pragma unroll
    for (int mt = 0; mt < 8; ++mt) S[mt] = (f32x4){0.f, 0.f, 0.f, 0.f};
    u32x4 r[9];
    const float gl_all = DGL[bh * 32 + (lane_in & 31)];
    const float onorm = A.in[I_ONORM][l * 128 + 16 * wave + (lane_in & 15)];
#define DS_LOAD(itn, toff) do { const size_t _i = (size_t)(itn); const unsigned char* _kc = gKC + _i * 16384; const unsigned char* _qd = gQD + _i * 16384; \
        const unsigned char* _qk = gQK + _i * 8192; const unsigned char* _kt = gKT + _i * 16384; \
        r[0] = *(const u32x4*)(_kc + (toff)); r[1] = *(const u32x4*)(_kc + (toff) + 8192u); \
        r[2] = *(const u32x4*)(_qd + (toff)); r[3] = *(const u32x4*)(_qd + (toff) + 8192u); \
        r[4] = *(const u32x4*)(_qk + (toff)); \
        r[5] = *(const u32x4*)(_kt + (toff)); r[6] = *(const u32x4*)(_kt + (toff) + 8192u); \
        const unsigned char* _w = gW + _i * 16384; r[7] = *(const u32x4*)(_w + (toff)); r[8] = *(const u32x4*)(_w + (toff) + 8192u); } while (0)
    { const unsigned t0 = (unsigned)tid_in * 16u; DS_LOAD(bh * 32, t0); }
#pragma unroll 1
    for (int n = 0; n < 32; ++n) {
        int tid = tid_in; asm volatile("" : "+v"(tid));
        const int lane = tid & 63, fr = lane & 15, quad = lane >> 4, vcol = 16 * wave + fr;
        const unsigned toff = (unsigned)tid * 16u;
        const int it = bh * 32 + n, tokb = b * SEQ + n * 64;
        __syncthreads();
        { const int i0 = tid, i1 = tid + 512;
          *(LAS u32x4*)(KCs + (i0 >> 4) * 272 + (i0 & 15) * 16) = r[0]; *(LAS u32x4*)(KCs + (i1 >> 4) * 272 + (i1 & 15) * 16) = r[1];
          *(LAS u32x4*)(QDs + (i0 >> 4) * 272 + (i0 & 15) * 16) = r[2]; *(LAS u32x4*)(QDs + (i1 >> 4) * 272 + (i1 & 15) * 16) = r[3];
          *(LAS u32x4*)(QKs + (i0 >> 3) * 144 + (i0 & 7) * 16) = r[4];
          *(LAS u32x4*)(KDTs + (i0 >> 3) * 144 + (i0 & 7) * 16) = r[5]; *(LAS u32x4*)(KDTs + (i1 >> 3) * 144 + (i1 & 7) * 16) = r[6];
          *(LAS u32x4*)(Ws + (i0 >> 4) * 272 + (i0 & 15) * 16) = r[7]; *(LAS u32x4*)(Ws + (i1 >> 4) * 272 + (i1 & 15) * 16) = r[8]; }
        __syncthreads();
        const float glast = __builtin_bit_cast(float, __builtin_amdgcn_readlane(__builtin_bit_cast(int, gl_all), n));
        const bf16_t* gateb = (const bf16_t*)(A.ws + WS_PROJ) + (size_t)tokb * NPROJ + PC_G + h * 128;
        unsigned gtp[4][4];
#pragma unroll
        for (int mt = 0; mt < 4; ++mt)
#pragma unroll
            for (int i = 0; i < 4; ++i) gtp[mt][i] = gateb[(unsigned)((mt * 16 + quad * 4 + i) * NPROJ + vcol)];
#pragma unroll
        for (int mt = 0; mt < 8; ++mt) { u32x2 p; p.x = pk2(S[mt][0], S[mt][1]); p.y = pk2(S[mt][2], S[mt][3]); *(LAS u32x2*)(SS + fr * 272 + (mt * 16 + quad * 4) * 2) = p; }
        LDS_FENCE();
        bf16x8 Sb[4];
#pragma unroll
        for (int kk = 0; kk < 4; ++kk) Sb[kk] = *(LAS bf16x8*)(SS + fr * 272 + (kk * 32 + quad * 8) * 2);
        f32x4 U[4], O[4];
#pragma unroll
        for (int mt = 0; mt < 4; ++mt) { f32x4 au, ao = {0.f, 0.f, 0.f, 0.f};
#pragma unroll
            for (int i = 0; i < 4; ++i) au[i] = bf2f(*(LAS bf16_t*)(Ws + (mt * 16 + quad * 4 + i) * 272 + vcol * 2));
#pragma unroll
            for (int kk = 0; kk < 4; ++kk) { const bf16x8 a1 = *(LAS bf16x8*)(KCs + (mt * 16 + fr) * 272 + (kk * 32 + quad * 8) * 2); au = mfma16(a1, Sb[kk], au);
                const bf16x8 a2 = *(LAS bf16x8*)(QDs + (mt * 16 + fr) * 272 + (kk * 32 + quad * 8) * 2); ao = mfma16(a2, Sb[kk], ao); }
            U[mt] = au; O[mt] = ao; __builtin_amdgcn_sched_barrier(0); }
        if (n + 1 < 32) DS_LOAD(it + 1, toff);
#pragma unroll
        for (int mt = 0; mt < 4; ++mt) { u32x2 p; p.x = pk2(U[mt][0], U[mt][1]); p.y = pk2(U[mt][2], U[mt][3]); *(LAS u32x2*)(US + fr * 144 + (mt * 16 + quad * 4) * 2) = p; }
        LDS_FENCE();
        bf16x8 Ub[2];
#pragma unroll
        for (int kk = 0; kk < 2; ++kk) Ub[kk] = *(LAS bf16x8*)(US + fr * 144 + (kk * 32 + quad * 8) * 2);
#pragma unroll
        for (int mt = 0; mt < 4; ++mt)
#pragma unroll
            for (int kk = 0; kk < 2; ++kk) { const bf16x8 a = *(LAS bf16x8*)(QKs + (mt * 16 + fr) * 144 + (kk * 32 + quad * 8) * 2); O[mt] = mfma16(a, Ub[kk], O[mt]); }
        __builtin_amdgcn_sched_barrier(0);
#pragma unroll
        for (int mt = 0; mt < 8; ++mt) { S[mt] *= glast;
#pragma unroll
            for (int kk = 0; kk < 2; ++kk) { const bf16x8 a = *(LAS bf16x8*)(KDTs + (mt * 16 + fr) * 144 + (kk * 32 + quad * 8) * 2); S[mt] = mfma16(a, Ub[kk], S[mt]); }
            if (mt & 1) __builtin_amdgcn_sched_barrier(0); }
#pragma unroll
        for (int mt = 0; mt < 4; ++mt)
#pragma unroll
            for (int i = 0; i < 4; ++i) { float p = O[mt][i] * O[mt][i]; p += __shfl_xor(p, 1); p += __shfl_xor(p, 2); p += __shfl_xor(p, 4); p += __shfl_xor(p, 8);
                if (fr == 0) PART[wave * 64 + mt * 16 + quad * 4 + i] = p; }
        __syncthreads();
        bf16_t* mixb = (bf16_t*)(A.ws + WS_MIX) + (size_t)tokb * D + h * 128;
#pragma unroll
        for (int mt = 0; mt < 4; ++mt)
#pragma unroll
            for (int i = 0; i < 4; ++i) { const int t = mt * 16 + quad * 4 + i; float tot = 0.f;
#pragma unroll
                for (int w = 0; w < 8; ++w) tot += PART[w * 64 + t];
                const float sc = rsqrtf(tot * (1.f / 128.f) + EPS) * onorm;
                const float gtv = bf2f(gtp[mt][i]);
                mixb[(unsigned)(t * D + vcol)] = (bf16_t)f2bf(O[mt][i] * sc * silu_f(gtv)); }
    }
#undef DS_LOAD
    { const int lane = lane_in, fr = lane & 15, quad = lane >> 4, vcol = 16 * wave + fr;
      float* dp = A.out + O_DP + (size_t)((l * 8 + b) * 4 + h) * 16384;
#pragma unroll
      for (int mt = 0; mt < 8; ++mt)
#pragma unroll
          for (int i = 0; i < 4; ++i) dp[(mt * 16 + quad * 4 + i) * 128 + vcol] = S[mt][i]; }
    __syncthreads();
}

__device__ __forceinline__ void delta_sample_item(const DevArgs& A, int l, LAS unsigned char* lds, int item, int tid, int wave, int lane) {
    const int b = item >> 2, h = item & 3, tokS = NP + b * 4;
    LAS float* RAW = (LAS float*)lds; LAS float* RED = RAW + 1536; LAS float* OB = RED + 512; LAS float* SC = OB + 512;
    const bf16_t* PROJ = (const bf16_t*)(A.ws + WS_PROJ); const float* AB = (const float*)(A.ws + WS_AB); bf16_t* MIX = (bf16_t*)(A.ws + WS_MIX);
    const float* cw = A.in[I_CONVW] + (size_t)l * 4 * 1536;
    for (int idx = tid; idx < 1536; idx += 512) { const int part = idx >> 9, t = (idx >> 7) & 3, c = idx & 127, col = part * 512 + h * 128 + c;
        float acc = 0.f;
#pragma unroll
        for (int j = 0; j < 4; ++j) { const int tt = t - 3 + j;
            const float x = (tt >= 0) ? bf2f(PROJ[(size_t)(tokS + tt) * NPROJ + col]) : A.in[I_SCONV][((size_t)(l * 128 + b) * 3 + (3 + tt)) * 1536 + col];
            acc += cw[j * 1536 + col] * x; }
        RAW[idx] = silu_f(acc); }
    if (tid < 4) { const float a = AB[(size_t)(tokS + tid) * 8 + h], bb = AB[(size_t)(tokS + tid) * 8 + 4 + h];
        const float xx = a + A.in[I_DTB][l * 4 + h]; const float sp = xx > 20.f ? xx : log1pf(expf(xx));
        SC[8 + tid] = 1.f / (1.f + expf(-bb)); SC[12 + tid] = expf(-expf(A.in[I_ALOG][l * 4 + h]) * sp); }
    const int v = tid & 127, kq = tid >> 7;
    float S[32];
    { const float* sp = A.in[I_SDELTA] + (size_t)((l * 128 + b) * 4 + h) * 16384;
#pragma unroll
      for (int i = 0; i < 32; ++i) S[i] = sp[(kq * 32 + i) * 128 + v]; }
    __syncthreads();
    { const int part = wave >> 2, t = wave & 3; const float x0 = RAW[part * 512 + t * 128 + lane], x1 = RAW[part * 512 + t * 128 + 64 + lane];
      const float ss = wave_sum(x0 * x0 + x1 * x1); if (lane == 0) SC[part * 4 + t] = rsqrtf(ss + EPS) * (part == 0 ? 0.08838834764831845f : 1.f); }
    __syncthreads();
    for (int t = 0; t < 4; ++t) {
        const float rq = SC[t], rk = SC[4 + t], beta = SC[8 + t], g = SC[12 + t];
        float pr = 0.f;
#pragma unroll
        for (int i = 0; i < 32; ++i) pr += S[i] * RAW[512 + t * 128 + kq * 32 + i];
        RED[kq * 128 + v] = pr * rk;
        __syncthreads();
        const float rr = (RED[v] + RED[128 + v]) + (RED[256 + v] + RED[384 + v]);
        const float u = beta * (RAW[1024 + t * 128 + v] - g * rr);
        float po = 0.f;
#pragma unroll
        for (int i = 0; i < 32; ++i) { const float kh = RAW[512 + t * 128 + kq * 32 + i] * rk; S[i] = g * S[i] + kh * u; po += S[i] * RAW[t * 128 + kq * 32 + i]; }
        __syncthreads();
        RED[kq * 128 + v] = po * rq;
        __syncthreads();
        if (kq == 0) OB[t * 128 + v] = (RED[v] + RED[128 + v]) + (RED[256 + v] + RED[384 + v]);
        __syncthreads();
    }
    if (wave < 4) { const int t = wave; const float x0 = OB[t * 128 + lane], x1 = OB[t * 128 + 64 + lane];
        const float ss = wave_sum(x0 * x0 + x1 * x1); const float sc = rsqrtf(ss * (1.f / 128.f) + EPS);
        const float g0 = bf2f(PROJ[(size_t)(tokS + t) * NPROJ + PC_G + h * 128 + lane]), g1 = bf2f(PROJ[(size_t)(tokS + t) * NPROJ + PC_G + h * 128 + 64 + lane]);
        MIX[(size_t)(tokS + t) * D + h * 128 + lane] = (bf16_t)f2bf(x0 * sc * A.in[I_ONORM][l * 128 + lane] * silu_f(g0));
        MIX[(size_t)(tokS + t) * D + h * 128 + 64 + lane] = (bf16_t)f2bf(x1 * sc * A.in[I_ONORM][l * 128 + 64 + lane] * silu_f(g1)); }
    { float* dsp = A.out + O_DS + (size_t)((l * 128 + b) * 4 + h) * 16384;
#pragma unroll
      for (int i = 0; i < 32; ++i) dsp[(kq * 32 + i) * 128 + v] = S[i]; }
    __syncthreads();
}

#define SSM_BCAST_U(t) do { unsigned _w[8]; \
        _w[0] = __builtin_amdgcn_readlane(ua.x, t); _w[1] = __builtin_amdgcn_readlane(ua.y, t); _w[2] = __builtin_amdgcn_readlane(ua.z, t); _w[3] = __builtin_amdgcn_readlane(ua.w, t); \
        _w[4] = __builtin_amdgcn_readlane(ub.x, t); _w[5] = __builtin_amdgcn_readlane(ub.y, t); _w[6] = __builtin_amdgcn_readlane(ub.z, t); _w[7] = __builtin_amdgcn_readlane(ub.w, t); \
        _Pragma("unroll") for (int _d = 0; _d < 8; ++_d) { uu[2 * _d] = __uint_as_float(_w[_d] << 16); uu[2 * _d + 1] = __uint_as_float(_w[_d] & 0xffff0000u); } } while (0)
#define SSM_STEP() do { float _br = 0.f, _bi = 0.f; \
        _Pragma("unroll") for (int _h = 0; _h < 16; ++_h) { _br = fmaf(Br[_h], uu[_h], _br); _bi = fmaf(Bi[_h], uu[_h], _bi); } \
        const float _nr = lr * hr - li * hi + _br, _ni = lr * hi + li * hr + _bi; hr = _nr; hi = _ni; } while (0)

__device__ __forceinline__ void ssm_part1_item(const DevArgs& A, int l, int it, int lane) {
    const int g = it & 15, bc = it >> 4, b = bc / 31, c = bc % 31;
    const float* bb = (const float*)(A.ws + WS_BBAR) + ((size_t)(l * 16 + g) * 64 + lane) * 32;
    float Br[16], Bi[16];
#pragma unroll
    for (int q = 0; q < 4; ++q) { const f32x4 x = ((const f32x4*)bb)[q], y = ((const f32x4*)bb)[4 + q];
        Br[4 * q] = x.x; Br[4 * q + 1] = x.y; Br[4 * q + 2] = x.z; Br[4 * q + 3] = x.w; Bi[4 * q] = y.x; Bi[4 * q + 1] = y.y; Bi[4 * q + 2] = y.z; Bi[4 * q + 3] = y.w; }
    const f32x4 lk = ((const f32x4*)(A.ws + WS_SSMK))[(l * 16 + g) * 64 + lane]; const float lr = lk.x, li = lk.y;
    const bf16_t* up = (const bf16_t*)(A.ws + WS_PROJ) + (size_t)(b * SEQ + c * 64 + lane) * NPROJ + PC_SSM + g * 16;
    const u32x4 ua = *(const u32x4*)up, ub = *(const u32x4*)(up + 8);
    float hr = 0.f, hi = 0.f, uu[16];
#pragma unroll 1
    for (int t = 0; t < 64; ++t) { SSM_BCAST_U(t); SSM_STEP(); }
    f32x2 e; e.x = hr; e.y = hi;
    ((f32x2*)(A.ws + WS_SSME))[((size_t)(b * 32 + c) * 16 + g) * 64 + lane] = e;
}

__device__ __forceinline__ void ssm_part2_item(const DevArgs& A, int l, LAS unsigned char* lds, int it, int tid, int wave, int lane) {
    const int tok0 = it * 64, fr = lane & 15, quad = lane >> 4;
    const bool samp = it >= 256; const int b = it >> 5, c = it & 31;
    LAS unsigned char* YS = lds; LAS unsigned char* HS = lds + 33792 + wave * 4352;
    const bf16_t* PROJ = (const bf16_t*)(A.ws + WS_PROJ); bf16_t* MIX = (bf16_t*)(A.ws + WS_MIX);
#pragma unroll 1
    for (int gi = 0; gi < 2; ++gi) {
        const int g = wave * 2 + gi;
        const float* bb = (const float*)(A.ws + WS_BBAR) + ((size_t)(l * 16 + g) * 64 + lane) * 32;
        float Br[16], Bi[16];
#pragma unroll
        for (int q = 0; q < 4; ++q) { const f32x4 x = ((const f32x4*)bb)[q], y = ((const f32x4*)bb)[4 + q];
            Br[4 * q] = x.x; Br[4 * q + 1] = x.y; Br[4 * q + 2] = x.z; Br[4 * q + 3] = x.w; Bi[4 * q] = y.x; Bi[4 * q + 1] = y.y; Bi[4 * q + 2] = y.z; Bi[4 * q + 3] = y.w; }
        const f32x4 lk = ((const f32x4*)(A.ws + WS_SSMK))[(l * 16 + g) * 64 + lane]; const float lr = lk.x, li = lk.y, Lr = lk.z, Li = lk.w;
        bf16x8 Cb[4];
#pragma unroll
        for (int kk = 0; kk < 4; ++kk) { const size_t co = ((size_t)(l * 16 + g) * 16 + fr) * 64 + kk * 16 + quad * 4;
            const f32x4 cr = *(const f32x4*)(A.in[I_CRE] + co), ci = *(const f32x4*)(A.in[I_CIM] + co);
            u32x4 pk; pk.x = pk2(cr.x, -ci.x); pk.y = pk2(cr.y, -ci.y); pk.z = pk2(cr.z, -ci.z); pk.w = pk2(cr.w, -ci.w);
            Cb[kk] = __builtin_bit_cast(bf16x8, pk); }
        const bf16_t* up = PROJ + (size_t)(tok0 + lane) * NPROJ + PC_SSM + g * 16;
        const u32x4 ua = *(const u32x4*)up, ub = *(const u32x4*)(up + 8);
        float hr = 0.f, hi = 0.f, uu[16];
        if (!samp && c > 0) { const f32x2* E = (const f32x2*)(A.ws + WS_SSME) + ((size_t)(b * 32) * 16 + g) * 64 + lane;
#pragma unroll
            for (int cb = 0; cb < 32; cb += 16) { f32x2 ev[16];
#pragma unroll
                for (int q = 0; q < 16; ++q) { const int cc = cb + q; ev[q] = (cc < c) ? E[(size_t)cc * 1024] : (f32x2){0.f, 0.f}; }
#pragma unroll
                for (int q = 0; q < 16; ++q) { const int cc = cb + q; if (cc < c) { const float nr = Lr * hr - Li * hi + ev[q].x, ni = Lr * hi + Li * hr + ev[q].y; hr = nr; hi = ni; } } } }
        const float dsk = A.in[I_SSMD][l * 256 + g * 16 + fr];
#pragma unroll 1
        for (int sub = 0; sub < 4; ++sub) {
#pragma unroll 1
            for (int tt = 0; tt < 16; ++tt) { const int t = sub * 16 + tt;
                const int sb = (it - 256) * 16 + (t >> 2);
                if (samp && (t & 3) == 0) { hr = A.in[I_SRE][((size_t)(l * 128 + sb) * 16 + g) * 64 + lane]; hi = A.in[I_SIM][((size_t)(l * 128 + sb) * 16 + g) * 64 + lane]; }
                SSM_BCAST_U(t); SSM_STEP();
                *(LAS unsigned*)(HS + tt * 272 + lane * 4) = pg8::cvt_pk_bf16(hr, hi);
                if (samp && (t & 3) == 3) { A.out[O_RES + ((size_t)(l * 128 + sb) * 16 + g) * 64 + lane] = hr; A.out[O_IMS + ((size_t)(l * 128 + sb) * 16 + g) * 64 + lane] = hi; }
            }
            LDS_FENCE();
            f32x4 acc = {0.f, 0.f, 0.f, 0.f};
#pragma unroll
            for (int kk = 0; kk < 4; ++kk) { const bf16x8 a = *(LAS bf16x8*)(HS + fr * 272 + (kk * 32 + quad * 8) * 2); acc = mfma16(a, Cb[kk], acc); }
#pragma unroll
            for (int i = 0; i < 4; ++i) { const int t = sub * 16 + quad * 4 + i; const float uv = bf2f(PROJ[(size_t)(tok0 + t) * NPROJ + PC_SSM + g * 16 + fr]);
                *(LAS bf16_t*)(YS + t * 528 + (g * 16 + fr) * 2) = (bf16_t)f2bf(gelu_tanh_f(acc[i] + dsk * uv)); }
            LDS_FENCE();
        }
        if (!samp && c == 31) { A.out[O_REP + ((size_t)(l * 8 + b) * 16 + g) * 64 + lane] = hr; A.out[O_IMP + ((size_t)(l * 8 + b) * 16 + g) * 64 + lane] = hi; }
    }
    __syncthreads();
    {
        const bf16_t* GT = (const bf16_t*)(A.ws + WS_GLUT + l * SZ_GLUT);
        f32x4 acc[4][2];
#pragma unroll
        for (int mt = 0; mt < 4; ++mt) { acc[mt][0] = (f32x4){0.f, 0.f, 0.f, 0.f}; acc[mt][1] = (f32x4){0.f, 0.f, 0.f, 0.f}; }
#pragma unroll
        for (int kk = 0; kk < 8; ++kk) { bf16x8 bfr[2];
#pragma unroll
            for (int nt = 0; nt < 2; ++nt) bfr[nt] = *(const bf16x8*)(GT + (size_t)(32 * wave + nt * 16 + fr) * 256 + kk * 32 + quad * 8);
#pragma unroll
            for (int mt = 0; mt < 4; ++mt) { const bf16x8 a = *(LAS bf16x8*)(YS + (mt * 16 + fr) * 528 + (kk * 32 + quad * 8) * 2);
                acc[mt][0] = mfma16(a, bfr[0], acc[mt][0]); acc[mt][1] = mfma16(a, bfr[1], acc[mt][1]); } }
#pragma unroll
        for (int nt = 0; nt < 2; ++nt) { const int ncol = 32 * wave + nt * 16 + fr; const float gb = A.in[I_GLUB][l * 256 + ncol];
#pragma unroll
            for (int mt = 0; mt < 4; ++mt)
#pragma unroll
                for (int i = 0; i < 4; ++i) { const int t = mt * 16 + quad * 4 + i; const float y = bf2f(*(LAS bf16_t*)(YS + t * 528 + ncol * 2));
                    MIX[(size_t)(tok0 + t) * D + 512 + ncol] = (bf16_t)f2bf(y * sigmoid_f(acc[mt][nt][i] + gb)); } }
    }
    __syncthreads();
}

__device__ __forceinline__ void pool_item(const DevArgs& A, int l, LAS unsigned char* lds, int it, int tid, int wave, int lane) {
    const int tok0 = it * 64, fr = lane & 15, quad = lane >> 4; const bool samp = it >= 256;
    LAS unsigned char* RS = lds;
    const bf16_t* PROJ = (const bf16_t*)(A.ws + WS_PROJ); bf16_t* MIX = (bf16_t*)(A.ws + WS_MIX);
    if (!samp) {
        LAS unsigned char* XT = lds + 33792;
        const int b = it >> 5, c = it & 31;
        for (int id = tid; id < 79 * 32; id += 512) { const int r = id >> 5, c16 = id & 31, tl = c * 64 - 15 + r;
            u32x4 v = {0u, 0u, 0u, 0u}; if (tl >= 0) v = *(const u32x4*)(PROJ + (size_t)(b * SEQ + tl) * NPROJ + PC_POOL + c16 * 8);
            *(LAS u32x4*)(XT + r * 528 + c16 * 16) = v; }
        __syncthreads();
        const int ch = tid & 255, half = tid >> 8, g = ch >> 6, w = 2 << g, r0 = half * 32;
        float sum = 0.f;
        for (int j = 0; j < w; ++j) sum += bf2f(*(LAS bf16_t*)(XT + (r0 + 15 - j) * 528 + ch * 2));
#pragma unroll 4
        for (int rr = 0; rr < 32; ++rr) { const int r = r0 + rr, tl = c * 64 + r;
            const float u = bf2f(*(LAS bf16_t*)(XT + (r + 15) * 528 + ch * 2));
            if (rr > 0) sum += u - bf2f(*(LAS bf16_t*)(XT + (r + 15 - w) * 528 + ch * 2));
            const float cnt = (float)((tl + 1 < w) ? tl + 1 : w);
            *(LAS bf16_t*)(RS + r * 528 + ch * 2) = (bf16_t)f2bf(sum / cnt - u); }
    } else {
#pragma unroll 1
        for (int pr = 0; pr < 8; ++pr) { const int idx = pr * 512 + tid, ch = idx & 255, sq = idx >> 8, g = ch >> 6, w = 2 << g;
            const int sb = (it - 256) * 16 + sq;
            const float* sbuf = A.in[I_SPOOL] + (size_t)(l * 128 + sb) * 15 * 256 + ch;
            const bf16_t* base = PROJ + (size_t)(NP + sb * 4) * NPROJ + PC_POOL + ch;
            float e[19];
#pragma unroll
            for (int j = 0; j < 15; ++j) e[j] = sbuf[j * 256];
#pragma unroll
            for (int j = 0; j < 4; ++j) e[15 + j] = bf2f(base[(size_t)j * NPROJ]);
#pragma unroll
            for (int t = 0; t < 4; ++t) { float sum = 0.f;
#pragma unroll
                for (int j = 0; j < 16; ++j) sum += (j < w) ? e[15 + t - j] : 0.f;
                *(LAS bf16_t*)(RS + (sq * 4 + t) * 528 + ch * 2) = (bf16_t)f2bf(sum / (float)w - e[15 + t]); } }
    }
    __syncthreads();
    { const int g2 = wave >> 1; const bf16_t* PT = (const bf16_t*)(A.ws + WS_POOLT + l * SZ_POOLT) + g2 * 4096;
      f32x4 acc[4][2];
#pragma unroll
      for (int mt = 0; mt < 4; ++mt) { acc[mt][0] = (f32x4){0.f, 0.f, 0.f, 0.f}; acc[mt][1] = (f32x4){0.f, 0.f, 0.f, 0.f}; }
#pragma unroll
      for (int kk = 0; kk < 2; ++kk) { bf16x8 bfr[2];
#pragma unroll
          for (int nt = 0; nt < 2; ++nt) bfr[nt] = *(const bf16x8*)(PT + (size_t)((wave & 1) * 32 + nt * 16 + fr) * 64 + kk * 32 + quad * 8);
#pragma unroll
          for (int mt = 0; mt < 4; ++mt) { const bf16x8 a = *(LAS bf16x8*)(RS + (mt * 16 + fr) * 528 + (g2 * 64 + kk * 32 + quad * 8) * 2);
              acc[mt][0] = mfma16(a, bfr[0], acc[mt][0]); acc[mt][1] = mfma16(a, bfr[1], acc[mt][1]); } }
#pragma unroll
      for (int nt = 0; nt < 2; ++nt) { const int col = 32 * wave + nt * 16 + fr; const float ps = A.in[I_POOLS][l * 256 + col];
#pragma unroll
          for (int mt = 0; mt < 4; ++mt)
#pragma unroll
              for (int i = 0; i < 4; ++i) { const int t = mt * 16 + quad * 4 + i; MIX[(size_t)(tok0 + t) * D + 768 + col] = (bf16_t)f2bf(acc[mt][nt][i] * ps); } } }
    __syncthreads();
}

__device__ __forceinline__ void state_copies(const DevArgs& A, int l, int gt, int NT) {
    const bf16_t* PROJ = (const bf16_t*)(A.ws + WS_PROJ);
    for (int i = gt; i < 8 * 3 * 1536; i += NT) { const int col = i % 1536, j = (i / 1536) % 3, b = i / 4608;
        A.out[O_CP + (size_t)l * 8 * 4608 + i] = bf2f(PROJ[(size_t)(b * SEQ + SEQ - 3 + j) * NPROJ + col]); }
    for (int i = gt; i < 128 * 3 * 1536; i += NT) { const int col = i % 1536, j = (i / 1536) % 3, b = i / 4608;
        A.out[O_CS + (size_t)l * 128 * 4608 + i] = bf2f(PROJ[(size_t)(NP + b * 4 + 1 + j) * NPROJ + col]); }
    for (int i = gt; i < 8 * 15 * 256; i += NT) { const int ch = i & 255, j = (i >> 8) % 15, b = i / 3840;
        A.out[O_PP + (size_t)l * 8 * 3840 + i] = bf2f(PROJ[(size_t)(b * SEQ + SEQ - 15 + j) * NPROJ + PC_POOL + ch]); }
    for (int i = gt; i < 128 * 15 * 256; i += NT) { const int ch = i & 255, j = (i >> 8) % 15, b = i / 3840;
        A.out[O_PS + (size_t)l * 128 * 3840 + i] = (j < 11) ? A.in[I_SPOOL][((size_t)(l * 128 + b) * 15 + 4 + j) * 256 + ch]
                                                             : bf2f(PROJ[(size_t)(NP + b * 4 + (j - 11)) * NPROJ + PC_POOL + ch]); }
}

constexpr int NPH = 2 + DEPTH * 8;
__global__ void __launch_bounds__(512, 2) mega_fwd(Args KA) {
    DevArgs A; A.out = KA.out; A.ws = KA.ws; A.ph_lo = KA.ph_lo; A.ph_hi = KA.ph_hi;
    extern __shared__ __attribute__((aligned(16))) unsigned char lds_raw[];
    LAS unsigned char* lds = (LAS unsigned char*)lds_raw;
    cg::grid_group grid = cg::this_grid();
    const int G = gridDim.x, NGW = G * 8, NT = G * 512;
    int ph = 0;
#define PH_BEGIN if (A.ph_lo <= ph && ph < A.ph_hi) { int tid = threadIdx.x; asm volatile("" : "+v"(tid)); const int wave = __builtin_amdgcn_readfirstlane(tid >> 6), lane = tid & 63, gw = blockIdx.x * 8 + wave, gt = blockIdx.x * 512 + tid; (void)gw; (void)gt; (void)lane;
#define PH_END   if (ph + 1 < A.ph_hi) grid.sync(); } ++ph;
    bf16_t* Hb = (bf16_t*)(A.ws + WS_H); float* AB = (float*)(A.ws + WS_AB); float* MIXO = (float*)(A.ws + WS_MIXO);
    bf16_t* PROJ = (bf16_t*)(A.ws + WS_PROJ); bf16_t* MIX = (bf16_t*)(A.ws + WS_MIX); bf16_t* HID = (bf16_t*)(A.ws + WS_HID);

#ifndef NO_PRO
    PH_BEGIN prologue(A, lds, wave, lane, gw, NGW); __syncthreads(); PH_END
#endif
#ifndef NO_N0
    PH_BEGIN norm_rows(nullptr, nullptr, A.in[I_XP], A.in[I_XS], nullptr, A.in[I_NMPRE], Hb, (const float*)(A.ws + WS_WAB), AB, gw, NGW, lane); PH_END
#endif

#pragma unroll 1
    for (int l = 0; l < DEPTH; ++l) {
#ifndef NO_G1
        PH_BEGIN { pg8::Gemm g{Hb, (const bf16_t*)(A.ws + WS_WIN + l * SZ_WIN), NTOK, NPROJ, D}; pg8::StaticOrder S; S.init(NTOK, NPROJ, G, (int)blockIdx.x);
            pg8::EpiBf16<0> E{PROJ, NPROJ, nullptr, 0, 0}; pg8::gemm_phase<pg8::EpiBf16<0>, pg8::StaticOrder>(lds, g, S, E, nullptr); } PH_END
#endif
        PH_BEGIN {
            #ifndef NO_DPREP
            for (int it = blockIdx.x; it < 1024; it += G) delta_prep_item(A, l, lds, it, tid, wave, lane);
#endif
            #ifndef NO_DSAMP
            for (int it = blockIdx.x; it < 512; it += G) delta_sample_item(A, l, lds, it, tid, wave, lane);
#endif
            #ifndef NO_SSM1
            for (int it = gw; it < 8 * 31 * 16; it += NGW) ssm_part1_item(A, l, it, lane);
#endif
            #ifndef NO_POOL
            for (int it = blockIdx.x; it < 264; it += G) pool_item(A, l, lds, it, tid, wave, lane);
#endif
            state_copies(A, l, gt, NT);
        } PH_END
        PH_BEGIN {
#ifndef NO_P3
            const int nd = (G > 64) ? 32 : 0;
#ifndef NO_DSCAN
            if (nd == 0 || (int)blockIdx.x < nd) for (int it = blockIdx.x; it < 32; it += G) delta_scan_item(A, l, lds, it, tid, wave, lane);
#endif
#ifndef NO_SSM2
            if (nd == 0 || (int)blockIdx.x >= nd) for (int it = blockIdx.x - nd; it < 264; it += G - nd) ssm_part2_item(A, l, lds, it, tid, wave, lane);
#endif
#endif
        } PH_END
#ifndef NO_G2
        PH_BEGIN { pg8::Gemm g{MIX, (const bf16_t*)(A.ws + WS_WOUT + l * SZ_WOUT), NTOK, D, D}; pg8::StaticOrder S; S.init(NTOK, D, G, (int)blockIdx.x);
            pg8::EpiF32 E{MIXO, D, nullptr}; pg8::gemm_phase<pg8::EpiF32, pg8::StaticOrder>(lds, g, S, E, nullptr); } PH_END
#endif
#ifndef NO_N5
        PH_BEGIN norm_rows(MIXO, A.in[I_NMPOST] + l * D, l == 0 ? A.in[I_XP] : A.out, l == 0 ? A.in[I_XS] : nullptr, A.out, A.in[I_NFPRE] + l * D, Hb, nullptr, nullptr, gw, NGW, lane); PH_END
#endif
#ifndef NO_G3
        PH_BEGIN { pg8::Gemm g{Hb, (const bf16_t*)(A.ws + WS_WGU + l * SZ_WGU), NTOK, NGU, D}; pg8::StaticOrder S; S.init(NTOK, NGU, G, (int)blockIdx.x);
            EpiSwiGLU E{HID, DFF}; pg8::gemm_phase<EpiSwiGLU, pg8::StaticOrder>(lds, g, S, E, nullptr); } PH_END
#endif
#ifndef NO_G4
        PH_BEGIN { pg8::Gemm g{HID, (const bf16_t*)(A.ws + WS_WDN + l * SZ_WDN), NTOK, D, DFF}; pg8::StaticOrder S; S.init(NTOK, D, G, (int)blockIdx.x);
            pg8::EpiF32 E{MIXO, D, nullptr}; pg8::gemm_phase<pg8::EpiF32, pg8::StaticOrder>(lds, g, S, E, nullptr); } PH_END
#endif
#ifndef NO_N8
        PH_BEGIN norm_rows(MIXO, A.in[I_NFPOST] + l * D, A.out, nullptr, A.out, l + 1 < DEPTH ? A.in[I_NMPRE] + (l + 1) * D : nullptr, l + 1 < DEPTH ? Hb : nullptr,
                           l + 1 < DEPTH ? (const float*)(A.ws + WS_WAB + (l + 1) * SZ_WAB) : nullptr, AB, gw, NGW, lane); PH_END
#endif
    }
#undef PH_BEGIN
#undef PH_END
}

extern "C" void kernel_launch(void* const* d_in, const int* in_sizes, int n_in, void* d_out, int out_size, void* d_ws, size_t ws_size, hipStream_t stream) {
    static int grid = 0;
    if (grid == 0) {
        if (n_in != 32 || (size_t)out_size != O_END || ws_size < WS_END) fprintf(stderr, "kernel_launch: unexpected sizes: n_in %d out %d (want %zu) ws %zu (want >= %zu)\n", n_in, out_size, (size_t)O_END, ws_size, (size_t)WS_END);
        int dev = 0, cus = 0, per_cu = 0;
        (void)hipGetDevice(&dev); (void)hipDeviceGetAttribute(&cus, hipDeviceAttributeMultiprocessorCount, dev);
        if (hipFuncSetAttribute((const void*)mega_fwd, hipFuncAttributeMaxDynamicSharedMemorySize, LDS_BYTES) != hipSuccess) fprintf(stderr, "kernel_launch: hipFuncSetAttribute failed\n");
        if (hipOccupancyMaxActiveBlocksPerMultiprocessor(&per_cu, (const void*)mega_fwd, 512, LDS_BYTES) != hipSuccess || per_cu < 1) { fprintf(stderr, "kernel_launch: occupancy query gave %d\n", per_cu); per_cu = 1; (void)hipGetLastError(); }
        grid = cus * per_cu; if (grid <= 0) grid = 256;
        fprintf(stderr, "kernel_launch: grid %d (cus %d x %d)\n", grid, cus, per_cu);
    }
    Args a{};
    for (int i = 0; i < 32; ++i) a.in[i] = (const float*)d_in[i];
    a.out = (float*)d_out; a.ws = (unsigned char*)d_ws;
#if MK_COOP
    a.ph_lo = 0; a.ph_hi = NPH;
    void* args[] = {&a};
    const hipError_t e = hipLaunchCooperativeKernel((const void*)mega_fwd, dim3(grid), dim3(512), args, LDS_BYTES, stream);
    if (e != hipSuccess) fprintf(stderr, "kernel_launch: cooperative launch failed: %s (grid %d)\n", hipGetErrorString(e), grid);
#else
    for (int p = 0; p < NPH; ++p) { a.ph_lo = p; a.ph_hi = p + 1; hipLaunchKernelGGL(mega_fwd, dim3(grid), dim3(512), LDS_BYTES, stream, a); }
#endif
}
```

```cpp
#include <hip/hip_runtime.h>
#include <hip/hip_cooperative_groups.h>
#include <cstdio>
#include <cstdint>
namespace cg = cooperative_groups;
#ifndef MK_COOP
#define MK_COOP 1
#endif
namespace pg8 {
#define PG8_LAS __attribute__((address_space(3)))
typedef unsigned short bf16_t;
typedef short bf16x8 __attribute__((ext_vector_type(8)));
typedef float f32x4 __attribute__((ext_vector_type(4)));
typedef unsigned u32x4 __attribute__((ext_vector_type(4)));
constexpr int BM = 256, BK = 64, HALF = 128, HTB = HALF * BK * 2  , STAGE_BYTES = 8 * HTB, NXCD = 8, WGM = 8;

__host__ __device__ __forceinline__ int lds_byte(int r, int c) { const int st = (r >> 4) * 2 + (c >> 5), rr = r & 15, cc = c & 31, ob = rr * 64 + cc * 2; return st * 1024 + (ob ^ (((ob >> 9) & 1) << 5)); }
__host__ __device__ __forceinline__ void stage_rc(int b, int& R, int& C) { const int st = b / 1024, sb = b % 1024, swz = sb ^ (((sb >> 9) & 1) << 5); R = (st >> 1) * 16 + swz / 64; C = (st & 1) * 32 + (swz % 64) / 2; }
__host__ __device__ __forceinline__ int perm32(int rho) { const int n = rho >> 4, i = rho & 15; return 8 * (i >> 2) + 4 * n + (i & 3); }

struct Unit { int pm, pn; };
struct Gemm { const bf16_t* A; const bf16_t* Bt; int M, N, K; };

struct StaticOrder {
    int nM, nN, nwg, G, c;
    __host__ __device__ void init(int M, int N, int G_, int c_) { nM = M / BM; nN = N / BM; nwg = nM * nN; G = G_; c = c_; }
    __host__ __device__ bool next(int i, Unit& u) const {
        const long L = (long)i * G + c; if (L >= nwg) return false;
        int wgid = (int)L; { const int q = nwg / NXCD, r = nwg % NXCD, xcd = wgid % NXCD, off = wgid / NXCD; wgid = (xcd < r ? xcd * (q + 1) : r * (q + 1) + (xcd - r) * q) + off; }
        const int nig = WGM * nN, gid = wgid / nig, fm = gid * WGM, gsz = (nM - fm) < WGM ? (nM - fm) : WGM;
        u.pm = fm + ((wgid % nig) % gsz); u.pn = (wgid % nig) / gsz; return true;
    }
    __device__ __forceinline__ void a_ready(const Unit&) const {}
    __device__ __forceinline__ void done(const Unit&) const {}
};
__device__ __forceinline__ unsigned cvt_pk_bf16(float lo, float hi) { unsigned r; asm volatile("v_cvt_pk_bf16_f32 %0, %1, %2" : "=v"(r) : "v"(lo), "v"(hi)); return r; }
typedef float f32x2 __attribute__((ext_vector_type(2)));
__device__ __forceinline__ f32x2 gelu_pk(f32x2 v) {
    const f32x2 av = __builtin_elementwise_abs(v), d = av * 0.2316418882f + 1.0f;
    f32x2 t; t.x = __builtin_amdgcn_rcpf(d.x); t.y = __builtin_amdgcn_rcpf(d.y);
    f32x2 q = t * 0.5307027145f + (-0.7265760135f); q = q * t + 0.7107068705f; q = q * t + (-0.142248368f); q = q * t + 0.127414796f; q = q * t;
    const f32x2 s = (v * v) * (-0.72134752044f);
    f32x2 e; e.x = __builtin_amdgcn_exp2f(s.x); e.y = __builtin_amdgcn_exp2f(s.y);
    const f32x2 m = v * (q * e), r = v - m;
    f32x2 o; o.x = v.x < 0.f ? m.x : r.x; o.y = v.y < 0.f ? m.y : r.y; return o;
}

struct EpiF32 {
    static constexpr bool PERM = false, AFTER_DRAIN = false;
    float* C; int ldc; const float* bias;
    __device__ __forceinline__ void operator()(const f32x4 (&acc)[2][2][4][2], const Unit& u, int wr, int wc, int fr, int fq) const {
        const int row0 = u.pm * BM + wr * 64 + fr, col0 = u.pn * BM + wc * 32 + 4 * fq;
        f32x4 bv[2][2];
#pragma unroll
        for (int bj = 0; bj < 2; ++bj)
#pragma unroll
            for (int n = 0; n < 2; ++n) bv[bj][n] = bias ? *(const f32x4*)(bias + col0 + bj * HALF + n * 16) : (f32x4){0.f, 0.f, 0.f, 0.f};
#pragma unroll
        for (int ai = 0; ai < 2; ++ai)
#pragma unroll
            for (int m = 0; m < 4; ++m) { float* rowp = C + (size_t)(row0 + ai * HALF + m * 16) * ldc + col0;
#pragma unroll
                for (int bj = 0; bj < 2; ++bj)
#pragma unroll
                    for (int n = 0; n < 2; ++n) *(f32x4*)(rowp + bj * HALF + n * 16) = acc[ai][bj][m][n] + bv[bj][n]; }
    }
};
template <int ACT  > struct EpiBf16 {
    static constexpr bool PERM = true, AFTER_DRAIN = false;
    bf16_t* O; int ldc; const float* bias; int split_cols; size_t split_stride;
    __device__ __forceinline__ void operator()(const f32x4 (&acc)[2][2][4][2], const Unit& u, int wr, int wc, int fr, int fq) const {
        const int row0 = u.pm * BM + wr * 64 + fr; int colt = u.pn * BM; bf16_t* base = O;
        if (split_cols) { const int t = colt / split_cols; base += (size_t)t * split_stride; colt -= t * split_cols; }
        const int col0 = colt + wc * 32 + 8 * fq, bcol0 = u.pn * BM + wc * 32 + 8 * fq;
        f32x4 bv[2][2];
#pragma unroll
        for (int bj = 0; bj < 2; ++bj)
#pragma unroll
            for (int n = 0; n < 2; ++n) bv[bj][n] = bias ? *(const f32x4*)(bias + bcol0 + bj * HALF + 4 * n) : (f32x4){0.f, 0.f, 0.f, 0.f};
#pragma unroll
        for (int ai = 0; ai < 2; ++ai)
#pragma unroll
            for (int m = 0; m < 4; ++m) { bf16_t* rowp = base + (size_t)(row0 + ai * HALF + m * 16) * ldc + col0;
#pragma unroll
                for (int bj = 0; bj < 2; ++bj) { f32x4 v0 = acc[ai][bj][m][0] + bv[bj][0], v1 = acc[ai][bj][m][1] + bv[bj][1];
                    if (ACT == 1) { f32x2 a = gelu_pk((f32x2){v0[0], v0[1]}), b = gelu_pk((f32x2){v0[2], v0[3]}), c = gelu_pk((f32x2){v1[0], v1[1]}), d = gelu_pk((f32x2){v1[2], v1[3]});
                        v0 = (f32x4){a.x, a.y, b.x, b.y}; v1 = (f32x4){c.x, c.y, d.x, d.y}; }
                    if (ACT == 2) {
#pragma unroll
                        for (int j = 0; j < 4; ++j) { v0[j] = 0.5f * v0[j] * (1.0f + erff(v0[j] * 0.70710678f)); v1[j] = 0.5f * v1[j] * (1.0f + erff(v1[j] * 0.70710678f)); } }
                    u32x4 w; w.x = cvt_pk_bf16(v0[0], v0[1]); w.y = cvt_pk_bf16(v0[2], v0[3]); w.z = cvt_pk_bf16(v1[0], v1[1]); w.w = cvt_pk_bf16(v1[2], v1[3]);
                    *(u32x4*)(rowp + bj * HALF) = w; } }
    }
};
template <class Epi, class Sched, bool STAMP = false>
__device__ __forceinline__ void gemm_phase(PG8_LAS unsigned char* lds, const Gemm g, const Sched& S, const Epi& E, unsigned long long* stamps) {
    int tid_ = threadIdx.x; asm volatile("" : "+v"(tid_));
    const int tid = tid_, wid = __builtin_amdgcn_readfirstlane(tid >> 6), lane = tid & 63, wr = wid >> 2, wc = wid & 3, fr = lane & 15, fq = lane >> 4;
    const int K = g.K, nt = K / BK;
    int ts_lo = 0, ts_hi = 0, nts = 0; const unsigned long long rt_entry = STAMP ? (unsigned long long)wall_clock64() : 0ull;
#define PG8_STAMP() do { if (STAMP && wid == 0 && nts < 64) { const unsigned long long _c = (unsigned long long)clock64(); \
        ts_lo = (lane == nts) ? (int)(unsigned)_c : ts_lo; ts_hi = (lane == nts) ? (int)(unsigned)(_c >> 32) : ts_hi; ++nts; } } while (0)
    PG8_STAMP();
    unsigned voffA[2], voffB[2];
#pragma unroll
    for (int i = 0; i < 2; ++i) { int R, C; stage_rc(tid * 16 + i * 8192, R, C); const int Rb = Epi::PERM ? ((R & ~31) + perm32(R & 31)) : R;
        voffA[i] = (unsigned)(R * K + C) * 2u; voffB[i] = (unsigned)(Rb * K + C) * 2u; }
    const size_t kstep = (size_t)(BK * 2);
    const size_t hstep = (size_t)HALF * K * 2;
    const size_t tstep = 2 * hstep;
    const unsigned ldsw = (unsigned)wid * 1024u;
    const int aoff = lds_byte(wr * 64 + fr, fq * 8), boff = lds_byte(wc * 32 + fr, fq * 8);
#define PG8_SA(b, h) (((b) * 2 + (h)) * HTB)
#define PG8_SB(b, h) ((4 + (b) * 2 + (h)) * HTB)
#define PG8_STAGE(bufoff, gbase, voff) do { _Pragma("unroll") for (int _i = 0; _i < 2; ++_i) \
        __builtin_amdgcn_global_load_lds((const unsigned*)((const char*)(gbase) + (voff)[_i]), (PG8_LAS unsigned*)(lds + (bufoff) + ldsw + _i * 8192), 16, 0, 0); } while (0)
#define PG8_LDA(dst, b, h) do { _Pragma("unroll") for (int m = 0; m < 4; ++m) _Pragma("unroll") for (int k = 0; k < 2; ++k) dst[m][k] = *(const PG8_LAS bf16x8*)(lds + PG8_SA(b, h) + aoff + m * 2048 + k * 1024); } while (0)
#define PG8_LDB(dst, b, h) do { _Pragma("unroll") for (int n = 0; n < 2; ++n) _Pragma("unroll") for (int k = 0; k < 2; ++k) dst[n][k] = *(const PG8_LAS bf16x8*)(lds + PG8_SB(b, h) + boff + n * 2048 + k * 1024); } while (0)
#define PG8_MMA(ai, bj, At, Bt) do { __builtin_amdgcn_s_setprio(1); _Pragma("unroll") for (int m = 0; m < 4; ++m) _Pragma("unroll") for (int n = 0; n < 2; ++n) _Pragma("unroll") for (int k = 0; k < 2; ++k) \
        acc[ai][bj][m][n] = __builtin_amdgcn_mfma_f32_16x16x32_bf16(Bt[n][k], At[m][k], acc[ai][bj][m][n], 0, 0, 0); __builtin_amdgcn_s_setprio(0); } while (0)
#define PG8_WAIT_V(n) asm volatile("s_waitcnt vmcnt(" #n ")" ::: "memory")
#define PG8_WAIT_L(n) asm volatile("s_waitcnt lgkmcnt(" #n ")" ::: "memory")
#define PG8_BAR __builtin_amdgcn_s_barrier()
#define PG8_SCHED __builtin_amdgcn_sched_barrier(0)
    Unit cur, nxt; int ui = 0;
    if (!S.next(0, cur)) return;
    f32x4 acc[2][2][4][2];
#pragma unroll
    for (int a = 0; a < 2; ++a)
#pragma unroll
        for (int b = 0; b < 2; ++b)
#pragma unroll
            for (int m = 0; m < 4; ++m)
#pragma unroll
                for (int n = 0; n < 2; ++n) acc[a][b][m][n] = (f32x4){0.f, 0.f, 0.f, 0.f};
    bf16x8 At[4][2], B0[2][2], B1[2][2];
    const char* cA = (const char*)g.A + (size_t)cur.pm * tstep; const char* cB = (const char*)g.Bt + (size_t)cur.pn * tstep;
    S.a_ready(cur);
    PG8_STAGE(PG8_SB(0, 0), cB, voffB); PG8_STAGE(PG8_SA(0, 0), cA, voffA); PG8_STAGE(PG8_SB(0, 1), cB + hstep, voffB); PG8_STAGE(PG8_SA(0, 1), cA + hstep, voffA);
    if (wr == 1) PG8_BAR;
    PG8_WAIT_V(4); PG8_BAR;
    PG8_STAGE(PG8_SB(1, 0), cB + kstep, voffB); PG8_STAGE(PG8_SA(1, 0), cA + kstep, voffA); PG8_STAGE(PG8_SB(1, 1), cB + hstep + kstep, voffB);
    PG8_WAIT_V(6); PG8_BAR;
    PG8_STAMP();
    for (;;) {
        const bool has_next = S.next(ui + 1, nxt);
        const char* nA = has_next ? (const char*)g.A + (size_t)nxt.pm * tstep : cA; const char* nB = has_next ? (const char*)g.Bt + (size_t)nxt.pn * tstep : cB;
        for (int t = 0; t < nt; t += 2) {
            const bool last = (t == nt - 2);
            const char* a1 = cA + (size_t)(t + 1) * kstep;
            const char* a2 = last ? nA : cA + (size_t)(t + 2) * kstep; const char* b2 = last ? nB : cB + (size_t)(t + 2) * kstep;
            const char* a3 = a2 + kstep; const char* b3 = b2 + kstep;
            if (last && has_next) S.a_ready(nxt);
            PG8_LDB(B0, 0, 0); PG8_SCHED; PG8_LDA(At, 0, 0); PG8_STAGE(PG8_SA(1, 1), a1 + hstep, voffA);
            PG8_WAIT_L(8); PG8_BAR; PG8_WAIT_L(0); PG8_MMA(0, 0, At, B0); PG8_BAR; PG8_SCHED;
            PG8_LDB(B1, 0, 1); PG8_STAGE(PG8_SB(0, 0), b2, voffB);
            PG8_BAR; PG8_WAIT_L(0); PG8_MMA(0, 1, At, B1); PG8_BAR;
            PG8_LDA(At, 0, 1); PG8_STAGE(PG8_SA(0, 0), a2, voffA);
            PG8_BAR; PG8_WAIT_L(0); PG8_MMA(1, 0, At, B0); PG8_BAR; PG8_SCHED;
            PG8_STAGE(PG8_SB(0, 1), b2 + hstep, voffB);
            PG8_WAIT_V(6); PG8_BAR; PG8_MMA(1, 1, At, B1); PG8_BAR;
            PG8_LDB(B0, 1, 0); PG8_SCHED; PG8_LDA(At, 1, 0); PG8_STAGE(PG8_SA(0, 1), a2 + hstep, voffA);
            PG8_WAIT_L(8); PG8_BAR; PG8_WAIT_L(0); PG8_MMA(0, 0, At, B0); PG8_BAR; PG8_SCHED;
            PG8_LDB(B1, 1, 1); PG8_STAGE(PG8_SB(1, 0), b3, voffB);
            PG8_BAR; PG8_WAIT_L(0); PG8_MMA(0, 1, At, B1); PG8_BAR;
            PG8_LDA(At, 1, 1); PG8_STAGE(PG8_SA(1, 0), a3, voffA);
            PG8_BAR; PG8_WAIT_L(0); PG8_MMA(1, 0, At, B0); PG8_BAR; PG8_SCHED;
            PG8_STAGE(PG8_SB(1, 1), b3 + hstep, voffB);
            PG8_WAIT_V(6); PG8_BAR; PG8_MMA(1, 1, At, B1); PG8_BAR;
        }
        PG8_STAMP();
        if constexpr (!Epi::AFTER_DRAIN) { E(acc, cur, wr, wc, fr, fq); S.done(cur); }
        PG8_STAMP();
        if (!has_next) break;
#pragma unroll
        for (int a = 0; a < 2; ++a)
#pragma unroll
            for (int b = 0; b < 2; ++b)
#pragma unroll
                for (int m = 0; m < 4; ++m)
#pragma unroll
                    for (int n = 0; n < 2; ++n) acc[a][b][m][n] = (f32x4){0.f, 0.f, 0.f, 0.f};
        cur = nxt; cA = nA; cB = nB; ++ui;
    }
    PG8_WAIT_V(0);
    if (wr == 0) PG8_BAR;
    PG8_BAR;
    if constexpr (Epi::AFTER_DRAIN) { E.fused(acc, cur, wr, wc, fr, fq, lds, wid, lane); S.done(cur); }
    PG8_STAMP();
    if (STAMP && wid == 0) { stamps[lane] = lane < nts ? (((unsigned long long)(unsigned)ts_hi << 32) | (unsigned)ts_lo) : 0ull;
        if (lane == 62) stamps[62] = rt_entry; if (lane == 63) stamps[63] = (unsigned long long)wall_clock64(); }
#undef PG8_STAMP
#undef PG8_SA
#undef PG8_SB
#undef PG8_STAGE
#undef PG8_LDA
#undef PG8_LDB
#undef PG8_MMA
#undef PG8_WAIT_V
#undef PG8_WAIT_L
#undef PG8_BAR
#undef PG8_SCHED
}
}

#define LAS __attribute__((address_space(3)))
typedef unsigned short bf16_t;
typedef short bf16x8 __attribute__((ext_vector_type(8)));
typedef float f32x4 __attribute__((ext_vector_type(4)));
typedef float f32x2 __attribute__((ext_vector_type(2)));
typedef unsigned u32x4 __attribute__((ext_vector_type(4)));
typedef unsigned u32x2 __attribute__((ext_vector_type(2)));

constexpr int D = 1024, NP = 16384, NS = 512, NTOK = NP + NS, SEQ = 2048, NB = 8, NSB = 128, DEPTH = 4;
constexpr int INW = 2568, NPROJ = 2560, DFF = 2816, NGU = 5632;
constexpr int PC_G = 1536, PC_SSM = 2048, PC_POOL = 2304;
constexpr float EPS = 1e-6f;
constexpr int LDS_BYTES = 147456;

constexpr size_t SZ_WIN = (size_t)NPROJ * D * 2, SZ_WOUT = (size_t)D * D * 2, SZ_WGU = (size_t)NGU * D * 2, SZ_WDN = (size_t)D * DFF * 2;
constexpr size_t SZ_WAB = 8 * D * 4, SZ_GLUT = 256 * 256 * 2, SZ_POOLT = 4 * 64 * 64 * 2, SZ_SSMK = 16 * 64 * 4 * 4, SZ_BBAR = 16 * 64 * 32 * 4;
constexpr size_t WS_WIN = 0;
constexpr size_t WS_WOUT = WS_WIN + DEPTH * SZ_WIN;
constexpr size_t WS_WGU = WS_WOUT + DEPTH * SZ_WOUT;
constexpr size_t WS_WDN = WS_WGU + DEPTH * SZ_WGU;
constexpr size_t WS_WAB = WS_WDN + DEPTH * SZ_WDN;
constexpr size_t WS_GLUT = WS_WAB + DEPTH * SZ_WAB;
constexpr size_t WS_POOLT = WS_GLUT + DEPTH * SZ_GLUT;
constexpr size_t WS_SSMK = WS_POOLT + DEPTH * SZ_POOLT;
constexpr size_t WS_BBAR = WS_SSMK + DEPTH * SZ_SSMK;
constexpr size_t WS_H = WS_BBAR + DEPTH * SZ_BBAR;
constexpr size_t WS_AB = WS_H + (size_t)NTOK * D * 2;
constexpr size_t WS_MIX = WS_AB + (size_t)NTOK * 8 * 4;
constexpr size_t WS_MIXO = WS_MIX + (size_t)NTOK * D * 2;
constexpr size_t WS_SSME = WS_MIXO + (size_t)NTOK * D * 4;
constexpr size_t WS_PROJ = WS_SSME + (size_t)8 * 32 * 16 * 64 * 2 * 4;
constexpr size_t WS_DW = WS_PROJ + (size_t)NTOK * NPROJ * 2;
constexpr size_t WS_DKC = WS_DW + (size_t)1024 * 8192 * 4;
constexpr size_t WS_DQD = WS_DKC + (size_t)1024 * 8192 * 2;
constexpr size_t WS_DQK = WS_DQD + (size_t)1024 * 8192 * 2;
constexpr size_t WS_DKT = WS_DQK + (size_t)1024 * 4096 * 2;
constexpr size_t WS_DGL = WS_DKT + (size_t)1024 * 8192 * 2;
constexpr size_t WS_BAR = WS_DGL + 4096;
constexpr size_t WS_END = WS_BAR + 16384;
constexpr size_t WS_HID = WS_PROJ;
static_assert(WS_HID + (size_t)NTOK * DFF * 2 <= WS_END, "HID overlay");
static_assert(WS_H % 256 == 0 && WS_PROJ % 256 == 0 && WS_DW % 256 == 0, "align");

constexpr size_t O_YP = 0, O_YS = O_YP + (size_t)NP * D, O_DP = O_YS + (size_t)NS * D, O_CP = O_DP + (size_t)DEPTH * 8 * 4 * 16384,
                 O_REP = O_CP + (size_t)DEPTH * 8 * 3 * 1536, O_IMP = O_REP + (size_t)DEPTH * 8 * 1024, O_PP = O_IMP + (size_t)DEPTH * 8 * 1024,
                 O_DS = O_PP + (size_t)DEPTH * 8 * 15 * 256, O_CS = O_DS + (size_t)DEPTH * 128 * 4 * 16384, O_RES = O_CS + (size_t)DEPTH * 128 * 3 * 1536,
                 O_IMS = O_RES + (size_t)DEPTH * 128 * 1024, O_PS = O_IMS + (size_t)DEPTH * 128 * 1024, O_END = O_PS + (size_t)DEPTH * 128 * 15 * 256;

struct Args { const float* in[32]; float* out; unsigned char* ws; int ph_lo, ph_hi; };
typedef const float* cfp_t;
typedef __attribute__((address_space(4))) const unsigned char* kptr_t;
struct InProxy { __device__ __forceinline__ const float* operator[](int i) const {
    kptr_t p = (kptr_t)__builtin_amdgcn_kernarg_segment_ptr(); asm volatile("" : "+s"(p)); return *(__attribute__((address_space(4))) const cfp_t*)(p + 8 * i); } };
struct DevArgs { InProxy in; float* out; unsigned char* ws; int ph_lo, ph_hi; };
enum { I_XP = 0, I_XS, I_SDELTA, I_SCONV, I_SRE, I_SIM, I_SPOOL, I_NMPRE, I_NMPOST, I_NFPRE, I_NFPOST, I_WIN, I_CONVW, I_ALOG, I_DTB, I_ONORM,
       I_ARE, I_AIM, I_LOGDT, I_BRE, I_BIM, I_CRE, I_CIM, I_SSMD, I_GLUW, I_GLUB, I_POOLW, I_POOLS, I_WOUT, I_WG, I_WU, I_WD };

__device__ __forceinline__ unsigned f2bf(float f) { unsigned u = __float_as_uint(f); return (u + 0x7fffu + ((u >> 16) & 1u)) >> 16; }
__device__ __forceinline__ float bf2f(unsigned b) { return __uint_as_float(b << 16); }
__device__ __forceinline__ unsigned pk2(float lo, float hi) { return f2bf(lo) | (f2bf(hi) << 16); }
__device__ __forceinline__ float wave_sum(float v) {
#pragma unroll
    for (int o = 1; o < 64; o <<= 1) v += __shfl_xor(v, o);
    return v;
}
__device__ __forceinline__ float silu_f(float y) { return y / (1.f + __expf(-y)); }
__device__ __forceinline__ float sigmoid_f(float y) { return 1.f / (1.f + __expf(-y)); }
__device__ __forceinline__ float gelu_tanh_f(float x) { const float t = tanhf(0.7978845608028654f * (x + 0.044715f * x * x * x)); return 0.5f * x * (1.f + t); }
__device__ __forceinline__ f32x4 mfma16(bf16x8 a, bf16x8 b, f32x4 c) { return __builtin_amdgcn_mfma_f32_16x16x32_bf16(a, b, c, 0, 0, 0); }
#define LDS_FENCE() asm volatile("s_waitcnt lgkmcnt(0)" ::: "memory")

struct EpiSwiGLU {
    static constexpr bool PERM = false, AFTER_DRAIN = false;
    bf16_t* O; int ldc;
    __device__ __forceinline__ void operator()(const pg8::f32x4 (&acc)[2][2][4][2], const pg8::Unit& u, int wr, int wc, int fr, int fq) const {
        const int row0 = u.pm * 256 + wr * 64 + fr, hid0 = u.pn * 128 + wc * 16 + 4 * fq;
#pragma unroll
        for (int ai = 0; ai < 2; ++ai)
#pragma unroll
            for (int m = 0; m < 4; ++m) { bf16_t* rowp = O + (size_t)(row0 + ai * 128 + m * 16) * ldc + hid0;
#pragma unroll
                for (int bj = 0; bj < 2; ++bj) { const pg8::f32x4 g = acc[ai][bj][m][0], v = acc[ai][bj][m][1];
                    u32x2 w; w.x = pk2(silu_f(g[0]) * v[0], silu_f(g[1]) * v[1]); w.y = pk2(silu_f(g[2]) * v[2], silu_f(g[3]) * v[3]);
                    *(u32x2*)(rowp + bj * 64) = w; } }
    }
};

struct SrcIn { const float* w; __device__ __forceinline__ float operator()(int k, int n) const { return w[(size_t)k * INW + (n < 1536 ? n : n + 8)]; } };
struct SrcPlain { const float* w; int N; __device__ __forceinline__ float operator()(int k, int n) const { return w[(size_t)k * N + n]; } };
struct SrcGU { const float* g; const float* u; __device__ __forceinline__ float operator()(int k, int n) const { const int r = n & 31, hid = (n >> 5) * 16 + (r & 15); const long long du = (r < 16) ? 0ll : (long long)(u - g); return g[du + (long long)k * DFF + hid]; } };
template <class Src> __device__ __forceinline__ void transpose_item(const Src& src, int K, bf16_t* WT, int nblk, LAS float* scr, int item, int lane) {
    const int kb = item / nblk, nb = item % nblk, k0 = 64 * kb, n0 = 32 * nb;
#pragma unroll 8
    for (int i = 0; i < 32; ++i) { const int kk = 2 * i + (lane >> 5); scr[kk * 33 + (lane & 31)] = src(k0 + kk, n0 + (lane & 31)); }
    LDS_FENCE();
    const int c = lane & 7;
#pragma unroll
    for (int j = 0; j < 4; ++j) { const int n = (lane >> 3) + 8 * j; const LAS float* s = scr + (8 * c) * 33 + n;
        u32x4 o; o.x = pk2(s[0 * 33], s[1 * 33]); o.y = pk2(s[2 * 33], s[3 * 33]); o.z = pk2(s[4 * 33], s[5 * 33]); o.w = pk2(s[6 * 33], s[7 * 33]);
        *(u32x4*)(WT + (size_t)(n0 + n) * K + k0 + 8 * c) = o; }
    LDS_FENCE();
}

__device__ __forceinline__ void norm_rows(const float* T, const float* wt, const float* X0, const float* X1, float* Xout, const float* wh, bf16_t* H,
                                          const float* Wab, float* AB, int gw, int NGW, int lane) {
    for (int m = gw; m < NTOK; m += NGW) {
        const float* xr = (X1 && m >= NP) ? X1 + (size_t)(m - NP) * D : X0 + (size_t)m * D;
        f32x4 x[4];
#pragma unroll
        for (int j = 0; j < 4; ++j) x[j] = ((const f32x4*)xr)[lane + 64 * j];
        if (T) {
            f32x4 t[4]; float ss = 0.f;
#pragma unroll
            for (int j = 0; j < 4; ++j) { t[j] = ((const f32x4*)(T + (size_t)m * D))[lane + 64 * j]; ss += (t[j].x * t[j].x + t[j].y * t[j].y) + (t[j].z * t[j].z + t[j].w * t[j].w); }
            ss = wave_sum(ss); const float r = rsqrtf(ss * (1.f / D) + EPS);
#pragma unroll
            for (int j = 0; j < 4; ++j) { const f32x4 w = ((const f32x4*)wt)[lane + 64 * j]; x[j] += t[j] * r * w; }
        }
        if (Xout) {
#pragma unroll
            for (int j = 0; j < 4; ++j) ((f32x4*)(Xout + (size_t)m * D))[lane + 64 * j] = x[j];
        }
        if (H) {
            float ss = 0.f;
#pragma unroll
            for (int j = 0; j < 4; ++j) ss += (x[j].x * x[j].x + x[j].y * x[j].y) + (x[j].z * x[j].z + x[j].w * x[j].w);
            ss = wave_sum(ss); const float r = rsqrtf(ss * (1.f / D) + EPS);
            f32x4 hv[4];
#pragma unroll
            for (int j = 0; j < 4; ++j) { const f32x4 w = ((const f32x4*)wh)[lane + 64 * j]; hv[j] = x[j] * r * w;
                u32x2 o; o.x = pk2(hv[j].x, hv[j].y); o.y = pk2(hv[j].z, hv[j].w); ((u32x2*)(H + (size_t)m * D))[lane + 64 * j] = o; }
            if (Wab) {
#pragma unroll
                for (int c = 0; c < 8; ++c) { float d = 0.f;
#pragma unroll
                    for (int j = 0; j < 4; ++j) { const f32x4 w = ((const f32x4*)(Wab + c * D))[lane + 64 * j]; d += (hv[j].x * w.x + hv[j].y * w.y) + (hv[j].z * w.z + hv[j].w * w.w); }
                    d = wave_sum(d); if (lane == 0) AB[(size_t)m * 8 + c] = d; }
            }
        }
    }
}

__device__ __forceinline__ void prologue(const DevArgs& A, LAS unsigned char* lds, int wave, int lane, int gw, int NGW) {
    LAS float* scr = (LAS float*)(lds + wave * 8704);
    constexpr int I_IN = 16 * 80, I_OUT = 16 * 32, I_GU = 16 * 176, I_DN = 44 * 32, I_GLU = 4 * 8, I_POOL = 8, PER = I_IN + I_OUT + I_GU + I_DN + I_GLU + I_POOL;
    for (int it = gw; it < DEPTH * PER; it += NGW) {
        const int l = it / PER; int r = it % PER;
        if (r < I_IN) { SrcIn s{A.in[I_WIN] + (size_t)l * D * INW}; transpose_item(s, D, (bf16_t*)(A.ws + WS_WIN + l * SZ_WIN), NPROJ / 32, scr, r, lane); continue; } r -= I_IN;
        if (r < I_OUT) { SrcPlain s{A.in[I_WOUT] + (size_t)l * D * D, D}; transpose_item(s, D, (bf16_t*)(A.ws + WS_WOUT + l * SZ_WOUT), D / 32, scr, r, lane); continue; } r -= I_OUT;
        if (r < I_GU) { SrcGU s{A.in[I_WG] + (size_t)l * D * DFF, A.in[I_WU] + (size_t)l * D * DFF}; transpose_item(s, D, (bf16_t*)(A.ws + WS_WGU + l * SZ_WGU), NGU / 32, scr, r, lane); continue; } r -= I_GU;
        if (r < I_DN) { SrcPlain s{A.in[I_WD] + (size_t)l * DFF * D, D}; transpose_item(s, DFF, (bf16_t*)(A.ws + WS_WDN + l * SZ_WDN), D / 32, scr, r, lane); continue; } r -= I_DN;
        if (r < I_GLU) { SrcPlain s{A.in[I_GLUW] + (size_t)l * 65536, 256}; transpose_item(s, 256, (bf16_t*)(A.ws + WS_GLUT + l * SZ_GLUT), 8, scr, r, lane); continue; } r -= I_GLU;
        { const int g = r >> 1; SrcPlain s{A.in[I_POOLW] + (size_t)(l * 4 + g) * 4096, 64}; transpose_item(s, 64, (bf16_t*)(A.ws + WS_POOLT + l * SZ_POOLT) + g * 4096, 2, scr, r & 1, lane); }
    }
    const int gt = gw * 64 + lane, NT = NGW * 64;
    float* wab = (float*)(A.ws + WS_WAB);
    for (int i = gt; i < DEPTH * 8 * D; i += NT) { const int l = i / (8 * D), j = (i / D) & 7, k = i % D; wab[i] = A.in[I_WIN][((size_t)l * D + k) * INW + 1536 + j]; }
    float* ssmk = (float*)(A.ws + WS_SSMK); float* bbar = (float*)(A.ws + WS_BBAR);
    for (int i = gt; i < DEPTH * 16 * 64; i += NT) {
        const int lg = i >> 6;
        const float dt = expf(A.in[I_LOGDT][lg]), ar = A.in[I_ARE][i], ai = A.in[I_AIM][i];
        const float mag = expf(ar * dt);
        float rev = ai * dt * 0.15915494309189535f; rev -= floorf(rev);
        const float sn = __builtin_amdgcn_sinf(rev), cs = __builtin_amdgcn_cosf(rev);
        const float lr = mag * cs, li = mag * sn;
        float pr = lr, pi = li;
#pragma unroll
        for (int q = 0; q < 6; ++q) { const float nr2 = pr * pr - pi * pi, ni2 = 2.f * pr * pi; pr = nr2; pi = ni2; }
        ssmk[i * 4 + 0] = lr; ssmk[i * 4 + 1] = li; ssmk[i * 4 + 2] = pr; ssmk[i * 4 + 3] = pi;
        const float nr = lr - 1.f, ni = li, d2 = ar * ar + ai * ai;
        const float cre = (nr * ar + ni * ai) / d2, cim = (ni * ar - nr * ai) / d2;
#pragma unroll
        for (int h = 0; h < 16; ++h) { const float br = A.in[I_BRE][(size_t)i * 16 + h], bi = A.in[I_BIM][(size_t)i * 16 + h];
            bbar[(size_t)i * 32 + h] = cre * br - cim * bi; bbar[(size_t)i * 32 + 16 + h] = cre * bi + cim * br; }
    }
}

__device__ __forceinline__ void delta_prep_item(const DevArgs& A, int l, LAS unsigned char* lds, int item, int tid, int wave, int lane) {
    const int bh = item >> 5, n = item & 31, b = bh >> 2, h = bh & 3;
    const int tok0 = b * SEQ + n * 64;
    LAS bf16_t* QS = (LAS bf16_t*)(lds); LAS bf16_t* KS = (LAS bf16_t*)(lds + 17408);
    LAS float* RHS = (LAS float*)(lds + 34816);
    LAS float* AM = (LAS float*)(lds + 100352); LAS float* PM = (LAS float*)(lds + 117760);
    LAS float* GAM = (LAS float*)(lds + 135168); LAS float* BETA = GAM + 64; LAS float* RQ = GAM + 128; LAS float* RK = GAM + 192;
    const bf16_t* PROJ = (const bf16_t*)(A.ws + WS_PROJ);
    const float* AB = (const float*)(A.ws + WS_AB);
    if (tid < 384) {
        const int part = tid >> 7, c = tid & 127, col = part * 512 + h * 128 + c;
        const float* cw = A.in[I_CONVW] + (size_t)l * 4 * 1536;
        const float w0 = cw[col], w1 = cw[1536 + col], w2 = cw[3072 + col], w3 = cw[4608 + col];
        const bf16_t* pp = PROJ + (size_t)tok0 * NPROJ + col;
        float xr[67];
#pragma unroll
        for (int t = 0; t < 67; ++t) xr[t] = (n > 0 || t >= 3) ? bf2f(pp[(long)(t - 3) * NPROJ]) : 0.f;
#pragma unroll
        for (int t = 0; t < 64; ++t) {
            const float y = w0 * xr[t] + w1 * xr[t + 1] + w2 * xr[t + 2] + w3 * xr[t + 3];
            const float s = silu_f(y);
            if (part == 0) QS[t * 136 + c] = (bf16_t)f2bf(s);
            else if (part == 1) KS[t * 136 + c] = (bf16_t)f2bf(s);
            else RHS[t * 256 + c] = s;
        }
    } else if (tid < 448) {
        const int t = tid - 384;
        const float a = AB[(size_t)(tok0 + t) * 8 + h], bb = AB[(size_t)(tok0 + t) * 8 + 4 + h];
        const float xx = a + A.in[I_DTB][l * 4 + h];
        const float sp = xx > 20.f ? xx : log1pf(expf(xx));
        float lg = -expf(A.in[I_ALOG][l * 4 + h]) * sp;
#pragma unroll
        for (int off = 1; off < 64; off <<= 1) { const float v = __shfl_up(lg, off); if (lane >= off) lg += v; }
        GAM[t] = lg; BETA[t] = 1.f / (1.f + expf(-bb));
    }
    __syncthreads();
    {
        const int t = tid >> 3, part = tid & 7; float sq = 0.f, sk = 0.f;
#pragma unroll
        for (int j = 0; j < 16; ++j) { const float q = bf2f(QS[t * 136 + part * 16 + j]), k = bf2f(KS[t * 136 + part * 16 + j]); sq += q * q; sk += k * k; }
        sq += __shfl_xor(sq, 1); sq += __shfl_xor(sq, 2); sq += __shfl_xor(sq, 4);
        sk += __shfl_xor(sk, 1); sk += __shfl_xor(sk, 2); sk += __shfl_xor(sk, 4);
        if (part == 0) { RQ[t] = rsqrtf(sq + EPS) * 0.08838834764831845f; RK[t] = rsqrtf(sk + EPS); }
    }
    {
        const int prod = wave >> 2, mt = wave & 3, fr = lane & 15, quad = lane >> 4;
        LAS bf16_t* Aop = prod ? QS : KS; LAS float* dst = prod ? PM : AM;
        bf16x8 a[4];
#pragma unroll
        for (int kk = 0; kk < 4; ++kk) a[kk] = *(LAS bf16x8*)(Aop + (mt * 16 + fr) * 136 + kk * 32 + quad * 8);
#pragma unroll
        for (int nt = 0; nt < 4; ++nt) { f32x4 acc = {0.f, 0.f, 0.f, 0.f};
#pragma unroll
            for (int kk = 0; kk < 4; ++kk) { const bf16x8 bq = *(LAS bf16x8*)(KS + (nt * 16 + fr) * 136 + kk * 32 + quad * 8); acc = mfma16(a[kk], bq, acc); }
#pragma unroll
            for (int i = 0; i < 4; ++i) dst[(mt * 16 + quad * 4 + i) * 68 + nt * 16 + fr] = acc[i]; }
    }
    __syncthreads();
    bf16_t* DQK = (bf16_t*)(A.ws + WS_DQK) + (size_t)item * 4096;
    bf16_t* DQD = (bf16_t*)(A.ws + WS_DQD) + (size_t)item * 8192;
    bf16_t* DKT = (bf16_t*)(A.ws + WS_DKT) + (size_t)item * 8192;
    for (int idx = tid; idx < 4096; idx += 512) { const int t = idx >> 6, s = idx & 63;
        const float dec = (s <= t) ? __expf(GAM[t] - GAM[s]) : 0.f;
        const float am = AM[t * 68 + s], pm = PM[t * 68 + s];
        AM[t * 68 + s] = (s < t) ? BETA[t] * RK[t] * RK[s] * am * dec : 0.f;
        DQK[idx] = (bf16_t)f2bf(RQ[t] * RK[s] * pm * dec); }
    for (int idx = tid; idx < 8192; idx += 512) { const int t = idx >> 7, c = idx & 127; const float bt = BETA[t], eg = __expf(GAM[t]);
        const float kraw = bf2f(KS[t * 136 + c]), qraw = bf2f(QS[t * 136 + c]);
        RHS[t * 256 + c] *= bt; RHS[t * 256 + 128 + c] = bt * eg * RK[t] * kraw;
        DQD[idx] = (bf16_t)f2bf(qraw * RQ[t] * eg); }
    { const float g63 = GAM[63];
      for (int idx = tid; idx < 8192; idx += 512) { const int c = idx >> 6, t = idx & 63; DKT[idx] = (bf16_t)f2bf(bf2f(KS[t * 136 + c]) * RK[t] * __expf(g63 - GAM[t])); }
      if (tid == 0) ((float*)(A.ws + WS_DGL))[item] = __expf(g63); }
    __syncthreads();
    if (tid < 256) {
        float sol[64];
        LAS float* amp = AM; asm volatile("" : "+v"(amp));
        LAS float* rhp = RHS + tid; asm volatile("" : "+v"(rhp));
#pragma unroll
        for (int t = 0; t < 64; ++t) { float acc = rhp[t * 256];
#pragma unroll
            for (int s = 0; s < t; ++s) acc = fmaf(-amp[t * 68 + s], sol[s], acc);
            sol[t] = acc; __builtin_amdgcn_sched_barrier(0); }
        if (tid < 128) { bf16_t* DW = (bf16_t*)(A.ws + WS_DW) + (size_t)item * 8192 + tid;
#pragma unroll
            for (int t = 0; t < 64; ++t) DW[t * 128] = (bf16_t)f2bf(sol[t]); }
        else { bf16_t* DKC = (bf16_t*)(A.ws + WS_DKC) + (size_t)item * 8192 + (tid - 128);
#pragma unroll
            for (int t = 0; t < 64; ++t) DKC[t * 128] = (bf16_t)f2bf(-sol[t]); }
    }
    __syncthreads();
}

__device__ __forceinline__ void delta_scan_item(const DevArgs& A, int l, LAS unsigned char* lds, int bh, int tid_in, int wave, int lane_in) {
    const int b = bh >> 2, h = bh & 3;
    LAS unsigned char* KCs = lds; LAS unsigned char* QDs = lds + 17408; LAS unsigned char* QKs = lds + 34816; LAS unsigned char* KDTs = lds + 44032;
    LAS unsigned char* Ws = lds + 62464;
    LAS unsigned char* SS = lds + 79872 + wave * 4352; LAS unsigned char* US = lds + 114688 + wave * 2304;
    LAS float* PART = (LAS float*)(lds + 133120);
    const unsigned char* gW = A.ws + WS_DW;
    const unsigned char* gKC = A.ws + WS_DKC; const unsigned char* gQD = A.ws + WS_DQD; const unsigned char* gQK = A.ws + WS_DQK; const unsigned char* gKT = A.ws + WS_DKT;
    const float* DGL = (const float*)(A.ws + WS_DGL);
    f32x4 S[8];
#pragma unroll
    for (int mt = 0; mt < 8; ++mt) S[mt] = (f32x4){0.f, 0.f, 0.f, 0.f};
    u32x4 r[9];
    const float gl_all = DGL[bh * 32 + (lane_in & 31)];
    const float onorm = A.in[I_ONORM][l * 128 + 16 * wave + (lane_in & 15)];
#define DS_LOAD(itn, toff) do { const size_t _i = (size_t)(itn); const unsigned char* _kc = gKC + _i * 16384; const unsigned char* _qd = gQD + _i * 16384; \
        const unsigned char* _qk = gQK + _i * 8192; const unsigned char* _kt = gKT + _i * 16384; \
        r[0] = *(const u32x4*)(_kc + (toff)); r[1] = *(const u32x4*)(_kc + (toff) + 8192u); \
        r[2] = *(const u32x4*)(_qd + (toff)); r[3] = *(const u32x4*)(_qd + (toff) + 8192u); \
        r[4] = *(const u32x4*)(_qk + (toff)); \
        r[5] = *(const u32x4*)(_kt + (toff)); r[6] = *(const u32x4*)(_kt + (toff) + 8192u); \
        const unsigned char* _w = gW + _i * 16384; r[7] = *(const u32x4*)(_w + (toff)); r[8] = *(const u32x4*)(_w + (toff) + 8192u); } while (0)
    { const unsigned t0 = (unsigned)tid_in * 16u; DS_LOAD(bh * 32, t0); }
#pragma unroll 1
    for (int n = 0; n < 32; ++n) {
        int tid = tid_in; asm volatile("" : "+v"(tid));
        const int lane = tid & 63, fr = lane & 15, quad = lane >> 4, vcol = 16 * wave + fr;
        const unsigned toff = (unsigned)tid * 16u;
        const int it = bh * 32 + n, tokb = b * SEQ + n * 64;
        __syncthreads();
        { const int i0 = tid, i1 = tid + 512;
          *(LAS u32x4*)(KCs + (i0 >> 4) * 272 + (i0 & 15) * 16) = r[0]; *(LAS u32x4*)(KCs + (i1 >> 4) * 272 + (i1 & 15) * 16) = r[1];
          *(LAS u32x4*)(QDs + (i0 >> 4) * 272 + (i0 & 15) * 16) = r[2]; *(LAS u32x4*)(QDs + (i1 >> 4) * 272 + (i1 & 15) * 16) = r[3];
          *(LAS u32x4*)(QKs + (i0 >> 3) * 144 + (i0 & 7) * 16) = r[4];
          *(LAS u32x4*)(KDTs + (i0 >> 3) * 144 + (i0 & 7) * 16) = r[5]; *(LAS u32x4*)(KDTs + (i1 >> 3) * 144 + (i1 & 7) * 16) = r[6];
          *(LAS u32x4*)(Ws + (i0 >> 4) * 272 + (i0 & 15) * 16) = r[7]; *(LAS u32x4*)(Ws + (i1 >> 4) * 272 + (i1 & 15) * 16) = r[8]; }
        __syncthreads();
        const float glast = __builtin_bit_cast(float, __builtin_amdgcn_readlane(__builtin_bit_cast(int, gl_all), n));
        const bf16_t* gateb = (const bf16_t*)(A.ws + WS_PROJ) + (size_t)tokb * NPROJ + PC_G + h * 128;
        unsigned gtp[4][4];
#pragma unroll
        for (int mt = 0; mt < 4; ++mt)
#pragma unroll
            for (int i = 0; i < 4; ++i) gtp[mt][i] = gateb[(unsigned)((mt * 16 + quad * 4 + i) * NPROJ + vcol)];
#pragma unroll
        for (int mt = 0; mt < 8; ++mt) { u32x2 p; p.x = pk2(S[mt][0], S[mt][1]); p.y = pk2(S[mt][2], S[mt][3]); *(LAS u32x2*)(SS + fr * 272 + (mt * 16 + quad * 4) * 2) = p; }
        LDS_FENCE();
        bf16x8 Sb[4];
#pragma unroll
        for (int kk = 0; kk < 4; ++kk) Sb[kk] = *(LAS bf16x8*)(SS + fr * 272 + (kk * 32 + quad * 8) * 2);
        f32x4 U[4], O[4];
#pragma unroll
        for (int mt = 0; mt < 4; ++mt) { f32x4 au, ao = {0.f, 0.f, 0.f, 0.f};
#pragma unroll
            for (int i = 0; i < 4; ++i) au[i] = bf2f(*(LAS bf16_t*)(Ws + (mt * 16 + quad * 4 + i) * 272 + vcol * 2));
#pragma unroll
            for (int kk = 0; kk < 4; ++kk) { const bf16x8 a1 = *(LAS bf16x8*)(KCs + (mt * 16 + fr) * 272 + (kk * 32 + quad * 8) * 2); au = mfma16(a1, Sb[kk], au);
                const bf16x8 a2 = *(LAS bf16x8*)(QDs + (mt * 16 + fr) * 272 + (kk * 32 + quad * 8) * 2); ao = mfma16(a2, Sb[kk], ao); }
            U[mt] = au; O[mt] = ao; __builtin_amdgcn_sched_barrier(0); }
        if (n + 1 < 32) DS_LOAD(it + 1, toff);
#pragma unroll
        for (int mt = 0; mt < 4; ++mt) { u32x2 p; p.x = pk2(U[mt][0], U[mt][1]); p.y = pk2(U[mt][2], U[mt][3]); *(LAS u32x2*)(US + fr * 144 + (mt * 16 + quad * 4) * 2) = p; }
        LDS_FENCE();
        bf16x8 Ub[2];
#pragma unroll
        for (int kk = 0; kk < 2; ++kk) Ub[kk] = *(LAS bf16x8*)(US + fr * 144 + (kk * 32 + quad * 8) * 2);
#pragma unroll
        for (int mt = 0; mt < 4; ++mt)
#pragma unroll
            for (int kk = 0; kk < 2; ++kk) { const bf16x8 a = *(LAS bf16x8*)(QKs + (mt * 16 + fr) * 144 + (kk * 32 + quad * 8) * 2); O[mt] = mfma16(a, Ub[kk], O[mt]); }
        __builtin_amdgcn_sched_barrier(0);
#pragma unroll
        for (int mt = 0; mt < 8; ++mt) { S[mt] *= glast;
#pragma unroll
            for (int kk = 0; kk < 2; ++kk) { const bf16x8 a = *(LAS bf16x8*)(KDTs + (mt * 16 + fr) * 144 + (kk * 32 + quad * 8) * 2); S[mt] = mfma16(a, Ub[kk], S[mt]); }
            if (mt & 1) __builtin_amdgcn_sched_barrier(0); }
#pragma unroll
        for (int mt = 0; mt < 4; ++mt)
#pragma unroll
            for (int i = 0; i < 4; ++i) { float p = O[mt][i] * O[mt][i]; p += __shfl_xor(p, 1); p += __shfl_xor(p, 2); p += __shfl_xor(p, 4); p += __shfl_xor(p, 8);
                if (fr == 0) PART[wave * 64 + mt * 16 + quad * 4 + i] = p; }
        __syncthreads();
        bf16_t* mixb = (bf16_t*)(A.ws + WS_MIX) + (size_t)tokb * D + h * 128;
#pragma unroll
        for (int mt = 0; mt < 4; ++mt)
#pragma unroll
            for (int i = 0; i < 4; ++i) { const int t = mt * 16 + quad * 4 + i; float tot = 0.f;
#pragma unroll
                for (int w = 0; w < 8; ++w) tot += PART[w * 64 + t];
                const float sc = rsqrtf(tot * (1.f / 128.f) + EPS) * onorm;
                const float gtv = bf2f(gtp[mt][i]);
                mixb[(unsigned)(t * D + vcol)] = (bf16_t)f2bf(O[mt][i] * sc * silu_f(gtv)); }
    }
#undef DS_LOAD
    { const int lane = lane_in, fr = lane & 15, quad = lane >> 4, vcol = 16 * wave + fr;
      float* dp = A.out + O_DP + (size_t)((l * 8 + b) * 4 + h) * 16384;
#pragma unroll
      for (int mt = 0; mt < 8; ++mt)
#pragma unroll
          for (int i = 0; i < 4; ++i) dp[(mt * 16 + quad * 4 + i) * 128 + vcol] = S[mt][i]; }
    __syncthreads();
}

__device__ __forceinline__ void delta_sample_item(const DevArgs& A, int l, LAS unsigned char* lds, int item, int tid, int wave, int lane) {
    const int b = item >> 2, h = item & 3, tokS = NP + b * 4;
    LAS float* RAW = (LAS float*)lds; LAS float* RED = RAW + 1536; LAS float* OB = RED + 512; LAS float* SC = OB + 512;
    const bf16_t* PROJ = (const bf16_t*)(A.ws + WS_PROJ); const float* AB = (const float*)(A.ws + WS_AB); bf16_t* MIX = (bf16_t*)(A.ws + WS_MIX);
    const float* cw = A.in[I_CONVW] + (size_t)l * 4 * 1536;
    for (int idx = tid; idx < 1536; idx += 512) { const int part = idx >> 9, t = (idx >> 7) & 3, c = idx & 127, col = part * 512 + h * 128 + c;
        float acc = 0.f;
#pragma unroll
        for (int j = 0; j < 4; ++j) { const int tt = t - 3 + j;
            const float x = (tt >= 0) ? bf2f(PROJ[(size_t)(tokS + tt) * NPROJ + col]) : A.in[I_SCONV][((size_t)(l * 128 + b) * 3 + (3 + tt)) * 1536 + col];
            acc += cw[j * 1536 + col] * x; }
        RAW[idx] = silu_f(acc); }
    if (tid < 4) { const float a = AB[(size_t)(tokS + tid) * 8 + h], bb = AB[(size_t)(tokS + tid) * 8 + 4 + h];
        const float xx = a + A.in[I_DTB][l * 4 + h]; const float sp = xx > 20.f ? xx : log1pf(expf(xx));
        SC[8 + tid] = 1.f / (1.f + expf(-bb)); SC[12 + tid] = expf(-expf(A.in[I_ALOG][l * 4 + h]) * sp); }
    const int v = tid & 127, kq = tid >> 7;
    float S[32];
    { const float* sp = A.in[I_SDELTA] + (size_t)((l * 128 + b) * 4 + h) * 16384;
#pragma unroll
      for (int i = 0; i < 32; ++i) S[i] = sp[(kq * 32 + i) * 128 + v]; }
    __syncthreads();
    { const int part = wave >> 2, t = wave & 3; const float x0 = RAW[part * 512 + t * 128 + lane], x1 = RAW[part * 512 + t * 128 + 64 + lane];
      const float ss = wave_sum(x0 * x0 + x1 * x1); if (lane == 0) SC[part * 4 + t] = rsqrtf(ss + EPS) * (part == 0 ? 0.08838834764831845f : 1.f); }
    __syncthreads();
    for (int t = 0; t < 4; ++t) {
        const float rq = SC[t], rk = SC[4 + t], beta = SC[8 + t], g = SC[12 + t];
        float pr = 0.f;
#pragma unroll
        for (int i = 0; i < 32; ++i) pr += S[i] * RAW[512 + t * 128 + kq * 32 + i];
        RED[kq * 128 + v] = pr * rk;
        __syncthreads();
        const float rr = (RED[v] + RED[128 + v]) + (RED[256 + v] + RED[384 + v]);
        const float u = beta * (RAW[1024 + t * 128 + v] - g * rr);
        float po = 0.f;
#pragma unroll
        for (int i = 0; i < 32; ++i) { const float kh = RAW[512 + t * 128 + kq * 32 + i] * rk; S[i] = g * S[i] + kh * u; po += S[i] * RAW[t * 128 + kq * 32 + i]; }
        __syncthreads();
        RED[kq * 128 + v] = po * rq;
        __syncthreads();
        if (kq == 0) OB[t * 128 + v] = (RED[v] + RED[128 + v]) + (RED[256 + v] + RED[384 + v]);
        __syncthreads();
    }
    if (wave < 4) { const int t = wave; const float x0 = OB[t * 128 + lane], x1 = OB[t * 128 + 64 + lane];
        const float ss = wave_sum(x0 * x0 + x1 * x1); const float sc = rsqrtf(ss * (1.f / 128.f) + EPS);
        const float g0 = bf2f(PROJ[(size_t)(tokS + t) * NPROJ + PC_G + h * 128 + lane]), g1 = bf2f(PROJ[(size_t)(tokS + t) * NPROJ + PC_G + h * 128 + 64 + lane]);
        MIX[(size_t)(tokS + t) * D + h * 128 + lane] = (bf16_t)f2bf(x0 * sc * A.in[I_ONORM][l * 128 + lane] * silu_f(g0));
        MIX[(size_t)(tokS + t) * D + h * 128 + 64 + lane] = (bf16_t)f2bf(x1 * sc * A.in[I_ONORM][l * 128 + 64 + lane] * silu_f(g1)); }
    { float* dsp = A.out + O_DS + (size_t)((l * 128 + b) * 4 + h) * 16384;
#pragma unroll
      for (int i = 0; i < 32; ++i) dsp[(kq * 32 + i) * 128 + v] = S[i]; }
    __syncthreads();
}

#define SSM_BCAST_U(t) do { unsigned _w[8]; \
        _w[0] = __builtin_amdgcn_readlane(ua.x, t); _w[1] = __builtin_amdgcn_readlane(ua.y, t); _w[2] = __builtin_amdgcn_readlane(ua.z, t); _w[3] = __builtin_amdgcn_readlane(ua.w, t); \
        _w[4] = __builtin_amdgcn_readlane(ub.x, t); _w[5] = __builtin_amdgcn_readlane(ub.y, t); _w[6] = __builtin_amdgcn_readlane(ub.z, t); _w[7] = __builtin_amdgcn_readlane(ub.w, t); \
        _Pragma("unroll") for (int _d = 0; _d < 8; ++_d) { uu[2 * _d] = __uint_as_float(_w[_d] << 16); uu[2 * _d + 1] = __uint_as_float(_w[_d] & 0xffff0000u); } } while (0)
#define SSM_STEP() do { float _br = 0.f, _bi = 0.f; \
        _Pragma("unroll") for (int _h = 0; _h < 16; ++_h) { _br = fmaf(Br[_h], uu[_h], _br); _bi = fmaf(Bi[_h], uu[_h], _bi); } \
        const float _nr = lr * hr - li * hi + _br, _ni = lr * hi + li * hr + _bi; hr = _nr; hi = _ni; } while (0)

__device__ __forceinline__ void ssm_part1_item(const DevArgs& A, int l, int it, int lane) {
    const int g = it & 15, bc = it >> 4, b = bc / 31, c = bc % 31;
    const float* bb = (const float*)(A.ws + WS_BBAR) + ((size_t)(l * 16 + g) * 64 + lane) * 32;
    float Br[16], Bi[16];
#pragma unroll
    for (int q = 0; q < 4; ++q) { const f32x4 x = ((const f32x4*)bb)[q], y = ((const f32x4*)bb)[4 + q];
        Br[4 * q] = x.x; Br[4 * q + 1] = x.y; Br[4 * q + 2] = x.z; Br[4 * q + 3] = x.w; Bi[4 * q] = y.x; Bi[4 * q + 1] = y.y; Bi[4 * q + 2] = y.z; Bi[4 * q + 3] = y.w; }
    const f32x4 lk = ((const f32x4*)(A.ws + WS_SSMK))[(l * 16 + g) * 64 + lane]; const float lr = lk.x, li = lk.y;
    const bf16_t* up = (const bf16_t*)(A.ws + WS_PROJ) + (size_t)(b * SEQ + c * 64 + lane) * NPROJ + PC_SSM + g * 16;
    const u32x4 ua = *(const u32x4*)up, ub = *(const u32x4*)(up + 8);
    float hr = 0.f, hi = 0.f, uu[16];
#pragma unroll 1
    for (int t = 0; t < 64; ++t) { SSM_BCAST_U(t); SSM_STEP(); }
    f32x2 e; e.x = hr; e.y = hi;
    ((f32x2*)(A.ws + WS_SSME))[((size_t)(b * 32 + c) * 16 + g) * 64 + lane] = e;
}

__device__ __forceinline__ void ssm_part2_item(const DevArgs& A, int l, LAS unsigned char* lds, int it, int tid, int wave, int lane) {
    const int tok0 = it * 64, fr = lane & 15, quad = lane >> 4;
    const bool samp = it >= 256; const int b = it >> 5, c = it & 31;
    LAS unsigned char* YS = lds; LAS unsigned char* HS = lds + 33792 + wave * 4352;
    const bf16_t* PROJ = (const bf16_t*)(A.ws + WS_PROJ); bf16_t* MIX = (bf16_t*)(A.ws + WS_MIX);
#pragma unroll 1
    for (int gi = 0; gi < 2; ++gi) {
        const int g = wave * 2 + gi;
        const float* bb = (const float*)(A.ws + WS_BBAR) + ((size_t)(l * 16 + g) * 64 + lane) * 32;
        float Br[16], Bi[16];
#pragma unroll
        for (int q = 0; q < 4; ++q) { const f32x4 x = ((const f32x4*)bb)[q], y = ((const f32x4*)bb)[4 + q];
            Br[4 * q] = x.x; Br[4 * q + 1] = x.y; Br[4 * q + 2] = x.z; Br[4 * q + 3] = x.w; Bi[4 * q] = y.x; Bi[4 * q + 1] = y.y; Bi[4 * q + 2] = y.z; Bi[4 * q + 3] = y.w; }
        const f32x4 lk = ((const f32x4*)(A.ws + WS_SSMK))[(l * 16 + g) * 64 + lane]; const float lr = lk.x, li = lk.y, Lr = lk.z, Li = lk.w;
        bf16x8 Cb[4];
#pragma unroll
        for (int kk = 0; kk < 4; ++kk) { const size_t co = ((size_t)(l * 16 + g) * 16 + fr) * 64 + kk * 16 + quad * 4;
            const f32x4 cr = *(const f32x4*)(A.in[I_CRE] + co), ci = *(const f32x4*)(A.in[I_CIM] + co);
            u32x4 pk; pk.x = pk2(cr.x, -ci.x); pk.y = pk2(cr.y, -ci.y); pk.z = pk2(cr.z, -ci.z); pk.w = pk2(cr.w, -ci.w);
            Cb[kk] = __builtin_bit_cast(bf16x8, pk); }
        const bf16_t* up = PROJ + (size_t)(tok0 + lane) * NPROJ + PC_SSM + g * 16;
        const u32x4 ua = *(const u32x4*)up, ub = *(const u32x4*)(up + 8);
        float hr = 0.f, hi = 0.f, uu[16];
        if (!samp && c > 0) { const f32x2* E = (const f32x2*)(A.ws + WS_SSME) + ((size_t)(b * 32) * 16 + g) * 64 + lane;
#pragma unroll
            for (int cb = 0; cb < 32; cb += 16) { f32x2 ev[16];
#pragma unroll
                for (int q = 0; q < 16; ++q) { const int cc = cb + q; ev[q] = (cc < c) ? E[(size_t)cc * 1024] : (f32x2){0.f, 0.f}; }
#pragma unroll
                for (int q = 0; q < 16; ++q) { const int cc = cb + q; if (cc < c) { const float nr = Lr * hr - Li * hi + ev[q].x, ni = Lr * hi + Li * hr + ev[q].y; hr = nr; hi = ni; } } } }
        const float dsk = A.in[I_SSMD][l * 256 + g * 16 + fr];
#pragma unroll 1
        for (int sub = 0; sub < 4; ++sub) {
#pragma unroll 1
            for (int tt = 0; tt < 16; ++tt) { const int t = sub * 16 + tt;
                const int sb = (it - 256) * 16 + (t >> 2);
                if (samp && (t & 3) == 0) { hr = A.in[I_SRE][((size_t)(l * 128 + sb) * 16 + g) * 64 + lane]; hi = A.in[I_SIM][((size_t)(l * 128 + sb) * 16 + g) * 64 + lane]; }
                SSM_BCAST_U(t); SSM_STEP();
                *(LAS unsigned*)(HS + tt * 272 + lane * 4) = pg8::cvt_pk_bf16(hr, hi);
                if (samp && (t & 3) == 3) { A.out[O_RES + ((size_t)(l * 128 + sb) * 16 + g) * 64 + lane] = hr; A.out[O_IMS + ((size_t)(l * 128 + sb) * 16 + g) * 64 + lane] = hi; }
            }
            LDS_FENCE();
            f32x4 acc = {0.f, 0.f, 0.f, 0.f};
#pragma unroll
            for (int kk = 0; kk < 4; ++kk) { const bf16x8 a = *(LAS bf16x8*)(HS + fr * 272 + (kk * 32 + quad * 8) * 2); acc = mfma16(a, Cb[kk], acc); }
#pragma unroll
            for (int i = 0; i < 4; ++i) { const int t = sub * 16 + quad * 4 + i; const float uv = bf2f(PROJ[(size_t)(tok0 + t) * NPROJ + PC_SSM + g * 16 + fr]);
                *(LAS bf16_t*)(YS + t * 528 + (g * 16 + fr) * 2) = (bf16_t)f2bf(gelu_tanh_f(acc[i] + dsk * uv)); }
            LDS_FENCE();
        }
        if (!samp && c == 31) { A.out[O_REP + ((size_t)(l * 8 + b) * 16 + g) * 64 + lane] = hr; A.out[O_IMP + ((size_t)(l * 8 + b) * 16 + g) * 64 + lane] = hi; }
    }
    __syncthreads();
    {
        const bf16_t* GT = (const bf16_t*)(A.ws + WS_GLUT + l * SZ_GLUT);
        f32x4 acc[4][2];
#pragma unroll
        for (int mt = 0; mt < 4; ++mt) { acc[mt][0] = (f32x4){0.f, 0.f, 0.f, 0.f}; acc[mt][1] = (f32x4){0.f, 0.f, 0.f, 0.f}; }
#pragma unroll
        for (int kk = 0; kk < 8; ++kk) { bf16x8 bfr[2];
#pragma unroll
            for (int nt = 0; nt < 2; ++nt) bfr[nt] = *(const bf16x8*)(GT + (size_t)(32 * wave + nt * 16 + fr) * 256 + kk * 32 + quad * 8);
#pragma unroll
            for (int mt = 0; mt < 4; ++mt) { const bf16x8 a = *(LAS bf16x8*)(YS + (mt * 16 + fr) * 528 + (kk * 32 + quad * 8) * 2);
                acc[mt][0] = mfma16(a, bfr[0], acc[mt][0]); acc[mt][1] = mfma16(a, bfr[1], acc[mt][1]); } }
#pragma unroll
        for (int nt = 0; nt < 2; ++nt) { const int ncol = 32 * wave + nt * 16 + fr; const float gb = A.in[I_GLUB][l * 256 + ncol];
#pragma unroll
            for (int mt = 0; mt < 4; ++mt)
#pragma unroll
                for (int i = 0; i < 4; ++i) { const int t = mt * 16 + quad * 4 + i; const float y = bf2f(*(LAS bf16_t*)(YS + t * 528 + ncol * 2));
                    MIX[(size_t)(tok0 + t) * D + 512 + ncol] = (bf16_t)f2bf(y * sigmoid_f(acc[mt][nt][i] + gb)); } }
    }
    __syncthreads();
}

__device__ __forceinline__ void pool_item(const DevArgs& A, int l, LAS unsigned char* lds, int it, int tid, int wave, int lane) {
    const int tok0 = it * 64, fr = lane & 15, quad = lane >> 4; const bool samp = it >= 256;
    LAS unsigned char* RS = lds;
    const bf16_t* PROJ = (const bf16_t*)(A.ws + WS_PROJ); bf16_t* MIX = (bf16_t*)(A.ws + WS_MIX);
    if (!samp) {
        LAS unsigned char* XT = lds + 33792;
        const int b = it >> 5, c = it & 31;
        for (int id = tid; id < 79 * 32; id += 512) { const int r = id >> 5, c16 = id & 31, tl = c * 64 - 15 + r;
            u32x4 v = {0u, 0u, 0u, 0u}; if (tl >= 0) v = *(const u32x4*)(PROJ + (size_t)(b * SEQ + tl) * NPROJ + PC_POOL + c16 * 8);
            *(LAS u32x4*)(XT + r * 528 + c16 * 16) = v; }
        __syncthreads();
        const int ch = tid & 255, half = tid >> 8, g = ch >> 6, w = 2 << g, r0 = half * 32;
        float sum = 0.f;
        for (int j = 0; j < w; ++j) sum += bf2f(*(LAS bf16_t*)(XT + (r0 + 15 - j) * 528 + ch * 2));
#pragma unroll 4
        for (int rr = 0; rr < 32; ++rr) { const int r = r0 + rr, tl = c * 64 + r;
            const float u = bf2f(*(LAS bf16_t*)(XT + (r + 15) * 528 + ch * 2));
            if (rr > 0) sum += u - bf2f(*(LAS bf16_t*)(XT + (r + 15 - w) * 528 + ch * 2));
            const float cnt = (float)((tl + 1 < w) ? tl + 1 : w);
            *(LAS bf16_t*)(RS + r * 528 + ch * 2) = (bf16_t)f2bf(sum / cnt - u); }
    } else {
#pragma unroll 1
        for (int pr = 0; pr < 8; ++pr) { const int idx = pr * 512 + tid, ch = idx & 255, sq = idx >> 8, g = ch >> 6, w = 2 << g;
            const int sb = (it - 256) * 16 + sq;
            const float* sbuf = A.in[I_SPOOL] + (size_t)(l * 128 + sb) * 15 * 256 + ch;
            const bf16_t* base = PROJ + (size_t)(NP + sb * 4) * NPROJ + PC_POOL + ch;
            float e[19];
#pragma unroll
            for (int j = 0; j < 15; ++j) e[j] = sbuf[j * 256];
#pragma unroll
            for (int j = 0; j < 4; ++j) e[15 + j] = bf2f(base[(size_t)j * NPROJ]);
#pragma unroll
            for (int t = 0; t < 4; ++t) { float sum = 0.f;
#pragma unroll
                for (int j = 0; j < 16; ++j) sum += (j < w) ? e[15 + t - j] : 0.f;
                *(LAS bf16_t*)(RS + (sq * 4 + t) * 528 + ch * 2) = (bf16_t)f2bf(sum / (float)w - e[15 + t]); } }
    }
    __syncthreads();
    { const int g2 = wave >> 1; const bf16_t* PT = (const bf16_t*)(A.ws + WS_POOLT + l * SZ_POOLT) + g2 * 4096;
      f32x4 acc[4][2];
#pragma unroll
      for (int mt = 0; mt < 4; ++mt) { acc[mt][0] = (f32x4){0.f, 0.f, 0.f, 0.f}; acc[mt][1] = (f32x4){0.f, 0.f, 0.f, 0.f}; }
#pragma unroll
      for (int kk = 0; kk < 2; ++kk) { bf16x8 bfr[2];
#pragma unroll
          for (int nt = 0; nt < 2; ++nt) bfr[nt] = *(const bf16x8*)(PT + (size_t)((wave & 1) * 32 + nt * 16 + fr) * 64 + kk * 32 + quad * 8);
#pragma unroll
          for (int mt = 0; mt < 4; ++mt) { const bf16x8 a = *(LAS bf16x8*)(RS + (mt * 16 + fr) * 528 + (g2 * 64 + kk * 32 + quad * 8) * 2);
              acc[mt][0] = mfma16(a, bfr[0], acc[mt][0]); acc[mt][1] = mfma16(a, bfr[1], acc[mt][1]); } }
#pragma unroll
      for (int nt = 0; nt < 2; ++nt) { const int col = 32 * wave + nt * 16 + fr; const float ps = A.in[I_POOLS][l * 256 + col];
#pragma unroll
          for (int mt = 0; mt < 4; ++mt)
#pragma unroll
              for (int i = 0; i < 4; ++i) { const int t = mt * 16 + quad * 4 + i; MIX[(size_t)(tok0 + t) * D + 768 + col] = (bf16_t)f2bf(acc[mt][nt][i] * ps); } } }
    __syncthreads();
}

__device__ __forceinline__ void state_copies(const DevArgs& A, int l, int gt, int NT) {
    const bf16_t* PROJ = (const bf16_t*)(A.ws + WS_PROJ);
    for (int i = gt; i < 8 * 3 * 1536; i += NT) { const int col = i % 1536, j = (i / 1536) % 3, b = i / 4608;
        A.out[O_CP + (size_t)l * 8 * 4608 + i] = bf2f(PROJ[(size_t)(b * SEQ + SEQ - 3 + j) * NPROJ + col]); }
    for (int i = gt; i < 128 * 3 * 1536; i += NT) { const int col = i % 1536, j = (i / 1536) % 3, b = i / 4608;
        A.out[O_CS + (size_t)l * 128 * 4608 + i] = bf2f(PROJ[(size_t)(NP + b * 4 + 1 + j) * NPROJ + col]); }
    for (int i = gt; i < 8 * 15 * 256; i += NT) { const int ch = i & 255, j = (i >> 8) % 15, b = i / 3840;
        A.out[O_PP + (size_t)l * 8 * 3840 + i] = bf2f(PROJ[(size_t)(b * SEQ + SEQ - 15 + j) * NPROJ + PC_POOL + ch]); }
    for (int i = gt; i < 128 * 15 * 256; i += NT) { const int ch = i & 255, j = (i >> 8) % 15, b = i / 3840;
        A.out[O_PS + (size_t)l * 128 * 3840 + i] = (j < 11) ? A.in[I_SPOOL][((size_t)(l * 128 + b) * 15 + 4 + j) * 256 + ch]
                                                             : bf2f(PROJ[(size_t)(NP + b * 4 + (j - 11)) * NPROJ + PC_POOL + ch]); }
}

#define XB_TMO      128
#define XB_XCNT(j)  (256  + 64 * (j))
#define XB_XSUB(j)  (1280 + 64 * (j))
#define XB_XGEN(j)  (2304 + 64 * (j))
#define XB_TOP      3328
#define XB_TOPGEN   3392
#define XCD_BAR_WORDS 3456
#define XB_SPIN_CAP (1u << 18)

__device__ __forceinline__ unsigned xb_ld(unsigned* p)              { return __hip_atomic_load(p, __ATOMIC_RELAXED, __HIP_MEMORY_SCOPE_AGENT); }
__device__ __forceinline__ unsigned xb_add(unsigned* p, unsigned v) { return __hip_atomic_fetch_add(p, v, __ATOMIC_RELAXED, __HIP_MEMORY_SCOPE_AGENT); }
__device__ __forceinline__ unsigned xb_xcc_id() { return (unsigned)__builtin_amdgcn_s_getreg((3 << 11) | 20) & 0xFu; }
#define XB_SPIN(cond, bar) do { unsigned _sp = 0; while (cond) { __builtin_amdgcn_s_sleep(1); \
    if ((++_sp & 255u) == 0u) { if (xb_ld(&(bar)[XB_TMO])) break; if (_sp > XB_SPIN_CAP) { atomicAdd(&(bar)[XB_TMO], 1u); break; } } } } while (0)

struct XcdBarrier {
    unsigned* bar; unsigned x;
    volatile LAS unsigned* st;
};

__device__ __forceinline__ XcdBarrier xcd_barrier_post(unsigned* bar, volatile LAS unsigned* st) {
    XcdBarrier b; b.bar = bar; b.x = xb_xcc_id(); b.st = st;
    if (threadIdx.x == 0) (void)xb_add(&bar[XB_XCNT(b.x)], 1u);
    return b;
}
__device__ __forceinline__ void xcd_barrier_complete(unsigned* bar, unsigned x, unsigned& nloc, unsigned& nx) {
    const unsigned G = gridDim.x * gridDim.y * gridDim.z;
    unsigned sum, cnt, mine, sp = 0u;
    for (;;) {
        sum = 0u; cnt = 0u; mine = 0u;
#pragma unroll
        for (unsigned j = 0; j < 16; ++j) { const unsigned c = xb_ld(&bar[XB_XCNT(j)]); sum += c; cnt += (c > 0u) ? 1u : 0u; mine = (j == x) ? c : mine; }
        if (sum == G) break;
        __builtin_amdgcn_s_sleep(1);
        if ((++sp & 255u) == 0u) { if (xb_ld(&bar[XB_TMO])) break; if (sp > XB_SPIN_CAP) { atomicAdd(&bar[XB_TMO], 1u); break; } }
    }
    nloc = mine > 0u ? mine : 1u; nx = cnt > 0u ? cnt : 1u;
}

__device__ __forceinline__ void xcd_barrier(const XcdBarrier& b) {
    asm volatile("s_waitcnt vmcnt(0)" ::: "memory");
    __syncthreads();
    if (threadIdx.x == 0) {
        unsigned* bar = b.bar;
        __builtin_amdgcn_s_waitcnt(0);
        unsigned nloc = b.st[0], nx = b.st[1];
        if (nloc == 0u) { xcd_barrier_complete(bar, b.x, nloc, nx); b.st[0] = nloc; b.st[1] = nx; }
        const unsigned old = xb_add(&bar[XB_XSUB(b.x)], 1u);
        const unsigned gen = old / nloc;
        if (old + 1u == (gen + 1u) * nloc) {
            __builtin_amdgcn_fence(__ATOMIC_RELEASE, "agent");
            asm volatile("s_waitcnt vmcnt(0)" ::: "memory");
            const unsigned og = xb_add(&bar[XB_TOP], 1u);
            const unsigned tg = og / nx;
            if (og + 1u == (tg + 1u) * nx) xb_add(&bar[XB_TOPGEN], 1u);
            else XB_SPIN(xb_ld(&bar[XB_TOPGEN]) == tg, bar);
            __builtin_amdgcn_fence(__ATOMIC_ACQUIRE, "agent");
            xb_add(&bar[XB_XGEN(b.x)], 1u);
            asm volatile("s_waitcnt vmcnt(0)" ::: "memory");
        } else {
            XB_SPIN(xb_ld(&bar[XB_XGEN(b.x)]) == gen, bar);
            __builtin_amdgcn_fence(__ATOMIC_ACQUIRE, "agent");
            asm volatile("s_waitcnt vmcnt(0)" ::: "memory");
        }
    }
    __syncthreads();
}

#ifndef REP_DPREP
#define REP_DPREP 1
#endif
#ifndef REP_DSAMP
#define REP_DSAMP 1
#endif
#ifndef REP_SSM1
#define REP_SSM1 1
#endif
#ifndef REP_POOL
#define REP_POOL 1
#endif
#ifndef REP_DSCAN
#define REP_DSCAN 1
#endif
#ifndef REP_SSM2
#define REP_SSM2 1
#endif
#ifndef REP_G
#define REP_G 1
#endif
constexpr int NPH = 2 + DEPTH * 8;
__global__ void __launch_bounds__(512, 2) mega_fwd(Args KA) {
    DevArgs A; A.out = KA.out; A.ws = KA.ws; A.ph_lo = KA.ph_lo; A.ph_hi = KA.ph_hi;
    extern __shared__ __attribute__((aligned(16))) unsigned char lds_raw[];
    LAS unsigned char* lds = (LAS unsigned char*)lds_raw;
    cg::grid_group grid = cg::this_grid();
    volatile LAS unsigned* xst = (volatile LAS unsigned*)(lds + LDS_BYTES - 64);
    if (threadIdx.x == 0) { xst[0] = 0u; xst[1] = 0u; }
    __syncthreads();
    const XcdBarrier xb = xcd_barrier_post((unsigned*)(KA.ws + WS_BAR), xst);
    const int G = gridDim.x, NGW = G * 8, NT = G * 512;
    int ph = 0;
#define PH_BEGIN if (A.ph_lo <= ph && ph < A.ph_hi) { int tid = threadIdx.x; asm volatile("" : "+v"(tid)); const int wave = __builtin_amdgcn_readfirstlane(tid >> 6), lane = tid & 63, gw = blockIdx.x * 8 + wave, gt = blockIdx.x * 512 + tid; (void)gw; (void)gt; (void)lane;
#define PH_END   if (ph + 1 < A.ph_hi) { if (ph == 0) grid.sync(); else xcd_barrier(xb); } } ++ph;
    bf16_t* Hb = (bf16_t*)(A.ws + WS_H); float* AB = (float*)(A.ws + WS_AB); float* MIXO = (float*)(A.ws + WS_MIXO);
    bf16_t* PROJ = (bf16_t*)(A.ws + WS_PROJ); bf16_t* MIX = (bf16_t*)(A.ws + WS_MIX); bf16_t* HID = (bf16_t*)(A.ws + WS_HID);

    PH_BEGIN prologue(A, lds, wave, lane, gw, NGW); __syncthreads(); PH_END
    PH_BEGIN norm_rows(nullptr, nullptr, A.in[I_XP], A.in[I_XS], nullptr, A.in[I_NMPRE], Hb, (const float*)(A.ws + WS_WAB), AB, gw, NGW, lane); PH_END

#pragma unroll 1
    for (int l = 0; l < DEPTH; ++l) {
        PH_BEGIN for (int rep = 0; rep < REP_G; ++rep) { pg8::Gemm g{Hb, (const bf16_t*)(A.ws + WS_WIN + l * SZ_WIN), NTOK, NPROJ, D}; pg8::StaticOrder S; S.init(NTOK, NPROJ, G, (int)blockIdx.x);
            pg8::EpiBf16<0> E{PROJ, NPROJ, nullptr, 0, 0}; pg8::gemm_phase<pg8::EpiBf16<0>, pg8::StaticOrder>(lds, g, S, E, nullptr); } PH_END
        PH_BEGIN {
            for (int rep = 0; rep < REP_DPREP; ++rep) for (int it = blockIdx.x; it < 1024; it += G) delta_prep_item(A, l, lds, it, tid, wave, lane);
            for (int rep = 0; rep < REP_DSAMP; ++rep) for (int it = blockIdx.x; it < 512; it += G) delta_sample_item(A, l, lds, it, tid, wave, lane);
            for (int rep = 0; rep < REP_SSM1; ++rep) for (int it = gw; it < 8 * 31 * 16; it += NGW) ssm_part1_item(A, l, it, lane);
            for (int rep = 0; rep < REP_POOL; ++rep) for (int it = blockIdx.x; it < 264; it += G) pool_item(A, l, lds, it, tid, wave, lane);
            state_copies(A, l, gt, NT);
        } PH_END
        PH_BEGIN {
            const int nd = (G > 64) ? 32 : 0;
            if (nd == 0 || (int)blockIdx.x < nd) for (int rep = 0; rep < REP_DSCAN; ++rep) for (int it = blockIdx.x; it < 32; it += G) delta_scan_item(A, l, lds, it, tid, wave, lane);
            if (nd == 0 || (int)blockIdx.x >= nd) for (int rep = 0; rep < REP_SSM2; ++rep) for (int it = blockIdx.x - nd; it < 264; it += G - nd) ssm_part2_item(A, l, lds, it, tid, wave, lane);
        } PH_END
        PH_BEGIN for (int rep = 0; rep < REP_G; ++rep) { pg8::Gemm g{MIX, (const bf16_t*)(A.ws + WS_WOUT + l * SZ_WOUT), NTOK, D, D}; pg8::StaticOrder S; S.init(NTOK, D, G, (int)blockIdx.x);
            pg8::EpiF32 E{MIXO, D, nullptr}; pg8::gemm_phase<pg8::EpiF32, pg8::StaticOrder>(lds, g, S, E, nullptr); } PH_END
        PH_BEGIN norm_rows(MIXO, A.in[I_NMPOST] + l * D, l == 0 ? A.in[I_XP] : A.out, l == 0 ? A.in[I_XS] : nullptr, A.out, A.in[I_NFPRE] + l * D, Hb, nullptr, nullptr, gw, NGW, lane); PH_END
        PH_BEGIN for (int rep = 0; rep < REP_G; ++rep) { pg8::Gemm g{Hb, (const bf16_t*)(A.ws + WS_WGU + l * SZ_WGU), NTOK, NGU, D}; pg8::StaticOrder S; S.init(NTOK, NGU, G, (int)blockIdx.x);
            EpiSwiGLU E{HID, DFF}; pg8::gemm_phase<EpiSwiGLU, pg8::StaticOrder>(lds, g, S, E, nullptr); } PH_END
        PH_BEGIN for (int rep = 0; rep < REP_G; ++rep) { pg8::Gemm g{HID, (const bf16_t*)(A.ws + WS_WDN + l * SZ_WDN), NTOK, D, DFF}; pg8::StaticOrder S; S.init(NTOK, D, G, (int)blockIdx.x);
            pg8::EpiF32 E{MIXO, D, nullptr}; pg8::gemm_phase<pg8::EpiF32, pg8::StaticOrder>(lds, g, S, E, nullptr); } PH_END
        PH_BEGIN norm_rows(MIXO, A.in[I_NFPOST] + l * D, A.out, nullptr, A.out, l + 1 < DEPTH ? A.in[I_NMPRE] + (l + 1) * D : nullptr, l + 1 < DEPTH ? Hb : nullptr,
                           l + 1 < DEPTH ? (const float*)(A.ws + WS_WAB + (l + 1) * SZ_WAB) : nullptr, AB, gw, NGW, lane); PH_END
    }
#undef PH_BEGIN
#undef PH_END
}

extern "C" void kernel_launch(void* const* d_in, const int* in_sizes, int n_in, void* d_out, int out_size, void* d_ws, size_t ws_size, hipStream_t stream) {
    static int grid = 0;
    if (grid == 0) {
        if (n_in != 32 || (size_t)out_size != O_END || ws_size < WS_END) fprintf(stderr, "kernel_launch: unexpected sizes: n_in %d out %d (want %zu) ws %zu (want >= %zu)\n", n_in, out_size, (size_t)O_END, ws_size, (size_t)WS_END);
        int dev = 0, cus = 0, per_cu = 0;
        (void)hipGetDevice(&dev); (void)hipDeviceGetAttribute(&cus, hipDeviceAttributeMultiprocessorCount, dev);
        if (hipFuncSetAttribute((const void*)mega_fwd, hipFuncAttributeMaxDynamicSharedMemorySize, LDS_BYTES) != hipSuccess) fprintf(stderr, "kernel_launch: hipFuncSetAttribute failed\n");
        if (hipOccupancyMaxActiveBlocksPerMultiprocessor(&per_cu, (const void*)mega_fwd, 512, LDS_BYTES) != hipSuccess || per_cu < 1) { fprintf(stderr, "kernel_launch: occupancy query gave %d\n", per_cu); per_cu = 1; (void)hipGetLastError(); }
        grid = cus * per_cu; if (grid <= 0) grid = 256;
        fprintf(stderr, "kernel_launch: grid %d (cus %d x %d)\n", grid, cus, per_cu);
    }
    (void)hipMemsetAsync((unsigned char*)d_ws + WS_BAR, 0, 16384, stream);
    Args a{};
    for (int i = 0; i < 32; ++i) a.in[i] = (const float*)d_in[i];
    a.out = (float*)d_out; a.ws = (unsigned char*)d_ws;
#if MK_COOP
    a.ph_lo = 0; a.ph_hi = NPH;
    void* args[] = {&a};
    const hipError_t e = hipLaunchCooperativeKernel((const void*)mega_fwd, dim3(grid), dim3(512), args, LDS_BYTES, stream);
    if (e != hipSuccess) fprintf(stderr, "kernel_launch: cooperative launch failed: %s (grid %d)\n", hipGetErrorString(e), grid);
#else
    for (int p = 0; p < NPH; ++p) { a.ph_lo = p; a.ph_hi = p + 1; hipLaunchKernelGGL(mega_fwd, dim3(grid), dim3(512), LDS_BYTES, stream, a); }
#endif
}
```

```cpp
#include <hip/hip_runtime.h>
#include <hip/hip_cooperative_groups.h>
#include <cstdio>
#include <cstdint>
namespace cg = cooperative_groups;
#ifndef MK_COOP
#define MK_COOP 1
#endif
namespace pg8 {
#define PG8_LAS __attribute__((address_space(3)))
typedef unsigned short bf16_t;
typedef short bf16x8 __attribute__((ext_vector_type(8)));
typedef float f32x4 __attribute__((ext_vector_type(4)));
typedef unsigned u32x4 __attribute__((ext_vector_type(4)));
constexpr int BM = 256, BK = 64, HALF = 128, HTB = HALF * BK * 2  , STAGE_BYTES = 8 * HTB, NXCD = 8, WGM = 8;

__host__ __device__ __forceinline__ int lds_byte(int r, int c) { const int st = (r >> 4) * 2 + (c >> 5), rr = r & 15, cc = c & 31, ob = rr * 64 + cc * 2; return st * 1024 + (ob ^ (((ob >> 9) & 1) << 5)); }
__host__ __device__ __forceinline__ void stage_rc(int b, int& R, int& C) { const int st = b / 1024, sb = b % 1024, swz = sb ^ (((sb >> 9) & 1) << 5); R = (st >> 1) * 16 + swz / 64; C = (st & 1) * 32 + (swz % 64) / 2; }
__host__ __device__ __forceinline__ int perm32(int rho) { const int n = rho >> 4, i = rho & 15; return 8 * (i >> 2) + 4 * n + (i & 3); }

struct Unit { int pm, pn; };
struct Gemm { const bf16_t* A; const bf16_t* Bt; int M, N, K; };

struct StaticOrder {
    int nM, nN, nwg, G, c;
    __host__ __device__ void init(int M, int N, int G_, int c_) { nM = M / BM; nN = N / BM; nwg = nM * nN; G = G_; c = c_; }
    __host__ __device__ bool next(int i, Unit& u) const {
        const long L = (long)i * G + c; if (L >= nwg) return false;
        int wgid = (int)L; { const int q = nwg / NXCD, r = nwg % NXCD, xcd = wgid % NXCD, off = wgid / NXCD; wgid = (xcd < r ? xcd * (q + 1) : r * (q + 1) + (xcd - r) * q) + off; }
        const int nig = WGM * nN, gid = wgid / nig, fm = gid * WGM, gsz = (nM - fm) < WGM ? (nM - fm) : WGM;
        u.pm = fm + ((wgid % nig) % gsz); u.pn = (wgid % nig) / gsz; return true;
    }
    __device__ __forceinline__ void a_ready(const Unit&) const {}
    __device__ __forceinline__ void done(const Unit&) const {}
};
__device__ __forceinline__ unsigned cvt_pk_bf16(float lo, float hi) { unsigned r; asm volatile("v_cvt_pk_bf16_f32 %0, %1, %2" : "=v"(r) : "v"(lo), "v"(hi)); return r; }
typedef float f32x2 __attribute__((ext_vector_type(2)));
__device__ __forceinline__ f32x2 gelu_pk(f32x2 v) {
    const f32x2 av = __builtin_elementwise_abs(v), d = av * 0.2316418882f + 1.0f;
    f32x2 t; t.x = __builtin_amdgcn_rcpf(d.x); t.y = __builtin_amdgcn_rcpf(d.y);
    f32x2 q = t * 0.5307027145f + (-0.7265760135f); q = q * t + 0.7107068705f; q = q * t + (-0.142248368f); q = q * t + 0.127414796f; q = q * t;
    const f32x2 s = (v * v) * (-0.72134752044f);
    f32x2 e; e.x = __builtin_amdgcn_exp2f(s.x); e.y = __builtin_amdgcn_exp2f(s.y);
    const f32x2 m = v * (q * e), r = v - m;
    f32x2 o; o.x = v.x < 0.f ? m.x : r.x; o.y = v.y < 0.f ? m.y : r.y; return o;
}

struct EpiF32 {
    static constexpr bool PERM = false, AFTER_DRAIN = false;
    float* C; int ldc; const float* bias;
    __device__ __forceinline__ void operator()(const f32x4 (&acc)[2][2][4][2], const Unit& u, int wr, int wc, int fr, int fq) const {
        const int row0 = u.pm * BM + wr * 64 + fr, col0 = u.pn * BM + wc * 32 + 4 * fq;
        f32x4 bv[2][2];
#pragma unroll
        for (int bj = 0; bj < 2; ++bj)
#pragma unroll
            for (int n = 0; n < 2; ++n) bv[bj][n] = bias ? *(const f32x4*)(bias + col0 + bj * HALF + n * 16) : (f32x4){0.f, 0.f, 0.f, 0.f};
#pragma unroll
        for (int ai = 0; ai < 2; ++ai)
#pragma unroll
            for (int m = 0; m < 4; ++m) { float* rowp = C + (size_t)(row0 + ai * HALF + m * 16) * ldc + col0;
#pragma unroll
                for (int bj = 0; bj < 2; ++bj)
#pragma unroll
                    for (int n = 0; n < 2; ++n) *(f32x4*)(rowp + bj * HALF + n * 16) = acc[ai][bj][m][n] + bv[bj][n]; }
    }
};
template <int ACT  > struct EpiBf16 {
    static constexpr bool PERM = true, AFTER_DRAIN = false;
    bf16_t* O; int ldc; const float* bias; int split_cols; size_t split_stride;
    __device__ __forceinline__ void operator()(const f32x4 (&acc)[2][2][4][2], const Unit& u, int wr, int wc, int fr, int fq) const {
        const int row0 = u.pm * BM + wr * 64 + fr; int colt = u.pn * BM; bf16_t* base = O;
        if (split_cols) { const int t = colt / split_cols; base += (size_t)t * split_stride; colt -= t * split_cols; }
        const int col0 = colt + wc * 32 + 8 * fq, bcol0 = u.pn * BM + wc * 32 + 8 * fq;
        f32x4 bv[2][2];
#pragma unroll
        for (int bj = 0; bj < 2; ++bj)
#pragma unroll
            for (int n = 0; n < 2; ++n) bv[bj][n] = bias ? *(const f32x4*)(bias + bcol0 + bj * HALF + 4 * n) : (f32x4){0.f, 0.f, 0.f, 0.f};
#pragma unroll
        for (int ai = 0; ai < 2; ++ai)
#pragma unroll
            for (int m = 0; m < 4; ++m) { bf16_t* rowp = base + (size_t)(row0 + ai * HALF + m * 16) * ldc + col0;
#pragma unroll
                for (int bj = 0; bj < 2; ++bj) { f32x4 v0 = acc[ai][bj][m][0] + bv[bj][0], v1 = acc[ai][bj][m][1] + bv[bj][1];
                    if (ACT == 1) { f32x2 a = gelu_pk((f32x2){v0[0], v0[1]}), b = gelu_pk((f32x2){v0[2], v0[3]}), c = gelu_pk((f32x2){v1[0], v1[1]}), d = gelu_pk((f32x2){v1[2], v1[3]});
                        v0 = (f32x4){a.x, a.y, b.x, b.y}; v1 = (f32x4){c.x, c.y, d.x, d.y}; }
                    if (ACT == 2) {
#pragma unroll
                        for (int j = 0; j < 4; ++j) { v0[j] = 0.5f * v0[j] * (1.0f + erff(v0[j] * 0.70710678f)); v1[j] = 0.5f * v1[j] * (1.0f + erff(v1[j] * 0.70710678f)); } }
                    u32x4 w; w.x = cvt_pk_bf16(v0[0], v0[1]); w.y = cvt_pk_bf16(v0[2], v0[3]); w.z = cvt_pk_bf16(v1[0], v1[1]); w.w = cvt_pk_bf16(v1[2], v1[3]);
                    *(u32x4*)(rowp + bj * HALF) = w; } }
    }
};
template <class Epi, class Sched, bool STAMP = false>
__device__ __forceinline__ void gemm_phase(PG8_LAS unsigned char* lds, const Gemm g, const Sched& S, const Epi& E, unsigned long long* stamps) {
    int tid_ = threadIdx.x; asm volatile("" : "+v"(tid_));
    const int tid = tid_, wid = __builtin_amdgcn_readfirstlane(tid >> 6), lane = tid & 63, wr = wid >> 2, wc = wid & 3, fr = lane & 15, fq = lane >> 4;
    const int K = g.K, nt = K / BK;
    int ts_lo = 0, ts_hi = 0, nts = 0; const unsigned long long rt_entry = STAMP ? (unsigned long long)wall_clock64() : 0ull;
#define PG8_STAMP() do { if (STAMP && wid == 0 && nts < 64) { const unsigned long long _c = (unsigned long long)clock64(); \
        ts_lo = (lane == nts) ? (int)(unsigned)_c : ts_lo; ts_hi = (lane == nts) ? (int)(unsigned)(_c >> 32) : ts_hi; ++nts; } } while (0)
    PG8_STAMP();
    unsigned voffA[2], voffB[2];
#pragma unroll
    for (int i = 0; i < 2; ++i) { int R, C; stage_rc(tid * 16 + i * 8192, R, C); const int Rb = Epi::PERM ? ((R & ~31) + perm32(R & 31)) : R;
        voffA[i] = (unsigned)(R * K + C) * 2u; voffB[i] = (unsigned)(Rb * K + C) * 2u; }
    const size_t kstep = (size_t)(BK * 2);
    const size_t hstep = (size_t)HALF * K * 2;
    const size_t tstep = 2 * hstep;
    const unsigned ldsw = (unsigned)wid * 1024u;
    const int aoff = lds_byte(wr * 64 + fr, fq * 8), boff = lds_byte(wc * 32 + fr, fq * 8);
#define PG8_SA(b, h) (((b) * 2 + (h)) * HTB)
#define PG8_SB(b, h) ((4 + (b) * 2 + (h)) * HTB)
#define PG8_STAGE(bufoff, gbase, voff) do { _Pragma("unroll") for (int _i = 0; _i < 2; ++_i) \
        __builtin_amdgcn_global_load_lds((const unsigned*)((const char*)(gbase) + (voff)[_i]), (PG8_LAS unsigned*)(lds + (bufoff) + ldsw + _i * 8192), 16, 0, 0); } while (0)
#define PG8_LDA(dst, b, h) do { _Pragma("unroll") for (int m = 0; m < 4; ++m) _Pragma("unroll") for (int k = 0; k < 2; ++k) dst[m][k] = *(const PG8_LAS bf16x8*)(lds + PG8_SA(b, h) + aoff + m * 2048 + k * 1024); } while (0)
#define PG8_LDB(dst, b, h) do { _Pragma("unroll") for (int n = 0; n < 2; ++n) _Pragma("unroll") for (int k = 0; k < 2; ++k) dst[n][k] = *(const PG8_LAS bf16x8*)(lds + PG8_SB(b, h) + boff + n * 2048 + k * 1024); } while (0)
#define PG8_MMA(ai, bj, At, Bt) do { __builtin_amdgcn_s_setprio(1); _Pragma("unroll") for (int m = 0; m < 4; ++m) _Pragma("unroll") for (int n = 0; n < 2; ++n) _Pragma("unroll") for (int k = 0; k < 2; ++k) \
        acc[ai][bj][m][n] = __builtin_amdgcn_mfma_f32_16x16x32_bf16(Bt[n][k], At[m][k], acc[ai][bj][m][n], 0, 0, 0); __builtin_amdgcn_s_setprio(0); } while (0)
#define PG8_WAIT_V(n) asm volatile("s_waitcnt vmcnt(" #n ")" ::: "memory")
#define PG8_WAIT_L(n) asm volatile("s_waitcnt lgkmcnt(" #n ")" ::: "memory")
#define PG8_BAR __builtin_amdgcn_s_barrier()
#define PG8_SCHED __builtin_amdgcn_sched_barrier(0)
    Unit cur, nxt; int ui = 0;
    if (!S.next(0, cur)) return;
    f32x4 acc[2][2][4][2];
#pragma unroll
    for (int a = 0; a < 2; ++a)
#pragma unroll
        for (int b = 0; b < 2; ++b)
#pragma unroll
            for (int m = 0; m < 4; ++m)
#pragma unroll
                for (int n = 0; n < 2; ++n) acc[a][b][m][n] = (f32x4){0.f, 0.f, 0.f, 0.f};
    bf16x8 At[4][2], B0[2][2], B1[2][2];
    const char* cA = (const char*)g.A + (size_t)cur.pm * tstep; const char* cB = (const char*)g.Bt + (size_t)cur.pn * tstep;
    S.a_ready(cur);
    PG8_STAGE(PG8_SB(0, 0), cB, voffB); PG8_STAGE(PG8_SA(0, 0), cA, voffA); PG8_STAGE(PG8_SB(0, 1), cB + hstep, voffB); PG8_STAGE(PG8_SA(0, 1), cA + hstep, voffA);
    if (wr == 1) PG8_BAR;
    PG8_WAIT_V(4); PG8_BAR;
    PG8_STAGE(PG8_SB(1, 0), cB + kstep, voffB); PG8_STAGE(PG8_SA(1, 0), cA + kstep, voffA); PG8_STAGE(PG8_SB(1, 1), cB + hstep + kstep, voffB);
    PG8_WAIT_V(6); PG8_BAR;
    PG8_STAMP();
    for (;;) {
        const bool has_next = S.next(ui + 1, nxt);
        const char* nA = has_next ? (const char*)g.A + (size_t)nxt.pm * tstep : cA; const char* nB = has_next ? (const char*)g.Bt + (size_t)nxt.pn * tstep : cB;
        for (int t = 0; t < nt; t += 2) {
            const bool last = (t == nt - 2);
            const char* a1 = cA + (size_t)(t + 1) * kstep;
            const char* a2 = last ? nA : cA + (size_t)(t + 2) * kstep; const char* b2 = last ? nB : cB + (size_t)(t + 2) * kstep;
            const char* a3 = a2 + kstep; const char* b3 = b2 + kstep;
            if (last && has_next) S.a_ready(nxt);
            PG8_LDB(B0, 0, 0); PG8_SCHED; PG8_LDA(At, 0, 0); PG8_STAGE(PG8_SA(1, 1), a1 + hstep, voffA);
            PG8_WAIT_L(8); PG8_BAR; PG8_WAIT_L(0); PG8_MMA(0, 0, At, B0); PG8_BAR; PG8_SCHED;
            PG8_LDB(B1, 0, 1); PG8_STAGE(PG8_SB(0, 0), b2, voffB);
            PG8_BAR; PG8_WAIT_L(0); PG8_MMA(0, 1, At, B1); PG8_BAR;
            PG8_LDA(At, 0, 1); PG8_STAGE(PG8_SA(0, 0), a2, voffA);
            PG8_BAR; PG8_WAIT_L(0); PG8_MMA(1, 0, At, B0); PG8_BAR; PG8_SCHED;
            PG8_STAGE(PG8_SB(0, 1), b2 + hstep, voffB);
            PG8_WAIT_V(6); PG8_BAR; PG8_MMA(1, 1, At, B1); PG8_BAR;
            PG8_LDB(B0, 1, 0); PG8_SCHED; PG8_LDA(At, 1, 0); PG8_STAGE(PG8_SA(0, 1), a2 + hstep, voffA);
            PG8_WAIT_L(8); PG8_BAR; PG8_WAIT_L(0); PG8_MMA(0, 0, At, B0); PG8_BAR; PG8_SCHED;
            PG8_LDB(B1, 1, 1); PG8_STAGE(PG8_SB(1, 0), b3, voffB);
            PG8_BAR; PG8_WAIT_L(0); PG8_MMA(0, 1, At, B1); PG8_BAR;
            PG8_LDA(At, 1, 1); PG8_STAGE(PG8_SA(1, 0), a3, voffA);
            PG8_BAR; PG8_WAIT_L(0); PG8_MMA(1, 0, At, B0); PG8_BAR; PG8_SCHED;
            PG8_STAGE(PG8_SB(1, 1), b3 + hstep, voffB);
            PG8_WAIT_V(6); PG8_BAR; PG8_MMA(1, 1, At, B1); PG8_BAR;
        }
        PG8_STAMP();
        if constexpr (!Epi::AFTER_DRAIN) { E(acc, cur, wr, wc, fr, fq); S.done(cur); }
        PG8_STAMP();
        if (!has_next) break;
#pragma unroll
        for (int a = 0; a < 2; ++a)
#pragma unroll
            for (int b = 0; b < 2; ++b)
#pragma unroll
                for (int m = 0; m < 4; ++m)
#pragma unroll
                    for (int n = 0; n < 2; ++n) acc[a][b][m][n] = (f32x4){0.f, 0.f, 0.f, 0.f};
        cur = nxt; cA = nA; cB = nB; ++ui;
    }
    PG8_WAIT_V(0);
    if (wr == 0) PG8_BAR;
    PG8_BAR;
    if constexpr (Epi::AFTER_DRAIN) { E.fused(acc, cur, wr, wc, fr, fq, lds, wid, lane); S.done(cur); }
    PG8_STAMP();
    if (STAMP && wid == 0) { stamps[lane] = lane < nts ? (((unsigned long long)(unsigned)ts_hi << 32) | (unsigned)ts_lo) : 0ull;
        if (lane == 62) stamps[62] = rt_entry; if (lane == 63) stamps[63] = (unsigned long long)wall_clock64(); }
#undef PG8_STAMP
#undef PG8_SA
#undef PG8_SB
#undef PG8_STAGE
#undef PG8_LDA
#undef PG8_LDB
#undef PG8_MMA
#undef PG8_WAIT_V
#undef PG8_WAIT_L
#undef PG8_BAR
#undef PG8_SCHED
}
}

#define LAS __attribute__((address_space(3)))
typedef unsigned short bf16_t;
typedef short bf16x8 __attribute__((ext_vector_type(8)));
typedef float f32x4 __attribute__((ext_vector_type(4)));
typedef float f32x2 __attribute__((ext_vector_type(2)));
typedef unsigned u32x4 __attribute__((ext_vector_type(4)));
typedef unsigned u32x2 __attribute__((ext_vector_type(2)));

constexpr int D = 1024, NP = 16384, NS = 512, NTOK = NP + NS, SEQ = 2048, NB = 8, NSB = 128, DEPTH = 4;
constexpr int INW = 2568, NPROJ = 2560, DFF = 2816, NGU = 5632;
constexpr int PC_G = 1536, PC_SSM = 2048, PC_POOL = 2304;
constexpr float EPS = 1e-6f;
constexpr int LDS_BYTES = 163840;

constexpr size_t SZ_WIN = (size_t)NPROJ * D * 2, SZ_WOUT = (size_t)D * D * 2, SZ_WGU = (size_t)NGU * D * 2, SZ_WDN = (size_t)D * DFF * 2;
constexpr size_t SZ_WAB = 8 * D * 4, SZ_GLUT = 256 * 256 * 2, SZ_POOLT = 4 * 64 * 64 * 2, SZ_SSMK = 16 * 64 * 4 * 4, SZ_BBAR = 16 * 64 * 32 * 4;
constexpr size_t WS_WIN = 0;
constexpr size_t WS_WOUT = WS_WIN + DEPTH * SZ_WIN;
constexpr size_t WS_WGU = WS_WOUT + DEPTH * SZ_WOUT;
constexpr size_t WS_WDN = WS_WGU + DEPTH * SZ_WGU;
constexpr size_t WS_WAB = WS_WDN + DEPTH * SZ_WDN;
constexpr size_t WS_GLUT = WS_WAB + DEPTH * SZ_WAB;
constexpr size_t WS_POOLT = WS_GLUT + DEPTH * SZ_GLUT;
constexpr size_t WS_SSMK = WS_POOLT + DEPTH * SZ_POOLT;
constexpr size_t WS_BBAR = WS_SSMK + DEPTH * SZ_SSMK;
constexpr size_t WS_H = WS_BBAR + DEPTH * SZ_BBAR;
constexpr size_t WS_AB = WS_H + (size_t)NTOK * D * 2;
constexpr size_t WS_MIX = WS_AB + (size_t)NTOK * 8 * 4;
constexpr size_t WS_MIXO = WS_MIX + (size_t)NTOK * D * 2;
constexpr size_t WS_SSME = WS_MIXO + (size_t)NTOK * D * 4;
constexpr size_t WS_PROJ = WS_SSME + (size_t)8 * 32 * 16 * 64 * 2 * 4;
constexpr size_t WS_DW = WS_PROJ + (size_t)NTOK * NPROJ * 2;
constexpr size_t WS_DKC = WS_DW + (size_t)1024 * 8192 * 4;
constexpr size_t WS_DQD = WS_DKC + (size_t)1024 * 8192 * 2;
constexpr size_t WS_DQK = WS_DQD + (size_t)1024 * 8192 * 2;
constexpr size_t WS_DKT = WS_DQK + (size_t)1024 * 4096 * 2;
constexpr size_t WS_DGL = WS_DKT + (size_t)1024 * 8192 * 2;
constexpr size_t WS_DGS = WS_DGL + 4096;
constexpr size_t WS_BAR = WS_DGS + (size_t)1024 * 8192 * 2;
constexpr size_t WS_END = WS_BAR + 16384;
constexpr size_t WS_HID = WS_PROJ;
static_assert(WS_HID + (size_t)NTOK * DFF * 2 <= WS_END, "HID overlay");
static_assert(WS_H % 256 == 0 && WS_PROJ % 256 == 0 && WS_DW % 256 == 0, "align");

constexpr size_t O_YP = 0, O_YS = O_YP + (size_t)NP * D, O_DP = O_YS + (size_t)NS * D, O_CP = O_DP + (size_t)DEPTH * 8 * 4 * 16384,
                 O_REP = O_CP + (size_t)DEPTH * 8 * 3 * 1536, O_IMP = O_REP + (size_t)DEPTH * 8 * 1024, O_PP = O_IMP + (size_t)DEPTH * 8 * 1024,
                 O_DS = O_PP + (size_t)DEPTH * 8 * 15 * 256, O_CS = O_DS + (size_t)DEPTH * 128 * 4 * 16384, O_RES = O_CS + (size_t)DEPTH * 128 * 3 * 1536,
                 O_IMS = O_RES + (size_t)DEPTH * 128 * 1024, O_PS = O_IMS + (size_t)DEPTH * 128 * 1024, O_END = O_PS + (size_t)DEPTH * 128 * 15 * 256;

struct Args { const float* in[32]; float* out; unsigned char* ws; int ph_lo, ph_hi; };
typedef const float* cfp_t;
typedef __attribute__((address_space(4))) const unsigned char* kptr_t;
struct InProxy { __device__ __forceinline__ const float* operator[](int i) const {
    kptr_t p = (kptr_t)__builtin_amdgcn_kernarg_segment_ptr(); asm volatile("" : "+s"(p)); return *(__attribute__((address_space(4))) const cfp_t*)(p + 8 * i); } };
struct DevArgs { InProxy in; float* out; unsigned char* ws; int ph_lo, ph_hi; };
enum { I_XP = 0, I_XS, I_SDELTA, I_SCONV, I_SRE, I_SIM, I_SPOOL, I_NMPRE, I_NMPOST, I_NFPRE, I_NFPOST, I_WIN, I_CONVW, I_ALOG, I_DTB, I_ONORM,
       I_ARE, I_AIM, I_LOGDT, I_BRE, I_BIM, I_CRE, I_CIM, I_SSMD, I_GLUW, I_GLUB, I_POOLW, I_POOLS, I_WOUT, I_WG, I_WU, I_WD };

__device__ __forceinline__ unsigned f2bf(float f) { unsigned u = __float_as_uint(f); return (u + 0x7fffu + ((u >> 16) & 1u)) >> 16; }
__device__ __forceinline__ float bf2f(unsigned b) { return __uint_as_float(b << 16); }
__device__ __forceinline__ unsigned pk2(float lo, float hi) { return f2bf(lo) | (f2bf(hi) << 16); }
__device__ __forceinline__ float wave_sum(float v) {
#pragma unroll
    for (int o = 1; o < 64; o <<= 1) v += __shfl_xor(v, o);
    return v;
}
__device__ __forceinline__ float silu_f(float y) { return y / (1.f + __expf(-y)); }
__device__ __forceinline__ float sigmoid_f(float y) { return 1.f / (1.f + __expf(-y)); }
__device__ __forceinline__ float gelu_tanh_f(float x) { const float t = tanhf(0.7978845608028654f * (x + 0.044715f * x * x * x)); return 0.5f * x * (1.f + t); }
__device__ __forceinline__ f32x4 mfma16(bf16x8 a, bf16x8 b, f32x4 c) { return __builtin_amdgcn_mfma_f32_16x16x32_bf16(a, b, c, 0, 0, 0); }
#define LDS_FENCE() asm volatile("s_waitcnt lgkmcnt(0)" ::: "memory")

struct EpiSwiGLU {
    static constexpr bool PERM = false, AFTER_DRAIN = false;
    bf16_t* O; int ldc;
    __device__ __forceinline__ void operator()(const pg8::f32x4 (&acc)[2][2][4][2], const pg8::Unit& u, int wr, int wc, int fr, int fq) const {
        const int row0 = u.pm * 256 + wr * 64 + fr, hid0 = u.pn * 128 + wc * 16 + 4 * fq;
#pragma unroll
        for (int ai = 0; ai < 2; ++ai)
#pragma unroll
            for (int m = 0; m < 4; ++m) { bf16_t* rowp = O + (size_t)(row0 + ai * 128 + m * 16) * ldc + hid0;
#pragma unroll
                for (int bj = 0; bj < 2; ++bj) { const pg8::f32x4 g = acc[ai][bj][m][0], v = acc[ai][bj][m][1];
                    u32x2 w; w.x = pk2(silu_f(g[0]) * v[0], silu_f(g[1]) * v[1]); w.y = pk2(silu_f(g[2]) * v[2], silu_f(g[3]) * v[3]);
                    *(u32x2*)(rowp + bj * 64) = w; } }
    }
};

#define XB_TMO      128
#define XB_XCNT(j)  (256  + 64 * (j))
#define XB_XSUB(j)  (1280 + 64 * (j))
#define XB_XGEN(j)  (2304 + 64 * (j))
#define XB_TOP      3328
#define XB_TOPGEN   3392
#define XCD_BAR_WORDS 3456
#define XB_SPIN_CAP (1u << 18)

__device__ __forceinline__ unsigned xb_ld(unsigned* p)              { return __hip_atomic_load(p, __ATOMIC_RELAXED, __HIP_MEMORY_SCOPE_AGENT); }
__device__ __forceinline__ unsigned xb_add(unsigned* p, unsigned v) { return __hip_atomic_fetch_add(p, v, __ATOMIC_RELAXED, __HIP_MEMORY_SCOPE_AGENT); }
__device__ __forceinline__ unsigned xb_xcc_id() { return (unsigned)__builtin_amdgcn_s_getreg((3 << 11) | 20) & 0xFu; }
#define XB_SPIN(cond, bar) do { unsigned _sp = 0; while (cond) { __builtin_amdgcn_s_sleep(1); \
    if ((++_sp & 255u) == 0u) { if (xb_ld(&(bar)[XB_TMO])) break; if (_sp > XB_SPIN_CAP) { atomicAdd(&(bar)[XB_TMO], 1u); break; } } } } while (0)

struct XcdBarrier {
    unsigned* bar; unsigned x;
    volatile LAS unsigned* st;
};

__device__ __forceinline__ XcdBarrier xcd_barrier_post(unsigned* bar, volatile LAS unsigned* st) {
    XcdBarrier b; b.bar = bar; b.x = xb_xcc_id(); b.st = st;
    if (threadIdx.x == 0) (void)xb_add(&bar[XB_XCNT(b.x)], 1u);
    return b;
}
__device__ __forceinline__ void xcd_barrier_complete(unsigned* bar, unsigned x, unsigned& nloc, unsigned& nx) {
    const unsigned G = gridDim.x * gridDim.y * gridDim.z;
    unsigned sum, cnt, mine, sp = 0u;
    for (;;) {
        sum = 0u; cnt = 0u; mine = 0u;
#pragma unroll
        for (unsigned j = 0; j < 16; ++j) { const unsigned c = xb_ld(&bar[XB_XCNT(j)]); sum += c; cnt += (c > 0u) ? 1u : 0u; mine = (j == x) ? c : mine; }
        if (sum == G) break;
        __builtin_amdgcn_s_sleep(1);
        if ((++sp & 255u) == 0u) { if (xb_ld(&bar[XB_TMO])) break; if (sp > XB_SPIN_CAP) { atomicAdd(&bar[XB_TMO], 1u); break; } }
    }
    nloc = mine > 0u ? mine : 1u; nx = cnt > 0u ? cnt : 1u;
}

__device__ __forceinline__ void xcd_barrier(const XcdBarrier& b) {
    asm volatile("s_waitcnt vmcnt(0)" ::: "memory");
    __syncthreads();
    if (threadIdx.x == 0) {
        unsigned* bar = b.bar; asm volatile("" : "+s"(bar));
        __builtin_amdgcn_s_waitcnt(0);
        unsigned nloc = b.st[0], nx = b.st[1];
        if (nloc == 0u) { xcd_barrier_complete(bar, b.x, nloc, nx); b.st[0] = nloc; b.st[1] = nx; }
        const unsigned old = xb_add(&bar[XB_XSUB(b.x)], 1u);
        const unsigned gen = old / nloc;
        if (old + 1u == (gen + 1u) * nloc) {
            __builtin_amdgcn_fence(__ATOMIC_RELEASE, "agent");
            asm volatile("s_waitcnt vmcnt(0)" ::: "memory");
            const unsigned og = xb_add(&bar[XB_TOP], 1u);
            const unsigned tg = og / nx;
            if (og + 1u == (tg + 1u) * nx) xb_add(&bar[XB_TOPGEN], 1u);
            else XB_SPIN(xb_ld(&bar[XB_TOPGEN]) == tg, bar);
            __builtin_amdgcn_fence(__ATOMIC_ACQUIRE, "agent");
            xb_add(&bar[XB_XGEN(b.x)], 1u);
            asm volatile("s_waitcnt vmcnt(0)" ::: "memory");
        } else {
            XB_SPIN(xb_ld(&bar[XB_XGEN(b.x)]) == gen, bar);
            __builtin_amdgcn_fence(__ATOMIC_ACQUIRE, "agent");
            asm volatile("s_waitcnt vmcnt(0)" ::: "memory");
        }
    }
    __syncthreads();
}

struct SrcIn { const float* w; __device__ __forceinline__ float operator()(int k, int n) const { return w[(size_t)k * INW + (n < 1536 ? n : n + 8)]; } };
struct SrcPlain { const float* w; int N; __device__ __forceinline__ float operator()(int k, int n) const { return w[(size_t)k * N + n]; } };
struct SrcGU { const float* g; const float* u; __device__ __forceinline__ float operator()(int k, int n) const { const int r = n & 31, hid = (n >> 5) * 16 + (r & 15); const long long du = (r < 16) ? 0ll : (long long)(u - g); return g[du + (long long)k * DFF + hid]; } };
template <class Src> __device__ __forceinline__ void transpose_item(const Src& src, int K, bf16_t* WT, int nblk, LAS float* scr, int item, int lane) {
    const int kb = item / nblk, nb = item % nblk, k0 = 64 * kb, n0 = 32 * nb;
#pragma unroll 8
    for (int i = 0; i < 32; ++i) { const int kk = 2 * i + (lane >> 5); scr[kk * 33 + (lane & 31)] = src(k0 + kk, n0 + (lane & 31)); }
    LDS_FENCE();
    const int c = lane & 7;
#pragma unroll
    for (int j = 0; j < 4; ++j) { const int n = (lane >> 3) + 8 * j; const LAS float* s = scr + (8 * c) * 33 + n;
        u32x4 o; o.x = pk2(s[0 * 33], s[1 * 33]); o.y = pk2(s[2 * 33], s[3 * 33]); o.z = pk2(s[4 * 33], s[5 * 33]); o.w = pk2(s[6 * 33], s[7 * 33]);
        *(u32x4*)(WT + (size_t)(n0 + n) * K + k0 + 8 * c) = o; }
    LDS_FENCE();
}

__device__ __forceinline__ void norm_rows(const float* T, const float* wt, const float* X0, const float* X1, float* Xout, const float* wh, bf16_t* H,
                                          const float* Wab, float* AB, int gw, int NGW, int lane) {
#pragma unroll 1
    for (int m = gw; m < NTOK; m += NGW) {
        const float* xr = (X1 && m >= NP) ? X1 + (size_t)(m - NP) * D : X0 + (size_t)m * D;
        f32x4 x[4];
#pragma unroll
        for (int j = 0; j < 4; ++j) x[j] = ((const f32x4*)xr)[lane + 64 * j];
        if (T) {
            f32x4 t[4]; float ss = 0.f;
#pragma unroll
            for (int j = 0; j < 4; ++j) { t[j] = ((const f32x4*)(T + (size_t)m * D))[lane + 64 * j]; ss += (t[j].x * t[j].x + t[j].y * t[j].y) + (t[j].z * t[j].z + t[j].w * t[j].w); }
            ss = wave_sum(ss); const float r = rsqrtf(ss * (1.f / D) + EPS);
#pragma unroll
            for (int j = 0; j < 4; ++j) { const f32x4 w = ((const f32x4*)wt)[lane + 64 * j]; x[j] += t[j] * r * w; }
        }
        if (Xout) {
#pragma unroll
            for (int j = 0; j < 4; ++j) ((f32x4*)(Xout + (size_t)m * D))[lane + 64 * j] = x[j];
        }
        if (H) {
            float ss = 0.f;
#pragma unroll
            for (int j = 0; j < 4; ++j) ss += (x[j].x * x[j].x + x[j].y * x[j].y) + (x[j].z * x[j].z + x[j].w * x[j].w);
            ss = wave_sum(ss); const float r = rsqrtf(ss * (1.f / D) + EPS);
            f32x4 hv[4];
#pragma unroll
            for (int j = 0; j < 4; ++j) { const f32x4 w = ((const f32x4*)wh)[lane + 64 * j]; hv[j] = x[j] * r * w;
                u32x2 o; o.x = pk2(hv[j].x, hv[j].y); o.y = pk2(hv[j].z, hv[j].w); ((u32x2*)(H + (size_t)m * D))[lane + 64 * j] = o; }
            if (Wab) {
#pragma unroll
                for (int c = 0; c < 8; ++c) { float d = 0.f;
#pragma unroll
                    for (int j = 0; j < 4; ++j) { const f32x4 w = ((const f32x4*)(Wab + c * D))[lane + 64 * j]; d += (hv[j].x * w.x + hv[j].y * w.y) + (hv[j].z * w.z + hv[j].w * w.w); }
                    d = wave_sum(d); if (lane == 0) AB[(size_t)m * 8 + c] = d; }
            }
        }
    }
}

__device__ __forceinline__ void prologue(const DevArgs& A, LAS unsigned char* lds, int wave, int lane, int gw, int NGW) {
    LAS float* scr = (LAS float*)(lds + wave * 8704);
    constexpr int I_IN = 16 * 80, I_OUT = 16 * 32, I_GU = 16 * 176, I_DN = 44 * 32, I_GLU = 4 * 8, I_POOL = 8, PER = I_IN + I_OUT + I_GU + I_DN + I_GLU + I_POOL;
#pragma unroll 1
    for (int it = gw; it < DEPTH * PER; it += NGW) {
        const int l = it / PER; int r = it % PER;
        if (r < I_IN) { SrcIn s{A.in[I_WIN] + (size_t)l * D * INW}; transpose_item(s, D, (bf16_t*)(A.ws + WS_WIN + l * SZ_WIN), NPROJ / 32, scr, r, lane); continue; } r -= I_IN;
        if (r < I_OUT) { SrcPlain s{A.in[I_WOUT] + (size_t)l * D * D, D}; transpose_item(s, D, (bf16_t*)(A.ws + WS_WOUT + l * SZ_WOUT), D / 32, scr, r, lane); continue; } r -= I_OUT;
        if (r < I_GU) { SrcGU s{A.in[I_WG] + (size_t)l * D * DFF, A.in[I_WU] + (size_t)l * D * DFF}; transpose_item(s, D, (bf16_t*)(A.ws + WS_WGU + l * SZ_WGU), NGU / 32, scr, r, lane); continue; } r -= I_GU;
        if (r < I_DN) { SrcPlain s{A.in[I_WD] + (size_t)l * DFF * D, D}; transpose_item(s, DFF, (bf16_t*)(A.ws + WS_WDN + l * SZ_WDN), D / 32, scr, r, lane); continue; } r -= I_DN;
        if (r < I_GLU) { SrcPlain s{A.in[I_GLUW] + (size_t)l * 65536, 256}; transpose_item(s, 256, (bf16_t*)(A.ws + WS_GLUT + l * SZ_GLUT), 8, scr, r, lane); continue; } r -= I_GLU;
        { const int g = r >> 1; SrcPlain s{A.in[I_POOLW] + (size_t)(l * 4 + g) * 4096, 64}; transpose_item(s, 64, (bf16_t*)(A.ws + WS_POOLT + l * SZ_POOLT) + g * 4096, 2, scr, r & 1, lane); }
    }
    const int gt = gw * 64 + lane, NT = NGW * 64;
    float* wab = (float*)(A.ws + WS_WAB);
#pragma unroll 1
    for (int i = gt; i < DEPTH * 8 * D; i += NT) { const int l = i / (8 * D), j = (i / D) & 7, k = i % D; wab[i] = A.in[I_WIN][((size_t)l * D + k) * INW + 1536 + j]; }
    float* ssmk = (float*)(A.ws + WS_SSMK); float* bbar = (float*)(A.ws + WS_BBAR);
#pragma unroll 1
    for (int i = gt; i < DEPTH * 16 * 64; i += NT) {
        const int lg = i >> 6;
        const float dt = expf(A.in[I_LOGDT][lg]), ar = A.in[I_ARE][i], ai = A.in[I_AIM][i];
        const float mag = expf(ar * dt);
        float rev = ai * dt * 0.15915494309189535f; rev -= floorf(rev);
        const float sn = __builtin_amdgcn_sinf(rev), cs = __builtin_amdgcn_cosf(rev);
        const float lr = mag * cs, li = mag * sn;
        float pr = lr, pi = li;
#pragma unroll
        for (int q = 0; q < 6; ++q) { const float nr2 = pr * pr - pi * pi, ni2 = 2.f * pr * pi; pr = nr2; pi = ni2; }
        ssmk[i * 4 + 0] = lr; ssmk[i * 4 + 1] = li; ssmk[i * 4 + 2] = pr; ssmk[i * 4 + 3] = pi;
        const float nr = lr - 1.f, ni = li, d2 = ar * ar + ai * ai;
        const float cre = (nr * ar + ni * ai) / d2, cim = (ni * ar - nr * ai) / d2;
#pragma unroll
        for (int h = 0; h < 16; ++h) { const float br = A.in[I_BRE][(size_t)i * 16 + h], bi = A.in[I_BIM][(size_t)i * 16 + h];
            bbar[(size_t)i * 32 + h] = cre * br - cim * bi; bbar[(size_t)i * 32 + 16 + h] = cre * bi + cim * br; }
    }
}

__device__ __forceinline__ void delta_prep_item(const DevArgs& A, int l, LAS unsigned char* lds, int item, int tid, int wave, int lane) {
    const int bh = item >> 5, n = item & 31, b = bh >> 2, h = bh & 3;
    const int tok0 = b * SEQ + n * 64;
    LAS bf16_t* QS = (LAS bf16_t*)(lds); LAS bf16_t* KS = (LAS bf16_t*)(lds + 17408);
    LAS float* RHS = (LAS float*)(lds + 34816);
    LAS float* AM = (LAS float*)(lds + 100352); LAS float* PM = (LAS float*)(lds + 117760);
    LAS float* GAM = (LAS float*)(lds + 135168); LAS float* BETA = GAM + 64; LAS float* RQ = GAM + 128; LAS float* RK = GAM + 192;
    const bf16_t* PROJ = (const bf16_t*)(A.ws + WS_PROJ);
    const float* AB = (const float*)(A.ws + WS_AB);
    unsigned gv[16];
#pragma unroll
    for (int j = 0; j < 16; ++j) { const int idx = tid + 512 * j; gv[j] = PROJ[(size_t)(tok0 + (idx >> 7)) * NPROJ + PC_G + h * 128 + (idx & 127)]; }
    if (tid < 384) {
        const int part = tid >> 7, c = tid & 127, col = part * 512 + h * 128 + c;
        const float* cw = A.in[I_CONVW] + (size_t)l * 4 * 1536;
        const float w0 = cw[col], w1 = cw[1536 + col], w2 = cw[3072 + col], w3 = cw[4608 + col];
        const bf16_t* pp = PROJ + (size_t)tok0 * NPROJ + col;
        float xr[67];
#pragma unroll
        for (int t = 0; t < 67; ++t) xr[t] = (n > 0 || t >= 3) ? bf2f(pp[(long)(t - 3) * NPROJ]) : 0.f;
#pragma unroll
        for (int t = 0; t < 64; ++t) {
            const float y = w0 * xr[t] + w1 * xr[t + 1] + w2 * xr[t + 2] + w3 * xr[t + 3];
            const float s = silu_f(y);
            if (part == 0) QS[t * 136 + c] = (bf16_t)f2bf(s);
            else if (part == 1) KS[t * 136 + c] = (bf16_t)f2bf(s);
            else RHS[t * 256 + c] = s;
        }
    } else if (tid < 448) {
        const int t = tid - 384;
        const float a = AB[(size_t)(tok0 + t) * 8 + h], bb = AB[(size_t)(tok0 + t) * 8 + 4 + h];
        const float xx = a + A.in[I_DTB][l * 4 + h];
        const float sp = xx > 20.f ? xx : log1pf(expf(xx));
        float lg = -expf(A.in[I_ALOG][l * 4 + h]) * sp;
#pragma unroll
        for (int off = 1; off < 64; off <<= 1) { const float v = __shfl_up(lg, off); if (lane >= off) lg += v; }
        GAM[t] = lg; BETA[t] = 1.f / (1.f + expf(-bb));
    }
    __syncthreads();
    {
        const int t = tid >> 3, part = tid & 7; float sq = 0.f, sk = 0.f;
#pragma unroll
        for (int j = 0; j < 16; ++j) { const float q = bf2f(QS[t * 136 + part * 16 + j]), k = bf2f(KS[t * 136 + part * 16 + j]); sq += q * q; sk += k * k; }
        sq += __shfl_xor(sq, 1); sq += __shfl_xor(sq, 2); sq += __shfl_xor(sq, 4);
        sk += __shfl_xor(sk, 1); sk += __shfl_xor(sk, 2); sk += __shfl_xor(sk, 4);
        if (part == 0) { RQ[t] = rsqrtf(sq + EPS) * 0.08838834764831845f; RK[t] = rsqrtf(sk + EPS); }
    }
    {
        const int prod = wave >> 2, mt = wave & 3, fr = lane & 15, quad = lane >> 4;
        LAS bf16_t* Aop = prod ? QS : KS; LAS float* dst = prod ? PM : AM;
        bf16x8 a[4];
#pragma unroll
        for (int kk = 0; kk < 4; ++kk) a[kk] = *(LAS bf16x8*)(Aop + (mt * 16 + fr) * 136 + kk * 32 + quad * 8);
#pragma unroll
        for (int nt = 0; nt < 4; ++nt) { f32x4 acc = {0.f, 0.f, 0.f, 0.f};
#pragma unroll
            for (int kk = 0; kk < 4; ++kk) { const bf16x8 bq = *(LAS bf16x8*)(KS + (nt * 16 + fr) * 136 + kk * 32 + quad * 8); acc = mfma16(a[kk], bq, acc); }
#pragma unroll
            for (int i = 0; i < 4; ++i) dst[(mt * 16 + quad * 4 + i) * 68 + nt * 16 + fr] = acc[i]; }
    }
    __syncthreads();
    bf16_t* DQK = (bf16_t*)(A.ws + WS_DQK) + (size_t)item * 4096;
    bf16_t* DQD = (bf16_t*)(A.ws + WS_DQD) + (size_t)item * 8192;
    bf16_t* DKT = (bf16_t*)(A.ws + WS_DKT) + (size_t)item * 8192;
    for (int idx = tid; idx < 4096; idx += 512) { const int t = idx >> 6, s = idx & 63;
        const float dec = (s <= t) ? __expf(GAM[t] - GAM[s]) : 0.f;
        const float am = AM[t * 68 + s], pm = PM[t * 68 + s];
        AM[t * 68 + s] = (s < t) ? BETA[t] * RK[t] * RK[s] * am * dec : 0.f;
        DQK[idx] = (bf16_t)f2bf(RQ[t] * RK[s] * pm * dec); }
    for (int idx = tid; idx < 8192; idx += 512) { const int t = idx >> 7, c = idx & 127; const float bt = BETA[t], eg = __expf(GAM[t]);
        const float kraw = bf2f(KS[t * 136 + c]), qraw = bf2f(QS[t * 136 + c]);
        RHS[t * 256 + c] *= bt; RHS[t * 256 + 128 + c] = bt * eg * RK[t] * kraw;
        DQD[idx] = (bf16_t)f2bf(qraw * RQ[t] * eg); }
    { const float g63 = GAM[63];
      for (int idx = tid; idx < 8192; idx += 512) { const int c = idx >> 6, t = idx & 63; DKT[idx] = (bf16_t)f2bf(bf2f(KS[t * 136 + c]) * RK[t] * __expf(g63 - GAM[t])); }
      if (tid == 0) ((float*)(A.ws + WS_DGL))[item] = __expf(g63); }
    { bf16_t* DGS = (bf16_t*)(A.ws + WS_DGS) + (size_t)item * 8192; const float on = A.in[I_ONORM][l * 128 + (tid & 127)];
#pragma unroll
      for (int j = 0; j < 16; ++j) DGS[tid + 512 * j] = (bf16_t)f2bf(silu_f(bf2f(gv[j])) * on); }
    __syncthreads();
#ifndef REP_SOLVE
#define REP_SOLVE 1
#endif
    if (tid < 256) for (int rep = 0; rep < REP_SOLVE; ++rep) {
        float sol[64];
        LAS float* amp = AM; asm volatile("" : "+v"(amp));
        LAS float* rhp = RHS + tid; asm volatile("" : "+v"(rhp));
#pragma unroll
        for (int t = 0; t < 64; ++t) { float acc = rhp[t * 256];
#pragma unroll
            for (int s = 0; s < t; ++s) acc = fmaf(-amp[t * 68 + s], sol[s], acc);
            sol[t] = acc; __builtin_amdgcn_sched_barrier(0); }
        if (tid < 128) { u32x4* DW = (u32x4*)((bf16_t*)(A.ws + WS_DW) + (size_t)item * 8192 + tid * 64);
#pragma unroll
            for (int q = 0; q < 8; ++q) { u32x4 o; o.x = pg8::cvt_pk_bf16(sol[8 * q], sol[8 * q + 1]); o.y = pg8::cvt_pk_bf16(sol[8 * q + 2], sol[8 * q + 3]);
                o.z = pg8::cvt_pk_bf16(sol[8 * q + 4], sol[8 * q + 5]); o.w = pg8::cvt_pk_bf16(sol[8 * q + 6], sol[8 * q + 7]); DW[q] = o; } }
        else { bf16_t* DKC = (bf16_t*)(A.ws + WS_DKC) + (size_t)item * 8192 + (tid - 128);
#pragma unroll
            for (int t = 0; t < 64; ++t) DKC[t * 128] = (bf16_t)f2bf(-sol[t]); }
    }
    __syncthreads();
}

__device__ __forceinline__ void delta_scan_item(const DevArgs& A, int l, LAS unsigned char* lds, int bh, int tid_in, int wave, int lane_in, const XcdBarrier& xb, int SUB) {
    const int b = bh >> 2, h = bh & 3;
    LAS unsigned char* KCs = lds; LAS unsigned char* QDs = lds + 17408; LAS unsigned char* QKs = lds + 34816; LAS unsigned char* KDTs = lds + 44032;
    LAS unsigned char* Ws = lds + 62464;
    LAS unsigned char* GSs = lds + 80896;
    LAS unsigned char* SS = lds + 98304 + wave * 4352; LAS unsigned char* US = lds + 133120 + wave * 2304;
    LAS float* PART = (LAS float*)(lds + 151552);
    const unsigned char* gW = A.ws + WS_DW; const unsigned char* gGS = A.ws + WS_DGS;
    const unsigned char* gKC = A.ws + WS_DKC; const unsigned char* gQD = A.ws + WS_DQD; const unsigned char* gQK = A.ws + WS_DQK; const unsigned char* gKT = A.ws + WS_DKT;
    const float* DGL = (const float*)(A.ws + WS_DGL);
    f32x4 S[8];
#pragma unroll
    for (int mt = 0; mt < 8; ++mt) S[mt] = (f32x4){0.f, 0.f, 0.f, 0.f};
    u32x4 r[9], rg[2];
    float gl_all = 0.f;
#define DS_LOAD(itn, toff) do { const size_t _i = (size_t)(itn); const unsigned char* _kc = gKC + _i * 16384; const unsigned char* _qd = gQD + _i * 16384; \
        const unsigned char* _qk = gQK + _i * 8192; const unsigned char* _kt = gKT + _i * 16384; \
        r[0] = *(const u32x4*)(_kc + (toff)); r[1] = *(const u32x4*)(_kc + (toff) + 8192u); \
        r[2] = *(const u32x4*)(_qd + (toff)); r[3] = *(const u32x4*)(_qd + (toff) + 8192u); \
        r[4] = *(const u32x4*)(_qk + (toff)); \
        r[5] = *(const u32x4*)(_kt + (toff)); r[6] = *(const u32x4*)(_kt + (toff) + 8192u); \
        const unsigned char* _w = gW + _i * 16384; r[7] = *(const u32x4*)(_w + (toff)); r[8] = *(const u32x4*)(_w + (toff) + 8192u); } while (0)
#define DS_LOADG(itn, toff) do { const unsigned char* _g = gGS + (size_t)(itn) * 16384; rg[0] = *(const u32x4*)(_g + (toff)); rg[1] = *(const u32x4*)(_g + (toff) + 8192u); } while (0)
#define DS_STAGE(tidv) do { const int i0 = (tidv), i1 = (tidv) + 512; \
          *(LAS u32x4*)(KCs + (i0 >> 4) * 272 + (i0 & 15) * 16) = r[0]; *(LAS u32x4*)(KCs + (i1 >> 4) * 272 + (i1 & 15) * 16) = r[1]; \
          *(LAS u32x4*)(QDs + (i0 >> 4) * 272 + (i0 & 15) * 16) = r[2]; *(LAS u32x4*)(QDs + (i1 >> 4) * 272 + (i1 & 15) * 16) = r[3]; \
          *(LAS u32x4*)(QKs + (i0 >> 3) * 144 + (i0 & 7) * 16) = r[4]; \
          *(LAS u32x4*)(KDTs + (i0 >> 3) * 144 + (i0 & 7) * 16) = r[5]; *(LAS u32x4*)(KDTs + (i1 >> 3) * 144 + (i1 & 7) * 16) = r[6]; \
          *(LAS u32x4*)(Ws + (i0 >> 3) * 144 + (i0 & 7) * 16) = r[7]; *(LAS u32x4*)(Ws + (i1 >> 3) * 144 + (i1 & 7) * 16) = r[8]; } while (0)
#define DS_STAGEG(tidv) do { const int i0 = (tidv), i1 = (tidv) + 512; \
          *(LAS u32x4*)(GSs + (i0 >> 4) * 272 + (i0 & 15) * 16) = rg[0]; *(LAS u32x4*)(GSs + (i1 >> 4) * 272 + (i1 & 15) * 16) = rg[1]; } while (0)
#pragma unroll 1
    for (int n = 0; n < 32; ++n) {
        int tid = tid_in; asm volatile("" : "+v"(tid));
        const bool bstart = (SUB > 0) ? (n % SUB == 0) : (n == 0);
        const bool bnext1 = (SUB > 0) && ((n + 1) % SUB == 0), bnext2 = (SUB > 0) && ((n + 2) % SUB == 0);
        if (bstart) { if (n > 0) xcd_barrier(xb);
            gl_all = DGL[bh * 32 + (tid & 31)];
            const unsigned t0 = (unsigned)tid * 16u; DS_LOAD(bh * 32 + n, t0); DS_LOADG(bh * 32 + n, t0); DS_STAGE(tid); DS_STAGEG(tid);
            if (n + 1 < 32 && !bnext1) { DS_LOAD(bh * 32 + n + 1, t0); DS_LOADG(bh * 32 + n + 1, t0); }
            __syncthreads(); }
        else { DS_STAGEG(tid);
            if (n + 1 < 32 && !bnext1) DS_LOADG(bh * 32 + n + 1, (unsigned)tid * 16u); }
        const int lane = tid & 63, fr = lane & 15, quad = lane >> 4, vcol = 16 * wave + fr;
        const unsigned toff = (unsigned)tid * 16u;
        const int it = bh * 32 + n, tokb = b * SEQ + n * 64;
        const float glast = __builtin_bit_cast(float, __builtin_amdgcn_readlane(__builtin_bit_cast(int, gl_all), n));
#pragma unroll
        for (int mt = 0; mt < 8; ++mt) { u32x2 p; p.x = pg8::cvt_pk_bf16(S[mt][0], S[mt][1]); p.y = pg8::cvt_pk_bf16(S[mt][2], S[mt][3]); *(LAS u32x2*)(SS + fr * 272 + (mt * 16 + quad * 4) * 2) = p; }
        LDS_FENCE();
        bf16x8 Sb[4];
#pragma unroll
        for (int kk = 0; kk < 4; ++kk) Sb[kk] = *(LAS bf16x8*)(SS + fr * 272 + (kk * 32 + quad * 8) * 2);
        f32x4 U[4], O[4];
#pragma unroll
        for (int mt = 0; mt < 4; ++mt) { f32x4 au, ao = {0.f, 0.f, 0.f, 0.f};
            { const u32x2 wq = *(LAS u32x2*)(Ws + vcol * 144 + (mt * 16 + quad * 4) * 2);
              au[0] = __uint_as_float(wq.x << 16); au[1] = __uint_as_float(wq.x & 0xffff0000u); au[2] = __uint_as_float(wq.y << 16); au[3] = __uint_as_float(wq.y & 0xffff0000u); }
#pragma unroll
            for (int kk = 0; kk < 4; ++kk) { const bf16x8 a1 = *(LAS bf16x8*)(KCs + (mt * 16 + fr) * 272 + (kk * 32 + quad * 8) * 2); au = mfma16(a1, Sb[kk], au);
                const bf16x8 a2 = *(LAS bf16x8*)(QDs + (mt * 16 + fr) * 272 + (kk * 32 + quad * 8) * 2); ao = mfma16(a2, Sb[kk], ao); }
            U[mt] = au; O[mt] = ao; __builtin_amdgcn_sched_barrier(0); }
#pragma unroll
        for (int mt = 0; mt < 4; ++mt) { u32x2 p; p.x = pg8::cvt_pk_bf16(U[mt][0], U[mt][1]); p.y = pg8::cvt_pk_bf16(U[mt][2], U[mt][3]); *(LAS u32x2*)(US + fr * 144 + (mt * 16 + quad * 4) * 2) = p; }
        LDS_FENCE();
        bf16x8 Ub[2];
#pragma unroll
        for (int kk = 0; kk < 2; ++kk) Ub[kk] = *(LAS bf16x8*)(US + fr * 144 + (kk * 32 + quad * 8) * 2);
#pragma unroll
        for (int mt = 0; mt < 4; ++mt)
#pragma unroll
            for (int kk = 0; kk < 2; ++kk) { const bf16x8 a = *(LAS bf16x8*)(QKs + (mt * 16 + fr) * 144 + (kk * 32 + quad * 8) * 2); O[mt] = mfma16(a, Ub[kk], O[mt]); }
        __builtin_amdgcn_sched_barrier(0);
#pragma unroll
        for (int mt = 0; mt < 8; ++mt) { S[mt] *= glast;
#pragma unroll
            for (int kk = 0; kk < 2; ++kk) { const bf16x8 a = *(LAS bf16x8*)(KDTs + (mt * 16 + fr) * 144 + (kk * 32 + quad * 8) * 2); S[mt] = mfma16(a, Ub[kk], S[mt]); }
            if (mt & 1) __builtin_amdgcn_sched_barrier(0); }
        { float pp[16];
#pragma unroll
          for (int e = 0; e < 16; ++e) pp[e] = O[e >> 2][e & 3] * O[e >> 2][e & 3];
#pragma unroll
          for (int st = 1; st < 16; st <<= 1) {
#pragma unroll
              for (int e = 0; e < 16; ++e) pp[e] += __shfl_xor(pp[e], st); }
          if (fr == 0) {
#pragma unroll
              for (int e = 0; e < 16; ++e) PART[((e >> 2) * 16 + quad * 4 + (e & 3)) * 8 + wave] = pp[e]; } }
        __syncthreads();
        if (n + 1 < 32 && !bnext1) { DS_STAGE(tid); if (n + 2 < 32 && !bnext2) DS_LOAD(it + 2, toff); }
        bf16_t* mixb = (bf16_t*)(A.ws + WS_MIX) + (size_t)tokb * D + h * 128;
#pragma unroll
        for (int mt = 0; mt < 4; ++mt)
#pragma unroll
            for (int i = 0; i < 4; ++i) { const int t = mt * 16 + quad * 4 + i;
                const f32x4 p0 = *(LAS f32x4*)(PART + t * 8), p1 = *(LAS f32x4*)(PART + t * 8 + 4);
                const float tot = ((p0[0] + p0[1]) + (p0[2] + p0[3])) + ((p1[0] + p1[1]) + (p1[2] + p1[3]));
                const float sc = rsqrtf(tot * (1.f / 128.f) + EPS);
                const float gs = bf2f(*(LAS bf16_t*)(GSs + t * 272 + vcol * 2));
                mixb[(unsigned)(t * D + vcol)] = (bf16_t)(pg8::cvt_pk_bf16(O[mt][i] * sc * gs, 0.f) & 0xffffu); }
        __syncthreads();
    }
#undef DS_STAGE
#undef DS_LOADG
#undef DS_STAGEG
#undef DS_LOAD
    { const int lane = lane_in, fr = lane & 15, quad = lane >> 4, vcol = 16 * wave + fr;
      float* dp = A.out + O_DP + (size_t)((l * 8 + b) * 4 + h) * 16384;
#pragma unroll
      for (int mt = 0; mt < 8; ++mt)
#pragma unroll
          for (int i = 0; i < 4; ++i) dp[(mt * 16 + quad * 4 + i) * 128 + vcol] = S[mt][i]; }
    __syncthreads();
}

__device__ __forceinline__ void delta_sample_item(const DevArgs& A, int l, LAS unsigned char* lds, int item, int tid, int wave, int lane) {
    const int b = item >> 2, h = item & 3, tokS = NP + b * 4;
    LAS float* RAW = (LAS float*)lds; LAS float* RED = RAW + 1536; LAS float* OB = RED + 512; LAS float* SC = OB + 512;
    const bf16_t* PROJ = (const bf16_t*)(A.ws + WS_PROJ); const float* AB = (const float*)(A.ws + WS_AB); bf16_t* MIX = (bf16_t*)(A.ws + WS_MIX);
    const float* cw = A.in[I_CONVW] + (size_t)l * 4 * 1536;
    for (int idx = tid; idx < 1536; idx += 512) { const int part = idx >> 9, t = (idx >> 7) & 3, c = idx & 127, col = part * 512 + h * 128 + c;
        float acc = 0.f;
#pragma unroll
        for (int j = 0; j < 4; ++j) { const int tt = t - 3 + j;
            const float x = (tt >= 0) ? bf2f(PROJ[(size_t)(tokS + tt) * NPROJ + col]) : A.in[I_SCONV][((size_t)(l * 128 + b) * 3 + (3 + tt)) * 1536 + col];
            acc += cw[j * 1536 + col] * x; }
        RAW[idx] = silu_f(acc); }
    if (tid < 4) { const float a = AB[(size_t)(tokS + tid) * 8 + h], bb = AB[(size_t)(tokS + tid) * 8 + 4 + h];
        const float xx = a + A.in[I_DTB][l * 4 + h]; const float sp = xx > 20.f ? xx : log1pf(expf(xx));
        SC[8 + tid] = 1.f / (1.f + expf(-bb)); SC[12 + tid] = expf(-expf(A.in[I_ALOG][l * 4 + h]) * sp); }
    const int v = tid & 127, kq = tid >> 7;
    float S[32];
    { const float* sp = A.in[I_SDELTA] + (size_t)((l * 128 + b) * 4 + h) * 16384;
#pragma unroll
      for (int i = 0; i < 32; ++i) S[i] = sp[(kq * 32 + i) * 128 + v]; }
    __syncthreads();
    { const int part = wave >> 2, t = wave & 3; const float x0 = RAW[part * 512 + t * 128 + lane], x1 = RAW[part * 512 + t * 128 + 64 + lane];
      const float ss = wave_sum(x0 * x0 + x1 * x1); if (lane == 0) SC[part * 4 + t] = rsqrtf(ss + EPS) * (part == 0 ? 0.08838834764831845f : 1.f); }
    __syncthreads();
    for (int t = 0; t < 4; ++t) {
        const float rq = SC[t], rk = SC[4 + t], beta = SC[8 + t], g = SC[12 + t];
        float pr = 0.f;
#pragma unroll
        for (int i = 0; i < 32; ++i) pr += S[i] * RAW[512 + t * 128 + kq * 32 + i];
        RED[kq * 128 + v] = pr * rk;
        __syncthreads();
        const float rr = (RED[v] + RED[128 + v]) + (RED[256 + v] + RED[384 + v]);
        const float u = beta * (RAW[1024 + t * 128 + v] - g * rr);
        float po = 0.f;
#pragma unroll
        for (int i = 0; i < 32; ++i) { const float kh = RAW[512 + t * 128 + kq * 32 + i] * rk; S[i] = g * S[i] + kh * u; po += S[i] * RAW[t * 128 + kq * 32 + i]; }
        __syncthreads();
        RED[kq * 128 + v] = po * rq;
        __syncthreads();
        if (kq == 0) OB[t * 128 + v] = (RED[v] + RED[128 + v]) + (RED[256 + v] + RED[384 + v]);
        __syncthreads();
    }
    if (wave < 4) { const int t = wave; const float x0 = OB[t * 128 + lane], x1 = OB[t * 128 + 64 + lane];
        const float ss = wave_sum(x0 * x0 + x1 * x1); const float sc = rsqrtf(ss * (1.f / 128.f) + EPS);
        const float g0 = bf2f(PROJ[(size_t)(tokS + t) * NPROJ + PC_G + h * 128 + lane]), g1 = bf2f(PROJ[(size_t)(tokS + t) * NPROJ + PC_G + h * 128 + 64 + lane]);
        MIX[(size_t)(tokS + t) * D + h * 128 + lane] = (bf16_t)f2bf(x0 * sc * A.in[I_ONORM][l * 128 + lane] * silu_f(g0));
        MIX[(size_t)(tokS + t) * D + h * 128 + 64 + lane] = (bf16_t)f2bf(x1 * sc * A.in[I_ONORM][l * 128 + 64 + lane] * silu_f(g1)); }
    { float* dsp = A.out + O_DS + (size_t)((l * 128 + b) * 4 + h) * 16384;
#pragma unroll
      for (int i = 0; i < 32; ++i) dsp[(kq * 32 + i) * 128 + v] = S[i]; }
    __syncthreads();
}

#define SSM_BCAST_U(t) do { unsigned _w[8]; \
        _w[0] = __builtin_amdgcn_readlane(ua.x, t); _w[1] = __builtin_amdgcn_readlane(ua.y, t); _w[2] = __builtin_amdgcn_readlane(ua.z, t); _w[3] = __builtin_amdgcn_readlane(ua.w, t); \
        _w[4] = __builtin_amdgcn_readlane(ub.x, t); _w[5] = __builtin_amdgcn_readlane(ub.y, t); _w[6] = __builtin_amdgcn_readlane(ub.z, t); _w[7] = __builtin_amdgcn_readlane(ub.w, t); \
        _Pragma("unroll") for (int _d = 0; _d < 8; ++_d) { uu[2 * _d] = __uint_as_float(_w[_d] << 16); uu[2 * _d + 1] = __uint_as_float(_w[_d] & 0xffff0000u); } } while (0)
#define SSM_STEP() do { float _br = 0.f, _bi = 0.f; \
        _Pragma("unroll") for (int _h = 0; _h < 16; ++_h) { _br = fmaf(Br[_h], uu[_h], _br); _bi = fmaf(Bi[_h], uu[_h], _bi); } \
        const float _nr = lr * hr - li * hi + _br, _ni = lr * hi + li * hr + _bi; hr = _nr; hi = _ni; } while (0)

__device__ __forceinline__ void ssm_part1_item(const DevArgs& A, int l, int it, int lane) {
    const int g = it & 15, bc = it >> 4, b = bc / 31, c = bc % 31;
    const float* bb = (const float*)(A.ws + WS_BBAR) + ((size_t)(l * 16 + g) * 64 + lane) * 32;
    float Br[16], Bi[16];
#pragma unroll
    for (int q = 0; q < 4; ++q) { const f32x4 x = ((const f32x4*)bb)[q], y = ((const f32x4*)bb)[4 + q];
        Br[4 * q] = x.x; Br[4 * q + 1] = x.y; Br[4 * q + 2] = x.z; Br[4 * q + 3] = x.w; Bi[4 * q] = y.x; Bi[4 * q + 1] = y.y; Bi[4 * q + 2] = y.z; Bi[4 * q + 3] = y.w; }
    const f32x4 lk = ((const f32x4*)(A.ws + WS_SSMK))[(l * 16 + g) * 64 + lane]; const float lr = lk.x, li = lk.y;
    const bf16_t* up = (const bf16_t*)(A.ws + WS_PROJ) + (size_t)(b * SEQ + c * 64 + lane) * NPROJ + PC_SSM + g * 16;
    const u32x4 ua = *(const u32x4*)up, ub = *(const u32x4*)(up + 8);
    float hr = 0.f, hi = 0.f, uu[16];
#pragma unroll 1
    for (int t = 0; t < 64; ++t) { SSM_BCAST_U(t); SSM_STEP(); }
    f32x2 e; e.x = hr; e.y = hi;
    ((f32x2*)(A.ws + WS_SSME))[((size_t)(b * 32 + c) * 16 + g) * 64 + lane] = e;
}

__device__ __forceinline__ void ssm_part2_item(const DevArgs& A, int l, LAS unsigned char* lds, int it, int tid, int wave, int lane) {
    const int tok0 = it * 64, fr = lane & 15, quad = lane >> 4;
    const bool samp = it >= 256; const int b = it >> 5, c = it & 31;
    LAS unsigned char* YS = lds; LAS unsigned char* HS = lds + 33792 + wave * 4352;
    const bf16_t* PROJ = (const bf16_t*)(A.ws + WS_PROJ); bf16_t* MIX = (bf16_t*)(A.ws + WS_MIX);
#pragma unroll 1
    for (int gi = 0; gi < 2; ++gi) {
        const int g = wave * 2 + gi;
        const float* bb = (const float*)(A.ws + WS_BBAR) + ((size_t)(l * 16 + g) * 64 + lane) * 32;
        float Br[16], Bi[16];
#pragma unroll
        for (int q = 0; q < 4; ++q) { const f32x4 x = ((const f32x4*)bb)[q], y = ((const f32x4*)bb)[4 + q];
            Br[4 * q] = x.x; Br[4 * q + 1] = x.y; Br[4 * q + 2] = x.z; Br[4 * q + 3] = x.w; Bi[4 * q] = y.x; Bi[4 * q + 1] = y.y; Bi[4 * q + 2] = y.z; Bi[4 * q + 3] = y.w; }
        const f32x4 lk = ((const f32x4*)(A.ws + WS_SSMK))[(l * 16 + g) * 64 + lane]; const float lr = lk.x, li = lk.y, Lr = lk.z, Li = lk.w;
        bf16x8 Cb[4];
#pragma unroll
        for (int kk = 0; kk < 4; ++kk) { const size_t co = ((size_t)(l * 16 + g) * 16 + fr) * 64 + kk * 16 + quad * 4;
            const f32x4 cr = *(const f32x4*)(A.in[I_CRE] + co), ci = *(const f32x4*)(A.in[I_CIM] + co);
            u32x4 pk; pk.x = pk2(cr.x, -ci.x); pk.y = pk2(cr.y, -ci.y); pk.z = pk2(cr.z, -ci.z); pk.w = pk2(cr.w, -ci.w);
            Cb[kk] = __builtin_bit_cast(bf16x8, pk); }
        const bf16_t* up = PROJ + (size_t)(tok0 + lane) * NPROJ + PC_SSM + g * 16;
        const u32x4 ua = *(const u32x4*)up, ub = *(const u32x4*)(up + 8);
        float hr = 0.f, hi = 0.f, uu[16];
        if (!samp && c > 0) { const f32x2* E = (const f32x2*)(A.ws + WS_SSME) + ((size_t)(b * 32) * 16 + g) * 64 + lane;
#pragma unroll
            for (int cb = 0; cb < 32; cb += 16) { f32x2 ev[16];
#pragma unroll
                for (int q = 0; q < 16; ++q) { const int cc = cb + q; ev[q] = (cc < c) ? E[(size_t)cc * 1024] : (f32x2){0.f, 0.f}; }
#pragma unroll
                for (int q = 0; q < 16; ++q) { const int cc = cb + q; if (cc < c) { const float nr = Lr * hr - Li * hi + ev[q].x, ni = Lr * hi + Li * hr + ev[q].y; hr = nr; hi = ni; } } } }
        const float dsk = A.in[I_SSMD][l * 256 + g * 16 + fr];
#pragma unroll 1
        for (int sub = 0; sub < 4; ++sub) {
#pragma unroll 1
            for (int tt = 0; tt < 16; ++tt) { const int t = sub * 16 + tt;
                const int sb = (it - 256) * 16 + (t >> 2);
                if (samp && (t & 3) == 0) { hr = A.in[I_SRE][((size_t)(l * 128 + sb) * 16 + g) * 64 + lane]; hi = A.in[I_SIM][((size_t)(l * 128 + sb) * 16 + g) * 64 + lane]; }
                SSM_BCAST_U(t); SSM_STEP();
                *(LAS unsigned*)(HS + tt * 272 + lane * 4) = pg8::cvt_pk_bf16(hr, hi);
                if (samp && (t & 3) == 3) { A.out[O_RES + ((size_t)(l * 128 + sb) * 16 + g) * 64 + lane] = hr; A.out[O_IMS + ((size_t)(l * 128 + sb) * 16 + g) * 64 + lane] = hi; }
            }
            LDS_FENCE();
            f32x4 acc = {0.f, 0.f, 0.f, 0.f};
#pragma unroll
            for (int kk = 0; kk < 4; ++kk) { const bf16x8 a = *(LAS bf16x8*)(HS + fr * 272 + (kk * 32 + quad * 8) * 2); acc = mfma16(a, Cb[kk], acc); }
#pragma unroll
            for (int i = 0; i < 4; ++i) { const int t = sub * 16 + quad * 4 + i; const float uv = bf2f(PROJ[(size_t)(tok0 + t) * NPROJ + PC_SSM + g * 16 + fr]);
                *(LAS bf16_t*)(YS + t * 528 + (g * 16 + fr) * 2) = (bf16_t)f2bf(gelu_tanh_f(acc[i] + dsk * uv)); }
            LDS_FENCE();
        }
        if (!samp && c == 31) { A.out[O_REP + ((size_t)(l * 8 + b) * 16 + g) * 64 + lane] = hr; A.out[O_IMP + ((size_t)(l * 8 + b) * 16 + g) * 64 + lane] = hi; }
    }
    __syncthreads();
    {
        const bf16_t* GT = (const bf16_t*)(A.ws + WS_GLUT + l * SZ_GLUT);
        f32x4 acc[4][2];
#pragma unroll
        for (int mt = 0; mt < 4; ++mt) { acc[mt][0] = (f32x4){0.f, 0.f, 0.f, 0.f}; acc[mt][1] = (f32x4){0.f, 0.f, 0.f, 0.f}; }
#pragma unroll
        for (int kk = 0; kk < 8; ++kk) { bf16x8 bfr[2];
#pragma unroll
            for (int nt = 0; nt < 2; ++nt) bfr[nt] = *(const bf16x8*)(GT + (size_t)(32 * wave + nt * 16 + fr) * 256 + kk * 32 + quad * 8);
#pragma unroll
            for (int mt = 0; mt < 4; ++mt) { const bf16x8 a = *(LAS bf16x8*)(YS + (mt * 16 + fr) * 528 + (kk * 32 + quad * 8) * 2);
                acc[mt][0] = mfma16(a, bfr[0], acc[mt][0]); acc[mt][1] = mfma16(a, bfr[1], acc[mt][1]); } }
#pragma unroll
        for (int nt = 0; nt < 2; ++nt) { const int ncol = 32 * wave + nt * 16 + fr; const float gb = A.in[I_GLUB][l * 256 + ncol];
#pragma unroll
            for (int mt = 0; mt < 4; ++mt)
#pragma unroll
                for (int i = 0; i < 4; ++i) { const int t = mt * 16 + quad * 4 + i; const float y = bf2f(*(LAS bf16_t*)(YS + t * 528 + ncol * 2));
                    MIX[(size_t)(tok0 + t) * D + 512 + ncol] = (bf16_t)f2bf(y * sigmoid_f(acc[mt][nt][i] + gb)); } }
    }
    __syncthreads();
}

__device__ __forceinline__ void pool_item(const DevArgs& A, int l, LAS unsigned char* lds, int it, int tid, int wave, int lane) {
    const int tok0 = it * 64, fr = lane & 15, quad = lane >> 4; const bool samp = it >= 256;
    LAS unsigned char* RS = lds;
    const bf16_t* PROJ = (const bf16_t*)(A.ws + WS_PROJ); bf16_t* MIX = (bf16_t*)(A.ws + WS_MIX);
    if (!samp) {
        LAS unsigned char* XT = lds + 33792;
        const int b = it >> 5, c = it & 31;
        for (int id = tid; id < 79 * 32; id += 512) { const int r = id >> 5, c16 = id & 31, tl = c * 64 - 15 + r;
            u32x4 v = {0u, 0u, 0u, 0u}; if (tl >= 0) v = *(const u32x4*)(PROJ + (size_t)(b * SEQ + tl) * NPROJ + PC_POOL + c16 * 8);
            *(LAS u32x4*)(XT + r * 528 + c16 * 16) = v; }
        __syncthreads();
        const int ch = tid & 255, half = tid >> 8, g = ch >> 6, w = 2 << g, r0 = half * 32;
        float sum = 0.f;
        for (int j = 0; j < w; ++j) sum += bf2f(*(LAS bf16_t*)(XT + (r0 + 15 - j) * 528 + ch * 2));
#pragma unroll 4
        for (int rr = 0; rr < 32; ++rr) { const int r = r0 + rr, tl = c * 64 + r;
            const float u = bf2f(*(LAS bf16_t*)(XT + (r + 15) * 528 + ch * 2));
            if (rr > 0) sum += u - bf2f(*(LAS bf16_t*)(XT + (r + 15 - w) * 528 + ch * 2));
            const float cnt = (float)((tl + 1 < w) ? tl + 1 : w);
            *(LAS bf16_t*)(RS + r * 528 + ch * 2) = (bf16_t)f2bf(sum / cnt - u); }
    } else {
#pragma unroll 1
        for (int pr = 0; pr < 8; ++pr) { const int idx = pr * 512 + tid, ch = idx & 255, sq = idx >> 8, g = ch >> 6, w = 2 << g;
            const int sb = (it - 256) * 16 + sq;
            const float* sbuf = A.in[I_SPOOL] + (size_t)(l * 128 + sb) * 15 * 256 + ch;
            const bf16_t* base = PROJ + (size_t)(NP + sb * 4) * NPROJ + PC_POOL + ch;
            float e[19];
#pragma unroll
            for (int j = 0; j < 15; ++j) e[j] = sbuf[j * 256];
#pragma unroll
            for (int j = 0; j < 4; ++j) e[15 + j] = bf2f(base[(size_t)j * NPROJ]);
#pragma unroll
            for (int t = 0; t < 4; ++t) { float sum = 0.f;
#pragma unroll
                for (int j = 0; j < 16; ++j) sum += (j < w) ? e[15 + t - j] : 0.f;
                *(LAS bf16_t*)(RS + (sq * 4 + t) * 528 + ch * 2) = (bf16_t)f2bf(sum / (float)w - e[15 + t]); } }
    }
    __syncthreads();
    { const int g2 = wave >> 1; const bf16_t* PT = (const bf16_t*)(A.ws + WS_POOLT + l * SZ_POOLT) + g2 * 4096;
      f32x4 acc[4][2];
#pragma unroll
      for (int mt = 0; mt < 4; ++mt) { acc[mt][0] = (f32x4){0.f, 0.f, 0.f, 0.f}; acc[mt][1] = (f32x4){0.f, 0.f, 0.f, 0.f}; }
#pragma unroll
      for (int kk = 0; kk < 2; ++kk) { bf16x8 bfr[2];
#pragma unroll
          for (int nt = 0; nt < 2; ++nt) bfr[nt] = *(const bf16x8*)(PT + (size_t)((wave & 1) * 32 + nt * 16 + fr) * 64 + kk * 32 + quad * 8);
#pragma unroll
          for (int mt = 0; mt < 4; ++mt) { const bf16x8 a = *(LAS bf16x8*)(RS + (mt * 16 + fr) * 528 + (g2 * 64 + kk * 32 + quad * 8) * 2);
              acc[mt][0] = mfma16(a, bfr[0], acc[mt][0]); acc[mt][1] = mfma16(a, bfr[1], acc[mt][1]); } }
#pragma unroll
      for (int nt = 0; nt < 2; ++nt) { const int col = 32 * wave + nt * 16 + fr; const float ps = A.in[I_POOLS][l * 256 + col];
#pragma unroll
          for (int mt = 0; mt < 4; ++mt)
#pragma unroll
              for (int i = 0; i < 4; ++i) { const int t = mt * 16 + quad * 4 + i; MIX[(size_t)(tok0 + t) * D + 768 + col] = (bf16_t)f2bf(acc[mt][nt][i] * ps); } } }
    __syncthreads();
}

__device__ __forceinline__ void state_copies(const DevArgs& A, int l, int gt, int NT) {
    const bf16_t* PROJ = (const bf16_t*)(A.ws + WS_PROJ);
#pragma unroll 1
    for (int i = gt; i < 8 * 3 * 1536; i += NT) { const int col = i % 1536, j = (i / 1536) % 3, b = i / 4608;
        A.out[O_CP + (size_t)l * 8 * 4608 + i] = bf2f(PROJ[(size_t)(b * SEQ + SEQ - 3 + j) * NPROJ + col]); }
#pragma unroll 1
    for (int i = gt; i < 128 * 3 * 1536; i += NT) { const int col = i % 1536, j = (i / 1536) % 3, b = i / 4608;
        A.out[O_CS + (size_t)l * 128 * 4608 + i] = bf2f(PROJ[(size_t)(NP + b * 4 + 1 + j) * NPROJ + col]); }
#pragma unroll 1
    for (int i = gt; i < 8 * 15 * 256; i += NT) { const int ch = i & 255, j = (i >> 8) % 15, b = i / 3840;
        A.out[O_PP + (size_t)l * 8 * 3840 + i] = bf2f(PROJ[(size_t)(b * SEQ + SEQ - 15 + j) * NPROJ + PC_POOL + ch]); }
#pragma unroll 1
    for (int i = gt; i < 128 * 15 * 256; i += NT) { const int ch = i & 255, j = (i >> 8) % 15, b = i / 3840;
        A.out[O_PS + (size_t)l * 128 * 3840 + i] = (j < 11) ? A.in[I_SPOOL][((size_t)(l * 128 + b) * 15 + 4 + j) * 256 + ch]
                                                             : bf2f(PROJ[(size_t)(NP + b * 4 + (j - 11)) * NPROJ + PC_POOL + ch]); }
}

#ifndef REP_DPREP
#define REP_DPREP 1
#endif
#ifndef REP_DSAMP
#define REP_DSAMP 1
#endif
#ifndef REP_SSM1
#define REP_SSM1 1
#endif
#ifndef REP_POOL
#define REP_POOL 1
#endif
#ifndef REP_DSCAN
#define REP_DSCAN 1
#endif
#ifndef REP_SSM2
#define REP_SSM2 1
#endif
#ifndef REP_G
#define REP_G 1
#endif
constexpr int NPH = 2 + DEPTH * 8;
__global__ void __launch_bounds__(512, 2) mega_fwd(Args KA) {
    DevArgs A; A.out = KA.out; A.ws = KA.ws; A.ph_lo = KA.ph_lo; A.ph_hi = KA.ph_hi;
    extern __shared__ __attribute__((aligned(16))) unsigned char lds_raw[];
    LAS unsigned char* lds = (LAS unsigned char*)lds_raw;
    cg::grid_group grid = cg::this_grid();
    volatile LAS unsigned* xst = (volatile LAS unsigned*)(lds + LDS_BYTES - 64);
    if (threadIdx.x == 0) { xst[0] = 0u; xst[1] = 0u; }
    __syncthreads();
    const XcdBarrier xb = xcd_barrier_post((unsigned*)(KA.ws + WS_BAR), xst);
    constexpr int G = 256, NGW = G * 8, NT = G * 512;
    int ph = 0;
#define PH_BEGIN if (A.ph_lo <= ph && ph < A.ph_hi) { int tid = threadIdx.x; asm volatile("" : "+v"(tid)); { unsigned char* _w = A.ws; asm volatile("" : "+s"(_w)); A.ws = _w; float* _o = A.out; asm volatile("" : "+s"(_o)); A.out = _o; } const int wave = __builtin_amdgcn_readfirstlane(tid >> 6), lane = tid & 63, gw = blockIdx.x * 8 + wave, gt = blockIdx.x * 512 + tid; (void)gw; (void)gt; (void)lane;
#define PH_END   if (ph + 1 < A.ph_hi) { if (ph == 0) grid.sync(); else xcd_barrier(xb); } } ++ph;
#define Hb   ((bf16_t*)(A.ws + WS_H))
#define AB   ((float*)(A.ws + WS_AB))
#define MIXO ((float*)(A.ws + WS_MIXO))
#define PROJ ((bf16_t*)(A.ws + WS_PROJ))
#define MIX  ((bf16_t*)(A.ws + WS_MIX))
#define HID  ((bf16_t*)(A.ws + WS_HID))

#ifndef REP_PRO
#define REP_PRO 1
#endif
#ifndef REP_N0
#define REP_N0 1
#endif
    PH_BEGIN for (int rep = 0; rep < REP_PRO; ++rep) { prologue(A, lds, wave, lane, gw, NGW); __syncthreads(); } PH_END
    PH_BEGIN for (int rep = 0; rep < REP_N0; ++rep) norm_rows(nullptr, nullptr, A.in[I_XP], A.in[I_XS], nullptr, A.in[I_NMPRE], Hb, (const float*)(A.ws + WS_WAB), AB, gw, NGW, lane); PH_END

#pragma unroll 1
    for (int l = 0; l < DEPTH; ++l) {
        PH_BEGIN for (int rep = 0; rep < REP_G; ++rep) { pg8::Gemm g{Hb, (const bf16_t*)(A.ws + WS_WIN + l * SZ_WIN), NTOK, NPROJ, D}; pg8::StaticOrder S; S.init(NTOK, NPROJ, G, (int)blockIdx.x);
            pg8::EpiBf16<0> E{PROJ, NPROJ, nullptr, 0, 0}; pg8::gemm_phase<pg8::EpiBf16<0>, pg8::StaticOrder>(lds, g, S, E, nullptr); } PH_END
        constexpr int SUBC = 7;
        PH_BEGIN {
#pragma unroll 1
            for (int j = blockIdx.x; j < 32 * SUBC; j += G) delta_prep_item(A, l, lds, (j & 31) * 32 + (j >> 5), tid, wave, lane);
#pragma unroll 1
            for (int it = blockIdx.x; it < 512; it += G) delta_sample_item(A, l, lds, it, tid, wave, lane);
#pragma unroll 1
            for (int it = gw; it < 8 * 31 * 16; it += NGW) ssm_part1_item(A, l, it, lane);
#pragma unroll 1
            for (int it = blockIdx.x; it < 264; it += G) pool_item(A, l, lds, it, tid, wave, lane);
            state_copies(A, l, gt, NT);
        } PH_END
        PH_BEGIN {
            {
                if (blockIdx.x < 32) delta_scan_item(A, l, lds, blockIdx.x, tid, wave, lane, xb, SUBC);
                else { const int w = blockIdx.x - 32; constexpr int NW = G - 32;
#pragma unroll 1
                    for (int k = 1; k <= 5; ++k) {
                        const int n0 = k * SUBC, nn = (n0 >= 32) ? 0 : ((32 - n0 < SUBC) ? 32 - n0 : SUBC);
                        int nprep = 32 * nn;
#pragma unroll 1
                        for (int j = w; j < nprep; j += NW) delta_prep_item(A, l, lds, (j & 31) * 32 + n0 + (j >> 5), tid, wave, lane);
                        { const int it = (k == 4) ? w - 128 : ((k == 5) ? 96 + w : -1);
                          if (it >= 0 && it < ((k == 4) ? 96 : 264)) ssm_part2_item(A, l, lds, it, tid, wave, lane); }
                        if (k < 5) xcd_barrier(xb);
                    } }
            }
        } PH_END
        PH_BEGIN for (int rep = 0; rep < REP_G; ++rep) { pg8::Gemm g{MIX, (const bf16_t*)(A.ws + WS_WOUT + l * SZ_WOUT), NTOK, D, D}; pg8::StaticOrder S; S.init(NTOK, D, G, (int)blockIdx.x);
            pg8::EpiF32 E{MIXO, D, nullptr}; pg8::gemm_phase<pg8::EpiF32, pg8::StaticOrder>(lds, g, S, E, nullptr); } PH_END
#ifndef REP_N5
#define REP_N5 1
#endif
        PH_BEGIN for (int rep = 0; rep < (l == 0 ? REP_N5 : 1); ++rep) norm_rows(MIXO, A.in[I_NMPOST] + l * D, l == 0 ? A.in[I_XP] : A.out, l == 0 ? A.in[I_XS] : nullptr, A.out, A.in[I_NFPRE] + l * D, Hb, nullptr, nullptr, gw, NGW, lane); PH_END
        PH_BEGIN for (int rep = 0; rep < REP_G; ++rep) { pg8::Gemm g{Hb, (const bf16_t*)(A.ws + WS_WGU + l * SZ_WGU), NTOK, NGU, D}; pg8::StaticOrder S; S.init(NTOK, NGU, G, (int)blockIdx.x);
            EpiSwiGLU E{HID, DFF}; pg8::gemm_phase<EpiSwiGLU, pg8::StaticOrder>(lds, g, S, E, nullptr); } PH_END
        PH_BEGIN for (int rep = 0; rep < REP_G; ++rep) { pg8::Gemm g{HID, (const bf16_t*)(A.ws + WS_WDN + l * SZ_WDN), NTOK, D, DFF}; pg8::StaticOrder S; S.init(NTOK, D, G, (int)blockIdx.x);
            pg8::EpiF32 E{MIXO, D, nullptr}; pg8::gemm_phase<pg8::EpiF32, pg8::StaticOrder>(lds, g, S, E, nullptr); } PH_END
        PH_BEGIN norm_rows(MIXO, A.in[I_NFPOST] + l * D, A.out, nullptr, A.out, l + 1 < DEPTH ? A.in[I_NMPRE] + (l + 1) * D : nullptr, l + 1 < DEPTH ? Hb : nullptr,
                           l + 1 < DEPTH ? (const float*)(A.ws + WS_WAB + (l + 1) * SZ_WAB) : nullptr, AB, gw, NGW, lane); PH_END
    }
#undef PH_BEGIN
#undef PH_END
#undef Hb
#undef AB
#undef MIXO
#undef PROJ
#undef MIX
#undef HID
}

extern "C" void kernel_launch(void* const* d_in, const int* in_sizes, int n_in, void* d_out, int out_size, void* d_ws, size_t ws_size, hipStream_t stream) {
    static int grid = 0;
    if (grid == 0) {
        if (n_in != 32 || (size_t)out_size != O_END || ws_size < WS_END) fprintf(stderr, "kernel_launch: unexpected sizes: n_in %d out %d (want %zu) ws %zu (want >= %zu)\n", n_in, out_size, (size_t)O_END, ws_size, (size_t)WS_END);
        int dev = 0, cus = 0, per_cu = 0;
        (void)hipGetDevice(&dev); (void)hipDeviceGetAttribute(&cus, hipDeviceAttributeMultiprocessorCount, dev);
        if (hipFuncSetAttribute((const void*)mega_fwd, hipFuncAttributeMaxDynamicSharedMemorySize, LDS_BYTES) != hipSuccess) fprintf(stderr, "kernel_launch: hipFuncSetAttribute failed\n");
        if (hipOccupancyMaxActiveBlocksPerMultiprocessor(&per_cu, (const void*)mega_fwd, 512, LDS_BYTES) != hipSuccess || per_cu < 1) { fprintf(stderr, "kernel_launch: occupancy query gave %d\n", per_cu); per_cu = 1; (void)hipGetLastError(); }
        grid = cus * per_cu; if (grid <= 0) grid = 256;
        if (grid >= 256) grid = 256;
        fprintf(stderr, "kernel_launch: grid %d (cus %d x %d)%s\n", grid, cus, per_cu, grid < 256 ? "  ERROR: this build needs >= 256 co-resident workgroups" : "");
    }
    (void)hipMemsetAsync((unsigned char*)d_ws + WS_BAR, 0, 16384, stream);
    Args a{};
    for (int i = 0; i < 32; ++i) a.in[i] = (const float*)d_in[i];
    a.out = (float*)d_out; a.ws = (unsigned char*)d_ws;
#if MK_COOP
    a.ph_lo = 0; a.ph_hi = NPH;
    void* args[] = {&a};
    const hipError_t e = hipLaunchCooperativeKernel((const void*)mega_fwd, dim3(grid), dim3(512), args, LDS_BYTES, stream);
    if (e != hipSuccess) fprintf(stderr, "kernel_launch: cooperative launch failed: %s (grid %d)\n", hipGetErrorString(e), grid);
#else
    for (int p = 0; p < NPH; ++p) { a.ph_lo = p; a.ph_hi = p + 1; hipLaunchKernelGGL(mega_fwd, dim3(grid), dim3(512), LDS_BYTES, stream, a); }
#endif
}
```

```cpp
#include <hip/hip_runtime.h>
#include <hip/hip_cooperative_groups.h>
#include <cstdio>
#include <cstdint>
namespace cg = cooperative_groups;
#ifndef MK_COOP
#define MK_COOP 1
#endif
namespace pg8 {
#define PG8_LAS __attribute__((address_space(3)))
typedef unsigned short bf16_t;
typedef short bf16x8 __attribute__((ext_vector_type(8)));
typedef float f32x4 __attribute__((ext_vector_type(4)));
typedef unsigned u32x4 __attribute__((ext_vector_type(4)));
constexpr int BM = 256, BK = 64, HALF = 128, HTB = HALF * BK * 2  , STAGE_BYTES = 8 * HTB, NXCD = 8, WGM = 8;

__host__ __device__ __forceinline__ int lds_byte(int r, int c) { const int st = (r >> 4) * 2 + (c >> 5), rr = r & 15, cc = c & 31, ob = rr * 64 + cc * 2; return st * 1024 + (ob ^ (((ob >> 9) & 1) << 5)); }
__host__ __device__ __forceinline__ void stage_rc(int b, int& R, int& C) { const int st = b / 1024, sb = b % 1024, swz = sb ^ (((sb >> 9) & 1) << 5); R = (st >> 1) * 16 + swz / 64; C = (st & 1) * 32 + (swz % 64) / 2; }
__host__ __device__ __forceinline__ int perm32(int rho) { const int n = rho >> 4, i = rho & 15; return 8 * (i >> 2) + 4 * n + (i & 3); }

struct Unit { int pm, pn, ks; };
struct Gemm { const bf16_t* A; const bf16_t* Bt; int M, N, K, lda, ldb; };

struct StaticOrder {
    int nM, nN, nwg, G, c;
    __host__ __device__ void init(int M, int N, int G_, int c_) { nM = M / BM; nN = N / BM; nwg = nM * nN; G = G_; c = c_; }
    __host__ __device__ bool next(int i, Unit& u) const {
        const long L = (long)i * G + c; if (L >= nwg) return false;
        int wgid = (int)L; { const int q = nwg / NXCD, r = nwg % NXCD, xcd = wgid % NXCD, off = wgid / NXCD; wgid = (xcd < r ? xcd * (q + 1) : r * (q + 1) + (xcd - r) * q) + off; }
        const int nig = WGM * nN, gid = wgid / nig, fm = gid * WGM, gsz = (nM - fm) < WGM ? (nM - fm) : WGM;
        u.pm = fm + ((wgid % nig) % gsz); u.pn = (wgid % nig) / gsz; u.ks = 0; return true;
    }
    __device__ __forceinline__ void a_ready(const Unit&) const {}
    __device__ __forceinline__ void done(const Unit&) const {}
};
__device__ __forceinline__ unsigned cvt_pk_bf16(float lo, float hi) { unsigned r; asm volatile("v_cvt_pk_bf16_f32 %0, %1, %2" : "=v"(r) : "v"(lo), "v"(hi)); return r; }
typedef float f32x2 __attribute__((ext_vector_type(2)));
__device__ __forceinline__ f32x2 gelu_pk(f32x2 v) {
    const f32x2 av = __builtin_elementwise_abs(v), d = av * 0.2316418882f + 1.0f;
    f32x2 t; t.x = __builtin_amdgcn_rcpf(d.x); t.y = __builtin_amdgcn_rcpf(d.y);
    f32x2 q = t * 0.5307027145f + (-0.7265760135f); q = q * t + 0.7107068705f; q = q * t + (-0.142248368f); q = q * t + 0.127414796f; q = q * t;
    const f32x2 s = (v * v) * (-0.72134752044f);
    f32x2 e; e.x = __builtin_amdgcn_exp2f(s.x); e.y = __builtin_amdgcn_exp2f(s.y);
    const f32x2 m = v * (q * e), r = v - m;
    f32x2 o; o.x = v.x < 0.f ? m.x : r.x; o.y = v.y < 0.f ? m.y : r.y; return o;
}

struct EpiF32 {
    static constexpr bool PERM = false, AFTER_DRAIN = false;
    float* C; int ldc; const float* bias;
    __device__ __forceinline__ void operator()(const f32x4 (&acc)[2][2][4][2], const Unit& u, int wr, int wc, int fr, int fq) const {
        const int row0 = u.pm * BM + wr * 64 + fr, col0 = u.pn * BM + wc * 32 + 4 * fq;
        f32x4 bv[2][2];
#pragma unroll
        for (int bj = 0; bj < 2; ++bj)
#pragma unroll
            for (int n = 0; n < 2; ++n) bv[bj][n] = bias ? *(const f32x4*)(bias + col0 + bj * HALF + n * 16) : (f32x4){0.f, 0.f, 0.f, 0.f};
#pragma unroll
        for (int ai = 0; ai < 2; ++ai)
#pragma unroll
            for (int m = 0; m < 4; ++m) { float* rowp = C + (size_t)(row0 + ai * HALF + m * 16) * ldc + col0;
#pragma unroll
                for (int bj = 0; bj < 2; ++bj)
#pragma unroll
                    for (int n = 0; n < 2; ++n) *(f32x4*)(rowp + bj * HALF + n * 16) = acc[ai][bj][m][n] + bv[bj][n]; }
    }
};
template <int ACT  > struct EpiBf16 {
    static constexpr bool PERM = true, AFTER_DRAIN = false;
    bf16_t* O; int ldc; const float* bias; int split_cols; size_t split_stride;
    __device__ __forceinline__ void operator()(const f32x4 (&acc)[2][2][4][2], const Unit& u, int wr, int wc, int fr, int fq) const {
        const int row0 = u.pm * BM + wr * 64 + fr; int colt = u.pn * BM; bf16_t* base = O;
        if (split_cols) { const int t = colt / split_cols; base += (size_t)t * split_stride; colt -= t * split_cols; }
        const int col0 = colt + wc * 32 + 8 * fq, bcol0 = u.pn * BM + wc * 32 + 8 * fq;
        f32x4 bv[2][2];
#pragma unroll
        for (int bj = 0; bj < 2; ++bj)
#pragma unroll
            for (int n = 0; n < 2; ++n) bv[bj][n] = bias ? *(const f32x4*)(bias + bcol0 + bj * HALF + 4 * n) : (f32x4){0.f, 0.f, 0.f, 0.f};
#pragma unroll
        for (int ai = 0; ai < 2; ++ai)
#pragma unroll
            for (int m = 0; m < 4; ++m) { bf16_t* rowp = base + (size_t)(row0 + ai * HALF + m * 16) * ldc + col0;
#pragma unroll
                for (int bj = 0; bj < 2; ++bj) { f32x4 v0 = acc[ai][bj][m][0] + bv[bj][0], v1 = acc[ai][bj][m][1] + bv[bj][1];
                    if (ACT == 1) { f32x2 a = gelu_pk((f32x2){v0[0], v0[1]}), b = gelu_pk((f32x2){v0[2], v0[3]}), c = gelu_pk((f32x2){v1[0], v1[1]}), d = gelu_pk((f32x2){v1[2], v1[3]});
                        v0 = (f32x4){a.x, a.y, b.x, b.y}; v1 = (f32x4){c.x, c.y, d.x, d.y}; }
                    if (ACT == 2) {
#pragma unroll
                        for (int j = 0; j < 4; ++j) { v0[j] = 0.5f * v0[j] * (1.0f + erff(v0[j] * 0.70710678f)); v1[j] = 0.5f * v1[j] * (1.0f + erff(v1[j] * 0.70710678f)); } }
                    u32x4 w; w.x = cvt_pk_bf16(v0[0], v0[1]); w.y = cvt_pk_bf16(v0[2], v0[3]); w.z = cvt_pk_bf16(v1[0], v1[1]); w.w = cvt_pk_bf16(v1[2], v1[3]);
                    *(u32x4*)(rowp + bj * HALF) = w; } }
    }
};
template <class Epi, class Sched, bool STAMP = false>
__device__ __forceinline__ void gemm_phase(PG8_LAS unsigned char* lds, const Gemm g, const Sched& S, const Epi& E, unsigned long long* stamps) {
    int tid_ = threadIdx.x; asm volatile("" : "+v"(tid_));
    const int tid = tid_, wid = __builtin_amdgcn_readfirstlane(tid >> 6), lane = tid & 63, wr = wid >> 2, wc = wid & 3, fr = lane & 15, fq = lane >> 4;
    const int K = g.K, nt = K / BK;
    int ts_lo = 0, ts_hi = 0, nts = 0; const unsigned long long rt_entry = STAMP ? (unsigned long long)wall_clock64() : 0ull;
#define PG8_STAMP() do { if (STAMP && wid == 0 && nts < 64) { const unsigned long long _c = (unsigned long long)clock64(); \
        ts_lo = (lane == nts) ? (int)(unsigned)_c : ts_lo; ts_hi = (lane == nts) ? (int)(unsigned)(_c >> 32) : ts_hi; ++nts; } } while (0)
    PG8_STAMP();
    unsigned voffA[2], voffB[2];
#pragma unroll
    for (int i = 0; i < 2; ++i) { int R, C; stage_rc(tid * 16 + i * 8192, R, C); const int Rb = Epi::PERM ? ((R & ~31) + perm32(R & 31)) : R;
        voffA[i] = (unsigned)(R * g.lda + C) * 2u; voffB[i] = (unsigned)(Rb * g.ldb + C) * 2u; }
    const size_t kstep = (size_t)(BK * 2);
    const size_t hstepA = (size_t)HALF * g.lda * 2, hstepB = (size_t)HALF * g.ldb * 2;
    const size_t tstepA = 2 * hstepA, tstepB = 2 * hstepB, sstep = (size_t)K * 2;
    const unsigned ldsw = (unsigned)wid * 1024u;
    const int aoff = lds_byte(wr * 64 + fr, fq * 8), boff = lds_byte(wc * 32 + fr, fq * 8);
#define PG8_SA(b, h) (((b) * 2 + (h)) * HTB)
#define PG8_SB(b, h) ((4 + (b) * 2 + (h)) * HTB)
#define PG8_STAGE(bufoff, gbase, voff) do { _Pragma("unroll") for (int _i = 0; _i < 2; ++_i) \
        __builtin_amdgcn_global_load_lds((const unsigned*)((const char*)(gbase) + (voff)[_i]), (PG8_LAS unsigned*)(lds + (bufoff) + ldsw + _i * 8192), 16, 0, 0); } while (0)
#define PG8_LDA(dst, b, h) do { _Pragma("unroll") for (int m = 0; m < 4; ++m) _Pragma("unroll") for (int k = 0; k < 2; ++k) dst[m][k] = *(const PG8_LAS bf16x8*)(lds + PG8_SA(b, h) + aoff + m * 2048 + k * 1024); } while (0)
#define PG8_LDB(dst, b, h) do { _Pragma("unroll") for (int n = 0; n < 2; ++n) _Pragma("unroll") for (int k = 0; k < 2; ++k) dst[n][k] = *(const PG8_LAS bf16x8*)(lds + PG8_SB(b, h) + boff + n * 2048 + k * 1024); } while (0)
#define PG8_MMA(ai, bj, At, Bt) do { __builtin_amdgcn_s_setprio(1); _Pragma("unroll") for (int m = 0; m < 4; ++m) _Pragma("unroll") for (int n = 0; n < 2; ++n) _Pragma("unroll") for (int k = 0; k < 2; ++k) \
        acc[ai][bj][m][n] = __builtin_amdgcn_mfma_f32_16x16x32_bf16(Bt[n][k], At[m][k], acc[ai][bj][m][n], 0, 0, 0); __builtin_amdgcn_s_setprio(0); } while (0)
#define PG8_WAIT_V(n) asm volatile("s_waitcnt vmcnt(" #n ")" ::: "memory")
#define PG8_WAIT_L(n) asm volatile("s_waitcnt lgkmcnt(" #n ")" ::: "memory")
#define PG8_BAR __builtin_amdgcn_s_barrier()
#define PG8_SCHED __builtin_amdgcn_sched_barrier(0)
    Unit cur, nxt; int ui = 0;
    if (!S.next(0, cur)) return;
    f32x4 acc[2][2][4][2];
#pragma unroll
    for (int a = 0; a < 2; ++a)
#pragma unroll
        for (int b = 0; b < 2; ++b)
#pragma unroll
            for (int m = 0; m < 4; ++m)
#pragma unroll
                for (int n = 0; n < 2; ++n) acc[a][b][m][n] = (f32x4){0.f, 0.f, 0.f, 0.f};
    bf16x8 At[4][2], B0[2][2], B1[2][2];
    const char* cA = (const char*)g.A + (size_t)cur.pm * tstepA + (size_t)cur.ks * sstep; const char* cB = (const char*)g.Bt + (size_t)cur.pn * tstepB + (size_t)cur.ks * sstep;
    S.a_ready(cur);
    PG8_STAGE(PG8_SB(0, 0), cB, voffB); PG8_STAGE(PG8_SA(0, 0), cA, voffA); PG8_STAGE(PG8_SB(0, 1), cB + hstepB, voffB); PG8_STAGE(PG8_SA(0, 1), cA + hstepA, voffA);
    if (wr == 1) PG8_BAR;
    PG8_WAIT_V(4); PG8_BAR;
    PG8_STAGE(PG8_SB(1, 0), cB + kstep, voffB); PG8_STAGE(PG8_SA(1, 0), cA + kstep, voffA); PG8_STAGE(PG8_SB(1, 1), cB + hstepB + kstep, voffB);
    PG8_WAIT_V(6); PG8_BAR;
    PG8_STAMP();
    for (;;) {
        const bool has_next = S.next(ui + 1, nxt);
        const char* nA = has_next ? (const char*)g.A + (size_t)nxt.pm * tstepA + (size_t)nxt.ks * sstep : cA; const char* nB = has_next ? (const char*)g.Bt + (size_t)nxt.pn * tstepB + (size_t)nxt.ks * sstep : cB;
        for (int t = 0; t < nt; t += 2) {
            const bool last = (t == nt - 2);
            const char* a1 = cA + (size_t)(t + 1) * kstep;
            const char* a2 = last ? nA : cA + (size_t)(t + 2) * kstep; const char* b2 = last ? nB : cB + (size_t)(t + 2) * kstep;
            const char* a3 = a2 + kstep; const char* b3 = b2 + kstep;
            if (last && has_next) S.a_ready(nxt);
            PG8_LDB(B0, 0, 0); PG8_SCHED; PG8_LDA(At, 0, 0); PG8_STAGE(PG8_SA(1, 1), a1 + hstepA, voffA);
            PG8_WAIT_L(8); PG8_BAR; PG8_WAIT_L(0); PG8_MMA(0, 0, At, B0); PG8_BAR; PG8_SCHED;
            PG8_LDB(B1, 0, 1); PG8_STAGE(PG8_SB(0, 0), b2, voffB);
            PG8_BAR; PG8_WAIT_L(0); PG8_MMA(0, 1, At, B1); PG8_BAR;
            PG8_LDA(At, 0, 1); PG8_STAGE(PG8_SA(0, 0), a2, voffA);
            PG8_BAR; PG8_WAIT_L(0); PG8_MMA(1, 0, At, B0); PG8_BAR; PG8_SCHED;
            PG8_STAGE(PG8_SB(0, 1), b2 + hstepB, voffB);
            PG8_WAIT_V(6); PG8_BAR; PG8_MMA(1, 1, At, B1); PG8_BAR;
            PG8_LDB(B0, 1, 0); PG8_SCHED; PG8_LDA(At, 1, 0); PG8_STAGE(PG8_SA(0, 1), a2 + hstepA, voffA);
            PG8_WAIT_L(8); PG8_BAR; PG8_WAIT_L(0); PG8_MMA(0, 0, At, B0); PG8_BAR; PG8_SCHED;
            PG8_LDB(B1, 1, 1); PG8_STAGE(PG8_SB(1, 0), b3, voffB);
            PG8_BAR; PG8_WAIT_L(0); PG8_MMA(0, 1, At, B1); PG8_BAR;
            PG8_LDA(At, 1, 1); PG8_STAGE(PG8_SA(1, 0), a3, voffA);
            PG8_BAR; PG8_WAIT_L(0); PG8_MMA(1, 0, At, B0); PG8_BAR; PG8_SCHED;
            PG8_STAGE(PG8_SB(1, 1), b3 + hstepB, voffB);
            PG8_WAIT_V(6); PG8_BAR; PG8_MMA(1, 1, At, B1); PG8_BAR;
        }
        PG8_STAMP();
        if constexpr (!Epi::AFTER_DRAIN) { E(acc, cur, wr, wc, fr, fq); S.done(cur); }
        PG8_STAMP();
        if (!has_next) break;
#pragma unroll
        for (int a = 0; a < 2; ++a)
#pragma unroll
            for (int b = 0; b < 2; ++b)
#pragma unroll
                for (int m = 0; m < 4; ++m)
#pragma unroll
                    for (int n = 0; n < 2; ++n) acc[a][b][m][n] = (f32x4){0.f, 0.f, 0.f, 0.f};
        cur = nxt; cA = nA; cB = nB; ++ui;
    }
    PG8_WAIT_V(0);
    if (wr == 0) PG8_BAR;
    PG8_BAR;
    if constexpr (Epi::AFTER_DRAIN) { E.fused(acc, cur, wr, wc, fr, fq, lds, wid, lane); S.done(cur); }
    PG8_STAMP();
    if (STAMP && wid == 0) { stamps[lane] = lane < nts ? (((unsigned long long)(unsigned)ts_hi << 32) | (unsigned)ts_lo) : 0ull;
        if (lane == 62) stamps[62] = rt_entry; if (lane == 63) stamps[63] = (unsigned long long)wall_clock64(); }
#undef PG8_STAMP
#undef PG8_SA
#undef PG8_SB
#undef PG8_STAGE
#undef PG8_LDA
#undef PG8_LDB
#undef PG8_MMA
#undef PG8_WAIT_V
#undef PG8_WAIT_L
#undef PG8_BAR
#undef PG8_SCHED
}
}

#define LAS __attribute__((address_space(3)))
typedef unsigned short bf16_t;
typedef short bf16x8 __attribute__((ext_vector_type(8)));
typedef float f32x4 __attribute__((ext_vector_type(4)));
typedef float f32x2 __attribute__((ext_vector_type(2)));
typedef unsigned u32x4 __attribute__((ext_vector_type(4)));
typedef unsigned u32x2 __attribute__((ext_vector_type(2)));

constexpr int D = 1024, NP = 16384, NS = 512, NTOK = NP + NS, SEQ = 2048, NB = 8, NSB = 128, DEPTH = 4;
constexpr int INW = 2568, NPROJ = 2560, DFF = 2816, NGU = 5632;
constexpr int PC_G = 1536, PC_SSM = 2048, PC_POOL = 2304;
constexpr float EPS = 1e-6f;
constexpr int LDS_BYTES = 163840;

constexpr size_t SZ_WIN = (size_t)NPROJ * D * 2, SZ_WOUT = (size_t)D * D * 2, SZ_WGU = (size_t)NGU * D * 2, SZ_WDN = (size_t)D * DFF * 2;
constexpr size_t SZ_WAB = 8 * D * 4, SZ_GLUT = 256 * 256 * 2, SZ_POOLT = 4 * 64 * 64 * 2, SZ_SSMK = 16 * 64 * 4 * 4, SZ_BBAR = 16 * 64 * 32 * 4;
constexpr size_t WS_WIN = 0;
constexpr size_t WS_WOUT = WS_WIN + DEPTH * SZ_WIN;
constexpr size_t WS_WGU = WS_WOUT + DEPTH * SZ_WOUT;
constexpr size_t WS_WDN = WS_WGU + DEPTH * SZ_WGU;
constexpr size_t WS_WAB = WS_WDN + DEPTH * SZ_WDN;
constexpr size_t WS_GLUT = WS_WAB + DEPTH * SZ_WAB;
constexpr size_t WS_POOLT = WS_GLUT + DEPTH * SZ_GLUT;
constexpr size_t WS_SSMK = WS_POOLT + DEPTH * SZ_POOLT;
constexpr size_t WS_BBAR = WS_SSMK + DEPTH * SZ_SSMK;
constexpr size_t WS_H = WS_BBAR + DEPTH * SZ_BBAR;
constexpr size_t WS_AB = WS_H + (size_t)NTOK * D * 2;
constexpr size_t WS_MIX = WS_AB + (size_t)NTOK * 8 * 4;
constexpr size_t WS_MIXO = WS_MIX + (size_t)NTOK * D * 2;
constexpr size_t WS_SSME = WS_MIXO + (size_t)NTOK * D * 4;
constexpr size_t WS_PROJ = WS_SSME + (size_t)8 * 32 * 16 * 64 * 2 * 4;
constexpr size_t WS_DW = WS_PROJ + (size_t)NTOK * NPROJ * 2;
constexpr size_t WS_DKC = WS_DW + (size_t)1024 * 8192 * 4;
constexpr size_t WS_DQD = WS_DKC + (size_t)1024 * 8192 * 2;
constexpr size_t WS_DQK = WS_DQD + (size_t)1024 * 8192 * 2;
constexpr size_t WS_DKT = WS_DQK + (size_t)1024 * 4096 * 2;
constexpr size_t WS_DGL = WS_DKT + (size_t)1024 * 8192 * 2;
constexpr size_t WS_DGS = WS_DGL + 4096;
constexpr size_t WS_BAR = WS_DGS + (size_t)1024 * 8192 * 2;
constexpr size_t WS_PARTS = WS_BAR + 16384;
constexpr size_t WS_END = WS_PARTS + (size_t)11 * 512 * 1024 * 4;
constexpr size_t WS_HID = WS_PROJ;
static_assert(WS_HID + (size_t)NTOK * DFF * 2 <= WS_END, "HID overlay");
static_assert(WS_H % 256 == 0 && WS_PROJ % 256 == 0 && WS_DW % 256 == 0, "align");

constexpr size_t O_YP = 0, O_YS = O_YP + (size_t)NP * D, O_DP = O_YS + (size_t)NS * D, O_CP = O_DP + (size_t)DEPTH * 8 * 4 * 16384,
                 O_REP = O_CP + (size_t)DEPTH * 8 * 3 * 1536, O_IMP = O_REP + (size_t)DEPTH * 8 * 1024, O_PP = O_IMP + (size_t)DEPTH * 8 * 1024,
                 O_DS = O_PP + (size_t)DEPTH * 8 * 15 * 256, O_CS = O_DS + (size_t)DEPTH * 128 * 4 * 16384, O_RES = O_CS + (size_t)DEPTH * 128 * 3 * 1536,
                 O_IMS = O_RES + (size_t)DEPTH * 128 * 1024, O_PS = O_IMS + (size_t)DEPTH * 128 * 1024, O_END = O_PS + (size_t)DEPTH * 128 * 15 * 256;

struct Args { const float* in[32]; float* out; unsigned char* ws; int ph_lo, ph_hi; };
typedef const float* cfp_t;
typedef __attribute__((address_space(4))) const unsigned char* kptr_t;
struct InProxy { __device__ __forceinline__ const float* operator[](int i) const {
    kptr_t p = (kptr_t)__builtin_amdgcn_kernarg_segment_ptr(); asm volatile("" : "+s"(p)); return *(__attribute__((address_space(4))) const cfp_t*)(p + 8 * i); } };
struct DevArgs { InProxy in; float* out; unsigned char* ws; int ph_lo, ph_hi; };
enum { I_XP = 0, I_XS, I_SDELTA, I_SCONV, I_SRE, I_SIM, I_SPOOL, I_NMPRE, I_NMPOST, I_NFPRE, I_NFPOST, I_WIN, I_CONVW, I_ALOG, I_DTB, I_ONORM,
       I_ARE, I_AIM, I_LOGDT, I_BRE, I_BIM, I_CRE, I_CIM, I_SSMD, I_GLUW, I_GLUB, I_POOLW, I_POOLS, I_WOUT, I_WG, I_WU, I_WD };

__device__ __forceinline__ unsigned f2bf(float f) { unsigned u = __float_as_uint(f); return (u + 0x7fffu + ((u >> 16) & 1u)) >> 16; }
__device__ __forceinline__ float bf2f(unsigned b) { return __uint_as_float(b << 16); }
__device__ __forceinline__ unsigned pk2(float lo, float hi) { return f2bf(lo) | (f2bf(hi) << 16); }
__device__ __forceinline__ float wave_sum(float v) {
#pragma unroll
    for (int o = 1; o < 64; o <<= 1) v += __shfl_xor(v, o);
    return v;
}
__device__ __forceinline__ float silu_f(float y) { return y / (1.f + __expf(-y)); }
__device__ __forceinline__ float sigmoid_f(float y) { return 1.f / (1.f + __expf(-y)); }
__device__ __forceinline__ float gelu_tanh_f(float x) { const float t = tanhf(0.7978845608028654f * (x + 0.044715f * x * x * x)); return 0.5f * x * (1.f + t); }
__device__ __forceinline__ f32x4 mfma16(bf16x8 a, bf16x8 b, f32x4 c) { return __builtin_amdgcn_mfma_f32_16x16x32_bf16(a, b, c, 0, 0, 0); }
#define LDS_FENCE() asm volatile("s_waitcnt lgkmcnt(0)" ::: "memory")

struct EpiSwiGLU {
    static constexpr bool PERM = false, AFTER_DRAIN = false;
    bf16_t* O; int ldc;
    __device__ __forceinline__ void operator()(const pg8::f32x4 (&acc)[2][2][4][2], const pg8::Unit& u, int wr, int wc, int fr, int fq) const {
        const int row0 = u.pm * 256 + wr * 64 + fr, hid0 = u.pn * 128 + wc * 16 + 4 * fq;
#pragma unroll
        for (int ai = 0; ai < 2; ++ai)
#pragma unroll
            for (int m = 0; m < 4; ++m) { bf16_t* rowp = O + (size_t)(row0 + ai * 128 + m * 16) * ldc + hid0;
#pragma unroll
                for (int bj = 0; bj < 2; ++bj) { const pg8::f32x4 g = acc[ai][bj][m][0], v = acc[ai][bj][m][1];
                    u32x2 w; w.x = pk2(silu_f(g[0]) * v[0], silu_f(g[1]) * v[1]); w.y = pk2(silu_f(g[2]) * v[2], silu_f(g[3]) * v[3]);
                    *(u32x2*)(rowp + bj * 64) = w; } }
    }
};

#define XB_TMO      128
#define XB_XCNT(j)  (256  + 64 * (j))
#define XB_XSUB(j)  (1280 + 64 * (j))
#define XB_XGEN(j)  (2304 + 64 * (j))
#define XB_TOP      3328
#define XB_TOPGEN   3392
#define XCD_BAR_WORDS 3456
#define XB_SPIN_CAP (1u << 18)

__device__ __forceinline__ unsigned xb_ld(unsigned* p)              { return __hip_atomic_load(p, __ATOMIC_RELAXED, __HIP_MEMORY_SCOPE_AGENT); }
__device__ __forceinline__ unsigned xb_add(unsigned* p, unsigned v) { return __hip_atomic_fetch_add(p, v, __ATOMIC_RELAXED, __HIP_MEMORY_SCOPE_AGENT); }
__device__ __forceinline__ unsigned xb_xcc_id() { return (unsigned)__builtin_amdgcn_s_getreg((3 << 11) | 20) & 0xFu; }
#define XB_SPIN(cond, bar) do { unsigned _sp = 0; while (cond) { __builtin_amdgcn_s_sleep(1); \
    if ((++_sp & 255u) == 0u) { if (xb_ld(&(bar)[XB_TMO])) break; if (_sp > XB_SPIN_CAP) { atomicAdd(&(bar)[XB_TMO], 1u); break; } } } } while (0)

struct XcdBarrier {
    unsigned* bar; unsigned x;
    volatile LAS unsigned* st;
};

__device__ __forceinline__ XcdBarrier xcd_barrier_post(unsigned* bar, volatile LAS unsigned* st) {
    XcdBarrier b; b.bar = bar; b.x = xb_xcc_id(); b.st = st;
    if (threadIdx.x == 0) (void)xb_add(&bar[XB_XCNT(b.x)], 1u);
    return b;
}
__device__ __forceinline__ void xcd_barrier_complete(unsigned* bar, unsigned x, unsigned& nloc, unsigned& nx) {
    const unsigned G = gridDim.x * gridDim.y * gridDim.z;
    unsigned sum, cnt, mine, sp = 0u;
    for (;;) {
        sum = 0u; cnt = 0u; mine = 0u;
#pragma unroll
        for (unsigned j = 0; j < 16; ++j) { const unsigned c = xb_ld(&bar[XB_XCNT(j)]); sum += c; cnt += (c > 0u) ? 1u : 0u; mine = (j == x) ? c : mine; }
        if (sum == G) break;
        __builtin_amdgcn_s_sleep(1);
        if ((++sp & 255u) == 0u) { if (xb_ld(&bar[XB_TMO])) break; if (sp > XB_SPIN_CAP) { atomicAdd(&bar[XB_TMO], 1u); break; } }
    }
    nloc = mine > 0u ? mine : 1u; nx = cnt > 0u ? cnt : 1u;
}

__device__ __forceinline__ void xcd_barrier(const XcdBarrier& b) {
    asm volatile("s_waitcnt vmcnt(0)" ::: "memory");
    __syncthreads();
    if (threadIdx.x == 0) {
        unsigned* bar = b.bar; asm volatile("" : "+s"(bar));
        __builtin_amdgcn_s_waitcnt(0);
        unsigned nloc = b.st[0], nx = b.st[1];
        if (nloc == 0u) { xcd_barrier_complete(bar, b.x, nloc, nx); b.st[0] = nloc; b.st[1] = nx; }
        const unsigned old = xb_add(&bar[XB_XSUB(b.x)], 1u);
        const unsigned gen = old / nloc;
        if (old + 1u == (gen + 1u) * nloc) {
            __builtin_amdgcn_fence(__ATOMIC_RELEASE, "agent");
            asm volatile("s_waitcnt vmcnt(0)" ::: "memory");
            const unsigned og = xb_add(&bar[XB_TOP], 1u);
            const unsigned tg = og / nx;
            if (og + 1u == (tg + 1u) * nx) xb_add(&bar[XB_TOPGEN], 1u);
            else XB_SPIN(xb_ld(&bar[XB_TOPGEN]) == tg, bar);
            __builtin_amdgcn_fence(__ATOMIC_ACQUIRE, "agent");
            xb_add(&bar[XB_XGEN(b.x)], 1u);
            asm volatile("s_waitcnt vmcnt(0)" ::: "memory");
        } else {
            XB_SPIN(xb_ld(&bar[XB_XGEN(b.x)]) == gen, bar);
            __builtin_amdgcn_fence(__ATOMIC_ACQUIRE, "agent");
            asm volatile("s_waitcnt vmcnt(0)" ::: "memory");
        }
    }
    __syncthreads();
}

struct SliceOrder {
    int nunits, G, c;
    __device__ __forceinline__ bool next(int i, pg8::Unit& u) const { const int L = i * G + c; if (L >= nunits) return false; const int t = L & 7; u.pm = t >> 2; u.pn = t & 3; u.ks = L >> 3; return true; }
    __device__ __forceinline__ void a_ready(const pg8::Unit&) const {}
    __device__ __forceinline__ void done(const pg8::Unit&) const {}
};
struct EpiF32Part {
    static constexpr bool PERM = false, AFTER_DRAIN = false;
    float* C;
    __device__ __forceinline__ void operator()(const pg8::f32x4 (&acc)[2][2][4][2], const pg8::Unit& u, int wr, int wc, int fr, int fq) const {
        const int row0 = u.pm * 256 + wr * 64 + fr, col0 = u.pn * 256 + wc * 32 + 4 * fq; float* base = C + (size_t)u.ks * (512 * 1024);
#pragma unroll
        for (int ai = 0; ai < 2; ++ai)
#pragma unroll
            for (int m = 0; m < 4; ++m) { float* rowp = base + (size_t)(row0 + ai * 128 + m * 16) * 1024 + col0;
#pragma unroll
                for (int bj = 0; bj < 2; ++bj)
#pragma unroll
                    for (int n = 0; n < 2; ++n) *(pg8::f32x4*)(rowp + bj * 128 + n * 16) = acc[ai][bj][m][n]; }
    }
};

struct SrcIn { const float* w; __device__ __forceinline__ float operator()(int k, int n) const { return w[(size_t)k * INW + (n < 1536 ? n : n + 8)]; } };
struct SrcPlain { const float* w; int N; __device__ __forceinline__ float operator()(int k, int n) const { return w[(size_t)k * N + n]; } };
struct SrcGU { const float* g; const float* u; __device__ __forceinline__ float operator()(int k, int n) const { const int r = n & 31, hid = (n >> 5) * 16 + (r & 15); const long long du = (r < 16) ? 0ll : (long long)(u - g); return g[du + (long long)k * DFF + hid]; } };
template <class Src> __device__ __forceinline__ void transpose_item(const Src& src, int K, bf16_t* WT, int nblk, LAS float* scr, int item, int lane) {
    const int kb = item / nblk, nb = item % nblk, k0 = 64 * kb, n0 = 32 * nb;
#pragma unroll 8
    for (int i = 0; i < 32; ++i) { const int kk = 2 * i + (lane >> 5); scr[kk * 33 + (lane & 31)] = src(k0 + kk, n0 + (lane & 31)); }
    LDS_FENCE();
    const int c = lane & 7;
#pragma unroll
    for (int j = 0; j < 4; ++j) { const int n = (lane >> 3) + 8 * j; const LAS float* s = scr + (8 * c) * 33 + n;
        u32x4 o; o.x = pk2(s[0 * 33], s[1 * 33]); o.y = pk2(s[2 * 33], s[3 * 33]); o.z = pk2(s[4 * 33], s[5 * 33]); o.w = pk2(s[6 * 33], s[7 * 33]);
        *(u32x4*)(WT + (size_t)(n0 + n) * K + k0 + 8 * c) = o; }
    LDS_FENCE();
}

__device__ __forceinline__ void norm_rows(const float* T, const float* wt, const float* X0, const float* X1, float* Xout, const float* wh, bf16_t* H,
                                          const float* Wab, float* AB, int gw, int NGW, int lane, const float* Tp = nullptr, int ns = 0) {
#pragma unroll 1
    for (int m = gw; m < NTOK; m += NGW) {
        const float* xr = (X1 && m >= NP) ? X1 + (size_t)(m - NP) * D : X0 + (size_t)m * D;
        f32x4 x[4];
#pragma unroll
        for (int j = 0; j < 4; ++j) x[j] = ((const f32x4*)xr)[lane + 64 * j];
        if (T) {
            f32x4 t[4]; float ss = 0.f;
#pragma unroll
            for (int j = 0; j < 4; ++j) {
                if (Tp && m >= NP) { f32x4 a = {0.f, 0.f, 0.f, 0.f}; for (int q = 0; q < ns; ++q) a += ((const f32x4*)(Tp + (size_t)q * (512 * 1024) + (size_t)(m - NP) * D))[lane + 64 * j]; t[j] = a; }
                else t[j] = ((const f32x4*)(T + (size_t)m * D))[lane + 64 * j];
                ss += (t[j].x * t[j].x + t[j].y * t[j].y) + (t[j].z * t[j].z + t[j].w * t[j].w); }
            ss = wave_sum(ss); const float r = rsqrtf(ss * (1.f / D) + EPS);
#pragma unroll
            for (int j = 0; j < 4; ++j) { const f32x4 w = ((const f32x4*)wt)[lane + 64 * j]; x[j] += t[j] * r * w; }
        }
        if (Xout) {
#pragma unroll
            for (int j = 0; j < 4; ++j) ((f32x4*)(Xout + (size_t)m * D))[lane + 64 * j] = x[j];
        }
        if (H) {
            float ss = 0.f;
#pragma unroll
            for (int j = 0; j < 4; ++j) ss += (x[j].x * x[j].x + x[j].y * x[j].y) + (x[j].z * x[j].z + x[j].w * x[j].w);
            ss = wave_sum(ss); const float r = rsqrtf(ss * (1.f / D) + EPS);
            f32x4 hv[4];
#pragma unroll
            for (int j = 0; j < 4; ++j) { const f32x4 w = ((const f32x4*)wh)[lane + 64 * j]; hv[j] = x[j] * r * w;
                u32x2 o; o.x = pk2(hv[j].x, hv[j].y); o.y = pk2(hv[j].z, hv[j].w); ((u32x2*)(H + (size_t)m * D))[lane + 64 * j] = o; }
            if (Wab) {
#pragma unroll
                for (int c = 0; c < 8; ++c) { float d = 0.f;
#pragma unroll
                    for (int j = 0; j < 4; ++j) { const f32x4 w = ((const f32x4*)(Wab + c * D))[lane + 64 * j]; d += (hv[j].x * w.x + hv[j].y * w.y) + (hv[j].z * w.z + hv[j].w * w.w); }
                    d = wave_sum(d); if (lane == 0) AB[(size_t)m * 8 + c] = d; }
            }
        }
    }
}

__device__ __forceinline__ void prologue(const DevArgs& A, LAS unsigned char* lds, int wave, int lane, int gw, int NGW) {
    LAS float* scr = (LAS float*)(lds + wave * 8704);
    constexpr int I_IN = 16 * 80, I_OUT = 16 * 32, I_GU = 16 * 176, I_DN = 44 * 32, I_GLU = 4 * 8, I_POOL = 8, PER = I_IN + I_OUT + I_GU + I_DN + I_GLU + I_POOL;
#pragma unroll 1
    for (int it = gw; it < DEPTH * PER; it += NGW) {
        const int l = it / PER; int r = it % PER;
        if (r < I_IN) { SrcIn s{A.in[I_WIN] + (size_t)l * D * INW}; transpose_item(s, D, (bf16_t*)(A.ws + WS_WIN + l * SZ_WIN), NPROJ / 32, scr, r, lane); continue; } r -= I_IN;
        if (r < I_OUT) { SrcPlain s{A.in[I_WOUT] + (size_t)l * D * D, D}; transpose_item(s, D, (bf16_t*)(A.ws + WS_WOUT + l * SZ_WOUT), D / 32, scr, r, lane); continue; } r -= I_OUT;
        if (r < I_GU) { SrcGU s{A.in[I_WG] + (size_t)l * D * DFF, A.in[I_WU] + (size_t)l * D * DFF}; transpose_item(s, D, (bf16_t*)(A.ws + WS_WGU + l * SZ_WGU), NGU / 32, scr, r, lane); continue; } r -= I_GU;
        if (r < I_DN) { SrcPlain s{A.in[I_WD] + (size_t)l * DFF * D, D}; transpose_item(s, DFF, (bf16_t*)(A.ws + WS_WDN + l * SZ_WDN), D / 32, scr, r, lane); continue; } r -= I_DN;
        if (r < I_GLU) { SrcPlain s{A.in[I_GLUW] + (size_t)l * 65536, 256}; transpose_item(s, 256, (bf16_t*)(A.ws + WS_GLUT + l * SZ_GLUT), 8, scr, r, lane); continue; } r -= I_GLU;
        { const int g = r >> 1; SrcPlain s{A.in[I_POOLW] + (size_t)(l * 4 + g) * 4096, 64}; transpose_item(s, 64, (bf16_t*)(A.ws + WS_POOLT + l * SZ_POOLT) + g * 4096, 2, scr, r & 1, lane); }
    }
    const int gt = gw * 64 + lane, NT = NGW * 64;
    float* wab = (float*)(A.ws + WS_WAB);
#pragma unroll 1
    for (int i = gt; i < DEPTH * 8 * D; i += NT) { const int l = i / (8 * D), j = (i / D) & 7, k = i % D; wab[i] = A.in[I_WIN][((size_t)l * D + k) * INW + 1536 + j]; }
    float* ssmk = (float*)(A.ws + WS_SSMK); float* bbar = (float*)(A.ws + WS_BBAR);
#pragma unroll 1
    for (int i = gt; i < DEPTH * 16 * 64; i += NT) {
        const int lg = i >> 6;
        const float dt = expf(A.in[I_LOGDT][lg]), ar = A.in[I_ARE][i], ai = A.in[I_AIM][i];
        const float mag = expf(ar * dt);
        float rev = ai * dt * 0.15915494309189535f; rev -= floorf(rev);
        const float sn = __builtin_amdgcn_sinf(rev), cs = __builtin_amdgcn_cosf(rev);
        const float lr = mag * cs, li = mag * sn;
        float pr = lr, pi = li;
#pragma unroll
        for (int q = 0; q < 6; ++q) { const float nr2 = pr * pr - pi * pi, ni2 = 2.f * pr * pi; pr = nr2; pi = ni2; }
        ssmk[i * 4 + 0] = lr; ssmk[i * 4 + 1] = li; ssmk[i * 4 + 2] = pr; ssmk[i * 4 + 3] = pi;
        const float nr = lr - 1.f, ni = li, d2 = ar * ar + ai * ai;
        const float cre = (nr * ar + ni * ai) / d2, cim = (ni * ar - nr * ai) / d2;
#pragma unroll
        for (int h = 0; h < 16; ++h) { const float br = A.in[I_BRE][(size_t)i * 16 + h], bi = A.in[I_BIM][(size_t)i * 16 + h];
            bbar[(size_t)i * 32 + h] = cre * br - cim * bi; bbar[(size_t)i * 32 + 16 + h] = cre * bi + cim * br; }
    }
}

__device__ __forceinline__ void delta_prep_item(const DevArgs& A, int l, LAS unsigned char* lds, int item, int tid, int wave, int lane) {
    asm volatile("" : "+v"(tid)); lane = tid & 63; wave = __builtin_amdgcn_readfirstlane(tid >> 6);
    const int bh = item >> 5, n = item & 31, b = bh >> 2, h = bh & 3;
    const int tok0 = b * SEQ + n * 64;
    LAS bf16_t* QS = (LAS bf16_t*)(lds); LAS bf16_t* KS = (LAS bf16_t*)(lds + 17408);
    LAS float* RHS = (LAS float*)(lds + 34816);
    LAS float* AM = (LAS float*)(lds + 100352); LAS float* PM = (LAS float*)(lds + 117760);
    LAS float* GAM = (LAS float*)(lds + 135168); LAS float* BETA = GAM + 64; LAS float* RQ = GAM + 128; LAS float* RK = GAM + 192;
    const bf16_t* PROJ = (const bf16_t*)(A.ws + WS_PROJ);
    const float* AB = (const float*)(A.ws + WS_AB);
    unsigned gv[16];
#pragma unroll
    for (int j = 0; j < 16; ++j) { const int idx = tid + 512 * j; gv[j] = PROJ[(size_t)(tok0 + (idx >> 7)) * NPROJ + PC_G + h * 128 + (idx & 127)]; }
    if (tid < 384) {
        const int part = tid >> 7, c = tid & 127, col = part * 512 + h * 128 + c;
        const float* cw = A.in[I_CONVW] + (size_t)l * 4 * 1536;
        const float w0 = cw[col], w1 = cw[1536 + col], w2 = cw[3072 + col], w3 = cw[4608 + col];
        const bf16_t* pp = PROJ + (size_t)tok0 * NPROJ + col;
        float xr[67];
#pragma unroll
        for (int t = 0; t < 67; ++t) xr[t] = (n > 0 || t >= 3) ? bf2f(pp[(long)(t - 3) * NPROJ]) : 0.f;
#pragma unroll
        for (int t = 0; t < 64; ++t) {
            const float y = w0 * xr[t] + w1 * xr[t + 1] + w2 * xr[t + 2] + w3 * xr[t + 3];
            const float s = silu_f(y);
            if (part == 0) QS[t * 136 + c] = (bf16_t)f2bf(s);
            else if (part == 1) KS[t * 136 + c] = (bf16_t)f2bf(s);
            else RHS[t * 256 + c] = s;
        }
    } else if (tid < 448) {
        const int t = tid - 384;
        const float a = AB[(size_t)(tok0 + t) * 8 + h], bb = AB[(size_t)(tok0 + t) * 8 + 4 + h];
        const float xx = a + A.in[I_DTB][l * 4 + h];
        const float sp = xx > 20.f ? xx : log1pf(expf(xx));
        float lg = -expf(A.in[I_ALOG][l * 4 + h]) * sp;
#pragma unroll
        for (int off = 1; off < 64; off <<= 1) { const float v = __shfl_up(lg, off); if (lane >= off) lg += v; }
        GAM[t] = lg; BETA[t] = 1.f / (1.f + expf(-bb));
    }
    __syncthreads();
    {
        const int t = tid >> 3, part = tid & 7; float sq = 0.f, sk = 0.f;
#pragma unroll
        for (int j = 0; j < 16; ++j) { const float q = bf2f(QS[t * 136 + part * 16 + j]), k = bf2f(KS[t * 136 + part * 16 + j]); sq += q * q; sk += k * k; }
        sq += __shfl_xor(sq, 1); sq += __shfl_xor(sq, 2); sq += __shfl_xor(sq, 4);
        sk += __shfl_xor(sk, 1); sk += __shfl_xor(sk, 2); sk += __shfl_xor(sk, 4);
        if (part == 0) { RQ[t] = rsqrtf(sq + EPS) * 0.08838834764831845f; RK[t] = rsqrtf(sk + EPS); }
    }
    {
        const int prod = wave >> 2, mt = wave & 3, fr = lane & 15, quad = lane >> 4;
        LAS bf16_t* Aop = prod ? QS : KS; LAS float* dst = prod ? PM : AM;
        bf16x8 a[4];
#pragma unroll
        for (int kk = 0; kk < 4; ++kk) a[kk] = *(LAS bf16x8*)(Aop + (mt * 16 + fr) * 136 + kk * 32 + quad * 8);
#pragma unroll
        for (int nt = 0; nt < 4; ++nt) { f32x4 acc = {0.f, 0.f, 0.f, 0.f};
#pragma unroll
            for (int kk = 0; kk < 4; ++kk) { const bf16x8 bq = *(LAS bf16x8*)(KS + (nt * 16 + fr) * 136 + kk * 32 + quad * 8); acc = mfma16(a[kk], bq, acc); }
#pragma unroll
            for (int i = 0; i < 4; ++i) dst[(mt * 16 + quad * 4 + i) * 68 + nt * 16 + fr] = acc[i]; }
    }
    __syncthreads();
    bf16_t* DQK = (bf16_t*)(A.ws + WS_DQK) + (size_t)item * 4096;
    bf16_t* DQD = (bf16_t*)(A.ws + WS_DQD) + (size_t)item * 8192;
    bf16_t* DKT = (bf16_t*)(A.ws + WS_DKT) + (size_t)item * 8192;
    for (int idx = tid; idx < 4096; idx += 512) { const int t = idx >> 6, s = idx & 63;
        const float dec = (s <= t) ? __expf(GAM[t] - GAM[s]) : 0.f;
        const float am = AM[t * 68 + s], pm = PM[t * 68 + s];
        AM[t * 68 + s] = (s < t) ? BETA[t] * RK[t] * RK[s] * am * dec : 0.f;
        DQK[idx] = (bf16_t)f2bf(RQ[t] * RK[s] * pm * dec); }
    for (int idx = tid; idx < 8192; idx += 512) { const int t = idx >> 7, c = idx & 127; const float bt = BETA[t], eg = __expf(GAM[t]);
        const float kraw = bf2f(KS[t * 136 + c]);
        RHS[t * 256 + c] *= bt; RHS[t * 256 + 128 + c] = bt * eg * RK[t] * kraw; }
    { bf16_t* DGS = (bf16_t*)(A.ws + WS_DGS) + (size_t)item * 8192; const float on = A.in[I_ONORM][l * 128 + (tid & 127)];
#pragma unroll
      for (int j = 0; j < 16; ++j) DGS[tid + 512 * j] = (bf16_t)f2bf(silu_f(bf2f(gv[j])) * on); }
    __syncthreads();
    if (tid >= 256) {
        const int wt = tid - 256; const float g63 = GAM[63];
        for (int idx = wt; idx < 8192; idx += 256) { const int t = idx >> 7, c = idx & 127; DQD[idx] = (bf16_t)f2bf(bf2f(QS[t * 136 + c]) * RQ[t] * __expf(GAM[t])); }
        for (int idx = wt; idx < 8192; idx += 256) { const int c = idx >> 6, t = idx & 63; DKT[idx] = (bf16_t)f2bf(bf2f(KS[t * 136 + c]) * RK[t] * __expf(g63 - GAM[t])); }
        if (wt == 0) ((float*)(A.ws + WS_DGL))[item] = __expf(g63);
    }
#ifndef REP_SOLVE
#define REP_SOLVE 1
#endif
    if (tid < 256) for (int rep = 0; rep < REP_SOLVE; ++rep) {
        float sol[64];
        LAS float* amp = AM; asm volatile("" : "+v"(amp));
        LAS float* rhp = RHS + tid; asm volatile("" : "+v"(rhp));
#pragma unroll
        for (int t = 0; t < 64; ++t) { float acc = rhp[t * 256];
#pragma unroll
            for (int s = 0; s < t; ++s) acc = fmaf(-amp[t * 68 + s], sol[s], acc);
            sol[t] = acc; __builtin_amdgcn_sched_barrier(0); }
        if (tid < 128) { u32x4* DW = (u32x4*)((bf16_t*)(A.ws + WS_DW) + (size_t)item * 8192 + tid * 64);
#pragma unroll
            for (int q = 0; q < 8; ++q) { u32x4 o; o.x = pg8::cvt_pk_bf16(sol[8 * q], sol[8 * q + 1]); o.y = pg8::cvt_pk_bf16(sol[8 * q + 2], sol[8 * q + 3]);
                o.z = pg8::cvt_pk_bf16(sol[8 * q + 4], sol[8 * q + 5]); o.w = pg8::cvt_pk_bf16(sol[8 * q + 6], sol[8 * q + 7]); DW[q] = o; } }
        else { bf16_t* DKC = (bf16_t*)(A.ws + WS_DKC) + (size_t)item * 8192 + (tid - 128);
#pragma unroll
            for (int t = 0; t < 64; ++t) DKC[t * 128] = (bf16_t)f2bf(-sol[t]); }
    }
    __syncthreads();
}

__device__ __forceinline__ void delta_scan_item(const DevArgs& A, int l, LAS unsigned char* lds, int bh, int tid_in, int wave, int lane_in, const XcdBarrier& xb, int SUB) {
    const int b = bh >> 2, h = bh & 3;
    LAS unsigned char* KCs = lds; LAS unsigned char* QDs = lds + 17408; LAS unsigned char* QKs = lds + 34816; LAS unsigned char* KDTs = lds + 44032;
    LAS unsigned char* Ws = lds + 62464;
    LAS unsigned char* GSs = lds + 80896;
    LAS unsigned char* SS = lds + 98304 + wave * 4352; LAS unsigned char* US = lds + 133120 + wave * 2304;
    LAS float* PART = (LAS float*)(lds + 151552);
    const unsigned char* gW = A.ws + WS_DW; const unsigned char* gGS = A.ws + WS_DGS;
    const unsigned char* gKC = A.ws + WS_DKC; const unsigned char* gQD = A.ws + WS_DQD; const unsigned char* gQK = A.ws + WS_DQK; const unsigned char* gKT = A.ws + WS_DKT;
    const float* DGL = (const float*)(A.ws + WS_DGL);
    f32x4 S[8];
#pragma unroll
    for (int mt = 0; mt < 8; ++mt) S[mt] = (f32x4){0.f, 0.f, 0.f, 0.f};
    u32x4 r[9], rg[2];
    float gl_all = 0.f;
#define DS_LOAD(itn, toff) do { const size_t _i = (size_t)(itn); const unsigned char* _kc = gKC + _i * 16384; const unsigned char* _qd = gQD + _i * 16384; \
        const unsigned char* _qk = gQK + _i * 8192; const unsigned char* _kt = gKT + _i * 16384; \
        r[0] = *(const u32x4*)(_kc + (toff)); r[1] = *(const u32x4*)(_kc + (toff) + 8192u); \
        r[2] = *(const u32x4*)(_qd + (toff)); r[3] = *(const u32x4*)(_qd + (toff) + 8192u); \
        r[4] = *(const u32x4*)(_qk + (toff)); \
        r[5] = *(const u32x4*)(_kt + (toff)); r[6] = *(const u32x4*)(_kt + (toff) + 8192u); \
        const unsigned char* _w = gW + _i * 16384; r[7] = *(const u32x4*)(_w + (toff)); r[8] = *(const u32x4*)(_w + (toff) + 8192u); } while (0)
#define DS_LOADG(itn, toff) do { const unsigned char* _g = gGS + (size_t)(itn) * 16384; rg[0] = *(const u32x4*)(_g + (toff)); rg[1] = *(const u32x4*)(_g + (toff) + 8192u); } while (0)
#define DS_STAGE(tidv) do { const int i0 = (tidv), i1 = (tidv) + 512; \
          *(LAS u32x4*)(KCs + (i0 >> 4) * 272 + (i0 & 15) * 16) = r[0]; *(LAS u32x4*)(KCs + (i1 >> 4) * 272 + (i1 & 15) * 16) = r[1]; \
          *(LAS u32x4*)(QDs + (i0 >> 4) * 272 + (i0 & 15) * 16) = r[2]; *(LAS u32x4*)(QDs + (i1 >> 4) * 272 + (i1 & 15) * 16) = r[3]; \
          *(LAS u32x4*)(QKs + (i0 >> 3) * 144 + (i0 & 7) * 16) = r[4]; \
          *(LAS u32x4*)(KDTs + (i0 >> 3) * 144 + (i0 & 7) * 16) = r[5]; *(LAS u32x4*)(KDTs + (i1 >> 3) * 144 + (i1 & 7) * 16) = r[6]; \
          *(LAS u32x4*)(Ws + (i0 >> 3) * 144 + (i0 & 7) * 16) = r[7]; *(LAS u32x4*)(Ws + (i1 >> 3) * 144 + (i1 & 7) * 16) = r[8]; } while (0)
#define DS_STAGEG(tidv) do { const int i0 = (tidv), i1 = (tidv) + 512; \
          *(LAS u32x4*)(GSs + (i0 >> 4) * 272 + (i0 & 15) * 16) = rg[0]; *(LAS u32x4*)(GSs + (i1 >> 4) * 272 + (i1 & 15) * 16) = rg[1]; } while (0)
#pragma unroll 1
    for (int n = 0; n < 32; ++n) {
        int tid = tid_in; asm volatile("" : "+v"(tid));
        const bool bstart = (SUB > 0) ? (n % SUB == 0) : (n == 0);
        const bool bnext1 = (SUB > 0) && ((n + 1) % SUB == 0), bnext2 = (SUB > 0) && ((n + 2) % SUB == 0);
        if (bstart) { if (n > 0) xcd_barrier(xb);
            gl_all = DGL[bh * 32 + (tid & 31)];
            const unsigned t0 = (unsigned)tid * 16u; DS_LOAD(bh * 32 + n, t0); DS_LOADG(bh * 32 + n, t0); DS_STAGE(tid); DS_STAGEG(tid);
            if (n + 1 < 32 && !bnext1) { DS_LOAD(bh * 32 + n + 1, t0); DS_LOADG(bh * 32 + n + 1, t0); }
            __syncthreads(); }
        else { DS_STAGEG(tid);
            if (n + 1 < 32 && !bnext1) DS_LOADG(bh * 32 + n + 1, (unsigned)tid * 16u); }
        const int lane = tid & 63, fr = lane & 15, quad = lane >> 4, vcol = 16 * wave + fr;
        const unsigned toff = (unsigned)tid * 16u;
        const int it = bh * 32 + n, tokb = b * SEQ + n * 64;
        const float glast = __builtin_bit_cast(float, __builtin_amdgcn_readlane(__builtin_bit_cast(int, gl_all), n));
#pragma unroll
        for (int mt = 0; mt < 8; ++mt) { u32x2 p; p.x = pg8::cvt_pk_bf16(S[mt][0], S[mt][1]); p.y = pg8::cvt_pk_bf16(S[mt][2], S[mt][3]); *(LAS u32x2*)(SS + fr * 272 + (mt * 16 + quad * 4) * 2) = p; }
        LDS_FENCE();
        bf16x8 Sb[4];
#pragma unroll
        for (int kk = 0; kk < 4; ++kk) Sb[kk] = *(LAS bf16x8*)(SS + fr * 272 + (kk * 32 + quad * 8) * 2);
        f32x4 U[4], O[4];
#pragma unroll
        for (int mt = 0; mt < 4; ++mt) { f32x4 au, ao = {0.f, 0.f, 0.f, 0.f};
            { const u32x2 wq = *(LAS u32x2*)(Ws + vcol * 144 + (mt * 16 + quad * 4) * 2);
              au[0] = __uint_as_float(wq.x << 16); au[1] = __uint_as_float(wq.x & 0xffff0000u); au[2] = __uint_as_float(wq.y << 16); au[3] = __uint_as_float(wq.y & 0xffff0000u); }
#pragma unroll
            for (int kk = 0; kk < 4; ++kk) { const bf16x8 a1 = *(LAS bf16x8*)(KCs + (mt * 16 + fr) * 272 + (kk * 32 + quad * 8) * 2); au = mfma16(a1, Sb[kk], au);
                const bf16x8 a2 = *(LAS bf16x8*)(QDs + (mt * 16 + fr) * 272 + (kk * 32 + quad * 8) * 2); ao = mfma16(a2, Sb[kk], ao); }
            U[mt] = au; O[mt] = ao; __builtin_amdgcn_sched_barrier(0); }
#pragma unroll
        for (int mt = 0; mt < 4; ++mt) { u32x2 p; p.x = pg8::cvt_pk_bf16(U[mt][0], U[mt][1]); p.y = pg8::cvt_pk_bf16(U[mt][2], U[mt][3]); *(LAS u32x2*)(US + fr * 144 + (mt * 16 + quad * 4) * 2) = p; }
        LDS_FENCE();
        bf16x8 Ub[2];
#pragma unroll
        for (int kk = 0; kk < 2; ++kk) Ub[kk] = *(LAS bf16x8*)(US + fr * 144 + (kk * 32 + quad * 8) * 2);
#pragma unroll
        for (int mt = 0; mt < 4; ++mt)
#pragma unroll
            for (int kk = 0; kk < 2; ++kk) { const bf16x8 a = *(LAS bf16x8*)(QKs + (mt * 16 + fr) * 144 + (kk * 32 + quad * 8) * 2); O[mt] = mfma16(a, Ub[kk], O[mt]); }
        __builtin_amdgcn_sched_barrier(0);
#pragma unroll
        for (int mt = 0; mt < 8; ++mt) { S[mt] *= glast;
#pragma unroll
            for (int kk = 0; kk < 2; ++kk) { const bf16x8 a = *(LAS bf16x8*)(KDTs + (mt * 16 + fr) * 144 + (kk * 32 + quad * 8) * 2); S[mt] = mfma16(a, Ub[kk], S[mt]); }
            if (mt & 1) __builtin_amdgcn_sched_barrier(0); }
        { float pp[16];
#pragma unroll
          for (int e = 0; e < 16; ++e) pp[e] = O[e >> 2][e & 3] * O[e >> 2][e & 3];
#pragma unroll
          for (int st = 1; st < 16; st <<= 1) {
#pragma unroll
              for (int e = 0; e < 16; ++e) pp[e] += __shfl_xor(pp[e], st); }
          if (fr == 0) {
#pragma unroll
              for (int e = 0; e < 16; ++e) PART[((e >> 2) * 16 + quad * 4 + (e & 3)) * 8 + wave] = pp[e]; } }
        __syncthreads();
        if (n + 1 < 32 && !bnext1) { DS_STAGE(tid); if (n + 2 < 32 && !bnext2) DS_LOAD(it + 2, toff); }
        bf16_t* mixb = (bf16_t*)(A.ws + WS_MIX) + (size_t)tokb * D + h * 128;
#pragma unroll
        for (int mt = 0; mt < 4; ++mt)
#pragma unroll
            for (int i = 0; i < 4; ++i) { const int t = mt * 16 + quad * 4 + i;
                const f32x4 p0 = *(LAS f32x4*)(PART + t * 8), p1 = *(LAS f32x4*)(PART + t * 8 + 4);
                const float tot = ((p0[0] + p0[1]) + (p0[2] + p0[3])) + ((p1[0] + p1[1]) + (p1[2] + p1[3]));
                const float sc = rsqrtf(tot * (1.f / 128.f) + EPS);
                const float gs = bf2f(*(LAS bf16_t*)(GSs + t * 272 + vcol * 2));
                mixb[(unsigned)(t * D + vcol)] = (bf16_t)(pg8::cvt_pk_bf16(O[mt][i] * sc * gs, 0.f) & 0xffffu); }
        __syncthreads();
    }
#undef DS_STAGE
#undef DS_LOADG
#undef DS_STAGEG
#undef DS_LOAD
    { const int lane = lane_in, fr = lane & 15, quad = lane >> 4, vcol = 16 * wave + fr;
      float* dp = A.out + O_DP + (size_t)((l * 8 + b) * 4 + h) * 16384;
#pragma unroll
      for (int mt = 0; mt < 8; ++mt)
#pragma unroll
          for (int i = 0; i < 4; ++i) dp[(mt * 16 + quad * 4 + i) * 128 + vcol] = S[mt][i]; }
    __syncthreads();
}

__device__ __forceinline__ void delta_sample_item(const DevArgs& A, int l, LAS unsigned char* lds, int item, int tid, int wave, int lane) {
    asm volatile("" : "+v"(tid)); lane = tid & 63; wave = __builtin_amdgcn_readfirstlane(tid >> 6);
    const int b = item >> 2, h = item & 3, tokS = NP + b * 4;
    LAS float* RAW = (LAS float*)lds; LAS float* RED = RAW + 1536; LAS float* OB = RED + 512; LAS float* SC = OB + 512;
    const bf16_t* PROJ = (const bf16_t*)(A.ws + WS_PROJ); const float* AB = (const float*)(A.ws + WS_AB); bf16_t* MIX = (bf16_t*)(A.ws + WS_MIX);
    const float* cw = A.in[I_CONVW] + (size_t)l * 4 * 1536;
    for (int idx = tid; idx < 1536; idx += 512) { const int part = idx >> 9, t = (idx >> 7) & 3, c = idx & 127, col = part * 512 + h * 128 + c;
        float acc = 0.f;
#pragma unroll
        for (int j = 0; j < 4; ++j) { const int tt = t - 3 + j;
            const float x = (tt >= 0) ? bf2f(PROJ[(size_t)(tokS + tt) * NPROJ + col]) : A.in[I_SCONV][((size_t)(l * 128 + b) * 3 + (3 + tt)) * 1536 + col];
            acc += cw[j * 1536 + col] * x; }
        RAW[idx] = silu_f(acc); }
    if (tid < 4) { const float a = AB[(size_t)(tokS + tid) * 8 + h], bb = AB[(size_t)(tokS + tid) * 8 + 4 + h];
        const float xx = a + A.in[I_DTB][l * 4 + h]; const float sp = xx > 20.f ? xx : log1pf(expf(xx));
        SC[8 + tid] = 1.f / (1.f + expf(-bb)); SC[12 + tid] = expf(-expf(A.in[I_ALOG][l * 4 + h]) * sp); }
    const int v = tid & 127, kq = tid >> 7;
    float S[32];
    { const float* sp = A.in[I_SDELTA] + (size_t)((l * 128 + b) * 4 + h) * 16384;
#pragma unroll
      for (int i = 0; i < 32; ++i) S[i] = sp[(kq * 32 + i) * 128 + v]; }
    __syncthreads();
    { const int part = wave >> 2, t = wave & 3; const float x0 = RAW[part * 512 + t * 128 + lane], x1 = RAW[part * 512 + t * 128 + 64 + lane];
      const float ss = wave_sum(x0 * x0 + x1 * x1); if (lane == 0) SC[part * 4 + t] = rsqrtf(ss + EPS) * (part == 0 ? 0.08838834764831845f : 1.f); }
    __syncthreads();
    for (int t = 0; t < 4; ++t) {
        const float rq = SC[t], rk = SC[4 + t], beta = SC[8 + t], g = SC[12 + t];
        float pr = 0.f;
#pragma unroll
        for (int i = 0; i < 32; ++i) pr += S[i] * RAW[512 + t * 128 + kq * 32 + i];
        RED[kq * 128 + v] = pr * rk;
        __syncthreads();
        const float rr = (RED[v] + RED[128 + v]) + (RED[256 + v] + RED[384 + v]);
        const float u = beta * (RAW[1024 + t * 128 + v] - g * rr);
        float po = 0.f;
#pragma unroll
        for (int i = 0; i < 32; ++i) { const float kh = RAW[512 + t * 128 + kq * 32 + i] * rk; S[i] = g * S[i] + kh * u; po += S[i] * RAW[t * 128 + kq * 32 + i]; }
        __syncthreads();
        RED[kq * 128 + v] = po * rq;
        __syncthreads();
        if (kq == 0) OB[t * 128 + v] = (RED[v] + RED[128 + v]) + (RED[256 + v] + RED[384 + v]);
        __syncthreads();
    }
    if (wave < 4) { const int t = wave; const float x0 = OB[t * 128 + lane], x1 = OB[t * 128 + 64 + lane];
        const float ss = wave_sum(x0 * x0 + x1 * x1); const float sc = rsqrtf(ss * (1.f / 128.f) + EPS);
        const float g0 = bf2f(PROJ[(size_t)(tokS + t) * NPROJ + PC_G + h * 128 + lane]), g1 = bf2f(PROJ[(size_t)(tokS + t) * NPROJ + PC_G + h * 128 + 64 + lane]);
        MIX[(size_t)(tokS + t) * D + h * 128 + lane] = (bf16_t)f2bf(x0 * sc * A.in[I_ONORM][l * 128 + lane] * silu_f(g0));
        MIX[(size_t)(tokS + t) * D + h * 128 + 64 + lane] = (bf16_t)f2bf(x1 * sc * A.in[I_ONORM][l * 128 + 64 + lane] * silu_f(g1)); }
    { float* dsp = A.out + O_DS + (size_t)((l * 128 + b) * 4 + h) * 16384;
#pragma unroll
      for (int i = 0; i < 32; ++i) dsp[(kq * 32 + i) * 128 + v] = S[i]; }
    __syncthreads();
}

#define SSM_BCAST_U(t) do { unsigned _w[8]; \
        _w[0] = __builtin_amdgcn_readlane(ua.x, t); _w[1] = __builtin_amdgcn_readlane(ua.y, t); _w[2] = __builtin_amdgcn_readlane(ua.z, t); _w[3] = __builtin_amdgcn_readlane(ua.w, t); \
        _w[4] = __builtin_amdgcn_readlane(ub.x, t); _w[5] = __builtin_amdgcn_readlane(ub.y, t); _w[6] = __builtin_amdgcn_readlane(ub.z, t); _w[7] = __builtin_amdgcn_readlane(ub.w, t); \
        _Pragma("unroll") for (int _d = 0; _d < 8; ++_d) { uu[2 * _d] = __uint_as_float(_w[_d] << 16); uu[2 * _d + 1] = __uint_as_float(_w[_d] & 0xffff0000u); } } while (0)
#define SSM_STEP() do { float _br = 0.f, _bi = 0.f; \
        _Pragma("unroll") for (int _h = 0; _h < 16; ++_h) { _br = fmaf(Br[_h], uu[_h], _br); _bi = fmaf(Bi[_h], uu[_h], _bi); } \
        const float _nr = lr * hr - li * hi + _br, _ni = lr * hi + li * hr + _bi; hr = _nr; hi = _ni; } while (0)

__device__ __forceinline__ void ssm_part1_item(const DevArgs& A, int l, int it, int lane) {
    const int g = it & 15, bc = it >> 4, b = bc / 31, c = bc % 31;
    const float* bb = (const float*)(A.ws + WS_BBAR) + ((size_t)(l * 16 + g) * 64 + lane) * 32;
    float Br[16], Bi[16];
#pragma unroll
    for (int q = 0; q < 4; ++q) { const f32x4 x = ((const f32x4*)bb)[q], y = ((const f32x4*)bb)[4 + q];
        Br[4 * q] = x.x; Br[4 * q + 1] = x.y; Br[4 * q + 2] = x.z; Br[4 * q + 3] = x.w; Bi[4 * q] = y.x; Bi[4 * q + 1] = y.y; Bi[4 * q + 2] = y.z; Bi[4 * q + 3] = y.w; }
    const f32x4 lk = ((const f32x4*)(A.ws + WS_SSMK))[(l * 16 + g) * 64 + lane]; const float lr = lk.x, li = lk.y;
    const bf16_t* up = (const bf16_t*)(A.ws + WS_PROJ) + (size_t)(b * SEQ + c * 64 + lane) * NPROJ + PC_SSM + g * 16;
    const u32x4 ua = *(const u32x4*)up, ub = *(const u32x4*)(up + 8);
    float hr = 0.f, hi = 0.f, uu[16];
#pragma unroll 1
    for (int t = 0; t < 64; ++t) { SSM_BCAST_U(t); SSM_STEP(); }
    f32x2 e; e.x = hr; e.y = hi;
    ((f32x2*)(A.ws + WS_SSME))[((size_t)(b * 32 + c) * 16 + g) * 64 + lane] = e;
}

__device__ __forceinline__ void ssm_part2_item(const DevArgs& A, int l, LAS unsigned char* lds, int it, int tid, int wave, int lane) {
    asm volatile("" : "+v"(tid)); lane = tid & 63; wave = __builtin_amdgcn_readfirstlane(tid >> 6);
    const int tok0 = it * 64, fr = lane & 15, quad = lane >> 4;
    const bool samp = it >= 256; const int b = it >> 5, c = it & 31;
    LAS unsigned char* YS = lds; LAS unsigned char* HS = lds + 33792 + wave * 4352;
    const bf16_t* PROJ = (const bf16_t*)(A.ws + WS_PROJ); bf16_t* MIX = (bf16_t*)(A.ws + WS_MIX);
#pragma unroll 1
    for (int gi = 0; gi < 2; ++gi) {
        const int g = wave * 2 + gi;
        const float* bb = (const float*)(A.ws + WS_BBAR) + ((size_t)(l * 16 + g) * 64 + lane) * 32;
        float Br[16], Bi[16];
#pragma unroll
        for (int q = 0; q < 4; ++q) { const f32x4 x = ((const f32x4*)bb)[q], y = ((const f32x4*)bb)[4 + q];
            Br[4 * q] = x.x; Br[4 * q + 1] = x.y; Br[4 * q + 2] = x.z; Br[4 * q + 3] = x.w; Bi[4 * q] = y.x; Bi[4 * q + 1] = y.y; Bi[4 * q + 2] = y.z; Bi[4 * q + 3] = y.w; }
        const f32x4 lk = ((const f32x4*)(A.ws + WS_SSMK))[(l * 16 + g) * 64 + lane]; const float lr = lk.x, li = lk.y, Lr = lk.z, Li = lk.w;
        bf16x8 Cb[4];
#pragma unroll
        for (int kk = 0; kk < 4; ++kk) { const size_t co = ((size_t)(l * 16 + g) * 16 + fr) * 64 + kk * 16 + quad * 4;
            const f32x4 cr = *(const f32x4*)(A.in[I_CRE] + co), ci = *(const f32x4*)(A.in[I_CIM] + co);
            u32x4 pk; pk.x = pk2(cr.x, -ci.x); pk.y = pk2(cr.y, -ci.y); pk.z = pk2(cr.z, -ci.z); pk.w = pk2(cr.w, -ci.w);
            Cb[kk] = __builtin_bit_cast(bf16x8, pk); }
        const bf16_t* up = PROJ + (size_t)(tok0 + lane) * NPROJ + PC_SSM + g * 16;
        const u32x4 ua = *(const u32x4*)up, ub = *(const u32x4*)(up + 8);
        float hr = 0.f, hi = 0.f, uu[16];
        if (!samp && c > 0) { const f32x2* E = (const f32x2*)(A.ws + WS_SSME) + ((size_t)(b * 32) * 16 + g) * 64 + lane;
#pragma unroll
            for (int cb = 0; cb < 32; cb += 16) { f32x2 ev[16];
#pragma unroll
                for (int q = 0; q < 16; ++q) { const int cc = cb + q; ev[q] = (cc < c) ? E[(size_t)cc * 1024] : (f32x2){0.f, 0.f}; }
#pragma unroll
                for (int q = 0; q < 16; ++q) { const int cc = cb + q; if (cc < c) { const float nr = Lr * hr - Li * hi + ev[q].x, ni = Lr * hi + Li * hr + ev[q].y; hr = nr; hi = ni; } } } }
        const float dsk = A.in[I_SSMD][l * 256 + g * 16 + fr];
#pragma unroll 1
        for (int sub = 0; sub < 4; ++sub) {
#pragma unroll 1
            for (int tt = 0; tt < 16; ++tt) { const int t = sub * 16 + tt;
                const int sb = (it - 256) * 16 + (t >> 2);
                if (samp && (t & 3) == 0) { hr = A.in[I_SRE][((size_t)(l * 128 + sb) * 16 + g) * 64 + lane]; hi = A.in[I_SIM][((size_t)(l * 128 + sb) * 16 + g) * 64 + lane]; }
                SSM_BCAST_U(t); SSM_STEP();
                *(LAS unsigned*)(HS + tt * 272 + lane * 4) = pg8::cvt_pk_bf16(hr, hi);
                if (samp && (t & 3) == 3) { A.out[O_RES + ((size_t)(l * 128 + sb) * 16 + g) * 64 + lane] = hr; A.out[O_IMS + ((size_t)(l * 128 + sb) * 16 + g) * 64 + lane] = hi; }
            }
            LDS_FENCE();
            f32x4 acc = {0.f, 0.f, 0.f, 0.f};
#pragma unroll
            for (int kk = 0; kk < 4; ++kk) { const bf16x8 a = *(LAS bf16x8*)(HS + fr * 272 + (kk * 32 + quad * 8) * 2); acc = mfma16(a, Cb[kk], acc); }
#pragma unroll
            for (int i = 0; i < 4; ++i) { const int t = sub * 16 + quad * 4 + i; const float uv = bf2f(PROJ[(size_t)(tok0 + t) * NPROJ + PC_SSM + g * 16 + fr]);
                *(LAS bf16_t*)(YS + t * 528 + (g * 16 + fr) * 2) = (bf16_t)f2bf(gelu_tanh_f(acc[i] + dsk * uv)); }
            LDS_FENCE();
        }
        if (!samp && c == 31) { A.out[O_REP + ((size_t)(l * 8 + b) * 16 + g) * 64 + lane] = hr; A.out[O_IMP + ((size_t)(l * 8 + b) * 16 + g) * 64 + lane] = hi; }
    }
    __syncthreads();
    {
        const bf16_t* GT = (const bf16_t*)(A.ws + WS_GLUT + l * SZ_GLUT);
        f32x4 acc[4][2];
#pragma unroll
        for (int mt = 0; mt < 4; ++mt) { acc[mt][0] = (f32x4){0.f, 0.f, 0.f, 0.f}; acc[mt][1] = (f32x4){0.f, 0.f, 0.f, 0.f}; }
#pragma unroll
        for (int kk = 0; kk < 8; ++kk) { bf16x8 bfr[2];
#pragma unroll
            for (int nt = 0; nt < 2; ++nt) bfr[nt] = *(const bf16x8*)(GT + (size_t)(32 * wave + nt * 16 + fr) * 256 + kk * 32 + quad * 8);
#pragma unroll
            for (int mt = 0; mt < 4; ++mt) { const bf16x8 a = *(LAS bf16x8*)(YS + (mt * 16 + fr) * 528 + (kk * 32 + quad * 8) * 2);
                acc[mt][0] = mfma16(a, bfr[0], acc[mt][0]); acc[mt][1] = mfma16(a, bfr[1], acc[mt][1]); } }
#pragma unroll
        for (int nt = 0; nt < 2; ++nt) { const int ncol = 32 * wave + nt * 16 + fr; const float gb = A.in[I_GLUB][l * 256 + ncol];
#pragma unroll
            for (int mt = 0; mt < 4; ++mt)
#pragma unroll
                for (int i = 0; i < 4; ++i) { const int t = mt * 16 + quad * 4 + i; const float y = bf2f(*(LAS bf16_t*)(YS + t * 528 + ncol * 2));
                    MIX[(size_t)(tok0 + t) * D + 512 + ncol] = (bf16_t)f2bf(y * sigmoid_f(acc[mt][nt][i] + gb)); } }
    }
    __syncthreads();
}

__device__ __forceinline__ void pool_item(const DevArgs& A, int l, LAS unsigned char* lds, int it, int tid, int wave, int lane) {
    asm volatile("" : "+v"(tid)); lane = tid & 63; wave = __builtin_amdgcn_readfirstlane(tid >> 6);
    const int tok0 = it * 64, fr = lane & 15, quad = lane >> 4; const bool samp = it >= 256;
    LAS unsigned char* RS = lds;
    const bf16_t* PROJ = (const bf16_t*)(A.ws + WS_PROJ); bf16_t* MIX = (bf16_t*)(A.ws + WS_MIX);
    if (!samp) {
        LAS unsigned char* XT = lds + 33792;
        const int b = it >> 5, c = it & 31;
        for (int id = tid; id < 79 * 32; id += 512) { const int r = id >> 5, c16 = id & 31, tl = c * 64 - 15 + r;
            u32x4 v = {0u, 0u, 0u, 0u}; if (tl >= 0) v = *(const u32x4*)(PROJ + (size_t)(b * SEQ + tl) * NPROJ + PC_POOL + c16 * 8);
            *(LAS u32x4*)(XT + r * 528 + c16 * 16) = v; }
        __syncthreads();
        const int ch = tid & 255, half = tid >> 8, g = ch >> 6, w = 2 << g, r0 = half * 32;
        float sum = 0.f;
        for (int j = 0; j < w; ++j) sum += bf2f(*(LAS bf16_t*)(XT + (r0 + 15 - j) * 528 + ch * 2));
#pragma unroll 4
        for (int rr = 0; rr < 32; ++rr) { const int r = r0 + rr, tl = c * 64 + r;
            const float u = bf2f(*(LAS bf16_t*)(XT + (r + 15) * 528 + ch * 2));
            if (rr > 0) sum += u - bf2f(*(LAS bf16_t*)(XT + (r + 15 - w) * 528 + ch * 2));
            const float cnt = (float)((tl + 1 < w) ? tl + 1 : w);
            *(LAS bf16_t*)(RS + r * 528 + ch * 2) = (bf16_t)f2bf(sum / cnt - u); }
    } else {
#pragma unroll 1
        for (int pr = 0; pr < 8; ++pr) { const int idx = pr * 512 + tid, ch = idx & 255, sq = idx >> 8, g = ch >> 6, w = 2 << g;
            const int sb = (it - 256) * 16 + sq;
            const float* sbuf = A.in[I_SPOOL] + (size_t)(l * 128 + sb) * 15 * 256 + ch;
            const bf16_t* base = PROJ + (size_t)(NP + sb * 4) * NPROJ + PC_POOL + ch;
            float e[19];
#pragma unroll
            for (int j = 0; j < 15; ++j) e[j] = sbuf[j * 256];
#pragma unroll
            for (int j = 0; j < 4; ++j) e[15 + j] = bf2f(base[(size_t)j * NPROJ]);
#pragma unroll
            for (int t = 0; t < 4; ++t) { float sum = 0.f;
#pragma unroll
                for (int j = 0; j < 16; ++j) sum += (j < w) ? e[15 + t - j] : 0.f;
                *(LAS bf16_t*)(RS + (sq * 4 + t) * 528 + ch * 2) = (bf16_t)f2bf(sum / (float)w - e[15 + t]); } }
    }
    __syncthreads();
    { const int g2 = wave >> 1; const bf16_t* PT = (const bf16_t*)(A.ws + WS_POOLT + l * SZ_POOLT) + g2 * 4096;
      f32x4 acc[4][2];
#pragma unroll
      for (int mt = 0; mt < 4; ++mt) { acc[mt][0] = (f32x4){0.f, 0.f, 0.f, 0.f}; acc[mt][1] = (f32x4){0.f, 0.f, 0.f, 0.f}; }
#pragma unroll
      for (int kk = 0; kk < 2; ++kk) { bf16x8 bfr[2];
#pragma unroll
          for (int nt = 0; nt < 2; ++nt) bfr[nt] = *(const bf16x8*)(PT + (size_t)((wave & 1) * 32 + nt * 16 + fr) * 64 + kk * 32 + quad * 8);
#pragma unroll
          for (int mt = 0; mt < 4; ++mt) { const bf16x8 a = *(LAS bf16x8*)(RS + (mt * 16 + fr) * 528 + (g2 * 64 + kk * 32 + quad * 8) * 2);
              acc[mt][0] = mfma16(a, bfr[0], acc[mt][0]); acc[mt][1] = mfma16(a, bfr[1], acc[mt][1]); } }
#pragma unroll
      for (int nt = 0; nt < 2; ++nt) { const int col = 32 * wave + nt * 16 + fr; const float ps = A.in[I_POOLS][l * 256 + col];
#pragma unroll
          for (int mt = 0; mt < 4; ++mt)
#pragma unroll
              for (int i = 0; i < 4; ++i) { const int t = mt * 16 + quad * 4 + i; MIX[(size_t)(tok0 + t) * D + 768 + col] = (bf16_t)f2bf(acc[mt][nt][i] * ps); } } }
    __syncthreads();
}

__device__ __forceinline__ void state_copies(const DevArgs& A, int l, int gt, int NT) {
    const bf16_t* PROJ = (const bf16_t*)(A.ws + WS_PROJ);
#pragma unroll 1
    for (int i = gt; i < 8 * 3 * 1536; i += NT) { const int col = i % 1536, j = (i / 1536) % 3, b = i / 4608;
        A.out[O_CP + (size_t)l * 8 * 4608 + i] = bf2f(PROJ[(size_t)(b * SEQ + SEQ - 3 + j) * NPROJ + col]); }
#pragma unroll 1
    for (int i = gt; i < 128 * 3 * 1536; i += NT) { const int col = i % 1536, j = (i / 1536) % 3, b = i / 4608;
        A.out[O_CS + (size_t)l * 128 * 4608 + i] = bf2f(PROJ[(size_t)(NP + b * 4 + 1 + j) * NPROJ + col]); }
#pragma unroll 1
    for (int i = gt; i < 8 * 15 * 256; i += NT) { const int ch = i & 255, j = (i >> 8) % 15, b = i / 3840;
        A.out[O_PP + (size_t)l * 8 * 3840 + i] = bf2f(PROJ[(size_t)(b * SEQ + SEQ - 15 + j) * NPROJ + PC_POOL + ch]); }
#pragma unroll 1
    for (int i = gt; i < 128 * 15 * 256; i += NT) { const int ch = i & 255, j = (i >> 8) % 15, b = i / 3840;
        A.out[O_PS + (size_t)l * 128 * 3840 + i] = (j < 11) ? A.in[I_SPOOL][((size_t)(l * 128 + b) * 15 + 4 + j) * 256 + ch]
                                                             : bf2f(PROJ[(size_t)(NP + b * 4 + (j - 11)) * NPROJ + PC_POOL + ch]); }
}

#ifndef REP_DPREP
#define REP_DPREP 1
#endif
#ifndef REP_DSAMP
#define REP_DSAMP 1
#endif
#ifndef REP_SSM1
#define REP_SSM1 1
#endif
#ifndef REP_POOL
#define REP_POOL 1
#endif
#ifndef REP_DSCAN
#define REP_DSCAN 1
#endif
#ifndef REP_SSM2
#define REP_SSM2 1
#endif
#ifndef REP_G
#define REP_G 1
#endif
constexpr int NPH = 2 + DEPTH * 8;
__global__ void __launch_bounds__(512, 2) mega_fwd(Args KA) {
    DevArgs A; A.out = KA.out; A.ws = KA.ws; A.ph_lo = KA.ph_lo; A.ph_hi = KA.ph_hi;
    extern __shared__ __attribute__((aligned(16))) unsigned char lds_raw[];
    LAS unsigned char* lds = (LAS unsigned char*)lds_raw;
    cg::grid_group grid = cg::this_grid();
    volatile LAS unsigned* xst = (volatile LAS unsigned*)(lds + LDS_BYTES - 64);
    if (threadIdx.x == 0) { xst[0] = 0u; xst[1] = 0u; }
    __syncthreads();
    const XcdBarrier xb = xcd_barrier_post((unsigned*)(KA.ws + WS_BAR), xst);
    constexpr int G = 256, NGW = G * 8, NT = G * 512;
    int ph = 0;
#define PH_BEGIN if (A.ph_lo <= ph && ph < A.ph_hi) { int tid = threadIdx.x; asm volatile("" : "+v"(tid)); { unsigned char* _w = A.ws; asm volatile("" : "+s"(_w)); A.ws = _w; float* _o = A.out; asm volatile("" : "+s"(_o)); A.out = _o; } const int wave = __builtin_amdgcn_readfirstlane(tid >> 6), lane = tid & 63, gw = blockIdx.x * 8 + wave, gt = blockIdx.x * 512 + tid; (void)gw; (void)gt; (void)lane;
#define PH_END   if (ph + 1 < A.ph_hi) { if (ph == 0) grid.sync(); else xcd_barrier(xb); } } ++ph;
#define Hb   ((bf16_t*)(A.ws + WS_H))
#define AB   ((float*)(A.ws + WS_AB))
#define MIXO ((float*)(A.ws + WS_MIXO))
#define PROJ ((bf16_t*)(A.ws + WS_PROJ))
#define MIX  ((bf16_t*)(A.ws + WS_MIX))
#define HID  ((bf16_t*)(A.ws + WS_HID))

#ifndef REP_PRO
#define REP_PRO 1
#endif
#ifndef REP_N0
#define REP_N0 1
#endif
    PH_BEGIN for (int rep = 0; rep < REP_PRO; ++rep) { prologue(A, lds, wave, lane, gw, NGW); __syncthreads(); } PH_END
    PH_BEGIN for (int rep = 0; rep < REP_N0; ++rep) norm_rows(nullptr, nullptr, A.in[I_XP], A.in[I_XS], nullptr, A.in[I_NMPRE], Hb, (const float*)(A.ws + WS_WAB), AB, gw, NGW, lane); PH_END

#pragma unroll 1
    for (int l = 0; l < DEPTH; ++l) {
        PH_BEGIN for (int rep = 0; rep < REP_G; ++rep) { pg8::Gemm g{Hb, (const bf16_t*)(A.ws + WS_WIN + l * SZ_WIN), NTOK, NPROJ, D, D, D}; pg8::StaticOrder S; S.init(NTOK, NPROJ, G, (int)blockIdx.x);
            pg8::EpiBf16<0> E{PROJ, NPROJ, nullptr, 0, 0}; pg8::gemm_phase<pg8::EpiBf16<0>, pg8::StaticOrder>(lds, g, S, E, nullptr); } PH_END
        constexpr int SUBC = 7;
        PH_BEGIN {
#pragma unroll 1
            for (int j = blockIdx.x; j < 32 * SUBC; j += G) delta_prep_item(A, l, lds, (j & 31) * 32 + (j >> 5), tid, wave, lane);
#pragma unroll 1
            for (int it = blockIdx.x; it < 512; it += G) delta_sample_item(A, l, lds, it, tid, wave, lane);
#pragma unroll 1
            for (int it = gw; it < 8 * 31 * 16; it += NGW) ssm_part1_item(A, l, it, lane);
#pragma unroll 1
            for (int it = blockIdx.x; it < 264; it += G) pool_item(A, l, lds, it, tid, wave, lane);
            state_copies(A, l, gt, NT);
        } PH_END
        PH_BEGIN {
            {
                if (blockIdx.x < 32) delta_scan_item(A, l, lds, blockIdx.x, tid, wave, lane, xb, SUBC);
                else { const int w = blockIdx.x - 32; constexpr int NW = G - 32;
#pragma unroll 1
                    for (int k = 1; k <= 5; ++k) {
                        const int n0 = k * SUBC, nn = (n0 >= 32) ? 0 : ((32 - n0 < SUBC) ? 32 - n0 : SUBC);
                        int nprep = 32 * nn;
#ifndef REP_WPREP
#define REP_WPREP 1
#endif
#pragma unroll 1
                        for (int rep = 0; rep < REP_WPREP; ++rep)
#pragma unroll 1
                        for (int j = w; j < nprep; j += NW) delta_prep_item(A, l, lds, (j & 31) * 32 + n0 + (j >> 5), tid, wave, lane);
                        { const int it = (k == 4) ? w - 128 : ((k == 5) ? 96 + w : -1);
                          if (it >= 0 && it < ((k == 4) ? 96 : 264)) ssm_part2_item(A, l, lds, it, tid, wave, lane); }
                        if (k < 5) xcd_barrier(xb);
                    } }
            }
        } PH_END
        PH_BEGIN for (int rep = 0; rep < REP_G; ++rep) { pg8::Gemm g{MIX, (const bf16_t*)(A.ws + WS_WOUT + l * SZ_WOUT), NP, D, D, D, D}; pg8::StaticOrder S; S.init(NP, D, G, (int)blockIdx.x);
            pg8::EpiF32 E{MIXO, D, nullptr}; pg8::gemm_phase<pg8::EpiF32, pg8::StaticOrder>(lds, g, S, E, nullptr);
            pg8::Gemm g2{MIX + (size_t)NP * D, (const bf16_t*)(A.ws + WS_WOUT + l * SZ_WOUT), NS, D, 256, D, D}; SliceOrder S2{8 * (D / 256), G, (int)blockIdx.x};
            EpiF32Part E2{(float*)(A.ws + WS_PARTS)}; pg8::gemm_phase<EpiF32Part, SliceOrder>(lds, g2, S2, E2, nullptr); } PH_END
#ifndef REP_N5
#define REP_N5 1
#endif
        PH_BEGIN for (int rep = 0; rep < (l == 0 ? REP_N5 : 1); ++rep) norm_rows(MIXO, A.in[I_NMPOST] + l * D, l == 0 ? A.in[I_XP] : A.out, l == 0 ? A.in[I_XS] : nullptr, A.out, A.in[I_NFPRE] + l * D, Hb, nullptr, nullptr, gw, NGW, lane, (const float*)(A.ws + WS_PARTS), D / 256); PH_END
        PH_BEGIN for (int rep = 0; rep < REP_G; ++rep) { pg8::Gemm g{Hb, (const bf16_t*)(A.ws + WS_WGU + l * SZ_WGU), NTOK, NGU, D, D, D}; pg8::StaticOrder S; S.init(NTOK, NGU, G, (int)blockIdx.x);
            EpiSwiGLU E{HID, DFF}; pg8::gemm_phase<EpiSwiGLU, pg8::StaticOrder>(lds, g, S, E, nullptr); } PH_END
        PH_BEGIN for (int rep = 0; rep < REP_G; ++rep) { pg8::Gemm g{HID, (const bf16_t*)(A.ws + WS_WDN + l * SZ_WDN), NP, D, DFF, DFF, DFF}; pg8::StaticOrder S; S.init(NP, D, G, (int)blockIdx.x);
            pg8::EpiF32 E{MIXO, D, nullptr}; pg8::gemm_phase<pg8::EpiF32, pg8::StaticOrder>(lds, g, S, E, nullptr);
            pg8::Gemm g2{HID + (size_t)NP * DFF, (const bf16_t*)(A.ws + WS_WDN + l * SZ_WDN), NS, D, 256, DFF, DFF}; SliceOrder S2{8 * (DFF / 256), G, (int)blockIdx.x};
            EpiF32Part E2{(float*)(A.ws + WS_PARTS)}; pg8::gemm_phase<EpiF32Part, SliceOrder>(lds, g2, S2, E2, nullptr); } PH_END
        PH_BEGIN norm_rows(MIXO, A.in[I_NFPOST] + l * D, A.out, nullptr, A.out, l + 1 < DEPTH ? A.in[I_NMPRE] + (l + 1) * D : nullptr, l + 1 < DEPTH ? Hb : nullptr,
                           l + 1 < DEPTH ? (const float*)(A.ws + WS_WAB + (l + 1) * SZ_WAB) : nullptr, AB, gw, NGW, lane, (const float*)(A.ws + WS_PARTS), DFF / 256); PH_END
    }
#undef PH_BEGIN
#undef PH_END
#undef Hb
#undef AB
#undef MIXO
#undef PROJ
#undef MIX
#undef HID
}

extern "C" void kernel_launch(void* const* d_in, const int* in_sizes, int n_in, void* d_out, int out_size, void* d_ws, size_t ws_size, hipStream_t stream) {
    static int grid = 0;
    if (grid == 0) {
        if (n_in != 32 || (size_t)out_size != O_END || ws_size < WS_END) fprintf(stderr, "kernel_launch: unexpected sizes: n_in %d out %d (want %zu) ws %zu (want >= %zu)\n", n_in, out_size, (size_t)O_END, ws_size, (size_t)WS_END);
        int dev = 0, cus = 0, per_cu = 0;
        (void)hipGetDevice(&dev); (void)hipDeviceGetAttribute(&cus, hipDeviceAttributeMultiprocessorCount, dev);
        if (hipFuncSetAttribute((const void*)mega_fwd, hipFuncAttributeMaxDynamicSharedMemorySize, LDS_BYTES) != hipSuccess) fprintf(stderr, "kernel_launch: hipFuncSetAttribute failed\n");
        if (hipOccupancyMaxActiveBlocksPerMultiprocessor(&per_cu, (const void*)mega_fwd, 512, LDS_BYTES) != hipSuccess || per_cu < 1) { fprintf(stderr, "kernel_launch: occupancy query gave %d\n", per_cu); per_cu = 1; (void)hipGetLastError(); }
        grid = cus * per_cu; if (grid <= 0) grid = 256;
        if (grid >= 256) grid = 256;
        fprintf(stderr, "kernel_launch: grid %d (cus %d x %d)%s\n", grid, cus, per_cu, grid < 256 ? "  ERROR: this build needs >= 256 co-resident workgroups" : "");
    }
    (void)hipMemsetAsync((unsigned char*)d_ws + WS_BAR, 0, 16384, stream);
    Args a{};
    for (int i = 0; i < 32; ++i) a.in[i] = (const float*)d_in[i];
    a.out = (float*)d_out; a.ws = (unsigned char*)d_ws;
#if MK_COOP
    a.ph_lo = 0; a.ph_hi = NPH;
    void* args[] = {&a};
    const hipError_t e = hipLaunchCooperativeKernel((const void*)mega_fwd, dim3(grid), dim3(512), args, LDS_BYTES, stream);
    if (e != hipSuccess) fprintf(stderr, "kernel_launch: cooperative launch failed: %s (grid %d)\n", hipGetErrorString(e), grid);
#else
    for (int p = 0; p < NPH; ++p) { a.ph_lo = p; a.ph_hi = p + 1; hipLaunchKernelGGL(mega_fwd, dim3(grid), dim3(512), LDS_BYTES, stream, a); }
#endif
}
```

```cpp
#include <hip/hip_runtime.h>
#include <hip/hip_cooperative_groups.h>
#include <cstdio>
#include <cstdint>
namespace cg = cooperative_groups;
#ifndef MK_COOP
#define MK_COOP 1
#endif
namespace pg8 {
#define PG8_LAS __attribute__((address_space(3)))
typedef unsigned short bf16_t;
typedef short bf16x8 __attribute__((ext_vector_type(8)));
typedef float f32x4 __attribute__((ext_vector_type(4)));
typedef unsigned u32x4 __attribute__((ext_vector_type(4)));
constexpr int BM = 256, BK = 64, HALF = 128, HTB = HALF * BK * 2  , STAGE_BYTES = 8 * HTB, NXCD = 8, WGM = 8;

__host__ __device__ __forceinline__ int lds_byte(int r, int c) { const int st = (r >> 4) * 2 + (c >> 5), rr = r & 15, cc = c & 31, ob = rr * 64 + cc * 2; return st * 1024 + (ob ^ (((ob >> 9) & 1) << 5)); }
__host__ __device__ __forceinline__ void stage_rc(int b, int& R, int& C) { const int st = b / 1024, sb = b % 1024, swz = sb ^ (((sb >> 9) & 1) << 5); R = (st >> 1) * 16 + swz / 64; C = (st & 1) * 32 + (swz % 64) / 2; }
__host__ __device__ __forceinline__ int perm32(int rho) { const int n = rho >> 4, i = rho & 15; return 8 * (i >> 2) + 4 * n + (i & 3); }

struct Unit { int pm, pn, ks; };
struct Gemm { const bf16_t* A; const bf16_t* Bt; int M, N, K, lda, ldb; };

struct StaticOrder {
    int nM, nN, nwg, G, c;
    __host__ __device__ void init(int M, int N, int G_, int c_) { nM = M / BM; nN = N / BM; nwg = nM * nN; G = G_; c = c_; }
    __host__ __device__ bool next(int i, Unit& u) const {
        const long L = (long)i * G + c; if (L >= nwg) return false;
        int wgid = (int)L; { const int q = nwg / NXCD, r = nwg % NXCD, xcd = wgid % NXCD, off = wgid / NXCD; wgid = (xcd < r ? xcd * (q + 1) : r * (q + 1) + (xcd - r) * q) + off; }
        const int nig = WGM * nN, gid = wgid / nig, fm = gid * WGM, gsz = (nM - fm) < WGM ? (nM - fm) : WGM;
        u.pm = fm + ((wgid % nig) % gsz); u.pn = (wgid % nig) / gsz; u.ks = 0; return true;
    }
    __device__ __forceinline__ void a_ready(const Unit&) const {}
    __device__ __forceinline__ void done(const Unit&) const {}
};
__device__ __forceinline__ unsigned cvt_pk_bf16(float lo, float hi) { unsigned r; asm volatile("v_cvt_pk_bf16_f32 %0, %1, %2" : "=v"(r) : "v"(lo), "v"(hi)); return r; }
typedef float f32x2 __attribute__((ext_vector_type(2)));
__device__ __forceinline__ f32x2 gelu_pk(f32x2 v) {
    const f32x2 av = __builtin_elementwise_abs(v), d = av * 0.2316418882f + 1.0f;
    f32x2 t; t.x = __builtin_amdgcn_rcpf(d.x); t.y = __builtin_amdgcn_rcpf(d.y);
    f32x2 q = t * 0.5307027145f + (-0.7265760135f); q = q * t + 0.7107068705f; q = q * t + (-0.142248368f); q = q * t + 0.127414796f; q = q * t;
    const f32x2 s = (v * v) * (-0.72134752044f);
    f32x2 e; e.x = __builtin_amdgcn_exp2f(s.x); e.y = __builtin_amdgcn_exp2f(s.y);
    const f32x2 m = v * (q * e), r = v - m;
    f32x2 o; o.x = v.x < 0.f ? m.x : r.x; o.y = v.y < 0.f ? m.y : r.y; return o;
}

struct EpiF32 {
    static constexpr bool PERM = false, AFTER_DRAIN = false;
    float* C; int ldc; const float* bias;
    __device__ __forceinline__ void operator()(const f32x4 (&acc)[2][2][4][2], const Unit& u, int wr, int wc, int fr, int fq) const {
        const int row0 = u.pm * BM + wr * 64 + fr, col0 = u.pn * BM + wc * 32 + 4 * fq;
        f32x4 bv[2][2];
#pragma unroll
        for (int bj = 0; bj < 2; ++bj)
#pragma unroll
            for (int n = 0; n < 2; ++n) bv[bj][n] = bias ? *(const f32x4*)(bias + col0 + bj * HALF + n * 16) : (f32x4){0.f, 0.f, 0.f, 0.f};
#pragma unroll
        for (int ai = 0; ai < 2; ++ai)
#pragma unroll
            for (int m = 0; m < 4; ++m) { float* rowp = C + (size_t)(row0 + ai * HALF + m * 16) * ldc + col0;
#pragma unroll
                for (int bj = 0; bj < 2; ++bj)
#pragma unroll
                    for (int n = 0; n < 2; ++n) *(f32x4*)(rowp + bj * HALF + n * 16) = acc[ai][bj][m][n] + bv[bj][n]; }
    }
};
template <int ACT  > struct EpiBf16 {
    static constexpr bool PERM = true, AFTER_DRAIN = false;
    bf16_t* O; int ldc; const float* bias; int split_cols; size_t split_stride;
    __device__ __forceinline__ void operator()(const f32x4 (&acc)[2][2][4][2], const Unit& u, int wr, int wc, int fr, int fq) const {
        const int row0 = u.pm * BM + wr * 64 + fr; int colt = u.pn * BM; bf16_t* base = O;
        if (split_cols) { const int t = colt / split_cols; base += (size_t)t * split_stride; colt -= t * split_cols; }
        const int col0 = colt + wc * 32 + 8 * fq, bcol0 = u.pn * BM + wc * 32 + 8 * fq;
        f32x4 bv[2][2];
#pragma unroll
        for (int bj = 0; bj < 2; ++bj)
#pragma unroll
            for (int n = 0; n < 2; ++n) bv[bj][n] = bias ? *(const f32x4*)(bias + bcol0 + bj * HALF + 4 * n) : (f32x4){0.f, 0.f, 0.f, 0.f};
#pragma unroll
        for (int ai = 0; ai < 2; ++ai)
#pragma unroll
            for (int m = 0; m < 4; ++m) { bf16_t* rowp = base + (size_t)(row0 + ai * HALF + m * 16) * ldc + col0;
#pragma unroll
                for (int bj = 0; bj < 2; ++bj) { f32x4 v0 = acc[ai][bj][m][0] + bv[bj][0], v1 = acc[ai][bj][m][1] + bv[bj][1];
                    if (ACT == 1) { f32x2 a = gelu_pk((f32x2){v0[0], v0[1]}), b = gelu_pk((f32x2){v0[2], v0[3]}), c = gelu_pk((f32x2){v1[0], v1[1]}), d = gelu_pk((f32x2){v1[2], v1[3]});
                        v0 = (f32x4){a.x, a.y, b.x, b.y}; v1 = (f32x4){c.x, c.y, d.x, d.y}; }
                    if (ACT == 2) {
#pragma unroll
                        for (int j = 0; j < 4; ++j) { v0[j] = 0.5f * v0[j] * (1.0f + erff(v0[j] * 0.70710678f)); v1[j] = 0.5f * v1[j] * (1.0f + erff(v1[j] * 0.70710678f)); } }
                    u32x4 w; w.x = cvt_pk_bf16(v0[0], v0[1]); w.y = cvt_pk_bf16(v0[2], v0[3]); w.z = cvt_pk_bf16(v1[0], v1[1]); w.w = cvt_pk_bf16(v1[2], v1[3]);
                    *(u32x4*)(rowp + bj * HALF) = w; } }
    }
};
template <class Epi, class Sched, bool STAMP = false>
__device__ __forceinline__ void gemm_phase(PG8_LAS unsigned char* lds, const Gemm g, const Sched& S, const Epi& E, unsigned long long* stamps) {
    int tid_ = threadIdx.x; asm volatile("" : "+v"(tid_));
    const int tid = tid_, wid = __builtin_amdgcn_readfirstlane(tid >> 6), lane = tid & 63, wr = wid >> 2, wc = wid & 3, fr = lane & 15, fq = lane >> 4;
    const int K = g.K, nt = K / BK;
    int ts_lo = 0, ts_hi = 0, nts = 0; const unsigned long long rt_entry = STAMP ? (unsigned long long)wall_clock64() : 0ull;
#define PG8_STAMP() do { if (STAMP && wid == 0 && nts < 64) { const unsigned long long _c = (unsigned long long)clock64(); \
        ts_lo = (lane == nts) ? (int)(unsigned)_c : ts_lo; ts_hi = (lane == nts) ? (int)(unsigned)(_c >> 32) : ts_hi; ++nts; } } while (0)
    PG8_STAMP();
    unsigned voffA[2], voffB[2];
#pragma unroll
    for (int i = 0; i < 2; ++i) { int R, C; stage_rc(tid * 16 + i * 8192, R, C); const int Rb = Epi::PERM ? ((R & ~31) + perm32(R & 31)) : R;
        voffA[i] = (unsigned)(R * g.lda + C) * 2u; voffB[i] = (unsigned)(Rb * g.ldb + C) * 2u; }
    const size_t kstep = (size_t)(BK * 2);
    const size_t hstepA = (size_t)HALF * g.lda * 2, hstepB = (size_t)HALF * g.ldb * 2;
    const size_t tstepA = 2 * hstepA, tstepB = 2 * hstepB, sstep = (size_t)K * 2;
    const unsigned ldsw = (unsigned)wid * 1024u;
    const int aoff = lds_byte(wr * 64 + fr, fq * 8), boff = lds_byte(wc * 32 + fr, fq * 8);
#define PG8_SA(b, h) (((b) * 2 + (h)) * HTB)
#define PG8_SB(b, h) ((4 + (b) * 2 + (h)) * HTB)
#define PG8_STAGE(bufoff, gbase, voff) do { _Pragma("unroll") for (int _i = 0; _i < 2; ++_i) \
        __builtin_amdgcn_global_load_lds((const unsigned*)((const char*)(gbase) + (voff)[_i]), (PG8_LAS unsigned*)(lds + (bufoff) + ldsw + _i * 8192), 16, 0, 0); } while (0)
#define PG8_LDA(dst, b, h) do { _Pragma("unroll") for (int m = 0; m < 4; ++m) _Pragma("unroll") for (int k = 0; k < 2; ++k) dst[m][k] = *(const PG8_LAS bf16x8*)(lds + PG8_SA(b, h) + aoff + m * 2048 + k * 1024); } while (0)
#define PG8_LDB(dst, b, h) do { _Pragma("unroll") for (int n = 0; n < 2; ++n) _Pragma("unroll") for (int k = 0; k < 2; ++k) dst[n][k] = *(const PG8_LAS bf16x8*)(lds + PG8_SB(b, h) + boff + n * 2048 + k * 1024); } while (0)
#define PG8_MMA(ai, bj, At, Bt) do { __builtin_amdgcn_s_setprio(1); _Pragma("unroll") for (int m = 0; m < 4; ++m) _Pragma("unroll") for (int n = 0; n < 2; ++n) _Pragma("unroll") for (int k = 0; k < 2; ++k) \
        acc[ai][bj][m][n] = __builtin_amdgcn_mfma_f32_16x16x32_bf16(Bt[n][k], At[m][k], acc[ai][bj][m][n], 0, 0, 0); __builtin_amdgcn_s_setprio(0); } while (0)
#define PG8_WAIT_V(n) asm volatile("s_waitcnt vmcnt(" #n ")" ::: "memory")
#define PG8_WAIT_L(n) asm volatile("s_waitcnt lgkmcnt(" #n ")" ::: "memory")
#define PG8_BAR __builtin_amdgcn_s_barrier()
#define PG8_SCHED __builtin_amdgcn_sched_barrier(0)
    Unit cur, nxt; int ui = 0;
    if (!S.next(0, cur)) return;
    f32x4 acc[2][2][4][2];
#pragma unroll
    for (int a = 0; a < 2; ++a)
#pragma unroll
        for (int b = 0; b < 2; ++b)
#pragma unroll
            for (int m = 0; m < 4; ++m)
#pragma unroll
                for (int n = 0; n < 2; ++n) acc[a][b][m][n] = (f32x4){0.f, 0.f, 0.f, 0.f};
    bf16x8 At[4][2], B0[2][2], B1[2][2];
    const char* cA = (const char*)g.A + (size_t)cur.pm * tstepA + (size_t)cur.ks * sstep; const char* cB = (const char*)g.Bt + (size_t)cur.pn * tstepB + (size_t)cur.ks * sstep;
    S.a_ready(cur);
    PG8_STAGE(PG8_SB(0, 0), cB, voffB); PG8_STAGE(PG8_SA(0, 0), cA, voffA); PG8_STAGE(PG8_SB(0, 1), cB + hstepB, voffB); PG8_STAGE(PG8_SA(0, 1), cA + hstepA, voffA);
    if (wr == 1) PG8_BAR;
    PG8_WAIT_V(4); PG8_BAR;
    PG8_STAGE(PG8_SB(1, 0), cB + kstep, voffB); PG8_STAGE(PG8_SA(1, 0), cA + kstep, voffA); PG8_STAGE(PG8_SB(1, 1), cB + hstepB + kstep, voffB);
    PG8_WAIT_V(6); PG8_BAR;
    PG8_STAMP();
    for (;;) {
        const bool has_next = S.next(ui + 1, nxt);
        const char* nA = has_next ? (const char*)g.A + (size_t)nxt.pm * tstepA + (size_t)nxt.ks * sstep : cA; const char* nB = has_next ? (const char*)g.Bt + (size_t)nxt.pn * tstepB + (size_t)nxt.ks * sstep : cB;
        for (int t = 0; t < nt; t += 2) {
            const bool last = (t == nt - 2);
            const char* a1 = cA + (size_t)(t + 1) * kstep;
            const char* a2 = last ? nA : cA + (size_t)(t + 2) * kstep; const char* b2 = last ? nB : cB + (size_t)(t + 2) * kstep;
            const char* a3 = a2 + kstep; const char* b3 = b2 + kstep;
            if (last && has_next) S.a_ready(nxt);
            PG8_LDB(B0, 0, 0); PG8_SCHED; PG8_LDA(At, 0, 0); PG8_STAGE(PG8_SA(1, 1), a1 + hstepA, voffA);
            PG8_WAIT_L(8); PG8_BAR; PG8_WAIT_L(0); PG8_MMA(0, 0, At, B0); PG8_BAR; PG8_SCHED;
            PG8_LDB(B1, 0, 1); PG8_STAGE(PG8_SB(0, 0), b2, voffB);
            PG8_BAR; PG8_WAIT_L(0); PG8_MMA(0, 1, At, B1); PG8_BAR;
            PG8_LDA(At, 0, 1); PG8_STAGE(PG8_SA(0, 0), a2, voffA);
            PG8_BAR; PG8_WAIT_L(0); PG8_MMA(1, 0, At, B0); PG8_BAR; PG8_SCHED;
            PG8_STAGE(PG8_SB(0, 1), b2 + hstepB, voffB);
            PG8_WAIT_V(6); PG8_BAR; PG8_MMA(1, 1, At, B1); PG8_BAR;
            PG8_LDB(B0, 1, 0); PG8_SCHED; PG8_LDA(At, 1, 0); PG8_STAGE(PG8_SA(0, 1), a2 + hstepA, voffA);
            PG8_WAIT_L(8); PG8_BAR; PG8_WAIT_L(0); PG8_MMA(0, 0, At, B0); PG8_BAR; PG8_SCHED;
            PG8_LDB(B1, 1, 1); PG8_STAGE(PG8_SB(1, 0), b3, voffB);
            PG8_BAR; PG8_WAIT_L(0); PG8_MMA(0, 1, At, B1); PG8_BAR;
            PG8_LDA(At, 1, 1); PG8_STAGE(PG8_SA(1, 0), a3, voffA);
            PG8_BAR; PG8_WAIT_L(0); PG8_MMA(1, 0, At, B0); PG8_BAR; PG8_SCHED;
            PG8_STAGE(PG8_SB(1, 1), b3 + hstepB, voffB);
            PG8_WAIT_V(6); PG8_BAR; PG8_MMA(1, 1, At, B1); PG8_BAR;
        }
        PG8_STAMP();
        if constexpr (!Epi::AFTER_DRAIN) { E(acc, cur, wr, wc, fr, fq); S.done(cur); }
        PG8_STAMP();
        if (!has_next) break;
#pragma unroll
        for (int a = 0; a < 2; ++a)
#pragma unroll
            for (int b = 0; b < 2; ++b)
#pragma unroll
                for (int m = 0; m < 4; ++m)
#pragma unroll
                    for (int n = 0; n < 2; ++n) acc[a][b][m][n] = (f32x4){0.f, 0.f, 0.f, 0.f};
        cur = nxt; cA = nA; cB = nB; ++ui;
    }
    PG8_WAIT_V(0);
    if (wr == 0) PG8_BAR;
    PG8_BAR;
    if constexpr (Epi::AFTER_DRAIN) { E.fused(acc, cur, wr, wc, fr, fq, lds, wid, lane); S.done(cur); }
    PG8_STAMP();
    if (STAMP && wid == 0) { stamps[lane] = lane < nts ? (((unsigned long long)(unsigned)ts_hi << 32) | (unsigned)ts_lo) : 0ull;
        if (lane == 62) stamps[62] = rt_entry; if (lane == 63) stamps[63] = (unsigned long long)wall_clock64(); }
#undef PG8_STAMP
#undef PG8_SA
#undef PG8_SB
#undef PG8_STAGE
#undef PG8_LDA
#undef PG8_LDB
#undef PG8_MMA
#undef PG8_WAIT_V
#undef PG8_WAIT_L
#undef PG8_BAR
#undef PG8_SCHED
}
}

#define LAS __attribute__((address_space(3)))
typedef unsigned short bf16_t;
typedef short bf16x8 __attribute__((ext_vector_type(8)));
typedef float f32x4 __attribute__((ext_vector_type(4)));
typedef float f32x2 __attribute__((ext_vector_type(2)));
typedef unsigned u32x4 __attribute__((ext_vector_type(4)));
typedef unsigned u32x2 __attribute__((ext_vector_type(2)));

constexpr int D = 1024, NP = 16384, NS = 512, NTOK = NP + NS, SEQ = 2048, NB = 8, NSB = 128, DEPTH = 4;
constexpr int INW = 2568, NPROJ = 2560, DFF = 2816, NGU = 5632;
constexpr int PC_G = 1536, PC_SSM = 2048, PC_POOL = 2304;
constexpr float EPS = 1e-6f;
constexpr int LDS_BYTES = 163840;

constexpr size_t SZ_WIN = (size_t)NPROJ * D * 2, SZ_WOUT = (size_t)D * D * 2, SZ_WGU = (size_t)NGU * D * 2, SZ_WDN = (size_t)D * DFF * 2;
constexpr size_t SZ_WAB = 8 * D * 4, SZ_GLUT = 256 * 256 * 2, SZ_POOLT = 4 * 64 * 64 * 2, SZ_SSMK = 16 * 64 * 4 * 4, SZ_BBAR = 16 * 64 * 32 * 4;
constexpr size_t WS_WIN = 0;
constexpr size_t WS_WOUT = WS_WIN + DEPTH * SZ_WIN;
constexpr size_t WS_WGU = WS_WOUT + DEPTH * SZ_WOUT;
constexpr size_t WS_WDN = WS_WGU + DEPTH * SZ_WGU;
constexpr size_t WS_WAB = WS_WDN + DEPTH * SZ_WDN;
constexpr size_t WS_GLUT = WS_WAB + DEPTH * SZ_WAB;
constexpr size_t WS_POOLT = WS_GLUT + DEPTH * SZ_GLUT;
constexpr size_t WS_SSMK = WS_POOLT + DEPTH * SZ_POOLT;
constexpr size_t WS_BBAR = WS_SSMK + DEPTH * SZ_SSMK;
constexpr size_t WS_H = WS_BBAR + DEPTH * SZ_BBAR;
constexpr size_t WS_AB = WS_H + (size_t)NTOK * D * 2;
constexpr size_t WS_MIX = WS_AB + (size_t)NTOK * 8 * 4;
constexpr size_t WS_MIXO = WS_MIX + (size_t)NTOK * D * 2;
constexpr size_t WS_SSME = WS_MIXO + (size_t)NTOK * D * 4;
constexpr size_t WS_PROJ = WS_SSME + (size_t)8 * 32 * 16 * 64 * 2 * 4;
constexpr size_t WS_DW = WS_PROJ + (size_t)NTOK * NPROJ * 2;
constexpr size_t WS_DKC = WS_DW + (size_t)1024 * 8192 * 4;
constexpr size_t WS_DQD = WS_DKC + (size_t)1024 * 8192 * 2;
constexpr size_t WS_DQK = WS_DQD + (size_t)1024 * 8192 * 2;
constexpr size_t WS_DKT = WS_DQK + (size_t)1024 * 4096 * 2;
constexpr size_t WS_DGL = WS_DKT + (size_t)1024 * 8192 * 2;
constexpr size_t WS_DGS = WS_DGL + 4096;
constexpr size_t WS_BAR = WS_DGS + (size_t)1024 * 8192 * 2;
constexpr size_t WS_PARTS = WS_BAR + 16384;
constexpr size_t WS_END = WS_PARTS + (size_t)11 * 512 * 1024 * 4;
constexpr size_t WS_HID = WS_PROJ;
static_assert(WS_HID + (size_t)NTOK * DFF * 2 <= WS_END, "HID overlay");
static_assert(WS_H % 256 == 0 && WS_PROJ % 256 == 0 && WS_DW % 256 == 0, "align");

constexpr size_t O_YP = 0, O_YS = O_YP + (size_t)NP * D, O_DP = O_YS + (size_t)NS * D, O_CP = O_DP + (size_t)DEPTH * 8 * 4 * 16384,
                 O_REP = O_CP + (size_t)DEPTH * 8 * 3 * 1536, O_IMP = O_REP + (size_t)DEPTH * 8 * 1024, O_PP = O_IMP + (size_t)DEPTH * 8 * 1024,
                 O_DS = O_PP + (size_t)DEPTH * 8 * 15 * 256, O_CS = O_DS + (size_t)DEPTH * 128 * 4 * 16384, O_RES = O_CS + (size_t)DEPTH * 128 * 3 * 1536,
                 O_IMS = O_RES + (size_t)DEPTH * 128 * 1024, O_PS = O_IMS + (size_t)DEPTH * 128 * 1024, O_END = O_PS + (size_t)DEPTH * 128 * 15 * 256;

struct Args { const float* in[32]; float* out; unsigned char* ws; int ph_lo, ph_hi; };
typedef const float* cfp_t;
typedef __attribute__((address_space(4))) const unsigned char* kptr_t;
struct InProxy { __device__ __forceinline__ const float* operator[](int i) const {
    kptr_t p = (kptr_t)__builtin_amdgcn_kernarg_segment_ptr(); asm volatile("" : "+s"(p)); return *(__attribute__((address_space(4))) const cfp_t*)(p + 8 * i); } };
struct DevArgs { InProxy in; float* out; unsigned char* ws; int ph_lo, ph_hi; };
enum { I_XP = 0, I_XS, I_SDELTA, I_SCONV, I_SRE, I_SIM, I_SPOOL, I_NMPRE, I_NMPOST, I_NFPRE, I_NFPOST, I_WIN, I_CONVW, I_ALOG, I_DTB, I_ONORM,
       I_ARE, I_AIM, I_LOGDT, I_BRE, I_BIM, I_CRE, I_CIM, I_SSMD, I_GLUW, I_GLUB, I_POOLW, I_POOLS, I_WOUT, I_WG, I_WU, I_WD };

__device__ __forceinline__ unsigned f2bf(float f) { unsigned u = __float_as_uint(f); return (u + 0x7fffu + ((u >> 16) & 1u)) >> 16; }
__device__ __forceinline__ float bf2f(unsigned b) { return __uint_as_float(b << 16); }
__device__ __forceinline__ unsigned pk2(float lo, float hi) { return f2bf(lo) | (f2bf(hi) << 16); }
__device__ __forceinline__ float wave_sum(float v) {
#pragma unroll
    for (int o = 1; o < 64; o <<= 1) v += __shfl_xor(v, o);
    return v;
}
__device__ __forceinline__ float silu_f(float y) { return y / (1.f + __expf(-y)); }
__device__ __forceinline__ float sigmoid_f(float y) { return 1.f / (1.f + __expf(-y)); }
__device__ __forceinline__ float gelu_tanh_f(float x) { const float t = tanhf(0.7978845608028654f * (x + 0.044715f * x * x * x)); return 0.5f * x * (1.f + t); }
__device__ __forceinline__ f32x4 mfma16(bf16x8 a, bf16x8 b, f32x4 c) { return __builtin_amdgcn_mfma_f32_16x16x32_bf16(a, b, c, 0, 0, 0); }
#define LDS_FENCE() asm volatile("s_waitcnt lgkmcnt(0)" ::: "memory")

struct EpiSwiGLU {
    static constexpr bool PERM = false, AFTER_DRAIN = false;
    bf16_t* O; int ldc;
    __device__ __forceinline__ void operator()(const pg8::f32x4 (&acc)[2][2][4][2], const pg8::Unit& u, int wr, int wc, int fr, int fq) const {
        const int row0 = u.pm * 256 + wr * 64 + fr, hid0 = u.pn * 128 + wc * 16 + 4 * fq;
#pragma unroll
        for (int ai = 0; ai < 2; ++ai)
#pragma unroll
            for (int m = 0; m < 4; ++m) { bf16_t* rowp = O + (size_t)(row0 + ai * 128 + m * 16) * ldc + hid0;
#pragma unroll
                for (int bj = 0; bj < 2; ++bj) { const pg8::f32x4 g = acc[ai][bj][m][0], v = acc[ai][bj][m][1];
                    u32x2 w; w.x = pk2(silu_f(g[0]) * v[0], silu_f(g[1]) * v[1]); w.y = pk2(silu_f(g[2]) * v[2], silu_f(g[3]) * v[3]);
                    *(u32x2*)(rowp + bj * 64) = w; } }
    }
};

#define XB_TMO      128
#define XB_XCNT(j)  (256  + 64 * (j))
#define XB_XSUB(j)  (1280 + 64 * (j))
#define XB_XGEN(j)  (2304 + 64 * (j))
#define XB_TOP      3328
#define XB_TOPGEN   3392
#define XCD_BAR_WORDS 3456
#define XB_SPIN_CAP (1u << 18)

__device__ __forceinline__ unsigned xb_ld(unsigned* p)              { return __hip_atomic_load(p, __ATOMIC_RELAXED, __HIP_MEMORY_SCOPE_AGENT); }
__device__ __forceinline__ unsigned xb_add(unsigned* p, unsigned v) { return __hip_atomic_fetch_add(p, v, __ATOMIC_RELAXED, __HIP_MEMORY_SCOPE_AGENT); }
__device__ __forceinline__ unsigned xb_xcc_id() { return (unsigned)__builtin_amdgcn_s_getreg((3 << 11) | 20) & 0xFu; }
#define XB_SPIN(cond, bar) do { unsigned _sp = 0; while (cond) { __builtin_amdgcn_s_sleep(1); \
    if ((++_sp & 255u) == 0u) { if (xb_ld(&(bar)[XB_TMO])) break; if (_sp > XB_SPIN_CAP) { atomicAdd(&(bar)[XB_TMO], 1u); break; } } } } while (0)

struct XcdBarrier {
    unsigned* bar; unsigned x;
    volatile LAS unsigned* st;
};

__device__ __forceinline__ XcdBarrier xcd_barrier_post(unsigned* bar, volatile LAS unsigned* st) {
    XcdBarrier b; b.bar = bar; b.x = xb_xcc_id(); b.st = st;
    if (threadIdx.x == 0) (void)xb_add(&bar[XB_XCNT(b.x)], 1u);
    return b;
}
__device__ __forceinline__ void xcd_barrier_complete(unsigned* bar, unsigned x, unsigned& nloc, unsigned& nx) {
    const unsigned G = gridDim.x * gridDim.y * gridDim.z;
    unsigned sum, cnt, mine, sp = 0u;
    for (;;) {
        sum = 0u; cnt = 0u; mine = 0u;
#pragma unroll
        for (unsigned j = 0; j < 16; ++j) { const unsigned c = xb_ld(&bar[XB_XCNT(j)]); sum += c; cnt += (c > 0u) ? 1u : 0u; mine = (j == x) ? c : mine; }
        if (sum == G) break;
        __builtin_amdgcn_s_sleep(1);
        if ((++sp & 255u) == 0u) { if (xb_ld(&bar[XB_TMO])) break; if (sp > XB_SPIN_CAP) { atomicAdd(&bar[XB_TMO], 1u); break; } }
    }
    nloc = mine > 0u ? mine : 1u; nx = cnt > 0u ? cnt : 1u;
}

__device__ __forceinline__ void xcd_barrier(const XcdBarrier& b) {
    asm volatile("s_waitcnt vmcnt(0)" ::: "memory");
    __syncthreads();
    if (threadIdx.x == 0) {
        unsigned* bar = b.bar; asm volatile("" : "+s"(bar));
        __builtin_amdgcn_s_waitcnt(0);
        unsigned nloc = b.st[0], nx = b.st[1];
        if (nloc == 0u) { xcd_barrier_complete(bar, b.x, nloc, nx); b.st[0] = nloc; b.st[1] = nx; }
        const unsigned old = xb_add(&bar[XB_XSUB(b.x)], 1u);
        const unsigned gen = old / nloc;
        if (old + 1u == (gen + 1u) * nloc) {
            __builtin_amdgcn_fence(__ATOMIC_RELEASE, "agent");
            asm volatile("s_waitcnt vmcnt(0)" ::: "memory");
            const unsigned og = xb_add(&bar[XB_TOP], 1u);
            const unsigned tg = og / nx;
            if (og + 1u == (tg + 1u) * nx) xb_add(&bar[XB_TOPGEN], 1u);
            else XB_SPIN(xb_ld(&bar[XB_TOPGEN]) == tg, bar);
            __builtin_amdgcn_fence(__ATOMIC_ACQUIRE, "agent");
            xb_add(&bar[XB_XGEN(b.x)], 1u);
            asm volatile("s_waitcnt vmcnt(0)" ::: "memory");
        } else {
            XB_SPIN(xb_ld(&bar[XB_XGEN(b.x)]) == gen, bar);
            __builtin_amdgcn_fence(__ATOMIC_ACQUIRE, "agent");
            asm volatile("s_waitcnt vmcnt(0)" ::: "memory");
        }
    }
    __syncthreads();
}

struct SliceOrder {
    int nunits, G, c;
    __device__ __forceinline__ bool next(int i, pg8::Unit& u) const { const int L = i * G + c; if (L >= nunits) return false; const int t = L & 7; u.pm = t >> 2; u.pn = t & 3; u.ks = L >> 3; return true; }
    __device__ __forceinline__ void a_ready(const pg8::Unit&) const {}
    __device__ __forceinline__ void done(const pg8::Unit&) const {}
};
struct EpiF32Part {
    static constexpr bool PERM = false, AFTER_DRAIN = false;
    float* C;
    __device__ __forceinline__ void operator()(const pg8::f32x4 (&acc)[2][2][4][2], const pg8::Unit& u, int wr, int wc, int fr, int fq) const {
        const int row0 = u.pm * 256 + wr * 64 + fr, col0 = u.pn * 256 + wc * 32 + 4 * fq; float* base = C + (size_t)u.ks * (512 * 1024);
#pragma unroll
        for (int ai = 0; ai < 2; ++ai)
#pragma unroll
            for (int m = 0; m < 4; ++m) { float* rowp = base + (size_t)(row0 + ai * 128 + m * 16) * 1024 + col0;
#pragma unroll
                for (int bj = 0; bj < 2; ++bj)
#pragma unroll
                    for (int n = 0; n < 2; ++n) *(pg8::f32x4*)(rowp + bj * 128 + n * 16) = acc[ai][bj][m][n]; }
    }
};

struct SrcIn { const float* w; __device__ __forceinline__ float operator()(int k, int n) const { return w[(size_t)k * INW + (n < 1536 ? n : n + 8)]; } };
struct SrcPlain { const float* w; int N; __device__ __forceinline__ float operator()(int k, int n) const { return w[(size_t)k * N + n]; } };
struct SrcGU { const float* g; const float* u; __device__ __forceinline__ float operator()(int k, int n) const { const int r = n & 31, hid = (n >> 5) * 16 + (r & 15); const long long du = (r < 16) ? 0ll : (long long)(u - g); return g[du + (long long)k * DFF + hid]; } };
template <class Src> __device__ __forceinline__ void transpose_item(const Src& src, int K, bf16_t* WT, int nblk, LAS float* scr, int item, int lane) {
    const int kb = item / nblk, nb = item % nblk, k0 = 64 * kb, n0 = 32 * nb;
#pragma unroll 8
    for (int i = 0; i < 32; ++i) { const int kk = 2 * i + (lane >> 5); scr[kk * 33 + (lane & 31)] = src(k0 + kk, n0 + (lane & 31)); }
    LDS_FENCE();
    const int c = lane & 7;
#pragma unroll
    for (int j = 0; j < 4; ++j) { const int n = (lane >> 3) + 8 * j; const LAS float* s = scr + (8 * c) * 33 + n;
        u32x4 o; o.x = pk2(s[0 * 33], s[1 * 33]); o.y = pk2(s[2 * 33], s[3 * 33]); o.z = pk2(s[4 * 33], s[5 * 33]); o.w = pk2(s[6 * 33], s[7 * 33]);
        *(u32x4*)(WT + (size_t)(n0 + n) * K + k0 + 8 * c) = o; }
    LDS_FENCE();
}

__device__ __forceinline__ void norm_rows(const float* T, const float* wt, const float* X0, const float* X1, float* Xout, const float* wh, bf16_t* H,
                                          const float* Wab, float* AB, int gw, int NGW, int lane, const float* Tp = nullptr, int ns = 0) {
#pragma unroll 1
    for (int m = gw; m < NTOK; m += NGW) {
        const float* xr = (X1 && m >= NP) ? X1 + (size_t)(m - NP) * D : X0 + (size_t)m * D;
        f32x4 x[4];
#pragma unroll
        for (int j = 0; j < 4; ++j) x[j] = ((const f32x4*)xr)[lane + 64 * j];
        if (T) {
            f32x4 t[4]; float ss = 0.f;
#pragma unroll
            for (int j = 0; j < 4; ++j) {
                if (Tp && m >= NP) { f32x4 a = {0.f, 0.f, 0.f, 0.f}; for (int q = 0; q < ns; ++q) a += ((const f32x4*)(Tp + (size_t)q * (512 * 1024) + (size_t)(m - NP) * D))[lane + 64 * j]; t[j] = a; }
                else t[j] = ((const f32x4*)(T + (size_t)m * D))[lane + 64 * j];
                ss += (t[j].x * t[j].x + t[j].y * t[j].y) + (t[j].z * t[j].z + t[j].w * t[j].w); }
            ss = wave_sum(ss); const float r = rsqrtf(ss * (1.f / D) + EPS);
#pragma unroll
            for (int j = 0; j < 4; ++j) { const f32x4 w = ((const f32x4*)wt)[lane + 64 * j]; x[j] += t[j] * r * w; }
        }
        if (Xout) {
#pragma unroll
            for (int j = 0; j < 4; ++j) ((f32x4*)(Xout + (size_t)m * D))[lane + 64 * j] = x[j];
        }
        if (H) {
            float ss = 0.f;
#pragma unroll
            for (int j = 0; j < 4; ++j) ss += (x[j].x * x[j].x + x[j].y * x[j].y) + (x[j].z * x[j].z + x[j].w * x[j].w);
            ss = wave_sum(ss); const float r = rsqrtf(ss * (1.f / D) + EPS);
            f32x4 hv[4];
#pragma unroll
            for (int j = 0; j < 4; ++j) { const f32x4 w = ((const f32x4*)wh)[lane + 64 * j]; hv[j] = x[j] * r * w;
                u32x2 o; o.x = pk2(hv[j].x, hv[j].y); o.y = pk2(hv[j].z, hv[j].w); ((u32x2*)(H + (size_t)m * D))[lane + 64 * j] = o; }
            if (Wab) {
#pragma unroll
                for (int c = 0; c < 8; ++c) { float d = 0.f;
#pragma unroll
                    for (int j = 0; j < 4; ++j) { const f32x4 w = ((const f32x4*)(Wab + c * D))[lane + 64 * j]; d += (hv[j].x * w.x + hv[j].y * w.y) + (hv[j].z * w.z + hv[j].w * w.w); }
                    d = wave_sum(d); if (lane == 0) AB[(size_t)m * 8 + c] = d; }
            }
        }
    }
}

__device__ __forceinline__ void prologue(const DevArgs& A, LAS unsigned char* lds, int wave, int lane, int gw, int NGW) {
    LAS float* scr = (LAS float*)(lds + wave * 8704);
    constexpr int I_IN = 16 * 80, I_OUT = 16 * 32, I_GU = 16 * 176, I_DN = 44 * 32, I_GLU = 4 * 8, I_POOL = 8, PER = I_IN + I_OUT + I_GU + I_DN + I_GLU + I_POOL;
#pragma unroll 1
    for (int it = gw; it < DEPTH * PER; it += NGW) {
        const int l = it / PER; int r = it % PER;
        if (r < I_IN) { SrcIn s{A.in[I_WIN] + (size_t)l * D * INW}; transpose_item(s, D, (bf16_t*)(A.ws + WS_WIN + l * SZ_WIN), NPROJ / 32, scr, r, lane); continue; } r -= I_IN;
        if (r < I_OUT) { SrcPlain s{A.in[I_WOUT] + (size_t)l * D * D, D}; transpose_item(s, D, (bf16_t*)(A.ws + WS_WOUT + l * SZ_WOUT), D / 32, scr, r, lane); continue; } r -= I_OUT;
        if (r < I_GU) { SrcGU s{A.in[I_WG] + (size_t)l * D * DFF, A.in[I_WU] + (size_t)l * D * DFF}; transpose_item(s, D, (bf16_t*)(A.ws + WS_WGU + l * SZ_WGU), NGU / 32, scr, r, lane); continue; } r -= I_GU;
        if (r < I_DN) { SrcPlain s{A.in[I_WD] + (size_t)l * DFF * D, D}; transpose_item(s, DFF, (bf16_t*)(A.ws + WS_WDN + l * SZ_WDN), D / 32, scr, r, lane); continue; } r -= I_DN;
        if (r < I_GLU) { SrcPlain s{A.in[I_GLUW] + (size_t)l * 65536, 256}; transpose_item(s, 256, (bf16_t*)(A.ws + WS_GLUT + l * SZ_GLUT), 8, scr, r, lane); continue; } r -= I_GLU;
        { const int g = r >> 1; SrcPlain s{A.in[I_POOLW] + (size_t)(l * 4 + g) * 4096, 64}; transpose_item(s, 64, (bf16_t*)(A.ws + WS_POOLT + l * SZ_POOLT) + g * 4096, 2, scr, r & 1, lane); }
    }
    const int gt = gw * 64 + lane, NT = NGW * 64;
    float* wab = (float*)(A.ws + WS_WAB);
#pragma unroll 1
    for (int i = gt; i < DEPTH * 8 * D; i += NT) { const int l = i / (8 * D), j = (i / D) & 7, k = i % D; wab[i] = A.in[I_WIN][((size_t)l * D + k) * INW + 1536 + j]; }
    float* ssmk = (float*)(A.ws + WS_SSMK); float* bbar = (float*)(A.ws + WS_BBAR);
#pragma unroll 1
    for (int i = gt; i < DEPTH * 16 * 64; i += NT) {
        const int lg = i >> 6;
        const float dt = expf(A.in[I_LOGDT][lg]), ar = A.in[I_ARE][i], ai = A.in[I_AIM][i];
        const float mag = expf(ar * dt);
        float rev = ai * dt * 0.15915494309189535f; rev -= floorf(rev);
        const float sn = __builtin_amdgcn_sinf(rev), cs = __builtin_amdgcn_cosf(rev);
        const float lr = mag * cs, li = mag * sn;
        float pr = lr, pi = li;
#pragma unroll
        for (int q = 0; q < 6; ++q) { const float nr2 = pr * pr - pi * pi, ni2 = 2.f * pr * pi; pr = nr2; pi = ni2; }
        ssmk[i * 4 + 0] = lr; ssmk[i * 4 + 1] = li; ssmk[i * 4 + 2] = pr; ssmk[i * 4 + 3] = pi;
        const float nr = lr - 1.f, ni = li, d2 = ar * ar + ai * ai;
        const float cre = (nr * ar + ni * ai) / d2, cim = (ni * ar - nr * ai) / d2;
#pragma unroll
        for (int h = 0; h < 16; ++h) { const float br = A.in[I_BRE][(size_t)i * 16 + h], bi = A.in[I_BIM][(size_t)i * 16 + h];
            bbar[(size_t)i * 32 + h] = cre * br - cim * bi; bbar[(size_t)i * 32 + 16 + h] = cre * bi + cim * br; }
    }
}

__device__ __forceinline__ unsigned bfmul2(unsigned pk, float f0, float f1) { return pg8::cvt_pk_bf16(__uint_as_float(pk << 16) * f0, __uint_as_float(pk & 0xffff0000u) * f1); }
__device__ __forceinline__ void delta_prep_item(const DevArgs& A, int l, LAS unsigned char* lds, int item, int tid, int wave, int lane) {
    asm volatile("" : "+v"(tid)); lane = tid & 63; wave = __builtin_amdgcn_readfirstlane(tid >> 6);
    const int bh = item >> 5, n = item & 31, b = bh >> 2, h = bh & 3;
    const int tok0 = b * SEQ + n * 64;
    LAS bf16_t* QS = (LAS bf16_t*)(lds); LAS bf16_t* KS = (LAS bf16_t*)(lds + 17408);
    LAS unsigned char* KT = lds + 34816; LAS unsigned char* VT = lds + 53248; LAS unsigned char* RTK = lds + 71680;
    LAS float* AM = (LAS float*)(lds + 90112); LAS float* PM = (LAS float*)(lds + 107520); LAS float* PSC = PM; LAS float* TM = (LAS float*)(lds + 124928);
    LAS unsigned char* TB = lds + 142336;
    LAS float* GAM = (LAS float*)(lds + 151552); LAS float* BETA = GAM + 64; LAS float* RQ = GAM + 128; LAS float* RK = GAM + 192;
    LAS float* F2 = GAM + 256; LAS float* F3 = GAM + 320; LAS float* F4 = GAM + 384;
    const bf16_t* PROJ = (const bf16_t*)(A.ws + WS_PROJ);
    const float* AB = (const float*)(A.ws + WS_AB);
    u32x4 gv[2];
#pragma unroll
    for (int j = 0; j < 2; ++j) { const int id = tid + 512 * j; gv[j] = *(const u32x4*)(PROJ + (size_t)(tok0 + (id >> 4)) * NPROJ + PC_G + h * 128 + (id & 15) * 8); }
    if (tid < 384) {
        const int part = tid >> 7, c = tid & 127, col = part * 512 + h * 128 + c;
        const float* cw = A.in[I_CONVW] + (size_t)l * 4 * 1536;
        const float w0 = cw[col], w1 = cw[1536 + col], w2 = cw[3072 + col], w3 = cw[4608 + col];
        const bf16_t* pp = PROJ + (size_t)tok0 * NPROJ + col;
        float xr[67];
#pragma unroll
        for (int t = 0; t < 67; ++t) xr[t] = (n > 0 || t >= 3) ? bf2f(pp[(long)(t - 3) * NPROJ]) : 0.f;
        unsigned pk[32];
#pragma unroll
        for (int t = 0; t < 64; t += 2) {
            const float s0 = silu_f(w0 * xr[t] + w1 * xr[t + 1] + w2 * xr[t + 2] + w3 * xr[t + 3]);
            const float s1 = silu_f(w0 * xr[t + 1] + w1 * xr[t + 2] + w2 * xr[t + 3] + w3 * xr[t + 4]);
            pk[t >> 1] = pg8::cvt_pk_bf16(s0, s1);
        }
        if (part < 2) { LAS bf16_t* dst = (part == 0 ? QS : KS) + c;
#pragma unroll
            for (int t = 0; t < 64; t += 2) { dst[t * 136] = (bf16_t)(pk[t >> 1] & 0xffffu); dst[(t + 1) * 136] = (bf16_t)(pk[t >> 1] >> 16); } }
        if (part > 0) { LAS unsigned char* dst = (part == 1 ? KT : VT) + c * 144;
#pragma unroll
            for (int q = 0; q < 8; ++q) { u32x4 o; o.x = pk[4 * q]; o.y = pk[4 * q + 1]; o.z = pk[4 * q + 2]; o.w = pk[4 * q + 3]; *(LAS u32x4*)(dst + q * 16) = o; } }
    } else if (tid < 448) {
        const int t = tid - 384;
        const float a = AB[(size_t)(tok0 + t) * 8 + h], bb = AB[(size_t)(tok0 + t) * 8 + 4 + h];
        const float xx = a + A.in[I_DTB][l * 4 + h];
        const float sp = xx > 20.f ? xx : log1pf(expf(xx));
        float lg = -expf(A.in[I_ALOG][l * 4 + h]) * sp;
#pragma unroll
        for (int off = 1; off < 64; off <<= 1) { const float v = __shfl_up(lg, off); if (lane >= off) lg += v; }
        GAM[t] = lg; BETA[t] = 1.f / (1.f + expf(-bb));
    }
    __syncthreads();
    {
        const int t = tid >> 3, part = tid & 7; float sq = 0.f, sk = 0.f;
#pragma unroll
        for (int j = 0; j < 16; ++j) { const float q = bf2f(QS[t * 136 + part * 16 + j]), k = bf2f(KS[t * 136 + part * 16 + j]); sq += q * q; sk += k * k; }
        sq += __shfl_xor(sq, 1); sq += __shfl_xor(sq, 2); sq += __shfl_xor(sq, 4);
        sk += __shfl_xor(sk, 1); sk += __shfl_xor(sk, 2); sk += __shfl_xor(sk, 4);
        if (part == 0) { const float rq = rsqrtf(sq + EPS) * 0.08838834764831845f, rk = rsqrtf(sk + EPS), g = GAM[t], eg = __expf(g), bt = BETA[t];
            RQ[t] = rq; RK[t] = rk; F2[t] = bt * eg * rk; F3[t] = rk * __expf(GAM[63] - g); F4[t] = rq * eg; }
    }
    {
        const int prod = wave >> 2, mt = wave & 3, fr = lane & 15, quad = lane >> 4;
        LAS bf16_t* Aop = prod ? QS : KS; LAS float* dst = prod ? PM : AM;
        bf16x8 a[4];
#pragma unroll
        for (int kk = 0; kk < 4; ++kk) a[kk] = *(LAS bf16x8*)(Aop + (mt * 16 + fr) * 136 + kk * 32 + quad * 8);
#pragma unroll
        for (int nt = 0; nt < 4; ++nt) { f32x4 acc = {0.f, 0.f, 0.f, 0.f};
#pragma unroll
            for (int kk = 0; kk < 4; ++kk) { const bf16x8 bq = *(LAS bf16x8*)(KS + (nt * 16 + fr) * 136 + kk * 32 + quad * 8); acc = mfma16(a[kk], bq, acc); }
#pragma unroll
            for (int i = 0; i < 4; ++i) dst[(mt * 16 + quad * 4 + i) * 68 + nt * 16 + fr] = acc[i]; }
    }
    __syncthreads();
    {
        const int t = tid >> 3, s8 = (tid & 7) * 8; const float gt = GAM[t], bk = BETA[t] * RK[t], rqt = RQ[t];
        float av[8], pv[8];
#pragma unroll
        for (int j = 0; j < 8; ++j) { const int s = s8 + j; const float rks = RK[s]; const float dec = (s <= t) ? __expf(gt - GAM[s]) * rks : 0.f;
            av[j] = (s < t) ? bk * dec * AM[t * 68 + s] : 0.f; pv[j] = rqt * dec * PM[t * 68 + s]; }
#pragma unroll
        for (int j = 0; j < 8; ++j) AM[t * 68 + s8 + j] = av[j];
        u32x4 o; o.x = pg8::cvt_pk_bf16(pv[0], pv[1]); o.y = pg8::cvt_pk_bf16(pv[2], pv[3]); o.z = pg8::cvt_pk_bf16(pv[4], pv[5]); o.w = pg8::cvt_pk_bf16(pv[6], pv[7]);
        *(u32x4*)((bf16_t*)(A.ws + WS_DQK) + (size_t)item * 4096 + t * 64 + s8) = o;
        for (int e = tid; e < 64 * 68; e += 512) TM[e] = 0.f;
        if (tid == 0) ((float*)(A.ws + WS_DGL))[item] = __expf(GAM[63]);
    }
    __syncthreads();
    if (wave == 0) {
        const int i = lane >> 4, c = lane & 15;
        LAS float* amp = AM + (16 * i) * 68 + 16 * i; asm volatile("" : "+v"(amp));
        float x[16];
#pragma unroll
        for (int r = 0; r < 16; ++r) { float acc = (r == c) ? 1.f : 0.f;
#pragma unroll
            for (int s = 0; s < r; ++s) acc = fmaf(-amp[r * 68 + s], x[s], acc);
            x[r] = acc; }
        LAS float* tmp = TM + (16 * i) * 68 + 16 * i + c;
#pragma unroll
        for (int r = 0; r < 16; ++r) tmp[r * 68] = x[r];
    }
    __syncthreads();
    {
        const int wt = tid;
        for (int id = wt; id < 1024; id += 512) {
            const int c = id >> 3, t8 = (id & 7) * 8;
            const f32x4 b0 = *(LAS f32x4*)(BETA + t8), b1 = *(LAS f32x4*)(BETA + t8 + 4);
            u32x4 v = *(LAS u32x4*)(VT + c * 144 + t8 * 2);
            v.x = bfmul2(v.x, b0[0], b0[1]); v.y = bfmul2(v.y, b0[2], b0[3]); v.z = bfmul2(v.z, b1[0], b1[1]); v.w = bfmul2(v.w, b1[2], b1[3]);
            *(LAS u32x4*)(VT + c * 144 + t8 * 2) = v;
            const f32x4 f20 = *(LAS f32x4*)(F2 + t8), f21 = *(LAS f32x4*)(F2 + t8 + 4), f30 = *(LAS f32x4*)(F3 + t8), f31 = *(LAS f32x4*)(F3 + t8 + 4);
            const u32x4 k = *(LAS u32x4*)(KT + c * 144 + t8 * 2);
            u32x4 rk; rk.x = bfmul2(k.x, f20[0], f20[1]); rk.y = bfmul2(k.y, f20[2], f20[3]); rk.z = bfmul2(k.z, f21[0], f21[1]); rk.w = bfmul2(k.w, f21[2], f21[3]);
            *(LAS u32x4*)(RTK + c * 144 + t8 * 2) = rk;
            u32x4 kd; kd.x = bfmul2(k.x, f30[0], f30[1]); kd.y = bfmul2(k.y, f30[2], f30[3]); kd.z = bfmul2(k.z, f31[0], f31[1]); kd.w = bfmul2(k.w, f31[2], f31[3]);
            *(u32x4*)((bf16_t*)(A.ws + WS_DKT) + (size_t)item * 8192 + c * 64 + t8) = kd; }
        for (int id = wt; id < 1024; id += 512) {
            const int t = id >> 4, c8 = (id & 15) * 8; const float f = F4[t];
            u32x4 q = *(LAS u32x4*)((LAS unsigned char*)QS + t * 272 + c8 * 2);
            q.x = bfmul2(q.x, f, f); q.y = bfmul2(q.y, f, f); q.z = bfmul2(q.z, f, f); q.w = bfmul2(q.w, f, f);
            *(u32x4*)((bf16_t*)(A.ws + WS_DQD) + (size_t)item * 8192 + t * 128 + c8) = q; }
    }
    {
        const int c8 = (tid & 15) * 8; const float* on = A.in[I_ONORM] + l * 128 + c8;
        const f32x4 o0 = *(const f32x4*)on, o1 = *(const f32x4*)(on + 4);
#pragma unroll
        for (int j = 0; j < 2; ++j) { const int id = tid + 512 * j; const u32x4 g = gv[j]; u32x4 o;
            o.x = pg8::cvt_pk_bf16(silu_f(__uint_as_float(g.x << 16)) * o0[0], silu_f(__uint_as_float(g.x & 0xffff0000u)) * o0[1]);
            o.y = pg8::cvt_pk_bf16(silu_f(__uint_as_float(g.y << 16)) * o0[2], silu_f(__uint_as_float(g.y & 0xffff0000u)) * o0[3]);
            o.z = pg8::cvt_pk_bf16(silu_f(__uint_as_float(g.z << 16)) * o1[0], silu_f(__uint_as_float(g.z & 0xffff0000u)) * o1[1]);
            o.w = pg8::cvt_pk_bf16(silu_f(__uint_as_float(g.w << 16)) * o1[2], silu_f(__uint_as_float(g.w & 0xffff0000u)) * o1[3]);
            *(u32x4*)((bf16_t*)(A.ws + WS_DGS) + (size_t)item * 8192 + (id >> 4) * 128 + c8) = o; }
    }
    __syncthreads();
    const int p2 = tid >> 8, r2 = (tid >> 4) & 15, c2 = tid & 15, rb = p2 ? 48 : 16, cb = p2 ? 32 : 0;
    {
        float acc = 0.f;
#pragma unroll
        for (int s = 0; s < 16; ++s) acc = fmaf(AM[(rb + r2) * 68 + cb + s], TM[(cb + s) * 68 + cb + c2], acc);
        PSC[(p2 * 16 + r2) * 68 + c2] = acc; }
    __syncthreads();
    {
        float acc = 0.f;
#pragma unroll
        for (int s = 0; s < 16; ++s) acc = fmaf(TM[(rb + r2) * 68 + rb + s], PSC[(p2 * 16 + s) * 68 + c2], acc);
        TM[(rb + r2) * 68 + cb + c2] = -acc; }
    __syncthreads();
    float p3[2];
#pragma unroll
    for (int j = 0; j < 2; ++j) { const int e = tid + 512 * j, r = e >> 5, c = e & 31; float acc = 0.f;
#pragma unroll 8
        for (int s = 0; s < 32; ++s) acc = fmaf(AM[(32 + r) * 68 + s], TM[s * 68 + c], acc);
        p3[j] = acc; }
    __syncthreads();
#pragma unroll
    for (int j = 0; j < 2; ++j) { const int e = tid + 512 * j; PSC[(e >> 5) * 68 + (e & 31)] = p3[j]; }
    __syncthreads();
#pragma unroll
    for (int j = 0; j < 2; ++j) { const int e = tid + 512 * j, r = e >> 5, c = e & 31; float acc = 0.f;
#pragma unroll 8
        for (int s = 0; s < 32; ++s) acc = fmaf(TM[(32 + r) * 68 + 32 + s], PSC[s * 68 + c], acc);
        p3[j] = -acc; }
#pragma unroll
    for (int j = 0; j < 2; ++j) { const int e = tid + 512 * j; TM[(32 + (e >> 5)) * 68 + (e & 31)] = p3[j]; }
    __syncthreads();
#pragma unroll
    for (int j = 0; j < 4; ++j) { const int e = tid + 512 * j, t = e >> 5, s2 = (e & 31) * 2;
        *(LAS unsigned*)(TB + t * 144 + s2 * 2) = pg8::cvt_pk_bf16(TM[t * 68 + s2], TM[t * 68 + s2 + 1]); }
    __syncthreads();
    {
        const int fr = lane & 15, quad = lane >> 4;
        bf16x8 bv[2], ak[2];
#pragma unroll
        for (int kk = 0; kk < 2; ++kk) { bv[kk] = *(LAS bf16x8*)(VT + (16 * wave + fr) * 144 + (kk * 32 + quad * 8) * 2); ak[kk] = *(LAS bf16x8*)(RTK + (16 * wave + fr) * 144 + (kk * 32 + quad * 8) * 2); }
        bf16_t* DW = (bf16_t*)(A.ws + WS_DW) + (size_t)item * 8192; bf16_t* DKC = (bf16_t*)(A.ws + WS_DKC) + (size_t)item * 8192;
#pragma unroll
        for (int mt = 0; mt < 4; ++mt) { f32x4 aw = {0.f, 0.f, 0.f, 0.f}, akc = {0.f, 0.f, 0.f, 0.f};
#pragma unroll
            for (int kk = 0; kk < 2; ++kk) { const bf16x8 tf = *(LAS bf16x8*)(TB + (mt * 16 + fr) * 144 + (kk * 32 + quad * 8) * 2);
                aw = mfma16(tf, bv[kk], aw);
                akc = mfma16(ak[kk], tf, akc); }
            u32x2 ow; ow.x = pk2(aw[0], aw[1]); ow.y = pk2(aw[2], aw[3]);
            *(u32x2*)(DW + (16 * wave + fr) * 64 + mt * 16 + quad * 4) = ow;
            u32x2 ok; ok.x = pk2(-akc[0], -akc[1]); ok.y = pk2(-akc[2], -akc[3]);
            *(u32x2*)(DKC + (mt * 16 + fr) * 128 + 16 * wave + quad * 4) = ok; }
    }
    __syncthreads();
}

__device__ __forceinline__ void delta_scan_item(const DevArgs& A, int l, LAS unsigned char* lds, int bh, int tid_in, int wave, int lane_in, const XcdBarrier& xb, int SUB) {
    const int b = bh >> 2, h = bh & 3;
    LAS unsigned char* KCs = lds; LAS unsigned char* QDs = lds + 17408; LAS unsigned char* QKs = lds + 34816; LAS unsigned char* KDTs = lds + 44032;
    LAS unsigned char* Ws = lds + 62464;
    LAS unsigned char* GSs = lds + 80896;
    LAS unsigned char* SS = lds + 98304 + wave * 4352; LAS unsigned char* US = lds + 133120 + wave * 2304;
    LAS float* PART = (LAS float*)(lds + 151552);
    const unsigned char* gW = A.ws + WS_DW; const unsigned char* gGS = A.ws + WS_DGS;
    const unsigned char* gKC = A.ws + WS_DKC; const unsigned char* gQD = A.ws + WS_DQD; const unsigned char* gQK = A.ws + WS_DQK; const unsigned char* gKT = A.ws + WS_DKT;
    const float* DGL = (const float*)(A.ws + WS_DGL);
    f32x4 S[8];
#pragma unroll
    for (int mt = 0; mt < 8; ++mt) S[mt] = (f32x4){0.f, 0.f, 0.f, 0.f};
    u32x4 r[9], rg[2];
    float gl_all = 0.f;
#define DS_LOAD(itn, toff) do { const size_t _i = (size_t)(itn); const unsigned char* _kc = gKC + _i * 16384; const unsigned char* _qd = gQD + _i * 16384; \
        const unsigned char* _qk = gQK + _i * 8192; const unsigned char* _kt = gKT + _i * 16384; \
        r[0] = *(const u32x4*)(_kc + (toff)); r[1] = *(const u32x4*)(_kc + (toff) + 8192u); \
        r[2] = *(const u32x4*)(_qd + (toff)); r[3] = *(const u32x4*)(_qd + (toff) + 8192u); \
        r[4] = *(const u32x4*)(_qk + (toff)); \
        r[5] = *(const u32x4*)(_kt + (toff)); r[6] = *(const u32x4*)(_kt + (toff) + 8192u); \
        const unsigned char* _w = gW + _i * 16384; r[7] = *(const u32x4*)(_w + (toff)); r[8] = *(const u32x4*)(_w + (toff) + 8192u); } while (0)
#define DS_LOADG(itn, toff) do { const unsigned char* _g = gGS + (size_t)(itn) * 16384; rg[0] = *(const u32x4*)(_g + (toff)); rg[1] = *(const u32x4*)(_g + (toff) + 8192u); } while (0)
#define DS_STAGE(tidv) do { const int i0 = (tidv), i1 = (tidv) + 512; \
          *(LAS u32x4*)(KCs + (i0 >> 4) * 272 + (i0 & 15) * 16) = r[0]; *(LAS u32x4*)(KCs + (i1 >> 4) * 272 + (i1 & 15) * 16) = r[1]; \
          *(LAS u32x4*)(QDs + (i0 >> 4) * 272 + (i0 & 15) * 16) = r[2]; *(LAS u32x4*)(QDs + (i1 >> 4) * 272 + (i1 & 15) * 16) = r[3]; \
          *(LAS u32x4*)(QKs + (i0 >> 3) * 144 + (i0 & 7) * 16) = r[4]; \
          *(LAS u32x4*)(KDTs + (i0 >> 3) * 144 + (i0 & 7) * 16) = r[5]; *(LAS u32x4*)(KDTs + (i1 >> 3) * 144 + (i1 & 7) * 16) = r[6]; \
          *(LAS u32x4*)(Ws + (i0 >> 3) * 144 + (i0 & 7) * 16) = r[7]; *(LAS u32x4*)(Ws + (i1 >> 3) * 144 + (i1 & 7) * 16) = r[8]; } while (0)
#define DS_STAGEG(tidv) do { const int i0 = (tidv), i1 = (tidv) + 512; \
          *(LAS u32x4*)(GSs + (i0 >> 4) * 272 + (i0 & 15) * 16) = rg[0]; *(LAS u32x4*)(GSs + (i1 >> 4) * 272 + (i1 & 15) * 16) = rg[1]; } while (0)
#pragma unroll 1
    for (int n = 0; n < 32; ++n) {
        int tid = tid_in; asm volatile("" : "+v"(tid));
        const bool bstart = (SUB > 0) ? (n % SUB == 0) : (n == 0);
        const bool bnext1 = (SUB > 0) && ((n + 1) % SUB == 0), bnext2 = (SUB > 0) && ((n + 2) % SUB == 0);
        if (bstart) { if (n > 0) xcd_barrier(xb);
            gl_all = DGL[bh * 32 + (tid & 31)];
            const unsigned t0 = (unsigned)tid * 16u; DS_LOAD(bh * 32 + n, t0); DS_LOADG(bh * 32 + n, t0); DS_STAGE(tid); DS_STAGEG(tid);
            if (n + 1 < 32 && !bnext1) { DS_LOAD(bh * 32 + n + 1, t0); DS_LOADG(bh * 32 + n + 1, t0); }
            __syncthreads(); }
        else { DS_STAGEG(tid);
            if (n + 1 < 32 && !bnext1) DS_LOADG(bh * 32 + n + 1, (unsigned)tid * 16u); }
        const int lane = tid & 63, fr = lane & 15, quad = lane >> 4, vcol = 16 * wave + fr;
        const unsigned toff = (unsigned)tid * 16u;
        const int it = bh * 32 + n, tokb = b * SEQ + n * 64;
        const float glast = __builtin_bit_cast(float, __builtin_amdgcn_readlane(__builtin_bit_cast(int, gl_all), n));
        asm volatile("s_nop 7\n\ts_nop 7" ::: "memory");
#pragma unroll
        for (int mt = 0; mt < 8; ++mt) { u32x2 p; p.x = pg8::cvt_pk_bf16(S[mt][0], S[mt][1]); p.y = pg8::cvt_pk_bf16(S[mt][2], S[mt][3]); *(LAS u32x2*)(SS + fr * 272 + (mt * 16 + quad * 4) * 2) = p; }
        LDS_FENCE();
        bf16x8 Sb[4];
#pragma unroll
        for (int kk = 0; kk < 4; ++kk) Sb[kk] = *(LAS bf16x8*)(SS + fr * 272 + (kk * 32 + quad * 8) * 2);
        f32x4 U[4], O[4];
#pragma unroll
        for (int mt = 0; mt < 4; ++mt) { f32x4 au, ao = {0.f, 0.f, 0.f, 0.f};
            { const u32x2 wq = *(LAS u32x2*)(Ws + vcol * 144 + (mt * 16 + quad * 4) * 2);
              au[0] = __uint_as_float(wq.x << 16); au[1] = __uint_as_float(wq.x & 0xffff0000u); au[2] = __uint_as_float(wq.y << 16); au[3] = __uint_as_float(wq.y & 0xffff0000u); }
#pragma unroll
            for (int kk = 0; kk < 4; ++kk) { const bf16x8 a1 = *(LAS bf16x8*)(KCs + (mt * 16 + fr) * 272 + (kk * 32 + quad * 8) * 2); au = mfma16(a1, Sb[kk], au);
                const bf16x8 a2 = *(LAS bf16x8*)(QDs + (mt * 16 + fr) * 272 + (kk * 32 + quad * 8) * 2); ao = mfma16(a2, Sb[kk], ao); }
            U[mt] = au; O[mt] = ao; __builtin_amdgcn_sched_barrier(0); }
        asm volatile("s_nop 7\n\ts_nop 7" ::: "memory");
#pragma unroll
        for (int mt = 0; mt < 4; ++mt) { u32x2 p; p.x = pg8::cvt_pk_bf16(U[mt][0], U[mt][1]); p.y = pg8::cvt_pk_bf16(U[mt][2], U[mt][3]); *(LAS u32x2*)(US + fr * 144 + (mt * 16 + quad * 4) * 2) = p; }
        LDS_FENCE();
        bf16x8 Ub[2];
#pragma unroll
        for (int kk = 0; kk < 2; ++kk) Ub[kk] = *(LAS bf16x8*)(US + fr * 144 + (kk * 32 + quad * 8) * 2);
#pragma unroll
        for (int mt = 0; mt < 4; ++mt)
#pragma unroll
            for (int kk = 0; kk < 2; ++kk) { const bf16x8 a = *(LAS bf16x8*)(QKs + (mt * 16 + fr) * 144 + (kk * 32 + quad * 8) * 2); O[mt] = mfma16(a, Ub[kk], O[mt]); }
        __builtin_amdgcn_sched_barrier(0);
#pragma unroll
        for (int mt = 0; mt < 8; ++mt) { S[mt] *= glast;
#pragma unroll
            for (int kk = 0; kk < 2; ++kk) { const bf16x8 a = *(LAS bf16x8*)(KDTs + (mt * 16 + fr) * 144 + (kk * 32 + quad * 8) * 2); S[mt] = mfma16(a, Ub[kk], S[mt]); }
            if (mt & 1) __builtin_amdgcn_sched_barrier(0); }
        { float pp[16];
#pragma unroll
          for (int e = 0; e < 16; ++e) pp[e] = O[e >> 2][e & 3] * O[e >> 2][e & 3];
#pragma unroll
          for (int st = 1; st < 16; st <<= 1) {
#pragma unroll
              for (int e = 0; e < 16; ++e) pp[e] += __shfl_xor(pp[e], st); }
          if (fr == 0) {
#pragma unroll
              for (int e = 0; e < 16; ++e) PART[((e >> 2) * 16 + quad * 4 + (e & 3)) * 8 + wave] = pp[e]; } }
        __syncthreads();
        if (n + 1 < 32 && !bnext1) { DS_STAGE(tid); if (n + 2 < 32 && !bnext2) DS_LOAD(it + 2, toff); }
        bf16_t* mixb = (bf16_t*)(A.ws + WS_MIX) + (size_t)tokb * D + h * 128;
#pragma unroll
        for (int mt = 0; mt < 4; ++mt)
#pragma unroll
            for (int i = 0; i < 4; ++i) { const int t = mt * 16 + quad * 4 + i;
                const f32x4 p0 = *(LAS f32x4*)(PART + t * 8), p1 = *(LAS f32x4*)(PART + t * 8 + 4);
                const float tot = ((p0[0] + p0[1]) + (p0[2] + p0[3])) + ((p1[0] + p1[1]) + (p1[2] + p1[3]));
                const float sc = rsqrtf(tot * (1.f / 128.f) + EPS);
                const float gs = bf2f(*(LAS bf16_t*)(GSs + t * 272 + vcol * 2));
                mixb[(unsigned)(t * D + vcol)] = (bf16_t)(pg8::cvt_pk_bf16(O[mt][i] * sc * gs, 0.f) & 0xffffu); }
        __syncthreads();
    }
#undef DS_STAGE
#undef DS_LOADG
#undef DS_STAGEG
#undef DS_LOAD
    { const int lane = lane_in, fr = lane & 15, quad = lane >> 4, vcol = 16 * wave + fr;
      float* dp = A.out + O_DP + (size_t)((l * 8 + b) * 4 + h) * 16384;
#pragma unroll
      for (int mt = 0; mt < 8; ++mt)
#pragma unroll
          for (int i = 0; i < 4; ++i) dp[(mt * 16 + quad * 4 + i) * 128 + vcol] = S[mt][i]; }
    __syncthreads();
}

__device__ __forceinline__ void delta_sample_item(const DevArgs& A, int l, LAS unsigned char* lds, int item, int tid, int wave, int lane) {
    asm volatile("" : "+v"(tid)); lane = tid & 63; wave = __builtin_amdgcn_readfirstlane(tid >> 6);
    const int b = item >> 2, h = item & 3, tokS = NP + b * 4;
    LAS float* RAW = (LAS float*)lds; LAS float* RED = RAW + 1536; LAS float* OB = RED + 512; LAS float* SC = OB + 512;
    const bf16_t* PROJ = (const bf16_t*)(A.ws + WS_PROJ); const float* AB = (const float*)(A.ws + WS_AB); bf16_t* MIX = (bf16_t*)(A.ws + WS_MIX);
    const float* cw = A.in[I_CONVW] + (size_t)l * 4 * 1536;
    for (int idx = tid; idx < 1536; idx += 512) { const int part = idx >> 9, t = (idx >> 7) & 3, c = idx & 127, col = part * 512 + h * 128 + c;
        float acc = 0.f;
#pragma unroll
        for (int j = 0; j < 4; ++j) { const int tt = t - 3 + j;
            const float x = (tt >= 0) ? bf2f(PROJ[(size_t)(tokS + tt) * NPROJ + col]) : A.in[I_SCONV][((size_t)(l * 128 + b) * 3 + (3 + tt)) * 1536 + col];
            acc += cw[j * 1536 + col] * x; }
        RAW[idx] = silu_f(acc); }
    if (tid < 4) { const float a = AB[(size_t)(tokS + tid) * 8 + h], bb = AB[(size_t)(tokS + tid) * 8 + 4 + h];
        const float xx = a + A.in[I_DTB][l * 4 + h]; const float sp = xx > 20.f ? xx : log1pf(expf(xx));
        SC[8 + tid] = 1.f / (1.f + expf(-bb)); SC[12 + tid] = expf(-expf(A.in[I_ALOG][l * 4 + h]) * sp); }
    const int v = tid & 127, kq = tid >> 7;
    float S[32];
    { const float* sp = A.in[I_SDELTA] + (size_t)((l * 128 + b) * 4 + h) * 16384;
#pragma unroll
      for (int i = 0; i < 32; ++i) S[i] = sp[(kq * 32 + i) * 128 + v]; }
    __syncthreads();
    { const int part = wave >> 2, t = wave & 3; const float x0 = RAW[part * 512 + t * 128 + lane], x1 = RAW[part * 512 + t * 128 + 64 + lane];
      const float ss = wave_sum(x0 * x0 + x1 * x1); if (lane == 0) SC[part * 4 + t] = rsqrtf(ss + EPS) * (part == 0 ? 0.08838834764831845f : 1.f); }
    __syncthreads();
    for (int t = 0; t < 4; ++t) {
        const float rq = SC[t], rk = SC[4 + t], beta = SC[8 + t], g = SC[12 + t];
        float pr = 0.f;
#pragma unroll
        for (int i = 0; i < 32; ++i) pr += S[i] * RAW[512 + t * 128 + kq * 32 + i];
        RED[kq * 128 + v] = pr * rk;
        __syncthreads();
        const float rr = (RED[v] + RED[128 + v]) + (RED[256 + v] + RED[384 + v]);
        const float u = beta * (RAW[1024 + t * 128 + v] - g * rr);
        float po = 0.f;
#pragma unroll
        for (int i = 0; i < 32; ++i) { const float kh = RAW[512 + t * 128 + kq * 32 + i] * rk; S[i] = g * S[i] + kh * u; po += S[i] * RAW[t * 128 + kq * 32 + i]; }
        __syncthreads();
        RED[kq * 128 + v] = po * rq;
        __syncthreads();
        if (kq == 0) OB[t * 128 + v] = (RED[v] + RED[128 + v]) + (RED[256 + v] + RED[384 + v]);
        __syncthreads();
    }
    if (wave < 4) { const int t = wave; const float x0 = OB[t * 128 + lane], x1 = OB[t * 128 + 64 + lane];
        const float ss = wave_sum(x0 * x0 + x1 * x1); const float sc = rsqrtf(ss * (1.f / 128.f) + EPS);
        const float g0 = bf2f(PROJ[(size_t)(tokS + t) * NPROJ + PC_G + h * 128 + lane]), g1 = bf2f(PROJ[(size_t)(tokS + t) * NPROJ + PC_G + h * 128 + 64 + lane]);
        MIX[(size_t)(tokS + t) * D + h * 128 + lane] = (bf16_t)f2bf(x0 * sc * A.in[I_ONORM][l * 128 + lane] * silu_f(g0));
        MIX[(size_t)(tokS + t) * D + h * 128 + 64 + lane] = (bf16_t)f2bf(x1 * sc * A.in[I_ONORM][l * 128 + 64 + lane] * silu_f(g1)); }
    { float* dsp = A.out + O_DS + (size_t)((l * 128 + b) * 4 + h) * 16384;
#pragma unroll
      for (int i = 0; i < 32; ++i) dsp[(kq * 32 + i) * 128 + v] = S[i]; }
    __syncthreads();
}

#define SSM_BCAST_U(t) do { unsigned _w[8]; \
        _w[0] = __builtin_amdgcn_readlane(ua.x, t); _w[1] = __builtin_amdgcn_readlane(ua.y, t); _w[2] = __builtin_amdgcn_readlane(ua.z, t); _w[3] = __builtin_amdgcn_readlane(ua.w, t); \
        _w[4] = __builtin_amdgcn_readlane(ub.x, t); _w[5] = __builtin_amdgcn_readlane(ub.y, t); _w[6] = __builtin_amdgcn_readlane(ub.z, t); _w[7] = __builtin_amdgcn_readlane(ub.w, t); \
        _Pragma("unroll") for (int _d = 0; _d < 8; ++_d) { uu[2 * _d] = __uint_as_float(_w[_d] << 16); uu[2 * _d + 1] = __uint_as_float(_w[_d] & 0xffff0000u); } } while (0)
#define SSM_STEP() do { float _br = 0.f, _bi = 0.f; \
        _Pragma("unroll") for (int _h = 0; _h < 16; ++_h) { _br = fmaf(Br[_h], uu[_h], _br); _bi = fmaf(Bi[_h], uu[_h], _bi); } \
        const float _nr = lr * hr - li * hi + _br, _ni = lr * hi + li * hr + _bi; hr = _nr; hi = _ni; } while (0)

__device__ __forceinline__ void ssm_part1_item(const DevArgs& A, int l, int it, int lane) {
    const int g = it & 15, bc = it >> 4, b = bc / 31, c = bc % 31;
    const float* bb = (const float*)(A.ws + WS_BBAR) + ((size_t)(l * 16 + g) * 64 + lane) * 32;
    float Br[16], Bi[16];
#pragma unroll
    for (int q = 0; q < 4; ++q) { const f32x4 x = ((const f32x4*)bb)[q], y = ((const f32x4*)bb)[4 + q];
        Br[4 * q] = x.x; Br[4 * q + 1] = x.y; Br[4 * q + 2] = x.z; Br[4 * q + 3] = x.w; Bi[4 * q] = y.x; Bi[4 * q + 1] = y.y; Bi[4 * q + 2] = y.z; Bi[4 * q + 3] = y.w; }
    const f32x4 lk = ((const f32x4*)(A.ws + WS_SSMK))[(l * 16 + g) * 64 + lane]; const float lr = lk.x, li = lk.y;
    const bf16_t* up = (const bf16_t*)(A.ws + WS_PROJ) + (size_t)(b * SEQ + c * 64 + lane) * NPROJ + PC_SSM + g * 16;
    const u32x4 ua = *(const u32x4*)up, ub = *(const u32x4*)(up + 8);
    float hr = 0.f, hi = 0.f, uu[16];
#pragma unroll 1
    for (int t = 0; t < 64; ++t) { SSM_BCAST_U(t); SSM_STEP(); }
    f32x2 e; e.x = hr; e.y = hi;
    ((f32x2*)(A.ws + WS_SSME))[((size_t)(b * 32 + c) * 16 + g) * 64 + lane] = e;
}

__device__ __forceinline__ void ssm_part2_item(const DevArgs& A, int l, LAS unsigned char* lds, int it, int tid, int wave, int lane) {
    asm volatile("" : "+v"(tid)); lane = tid & 63; wave = __builtin_amdgcn_readfirstlane(tid >> 6);
    const int tok0 = it * 64, fr = lane & 15, quad = lane >> 4;
    const bool samp = it >= 256; const int b = it >> 5, c = it & 31;
    LAS unsigned char* YS = lds; LAS unsigned char* HS = lds + 33792 + wave * 4352;
    const bf16_t* PROJ = (const bf16_t*)(A.ws + WS_PROJ); bf16_t* MIX = (bf16_t*)(A.ws + WS_MIX);
#pragma unroll 1
    for (int gi = 0; gi < 2; ++gi) {
        const int g = wave * 2 + gi;
        const float* bb = (const float*)(A.ws + WS_BBAR) + ((size_t)(l * 16 + g) * 64 + lane) * 32;
        float Br[16], Bi[16];
#pragma unroll
        for (int q = 0; q < 4; ++q) { const f32x4 x = ((const f32x4*)bb)[q], y = ((const f32x4*)bb)[4 + q];
            Br[4 * q] = x.x; Br[4 * q + 1] = x.y; Br[4 * q + 2] = x.z; Br[4 * q + 3] = x.w; Bi[4 * q] = y.x; Bi[4 * q + 1] = y.y; Bi[4 * q + 2] = y.z; Bi[4 * q + 3] = y.w; }
        const f32x4 lk = ((const f32x4*)(A.ws + WS_SSMK))[(l * 16 + g) * 64 + lane]; const float lr = lk.x, li = lk.y, Lr = lk.z, Li = lk.w;
        bf16x8 Cb[4];
#pragma unroll
        for (int kk = 0; kk < 4; ++kk) { const size_t co = ((size_t)(l * 16 + g) * 16 + fr) * 64 + kk * 16 + quad * 4;
            const f32x4 cr = *(const f32x4*)(A.in[I_CRE] + co), ci = *(const f32x4*)(A.in[I_CIM] + co);
            u32x4 pk; pk.x = pk2(cr.x, -ci.x); pk.y = pk2(cr.y, -ci.y); pk.z = pk2(cr.z, -ci.z); pk.w = pk2(cr.w, -ci.w);
            Cb[kk] = __builtin_bit_cast(bf16x8, pk); }
        const bf16_t* up = PROJ + (size_t)(tok0 + lane) * NPROJ + PC_SSM + g * 16;
        const u32x4 ua = *(const u32x4*)up, ub = *(const u32x4*)(up + 8);
        float hr = 0.f, hi = 0.f, uu[16];
        if (!samp && c > 0) { const f32x2* E = (const f32x2*)(A.ws + WS_SSME) + ((size_t)(b * 32) * 16 + g) * 64 + lane;
#pragma unroll
            for (int cb = 0; cb < 32; cb += 16) { f32x2 ev[16];
#pragma unroll
                for (int q = 0; q < 16; ++q) { const int cc = cb + q; ev[q] = (cc < c) ? E[(size_t)cc * 1024] : (f32x2){0.f, 0.f}; }
#pragma unroll
                for (int q = 0; q < 16; ++q) { const int cc = cb + q; if (cc < c) { const float nr = Lr * hr - Li * hi + ev[q].x, ni = Lr * hi + Li * hr + ev[q].y; hr = nr; hi = ni; } } } }
        const float dsk = A.in[I_SSMD][l * 256 + g * 16 + fr];
#pragma unroll 1
        for (int sub = 0; sub < 4; ++sub) {
#pragma unroll 1
            for (int tt = 0; tt < 16; ++tt) { const int t = sub * 16 + tt;
                const int sb = (it - 256) * 16 + (t >> 2);
                if (samp && (t & 3) == 0) { hr = A.in[I_SRE][((size_t)(l * 128 + sb) * 16 + g) * 64 + lane]; hi = A.in[I_SIM][((size_t)(l * 128 + sb) * 16 + g) * 64 + lane]; }
                SSM_BCAST_U(t); SSM_STEP();
                *(LAS unsigned*)(HS + tt * 272 + lane * 4) = pg8::cvt_pk_bf16(hr, hi);
                if (samp && (t & 3) == 3) { A.out[O_RES + ((size_t)(l * 128 + sb) * 16 + g) * 64 + lane] = hr; A.out[O_IMS + ((size_t)(l * 128 + sb) * 16 + g) * 64 + lane] = hi; }
            }
            LDS_FENCE();
            f32x4 acc = {0.f, 0.f, 0.f, 0.f};
#pragma unroll
            for (int kk = 0; kk < 4; ++kk) { const bf16x8 a = *(LAS bf16x8*)(HS + fr * 272 + (kk * 32 + quad * 8) * 2); acc = mfma16(a, Cb[kk], acc); }
#pragma unroll
            for (int i = 0; i < 4; ++i) { const int t = sub * 16 + quad * 4 + i; const float uv = bf2f(PROJ[(size_t)(tok0 + t) * NPROJ + PC_SSM + g * 16 + fr]);
                *(LAS bf16_t*)(YS + t * 528 + (g * 16 + fr) * 2) = (bf16_t)f2bf(gelu_tanh_f(acc[i] + dsk * uv)); }
            LDS_FENCE();
        }
        if (!samp && c == 31) { A.out[O_REP + ((size_t)(l * 8 + b) * 16 + g) * 64 + lane] = hr; A.out[O_IMP + ((size_t)(l * 8 + b) * 16 + g) * 64 + lane] = hi; }
    }
    __syncthreads();
    {
        const bf16_t* GT = (const bf16_t*)(A.ws + WS_GLUT + l * SZ_GLUT);
        f32x4 acc[4][2];
#pragma unroll
        for (int mt = 0; mt < 4; ++mt) { acc[mt][0] = (f32x4){0.f, 0.f, 0.f, 0.f}; acc[mt][1] = (f32x4){0.f, 0.f, 0.f, 0.f}; }
#pragma unroll
        for (int kk = 0; kk < 8; ++kk) { bf16x8 bfr[2];
#pragma unroll
            for (int nt = 0; nt < 2; ++nt) bfr[nt] = *(const bf16x8*)(GT + (size_t)(32 * wave + nt * 16 + fr) * 256 + kk * 32 + quad * 8);
#pragma unroll
            for (int mt = 0; mt < 4; ++mt) { const bf16x8 a = *(LAS bf16x8*)(YS + (mt * 16 + fr) * 528 + (kk * 32 + quad * 8) * 2);
                acc[mt][0] = mfma16(a, bfr[0], acc[mt][0]); acc[mt][1] = mfma16(a, bfr[1], acc[mt][1]); } }
#pragma unroll
        for (int nt = 0; nt < 2; ++nt) { const int ncol = 32 * wave + nt * 16 + fr; const float gb = A.in[I_GLUB][l * 256 + ncol];
#pragma unroll
            for (int mt = 0; mt < 4; ++mt)
#pragma unroll
                for (int i = 0; i < 4; ++i) { const int t = mt * 16 + quad * 4 + i; const float y = bf2f(*(LAS bf16_t*)(YS + t * 528 + ncol * 2));
                    MIX[(size_t)(tok0 + t) * D + 512 + ncol] = (bf16_t)f2bf(y * sigmoid_f(acc[mt][nt][i] + gb)); } }
    }
    __syncthreads();
}

__device__ __forceinline__ void pool_item(const DevArgs& A, int l, LAS unsigned char* lds, int it, int tid, int wave, int lane) {
    asm volatile("" : "+v"(tid)); lane = tid & 63; wave = __builtin_amdgcn_readfirstlane(tid >> 6);
    const int tok0 = it * 64, fr = lane & 15, quad = lane >> 4; const bool samp = it >= 256;
    LAS unsigned char* RS = lds;
    const bf16_t* PROJ = (const bf16_t*)(A.ws + WS_PROJ); bf16_t* MIX = (bf16_t*)(A.ws + WS_MIX);
    if (!samp) {
        LAS unsigned char* XT = lds + 33792;
        const int b = it >> 5, c = it & 31;
        for (int id = tid; id < 79 * 32; id += 512) { const int r = id >> 5, c16 = id & 31, tl = c * 64 - 15 + r;
            u32x4 v = {0u, 0u, 0u, 0u}; if (tl >= 0) v = *(const u32x4*)(PROJ + (size_t)(b * SEQ + tl) * NPROJ + PC_POOL + c16 * 8);
            *(LAS u32x4*)(XT + r * 528 + c16 * 16) = v; }
        __syncthreads();
        const int ch = tid & 255, half = tid >> 8, g = ch >> 6, w = 2 << g, r0 = half * 32;
        float sum = 0.f;
        for (int j = 0; j < w; ++j) sum += bf2f(*(LAS bf16_t*)(XT + (r0 + 15 - j) * 528 + ch * 2));
#pragma unroll 4
        for (int rr = 0; rr < 32; ++rr) { const int r = r0 + rr, tl = c * 64 + r;
            const float u = bf2f(*(LAS bf16_t*)(XT + (r + 15) * 528 + ch * 2));
            if (rr > 0) sum += u - bf2f(*(LAS bf16_t*)(XT + (r + 15 - w) * 528 + ch * 2));
            const float cnt = (float)((tl + 1 < w) ? tl + 1 : w);
            *(LAS bf16_t*)(RS + r * 528 + ch * 2) = (bf16_t)f2bf(sum / cnt - u); }
    } else {
#pragma unroll 1
        for (int pr = 0; pr < 8; ++pr) { const int idx = pr * 512 + tid, ch = idx & 255, sq = idx >> 8, g = ch >> 6, w = 2 << g;
            const int sb = (it - 256) * 16 + sq;
            const float* sbuf = A.in[I_SPOOL] + (size_t)(l * 128 + sb) * 15 * 256 + ch;
            const bf16_t* base = PROJ + (size_t)(NP + sb * 4) * NPROJ + PC_POOL + ch;
            float e[19];
#pragma unroll
            for (int j = 0; j < 15; ++j) e[j] = sbuf[j * 256];
#pragma unroll
            for (int j = 0; j < 4; ++j) e[15 + j] = bf2f(base[(size_t)j * NPROJ]);
#pragma unroll
            for (int t = 0; t < 4; ++t) { float sum = 0.f;
#pragma unroll
                for (int j = 0; j < 16; ++j) sum += (j < w) ? e[15 + t - j] : 0.f;
                *(LAS bf16_t*)(RS + (sq * 4 + t) * 528 + ch * 2) = (bf16_t)f2bf(sum / (float)w - e[15 + t]); } }
    }
    __syncthreads();
    { const int g2 = wave >> 1; const bf16_t* PT = (const bf16_t*)(A.ws + WS_POOLT + l * SZ_POOLT) + g2 * 4096;
      f32x4 acc[4][2];
#pragma unroll
      for (int mt = 0; mt < 4; ++mt) { acc[mt][0] = (f32x4){0.f, 0.f, 0.f, 0.f}; acc[mt][1] = (f32x4){0.f, 0.f, 0.f, 0.f}; }
#pragma unroll
      for (int kk = 0; kk < 2; ++kk) { bf16x8 bfr[2];
#pragma unroll
          for (int nt = 0; nt < 2; ++nt) bfr[nt] = *(const bf16x8*)(PT + (size_t)((wave & 1) * 32 + nt * 16 + fr) * 64 + kk * 32 + quad * 8);
#pragma unroll
          for (int mt = 0; mt < 4; ++mt) { const bf16x8 a = *(LAS bf16x8*)(RS + (mt * 16 + fr) * 528 + (g2 * 64 + kk * 32 + quad * 8) * 2);
              acc[mt][0] = mfma16(a, bfr[0], acc[mt][0]); acc[mt][1] = mfma16(a, bfr[1], acc[mt][1]); } }
#pragma unroll
      for (int nt = 0; nt < 2; ++nt) { const int col = 32 * wave + nt * 16 + fr; const float ps = A.in[I_POOLS][l * 256 + col];
#pragma unroll
          for (int mt = 0; mt < 4; ++mt)
#pragma unroll
              for (int i = 0; i < 4; ++i) { const int t = mt * 16 + quad * 4 + i; MIX[(size_t)(tok0 + t) * D + 768 + col] = (bf16_t)f2bf(acc[mt][nt][i] * ps); } } }
    __syncthreads();
}

__device__ __forceinline__ void state_copies(const DevArgs& A, int l, int gt, int NT) {
    const bf16_t* PROJ = (const bf16_t*)(A.ws + WS_PROJ);
#pragma unroll 1
    for (int i = gt; i < 8 * 3 * 1536; i += NT) { const int col = i % 1536, j = (i / 1536) % 3, b = i / 4608;
        A.out[O_CP + (size_t)l * 8 * 4608 + i] = bf2f(PROJ[(size_t)(b * SEQ + SEQ - 3 + j) * NPROJ + col]); }
#pragma unroll 1
    for (int i = gt; i < 128 * 3 * 1536; i += NT) { const int col = i % 1536, j = (i / 1536) % 3, b = i / 4608;
        A.out[O_CS + (size_t)l * 128 * 4608 + i] = bf2f(PROJ[(size_t)(NP + b * 4 + 1 + j) * NPROJ + col]); }
#pragma unroll 1
    for (int i = gt; i < 8 * 15 * 256; i += NT) { const int ch = i & 255, j = (i >> 8) % 15, b = i / 3840;
        A.out[O_PP + (size_t)l * 8 * 3840 + i] = bf2f(PROJ[(size_t)(b * SEQ + SEQ - 15 + j) * NPROJ + PC_POOL + ch]); }
#pragma unroll 1
    for (int i = gt; i < 128 * 15 * 256; i += NT) { const int ch = i & 255, j = (i >> 8) % 15, b = i / 3840;
        A.out[O_PS + (size_t)l * 128 * 3840 + i] = (j < 11) ? A.in[I_SPOOL][((size_t)(l * 128 + b) * 15 + 4 + j) * 256 + ch]
                                                             : bf2f(PROJ[(size_t)(NP + b * 4 + (j - 11)) * NPROJ + PC_POOL + ch]); }
}

#ifndef REP_DPREP
#define REP_DPREP 1
#endif
#ifndef REP_DSAMP
#define REP_DSAMP 1
#endif
#ifndef REP_SSM1
#define REP_SSM1 1
#endif
#ifndef REP_POOL
#define REP_POOL 1
#endif
#ifndef REP_DSCAN
#define REP_DSCAN 1
#endif
#ifndef REP_SSM2
#define REP_SSM2 1
#endif
#ifndef REP_G
#define REP_G 1
#endif
#ifndef REP_P3
#define REP_P3 1
#endif
#ifndef REP_P2
#define REP_P2 1
#endif
constexpr int NPH = 2 + DEPTH * 8;
__global__ void __launch_bounds__(512, 2) mega_fwd(Args KA) {
    DevArgs A; A.out = KA.out; A.ws = KA.ws; A.ph_lo = KA.ph_lo; A.ph_hi = KA.ph_hi;
    extern __shared__ __attribute__((aligned(16))) unsigned char lds_raw[];
    LAS unsigned char* lds = (LAS unsigned char*)lds_raw;
    cg::grid_group grid = cg::this_grid();
    volatile LAS unsigned* xst = (volatile LAS unsigned*)(lds + LDS_BYTES - 64);
    if (threadIdx.x == 0) { xst[0] = 0u; xst[1] = 0u; }
    __syncthreads();
    const XcdBarrier xb = xcd_barrier_post((unsigned*)(KA.ws + WS_BAR), xst);
    constexpr int G = 256, NGW = G * 8, NT = G * 512;
    int ph = 0;
#define PH_BEGIN if (A.ph_lo <= ph && ph < A.ph_hi) { int tid = threadIdx.x; asm volatile("" : "+v"(tid)); { unsigned char* _w = A.ws; asm volatile("" : "+s"(_w)); A.ws = _w; float* _o = A.out; asm volatile("" : "+s"(_o)); A.out = _o; } const int wave = __builtin_amdgcn_readfirstlane(tid >> 6), lane = tid & 63, gw = blockIdx.x * 8 + wave, gt = blockIdx.x * 512 + tid; (void)gw; (void)gt; (void)lane;
#define PH_END   if (ph + 1 < A.ph_hi) { if (ph == 0) grid.sync(); else xcd_barrier(xb); } } ++ph;
#define Hb   ((bf16_t*)(A.ws + WS_H))
#define AB   ((float*)(A.ws + WS_AB))
#define MIXO ((float*)(A.ws + WS_MIXO))
#define PROJ ((bf16_t*)(A.ws + WS_PROJ))
#define MIX  ((bf16_t*)(A.ws + WS_MIX))
#define HID  ((bf16_t*)(A.ws + WS_HID))

#ifndef REP_PRO
#define REP_PRO 1
#endif
#ifndef REP_N0
#define REP_N0 1
#endif
    PH_BEGIN for (int rep = 0; rep < REP_PRO; ++rep) { prologue(A, lds, wave, lane, gw, NGW); __syncthreads(); } PH_END
    PH_BEGIN for (int rep = 0; rep < REP_N0; ++rep) norm_rows(nullptr, nullptr, A.in[I_XP], A.in[I_XS], nullptr, A.in[I_NMPRE], Hb, (const float*)(A.ws + WS_WAB), AB, gw, NGW, lane); PH_END

#pragma unroll 1
    for (int l = 0; l < DEPTH; ++l) {
        PH_BEGIN for (int rep = 0; rep < REP_G; ++rep) { pg8::Gemm g{Hb, (const bf16_t*)(A.ws + WS_WIN + l * SZ_WIN), NTOK, NPROJ, D, D, D}; pg8::StaticOrder S; S.init(NTOK, NPROJ, G, (int)blockIdx.x);
            pg8::EpiBf16<0> E{PROJ, NPROJ, nullptr, 0, 0}; pg8::gemm_phase<pg8::EpiBf16<0>, pg8::StaticOrder>(lds, g, S, E, nullptr); } PH_END
        constexpr int SUBC = 7;
        PH_BEGIN {
#pragma unroll 1
          for (int rep2 = 0; rep2 < REP_P2; ++rep2) {
#pragma unroll 1
            for (int j = blockIdx.x; j < 32 * SUBC; j += G) delta_prep_item(A, l, lds, (j & 31) * 32 + (j >> 5), tid, wave, lane);
#pragma unroll 1
            for (int it = blockIdx.x; it < 512; it += G) delta_sample_item(A, l, lds, it, tid, wave, lane);
#pragma unroll 1
            for (int it = gw; it < 8 * 31 * 16; it += NGW) ssm_part1_item(A, l, it, lane);
#pragma unroll 1
            for (int it = blockIdx.x; it < 264; it += G) pool_item(A, l, lds, it, tid, wave, lane);
            state_copies(A, l, gt, NT);
          }
        } PH_END
        PH_BEGIN {
#pragma unroll 1
            for (int rep3 = 0; rep3 < REP_P3; ++rep3) {
                if (blockIdx.x < 32) delta_scan_item(A, l, lds, blockIdx.x, tid, wave, lane, xb, SUBC);
                else { const int w = blockIdx.x - 32; constexpr int NW = G - 32;
#pragma unroll 1
                    for (int k = 1; k <= 5; ++k) {
                        const int n0 = k * SUBC, nn = (n0 >= 32) ? 0 : ((32 - n0 < SUBC) ? 32 - n0 : SUBC);
                        int nprep = 32 * nn;
#ifndef REP_WPREP
#define REP_WPREP 1
#endif
#pragma unroll 1
                        for (int rep = 0; rep < REP_WPREP; ++rep)
#pragma unroll 1
                        for (int j = w; j < nprep; j += NW) delta_prep_item(A, l, lds, (j & 31) * 32 + n0 + (j >> 5), tid, wave, lane);
                        { const int it = (k == 4) ? w - 128 : ((k == 5) ? 96 + w : -1);
                          if (it >= 0 && it < ((k == 4) ? 96 : 264)) ssm_part2_item(A, l, lds, it, tid, wave, lane); }
                        if (k < 5) xcd_barrier(xb);
                    } }
            }
        } PH_END
        PH_BEGIN for (int rep = 0; rep < REP_G; ++rep) { pg8::Gemm g{MIX, (const bf16_t*)(A.ws + WS_WOUT + l * SZ_WOUT), NP, D, D, D, D}; pg8::StaticOrder S; S.init(NP, D, G, (int)blockIdx.x);
            pg8::EpiF32 E{MIXO, D, nullptr}; pg8::gemm_phase<pg8::EpiF32, pg8::StaticOrder>(lds, g, S, E, nullptr);
            pg8::Gemm g2{MIX + (size_t)NP * D, (const bf16_t*)(A.ws + WS_WOUT + l * SZ_WOUT), NS, D, 256, D, D}; SliceOrder S2{8 * (D / 256), G, (int)blockIdx.x};
            EpiF32Part E2{(float*)(A.ws + WS_PARTS)}; pg8::gemm_phase<EpiF32Part, SliceOrder>(lds, g2, S2, E2, nullptr); } PH_END
#ifndef REP_N5
#define REP_N5 1
#endif
        PH_BEGIN for (int rep = 0; rep < (l == 0 ? REP_N5 : 1); ++rep) norm_rows(MIXO, A.in[I_NMPOST] + l * D, l == 0 ? A.in[I_XP] : A.out, l == 0 ? A.in[I_XS] : nullptr, A.out, A.in[I_NFPRE] + l * D, Hb, nullptr, nullptr, gw, NGW, lane, (const float*)(A.ws + WS_PARTS), D / 256); PH_END
        PH_BEGIN for (int rep = 0; rep < REP_G; ++rep) { pg8::Gemm g{Hb, (const bf16_t*)(A.ws + WS_WGU + l * SZ_WGU), NTOK, NGU, D, D, D}; pg8::StaticOrder S; S.init(NTOK, NGU, G, (int)blockIdx.x);
            EpiSwiGLU E{HID, DFF}; pg8::gemm_phase<EpiSwiGLU, pg8::StaticOrder>(lds, g, S, E, nullptr); } PH_END
        PH_BEGIN for (int rep = 0; rep < REP_G; ++rep) { pg8::Gemm g{HID, (const bf16_t*)(A.ws + WS_WDN + l * SZ_WDN), NP, D, DFF, DFF, DFF}; pg8::StaticOrder S; S.init(NP, D, G, (int)blockIdx.x);
            pg8::EpiF32 E{MIXO, D, nullptr}; pg8::gemm_phase<pg8::EpiF32, pg8::StaticOrder>(lds, g, S, E, nullptr);
            pg8::Gemm g2{HID + (size_t)NP * DFF, (const bf16_t*)(A.ws + WS_WDN + l * SZ_WDN), NS, D, 256, DFF, DFF}; SliceOrder S2{8 * (DFF / 256), G, (int)blockIdx.x};
            EpiF32Part E2{(float*)(A.ws + WS_PARTS)}; pg8::gemm_phase<EpiF32Part, SliceOrder>(lds, g2, S2, E2, nullptr); } PH_END
        PH_BEGIN norm_rows(MIXO, A.in[I_NFPOST] + l * D, A.out, nullptr, A.out, l + 1 < DEPTH ? A.in[I_NMPRE] + (l + 1) * D : nullptr, l + 1 < DEPTH ? Hb : nullptr,
                           l + 1 < DEPTH ? (const float*)(A.ws + WS_WAB + (l + 1) * SZ_WAB) : nullptr, AB, gw, NGW, lane, (const float*)(A.ws + WS_PARTS), DFF / 256); PH_END
    }
#undef PH_BEGIN
#undef PH_END
#undef Hb
#undef AB
#undef MIXO
#undef PROJ
#undef MIX
#undef HID
}

extern "C" void kernel_launch(void* const* d_in, const int* in_sizes, int n_in, void* d_out, int out_size, void* d_ws, size_t ws_size, hipStream_t stream) {
    static int grid = 0;
    if (grid == 0) {
        if (n_in != 32 || (size_t)out_size != O_END || ws_size < WS_END) fprintf(stderr, "kernel_launch: unexpected sizes: n_in %d out %d (want %zu) ws %zu (want >= %zu)\n", n_in, out_size, (size_t)O_END, ws_size, (size_t)WS_END);
        int dev = 0, cus = 0, per_cu = 0;
        (void)hipGetDevice(&dev); (void)hipDeviceGetAttribute(&cus, hipDeviceAttributeMultiprocessorCount, dev);
        if (hipFuncSetAttribute((const void*)mega_fwd, hipFuncAttributeMaxDynamicSharedMemorySize, LDS_BYTES) != hipSuccess) fprintf(stderr, "kernel_launch: hipFuncSetAttribute failed\n");
        if (hipOccupancyMaxActiveBlocksPerMultiprocessor(&per_cu, (const void*)mega_fwd, 512, LDS_BYTES) != hipSuccess || per_cu < 1) { fprintf(stderr, "kernel_launch: occupancy query gave %d\n", per_cu); per_cu = 1; (void)hipGetLastError(); }
        grid = cus * per_cu; if (grid <= 0) grid = 256;
        if (grid >= 256) grid = 256;
        fprintf(stderr, "kernel_launch: grid %d (cus %d x %d)%s\n", grid, cus, per_cu, grid < 256 ? "  ERROR: this build needs >= 256 co-resident workgroups" : "");
    }
    (void)hipMemsetAsync((unsigned char*)d_ws + WS_BAR, 0, 16384, stream);
    Args a{};
    for (int i = 0; i < 32; ++i) a.in[i] = (const float*)d_in[i];
    a.out = (float*)d_out; a.ws = (unsigned char*)d_ws;
#if MK_COOP
    a.ph_lo = 0; a.ph_hi = NPH;
    void* args[] = {&a};
    const hipError_t e = hipLaunchCooperativeKernel((const void*)mega_fwd, dim3(grid), dim3(512), args, LDS_BYTES, stream);
    if (e != hipSuccess) fprintf(stderr, "kernel_launch: cooperative launch failed: %s (grid %d)\n", hipGetErrorString(e), grid);
#else
    for (int p = 0; p < NPH; ++p) { a.ph_lo = p; a.ph_hi = p + 1; hipLaunchKernelGGL(mega_fwd, dim3(grid), dim3(512), LDS_BYTES, stream, a); }
#endif
}
```

```cpp
#include <hip/hip_runtime.h>
#include <hip/hip_cooperative_groups.h>
#include <cstdio>
#include <cstdint>
namespace cg = cooperative_groups;
#ifndef MK_COOP
#define MK_COOP 1
#endif
namespace pg8 {
#define PG8_LAS __attribute__((address_space(3)))
typedef unsigned short bf16_t;
typedef short bf16x8 __attribute__((ext_vector_type(8)));
typedef float f32x4 __attribute__((ext_vector_type(4)));
typedef unsigned u32x4 __attribute__((ext_vector_type(4)));
constexpr int BM = 256, BK = 64, HALF = 128, HTB = HALF * BK * 2  , STAGE_BYTES = 8 * HTB, NXCD = 8, WGM = 8;

__host__ __device__ __forceinline__ int lds_byte(int r, int c) { const int st = (r >> 4) * 2 + (c >> 5), rr = r & 15, cc = c & 31, ob = rr * 64 + cc * 2; return st * 1024 + (ob ^ (((ob >> 9) & 1) << 5)); }
__host__ __device__ __forceinline__ void stage_rc(int b, int& R, int& C) { const int st = b / 1024, sb = b % 1024, swz = sb ^ (((sb >> 9) & 1) << 5); R = (st >> 1) * 16 + swz / 64; C = (st & 1) * 32 + (swz % 64) / 2; }
__host__ __device__ __forceinline__ int perm32(int rho) { const int n = rho >> 4, i = rho & 15; return 8 * (i >> 2) + 4 * n + (i & 3); }

struct Unit { int pm, pn, ks; };
struct Gemm { const bf16_t* A; const bf16_t* Bt; int M, N, K, lda, ldb; };

struct StaticOrder {
    int nM, nN, nwg, G, c;
    __host__ __device__ void init(int M, int N, int G_, int c_) { nM = M / BM; nN = N / BM; nwg = nM * nN; G = G_; c = c_; }
    __host__ __device__ bool next(int i, Unit& u) const {
        const long L = (long)i * G + c; if (L >= nwg) return false;
        int wgid = (int)L; { const int q = nwg / NXCD, r = nwg % NXCD, xcd = wgid % NXCD, off = wgid / NXCD; wgid = (xcd < r ? xcd * (q + 1) : r * (q + 1) + (xcd - r) * q) + off; }
        const int nig = WGM * nN, gid = wgid / nig, fm = gid * WGM, gsz = (nM - fm) < WGM ? (nM - fm) : WGM;
        u.pm = fm + ((wgid % nig) % gsz); u.pn = (wgid % nig) / gsz; u.ks = 0; return true;
    }
    __device__ __forceinline__ void a_ready(const Unit&) const {}
    __device__ __forceinline__ void done(const Unit&) const {}
};
__device__ __forceinline__ unsigned cvt_pk_bf16(float lo, float hi) { unsigned r; asm volatile("v_cvt_pk_bf16_f32 %0, %1, %2" : "=v"(r) : "v"(lo), "v"(hi)); return r; }
typedef float f32x2 __attribute__((ext_vector_type(2)));
__device__ __forceinline__ f32x2 gelu_pk(f32x2 v) {
    const f32x2 av = __builtin_elementwise_abs(v), d = av * 0.2316418882f + 1.0f;
    f32x2 t; t.x = __builtin_amdgcn_rcpf(d.x); t.y = __builtin_amdgcn_rcpf(d.y);
    f32x2 q = t * 0.5307027145f + (-0.7265760135f); q = q * t + 0.7107068705f; q = q * t + (-0.142248368f); q = q * t + 0.127414796f; q = q * t;
    const f32x2 s = (v * v) * (-0.72134752044f);
    f32x2 e; e.x = __builtin_amdgcn_exp2f(s.x); e.y = __builtin_amdgcn_exp2f(s.y);
    const f32x2 m = v * (q * e), r = v - m;
    f32x2 o; o.x = v.x < 0.f ? m.x : r.x; o.y = v.y < 0.f ? m.y : r.y; return o;
}

struct EpiF32 {
    static constexpr bool PERM = false, AFTER_DRAIN = false;
    float* C; int ldc; const float* bias;
    __device__ __forceinline__ void operator()(const f32x4 (&acc)[2][2][4][2], const Unit& u, int wr, int wc, int fr, int fq) const {
        const int row0 = u.pm * BM + wr * 64 + fr, col0 = u.pn * BM + wc * 32 + 4 * fq;
        f32x4 bv[2][2];
#pragma unroll
        for (int bj = 0; bj < 2; ++bj)
#pragma unroll
            for (int n = 0; n < 2; ++n) bv[bj][n] = bias ? *(const f32x4*)(bias + col0 + bj * HALF + n * 16) : (f32x4){0.f, 0.f, 0.f, 0.f};
#pragma unroll
        for (int ai = 0; ai < 2; ++ai)
#pragma unroll
            for (int m = 0; m < 4; ++m) { float* rowp = C + (size_t)(row0 + ai * HALF + m * 16) * ldc + col0;
#pragma unroll
                for (int bj = 0; bj < 2; ++bj)
#pragma unroll
                    for (int n = 0; n < 2; ++n) *(f32x4*)(rowp + bj * HALF + n * 16) = acc[ai][bj][m][n] + bv[bj][n]; }
    }
};
template <int ACT  > struct EpiBf16 {
    static constexpr bool PERM = true, AFTER_DRAIN = false;
    bf16_t* O; int ldc; const float* bias; int split_cols; size_t split_stride;
    __device__ __forceinline__ void operator()(const f32x4 (&acc)[2][2][4][2], const Unit& u, int wr, int wc, int fr, int fq) const {
        const int row0 = u.pm * BM + wr * 64 + fr; int colt = u.pn * BM; bf16_t* base = O;
        if (split_cols) { const int t = colt / split_cols; base += (size_t)t * split_stride; colt -= t * split_cols; }
        const int col0 = colt + wc * 32 + 8 * fq, bcol0 = u.pn * BM + wc * 32 + 8 * fq;
        f32x4 bv[2][2];
#pragma unroll
        for (int bj = 0; bj < 2; ++bj)
#pragma unroll
            for (int n = 0; n < 2; ++n) bv[bj][n] = bias ? *(const f32x4*)(bias + bcol0 + bj * HALF + 4 * n) : (f32x4){0.f, 0.f, 0.f, 0.f};
#pragma unroll
        for (int ai = 0; ai < 2; ++ai)
#pragma unroll
            for (int m = 0; m < 4; ++m) { bf16_t* rowp = base + (size_t)(row0 + ai * HALF + m * 16) * ldc + col0;
#pragma unroll
                for (int bj = 0; bj < 2; ++bj) { f32x4 v0 = acc[ai][bj][m][0] + bv[bj][0], v1 = acc[ai][bj][m][1] + bv[bj][1];
                    if (ACT == 1) { f32x2 a = gelu_pk((f32x2){v0[0], v0[1]}), b = gelu_pk((f32x2){v0[2], v0[3]}), c = gelu_pk((f32x2){v1[0], v1[1]}), d = gelu_pk((f32x2){v1[2], v1[3]});
                        v0 = (f32x4){a.x, a.y, b.x, b.y}; v1 = (f32x4){c.x, c.y, d.x, d.y}; }
                    if (ACT == 2) {
#pragma unroll
                        for (int j = 0; j < 4; ++j) { v0[j] = 0.5f * v0[j] * (1.0f + erff(v0[j] * 0.70710678f)); v1[j] = 0.5f * v1[j] * (1.0f + erff(v1[j] * 0.70710678f)); } }
                    u32x4 w; w.x = cvt_pk_bf16(v0[0], v0[1]); w.y = cvt_pk_bf16(v0[2], v0[3]); w.z = cvt_pk_bf16(v1[0], v1[1]); w.w = cvt_pk_bf16(v1[2], v1[3]);
                    *(u32x4*)(rowp + bj * HALF) = w; } }
    }
};
template <class Epi, class Sched, bool STAMP = false>
__device__ __forceinline__ void gemm_phase(PG8_LAS unsigned char* lds, const Gemm g, const Sched& S, const Epi& E, unsigned long long* stamps) {
    int tid_ = threadIdx.x; asm volatile("" : "+v"(tid_));
    const int tid = tid_, wid = __builtin_amdgcn_readfirstlane(tid >> 6), lane = tid & 63, wr = wid >> 2, wc = wid & 3, fr = lane & 15, fq = lane >> 4;
    const int K = g.K, nt = K / BK;
    int ts_lo = 0, ts_hi = 0, nts = 0; const unsigned long long rt_entry = STAMP ? (unsigned long long)wall_clock64() : 0ull;
#define PG8_STAMP() do { if (STAMP && wid == 0 && nts < 64) { const unsigned long long _c = (unsigned long long)clock64(); \
        ts_lo = (lane == nts) ? (int)(unsigned)_c : ts_lo; ts_hi = (lane == nts) ? (int)(unsigned)(_c >> 32) : ts_hi; ++nts; } } while (0)
    PG8_STAMP();
    unsigned voffA[2], voffB[2];
#pragma unroll
    for (int i = 0; i < 2; ++i) { int R, C; stage_rc(tid * 16 + i * 8192, R, C); const int Rb = Epi::PERM ? ((R & ~31) + perm32(R & 31)) : R;
        voffA[i] = (unsigned)(R * g.lda + C) * 2u; voffB[i] = (unsigned)(Rb * g.ldb + C) * 2u; }
    const size_t kstep = (size_t)(BK * 2);
    const size_t hstepA = (size_t)HALF * g.lda * 2, hstepB = (size_t)HALF * g.ldb * 2;
    const size_t tstepA = 2 * hstepA, tstepB = 2 * hstepB, sstep = (size_t)K * 2;
    const unsigned ldsw = (unsigned)wid * 1024u;
    const int aoff = lds_byte(wr * 64 + fr, fq * 8), boff = lds_byte(wc * 32 + fr, fq * 8);
#define PG8_SA(b, h) (((b) * 2 + (h)) * HTB)
#define PG8_SB(b, h) ((4 + (b) * 2 + (h)) * HTB)
#define PG8_STAGE(bufoff, gbase, voff) do { _Pragma("unroll") for (int _i = 0; _i < 2; ++_i) \
        __builtin_amdgcn_global_load_lds((const unsigned*)((const char*)(gbase) + (voff)[_i]), (PG8_LAS unsigned*)(lds + (bufoff) + ldsw + _i * 8192), 16, 0, 0); } while (0)
#define PG8_LDA(dst, b, h) do { _Pragma("unroll") for (int m = 0; m < 4; ++m) _Pragma("unroll") for (int k = 0; k < 2; ++k) dst[m][k] = *(const PG8_LAS bf16x8*)(lds + PG8_SA(b, h) + aoff + m * 2048 + k * 1024); } while (0)
#define PG8_LDB(dst, b, h) do { _Pragma("unroll") for (int n = 0; n < 2; ++n) _Pragma("unroll") for (int k = 0; k < 2; ++k) dst[n][k] = *(const PG8_LAS bf16x8*)(lds + PG8_SB(b, h) + boff + n * 2048 + k * 1024); } while (0)
#define PG8_MMA(ai, bj, At, Bt) do { __builtin_amdgcn_s_setprio(1); _Pragma("unroll") for (int m = 0; m < 4; ++m) _Pragma("unroll") for (int n = 0; n < 2; ++n) _Pragma("unroll") for (int k = 0; k < 2; ++k) \
        acc[ai][bj][m][n] = __builtin_amdgcn_mfma_f32_16x16x32_bf16(Bt[n][k], At[m][k], acc[ai][bj][m][n], 0, 0, 0); __builtin_amdgcn_s_setprio(0); } while (0)
#define PG8_WAIT_V(n) asm volatile("s_waitcnt vmcnt(" #n ")" ::: "memory")
#define PG8_WAIT_L(n) asm volatile("s_waitcnt lgkmcnt(" #n ")" ::: "memory")
#define PG8_BAR __builtin_amdgcn_s_barrier()
#define PG8_SCHED __builtin_amdgcn_sched_barrier(0)
    Unit cur, nxt; int ui = 0;
    if (!S.next(0, cur)) return;
    f32x4 acc[2][2][4][2];
#pragma unroll
    for (int a = 0; a < 2; ++a)
#pragma unroll
        for (int b = 0; b < 2; ++b)
#pragma unroll
            for (int m = 0; m < 4; ++m)
#pragma unroll
                for (int n = 0; n < 2; ++n) acc[a][b][m][n] = (f32x4){0.f, 0.f, 0.f, 0.f};
    bf16x8 At[4][2], B0[2][2], B1[2][2];
    const char* cA = (const char*)g.A + (size_t)cur.pm * tstepA + (size_t)cur.ks * sstep; const char* cB = (const char*)g.Bt + (size_t)cur.pn * tstepB + (size_t)cur.ks * sstep;
    S.a_ready(cur);
    PG8_STAGE(PG8_SB(0, 0), cB, voffB); PG8_STAGE(PG8_SA(0, 0), cA, voffA); PG8_STAGE(PG8_SB(0, 1), cB + hstepB, voffB); PG8_STAGE(PG8_SA(0, 1), cA + hstepA, voffA);
    if (wr == 1) PG8_BAR;
    PG8_WAIT_V(4); PG8_BAR;
    PG8_STAGE(PG8_SB(1, 0), cB + kstep, voffB); PG8_STAGE(PG8_SA(1, 0), cA + kstep, voffA); PG8_STAGE(PG8_SB(1, 1), cB + hstepB + kstep, voffB);
    PG8_WAIT_V(6); PG8_BAR;
    PG8_STAMP();
    for (;;) {
        const bool has_next = S.next(ui + 1, nxt);
        const char* nA = has_next ? (const char*)g.A + (size_t)nxt.pm * tstepA + (size_t)nxt.ks * sstep : cA; const char* nB = has_next ? (const char*)g.Bt + (size_t)nxt.pn * tstepB + (size_t)nxt.ks * sstep : cB;
        for (int t = 0; t < nt; t += 2) {
            const bool last = (t == nt - 2);
            const char* a1 = cA + (size_t)(t + 1) * kstep;
            const char* a2 = last ? nA : cA + (size_t)(t + 2) * kstep; const char* b2 = last ? nB : cB + (size_t)(t + 2) * kstep;
            const char* a3 = a2 + kstep; const char* b3 = b2 + kstep;
            if (last && has_next) S.a_ready(nxt);
            PG8_LDB(B0, 0, 0); PG8_SCHED; PG8_LDA(At, 0, 0); PG8_STAGE(PG8_SA(1, 1), a1 + hstepA, voffA);
            PG8_WAIT_L(8); PG8_BAR; PG8_WAIT_L(0); PG8_MMA(0, 0, At, B0); PG8_BAR; PG8_SCHED;
            PG8_LDB(B1, 0, 1); PG8_STAGE(PG8_SB(0, 0), b2, voffB);
            PG8_BAR; PG8_WAIT_L(0); PG8_MMA(0, 1, At, B1); PG8_BAR;
            PG8_LDA(At, 0, 1); PG8_STAGE(PG8_SA(0, 0), a2, voffA);
            PG8_BAR; PG8_WAIT_L(0); PG8_MMA(1, 0, At, B0); PG8_BAR; PG8_SCHED;
            PG8_STAGE(PG8_SB(0, 1), b2 + hstepB, voffB);
            PG8_WAIT_V(6); PG8_BAR; PG8_MMA(1, 1, At, B1); PG8_BAR;
            PG8_LDB(B0, 1, 0); PG8_SCHED; PG8_LDA(At, 1, 0); PG8_STAGE(PG8_SA(0, 1), a2 + hstepA, voffA);
            PG8_WAIT_L(8); PG8_BAR; PG8_WAIT_L(0); PG8_MMA(0, 0, At, B0); PG8_BAR; PG8_SCHED;
            PG8_LDB(B1, 1, 1); PG8_STAGE(PG8_SB(1, 0), b3, voffB);
            PG8_BAR; PG8_WAIT_L(0); PG8_MMA(0, 1, At, B1); PG8_BAR;
            PG8_LDA(At, 1, 1); PG8_STAGE(PG8_SA(1, 0), a3, voffA);
            PG8_BAR; PG8_WAIT_L(0); PG8_MMA(1, 0, At, B0); PG8_BAR; PG8_SCHED;
            PG8_STAGE(PG8_SB(1, 1), b3 + hstepB, voffB);
            PG8_WAIT_V(6); PG8_BAR; PG8_MMA(1, 1, At, B1); PG8_BAR;
        }
        PG8_STAMP();
        if constexpr (!Epi::AFTER_DRAIN) { E(acc, cur, wr, wc, fr, fq); S.done(cur); }
        PG8_STAMP();
        if (!has_next) break;
#pragma unroll
        for (int a = 0; a < 2; ++a)
#pragma unroll
            for (int b = 0; b < 2; ++b)
#pragma unroll
                for (int m = 0; m < 4; ++m)
#pragma unroll
                    for (int n = 0; n < 2; ++n) acc[a][b][m][n] = (f32x4){0.f, 0.f, 0.f, 0.f};
        cur = nxt; cA = nA; cB = nB; ++ui;
    }
    PG8_WAIT_V(0);
    if (wr == 0) PG8_BAR;
    PG8_BAR;
    if constexpr (Epi::AFTER_DRAIN) { E.fused(acc, cur, wr, wc, fr, fq, lds, wid, lane); S.done(cur); }
    PG8_STAMP();
    if (STAMP && wid == 0) { stamps[lane] = lane < nts ? (((unsigned long long)(unsigned)ts_hi << 32) | (unsigned)ts_lo) : 0ull;
        if (lane == 62) stamps[62] = rt_entry; if (lane == 63) stamps[63] = (unsigned long long)wall_clock64(); }
#undef PG8_STAMP
#undef PG8_SA
#undef PG8_SB
#undef PG8_STAGE
#undef PG8_LDA
#undef PG8_LDB
#undef PG8_MMA
#undef PG8_WAIT_V
#undef PG8_WAIT_L
#undef PG8_BAR
#undef PG8_SCHED
}
}

#define LAS __attribute__((address_space(3)))
typedef unsigned short bf16_t;
typedef short bf16x8 __attribute__((ext_vector_type(8)));
typedef float f32x4 __attribute__((ext_vector_type(4)));
typedef float f32x2 __attribute__((ext_vector_type(2)));
typedef unsigned u32x4 __attribute__((ext_vector_type(4)));
typedef unsigned u32x2 __attribute__((ext_vector_type(2)));

constexpr int D = 1024, NP = 16384, NS = 512, NTOK = NP + NS, SEQ = 2048, NB = 8, NSB = 128, DEPTH = 4;
constexpr int INW = 2568, NPROJ = 2560, DFF = 2816, NGU = 5632;
constexpr int PC_G = 1536, PC_SSM = 2048, PC_POOL = 2304;
constexpr float EPS = 1e-6f;
constexpr int LDS_BYTES = 163840;

constexpr size_t SZ_WIN = (size_t)NPROJ * D * 2, SZ_WOUT = (size_t)D * D * 2, SZ_WGU = (size_t)NGU * D * 2, SZ_WDN = (size_t)D * DFF * 2;
constexpr size_t SZ_WAB = 8 * D * 4, SZ_GLUT = 256 * 256 * 2, SZ_POOLT = 4 * 64 * 64 * 2, SZ_SSMK = 16 * 64 * 4 * 4, SZ_BBAR = 16 * 64 * 32 * 4;
constexpr size_t WS_WIN = 0;
constexpr size_t WS_WOUT = WS_WIN + DEPTH * SZ_WIN;
constexpr size_t WS_WGU = WS_WOUT + DEPTH * SZ_WOUT;
constexpr size_t WS_WDN = WS_WGU + DEPTH * SZ_WGU;
constexpr size_t WS_WAB = WS_WDN + DEPTH * SZ_WDN;
constexpr size_t WS_GLUT = WS_WAB + DEPTH * SZ_WAB;
constexpr size_t WS_POOLT = WS_GLUT + DEPTH * SZ_GLUT;
constexpr size_t WS_SSMK = WS_POOLT + DEPTH * SZ_POOLT;
constexpr size_t WS_BBAR = WS_SSMK + DEPTH * SZ_SSMK;
constexpr size_t WS_H = WS_BBAR + DEPTH * SZ_BBAR;
constexpr size_t WS_AB = WS_H + (size_t)NTOK * D * 2;
constexpr size_t WS_MIX = WS_AB + (size_t)NTOK * 8 * 4;
constexpr size_t WS_MIXO = WS_MIX + (size_t)NTOK * D * 2;
constexpr size_t WS_SSME = WS_MIXO + (size_t)NTOK * D * 4;
constexpr size_t WS_PROJ = WS_SSME + (size_t)8 * 32 * 16 * 64 * 2 * 4;
constexpr size_t WS_DW = WS_PROJ + (size_t)NTOK * NPROJ * 2;
constexpr size_t WS_DKC = WS_DW + (size_t)1024 * 8192 * 4;
constexpr size_t WS_DQD = WS_DKC + (size_t)1024 * 8192 * 2;
constexpr size_t WS_DQK = WS_DQD + (size_t)1024 * 8192 * 2;
constexpr size_t WS_DKT = WS_DQK + (size_t)1024 * 4096 * 2;
constexpr size_t WS_DGL = WS_DKT + (size_t)1024 * 8192 * 2;
constexpr size_t WS_DGS = WS_DGL + 4096;
constexpr size_t WS_BAR = WS_DGS + (size_t)1024 * 8192 * 2;
constexpr size_t WS_PARTS = WS_BAR + 16384;
constexpr size_t WS_END = WS_PARTS + (size_t)11 * 512 * 1024 * 4;
constexpr size_t WS_HID = WS_PROJ;
static_assert(WS_HID + (size_t)NTOK * DFF * 2 <= WS_END, "HID overlay");
static_assert(WS_H % 256 == 0 && WS_PROJ % 256 == 0 && WS_DW % 256 == 0, "align");

constexpr size_t O_YP = 0, O_YS = O_YP + (size_t)NP * D, O_DP = O_YS + (size_t)NS * D, O_CP = O_DP + (size_t)DEPTH * 8 * 4 * 16384,
                 O_REP = O_CP + (size_t)DEPTH * 8 * 3 * 1536, O_IMP = O_REP + (size_t)DEPTH * 8 * 1024, O_PP = O_IMP + (size_t)DEPTH * 8 * 1024,
                 O_DS = O_PP + (size_t)DEPTH * 8 * 15 * 256, O_CS = O_DS + (size_t)DEPTH * 128 * 4 * 16384, O_RES = O_CS + (size_t)DEPTH * 128 * 3 * 1536,
                 O_IMS = O_RES + (size_t)DEPTH * 128 * 1024, O_PS = O_IMS + (size_t)DEPTH * 128 * 1024, O_END = O_PS + (size_t)DEPTH * 128 * 15 * 256;

struct Args { const float* in[32]; float* out; unsigned char* ws; int ph_lo, ph_hi; };
typedef const float* cfp_t;
typedef __attribute__((address_space(4))) const unsigned char* kptr_t;
struct InProxy { __device__ __forceinline__ const float* operator[](int i) const {
    kptr_t p = (kptr_t)__builtin_amdgcn_kernarg_segment_ptr(); asm volatile("" : "+s"(p)); return *(__attribute__((address_space(4))) const cfp_t*)(p + 8 * i); } };
struct DevArgs { InProxy in; float* out; unsigned char* ws; int ph_lo, ph_hi; };
enum { I_XP = 0, I_XS, I_SDELTA, I_SCONV, I_SRE, I_SIM, I_SPOOL, I_NMPRE, I_NMPOST, I_NFPRE, I_NFPOST, I_WIN, I_CONVW, I_ALOG, I_DTB, I_ONORM,
       I_ARE, I_AIM, I_LOGDT, I_BRE, I_BIM, I_CRE, I_CIM, I_SSMD, I_GLUW, I_GLUB, I_POOLW, I_POOLS, I_WOUT, I_WG, I_WU, I_WD };

__device__ __forceinline__ unsigned f2bf(float f) { unsigned u = __float_as_uint(f); return (u + 0x7fffu + ((u >> 16) & 1u)) >> 16; }
__device__ __forceinline__ float bf2f(unsigned b) { return __uint_as_float(b << 16); }
__device__ __forceinline__ unsigned pk2(float lo, float hi) { return f2bf(lo) | (f2bf(hi) << 16); }
__device__ __forceinline__ float wave_sum(float v) {
#pragma unroll
    for (int o = 1; o < 64; o <<= 1) v += __shfl_xor(v, o);
    return v;
}
__device__ __forceinline__ float silu_f(float y) { return y / (1.f + __expf(-y)); }
__device__ __forceinline__ float sigmoid_f(float y) { return 1.f / (1.f + __expf(-y)); }
__device__ __forceinline__ float gelu_tanh_f(float x) { const float t = tanhf(0.7978845608028654f * (x + 0.044715f * x * x * x)); return 0.5f * x * (1.f + t); }
__device__ __forceinline__ f32x4 mfma16(bf16x8 a, bf16x8 b, f32x4 c) { return __builtin_amdgcn_mfma_f32_16x16x32_bf16(a, b, c, 0, 0, 0); }
#define LDS_FENCE() asm volatile("s_waitcnt lgkmcnt(0)" ::: "memory")

struct EpiSwiGLU {
    static constexpr bool PERM = false, AFTER_DRAIN = false;
    bf16_t* O; int ldc;
    __device__ __forceinline__ void operator()(const pg8::f32x4 (&acc)[2][2][4][2], const pg8::Unit& u, int wr, int wc, int fr, int fq) const {
        const int row0 = u.pm * 256 + wr * 64 + fr, hid0 = u.pn * 128 + wc * 16 + 4 * fq;
#pragma unroll
        for (int ai = 0; ai < 2; ++ai)
#pragma unroll
            for (int m = 0; m < 4; ++m) { bf16_t* rowp = O + (size_t)(row0 + ai * 128 + m * 16) * ldc + hid0;
#pragma unroll
                for (int bj = 0; bj < 2; ++bj) { const pg8::f32x4 g = acc[ai][bj][m][0], v = acc[ai][bj][m][1];
                    u32x2 w; w.x = pk2(silu_f(g[0]) * v[0], silu_f(g[1]) * v[1]); w.y = pk2(silu_f(g[2]) * v[2], silu_f(g[3]) * v[3]);
                    *(u32x2*)(rowp + bj * 64) = w; } }
    }
};

#define XB_TMO      128
#define XB_XCNT(j)  (256  + 64 * (j))
#define XB_XSUB(j)  (1280 + 64 * (j))
#define XB_XGEN(j)  (2304 + 64 * (j))
#define XB_TOP      3328
#define XB_TOPGEN   3392
#define XCD_BAR_WORDS 3456
#define XB_SPIN_CAP (1u << 18)

__device__ __forceinline__ unsigned xb_ld(unsigned* p)              { return __hip_atomic_load(p, __ATOMIC_RELAXED, __HIP_MEMORY_SCOPE_AGENT); }
__device__ __forceinline__ unsigned xb_add(unsigned* p, unsigned v) { return __hip_atomic_fetch_add(p, v, __ATOMIC_RELAXED, __HIP_MEMORY_SCOPE_AGENT); }
__device__ __forceinline__ unsigned xb_xcc_id() { return (unsigned)__builtin_amdgcn_s_getreg((3 << 11) | 20) & 0xFu; }
#define XB_SPIN(cond, bar) do { unsigned _sp = 0; while (cond) { __builtin_amdgcn_s_sleep(1); \
    if ((++_sp & 255u) == 0u) { if (xb_ld(&(bar)[XB_TMO])) break; if (_sp > XB_SPIN_CAP) { atomicAdd(&(bar)[XB_TMO], 1u); break; } } } } while (0)

struct XcdBarrier {
    unsigned* bar; unsigned x;
    volatile LAS unsigned* st;
};

__device__ __forceinline__ XcdBarrier xcd_barrier_post(unsigned* bar, volatile LAS unsigned* st) {
    XcdBarrier b; b.bar = bar; b.x = xb_xcc_id(); b.st = st;
    if (threadIdx.x == 0) (void)xb_add(&bar[XB_XCNT(b.x)], 1u);
    return b;
}
__device__ __forceinline__ void xcd_barrier_complete(unsigned* bar, unsigned x, unsigned& nloc, unsigned& nx) {
    const unsigned G = gridDim.x * gridDim.y * gridDim.z;
    unsigned sum, cnt, mine, sp = 0u;
    for (;;) {
        sum = 0u; cnt = 0u; mine = 0u;
#pragma unroll
        for (unsigned j = 0; j < 16; ++j) { const unsigned c = xb_ld(&bar[XB_XCNT(j)]); sum += c; cnt += (c > 0u) ? 1u : 0u; mine = (j == x) ? c : mine; }
        if (sum == G) break;
        __builtin_amdgcn_s_sleep(1);
        if ((++sp & 255u) == 0u) { if (xb_ld(&bar[XB_TMO])) break; if (sp > XB_SPIN_CAP) { atomicAdd(&bar[XB_TMO], 1u); break; } }
    }
    nloc = mine > 0u ? mine : 1u; nx = cnt > 0u ? cnt : 1u;
}

__device__ __forceinline__ void xcd_barrier(const XcdBarrier& b) {
    asm volatile("s_waitcnt vmcnt(0)" ::: "memory");
    __syncthreads();
    if (threadIdx.x == 0) {
        unsigned* bar = b.bar; asm volatile("" : "+s"(bar));
        __builtin_amdgcn_s_waitcnt(0);
        unsigned nloc = b.st[0], nx = b.st[1];
        if (nloc == 0u) { xcd_barrier_complete(bar, b.x, nloc, nx); b.st[0] = nloc; b.st[1] = nx; }
        const unsigned old = xb_add(&bar[XB_XSUB(b.x)], 1u);
        const unsigned gen = old / nloc;
        if (old + 1u == (gen + 1u) * nloc) {
            __builtin_amdgcn_fence(__ATOMIC_RELEASE, "agent");
            asm volatile("s_waitcnt vmcnt(0)" ::: "memory");
            const unsigned og = xb_add(&bar[XB_TOP], 1u);
            const unsigned tg = og / nx;
            if (og + 1u == (tg + 1u) * nx) xb_add(&bar[XB_TOPGEN], 1u);
            else XB_SPIN(xb_ld(&bar[XB_TOPGEN]) == tg, bar);
            __builtin_amdgcn_fence(__ATOMIC_ACQUIRE, "agent");
            xb_add(&bar[XB_XGEN(b.x)], 1u);
            asm volatile("s_waitcnt vmcnt(0)" ::: "memory");
        } else {
            XB_SPIN(xb_ld(&bar[XB_XGEN(b.x)]) == gen, bar);
            __builtin_amdgcn_fence(__ATOMIC_ACQUIRE, "agent");
            asm volatile("s_waitcnt vmcnt(0)" ::: "memory");
        }
    }
    __syncthreads();
}

struct SliceOrder {
    int nunits, G, c;
    __device__ __forceinline__ bool next(int i, pg8::Unit& u) const { const int L = i * G + c; if (L >= nunits) return false; const int t = L & 7; u.pm = t >> 2; u.pn = t & 3; u.ks = L >> 3; return true; }
    __device__ __forceinline__ void a_ready(const pg8::Unit&) const {}
    __device__ __forceinline__ void done(const pg8::Unit&) const {}
};
struct EpiF32Part {
    static constexpr bool PERM = false, AFTER_DRAIN = false;
    float* C;
    __device__ __forceinline__ void operator()(const pg8::f32x4 (&acc)[2][2][4][2], const pg8::Unit& u, int wr, int wc, int fr, int fq) const {
        const int row0 = u.pm * 256 + wr * 64 + fr, col0 = u.pn * 256 + wc * 32 + 4 * fq; float* base = C + (size_t)u.ks * (512 * 1024);
#pragma unroll
        for (int ai = 0; ai < 2; ++ai)
#pragma unroll
            for (int m = 0; m < 4; ++m) { float* rowp = base + (size_t)(row0 + ai * 128 + m * 16) * 1024 + col0;
#pragma unroll
                for (int bj = 0; bj < 2; ++bj)
#pragma unroll
                    for (int n = 0; n < 2; ++n) *(pg8::f32x4*)(rowp + bj * 128 + n * 16) = acc[ai][bj][m][n]; }
    }
};

struct SrcIn { const float* w; __device__ __forceinline__ float operator()(int k, int n) const { return w[(size_t)k * INW + (n < 1536 ? n : n + 8)]; } };
struct SrcPlain { const float* w; int N; __device__ __forceinline__ float operator()(int k, int n) const { return w[(size_t)k * N + n]; } };
struct SrcGU { const float* g; const float* u; __device__ __forceinline__ float operator()(int k, int n) const { const int r = n & 31, hid = (n >> 5) * 16 + (r & 15); const long long du = (r < 16) ? 0ll : (long long)(u - g); return g[du + (long long)k * DFF + hid]; } };
template <class Src> __device__ __forceinline__ void transpose_item(const Src& src, int K, bf16_t* WT, int nblk, LAS float* scr, int item, int lane) {
    const int kb = item / nblk, nb = item % nblk, k0 = 64 * kb, n0 = 32 * nb;
#pragma unroll 8
    for (int i = 0; i < 32; ++i) { const int kk = 2 * i + (lane >> 5); scr[kk * 33 + (lane & 31)] = src(k0 + kk, n0 + (lane & 31)); }
    LDS_FENCE();
    const int c = lane & 7;
#pragma unroll
    for (int j = 0; j < 4; ++j) { const int n = (lane >> 3) + 8 * j; const LAS float* s = scr + (8 * c) * 33 + n;
        u32x4 o; o.x = pk2(s[0 * 33], s[1 * 33]); o.y = pk2(s[2 * 33], s[3 * 33]); o.z = pk2(s[4 * 33], s[5 * 33]); o.w = pk2(s[6 * 33], s[7 * 33]);
        *(u32x4*)(WT + (size_t)(n0 + n) * K + k0 + 8 * c) = o; }
    LDS_FENCE();
}

__device__ __forceinline__ void norm_rows(const float* T, const float* wt, const float* X0, const float* X1, float* Xout, const float* wh, bf16_t* H,
                                          const float* Wab, float* AB, int gw, int NGW, int lane, const float* Tp = nullptr, int ns = 0) {
#pragma unroll 1
    for (int m = gw; m < NTOK; m += NGW) {
        const float* xr = (X1 && m >= NP) ? X1 + (size_t)(m - NP) * D : X0 + (size_t)m * D;
        f32x4 x[4];
#pragma unroll
        for (int j = 0; j < 4; ++j) x[j] = ((const f32x4*)xr)[lane + 64 * j];
        if (T) {
            f32x4 t[4]; float ss = 0.f;
#pragma unroll
            for (int j = 0; j < 4; ++j) {
                if (Tp && m >= NP) { f32x4 a = {0.f, 0.f, 0.f, 0.f}; for (int q = 0; q < ns; ++q) a += ((const f32x4*)(Tp + (size_t)q * (512 * 1024) + (size_t)(m - NP) * D))[lane + 64 * j]; t[j] = a; }
                else t[j] = ((const f32x4*)(T + (size_t)m * D))[lane + 64 * j];
                ss += (t[j].x * t[j].x + t[j].y * t[j].y) + (t[j].z * t[j].z + t[j].w * t[j].w); }
            ss = wave_sum(ss); const float r = rsqrtf(ss * (1.f / D) + EPS);
#pragma unroll
            for (int j = 0; j < 4; ++j) { const f32x4 w = ((const f32x4*)wt)[lane + 64 * j]; x[j] += t[j] * r * w; }
        }
        if (Xout) {
#pragma unroll
            for (int j = 0; j < 4; ++j) ((f32x4*)(Xout + (size_t)m * D))[lane + 64 * j] = x[j];
        }
        if (H) {
            float ss = 0.f;
#pragma unroll
            for (int j = 0; j < 4; ++j) ss += (x[j].x * x[j].x + x[j].y * x[j].y) + (x[j].z * x[j].z + x[j].w * x[j].w);
            ss = wave_sum(ss); const float r = rsqrtf(ss * (1.f / D) + EPS);
            f32x4 hv[4];
#pragma unroll
            for (int j = 0; j < 4; ++j) { const f32x4 w = ((const f32x4*)wh)[lane + 64 * j]; hv[j] = x[j] * r * w;
                u32x2 o; o.x = pk2(hv[j].x, hv[j].y); o.y = pk2(hv[j].z, hv[j].w); ((u32x2*)(H + (size_t)m * D))[lane + 64 * j] = o; }
            if (Wab) {
#pragma unroll
                for (int c = 0; c < 8; ++c) { float d = 0.f;
#pragma unroll
                    for (int j = 0; j < 4; ++j) { const f32x4 w = ((const f32x4*)(Wab + c * D))[lane + 64 * j]; d += (hv[j].x * w.x + hv[j].y * w.y) + (hv[j].z * w.z + hv[j].w * w.w); }
                    d = wave_sum(d); if (lane == 0) AB[(size_t)m * 8 + c] = d; }
            }
        }
    }
}

__device__ __forceinline__ void prologue(const DevArgs& A, LAS unsigned char* lds, int wave, int lane, int gw, int NGW) {
    LAS float* scr = (LAS float*)(lds + wave * 8704);
    constexpr int I_IN = 16 * 80, I_OUT = 16 * 32, I_GU = 16 * 176, I_DN = 44 * 32, I_GLU = 4 * 8, I_POOL = 8, PER = I_IN + I_OUT + I_GU + I_DN + I_GLU + I_POOL;
#pragma unroll 1
    for (int it = gw; it < DEPTH * PER; it += NGW) {
        const int l = it / PER; int r = it % PER;
        if (r < I_IN) { SrcIn s{A.in[I_WIN] + (size_t)l * D * INW}; transpose_item(s, D, (bf16_t*)(A.ws + WS_WIN + l * SZ_WIN), NPROJ / 32, scr, r, lane); continue; } r -= I_IN;
        if (r < I_OUT) { SrcPlain s{A.in[I_WOUT] + (size_t)l * D * D, D}; transpose_item(s, D, (bf16_t*)(A.ws + WS_WOUT + l * SZ_WOUT), D / 32, scr, r, lane); continue; } r -= I_OUT;
        if (r < I_GU) { SrcGU s{A.in[I_WG] + (size_t)l * D * DFF, A.in[I_WU] + (size_t)l * D * DFF}; transpose_item(s, D, (bf16_t*)(A.ws + WS_WGU + l * SZ_WGU), NGU / 32, scr, r, lane); continue; } r -= I_GU;
        if (r < I_DN) { SrcPlain s{A.in[I_WD] + (size_t)l * DFF * D, D}; transpose_item(s, DFF, (bf16_t*)(A.ws + WS_WDN + l * SZ_WDN), D / 32, scr, r, lane); continue; } r -= I_DN;
        if (r < I_GLU) { SrcPlain s{A.in[I_GLUW] + (size_t)l * 65536, 256}; transpose_item(s, 256, (bf16_t*)(A.ws + WS_GLUT + l * SZ_GLUT), 8, scr, r, lane); continue; } r -= I_GLU;
        { const int g = r >> 1; SrcPlain s{A.in[I_POOLW] + (size_t)(l * 4 + g) * 4096, 64}; transpose_item(s, 64, (bf16_t*)(A.ws + WS_POOLT + l * SZ_POOLT) + g * 4096, 2, scr, r & 1, lane); }
    }
    const int gt = gw * 64 + lane, NT = NGW * 64;
    float* wab = (float*)(A.ws + WS_WAB);
#pragma unroll 1
    for (int i = gt; i < DEPTH * 8 * D; i += NT) { const int l = i / (8 * D), j = (i / D) & 7, k = i % D; wab[i] = A.in[I_WIN][((size_t)l * D + k) * INW + 1536 + j]; }
    float* ssmk = (float*)(A.ws + WS_SSMK); float* bbar = (float*)(A.ws + WS_BBAR);
#pragma unroll 1
    for (int i = gt; i < DEPTH * 16 * 64; i += NT) {
        const int lg = i >> 6;
        const float dt = expf(A.in[I_LOGDT][lg]), ar = A.in[I_ARE][i], ai = A.in[I_AIM][i];
        const float mag = expf(ar * dt);
        float rev = ai * dt * 0.15915494309189535f; rev -= floorf(rev);
        const float sn = __builtin_amdgcn_sinf(rev), cs = __builtin_amdgcn_cosf(rev);
        const float lr = mag * cs, li = mag * sn;
        float pr = lr, pi = li;
#pragma unroll
        for (int q = 0; q < 6; ++q) { const float nr2 = pr * pr - pi * pi, ni2 = 2.f * pr * pi; pr = nr2; pi = ni2; }
        ssmk[i * 4 + 0] = lr; ssmk[i * 4 + 1] = li; ssmk[i * 4 + 2] = pr; ssmk[i * 4 + 3] = pi;
        const float nr = lr - 1.f, ni = li, d2 = ar * ar + ai * ai;
        const float cre = (nr * ar + ni * ai) / d2, cim = (ni * ar - nr * ai) / d2;
#pragma unroll
        for (int h = 0; h < 16; ++h) { const float br = A.in[I_BRE][(size_t)i * 16 + h], bi = A.in[I_BIM][(size_t)i * 16 + h];
            bbar[(size_t)i * 32 + h] = cre * br - cim * bi; bbar[(size_t)i * 32 + 16 + h] = cre * bi + cim * br; }
    }
}

__device__ __forceinline__ unsigned bfmul2(unsigned pk, float f0, float f1) { return pg8::cvt_pk_bf16(__uint_as_float(pk << 16) * f0, __uint_as_float(pk & 0xffff0000u) * f1); }
__device__ __forceinline__ void delta_prep_item(const DevArgs& A, int l, LAS unsigned char* lds, int item, int tid, int wave, int lane) {
    asm volatile("" : "+v"(tid)); lane = tid & 63; wave = __builtin_amdgcn_readfirstlane(tid >> 6);
    const int bh = item >> 5, n = item & 31, b = bh >> 2, h = bh & 3;
    const int tok0 = b * SEQ + n * 64;
    LAS bf16_t* QS = (LAS bf16_t*)(lds); LAS bf16_t* KS = (LAS bf16_t*)(lds + 17408);
    LAS unsigned char* KT = lds + 34816; LAS unsigned char* VT = lds + 53248; LAS unsigned char* RTK = lds + 71680;
    LAS float* AM = (LAS float*)(lds + 90112); LAS float* PM = (LAS float*)(lds + 107520); LAS float* PSC = PM; LAS float* TM = (LAS float*)(lds + 124928);
    LAS unsigned char* TB = lds + 142336;
    LAS float* GAM = (LAS float*)(lds + 151552); LAS float* BETA = GAM + 64; LAS float* RQ = GAM + 128; LAS float* RK = GAM + 192;
    LAS float* F2 = GAM + 256; LAS float* F3 = GAM + 320; LAS float* F4 = GAM + 384;
    const bf16_t* PROJ = (const bf16_t*)(A.ws + WS_PROJ);
    const float* AB = (const float*)(A.ws + WS_AB);
    u32x4 gv[2];
#pragma unroll
    for (int j = 0; j < 2; ++j) { const int id = tid + 512 * j; gv[j] = *(const u32x4*)(PROJ + (size_t)(tok0 + (id >> 4)) * NPROJ + PC_G + h * 128 + (id & 15) * 8); }
    if (tid < 384) {
        const int part = tid >> 7, c = tid & 127, col = part * 512 + h * 128 + c;
        const float* cw = A.in[I_CONVW] + (size_t)l * 4 * 1536;
        const float w0 = cw[col], w1 = cw[1536 + col], w2 = cw[3072 + col], w3 = cw[4608 + col];
        const bf16_t* pp = PROJ + (size_t)tok0 * NPROJ + col;
        float xr[67];
#pragma unroll
        for (int t = 0; t < 67; ++t) xr[t] = (n > 0 || t >= 3) ? bf2f(pp[(long)(t - 3) * NPROJ]) : 0.f;
        unsigned pk[32];
#pragma unroll
        for (int t = 0; t < 64; t += 2) {
            const float s0 = silu_f(w0 * xr[t] + w1 * xr[t + 1] + w2 * xr[t + 2] + w3 * xr[t + 3]);
            const float s1 = silu_f(w0 * xr[t + 1] + w1 * xr[t + 2] + w2 * xr[t + 3] + w3 * xr[t + 4]);
            pk[t >> 1] = pg8::cvt_pk_bf16(s0, s1);
        }
        if (part < 2) { LAS bf16_t* dst = (part == 0 ? QS : KS) + c;
#pragma unroll
            for (int t = 0; t < 64; t += 2) { dst[t * 136] = (bf16_t)(pk[t >> 1] & 0xffffu); dst[(t + 1) * 136] = (bf16_t)(pk[t >> 1] >> 16); } }
        if (part > 0) { LAS unsigned char* dst = (part == 1 ? KT : VT) + c * 144;
#pragma unroll
            for (int q = 0; q < 8; ++q) { u32x4 o; o.x = pk[4 * q]; o.y = pk[4 * q + 1]; o.z = pk[4 * q + 2]; o.w = pk[4 * q + 3]; *(LAS u32x4*)(dst + q * 16) = o; } }
    } else if (tid < 448) {
        const int t = tid - 384;
        const float a = AB[(size_t)(tok0 + t) * 8 + h], bb = AB[(size_t)(tok0 + t) * 8 + 4 + h];
        const float xx = a + A.in[I_DTB][l * 4 + h];
        const float sp = xx > 20.f ? xx : log1pf(expf(xx));
        float lg = -expf(A.in[I_ALOG][l * 4 + h]) * sp;
#pragma unroll
        for (int off = 1; off < 64; off <<= 1) { const float v = __shfl_up(lg, off); if (lane >= off) lg += v; }
        GAM[t] = lg; BETA[t] = 1.f / (1.f + expf(-bb));
    }
    __syncthreads();
    {
        const int t = tid >> 3, part = tid & 7; float sq = 0.f, sk = 0.f;
#pragma unroll
        for (int j = 0; j < 16; ++j) { const float q = bf2f(QS[t * 136 + part * 16 + j]), k = bf2f(KS[t * 136 + part * 16 + j]); sq += q * q; sk += k * k; }
        sq += __shfl_xor(sq, 1); sq += __shfl_xor(sq, 2); sq += __shfl_xor(sq, 4);
        sk += __shfl_xor(sk, 1); sk += __shfl_xor(sk, 2); sk += __shfl_xor(sk, 4);
        if (part == 0) { const float rq = rsqrtf(sq + EPS) * 0.08838834764831845f, rk = rsqrtf(sk + EPS), g = GAM[t], eg = __expf(g), bt = BETA[t];
            RQ[t] = rq; RK[t] = rk; F2[t] = bt * eg * rk; F3[t] = rk * __expf(GAM[63] - g); F4[t] = rq * eg; }
    }
    {
        const int prod = wave >> 2, mt = wave & 3, fr = lane & 15, quad = lane >> 4;
        LAS bf16_t* Aop = prod ? QS : KS; LAS float* dst = prod ? PM : AM;
        bf16x8 a[4];
#pragma unroll
        for (int kk = 0; kk < 4; ++kk) a[kk] = *(LAS bf16x8*)(Aop + (mt * 16 + fr) * 136 + kk * 32 + quad * 8);
#pragma unroll
        for (int nt = 0; nt < 4; ++nt) { f32x4 acc = {0.f, 0.f, 0.f, 0.f};
#pragma unroll
            for (int kk = 0; kk < 4; ++kk) { const bf16x8 bq = *(LAS bf16x8*)(KS + (nt * 16 + fr) * 136 + kk * 32 + quad * 8); acc = mfma16(a[kk], bq, acc); }
#pragma unroll
            for (int i = 0; i < 4; ++i) dst[(mt * 16 + quad * 4 + i) * 68 + nt * 16 + fr] = acc[i]; }
    }
    __syncthreads();
    {
        const int t = tid >> 3, s8 = (tid & 7) * 8; const float gt = GAM[t], bk = BETA[t] * RK[t], rqt = RQ[t];
        float av[8], pv[8];
#pragma unroll
        for (int j = 0; j < 8; ++j) { const int s = s8 + j; const float rks = RK[s]; const float dec = (s <= t) ? __expf(gt - GAM[s]) * rks : 0.f;
            av[j] = (s < t) ? bk * dec * AM[t * 68 + s] : 0.f; pv[j] = rqt * dec * PM[t * 68 + s]; }
#pragma unroll
        for (int j = 0; j < 8; ++j) AM[t * 68 + s8 + j] = av[j];
        u32x4 o; o.x = pg8::cvt_pk_bf16(pv[0], pv[1]); o.y = pg8::cvt_pk_bf16(pv[2], pv[3]); o.z = pg8::cvt_pk_bf16(pv[4], pv[5]); o.w = pg8::cvt_pk_bf16(pv[6], pv[7]);
        *(u32x4*)((bf16_t*)(A.ws + WS_DQK) + (size_t)item * 4096 + t * 64 + s8) = o;
        for (int e = tid; e < 64 * 68; e += 512) TM[e] = 0.f;
        if (tid == 0) ((float*)(A.ws + WS_DGL))[item] = __expf(GAM[63]);
    }
    __syncthreads();
    if (wave == 0) {
        const int i = lane >> 4, c = lane & 15;
        LAS float* amp = AM + (16 * i) * 68 + 16 * i; asm volatile("" : "+v"(amp));
        float x[16];
#pragma unroll
        for (int r = 0; r < 16; ++r) { float acc = (r == c) ? 1.f : 0.f;
#pragma unroll
            for (int s = 0; s < r; ++s) acc = fmaf(-amp[r * 68 + s], x[s], acc);
            x[r] = acc; }
        LAS float* tmp = TM + (16 * i) * 68 + 16 * i + c;
#pragma unroll
        for (int r = 0; r < 16; ++r) tmp[r * 68] = x[r];
    } else {
        const int wt = tid - 64;
        for (int id = wt; id < 1024; id += 448) {
            const int c = id >> 3, t8 = (id & 7) * 8;
            const f32x4 b0 = *(LAS f32x4*)(BETA + t8), b1 = *(LAS f32x4*)(BETA + t8 + 4);
            u32x4 v = *(LAS u32x4*)(VT + c * 144 + t8 * 2);
            v.x = bfmul2(v.x, b0[0], b0[1]); v.y = bfmul2(v.y, b0[2], b0[3]); v.z = bfmul2(v.z, b1[0], b1[1]); v.w = bfmul2(v.w, b1[2], b1[3]);
            *(LAS u32x4*)(VT + c * 144 + t8 * 2) = v;
            const f32x4 f20 = *(LAS f32x4*)(F2 + t8), f21 = *(LAS f32x4*)(F2 + t8 + 4), f30 = *(LAS f32x4*)(F3 + t8), f31 = *(LAS f32x4*)(F3 + t8 + 4);
            const u32x4 k = *(LAS u32x4*)(KT + c * 144 + t8 * 2);
            u32x4 rk; rk.x = bfmul2(k.x, f20[0], f20[1]); rk.y = bfmul2(k.y, f20[2], f20[3]); rk.z = bfmul2(k.z, f21[0], f21[1]); rk.w = bfmul2(k.w, f21[2], f21[3]);
            *(LAS u32x4*)(RTK + c * 144 + t8 * 2) = rk;
            u32x4 kd; kd.x = bfmul2(k.x, f30[0], f30[1]); kd.y = bfmul2(k.y, f30[2], f30[3]); kd.z = bfmul2(k.z, f31[0], f31[1]); kd.w = bfmul2(k.w, f31[2], f31[3]);
            *(u32x4*)((bf16_t*)(A.ws + WS_DKT) + (size_t)item * 8192 + c * 64 + t8) = kd; }
        for (int id = wt; id < 1024; id += 448) {
            const int t = id >> 4, c8 = (id & 15) * 8; const float f = F4[t];
            u32x4 q = *(LAS u32x4*)((LAS unsigned char*)QS + t * 272 + c8 * 2);
            q.x = bfmul2(q.x, f, f); q.y = bfmul2(q.y, f, f); q.z = bfmul2(q.z, f, f); q.w = bfmul2(q.w, f, f);
            *(u32x4*)((bf16_t*)(A.ws + WS_DQD) + (size_t)item * 8192 + t * 128 + c8) = q; }
    }
    {
        const int c8 = (tid & 15) * 8; const float* on = A.in[I_ONORM] + l * 128 + c8;
        const f32x4 o0 = *(const f32x4*)on, o1 = *(const f32x4*)(on + 4);
#pragma unroll
        for (int j = 0; j < 2; ++j) { const int id = tid + 512 * j; const u32x4 g = gv[j]; u32x4 o;
            o.x = pg8::cvt_pk_bf16(silu_f(__uint_as_float(g.x << 16)) * o0[0], silu_f(__uint_as_float(g.x & 0xffff0000u)) * o0[1]);
            o.y = pg8::cvt_pk_bf16(silu_f(__uint_as_float(g.y << 16)) * o0[2], silu_f(__uint_as_float(g.y & 0xffff0000u)) * o0[3]);
            o.z = pg8::cvt_pk_bf16(silu_f(__uint_as_float(g.z << 16)) * o1[0], silu_f(__uint_as_float(g.z & 0xffff0000u)) * o1[1]);
            o.w = pg8::cvt_pk_bf16(silu_f(__uint_as_float(g.w << 16)) * o1[2], silu_f(__uint_as_float(g.w & 0xffff0000u)) * o1[3]);
            *(u32x4*)((bf16_t*)(A.ws + WS_DGS) + (size_t)item * 8192 + (id >> 4) * 128 + c8) = o; }
    }
    __syncthreads();
    const int p2 = tid >> 8, r2 = (tid >> 4) & 15, c2 = tid & 15, rb = p2 ? 48 : 16, cb = p2 ? 32 : 0;
    {
        float acc = 0.f;
#pragma unroll
        for (int s = 0; s < 16; ++s) acc = fmaf(AM[(rb + r2) * 68 + cb + s], TM[(cb + s) * 68 + cb + c2], acc);
        PSC[(p2 * 16 + r2) * 68 + c2] = acc; }
    __syncthreads();
    {
        float acc = 0.f;
#pragma unroll
        for (int s = 0; s < 16; ++s) acc = fmaf(TM[(rb + r2) * 68 + rb + s], PSC[(p2 * 16 + s) * 68 + c2], acc);
        TM[(rb + r2) * 68 + cb + c2] = -acc; }
    __syncthreads();
    float p3[2];
#pragma unroll
    for (int j = 0; j < 2; ++j) { const int e = tid + 512 * j, r = e >> 5, c = e & 31; float acc = 0.f;
#pragma unroll 8
        for (int s = 0; s < 32; ++s) acc = fmaf(AM[(32 + r) * 68 + s], TM[s * 68 + c], acc);
        p3[j] = acc; }
    __syncthreads();
#pragma unroll
    for (int j = 0; j < 2; ++j) { const int e = tid + 512 * j; PSC[(e >> 5) * 68 + (e & 31)] = p3[j]; }
    __syncthreads();
#pragma unroll
    for (int j = 0; j < 2; ++j) { const int e = tid + 512 * j, r = e >> 5, c = e & 31; float acc = 0.f;
#pragma unroll 8
        for (int s = 0; s < 32; ++s) acc = fmaf(TM[(32 + r) * 68 + 32 + s], PSC[s * 68 + c], acc);
        p3[j] = -acc; }
#pragma unroll
    for (int j = 0; j < 2; ++j) { const int e = tid + 512 * j; TM[(32 + (e >> 5)) * 68 + (e & 31)] = p3[j]; }
    __syncthreads();
#pragma unroll
    for (int j = 0; j < 4; ++j) { const int e = tid + 512 * j, t = e >> 5, s2 = (e & 31) * 2;
        *(LAS unsigned*)(TB + t * 144 + s2 * 2) = pg8::cvt_pk_bf16(TM[t * 68 + s2], TM[t * 68 + s2 + 1]); }
    __syncthreads();
    {
        const int fr = lane & 15, quad = lane >> 4;
        bf16x8 bv[2], ak[2];
#pragma unroll
        for (int kk = 0; kk < 2; ++kk) { bv[kk] = *(LAS bf16x8*)(VT + (16 * wave + fr) * 144 + (kk * 32 + quad * 8) * 2); ak[kk] = *(LAS bf16x8*)(RTK + (16 * wave + fr) * 144 + (kk * 32 + quad * 8) * 2); }
        bf16_t* DW = (bf16_t*)(A.ws + WS_DW) + (size_t)item * 8192; bf16_t* DKC = (bf16_t*)(A.ws + WS_DKC) + (size_t)item * 8192;
#pragma unroll
        for (int mt = 0; mt < 4; ++mt) { f32x4 aw = {0.f, 0.f, 0.f, 0.f}, akc = {0.f, 0.f, 0.f, 0.f};
#pragma unroll
            for (int kk = 0; kk < 2; ++kk) { const bf16x8 tf = *(LAS bf16x8*)(TB + (mt * 16 + fr) * 144 + (kk * 32 + quad * 8) * 2);
                aw = mfma16(tf, bv[kk], aw);
                akc = mfma16(ak[kk], tf, akc); }
            u32x2 ow; ow.x = pk2(aw[0], aw[1]); ow.y = pk2(aw[2], aw[3]);
            *(u32x2*)(DW + (16 * wave + fr) * 64 + mt * 16 + quad * 4) = ow;
            u32x2 ok; ok.x = pk2(-akc[0], -akc[1]); ok.y = pk2(-akc[2], -akc[3]);
            *(u32x2*)(DKC + (mt * 16 + fr) * 128 + 16 * wave + quad * 4) = ok; }
    }
    __syncthreads();
}

__device__ __forceinline__ void delta_scan_item(const DevArgs& A, int l, LAS unsigned char* lds, int bh, int tid_in, int wave, int lane_in, const XcdBarrier& xb, int SUB) {
    const int b = bh >> 2, h = bh & 3;
    LAS unsigned char* KCs = lds; LAS unsigned char* QDs = lds + 17408; LAS unsigned char* QKs = lds + 34816; LAS unsigned char* KDTs = lds + 44032;
    LAS unsigned char* Ws = lds + 62464;
    LAS unsigned char* GSs = lds + 80896;
    LAS unsigned char* SS = lds + 98304 + wave * 4352; LAS unsigned char* US = lds + 133120 + wave * 2304;
    LAS float* PART = (LAS float*)(lds + 151552);
    const unsigned char* gW = A.ws + WS_DW; const unsigned char* gGS = A.ws + WS_DGS;
    const unsigned char* gKC = A.ws + WS_DKC; const unsigned char* gQD = A.ws + WS_DQD; const unsigned char* gQK = A.ws + WS_DQK; const unsigned char* gKT = A.ws + WS_DKT;
    const float* DGL = (const float*)(A.ws + WS_DGL);
    f32x4 S[8];
#pragma unroll
    for (int mt = 0; mt < 8; ++mt) S[mt] = (f32x4){0.f, 0.f, 0.f, 0.f};
    u32x4 r[9], rg[2];
    float gl_all = 0.f;
#define DS_LOAD(itn, toff) do { const size_t _i = (size_t)(itn); const unsigned char* _kc = gKC + _i * 16384; const unsigned char* _qd = gQD + _i * 16384; \
        const unsigned char* _qk = gQK + _i * 8192; const unsigned char* _kt = gKT + _i * 16384; \
        r[0] = *(const u32x4*)(_kc + (toff)); r[1] = *(const u32x4*)(_kc + (toff) + 8192u); \
        r[2] = *(const u32x4*)(_qd + (toff)); r[3] = *(const u32x4*)(_qd + (toff) + 8192u); \
        r[4] = *(const u32x4*)(_qk + (toff)); \
        r[5] = *(const u32x4*)(_kt + (toff)); r[6] = *(const u32x4*)(_kt + (toff) + 8192u); \
        const unsigned char* _w = gW + _i * 16384; r[7] = *(const u32x4*)(_w + (toff)); r[8] = *(const u32x4*)(_w + (toff) + 8192u); } while (0)
#define DS_LOADG(itn, toff) do { const unsigned char* _g = gGS + (size_t)(itn) * 16384; rg[0] = *(const u32x4*)(_g + (toff)); rg[1] = *(const u32x4*)(_g + (toff) + 8192u); } while (0)
#define DS_STAGE(tidv) do { const int i0 = (tidv), i1 = (tidv) + 512; \
          *(LAS u32x4*)(KCs + (i0 >> 4) * 272 + (i0 & 15) * 16) = r[0]; *(LAS u32x4*)(KCs + (i1 >> 4) * 272 + (i1 & 15) * 16) = r[1]; \
          *(LAS u32x4*)(QDs + (i0 >> 4) * 272 + (i0 & 15) * 16) = r[2]; *(LAS u32x4*)(QDs + (i1 >> 4) * 272 + (i1 & 15) * 16) = r[3]; \
          *(LAS u32x4*)(QKs + (i0 >> 3) * 144 + (i0 & 7) * 16) = r[4]; \
          *(LAS u32x4*)(KDTs + (i0 >> 3) * 144 + (i0 & 7) * 16) = r[5]; *(LAS u32x4*)(KDTs + (i1 >> 3) * 144 + (i1 & 7) * 16) = r[6]; \
          *(LAS u32x4*)(Ws + (i0 >> 3) * 144 + (i0 & 7) * 16) = r[7]; *(LAS u32x4*)(Ws + (i1 >> 3) * 144 + (i1 & 7) * 16) = r[8]; } while (0)
#define DS_STAGEG(tidv) do { const int i0 = (tidv), i1 = (tidv) + 512; \
          *(LAS u32x4*)(GSs + (i0 >> 4) * 272 + (i0 & 15) * 16) = rg[0]; *(LAS u32x4*)(GSs + (i1 >> 4) * 272 + (i1 & 15) * 16) = rg[1]; } while (0)
#pragma unroll 1
    for (int n = 0; n < 32; ++n) {
        int tid = tid_in; asm volatile("" : "+v"(tid));
        const bool bstart = (SUB > 0) ? (n % SUB == 0) : (n == 0);
        const bool bnext1 = (SUB > 0) && ((n + 1) % SUB == 0), bnext2 = (SUB > 0) && ((n + 2) % SUB == 0);
        if (bstart) { if (n > 0) xcd_barrier(xb);
            gl_all = DGL[bh * 32 + (tid & 31)];
            const unsigned t0 = (unsigned)tid * 16u; DS_LOAD(bh * 32 + n, t0); DS_LOADG(bh * 32 + n, t0); DS_STAGE(tid); DS_STAGEG(tid);
            if (n + 1 < 32 && !bnext1) { DS_LOAD(bh * 32 + n + 1, t0); DS_LOADG(bh * 32 + n + 1, t0); }
            __syncthreads(); }
        else { DS_STAGEG(tid);
            if (n + 1 < 32 && !bnext1) DS_LOADG(bh * 32 + n + 1, (unsigned)tid * 16u); }
        const int lane = tid & 63, fr = lane & 15, quad = lane >> 4, vcol = 16 * wave + fr;
        const unsigned toff = (unsigned)tid * 16u;
        const int it = bh * 32 + n, tokb = b * SEQ + n * 64;
        const float glast = __builtin_bit_cast(float, __builtin_amdgcn_readlane(__builtin_bit_cast(int, gl_all), n));
        asm volatile("s_nop 7\n\ts_nop 7" ::: "memory");
#pragma unroll
        for (int mt = 0; mt < 8; ++mt) { u32x2 p; p.x = pg8::cvt_pk_bf16(S[mt][0], S[mt][1]); p.y = pg8::cvt_pk_bf16(S[mt][2], S[mt][3]); *(LAS u32x2*)(SS + fr * 272 + (mt * 16 + quad * 4) * 2) = p; }
        LDS_FENCE();
        bf16x8 Sb[4];
#pragma unroll
        for (int kk = 0; kk < 4; ++kk) Sb[kk] = *(LAS bf16x8*)(SS + fr * 272 + (kk * 32 + quad * 8) * 2);
        f32x4 U[4], O[4];
#pragma unroll
        for (int mt = 0; mt < 4; ++mt) { f32x4 au, ao = {0.f, 0.f, 0.f, 0.f};
            { const u32x2 wq = *(LAS u32x2*)(Ws + vcol * 144 + (mt * 16 + quad * 4) * 2);
              au[0] = __uint_as_float(wq.x << 16); au[1] = __uint_as_float(wq.x & 0xffff0000u); au[2] = __uint_as_float(wq.y << 16); au[3] = __uint_as_float(wq.y & 0xffff0000u); }
#pragma unroll
            for (int kk = 0; kk < 4; ++kk) { const bf16x8 a1 = *(LAS bf16x8*)(KCs + (mt * 16 + fr) * 272 + (kk * 32 + quad * 8) * 2); au = mfma16(a1, Sb[kk], au);
                const bf16x8 a2 = *(LAS bf16x8*)(QDs + (mt * 16 + fr) * 272 + (kk * 32 + quad * 8) * 2); ao = mfma16(a2, Sb[kk], ao); }
            U[mt] = au; O[mt] = ao; __builtin_amdgcn_sched_barrier(0); }
        asm volatile("s_nop 7\n\ts_nop 7" ::: "memory");
#pragma unroll
        for (int mt = 0; mt < 4; ++mt) { u32x2 p; p.x = pg8::cvt_pk_bf16(U[mt][0], U[mt][1]); p.y = pg8::cvt_pk_bf16(U[mt][2], U[mt][3]); *(LAS u32x2*)(US + fr * 144 + (mt * 16 + quad * 4) * 2) = p; }
        LDS_FENCE();
        bf16x8 Ub[2];
#pragma unroll
        for (int kk = 0; kk < 2; ++kk) Ub[kk] = *(LAS bf16x8*)(US + fr * 144 + (kk * 32 + quad * 8) * 2);
#pragma unroll
        for (int mt = 0; mt < 4; ++mt)
#pragma unroll
            for (int kk = 0; kk < 2; ++kk) { const bf16x8 a = *(LAS bf16x8*)(QKs + (mt * 16 + fr) * 144 + (kk * 32 + quad * 8) * 2); O[mt] = mfma16(a, Ub[kk], O[mt]); }
        __builtin_amdgcn_sched_barrier(0);
#pragma unroll
        for (int mt = 0; mt < 8; ++mt) { S[mt] *= glast;
#pragma unroll
            for (int kk = 0; kk < 2; ++kk) { const bf16x8 a = *(LAS bf16x8*)(KDTs + (mt * 16 + fr) * 144 + (kk * 32 + quad * 8) * 2); S[mt] = mfma16(a, Ub[kk], S[mt]); }
            if (mt & 1) __builtin_amdgcn_sched_barrier(0); }
        { float pp[16];
#pragma unroll
          for (int e = 0; e < 16; ++e) pp[e] = O[e >> 2][e & 3] * O[e >> 2][e & 3];
#pragma unroll
          for (int st = 1; st < 16; st <<= 1) {
#pragma unroll
              for (int e = 0; e < 16; ++e) pp[e] += __shfl_xor(pp[e], st); }
          if (fr == 0) {
#pragma unroll
              for (int e = 0; e < 16; ++e) PART[((e >> 2) * 16 + quad * 4 + (e & 3)) * 8 + wave] = pp[e]; } }
        __syncthreads();
        if (n + 1 < 32 && !bnext1) { DS_STAGE(tid); if (n + 2 < 32 && !bnext2) DS_LOAD(it + 2, toff); }
        bf16_t* mixb = (bf16_t*)(A.ws + WS_MIX) + (size_t)tokb * D + h * 128;
#pragma unroll
        for (int mt = 0; mt < 4; ++mt)
#pragma unroll
            for (int i = 0; i < 4; ++i) { const int t = mt * 16 + quad * 4 + i;
                const f32x4 p0 = *(LAS f32x4*)(PART + t * 8), p1 = *(LAS f32x4*)(PART + t * 8 + 4);
                const float tot = ((p0[0] + p0[1]) + (p0[2] + p0[3])) + ((p1[0] + p1[1]) + (p1[2] + p1[3]));
                const float sc = rsqrtf(tot * (1.f / 128.f) + EPS);
                const float gs = bf2f(*(LAS bf16_t*)(GSs + t * 272 + vcol * 2));
                mixb[(unsigned)(t * D + vcol)] = (bf16_t)(pg8::cvt_pk_bf16(O[mt][i] * sc * gs, 0.f) & 0xffffu); }
        __syncthreads();
    }
#undef DS_STAGE
#undef DS_LOADG
#undef DS_STAGEG
#undef DS_LOAD
    { const int lane = lane_in, fr = lane & 15, quad = lane >> 4, vcol = 16 * wave + fr;
      float* dp = A.out + O_DP + (size_t)((l * 8 + b) * 4 + h) * 16384;
#pragma unroll
      for (int mt = 0; mt < 8; ++mt)
#pragma unroll
          for (int i = 0; i < 4; ++i) dp[(mt * 16 + quad * 4 + i) * 128 + vcol] = S[mt][i]; }
    __syncthreads();
}

__device__ __forceinline__ void delta_sample_item(const DevArgs& A, int l, LAS unsigned char* lds, int item, int tid, int wave, int lane) {
    asm volatile("" : "+v"(tid)); lane = tid & 63; wave = __builtin_amdgcn_readfirstlane(tid >> 6);
    const int b = item >> 2, h = item & 3, tokS = NP + b * 4;
    LAS float* RAW = (LAS float*)lds; LAS float* RED = RAW + 1536; LAS float* OB = RED + 512; LAS float* SC = OB + 512;
    const bf16_t* PROJ = (const bf16_t*)(A.ws + WS_PROJ); const float* AB = (const float*)(A.ws + WS_AB); bf16_t* MIX = (bf16_t*)(A.ws + WS_MIX);
    const float* cw = A.in[I_CONVW] + (size_t)l * 4 * 1536;
    for (int idx = tid; idx < 1536; idx += 512) { const int part = idx >> 9, t = (idx >> 7) & 3, c = idx & 127, col = part * 512 + h * 128 + c;
        float acc = 0.f;
#pragma unroll
        for (int j = 0; j < 4; ++j) { const int tt = t - 3 + j;
            const float x = (tt >= 0) ? bf2f(PROJ[(size_t)(tokS + tt) * NPROJ + col]) : A.in[I_SCONV][((size_t)(l * 128 + b) * 3 + (3 + tt)) * 1536 + col];
            acc += cw[j * 1536 + col] * x; }
        RAW[idx] = silu_f(acc); }
    if (tid < 4) { const float a = AB[(size_t)(tokS + tid) * 8 + h], bb = AB[(size_t)(tokS + tid) * 8 + 4 + h];
        const float xx = a + A.in[I_DTB][l * 4 + h]; const float sp = xx > 20.f ? xx : log1pf(expf(xx));
        SC[8 + tid] = 1.f / (1.f + expf(-bb)); SC[12 + tid] = expf(-expf(A.in[I_ALOG][l * 4 + h]) * sp); }
    const int v = tid & 127, kq = tid >> 7;
    float S[32];
    { const float* sp = A.in[I_SDELTA] + (size_t)((l * 128 + b) * 4 + h) * 16384;
#pragma unroll
      for (int i = 0; i < 32; ++i) S[i] = sp[(kq * 32 + i) * 128 + v]; }
    __syncthreads();
    { const int part = wave >> 2, t = wave & 3; const float x0 = RAW[part * 512 + t * 128 + lane], x1 = RAW[part * 512 + t * 128 + 64 + lane];
      const float ss = wave_sum(x0 * x0 + x1 * x1); if (lane == 0) SC[part * 4 + t] = rsqrtf(ss + EPS) * (part == 0 ? 0.08838834764831845f : 1.f); }
    __syncthreads();
    for (int t = 0; t < 4; ++t) {
        const float rq = SC[t], rk = SC[4 + t], beta = SC[8 + t], g = SC[12 + t];
        float pr = 0.f;
#pragma unroll
        for (int i = 0; i < 32; ++i) pr += S[i] * RAW[512 + t * 128 + kq * 32 + i];
        RED[kq * 128 + v] = pr * rk;
        __syncthreads();
        const float rr = (RED[v] + RED[128 + v]) + (RED[256 + v] + RED[384 + v]);
        const float u = beta * (RAW[1024 + t * 128 + v] - g * rr);
        float po = 0.f;
#pragma unroll
        for (int i = 0; i < 32; ++i) { const float kh = RAW[512 + t * 128 + kq * 32 + i] * rk; S[i] = g * S[i] + kh * u; po += S[i] * RAW[t * 128 + kq * 32 + i]; }
        __syncthreads();
        RED[kq * 128 + v] = po * rq;
        __syncthreads();
        if (kq == 0) OB[t * 128 + v] = (RED[v] + RED[128 + v]) + (RED[256 + v] + RED[384 + v]);
        __syncthreads();
    }
    if (wave < 4) { const int t = wave; const float x0 = OB[t * 128 + lane], x1 = OB[t * 128 + 64 + lane];
        const float ss = wave_sum(x0 * x0 + x1 * x1); const float sc = rsqrtf(ss * (1.f / 128.f) + EPS);
        const float g0 = bf2f(PROJ[(size_t)(tokS + t) * NPROJ + PC_G + h * 128 + lane]), g1 = bf2f(PROJ[(size_t)(tokS + t) * NPROJ + PC_G + h * 128 + 64 + lane]);
        MIX[(size_t)(tokS + t) * D + h * 128 + lane] = (bf16_t)f2bf(x0 * sc * A.in[I_ONORM][l * 128 + lane] * silu_f(g0));
        MIX[(size_t)(tokS + t) * D + h * 128 + 64 + lane] = (bf16_t)f2bf(x1 * sc * A.in[I_ONORM][l * 128 + 64 + lane] * silu_f(g1)); }
    { float* dsp = A.out + O_DS + (size_t)((l * 128 + b) * 4 + h) * 16384;
#pragma unroll
      for (int i = 0; i < 32; ++i) dsp[(kq * 32 + i) * 128 + v] = S[i]; }
    __syncthreads();
}

#define SSM_BCAST_U(t) do { unsigned _w[8]; \
        _w[0] = __builtin_amdgcn_readlane(ua.x, t); _w[1] = __builtin_amdgcn_readlane(ua.y, t); _w[2] = __builtin_amdgcn_readlane(ua.z, t); _w[3] = __builtin_amdgcn_readlane(ua.w, t); \
        _w[4] = __builtin_amdgcn_readlane(ub.x, t); _w[5] = __builtin_amdgcn_readlane(ub.y, t); _w[6] = __builtin_amdgcn_readlane(ub.z, t); _w[7] = __builtin_amdgcn_readlane(ub.w, t); \
        _Pragma("unroll") for (int _d = 0; _d < 8; ++_d) { uu[2 * _d] = __uint_as_float(_w[_d] << 16); uu[2 * _d + 1] = __uint_as_float(_w[_d] & 0xffff0000u); } } while (0)
#define SSM_STEP() do { float _br = 0.f, _bi = 0.f; \
        _Pragma("unroll") for (int _h = 0; _h < 16; ++_h) { _br = fmaf(Br[_h], uu[_h], _br); _bi = fmaf(Bi[_h], uu[_h], _bi); } \
        const float _nr = lr * hr - li * hi + _br, _ni = lr * hi + li * hr + _bi; hr = _nr; hi = _ni; } while (0)

__device__ __forceinline__ void ssm_part1_item(const DevArgs& A, int l, int it, int lane) {
    const int g = it & 15, bc = it >> 4, b = bc / 31, c = bc % 31;
    const float* bb = (const float*)(A.ws + WS_BBAR) + ((size_t)(l * 16 + g) * 64 + lane) * 32;
    float Br[16], Bi[16];
#pragma unroll
    for (int q = 0; q < 4; ++q) { const f32x4 x = ((const f32x4*)bb)[q], y = ((const f32x4*)bb)[4 + q];
        Br[4 * q] = x.x; Br[4 * q + 1] = x.y; Br[4 * q + 2] = x.z; Br[4 * q + 3] = x.w; Bi[4 * q] = y.x; Bi[4 * q + 1] = y.y; Bi[4 * q + 2] = y.z; Bi[4 * q + 3] = y.w; }
    const f32x4 lk = ((const f32x4*)(A.ws + WS_SSMK))[(l * 16 + g) * 64 + lane]; const float lr = lk.x, li = lk.y;
    const bf16_t* up = (const bf16_t*)(A.ws + WS_PROJ) + (size_t)(b * SEQ + c * 64 + lane) * NPROJ + PC_SSM + g * 16;
    const u32x4 ua = *(const u32x4*)up, ub = *(const u32x4*)(up + 8);
    float hr = 0.f, hi = 0.f, uu[16];
#pragma unroll 1
    for (int t = 0; t < 64; ++t) { SSM_BCAST_U(t); SSM_STEP(); }
    f32x2 e; e.x = hr; e.y = hi;
    ((f32x2*)(A.ws + WS_SSME))[((size_t)(b * 32 + c) * 16 + g) * 64 + lane] = e;
}

__device__ __forceinline__ void ssm_part2_item(const DevArgs& A, int l, LAS unsigned char* lds, int it, int tid, int wave, int lane) {
    asm volatile("" : "+v"(tid)); lane = tid & 63; wave = __builtin_amdgcn_readfirstlane(tid >> 6);
    const int tok0 = it * 64, fr = lane & 15, quad = lane >> 4;
    const bool samp = it >= 256; const int b = it >> 5, c = it & 31;
    LAS unsigned char* YS = lds; LAS unsigned char* HS = lds + 33792 + wave * 4352;
    const bf16_t* PROJ = (const bf16_t*)(A.ws + WS_PROJ); bf16_t* MIX = (bf16_t*)(A.ws + WS_MIX);
#pragma unroll 1
    for (int gi = 0; gi < 2; ++gi) {
        const int g = wave * 2 + gi;
        const float* bb = (const float*)(A.ws + WS_BBAR) + ((size_t)(l * 16 + g) * 64 + lane) * 32;
        float Br[16], Bi[16];
#pragma unroll
        for (int q = 0; q < 4; ++q) { const f32x4 x = ((const f32x4*)bb)[q], y = ((const f32x4*)bb)[4 + q];
            Br[4 * q] = x.x; Br[4 * q + 1] = x.y; Br[4 * q + 2] = x.z; Br[4 * q + 3] = x.w; Bi[4 * q] = y.x; Bi[4 * q + 1] = y.y; Bi[4 * q + 2] = y.z; Bi[4 * q + 3] = y.w; }
        const f32x4 lk = ((const f32x4*)(A.ws + WS_SSMK))[(l * 16 + g) * 64 + lane]; const float lr = lk.x, li = lk.y, Lr = lk.z, Li = lk.w;
        bf16x8 Cb[4];
#pragma unroll
        for (int kk = 0; kk < 4; ++kk) { const size_t co = ((size_t)(l * 16 + g) * 16 + fr) * 64 + kk * 16 + quad * 4;
            const f32x4 cr = *(const f32x4*)(A.in[I_CRE] + co), ci = *(const f32x4*)(A.in[I_CIM] + co);
            u32x4 pk; pk.x = pk2(cr.x, -ci.x); pk.y = pk2(cr.y, -ci.y); pk.z = pk2(cr.z, -ci.z); pk.w = pk2(cr.w, -ci.w);
            Cb[kk] = __builtin_bit_cast(bf16x8, pk); }
        const bf16_t* up = PROJ + (size_t)(tok0 + lane) * NPROJ + PC_SSM + g * 16;
        const u32x4 ua = *(const u32x4*)up, ub = *(const u32x4*)(up + 8);
        float hr = 0.f, hi = 0.f, uu[16];
        if (!samp && c > 0) { const f32x2* E = (const f32x2*)(A.ws + WS_SSME) + ((size_t)(b * 32) * 16 + g) * 64 + lane;
#pragma unroll
            for (int cb = 0; cb < 32; cb += 16) { f32x2 ev[16];
#pragma unroll
                for (int q = 0; q < 16; ++q) { const int cc = cb + q; ev[q] = (cc < c) ? E[(size_t)cc * 1024] : (f32x2){0.f, 0.f}; }
#pragma unroll
                for (int q = 0; q < 16; ++q) { const int cc = cb + q; if (cc < c) { const float nr = Lr * hr - Li * hi + ev[q].x, ni = Lr * hi + Li * hr + ev[q].y; hr = nr; hi = ni; } } } }
        const float dsk = A.in[I_SSMD][l * 256 + g * 16 + fr];
#pragma unroll 1
        for (int sub = 0; sub < 4; ++sub) {
#pragma unroll 1
            for (int tt = 0; tt < 16; ++tt) { const int t = sub * 16 + tt;
                const int sb = (it - 256) * 16 + (t >> 2);
                if (samp && (t & 3) == 0) { hr = A.in[I_SRE][((size_t)(l * 128 + sb) * 16 + g) * 64 + lane]; hi = A.in[I_SIM][((size_t)(l * 128 + sb) * 16 + g) * 64 + lane]; }
                SSM_BCAST_U(t); SSM_STEP();
                *(LAS unsigned*)(HS + tt * 272 + lane * 4) = pg8::cvt_pk_bf16(hr, hi);
                if (samp && (t & 3) == 3) { A.out[O_RES + ((size_t)(l * 128 + sb) * 16 + g) * 64 + lane] = hr; A.out[O_IMS + ((size_t)(l * 128 + sb) * 16 + g) * 64 + lane] = hi; }
            }
            LDS_FENCE();
            f32x4 acc = {0.f, 0.f, 0.f, 0.f};
#pragma unroll
            for (int kk = 0; kk < 4; ++kk) { const bf16x8 a = *(LAS bf16x8*)(HS + fr * 272 + (kk * 32 + quad * 8) * 2); acc = mfma16(a, Cb[kk], acc); }
#pragma unroll
            for (int i = 0; i < 4; ++i) { const int t = sub * 16 + quad * 4 + i; const float uv = bf2f(PROJ[(size_t)(tok0 + t) * NPROJ + PC_SSM + g * 16 + fr]);
                *(LAS bf16_t*)(YS + t * 528 + (g * 16 + fr) * 2) = (bf16_t)f2bf(gelu_tanh_f(acc[i] + dsk * uv)); }
            LDS_FENCE();
        }
        if (!samp && c == 31) { A.out[O_REP + ((size_t)(l * 8 + b) * 16 + g) * 64 + lane] = hr; A.out[O_IMP + ((size_t)(l * 8 + b) * 16 + g) * 64 + lane] = hi; }
    }
    __syncthreads();
    {
        const bf16_t* GT = (const bf16_t*)(A.ws + WS_GLUT + l * SZ_GLUT);
        f32x4 acc[4][2];
#pragma unroll
        for (int mt = 0; mt < 4; ++mt) { acc[mt][0] = (f32x4){0.f, 0.f, 0.f, 0.f}; acc[mt][1] = (f32x4){0.f, 0.f, 0.f, 0.f}; }
#pragma unroll
        for (int kk = 0; kk < 8; ++kk) { bf16x8 bfr[2];
#pragma unroll
            for (int nt = 0; nt < 2; ++nt) bfr[nt] = *(const bf16x8*)(GT + (size_t)(32 * wave + nt * 16 + fr) * 256 + kk * 32 + quad * 8);
#pragma unroll
            for (int mt = 0; mt < 4; ++mt) { const bf16x8 a = *(LAS bf16x8*)(YS + (mt * 16 + fr) * 528 + (kk * 32 + quad * 8) * 2);
                acc[mt][0] = mfma16(a, bfr[0], acc[mt][0]); acc[mt][1] = mfma16(a, bfr[1], acc[mt][1]); } }
#pragma unroll
        for (int nt = 0; nt < 2; ++nt) { const int ncol = 32 * wave + nt * 16 + fr; const float gb = A.in[I_GLUB][l * 256 + ncol];
#pragma unroll
            for (int mt = 0; mt < 4; ++mt)
#pragma unroll
                for (int i = 0; i < 4; ++i) { const int t = mt * 16 + quad * 4 + i; const float y = bf2f(*(LAS bf16_t*)(YS + t * 528 + ncol * 2));
                    MIX[(size_t)(tok0 + t) * D + 512 + ncol] = (bf16_t)f2bf(y * sigmoid_f(acc[mt][nt][i] + gb)); } }
    }
    __syncthreads();
}

__device__ __forceinline__ void pool_item(const DevArgs& A, int l, LAS unsigned char* lds, int it, int tid, int wave, int lane) {
    asm volatile("" : "+v"(tid)); lane = tid & 63; wave = __builtin_amdgcn_readfirstlane(tid >> 6);
    const int tok0 = it * 64, fr = lane & 15, quad = lane >> 4; const bool samp = it >= 256;
    LAS unsigned char* RS = lds;
    const bf16_t* PROJ = (const bf16_t*)(A.ws + WS_PROJ); bf16_t* MIX = (bf16_t*)(A.ws + WS_MIX);
    if (!samp) {
        LAS unsigned char* XT = lds + 33792;
        const int b = it >> 5, c = it & 31;
        for (int id = tid; id < 79 * 32; id += 512) { const int r = id >> 5, c16 = id & 31, tl = c * 64 - 15 + r;
            u32x4 v = {0u, 0u, 0u, 0u}; if (tl >= 0) v = *(const u32x4*)(PROJ + (size_t)(b * SEQ + tl) * NPROJ + PC_POOL + c16 * 8);
            *(LAS u32x4*)(XT + r * 528 + c16 * 16) = v; }
        __syncthreads();
        const int ch = tid & 255, half = tid >> 8, g = ch >> 6, w = 2 << g, r0 = half * 32;
        float sum = 0.f;
        for (int j = 0; j < w; ++j) sum += bf2f(*(LAS bf16_t*)(XT + (r0 + 15 - j) * 528 + ch * 2));
#pragma unroll 4
        for (int rr = 0; rr < 32; ++rr) { const int r = r0 + rr, tl = c * 64 + r;
            const float u = bf2f(*(LAS bf16_t*)(XT + (r + 15) * 528 + ch * 2));
            if (rr > 0) sum += u - bf2f(*(LAS bf16_t*)(XT + (r + 15 - w) * 528 + ch * 2));
            const float cnt = (float)((tl + 1 < w) ? tl + 1 : w);
            *(LAS bf16_t*)(RS + r * 528 + ch * 2) = (bf16_t)f2bf(sum / cnt - u); }
    } else {
#pragma unroll 1
        for (int pr = 0; pr < 8; ++pr) { const int idx = pr * 512 + tid, ch = idx & 255, sq = idx >> 8, g = ch >> 6, w = 2 << g;
            const int sb = (it - 256) * 16 + sq;
            const float* sbuf = A.in[I_SPOOL] + (size_t)(l * 128 + sb) * 15 * 256 + ch;
            const bf16_t* base = PROJ + (size_t)(NP + sb * 4) * NPROJ + PC_POOL + ch;
            float e[19];
#pragma unroll
            for (int j = 0; j < 15; ++j) e[j] = sbuf[j * 256];
#pragma unroll
            for (int j = 0; j < 4; ++j) e[15 + j] = bf2f(base[(size_t)j * NPROJ]);
#pragma unroll
            for (int t = 0; t < 4; ++t) { float sum = 0.f;
#pragma unroll
                for (int j = 0; j < 16; ++j) sum += (j < w) ? e[15 + t - j] : 0.f;
                *(LAS bf16_t*)(RS + (sq * 4 + t) * 528 + ch * 2) = (bf16_t)f2bf(sum / (float)w - e[15 + t]); } }
    }
    __syncthreads();
    { const int g2 = wave >> 1; const bf16_t* PT = (const bf16_t*)(A.ws + WS_POOLT + l * SZ_POOLT) + g2 * 4096;
      f32x4 acc[4][2];
#pragma unroll
      for (int mt = 0; mt < 4; ++mt) { acc[mt][0] = (f32x4){0.f, 0.f, 0.f, 0.f}; acc[mt][1] = (f32x4){0.f, 0.f, 0.f, 0.f}; }
#pragma unroll
      for (int kk = 0; kk < 2; ++kk) { bf16x8 bfr[2];
#pragma unroll
          for (int nt = 0; nt < 2; ++nt) bfr[nt] = *(const bf16x8*)(PT + (size_t)((wave & 1) * 32 + nt * 16 + fr) * 64 + kk * 32 + quad * 8);
#pragma unroll
          for (int mt = 0; mt < 4; ++mt) { const bf16x8 a = *(LAS bf16x8*)(RS + (mt * 16 + fr) * 528 + (g2 * 64 + kk * 32 + quad * 8) * 2);
              acc[mt][0] = mfma16(a, bfr[0], acc[mt][0]); acc[mt][1] = mfma16(a, bfr[1], acc[mt][1]); } }
#pragma unroll
      for (int nt = 0; nt < 2; ++nt) { const int col = 32 * wave + nt * 16 + fr; const float ps = A.in[I_POOLS][l * 256 + col];
#pragma unroll
          for (int mt = 0; mt < 4; ++mt)
#pragma unroll
              for (int i = 0; i < 4; ++i) { const int t = mt * 16 + quad * 4 + i; MIX[(size_t)(tok0 + t) * D + 768 + col] = (bf16_t)f2bf(acc[mt][nt][i] * ps); } } }
    __syncthreads();
}

__device__ __forceinline__ void state_copies(const DevArgs& A, int l, int gt, int NT) {
    const bf16_t* PROJ = (const bf16_t*)(A.ws + WS_PROJ);
#pragma unroll 1
    for (int i = gt; i < 8 * 3 * 1536; i += NT) { const int col = i % 1536, j = (i / 1536) % 3, b = i / 4608;
        A.out[O_CP + (size_t)l * 8 * 4608 + i] = bf2f(PROJ[(size_t)(b * SEQ + SEQ - 3 + j) * NPROJ + col]); }
#pragma unroll 1
    for (int i = gt; i < 128 * 3 * 1536; i += NT) { const int col = i % 1536, j = (i / 1536) % 3, b = i / 4608;
        A.out[O_CS + (size_t)l * 128 * 4608 + i] = bf2f(PROJ[(size_t)(NP + b * 4 + 1 + j) * NPROJ + col]); }
#pragma unroll 1
    for (int i = gt; i < 8 * 15 * 256; i += NT) { const int ch = i & 255, j = (i >> 8) % 15, b = i / 3840;
        A.out[O_PP + (size_t)l * 8 * 3840 + i] = bf2f(PROJ[(size_t)(b * SEQ + SEQ - 15 + j) * NPROJ + PC_POOL + ch]); }
#pragma unroll 1
    for (int i = gt; i < 128 * 15 * 256; i += NT) { const int ch = i & 255, j = (i >> 8) % 15, b = i / 3840;
        A.out[O_PS + (size_t)l * 128 * 3840 + i] = (j < 11) ? A.in[I_SPOOL][((size_t)(l * 128 + b) * 15 + 4 + j) * 256 + ch]
                                                             : bf2f(PROJ[(size_t)(NP + b * 4 + (j - 11)) * NPROJ + PC_POOL + ch]); }
}

#ifndef REP_DPREP
#define REP_DPREP 1
#endif
#ifndef REP_DSAMP
#define REP_DSAMP 1
#endif
#ifndef REP_SSM1
#define REP_SSM1 1
#endif
#ifndef REP_POOL
#define REP_POOL 1
#endif
#ifndef REP_DSCAN
#define REP_DSCAN 1
#endif
#ifndef REP_SSM2
#define REP_SSM2 1
#endif
#ifndef REP_G
#define REP_G 1
#endif
#ifndef REP_P3
#define REP_P3 1
#endif
#ifndef REP_P2
#define REP_P2 1
#endif
constexpr int NPH = 2 + DEPTH * 8;
__global__ void __launch_bounds__(512, 2) mega_fwd(Args KA) {
    DevArgs A; A.out = KA.out; A.ws = KA.ws; A.ph_lo = KA.ph_lo; A.ph_hi = KA.ph_hi;
    extern __shared__ __attribute__((aligned(16))) unsigned char lds_raw[];
    LAS unsigned char* lds = (LAS unsigned char*)lds_raw;
    cg::grid_group grid = cg::this_grid();
    volatile LAS unsigned* xst = (volatile LAS unsigned*)(lds + LDS_BYTES - 64);
    if (threadIdx.x == 0) { xst[0] = 0u; xst[1] = 0u; }
    __syncthreads();
    const XcdBarrier xb = xcd_barrier_post((unsigned*)(KA.ws + WS_BAR), xst);
    constexpr int G = 256, NGW = G * 8, NT = G * 512;
    int ph = 0;
#define PH_BEGIN if (A.ph_lo <= ph && ph < A.ph_hi) { int tid = threadIdx.x; asm volatile("" : "+v"(tid)); { unsigned char* _w = A.ws; asm volatile("" : "+s"(_w)); A.ws = _w; float* _o = A.out; asm volatile("" : "+s"(_o)); A.out = _o; } const int wave = __builtin_amdgcn_readfirstlane(tid >> 6), lane = tid & 63, gw = blockIdx.x * 8 + wave, gt = blockIdx.x * 512 + tid; (void)gw; (void)gt; (void)lane;
#define PH_END   if (ph + 1 < A.ph_hi) { if (ph == 0) grid.sync(); else xcd_barrier(xb); } } ++ph;
#define Hb   ((bf16_t*)(A.ws + WS_H))
#define AB   ((float*)(A.ws + WS_AB))
#define MIXO ((float*)(A.ws + WS_MIXO))
#define PROJ ((bf16_t*)(A.ws + WS_PROJ))
#define MIX  ((bf16_t*)(A.ws + WS_MIX))
#define HID  ((bf16_t*)(A.ws + WS_HID))

#ifndef REP_PRO
#define REP_PRO 1
#endif
#ifndef REP_N0
#define REP_N0 1
#endif
    PH_BEGIN for (int rep = 0; rep < REP_PRO; ++rep) { prologue(A, lds, wave, lane, gw, NGW); __syncthreads(); } PH_END
    PH_BEGIN for (int rep = 0; rep < REP_N0; ++rep) norm_rows(nullptr, nullptr, A.in[I_XP], A.in[I_XS], nullptr, A.in[I_NMPRE], Hb, (const float*)(A.ws + WS_WAB), AB, gw, NGW, lane); PH_END

#pragma unroll 1
    for (int l = 0; l < DEPTH; ++l) {
        PH_BEGIN for (int rep = 0; rep < REP_G; ++rep) { pg8::Gemm g{Hb, (const bf16_t*)(A.ws + WS_WIN + l * SZ_WIN), NTOK, NPROJ, D, D, D}; pg8::StaticOrder S; S.init(NTOK, NPROJ, G, (int)blockIdx.x);
            pg8::EpiBf16<0> E{PROJ, NPROJ, nullptr, 0, 0}; pg8::gemm_phase<pg8::EpiBf16<0>, pg8::StaticOrder>(lds, g, S, E, nullptr); } PH_END
        constexpr int SUBC = 7;
        PH_BEGIN {
#pragma unroll 1
          for (int rep2 = 0; rep2 < REP_P2; ++rep2) {
#pragma unroll 1
            for (int j = blockIdx.x; j < 32 * SUBC; j += G) delta_prep_item(A, l, lds, (j & 31) * 32 + (j >> 5), tid, wave, lane);
          }
        } PH_END
        PH_BEGIN {
#pragma unroll 1
            for (int rep3 = 0; rep3 < REP_P3; ++rep3) {
                if (blockIdx.x < 32) delta_scan_item(A, l, lds, blockIdx.x, tid, wave, lane, xb, SUBC);
                else { const int w = blockIdx.x - 32; constexpr int NW = G - 32;
#pragma unroll 1
                    for (int k = 1; k <= 5; ++k) {
                        const int n0 = k * SUBC, nn = (n0 >= 32) ? 0 : ((32 - n0 < SUBC) ? 32 - n0 : SUBC);
                        int nprep = 32 * nn;
#ifndef REP_WPREP
#define REP_WPREP 1
#endif
#pragma unroll 1
                        for (int rep = 0; rep < REP_WPREP; ++rep)
#pragma unroll 1
                        for (int j = w; j < nprep; j += NW) delta_prep_item(A, l, lds, (j & 31) * 32 + n0 + (j >> 5), tid, wave, lane);
                        if (k == 1) {
#pragma unroll 1
                            for (int it = w; it < 512; it += NW) delta_sample_item(A, l, lds, it, tid, wave, lane); }
                        if (k == 2) {
#pragma unroll 1
                            for (int it = w * 8 + wave; it < 8 * 31 * 16; it += NW * 8) { int t1 = threadIdx.x; asm volatile("" : "+v"(t1)); ssm_part1_item(A, l, it, t1 & 63); }
                            { int t2 = threadIdx.x; asm volatile("" : "+v"(t2)); int wl = blockIdx.x; asm volatile("" : "+s"(wl)); state_copies(A, l, (wl - 32) * 512 + t2, NW * 512); } }
                        if (k == 3) {
#pragma unroll 1
                            for (int it = w; it < 264; it += NW) pool_item(A, l, lds, it, tid, wave, lane); }
                        { const int it = (k == 4) ? w - 128 : ((k == 5) ? 96 + w : -1);
                          if (it >= 0 && it < ((k == 4) ? 96 : 264)) ssm_part2_item(A, l, lds, it, tid, wave, lane); }
                        if (k < 5) xcd_barrier(xb);
                    } }
            }
        } PH_END
        PH_BEGIN for (int rep = 0; rep < REP_G; ++rep) { pg8::Gemm g{MIX, (const bf16_t*)(A.ws + WS_WOUT + l * SZ_WOUT), NP, D, D, D, D}; pg8::StaticOrder S; S.init(NP, D, G, (int)blockIdx.x);
            pg8::EpiF32 E{MIXO, D, nullptr}; pg8::gemm_phase<pg8::EpiF32, pg8::StaticOrder>(lds, g, S, E, nullptr);
            pg8::Gemm g2{MIX + (size_t)NP * D, (const bf16_t*)(A.ws + WS_WOUT + l * SZ_WOUT), NS, D, 256, D, D}; SliceOrder S2{8 * (D / 256), G, (int)blockIdx.x};
            EpiF32Part E2{(float*)(A.ws + WS_PARTS)}; pg8::gemm_phase<EpiF32Part, SliceOrder>(lds, g2, S2, E2, nullptr); } PH_END
#ifndef REP_N5
#define REP_N5 1
#endif
        PH_BEGIN for (int rep = 0; rep < (l == 0 ? REP_N5 : 1); ++rep) norm_rows(MIXO, A.in[I_NMPOST] + l * D, l == 0 ? A.in[I_XP] : A.out, l == 0 ? A.in[I_XS] : nullptr, A.out, A.in[I_NFPRE] + l * D, Hb, nullptr, nullptr, gw, NGW, lane, (const float*)(A.ws + WS_PARTS), D / 256); PH_END
        PH_BEGIN for (int rep = 0; rep < REP_G; ++rep) { pg8::Gemm g{Hb, (const bf16_t*)(A.ws + WS_WGU + l * SZ_WGU), NTOK, NGU, D, D, D}; pg8::StaticOrder S; S.init(NTOK, NGU, G, (int)blockIdx.x);
            EpiSwiGLU E{HID, DFF}; pg8::gemm_phase<EpiSwiGLU, pg8::StaticOrder>(lds, g, S, E, nullptr); } PH_END
        PH_BEGIN for (int rep = 0; rep < REP_G; ++rep) { pg8::Gemm g{HID, (const bf16_t*)(A.ws + WS_WDN + l * SZ_WDN), NP, D, DFF, DFF, DFF}; pg8::StaticOrder S; S.init(NP, D, G, (int)blockIdx.x);
            pg8::EpiF32 E{MIXO, D, nullptr}; pg8::gemm_phase<pg8::EpiF32, pg8::StaticOrder>(lds, g, S, E, nullptr);
            pg8::Gemm g2{HID + (size_t)NP * DFF, (const bf16_t*)(A.ws + WS_WDN + l * SZ_WDN), NS, D, 256, DFF, DFF}; SliceOrder S2{8 * (DFF / 256), G, (int)blockIdx.x};
            EpiF32Part E2{(float*)(A.ws + WS_PARTS)}; pg8::gemm_phase<EpiF32Part, SliceOrder>(lds, g2, S2, E2, nullptr); } PH_END
        PH_BEGIN norm_rows(MIXO, A.in[I_NFPOST] + l * D, A.out, nullptr, A.out, l + 1 < DEPTH ? A.in[I_NMPRE] + (l + 1) * D : nullptr, l + 1 < DEPTH ? Hb : nullptr,
                           l + 1 < DEPTH ? (const float*)(A.ws + WS_WAB + (l + 1) * SZ_WAB) : nullptr, AB, gw, NGW, lane, (const float*)(A.ws + WS_PARTS), DFF / 256); PH_END
    }
#undef PH_BEGIN
#undef PH_END
#undef Hb
#undef AB
#undef MIXO
#undef PROJ
#undef MIX
#undef HID
}

extern "C" void kernel_launch(void* const* d_in, const int* in_sizes, int n_in, void* d_out, int out_size, void* d_ws, size_t ws_size, hipStream_t stream) {
    static int grid = 0;
    if (grid == 0) {
        if (n_in != 32 || (size_t)out_size != O_END || ws_size < WS_END) fprintf(stderr, "kernel_launch: unexpected sizes: n_in %d out %d (want %zu) ws %zu (want >= %zu)\n", n_in, out_size, (size_t)O_END, ws_size, (size_t)WS_END);
        int dev = 0, cus = 0, per_cu = 0;
        (void)hipGetDevice(&dev); (void)hipDeviceGetAttribute(&cus, hipDeviceAttributeMultiprocessorCount, dev);
        if (hipFuncSetAttribute((const void*)mega_fwd, hipFuncAttributeMaxDynamicSharedMemorySize, LDS_BYTES) != hipSuccess) fprintf(stderr, "kernel_launch: hipFuncSetAttribute failed\n");
        if (hipOccupancyMaxActiveBlocksPerMultiprocessor(&per_cu, (const void*)mega_fwd, 512, LDS_BYTES) != hipSuccess || per_cu < 1) { fprintf(stderr, "kernel_launch: occupancy query gave %d\n", per_cu); per_cu = 1; (void)hipGetLastError(); }
        grid = cus * per_cu; if (grid <= 0) grid = 256;
        if (grid >= 256) grid = 256;
        fprintf(stderr, "kernel_launch: grid %d (cus %d x %d)%s\n", grid, cus, per_cu, grid < 256 ? "  ERROR: this build needs >= 256 co-resident workgroups" : "");
    }
    (void)hipMemsetAsync((unsigned char*)d_ws + WS_BAR, 0, 16384, stream);
    Args a{};
    for (int i = 0; i < 32; ++i) a.in[i] = (const float*)d_in[i];
    a.out = (float*)d_out; a.ws = (unsigned char*)d_ws;
#if MK_COOP
    a.ph_lo = 0; a.ph_hi = NPH;
    void* args[] = {&a};
    const hipError_t e = hipLaunchCooperativeKernel((const void*)mega_fwd, dim3(grid), dim3(512), args, LDS_BYTES, stream);
    if (e != hipSuccess) fprintf(stderr, "kernel_launch: cooperative launch failed: %s (grid %d)\n", hipGetErrorString(e), grid);
#else
    for (int p = 0; p < NPH; ++p) { a.ph_lo = p; a.ph_hi = p + 1; hipLaunchKernelGGL(mega_fwd, dim3(grid), dim3(512), LDS_BYTES, stream, a); }
#endif
}
```

```cpp
#include <hip/hip_runtime.h>
#include <hip/hip_cooperative_groups.h>
#include <cstdio>
#include <cstdint>
namespace cg = cooperative_groups;
#ifndef MK_COOP
#define MK_COOP 1
#endif
namespace pg8 {
#define PG8_LAS __attribute__((address_space(3)))
typedef unsigned short bf16_t;
typedef short bf16x8 __attribute__((ext_vector_type(8)));
typedef float f32x4 __attribute__((ext_vector_type(4)));
typedef unsigned u32x4 __attribute__((ext_vector_type(4)));
constexpr int BM = 256, BK = 64, HALF = 128, HTB = HALF * BK * 2  , STAGE_BYTES = 8 * HTB, NXCD = 8, WGM = 8;

__host__ __device__ __forceinline__ int lds_byte(int r, int c) { const int st = (r >> 4) * 2 + (c >> 5), rr = r & 15, cc = c & 31, ob = rr * 64 + cc * 2; return st * 1024 + (ob ^ (((ob >> 9) & 1) << 5)); }
__host__ __device__ __forceinline__ void stage_rc(int b, int& R, int& C) { const int st = b / 1024, sb = b % 1024, swz = sb ^ (((sb >> 9) & 1) << 5); R = (st >> 1) * 16 + swz / 64; C = (st & 1) * 32 + (swz % 64) / 2; }
__host__ __device__ __forceinline__ int perm32(int rho) { const int n = rho >> 4, i = rho & 15; return 8 * (i >> 2) + 4 * n + (i & 3); }

struct Unit { int pm, pn, ks; };
struct Gemm { const bf16_t* A; const bf16_t* Bt; int M, N, K, lda, ldb; };

struct StaticOrder {
    int nM, nN, nwg, G, c;
    __host__ __device__ void init(int M, int N, int G_, int c_) { nM = M / BM; nN = N / BM; nwg = nM * nN; G = G_; c = c_; }
    __host__ __device__ bool next(int i, Unit& u) const {
        const long L = (long)i * G + c; if (L >= nwg) return false;
        int wgid = (int)L; { const int q = nwg / NXCD, r = nwg % NXCD, xcd = wgid % NXCD, off = wgid / NXCD; wgid = (xcd < r ? xcd * (q + 1) : r * (q + 1) + (xcd - r) * q) + off; }
        const int nig = WGM * nN, gid = wgid / nig, fm = gid * WGM, gsz = (nM - fm) < WGM ? (nM - fm) : WGM;
        u.pm = fm + ((wgid % nig) % gsz); u.pn = (wgid % nig) / gsz; u.ks = 0; return true;
    }
    __device__ __forceinline__ void a_ready(const Unit&) const {}
    __device__ __forceinline__ void done(const Unit&) const {}
};
__device__ __forceinline__ unsigned cvt_pk_bf16(float lo, float hi) { unsigned r; asm volatile("v_cvt_pk_bf16_f32 %0, %1, %2" : "=v"(r) : "v"(lo), "v"(hi)); return r; }
typedef float f32x2 __attribute__((ext_vector_type(2)));
__device__ __forceinline__ f32x2 gelu_pk(f32x2 v) {
    const f32x2 av = __builtin_elementwise_abs(v), d = av * 0.2316418882f + 1.0f;
    f32x2 t; t.x = __builtin_amdgcn_rcpf(d.x); t.y = __builtin_amdgcn_rcpf(d.y);
    f32x2 q = t * 0.5307027145f + (-0.7265760135f); q = q * t + 0.7107068705f; q = q * t + (-0.142248368f); q = q * t + 0.127414796f; q = q * t;
    const f32x2 s = (v * v) * (-0.72134752044f);
    f32x2 e; e.x = __builtin_amdgcn_exp2f(s.x); e.y = __builtin_amdgcn_exp2f(s.y);
    const f32x2 m = v * (q * e), r = v - m;
    f32x2 o; o.x = v.x < 0.f ? m.x : r.x; o.y = v.y < 0.f ? m.y : r.y; return o;
}

struct EpiF32 {
    static constexpr bool PERM = false, AFTER_DRAIN = false;
    float* C; int ldc; const float* bias;
    __device__ __forceinline__ void operator()(const f32x4 (&acc)[2][2][4][2], const Unit& u, int wr, int wc, int fr, int fq) const {
        const int row0 = u.pm * BM + wr * 64 + fr, col0 = u.pn * BM + wc * 32 + 4 * fq;
        f32x4 bv[2][2];
#pragma unroll
        for (int bj = 0; bj < 2; ++bj)
#pragma unroll
            for (int n = 0; n < 2; ++n) bv[bj][n] = bias ? *(const f32x4*)(bias + col0 + bj * HALF + n * 16) : (f32x4){0.f, 0.f, 0.f, 0.f};
#pragma unroll
        for (int ai = 0; ai < 2; ++ai)
#pragma unroll
            for (int m = 0; m < 4; ++m) { float* rowp = C + (size_t)(row0 + ai * HALF + m * 16) * ldc + col0;
#pragma unroll
                for (int bj = 0; bj < 2; ++bj)
#pragma unroll
                    for (int n = 0; n < 2; ++n) *(f32x4*)(rowp + bj * HALF + n * 16) = acc[ai][bj][m][n] + bv[bj][n]; }
    }
};
template <int ACT  > struct EpiBf16 {
    static constexpr bool PERM = true, AFTER_DRAIN = false;
    bf16_t* O; int ldc; const float* bias; int split_cols; size_t split_stride;
    __device__ __forceinline__ void operator()(const f32x4 (&acc)[2][2][4][2], const Unit& u, int wr, int wc, int fr, int fq) const {
        const int row0 = u.pm * BM + wr * 64 + fr; int colt = u.pn * BM; bf16_t* base = O;
        if (split_cols) { const int t = colt / split_cols; base += (size_t)t * split_stride; colt -= t * split_cols; }
        const int col0 = colt + wc * 32 + 8 * fq, bcol0 = u.pn * BM + wc * 32 + 8 * fq;
        f32x4 bv[2][2];
#pragma unroll
        for (int bj = 0; bj < 2; ++bj)
#pragma unroll
            for (int n = 0; n < 2; ++n) bv[bj][n] = bias ? *(const f32x4*)(bias + bcol0 + bj * HALF + 4 * n) : (f32x4){0.f, 0.f, 0.f, 0.f};
#pragma unroll
        for (int ai = 0; ai < 2; ++ai)
#pragma unroll
            for (int m = 0; m < 4; ++m) { bf16_t* rowp = base + (size_t)(row0 + ai * HALF + m * 16) * ldc + col0;
#pragma unroll
                for (int bj = 0; bj < 2; ++bj) { f32x4 v0 = acc[ai][bj][m][0] + bv[bj][0], v1 = acc[ai][bj][m][1] + bv[bj][1];
                    if (ACT == 1) { f32x2 a = gelu_pk((f32x2){v0[0], v0[1]}), b = gelu_pk((f32x2){v0[2], v0[3]}), c = gelu_pk((f32x2){v1[0], v1[1]}), d = gelu_pk((f32x2){v1[2], v1[3]});
                        v0 = (f32x4){a.x, a.y, b.x, b.y}; v1 = (f32x4){c.x, c.y, d.x, d.y}; }
                    if (ACT == 2) {
#pragma unroll
                        for (int j = 0; j < 4; ++j) { v0[j] = 0.5f * v0[j] * (1.0f + erff(v0[j] * 0.70710678f)); v1[j] = 0.5f * v1[j] * (1.0f + erff(v1[j] * 0.70710678f)); } }
                    u32x4 w; w.x = cvt_pk_bf16(v0[0], v0[1]); w.y = cvt_pk_bf16(v0[2], v0[3]); w.z = cvt_pk_bf16(v1[0], v1[1]); w.w = cvt_pk_bf16(v1[2], v1[3]);
                    *(u32x4*)(rowp + bj * HALF) = w; } }
    }
};
template <class Epi, class Sched, bool STAMP = false>
__device__ __forceinline__ void gemm_phase(PG8_LAS unsigned char* lds, const Gemm g, const Sched& S, const Epi& E, unsigned long long* stamps) {
    int tid_ = threadIdx.x; asm volatile("" : "+v"(tid_));
    const int tid = tid_, wid = __builtin_amdgcn_readfirstlane(tid >> 6), lane = tid & 63, wr = wid >> 2, wc = wid & 3, fr = lane & 15, fq = lane >> 4;
    const int K = g.K, nt = K / BK;
    int ts_lo = 0, ts_hi = 0, nts = 0; const unsigned long long rt_entry = STAMP ? (unsigned long long)wall_clock64() : 0ull;
#define PG8_STAMP() do { if (STAMP && wid == 0 && nts < 64) { const unsigned long long _c = (unsigned long long)clock64(); \
        ts_lo = (lane == nts) ? (int)(unsigned)_c : ts_lo; ts_hi = (lane == nts) ? (int)(unsigned)(_c >> 32) : ts_hi; ++nts; } } while (0)
    PG8_STAMP();
    unsigned voffA[2], voffB[2];
#pragma unroll
    for (int i = 0; i < 2; ++i) { int R, C; stage_rc(tid * 16 + i * 8192, R, C); const int Rb = Epi::PERM ? ((R & ~31) + perm32(R & 31)) : R;
        voffA[i] = (unsigned)(R * g.lda + C) * 2u; voffB[i] = (unsigned)(Rb * g.ldb + C) * 2u; }
    const size_t kstep = (size_t)(BK * 2);
    const size_t hstepA = (size_t)HALF * g.lda * 2, hstepB = (size_t)HALF * g.ldb * 2;
    const size_t tstepA = 2 * hstepA, tstepB = 2 * hstepB, sstep = (size_t)K * 2;
    const unsigned ldsw = (unsigned)wid * 1024u;
    const int aoff = lds_byte(wr * 64 + fr, fq * 8), boff = lds_byte(wc * 32 + fr, fq * 8);
#define PG8_SA(b, h) (((b) * 2 + (h)) * HTB)
#define PG8_SB(b, h) ((4 + (b) * 2 + (h)) * HTB)
#define PG8_STAGE(bufoff, gbase, voff) do { _Pragma("unroll") for (int _i = 0; _i < 2; ++_i) \
        __builtin_amdgcn_global_load_lds((const unsigned*)((const char*)(gbase) + (voff)[_i]), (PG8_LAS unsigned*)(lds + (bufoff) + ldsw + _i * 8192), 16, 0, 0); } while (0)
#define PG8_LDA(dst, b, h) do { _Pragma("unroll") for (int m = 0; m < 4; ++m) _Pragma("unroll") for (int k = 0; k < 2; ++k) dst[m][k] = *(const PG8_LAS bf16x8*)(lds + PG8_SA(b, h) + aoff + m * 2048 + k * 1024); } while (0)
#define PG8_LDB(dst, b, h) do { _Pragma("unroll") for (int n = 0; n < 2; ++n) _Pragma("unroll") for (int k = 0; k < 2; ++k) dst[n][k] = *(const PG8_LAS bf16x8*)(lds + PG8_SB(b, h) + boff + n * 2048 + k * 1024); } while (0)
#define PG8_MMA(ai, bj, At, Bt) do { __builtin_amdgcn_s_setprio(1); _Pragma("unroll") for (int m = 0; m < 4; ++m) _Pragma("unroll") for (int n = 0; n < 2; ++n) _Pragma("unroll") for (int k = 0; k < 2; ++k) \
        acc[ai][bj][m][n] = __builtin_amdgcn_mfma_f32_16x16x32_bf16(Bt[n][k], At[m][k], acc[ai][bj][m][n], 0, 0, 0); __builtin_amdgcn_s_setprio(0); } while (0)
#define PG8_WAIT_V(n) asm volatile("s_waitcnt vmcnt(" #n ")" ::: "memory")
#define PG8_WAIT_L(n) asm volatile("s_waitcnt lgkmcnt(" #n ")" ::: "memory")
#define PG8_BAR __builtin_amdgcn_s_barrier()
#define PG8_SCHED __builtin_amdgcn_sched_barrier(0)
    Unit cur, nxt; int ui = 0;
    if (!S.next(0, cur)) return;
    f32x4 acc[2][2][4][2];
#pragma unroll
    for (int a = 0; a < 2; ++a)
#pragma unroll
        for (int b = 0; b < 2; ++b)
#pragma unroll
            for (int m = 0; m < 4; ++m)
#pragma unroll
                for (int n = 0; n < 2; ++n) acc[a][b][m][n] = (f32x4){0.f, 0.f, 0.f, 0.f};
    bf16x8 At[4][2], B0[2][2], B1[2][2];
    const char* cA = (const char*)g.A + (size_t)cur.pm * tstepA + (size_t)cur.ks * sstep; const char* cB = (const char*)g.Bt + (size_t)cur.pn * tstepB + (size_t)cur.ks * sstep;
    S.a_ready(cur);
    PG8_STAGE(PG8_SB(0, 0), cB, voffB); PG8_STAGE(PG8_SA(0, 0), cA, voffA); PG8_STAGE(PG8_SB(0, 1), cB + hstepB, voffB); PG8_STAGE(PG8_SA(0, 1), cA + hstepA, voffA);
    if (wr == 1) PG8_BAR;
    PG8_WAIT_V(4); PG8_BAR;
    PG8_STAGE(PG8_SB(1, 0), cB + kstep, voffB); PG8_STAGE(PG8_SA(1, 0), cA + kstep, voffA); PG8_STAGE(PG8_SB(1, 1), cB + hstepB + kstep, voffB);
    PG8_WAIT_V(6); PG8_BAR;
    PG8_STAMP();
    for (;;) {
        const bool has_next = S.next(ui + 1, nxt);
        const char* nA = has_next ? (const char*)g.A + (size_t)nxt.pm * tstepA + (size_t)nxt.ks * sstep : cA; const char* nB = has_next ? (const char*)g.Bt + (size_t)nxt.pn * tstepB + (size_t)nxt.ks * sstep : cB;
        for (int t = 0; t < nt; t += 2) {
            const bool last = (t == nt - 2);
            const char* a1 = cA + (size_t)(t + 1) * kstep;
            const char* a2 = last ? nA : cA + (size_t)(t + 2) * kstep; const char* b2 = last ? nB : cB + (size_t)(t + 2) * kstep;
            const char* a3 = a2 + kstep; const char* b3 = b2 + kstep;
            if (last && has_next) S.a_ready(nxt);
            PG8_LDB(B0, 0, 0); PG8_SCHED; PG8_LDA(At, 0, 0); PG8_STAGE(PG8_SA(1, 1), a1 + hstepA, voffA);
            PG8_WAIT_L(8); PG8_BAR; PG8_WAIT_L(0); PG8_MMA(0, 0, At, B0); PG8_BAR; PG8_SCHED;
            PG8_LDB(B1, 0, 1); PG8_STAGE(PG8_SB(0, 0), b2, voffB);
            PG8_BAR; PG8_WAIT_L(0); PG8_MMA(0, 1, At, B1); PG8_BAR;
            PG8_LDA(At, 0, 1); PG8_STAGE(PG8_SA(0, 0), a2, voffA);
            PG8_BAR; PG8_WAIT_L(0); PG8_MMA(1, 0, At, B0); PG8_BAR; PG8_SCHED;
            PG8_STAGE(PG8_SB(0, 1), b2 + hstepB, voffB);
            PG8_WAIT_V(6); PG8_BAR; PG8_MMA(1, 1, At, B1); PG8_BAR;
            PG8_LDB(B0, 1, 0); PG8_SCHED; PG8_LDA(At, 1, 0); PG8_STAGE(PG8_SA(0, 1), a2 + hstepA, voffA);
            PG8_WAIT_L(8); PG8_BAR; PG8_WAIT_L(0); PG8_MMA(0, 0, At, B0); PG8_BAR; PG8_SCHED;
            PG8_LDB(B1, 1, 1); PG8_STAGE(PG8_SB(1, 0), b3, voffB);
            PG8_BAR; PG8_WAIT_L(0); PG8_MMA(0, 1, At, B1); PG8_BAR;
            PG8_LDA(At, 1, 1); PG8_STAGE(PG8_SA(1, 0), a3, voffA);
            PG8_BAR; PG8_WAIT_L(0); PG8_MMA(1, 0, At, B0); PG8_BAR; PG8_SCHED;
            PG8_STAGE(PG8_SB(1, 1), b3 + hstepB, voffB);
            PG8_WAIT_V(6); PG8_BAR; PG8_MMA(1, 1, At, B1); PG8_BAR;
        }
        PG8_STAMP();
        if constexpr (!Epi::AFTER_DRAIN) { E(acc, cur, wr, wc, fr, fq); S.done(cur); }
        PG8_STAMP();
        if (!has_next) break;
#pragma unroll
        for (int a = 0; a < 2; ++a)
#pragma unroll
            for (int b = 0; b < 2; ++b)
#pragma unroll
                for (int m = 0; m < 4; ++m)
#pragma unroll
                    for (int n = 0; n < 2; ++n) acc[a][b][m][n] = (f32x4){0.f, 0.f, 0.f, 0.f};
        cur = nxt; cA = nA; cB = nB; ++ui;
    }
    PG8_WAIT_V(0);
    if (wr == 0) PG8_BAR;
    PG8_BAR;
    if constexpr (Epi::AFTER_DRAIN) { E.fused(acc, cur, wr, wc, fr, fq, lds, wid, lane); S.done(cur); }
    PG8_STAMP();
    if (STAMP && wid == 0) { stamps[lane] = lane < nts ? (((unsigned long long)(unsigned)ts_hi << 32) | (unsigned)ts_lo) : 0ull;
        if (lane == 62) stamps[62] = rt_entry; if (lane == 63) stamps[63] = (unsigned long long)wall_clock64(); }
#undef PG8_STAMP
#undef PG8_SA
#undef PG8_SB
#undef PG8_STAGE
#undef PG8_LDA
#undef PG8_LDB
#undef PG8_MMA
#undef PG8_WAIT_V
#undef PG8_WAIT_L
#undef PG8_BAR
#undef PG8_SCHED
}
}

#define LAS __attribute__((address_space(3)))
typedef unsigned short bf16_t;
typedef short bf16x8 __attribute__((ext_vector_type(8)));
typedef float f32x4 __attribute__((ext_vector_type(4)));
typedef float f32x2 __attribute__((ext_vector_type(2)));
typedef unsigned u32x4 __attribute__((ext_vector_type(4)));
typedef unsigned u32x2 __attribute__((ext_vector_type(2)));

constexpr int D = 1024, NP = 16384, NS = 512, NTOK = NP + NS, SEQ = 2048, NB = 8, NSB = 128, DEPTH = 4;
constexpr int INW = 2568, NPROJ = 2560, DFF = 2816, NGU = 5632;
constexpr int PC_G = 1536, PC_SSM = 2048, PC_POOL = 2304;
constexpr float EPS = 1e-6f;
constexpr int LDS_BYTES = 163840;

constexpr size_t SZ_WIN = (size_t)NPROJ * D * 2, SZ_WOUT = (size_t)D * D * 2, SZ_WGU = (size_t)NGU * D * 2, SZ_WDN = (size_t)D * DFF * 2;
constexpr size_t SZ_WAB = 8 * D * 4, SZ_GLUT = 256 * 256 * 2, SZ_POOLT = 4 * 64 * 64 * 2, SZ_SSMK = 16 * 64 * 4 * 4, SZ_BBAR = 16 * 64 * 32 * 4;
constexpr size_t WS_WIN = 0;
constexpr size_t WS_WOUT = WS_WIN + DEPTH * SZ_WIN;
constexpr size_t WS_WGU = WS_WOUT + DEPTH * SZ_WOUT;
constexpr size_t WS_WDN = WS_WGU + DEPTH * SZ_WGU;
constexpr size_t WS_WAB = WS_WDN + DEPTH * SZ_WDN;
constexpr size_t WS_GLUT = WS_WAB + DEPTH * SZ_WAB;
constexpr size_t WS_POOLT = WS_GLUT + DEPTH * SZ_GLUT;
constexpr size_t WS_SSMK = WS_POOLT + DEPTH * SZ_POOLT;
constexpr size_t WS_BBAR = WS_SSMK + DEPTH * SZ_SSMK;
constexpr size_t WS_H = WS_BBAR + DEPTH * SZ_BBAR;
constexpr size_t WS_AB = WS_H + (size_t)NTOK * D * 2;
constexpr size_t WS_MIX = WS_AB + (size_t)NTOK * 8 * 4;
constexpr size_t WS_MIXO = WS_MIX + (size_t)NTOK * D * 2;
constexpr size_t WS_SSME = WS_MIXO + (size_t)NTOK * D * 4;
constexpr size_t WS_PROJ = WS_SSME + (size_t)8 * 32 * 16 * 64 * 2 * 4;
constexpr size_t WS_DW = WS_PROJ + (size_t)NTOK * NPROJ * 2;
constexpr size_t WS_DKC = WS_DW + (size_t)1024 * 8192 * 4;
constexpr size_t WS_DQD = WS_DKC + (size_t)1024 * 8192 * 2;
constexpr size_t WS_DQK = WS_DQD + (size_t)1024 * 8192 * 2;
constexpr size_t WS_DKT = WS_DQK + (size_t)1024 * 4096 * 2;
constexpr size_t WS_DGL = WS_DKT + (size_t)1024 * 8192 * 2;
constexpr size_t WS_DGS = WS_DGL + 4096;
constexpr size_t WS_BAR = WS_DGS + (size_t)1024 * 8192 * 2;
constexpr size_t WS_PARTS = WS_BAR + 16384;
constexpr size_t WS_END = WS_PARTS + (size_t)11 * 512 * 1024 * 4;
constexpr size_t WS_HID = WS_PROJ;
static_assert(WS_HID + (size_t)NTOK * DFF * 2 <= WS_END, "HID overlay");
static_assert(WS_H % 256 == 0 && WS_PROJ % 256 == 0 && WS_DW % 256 == 0, "align");

constexpr size_t O_YP = 0, O_YS = O_YP + (size_t)NP * D, O_DP = O_YS + (size_t)NS * D, O_CP = O_DP + (size_t)DEPTH * 8 * 4 * 16384,
                 O_REP = O_CP + (size_t)DEPTH * 8 * 3 * 1536, O_IMP = O_REP + (size_t)DEPTH * 8 * 1024, O_PP = O_IMP + (size_t)DEPTH * 8 * 1024,
                 O_DS = O_PP + (size_t)DEPTH * 8 * 15 * 256, O_CS = O_DS + (size_t)DEPTH * 128 * 4 * 16384, O_RES = O_CS + (size_t)DEPTH * 128 * 3 * 1536,
                 O_IMS = O_RES + (size_t)DEPTH * 128 * 1024, O_PS = O_IMS + (size_t)DEPTH * 128 * 1024, O_END = O_PS + (size_t)DEPTH * 128 * 15 * 256;

struct Args { const float* in[32]; float* out; unsigned char* ws; int ph_lo, ph_hi; };
typedef const float* cfp_t;
typedef __attribute__((address_space(4))) const unsigned char* kptr_t;
struct InProxy { __device__ __forceinline__ const float* operator[](int i) const {
    kptr_t p = (kptr_t)__builtin_amdgcn_kernarg_segment_ptr(); asm volatile("" : "+s"(p)); return *(__attribute__((address_space(4))) const cfp_t*)(p + 8 * i); } };
struct DevArgs { InProxy in; float* out; unsigned char* ws; int ph_lo, ph_hi; };
enum { I_XP = 0, I_XS, I_SDELTA, I_SCONV, I_SRE, I_SIM, I_SPOOL, I_NMPRE, I_NMPOST, I_NFPRE, I_NFPOST, I_WIN, I_CONVW, I_ALOG, I_DTB, I_ONORM,
       I_ARE, I_AIM, I_LOGDT, I_BRE, I_BIM, I_CRE, I_CIM, I_SSMD, I_GLUW, I_GLUB, I_POOLW, I_POOLS, I_WOUT, I_WG, I_WU, I_WD };

__device__ __forceinline__ unsigned f2bf(float f) { unsigned u = __float_as_uint(f); return (u + 0x7fffu + ((u >> 16) & 1u)) >> 16; }
__device__ __forceinline__ float bf2f(unsigned b) { return __uint_as_float(b << 16); }
__device__ __forceinline__ unsigned pk2(float lo, float hi) { return f2bf(lo) | (f2bf(hi) << 16); }
template <int CTRL> __device__ __forceinline__ float dpp_f(float v) { return __builtin_bit_cast(float, __builtin_amdgcn_update_dpp(0, __builtin_bit_cast(int, v), CTRL, 0xF, 0xF, true)); }
__device__ __forceinline__ float row_sum8(float v) { v += dpp_f<0xB1>(v); v += dpp_f<0x4E>(v); v += dpp_f<0x141>(v); return v; }
__device__ __forceinline__ float row_sum16(float v) { v = row_sum8(v); v += dpp_f<0x140>(v); return v; }
__device__ __forceinline__ float wave_sum(float v) { v = row_sum16(v); v += __shfl_xor(v, 16); v += __shfl_xor(v, 32); return v; }
__device__ __forceinline__ float silu_f(float y) { return y / (1.f + __expf(-y)); }
__device__ __forceinline__ float sigmoid_f(float y) { return 1.f / (1.f + __expf(-y)); }
__device__ __forceinline__ float gelu_tanh_f(float x) { const float t = tanhf(0.7978845608028654f * (x + 0.044715f * x * x * x)); return 0.5f * x * (1.f + t); }
__device__ __forceinline__ f32x4 mfma16(bf16x8 a, bf16x8 b, f32x4 c) { return __builtin_amdgcn_mfma_f32_16x16x32_bf16(a, b, c, 0, 0, 0); }
#define LDS_FENCE() asm volatile("s_waitcnt lgkmcnt(0)" ::: "memory")

struct EpiSwiGLU {
    static constexpr bool PERM = false, AFTER_DRAIN = false;
    bf16_t* O; int ldc;
    __device__ __forceinline__ void operator()(const pg8::f32x4 (&acc)[2][2][4][2], const pg8::Unit& u, int wr, int wc, int fr, int fq) const {
        const int row0 = u.pm * 256 + wr * 64 + fr, hid0 = u.pn * 128 + wc * 16 + 4 * fq;
#pragma unroll
        for (int ai = 0; ai < 2; ++ai)
#pragma unroll
            for (int m = 0; m < 4; ++m) { bf16_t* rowp = O + (size_t)(row0 + ai * 128 + m * 16) * ldc + hid0;
#pragma unroll
                for (int bj = 0; bj < 2; ++bj) { const pg8::f32x4 g = acc[ai][bj][m][0], v = acc[ai][bj][m][1];
                    u32x2 w; w.x = pk2(silu_f(g[0]) * v[0], silu_f(g[1]) * v[1]); w.y = pk2(silu_f(g[2]) * v[2], silu_f(g[3]) * v[3]);
                    *(u32x2*)(rowp + bj * 64) = w; } }
    }
};

#define XB_TMO      128
#define XB_XCNT(j)  (256  + 64 * (j))
#define XB_XSUB(j)  (1280 + 64 * (j))
#define XB_XGEN(j)  (2304 + 64 * (j))
#define XB_TOP      3328
#define XB_TOPGEN   3392
#define XCD_BAR_WORDS 3456
#define XB_SPIN_CAP (1u << 18)

__device__ __forceinline__ unsigned xb_ld(unsigned* p)              { return __hip_atomic_load(p, __ATOMIC_RELAXED, __HIP_MEMORY_SCOPE_AGENT); }
__device__ __forceinline__ unsigned xb_add(unsigned* p, unsigned v) { return __hip_atomic_fetch_add(p, v, __ATOMIC_RELAXED, __HIP_MEMORY_SCOPE_AGENT); }
__device__ __forceinline__ unsigned xb_xcc_id() { return (unsigned)__builtin_amdgcn_s_getreg((3 << 11) | 20) & 0xFu; }
#define XB_SPIN(cond, bar) do { unsigned _sp = 0; while (cond) { __builtin_amdgcn_s_sleep(1); \
    if ((++_sp & 255u) == 0u) { if (xb_ld(&(bar)[XB_TMO])) break; if (_sp > XB_SPIN_CAP) { atomicAdd(&(bar)[XB_TMO], 1u); break; } } } } while (0)

struct XcdBarrier {
    unsigned* bar; unsigned x;
    volatile LAS unsigned* st;
};

__device__ __forceinline__ XcdBarrier xcd_barrier_post(unsigned* bar, volatile LAS unsigned* st) {
    XcdBarrier b; b.bar = bar; b.x = xb_xcc_id(); b.st = st;
    if (threadIdx.x == 0) (void)xb_add(&bar[XB_XCNT(b.x)], 1u);
    return b;
}
__device__ __forceinline__ void xcd_barrier_complete(unsigned* bar, unsigned x, unsigned& nloc, unsigned& nx) {
    const unsigned G = gridDim.x * gridDim.y * gridDim.z;
    unsigned sum, cnt, mine, sp = 0u;
    for (;;) {
        sum = 0u; cnt = 0u; mine = 0u;
#pragma unroll
        for (unsigned j = 0; j < 16; ++j) { const unsigned c = xb_ld(&bar[XB_XCNT(j)]); sum += c; cnt += (c > 0u) ? 1u : 0u; mine = (j == x) ? c : mine; }
        if (sum == G) break;
        __builtin_amdgcn_s_sleep(1);
        if ((++sp & 255u) == 0u) { if (xb_ld(&bar[XB_TMO])) break; if (sp > XB_SPIN_CAP) { atomicAdd(&bar[XB_TMO], 1u); break; } }
    }
    nloc = mine > 0u ? mine : 1u; nx = cnt > 0u ? cnt : 1u;
}

__device__ __forceinline__ void xcd_barrier(const XcdBarrier& b) {
    asm volatile("s_waitcnt vmcnt(0)" ::: "memory");
    __syncthreads();
    if (threadIdx.x == 0) {
        unsigned* bar = b.bar; asm volatile("" : "+s"(bar));
        __builtin_amdgcn_s_waitcnt(0);
        unsigned nloc = b.st[0], nx = b.st[1];
        if (nloc == 0u) { xcd_barrier_complete(bar, b.x, nloc, nx); b.st[0] = nloc; b.st[1] = nx; }
        const unsigned old = xb_add(&bar[XB_XSUB(b.x)], 1u);
        const unsigned gen = old / nloc;
        if (old + 1u == (gen + 1u) * nloc) {
            __builtin_amdgcn_fence(__ATOMIC_RELEASE, "agent");
            asm volatile("s_waitcnt vmcnt(0)" ::: "memory");
            const unsigned og = xb_add(&bar[XB_TOP], 1u);
            const unsigned tg = og / nx;
            if (og + 1u == (tg + 1u) * nx) xb_add(&bar[XB_TOPGEN], 1u);
            else XB_SPIN(xb_ld(&bar[XB_TOPGEN]) == tg, bar);
            __builtin_amdgcn_fence(__ATOMIC_ACQUIRE, "agent");
            xb_add(&bar[XB_XGEN(b.x)], 1u);
            asm volatile("s_waitcnt vmcnt(0)" ::: "memory");
        } else {
            XB_SPIN(xb_ld(&bar[XB_XGEN(b.x)]) == gen, bar);
            __builtin_amdgcn_fence(__ATOMIC_ACQUIRE, "agent");
            asm volatile("s_waitcnt vmcnt(0)" ::: "memory");
        }
    }
    __syncthreads();
}

struct SliceOrder {
    int nunits, G, c;
    __device__ __forceinline__ bool next(int i, pg8::Unit& u) const { const int L = i * G + c; if (L >= nunits) return false; const int t = L & 7; u.pm = t >> 2; u.pn = t & 3; u.ks = L >> 3; return true; }
    __device__ __forceinline__ void a_ready(const pg8::Unit&) const {}
    __device__ __forceinline__ void done(const pg8::Unit&) const {}
};
struct EpiF32Part {
    static constexpr bool PERM = false, AFTER_DRAIN = false;
    float* C;
    __device__ __forceinline__ void operator()(const pg8::f32x4 (&acc)[2][2][4][2], const pg8::Unit& u, int wr, int wc, int fr, int fq) const {
        const int row0 = u.pm * 256 + wr * 64 + fr, col0 = u.pn * 256 + wc * 32 + 4 * fq; float* base = C + (size_t)u.ks * (512 * 1024);
#pragma unroll
        for (int ai = 0; ai < 2; ++ai)
#pragma unroll
            for (int m = 0; m < 4; ++m) { float* rowp = base + (size_t)(row0 + ai * 128 + m * 16) * 1024 + col0;
#pragma unroll
                for (int bj = 0; bj < 2; ++bj)
#pragma unroll
                    for (int n = 0; n < 2; ++n) *(pg8::f32x4*)(rowp + bj * 128 + n * 16) = acc[ai][bj][m][n]; }
    }
};

struct SrcIn { const float* w; __device__ __forceinline__ float operator()(int k, int n) const { return w[(size_t)k * INW + (n < 1536 ? n : n + 8)]; } };
struct SrcPlain { const float* w; int N; __device__ __forceinline__ float operator()(int k, int n) const { return w[(size_t)k * N + n]; } };
struct SrcGU { const float* g; const float* u; __device__ __forceinline__ float operator()(int k, int n) const { const int r = n & 31, hid = (n >> 5) * 16 + (r & 15); const long long du = (r < 16) ? 0ll : (long long)(u - g); return g[du + (long long)k * DFF + hid]; } };
template <class Src> __device__ __forceinline__ void transpose_item(const Src& src, int K, bf16_t* WT, int nblk, LAS float* scr, int item, int lane) {
    const int kb = item / nblk, nb = item % nblk, k0 = 64 * kb, n0 = 32 * nb;
#pragma unroll 8
    for (int i = 0; i < 32; ++i) { const int kk = 2 * i + (lane >> 5); scr[kk * 33 + (lane & 31)] = src(k0 + kk, n0 + (lane & 31)); }
    LDS_FENCE();
    const int c = lane & 7;
#pragma unroll
    for (int j = 0; j < 4; ++j) { const int n = (lane >> 3) + 8 * j; const LAS float* s = scr + (8 * c) * 33 + n;
        u32x4 o; o.x = pk2(s[0 * 33], s[1 * 33]); o.y = pk2(s[2 * 33], s[3 * 33]); o.z = pk2(s[4 * 33], s[5 * 33]); o.w = pk2(s[6 * 33], s[7 * 33]);
        *(u32x4*)(WT + (size_t)(n0 + n) * K + k0 + 8 * c) = o; }
    LDS_FENCE();
}

__device__ __forceinline__ void norm_rows(const float* T, const float* wt, const float* X0, const float* X1, float* Xout, const float* wh, bf16_t* H,
                                          const float* Wab, float* AB, int gw, int NGW, int lane, const float* Tp = nullptr, int ns = 0) {
#pragma unroll 1
    for (int m = gw; m < NTOK; m += NGW) {
        f32x4 x[4], t[4];
        { const float* xr = (X1 && m >= NP) ? X1 + (size_t)(m - NP) * D : X0 + (size_t)m * D;
#pragma unroll
          for (int j = 0; j < 4; ++j) x[j] = ((const f32x4*)xr)[lane + 64 * j];
          if (T && !(Tp && m >= NP)) {
#pragma unroll
              for (int j = 0; j < 4; ++j) t[j] = ((const f32x4*)(T + (size_t)m * D))[lane + 64 * j]; } }
        if (T) {
            float ss = 0.f;
            if (Tp && m >= NP) {
#pragma unroll
                for (int j = 0; j < 4; ++j) { f32x4 a = {0.f, 0.f, 0.f, 0.f}; for (int q = 0; q < ns; ++q) a += ((const f32x4*)(Tp + (size_t)q * (512 * 1024) + (size_t)(m - NP) * D))[lane + 64 * j]; t[j] = a; } }
#pragma unroll
            for (int j = 0; j < 4; ++j) ss += (t[j].x * t[j].x + t[j].y * t[j].y) + (t[j].z * t[j].z + t[j].w * t[j].w);
            ss = wave_sum(ss); const float r = rsqrtf(ss * (1.f / D) + EPS);
#pragma unroll
            for (int j = 0; j < 4; ++j) { const f32x4 w = ((const f32x4*)wt)[lane + 64 * j]; x[j] += t[j] * r * w; }
        }
        if (Xout) {
#pragma unroll
            for (int j = 0; j < 4; ++j) ((f32x4*)(Xout + (size_t)m * D))[lane + 64 * j] = x[j];
        }
        if (H) {
            float ss = 0.f;
#pragma unroll
            for (int j = 0; j < 4; ++j) ss += (x[j].x * x[j].x + x[j].y * x[j].y) + (x[j].z * x[j].z + x[j].w * x[j].w);
            ss = wave_sum(ss); const float r = rsqrtf(ss * (1.f / D) + EPS);
            f32x4 hv[4];
#pragma unroll
            for (int j = 0; j < 4; ++j) { const f32x4 w = ((const f32x4*)wh)[lane + 64 * j]; hv[j] = x[j] * r * w;
                u32x2 o; o.x = pk2(hv[j].x, hv[j].y); o.y = pk2(hv[j].z, hv[j].w); ((u32x2*)(H + (size_t)m * D))[lane + 64 * j] = o; }
            if (Wab) {
                float d[8];
#pragma unroll
                for (int c = 0; c < 8; ++c) { float dd = 0.f;
#pragma unroll
                    for (int j = 0; j < 4; ++j) { const f32x4 w = ((const f32x4*)(Wab + c * D))[lane + 64 * j]; dd += (hv[j].x * w.x + hv[j].y * w.y) + (hv[j].z * w.z + hv[j].w * w.w); }
                    d[c] = dd; }
#pragma unroll
                for (int c = 0; c < 8; ++c) d[c] = row_sum16(d[c]);
#pragma unroll
                for (int o = 16; o < 64; o <<= 1) {
#pragma unroll
                    for (int c = 0; c < 8; ++c) d[c] += __shfl_xor(d[c], o); }
                if (lane == 0) { f32x4 o0 = {d[0], d[1], d[2], d[3]}, o1 = {d[4], d[5], d[6], d[7]}; *(f32x4*)(AB + (size_t)m * 8) = o0; *(f32x4*)(AB + (size_t)m * 8 + 4) = o1; }
            }
        }
    }
}

__device__ __forceinline__ void prologue(const DevArgs& A, LAS unsigned char* lds, int wave, int lane, int gw, int NGW) {
    LAS float* scr = (LAS float*)(lds + wave * 8704);
    constexpr int I_IN = 16 * 80, I_OUT = 16 * 32, I_GU = 16 * 176, I_DN = 44 * 32, I_GLU = 4 * 8, I_POOL = 8, PER = I_IN + I_OUT + I_GU + I_DN + I_GLU + I_POOL;
#pragma unroll 1
    for (int it = gw; it < DEPTH * PER; it += NGW) {
        const int l = it / PER; int r = it % PER;
        if (r < I_IN) { SrcIn s{A.in[I_WIN] + (size_t)l * D * INW}; transpose_item(s, D, (bf16_t*)(A.ws + WS_WIN + l * SZ_WIN), NPROJ / 32, scr, r, lane); continue; } r -= I_IN;
        if (r < I_OUT) { SrcPlain s{A.in[I_WOUT] + (size_t)l * D * D, D}; transpose_item(s, D, (bf16_t*)(A.ws + WS_WOUT + l * SZ_WOUT), D / 32, scr, r, lane); continue; } r -= I_OUT;
        if (r < I_GU) { SrcGU s{A.in[I_WG] + (size_t)l * D * DFF, A.in[I_WU] + (size_t)l * D * DFF}; transpose_item(s, D, (bf16_t*)(A.ws + WS_WGU + l * SZ_WGU), NGU / 32, scr, r, lane); continue; } r -= I_GU;
        if (r < I_DN) { SrcPlain s{A.in[I_WD] + (size_t)l * DFF * D, D}; transpose_item(s, DFF, (bf16_t*)(A.ws + WS_WDN + l * SZ_WDN), D / 32, scr, r, lane); continue; } r -= I_DN;
        if (r < I_GLU) { SrcPlain s{A.in[I_GLUW] + (size_t)l * 65536, 256}; transpose_item(s, 256, (bf16_t*)(A.ws + WS_GLUT + l * SZ_GLUT), 8, scr, r, lane); continue; } r -= I_GLU;
        { const int g = r >> 1; SrcPlain s{A.in[I_POOLW] + (size_t)(l * 4 + g) * 4096, 64}; transpose_item(s, 64, (bf16_t*)(A.ws + WS_POOLT + l * SZ_POOLT) + g * 4096, 2, scr, r & 1, lane); }
    }
    const int gt = gw * 64 + lane, NT = NGW * 64;
    float* wab = (float*)(A.ws + WS_WAB);
#pragma unroll 1
    for (int i = gt; i < DEPTH * 8 * D; i += NT) { const int l = i / (8 * D), j = (i / D) & 7, k = i % D; wab[i] = A.in[I_WIN][((size_t)l * D + k) * INW + 1536 + j]; }
    float* ssmk = (float*)(A.ws + WS_SSMK); float* bbar = (float*)(A.ws + WS_BBAR);
#pragma unroll 1
    for (int i = gt; i < DEPTH * 16 * 64; i += NT) {
        const int lg = i >> 6;
        const float dt = expf(A.in[I_LOGDT][lg]), ar = A.in[I_ARE][i], ai = A.in[I_AIM][i];
        const float mag = expf(ar * dt);
        float rev = ai * dt * 0.15915494309189535f; rev -= floorf(rev);
        const float sn = __builtin_amdgcn_sinf(rev), cs = __builtin_amdgcn_cosf(rev);
        const float lr = mag * cs, li = mag * sn;
        float pr = lr, pi = li;
#pragma unroll
        for (int q = 0; q < 6; ++q) { const float nr2 = pr * pr - pi * pi, ni2 = 2.f * pr * pi; pr = nr2; pi = ni2; }
        ssmk[i * 4 + 0] = lr; ssmk[i * 4 + 1] = li; ssmk[i * 4 + 2] = pr; ssmk[i * 4 + 3] = pi;
        const float nr = lr - 1.f, ni = li, d2 = ar * ar + ai * ai;
        const float cre = (nr * ar + ni * ai) / d2, cim = (ni * ar - nr * ai) / d2;
#pragma unroll
        for (int h = 0; h < 16; ++h) { const float br = A.in[I_BRE][(size_t)i * 16 + h], bi = A.in[I_BIM][(size_t)i * 16 + h];
            bbar[(size_t)i * 32 + h] = cre * br - cim * bi; bbar[(size_t)i * 32 + 16 + h] = cre * bi + cim * br; }
    }
}

__device__ __forceinline__ unsigned bfmul2(unsigned pk, float f0, float f1) { return pg8::cvt_pk_bf16(__uint_as_float(pk << 16) * f0, __uint_as_float(pk & 0xffff0000u) * f1); }
__device__ __forceinline__ void delta_prep_item(const DevArgs& A, int l, LAS unsigned char* lds, int item, int tid, int wave, int lane) {
    asm volatile("" : "+v"(tid)); lane = tid & 63; wave = __builtin_amdgcn_readfirstlane(tid >> 6);
    const int bh = item >> 5, n = item & 31, b = bh >> 2, h = bh & 3;
    const int tok0 = b * SEQ + n * 64;
    LAS bf16_t* QS = (LAS bf16_t*)(lds); LAS bf16_t* KS = (LAS bf16_t*)(lds + 17408);
    LAS unsigned char* KT = lds + 34816; LAS unsigned char* VT = lds + 53248; LAS unsigned char* RTK = lds + 71680;
    LAS float* AM = (LAS float*)(lds + 90112); LAS float* PM = (LAS float*)(lds + 107520); LAS float* PSC = PM; LAS float* TM = (LAS float*)(lds + 124928);
    LAS unsigned char* TB = lds + 142336;
    LAS float* GAM = (LAS float*)(lds + 151552); LAS float* BETA = GAM + 64; LAS float* RQ = GAM + 128; LAS float* RK = GAM + 192;
    LAS float* F2 = GAM + 256; LAS float* F3 = GAM + 320; LAS float* F4 = GAM + 384;
    const bf16_t* PROJ = (const bf16_t*)(A.ws + WS_PROJ);
    const float* AB = (const float*)(A.ws + WS_AB);
    u32x4 gv[2];
#pragma unroll
    for (int j = 0; j < 2; ++j) { const int id = tid + 512 * j; gv[j] = *(const u32x4*)(PROJ + (size_t)(tok0 + (id >> 4)) * NPROJ + PC_G + h * 128 + (id & 15) * 8); }
    if (tid < 384) {
        const int part = tid >> 7, c = tid & 127, col = part * 512 + h * 128 + c;
        const float* cw = A.in[I_CONVW] + (size_t)l * 4 * 1536;
        const float w0 = cw[col], w1 = cw[1536 + col], w2 = cw[3072 + col], w3 = cw[4608 + col];
        const bf16_t* pp = PROJ + (size_t)tok0 * NPROJ + col;
        float xr[67];
#pragma unroll
        for (int t = 0; t < 67; ++t) xr[t] = (n > 0 || t >= 3) ? bf2f(pp[(long)(t - 3) * NPROJ]) : 0.f;
        unsigned pk[32];
#pragma unroll
        for (int t = 0; t < 64; t += 2) {
            const float s0 = silu_f(w0 * xr[t] + w1 * xr[t + 1] + w2 * xr[t + 2] + w3 * xr[t + 3]);
            const float s1 = silu_f(w0 * xr[t + 1] + w1 * xr[t + 2] + w2 * xr[t + 3] + w3 * xr[t + 4]);
            pk[t >> 1] = pg8::cvt_pk_bf16(s0, s1);
        }
        if (part < 2) { LAS bf16_t* dst = (part == 0 ? QS : KS) + c;
#pragma unroll
            for (int t = 0; t < 64; t += 2) { dst[t * 136] = (bf16_t)(pk[t >> 1] & 0xffffu); dst[(t + 1) * 136] = (bf16_t)(pk[t >> 1] >> 16); } }
        if (part > 0) { LAS unsigned char* dst = (part == 1 ? KT : VT) + c * 144;
#pragma unroll
            for (int q = 0; q < 8; ++q) { u32x4 o; o.x = pk[4 * q]; o.y = pk[4 * q + 1]; o.z = pk[4 * q + 2]; o.w = pk[4 * q + 3]; *(LAS u32x4*)(dst + q * 16) = o; } }
    } else if (tid < 448) {
        const int t = tid - 384;
        const float a = AB[(size_t)(tok0 + t) * 8 + h], bb = AB[(size_t)(tok0 + t) * 8 + 4 + h];
        const float xx = a + A.in[I_DTB][l * 4 + h];
        const float sp = xx > 20.f ? xx : log1pf(expf(xx));
        float lg = -expf(A.in[I_ALOG][l * 4 + h]) * sp;
#pragma unroll
        for (int off = 1; off < 64; off <<= 1) { const float v = __shfl_up(lg, off); if (lane >= off) lg += v; }
        GAM[t] = lg; BETA[t] = 1.f / (1.f + expf(-bb));
    }
    __syncthreads();
    {
        const int t = tid >> 3, part = tid & 7; float sq = 0.f, sk = 0.f;
#pragma unroll
        for (int j = 0; j < 16; ++j) { const float q = bf2f(QS[t * 136 + part * 16 + j]), k = bf2f(KS[t * 136 + part * 16 + j]); sq += q * q; sk += k * k; }
        sq = row_sum8(sq); sk = row_sum8(sk);
        if (part == 0) { const float rq = rsqrtf(sq + EPS) * 0.08838834764831845f, rk = rsqrtf(sk + EPS), g = GAM[t], eg = __expf(g), bt = BETA[t];
            RQ[t] = rq; RK[t] = rk; F2[t] = bt * eg * rk; F3[t] = rk * __expf(GAM[63] - g); F4[t] = rq * eg; }
    }
    {
        const int prod = wave >> 2, mt = wave & 3, fr = lane & 15, quad = lane >> 4;
        LAS bf16_t* Aop = prod ? QS : KS; LAS float* dst = prod ? PM : AM;
        bf16x8 a[4];
#pragma unroll
        for (int kk = 0; kk < 4; ++kk) a[kk] = *(LAS bf16x8*)(Aop + (mt * 16 + fr) * 136 + kk * 32 + quad * 8);
#pragma unroll
        for (int nt = 0; nt < 4; ++nt) { f32x4 acc = {0.f, 0.f, 0.f, 0.f};
#pragma unroll
            for (int kk = 0; kk < 4; ++kk) { const bf16x8 bq = *(LAS bf16x8*)(KS + (nt * 16 + fr) * 136 + kk * 32 + quad * 8); acc = mfma16(a[kk], bq, acc); }
#pragma unroll
            for (int i = 0; i < 4; ++i) dst[(mt * 16 + quad * 4 + i) * 68 + nt * 16 + fr] = acc[i]; }
    }
    __syncthreads();
    {
        const int t = tid >> 3, s8 = (tid & 7) * 8; const float gt = GAM[t], bk = BETA[t] * RK[t], rqt = RQ[t];
        float av[8], pv[8];
#pragma unroll
        for (int j = 0; j < 8; ++j) { const int s = s8 + j; const float rks = RK[s]; const float dec = (s <= t) ? __expf(gt - GAM[s]) * rks : 0.f;
            av[j] = (s < t) ? bk * dec * AM[t * 68 + s] : 0.f; pv[j] = rqt * dec * PM[t * 68 + s]; }
#pragma unroll
        for (int j = 0; j < 8; ++j) AM[t * 68 + s8 + j] = av[j];
        u32x4 o; o.x = pg8::cvt_pk_bf16(pv[0], pv[1]); o.y = pg8::cvt_pk_bf16(pv[2], pv[3]); o.z = pg8::cvt_pk_bf16(pv[4], pv[5]); o.w = pg8::cvt_pk_bf16(pv[6], pv[7]);
        *(u32x4*)((bf16_t*)(A.ws + WS_DQK) + (size_t)item * 4096 + t * 64 + s8) = o;
        for (int e = tid; e < 64 * 68; e += 512) TM[e] = 0.f;
        if (tid == 0) ((float*)(A.ws + WS_DGL))[item] = __expf(GAM[63]);
    }
    __syncthreads();
    if (wave == 0) {
        const int i = lane >> 4, c = lane & 15;
        LAS float* amp = AM + (16 * i) * 68 + 16 * i; asm volatile("" : "+v"(amp));
        float x[16];
#pragma unroll
        for (int r = 0; r < 16; ++r) { float acc = (r == c) ? 1.f : 0.f;
#pragma unroll
            for (int s = 0; s < r; ++s) acc = fmaf(-amp[r * 68 + s], x[s], acc);
            x[r] = acc; }
        LAS float* tmp = TM + (16 * i) * 68 + 16 * i + c;
#pragma unroll
        for (int r = 0; r < 16; ++r) tmp[r * 68] = x[r];
    } else {
        const int wt = tid - 64;
        for (int id = wt; id < 1024; id += 448) {
            const int c = id >> 3, t8 = (id & 7) * 8;
            const f32x4 b0 = *(LAS f32x4*)(BETA + t8), b1 = *(LAS f32x4*)(BETA + t8 + 4);
            u32x4 v = *(LAS u32x4*)(VT + c * 144 + t8 * 2);
            v.x = bfmul2(v.x, b0[0], b0[1]); v.y = bfmul2(v.y, b0[2], b0[3]); v.z = bfmul2(v.z, b1[0], b1[1]); v.w = bfmul2(v.w, b1[2], b1[3]);
            *(LAS u32x4*)(VT + c * 144 + t8 * 2) = v;
            const f32x4 f20 = *(LAS f32x4*)(F2 + t8), f21 = *(LAS f32x4*)(F2 + t8 + 4), f30 = *(LAS f32x4*)(F3 + t8), f31 = *(LAS f32x4*)(F3 + t8 + 4);
            const u32x4 k = *(LAS u32x4*)(KT + c * 144 + t8 * 2);
            u32x4 rk; rk.x = bfmul2(k.x, f20[0], f20[1]); rk.y = bfmul2(k.y, f20[2], f20[3]); rk.z = bfmul2(k.z, f21[0], f21[1]); rk.w = bfmul2(k.w, f21[2], f21[3]);
            *(LAS u32x4*)(RTK + c * 144 + t8 * 2) = rk;
            u32x4 kd; kd.x = bfmul2(k.x, f30[0], f30[1]); kd.y = bfmul2(k.y, f30[2], f30[3]); kd.z = bfmul2(k.z, f31[0], f31[1]); kd.w = bfmul2(k.w, f31[2], f31[3]);
            *(u32x4*)((bf16_t*)(A.ws + WS_DKT) + (size_t)item * 8192 + c * 64 + t8) = kd; }
        for (int id = wt; id < 1024; id += 448) {
            const int t = id >> 4, c8 = (id & 15) * 8; const float f = F4[t];
            u32x4 q = *(LAS u32x4*)((LAS unsigned char*)QS + t * 272 + c8 * 2);
            q.x = bfmul2(q.x, f, f); q.y = bfmul2(q.y, f, f); q.z = bfmul2(q.z, f, f); q.w = bfmul2(q.w, f, f);
            *(u32x4*)((bf16_t*)(A.ws + WS_DQD) + (size_t)item * 8192 + t * 128 + c8) = q; }
    }
    {
        const int c8 = (tid & 15) * 8; const float* on = A.in[I_ONORM] + l * 128 + c8;
        const f32x4 o0 = *(const f32x4*)on, o1 = *(const f32x4*)(on + 4);
#pragma unroll
        for (int j = 0; j < 2; ++j) { const int id = tid + 512 * j; const u32x4 g = gv[j]; u32x4 o;
            o.x = pg8::cvt_pk_bf16(silu_f(__uint_as_float(g.x << 16)) * o0[0], silu_f(__uint_as_float(g.x & 0xffff0000u)) * o0[1]);
            o.y = pg8::cvt_pk_bf16(silu_f(__uint_as_float(g.y << 16)) * o0[2], silu_f(__uint_as_float(g.y & 0xffff0000u)) * o0[3]);
            o.z = pg8::cvt_pk_bf16(silu_f(__uint_as_float(g.z << 16)) * o1[0], silu_f(__uint_as_float(g.z & 0xffff0000u)) * o1[1]);
            o.w = pg8::cvt_pk_bf16(silu_f(__uint_as_float(g.w << 16)) * o1[2], silu_f(__uint_as_float(g.w & 0xffff0000u)) * o1[3]);
            *(u32x4*)((bf16_t*)(A.ws + WS_DGS) + (size_t)item * 8192 + (id >> 4) * 128 + c8) = o; }
    }
    __syncthreads();
    const int p2 = tid >> 8, r2 = (tid >> 4) & 15, c2 = tid & 15, rb = p2 ? 48 : 16, cb = p2 ? 32 : 0;
    {
        float acc = 0.f;
#pragma unroll
        for (int s = 0; s < 16; ++s) acc = fmaf(AM[(rb + r2) * 68 + cb + s], TM[(cb + s) * 68 + cb + c2], acc);
        PSC[(p2 * 16 + r2) * 68 + c2] = acc; }
    __syncthreads();
    {
        float acc = 0.f;
#pragma unroll
        for (int s = 0; s < 16; ++s) acc = fmaf(TM[(rb + r2) * 68 + rb + s], PSC[(p2 * 16 + s) * 68 + c2], acc);
        TM[(rb + r2) * 68 + cb + c2] = -acc; }
    __syncthreads();
    float p3[2];
#pragma unroll
    for (int j = 0; j < 2; ++j) { const int e = tid + 512 * j, r = e >> 5, c = e & 31; float acc = 0.f;
#pragma unroll 8
        for (int s = 0; s < 32; ++s) acc = fmaf(AM[(32 + r) * 68 + s], TM[s * 68 + c], acc);
        p3[j] = acc; }
    __syncthreads();
#pragma unroll
    for (int j = 0; j < 2; ++j) { const int e = tid + 512 * j; PSC[(e >> 5) * 68 + (e & 31)] = p3[j]; }
    __syncthreads();
#pragma unroll
    for (int j = 0; j < 2; ++j) { const int e = tid + 512 * j, r = e >> 5, c = e & 31; float acc = 0.f;
#pragma unroll 8
        for (int s = 0; s < 32; ++s) acc = fmaf(TM[(32 + r) * 68 + 32 + s], PSC[s * 68 + c], acc);
        p3[j] = -acc; }
#pragma unroll
    for (int j = 0; j < 2; ++j) { const int e = tid + 512 * j; TM[(32 + (e >> 5)) * 68 + (e & 31)] = p3[j]; }
    __syncthreads();
#pragma unroll
    for (int j = 0; j < 4; ++j) { const int e = tid + 512 * j, t = e >> 5, s2 = (e & 31) * 2;
        *(LAS unsigned*)(TB + t * 144 + s2 * 2) = pg8::cvt_pk_bf16(TM[t * 68 + s2], TM[t * 68 + s2 + 1]); }
    __syncthreads();
    {
        const int fr = lane & 15, quad = lane >> 4;
        bf16x8 bv[2], ak[2];
#pragma unroll
        for (int kk = 0; kk < 2; ++kk) { bv[kk] = *(LAS bf16x8*)(VT + (16 * wave + fr) * 144 + (kk * 32 + quad * 8) * 2); ak[kk] = *(LAS bf16x8*)(RTK + (16 * wave + fr) * 144 + (kk * 32 + quad * 8) * 2); }
        bf16_t* DW = (bf16_t*)(A.ws + WS_DW) + (size_t)item * 8192; bf16_t* DKC = (bf16_t*)(A.ws + WS_DKC) + (size_t)item * 8192;
#pragma unroll
        for (int mt = 0; mt < 4; ++mt) { f32x4 aw = {0.f, 0.f, 0.f, 0.f}, akc = {0.f, 0.f, 0.f, 0.f};
#pragma unroll
            for (int kk = 0; kk < 2; ++kk) { const bf16x8 tf = *(LAS bf16x8*)(TB + (mt * 16 + fr) * 144 + (kk * 32 + quad * 8) * 2);
                aw = mfma16(tf, bv[kk], aw);
                akc = mfma16(ak[kk], tf, akc); }
            u32x2 ow; ow.x = pk2(aw[0], aw[1]); ow.y = pk2(aw[2], aw[3]);
            *(u32x2*)(DW + (16 * wave + fr) * 64 + mt * 16 + quad * 4) = ow;
            u32x2 ok; ok.x = pk2(-akc[0], -akc[1]); ok.y = pk2(-akc[2], -akc[3]);
            *(u32x2*)(DKC + (mt * 16 + fr) * 128 + 16 * wave + quad * 4) = ok; }
    }
    __syncthreads();
}

__device__ __forceinline__ void delta_scan_item(const DevArgs& A, int l, LAS unsigned char* lds, int bh, int tid_in, int wave, int lane_in, const XcdBarrier& xb, int SUB) {
    const int b = bh >> 2, h = bh & 3;
    LAS unsigned char* KCs = lds; LAS unsigned char* QDs = lds + 17408; LAS unsigned char* QKs = lds + 34816; LAS unsigned char* KDTs = lds + 44032;
    LAS unsigned char* Ws = lds + 62464;
    LAS unsigned char* GSs = lds + 80896;
    LAS unsigned char* SS = lds + 98304 + wave * 4352; LAS unsigned char* US = lds + 133120 + wave * 2304;
    LAS float* PART = (LAS float*)(lds + 151552);
    const unsigned char* gW = A.ws + WS_DW; const unsigned char* gGS = A.ws + WS_DGS;
    const unsigned char* gKC = A.ws + WS_DKC; const unsigned char* gQD = A.ws + WS_DQD; const unsigned char* gQK = A.ws + WS_DQK; const unsigned char* gKT = A.ws + WS_DKT;
    const float* DGL = (const float*)(A.ws + WS_DGL);
    f32x4 S[8];
#pragma unroll
    for (int mt = 0; mt < 8; ++mt) S[mt] = (f32x4){0.f, 0.f, 0.f, 0.f};
    u32x4 r[9], rg[2];
    float gl_all = 0.f;
#define DS_LOAD(itn, toff) do { const size_t _i = (size_t)(itn); const unsigned char* _kc = gKC + _i * 16384; const unsigned char* _qd = gQD + _i * 16384; \
        const unsigned char* _qk = gQK + _i * 8192; const unsigned char* _kt = gKT + _i * 16384; \
        r[0] = *(const u32x4*)(_kc + (toff)); r[1] = *(const u32x4*)(_kc + (toff) + 8192u); \
        r[2] = *(const u32x4*)(_qd + (toff)); r[3] = *(const u32x4*)(_qd + (toff) + 8192u); \
        r[4] = *(const u32x4*)(_qk + (toff)); \
        r[5] = *(const u32x4*)(_kt + (toff)); r[6] = *(const u32x4*)(_kt + (toff) + 8192u); \
        const unsigned char* _w = gW + _i * 16384; r[7] = *(const u32x4*)(_w + (toff)); r[8] = *(const u32x4*)(_w + (toff) + 8192u); } while (0)
#define DS_LOADG(itn, toff) do { const unsigned char* _g = gGS + (size_t)(itn) * 16384; rg[0] = *(const u32x4*)(_g + (toff)); rg[1] = *(const u32x4*)(_g + (toff) + 8192u); } while (0)
#define DS_STAGE(tidv) do { const int i0 = (tidv), i1 = (tidv) + 512; \
          *(LAS u32x4*)(KCs + (i0 >> 4) * 272 + (i0 & 15) * 16) = r[0]; *(LAS u32x4*)(KCs + (i1 >> 4) * 272 + (i1 & 15) * 16) = r[1]; \
          *(LAS u32x4*)(QDs + (i0 >> 4) * 272 + (i0 & 15) * 16) = r[2]; *(LAS u32x4*)(QDs + (i1 >> 4) * 272 + (i1 & 15) * 16) = r[3]; \
          *(LAS u32x4*)(QKs + (i0 >> 3) * 144 + (i0 & 7) * 16) = r[4]; \
          *(LAS u32x4*)(KDTs + (i0 >> 3) * 144 + (i0 & 7) * 16) = r[5]; *(LAS u32x4*)(KDTs + (i1 >> 3) * 144 + (i1 & 7) * 16) = r[6]; \
          *(LAS u32x4*)(Ws + (i0 >> 3) * 144 + (i0 & 7) * 16) = r[7]; *(LAS u32x4*)(Ws + (i1 >> 3) * 144 + (i1 & 7) * 16) = r[8]; } while (0)
#define DS_STAGEG(tidv) do { const int i0 = (tidv), i1 = (tidv) + 512; \
          *(LAS u32x4*)(GSs + (i0 >> 4) * 272 + (i0 & 15) * 16) = rg[0]; *(LAS u32x4*)(GSs + (i1 >> 4) * 272 + (i1 & 15) * 16) = rg[1]; } while (0)
#pragma unroll 1
    for (int n = 0; n < 32; ++n) {
        int tid = tid_in; asm volatile("" : "+v"(tid));
        const bool bstart = (SUB > 0) ? (n % SUB == 0) : (n == 0);
        const bool bnext1 = (SUB > 0) && ((n + 1) % SUB == 0), bnext2 = (SUB > 0) && ((n + 2) % SUB == 0);
        if (bstart) { if (n > 0) xcd_barrier(xb);
            gl_all = DGL[bh * 32 + (tid & 31)];
            const unsigned t0 = (unsigned)tid * 16u; DS_LOAD(bh * 32 + n, t0); DS_LOADG(bh * 32 + n, t0); DS_STAGE(tid); DS_STAGEG(tid);
            if (n + 1 < 32 && !bnext1) { DS_LOAD(bh * 32 + n + 1, t0); DS_LOADG(bh * 32 + n + 1, t0); }
            __syncthreads(); }
        else { DS_STAGEG(tid);
            if (n + 1 < 32 && !bnext1) DS_LOADG(bh * 32 + n + 1, (unsigned)tid * 16u); }
        const int lane = tid & 63, fr = lane & 15, quad = lane >> 4, vcol = 16 * wave + fr;
        const unsigned toff = (unsigned)tid * 16u;
        const int it = bh * 32 + n, tokb = b * SEQ + n * 64;
        const float glast = __builtin_bit_cast(float, __builtin_amdgcn_readlane(__builtin_bit_cast(int, gl_all), n));
        asm volatile("s_nop 7\n\ts_nop 7" ::: "memory");
#pragma unroll
        for (int mt = 0; mt < 8; ++mt) { u32x2 p; p.x = pg8::cvt_pk_bf16(S[mt][0], S[mt][1]); p.y = pg8::cvt_pk_bf16(S[mt][2], S[mt][3]); *(LAS u32x2*)(SS + fr * 272 + (mt * 16 + quad * 4) * 2) = p; }
        LDS_FENCE();
        bf16x8 Sb[4];
#pragma unroll
        for (int kk = 0; kk < 4; ++kk) Sb[kk] = *(LAS bf16x8*)(SS + fr * 272 + (kk * 32 + quad * 8) * 2);
        f32x4 U[4], O[4];
#pragma unroll
        for (int mt = 0; mt < 4; ++mt) { f32x4 au, ao = {0.f, 0.f, 0.f, 0.f};
            { const u32x2 wq = *(LAS u32x2*)(Ws + vcol * 144 + (mt * 16 + quad * 4) * 2);
              au[0] = __uint_as_float(wq.x << 16); au[1] = __uint_as_float(wq.x & 0xffff0000u); au[2] = __uint_as_float(wq.y << 16); au[3] = __uint_as_float(wq.y & 0xffff0000u); }
#pragma unroll
            for (int kk = 0; kk < 4; ++kk) { const bf16x8 a1 = *(LAS bf16x8*)(KCs + (mt * 16 + fr) * 272 + (kk * 32 + quad * 8) * 2); au = mfma16(a1, Sb[kk], au);
                const bf16x8 a2 = *(LAS bf16x8*)(QDs + (mt * 16 + fr) * 272 + (kk * 32 + quad * 8) * 2); ao = mfma16(a2, Sb[kk], ao); }
            U[mt] = au; O[mt] = ao; __builtin_amdgcn_sched_barrier(0); }
        asm volatile("s_nop 7\n\ts_nop 7" ::: "memory");
#pragma unroll
        for (int mt = 0; mt < 4; ++mt) { u32x2 p; p.x = pg8::cvt_pk_bf16(U[mt][0], U[mt][1]); p.y = pg8::cvt_pk_bf16(U[mt][2], U[mt][3]); *(LAS u32x2*)(US + fr * 144 + (mt * 16 + quad * 4) * 2) = p; }
        LDS_FENCE();
        bf16x8 Ub[2];
#pragma unroll
        for (int kk = 0; kk < 2; ++kk) Ub[kk] = *(LAS bf16x8*)(US + fr * 144 + (kk * 32 + quad * 8) * 2);
#pragma unroll
        for (int mt = 0; mt < 4; ++mt)
#pragma unroll
            for (int kk = 0; kk < 2; ++kk) { const bf16x8 a = *(LAS bf16x8*)(QKs + (mt * 16 + fr) * 144 + (kk * 32 + quad * 8) * 2); O[mt] = mfma16(a, Ub[kk], O[mt]); }
        __builtin_amdgcn_sched_barrier(0);
#pragma unroll
        for (int mt = 0; mt < 8; ++mt) { S[mt] *= glast;
#pragma unroll
            for (int kk = 0; kk < 2; ++kk) { const bf16x8 a = *(LAS bf16x8*)(KDTs + (mt * 16 + fr) * 144 + (kk * 32 + quad * 8) * 2); S[mt] = mfma16(a, Ub[kk], S[mt]); }
            if (mt & 1) __builtin_amdgcn_sched_barrier(0); }
        { float pp[16];
#pragma unroll
          for (int e = 0; e < 16; ++e) pp[e] = O[e >> 2][e & 3] * O[e >> 2][e & 3];
#pragma unroll
          for (int e = 0; e < 16; ++e) pp[e] = row_sum16(pp[e]);
          if (fr == 0) {
#pragma unroll
              for (int e = 0; e < 16; ++e) PART[((e >> 2) * 16 + quad * 4 + (e & 3)) * 8 + wave] = pp[e]; } }
        __syncthreads();
        if (n + 1 < 32 && !bnext1) { DS_STAGE(tid); if (n + 2 < 32 && !bnext2) DS_LOAD(it + 2, toff); }
        bf16_t* mixb = (bf16_t*)(A.ws + WS_MIX) + (size_t)tokb * D + h * 128;
#pragma unroll
        for (int mt = 0; mt < 4; ++mt)
#pragma unroll
            for (int i = 0; i < 4; ++i) { const int t = mt * 16 + quad * 4 + i;
                const f32x4 p0 = *(LAS f32x4*)(PART + t * 8), p1 = *(LAS f32x4*)(PART + t * 8 + 4);
                const float tot = ((p0[0] + p0[1]) + (p0[2] + p0[3])) + ((p1[0] + p1[1]) + (p1[2] + p1[3]));
                const float sc = rsqrtf(tot * (1.f / 128.f) + EPS);
                const float gs = bf2f(*(LAS bf16_t*)(GSs + t * 272 + vcol * 2));
                mixb[(unsigned)(t * D + vcol)] = (bf16_t)(pg8::cvt_pk_bf16(O[mt][i] * sc * gs, 0.f) & 0xffffu); }
        __syncthreads();
    }
#undef DS_STAGE
#undef DS_LOADG
#undef DS_STAGEG
#undef DS_LOAD
    { const int lane = lane_in, fr = lane & 15, quad = lane >> 4, vcol = 16 * wave + fr;
      float* dp = A.out + O_DP + (size_t)((l * 8 + b) * 4 + h) * 16384;
#pragma unroll
      for (int mt = 0; mt < 8; ++mt)
#pragma unroll
          for (int i = 0; i < 4; ++i) dp[(mt * 16 + quad * 4 + i) * 128 + vcol] = S[mt][i]; }
    __syncthreads();
}

__device__ __forceinline__ void delta_sample_item(const DevArgs& A, int l, LAS unsigned char* lds, int item, int tid, int wave, int lane) {
    asm volatile("" : "+v"(tid)); lane = tid & 63; wave = __builtin_amdgcn_readfirstlane(tid >> 6);
    const int b = item >> 2, h = item & 3, tokS = NP + b * 4;
    LAS float* RAW = (LAS float*)lds; LAS float* RED = RAW + 1536; LAS float* OB = RED + 512; LAS float* SC = OB + 512;
    const bf16_t* PROJ = (const bf16_t*)(A.ws + WS_PROJ); const float* AB = (const float*)(A.ws + WS_AB); bf16_t* MIX = (bf16_t*)(A.ws + WS_MIX);
    const float* cw = A.in[I_CONVW] + (size_t)l * 4 * 1536;
    for (int idx = tid; idx < 1536; idx += 512) { const int part = idx >> 9, t = (idx >> 7) & 3, c = idx & 127, col = part * 512 + h * 128 + c;
        float acc = 0.f;
#pragma unroll
        for (int j = 0; j < 4; ++j) { const int tt = t - 3 + j;
            const float x = (tt >= 0) ? bf2f(PROJ[(size_t)(tokS + tt) * NPROJ + col]) : A.in[I_SCONV][((size_t)(l * 128 + b) * 3 + (3 + tt)) * 1536 + col];
            acc += cw[j * 1536 + col] * x; }
        RAW[idx] = silu_f(acc); }
    if (tid < 4) { const float a = AB[(size_t)(tokS + tid) * 8 + h], bb = AB[(size_t)(tokS + tid) * 8 + 4 + h];
        const float xx = a + A.in[I_DTB][l * 4 + h]; const float sp = xx > 20.f ? xx : log1pf(expf(xx));
        SC[8 + tid] = 1.f / (1.f + expf(-bb)); SC[12 + tid] = expf(-expf(A.in[I_ALOG][l * 4 + h]) * sp); }
    const int v = tid & 127, kq = tid >> 7;
    float S[32];
    { const float* sp = A.in[I_SDELTA] + (size_t)((l * 128 + b) * 4 + h) * 16384;
#pragma unroll
      for (int i = 0; i < 32; ++i) S[i] = sp[(kq * 32 + i) * 128 + v]; }
    __syncthreads();
    { const int part = wave >> 2, t = wave & 3; const float x0 = RAW[part * 512 + t * 128 + lane], x1 = RAW[part * 512 + t * 128 + 64 + lane];
      const float ss = wave_sum(x0 * x0 + x1 * x1); if (lane == 0) SC[part * 4 + t] = rsqrtf(ss + EPS) * (part == 0 ? 0.08838834764831845f : 1.f); }
    __syncthreads();
    for (int t = 0; t < 4; ++t) {
        const float rq = SC[t], rk = SC[4 + t], beta = SC[8 + t], g = SC[12 + t];
        float pr = 0.f;
#pragma unroll
        for (int i = 0; i < 32; ++i) pr += S[i] * RAW[512 + t * 128 + kq * 32 + i];
        RED[kq * 128 + v] = pr * rk;
        __syncthreads();
        const float rr = (RED[v] + RED[128 + v]) + (RED[256 + v] + RED[384 + v]);
        const float u = beta * (RAW[1024 + t * 128 + v] - g * rr);
        float po = 0.f;
#pragma unroll
        for (int i = 0; i < 32; ++i) { const float kh = RAW[512 + t * 128 + kq * 32 + i] * rk; S[i] = g * S[i] + kh * u; po += S[i] * RAW[t * 128 + kq * 32 + i]; }
        __syncthreads();
        RED[kq * 128 + v] = po * rq;
        __syncthreads();
        if (kq == 0) OB[t * 128 + v] = (RED[v] + RED[128 + v]) + (RED[256 + v] + RED[384 + v]);
        __syncthreads();
    }
    if (wave < 4) { const int t = wave; const float x0 = OB[t * 128 + lane], x1 = OB[t * 128 + 64 + lane];
        const float ss = wave_sum(x0 * x0 + x1 * x1); const float sc = rsqrtf(ss * (1.f / 128.f) + EPS);
        const float g0 = bf2f(PROJ[(size_t)(tokS + t) * NPROJ + PC_G + h * 128 + lane]), g1 = bf2f(PROJ[(size_t)(tokS + t) * NPROJ + PC_G + h * 128 + 64 + lane]);
        MIX[(size_t)(tokS + t) * D + h * 128 + lane] = (bf16_t)f2bf(x0 * sc * A.in[I_ONORM][l * 128 + lane] * silu_f(g0));
        MIX[(size_t)(tokS + t) * D + h * 128 + 64 + lane] = (bf16_t)f2bf(x1 * sc * A.in[I_ONORM][l * 128 + 64 + lane] * silu_f(g1)); }
    { float* dsp = A.out + O_DS + (size_t)((l * 128 + b) * 4 + h) * 16384;
#pragma unroll
      for (int i = 0; i < 32; ++i) dsp[(kq * 32 + i) * 128 + v] = S[i]; }
    __syncthreads();
}

#define SSM_BCAST_U(t) do { unsigned _w[8]; \
        _w[0] = __builtin_amdgcn_readlane(ua.x, t); _w[1] = __builtin_amdgcn_readlane(ua.y, t); _w[2] = __builtin_amdgcn_readlane(ua.z, t); _w[3] = __builtin_amdgcn_readlane(ua.w, t); \
        _w[4] = __builtin_amdgcn_readlane(ub.x, t); _w[5] = __builtin_amdgcn_readlane(ub.y, t); _w[6] = __builtin_amdgcn_readlane(ub.z, t); _w[7] = __builtin_amdgcn_readlane(ub.w, t); \
        _Pragma("unroll") for (int _d = 0; _d < 8; ++_d) { uu[2 * _d] = __uint_as_float(_w[_d] << 16); uu[2 * _d + 1] = __uint_as_float(_w[_d] & 0xffff0000u); } } while (0)
#define SSM_STEP() do { float _br = 0.f, _bi = 0.f; \
        _Pragma("unroll") for (int _h = 0; _h < 16; ++_h) { _br = fmaf(Br[_h], uu[_h], _br); _bi = fmaf(Bi[_h], uu[_h], _bi); } \
        const float _nr = lr * hr - li * hi + _br, _ni = lr * hi + li * hr + _bi; hr = _nr; hi = _ni; } while (0)

__device__ __forceinline__ void ssm_part1_item(const DevArgs& A, int l, int it, int lane) {
    const int g = it & 15, bc = it >> 4, b = bc / 31, c = bc % 31;
    const float* bb = (const float*)(A.ws + WS_BBAR) + ((size_t)(l * 16 + g) * 64 + lane) * 32;
    float Br[16], Bi[16];
#pragma unroll
    for (int q = 0; q < 4; ++q) { const f32x4 x = ((const f32x4*)bb)[q], y = ((const f32x4*)bb)[4 + q];
        Br[4 * q] = x.x; Br[4 * q + 1] = x.y; Br[4 * q + 2] = x.z; Br[4 * q + 3] = x.w; Bi[4 * q] = y.x; Bi[4 * q + 1] = y.y; Bi[4 * q + 2] = y.z; Bi[4 * q + 3] = y.w; }
    const f32x4 lk = ((const f32x4*)(A.ws + WS_SSMK))[(l * 16 + g) * 64 + lane]; const float lr = lk.x, li = lk.y;
    const bf16_t* up = (const bf16_t*)(A.ws + WS_PROJ) + (size_t)(b * SEQ + c * 64 + lane) * NPROJ + PC_SSM + g * 16;
    const u32x4 ua = *(const u32x4*)up, ub = *(const u32x4*)(up + 8);
    float hr = 0.f, hi = 0.f, uu[16];
#pragma unroll 1
    for (int t = 0; t < 64; ++t) { SSM_BCAST_U(t); SSM_STEP(); }
    f32x2 e; e.x = hr; e.y = hi;
    ((f32x2*)(A.ws + WS_SSME))[((size_t)(b * 32 + c) * 16 + g) * 64 + lane] = e;
}

__device__ __forceinline__ void ssm_part2_item(const DevArgs& A, int l, LAS unsigned char* lds, int it, int tid, int wave, int lane) {
    asm volatile("" : "+v"(tid)); lane = tid & 63; wave = __builtin_amdgcn_readfirstlane(tid >> 6);
    const int tok0 = it * 64, fr = lane & 15, quad = lane >> 4;
    const bool samp = it >= 256; const int b = it >> 5, c = it & 31;
    LAS unsigned char* YS = lds; LAS unsigned char* HS = lds + 33792 + wave * 4352;
    const bf16_t* PROJ = (const bf16_t*)(A.ws + WS_PROJ); bf16_t* MIX = (bf16_t*)(A.ws + WS_MIX);
#pragma unroll 1
    for (int gi = 0; gi < 2; ++gi) {
        const int g = wave * 2 + gi;
        const float* bb = (const float*)(A.ws + WS_BBAR) + ((size_t)(l * 16 + g) * 64 + lane) * 32;
        float Br[16], Bi[16];
#pragma unroll
        for (int q = 0; q < 4; ++q) { const f32x4 x = ((const f32x4*)bb)[q], y = ((const f32x4*)bb)[4 + q];
            Br[4 * q] = x.x; Br[4 * q + 1] = x.y; Br[4 * q + 2] = x.z; Br[4 * q + 3] = x.w; Bi[4 * q] = y.x; Bi[4 * q + 1] = y.y; Bi[4 * q + 2] = y.z; Bi[4 * q + 3] = y.w; }
        const f32x4 lk = ((const f32x4*)(A.ws + WS_SSMK))[(l * 16 + g) * 64 + lane]; const float lr = lk.x, li = lk.y, Lr = lk.z, Li = lk.w;
        bf16x8 Cb[4];
#pragma unroll
        for (int kk = 0; kk < 4; ++kk) { const size_t co = ((size_t)(l * 16 + g) * 16 + fr) * 64 + kk * 16 + quad * 4;
            const f32x4 cr = *(const f32x4*)(A.in[I_CRE] + co), ci = *(const f32x4*)(A.in[I_CIM] + co);
            u32x4 pk; pk.x = pk2(cr.x, -ci.x); pk.y = pk2(cr.y, -ci.y); pk.z = pk2(cr.z, -ci.z); pk.w = pk2(cr.w, -ci.w);
            Cb[kk] = __builtin_bit_cast(bf16x8, pk); }
        const bf16_t* up = PROJ + (size_t)(tok0 + lane) * NPROJ + PC_SSM + g * 16;
        const u32x4 ua = *(const u32x4*)up, ub = *(const u32x4*)(up + 8);
        float hr = 0.f, hi = 0.f, uu[16];
        if (!samp && c > 0) { const f32x2* E = (const f32x2*)(A.ws + WS_SSME) + ((size_t)(b * 32) * 16 + g) * 64 + lane;
#pragma unroll
            for (int cb = 0; cb < 32; cb += 16) { f32x2 ev[16];
#pragma unroll
                for (int q = 0; q < 16; ++q) { const int cc = cb + q; ev[q] = (cc < c) ? E[(size_t)cc * 1024] : (f32x2){0.f, 0.f}; }
#pragma unroll
                for (int q = 0; q < 16; ++q) { const int cc = cb + q; if (cc < c) { const float nr = Lr * hr - Li * hi + ev[q].x, ni = Lr * hi + Li * hr + ev[q].y; hr = nr; hi = ni; } } } }
        const float dsk = A.in[I_SSMD][l * 256 + g * 16 + fr];
#pragma unroll 1
        for (int sub = 0; sub < 4; ++sub) {
#pragma unroll 1
            for (int tt = 0; tt < 16; ++tt) { const int t = sub * 16 + tt;
                const int sb = (it - 256) * 16 + (t >> 2);
                if (samp && (t & 3) == 0) { hr = A.in[I_SRE][((size_t)(l * 128 + sb) * 16 + g) * 64 + lane]; hi = A.in[I_SIM][((size_t)(l * 128 + sb) * 16 + g) * 64 + lane]; }
                SSM_BCAST_U(t); SSM_STEP();
                *(LAS unsigned*)(HS + tt * 272 + lane * 4) = pg8::cvt_pk_bf16(hr, hi);
                if (samp && (t & 3) == 3) { A.out[O_RES + ((size_t)(l * 128 + sb) * 16 + g) * 64 + lane] = hr; A.out[O_IMS + ((size_t)(l * 128 + sb) * 16 + g) * 64 + lane] = hi; }
            }
            LDS_FENCE();
            f32x4 acc = {0.f, 0.f, 0.f, 0.f};
#pragma unroll
            for (int kk = 0; kk < 4; ++kk) { const bf16x8 a = *(LAS bf16x8*)(HS + fr * 272 + (kk * 32 + quad * 8) * 2); acc = mfma16(a, Cb[kk], acc); }
#pragma unroll
            for (int i = 0; i < 4; ++i) { const int t = sub * 16 + quad * 4 + i; const float uv = bf2f(PROJ[(size_t)(tok0 + t) * NPROJ + PC_SSM + g * 16 + fr]);
                *(LAS bf16_t*)(YS + t * 528 + (g * 16 + fr) * 2) = (bf16_t)f2bf(gelu_tanh_f(acc[i] + dsk * uv)); }
            LDS_FENCE();
        }
        if (!samp && c == 31) { A.out[O_REP + ((size_t)(l * 8 + b) * 16 + g) * 64 + lane] = hr; A.out[O_IMP + ((size_t)(l * 8 + b) * 16 + g) * 64 + lane] = hi; }
    }
    __syncthreads();
    {
        const bf16_t* GT = (const bf16_t*)(A.ws + WS_GLUT + l * SZ_GLUT);
        f32x4 acc[4][2];
#pragma unroll
        for (int mt = 0; mt < 4; ++mt) { acc[mt][0] = (f32x4){0.f, 0.f, 0.f, 0.f}; acc[mt][1] = (f32x4){0.f, 0.f, 0.f, 0.f}; }
#pragma unroll
        for (int kk = 0; kk < 8; ++kk) { bf16x8 bfr[2];
#pragma unroll
            for (int nt = 0; nt < 2; ++nt) bfr[nt] = *(const bf16x8*)(GT + (size_t)(32 * wave + nt * 16 + fr) * 256 + kk * 32 + quad * 8);
#pragma unroll
            for (int mt = 0; mt < 4; ++mt) { const bf16x8 a = *(LAS bf16x8*)(YS + (mt * 16 + fr) * 528 + (kk * 32 + quad * 8) * 2);
                acc[mt][0] = mfma16(a, bfr[0], acc[mt][0]); acc[mt][1] = mfma16(a, bfr[1], acc[mt][1]); } }
#pragma unroll
        for (int nt = 0; nt < 2; ++nt) { const int ncol = 32 * wave + nt * 16 + fr; const float gb = A.in[I_GLUB][l * 256 + ncol];
#pragma unroll
            for (int mt = 0; mt < 4; ++mt)
#pragma unroll
                for (int i = 0; i < 4; ++i) { const int t = mt * 16 + quad * 4 + i; const float y = bf2f(*(LAS bf16_t*)(YS + t * 528 + ncol * 2));
                    MIX[(size_t)(tok0 + t) * D + 512 + ncol] = (bf16_t)f2bf(y * sigmoid_f(acc[mt][nt][i] + gb)); } }
    }
    __syncthreads();
}

__device__ __forceinline__ void pool_item(const DevArgs& A, int l, LAS unsigned char* lds, int it, int tid, int wave, int lane) {
    asm volatile("" : "+v"(tid)); lane = tid & 63; wave = __builtin_amdgcn_readfirstlane(tid >> 6);
    const int tok0 = it * 64, fr = lane & 15, quad = lane >> 4; const bool samp = it >= 256;
    LAS unsigned char* RS = lds;
    const bf16_t* PROJ = (const bf16_t*)(A.ws + WS_PROJ); bf16_t* MIX = (bf16_t*)(A.ws + WS_MIX);
    if (!samp) {
        LAS unsigned char* XT = lds + 33792;
        const int b = it >> 5, c = it & 31;
        for (int id = tid; id < 79 * 32; id += 512) { const int r = id >> 5, c16 = id & 31, tl = c * 64 - 15 + r;
            u32x4 v = {0u, 0u, 0u, 0u}; if (tl >= 0) v = *(const u32x4*)(PROJ + (size_t)(b * SEQ + tl) * NPROJ + PC_POOL + c16 * 8);
            *(LAS u32x4*)(XT + r * 528 + c16 * 16) = v; }
        __syncthreads();
        const int ch = tid & 255, half = tid >> 8, g = ch >> 6, w = 2 << g, r0 = half * 32;
        float sum = 0.f;
        for (int j = 0; j < w; ++j) sum += bf2f(*(LAS bf16_t*)(XT + (r0 + 15 - j) * 528 + ch * 2));
#pragma unroll 4
        for (int rr = 0; rr < 32; ++rr) { const int r = r0 + rr, tl = c * 64 + r;
            const float u = bf2f(*(LAS bf16_t*)(XT + (r + 15) * 528 + ch * 2));
            if (rr > 0) sum += u - bf2f(*(LAS bf16_t*)(XT + (r + 15 - w) * 528 + ch * 2));
            const float cnt = (float)((tl + 1 < w) ? tl + 1 : w);
            *(LAS bf16_t*)(RS + r * 528 + ch * 2) = (bf16_t)f2bf(sum / cnt - u); }
    } else {
#pragma unroll 1
        for (int pr = 0; pr < 8; ++pr) { const int idx = pr * 512 + tid, ch = idx & 255, sq = idx >> 8, g = ch >> 6, w = 2 << g;
            const int sb = (it - 256) * 16 + sq;
            const float* sbuf = A.in[I_SPOOL] + (size_t)(l * 128 + sb) * 15 * 256 + ch;
            const bf16_t* base = PROJ + (size_t)(NP + sb * 4) * NPROJ + PC_POOL + ch;
            float e[19];
#pragma unroll
            for (int j = 0; j < 15; ++j) e[j] = sbuf[j * 256];
#pragma unroll
            for (int j = 0; j < 4; ++j) e[15 + j] = bf2f(base[(size_t)j * NPROJ]);
#pragma unroll
            for (int t = 0; t < 4; ++t) { float sum = 0.f;
#pragma unroll
                for (int j = 0; j < 16; ++j) sum += (j < w) ? e[15 + t - j] : 0.f;
                *(LAS bf16_t*)(RS + (sq * 4 + t) * 528 + ch * 2) = (bf16_t)f2bf(sum / (float)w - e[15 + t]); } }
    }
    __syncthreads();
    { const int g2 = wave >> 1; const bf16_t* PT = (const bf16_t*)(A.ws + WS_POOLT + l * SZ_POOLT) + g2 * 4096;
      f32x4 acc[4][2];
#pragma unroll
      for (int mt = 0; mt < 4; ++mt) { acc[mt][0] = (f32x4){0.f, 0.f, 0.f, 0.f}; acc[mt][1] = (f32x4){0.f, 0.f, 0.f, 0.f}; }
#pragma unroll
      for (int kk = 0; kk < 2; ++kk) { bf16x8 bfr[2];
#pragma unroll
          for (int nt = 0; nt < 2; ++nt) bfr[nt] = *(const bf16x8*)(PT + (size_t)((wave & 1) * 32 + nt * 16 + fr) * 64 + kk * 32 + quad * 8);
#pragma unroll
          for (int mt = 0; mt < 4; ++mt) { const bf16x8 a = *(LAS bf16x8*)(RS + (mt * 16 + fr) * 528 + (g2 * 64 + kk * 32 + quad * 8) * 2);
              acc[mt][0] = mfma16(a, bfr[0], acc[mt][0]); acc[mt][1] = mfma16(a, bfr[1], acc[mt][1]); } }
#pragma unroll
      for (int nt = 0; nt < 2; ++nt) { const int col = 32 * wave + nt * 16 + fr; const float ps = A.in[I_POOLS][l * 256 + col];
#pragma unroll
          for (int mt = 0; mt < 4; ++mt)
#pragma unroll
              for (int i = 0; i < 4; ++i) { const int t = mt * 16 + quad * 4 + i; MIX[(size_t)(tok0 + t) * D + 768 + col] = (bf16_t)f2bf(acc[mt][nt][i] * ps); } } }
    __syncthreads();
}

__device__ __forceinline__ void state_copies(const DevArgs& A, int l, int gt, int NT) {
    const bf16_t* PROJ = (const bf16_t*)(A.ws + WS_PROJ);
#pragma unroll 1
    for (int i = gt; i < 8 * 3 * 1536; i += NT) { const int col = i % 1536, j = (i / 1536) % 3, b = i / 4608;
        A.out[O_CP + (size_t)l * 8 * 4608 + i] = bf2f(PROJ[(size_t)(b * SEQ + SEQ - 3 + j) * NPROJ + col]); }
#pragma unroll 1
    for (int i = gt; i < 128 * 3 * 1536; i += NT) { const int col = i % 1536, j = (i / 1536) % 3, b = i / 4608;
        A.out[O_CS + (size_t)l * 128 * 4608 + i] = bf2f(PROJ[(size_t)(NP + b * 4 + 1 + j) * NPROJ + col]); }
#pragma unroll 1
    for (int i = gt; i < 8 * 15 * 256; i += NT) { const int ch = i & 255, j = (i >> 8) % 15, b = i / 3840;
        A.out[O_PP + (size_t)l * 8 * 3840 + i] = bf2f(PROJ[(size_t)(b * SEQ + SEQ - 15 + j) * NPROJ + PC_POOL + ch]); }
#pragma unroll 1
    for (int i = gt; i < 128 * 15 * 256; i += NT) { const int ch = i & 255, j = (i >> 8) % 15, b = i / 3840;
        A.out[O_PS + (size_t)l * 128 * 3840 + i] = (j < 11) ? A.in[I_SPOOL][((size_t)(l * 128 + b) * 15 + 4 + j) * 256 + ch]
                                                             : bf2f(PROJ[(size_t)(NP + b * 4 + (j - 11)) * NPROJ + PC_POOL + ch]); }
}

#ifndef REP_DPREP
#define REP_DPREP 1
#endif
#ifndef REP_DSAMP
#define REP_DSAMP 1
#endif
#ifndef REP_SSM1
#define REP_SSM1 1
#endif
#ifndef REP_POOL
#define REP_POOL 1
#endif
#ifndef REP_DSCAN
#define REP_DSCAN 1
#endif
#ifndef REP_SSM2
#define REP_SSM2 1
#endif
#ifndef REP_G
#define REP_G 1
#endif
#ifndef REP_P3
#define REP_P3 1
#endif
#ifndef REP_P2
#define REP_P2 1
#endif
constexpr int NPH = 2 + DEPTH * 8;
__global__ void __launch_bounds__(512, 2) mega_fwd(Args KA) {
    DevArgs A; A.out = KA.out; A.ws = KA.ws; A.ph_lo = KA.ph_lo; A.ph_hi = KA.ph_hi;
    extern __shared__ __attribute__((aligned(16))) unsigned char lds_raw[];
    LAS unsigned char* lds = (LAS unsigned char*)lds_raw;
    cg::grid_group grid = cg::this_grid();
    volatile LAS unsigned* xst = (volatile LAS unsigned*)(lds + LDS_BYTES - 64);
    if (threadIdx.x == 0) { xst[0] = 0u; xst[1] = 0u; }
    __syncthreads();
    const XcdBarrier xb = xcd_barrier_post((unsigned*)(KA.ws + WS_BAR), xst);
    constexpr int G = 256, NGW = G * 8, NT = G * 512;
    int ph = 0;
#define PH_BEGIN if (A.ph_lo <= ph && ph < A.ph_hi) { int tid = threadIdx.x; asm volatile("" : "+v"(tid)); { unsigned char* _w = A.ws; asm volatile("" : "+s"(_w)); A.ws = _w; float* _o = A.out; asm volatile("" : "+s"(_o)); A.out = _o; } const int wave = __builtin_amdgcn_readfirstlane(tid >> 6), lane = tid & 63, gw = blockIdx.x * 8 + wave, gt = blockIdx.x * 512 + tid; (void)gw; (void)gt; (void)lane;
#define PH_END   if (ph + 1 < A.ph_hi) { if (ph == 0) grid.sync(); else xcd_barrier(xb); } } ++ph;
#define Hb   ((bf16_t*)(A.ws + WS_H))
#define AB   ((float*)(A.ws + WS_AB))
#define MIXO ((float*)(A.ws + WS_MIXO))
#define PROJ ((bf16_t*)(A.ws + WS_PROJ))
#define MIX  ((bf16_t*)(A.ws + WS_MIX))
#define HID  ((bf16_t*)(A.ws + WS_HID))

#ifndef REP_PRO
#define REP_PRO 1
#endif
#ifndef REP_N0
#define REP_N0 1
#endif
    PH_BEGIN for (int rep = 0; rep < REP_PRO; ++rep) { prologue(A, lds, wave, lane, gw, NGW); __syncthreads(); } PH_END
    PH_BEGIN for (int rep = 0; rep < REP_N0; ++rep) norm_rows(nullptr, nullptr, A.in[I_XP], A.in[I_XS], nullptr, A.in[I_NMPRE], Hb, (const float*)(A.ws + WS_WAB), AB, gw, NGW, lane); PH_END

#pragma unroll 1
    for (int l = 0; l < DEPTH; ++l) {
        PH_BEGIN for (int rep = 0; rep < REP_G; ++rep) { pg8::Gemm g{Hb, (const bf16_t*)(A.ws + WS_WIN + l * SZ_WIN), NTOK, NPROJ, D, D, D}; pg8::StaticOrder S; S.init(NTOK, NPROJ, G, (int)blockIdx.x);
            pg8::EpiBf16<0> E{PROJ, NPROJ, nullptr, 0, 0}; pg8::gemm_phase<pg8::EpiBf16<0>, pg8::StaticOrder>(lds, g, S, E, nullptr); } PH_END
        constexpr int SUBC = 7;
        PH_BEGIN {
#pragma unroll 1
          for (int rep2 = 0; rep2 < REP_P2; ++rep2) {
#pragma unroll 1
            for (int j = blockIdx.x; j < 32 * SUBC; j += G) delta_prep_item(A, l, lds, (j & 31) * 32 + (j >> 5), tid, wave, lane);
          }
        } PH_END
        PH_BEGIN {
#pragma unroll 1
            for (int rep3 = 0; rep3 < REP_P3; ++rep3) {
                if (blockIdx.x < 32) delta_scan_item(A, l, lds, blockIdx.x, tid, wave, lane, xb, SUBC);
                else { const int w = blockIdx.x - 32; constexpr int NW = G - 32;
#pragma unroll 1
                    for (int k = 1; k <= 5; ++k) {
                        const int n0 = k * SUBC, nn = (n0 >= 32) ? 0 : ((32 - n0 < SUBC) ? 32 - n0 : SUBC);
                        int nprep = 32 * nn;
#ifndef REP_WPREP
#define REP_WPREP 1
#endif
#pragma unroll 1
                        for (int rep = 0; rep < REP_WPREP; ++rep)
#pragma unroll 1
                        for (int j = w; j < nprep; j += NW) delta_prep_item(A, l, lds, (j & 31) * 32 + n0 + (j >> 5), tid, wave, lane);
                        if (k == 1) {
#pragma unroll 1
                            for (int it = w; it < 512; it += NW) delta_sample_item(A, l, lds, it, tid, wave, lane); }
                        if (k == 2) {
#pragma unroll 1
                            for (int it = w * 8 + wave; it < 8 * 31 * 16; it += NW * 8) { int t1 = threadIdx.x; asm volatile("" : "+v"(t1)); ssm_part1_item(A, l, it, t1 & 63); }
                            { int t2 = threadIdx.x; asm volatile("" : "+v"(t2)); int wl = blockIdx.x; asm volatile("" : "+s"(wl)); state_copies(A, l, (wl - 32) * 512 + t2, NW * 512); } }
                        if (k == 3) {
#pragma unroll 1
                            for (int it = w; it < 264; it += NW) pool_item(A, l, lds, it, tid, wave, lane); }
                        { const int it = (k == 4) ? w - 128 : ((k == 5) ? 96 + w : -1);
                          if (it >= 0 && it < ((k == 4) ? 96 : 264)) ssm_part2_item(A, l, lds, it, tid, wave, lane); }
                        if (k < 5) xcd_barrier(xb);
                    } }
            }
        } PH_END
        PH_BEGIN for (int rep = 0; rep < REP_G; ++rep) { pg8::Gemm g{MIX, (const bf16_t*)(A.ws + WS_WOUT + l * SZ_WOUT), NP, D, D, D, D}; pg8::StaticOrder S; S.init(NP, D, G, (int)blockIdx.x);
            pg8::EpiF32 E{MIXO, D, nullptr}; pg8::gemm_phase<pg8::EpiF32, pg8::StaticOrder>(lds, g, S, E, nullptr);
            pg8::Gemm g2{MIX + (size_t)NP * D, (const bf16_t*)(A.ws + WS_WOUT + l * SZ_WOUT), NS, D, 256, D, D}; SliceOrder S2{8 * (D / 256), G, (int)blockIdx.x};
            EpiF32Part E2{(float*)(A.ws + WS_PARTS)}; pg8::gemm_phase<EpiF32Part, SliceOrder>(lds, g2, S2, E2, nullptr); } PH_END
#ifndef REP_N5
#define REP_N5 1
#endif
        PH_BEGIN for (int rep = 0; rep < (l == 0 ? REP_N5 : 1); ++rep) norm_rows(MIXO, A.in[I_NMPOST] + l * D, l == 0 ? A.in[I_XP] : A.out, l == 0 ? A.in[I_XS] : nullptr, A.out, A.in[I_NFPRE] + l * D, Hb, nullptr, nullptr, gw, NGW, lane, (const float*)(A.ws + WS_PARTS), D / 256); PH_END
        PH_BEGIN for (int rep = 0; rep < REP_G; ++rep) { pg8::Gemm g{Hb, (const bf16_t*)(A.ws + WS_WGU + l * SZ_WGU), NTOK, NGU, D, D, D}; pg8::StaticOrder S; S.init(NTOK, NGU, G, (int)blockIdx.x);
            EpiSwiGLU E{HID, DFF}; pg8::gemm_phase<EpiSwiGLU, pg8::StaticOrder>(lds, g, S, E, nullptr); } PH_END
        PH_BEGIN for (int rep = 0; rep < REP_G; ++rep) { pg8::Gemm g{HID, (const bf16_t*)(A.ws + WS_WDN + l * SZ_WDN), NP, D, DFF, DFF, DFF}; pg8::StaticOrder S; S.init(NP, D, G, (int)blockIdx.x);
            pg8::EpiF32 E{MIXO, D, nullptr}; pg8::gemm_phase<pg8::EpiF32, pg8::StaticOrder>(lds, g, S, E, nullptr);
            pg8::Gemm g2{HID + (size_t)NP * DFF, (const bf16_t*)(A.ws + WS_WDN + l * SZ_WDN), NS, D, 256, DFF, DFF}; SliceOrder S2{8 * (DFF / 256), G, (int)blockIdx.x};
            EpiF32Part E2{(float*)(A.ws + WS_PARTS)}; pg8::gemm_phase<EpiF32Part, SliceOrder>(lds, g2, S2, E2, nullptr); } PH_END
        PH_BEGIN norm_rows(MIXO, A.in[I_NFPOST] + l * D, A.out, nullptr, A.out, l + 1 < DEPTH ? A.in[I_NMPRE] + (l + 1) * D : nullptr, l + 1 < DEPTH ? Hb : nullptr,
                           l + 1 < DEPTH ? (const float*)(A.ws + WS_WAB + (l + 1) * SZ_WAB) : nullptr, AB, gw, NGW, lane, (const float*)(A.ws + WS_PARTS), DFF / 256); PH_END
    }
#undef PH_BEGIN
#undef PH_END
#undef Hb
#undef AB
#undef MIXO
#undef PROJ
#undef MIX
#undef HID
}

extern "C" void kernel_launch(void* const* d_in, const int* in_sizes, int n_in, void* d_out, int out_size, void* d_ws, size_t ws_size, hipStream_t stream) {
    static int grid = 0;
    if (grid == 0) {
        if (n_in != 32 || (size_t)out_size != O_END || ws_size < WS_END) fprintf(stderr, "kernel_launch: unexpected sizes: n_in %d out %d (want %zu) ws %zu (want >= %zu)\n", n_in, out_size, (size_t)O_END, ws_size, (size_t)WS_END);
        int dev = 0, cus = 0, per_cu = 0;
        (void)hipGetDevice(&dev); (void)hipDeviceGetAttribute(&cus, hipDeviceAttributeMultiprocessorCount, dev);
        if (hipFuncSetAttribute((const void*)mega_fwd, hipFuncAttributeMaxDynamicSharedMemorySize, LDS_BYTES) != hipSuccess) fprintf(stderr, "kernel_launch: hipFuncSetAttribute failed\n");
        if (hipOccupancyMaxActiveBlocksPerMultiprocessor(&per_cu, (const void*)mega_fwd, 512, LDS_BYTES) != hipSuccess || per_cu < 1) { fprintf(stderr, "kernel_launch: occupancy query gave %d\n", per_cu); per_cu = 1; (void)hipGetLastError(); }
        grid = cus * per_cu; if (grid <= 0) grid = 256;
        if (grid >= 256) grid = 256;
        fprintf(stderr, "kernel_launch: grid %d (cus %d x %d)%s\n", grid, cus, per_cu, grid < 256 ? "  ERROR: this build needs >= 256 co-resident workgroups" : "");
    }
    (void)hipMemsetAsync((unsigned char*)d_ws + WS_BAR, 0, 16384, stream);
    Args a{};
    for (int i = 0; i < 32; ++i) a.in[i] = (const float*)d_in[i];
    a.out = (float*)d_out; a.ws = (unsigned char*)d_ws;
#if MK_COOP
    a.ph_lo = 0; a.ph_hi = NPH;
    void* args[] = {&a};
    const hipError_t e = hipLaunchCooperativeKernel((const void*)mega_fwd, dim3(grid), dim3(512), args, LDS_BYTES, stream);
    if (e != hipSuccess) fprintf(stderr, "kernel_launch: cooperative launch failed: %s (grid %d)\n", hipGetErrorString(e), grid);
#else
    for (int p = 0; p < NPH; ++p) { a.ph_lo = p; a.ph_hi = p + 1; hipLaunchKernelGGL(mega_fwd, dim3(grid), dim3(512), LDS_BYTES, stream, a); }
#endif
}
```

```cpp
#include <hip/hip_runtime.h>
#include <hip/hip_cooperative_groups.h>
#include <cstdio>
#include <cstdint>
namespace cg = cooperative_groups;
#ifndef MK_COOP
#define MK_COOP 1
#endif
namespace pg8 {
#define PG8_LAS __attribute__((address_space(3)))
typedef unsigned short bf16_t;
typedef short bf16x8 __attribute__((ext_vector_type(8)));
typedef float f32x4 __attribute__((ext_vector_type(4)));
typedef unsigned u32x4 __attribute__((ext_vector_type(4)));
constexpr int BM = 256, BK = 64, HALF = 128, HTB = HALF * BK * 2  , STAGE_BYTES = 8 * HTB, NXCD = 8, WGM = 8;

__host__ __device__ __forceinline__ int lds_byte(int r, int c) { const int st = (r >> 4) * 2 + (c >> 5), rr = r & 15, cc = c & 31, ob = rr * 64 + cc * 2; return st * 1024 + (ob ^ (((ob >> 9) & 1) << 5)); }
__host__ __device__ __forceinline__ void stage_rc(int b, int& R, int& C) { const int st = b / 1024, sb = b % 1024, swz = sb ^ (((sb >> 9) & 1) << 5); R = (st >> 1) * 16 + swz / 64; C = (st & 1) * 32 + (swz % 64) / 2; }
__host__ __device__ __forceinline__ int perm32(int rho) { const int n = rho >> 4, i = rho & 15; return 8 * (i >> 2) + 4 * n + (i & 3); }

struct Unit { int pm, pn, ks; };
struct Gemm { const bf16_t* A; const bf16_t* Bt; int M, N, K, lda, ldb; };

struct StaticOrder {
    int nM, nN, nwg, G, c;
    __host__ __device__ void init(int M, int N, int G_, int c_) { nM = M / BM; nN = N / BM; nwg = nM * nN; G = G_; c = c_; }
    __host__ __device__ bool next(int i, Unit& u) const {
        const long L = (long)i * G + c; if (L >= nwg) return false;
        int wgid = (int)L; { const int q = nwg / NXCD, r = nwg % NXCD, xcd = wgid % NXCD, off = wgid / NXCD; wgid = (xcd < r ? xcd * (q + 1) : r * (q + 1) + (xcd - r) * q) + off; }
        const int nig = WGM * nN, gid = wgid / nig, fm = gid * WGM, gsz = (nM - fm) < WGM ? (nM - fm) : WGM;
        u.pm = fm + ((wgid % nig) % gsz); u.pn = (wgid % nig) / gsz; u.ks = 0; return true;
    }
    __device__ __forceinline__ void a_ready(const Unit&) const {}
    __device__ __forceinline__ void done(const Unit&) const {}
};
__device__ __forceinline__ unsigned cvt_pk_bf16(float lo, float hi) { unsigned r; asm volatile("v_cvt_pk_bf16_f32 %0, %1, %2" : "=v"(r) : "v"(lo), "v"(hi)); return r; }
typedef float f32x2 __attribute__((ext_vector_type(2)));
__device__ __forceinline__ f32x2 gelu_pk(f32x2 v) {
    const f32x2 av = __builtin_elementwise_abs(v), d = av * 0.2316418882f + 1.0f;
    f32x2 t; t.x = __builtin_amdgcn_rcpf(d.x); t.y = __builtin_amdgcn_rcpf(d.y);
    f32x2 q = t * 0.5307027145f + (-0.7265760135f); q = q * t + 0.7107068705f; q = q * t + (-0.142248368f); q = q * t + 0.127414796f; q = q * t;
    const f32x2 s = (v * v) * (-0.72134752044f);
    f32x2 e; e.x = __builtin_amdgcn_exp2f(s.x); e.y = __builtin_amdgcn_exp2f(s.y);
    const f32x2 m = v * (q * e), r = v - m;
    f32x2 o; o.x = v.x < 0.f ? m.x : r.x; o.y = v.y < 0.f ? m.y : r.y; return o;
}

struct EpiF32 {
    static constexpr bool PERM = false, AFTER_DRAIN = false;
    float* C; int ldc; const float* bias;
    __device__ __forceinline__ void operator()(const f32x4 (&acc)[2][2][4][2], const Unit& u, int wr, int wc, int fr, int fq) const {
        const int row0 = u.pm * BM + wr * 64 + fr, col0 = u.pn * BM + wc * 32 + 4 * fq;
        f32x4 bv[2][2];
#pragma unroll
        for (int bj = 0; bj < 2; ++bj)
#pragma unroll
            for (int n = 0; n < 2; ++n) bv[bj][n] = bias ? *(const f32x4*)(bias + col0 + bj * HALF + n * 16) : (f32x4){0.f, 0.f, 0.f, 0.f};
#pragma unroll
        for (int ai = 0; ai < 2; ++ai)
#pragma unroll
            for (int m = 0; m < 4; ++m) { float* rowp = C + (size_t)(row0 + ai * HALF + m * 16) * ldc + col0;
#pragma unroll
                for (int bj = 0; bj < 2; ++bj)
#pragma unroll
                    for (int n = 0; n < 2; ++n) *(f32x4*)(rowp + bj * HALF + n * 16) = acc[ai][bj][m][n] + bv[bj][n]; }
    }
};
template <int ACT  > struct EpiBf16 {
    static constexpr bool PERM = true, AFTER_DRAIN = false;
    bf16_t* O; int ldc; const float* bias; int split_cols; size_t split_stride;
    __device__ __forceinline__ void operator()(const f32x4 (&acc)[2][2][4][2], const Unit& u, int wr, int wc, int fr, int fq) const {
        const int row0 = u.pm * BM + wr * 64 + fr; int colt = u.pn * BM; bf16_t* base = O;
        if (split_cols) { const int t = colt / split_cols; base += (size_t)t * split_stride; colt -= t * split_cols; }
        const int col0 = colt + wc * 32 + 8 * fq, bcol0 = u.pn * BM + wc * 32 + 8 * fq;
        f32x4 bv[2][2];
#pragma unroll
        for (int bj = 0; bj < 2; ++bj)
#pragma unroll
            for (int n = 0; n < 2; ++n) bv[bj][n] = bias ? *(const f32x4*)(bias + bcol0 + bj * HALF + 4 * n) : (f32x4){0.f, 0.f, 0.f, 0.f};
#pragma unroll
        for (int ai = 0; ai < 2; ++ai)
#pragma unroll
            for (int m = 0; m < 4; ++m) { bf16_t* rowp = base + (size_t)(row0 + ai * HALF + m * 16) * ldc + col0;
#pragma unroll
                for (int bj = 0; bj < 2; ++bj) { f32x4 v0 = acc[ai][bj][m][0] + bv[bj][0], v1 = acc[ai][bj][m][1] + bv[bj][1];
                    if (ACT == 1) { f32x2 a = gelu_pk((f32x2){v0[0], v0[1]}), b = gelu_pk((f32x2){v0[2], v0[3]}), c = gelu_pk((f32x2){v1[0], v1[1]}), d = gelu_pk((f32x2){v1[2], v1[3]});
                        v0 = (f32x4){a.x, a.y, b.x, b.y}; v1 = (f32x4){c.x, c.y, d.x, d.y}; }
                    if (ACT == 2) {
#pragma unroll
                        for (int j = 0; j < 4; ++j) { v0[j] = 0.5f * v0[j] * (1.0f + erff(v0[j] * 0.70710678f)); v1[j] = 0.5f * v1[j] * (1.0f + erff(v1[j] * 0.70710678f)); } }
                    u32x4 w; w.x = cvt_pk_bf16(v0[0], v0[1]); w.y = cvt_pk_bf16(v0[2], v0[3]); w.z = cvt_pk_bf16(v1[0], v1[1]); w.w = cvt_pk_bf16(v1[2], v1[3]);
                    *(u32x4*)(rowp + bj * HALF) = w; } }
    }
};
template <class Epi, class Sched, bool STAMP = false>
__device__ __forceinline__ void gemm_phase(PG8_LAS unsigned char* lds, const Gemm g, const Sched& S, const Epi& E, unsigned long long* stamps) {
    int tid_ = threadIdx.x; asm volatile("" : "+v"(tid_));
    const int tid = tid_, wid = __builtin_amdgcn_readfirstlane(tid >> 6), lane = tid & 63, wr = wid >> 2, wc = wid & 3, fr = lane & 15, fq = lane >> 4;
    const int K = g.K, nt = K / BK;
    int ts_lo = 0, ts_hi = 0, nts = 0; const unsigned long long rt_entry = STAMP ? (unsigned long long)wall_clock64() : 0ull;
#define PG8_STAMP() do { if (STAMP && wid == 0 && nts < 64) { const unsigned long long _c = (unsigned long long)clock64(); \
        ts_lo = (lane == nts) ? (int)(unsigned)_c : ts_lo; ts_hi = (lane == nts) ? (int)(unsigned)(_c >> 32) : ts_hi; ++nts; } } while (0)
    PG8_STAMP();
    unsigned voffA[2], voffB[2];
#pragma unroll
    for (int i = 0; i < 2; ++i) { int R, C; stage_rc(tid * 16 + i * 8192, R, C); const int Rb = Epi::PERM ? ((R & ~31) + perm32(R & 31)) : R;
        voffA[i] = (unsigned)(R * g.lda + C) * 2u; voffB[i] = (unsigned)(Rb * g.ldb + C) * 2u; }
    const size_t kstep = (size_t)(BK * 2);
    const size_t hstepA = (size_t)HALF * g.lda * 2, hstepB = (size_t)HALF * g.ldb * 2;
    const size_t tstepA = 2 * hstepA, tstepB = 2 * hstepB, sstep = (size_t)K * 2;
    const unsigned ldsw = (unsigned)wid * 1024u;
    const int aoff = lds_byte(wr * 64 + fr, fq * 8), boff = lds_byte(wc * 32 + fr, fq * 8);
#define PG8_SA(b, h) (((b) * 2 + (h)) * HTB)
#define PG8_SB(b, h) ((4 + (b) * 2 + (h)) * HTB)
#define PG8_STAGE(bufoff, gbase, voff) do { _Pragma("unroll") for (int _i = 0; _i < 2; ++_i) \
        __builtin_amdgcn_global_load_lds((const unsigned*)((const char*)(gbase) + (voff)[_i]), (PG8_LAS unsigned*)(lds + (bufoff) + ldsw + _i * 8192), 16, 0, 0); } while (0)
#define PG8_LDA(dst, b, h) do { _Pragma("unroll") for (int m = 0; m < 4; ++m) _Pragma("unroll") for (int k = 0; k < 2; ++k) dst[m][k] = *(const PG8_LAS bf16x8*)(lds + PG8_SA(b, h) + aoff + m * 2048 + k * 1024); } while (0)
#define PG8_LDB(dst, b, h) do { _Pragma("unroll") for (int n = 0; n < 2; ++n) _Pragma("unroll") for (int k = 0; k < 2; ++k) dst[n][k] = *(const PG8_LAS bf16x8*)(lds + PG8_SB(b, h) + boff + n * 2048 + k * 1024); } while (0)
#define PG8_MMA(ai, bj, At, Bt) do { __builtin_amdgcn_s_setprio(1); _Pragma("unroll") for (int m = 0; m < 4; ++m) _Pragma("unroll") for (int n = 0; n < 2; ++n) _Pragma("unroll") for (int k = 0; k < 2; ++k) \
        acc[ai][bj][m][n] = __builtin_amdgcn_mfma_f32_16x16x32_bf16(Bt[n][k], At[m][k], acc[ai][bj][m][n], 0, 0, 0); __builtin_amdgcn_s_setprio(0); } while (0)
#define PG8_WAIT_V(n) asm volatile("s_waitcnt vmcnt(" #n ")" ::: "memory")
#define PG8_WAIT_L(n) asm volatile("s_waitcnt lgkmcnt(" #n ")" ::: "memory")
#define PG8_BAR __builtin_amdgcn_s_barrier()
#define PG8_SCHED __builtin_amdgcn_sched_barrier(0)
    Unit cur, nxt; int ui = 0;
    if (!S.next(0, cur)) return;
    f32x4 acc[2][2][4][2];
#pragma unroll
    for (int a = 0; a < 2; ++a)
#pragma unroll
        for (int b = 0; b < 2; ++b)
#pragma unroll
            for (int m = 0; m < 4; ++m)
#pragma unroll
                for (int n = 0; n < 2; ++n) acc[a][b][m][n] = (f32x4){0.f, 0.f, 0.f, 0.f};
    bf16x8 At[4][2], B0[2][2], B1[2][2];
    const char* cA = (const char*)g.A + (size_t)cur.pm * tstepA + (size_t)cur.ks * sstep; const char* cB = (const char*)g.Bt + (size_t)cur.pn * tstepB + (size_t)cur.ks * sstep;
    S.a_ready(cur);
    PG8_STAGE(PG8_SB(0, 0), cB, voffB); PG8_STAGE(PG8_SA(0, 0), cA, voffA); PG8_STAGE(PG8_SB(0, 1), cB + hstepB, voffB); PG8_STAGE(PG8_SA(0, 1), cA + hstepA, voffA);
    if (wr == 1) PG8_BAR;
    PG8_WAIT_V(4); PG8_BAR;
    PG8_STAGE(PG8_SB(1, 0), cB + kstep, voffB); PG8_STAGE(PG8_SA(1, 0), cA + kstep, voffA); PG8_STAGE(PG8_SB(1, 1), cB + hstepB + kstep, voffB);
    PG8_WAIT_V(6); PG8_BAR;
    PG8_STAMP();
    for (;;) {
        const bool has_next = S.next(ui + 1, nxt);
        const char* nA = has_next ? (const char*)g.A + (size_t)nxt.pm * tstepA + (size_t)nxt.ks * sstep : cA; const char* nB = has_next ? (const char*)g.Bt + (size_t)nxt.pn * tstepB + (size_t)nxt.ks * sstep : cB;
        for (int t = 0; t < nt; t += 2) {
            const bool last = (t == nt - 2);
            const char* a1 = cA + (size_t)(t + 1) * kstep;
            const char* a2 = last ? nA : cA + (size_t)(t + 2) * kstep; const char* b2 = last ? nB : cB + (size_t)(t + 2) * kstep;
            const char* a3 = a2 + kstep; const char* b3 = b2 + kstep;
            if (last && has_next) S.a_ready(nxt);
            PG8_LDB(B0, 0, 0); PG8_SCHED; PG8_LDA(At, 0, 0); PG8_STAGE(PG8_SA(1, 1), a1 + hstepA, voffA);
            PG8_WAIT_L(8); PG8_BAR; PG8_WAIT_L(0); PG8_MMA(0, 0, At, B0); PG8_BAR; PG8_SCHED;
            PG8_LDB(B1, 0, 1); PG8_STAGE(PG8_SB(0, 0), b2, voffB);
            PG8_BAR; PG8_WAIT_L(0); PG8_MMA(0, 1, At, B1); PG8_BAR;
            PG8_LDA(At, 0, 1); PG8_STAGE(PG8_SA(0, 0), a2, voffA);
            PG8_BAR; PG8_WAIT_L(0); PG8_MMA(1, 0, At, B0); PG8_BAR; PG8_SCHED;
            PG8_STAGE(PG8_SB(0, 1), b2 + hstepB, voffB);
            PG8_WAIT_V(6); PG8_BAR; PG8_MMA(1, 1, At, B1); PG8_BAR;
            PG8_LDB(B0, 1, 0); PG8_SCHED; PG8_LDA(At, 1, 0); PG8_STAGE(PG8_SA(0, 1), a2 + hstepA, voffA);
            PG8_WAIT_L(8); PG8_BAR; PG8_WAIT_L(0); PG8_MMA(0, 0, At, B0); PG8_BAR; PG8_SCHED;
            PG8_LDB(B1, 1, 1); PG8_STAGE(PG8_SB(1, 0), b3, voffB);
            PG8_BAR; PG8_WAIT_L(0); PG8_MMA(0, 1, At, B1); PG8_BAR;
            PG8_LDA(At, 1, 1); PG8_STAGE(PG8_SA(1, 0), a3, voffA);
            PG8_BAR; PG8_WAIT_L(0); PG8_MMA(1, 0, At, B0); PG8_BAR; PG8_SCHED;
            PG8_STAGE(PG8_SB(1, 1), b3 + hstepB, voffB);
            PG8_WAIT_V(6); PG8_BAR; PG8_MMA(1, 1, At, B1); PG8_BAR;
        }
        PG8_STAMP();
        if constexpr (!Epi::AFTER_DRAIN) { E(acc, cur, wr, wc, fr, fq); S.done(cur); }
        PG8_STAMP();
        if (!has_next) break;
#pragma unroll
        for (int a = 0; a < 2; ++a)
#pragma unroll
            for (int b = 0; b < 2; ++b)
#pragma unroll
                for (int m = 0; m < 4; ++m)
#pragma unroll
                    for (int n = 0; n < 2; ++n) acc[a][b][m][n] = (f32x4){0.f, 0.f, 0.f, 0.f};
        cur = nxt; cA = nA; cB = nB; ++ui;
    }
    PG8_WAIT_V(0);
    if (wr == 0) PG8_BAR;
    PG8_BAR;
    if constexpr (Epi::AFTER_DRAIN) { E.fused(acc, cur, wr, wc, fr, fq, lds, wid, lane); S.done(cur); }
    PG8_STAMP();
    if (STAMP && wid == 0) { stamps[lane] = lane < nts ? (((unsigned long long)(unsigned)ts_hi << 32) | (unsigned)ts_lo) : 0ull;
        if (lane == 62) stamps[62] = rt_entry; if (lane == 63) stamps[63] = (unsigned long long)wall_clock64(); }
#undef PG8_STAMP
#undef PG8_SA
#undef PG8_SB
#undef PG8_STAGE
#undef PG8_LDA
#undef PG8_LDB
#undef PG8_MMA
#undef PG8_WAIT_V
#undef PG8_WAIT_L
#undef PG8_BAR
#undef PG8_SCHED
}
}

#define LAS __attribute__((address_space(3)))
typedef unsigned short bf16_t;
typedef short bf16x8 __attribute__((ext_vector_type(8)));
typedef float f32x4 __attribute__((ext_vector_type(4)));
typedef float f32x2 __attribute__((ext_vector_type(2)));
typedef unsigned u32x4 __attribute__((ext_vector_type(4)));
typedef unsigned u32x2 __attribute__((ext_vector_type(2)));

constexpr int D = 1024, NP = 16384, NS = 512, NTOK = NP + NS, SEQ = 2048, NB = 8, NSB = 128, DEPTH = 4;
constexpr int INW = 2568, NPROJ = 2560, DFF = 2816, NGU = 5632;
constexpr int PC_G = 1536, PC_SSM = 2048, PC_POOL = 2304;
constexpr float EPS = 1e-6f;
constexpr int LDS_BYTES = 163840;

constexpr size_t SZ_WIN = (size_t)NPROJ * D * 2, SZ_WOUT = (size_t)D * D * 2, SZ_WGU = (size_t)NGU * D * 2, SZ_WDN = (size_t)D * DFF * 2;
constexpr size_t SZ_WAB = 8 * D * 4, SZ_GLUT = 256 * 256 * 2, SZ_POOLT = 4 * 64 * 64 * 2, SZ_SSMK = 16 * 64 * 4 * 4, SZ_BBAR = 16 * 64 * 32 * 4;
constexpr size_t WS_WIN = 0;
constexpr size_t WS_WOUT = WS_WIN + DEPTH * SZ_WIN;
constexpr size_t WS_WGU = WS_WOUT + DEPTH * SZ_WOUT;
constexpr size_t WS_WDN = WS_WGU + DEPTH * SZ_WGU;
constexpr size_t WS_WAB = WS_WDN + DEPTH * SZ_WDN;
constexpr size_t WS_GLUT = WS_WAB + DEPTH * SZ_WAB;
constexpr size_t WS_POOLT = WS_GLUT + DEPTH * SZ_GLUT;
constexpr size_t WS_SSMK = WS_POOLT + DEPTH * SZ_POOLT;
constexpr size_t WS_BBAR = WS_SSMK + DEPTH * SZ_SSMK;
constexpr size_t WS_H = WS_BBAR + DEPTH * SZ_BBAR;
constexpr size_t WS_AB = WS_H + (size_t)NTOK * D * 2;
constexpr size_t WS_MIX = WS_AB + (size_t)NTOK * 8 * 4;
constexpr size_t WS_MIXO = WS_MIX + (size_t)NTOK * D * 2;
constexpr size_t WS_SSME = WS_MIXO + (size_t)NTOK * D * 4;
constexpr size_t WS_PROJ = WS_SSME + (size_t)8 * 32 * 16 * 64 * 2 * 4;
constexpr size_t WS_DW = WS_PROJ + (size_t)NTOK * NPROJ * 2;
constexpr size_t WS_DKC = WS_DW + (size_t)1024 * 8192 * 4;
constexpr size_t WS_DQD = WS_DKC + (size_t)1024 * 8192 * 2;
constexpr size_t WS_DQK = WS_DQD + (size_t)1024 * 8192 * 2;
constexpr size_t WS_DKT = WS_DQK + (size_t)1024 * 4096 * 2;
constexpr size_t WS_DGL = WS_DKT + (size_t)1024 * 8192 * 2;
constexpr size_t WS_DGS = WS_DGL + 4096;
constexpr size_t WS_BAR = WS_DGS + (size_t)1024 * 8192 * 2;
constexpr size_t WS_PARTS = WS_BAR + 16384;
constexpr size_t WS_END = WS_PARTS + (size_t)11 * 512 * 1024 * 4;
constexpr size_t WS_HID = WS_PROJ;
static_assert(WS_HID + (size_t)NTOK * DFF * 2 <= WS_END, "HID overlay");
static_assert(WS_H % 256 == 0 && WS_PROJ % 256 == 0 && WS_DW % 256 == 0, "align");

constexpr size_t O_YP = 0, O_YS = O_YP + (size_t)NP * D, O_DP = O_YS + (size_t)NS * D, O_CP = O_DP + (size_t)DEPTH * 8 * 4 * 16384,
                 O_REP = O_CP + (size_t)DEPTH * 8 * 3 * 1536, O_IMP = O_REP + (size_t)DEPTH * 8 * 1024, O_PP = O_IMP + (size_t)DEPTH * 8 * 1024,
                 O_DS = O_PP + (size_t)DEPTH * 8 * 15 * 256, O_CS = O_DS + (size_t)DEPTH * 128 * 4 * 16384, O_RES = O_CS + (size_t)DEPTH * 128 * 3 * 1536,
                 O_IMS = O_RES + (size_t)DEPTH * 128 * 1024, O_PS = O_IMS + (size_t)DEPTH * 128 * 1024, O_END = O_PS + (size_t)DEPTH * 128 * 15 * 256;

struct Args { const float* in[32]; float* out; unsigned char* ws; int ph_lo, ph_hi; };
typedef const float* cfp_t;
typedef __attribute__((address_space(4))) const unsigned char* kptr_t;
struct InProxy { __device__ __forceinline__ const float* operator[](int i) const {
    kptr_t p = (kptr_t)__builtin_amdgcn_kernarg_segment_ptr(); asm volatile("" : "+s"(p)); return *(__attribute__((address_space(4))) const cfp_t*)(p + 8 * i); } };
struct DevArgs { InProxy in; float* out; unsigned char* ws; int ph_lo, ph_hi; };
enum { I_XP = 0, I_XS, I_SDELTA, I_SCONV, I_SRE, I_SIM, I_SPOOL, I_NMPRE, I_NMPOST, I_NFPRE, I_NFPOST, I_WIN, I_CONVW, I_ALOG, I_DTB, I_ONORM,
       I_ARE, I_AIM, I_LOGDT, I_BRE, I_BIM, I_CRE, I_CIM, I_SSMD, I_GLUW, I_GLUB, I_POOLW, I_POOLS, I_WOUT, I_WG, I_WU, I_WD };

__device__ __forceinline__ unsigned f2bf(float f) { unsigned u = __float_as_uint(f); return (u + 0x7fffu + ((u >> 16) & 1u)) >> 16; }
__device__ __forceinline__ float bf2f(unsigned b) { return __uint_as_float(b << 16); }
__device__ __forceinline__ unsigned pk2(float lo, float hi) { return f2bf(lo) | (f2bf(hi) << 16); }
template <int CTRL> __device__ __forceinline__ float dpp_f(float v) { return __builtin_bit_cast(float, __builtin_amdgcn_update_dpp(0, __builtin_bit_cast(int, v), CTRL, 0xF, 0xF, true)); }
__device__ __forceinline__ float row_sum8(float v) { v += dpp_f<0xB1>(v); v += dpp_f<0x4E>(v); v += dpp_f<0x141>(v); return v; }
__device__ __forceinline__ float row_sum16(float v) { v = row_sum8(v); v += dpp_f<0x140>(v); return v; }
__device__ __forceinline__ float wave_sum(float v) { v = row_sum16(v); v += __shfl_xor(v, 16); v += __shfl_xor(v, 32); return v; }
__device__ __forceinline__ float silu_f(float y) { return y / (1.f + __expf(-y)); }
__device__ __forceinline__ float sigmoid_f(float y) { return 1.f / (1.f + __expf(-y)); }
__device__ __forceinline__ float gelu_tanh_f(float x) { const float t = tanhf(0.7978845608028654f * (x + 0.044715f * x * x * x)); return 0.5f * x * (1.f + t); }
__device__ __forceinline__ f32x4 mfma16(bf16x8 a, bf16x8 b, f32x4 c) { return __builtin_amdgcn_mfma_f32_16x16x32_bf16(a, b, c, 0, 0, 0); }
#define LDS_FENCE() asm volatile("s_waitcnt lgkmcnt(0)" ::: "memory")

struct EpiSwiGLU {
    static constexpr bool PERM = false, AFTER_DRAIN = false;
    bf16_t* O; int ldc;
    __device__ __forceinline__ void operator()(const pg8::f32x4 (&acc)[2][2][4][2], const pg8::Unit& u, int wr, int wc, int fr, int fq) const {
        const int row0 = u.pm * 256 + wr * 64 + fr, hid0 = u.pn * 128 + wc * 16 + 4 * fq;
#pragma unroll
        for (int ai = 0; ai < 2; ++ai)
#pragma unroll
            for (int m = 0; m < 4; ++m) { bf16_t* rowp = O + (size_t)(row0 + ai * 128 + m * 16) * ldc + hid0;
#pragma unroll
                for (int bj = 0; bj < 2; ++bj) { const pg8::f32x4 g = acc[ai][bj][m][0], v = acc[ai][bj][m][1];
                    u32x2 w; w.x = pk2(silu_f(g[0]) * v[0], silu_f(g[1]) * v[1]); w.y = pk2(silu_f(g[2]) * v[2], silu_f(g[3]) * v[3]);
                    *(u32x2*)(rowp + bj * 64) = w; } }
    }
};

#define XB_TMO      128
#define XB_XCNT(j)  (256  + 64 * (j))
#define XB_XSUB(j)  (1280 + 64 * (j))
#define XB_XGEN(j)  (2304 + 64 * (j))
#define XB_TOP      3328
#define XB_TOPGEN   3392
#define XCD_BAR_WORDS 3456
#define XB_SPIN_CAP (1u << 18)

__device__ __forceinline__ unsigned xb_ld(unsigned* p)              { return __hip_atomic_load(p, __ATOMIC_RELAXED, __HIP_MEMORY_SCOPE_AGENT); }
__device__ __forceinline__ unsigned xb_add(unsigned* p, unsigned v) { return __hip_atomic_fetch_add(p, v, __ATOMIC_RELAXED, __HIP_MEMORY_SCOPE_AGENT); }
__device__ __forceinline__ unsigned xb_xcc_id() { return (unsigned)__builtin_amdgcn_s_getreg((3 << 11) | 20) & 0xFu; }
#define XB_SPIN(cond, bar) do { unsigned _sp = 0; while (cond) { __builtin_amdgcn_s_sleep(1); \
    if ((++_sp & 255u) == 0u) { if (xb_ld(&(bar)[XB_TMO])) break; if (_sp > XB_SPIN_CAP) { atomicAdd(&(bar)[XB_TMO], 1u); break; } } } } while (0)

struct XcdBarrier {
    unsigned* bar; unsigned x;
    volatile LAS unsigned* st;
};

__device__ __forceinline__ XcdBarrier xcd_barrier_post(unsigned* bar, volatile LAS unsigned* st) {
    XcdBarrier b; b.bar = bar; b.x = xb_xcc_id(); b.st = st;
    if (threadIdx.x == 0) (void)xb_add(&bar[XB_XCNT(b.x)], 1u);
    return b;
}
__device__ __forceinline__ void xcd_barrier_complete(unsigned* bar, unsigned x, unsigned& nloc, unsigned& nx) {
    const unsigned G = gridDim.x * gridDim.y * gridDim.z;
    unsigned sum, cnt, mine, sp = 0u;
    for (;;) {
        sum = 0u; cnt = 0u; mine = 0u;
#pragma unroll
        for (unsigned j = 0; j < 16; ++j) { const unsigned c = xb_ld(&bar[XB_XCNT(j)]); sum += c; cnt += (c > 0u) ? 1u : 0u; mine = (j == x) ? c : mine; }
        if (sum == G) break;
        __builtin_amdgcn_s_sleep(1);
        if ((++sp & 255u) == 0u) { if (xb_ld(&bar[XB_TMO])) break; if (sp > XB_SPIN_CAP) { atomicAdd(&bar[XB_TMO], 1u); break; } }
    }
    nloc = mine > 0u ? mine : 1u; nx = cnt > 0u ? cnt : 1u;
}

__device__ __forceinline__ void xcd_barrier(const XcdBarrier& b) {
    asm volatile("s_waitcnt vmcnt(0)" ::: "memory");
    __syncthreads();
    if (threadIdx.x == 0) {
        unsigned* bar = b.bar; asm volatile("" : "+s"(bar));
        __builtin_amdgcn_s_waitcnt(0);
        unsigned nloc = b.st[0], nx = b.st[1];
        if (nloc == 0u) { xcd_barrier_complete(bar, b.x, nloc, nx); b.st[0] = nloc; b.st[1] = nx; }
        const unsigned old = xb_add(&bar[XB_XSUB(b.x)], 1u);
        const unsigned gen = old / nloc;
        if (old + 1u == (gen + 1u) * nloc) {
            __builtin_amdgcn_fence(__ATOMIC_RELEASE, "agent");
            asm volatile("s_waitcnt vmcnt(0)" ::: "memory");
            const unsigned og = xb_add(&bar[XB_TOP], 1u);
            const unsigned tg = og / nx;
            if (og + 1u == (tg + 1u) * nx) xb_add(&bar[XB_TOPGEN], 1u);
            else XB_SPIN(xb_ld(&bar[XB_TOPGEN]) == tg, bar);
            __builtin_amdgcn_fence(__ATOMIC_ACQUIRE, "agent");
            xb_add(&bar[XB_XGEN(b.x)], 1u);
            asm volatile("s_waitcnt vmcnt(0)" ::: "memory");
        } else {
            XB_SPIN(xb_ld(&bar[XB_XGEN(b.x)]) == gen, bar);
            __builtin_amdgcn_fence(__ATOMIC_ACQUIRE, "agent");
            asm volatile("s_waitcnt vmcnt(0)" ::: "memory");
        }
    }
    __syncthreads();
}

struct SliceOrder {
    int nunits, G, c;
    __device__ __forceinline__ bool next(int i, pg8::Unit& u) const { const int L = i * G + c; if (L >= nunits) return false; const int t = L & 7; u.pm = t >> 2; u.pn = t & 3; u.ks = L >> 3; return true; }
    __device__ __forceinline__ void a_ready(const pg8::Unit&) const {}
    __device__ __forceinline__ void done(const pg8::Unit&) const {}
};
struct EpiF32Part {
    static constexpr bool PERM = false, AFTER_DRAIN = false;
    float* C;
    __device__ __forceinline__ void operator()(const pg8::f32x4 (&acc)[2][2][4][2], const pg8::Unit& u, int wr, int wc, int fr, int fq) const {
        const int row0 = u.pm * 256 + wr * 64 + fr, col0 = u.pn * 256 + wc * 32 + 4 * fq; float* base = C + (size_t)u.ks * (512 * 1024);
#pragma unroll
        for (int ai = 0; ai < 2; ++ai)
#pragma unroll
            for (int m = 0; m < 4; ++m) { float* rowp = base + (size_t)(row0 + ai * 128 + m * 16) * 1024 + col0;
#pragma unroll
                for (int bj = 0; bj < 2; ++bj)
#pragma unroll
                    for (int n = 0; n < 2; ++n) *(pg8::f32x4*)(rowp + bj * 128 + n * 16) = acc[ai][bj][m][n]; }
    }
};

struct SrcIn { const float* w; __device__ __forceinline__ float operator()(int k, int n) const { return w[(size_t)k * INW + (n < 1536 ? n : n + 8)]; } };
struct SrcPlain { const float* w; int N; __device__ __forceinline__ float operator()(int k, int n) const { return w[(size_t)k * N + n]; } };
struct SrcGU { const float* g; const float* u; __device__ __forceinline__ float operator()(int k, int n) const { const int r = n & 31, hid = (n >> 5) * 16 + (r & 15); const long long du = (r < 16) ? 0ll : (long long)(u - g); return g[du + (long long)k * DFF + hid]; } };
template <class Src> __device__ __forceinline__ void transpose_item(const Src& src, int K, bf16_t* WT, int nblk, LAS float* scr, int item, int lane) {
    const int kb = item / nblk, nb = item % nblk, k0 = 64 * kb, n0 = 32 * nb;
#pragma unroll 8
    for (int i = 0; i < 32; ++i) { const int kk = 2 * i + (lane >> 5); scr[kk * 33 + (lane & 31)] = src(k0 + kk, n0 + (lane & 31)); }
    LDS_FENCE();
    const int c = lane & 7;
#pragma unroll
    for (int j = 0; j < 4; ++j) { const int n = (lane >> 3) + 8 * j; const LAS float* s = scr + (8 * c) * 33 + n;
        u32x4 o; o.x = pk2(s[0 * 33], s[1 * 33]); o.y = pk2(s[2 * 33], s[3 * 33]); o.z = pk2(s[4 * 33], s[5 * 33]); o.w = pk2(s[6 * 33], s[7 * 33]);
        *(u32x4*)(WT + (size_t)(n0 + n) * K + k0 + 8 * c) = o; }
    LDS_FENCE();
}

__device__ __forceinline__ void norm_rows(const float* T, const float* wt, const float* X0, const float* X1, float* Xout, const float* wh, bf16_t* H,
                                          const float* Wab, float* AB, int gw, int NGW, int lane, const float* Tp = nullptr, int ns = 0) {
#pragma unroll 1
    for (int m = gw; m < NTOK; m += NGW) {
        f32x4 x[4], t[4];
        { const float* xr = (X1 && m >= NP) ? X1 + (size_t)(m - NP) * D : X0 + (size_t)m * D;
#pragma unroll
          for (int j = 0; j < 4; ++j) x[j] = ((const f32x4*)xr)[lane + 64 * j];
          if (T && !(Tp && m >= NP)) {
#pragma unroll
              for (int j = 0; j < 4; ++j) t[j] = ((const f32x4*)(T + (size_t)m * D))[lane + 64 * j]; } }
        if (T) {
            float ss = 0.f;
            if (Tp && m >= NP) {
#pragma unroll
                for (int j = 0; j < 4; ++j) { f32x4 a = {0.f, 0.f, 0.f, 0.f}; for (int q = 0; q < ns; ++q) a += ((const f32x4*)(Tp + (size_t)q * (512 * 1024) + (size_t)(m - NP) * D))[lane + 64 * j]; t[j] = a; } }
#pragma unroll
            for (int j = 0; j < 4; ++j) ss += (t[j].x * t[j].x + t[j].y * t[j].y) + (t[j].z * t[j].z + t[j].w * t[j].w);
            ss = wave_sum(ss); const float r = rsqrtf(ss * (1.f / D) + EPS);
#pragma unroll
            for (int j = 0; j < 4; ++j) { const f32x4 w = ((const f32x4*)wt)[lane + 64 * j]; x[j] += t[j] * r * w; }
        }
        if (Xout) {
#pragma unroll
            for (int j = 0; j < 4; ++j) ((f32x4*)(Xout + (size_t)m * D))[lane + 64 * j] = x[j];
        }
        if (H) {
            float ss = 0.f;
#pragma unroll
            for (int j = 0; j < 4; ++j) ss += (x[j].x * x[j].x + x[j].y * x[j].y) + (x[j].z * x[j].z + x[j].w * x[j].w);
            ss = wave_sum(ss); const float r = rsqrtf(ss * (1.f / D) + EPS);
            f32x4 hv[4];
#pragma unroll
            for (int j = 0; j < 4; ++j) { const f32x4 w = ((const f32x4*)wh)[lane + 64 * j]; hv[j] = x[j] * r * w;
                u32x2 o; o.x = pk2(hv[j].x, hv[j].y); o.y = pk2(hv[j].z, hv[j].w); ((u32x2*)(H + (size_t)m * D))[lane + 64 * j] = o; }
            if (Wab) {
                float d[8];
#pragma unroll
                for (int c = 0; c < 8; ++c) { float dd = 0.f;
#pragma unroll
                    for (int j = 0; j < 4; ++j) { const f32x4 w = ((const f32x4*)(Wab + c * D))[lane + 64 * j]; dd += (hv[j].x * w.x + hv[j].y * w.y) + (hv[j].z * w.z + hv[j].w * w.w); }
                    d[c] = dd; }
#pragma unroll
                for (int c = 0; c < 8; ++c) d[c] = row_sum16(d[c]);
#pragma unroll
                for (int o = 16; o < 64; o <<= 1) {
#pragma unroll
                    for (int c = 0; c < 8; ++c) d[c] += __shfl_xor(d[c], o); }
                if (lane == 0) { f32x4 o0 = {d[0], d[1], d[2], d[3]}, o1 = {d[4], d[5], d[6], d[7]}; *(f32x4*)(AB + (size_t)m * 8) = o0; *(f32x4*)(AB + (size_t)m * 8 + 4) = o1; }
            }
        }
    }
}

__device__ __forceinline__ void prologue(const DevArgs& A, LAS unsigned char* lds, int wave, int lane, int gw, int NGW) {
    LAS float* scr = (LAS float*)(lds + wave * 8704);
    constexpr int I_IN = 16 * 80, I_OUT = 16 * 32, I_GU = 16 * 176, I_DN = 44 * 32, I_GLU = 4 * 8, I_POOL = 8, PER = I_IN + I_OUT + I_GU + I_DN + I_GLU + I_POOL;
#pragma unroll 1
    for (int it = gw; it < DEPTH * PER; it += NGW) {
        const int l = it / PER; int r = it % PER;
        if (r < I_IN) { SrcIn s{A.in[I_WIN] + (size_t)l * D * INW}; transpose_item(s, D, (bf16_t*)(A.ws + WS_WIN + l * SZ_WIN), NPROJ / 32, scr, r, lane); continue; } r -= I_IN;
        if (r < I_OUT) { SrcPlain s{A.in[I_WOUT] + (size_t)l * D * D, D}; transpose_item(s, D, (bf16_t*)(A.ws + WS_WOUT + l * SZ_WOUT), D / 32, scr, r, lane); continue; } r -= I_OUT;
        if (r < I_GU) { SrcGU s{A.in[I_WG] + (size_t)l * D * DFF, A.in[I_WU] + (size_t)l * D * DFF}; transpose_item(s, D, (bf16_t*)(A.ws + WS_WGU + l * SZ_WGU), NGU / 32, scr, r, lane); continue; } r -= I_GU;
        if (r < I_DN) { SrcPlain s{A.in[I_WD] + (size_t)l * DFF * D, D}; transpose_item(s, DFF, (bf16_t*)(A.ws + WS_WDN + l * SZ_WDN), D / 32, scr, r, lane); continue; } r -= I_DN;
        if (r < I_GLU) { SrcPlain s{A.in[I_GLUW] + (size_t)l * 65536, 256}; transpose_item(s, 256, (bf16_t*)(A.ws + WS_GLUT + l * SZ_GLUT), 8, scr, r, lane); continue; } r -= I_GLU;
        { const int g = r >> 1; SrcPlain s{A.in[I_POOLW] + (size_t)(l * 4 + g) * 4096, 64}; transpose_item(s, 64, (bf16_t*)(A.ws + WS_POOLT + l * SZ_POOLT) + g * 4096, 2, scr, r & 1, lane); }
    }
    const int gt = gw * 64 + lane, NT = NGW * 64;
    float* wab = (float*)(A.ws + WS_WAB);
#pragma unroll 1
    for (int i = gt; i < DEPTH * 8 * D; i += NT) { const int l = i / (8 * D), j = (i / D) & 7, k = i % D; wab[i] = A.in[I_WIN][((size_t)l * D + k) * INW + 1536 + j]; }
    float* ssmk = (float*)(A.ws + WS_SSMK); float* bbar = (float*)(A.ws + WS_BBAR);
#pragma unroll 1
    for (int i = gt; i < DEPTH * 16 * 64; i += NT) {
        const int lg = i >> 6;
        const float dt = expf(A.in[I_LOGDT][lg]), ar = A.in[I_ARE][i], ai = A.in[I_AIM][i];
        const float mag = expf(ar * dt);
        float rev = ai * dt * 0.15915494309189535f; rev -= floorf(rev);
        const float sn = __builtin_amdgcn_sinf(rev), cs = __builtin_amdgcn_cosf(rev);
        const float lr = mag * cs, li = mag * sn;
        float pr = lr, pi = li;
#pragma unroll
        for (int q = 0; q < 6; ++q) { const float nr2 = pr * pr - pi * pi, ni2 = 2.f * pr * pi; pr = nr2; pi = ni2; }
        ssmk[i * 4 + 0] = lr; ssmk[i * 4 + 1] = li; ssmk[i * 4 + 2] = pr; ssmk[i * 4 + 3] = pi;
        const float nr = lr - 1.f, ni = li, d2 = ar * ar + ai * ai;
        const float cre = (nr * ar + ni * ai) / d2, cim = (ni * ar - nr * ai) / d2;
#pragma unroll
        for (int h = 0; h < 16; ++h) { const float br = A.in[I_BRE][(size_t)i * 16 + h], bi = A.in[I_BIM][(size_t)i * 16 + h];
            bbar[(size_t)i * 32 + h] = cre * br - cim * bi; bbar[(size_t)i * 32 + 16 + h] = cre * bi + cim * br; }
    }
}

__device__ __forceinline__ unsigned bfmul2(unsigned pk, float f0, float f1) { return pg8::cvt_pk_bf16(__uint_as_float(pk << 16) * f0, __uint_as_float(pk & 0xffff0000u) * f1); }
__device__ __forceinline__ void delta_prep_item(const DevArgs& A, int l, LAS unsigned char* lds, int item, int tid, int wave, int lane) {
    asm volatile("" : "+v"(tid)); lane = tid & 63; wave = __builtin_amdgcn_readfirstlane(tid >> 6);
    const int bh = item >> 5, n = item & 31, b = bh >> 2, h = bh & 3;
    const int tok0 = b * SEQ + n * 64;
    LAS bf16_t* QS = (LAS bf16_t*)(lds); LAS bf16_t* KS = (LAS bf16_t*)(lds + 17408);
    LAS unsigned char* KT = lds + 34816; LAS unsigned char* VT = lds + 53248; LAS unsigned char* RTK = lds + 71680;
    LAS float* AM = (LAS float*)(lds + 90112); LAS float* PM = (LAS float*)(lds + 107520); LAS float* PSC = PM; LAS float* TM = (LAS float*)(lds + 124928);
    LAS unsigned char* TB = lds + 142336;
    LAS float* GAM = (LAS float*)(lds + 151552); LAS float* BETA = GAM + 64; LAS float* RQ = GAM + 128; LAS float* RK = GAM + 192;
    LAS float* F2 = GAM + 256; LAS float* F3 = GAM + 320; LAS float* F4 = GAM + 384;
    const bf16_t* PROJ = (const bf16_t*)(A.ws + WS_PROJ);
    const float* AB = (const float*)(A.ws + WS_AB);
    u32x4 gv[2];
#pragma unroll
    for (int j = 0; j < 2; ++j) { const int id = tid + 512 * j; gv[j] = *(const u32x4*)(PROJ + (size_t)(tok0 + (id >> 4)) * NPROJ + PC_G + h * 128 + (id & 15) * 8); }
    if (tid < 384) {
        const int part = tid >> 7, c = tid & 127, col = part * 512 + h * 128 + c;
        const float* cw = A.in[I_CONVW] + (size_t)l * 4 * 1536;
        const float w0 = cw[col], w1 = cw[1536 + col], w2 = cw[3072 + col], w3 = cw[4608 + col];
        const bf16_t* pp = PROJ + (size_t)tok0 * NPROJ + col;
        float xr[67];
#pragma unroll
        for (int t = 0; t < 67; ++t) xr[t] = (n > 0 || t >= 3) ? bf2f(pp[(long)(t - 3) * NPROJ]) : 0.f;
        unsigned pk[32];
#pragma unroll
        for (int t = 0; t < 64; t += 2) {
            const float s0 = silu_f(w0 * xr[t] + w1 * xr[t + 1] + w2 * xr[t + 2] + w3 * xr[t + 3]);
            const float s1 = silu_f(w0 * xr[t + 1] + w1 * xr[t + 2] + w2 * xr[t + 3] + w3 * xr[t + 4]);
            pk[t >> 1] = pg8::cvt_pk_bf16(s0, s1);
        }
        if (part < 2) { LAS bf16_t* dst = (part == 0 ? QS : KS) + c;
#pragma unroll
            for (int t = 0; t < 64; t += 2) { dst[t * 136] = (bf16_t)(pk[t >> 1] & 0xffffu); dst[(t + 1) * 136] = (bf16_t)(pk[t >> 1] >> 16); } }
        if (part > 0) { LAS unsigned char* dst = (part == 1 ? KT : VT) + c * 144;
#pragma unroll
            for (int q = 0; q < 8; ++q) { u32x4 o; o.x = pk[4 * q]; o.y = pk[4 * q + 1]; o.z = pk[4 * q + 2]; o.w = pk[4 * q + 3]; *(LAS u32x4*)(dst + q * 16) = o; } }
    } else if (tid < 448) {
        const int t = tid - 384;
        const float a = AB[(size_t)(tok0 + t) * 8 + h], bb = AB[(size_t)(tok0 + t) * 8 + 4 + h];
        const float xx = a + A.in[I_DTB][l * 4 + h];
        const float sp = xx > 20.f ? xx : log1pf(expf(xx));
        float lg = -expf(A.in[I_ALOG][l * 4 + h]) * sp;
#pragma unroll
        for (int off = 1; off < 64; off <<= 1) { const float v = __shfl_up(lg, off); if (lane >= off) lg += v; }
        GAM[t] = lg; BETA[t] = 1.f / (1.f + expf(-bb));
    }
    __syncthreads();
    {
        const int t = tid >> 3, part = tid & 7; float sq = 0.f, sk = 0.f;
#pragma unroll
        for (int j = 0; j < 16; ++j) { const float q = bf2f(QS[t * 136 + part * 16 + j]), k = bf2f(KS[t * 136 + part * 16 + j]); sq += q * q; sk += k * k; }
        sq = row_sum8(sq); sk = row_sum8(sk);
        if (part == 0) { const float rq = rsqrtf(sq + EPS) * 0.08838834764831845f, rk = rsqrtf(sk + EPS), g = GAM[t], eg = __expf(g), bt = BETA[t];
            RQ[t] = rq; RK[t] = rk; F2[t] = bt * eg * rk; F3[t] = rk * __expf(GAM[63] - g); F4[t] = rq * eg; }
    }
    {
        const int prod = wave >> 2, mt = wave & 3, fr = lane & 15, quad = lane >> 4;
        LAS bf16_t* Aop = prod ? QS : KS; LAS float* dst = prod ? PM : AM;
        bf16x8 a[4];
#pragma unroll
        for (int kk = 0; kk < 4; ++kk) a[kk] = *(LAS bf16x8*)(Aop + (mt * 16 + fr) * 136 + kk * 32 + quad * 8);
#pragma unroll
        for (int nt = 0; nt < 4; ++nt) { f32x4 acc = {0.f, 0.f, 0.f, 0.f};
#pragma unroll
            for (int kk = 0; kk < 4; ++kk) { const bf16x8 bq = *(LAS bf16x8*)(KS + (nt * 16 + fr) * 136 + kk * 32 + quad * 8); acc = mfma16(a[kk], bq, acc); }
#pragma unroll
            for (int i = 0; i < 4; ++i) dst[(mt * 16 + quad * 4 + i) * 68 + nt * 16 + fr] = acc[i]; }
    }
    __syncthreads();
    {
        const int t = tid >> 3, s8 = (tid & 7) * 8; const float gt = GAM[t], bk = BETA[t] * RK[t], rqt = RQ[t];
        float av[8], pv[8];
#pragma unroll
        for (int j = 0; j < 8; ++j) { const int s = s8 + j; const float rks = RK[s]; const float dec = (s <= t) ? __expf(gt - GAM[s]) * rks : 0.f;
            av[j] = (s < t) ? bk * dec * AM[t * 68 + s] : 0.f; pv[j] = rqt * dec * PM[t * 68 + s]; }
#pragma unroll
        for (int j = 0; j < 8; ++j) AM[t * 68 + s8 + j] = av[j];
        u32x4 o; o.x = pg8::cvt_pk_bf16(pv[0], pv[1]); o.y = pg8::cvt_pk_bf16(pv[2], pv[3]); o.z = pg8::cvt_pk_bf16(pv[4], pv[5]); o.w = pg8::cvt_pk_bf16(pv[6], pv[7]);
        *(u32x4*)((bf16_t*)(A.ws + WS_DQK) + (size_t)item * 4096 + t * 64 + s8) = o;
        for (int e = tid; e < 64 * 68; e += 512) TM[e] = 0.f;
        if (tid == 0) ((float*)(A.ws + WS_DGL))[item] = __expf(GAM[63]);
    }
    __syncthreads();
    if (wave == 0) {
        const int i = lane >> 4, c = lane & 15;
        LAS float* amp = AM + (16 * i) * 68 + 16 * i; asm volatile("" : "+v"(amp));
        float x[16];
#pragma unroll
        for (int r = 0; r < 16; ++r) { float acc = (r == c) ? 1.f : 0.f;
#pragma unroll
            for (int s = 0; s < r; ++s) acc = fmaf(-amp[r * 68 + s], x[s], acc);
            x[r] = acc; }
        LAS float* tmp = TM + (16 * i) * 68 + 16 * i + c;
#pragma unroll
        for (int r = 0; r < 16; ++r) tmp[r * 68] = x[r];
    } else {
        const int wt = tid - 64;
        for (int id = wt; id < 1024; id += 448) {
            const int c = id >> 3, t8 = (id & 7) * 8;
            const f32x4 b0 = *(LAS f32x4*)(BETA + t8), b1 = *(LAS f32x4*)(BETA + t8 + 4);
            u32x4 v = *(LAS u32x4*)(VT + c * 144 + t8 * 2);
            v.x = bfmul2(v.x, b0[0], b0[1]); v.y = bfmul2(v.y, b0[2], b0[3]); v.z = bfmul2(v.z, b1[0], b1[1]); v.w = bfmul2(v.w, b1[2], b1[3]);
            *(LAS u32x4*)(VT + c * 144 + t8 * 2) = v;
            const f32x4 f20 = *(LAS f32x4*)(F2 + t8), f21 = *(LAS f32x4*)(F2 + t8 + 4), f30 = *(LAS f32x4*)(F3 + t8), f31 = *(LAS f32x4*)(F3 + t8 + 4);
            const u32x4 k = *(LAS u32x4*)(KT + c * 144 + t8 * 2);
            u32x4 rk; rk.x = bfmul2(k.x, f20[0], f20[1]); rk.y = bfmul2(k.y, f20[2], f20[3]); rk.z = bfmul2(k.z, f21[0], f21[1]); rk.w = bfmul2(k.w, f21[2], f21[3]);
            *(LAS u32x4*)(RTK + c * 144 + t8 * 2) = rk;
            u32x4 kd; kd.x = bfmul2(k.x, f30[0], f30[1]); kd.y = bfmul2(k.y, f30[2], f30[3]); kd.z = bfmul2(k.z, f31[0], f31[1]); kd.w = bfmul2(k.w, f31[2], f31[3]);
            *(u32x4*)((bf16_t*)(A.ws + WS_DKT) + (size_t)item * 8192 + c * 64 + t8) = kd; }
        for (int id = wt; id < 1024; id += 448) {
            const int t = id >> 4, c8 = (id & 15) * 8; const float f = F4[t];
            u32x4 q = *(LAS u32x4*)((LAS unsigned char*)QS + t * 272 + c8 * 2);
            q.x = bfmul2(q.x, f, f); q.y = bfmul2(q.y, f, f); q.z = bfmul2(q.z, f, f); q.w = bfmul2(q.w, f, f);
            *(u32x4*)((bf16_t*)(A.ws + WS_DQD) + (size_t)item * 8192 + t * 128 + c8) = q; }
    }
    {
        const int c8 = (tid & 15) * 8; const float* on = A.in[I_ONORM] + l * 128 + c8;
        const f32x4 o0 = *(const f32x4*)on, o1 = *(const f32x4*)(on + 4);
#pragma unroll
        for (int j = 0; j < 2; ++j) { const int id = tid + 512 * j; const u32x4 g = gv[j]; u32x4 o;
            o.x = pg8::cvt_pk_bf16(silu_f(__uint_as_float(g.x << 16)) * o0[0], silu_f(__uint_as_float(g.x & 0xffff0000u)) * o0[1]);
            o.y = pg8::cvt_pk_bf16(silu_f(__uint_as_float(g.y << 16)) * o0[2], silu_f(__uint_as_float(g.y & 0xffff0000u)) * o0[3]);
            o.z = pg8::cvt_pk_bf16(silu_f(__uint_as_float(g.z << 16)) * o1[0], silu_f(__uint_as_float(g.z & 0xffff0000u)) * o1[1]);
            o.w = pg8::cvt_pk_bf16(silu_f(__uint_as_float(g.w << 16)) * o1[2], silu_f(__uint_as_float(g.w & 0xffff0000u)) * o1[3]);
            *(u32x4*)((bf16_t*)(A.ws + WS_DGS) + (size_t)item * 8192 + (id >> 4) * 128 + c8) = o; }
    }
    __syncthreads();
    const int p2 = tid >> 8, r2 = (tid >> 4) & 15, c2 = tid & 15, rb = p2 ? 48 : 16, cb = p2 ? 32 : 0;
    {
        float acc = 0.f;
#pragma unroll
        for (int s = 0; s < 16; ++s) acc = fmaf(AM[(rb + r2) * 68 + cb + s], TM[(cb + s) * 68 + cb + c2], acc);
        PSC[(p2 * 16 + r2) * 68 + c2] = acc; }
    __syncthreads();
    {
        float acc = 0.f;
#pragma unroll
        for (int s = 0; s < 16; ++s) acc = fmaf(TM[(rb + r2) * 68 + rb + s], PSC[(p2 * 16 + s) * 68 + c2], acc);
        TM[(rb + r2) * 68 + cb + c2] = -acc; }
    __syncthreads();
    float p3[2];
#pragma unroll
    for (int j = 0; j < 2; ++j) { const int e = tid + 512 * j, r = e >> 5, c = e & 31; float acc = 0.f;
#pragma unroll 8
        for (int s = 0; s < 32; ++s) acc = fmaf(AM[(32 + r) * 68 + s], TM[s * 68 + c], acc);
        p3[j] = acc; }
    __syncthreads();
#pragma unroll
    for (int j = 0; j < 2; ++j) { const int e = tid + 512 * j; PSC[(e >> 5) * 68 + (e & 31)] = p3[j]; }
    __syncthreads();
#pragma unroll
    for (int j = 0; j < 2; ++j) { const int e = tid + 512 * j, r = e >> 5, c = e & 31; float acc = 0.f;
#pragma unroll 8
        for (int s = 0; s < 32; ++s) acc = fmaf(TM[(32 + r) * 68 + 32 + s], PSC[s * 68 + c], acc);
        p3[j] = -acc; }
#pragma unroll
    for (int j = 0; j < 2; ++j) { const int e = tid + 512 * j; TM[(32 + (e >> 5)) * 68 + (e & 31)] = p3[j]; }
    __syncthreads();
#pragma unroll
    for (int j = 0; j < 4; ++j) { const int e = tid + 512 * j, t = e >> 5, s2 = (e & 31) * 2;
        *(LAS unsigned*)(TB + t * 144 + s2 * 2) = pg8::cvt_pk_bf16(TM[t * 68 + s2], TM[t * 68 + s2 + 1]); }
    __syncthreads();
    {
        const int fr = lane & 15, quad = lane >> 4;
        bf16x8 bv[2], ak[2];
#pragma unroll
        for (int kk = 0; kk < 2; ++kk) { bv[kk] = *(LAS bf16x8*)(VT + (16 * wave + fr) * 144 + (kk * 32 + quad * 8) * 2); ak[kk] = *(LAS bf16x8*)(RTK + (16 * wave + fr) * 144 + (kk * 32 + quad * 8) * 2); }
        bf16_t* DW = (bf16_t*)(A.ws + WS_DW) + (size_t)item * 8192; bf16_t* DKC = (bf16_t*)(A.ws + WS_DKC) + (size_t)item * 8192;
#pragma unroll
        for (int mt = 0; mt < 4; ++mt) { f32x4 aw = {0.f, 0.f, 0.f, 0.f}, akc = {0.f, 0.f, 0.f, 0.f};
#pragma unroll
            for (int kk = 0; kk < 2; ++kk) { const bf16x8 tf = *(LAS bf16x8*)(TB + (mt * 16 + fr) * 144 + (kk * 32 + quad * 8) * 2);
                aw = mfma16(tf, bv[kk], aw);
                akc = mfma16(ak[kk], tf, akc); }
            u32x2 ow; ow.x = pk2(aw[0], aw[1]); ow.y = pk2(aw[2], aw[3]);
            *(u32x2*)(DW + (16 * wave + fr) * 64 + mt * 16 + quad * 4) = ow;
            u32x2 ok; ok.x = pk2(-akc[0], -akc[1]); ok.y = pk2(-akc[2], -akc[3]);
            *(u32x2*)(DKC + (mt * 16 + fr) * 128 + 16 * wave + quad * 4) = ok; }
    }
    __syncthreads();
}

__device__ __forceinline__ void delta_scan_item(const DevArgs& A, int l, LAS unsigned char* lds, int bh, int tid_in, int wave, int lane_in, const XcdBarrier& xb, int SUB) {
    const int b = bh >> 2, h = bh & 3;
    LAS unsigned char* KCs = lds; LAS unsigned char* QDs = lds + 17408; LAS unsigned char* QKs = lds + 34816; LAS unsigned char* KDTs = lds + 44032;
    LAS unsigned char* Ws = lds + 62464;
    LAS unsigned char* GSs = lds + 80896;
    LAS unsigned char* SS = lds + 98304 + wave * 4352; LAS unsigned char* US = lds + 133120 + wave * 2304;
    LAS float* PART = (LAS float*)(lds + 151552);
    const unsigned char* gW = A.ws + WS_DW; const unsigned char* gGS = A.ws + WS_DGS;
    const unsigned char* gKC = A.ws + WS_DKC; const unsigned char* gQD = A.ws + WS_DQD; const unsigned char* gQK = A.ws + WS_DQK; const unsigned char* gKT = A.ws + WS_DKT;
    const float* DGL = (const float*)(A.ws + WS_DGL);
    f32x4 S[8];
#pragma unroll
    for (int mt = 0; mt < 8; ++mt) S[mt] = (f32x4){0.f, 0.f, 0.f, 0.f};
    u32x4 r[9], rg[2];
    float gl_all = 0.f;
#define DS_LOAD(itn, toff) do { const size_t _i = (size_t)(itn); const unsigned char* _kc = gKC + _i * 16384; const unsigned char* _qd = gQD + _i * 16384; \
        const unsigned char* _qk = gQK + _i * 8192; const unsigned char* _kt = gKT + _i * 16384; \
        r[0] = *(const u32x4*)(_kc + (toff)); r[1] = *(const u32x4*)(_kc + (toff) + 8192u); \
        r[2] = *(const u32x4*)(_qd + (toff)); r[3] = *(const u32x4*)(_qd + (toff) + 8192u); \
        r[4] = *(const u32x4*)(_qk + (toff)); \
        r[5] = *(const u32x4*)(_kt + (toff)); r[6] = *(const u32x4*)(_kt + (toff) + 8192u); \
        const unsigned char* _w = gW + _i * 16384; r[7] = *(const u32x4*)(_w + (toff)); r[8] = *(const u32x4*)(_w + (toff) + 8192u); } while (0)
#define DS_LOADG(itn, toff) do { const unsigned char* _g = gGS + (size_t)(itn) * 16384; rg[0] = *(const u32x4*)(_g + (toff)); rg[1] = *(const u32x4*)(_g + (toff) + 8192u); } while (0)
#define DS_STAGE(tidv) do { const int i0 = (tidv), i1 = (tidv) + 512; \
          *(LAS u32x4*)(KCs + (i0 >> 4) * 272 + (i0 & 15) * 16) = r[0]; *(LAS u32x4*)(KCs + (i1 >> 4) * 272 + (i1 & 15) * 16) = r[1]; \
          *(LAS u32x4*)(QDs + (i0 >> 4) * 272 + (i0 & 15) * 16) = r[2]; *(LAS u32x4*)(QDs + (i1 >> 4) * 272 + (i1 & 15) * 16) = r[3]; \
          *(LAS u32x4*)(QKs + (i0 >> 3) * 144 + (i0 & 7) * 16) = r[4]; \
          *(LAS u32x4*)(KDTs + (i0 >> 3) * 144 + (i0 & 7) * 16) = r[5]; *(LAS u32x4*)(KDTs + (i1 >> 3) * 144 + (i1 & 7) * 16) = r[6]; \
          *(LAS u32x4*)(Ws + (i0 >> 3) * 144 + (i0 & 7) * 16) = r[7]; *(LAS u32x4*)(Ws + (i1 >> 3) * 144 + (i1 & 7) * 16) = r[8]; } while (0)
#define DS_STAGEG(tidv) do { const int i0 = (tidv), i1 = (tidv) + 512; \
          *(LAS u32x4*)(GSs + (i0 >> 4) * 272 + (i0 & 15) * 16) = rg[0]; *(LAS u32x4*)(GSs + (i1 >> 4) * 272 + (i1 & 15) * 16) = rg[1]; } while (0)
#pragma unroll 1
    for (int n = 0; n < 32; ++n) {
        int tid = tid_in; asm volatile("" : "+v"(tid));
        const bool bstart = (SUB > 0) ? (n % SUB == 0) : (n == 0);
        const bool bnext1 = (SUB > 0) && ((n + 1) % SUB == 0), bnext2 = (SUB > 0) && ((n + 2) % SUB == 0);
        if (bstart) { if (n > 0) xcd_barrier(xb);
            gl_all = DGL[bh * 32 + (tid & 31)];
            const unsigned t0 = (unsigned)tid * 16u; DS_LOAD(bh * 32 + n, t0); DS_LOADG(bh * 32 + n, t0); DS_STAGE(tid); DS_STAGEG(tid);
            if (n + 1 < 32 && !bnext1) { DS_LOAD(bh * 32 + n + 1, t0); DS_LOADG(bh * 32 + n + 1, t0); }
            __syncthreads(); }
        else { DS_STAGEG(tid);
            if (n + 1 < 32 && !bnext1) DS_LOADG(bh * 32 + n + 1, (unsigned)tid * 16u); }
        const int lane = tid & 63, fr = lane & 15, quad = lane >> 4, vcol = 16 * wave + fr;
        const unsigned toff = (unsigned)tid * 16u;
        const int it = bh * 32 + n, tokb = b * SEQ + n * 64;
        const float glast = __builtin_bit_cast(float, __builtin_amdgcn_readlane(__builtin_bit_cast(int, gl_all), n));
        asm volatile("s_nop 7\n\ts_nop 7" ::: "memory");
#pragma unroll
        for (int mt = 0; mt < 8; ++mt) { u32x2 p; p.x = pg8::cvt_pk_bf16(S[mt][0], S[mt][1]); p.y = pg8::cvt_pk_bf16(S[mt][2], S[mt][3]); *(LAS u32x2*)(SS + fr * 272 + (mt * 16 + quad * 4) * 2) = p; }
        LDS_FENCE();
        bf16x8 Sb[4];
#pragma unroll
        for (int kk = 0; kk < 4; ++kk) Sb[kk] = *(LAS bf16x8*)(SS + fr * 272 + (kk * 32 + quad * 8) * 2);
        f32x4 U[4], O[4];
#pragma unroll
        for (int mt = 0; mt < 4; ++mt) { f32x4 au, ao = {0.f, 0.f, 0.f, 0.f};
            { const u32x2 wq = *(LAS u32x2*)(Ws + vcol * 144 + (mt * 16 + quad * 4) * 2);
              au[0] = __uint_as_float(wq.x << 16); au[1] = __uint_as_float(wq.x & 0xffff0000u); au[2] = __uint_as_float(wq.y << 16); au[3] = __uint_as_float(wq.y & 0xffff0000u); }
#pragma unroll
            for (int kk = 0; kk < 4; ++kk) { const bf16x8 a1 = *(LAS bf16x8*)(KCs + (mt * 16 + fr) * 272 + (kk * 32 + quad * 8) * 2); au = mfma16(a1, Sb[kk], au);
                const bf16x8 a2 = *(LAS bf16x8*)(QDs + (mt * 16 + fr) * 272 + (kk * 32 + quad * 8) * 2); ao = mfma16(a2, Sb[kk], ao); }
            U[mt] = au; O[mt] = ao; __builtin_amdgcn_sched_barrier(0); }
        asm volatile("s_nop 7\n\ts_nop 7" ::: "memory");
#pragma unroll
        for (int mt = 0; mt < 4; ++mt) { u32x2 p; p.x = pg8::cvt_pk_bf16(U[mt][0], U[mt][1]); p.y = pg8::cvt_pk_bf16(U[mt][2], U[mt][3]); *(LAS u32x2*)(US + fr * 144 + (mt * 16 + quad * 4) * 2) = p; }
        LDS_FENCE();
        bf16x8 Ub[2];
#pragma unroll
        for (int kk = 0; kk < 2; ++kk) Ub[kk] = *(LAS bf16x8*)(US + fr * 144 + (kk * 32 + quad * 8) * 2);
#pragma unroll
        for (int mt = 0; mt < 4; ++mt)
#pragma unroll
            for (int kk = 0; kk < 2; ++kk) { const bf16x8 a = *(LAS bf16x8*)(QKs + (mt * 16 + fr) * 144 + (kk * 32 + quad * 8) * 2); O[mt] = mfma16(a, Ub[kk], O[mt]); }
        __builtin_amdgcn_sched_barrier(0);
#pragma unroll
        for (int mt = 0; mt < 8; ++mt) { S[mt] *= glast;
#pragma unroll
            for (int kk = 0; kk < 2; ++kk) { const bf16x8 a = *(LAS bf16x8*)(KDTs + (mt * 16 + fr) * 144 + (kk * 32 + quad * 8) * 2); S[mt] = mfma16(a, Ub[kk], S[mt]); }
            if (mt & 1) __builtin_amdgcn_sched_barrier(0); }
        { float pp[16];
#pragma unroll
          for (int e = 0; e < 16; ++e) pp[e] = O[e >> 2][e & 3] * O[e >> 2][e & 3];
#pragma unroll
          for (int e = 0; e < 16; ++e) pp[e] = row_sum16(pp[e]);
          if (fr == 0) {
#pragma unroll
              for (int e = 0; e < 16; ++e) PART[((e >> 2) * 16 + quad * 4 + (e & 3)) * 8 + wave] = pp[e]; } }
        __syncthreads();
        if (n + 1 < 32 && !bnext1) { DS_STAGE(tid); if (n + 2 < 32 && !bnext2) DS_LOAD(it + 2, toff); }
        bf16_t* mixb = (bf16_t*)(A.ws + WS_MIX) + (size_t)tokb * D + h * 128;
#pragma unroll
        for (int mt = 0; mt < 4; ++mt)
#pragma unroll
            for (int i = 0; i < 4; ++i) { const int t = mt * 16 + quad * 4 + i;
                const f32x4 p0 = *(LAS f32x4*)(PART + t * 8), p1 = *(LAS f32x4*)(PART + t * 8 + 4);
                const float tot = ((p0[0] + p0[1]) + (p0[2] + p0[3])) + ((p1[0] + p1[1]) + (p1[2] + p1[3]));
                const float sc = rsqrtf(tot * (1.f / 128.f) + EPS);
                const float gs = bf2f(*(LAS bf16_t*)(GSs + t * 272 + vcol * 2));
                mixb[(unsigned)(t * D + vcol)] = (bf16_t)(pg8::cvt_pk_bf16(O[mt][i] * sc * gs, 0.f) & 0xffffu); }
        __syncthreads();
    }
#undef DS_STAGE
#undef DS_LOADG
#undef DS_STAGEG
#undef DS_LOAD
    { const int lane = lane_in, fr = lane & 15, quad = lane >> 4, vcol = 16 * wave + fr;
      float* dp = A.out + O_DP + (size_t)((l * 8 + b) * 4 + h) * 16384;
#pragma unroll
      for (int mt = 0; mt < 8; ++mt)
#pragma unroll
          for (int i = 0; i < 4; ++i) dp[(mt * 16 + quad * 4 + i) * 128 + vcol] = S[mt][i]; }
    __syncthreads();
}

__device__ __forceinline__ void delta_sample_item(const DevArgs& A, int l, LAS unsigned char* lds, int item, int tid, int wave, int lane) {
    asm volatile("" : "+v"(tid)); lane = tid & 63; wave = __builtin_amdgcn_readfirstlane(tid >> 6);
    const int b = item >> 2, h = item & 3, tokS = NP + b * 4;
    LAS float* RAW = (LAS float*)lds; LAS float* RED = RAW + 1536; LAS float* OB = RED + 512; LAS float* SC = OB + 512;
    const bf16_t* PROJ = (const bf16_t*)(A.ws + WS_PROJ); const float* AB = (const float*)(A.ws + WS_AB); bf16_t* MIX = (bf16_t*)(A.ws + WS_MIX);
    const float* cw = A.in[I_CONVW] + (size_t)l * 4 * 1536;
    for (int idx = tid; idx < 1536; idx += 512) { const int part = idx >> 9, t = (idx >> 7) & 3, c = idx & 127, col = part * 512 + h * 128 + c;
        float acc = 0.f;
#pragma unroll
        for (int j = 0; j < 4; ++j) { const int tt = t - 3 + j;
            const float x = (tt >= 0) ? bf2f(PROJ[(size_t)(tokS + tt) * NPROJ + col]) : A.in[I_SCONV][((size_t)(l * 128 + b) * 3 + (3 + tt)) * 1536 + col];
            acc += cw[j * 1536 + col] * x; }
        RAW[idx] = silu_f(acc); }
    if (tid < 4) { const float a = AB[(size_t)(tokS + tid) * 8 + h], bb = AB[(size_t)(tokS + tid) * 8 + 4 + h];
        const float xx = a + A.in[I_DTB][l * 4 + h]; const float sp = xx > 20.f ? xx : log1pf(expf(xx));
        SC[8 + tid] = 1.f / (1.f + expf(-bb)); SC[12 + tid] = expf(-expf(A.in[I_ALOG][l * 4 + h]) * sp); }
    const int v = tid & 127, kq = tid >> 7;
    float S[32];
    { const float* sp = A.in[I_SDELTA] + (size_t)((l * 128 + b) * 4 + h) * 16384;
#pragma unroll
      for (int i = 0; i < 32; ++i) S[i] = sp[(kq * 32 + i) * 128 + v]; }
    __syncthreads();
    { const int part = wave >> 2, t = wave & 3; const float x0 = RAW[part * 512 + t * 128 + lane], x1 = RAW[part * 512 + t * 128 + 64 + lane];
      const float ss = wave_sum(x0 * x0 + x1 * x1); if (lane == 0) SC[part * 4 + t] = rsqrtf(ss + EPS) * (part == 0 ? 0.08838834764831845f : 1.f); }
    __syncthreads();
    for (int t = 0; t < 4; ++t) {
        const float rq = SC[t], rk = SC[4 + t], beta = SC[8 + t], g = SC[12 + t];
        float pr = 0.f;
#pragma unroll
        for (int i = 0; i < 32; ++i) pr += S[i] * RAW[512 + t * 128 + kq * 32 + i];
        RED[kq * 128 + v] = pr * rk;
        __syncthreads();
        const float rr = (RED[v] + RED[128 + v]) + (RED[256 + v] + RED[384 + v]);
        const float u = beta * (RAW[1024 + t * 128 + v] - g * rr);
        float po = 0.f;
#pragma unroll
        for (int i = 0; i < 32; ++i) { const float kh = RAW[512 + t * 128 + kq * 32 + i] * rk; S[i] = g * S[i] + kh * u; po += S[i] * RAW[t * 128 + kq * 32 + i]; }
        __syncthreads();
        RED[kq * 128 + v] = po * rq;
        __syncthreads();
        if (kq == 0) OB[t * 128 + v] = (RED[v] + RED[128 + v]) + (RED[256 + v] + RED[384 + v]);
        __syncthreads();
    }
    if (wave < 4) { const int t = wave; const float x0 = OB[t * 128 + lane], x1 = OB[t * 128 + 64 + lane];
        const float ss = wave_sum(x0 * x0 + x1 * x1); const float sc = rsqrtf(ss * (1.f / 128.f) + EPS);
        const float g0 = bf2f(PROJ[(size_t)(tokS + t) * NPROJ + PC_G + h * 128 + lane]), g1 = bf2f(PROJ[(size_t)(tokS + t) * NPROJ + PC_G + h * 128 + 64 + lane]);
        MIX[(size_t)(tokS + t) * D + h * 128 + lane] = (bf16_t)f2bf(x0 * sc * A.in[I_ONORM][l * 128 + lane] * silu_f(g0));
        MIX[(size_t)(tokS + t) * D + h * 128 + 64 + lane] = (bf16_t)f2bf(x1 * sc * A.in[I_ONORM][l * 128 + 64 + lane] * silu_f(g1)); }
    { float* dsp = A.out + O_DS + (size_t)((l * 128 + b) * 4 + h) * 16384;
#pragma unroll
      for (int i = 0; i < 32; ++i) dsp[(kq * 32 + i) * 128 + v] = S[i]; }
    __syncthreads();
}

#define SSM_BCAST_U(t) do { unsigned _w[8]; \
        _w[0] = __builtin_amdgcn_readlane(ua.x, t); _w[1] = __builtin_amdgcn_readlane(ua.y, t); _w[2] = __builtin_amdgcn_readlane(ua.z, t); _w[3] = __builtin_amdgcn_readlane(ua.w, t); \
        _w[4] = __builtin_amdgcn_readlane(ub.x, t); _w[5] = __builtin_amdgcn_readlane(ub.y, t); _w[6] = __builtin_amdgcn_readlane(ub.z, t); _w[7] = __builtin_amdgcn_readlane(ub.w, t); \
        _Pragma("unroll") for (int _d = 0; _d < 8; ++_d) { uu[2 * _d] = __uint_as_float(_w[_d] << 16); uu[2 * _d + 1] = __uint_as_float(_w[_d] & 0xffff0000u); } } while (0)
#define SSM_STEP() do { float _br = 0.f, _bi = 0.f; \
        _Pragma("unroll") for (int _h = 0; _h < 16; ++_h) { _br = fmaf(Br[_h], uu[_h], _br); _bi = fmaf(Bi[_h], uu[_h], _bi); } \
        const float _nr = lr * hr - li * hi + _br, _ni = lr * hi + li * hr + _bi; hr = _nr; hi = _ni; } while (0)

__device__ __forceinline__ void ssm_part1_item(const DevArgs& A, int l, int it, int lane) {
    const int g = it & 15, bc = it >> 4, b = bc / 31, c = bc % 31;
    const float* bb = (const float*)(A.ws + WS_BBAR) + ((size_t)(l * 16 + g) * 64 + lane) * 32;
    float Br[16], Bi[16];
#pragma unroll
    for (int q = 0; q < 4; ++q) { const f32x4 x = ((const f32x4*)bb)[q], y = ((const f32x4*)bb)[4 + q];
        Br[4 * q] = x.x; Br[4 * q + 1] = x.y; Br[4 * q + 2] = x.z; Br[4 * q + 3] = x.w; Bi[4 * q] = y.x; Bi[4 * q + 1] = y.y; Bi[4 * q + 2] = y.z; Bi[4 * q + 3] = y.w; }
    const f32x4 lk = ((const f32x4*)(A.ws + WS_SSMK))[(l * 16 + g) * 64 + lane]; const float lr = lk.x, li = lk.y;
    const bf16_t* up = (const bf16_t*)(A.ws + WS_PROJ) + (size_t)(b * SEQ + c * 64 + lane) * NPROJ + PC_SSM + g * 16;
    const u32x4 ua = *(const u32x4*)up, ub = *(const u32x4*)(up + 8);
    float hr = 0.f, hi = 0.f, uu[16];
#pragma unroll 1
    for (int t = 0; t < 64; ++t) { SSM_BCAST_U(t); SSM_STEP(); }
    f32x2 e; e.x = hr; e.y = hi;
    ((f32x2*)(A.ws + WS_SSME))[((size_t)(b * 32 + c) * 16 + g) * 64 + lane] = e;
}

__device__ __forceinline__ void ssm_part2_item(const DevArgs& A, int l, LAS unsigned char* lds, int it, int tid, int wave, int lane) {
    asm volatile("" : "+v"(tid)); lane = tid & 63; wave = __builtin_amdgcn_readfirstlane(tid >> 6);
    const int tok0 = it * 64, fr = lane & 15, quad = lane >> 4;
    const bool samp = it >= 256; const int b = it >> 5, c = it & 31;
    LAS unsigned char* YS = lds; LAS unsigned char* HS = lds + 33792 + wave * 4352;
    const bf16_t* PROJ = (const bf16_t*)(A.ws + WS_PROJ); bf16_t* MIX = (bf16_t*)(A.ws + WS_MIX);
#pragma unroll 1
    for (int gi = 0; gi < 2; ++gi) {
        const int g = wave * 2 + gi;
        const float* bb = (const float*)(A.ws + WS_BBAR) + ((size_t)(l * 16 + g) * 64 + lane) * 32;
        float Br[16], Bi[16];
#pragma unroll
        for (int q = 0; q < 4; ++q) { const f32x4 x = ((const f32x4*)bb)[q], y = ((const f32x4*)bb)[4 + q];
            Br[4 * q] = x.x; Br[4 * q + 1] = x.y; Br[4 * q + 2] = x.z; Br[4 * q + 3] = x.w; Bi[4 * q] = y.x; Bi[4 * q + 1] = y.y; Bi[4 * q + 2] = y.z; Bi[4 * q + 3] = y.w; }
        const f32x4 lk = ((const f32x4*)(A.ws + WS_SSMK))[(l * 16 + g) * 64 + lane]; const float lr = lk.x, li = lk.y, Lr = lk.z, Li = lk.w;
        bf16x8 Cb[4];
#pragma unroll
        for (int kk = 0; kk < 4; ++kk) { const size_t co = ((size_t)(l * 16 + g) * 16 + fr) * 64 + kk * 16 + quad * 4;
            const f32x4 cr = *(const f32x4*)(A.in[I_CRE] + co), ci = *(const f32x4*)(A.in[I_CIM] + co);
            u32x4 pk; pk.x = pk2(cr.x, -ci.x); pk.y = pk2(cr.y, -ci.y); pk.z = pk2(cr.z, -ci.z); pk.w = pk2(cr.w, -ci.w);
            Cb[kk] = __builtin_bit_cast(bf16x8, pk); }
        const bf16_t* up = PROJ + (size_t)(tok0 + lane) * NPROJ + PC_SSM + g * 16;
        const u32x4 ua = *(const u32x4*)up, ub = *(const u32x4*)(up + 8);
        float hr = 0.f, hi = 0.f, uu[16];
        if (!samp && c > 0) { const f32x2* E = (const f32x2*)(A.ws + WS_SSME) + ((size_t)(b * 32) * 16 + g) * 64 + lane;
#pragma unroll
            for (int cb = 0; cb < 32; cb += 16) { f32x2 ev[16];
#pragma unroll
                for (int q = 0; q < 16; ++q) { const int cc = cb + q; ev[q] = (cc < c) ? E[(size_t)cc * 1024] : (f32x2){0.f, 0.f}; }
#pragma unroll
                for (int q = 0; q < 16; ++q) { const int cc = cb + q; if (cc < c) { const float nr = Lr * hr - Li * hi + ev[q].x, ni = Lr * hi + Li * hr + ev[q].y; hr = nr; hi = ni; } } } }
        const float dsk = A.in[I_SSMD][l * 256 + g * 16 + fr];
        unsigned uvr[16];
#pragma unroll
        for (int e = 0; e < 16; ++e) uvr[e] = PROJ[(size_t)(tok0 + (e >> 2) * 16 + quad * 4 + (e & 3)) * NPROJ + PC_SSM + g * 16 + fr];
#pragma unroll
        for (int sub = 0; sub < 4; ++sub) {
#pragma unroll 1
            for (int tt = 0; tt < 16; ++tt) { const int t = sub * 16 + tt;
                const int sb = (it - 256) * 16 + (t >> 2);
                if (samp && (t & 3) == 0) { hr = A.in[I_SRE][((size_t)(l * 128 + sb) * 16 + g) * 64 + lane]; hi = A.in[I_SIM][((size_t)(l * 128 + sb) * 16 + g) * 64 + lane]; }
                SSM_BCAST_U(t); SSM_STEP();
                *(LAS unsigned*)(HS + tt * 272 + lane * 4) = pg8::cvt_pk_bf16(hr, hi);
                if (samp && (t & 3) == 3) { A.out[O_RES + ((size_t)(l * 128 + sb) * 16 + g) * 64 + lane] = hr; A.out[O_IMS + ((size_t)(l * 128 + sb) * 16 + g) * 64 + lane] = hi; }
            }
            LDS_FENCE();
            f32x4 acc = {0.f, 0.f, 0.f, 0.f};
#pragma unroll
            for (int kk = 0; kk < 4; ++kk) { const bf16x8 a = *(LAS bf16x8*)(HS + fr * 272 + (kk * 32 + quad * 8) * 2); acc = mfma16(a, Cb[kk], acc); }
#pragma unroll
            for (int i = 0; i < 4; ++i) { const int t = sub * 16 + quad * 4 + i; const float uv = bf2f(uvr[sub * 4 + i]);
                *(LAS bf16_t*)(YS + t * 528 + (g * 16 + fr) * 2) = (bf16_t)f2bf(gelu_tanh_f(acc[i] + dsk * uv)); }
            LDS_FENCE();
        }
        if (!samp && c == 31) { A.out[O_REP + ((size_t)(l * 8 + b) * 16 + g) * 64 + lane] = hr; A.out[O_IMP + ((size_t)(l * 8 + b) * 16 + g) * 64 + lane] = hi; }
    }
    __syncthreads();
    {
        const bf16_t* GT = (const bf16_t*)(A.ws + WS_GLUT + l * SZ_GLUT);
        f32x4 acc[4][2];
#pragma unroll
        for (int mt = 0; mt < 4; ++mt) { acc[mt][0] = (f32x4){0.f, 0.f, 0.f, 0.f}; acc[mt][1] = (f32x4){0.f, 0.f, 0.f, 0.f}; }
#pragma unroll
        for (int kk = 0; kk < 8; ++kk) { bf16x8 bfr[2];
#pragma unroll
            for (int nt = 0; nt < 2; ++nt) bfr[nt] = *(const bf16x8*)(GT + (size_t)(32 * wave + nt * 16 + fr) * 256 + kk * 32 + quad * 8);
#pragma unroll
            for (int mt = 0; mt < 4; ++mt) { const bf16x8 a = *(LAS bf16x8*)(YS + (mt * 16 + fr) * 528 + (kk * 32 + quad * 8) * 2);
                acc[mt][0] = mfma16(a, bfr[0], acc[mt][0]); acc[mt][1] = mfma16(a, bfr[1], acc[mt][1]); } }
#pragma unroll
        for (int nt = 0; nt < 2; ++nt) { const int ncol = 32 * wave + nt * 16 + fr; const float gb = A.in[I_GLUB][l * 256 + ncol];
#pragma unroll
            for (int mt = 0; mt < 4; ++mt)
#pragma unroll
                for (int i = 0; i < 4; ++i) { const int t = mt * 16 + quad * 4 + i; const float y = bf2f(*(LAS bf16_t*)(YS + t * 528 + ncol * 2));
                    MIX[(size_t)(tok0 + t) * D + 512 + ncol] = (bf16_t)f2bf(y * sigmoid_f(acc[mt][nt][i] + gb)); } }
    }
    __syncthreads();
}

__device__ __forceinline__ void pool_item(const DevArgs& A, int l, LAS unsigned char* lds, int it, int tid, int wave, int lane) {
    asm volatile("" : "+v"(tid)); lane = tid & 63; wave = __builtin_amdgcn_readfirstlane(tid >> 6);
    const int tok0 = it * 64, fr = lane & 15, quad = lane >> 4; const bool samp = it >= 256;
    LAS unsigned char* RS = lds;
    const bf16_t* PROJ = (const bf16_t*)(A.ws + WS_PROJ); bf16_t* MIX = (bf16_t*)(A.ws + WS_MIX);
    if (!samp) {
        LAS unsigned char* XT = lds + 33792;
        const int b = it >> 5, c = it & 31;
        for (int id = tid; id < 79 * 32; id += 512) { const int r = id >> 5, c16 = id & 31, tl = c * 64 - 15 + r;
            u32x4 v = {0u, 0u, 0u, 0u}; if (tl >= 0) v = *(const u32x4*)(PROJ + (size_t)(b * SEQ + tl) * NPROJ + PC_POOL + c16 * 8);
            *(LAS u32x4*)(XT + r * 528 + c16 * 16) = v; }
        __syncthreads();
        const int ch = tid & 255, half = tid >> 8, g = ch >> 6, w = 2 << g, r0 = half * 32;
        float sum = 0.f;
        for (int j = 0; j < w; ++j) sum += bf2f(*(LAS bf16_t*)(XT + (r0 + 15 - j) * 528 + ch * 2));
#pragma unroll 4
        for (int rr = 0; rr < 32; ++rr) { const int r = r0 + rr, tl = c * 64 + r;
            const float u = bf2f(*(LAS bf16_t*)(XT + (r + 15) * 528 + ch * 2));
            if (rr > 0) sum += u - bf2f(*(LAS bf16_t*)(XT + (r + 15 - w) * 528 + ch * 2));
            const float cnt = (float)((tl + 1 < w) ? tl + 1 : w);
            *(LAS bf16_t*)(RS + r * 528 + ch * 2) = (bf16_t)f2bf(sum / cnt - u); }
    } else {
#pragma unroll 1
        for (int pr = 0; pr < 8; ++pr) { const int idx = pr * 512 + tid, ch = idx & 255, sq = idx >> 8, g = ch >> 6, w = 2 << g;
            const int sb = (it - 256) * 16 + sq;
            const float* sbuf = A.in[I_SPOOL] + (size_t)(l * 128 + sb) * 15 * 256 + ch;
            const bf16_t* base = PROJ + (size_t)(NP + sb * 4) * NPROJ + PC_POOL + ch;
            float e[19];
#pragma unroll
            for (int j = 0; j < 15; ++j) e[j] = sbuf[j * 256];
#pragma unroll
            for (int j = 0; j < 4; ++j) e[15 + j] = bf2f(base[(size_t)j * NPROJ]);
#pragma unroll
            for (int t = 0; t < 4; ++t) { float sum = 0.f;
#pragma unroll
                for (int j = 0; j < 16; ++j) sum += (j < w) ? e[15 + t - j] : 0.f;
                *(LAS bf16_t*)(RS + (sq * 4 + t) * 528 + ch * 2) = (bf16_t)f2bf(sum / (float)w - e[15 + t]); } }
    }
    __syncthreads();
    { const int g2 = wave >> 1; const bf16_t* PT = (const bf16_t*)(A.ws + WS_POOLT + l * SZ_POOLT) + g2 * 4096;
      f32x4 acc[4][2];
#pragma unroll
      for (int mt = 0; mt < 4; ++mt) { acc[mt][0] = (f32x4){0.f, 0.f, 0.f, 0.f}; acc[mt][1] = (f32x4){0.f, 0.f, 0.f, 0.f}; }
#pragma unroll
      for (int kk = 0; kk < 2; ++kk) { bf16x8 bfr[2];
#pragma unroll
          for (int nt = 0; nt < 2; ++nt) bfr[nt] = *(const bf16x8*)(PT + (size_t)((wave & 1) * 32 + nt * 16 + fr) * 64 + kk * 32 + quad * 8);
#pragma unroll
          for (int mt = 0; mt < 4; ++mt) { const bf16x8 a = *(LAS bf16x8*)(RS + (mt * 16 + fr) * 528 + (g2 * 64 + kk * 32 + quad * 8) * 2);
              acc[mt][0] = mfma16(a, bfr[0], acc[mt][0]); acc[mt][1] = mfma16(a, bfr[1], acc[mt][1]); } }
#pragma unroll
      for (int nt = 0; nt < 2; ++nt) { const int col = 32 * wave + nt * 16 + fr; const float ps = A.in[I_POOLS][l * 256 + col];
#pragma unroll
          for (int mt = 0; mt < 4; ++mt)
#pragma unroll
              for (int i = 0; i < 4; ++i) { const int t = mt * 16 + quad * 4 + i; MIX[(size_t)(tok0 + t) * D + 768 + col] = (bf16_t)f2bf(acc[mt][nt][i] * ps); } } }
    __syncthreads();
}

__device__ __forceinline__ void state_copies(const DevArgs& A, int l, int gt, int NT) {
    const bf16_t* PROJ = (const bf16_t*)(A.ws + WS_PROJ);
#pragma unroll 1
    for (int i = gt; i < 8 * 3 * 1536; i += NT) { const int col = i % 1536, j = (i / 1536) % 3, b = i / 4608;
        A.out[O_CP + (size_t)l * 8 * 4608 + i] = bf2f(PROJ[(size_t)(b * SEQ + SEQ - 3 + j) * NPROJ + col]); }
#pragma unroll 1
    for (int i = gt; i < 128 * 3 * 1536; i += NT) { const int col = i % 1536, j = (i / 1536) % 3, b = i / 4608;
        A.out[O_CS + (size_t)l * 128 * 4608 + i] = bf2f(PROJ[(size_t)(NP + b * 4 + 1 + j) * NPROJ + col]); }
#pragma unroll 1
    for (int i = gt; i < 8 * 15 * 256; i += NT) { const int ch = i & 255, j = (i >> 8) % 15, b = i / 3840;
        A.out[O_PP + (size_t)l * 8 * 3840 + i] = bf2f(PROJ[(size_t)(b * SEQ + SEQ - 15 + j) * NPROJ + PC_POOL + ch]); }
#pragma unroll 1
    for (int i = gt; i < 128 * 15 * 256; i += NT) { const int ch = i & 255, j = (i >> 8) % 15, b = i / 3840;
        A.out[O_PS + (size_t)l * 128 * 3840 + i] = (j < 11) ? A.in[I_SPOOL][((size_t)(l * 128 + b) * 15 + 4 + j) * 256 + ch]
                                                             : bf2f(PROJ[(size_t)(NP + b * 4 + (j - 11)) * NPROJ + PC_POOL + ch]); }
}

#ifndef REP_DPREP
#define REP_DPREP 1
#endif
#ifndef REP_DSAMP
#define REP_DSAMP 1
#endif
#ifndef REP_SSM1
#define REP_SSM1 1
#endif
#ifndef REP_POOL
#define REP_POOL 1
#endif
#ifndef REP_DSCAN
#define REP_DSCAN 1
#endif
#ifndef REP_SSM2
#define REP_SSM2 1
#endif
#ifndef REP_G
#define REP_G 1
#endif
#ifndef REP_P3
#define REP_P3 1
#endif
#ifndef REP_P2
#define REP_P2 1
#endif
constexpr int NPH = 2 + DEPTH * 8;
__global__ void __launch_bounds__(512, 2) mega_fwd(Args KA) {
    DevArgs A; A.out = KA.out; A.ws = KA.ws; A.ph_lo = KA.ph_lo; A.ph_hi = KA.ph_hi;
    extern __shared__ __attribute__((aligned(16))) unsigned char lds_raw[];
    LAS unsigned char* lds = (LAS unsigned char*)lds_raw;
    cg::grid_group grid = cg::this_grid();
    volatile LAS unsigned* xst = (volatile LAS unsigned*)(lds + LDS_BYTES - 64);
    if (threadIdx.x == 0) { xst[0] = 0u; xst[1] = 0u; }
    __syncthreads();
    const XcdBarrier xb = xcd_barrier_post((unsigned*)(KA.ws + WS_BAR), xst);
    constexpr int G = 256, NGW = G * 8, NT = G * 512;
    int ph = 0;
#define PH_BEGIN if (A.ph_lo <= ph && ph < A.ph_hi) { int tid = threadIdx.x; asm volatile("" : "+v"(tid)); { unsigned char* _w = A.ws; asm volatile("" : "+s"(_w)); A.ws = _w; float* _o = A.out; asm volatile("" : "+s"(_o)); A.out = _o; } const int wave = __builtin_amdgcn_readfirstlane(tid >> 6), lane = tid & 63, gw = blockIdx.x * 8 + wave, gt = blockIdx.x * 512 + tid; (void)gw; (void)gt; (void)lane;
#define PH_END   if (ph + 1 < A.ph_hi) { if (ph == 0) grid.sync(); else xcd_barrier(xb); } } ++ph;
#define Hb   ((bf16_t*)(A.ws + WS_H))
#define AB   ((float*)(A.ws + WS_AB))
#define MIXO ((float*)(A.ws + WS_MIXO))
#define PROJ ((bf16_t*)(A.ws + WS_PROJ))
#define MIX  ((bf16_t*)(A.ws + WS_MIX))
#define HID  ((bf16_t*)(A.ws + WS_HID))

#ifndef REP_PRO
#define REP_PRO 1
#endif
#ifndef REP_N0
#define REP_N0 1
#endif
    PH_BEGIN for (int rep = 0; rep < REP_PRO; ++rep) { prologue(A, lds, wave, lane, gw, NGW); __syncthreads(); } PH_END
    PH_BEGIN for (int rep = 0; rep < REP_N0; ++rep) norm_rows(nullptr, nullptr, A.in[I_XP], A.in[I_XS], nullptr, A.in[I_NMPRE], Hb, (const float*)(A.ws + WS_WAB), AB, gw, NGW, lane); PH_END

#pragma unroll 1
    for (int l = 0; l < DEPTH; ++l) {
        PH_BEGIN for (int rep = 0; rep < REP_G; ++rep) { pg8::Gemm g{Hb, (const bf16_t*)(A.ws + WS_WIN + l * SZ_WIN), NTOK, NPROJ, D, D, D}; pg8::StaticOrder S; S.init(NTOK, NPROJ, G, (int)blockIdx.x);
            pg8::EpiBf16<0> E{PROJ, NPROJ, nullptr, 0, 0}; pg8::gemm_phase<pg8::EpiBf16<0>, pg8::StaticOrder>(lds, g, S, E, nullptr); } PH_END
        constexpr int SUBC = 7;
        PH_BEGIN {
#pragma unroll 1
          for (int rep2 = 0; rep2 < REP_P2; ++rep2) {
#pragma unroll 1
            for (int j = blockIdx.x; j < 32 * SUBC; j += G) delta_prep_item(A, l, lds, (j & 31) * 32 + (j >> 5), tid, wave, lane);
          }
        } PH_END
        PH_BEGIN {
#pragma unroll 1
            for (int rep3 = 0; rep3 < REP_P3; ++rep3) {
                if (blockIdx.x < 32) delta_scan_item(A, l, lds, blockIdx.x, tid, wave, lane, xb, SUBC);
                else { const int w = blockIdx.x - 32; constexpr int NW = G - 32;
#pragma unroll 1
                    for (int k = 1; k <= 5; ++k) {
                        const int n0 = k * SUBC, nn = (n0 >= 32) ? 0 : ((32 - n0 < SUBC) ? 32 - n0 : SUBC);
                        int nprep = 32 * nn;
#ifndef REP_WPREP
#define REP_WPREP 1
#endif
#pragma unroll 1
                        for (int rep = 0; rep < REP_WPREP; ++rep)
#pragma unroll 1
                        for (int j = w; j < nprep; j += NW) delta_prep_item(A, l, lds, (j & 31) * 32 + n0 + (j >> 5), tid, wave, lane);
                        if (k == 1) {
#pragma unroll 1
                            for (int it = w; it < 512; it += NW) delta_sample_item(A, l, lds, it, tid, wave, lane); }
                        if (k == 2) {
#pragma unroll 1
                            for (int it = w * 8 + wave; it < 8 * 31 * 16; it += NW * 8) { int t1 = threadIdx.x; asm volatile("" : "+v"(t1)); ssm_part1_item(A, l, it, t1 & 63); }
                            { int t2 = threadIdx.x; asm volatile("" : "+v"(t2)); int wl = blockIdx.x; asm volatile("" : "+s"(wl)); state_copies(A, l, (wl - 32) * 512 + t2, NW * 512); } }
                        if (k == 3) {
#pragma unroll 1
                            for (int it = w; it < 264; it += NW) pool_item(A, l, lds, it, tid, wave, lane); }
                        { const int it = (k == 4) ? w - 128 : ((k == 5) ? 96 + w : -1);
                          if (it >= 0 && it < ((k == 4) ? 96 : 264)) ssm_part2_item(A, l, lds, it, tid, wave, lane); }
                        if (k < 5) xcd_barrier(xb);
                    } }
            }
        } PH_END
        PH_BEGIN for (int rep = 0; rep < REP_G; ++rep) { pg8::Gemm g{MIX, (const bf16_t*)(A.ws + WS_WOUT + l * SZ_WOUT), NP, D, D, D, D}; pg8::StaticOrder S; S.init(NP, D, G, (int)blockIdx.x);
            pg8::EpiF32 E{MIXO, D, nullptr}; pg8::gemm_phase<pg8::EpiF32, pg8::StaticOrder>(lds, g, S, E, nullptr);
            pg8::Gemm g2{MIX + (size_t)NP * D, (const bf16_t*)(A.ws + WS_WOUT + l * SZ_WOUT), NS, D, 256, D, D}; SliceOrder S2{8 * (D / 256), G, (int)blockIdx.x};
            EpiF32Part E2{(float*)(A.ws + WS_PARTS)}; pg8::gemm_phase<EpiF32Part, SliceOrder>(lds, g2, S2, E2, nullptr); } PH_END
#ifndef REP_N5
#define REP_N5 1
#endif
        PH_BEGIN for (int rep = 0; rep < (l == 0 ? REP_N5 : 1); ++rep) norm_rows(MIXO, A.in[I_NMPOST] + l * D, l == 0 ? A.in[I_XP] : A.out, l == 0 ? A.in[I_XS] : nullptr, A.out, A.in[I_NFPRE] + l * D, Hb, nullptr, nullptr, gw, NGW, lane, (const float*)(A.ws + WS_PARTS), D / 256); PH_END
        PH_BEGIN for (int rep = 0; rep < REP_G; ++rep) { pg8::Gemm g{Hb, (const bf16_t*)(A.ws + WS_WGU + l * SZ_WGU), NTOK, NGU, D, D, D}; pg8::StaticOrder S; S.init(NTOK, NGU, G, (int)blockIdx.x);
            EpiSwiGLU E{HID, DFF}; pg8::gemm_phase<EpiSwiGLU, pg8::StaticOrder>(lds, g, S, E, nullptr); } PH_END
        PH_BEGIN for (int rep = 0; rep < REP_G; ++rep) { pg8::Gemm g{HID, (const bf16_t*)(A.ws + WS_WDN + l * SZ_WDN), NP, D, DFF, DFF, DFF}; pg8::StaticOrder S; S.init(NP, D, G, (int)blockIdx.x);
            pg8::EpiF32 E{MIXO, D, nullptr}; pg8::gemm_phase<pg8::EpiF32, pg8::StaticOrder>(lds, g, S, E, nullptr);
            pg8::Gemm g2{HID + (size_t)NP * DFF, (const bf16_t*)(A.ws + WS_WDN + l * SZ_WDN), NS, D, 256, DFF, DFF}; SliceOrder S2{8 * (DFF / 256), G, (int)blockIdx.x};
            EpiF32Part E2{(float*)(A.ws + WS_PARTS)}; pg8::gemm_phase<EpiF32Part, SliceOrder>(lds, g2, S2, E2, nullptr); } PH_END
        PH_BEGIN norm_rows(MIXO, A.in[I_NFPOST] + l * D, A.out, nullptr, A.out, l + 1 < DEPTH ? A.in[I_NMPRE] + (l + 1) * D : nullptr, l + 1 < DEPTH ? Hb : nullptr,
                           l + 1 < DEPTH ? (const float*)(A.ws + WS_WAB + (l + 1) * SZ_WAB) : nullptr, AB, gw, NGW, lane, (const float*)(A.ws + WS_PARTS), DFF / 256); PH_END
    }
#undef PH_BEGIN
#undef PH_END
#undef Hb
#undef AB
#undef MIXO
#undef PROJ
#undef MIX
#undef HID
}

extern "C" void kernel_launch(void* const* d_in, const int* in_sizes, int n_in, void* d_out, int out_size, void* d_ws, size_t ws_size, hipStream_t stream) {
    static int grid = 0;
    if (grid == 0) {
        if (n_in != 32 || (size_t)out_size != O_END || ws_size < WS_END) fprintf(stderr, "kernel_launch: unexpected sizes: n_in %d out %d (want %zu) ws %zu (want >= %zu)\n", n_in, out_size, (size_t)O_END, ws_size, (size_t)WS_END);
        int dev = 0, cus = 0, per_cu = 0;
        (void)hipGetDevice(&dev); (void)hipDeviceGetAttribute(&cus, hipDeviceAttributeMultiprocessorCount, dev);
        if (hipFuncSetAttribute((const void*)mega_fwd, hipFuncAttributeMaxDynamicSharedMemorySize, LDS_BYTES) != hipSuccess) fprintf(stderr, "kernel_launch: hipFuncSetAttribute failed\n");
        if (hipOccupancyMaxActiveBlocksPerMultiprocessor(&per_cu, (const void*)mega_fwd, 512, LDS_BYTES) != hipSuccess || per_cu < 1) { fprintf(stderr, "kernel_launch: occupancy query gave %d\n", per_cu); per_cu = 1; (void)hipGetLastError(); }
        grid = cus * per_cu; if (grid <= 0) grid = 256;
        if (grid >= 256) grid = 256;
        fprintf(stderr, "kernel_launch: grid %d (cus %d x %d)%s\n", grid, cus, per_cu, grid < 256 ? "  ERROR: this build needs >= 256 co-resident workgroups" : "");
    }
    (void)hipMemsetAsync((unsigned char*)d_ws + WS_BAR, 0, 16384, stream);
    Args a{};
    for (int i = 0; i < 32; ++i) a.in[i] = (const float*)d_in[i];
    a.out = (float*)d_out; a.ws = (unsigned char*)d_ws;
#if MK_COOP
    a.ph_lo = 0; a.ph_hi = NPH;
    void* args[] = {&a};
    const hipError_t e = hipLaunchCooperativeKernel((const void*)mega_fwd, dim3(grid), dim3(512), args, LDS_BYTES, stream);
    if (e != hipSuccess) fprintf(stderr, "kernel_launch: cooperative launch failed: %s (grid %d)\n", hipGetErrorString(e), grid);
#else
    for (int p = 0; p < NPH; ++p) { a.ph_lo = p; a.ph_hi = p + 1; hipLaunchKernelGGL(mega_fwd, dim3(grid), dim3(512), LDS_BYTES, stream, a); }
#endif
}
```

```cpp
#include <hip/hip_runtime.h>
#include <hip/hip_cooperative_groups.h>
#include <cstdio>
#include <cstdint>
namespace cg = cooperative_groups;
#ifndef MK_COOP
#define MK_COOP 1
#endif
namespace pg8 {
#define PG8_LAS __attribute__((address_space(3)))
typedef unsigned short bf16_t;
typedef short bf16x8 __attribute__((ext_vector_type(8)));
typedef float f32x4 __attribute__((ext_vector_type(4)));
typedef unsigned u32x4 __attribute__((ext_vector_type(4)));
constexpr int BM = 256, BK = 64, HALF = 128, HTB = HALF * BK * 2  , STAGE_BYTES = 8 * HTB, NXCD = 8, WGM = 8;

__host__ __device__ __forceinline__ int lds_byte(int r, int c) { const int st = (r >> 4) * 2 + (c >> 5), rr = r & 15, cc = c & 31, ob = rr * 64 + cc * 2; return st * 1024 + (ob ^ (((ob >> 9) & 1) << 5)); }
__host__ __device__ __forceinline__ void stage_rc(int b, int& R, int& C) { const int st = b / 1024, sb = b % 1024, swz = sb ^ (((sb >> 9) & 1) << 5); R = (st >> 1) * 16 + swz / 64; C = (st & 1) * 32 + (swz % 64) / 2; }
__host__ __device__ __forceinline__ int perm32(int rho) { const int n = rho >> 4, i = rho & 15; return 8 * (i >> 2) + 4 * n + (i & 3); }

struct Unit { int pm, pn, ks; };
struct Gemm { const bf16_t* A; const bf16_t* Bt; int M, N, K, lda, ldb; };

struct StaticOrder {
    int nM, nN, nwg, G, c;
    __host__ __device__ void init(int M, int N, int G_, int c_) { nM = M / BM; nN = N / BM; nwg = nM * nN; G = G_; c = c_; }
    __host__ __device__ bool next(int i, Unit& u) const {
        const long L = (long)i * G + c; if (L >= nwg) return false;
        int wgid = (int)L; { const int q = nwg / NXCD, r = nwg % NXCD, xcd = wgid % NXCD, off = wgid / NXCD; wgid = (xcd < r ? xcd * (q + 1) : r * (q + 1) + (xcd - r) * q) + off; }
        const int nig = WGM * nN, gid = wgid / nig, fm = gid * WGM, gsz = (nM - fm) < WGM ? (nM - fm) : WGM;
        u.pm = fm + ((wgid % nig) % gsz); u.pn = (wgid % nig) / gsz; u.ks = 0; return true;
    }
    __device__ __forceinline__ void a_ready(const Unit&) const {}
    __device__ __forceinline__ void done(const Unit&) const {}
};
__device__ __forceinline__ unsigned cvt_pk_bf16(float lo, float hi) { unsigned r; asm volatile("v_cvt_pk_bf16_f32 %0, %1, %2" : "=v"(r) : "v"(lo), "v"(hi)); return r; }
typedef float f32x2 __attribute__((ext_vector_type(2)));
__device__ __forceinline__ f32x2 gelu_pk(f32x2 v) {
    const f32x2 av = __builtin_elementwise_abs(v), d = av * 0.2316418882f + 1.0f;
    f32x2 t; t.x = __builtin_amdgcn_rcpf(d.x); t.y = __builtin_amdgcn_rcpf(d.y);
    f32x2 q = t * 0.5307027145f + (-0.7265760135f); q = q * t + 0.7107068705f; q = q * t + (-0.142248368f); q = q * t + 0.127414796f; q = q * t;
    const f32x2 s = (v * v) * (-0.72134752044f);
    f32x2 e; e.x = __builtin_amdgcn_exp2f(s.x); e.y = __builtin_amdgcn_exp2f(s.y);
    const f32x2 m = v * (q * e), r = v - m;
    f32x2 o; o.x = v.x < 0.f ? m.x : r.x; o.y = v.y < 0.f ? m.y : r.y; return o;
}

struct EpiF32 {
    static constexpr bool PERM = false, AFTER_DRAIN = false;
    float* C; int ldc; const float* bias;
    __device__ __forceinline__ void operator()(const f32x4 (&acc)[2][2][4][2], const Unit& u, int wr, int wc, int fr, int fq) const {
        const int row0 = u.pm * BM + wr * 64 + fr, col0 = u.pn * BM + wc * 32 + 4 * fq;
        f32x4 bv[2][2];
#pragma unroll
        for (int bj = 0; bj < 2; ++bj)
#pragma unroll
            for (int n = 0; n < 2; ++n) bv[bj][n] = bias ? *(const f32x4*)(bias + col0 + bj * HALF + n * 16) : (f32x4){0.f, 0.f, 0.f, 0.f};
#pragma unroll
        for (int ai = 0; ai < 2; ++ai)
#pragma unroll
            for (int m = 0; m < 4; ++m) { float* rowp = C + (size_t)(row0 + ai * HALF + m * 16) * ldc + col0;
#pragma unroll
                for (int bj = 0; bj < 2; ++bj)
#pragma unroll
                    for (int n = 0; n < 2; ++n) *(f32x4*)(rowp + bj * HALF + n * 16) = acc[ai][bj][m][n] + bv[bj][n]; }
    }
};
template <int ACT  > struct EpiBf16 {
    static constexpr bool PERM = true, AFTER_DRAIN = false;
    bf16_t* O; int ldc; const float* bias; int split_cols; size_t split_stride;
    __device__ __forceinline__ void operator()(const f32x4 (&acc)[2][2][4][2], const Unit& u, int wr, int wc, int fr, int fq) const {
        const int row0 = u.pm * BM + wr * 64 + fr; int colt = u.pn * BM; bf16_t* base = O;
        if (split_cols) { const int t = colt / split_cols; base += (size_t)t * split_stride; colt -= t * split_cols; }
        const int col0 = colt + wc * 32 + 8 * fq, bcol0 = u.pn * BM + wc * 32 + 8 * fq;
        f32x4 bv[2][2];
#pragma unroll
        for (int bj = 0; bj < 2; ++bj)
#pragma unroll
            for (int n = 0; n < 2; ++n) bv[bj][n] = bias ? *(const f32x4*)(bias + bcol0 + bj * HALF + 4 * n) : (f32x4){0.f, 0.f, 0.f, 0.f};
#pragma unroll
        for (int ai = 0; ai < 2; ++ai)
#pragma unroll
            for (int m = 0; m < 4; ++m) { bf16_t* rowp = base + (size_t)(row0 + ai * HALF + m * 16) * ldc + col0;
#pragma unroll
                for (int bj = 0; bj < 2; ++bj) { f32x4 v0 = acc[ai][bj][m][0] + bv[bj][0], v1 = acc[ai][bj][m][1] + bv[bj][1];
                    if (ACT == 1) { f32x2 a = gelu_pk((f32x2){v0[0], v0[1]}), b = gelu_pk((f32x2){v0[2], v0[3]}), c = gelu_pk((f32x2){v1[0], v1[1]}), d = gelu_pk((f32x2){v1[2], v1[3]});
                        v0 = (f32x4){a.x, a.y, b.x, b.y}; v1 = (f32x4){c.x, c.y, d.x, d.y}; }
                    if (ACT == 2) {
#pragma unroll
                        for (int j = 0; j < 4; ++j) { v0[j] = 0.5f * v0[j] * (1.0f + erff(v0[j] * 0.70710678f)); v1[j] = 0.5f * v1[j] * (1.0f + erff(v1[j] * 0.70710678f)); } }
                    u32x4 w; w.x = cvt_pk_bf16(v0[0], v0[1]); w.y = cvt_pk_bf16(v0[2], v0[3]); w.z = cvt_pk_bf16(v1[0], v1[1]); w.w = cvt_pk_bf16(v1[2], v1[3]);
                    *(u32x4*)(rowp + bj * HALF) = w; } }
    }
};
template <class Epi, class Sched, bool STAMP = false>
__device__ __forceinline__ void gemm_phase(PG8_LAS unsigned char* lds, const Gemm g, const Sched& S, const Epi& E, unsigned long long* stamps) {
    int tid_ = threadIdx.x; asm volatile("" : "+v"(tid_));
    const int tid = tid_, wid = __builtin_amdgcn_readfirstlane(tid >> 6), lane = tid & 63, wr = wid >> 2, wc = wid & 3, fr = lane & 15, fq = lane >> 4;
    const int K = g.K, nt = K / BK;
    int ts_lo = 0, ts_hi = 0, nts = 0; const unsigned long long rt_entry = STAMP ? (unsigned long long)wall_clock64() : 0ull;
#define PG8_STAMP() do { if (STAMP && wid == 0 && nts < 64) { const unsigned long long _c = (unsigned long long)clock64(); \
        ts_lo = (lane == nts) ? (int)(unsigned)_c : ts_lo; ts_hi = (lane == nts) ? (int)(unsigned)(_c >> 32) : ts_hi; ++nts; } } while (0)
    PG8_STAMP();
    unsigned voffA[2], voffB[2];
#pragma unroll
    for (int i = 0; i < 2; ++i) { int R, C; stage_rc(tid * 16 + i * 8192, R, C); const int Rb = Epi::PERM ? ((R & ~31) + perm32(R & 31)) : R;
        voffA[i] = (unsigned)(R * g.lda + C) * 2u; voffB[i] = (unsigned)(Rb * g.ldb + C) * 2u; }
    const size_t kstep = (size_t)(BK * 2);
    const size_t hstepA = (size_t)HALF * g.lda * 2, hstepB = (size_t)HALF * g.ldb * 2;
    const size_t tstepA = 2 * hstepA, tstepB = 2 * hstepB, sstep = (size_t)K * 2;
    const unsigned ldsw = (unsigned)wid * 1024u;
    const int aoff = lds_byte(wr * 64 + fr, fq * 8), boff = lds_byte(wc * 32 + fr, fq * 8);
#define PG8_SA(b, h) (((b) * 2 + (h)) * HTB)
#define PG8_SB(b, h) ((4 + (b) * 2 + (h)) * HTB)
#define PG8_STAGE(bufoff, gbase, voff) do { _Pragma("unroll") for (int _i = 0; _i < 2; ++_i) \
        __builtin_amdgcn_global_load_lds((const unsigned*)((const char*)(gbase) + (voff)[_i]), (PG8_LAS unsigned*)(lds + (bufoff) + ldsw + _i * 8192), 16, 0, 0); } while (0)
#define PG8_LDA(dst, b, h) do { _Pragma("unroll") for (int m = 0; m < 4; ++m) _Pragma("unroll") for (int k = 0; k < 2; ++k) dst[m][k] = *(const PG8_LAS bf16x8*)(lds + PG8_SA(b, h) + aoff + m * 2048 + k * 1024); } while (0)
#define PG8_LDB(dst, b, h) do { _Pragma("unroll") for (int n = 0; n < 2; ++n) _Pragma("unroll") for (int k = 0; k < 2; ++k) dst[n][k] = *(const PG8_LAS bf16x8*)(lds + PG8_SB(b, h) + boff + n * 2048 + k * 1024); } while (0)
#define PG8_MMA(ai, bj, At, Bt) do { __builtin_amdgcn_s_setprio(1); _Pragma("unroll") for (int m = 0; m < 4; ++m) _Pragma("unroll") for (int n = 0; n < 2; ++n) _Pragma("unroll") for (int k = 0; k < 2; ++k) \
        acc[ai][bj][m][n] = __builtin_amdgcn_mfma_f32_16x16x32_bf16(Bt[n][k], At[m][k], acc[ai][bj][m][n], 0, 0, 0); __builtin_amdgcn_s_setprio(0); } while (0)
#define PG8_WAIT_V(n) asm volatile("s_waitcnt vmcnt(" #n ")" ::: "memory")
#define PG8_WAIT_L(n) asm volatile("s_waitcnt lgkmcnt(" #n ")" ::: "memory")
#define PG8_BAR __builtin_amdgcn_s_barrier()
#define PG8_SCHED __builtin_amdgcn_sched_barrier(0)
    Unit cur, nxt; int ui = 0;
    if (!S.next(0, cur)) return;
    f32x4 acc[2][2][4][2];
#pragma unroll
    for (int a = 0; a < 2; ++a)
#pragma unroll
        for (int b = 0; b < 2; ++b)
#pragma unroll
            for (int m = 0; m < 4; ++m)
#pragma unroll
                for (int n = 0; n < 2; ++n) acc[a][b][m][n] = (f32x4){0.f, 0.f, 0.f, 0.f};
    bf16x8 At[4][2], B0[2][2], B1[2][2];
    const char* cA = (const char*)g.A + (size_t)cur.pm * tstepA + (size_t)cur.ks * sstep; const char* cB = (const char*)g.Bt + (size_t)cur.pn * tstepB + (size_t)cur.ks * sstep;
    S.a_ready(cur);
    PG8_STAGE(PG8_SB(0, 0), cB, voffB); PG8_STAGE(PG8_SA(0, 0), cA, voffA); PG8_STAGE(PG8_SB(0, 1), cB + hstepB, voffB); PG8_STAGE(PG8_SA(0, 1), cA + hstepA, voffA);
    if (wr == 1) PG8_BAR;
    PG8_WAIT_V(4); PG8_BAR;
    PG8_STAGE(PG8_SB(1, 0), cB + kstep, voffB); PG8_STAGE(PG8_SA(1, 0), cA + kstep, voffA); PG8_STAGE(PG8_SB(1, 1), cB + hstepB + kstep, voffB);
    PG8_WAIT_V(6); PG8_BAR;
    PG8_STAMP();
    for (;;) {
        const bool has_next = S.next(ui + 1, nxt);
        const char* nA = has_next ? (const char*)g.A + (size_t)nxt.pm * tstepA + (size_t)nxt.ks * sstep : cA; const char* nB = has_next ? (const char*)g.Bt + (size_t)nxt.pn * tstepB + (size_t)nxt.ks * sstep : cB;
        for (int t = 0; t < nt; t += 2) {
            const bool last = (t == nt - 2);
            const char* a1 = cA + (size_t)(t + 1) * kstep;
            const char* a2 = last ? nA : cA + (size_t)(t + 2) * kstep; const char* b2 = last ? nB : cB + (size_t)(t + 2) * kstep;
            const char* a3 = a2 + kstep; const char* b3 = b2 + kstep;
            if (last && has_next) S.a_ready(nxt);
            PG8_LDB(B0, 0, 0); PG8_SCHED; PG8_LDA(At, 0, 0); PG8_STAGE(PG8_SA(1, 1), a1 + hstepA, voffA);
            PG8_WAIT_L(8); PG8_BAR; PG8_WAIT_L(0); PG8_MMA(0, 0, At, B0); PG8_BAR; PG8_SCHED;
            PG8_LDB(B1, 0, 1); PG8_STAGE(PG8_SB(0, 0), b2, voffB);
            PG8_BAR; PG8_WAIT_L(0); PG8_MMA(0, 1, At, B1); PG8_BAR;
            PG8_LDA(At, 0, 1); PG8_STAGE(PG8_SA(0, 0), a2, voffA);
            PG8_BAR; PG8_WAIT_L(0); PG8_MMA(1, 0, At, B0); PG8_BAR; PG8_SCHED;
            PG8_STAGE(PG8_SB(0, 1), b2 + hstepB, voffB);
            PG8_WAIT_V(6); PG8_BAR; PG8_MMA(1, 1, At, B1); PG8_BAR;
            PG8_LDB(B0, 1, 0); PG8_SCHED; PG8_LDA(At, 1, 0); PG8_STAGE(PG8_SA(0, 1), a2 + hstepA, voffA);
            PG8_WAIT_L(8); PG8_BAR; PG8_WAIT_L(0); PG8_MMA(0, 0, At, B0); PG8_BAR; PG8_SCHED;
            PG8_LDB(B1, 1, 1); PG8_STAGE(PG8_SB(1, 0), b3, voffB);
            PG8_BAR; PG8_WAIT_L(0); PG8_MMA(0, 1, At, B1); PG8_BAR;
            PG8_LDA(At, 1, 1); PG8_STAGE(PG8_SA(1, 0), a3, voffA);
            PG8_BAR; PG8_WAIT_L(0); PG8_MMA(1, 0, At, B0); PG8_BAR; PG8_SCHED;
            PG8_STAGE(PG8_SB(1, 1), b3 + hstepB, voffB);
            PG8_WAIT_V(6); PG8_BAR; PG8_MMA(1, 1, At, B1); PG8_BAR;
        }
        PG8_STAMP();
        if constexpr (!Epi::AFTER_DRAIN) { E(acc, cur, wr, wc, fr, fq); S.done(cur); }
        PG8_STAMP();
        if (!has_next) break;
#pragma unroll
        for (int a = 0; a < 2; ++a)
#pragma unroll
            for (int b = 0; b < 2; ++b)
#pragma unroll
                for (int m = 0; m < 4; ++m)
#pragma unroll
                    for (int n = 0; n < 2; ++n) acc[a][b][m][n] = (f32x4){0.f, 0.f, 0.f, 0.f};
        cur = nxt; cA = nA; cB = nB; ++ui;
    }
    PG8_WAIT_V(0);
    if (wr == 0) PG8_BAR;
    PG8_BAR;
    if constexpr (Epi::AFTER_DRAIN) { E.fused(acc, cur, wr, wc, fr, fq, lds, wid, lane); S.done(cur); }
    PG8_STAMP();
    if (STAMP && wid == 0) { stamps[lane] = lane < nts ? (((unsigned long long)(unsigned)ts_hi << 32) | (unsigned)ts_lo) : 0ull;
        if (lane == 62) stamps[62] = rt_entry; if (lane == 63) stamps[63] = (unsigned long long)wall_clock64(); }
#undef PG8_STAMP
#undef PG8_SA
#undef PG8_SB
#undef PG8_STAGE
#undef PG8_LDA
#undef PG8_LDB
#undef PG8_MMA
#undef PG8_WAIT_V
#undef PG8_WAIT_L
#undef PG8_BAR
#undef PG8_SCHED
}
}

#define LAS __attribute__((address_space(3)))
typedef unsigned short bf16_t;
typedef short bf16x8 __attribute__((ext_vector_type(8)));
typedef float f32x4 __attribute__((ext_vector_type(4)));
typedef float f32x2 __attribute__((ext_vector_type(2)));
typedef unsigned u32x4 __attribute__((ext_vector_type(4)));
typedef unsigned u32x2 __attribute__((ext_vector_type(2)));

constexpr int D = 1024, NP = 16384, NS = 512, NTOK = NP + NS, SEQ = 2048, NB = 8, NSB = 128, DEPTH = 4;
constexpr int INW = 2568, NPROJ = 2560, DFF = 2816, NGU = 5632;
constexpr int PC_G = 1536, PC_SSM = 2048, PC_POOL = 2304;
constexpr float EPS = 1e-6f;
constexpr int LDS_BYTES = 163840;

constexpr size_t SZ_WIN = (size_t)NPROJ * D * 2, SZ_WOUT = (size_t)D * D * 2, SZ_WGU = (size_t)NGU * D * 2, SZ_WDN = (size_t)D * DFF * 2;
constexpr size_t SZ_WAB = 8 * D * 4, SZ_GLUT = 256 * 256 * 2, SZ_POOLT = 4 * 64 * 64 * 2, SZ_SSMK = 16 * 64 * 4 * 4, SZ_BBAR = 16 * 64 * 32 * 4;
constexpr size_t WS_WIN = 0;
constexpr size_t WS_WOUT = WS_WIN + DEPTH * SZ_WIN;
constexpr size_t WS_WGU = WS_WOUT + DEPTH * SZ_WOUT;
constexpr size_t WS_WDN = WS_WGU + DEPTH * SZ_WGU;
constexpr size_t WS_WAB = WS_WDN + DEPTH * SZ_WDN;
constexpr size_t WS_GLUT = WS_WAB + DEPTH * SZ_WAB;
constexpr size_t WS_POOLT = WS_GLUT + DEPTH * SZ_GLUT;
constexpr size_t WS_SSMK = WS_POOLT + DEPTH * SZ_POOLT;
constexpr size_t WS_BBAR = WS_SSMK + DEPTH * SZ_SSMK;
constexpr size_t WS_H = WS_BBAR + DEPTH * SZ_BBAR;
constexpr size_t WS_AB = WS_H + (size_t)NTOK * D * 2;
constexpr size_t WS_MIX = WS_AB + (size_t)NTOK * 8 * 4;
constexpr size_t WS_MIXO = WS_MIX + (size_t)NTOK * D * 2;
constexpr size_t WS_SSME = WS_MIXO + (size_t)NTOK * D * 4;
constexpr size_t WS_PROJ = WS_SSME + (size_t)8 * 32 * 16 * 64 * 2 * 4;
constexpr size_t WS_DW = WS_PROJ + (size_t)NTOK * NPROJ * 2;
constexpr size_t WS_DKC = WS_DW + (size_t)1024 * 8192 * 4;
constexpr size_t WS_DQD = WS_DKC + (size_t)1024 * 8192 * 2;
constexpr size_t WS_DQK = WS_DQD + (size_t)1024 * 8192 * 2;
constexpr size_t WS_DKT = WS_DQK + (size_t)1024 * 4096 * 2;
constexpr size_t WS_DGL = WS_DKT + (size_t)1024 * 8192 * 2;
constexpr size_t WS_DGS = WS_DGL + 4096;
constexpr size_t WS_BAR = WS_DGS + (size_t)1024 * 8192 * 2;
constexpr size_t WS_PARTS = WS_BAR + 16384;
constexpr size_t WS_END = WS_PARTS + (size_t)11 * 512 * 1024 * 4;
constexpr size_t WS_HID = WS_PROJ;
static_assert(WS_HID + (size_t)NTOK * DFF * 2 <= WS_END, "HID overlay");
static_assert(WS_H % 256 == 0 && WS_PROJ % 256 == 0 && WS_DW % 256 == 0, "align");

constexpr size_t O_YP = 0, O_YS = O_YP + (size_t)NP * D, O_DP = O_YS + (size_t)NS * D, O_CP = O_DP + (size_t)DEPTH * 8 * 4 * 16384,
                 O_REP = O_CP + (size_t)DEPTH * 8 * 3 * 1536, O_IMP = O_REP + (size_t)DEPTH * 8 * 1024, O_PP = O_IMP + (size_t)DEPTH * 8 * 1024,
                 O_DS = O_PP + (size_t)DEPTH * 8 * 15 * 256, O_CS = O_DS + (size_t)DEPTH * 128 * 4 * 16384, O_RES = O_CS + (size_t)DEPTH * 128 * 3 * 1536,
                 O_IMS = O_RES + (size_t)DEPTH * 128 * 1024, O_PS = O_IMS + (size_t)DEPTH * 128 * 1024, O_END = O_PS + (size_t)DEPTH * 128 * 15 * 256;

struct Args { const float* in[32]; float* out; unsigned char* ws; int ph_lo, ph_hi; };
typedef const float* cfp_t;
typedef __attribute__((address_space(4))) const unsigned char* kptr_t;
struct InProxy { __device__ __forceinline__ const float* operator[](int i) const {
    kptr_t p = (kptr_t)__builtin_amdgcn_kernarg_segment_ptr(); asm volatile("" : "+s"(p)); return *(__attribute__((address_space(4))) const cfp_t*)(p + 8 * i); } };
struct DevArgs { InProxy in; float* out; unsigned char* ws; int ph_lo, ph_hi; };
enum { I_XP = 0, I_XS, I_SDELTA, I_SCONV, I_SRE, I_SIM, I_SPOOL, I_NMPRE, I_NMPOST, I_NFPRE, I_NFPOST, I_WIN, I_CONVW, I_ALOG, I_DTB, I_ONORM,
       I_ARE, I_AIM, I_LOGDT, I_BRE, I_BIM, I_CRE, I_CIM, I_SSMD, I_GLUW, I_GLUB, I_POOLW, I_POOLS, I_WOUT, I_WG, I_WU, I_WD };

__device__ __forceinline__ unsigned f2bf(float f) { unsigned u = __float_as_uint(f); return (u + 0x7fffu + ((u >> 16) & 1u)) >> 16; }
__device__ __forceinline__ float bf2f(unsigned b) { return __uint_as_float(b << 16); }
__device__ __forceinline__ unsigned pk2(float lo, float hi) { return f2bf(lo) | (f2bf(hi) << 16); }
template <int CTRL> __device__ __forceinline__ float dpp_f(float v) { return __builtin_bit_cast(float, __builtin_amdgcn_update_dpp(0, __builtin_bit_cast(int, v), CTRL, 0xF, 0xF, true)); }
__device__ __forceinline__ float row_sum8(float v) { v += dpp_f<0xB1>(v); v += dpp_f<0x4E>(v); v += dpp_f<0x141>(v); return v; }
__device__ __forceinline__ float row_sum16(float v) { v = row_sum8(v); v += dpp_f<0x140>(v); return v; }
__device__ __forceinline__ float wave_sum(float v) { v = row_sum16(v); v += __shfl_xor(v, 16); v += __shfl_xor(v, 32); return v; }
__device__ __forceinline__ float silu_f(float y) { return y / (1.f + __expf(-y)); }
__device__ __forceinline__ float sigmoid_f(float y) { return 1.f / (1.f + __expf(-y)); }
__device__ __forceinline__ float gelu_tanh_f(float x) { const float t = tanhf(0.7978845608028654f * (x + 0.044715f * x * x * x)); return 0.5f * x * (1.f + t); }
__device__ __forceinline__ f32x4 mfma16(bf16x8 a, bf16x8 b, f32x4 c) { return __builtin_amdgcn_mfma_f32_16x16x32_bf16(a, b, c, 0, 0, 0); }
#define LDS_FENCE() asm volatile("s_waitcnt lgkmcnt(0)" ::: "memory")

struct EpiSwiGLU {
    static constexpr bool PERM = false, AFTER_DRAIN = false;
    bf16_t* O; int ldc;
    __device__ __forceinline__ void operator()(const pg8::f32x4 (&acc)[2][2][4][2], const pg8::Unit& u, int wr, int wc, int fr, int fq) const {
        const int row0 = u.pm * 256 + wr * 64 + fr, hid0 = u.pn * 128 + wc * 16 + 4 * fq;
#pragma unroll
        for (int ai = 0; ai < 2; ++ai)
#pragma unroll
            for (int m = 0; m < 4; ++m) { bf16_t* rowp = O + (size_t)(row0 + ai * 128 + m * 16) * ldc + hid0;
#pragma unroll
                for (int bj = 0; bj < 2; ++bj) { const pg8::f32x4 g = acc[ai][bj][m][0], v = acc[ai][bj][m][1];
                    u32x2 w; w.x = pg8::cvt_pk_bf16(silu_f(g[0]) * v[0], silu_f(g[1]) * v[1]); w.y = pg8::cvt_pk_bf16(silu_f(g[2]) * v[2], silu_f(g[3]) * v[3]);
                    *(u32x2*)(rowp + bj * 64) = w; } }
    }
};

#define XB_TMO      128
#define XB_XCNT(j)  (256  + 64 * (j))
#define XB_XSUB(j)  (1280 + 64 * (j))
#define XB_XGEN(j)  (2304 + 64 * (j))
#define XB_TOP      3328
#define XB_TOPGEN   3392
#define XCD_BAR_WORDS 3456
#define XB_SPIN_CAP (1u << 18)

__device__ __forceinline__ unsigned xb_ld(unsigned* p)              { return __hip_atomic_load(p, __ATOMIC_RELAXED, __HIP_MEMORY_SCOPE_AGENT); }
__device__ __forceinline__ unsigned xb_add(unsigned* p, unsigned v) { return __hip_atomic_fetch_add(p, v, __ATOMIC_RELAXED, __HIP_MEMORY_SCOPE_AGENT); }
__device__ __forceinline__ unsigned xb_xcc_id() { return (unsigned)__builtin_amdgcn_s_getreg((3 << 11) | 20) & 0xFu; }
#define XB_SPIN(cond, bar) do { unsigned _sp = 0; while (cond) { __builtin_amdgcn_s_sleep(1); \
    if ((++_sp & 255u) == 0u) { if (xb_ld(&(bar)[XB_TMO])) break; if (_sp > XB_SPIN_CAP) { atomicAdd(&(bar)[XB_TMO], 1u); break; } } } } while (0)

struct XcdBarrier {
    unsigned* bar; unsigned x;
    volatile LAS unsigned* st;
};

__device__ __forceinline__ XcdBarrier xcd_barrier_post(unsigned* bar, volatile LAS unsigned* st) {
    XcdBarrier b; b.bar = bar; b.x = xb_xcc_id(); b.st = st;
    if (threadIdx.x == 0) (void)xb_add(&bar[XB_XCNT(b.x)], 1u);
    return b;
}
__device__ __forceinline__ void xcd_barrier_complete(unsigned* bar, unsigned x, unsigned& nloc, unsigned& nx) {
    const unsigned G = gridDim.x * gridDim.y * gridDim.z;
    unsigned sum, cnt, mine, sp = 0u;
    for (;;) {
        sum = 0u; cnt = 0u; mine = 0u;
#pragma unroll
        for (unsigned j = 0; j < 16; ++j) { const unsigned c = xb_ld(&bar[XB_XCNT(j)]); sum += c; cnt += (c > 0u) ? 1u : 0u; mine = (j == x) ? c : mine; }
        if (sum == G) break;
        __builtin_amdgcn_s_sleep(1);
        if ((++sp & 255u) == 0u) { if (xb_ld(&bar[XB_TMO])) break; if (sp > XB_SPIN_CAP) { atomicAdd(&bar[XB_TMO], 1u); break; } }
    }
    nloc = mine > 0u ? mine : 1u; nx = cnt > 0u ? cnt : 1u;
}

__device__ __forceinline__ void xcd_barrier(const XcdBarrier& b) {
    asm volatile("s_waitcnt vmcnt(0)" ::: "memory");
    __syncthreads();
    if (threadIdx.x == 0) {
        unsigned* bar = b.bar; asm volatile("" : "+s"(bar));
        __builtin_amdgcn_s_waitcnt(0);
        unsigned nloc = b.st[0], nx = b.st[1];
        if (nloc == 0u) { xcd_barrier_complete(bar, b.x, nloc, nx); b.st[0] = nloc; b.st[1] = nx; }
        const unsigned old = xb_add(&bar[XB_XSUB(b.x)], 1u);
        const unsigned gen = old / nloc;
        if (old + 1u == (gen + 1u) * nloc) {
            __builtin_amdgcn_fence(__ATOMIC_RELEASE, "agent");
            asm volatile("s_waitcnt vmcnt(0)" ::: "memory");
            const unsigned og = xb_add(&bar[XB_TOP], 1u);
            const unsigned tg = og / nx;
            if (og + 1u == (tg + 1u) * nx) xb_add(&bar[XB_TOPGEN], 1u);
            else XB_SPIN(xb_ld(&bar[XB_TOPGEN]) == tg, bar);
            __builtin_amdgcn_fence(__ATOMIC_ACQUIRE, "agent");
            xb_add(&bar[XB_XGEN(b.x)], 1u);
            asm volatile("s_waitcnt vmcnt(0)" ::: "memory");
        } else {
            XB_SPIN(xb_ld(&bar[XB_XGEN(b.x)]) == gen, bar);
            __builtin_amdgcn_fence(__ATOMIC_ACQUIRE, "agent");
            asm volatile("s_waitcnt vmcnt(0)" ::: "memory");
        }
    }
    __syncthreads();
}

struct SliceOrder {
    int nunits, G, c;
    __device__ __forceinline__ bool next(int i, pg8::Unit& u) const { const int L = i * G + c; if (L >= nunits) return false; const int t = L & 7; u.pm = t >> 2; u.pn = t & 3; u.ks = L >> 3; return true; }
    __device__ __forceinline__ void a_ready(const pg8::Unit&) const {}
    __device__ __forceinline__ void done(const pg8::Unit&) const {}
};
struct EpiF32Part {
    static constexpr bool PERM = false, AFTER_DRAIN = false;
    float* C;
    __device__ __forceinline__ void operator()(const pg8::f32x4 (&acc)[2][2][4][2], const pg8::Unit& u, int wr, int wc, int fr, int fq) const {
        const int row0 = u.pm * 256 + wr * 64 + fr, col0 = u.pn * 256 + wc * 32 + 4 * fq; float* base = C + (size_t)u.ks * (512 * 1024);
#pragma unroll
        for (int ai = 0; ai < 2; ++ai)
#pragma unroll
            for (int m = 0; m < 4; ++m) { float* rowp = base + (size_t)(row0 + ai * 128 + m * 16) * 1024 + col0;
#pragma unroll
                for (int bj = 0; bj < 2; ++bj)
#pragma unroll
                    for (int n = 0; n < 2; ++n) *(pg8::f32x4*)(rowp + bj * 128 + n * 16) = acc[ai][bj][m][n]; }
    }
};

struct SrcIn { const float* w; __device__ __forceinline__ float operator()(int k, int n) const { return w[(size_t)k * INW + (n < 1536 ? n : n + 8)]; } };
struct SrcPlain { const float* w; int N; __device__ __forceinline__ float operator()(int k, int n) const { return w[(size_t)k * N + n]; } };
struct SrcGU { const float* g; const float* u; __device__ __forceinline__ float operator()(int k, int n) const { const int r = n & 31, hid = (n >> 5) * 16 + (r & 15); const long long du = (r < 16) ? 0ll : (long long)(u - g); return g[du + (long long)k * DFF + hid]; } };
template <class Src> __device__ __forceinline__ void transpose_item(const Src& src, int K, bf16_t* WT, int nblk, LAS float* scr, int item, int lane) {
    const int kb = item / nblk, nb = item % nblk, k0 = 64 * kb, n0 = 32 * nb;
#pragma unroll 8
    for (int i = 0; i < 32; ++i) { const int kk = 2 * i + (lane >> 5); scr[kk * 33 + (lane & 31)] = src(k0 + kk, n0 + (lane & 31)); }
    LDS_FENCE();
    const int c = lane & 7;
#pragma unroll
    for (int j = 0; j < 4; ++j) { const int n = (lane >> 3) + 8 * j; const LAS float* s = scr + (8 * c) * 33 + n;
        u32x4 o; o.x = pk2(s[0 * 33], s[1 * 33]); o.y = pk2(s[2 * 33], s[3 * 33]); o.z = pk2(s[4 * 33], s[5 * 33]); o.w = pk2(s[6 * 33], s[7 * 33]);
        *(u32x4*)(WT + (size_t)(n0 + n) * K + k0 + 8 * c) = o; }
    LDS_FENCE();
}

__device__ __forceinline__ void norm_rows(const float* T, const float* wt, const float* X0, const float* X1, float* Xout, const float* wh, bf16_t* H,
                                          const float* Wab, float* AB, int gw, int NGW, int lane, const float* Tp = nullptr, int ns = 0) {
#pragma unroll 1
    for (int m = gw; m < NTOK; m += NGW) {
        f32x4 x[4], t[4];
        { const float* xr = (X1 && m >= NP) ? X1 + (size_t)(m - NP) * D : X0 + (size_t)m * D;
#pragma unroll
          for (int j = 0; j < 4; ++j) x[j] = ((const f32x4*)xr)[lane + 64 * j];
          if (T && !(Tp && m >= NP)) {
#pragma unroll
              for (int j = 0; j < 4; ++j) { const u32x2 tb = ((const u32x2*)((const bf16_t*)T + (size_t)m * D))[lane + 64 * j];
                  t[j] = (f32x4){__uint_as_float(tb.x << 16), __uint_as_float(tb.x & 0xffff0000u), __uint_as_float(tb.y << 16), __uint_as_float(tb.y & 0xffff0000u)}; } } }
        if (T) {
            float ss = 0.f;
            if (Tp && m >= NP) {
#pragma unroll
                for (int j = 0; j < 4; ++j) { f32x4 a = {0.f, 0.f, 0.f, 0.f}; for (int q = 0; q < ns; ++q) a += ((const f32x4*)(Tp + (size_t)q * (512 * 1024) + (size_t)(m - NP) * D))[lane + 64 * j]; t[j] = a; } }
#pragma unroll
            for (int j = 0; j < 4; ++j) ss += (t[j].x * t[j].x + t[j].y * t[j].y) + (t[j].z * t[j].z + t[j].w * t[j].w);
            ss = wave_sum(ss); const float r = rsqrtf(ss * (1.f / D) + EPS);
#pragma unroll
            for (int j = 0; j < 4; ++j) { const f32x4 w = ((const f32x4*)wt)[lane + 64 * j]; x[j] += t[j] * r * w; }
        }
        if (Xout) {
#pragma unroll
            for (int j = 0; j < 4; ++j) ((f32x4*)(Xout + (size_t)m * D))[lane + 64 * j] = x[j];
        }
        if (H) {
            float ss = 0.f;
#pragma unroll
            for (int j = 0; j < 4; ++j) ss += (x[j].x * x[j].x + x[j].y * x[j].y) + (x[j].z * x[j].z + x[j].w * x[j].w);
            ss = wave_sum(ss); const float r = rsqrtf(ss * (1.f / D) + EPS);
            f32x4 hv[4];
#pragma unroll
            for (int j = 0; j < 4; ++j) { const f32x4 w = ((const f32x4*)wh)[lane + 64 * j]; hv[j] = x[j] * r * w;
                u32x2 o; o.x = pk2(hv[j].x, hv[j].y); o.y = pk2(hv[j].z, hv[j].w); ((u32x2*)(H + (size_t)m * D))[lane + 64 * j] = o; }
            if (Wab) {
                float d[8];
#pragma unroll
                for (int c = 0; c < 8; ++c) { float dd = 0.f;
#pragma unroll
                    for (int j = 0; j < 4; ++j) { const f32x4 w = ((const f32x4*)(Wab + c * D))[lane + 64 * j]; dd += (hv[j].x * w.x + hv[j].y * w.y) + (hv[j].z * w.z + hv[j].w * w.w); }
                    d[c] = dd; }
#pragma unroll
                for (int c = 0; c < 8; ++c) d[c] = row_sum16(d[c]);
#pragma unroll
                for (int o = 16; o < 64; o <<= 1) {
#pragma unroll
                    for (int c = 0; c < 8; ++c) d[c] += __shfl_xor(d[c], o); }
                if (lane == 0) { f32x4 o0 = {d[0], d[1], d[2], d[3]}, o1 = {d[4], d[5], d[6], d[7]}; *(f32x4*)(AB + (size_t)m * 8) = o0; *(f32x4*)(AB + (size_t)m * 8 + 4) = o1; }
            }
        }
    }
}

__device__ __forceinline__ void prologue(const DevArgs& A, LAS unsigned char* lds, int wave, int lane, int gw, int NGW) {
    LAS float* scr = (LAS float*)(lds + wave * 8704);
    constexpr int I_IN = 16 * 80, I_OUT = 16 * 32, I_GU = 16 * 176, I_DN = 44 * 32, I_GLU = 4 * 8, I_POOL = 8, PER = I_IN + I_OUT + I_GU + I_DN + I_GLU + I_POOL;
#pragma unroll 1
    for (int it = gw; it < DEPTH * PER; it += NGW) {
        const int l = it / PER; int r = it % PER;
        if (r < I_IN) { SrcIn s{A.in[I_WIN] + (size_t)l * D * INW}; transpose_item(s, D, (bf16_t*)(A.ws + WS_WIN + l * SZ_WIN), NPROJ / 32, scr, r, lane); continue; } r -= I_IN;
        if (r < I_OUT) { SrcPlain s{A.in[I_WOUT] + (size_t)l * D * D, D}; transpose_item(s, D, (bf16_t*)(A.ws + WS_WOUT + l * SZ_WOUT), D / 32, scr, r, lane); continue; } r -= I_OUT;
        if (r < I_GU) { SrcGU s{A.in[I_WG] + (size_t)l * D * DFF, A.in[I_WU] + (size_t)l * D * DFF}; transpose_item(s, D, (bf16_t*)(A.ws + WS_WGU + l * SZ_WGU), NGU / 32, scr, r, lane); continue; } r -= I_GU;
        if (r < I_DN) { SrcPlain s{A.in[I_WD] + (size_t)l * DFF * D, D}; transpose_item(s, DFF, (bf16_t*)(A.ws + WS_WDN + l * SZ_WDN), D / 32, scr, r, lane); continue; } r -= I_DN;
        if (r < I_GLU) { SrcPlain s{A.in[I_GLUW] + (size_t)l * 65536, 256}; transpose_item(s, 256, (bf16_t*)(A.ws + WS_GLUT + l * SZ_GLUT), 8, scr, r, lane); continue; } r -= I_GLU;
        { const int g = r >> 1; SrcPlain s{A.in[I_POOLW] + (size_t)(l * 4 + g) * 4096, 64}; transpose_item(s, 64, (bf16_t*)(A.ws + WS_POOLT + l * SZ_POOLT) + g * 4096, 2, scr, r & 1, lane); }
    }
    const int gt = gw * 64 + lane, NT = NGW * 64;
    float* wab = (float*)(A.ws + WS_WAB);
#pragma unroll 1
    for (int i = gt; i < DEPTH * 8 * D; i += NT) { const int l = i / (8 * D), j = (i / D) & 7, k = i % D; wab[i] = A.in[I_WIN][((size_t)l * D + k) * INW + 1536 + j]; }
    float* ssmk = (float*)(A.ws + WS_SSMK); float* bbar = (float*)(A.ws + WS_BBAR);
#pragma unroll 1
    for (int i = gt; i < DEPTH * 16 * 64; i += NT) {
        const int lg = i >> 6;
        const float dt = expf(A.in[I_LOGDT][lg]), ar = A.in[I_ARE][i], ai = A.in[I_AIM][i];
        const float mag = expf(ar * dt);
        float rev = ai * dt * 0.15915494309189535f; rev -= floorf(rev);
        const float sn = __builtin_amdgcn_sinf(rev), cs = __builtin_amdgcn_cosf(rev);
        const float lr = mag * cs, li = mag * sn;
        float pr = lr, pi = li;
#pragma unroll
        for (int q = 0; q < 6; ++q) { const float nr2 = pr * pr - pi * pi, ni2 = 2.f * pr * pi; pr = nr2; pi = ni2; }
        ssmk[i * 4 + 0] = lr; ssmk[i * 4 + 1] = li; ssmk[i * 4 + 2] = pr; ssmk[i * 4 + 3] = pi;
        const float nr = lr - 1.f, ni = li, d2 = ar * ar + ai * ai;
        const float cre = (nr * ar + ni * ai) / d2, cim = (ni * ar - nr * ai) / d2;
#pragma unroll
        for (int h = 0; h < 16; ++h) { const float br = A.in[I_BRE][(size_t)i * 16 + h], bi = A.in[I_BIM][(size_t)i * 16 + h];
            bbar[(size_t)i * 32 + h] = cre * br - cim * bi; bbar[(size_t)i * 32 + 16 + h] = cre * bi + cim * br; }
    }
}

__device__ __forceinline__ unsigned bfmul2(unsigned pk, float f0, float f1) { return pg8::cvt_pk_bf16(__uint_as_float(pk << 16) * f0, __uint_as_float(pk & 0xffff0000u) * f1); }
__device__ __forceinline__ void delta_prep_item(const DevArgs& A, int l, LAS unsigned char* lds, int item, int tid, int wave, int lane) {
    asm volatile("" : "+v"(tid)); lane = tid & 63; wave = __builtin_amdgcn_readfirstlane(tid >> 6);
    const int bh = item >> 5, n = item & 31, b = bh >> 2, h = bh & 3;
    const int tok0 = b * SEQ + n * 64;
    LAS bf16_t* QS = (LAS bf16_t*)(lds); LAS bf16_t* KS = (LAS bf16_t*)(lds + 17408);
    LAS unsigned char* KT = lds + 34816; LAS unsigned char* VT = lds + 53248; LAS unsigned char* RTK = lds + 71680;
    LAS float* AM = (LAS float*)(lds + 90112); LAS float* PM = (LAS float*)(lds + 107520); LAS float* PSC = PM; LAS float* TM = (LAS float*)(lds + 124928);
    LAS unsigned char* TB = lds + 142336;
    LAS float* GAM = (LAS float*)(lds + 151552); LAS float* BETA = GAM + 64; LAS float* RQ = GAM + 128; LAS float* RK = GAM + 192;
    LAS float* F2 = GAM + 256; LAS float* F3 = GAM + 320; LAS float* F4 = GAM + 384;
    const bf16_t* PROJ = (const bf16_t*)(A.ws + WS_PROJ);
    const float* AB = (const float*)(A.ws + WS_AB);
    u32x4 gv[2];
#pragma unroll
    for (int j = 0; j < 2; ++j) { const int id = tid + 512 * j; gv[j] = *(const u32x4*)(PROJ + (size_t)(tok0 + (id >> 4)) * NPROJ + PC_G + h * 128 + (id & 15) * 8); }
    if (tid < 384) {
        const int part = tid >> 7, c = tid & 127, col = part * 512 + h * 128 + c;
        const float* cw = A.in[I_CONVW] + (size_t)l * 4 * 1536;
        const float w0 = cw[col], w1 = cw[1536 + col], w2 = cw[3072 + col], w3 = cw[4608 + col];
        const bf16_t* pp = PROJ + (size_t)tok0 * NPROJ + col;
        float xr[67];
#pragma unroll
        for (int t = 0; t < 67; ++t) xr[t] = (n > 0 || t >= 3) ? bf2f(pp[(long)(t - 3) * NPROJ]) : 0.f;
        unsigned pk[32];
#pragma unroll
        for (int t = 0; t < 64; t += 2) {
            const float s0 = silu_f(w0 * xr[t] + w1 * xr[t + 1] + w2 * xr[t + 2] + w3 * xr[t + 3]);
            const float s1 = silu_f(w0 * xr[t + 1] + w1 * xr[t + 2] + w2 * xr[t + 3] + w3 * xr[t + 4]);
            pk[t >> 1] = pg8::cvt_pk_bf16(s0, s1);
        }
        if (part < 2) { LAS bf16_t* dst = (part == 0 ? QS : KS) + c;
#pragma unroll
            for (int t = 0; t < 64; t += 2) { dst[t * 136] = (bf16_t)(pk[t >> 1] & 0xffffu); dst[(t + 1) * 136] = (bf16_t)(pk[t >> 1] >> 16); } }
        if (part > 0) { LAS unsigned char* dst = (part == 1 ? KT : VT) + c * 144;
#pragma unroll
            for (int q = 0; q < 8; ++q) { u32x4 o; o.x = pk[4 * q]; o.y = pk[4 * q + 1]; o.z = pk[4 * q + 2]; o.w = pk[4 * q + 3]; *(LAS u32x4*)(dst + q * 16) = o; } }
    } else if (tid < 448) {
        const int t = tid - 384;
        const float a = AB[(size_t)(tok0 + t) * 8 + h], bb = AB[(size_t)(tok0 + t) * 8 + 4 + h];
        const float xx = a + A.in[I_DTB][l * 4 + h];
        const float sp = xx > 20.f ? xx : log1pf(expf(xx));
        float lg = -expf(A.in[I_ALOG][l * 4 + h]) * sp;
#pragma unroll
        for (int off = 1; off < 64; off <<= 1) { const float v = __shfl_up(lg, off); if (lane >= off) lg += v; }
        GAM[t] = lg; BETA[t] = 1.f / (1.f + expf(-bb));
    }
    __syncthreads();
    {
        const int t = tid >> 3, part = tid & 7; float sq = 0.f, sk = 0.f;
#pragma unroll
        for (int j = 0; j < 16; ++j) { const float q = bf2f(QS[t * 136 + part * 16 + j]), k = bf2f(KS[t * 136 + part * 16 + j]); sq += q * q; sk += k * k; }
        sq = row_sum8(sq); sk = row_sum8(sk);
        if (part == 0) { const float rq = rsqrtf(sq + EPS) * 0.08838834764831845f, rk = rsqrtf(sk + EPS), g = GAM[t], eg = __expf(g), bt = BETA[t];
            RQ[t] = rq; RK[t] = rk; F2[t] = bt * eg * rk; F3[t] = rk * __expf(GAM[63] - g); F4[t] = rq * eg; }
    }
    {
        const int prod = wave >> 2, mt = wave & 3, fr = lane & 15, quad = lane >> 4;
        LAS bf16_t* Aop = prod ? QS : KS; LAS float* dst = prod ? PM : AM;
        bf16x8 a[4];
#pragma unroll
        for (int kk = 0; kk < 4; ++kk) a[kk] = *(LAS bf16x8*)(Aop + (mt * 16 + fr) * 136 + kk * 32 + quad * 8);
#pragma unroll
        for (int nt = 0; nt < 4; ++nt) { f32x4 acc = {0.f, 0.f, 0.f, 0.f};
#pragma unroll
            for (int kk = 0; kk < 4; ++kk) { const bf16x8 bq = *(LAS bf16x8*)(KS + (nt * 16 + fr) * 136 + kk * 32 + quad * 8); acc = mfma16(a[kk], bq, acc); }
#pragma unroll
            for (int i = 0; i < 4; ++i) dst[(mt * 16 + quad * 4 + i) * 68 + nt * 16 + fr] = acc[i]; }
    }
    __syncthreads();
    {
        const int t = tid >> 3, s8 = (tid & 7) * 8; const float gt = GAM[t], bk = BETA[t] * RK[t], rqt = RQ[t];
        float av[8], pv[8];
#pragma unroll
        for (int j = 0; j < 8; ++j) { const int s = s8 + j; const float rks = RK[s]; const float dec = (s <= t) ? __expf(gt - GAM[s]) * rks : 0.f;
            av[j] = (s < t) ? bk * dec * AM[t * 68 + s] : 0.f; pv[j] = rqt * dec * PM[t * 68 + s]; }
#pragma unroll
        for (int j = 0; j < 8; ++j) AM[t * 68 + s8 + j] = av[j];
        u32x4 o; o.x = pg8::cvt_pk_bf16(pv[0], pv[1]); o.y = pg8::cvt_pk_bf16(pv[2], pv[3]); o.z = pg8::cvt_pk_bf16(pv[4], pv[5]); o.w = pg8::cvt_pk_bf16(pv[6], pv[7]);
        *(u32x4*)((bf16_t*)(A.ws + WS_DQK) + (size_t)item * 4096 + t * 64 + s8) = o;
        for (int e = tid; e < 64 * 68; e += 512) TM[e] = 0.f;
        if (tid == 0) ((float*)(A.ws + WS_DGL))[item] = __expf(GAM[63]);
    }
    __syncthreads();
    if (wave == 0) {
        const int i = lane >> 4, c = lane & 15;
        LAS float* amp = AM + (16 * i) * 68 + 16 * i; asm volatile("" : "+v"(amp));
        float x[16];
#pragma unroll
        for (int r = 0; r < 16; ++r) { float acc = (r == c) ? 1.f : 0.f;
#pragma unroll
            for (int s = 0; s < r; ++s) acc = fmaf(-amp[r * 68 + s], x[s], acc);
            x[r] = acc; }
        LAS float* tmp = TM + (16 * i) * 68 + 16 * i + c;
#pragma unroll
        for (int r = 0; r < 16; ++r) tmp[r * 68] = x[r];
    } else {
        const int wt = tid - 64;
        for (int id = wt; id < 1024; id += 448) {
            const int c = id >> 3, t8 = (id & 7) * 8;
            const f32x4 b0 = *(LAS f32x4*)(BETA + t8), b1 = *(LAS f32x4*)(BETA + t8 + 4);
            u32x4 v = *(LAS u32x4*)(VT + c * 144 + t8 * 2);
            v.x = bfmul2(v.x, b0[0], b0[1]); v.y = bfmul2(v.y, b0[2], b0[3]); v.z = bfmul2(v.z, b1[0], b1[1]); v.w = bfmul2(v.w, b1[2], b1[3]);
            *(LAS u32x4*)(VT + c * 144 + t8 * 2) = v;
            const f32x4 f20 = *(LAS f32x4*)(F2 + t8), f21 = *(LAS f32x4*)(F2 + t8 + 4), f30 = *(LAS f32x4*)(F3 + t8), f31 = *(LAS f32x4*)(F3 + t8 + 4);
            const u32x4 k = *(LAS u32x4*)(KT + c * 144 + t8 * 2);
            u32x4 rk; rk.x = bfmul2(k.x, f20[0], f20[1]); rk.y = bfmul2(k.y, f20[2], f20[3]); rk.z = bfmul2(k.z, f21[0], f21[1]); rk.w = bfmul2(k.w, f21[2], f21[3]);
            *(LAS u32x4*)(RTK + c * 144 + t8 * 2) = rk;
            u32x4 kd; kd.x = bfmul2(k.x, f30[0], f30[1]); kd.y = bfmul2(k.y, f30[2], f30[3]); kd.z = bfmul2(k.z, f31[0], f31[1]); kd.w = bfmul2(k.w, f31[2], f31[3]);
            *(u32x4*)((bf16_t*)(A.ws + WS_DKT) + (size_t)item * 8192 + c * 64 + t8) = kd; }
        for (int id = wt; id < 1024; id += 448) {
            const int t = id >> 4, c8 = (id & 15) * 8; const float f = F4[t];
            u32x4 q = *(LAS u32x4*)((LAS unsigned char*)QS + t * 272 + c8 * 2);
            q.x = bfmul2(q.x, f, f); q.y = bfmul2(q.y, f, f); q.z = bfmul2(q.z, f, f); q.w = bfmul2(q.w, f, f);
            *(u32x4*)((bf16_t*)(A.ws + WS_DQD) + (size_t)item * 8192 + t * 128 + c8) = q; }
    }
    {
        const int c8 = (tid & 15) * 8; const float* on = A.in[I_ONORM] + l * 128 + c8;
        const f32x4 o0 = *(const f32x4*)on, o1 = *(const f32x4*)(on + 4);
#pragma unroll
        for (int j = 0; j < 2; ++j) { const int id = tid + 512 * j; const u32x4 g = gv[j]; u32x4 o;
            o.x = pg8::cvt_pk_bf16(silu_f(__uint_as_float(g.x << 16)) * o0[0], silu_f(__uint_as_float(g.x & 0xffff0000u)) * o0[1]);
            o.y = pg8::cvt_pk_bf16(silu_f(__uint_as_float(g.y << 16)) * o0[2], silu_f(__uint_as_float(g.y & 0xffff0000u)) * o0[3]);
            o.z = pg8::cvt_pk_bf16(silu_f(__uint_as_float(g.z << 16)) * o1[0], silu_f(__uint_as_float(g.z & 0xffff0000u)) * o1[1]);
            o.w = pg8::cvt_pk_bf16(silu_f(__uint_as_float(g.w << 16)) * o1[2], silu_f(__uint_as_float(g.w & 0xffff0000u)) * o1[3]);
            *(u32x4*)((bf16_t*)(A.ws + WS_DGS) + (size_t)item * 8192 + (id >> 4) * 128 + c8) = o; }
    }
    __syncthreads();
    const int p2 = tid >> 8, r2 = (tid >> 4) & 15, c2 = tid & 15, rb = p2 ? 48 : 16, cb = p2 ? 32 : 0;
    {
        float acc = 0.f;
#pragma unroll
        for (int s = 0; s < 16; ++s) acc = fmaf(AM[(rb + r2) * 68 + cb + s], TM[(cb + s) * 68 + cb + c2], acc);
        PSC[(p2 * 16 + r2) * 68 + c2] = acc; }
    __syncthreads();
    {
        float acc = 0.f;
#pragma unroll
        for (int s = 0; s < 16; ++s) acc = fmaf(TM[(rb + r2) * 68 + rb + s], PSC[(p2 * 16 + s) * 68 + c2], acc);
        TM[(rb + r2) * 68 + cb + c2] = -acc; }
    __syncthreads();
    float p3[2];
#pragma unroll
    for (int j = 0; j < 2; ++j) { const int e = tid + 512 * j, r = e >> 5, c = e & 31; float acc = 0.f;
#pragma unroll 8
        for (int s = 0; s < 32; ++s) acc = fmaf(AM[(32 + r) * 68 + s], TM[s * 68 + c], acc);
        p3[j] = acc; }
    __syncthreads();
#pragma unroll
    for (int j = 0; j < 2; ++j) { const int e = tid + 512 * j; PSC[(e >> 5) * 68 + (e & 31)] = p3[j]; }
    __syncthreads();
#pragma unroll
    for (int j = 0; j < 2; ++j) { const int e = tid + 512 * j, r = e >> 5, c = e & 31; float acc = 0.f;
#pragma unroll 8
        for (int s = 0; s < 32; ++s) acc = fmaf(TM[(32 + r) * 68 + 32 + s], PSC[s * 68 + c], acc);
        p3[j] = -acc; }
#pragma unroll
    for (int j = 0; j < 2; ++j) { const int e = tid + 512 * j; TM[(32 + (e >> 5)) * 68 + (e & 31)] = p3[j]; }
    __syncthreads();
#pragma unroll
    for (int j = 0; j < 4; ++j) { const int e = tid + 512 * j, t = e >> 5, s2 = (e & 31) * 2;
        *(LAS unsigned*)(TB + t * 144 + s2 * 2) = pg8::cvt_pk_bf16(TM[t * 68 + s2], TM[t * 68 + s2 + 1]); }
    __syncthreads();
    {
        const int fr = lane & 15, quad = lane >> 4;
        bf16x8 bv[2], ak[2];
#pragma unroll
        for (int kk = 0; kk < 2; ++kk) { bv[kk] = *(LAS bf16x8*)(VT + (16 * wave + fr) * 144 + (kk * 32 + quad * 8) * 2); ak[kk] = *(LAS bf16x8*)(RTK + (16 * wave + fr) * 144 + (kk * 32 + quad * 8) * 2); }
        bf16_t* DW = (bf16_t*)(A.ws + WS_DW) + (size_t)item * 8192; bf16_t* DKC = (bf16_t*)(A.ws + WS_DKC) + (size_t)item * 8192;
#pragma unroll
        for (int mt = 0; mt < 4; ++mt) { f32x4 aw = {0.f, 0.f, 0.f, 0.f}, akc = {0.f, 0.f, 0.f, 0.f};
#pragma unroll
            for (int kk = 0; kk < 2; ++kk) { const bf16x8 tf = *(LAS bf16x8*)(TB + (mt * 16 + fr) * 144 + (kk * 32 + quad * 8) * 2);
                aw = mfma16(tf, bv[kk], aw);
                akc = mfma16(ak[kk], tf, akc); }
            u32x2 ow; ow.x = pk2(aw[0], aw[1]); ow.y = pk2(aw[2], aw[3]);
            *(u32x2*)(DW + (16 * wave + fr) * 64 + mt * 16 + quad * 4) = ow;
            u32x2 ok; ok.x = pk2(-akc[0], -akc[1]); ok.y = pk2(-akc[2], -akc[3]);
            *(u32x2*)(DKC + (mt * 16 + fr) * 128 + 16 * wave + quad * 4) = ok; }
    }
    __syncthreads();
}

__device__ __forceinline__ void delta_scan_item(const DevArgs& A, int l, LAS unsigned char* lds, int bh, int tid_in, int wave, int lane_in, const XcdBarrier& xb, int SUB) {
    const int b = bh >> 2, h = bh & 3;
    LAS unsigned char* KCs = lds; LAS unsigned char* QDs = lds + 17408; LAS unsigned char* QKs = lds + 34816; LAS unsigned char* KDTs = lds + 44032;
    LAS unsigned char* Ws = lds + 62464;
    LAS unsigned char* GSs = lds + 80896;
    LAS unsigned char* SS = lds + 98304 + wave * 4352; LAS unsigned char* US = lds + 133120 + wave * 2304;
    LAS float* PART = (LAS float*)(lds + 151552);
    const unsigned char* gW = A.ws + WS_DW; const unsigned char* gGS = A.ws + WS_DGS;
    const unsigned char* gKC = A.ws + WS_DKC; const unsigned char* gQD = A.ws + WS_DQD; const unsigned char* gQK = A.ws + WS_DQK; const unsigned char* gKT = A.ws + WS_DKT;
    const float* DGL = (const float*)(A.ws + WS_DGL);
    f32x4 S[8];
#pragma unroll
    for (int mt = 0; mt < 8; ++mt) S[mt] = (f32x4){0.f, 0.f, 0.f, 0.f};
    u32x4 r[9], rg[2];
    float gl_all = 0.f;
#define DS_LOAD(itn, toff) do { const size_t _i = (size_t)(itn); const unsigned char* _kc = gKC + _i * 16384; const unsigned char* _qd = gQD + _i * 16384; \
        const unsigned char* _qk = gQK + _i * 8192; const unsigned char* _kt = gKT + _i * 16384; \
        r[0] = *(const u32x4*)(_kc + (toff)); r[1] = *(const u32x4*)(_kc + (toff) + 8192u); \
        r[2] = *(const u32x4*)(_qd + (toff)); r[3] = *(const u32x4*)(_qd + (toff) + 8192u); \
        r[4] = *(const u32x4*)(_qk + (toff)); \
        r[5] = *(const u32x4*)(_kt + (toff)); r[6] = *(const u32x4*)(_kt + (toff) + 8192u); \
        const unsigned char* _w = gW + _i * 16384; r[7] = *(const u32x4*)(_w + (toff)); r[8] = *(const u32x4*)(_w + (toff) + 8192u); } while (0)
#define DS_LOADG(itn, toff) do { const unsigned char* _g = gGS + (size_t)(itn) * 16384; rg[0] = *(const u32x4*)(_g + (toff)); rg[1] = *(const u32x4*)(_g + (toff) + 8192u); } while (0)
#define DS_STAGE(tidv) do { const int i0 = (tidv), i1 = (tidv) + 512; \
          *(LAS u32x4*)(KCs + (i0 >> 4) * 272 + (i0 & 15) * 16) = r[0]; *(LAS u32x4*)(KCs + (i1 >> 4) * 272 + (i1 & 15) * 16) = r[1]; \
          *(LAS u32x4*)(QDs + (i0 >> 4) * 272 + (i0 & 15) * 16) = r[2]; *(LAS u32x4*)(QDs + (i1 >> 4) * 272 + (i1 & 15) * 16) = r[3]; \
          *(LAS u32x4*)(QKs + (i0 >> 3) * 144 + (i0 & 7) * 16) = r[4]; \
          *(LAS u32x4*)(KDTs + (i0 >> 3) * 144 + (i0 & 7) * 16) = r[5]; *(LAS u32x4*)(KDTs + (i1 >> 3) * 144 + (i1 & 7) * 16) = r[6]; \
          *(LAS u32x4*)(Ws + (i0 >> 3) * 144 + (i0 & 7) * 16) = r[7]; *(LAS u32x4*)(Ws + (i1 >> 3) * 144 + (i1 & 7) * 16) = r[8]; } while (0)
#define DS_STAGEG(tidv) do { const int i0 = (tidv), i1 = (tidv) + 512; \
          *(LAS u32x4*)(GSs + (i0 >> 4) * 272 + (i0 & 15) * 16) = rg[0]; *(LAS u32x4*)(GSs + (i1 >> 4) * 272 + (i1 & 15) * 16) = rg[1]; } while (0)
#pragma unroll 1
    for (int n = 0; n < 32; ++n) {
        int tid = tid_in; asm volatile("" : "+v"(tid));
        const bool bstart = (SUB > 0) ? (n % SUB == 0) : (n == 0);
        const bool bnext1 = (SUB > 0) && ((n + 1) % SUB == 0), bnext2 = (SUB > 0) && ((n + 2) % SUB == 0);
        if (bstart) { if (n > 0) xcd_barrier(xb);
            gl_all = DGL[bh * 32 + (tid & 31)];
            const unsigned t0 = (unsigned)tid * 16u; DS_LOAD(bh * 32 + n, t0); DS_LOADG(bh * 32 + n, t0); DS_STAGE(tid); DS_STAGEG(tid);
            if (n + 1 < 32 && !bnext1) { DS_LOAD(bh * 32 + n + 1, t0); DS_LOADG(bh * 32 + n + 1, t0); }
            __syncthreads(); }
        else { DS_STAGEG(tid);
            if (n + 1 < 32 && !bnext1) DS_LOADG(bh * 32 + n + 1, (unsigned)tid * 16u); }
        const int lane = tid & 63, fr = lane & 15, quad = lane >> 4, vcol = 16 * wave + fr;
        const unsigned toff = (unsigned)tid * 16u;
        const int it = bh * 32 + n, tokb = b * SEQ + n * 64;
        const float glast = __builtin_bit_cast(float, __builtin_amdgcn_readlane(__builtin_bit_cast(int, gl_all), n));
        asm volatile("s_nop 7\n\ts_nop 7" ::: "memory");
#pragma unroll
        for (int mt = 0; mt < 8; ++mt) { u32x2 p; p.x = pg8::cvt_pk_bf16(S[mt][0], S[mt][1]); p.y = pg8::cvt_pk_bf16(S[mt][2], S[mt][3]); *(LAS u32x2*)(SS + fr * 272 + (mt * 16 + quad * 4) * 2) = p; }
        LDS_FENCE();
        bf16x8 Sb[4];
#pragma unroll
        for (int kk = 0; kk < 4; ++kk) Sb[kk] = *(LAS bf16x8*)(SS + fr * 272 + (kk * 32 + quad * 8) * 2);
        f32x4 U[4], O[4];
#pragma unroll
        for (int mt = 0; mt < 4; ++mt) { f32x4 au, ao = {0.f, 0.f, 0.f, 0.f};
            { const u32x2 wq = *(LAS u32x2*)(Ws + vcol * 144 + (mt * 16 + quad * 4) * 2);
              au[0] = __uint_as_float(wq.x << 16); au[1] = __uint_as_float(wq.x & 0xffff0000u); au[2] = __uint_as_float(wq.y << 16); au[3] = __uint_as_float(wq.y & 0xffff0000u); }
#pragma unroll
            for (int kk = 0; kk < 4; ++kk) { const bf16x8 a1 = *(LAS bf16x8*)(KCs + (mt * 16 + fr) * 272 + (kk * 32 + quad * 8) * 2); au = mfma16(a1, Sb[kk], au);
                const bf16x8 a2 = *(LAS bf16x8*)(QDs + (mt * 16 + fr) * 272 + (kk * 32 + quad * 8) * 2); ao = mfma16(a2, Sb[kk], ao); }
            U[mt] = au; O[mt] = ao; __builtin_amdgcn_sched_barrier(0); }
        asm volatile("s_nop 7\n\ts_nop 7" ::: "memory");
#pragma unroll
        for (int mt = 0; mt < 4; ++mt) { u32x2 p; p.x = pg8::cvt_pk_bf16(U[mt][0], U[mt][1]); p.y = pg8::cvt_pk_bf16(U[mt][2], U[mt][3]); *(LAS u32x2*)(US + fr * 144 + (mt * 16 + quad * 4) * 2) = p; }
        LDS_FENCE();
        bf16x8 Ub[2];
#pragma unroll
        for (int kk = 0; kk < 2; ++kk) Ub[kk] = *(LAS bf16x8*)(US + fr * 144 + (kk * 32 + quad * 8) * 2);
#pragma unroll
        for (int mt = 0; mt < 4; ++mt)
#pragma unroll
            for (int kk = 0; kk < 2; ++kk) { const bf16x8 a = *(LAS bf16x8*)(QKs + (mt * 16 + fr) * 144 + (kk * 32 + quad * 8) * 2); O[mt] = mfma16(a, Ub[kk], O[mt]); }
        __builtin_amdgcn_sched_barrier(0);
#pragma unroll
        for (int mt = 0; mt < 8; ++mt) { S[mt] *= glast;
#pragma unroll
            for (int kk = 0; kk < 2; ++kk) { const bf16x8 a = *(LAS bf16x8*)(KDTs + (mt * 16 + fr) * 144 + (kk * 32 + quad * 8) * 2); S[mt] = mfma16(a, Ub[kk], S[mt]); }
            if (mt & 1) __builtin_amdgcn_sched_barrier(0); }
        { float pp[16];
#pragma unroll
          for (int e = 0; e < 16; ++e) pp[e] = O[e >> 2][e & 3] * O[e >> 2][e & 3];
#pragma unroll
          for (int e = 0; e < 16; ++e) pp[e] = row_sum16(pp[e]);
          if (fr == 0) {
#pragma unroll
              for (int e = 0; e < 16; ++e) PART[((e >> 2) * 16 + quad * 4 + (e & 3)) * 8 + wave] = pp[e]; } }
        __syncthreads();
        if (n + 1 < 32 && !bnext1) { DS_STAGE(tid); if (n + 2 < 32 && !bnext2) DS_LOAD(it + 2, toff); }
        bf16_t* mixb = (bf16_t*)(A.ws + WS_MIX) + (size_t)tokb * D + h * 128;
#pragma unroll
        for (int mt = 0; mt < 4; ++mt)
#pragma unroll
            for (int i = 0; i < 4; ++i) { const int t = mt * 16 + quad * 4 + i;
                const f32x4 p0 = *(LAS f32x4*)(PART + t * 8), p1 = *(LAS f32x4*)(PART + t * 8 + 4);
                const float tot = ((p0[0] + p0[1]) + (p0[2] + p0[3])) + ((p1[0] + p1[1]) + (p1[2] + p1[3]));
                const float sc = rsqrtf(tot * (1.f / 128.f) + EPS);
                const float gs = bf2f(*(LAS bf16_t*)(GSs + t * 272 + vcol * 2));
                mixb[(unsigned)(t * D + vcol)] = (bf16_t)(pg8::cvt_pk_bf16(O[mt][i] * sc * gs, 0.f) & 0xffffu); }
        __syncthreads();
    }
#undef DS_STAGE
#undef DS_LOADG
#undef DS_STAGEG
#undef DS_LOAD
    { const int lane = lane_in, fr = lane & 15, quad = lane >> 4, vcol = 16 * wave + fr;
      float* dp = A.out + O_DP + (size_t)((l * 8 + b) * 4 + h) * 16384;
#pragma unroll
      for (int mt = 0; mt < 8; ++mt)
#pragma unroll
          for (int i = 0; i < 4; ++i) dp[(mt * 16 + quad * 4 + i) * 128 + vcol] = S[mt][i]; }
    __syncthreads();
}

__device__ __forceinline__ void delta_sample_item(const DevArgs& A, int l, LAS unsigned char* lds, int item, int tid, int wave, int lane) {
    asm volatile("" : "+v"(tid)); lane = tid & 63; wave = __builtin_amdgcn_readfirstlane(tid >> 6);
    const int b = item >> 2, h = item & 3, tokS = NP + b * 4;
    LAS float* RAW = (LAS float*)lds; LAS float* RED = RAW + 1536; LAS float* OB = RED + 512; LAS float* SC = OB + 512;
    const bf16_t* PROJ = (const bf16_t*)(A.ws + WS_PROJ); const float* AB = (const float*)(A.ws + WS_AB); bf16_t* MIX = (bf16_t*)(A.ws + WS_MIX);
    const float* cw = A.in[I_CONVW] + (size_t)l * 4 * 1536;
    for (int idx = tid; idx < 1536; idx += 512) { const int part = idx >> 9, t = (idx >> 7) & 3, c = idx & 127, col = part * 512 + h * 128 + c;
        float acc = 0.f;
#pragma unroll
        for (int j = 0; j < 4; ++j) { const int tt = t - 3 + j;
            const float x = (tt >= 0) ? bf2f(PROJ[(size_t)(tokS + tt) * NPROJ + col]) : A.in[I_SCONV][((size_t)(l * 128 + b) * 3 + (3 + tt)) * 1536 + col];
            acc += cw[j * 1536 + col] * x; }
        RAW[idx] = silu_f(acc); }
    if (tid < 4) { const float a = AB[(size_t)(tokS + tid) * 8 + h], bb = AB[(size_t)(tokS + tid) * 8 + 4 + h];
        const float xx = a + A.in[I_DTB][l * 4 + h]; const float sp = xx > 20.f ? xx : log1pf(expf(xx));
        SC[8 + tid] = 1.f / (1.f + expf(-bb)); SC[12 + tid] = expf(-expf(A.in[I_ALOG][l * 4 + h]) * sp); }
    const int v = tid & 127, kq = tid >> 7;
    float S[32];
    { const float* sp = A.in[I_SDELTA] + (size_t)((l * 128 + b) * 4 + h) * 16384;
#pragma unroll
      for (int i = 0; i < 32; ++i) S[i] = sp[(kq * 32 + i) * 128 + v]; }
    __syncthreads();
    { const int part = wave >> 2, t = wave & 3; const float x0 = RAW[part * 512 + t * 128 + lane], x1 = RAW[part * 512 + t * 128 + 64 + lane];
      const float ss = wave_sum(x0 * x0 + x1 * x1); if (lane == 0) SC[part * 4 + t] = rsqrtf(ss + EPS) * (part == 0 ? 0.08838834764831845f : 1.f); }
    __syncthreads();
    for (int t = 0; t < 4; ++t) {
        const float rq = SC[t], rk = SC[4 + t], beta = SC[8 + t], g = SC[12 + t];
        float pr = 0.f;
#pragma unroll
        for (int i = 0; i < 32; ++i) pr += S[i] * RAW[512 + t * 128 + kq * 32 + i];
        RED[kq * 128 + v] = pr * rk;
        __syncthreads();
        const float rr = (RED[v] + RED[128 + v]) + (RED[256 + v] + RED[384 + v]);
        const float u = beta * (RAW[1024 + t * 128 + v] - g * rr);
        float po = 0.f;
#pragma unroll
        for (int i = 0; i < 32; ++i) { const float kh = RAW[512 + t * 128 + kq * 32 + i] * rk; S[i] = g * S[i] + kh * u; po += S[i] * RAW[t * 128 + kq * 32 + i]; }
        __syncthreads();
        RED[kq * 128 + v] = po * rq;
        __syncthreads();
        if (kq == 0) OB[t * 128 + v] = (RED[v] + RED[128 + v]) + (RED[256 + v] + RED[384 + v]);
        __syncthreads();
    }
    if (wave < 4) { const int t = wave; const float x0 = OB[t * 128 + lane], x1 = OB[t * 128 + 64 + lane];
        const float ss = wave_sum(x0 * x0 + x1 * x1); const float sc = rsqrtf(ss * (1.f / 128.f) + EPS);
        const float g0 = bf2f(PROJ[(size_t)(tokS + t) * NPROJ + PC_G + h * 128 + lane]), g1 = bf2f(PROJ[(size_t)(tokS + t) * NPROJ + PC_G + h * 128 + 64 + lane]);
        MIX[(size_t)(tokS + t) * D + h * 128 + lane] = (bf16_t)f2bf(x0 * sc * A.in[I_ONORM][l * 128 + lane] * silu_f(g0));
        MIX[(size_t)(tokS + t) * D + h * 128 + 64 + lane] = (bf16_t)f2bf(x1 * sc * A.in[I_ONORM][l * 128 + 64 + lane] * silu_f(g1)); }
    { float* dsp = A.out + O_DS + (size_t)((l * 128 + b) * 4 + h) * 16384;
#pragma unroll
      for (int i = 0; i < 32; ++i) dsp[(kq * 32 + i) * 128 + v] = S[i]; }
    __syncthreads();
}

#define SSM_BCAST_U(t) do { unsigned _w[8]; \
        _w[0] = __builtin_amdgcn_readlane(ua.x, t); _w[1] = __builtin_amdgcn_readlane(ua.y, t); _w[2] = __builtin_amdgcn_readlane(ua.z, t); _w[3] = __builtin_amdgcn_readlane(ua.w, t); \
        _w[4] = __builtin_amdgcn_readlane(ub.x, t); _w[5] = __builtin_amdgcn_readlane(ub.y, t); _w[6] = __builtin_amdgcn_readlane(ub.z, t); _w[7] = __builtin_amdgcn_readlane(ub.w, t); \
        _Pragma("unroll") for (int _d = 0; _d < 8; ++_d) { uu[2 * _d] = __uint_as_float(_w[_d] << 16); uu[2 * _d + 1] = __uint_as_float(_w[_d] & 0xffff0000u); } } while (0)
#define SSM_STEP() do { float _br = 0.f, _bi = 0.f; \
        _Pragma("unroll") for (int _h = 0; _h < 16; ++_h) { _br = fmaf(Br[_h], uu[_h], _br); _bi = fmaf(Bi[_h], uu[_h], _bi); } \
        const float _nr = lr * hr - li * hi + _br, _ni = lr * hi + li * hr + _bi; hr = _nr; hi = _ni; } while (0)

__device__ __forceinline__ void ssm_part1_item(const DevArgs& A, int l, int it, int lane) {
    const int g = it & 15, bc = it >> 4, b = bc / 31, c = bc % 31;
    const float* bb = (const float*)(A.ws + WS_BBAR) + ((size_t)(l * 16 + g) * 64 + lane) * 32;
    float Br[16], Bi[16];
#pragma unroll
    for (int q = 0; q < 4; ++q) { const f32x4 x = ((const f32x4*)bb)[q], y = ((const f32x4*)bb)[4 + q];
        Br[4 * q] = x.x; Br[4 * q + 1] = x.y; Br[4 * q + 2] = x.z; Br[4 * q + 3] = x.w; Bi[4 * q] = y.x; Bi[4 * q + 1] = y.y; Bi[4 * q + 2] = y.z; Bi[4 * q + 3] = y.w; }
    const f32x4 lk = ((const f32x4*)(A.ws + WS_SSMK))[(l * 16 + g) * 64 + lane]; const float lr = lk.x, li = lk.y;
    const bf16_t* up = (const bf16_t*)(A.ws + WS_PROJ) + (size_t)(b * SEQ + c * 64 + lane) * NPROJ + PC_SSM + g * 16;
    const u32x4 ua = *(const u32x4*)up, ub = *(const u32x4*)(up + 8);
    float hr = 0.f, hi = 0.f, uu[16];
#pragma unroll 1
    for (int t = 0; t < 64; ++t) { SSM_BCAST_U(t); SSM_STEP(); }
    f32x2 e; e.x = hr; e.y = hi;
    ((f32x2*)(A.ws + WS_SSME))[((size_t)(b * 32 + c) * 16 + g) * 64 + lane] = e;
}

__device__ __forceinline__ void ssm_part2_item(const DevArgs& A, int l, LAS unsigned char* lds, int it, int tid, int wave, int lane) {
    asm volatile("" : "+v"(tid)); lane = tid & 63; wave = __builtin_amdgcn_readfirstlane(tid >> 6);
    const int tok0 = it * 64, fr = lane & 15, quad = lane >> 4;
    const bool samp = it >= 256; const int b = it >> 5, c = it & 31;
    LAS unsigned char* YS = lds; LAS unsigned char* HS = lds + 33792 + wave * 4352;
    const bf16_t* PROJ = (const bf16_t*)(A.ws + WS_PROJ); bf16_t* MIX = (bf16_t*)(A.ws + WS_MIX);
#pragma unroll 1
    for (int gi = 0; gi < 2; ++gi) {
        const int g = wave * 2 + gi;
        const float* bb = (const float*)(A.ws + WS_BBAR) + ((size_t)(l * 16 + g) * 64 + lane) * 32;
        float Br[16], Bi[16];
#pragma unroll
        for (int q = 0; q < 4; ++q) { const f32x4 x = ((const f32x4*)bb)[q], y = ((const f32x4*)bb)[4 + q];
            Br[4 * q] = x.x; Br[4 * q + 1] = x.y; Br[4 * q + 2] = x.z; Br[4 * q + 3] = x.w; Bi[4 * q] = y.x; Bi[4 * q + 1] = y.y; Bi[4 * q + 2] = y.z; Bi[4 * q + 3] = y.w; }
        const f32x4 lk = ((const f32x4*)(A.ws + WS_SSMK))[(l * 16 + g) * 64 + lane]; const float lr = lk.x, li = lk.y, Lr = lk.z, Li = lk.w;
        bf16x8 Cb[4];
#pragma unroll
        for (int kk = 0; kk < 4; ++kk) { const size_t co = ((size_t)(l * 16 + g) * 16 + fr) * 64 + kk * 16 + quad * 4;
            const f32x4 cr = *(const f32x4*)(A.in[I_CRE] + co), ci = *(const f32x4*)(A.in[I_CIM] + co);
            u32x4 pk; pk.x = pk2(cr.x, -ci.x); pk.y = pk2(cr.y, -ci.y); pk.z = pk2(cr.z, -ci.z); pk.w = pk2(cr.w, -ci.w);
            Cb[kk] = __builtin_bit_cast(bf16x8, pk); }
        const bf16_t* up = PROJ + (size_t)(tok0 + lane) * NPROJ + PC_SSM + g * 16;
        const u32x4 ua = *(const u32x4*)up, ub = *(const u32x4*)(up + 8);
        float hr = 0.f, hi = 0.f, uu[16];
        if (!samp && c > 0) { const f32x2* E = (const f32x2*)(A.ws + WS_SSME) + ((size_t)(b * 32) * 16 + g) * 64 + lane;
#pragma unroll
            for (int cb = 0; cb < 32; cb += 16) { f32x2 ev[16];
#pragma unroll
                for (int q = 0; q < 16; ++q) { const int cc = cb + q; ev[q] = (cc < c) ? E[(size_t)cc * 1024] : (f32x2){0.f, 0.f}; }
#pragma unroll
                for (int q = 0; q < 16; ++q) { const int cc = cb + q; if (cc < c) { const float nr = Lr * hr - Li * hi + ev[q].x, ni = Lr * hi + Li * hr + ev[q].y; hr = nr; hi = ni; } } } }
        const float dsk = A.in[I_SSMD][l * 256 + g * 16 + fr];
        unsigned uvr[16];
#pragma unroll
        for (int e = 0; e < 16; ++e) uvr[e] = PROJ[(size_t)(tok0 + (e >> 2) * 16 + quad * 4 + (e & 3)) * NPROJ + PC_SSM + g * 16 + fr];
#pragma unroll
        for (int sub = 0; sub < 4; ++sub) {
#pragma unroll 1
            for (int tt = 0; tt < 16; ++tt) { const int t = sub * 16 + tt;
                const int sb = (it - 256) * 16 + (t >> 2);
                if (samp && (t & 3) == 0) { hr = A.in[I_SRE][((size_t)(l * 128 + sb) * 16 + g) * 64 + lane]; hi = A.in[I_SIM][((size_t)(l * 128 + sb) * 16 + g) * 64 + lane]; }
                SSM_BCAST_U(t); SSM_STEP();
                *(LAS unsigned*)(HS + tt * 272 + lane * 4) = pg8::cvt_pk_bf16(hr, hi);
                if (samp && (t & 3) == 3) { A.out[O_RES + ((size_t)(l * 128 + sb) * 16 + g) * 64 + lane] = hr; A.out[O_IMS + ((size_t)(l * 128 + sb) * 16 + g) * 64 + lane] = hi; }
            }
            LDS_FENCE();
            f32x4 acc = {0.f, 0.f, 0.f, 0.f};
#pragma unroll
            for (int kk = 0; kk < 4; ++kk) { const bf16x8 a = *(LAS bf16x8*)(HS + fr * 272 + (kk * 32 + quad * 8) * 2); acc = mfma16(a, Cb[kk], acc); }
#pragma unroll
            for (int i = 0; i < 4; ++i) { const int t = sub * 16 + quad * 4 + i; const float uv = bf2f(uvr[sub * 4 + i]);
                *(LAS bf16_t*)(YS + t * 528 + (g * 16 + fr) * 2) = (bf16_t)f2bf(gelu_tanh_f(acc[i] + dsk * uv)); }
            LDS_FENCE();
        }
        if (!samp && c == 31) { A.out[O_REP + ((size_t)(l * 8 + b) * 16 + g) * 64 + lane] = hr; A.out[O_IMP + ((size_t)(l * 8 + b) * 16 + g) * 64 + lane] = hi; }
    }
    __syncthreads();
    {
        const bf16_t* GT = (const bf16_t*)(A.ws + WS_GLUT + l * SZ_GLUT);
        f32x4 acc[4][2];
#pragma unroll
        for (int mt = 0; mt < 4; ++mt) { acc[mt][0] = (f32x4){0.f, 0.f, 0.f, 0.f}; acc[mt][1] = (f32x4){0.f, 0.f, 0.f, 0.f}; }
#pragma unroll
        for (int kk = 0; kk < 8; ++kk) { bf16x8 bfr[2];
#pragma unroll
            for (int nt = 0; nt < 2; ++nt) bfr[nt] = *(const bf16x8*)(GT + (size_t)(32 * wave + nt * 16 + fr) * 256 + kk * 32 + quad * 8);
#pragma unroll
            for (int mt = 0; mt < 4; ++mt) { const bf16x8 a = *(LAS bf16x8*)(YS + (mt * 16 + fr) * 528 + (kk * 32 + quad * 8) * 2);
                acc[mt][0] = mfma16(a, bfr[0], acc[mt][0]); acc[mt][1] = mfma16(a, bfr[1], acc[mt][1]); } }
#pragma unroll
        for (int nt = 0; nt < 2; ++nt) { const int ncol = 32 * wave + nt * 16 + fr; const float gb = A.in[I_GLUB][l * 256 + ncol];
#pragma unroll
            for (int mt = 0; mt < 4; ++mt)
#pragma unroll
                for (int i = 0; i < 4; ++i) { const int t = mt * 16 + quad * 4 + i; const float y = bf2f(*(LAS bf16_t*)(YS + t * 528 + ncol * 2));
                    MIX[(size_t)(tok0 + t) * D + 512 + ncol] = (bf16_t)f2bf(y * sigmoid_f(acc[mt][nt][i] + gb)); } }
    }
    __syncthreads();
}

__device__ __forceinline__ void pool_item(const DevArgs& A, int l, LAS unsigned char* lds, int it, int tid, int wave, int lane) {
    asm volatile("" : "+v"(tid)); lane = tid & 63; wave = __builtin_amdgcn_readfirstlane(tid >> 6);
    const int tok0 = it * 64, fr = lane & 15, quad = lane >> 4; const bool samp = it >= 256;
    LAS unsigned char* RS = lds;
    const bf16_t* PROJ = (const bf16_t*)(A.ws + WS_PROJ); bf16_t* MIX = (bf16_t*)(A.ws + WS_MIX);
    if (!samp) {
        LAS unsigned char* XT = lds + 33792;
        const int b = it >> 5, c = it & 31;
        for (int id = tid; id < 79 * 32; id += 512) { const int r = id >> 5, c16 = id & 31, tl = c * 64 - 15 + r;
            u32x4 v = {0u, 0u, 0u, 0u}; if (tl >= 0) v = *(const u32x4*)(PROJ + (size_t)(b * SEQ + tl) * NPROJ + PC_POOL + c16 * 8);
            *(LAS u32x4*)(XT + r * 528 + c16 * 16) = v; }
        __syncthreads();
        const int ch = tid & 255, half = tid >> 8, g = ch >> 6, w = 2 << g, r0 = half * 32;
        float sum = 0.f;
        for (int j = 0; j < w; ++j) sum += bf2f(*(LAS bf16_t*)(XT + (r0 + 15 - j) * 528 + ch * 2));
#pragma unroll 4
        for (int rr = 0; rr < 32; ++rr) { const int r = r0 + rr, tl = c * 64 + r;
            const float u = bf2f(*(LAS bf16_t*)(XT + (r + 15) * 528 + ch * 2));
            if (rr > 0) sum += u - bf2f(*(LAS bf16_t*)(XT + (r + 15 - w) * 528 + ch * 2));
            const float cnt = (float)((tl + 1 < w) ? tl + 1 : w);
            *(LAS bf16_t*)(RS + r * 528 + ch * 2) = (bf16_t)f2bf(sum / cnt - u); }
    } else {
#pragma unroll 1
        for (int pr = 0; pr < 8; ++pr) { const int idx = pr * 512 + tid, ch = idx & 255, sq = idx >> 8, g = ch >> 6, w = 2 << g;
            const int sb = (it - 256) * 16 + sq;
            const float* sbuf = A.in[I_SPOOL] + (size_t)(l * 128 + sb) * 15 * 256 + ch;
            const bf16_t* base = PROJ + (size_t)(NP + sb * 4) * NPROJ + PC_POOL + ch;
            float e[19];
#pragma unroll
            for (int j = 0; j < 15; ++j) e[j] = sbuf[j * 256];
#pragma unroll
            for (int j = 0; j < 4; ++j) e[15 + j] = bf2f(base[(size_t)j * NPROJ]);
#pragma unroll
            for (int t = 0; t < 4; ++t) { float sum = 0.f;
#pragma unroll
                for (int j = 0; j < 16; ++j) sum += (j < w) ? e[15 + t - j] : 0.f;
                *(LAS bf16_t*)(RS + (sq * 4 + t) * 528 + ch * 2) = (bf16_t)f2bf(sum / (float)w - e[15 + t]); } }
    }
    __syncthreads();
    { const int g2 = wave >> 1; const bf16_t* PT = (const bf16_t*)(A.ws + WS_POOLT + l * SZ_POOLT) + g2 * 4096;
      f32x4 acc[4][2];
#pragma unroll
      for (int mt = 0; mt < 4; ++mt) { acc[mt][0] = (f32x4){0.f, 0.f, 0.f, 0.f}; acc[mt][1] = (f32x4){0.f, 0.f, 0.f, 0.f}; }
#pragma unroll
      for (int kk = 0; kk < 2; ++kk) { bf16x8 bfr[2];
#pragma unroll
          for (int nt = 0; nt < 2; ++nt) bfr[nt] = *(const bf16x8*)(PT + (size_t)((wave & 1) * 32 + nt * 16 + fr) * 64 + kk * 32 + quad * 8);
#pragma unroll
          for (int mt = 0; mt < 4; ++mt) { const bf16x8 a = *(LAS bf16x8*)(RS + (mt * 16 + fr) * 528 + (g2 * 64 + kk * 32 + quad * 8) * 2);
              acc[mt][0] = mfma16(a, bfr[0], acc[mt][0]); acc[mt][1] = mfma16(a, bfr[1], acc[mt][1]); } }
#pragma unroll
      for (int nt = 0; nt < 2; ++nt) { const int col = 32 * wave + nt * 16 + fr; const float ps = A.in[I_POOLS][l * 256 + col];
#pragma unroll
          for (int mt = 0; mt < 4; ++mt)
#pragma unroll
              for (int i = 0; i < 4; ++i) { const int t = mt * 16 + quad * 4 + i; MIX[(size_t)(tok0 + t) * D + 768 + col] = (bf16_t)f2bf(acc[mt][nt][i] * ps); } } }
    __syncthreads();
}

__device__ __forceinline__ void state_copies(const DevArgs& A, int l, int gt, int NT) {
    const bf16_t* PROJ = (const bf16_t*)(A.ws + WS_PROJ);
#pragma unroll 1
    for (int i = gt; i < 8 * 3 * 1536; i += NT) { const int col = i % 1536, j = (i / 1536) % 3, b = i / 4608;
        A.out[O_CP + (size_t)l * 8 * 4608 + i] = bf2f(PROJ[(size_t)(b * SEQ + SEQ - 3 + j) * NPROJ + col]); }
#pragma unroll 1
    for (int i = gt; i < 128 * 3 * 1536; i += NT) { const int col = i % 1536, j = (i / 1536) % 3, b = i / 4608;
        A.out[O_CS + (size_t)l * 128 * 4608 + i] = bf2f(PROJ[(size_t)(NP + b * 4 + 1 + j) * NPROJ + col]); }
#pragma unroll 1
    for (int i = gt; i < 8 * 15 * 256; i += NT) { const int ch = i & 255, j = (i >> 8) % 15, b = i / 3840;
        A.out[O_PP + (size_t)l * 8 * 3840 + i] = bf2f(PROJ[(size_t)(b * SEQ + SEQ - 15 + j) * NPROJ + PC_POOL + ch]); }
#pragma unroll 1
    for (int i = gt; i < 128 * 15 * 256; i += NT) { const int ch = i & 255, j = (i >> 8) % 15, b = i / 3840;
        A.out[O_PS + (size_t)l * 128 * 3840 + i] = (j < 11) ? A.in[I_SPOOL][((size_t)(l * 128 + b) * 15 + 4 + j) * 256 + ch]
                                                             : bf2f(PROJ[(size_t)(NP + b * 4 + (j - 11)) * NPROJ + PC_POOL + ch]); }
}

#ifndef REP_DPREP
#define REP_DPREP 1
#endif
#ifndef REP_DSAMP
#define REP_DSAMP 1
#endif
#ifndef REP_SSM1
#define REP_SSM1 1
#endif
#ifndef REP_POOL
#define REP_POOL 1
#endif
#ifndef REP_DSCAN
#define REP_DSCAN 1
#endif
#ifndef REP_SSM2
#define REP_SSM2 1
#endif
#ifndef REP_G
#define REP_G 1
#endif
#ifndef REP_P3
#define REP_P3 1
#endif
#ifndef REP_P2
#define REP_P2 1
#endif
constexpr int NPH = 2 + DEPTH * 8;
__global__ void __launch_bounds__(512, 2) mega_fwd(Args KA) {
    DevArgs A; A.out = KA.out; A.ws = KA.ws; A.ph_lo = KA.ph_lo; A.ph_hi = KA.ph_hi;
    extern __shared__ __attribute__((aligned(16))) unsigned char lds_raw[];
    LAS unsigned char* lds = (LAS unsigned char*)lds_raw;
    cg::grid_group grid = cg::this_grid();
    volatile LAS unsigned* xst = (volatile LAS unsigned*)(lds + LDS_BYTES - 64);
    if (threadIdx.x == 0) { xst[0] = 0u; xst[1] = 0u; }
    __syncthreads();
    const XcdBarrier xb = xcd_barrier_post((unsigned*)(KA.ws + WS_BAR), xst);
    constexpr int G = 256, NGW = G * 8, NT = G * 512;
    int ph = 0;
#define PH_BEGIN if (A.ph_lo <= ph && ph < A.ph_hi) { int tid = threadIdx.x; asm volatile("" : "+v"(tid)); { unsigned char* _w = A.ws; asm volatile("" : "+s"(_w)); A.ws = _w; float* _o = A.out; asm volatile("" : "+s"(_o)); A.out = _o; } const int wave = __builtin_amdgcn_readfirstlane(tid >> 6), lane = tid & 63, gw = blockIdx.x * 8 + wave, gt = blockIdx.x * 512 + tid; (void)gw; (void)gt; (void)lane;
#define PH_END   if (ph + 1 < A.ph_hi) { if (ph == 0) grid.sync(); else xcd_barrier(xb); } } ++ph;
#define Hb   ((bf16_t*)(A.ws + WS_H))
#define AB   ((float*)(A.ws + WS_AB))
#define MIXO ((float*)(A.ws + WS_MIXO))
#define PROJ ((bf16_t*)(A.ws + WS_PROJ))
#define MIX  ((bf16_t*)(A.ws + WS_MIX))
#define HID  ((bf16_t*)(A.ws + WS_HID))

#ifndef REP_PRO
#define REP_PRO 1
#endif
#ifndef REP_N0
#define REP_N0 1
#endif
    PH_BEGIN for (int rep = 0; rep < REP_PRO; ++rep) { prologue(A, lds, wave, lane, gw, NGW); __syncthreads(); } PH_END
    PH_BEGIN for (int rep = 0; rep < REP_N0; ++rep) norm_rows(nullptr, nullptr, A.in[I_XP], A.in[I_XS], nullptr, A.in[I_NMPRE], Hb, (const float*)(A.ws + WS_WAB), AB, gw, NGW, lane); PH_END

#pragma unroll 1
    for (int l = 0; l < DEPTH; ++l) {
        PH_BEGIN for (int rep = 0; rep < REP_G; ++rep) { pg8::Gemm g{Hb, (const bf16_t*)(A.ws + WS_WIN + l * SZ_WIN), NTOK, NPROJ, D, D, D}; pg8::StaticOrder S; S.init(NTOK, NPROJ, G, (int)blockIdx.x);
            pg8::EpiBf16<0> E{PROJ, NPROJ, nullptr, 0, 0}; pg8::gemm_phase<pg8::EpiBf16<0>, pg8::StaticOrder>(lds, g, S, E, nullptr); } PH_END
        constexpr int SUBC = 7;
        PH_BEGIN {
#pragma unroll 1
          for (int rep2 = 0; rep2 < REP_P2; ++rep2) {
#pragma unroll 1
            for (int j = blockIdx.x; j < 32 * SUBC; j += G) delta_prep_item(A, l, lds, (j & 31) * 32 + (j >> 5), tid, wave, lane);
          }
        } PH_END
        PH_BEGIN {
#pragma unroll 1
            for (int rep3 = 0; rep3 < REP_P3; ++rep3) {
                if (blockIdx.x < 32) delta_scan_item(A, l, lds, blockIdx.x, tid, wave, lane, xb, SUBC);
                else { const int w = blockIdx.x - 32; constexpr int NW = G - 32;
#pragma unroll 1
                    for (int k = 1; k <= 5; ++k) {
                        const int n0 = k * SUBC, nn = (n0 >= 32) ? 0 : ((32 - n0 < SUBC) ? 32 - n0 : SUBC);
                        int nprep = 32 * nn;
#ifndef REP_WPREP
#define REP_WPREP 1
#endif
#pragma unroll 1
                        for (int rep = 0; rep < REP_WPREP; ++rep)
#pragma unroll 1
                        for (int j = w; j < nprep; j += NW) delta_prep_item(A, l, lds, (j & 31) * 32 + n0 + (j >> 5), tid, wave, lane);
                        if (k == 1) {
#pragma unroll 1
                            for (int it = w; it < 512; it += NW) delta_sample_item(A, l, lds, it, tid, wave, lane); }
                        if (k == 2) {
#pragma unroll 1
                            for (int it = w * 8 + wave; it < 8 * 31 * 16; it += NW * 8) { int t1 = threadIdx.x; asm volatile("" : "+v"(t1)); ssm_part1_item(A, l, it, t1 & 63); }
                            { int t2 = threadIdx.x; asm volatile("" : "+v"(t2)); int wl = blockIdx.x; asm volatile("" : "+s"(wl)); state_copies(A, l, (wl - 32) * 512 + t2, NW * 512); } }
                        if (k == 3) {
#pragma unroll 1
                            for (int it = w; it < 264; it += NW) pool_item(A, l, lds, it, tid, wave, lane); }
                        { const int it = (k == 4) ? w - 128 : ((k == 5) ? 96 + w : -1);
                          if (it >= 0 && it < ((k == 4) ? 96 : 264)) ssm_part2_item(A, l, lds, it, tid, wave, lane); }
                        if (k < 5) xcd_barrier(xb);
                    } }
            }
        } PH_END
        PH_BEGIN for (int rep = 0; rep < REP_G; ++rep) { pg8::Gemm g{MIX, (const bf16_t*)(A.ws + WS_WOUT + l * SZ_WOUT), NP, D, D, D, D}; pg8::StaticOrder S; S.init(NP, D, G, (int)blockIdx.x);
            pg8::EpiBf16<0> E{(bf16_t*)MIXO, D, nullptr, 0, 0}; pg8::gemm_phase<pg8::EpiBf16<0>, pg8::StaticOrder>(lds, g, S, E, nullptr);
            pg8::Gemm g2{MIX + (size_t)NP * D, (const bf16_t*)(A.ws + WS_WOUT + l * SZ_WOUT), NS, D, 256, D, D}; SliceOrder S2{8 * (D / 256), G, (int)blockIdx.x};
            EpiF32Part E2{(float*)(A.ws + WS_PARTS)}; pg8::gemm_phase<EpiF32Part, SliceOrder>(lds, g2, S2, E2, nullptr); } PH_END
#ifndef REP_N5
#define REP_N5 1
#endif
        PH_BEGIN for (int rep = 0; rep < (l == 0 ? REP_N5 : 1); ++rep) norm_rows(MIXO, A.in[I_NMPOST] + l * D, l == 0 ? A.in[I_XP] : A.out, l == 0 ? A.in[I_XS] : nullptr, A.out, A.in[I_NFPRE] + l * D, Hb, nullptr, nullptr, gw, NGW, lane, (const float*)(A.ws + WS_PARTS), D / 256); PH_END
        PH_BEGIN for (int rep = 0; rep < REP_G; ++rep) { pg8::Gemm g{Hb, (const bf16_t*)(A.ws + WS_WGU + l * SZ_WGU), NTOK, NGU, D, D, D}; pg8::StaticOrder S; S.init(NTOK, NGU, G, (int)blockIdx.x);
            EpiSwiGLU E{HID, DFF}; pg8::gemm_phase<EpiSwiGLU, pg8::StaticOrder>(lds, g, S, E, nullptr); } PH_END
        PH_BEGIN for (int rep = 0; rep < REP_G; ++rep) { pg8::Gemm g{HID, (const bf16_t*)(A.ws + WS_WDN + l * SZ_WDN), NP, D, DFF, DFF, DFF}; pg8::StaticOrder S; S.init(NP, D, G, (int)blockIdx.x);
            pg8::EpiBf16<0> E{(bf16_t*)MIXO, D, nullptr, 0, 0}; pg8::gemm_phase<pg8::EpiBf16<0>, pg8::StaticOrder>(lds, g, S, E, nullptr);
            pg8::Gemm g2{HID + (size_t)NP * DFF, (const bf16_t*)(A.ws + WS_WDN + l * SZ_WDN), NS, D, 256, DFF, DFF}; SliceOrder S2{8 * (DFF / 256), G, (int)blockIdx.x};
            EpiF32Part E2{(float*)(A.ws + WS_PARTS)}; pg8::gemm_phase<EpiF32Part, SliceOrder>(lds, g2, S2, E2, nullptr); } PH_END
        PH_BEGIN norm_rows(MIXO, A.in[I_NFPOST] + l * D, A.out, nullptr, A.out, l + 1 < DEPTH ? A.in[I_NMPRE] + (l + 1) * D : nullptr, l + 1 < DEPTH ? Hb : nullptr,
                           l + 1 < DEPTH ? (const float*)(A.ws + WS_WAB + (l + 1) * SZ_WAB) : nullptr, AB, gw, NGW, lane, (const float*)(A.ws + WS_PARTS), DFF / 256); PH_END
    }
#undef PH_BEGIN
#undef PH_END
#undef Hb
#undef AB
#undef MIXO
#undef PROJ
#undef MIX
#undef HID
}

extern "C" void kernel_launch(void* const* d_in, const int* in_sizes, int n_in, void* d_out, int out_size, void* d_ws, size_t ws_size, hipStream_t stream) {
    static int grid = 0;
    if (grid == 0) {
        if (n_in != 32 || (size_t)out_size != O_END || ws_size < WS_END) fprintf(stderr, "kernel_launch: unexpected sizes: n_in %d out %d (want %zu) ws %zu (want >= %zu)\n", n_in, out_size, (size_t)O_END, ws_size, (size_t)WS_END);
        int dev = 0, cus = 0, per_cu = 0;
        (void)hipGetDevice(&dev); (void)hipDeviceGetAttribute(&cus, hipDeviceAttributeMultiprocessorCount, dev);
        if (hipFuncSetAttribute((const void*)mega_fwd, hipFuncAttributeMaxDynamicSharedMemorySize, LDS_BYTES) != hipSuccess) fprintf(stderr, "kernel_launch: hipFuncSetAttribute failed\n");
        if (hipOccupancyMaxActiveBlocksPerMultiprocessor(&per_cu, (const void*)mega_fwd, 512, LDS_BYTES) != hipSuccess || per_cu < 1) { fprintf(stderr, "kernel_launch: occupancy query gave %d\n", per_cu); per_cu = 1; (void)hipGetLastError(); }
        grid = cus * per_cu; if (grid <= 0) grid = 256;
        if (grid >= 256) grid = 256;
        fprintf(stderr, "kernel_launch: grid %d (cus %d x %d)%s\n", grid, cus, per_cu, grid < 256 ? "  ERROR: this build needs >= 256 co-resident workgroups" : "");
    }
    (void)hipMemsetAsync((unsigned char*)d_ws + WS_BAR, 0, 16384, stream);
    Args a{};
    for (int i = 0; i < 32; ++i) a.in[i] = (const float*)d_in[i];
    a.out = (float*)d_out; a.ws = (unsigned char*)d_ws;
#if MK_COOP
    a.ph_lo = 0; a.ph_hi = NPH;
    void* args[] = {&a};
    const hipError_t e = hipLaunchCooperativeKernel((const void*)mega_fwd, dim3(grid), dim3(512), args, LDS_BYTES, stream);
    if (e != hipSuccess) fprintf(stderr, "kernel_launch: cooperative launch failed: %s (grid %d)\n", hipGetErrorString(e), grid);
#else
    for (int p = 0; p < NPH; ++p) { a.ph_lo = p; a.ph_hi = p + 1; hipLaunchKernelGGL(mega_fwd, dim3(grid), dim3(512), LDS_BYTES, stream, a); }
#endif
}
```

```cpp
#include <hip/hip_runtime.h>
#include <hip/hip_cooperative_groups.h>
#include <cstdio>
#include <cstdint>
namespace cg = cooperative_groups;
#ifndef MK_COOP
#define MK_COOP 1
#endif
namespace pg8 {
#define PG8_LAS __attribute__((address_space(3)))
typedef unsigned short bf16_t;
typedef short bf16x8 __attribute__((ext_vector_type(8)));
typedef float f32x4 __attribute__((ext_vector_type(4)));
typedef unsigned u32x4 __attribute__((ext_vector_type(4)));
constexpr int BM = 256, BK = 64, HALF = 128, HTB = HALF * BK * 2  , STAGE_BYTES = 8 * HTB, NXCD = 8, WGM = 8;

__host__ __device__ __forceinline__ int lds_byte(int r, int c) { const int st = (r >> 4) * 2 + (c >> 5), rr = r & 15, cc = c & 31, ob = rr * 64 + cc * 2; return st * 1024 + (ob ^ (((ob >> 9) & 1) << 5)); }
__host__ __device__ __forceinline__ void stage_rc(int b, int& R, int& C) { const int st = b / 1024, sb = b % 1024, swz = sb ^ (((sb >> 9) & 1) << 5); R = (st >> 1) * 16 + swz / 64; C = (st & 1) * 32 + (swz % 64) / 2; }
__host__ __device__ __forceinline__ int perm32(int rho) { const int n = rho >> 4, i = rho & 15; return 8 * (i >> 2) + 4 * n + (i & 3); }

struct Unit { int pm, pn, ks; };
struct Gemm { const bf16_t* A; const bf16_t* Bt; int M, N, K, lda, ldb; };

struct StaticOrder {
    int nM, nN, nwg, G, c;
    __host__ __device__ void init(int M, int N, int G_, int c_) { nM = M / BM; nN = N / BM; nwg = nM * nN; G = G_; c = c_; }
    __host__ __device__ bool next(int i, Unit& u) const {
        const long L = (long)i * G + c; if (L >= nwg) return false;
        int wgid = (int)L; { const int q = nwg / NXCD, r = nwg % NXCD, xcd = wgid % NXCD, off = wgid / NXCD; wgid = (xcd < r ? xcd * (q + 1) : r * (q + 1) + (xcd - r) * q) + off; }
        const int nig = WGM * nN, gid = wgid / nig, fm = gid * WGM, gsz = (nM - fm) < WGM ? (nM - fm) : WGM;
        u.pm = fm + ((wgid % nig) % gsz); u.pn = (wgid % nig) / gsz; u.ks = 0; return true;
    }
    __device__ __forceinline__ void a_ready(const Unit&) const {}
    __device__ __forceinline__ void done(const Unit&) const {}
};
__device__ __forceinline__ unsigned cvt_pk_bf16(float lo, float hi) { unsigned r; asm volatile("v_cvt_pk_bf16_f32 %0, %1, %2" : "=v"(r) : "v"(lo), "v"(hi)); return r; }
typedef float f32x2 __attribute__((ext_vector_type(2)));
__device__ __forceinline__ f32x2 gelu_pk(f32x2 v) {
    const f32x2 av = __builtin_elementwise_abs(v), d = av * 0.2316418882f + 1.0f;
    f32x2 t; t.x = __builtin_amdgcn_rcpf(d.x); t.y = __builtin_amdgcn_rcpf(d.y);
    f32x2 q = t * 0.5307027145f + (-0.7265760135f); q = q * t + 0.7107068705f; q = q * t + (-0.142248368f); q = q * t + 0.127414796f; q = q * t;
    const f32x2 s = (v * v) * (-0.72134752044f);
    f32x2 e; e.x = __builtin_amdgcn_exp2f(s.x); e.y = __builtin_amdgcn_exp2f(s.y);
    const f32x2 m = v * (q * e), r = v - m;
    f32x2 o; o.x = v.x < 0.f ? m.x : r.x; o.y = v.y < 0.f ? m.y : r.y; return o;
}

struct EpiF32 {
    static constexpr bool PERM = false, AFTER_DRAIN = false;
    float* C; int ldc; const float* bias;
    __device__ __forceinline__ void operator()(const f32x4 (&acc)[2][2][4][2], const Unit& u, int wr, int wc, int fr, int fq) const {
        const int row0 = u.pm * BM + wr * 64 + fr, col0 = u.pn * BM + wc * 32 + 4 * fq;
        f32x4 bv[2][2];
#pragma unroll
        for (int bj = 0; bj < 2; ++bj)
#pragma unroll
            for (int n = 0; n < 2; ++n) bv[bj][n] = bias ? *(const f32x4*)(bias + col0 + bj * HALF + n * 16) : (f32x4){0.f, 0.f, 0.f, 0.f};
#pragma unroll
        for (int ai = 0; ai < 2; ++ai)
#pragma unroll
            for (int m = 0; m < 4; ++m) { float* rowp = C + (size_t)(row0 + ai * HALF + m * 16) * ldc + col0;
#pragma unroll
                for (int bj = 0; bj < 2; ++bj)
#pragma unroll
                    for (int n = 0; n < 2; ++n) *(f32x4*)(rowp + bj * HALF + n * 16) = acc[ai][bj][m][n] + bv[bj][n]; }
    }
};
template <int ACT  > struct EpiBf16 {
    static constexpr bool PERM = true, AFTER_DRAIN = false;
    bf16_t* O; int ldc; const float* bias; int split_cols; size_t split_stride;
    __device__ __forceinline__ void operator()(const f32x4 (&acc)[2][2][4][2], const Unit& u, int wr, int wc, int fr, int fq) const {
        const int row0 = u.pm * BM + wr * 64 + fr; int colt = u.pn * BM; bf16_t* base = O;
        if (split_cols) { const int t = colt / split_cols; base += (size_t)t * split_stride; colt -= t * split_cols; }
        const int col0 = colt + wc * 32 + 8 * fq, bcol0 = u.pn * BM + wc * 32 + 8 * fq;
        f32x4 bv[2][2];
#pragma unroll
        for (int bj = 0; bj < 2; ++bj)
#pragma unroll
            for (int n = 0; n < 2; ++n) bv[bj][n] = bias ? *(const f32x4*)(bias + bcol0 + bj * HALF + 4 * n) : (f32x4){0.f, 0.f, 0.f, 0.f};
#pragma unroll
        for (int ai = 0; ai < 2; ++ai)
#pragma unroll
            for (int m = 0; m < 4; ++m) { bf16_t* rowp = base + (size_t)(row0 + ai * HALF + m * 16) * ldc + col0;
#pragma unroll
                for (int bj = 0; bj < 2; ++bj) { f32x4 v0 = acc[ai][bj][m][0] + bv[bj][0], v1 = acc[ai][bj][m][1] + bv[bj][1];
                    if (ACT == 1) { f32x2 a = gelu_pk((f32x2){v0[0], v0[1]}), b = gelu_pk((f32x2){v0[2], v0[3]}), c = gelu_pk((f32x2){v1[0], v1[1]}), d = gelu_pk((f32x2){v1[2], v1[3]});
                        v0 = (f32x4){a.x, a.y, b.x, b.y}; v1 = (f32x4){c.x, c.y, d.x, d.y}; }
                    if (ACT == 2) {
#pragma unroll
                        for (int j = 0; j < 4; ++j) { v0[j] = 0.5f * v0[j] * (1.0f + erff(v0[j] * 0.70710678f)); v1[j] = 0.5f * v1[j] * (1.0f + erff(v1[j] * 0.70710678f)); } }
                    u32x4 w; w.x = cvt_pk_bf16(v0[0], v0[1]); w.y = cvt_pk_bf16(v0[2], v0[3]); w.z = cvt_pk_bf16(v1[0], v1[1]); w.w = cvt_pk_bf16(v1[2], v1[3]);
                    *(u32x4*)(rowp + bj * HALF) = w; } }
    }
};
template <class Epi, class Sched, bool STAMP = false>
__device__ __forceinline__ void gemm_phase(PG8_LAS unsigned char* lds, const Gemm g, const Sched& S, const Epi& E, unsigned long long* stamps) {
    int tid_ = threadIdx.x; asm volatile("" : "+v"(tid_));
    const int tid = tid_, wid = __builtin_amdgcn_readfirstlane(tid >> 6), lane = tid & 63, wr = wid >> 2, wc = wid & 3, fr = lane & 15, fq = lane >> 4;
    const int K = g.K, nt = K / BK;
    int ts_lo = 0, ts_hi = 0, nts = 0; const unsigned long long rt_entry = STAMP ? (unsigned long long)wall_clock64() : 0ull;
#define PG8_STAMP() do { if (STAMP && wid == 0 && nts < 64) { const unsigned long long _c = (unsigned long long)clock64(); \
        ts_lo = (lane == nts) ? (int)(unsigned)_c : ts_lo; ts_hi = (lane == nts) ? (int)(unsigned)(_c >> 32) : ts_hi; ++nts; } } while (0)
    PG8_STAMP();
    unsigned voffA[2], voffB[2];
#pragma unroll
    for (int i = 0; i < 2; ++i) { int R, C; stage_rc(tid * 16 + i * 8192, R, C); const int Rb = Epi::PERM ? ((R & ~31) + perm32(R & 31)) : R;
        voffA[i] = (unsigned)(R * g.lda + C) * 2u; voffB[i] = (unsigned)(Rb * g.ldb + C) * 2u; }
    const size_t kstep = (size_t)(BK * 2);
    const size_t hstepA = (size_t)HALF * g.lda * 2, hstepB = (size_t)HALF * g.ldb * 2;
    const size_t tstepA = 2 * hstepA, tstepB = 2 * hstepB, sstep = (size_t)K * 2;
    const unsigned ldsw = (unsigned)wid * 1024u;
    const int aoff = lds_byte(wr * 64 + fr, fq * 8), boff = lds_byte(wc * 32 + fr, fq * 8);
#define PG8_SA(b, h) (((b) * 2 + (h)) * HTB)
#define PG8_SB(b, h) ((4 + (b) * 2 + (h)) * HTB)
#define PG8_STAGE(bufoff, gbase, voff) do { _Pragma("unroll") for (int _i = 0; _i < 2; ++_i) \
        __builtin_amdgcn_global_load_lds((const unsigned*)((const char*)(gbase) + (voff)[_i]), (PG8_LAS unsigned*)(lds + (bufoff) + ldsw + _i * 8192), 16, 0, 0); } while (0)
#define PG8_LDA(dst, b, h) do { _Pragma("unroll") for (int m = 0; m < 4; ++m) _Pragma("unroll") for (int k = 0; k < 2; ++k) dst[m][k] = *(const PG8_LAS bf16x8*)(lds + PG8_SA(b, h) + aoff + m * 2048 + k * 1024); } while (0)
#define PG8_LDB(dst, b, h) do { _Pragma("unroll") for (int n = 0; n < 2; ++n) _Pragma("unroll") for (int k = 0; k < 2; ++k) dst[n][k] = *(const PG8_LAS bf16x8*)(lds + PG8_SB(b, h) + boff + n * 2048 + k * 1024); } while (0)
#define PG8_MMA(ai, bj, At, Bt) do { __builtin_amdgcn_s_setprio(1); _Pragma("unroll") for (int m = 0; m < 4; ++m) _Pragma("unroll") for (int n = 0; n < 2; ++n) _Pragma("unroll") for (int k = 0; k < 2; ++k) \
        acc[ai][bj][m][n] = __builtin_amdgcn_mfma_f32_16x16x32_bf16(Bt[n][k], At[m][k], acc[ai][bj][m][n], 0, 0, 0); __builtin_amdgcn_s_setprio(0); } while (0)
#define PG8_WAIT_V(n) asm volatile("s_waitcnt vmcnt(" #n ")" ::: "memory")
#define PG8_WAIT_L(n) asm volatile("s_waitcnt lgkmcnt(" #n ")" ::: "memory")
#define PG8_BAR __builtin_amdgcn_s_barrier()
#define PG8_SCHED __builtin_amdgcn_sched_barrier(0)
    Unit cur, nxt; int ui = 0;
    if (!S.next(0, cur)) return;
    f32x4 acc[2][2][4][2];
#pragma unroll
    for (int a = 0; a < 2; ++a)
#pragma unroll
        for (int b = 0; b < 2; ++b)
#pragma unroll
            for (int m = 0; m < 4; ++m)
#pragma unroll
                for (int n = 0; n < 2; ++n) acc[a][b][m][n] = (f32x4){0.f, 0.f, 0.f, 0.f};
    bf16x8 At[4][2], B0[2][2], B1[2][2];
    const char* cA = (const char*)g.A + (size_t)cur.pm * tstepA + (size_t)cur.ks * sstep; const char* cB = (const char*)g.Bt + (size_t)cur.pn * tstepB + (size_t)cur.ks * sstep;
    S.a_ready(cur);
    PG8_STAGE(PG8_SB(0, 0), cB, voffB); PG8_STAGE(PG8_SA(0, 0), cA, voffA); PG8_STAGE(PG8_SB(0, 1), cB + hstepB, voffB); PG8_STAGE(PG8_SA(0, 1), cA + hstepA, voffA);
    if (wr == 1) PG8_BAR;
    PG8_WAIT_V(4); PG8_BAR;
    PG8_STAGE(PG8_SB(1, 0), cB + kstep, voffB); PG8_STAGE(PG8_SA(1, 0), cA + kstep, voffA); PG8_STAGE(PG8_SB(1, 1), cB + hstepB + kstep, voffB);
    PG8_WAIT_V(6); PG8_BAR;
    PG8_STAMP();
    for (;;) {
        const bool has_next = S.next(ui + 1, nxt);
        const char* nA = has_next ? (const char*)g.A + (size_t)nxt.pm * tstepA + (size_t)nxt.ks * sstep : cA; const char* nB = has_next ? (const char*)g.Bt + (size_t)nxt.pn * tstepB + (size_t)nxt.ks * sstep : cB;
        for (int t = 0; t < nt; t += 2) {
            const bool last = (t == nt - 2);
            const char* a1 = cA + (size_t)(t + 1) * kstep;
            const char* a2 = last ? nA : cA + (size_t)(t + 2) * kstep; const char* b2 = last ? nB : cB + (size_t)(t + 2) * kstep;
            const char* a3 = a2 + kstep; const char* b3 = b2 + kstep;
            if (last && has_next) S.a_ready(nxt);
            PG8_LDB(B0, 0, 0); PG8_SCHED; PG8_LDA(At, 0, 0); PG8_STAGE(PG8_SA(1, 1), a1 + hstepA, voffA);
            PG8_WAIT_L(8); PG8_BAR; PG8_WAIT_L(0); PG8_MMA(0, 0, At, B0); PG8_BAR; PG8_SCHED;
            PG8_LDB(B1, 0, 1); PG8_STAGE(PG8_SB(0, 0), b2, voffB);
            PG8_BAR; PG8_WAIT_L(0); PG8_MMA(0, 1, At, B1); PG8_BAR;
            PG8_LDA(At, 0, 1); PG8_STAGE(PG8_SA(0, 0), a2, voffA);
            PG8_BAR; PG8_WAIT_L(0); PG8_MMA(1, 0, At, B0); PG8_BAR; PG8_SCHED;
            PG8_STAGE(PG8_SB(0, 1), b2 + hstepB, voffB);
            PG8_WAIT_V(6); PG8_BAR; PG8_MMA(1, 1, At, B1); PG8_BAR;
            PG8_LDB(B0, 1, 0); PG8_SCHED; PG8_LDA(At, 1, 0); PG8_STAGE(PG8_SA(0, 1), a2 + hstepA, voffA);
            PG8_WAIT_L(8); PG8_BAR; PG8_WAIT_L(0); PG8_MMA(0, 0, At, B0); PG8_BAR; PG8_SCHED;
            PG8_LDB(B1, 1, 1); PG8_STAGE(PG8_SB(1, 0), b3, voffB);
            PG8_BAR; PG8_WAIT_L(0); PG8_MMA(0, 1, At, B1); PG8_BAR;
            PG8_LDA(At, 1, 1); PG8_STAGE(PG8_SA(1, 0), a3, voffA);
            PG8_BAR; PG8_WAIT_L(0); PG8_MMA(1, 0, At, B0); PG8_BAR; PG8_SCHED;
            PG8_STAGE(PG8_SB(1, 1), b3 + hstepB, voffB);
            PG8_WAIT_V(6); PG8_BAR; PG8_MMA(1, 1, At, B1); PG8_BAR;
        }
        PG8_STAMP();
        if constexpr (!Epi::AFTER_DRAIN) { E(acc, cur, wr, wc, fr, fq); S.done(cur); }
        PG8_STAMP();
        if (!has_next) break;
#pragma unroll
        for (int a = 0; a < 2; ++a)
#pragma unroll
            for (int b = 0; b < 2; ++b)
#pragma unroll
                for (int m = 0; m < 4; ++m)
#pragma unroll
                    for (int n = 0; n < 2; ++n) acc[a][b][m][n] = (f32x4){0.f, 0.f, 0.f, 0.f};
        cur = nxt; cA = nA; cB = nB; ++ui;
    }
    PG8_WAIT_V(0);
    if (wr == 0) PG8_BAR;
    PG8_BAR;
    if constexpr (Epi::AFTER_DRAIN) { E.fused(acc, cur, wr, wc, fr, fq, lds, wid, lane); S.done(cur); }
    PG8_STAMP();
    if (STAMP && wid == 0) { stamps[lane] = lane < nts ? (((unsigned long long)(unsigned)ts_hi << 32) | (unsigned)ts_lo) : 0ull;
        if (lane == 62) stamps[62] = rt_entry; if (lane == 63) stamps[63] = (unsigned long long)wall_clock64(); }
#undef PG8_STAMP
#undef PG8_SA
#undef PG8_SB
#undef PG8_STAGE
#undef PG8_LDA
#undef PG8_LDB
#undef PG8_MMA
#undef PG8_WAIT_V
#undef PG8_WAIT_L
#undef PG8_BAR
#undef PG8_SCHED
}
}

#define LAS __attribute__((address_space(3)))
typedef unsigned short bf16_t;
typedef short bf16x8 __attribute__((ext_vector_type(8)));
typedef float f32x4 __attribute__((ext_vector_type(4)));
typedef float f32x2 __attribute__((ext_vector_type(2)));
typedef unsigned u32x4 __attribute__((ext_vector_type(4)));
typedef unsigned u32x2 __attribute__((ext_vector_type(2)));

constexpr int D = 1024, NP = 16384, NS = 512, NTOK = NP + NS, SEQ = 2048, NB = 8, NSB = 128, DEPTH = 4;
constexpr int INW = 2568, NPROJ = 2560, DFF = 2816, NGU = 5632;
constexpr int PC_G = 1536, PC_SSM = 2048, PC_POOL = 2304;
constexpr float EPS = 1e-6f;
constexpr int LDS_BYTES = 163840;

constexpr size_t SZ_WIN = (size_t)NPROJ * D * 2, SZ_WOUT = (size_t)D * D * 2, SZ_WGU = (size_t)NGU * D * 2, SZ_WDN = (size_t)D * DFF * 2;
constexpr size_t SZ_WAB = 8 * D * 4, SZ_GLUT = 256 * 256 * 2, SZ_POOLT = 4 * 64 * 64 * 2, SZ_SSMK = 16 * 64 * 4 * 4, SZ_BBAR = 16 * 64 * 32 * 4;
constexpr size_t WS_WIN = 0;
constexpr size_t WS_WOUT = WS_WIN + DEPTH * SZ_WIN;
constexpr size_t WS_WGU = WS_WOUT + DEPTH * SZ_WOUT;
constexpr size_t WS_WDN = WS_WGU + DEPTH * SZ_WGU;
constexpr size_t WS_WAB = WS_WDN + DEPTH * SZ_WDN;
constexpr size_t WS_GLUT = WS_WAB + DEPTH * SZ_WAB;
constexpr size_t WS_POOLT = WS_GLUT + DEPTH * SZ_GLUT;
constexpr size_t WS_SSMK = WS_POOLT + DEPTH * SZ_POOLT;
constexpr size_t WS_BBAR = WS_SSMK + DEPTH * SZ_SSMK;
constexpr size_t WS_H = WS_BBAR + DEPTH * SZ_BBAR;
constexpr size_t WS_AB = WS_H + (size_t)NTOK * D * 2;
constexpr size_t WS_MIX = WS_AB + (size_t)NTOK * 8 * 4;
constexpr size_t WS_MIXO = WS_MIX + (size_t)NTOK * D * 2;
constexpr size_t WS_SSME = WS_MIXO + (size_t)NTOK * D * 4;
constexpr size_t WS_PROJ = WS_SSME + (size_t)8 * 32 * 16 * 64 * 2 * 4;
constexpr size_t WS_DW = WS_PROJ + (size_t)NTOK * NPROJ * 2;
constexpr size_t WS_DKC = WS_DW + (size_t)1024 * 8192 * 4;
constexpr size_t WS_DQD = WS_DKC + (size_t)1024 * 8192 * 2;
constexpr size_t WS_DQK = WS_DQD + (size_t)1024 * 8192 * 2;
constexpr size_t WS_DKT = WS_DQK + (size_t)1024 * 4096 * 2;
constexpr size_t WS_DGL = WS_DKT + (size_t)1024 * 8192 * 2;
constexpr size_t WS_DGS = WS_DGL + 4096;
constexpr size_t WS_BAR = WS_DGS + (size_t)1024 * 8192 * 2;
constexpr size_t WS_PARTS = WS_BAR + 16384;
constexpr size_t WS_END = WS_PARTS + (size_t)11 * 512 * 1024 * 4;
constexpr size_t WS_HID = WS_PROJ;
static_assert(WS_HID + (size_t)NTOK * DFF * 2 <= WS_END, "HID overlay");
static_assert(WS_H % 256 == 0 && WS_PROJ % 256 == 0 && WS_DW % 256 == 0, "align");

constexpr size_t O_YP = 0, O_YS = O_YP + (size_t)NP * D, O_DP = O_YS + (size_t)NS * D, O_CP = O_DP + (size_t)DEPTH * 8 * 4 * 16384,
                 O_REP = O_CP + (size_t)DEPTH * 8 * 3 * 1536, O_IMP = O_REP + (size_t)DEPTH * 8 * 1024, O_PP = O_IMP + (size_t)DEPTH * 8 * 1024,
                 O_DS = O_PP + (size_t)DEPTH * 8 * 15 * 256, O_CS = O_DS + (size_t)DEPTH * 128 * 4 * 16384, O_RES = O_CS + (size_t)DEPTH * 128 * 3 * 1536,
                 O_IMS = O_RES + (size_t)DEPTH * 128 * 1024, O_PS = O_IMS + (size_t)DEPTH * 128 * 1024, O_END = O_PS + (size_t)DEPTH * 128 * 15 * 256;

struct Args { const float* in[32]; float* out; unsigned char* ws; int ph_lo, ph_hi; };
typedef const float* cfp_t;
typedef __attribute__((address_space(4))) const unsigned char* kptr_t;
struct InProxy { __device__ __forceinline__ const float* operator[](int i) const {
    kptr_t p = (kptr_t)__builtin_amdgcn_kernarg_segment_ptr(); asm volatile("" : "+s"(p)); return *(__attribute__((address_space(4))) const cfp_t*)(p + 8 * i); } };
struct DevArgs { InProxy in; float* out; unsigned char* ws; int ph_lo, ph_hi; };
enum { I_XP = 0, I_XS, I_SDELTA, I_SCONV, I_SRE, I_SIM, I_SPOOL, I_NMPRE, I_NMPOST, I_NFPRE, I_NFPOST, I_WIN, I_CONVW, I_ALOG, I_DTB, I_ONORM,
       I_ARE, I_AIM, I_LOGDT, I_BRE, I_BIM, I_CRE, I_CIM, I_SSMD, I_GLUW, I_GLUB, I_POOLW, I_POOLS, I_WOUT, I_WG, I_WU, I_WD };

__device__ __forceinline__ unsigned f2bf(float f) { unsigned u = __float_as_uint(f); return (u + 0x7fffu + ((u >> 16) & 1u)) >> 16; }
__device__ __forceinline__ float bf2f(unsigned b) { return __uint_as_float(b << 16); }
__device__ __forceinline__ unsigned pk2(float lo, float hi) { return f2bf(lo) | (f2bf(hi) << 16); }
template <int CTRL> __device__ __forceinline__ float dpp_f(float v) { return __builtin_bit_cast(float, __builtin_amdgcn_update_dpp(0, __builtin_bit_cast(int, v), CTRL, 0xF, 0xF, true)); }
__device__ __forceinline__ float row_sum8(float v) { v += dpp_f<0xB1>(v); v += dpp_f<0x4E>(v); v += dpp_f<0x141>(v); return v; }
__device__ __forceinline__ float row_sum16(float v) { v = row_sum8(v); v += dpp_f<0x140>(v); return v; }
__device__ __forceinline__ float wave_sum(float v) { v = row_sum16(v); v += __shfl_xor(v, 16); v += __shfl_xor(v, 32); return v; }
__device__ __forceinline__ float silu_f(float y) { return y / (1.f + __expf(-y)); }
__device__ __forceinline__ float sigmoid_f(float y) { return 1.f / (1.f + __expf(-y)); }
__device__ __forceinline__ float gelu_tanh_f(float x) { const float t = tanhf(0.7978845608028654f * (x + 0.044715f * x * x * x)); return 0.5f * x * (1.f + t); }
__device__ __forceinline__ f32x4 mfma16(bf16x8 a, bf16x8 b, f32x4 c) { return __builtin_amdgcn_mfma_f32_16x16x32_bf16(a, b, c, 0, 0, 0); }
#define LDS_FENCE() asm volatile("s_waitcnt lgkmcnt(0)" ::: "memory")

struct EpiSwiGLU {
    static constexpr bool PERM = false, AFTER_DRAIN = false;
    bf16_t* O; int ldc;
    __device__ __forceinline__ void operator()(const pg8::f32x4 (&acc)[2][2][4][2], const pg8::Unit& u, int wr, int wc, int fr, int fq) const {
        const int row0 = u.pm * 256 + wr * 64 + fr, hid0 = u.pn * 128 + wc * 16 + 4 * fq;
#pragma unroll
        for (int ai = 0; ai < 2; ++ai)
#pragma unroll
            for (int m = 0; m < 4; ++m) { bf16_t* rowp = O + (size_t)(row0 + ai * 128 + m * 16) * ldc + hid0;
#pragma unroll
                for (int bj = 0; bj < 2; ++bj) { const pg8::f32x4 g = acc[ai][bj][m][0], v = acc[ai][bj][m][1];
                    u32x2 w; w.x = pg8::cvt_pk_bf16(silu_f(g[0]) * v[0], silu_f(g[1]) * v[1]); w.y = pg8::cvt_pk_bf16(silu_f(g[2]) * v[2], silu_f(g[3]) * v[3]);
                    *(u32x2*)(rowp + bj * 64) = w; } }
    }
};

#define XB_TMO      128
#define XB_XCNT(j)  (256  + 64 * (j))
#define XB_XSUB(j)  (1280 + 64 * (j))
#define XB_XGEN(j)  (2304 + 64 * (j))
#define XB_TOP      3328
#define XB_TOPGEN   3392
#define XCD_BAR_WORDS 3456
#define XB_SPIN_CAP (1u << 18)

__device__ __forceinline__ unsigned xb_ld(unsigned* p)              { return __hip_atomic_load(p, __ATOMIC_RELAXED, __HIP_MEMORY_SCOPE_AGENT); }
__device__ __forceinline__ unsigned xb_add(unsigned* p, unsigned v) { return __hip_atomic_fetch_add(p, v, __ATOMIC_RELAXED, __HIP_MEMORY_SCOPE_AGENT); }
__device__ __forceinline__ unsigned xb_xcc_id() { return (unsigned)__builtin_amdgcn_s_getreg((3 << 11) | 20) & 0xFu; }
#define XB_SPIN(cond, bar) do { unsigned _sp = 0; while (cond) { __builtin_amdgcn_s_sleep(1); \
    if ((++_sp & 255u) == 0u) { if (xb_ld(&(bar)[XB_TMO])) break; if (_sp > XB_SPIN_CAP) { atomicAdd(&(bar)[XB_TMO], 1u); break; } } } } while (0)

struct XcdBarrier {
    unsigned* bar; unsigned x;
    volatile LAS unsigned* st;
};

__device__ __forceinline__ XcdBarrier xcd_barrier_post(unsigned* bar, volatile LAS unsigned* st) {
    XcdBarrier b; b.bar = bar; b.x = xb_xcc_id(); b.st = st;
    if (threadIdx.x == 0) (void)xb_add(&bar[XB_XCNT(b.x)], 1u);
    return b;
}
__device__ __forceinline__ void xcd_barrier_complete(unsigned* bar, unsigned x, unsigned& nloc, unsigned& nx) {
    const unsigned G = gridDim.x * gridDim.y * gridDim.z;
    unsigned sum, cnt, mine, sp = 0u;
    for (;;) {
        sum = 0u; cnt = 0u; mine = 0u;
#pragma unroll
        for (unsigned j = 0; j < 16; ++j) { const unsigned c = xb_ld(&bar[XB_XCNT(j)]); sum += c; cnt += (c > 0u) ? 1u : 0u; mine = (j == x) ? c : mine; }
        if (sum == G) break;
        __builtin_amdgcn_s_sleep(1);
        if ((++sp & 255u) == 0u) { if (xb_ld(&bar[XB_TMO])) break; if (sp > XB_SPIN_CAP) { atomicAdd(&bar[XB_TMO], 1u); break; } }
    }
    nloc = mine > 0u ? mine : 1u; nx = cnt > 0u ? cnt : 1u;
}

__device__ __forceinline__ void xcd_barrier(const XcdBarrier& b) {
    asm volatile("s_waitcnt vmcnt(0)" ::: "memory");
    __syncthreads();
    if (threadIdx.x == 0) {
        unsigned* bar = b.bar; asm volatile("" : "+s"(bar));
        __builtin_amdgcn_s_waitcnt(0);
        unsigned nloc = b.st[0], nx = b.st[1];
        if (nloc == 0u) { xcd_barrier_complete(bar, b.x, nloc, nx); b.st[0] = nloc; b.st[1] = nx; }
        const unsigned old = xb_add(&bar[XB_XSUB(b.x)], 1u);
        const unsigned gen = old / nloc;
        if (old + 1u == (gen + 1u) * nloc) {
            __builtin_amdgcn_fence(__ATOMIC_RELEASE, "agent");
            asm volatile("s_waitcnt vmcnt(0)" ::: "memory");
            const unsigned og = xb_add(&bar[XB_TOP], 1u);
            const unsigned tg = og / nx;
            if (og + 1u == (tg + 1u) * nx) xb_add(&bar[XB_TOPGEN], 1u);
            else XB_SPIN(xb_ld(&bar[XB_TOPGEN]) == tg, bar);
            __builtin_amdgcn_fence(__ATOMIC_ACQUIRE, "agent");
            xb_add(&bar[XB_XGEN(b.x)], 1u);
            asm volatile("s_waitcnt vmcnt(0)" ::: "memory");
        } else {
            XB_SPIN(xb_ld(&bar[XB_XGEN(b.x)]) == gen, bar);
            __builtin_amdgcn_fence(__ATOMIC_ACQUIRE, "agent");
            asm volatile("s_waitcnt vmcnt(0)" ::: "memory");
        }
    }
    __syncthreads();
}

struct SliceOrder {
    int nunits, G, c;
    __device__ __forceinline__ bool next(int i, pg8::Unit& u) const { const int L = i * G + c; if (L >= nunits) return false; const int t = L & 7; u.pm = t >> 2; u.pn = t & 3; u.ks = L >> 3; return true; }
    __device__ __forceinline__ void a_ready(const pg8::Unit&) const {}
    __device__ __forceinline__ void done(const pg8::Unit&) const {}
};
struct EpiF32Part {
    static constexpr bool PERM = false, AFTER_DRAIN = false;
    float* C;
    __device__ __forceinline__ void operator()(const pg8::f32x4 (&acc)[2][2][4][2], const pg8::Unit& u, int wr, int wc, int fr, int fq) const {
        const int row0 = u.pm * 256 + wr * 64 + fr, col0 = u.pn * 256 + wc * 32 + 4 * fq; float* base = C + (size_t)u.ks * (512 * 1024);
#pragma unroll
        for (int ai = 0; ai < 2; ++ai)
#pragma unroll
            for (int m = 0; m < 4; ++m) { float* rowp = base + (size_t)(row0 + ai * 128 + m * 16) * 1024 + col0;
#pragma unroll
                for (int bj = 0; bj < 2; ++bj)
#pragma unroll
                    for (int n = 0; n < 2; ++n) *(pg8::f32x4*)(rowp + bj * 128 + n * 16) = acc[ai][bj][m][n]; }
    }
};

struct SrcIn { const float* w; __device__ __forceinline__ float operator()(int k, int n) const { return w[(size_t)k * INW + (n < 1536 ? n : n + 8)]; } };
struct SrcPlain { const float* w; int N; __device__ __forceinline__ float operator()(int k, int n) const { return w[(size_t)k * N + n]; } };
struct SrcGU { const float* g; const float* u; __device__ __forceinline__ float operator()(int k, int n) const { const int r = n & 31, hid = (n >> 5) * 16 + (r & 15); const long long du = (r < 16) ? 0ll : (long long)(u - g); return g[du + (long long)k * DFF + hid]; } };
template <class Src> __device__ __forceinline__ void transpose_item(const Src& src, int K, bf16_t* WT, int nblk, LAS float* scr, int item, int lane) {
    const int kb = item / nblk, nb = item % nblk, k0 = 64 * kb, n0 = 32 * nb;
#pragma unroll 8
    for (int i = 0; i < 32; ++i) { const int kk = 2 * i + (lane >> 5); scr[kk * 33 + (lane & 31)] = src(k0 + kk, n0 + (lane & 31)); }
    LDS_FENCE();
    const int c = lane & 7;
#pragma unroll
    for (int j = 0; j < 4; ++j) { const int n = (lane >> 3) + 8 * j; const LAS float* s = scr + (8 * c) * 33 + n;
        u32x4 o; o.x = pk2(s[0 * 33], s[1 * 33]); o.y = pk2(s[2 * 33], s[3 * 33]); o.z = pk2(s[4 * 33], s[5 * 33]); o.w = pk2(s[6 * 33], s[7 * 33]);
        *(u32x4*)(WT + (size_t)(n0 + n) * K + k0 + 8 * c) = o; }
    LDS_FENCE();
}

__device__ __forceinline__ void norm_rows(const float* T, const float* wt, const float* X0, const float* X1, float* Xout, const float* wh, bf16_t* H,
                                          const float* Wab, float* AB, int gw, int NGW, int lane, const float* Tp = nullptr, int ns = 0) {
#pragma unroll 1
    for (int m = gw; m < NTOK; m += NGW) {
        f32x4 x[4], t[4];
        { const float* xr = (X1 && m >= NP) ? X1 + (size_t)(m - NP) * D : X0 + (size_t)m * D;
#pragma unroll
          for (int j = 0; j < 4; ++j) x[j] = ((const f32x4*)xr)[lane + 64 * j];
          if (T && !(Tp && m >= NP)) {
#pragma unroll
              for (int j = 0; j < 4; ++j) { const u32x2 tb = ((const u32x2*)((const bf16_t*)T + (size_t)m * D))[lane + 64 * j];
                  t[j] = (f32x4){__uint_as_float(tb.x << 16), __uint_as_float(tb.x & 0xffff0000u), __uint_as_float(tb.y << 16), __uint_as_float(tb.y & 0xffff0000u)}; } } }
        if (T) {
            float ss = 0.f;
            if (Tp && m >= NP) {
#pragma unroll
                for (int j = 0; j < 4; ++j) { f32x4 a = {0.f, 0.f, 0.f, 0.f}; for (int q = 0; q < ns; ++q) a += ((const f32x4*)(Tp + (size_t)q * (512 * 1024) + (size_t)(m - NP) * D))[lane + 64 * j]; t[j] = a; } }
#pragma unroll
            for (int j = 0; j < 4; ++j) ss += (t[j].x * t[j].x + t[j].y * t[j].y) + (t[j].z * t[j].z + t[j].w * t[j].w);
            ss = wave_sum(ss); const float r = rsqrtf(ss * (1.f / D) + EPS);
#pragma unroll
            for (int j = 0; j < 4; ++j) { const f32x4 w = ((const f32x4*)wt)[lane + 64 * j]; x[j] += t[j] * r * w; }
        }
        if (Xout) {
#pragma unroll
            for (int j = 0; j < 4; ++j) ((f32x4*)(Xout + (size_t)m * D))[lane + 64 * j] = x[j];
        }
        if (H) {
            float ss = 0.f;
#pragma unroll
            for (int j = 0; j < 4; ++j) ss += (x[j].x * x[j].x + x[j].y * x[j].y) + (x[j].z * x[j].z + x[j].w * x[j].w);
            ss = wave_sum(ss); const float r = rsqrtf(ss * (1.f / D) + EPS);
            f32x4 hv[4];
#pragma unroll
            for (int j = 0; j < 4; ++j) { const f32x4 w = ((const f32x4*)wh)[lane + 64 * j]; hv[j] = x[j] * r * w;
                u32x2 o; o.x = pk2(hv[j].x, hv[j].y); o.y = pk2(hv[j].z, hv[j].w); ((u32x2*)(H + (size_t)m * D))[lane + 64 * j] = o; }
            if (Wab) {
                float d[8];
#pragma unroll
                for (int c = 0; c < 8; ++c) { float dd = 0.f;
#pragma unroll
                    for (int j = 0; j < 4; ++j) { const f32x4 w = ((const f32x4*)(Wab + c * D))[lane + 64 * j]; dd += (hv[j].x * w.x + hv[j].y * w.y) + (hv[j].z * w.z + hv[j].w * w.w); }
                    d[c] = dd; }
#pragma unroll
                for (int c = 0; c < 8; ++c) d[c] = row_sum16(d[c]);
#pragma unroll
                for (int o = 16; o < 64; o <<= 1) {
#pragma unroll
                    for (int c = 0; c < 8; ++c) d[c] += __shfl_xor(d[c], o); }
                if (lane == 0) { f32x4 o0 = {d[0], d[1], d[2], d[3]}, o1 = {d[4], d[5], d[6], d[7]}; *(f32x4*)(AB + (size_t)m * 8) = o0; *(f32x4*)(AB + (size_t)m * 8 + 4) = o1; }
            }
        }
    }
}

__device__ __forceinline__ void norm_rows_pf(const float* T, const float* wt, const float* X0, const float* X1, float* Xout, const float* wh, bf16_t* H,
                                             int gw, int NGW, int lane, const float* Tp, int ns) {
    f32x4 xn[4]; u32x2 tn[4];
#define NR_LOAD(mm) do { const int _m = (mm); const float* _xr = (X1 && _m >= NP) ? X1 + (size_t)(_m - NP) * D : X0 + (size_t)_m * D; \
        _Pragma("unroll") for (int j = 0; j < 4; ++j) xn[j] = ((const f32x4*)_xr)[lane + 64 * j]; \
        if (_m < NP) { _Pragma("unroll") for (int j = 0; j < 4; ++j) tn[j] = ((const u32x2*)((const bf16_t*)T + (size_t)_m * D))[lane + 64 * j]; } } while (0)
    if (gw < NTOK) NR_LOAD(gw);
#pragma unroll 1
    for (int m = gw; m < NTOK; m += NGW) {
        f32x4 x[4], t[4];
#pragma unroll
        for (int j = 0; j < 4; ++j) { x[j] = xn[j]; t[j] = (f32x4){__uint_as_float(tn[j].x << 16), __uint_as_float(tn[j].x & 0xffff0000u), __uint_as_float(tn[j].y << 16), __uint_as_float(tn[j].y & 0xffff0000u)}; }
        if (m + NGW < NTOK) NR_LOAD(m + NGW);
        if (m >= NP) {
#pragma unroll
            for (int j = 0; j < 4; ++j) { f32x4 a = {0.f, 0.f, 0.f, 0.f}; for (int q = 0; q < ns; ++q) a += ((const f32x4*)(Tp + (size_t)q * (512 * 1024) + (size_t)(m - NP) * D))[lane + 64 * j]; t[j] = a; } }
        float ss = 0.f;
#pragma unroll
        for (int j = 0; j < 4; ++j) ss += (t[j].x * t[j].x + t[j].y * t[j].y) + (t[j].z * t[j].z + t[j].w * t[j].w);
        ss = wave_sum(ss); const float r = rsqrtf(ss * (1.f / D) + EPS);
#pragma unroll
        for (int j = 0; j < 4; ++j) { const f32x4 w = ((const f32x4*)wt)[lane + 64 * j]; x[j] += t[j] * r * w; }
#pragma unroll
        for (int j = 0; j < 4; ++j) ((f32x4*)(Xout + (size_t)m * D))[lane + 64 * j] = x[j];
        float s2 = 0.f;
#pragma unroll
        for (int j = 0; j < 4; ++j) s2 += (x[j].x * x[j].x + x[j].y * x[j].y) + (x[j].z * x[j].z + x[j].w * x[j].w);
        s2 = wave_sum(s2); const float r2 = rsqrtf(s2 * (1.f / D) + EPS);
#pragma unroll
        for (int j = 0; j < 4; ++j) { const f32x4 w = ((const f32x4*)wh)[lane + 64 * j]; const f32x4 hv = x[j] * r2 * w;
            u32x2 o; o.x = pk2(hv.x, hv.y); o.y = pk2(hv.z, hv.w); ((u32x2*)(H + (size_t)m * D))[lane + 64 * j] = o; }
    }
#undef NR_LOAD
}

__device__ __forceinline__ void prologue(const DevArgs& A, LAS unsigned char* lds, int wave, int lane, int gw, int NGW) {
    LAS float* scr = (LAS float*)(lds + wave * 8704);
    constexpr int I_IN = 16 * 80, I_OUT = 16 * 32, I_GU = 16 * 176, I_DN = 44 * 32, I_GLU = 4 * 8, I_POOL = 8, PER = I_IN + I_OUT + I_GU + I_DN + I_GLU + I_POOL;
#pragma unroll 1
    for (int it = gw; it < DEPTH * PER; it += NGW) {
        const int l = it / PER; int r = it % PER;
        if (r < I_IN) { SrcIn s{A.in[I_WIN] + (size_t)l * D * INW}; transpose_item(s, D, (bf16_t*)(A.ws + WS_WIN + l * SZ_WIN), NPROJ / 32, scr, r, lane); continue; } r -= I_IN;
        if (r < I_OUT) { SrcPlain s{A.in[I_WOUT] + (size_t)l * D * D, D}; transpose_item(s, D, (bf16_t*)(A.ws + WS_WOUT + l * SZ_WOUT), D / 32, scr, r, lane); continue; } r -= I_OUT;
        if (r < I_GU) { SrcGU s{A.in[I_WG] + (size_t)l * D * DFF, A.in[I_WU] + (size_t)l * D * DFF}; transpose_item(s, D, (bf16_t*)(A.ws + WS_WGU + l * SZ_WGU), NGU / 32, scr, r, lane); continue; } r -= I_GU;
        if (r < I_DN) { SrcPlain s{A.in[I_WD] + (size_t)l * DFF * D, D}; transpose_item(s, DFF, (bf16_t*)(A.ws + WS_WDN + l * SZ_WDN), D / 32, scr, r, lane); continue; } r -= I_DN;
        if (r < I_GLU) { SrcPlain s{A.in[I_GLUW] + (size_t)l * 65536, 256}; transpose_item(s, 256, (bf16_t*)(A.ws + WS_GLUT + l * SZ_GLUT), 8, scr, r, lane); continue; } r -= I_GLU;
        { const int g = r >> 1; SrcPlain s{A.in[I_POOLW] + (size_t)(l * 4 + g) * 4096, 64}; transpose_item(s, 64, (bf16_t*)(A.ws + WS_POOLT + l * SZ_POOLT) + g * 4096, 2, scr, r & 1, lane); }
    }
    const int gt = gw * 64 + lane, NT = NGW * 64;
    float* wab = (float*)(A.ws + WS_WAB);
#pragma unroll 1
    for (int i = gt; i < DEPTH * 8 * D; i += NT) { const int l = i / (8 * D), j = (i / D) & 7, k = i % D; wab[i] = A.in[I_WIN][((size_t)l * D + k) * INW + 1536 + j]; }
    float* ssmk = (float*)(A.ws + WS_SSMK); float* bbar = (float*)(A.ws + WS_BBAR);
#pragma unroll 1
    for (int i = gt; i < DEPTH * 16 * 64; i += NT) {
        const int lg = i >> 6;
        const float dt = expf(A.in[I_LOGDT][lg]), ar = A.in[I_ARE][i], ai = A.in[I_AIM][i];
        const float mag = expf(ar * dt);
        float rev = ai * dt * 0.15915494309189535f; rev -= floorf(rev);
        const float sn = __builtin_amdgcn_sinf(rev), cs = __builtin_amdgcn_cosf(rev);
        const float lr = mag * cs, li = mag * sn;
        float pr = lr, pi = li;
#pragma unroll
        for (int q = 0; q < 6; ++q) { const float nr2 = pr * pr - pi * pi, ni2 = 2.f * pr * pi; pr = nr2; pi = ni2; }
        ssmk[i * 4 + 0] = lr; ssmk[i * 4 + 1] = li; ssmk[i * 4 + 2] = pr; ssmk[i * 4 + 3] = pi;
        const float nr = lr - 1.f, ni = li, d2 = ar * ar + ai * ai;
        const float cre = (nr * ar + ni * ai) / d2, cim = (ni * ar - nr * ai) / d2;
#pragma unroll
        for (int h = 0; h < 16; ++h) { const float br = A.in[I_BRE][(size_t)i * 16 + h], bi = A.in[I_BIM][(size_t)i * 16 + h];
            bbar[(size_t)i * 32 + h] = cre * br - cim * bi; bbar[(size_t)i * 32 + 16 + h] = cre * bi + cim * br; }
    }
}

__device__ __forceinline__ unsigned bfmul2(unsigned pk, float f0, float f1) { return pg8::cvt_pk_bf16(__uint_as_float(pk << 16) * f0, __uint_as_float(pk & 0xffff0000u) * f1); }
__device__ __forceinline__ void delta_prep_item(const DevArgs& A, int l, LAS unsigned char* lds, int item, int tid, int wave, int lane) {
    asm volatile("" : "+v"(tid)); lane = tid & 63; wave = __builtin_amdgcn_readfirstlane(tid >> 6);
    const int bh = item >> 5, n = item & 31, b = bh >> 2, h = bh & 3;
    const int tok0 = b * SEQ + n * 64;
    LAS bf16_t* QS = (LAS bf16_t*)(lds); LAS bf16_t* KS = (LAS bf16_t*)(lds + 17408);
    LAS unsigned char* KT = lds + 34816; LAS unsigned char* VT = lds + 53248; LAS unsigned char* RTK = lds + 71680;
    LAS float* AM = (LAS float*)(lds + 90112); LAS float* PM = (LAS float*)(lds + 107520); LAS float* PSC = PM; LAS float* TM = (LAS float*)(lds + 124928);
    LAS unsigned char* TB = lds + 142336;
    LAS float* GAM = (LAS float*)(lds + 151552); LAS float* BETA = GAM + 64; LAS float* RQ = GAM + 128; LAS float* RK = GAM + 192;
    LAS float* F2 = GAM + 256; LAS float* F3 = GAM + 320; LAS float* F4 = GAM + 384;
    const bf16_t* PROJ = (const bf16_t*)(A.ws + WS_PROJ);
    const float* AB = (const float*)(A.ws + WS_AB);
    u32x4 gv[2];
#pragma unroll
    for (int j = 0; j < 2; ++j) { const int id = tid + 512 * j; gv[j] = *(const u32x4*)(PROJ + (size_t)(tok0 + (id >> 4)) * NPROJ + PC_G + h * 128 + (id & 15) * 8); }
    if (tid < 384) {
        const int part = tid >> 7, c = tid & 127, col = part * 512 + h * 128 + c;
        const float* cw = A.in[I_CONVW] + (size_t)l * 4 * 1536;
        const float w0 = cw[col], w1 = cw[1536 + col], w2 = cw[3072 + col], w3 = cw[4608 + col];
        const bf16_t* pp = PROJ + (size_t)tok0 * NPROJ + col;
        float xr[67];
#pragma unroll
        for (int t = 0; t < 67; ++t) xr[t] = (n > 0 || t >= 3) ? bf2f(pp[(long)(t - 3) * NPROJ]) : 0.f;
        unsigned pk[32];
#pragma unroll
        for (int t = 0; t < 64; t += 2) {
            const float s0 = silu_f(w0 * xr[t] + w1 * xr[t + 1] + w2 * xr[t + 2] + w3 * xr[t + 3]);
            const float s1 = silu_f(w0 * xr[t + 1] + w1 * xr[t + 2] + w2 * xr[t + 3] + w3 * xr[t + 4]);
            pk[t >> 1] = pg8::cvt_pk_bf16(s0, s1);
        }
        if (part < 2) { LAS bf16_t* dst = (part == 0 ? QS : KS) + c;
#pragma unroll
            for (int t = 0; t < 64; t += 2) { dst[t * 136] = (bf16_t)(pk[t >> 1] & 0xffffu); dst[(t + 1) * 136] = (bf16_t)(pk[t >> 1] >> 16); } }
        if (part > 0) { LAS unsigned char* dst = (part == 1 ? KT : VT) + c * 144;
#pragma unroll
            for (int q = 0; q < 8; ++q) { u32x4 o; o.x = pk[4 * q]; o.y = pk[4 * q + 1]; o.z = pk[4 * q + 2]; o.w = pk[4 * q + 3]; *(LAS u32x4*)(dst + q * 16) = o; } }
    } else if (tid < 448) {
        const int t = tid - 384;
        const float a = AB[(size_t)(tok0 + t) * 8 + h], bb = AB[(size_t)(tok0 + t) * 8 + 4 + h];
        const float xx = a + A.in[I_DTB][l * 4 + h];
        const float sp = xx > 20.f ? xx : log1pf(expf(xx));
        float lg = -expf(A.in[I_ALOG][l * 4 + h]) * sp;
#pragma unroll
        for (int off = 1; off < 64; off <<= 1) { const float v = __shfl_up(lg, off); if (lane >= off) lg += v; }
        GAM[t] = lg; BETA[t] = 1.f / (1.f + expf(-bb));
    }
    __syncthreads();
    {
        const int t = tid >> 3, part = tid & 7; float sq = 0.f, sk = 0.f;
#pragma unroll
        for (int j = 0; j < 16; ++j) { const float q = bf2f(QS[t * 136 + part * 16 + j]), k = bf2f(KS[t * 136 + part * 16 + j]); sq += q * q; sk += k * k; }
        sq = row_sum8(sq); sk = row_sum8(sk);
        if (part == 0) { const float rq = rsqrtf(sq + EPS) * 0.08838834764831845f, rk = rsqrtf(sk + EPS), g = GAM[t], eg = __expf(g), bt = BETA[t];
            RQ[t] = rq; RK[t] = rk; F2[t] = bt * eg * rk; F3[t] = rk * __expf(GAM[63] - g); F4[t] = rq * eg; }
    }
    {
        const int prod = wave >> 2, mt = wave & 3, fr = lane & 15, quad = lane >> 4;
        LAS bf16_t* Aop = prod ? QS : KS; LAS float* dst = prod ? PM : AM;
        bf16x8 a[4];
#pragma unroll
        for (int kk = 0; kk < 4; ++kk) a[kk] = *(LAS bf16x8*)(Aop + (mt * 16 + fr) * 136 + kk * 32 + quad * 8);
#pragma unroll
        for (int nt = 0; nt < 4; ++nt) { f32x4 acc = {0.f, 0.f, 0.f, 0.f};
#pragma unroll
            for (int kk = 0; kk < 4; ++kk) { const bf16x8 bq = *(LAS bf16x8*)(KS + (nt * 16 + fr) * 136 + kk * 32 + quad * 8); acc = mfma16(a[kk], bq, acc); }
#pragma unroll
            for (int i = 0; i < 4; ++i) dst[(mt * 16 + quad * 4 + i) * 68 + nt * 16 + fr] = acc[i]; }
    }
    __syncthreads();
    {
        const int t = tid >> 3, s8 = (tid & 7) * 8; const float gt = GAM[t], bk = BETA[t] * RK[t], rqt = RQ[t];
        float av[8], pv[8];
#pragma unroll
        for (int j = 0; j < 8; ++j) { const int s = s8 + j; const float rks = RK[s]; const float dec = (s <= t) ? __expf(gt - GAM[s]) * rks : 0.f;
            av[j] = (s < t) ? bk * dec * AM[t * 68 + s] : 0.f; pv[j] = rqt * dec * PM[t * 68 + s]; }
#pragma unroll
        for (int j = 0; j < 8; ++j) AM[t * 68 + s8 + j] = av[j];
        u32x4 o; o.x = pg8::cvt_pk_bf16(pv[0], pv[1]); o.y = pg8::cvt_pk_bf16(pv[2], pv[3]); o.z = pg8::cvt_pk_bf16(pv[4], pv[5]); o.w = pg8::cvt_pk_bf16(pv[6], pv[7]);
        *(u32x4*)((bf16_t*)(A.ws + WS_DQK) + (size_t)item * 4096 + t * 64 + s8) = o;
        for (int e = tid; e < 64 * 68; e += 512) TM[e] = 0.f;
        if (tid == 0) ((float*)(A.ws + WS_DGL))[item] = __expf(GAM[63]);
    }
    __syncthreads();
    if (wave == 0) {
        const int i = lane >> 4, c = lane & 15;
        LAS float* amp = AM + (16 * i) * 68 + 16 * i; asm volatile("" : "+v"(amp));
        float x[16];
#pragma unroll
        for (int r = 0; r < 16; ++r) { float acc = (r == c) ? 1.f : 0.f;
#pragma unroll
            for (int s = 0; s < r; ++s) acc = fmaf(-amp[r * 68 + s], x[s], acc);
            x[r] = acc; }
        LAS float* tmp = TM + (16 * i) * 68 + 16 * i + c;
#pragma unroll
        for (int r = 0; r < 16; ++r) tmp[r * 68] = x[r];
    } else {
        const int wt = tid - 64;
        for (int id = wt; id < 1024; id += 448) {
            const int c = id >> 3, t8 = (id & 7) * 8;
            const f32x4 b0 = *(LAS f32x4*)(BETA + t8), b1 = *(LAS f32x4*)(BETA + t8 + 4);
            u32x4 v = *(LAS u32x4*)(VT + c * 144 + t8 * 2);
            v.x = bfmul2(v.x, b0[0], b0[1]); v.y = bfmul2(v.y, b0[2], b0[3]); v.z = bfmul2(v.z, b1[0], b1[1]); v.w = bfmul2(v.w, b1[2], b1[3]);
            *(LAS u32x4*)(VT + c * 144 + t8 * 2) = v;
            const f32x4 f20 = *(LAS f32x4*)(F2 + t8), f21 = *(LAS f32x4*)(F2 + t8 + 4), f30 = *(LAS f32x4*)(F3 + t8), f31 = *(LAS f32x4*)(F3 + t8 + 4);
            const u32x4 k = *(LAS u32x4*)(KT + c * 144 + t8 * 2);
            u32x4 rk; rk.x = bfmul2(k.x, f20[0], f20[1]); rk.y = bfmul2(k.y, f20[2], f20[3]); rk.z = bfmul2(k.z, f21[0], f21[1]); rk.w = bfmul2(k.w, f21[2], f21[3]);
            *(LAS u32x4*)(RTK + c * 144 + t8 * 2) = rk;
            u32x4 kd; kd.x = bfmul2(k.x, f30[0], f30[1]); kd.y = bfmul2(k.y, f30[2], f30[3]); kd.z = bfmul2(k.z, f31[0], f31[1]); kd.w = bfmul2(k.w, f31[2], f31[3]);
            *(u32x4*)((bf16_t*)(A.ws + WS_DKT) + (size_t)item * 8192 + c * 64 + t8) = kd; }
        for (int id = wt; id < 1024; id += 448) {
            const int t = id >> 4, c8 = (id & 15) * 8; const float f = F4[t];
            u32x4 q = *(LAS u32x4*)((LAS unsigned char*)QS + t * 272 + c8 * 2);
            q.x = bfmul2(q.x, f, f); q.y = bfmul2(q.y, f, f); q.z = bfmul2(q.z, f, f); q.w = bfmul2(q.w, f, f);
            *(u32x4*)((bf16_t*)(A.ws + WS_DQD) + (size_t)item * 8192 + t * 128 + c8) = q; }
    }
    {
        const int c8 = (tid & 15) * 8; const float* on = A.in[I_ONORM] + l * 128 + c8;
        const f32x4 o0 = *(const f32x4*)on, o1 = *(const f32x4*)(on + 4);
#pragma unroll
        for (int j = 0; j < 2; ++j) { const int id = tid + 512 * j; const u32x4 g = gv[j]; u32x4 o;
            o.x = pg8::cvt_pk_bf16(silu_f(__uint_as_float(g.x << 16)) * o0[0], silu_f(__uint_as_float(g.x & 0xffff0000u)) * o0[1]);
            o.y = pg8::cvt_pk_bf16(silu_f(__uint_as_float(g.y << 16)) * o0[2], silu_f(__uint_as_float(g.y & 0xffff0000u)) * o0[3]);
            o.z = pg8::cvt_pk_bf16(silu_f(__uint_as_float(g.z << 16)) * o1[0], silu_f(__uint_as_float(g.z & 0xffff0000u)) * o1[1]);
            o.w = pg8::cvt_pk_bf16(silu_f(__uint_as_float(g.w << 16)) * o1[2], silu_f(__uint_as_float(g.w & 0xffff0000u)) * o1[3]);
            *(u32x4*)((bf16_t*)(A.ws + WS_DGS) + (size_t)item * 8192 + (id >> 4) * 128 + c8) = o; }
    }
    __syncthreads();
    const int p2 = tid >> 8, r2 = (tid >> 4) & 15, c2 = tid & 15, rb = p2 ? 48 : 16, cb = p2 ? 32 : 0;
    {
        float acc = 0.f;
#pragma unroll
        for (int s = 0; s < 16; ++s) acc = fmaf(AM[(rb + r2) * 68 + cb + s], TM[(cb + s) * 68 + cb + c2], acc);
        PSC[(p2 * 16 + r2) * 68 + c2] = acc; }
    __syncthreads();
    {
        float acc = 0.f;
#pragma unroll
        for (int s = 0; s < 16; ++s) acc = fmaf(TM[(rb + r2) * 68 + rb + s], PSC[(p2 * 16 + s) * 68 + c2], acc);
        TM[(rb + r2) * 68 + cb + c2] = -acc; }
    __syncthreads();
    float p3[2];
#pragma unroll
    for (int j = 0; j < 2; ++j) { const int e = tid + 512 * j, r = e >> 5, c = e & 31; float acc = 0.f;
#pragma unroll 8
        for (int s = 0; s < 32; ++s) acc = fmaf(AM[(32 + r) * 68 + s], TM[s * 68 + c], acc);
        p3[j] = acc; }
    __syncthreads();
#pragma unroll
    for (int j = 0; j < 2; ++j) { const int e = tid + 512 * j; PSC[(e >> 5) * 68 + (e & 31)] = p3[j]; }
    __syncthreads();
#pragma unroll
    for (int j = 0; j < 2; ++j) { const int e = tid + 512 * j, r = e >> 5, c = e & 31; float acc = 0.f;
#pragma unroll 8
        for (int s = 0; s < 32; ++s) acc = fmaf(TM[(32 + r) * 68 + 32 + s], PSC[s * 68 + c], acc);
        p3[j] = -acc; }
#pragma unroll
    for (int j = 0; j < 2; ++j) { const int e = tid + 512 * j; TM[(32 + (e >> 5)) * 68 + (e & 31)] = p3[j]; }
    __syncthreads();
#pragma unroll
    for (int j = 0; j < 4; ++j) { const int e = tid + 512 * j, t = e >> 5, s2 = (e & 31) * 2;
        *(LAS unsigned*)(TB + t * 144 + s2 * 2) = pg8::cvt_pk_bf16(TM[t * 68 + s2], TM[t * 68 + s2 + 1]); }
    __syncthreads();
    {
        const int fr = lane & 15, quad = lane >> 4;
        bf16x8 bv[2], ak[2];
#pragma unroll
        for (int kk = 0; kk < 2; ++kk) { bv[kk] = *(LAS bf16x8*)(VT + (16 * wave + fr) * 144 + (kk * 32 + quad * 8) * 2); ak[kk] = *(LAS bf16x8*)(RTK + (16 * wave + fr) * 144 + (kk * 32 + quad * 8) * 2); }
        bf16_t* DW = (bf16_t*)(A.ws + WS_DW) + (size_t)item * 8192; bf16_t* DKC = (bf16_t*)(A.ws + WS_DKC) + (size_t)item * 8192;
#pragma unroll
        for (int mt = 0; mt < 4; ++mt) { f32x4 aw = {0.f, 0.f, 0.f, 0.f}, akc = {0.f, 0.f, 0.f, 0.f};
#pragma unroll
            for (int kk = 0; kk < 2; ++kk) { const bf16x8 tf = *(LAS bf16x8*)(TB + (mt * 16 + fr) * 144 + (kk * 32 + quad * 8) * 2);
                aw = mfma16(tf, bv[kk], aw);
                akc = mfma16(ak[kk], tf, akc); }
            u32x2 ow; ow.x = pk2(aw[0], aw[1]); ow.y = pk2(aw[2], aw[3]);
            *(u32x2*)(DW + (16 * wave + fr) * 64 + mt * 16 + quad * 4) = ow;
            u32x2 ok; ok.x = pk2(-akc[0], -akc[1]); ok.y = pk2(-akc[2], -akc[3]);
            *(u32x2*)(DKC + (mt * 16 + fr) * 128 + 16 * wave + quad * 4) = ok; }
    }
    __syncthreads();
}

__device__ __forceinline__ void delta_scan_item(const DevArgs& A, int l, LAS unsigned char* lds, int bh, int tid_in, int wave, int lane_in, const XcdBarrier& xb, int SUB) {
    const int b = bh >> 2, h = bh & 3;
    LAS unsigned char* KCs = lds; LAS unsigned char* QDs = lds + 17408; LAS unsigned char* QKs = lds + 34816; LAS unsigned char* KDTs = lds + 44032;
    LAS unsigned char* Ws = lds + 62464;
    LAS unsigned char* GSs = lds + 80896;
    LAS unsigned char* SS = lds + 98304 + wave * 4352; LAS unsigned char* US = lds + 133120 + wave * 2304;
    LAS float* PART = (LAS float*)(lds + 151552);
    const unsigned char* gW = A.ws + WS_DW; const unsigned char* gGS = A.ws + WS_DGS;
    const unsigned char* gKC = A.ws + WS_DKC; const unsigned char* gQD = A.ws + WS_DQD; const unsigned char* gQK = A.ws + WS_DQK; const unsigned char* gKT = A.ws + WS_DKT;
    const float* DGL = (const float*)(A.ws + WS_DGL);
    f32x4 S[8];
#pragma unroll
    for (int mt = 0; mt < 8; ++mt) S[mt] = (f32x4){0.f, 0.f, 0.f, 0.f};
    u32x4 r[9], rg[2];
    float gl_all = 0.f;
#define DS_LOAD(itn, toff) do { const size_t _i = (size_t)(itn); const unsigned char* _kc = gKC + _i * 16384; const unsigned char* _qd = gQD + _i * 16384; \
        const unsigned char* _qk = gQK + _i * 8192; const unsigned char* _kt = gKT + _i * 16384; \
        r[0] = *(const u32x4*)(_kc + (toff)); r[1] = *(const u32x4*)(_kc + (toff) + 8192u); \
        r[2] = *(const u32x4*)(_qd + (toff)); r[3] = *(const u32x4*)(_qd + (toff) + 8192u); \
        r[4] = *(const u32x4*)(_qk + (toff)); \
        r[5] = *(const u32x4*)(_kt + (toff)); r[6] = *(const u32x4*)(_kt + (toff) + 8192u); \
        const unsigned char* _w = gW + _i * 16384; r[7] = *(const u32x4*)(_w + (toff)); r[8] = *(const u32x4*)(_w + (toff) + 8192u); } while (0)
#define DS_LOADG(itn, toff) do { const unsigned char* _g = gGS + (size_t)(itn) * 16384; rg[0] = *(const u32x4*)(_g + (toff)); rg[1] = *(const u32x4*)(_g + (toff) + 8192u); } while (0)
#define DS_STAGE(tidv) do { const int i0 = (tidv), i1 = (tidv) + 512; \
          *(LAS u32x4*)(KCs + (i0 >> 4) * 272 + (i0 & 15) * 16) = r[0]; *(LAS u32x4*)(KCs + (i1 >> 4) * 272 + (i1 & 15) * 16) = r[1]; \
          *(LAS u32x4*)(QDs + (i0 >> 4) * 272 + (i0 & 15) * 16) = r[2]; *(LAS u32x4*)(QDs + (i1 >> 4) * 272 + (i1 & 15) * 16) = r[3]; \
          *(LAS u32x4*)(QKs + (i0 >> 3) * 144 + (i0 & 7) * 16) = r[4]; \
          *(LAS u32x4*)(KDTs + (i0 >> 3) * 144 + (i0 & 7) * 16) = r[5]; *(LAS u32x4*)(KDTs + (i1 >> 3) * 144 + (i1 & 7) * 16) = r[6]; \
          *(LAS u32x4*)(Ws + (i0 >> 3) * 144 + (i0 & 7) * 16) = r[7]; *(LAS u32x4*)(Ws + (i1 >> 3) * 144 + (i1 & 7) * 16) = r[8]; } while (0)
#define DS_STAGEG(tidv) do { const int i0 = (tidv), i1 = (tidv) + 512; \
          *(LAS u32x4*)(GSs + (i0 >> 4) * 272 + (i0 & 15) * 16) = rg[0]; *(LAS u32x4*)(GSs + (i1 >> 4) * 272 + (i1 & 15) * 16) = rg[1]; } while (0)
#pragma unroll 1
    for (int n = 0; n < 32; ++n) {
        int tid = tid_in; asm volatile("" : "+v"(tid));
        const bool bstart = (SUB > 0) ? (n % SUB == 0) : (n == 0);
        const bool bnext1 = (SUB > 0) && ((n + 1) % SUB == 0), bnext2 = (SUB > 0) && ((n + 2) % SUB == 0);
        if (bstart) { if (n > 0) xcd_barrier(xb);
            gl_all = DGL[bh * 32 + (tid & 31)];
            const unsigned t0 = (unsigned)tid * 16u; DS_LOAD(bh * 32 + n, t0); DS_LOADG(bh * 32 + n, t0); DS_STAGE(tid); DS_STAGEG(tid);
            if (n + 1 < 32 && !bnext1) { DS_LOAD(bh * 32 + n + 1, t0); DS_LOADG(bh * 32 + n + 1, t0); }
            __syncthreads(); }
        else { DS_STAGEG(tid);
            if (n + 1 < 32 && !bnext1) DS_LOADG(bh * 32 + n + 1, (unsigned)tid * 16u); }
        const int lane = tid & 63, fr = lane & 15, quad = lane >> 4, vcol = 16 * wave + fr;
        const unsigned toff = (unsigned)tid * 16u;
        const int it = bh * 32 + n, tokb = b * SEQ + n * 64;
        const float glast = __builtin_bit_cast(float, __builtin_amdgcn_readlane(__builtin_bit_cast(int, gl_all), n));
        asm volatile("s_nop 7\n\ts_nop 7" ::: "memory");
#pragma unroll
        for (int mt = 0; mt < 8; ++mt) { u32x2 p; p.x = pg8::cvt_pk_bf16(S[mt][0], S[mt][1]); p.y = pg8::cvt_pk_bf16(S[mt][2], S[mt][3]); *(LAS u32x2*)(SS + fr * 272 + (mt * 16 + quad * 4) * 2) = p; }
        LDS_FENCE();
        bf16x8 Sb[4];
#pragma unroll
        for (int kk = 0; kk < 4; ++kk) Sb[kk] = *(LAS bf16x8*)(SS + fr * 272 + (kk * 32 + quad * 8) * 2);
        f32x4 U[4], O[4];
#pragma unroll
        for (int mt = 0; mt < 4; ++mt) { f32x4 au, ao = {0.f, 0.f, 0.f, 0.f};
            { const u32x2 wq = *(LAS u32x2*)(Ws + vcol * 144 + (mt * 16 + quad * 4) * 2);
              au[0] = __uint_as_float(wq.x << 16); au[1] = __uint_as_float(wq.x & 0xffff0000u); au[2] = __uint_as_float(wq.y << 16); au[3] = __uint_as_float(wq.y & 0xffff0000u); }
#pragma unroll
            for (int kk = 0; kk < 4; ++kk) { const bf16x8 a1 = *(LAS bf16x8*)(KCs + (mt * 16 + fr) * 272 + (kk * 32 + quad * 8) * 2); au = mfma16(a1, Sb[kk], au);
                const bf16x8 a2 = *(LAS bf16x8*)(QDs + (mt * 16 + fr) * 272 + (kk * 32 + quad * 8) * 2); ao = mfma16(a2, Sb[kk], ao); }
            U[mt] = au; O[mt] = ao; __builtin_amdgcn_sched_barrier(0); }
        asm volatile("s_nop 7\n\ts_nop 7" ::: "memory");
#pragma unroll
        for (int mt = 0; mt < 4; ++mt) { u32x2 p; p.x = pg8::cvt_pk_bf16(U[mt][0], U[mt][1]); p.y = pg8::cvt_pk_bf16(U[mt][2], U[mt][3]); *(LAS u32x2*)(US + fr * 144 + (mt * 16 + quad * 4) * 2) = p; }
        LDS_FENCE();
        bf16x8 Ub[2];
#pragma unroll
        for (int kk = 0; kk < 2; ++kk) Ub[kk] = *(LAS bf16x8*)(US + fr * 144 + (kk * 32 + quad * 8) * 2);
#pragma unroll
        for (int mt = 0; mt < 4; ++mt)
#pragma unroll
            for (int kk = 0; kk < 2; ++kk) { const bf16x8 a = *(LAS bf16x8*)(QKs + (mt * 16 + fr) * 144 + (kk * 32 + quad * 8) * 2); O[mt] = mfma16(a, Ub[kk], O[mt]); }
        __builtin_amdgcn_sched_barrier(0);
#pragma unroll
        for (int mt = 0; mt < 8; ++mt) { S[mt] *= glast;
#pragma unroll
            for (int kk = 0; kk < 2; ++kk) { const bf16x8 a = *(LAS bf16x8*)(KDTs + (mt * 16 + fr) * 144 + (kk * 32 + quad * 8) * 2); S[mt] = mfma16(a, Ub[kk], S[mt]); }
            if (mt & 1) __builtin_amdgcn_sched_barrier(0); }
        { float pp[16];
#pragma unroll
          for (int e = 0; e < 16; ++e) pp[e] = O[e >> 2][e & 3] * O[e >> 2][e & 3];
#pragma unroll
          for (int e = 0; e < 16; ++e) pp[e] = row_sum16(pp[e]);
          if (fr == 0) {
#pragma unroll
              for (int e = 0; e < 16; ++e) PART[((e >> 2) * 16 + quad * 4 + (e & 3)) * 8 + wave] = pp[e]; } }
        __syncthreads();
        if (n + 1 < 32 && !bnext1) { DS_STAGE(tid); if (n + 2 < 32 && !bnext2) DS_LOAD(it + 2, toff); }
        bf16_t* mixb = (bf16_t*)(A.ws + WS_MIX) + (size_t)tokb * D + h * 128;
#pragma unroll
        for (int mt = 0; mt < 4; ++mt)
#pragma unroll
            for (int i = 0; i < 4; ++i) { const int t = mt * 16 + quad * 4 + i;
                const f32x4 p0 = *(LAS f32x4*)(PART + t * 8), p1 = *(LAS f32x4*)(PART + t * 8 + 4);
                const float tot = ((p0[0] + p0[1]) + (p0[2] + p0[3])) + ((p1[0] + p1[1]) + (p1[2] + p1[3]));
                const float sc = rsqrtf(tot * (1.f / 128.f) + EPS);
                const float gs = bf2f(*(LAS bf16_t*)(GSs + t * 272 + vcol * 2));
                mixb[(unsigned)(t * D + vcol)] = (bf16_t)(pg8::cvt_pk_bf16(O[mt][i] * sc * gs, 0.f) & 0xffffu); }
        __syncthreads();
    }
#undef DS_STAGE
#undef DS_LOADG
#undef DS_STAGEG
#undef DS_LOAD
    { const int lane = lane_in, fr = lane & 15, quad = lane >> 4, vcol = 16 * wave + fr;
      float* dp = A.out + O_DP + (size_t)((l * 8 + b) * 4 + h) * 16384;
#pragma unroll
      for (int mt = 0; mt < 8; ++mt)
#pragma unroll
          for (int i = 0; i < 4; ++i) dp[(mt * 16 + quad * 4 + i) * 128 + vcol] = S[mt][i]; }
    __syncthreads();
}

__device__ __forceinline__ void delta_sample_item(const DevArgs& A, int l, LAS unsigned char* lds, int item, int tid, int wave, int lane) {
    asm volatile("" : "+v"(tid)); lane = tid & 63; wave = __builtin_amdgcn_readfirstlane(tid >> 6);
    const int b = item >> 2, h = item & 3, tokS = NP + b * 4;
    LAS float* RAW = (LAS float*)lds; LAS float* RED = RAW + 1536; LAS float* OB = RED + 512; LAS float* SC = OB + 512;
    const bf16_t* PROJ = (const bf16_t*)(A.ws + WS_PROJ); const float* AB = (const float*)(A.ws + WS_AB); bf16_t* MIX = (bf16_t*)(A.ws + WS_MIX);
    const float* cw = A.in[I_CONVW] + (size_t)l * 4 * 1536;
    for (int idx = tid; idx < 1536; idx += 512) { const int part = idx >> 9, t = (idx >> 7) & 3, c = idx & 127, col = part * 512 + h * 128 + c;
        float acc = 0.f;
#pragma unroll
        for (int j = 0; j < 4; ++j) { const int tt = t - 3 + j;
            const float x = (tt >= 0) ? bf2f(PROJ[(size_t)(tokS + tt) * NPROJ + col]) : A.in[I_SCONV][((size_t)(l * 128 + b) * 3 + (3 + tt)) * 1536 + col];
            acc += cw[j * 1536 + col] * x; }
        RAW[idx] = silu_f(acc); }
    if (tid < 4) { const float a = AB[(size_t)(tokS + tid) * 8 + h], bb = AB[(size_t)(tokS + tid) * 8 + 4 + h];
        const float xx = a + A.in[I_DTB][l * 4 + h]; const float sp = xx > 20.f ? xx : log1pf(expf(xx));
        SC[8 + tid] = 1.f / (1.f + expf(-bb)); SC[12 + tid] = expf(-expf(A.in[I_ALOG][l * 4 + h]) * sp); }
    const int v = tid & 127, kq = tid >> 7;
    float S[32];
    { const float* sp = A.in[I_SDELTA] + (size_t)((l * 128 + b) * 4 + h) * 16384;
#pragma unroll
      for (int i = 0; i < 32; ++i) S[i] = sp[(kq * 32 + i) * 128 + v]; }
    __syncthreads();
    { const int part = wave >> 2, t = wave & 3; const float x0 = RAW[part * 512 + t * 128 + lane], x1 = RAW[part * 512 + t * 128 + 64 + lane];
      const float ss = wave_sum(x0 * x0 + x1 * x1); if (lane == 0) SC[part * 4 + t] = rsqrtf(ss + EPS) * (part == 0 ? 0.08838834764831845f : 1.f); }
    __syncthreads();
    for (int t = 0; t < 4; ++t) {
        const float rq = SC[t], rk = SC[4 + t], beta = SC[8 + t], g = SC[12 + t];
        float pr = 0.f;
#pragma unroll
        for (int i = 0; i < 32; ++i) pr += S[i] * RAW[512 + t * 128 + kq * 32 + i];
        RED[kq * 128 + v] = pr * rk;
        __syncthreads();
        const float rr = (RED[v] + RED[128 + v]) + (RED[256 + v] + RED[384 + v]);
        const float u = beta * (RAW[1024 + t * 128 + v] - g * rr);
        float po = 0.f;
#pragma unroll
        for (int i = 0; i < 32; ++i) { const float kh = RAW[512 + t * 128 + kq * 32 + i] * rk; S[i] = g * S[i] + kh * u; po += S[i] * RAW[t * 128 + kq * 32 + i]; }
        __syncthreads();
        RED[kq * 128 + v] = po * rq;
        __syncthreads();
        if (kq == 0) OB[t * 128 + v] = (RED[v] + RED[128 + v]) + (RED[256 + v] + RED[384 + v]);
        __syncthreads();
    }
    if (wave < 4) { const int t = wave; const float x0 = OB[t * 128 + lane], x1 = OB[t * 128 + 64 + lane];
        const float ss = wave_sum(x0 * x0 + x1 * x1); const float sc = rsqrtf(ss * (1.f / 128.f) + EPS);
        const float g0 = bf2f(PROJ[(size_t)(tokS + t) * NPROJ + PC_G + h * 128 + lane]), g1 = bf2f(PROJ[(size_t)(tokS + t) * NPROJ + PC_G + h * 128 + 64 + lane]);
        MIX[(size_t)(tokS + t) * D + h * 128 + lane] = (bf16_t)f2bf(x0 * sc * A.in[I_ONORM][l * 128 + lane] * silu_f(g0));
        MIX[(size_t)(tokS + t) * D + h * 128 + 64 + lane] = (bf16_t)f2bf(x1 * sc * A.in[I_ONORM][l * 128 + 64 + lane] * silu_f(g1)); }
    { float* dsp = A.out + O_DS + (size_t)((l * 128 + b) * 4 + h) * 16384;
#pragma unroll
      for (int i = 0; i < 32; ++i) dsp[(kq * 32 + i) * 128 + v] = S[i]; }
    __syncthreads();
}

#define SSM_BCAST_U(t) do { unsigned _w[8]; \
        _w[0] = __builtin_amdgcn_readlane(ua.x, t); _w[1] = __builtin_amdgcn_readlane(ua.y, t); _w[2] = __builtin_amdgcn_readlane(ua.z, t); _w[3] = __builtin_amdgcn_readlane(ua.w, t); \
        _w[4] = __builtin_amdgcn_readlane(ub.x, t); _w[5] = __builtin_amdgcn_readlane(ub.y, t); _w[6] = __builtin_amdgcn_readlane(ub.z, t); _w[7] = __builtin_amdgcn_readlane(ub.w, t); \
        _Pragma("unroll") for (int _d = 0; _d < 8; ++_d) { uu[2 * _d] = __uint_as_float(_w[_d] << 16); uu[2 * _d + 1] = __uint_as_float(_w[_d] & 0xffff0000u); } } while (0)
#define SSM_STEP() do { float _br = 0.f, _bi = 0.f; \
        _Pragma("unroll") for (int _h = 0; _h < 16; ++_h) { _br = fmaf(Br[_h], uu[_h], _br); _bi = fmaf(Bi[_h], uu[_h], _bi); } \
        const float _nr = lr * hr - li * hi + _br, _ni = lr * hi + li * hr + _bi; hr = _nr; hi = _ni; } while (0)

__device__ __forceinline__ void ssm_part1_item(const DevArgs& A, int l, int it, int lane) {
    const int g = it & 15, bc = it >> 4, b = bc / 31, c = bc % 31;
    const float* bb = (const float*)(A.ws + WS_BBAR) + ((size_t)(l * 16 + g) * 64 + lane) * 32;
    float Br[16], Bi[16];
#pragma unroll
    for (int q = 0; q < 4; ++q) { const f32x4 x = ((const f32x4*)bb)[q], y = ((const f32x4*)bb)[4 + q];
        Br[4 * q] = x.x; Br[4 * q + 1] = x.y; Br[4 * q + 2] = x.z; Br[4 * q + 3] = x.w; Bi[4 * q] = y.x; Bi[4 * q + 1] = y.y; Bi[4 * q + 2] = y.z; Bi[4 * q + 3] = y.w; }
    const f32x4 lk = ((const f32x4*)(A.ws + WS_SSMK))[(l * 16 + g) * 64 + lane]; const float lr = lk.x, li = lk.y;
    const bf16_t* up = (const bf16_t*)(A.ws + WS_PROJ) + (size_t)(b * SEQ + c * 64 + lane) * NPROJ + PC_SSM + g * 16;
    const u32x4 ua = *(const u32x4*)up, ub = *(const u32x4*)(up + 8);
    float hr = 0.f, hi = 0.f, uu[16];
#pragma unroll 1
    for (int t = 0; t < 64; ++t) { SSM_BCAST_U(t); SSM_STEP(); }
    f32x2 e; e.x = hr; e.y = hi;
    ((f32x2*)(A.ws + WS_SSME))[((size_t)(b * 32 + c) * 16 + g) * 64 + lane] = e;
}

__device__ __forceinline__ void ssm_part2_item(const DevArgs& A, int l, LAS unsigned char* lds, int it, int tid, int wave, int lane) {
    asm volatile("" : "+v"(tid)); lane = tid & 63; wave = __builtin_amdgcn_readfirstlane(tid >> 6);
    const int tok0 = it * 64, fr = lane & 15, quad = lane >> 4;
    const bool samp = it >= 256; const int b = it >> 5, c = it & 31;
    LAS unsigned char* YS = lds; LAS unsigned char* HS = lds + 33792 + wave * 4352;
    const bf16_t* PROJ = (const bf16_t*)(A.ws + WS_PROJ); bf16_t* MIX = (bf16_t*)(A.ws + WS_MIX);
#pragma unroll 1
    for (int gi = 0; gi < 2; ++gi) {
        const int g = wave * 2 + gi;
        const float* bb = (const float*)(A.ws + WS_BBAR) + ((size_t)(l * 16 + g) * 64 + lane) * 32;
        float Br[16], Bi[16];
#pragma unroll
        for (int q = 0; q < 4; ++q) { const f32x4 x = ((const f32x4*)bb)[q], y = ((const f32x4*)bb)[4 + q];
            Br[4 * q] = x.x; Br[4 * q + 1] = x.y; Br[4 * q + 2] = x.z; Br[4 * q + 3] = x.w; Bi[4 * q] = y.x; Bi[4 * q + 1] = y.y; Bi[4 * q + 2] = y.z; Bi[4 * q + 3] = y.w; }
        const f32x4 lk = ((const f32x4*)(A.ws + WS_SSMK))[(l * 16 + g) * 64 + lane]; const float lr = lk.x, li = lk.y, Lr = lk.z, Li = lk.w;
        bf16x8 Cb[4];
#pragma unroll
        for (int kk = 0; kk < 4; ++kk) { const size_t co = ((size_t)(l * 16 + g) * 16 + fr) * 64 + kk * 16 + quad * 4;
            const f32x4 cr = *(const f32x4*)(A.in[I_CRE] + co), ci = *(const f32x4*)(A.in[I_CIM] + co);
            u32x4 pk; pk.x = pk2(cr.x, -ci.x); pk.y = pk2(cr.y, -ci.y); pk.z = pk2(cr.z, -ci.z); pk.w = pk2(cr.w, -ci.w);
            Cb[kk] = __builtin_bit_cast(bf16x8, pk); }
        const bf16_t* up = PROJ + (size_t)(tok0 + lane) * NPROJ + PC_SSM + g * 16;
        const u32x4 ua = *(const u32x4*)up, ub = *(const u32x4*)(up + 8);
        float hr = 0.f, hi = 0.f, uu[16];
        if (!samp && c > 0) { const f32x2* E = (const f32x2*)(A.ws + WS_SSME) + ((size_t)(b * 32) * 16 + g) * 64 + lane;
#pragma unroll
            for (int cb = 0; cb < 32; cb += 16) { f32x2 ev[16];
#pragma unroll
                for (int q = 0; q < 16; ++q) { const int cc = cb + q; ev[q] = (cc < c) ? E[(size_t)cc * 1024] : (f32x2){0.f, 0.f}; }
#pragma unroll
                for (int q = 0; q < 16; ++q) { const int cc = cb + q; if (cc < c) { const float nr = Lr * hr - Li * hi + ev[q].x, ni = Lr * hi + Li * hr + ev[q].y; hr = nr; hi = ni; } } } }
        const float dsk = A.in[I_SSMD][l * 256 + g * 16 + fr];
        unsigned uvr[16];
#pragma unroll
        for (int e = 0; e < 16; ++e) uvr[e] = PROJ[(size_t)(tok0 + (e >> 2) * 16 + quad * 4 + (e & 3)) * NPROJ + PC_SSM + g * 16 + fr];
#pragma unroll
        for (int sub = 0; sub < 4; ++sub) {
#pragma unroll 1
            for (int tt = 0; tt < 16; ++tt) { const int t = sub * 16 + tt;
                const int sb = (it - 256) * 16 + (t >> 2);
                if (samp && (t & 3) == 0) { hr = A.in[I_SRE][((size_t)(l * 128 + sb) * 16 + g) * 64 + lane]; hi = A.in[I_SIM][((size_t)(l * 128 + sb) * 16 + g) * 64 + lane]; }
                SSM_BCAST_U(t); SSM_STEP();
                *(LAS unsigned*)(HS + tt * 272 + lane * 4) = pg8::cvt_pk_bf16(hr, hi);
                if (samp && (t & 3) == 3) { A.out[O_RES + ((size_t)(l * 128 + sb) * 16 + g) * 64 + lane] = hr; A.out[O_IMS + ((size_t)(l * 128 + sb) * 16 + g) * 64 + lane] = hi; }
            }
            LDS_FENCE();
            f32x4 acc = {0.f, 0.f, 0.f, 0.f};
#pragma unroll
            for (int kk = 0; kk < 4; ++kk) { const bf16x8 a = *(LAS bf16x8*)(HS + fr * 272 + (kk * 32 + quad * 8) * 2); acc = mfma16(a, Cb[kk], acc); }
#pragma unroll
            for (int i = 0; i < 4; ++i) { const int t = sub * 16 + quad * 4 + i; const float uv = bf2f(uvr[sub * 4 + i]);
                *(LAS bf16_t*)(YS + t * 528 + (g * 16 + fr) * 2) = (bf16_t)f2bf(gelu_tanh_f(acc[i] + dsk * uv)); }
            LDS_FENCE();
        }
        if (!samp && c == 31) { A.out[O_REP + ((size_t)(l * 8 + b) * 16 + g) * 64 + lane] = hr; A.out[O_IMP + ((size_t)(l * 8 + b) * 16 + g) * 64 + lane] = hi; }
    }
    __syncthreads();
    {
        const bf16_t* GT = (const bf16_t*)(A.ws + WS_GLUT + l * SZ_GLUT);
        f32x4 acc[4][2];
#pragma unroll
        for (int mt = 0; mt < 4; ++mt) { acc[mt][0] = (f32x4){0.f, 0.f, 0.f, 0.f}; acc[mt][1] = (f32x4){0.f, 0.f, 0.f, 0.f}; }
#pragma unroll
        for (int kk = 0; kk < 8; ++kk) { bf16x8 bfr[2];
#pragma unroll
            for (int nt = 0; nt < 2; ++nt) bfr[nt] = *(const bf16x8*)(GT + (size_t)(32 * wave + nt * 16 + fr) * 256 + kk * 32 + quad * 8);
#pragma unroll
            for (int mt = 0; mt < 4; ++mt) { const bf16x8 a = *(LAS bf16x8*)(YS + (mt * 16 + fr) * 528 + (kk * 32 + quad * 8) * 2);
                acc[mt][0] = mfma16(a, bfr[0], acc[mt][0]); acc[mt][1] = mfma16(a, bfr[1], acc[mt][1]); } }
#pragma unroll
        for (int nt = 0; nt < 2; ++nt) { const int ncol = 32 * wave + nt * 16 + fr; const float gb = A.in[I_GLUB][l * 256 + ncol];
#pragma unroll
            for (int mt = 0; mt < 4; ++mt)
#pragma unroll
                for (int i = 0; i < 4; ++i) { const int t = mt * 16 + quad * 4 + i; const float y = bf2f(*(LAS bf16_t*)(YS + t * 528 + ncol * 2));
                    MIX[(size_t)(tok0 + t) * D + 512 + ncol] = (bf16_t)f2bf(y * sigmoid_f(acc[mt][nt][i] + gb)); } }
    }
    __syncthreads();
}

__device__ __forceinline__ void pool_item(const DevArgs& A, int l, LAS unsigned char* lds, int it, int tid, int wave, int lane) {
    asm volatile("" : "+v"(tid)); lane = tid & 63; wave = __builtin_amdgcn_readfirstlane(tid >> 6);
    const int tok0 = it * 64, fr = lane & 15, quad = lane >> 4; const bool samp = it >= 256;
    LAS unsigned char* RS = lds;
    const bf16_t* PROJ = (const bf16_t*)(A.ws + WS_PROJ); bf16_t* MIX = (bf16_t*)(A.ws + WS_MIX);
    if (!samp) {
        LAS unsigned char* XT = lds + 33792;
        const int b = it >> 5, c = it & 31;
        for (int id = tid; id < 79 * 32; id += 512) { const int r = id >> 5, c16 = id & 31, tl = c * 64 - 15 + r;
            u32x4 v = {0u, 0u, 0u, 0u}; if (tl >= 0) v = *(const u32x4*)(PROJ + (size_t)(b * SEQ + tl) * NPROJ + PC_POOL + c16 * 8);
            *(LAS u32x4*)(XT + r * 528 + c16 * 16) = v; }
        __syncthreads();
        const int ch = tid & 255, half = tid >> 8, g = ch >> 6, w = 2 << g, r0 = half * 32;
        float sum = 0.f;
        for (int j = 0; j < w; ++j) sum += bf2f(*(LAS bf16_t*)(XT + (r0 + 15 - j) * 528 + ch * 2));
#pragma unroll 4
        for (int rr = 0; rr < 32; ++rr) { const int r = r0 + rr, tl = c * 64 + r;
            const float u = bf2f(*(LAS bf16_t*)(XT + (r + 15) * 528 + ch * 2));
            if (rr > 0) sum += u - bf2f(*(LAS bf16_t*)(XT + (r + 15 - w) * 528 + ch * 2));
            const float cnt = (float)((tl + 1 < w) ? tl + 1 : w);
            *(LAS bf16_t*)(RS + r * 528 + ch * 2) = (bf16_t)f2bf(sum / cnt - u); }
    } else {
#pragma unroll 1
        for (int pr = 0; pr < 8; ++pr) { const int idx = pr * 512 + tid, ch = idx & 255, sq = idx >> 8, g = ch >> 6, w = 2 << g;
            const int sb = (it - 256) * 16 + sq;
            const float* sbuf = A.in[I_SPOOL] + (size_t)(l * 128 + sb) * 15 * 256 + ch;
            const bf16_t* base = PROJ + (size_t)(NP + sb * 4) * NPROJ + PC_POOL + ch;
            float e[19];
#pragma unroll
            for (int j = 0; j < 15; ++j) e[j] = sbuf[j * 256];
#pragma unroll
            for (int j = 0; j < 4; ++j) e[15 + j] = bf2f(base[(size_t)j * NPROJ]);
#pragma unroll
            for (int t = 0; t < 4; ++t) { float sum = 0.f;
#pragma unroll
                for (int j = 0; j < 16; ++j) sum += (j < w) ? e[15 + t - j] : 0.f;
                *(LAS bf16_t*)(RS + (sq * 4 + t) * 528 + ch * 2) = (bf16_t)f2bf(sum / (float)w - e[15 + t]); } }
    }
    __syncthreads();
    { const int g2 = wave >> 1; const bf16_t* PT = (const bf16_t*)(A.ws + WS_POOLT + l * SZ_POOLT) + g2 * 4096;
      f32x4 acc[4][2];
#pragma unroll
      for (int mt = 0; mt < 4; ++mt) { acc[mt][0] = (f32x4){0.f, 0.f, 0.f, 0.f}; acc[mt][1] = (f32x4){0.f, 0.f, 0.f, 0.f}; }
#pragma unroll
      for (int kk = 0; kk < 2; ++kk) { bf16x8 bfr[2];
#pragma unroll
          for (int nt = 0; nt < 2; ++nt) bfr[nt] = *(const bf16x8*)(PT + (size_t)((wave & 1) * 32 + nt * 16 + fr) * 64 + kk * 32 + quad * 8);
#pragma unroll
          for (int mt = 0; mt < 4; ++mt) { const bf16x8 a = *(LAS bf16x8*)(RS + (mt * 16 + fr) * 528 + (g2 * 64 + kk * 32 + quad * 8) * 2);
              acc[mt][0] = mfma16(a, bfr[0], acc[mt][0]); acc[mt][1] = mfma16(a, bfr[1], acc[mt][1]); } }
#pragma unroll
      for (int nt = 0; nt < 2; ++nt) { const int col = 32 * wave + nt * 16 + fr; const float ps = A.in[I_POOLS][l * 256 + col];
#pragma unroll
          for (int mt = 0; mt < 4; ++mt)
#pragma unroll
              for (int i = 0; i < 4; ++i) { const int t = mt * 16 + quad * 4 + i; MIX[(size_t)(tok0 + t) * D + 768 + col] = (bf16_t)f2bf(acc[mt][nt][i] * ps); } } }
    __syncthreads();
}

__device__ __forceinline__ void state_copies(const DevArgs& A, int l, int gt, int NT) {
    const bf16_t* PROJ = (const bf16_t*)(A.ws + WS_PROJ);
#pragma unroll 1
    for (int i = gt; i < 8 * 3 * 1536; i += NT) { const int col = i % 1536, j = (i / 1536) % 3, b = i / 4608;
        A.out[O_CP + (size_t)l * 8 * 4608 + i] = bf2f(PROJ[(size_t)(b * SEQ + SEQ - 3 + j) * NPROJ + col]); }
#pragma unroll 1
    for (int i = gt; i < 128 * 3 * 1536; i += NT) { const int col = i % 1536, j = (i / 1536) % 3, b = i / 4608;
        A.out[O_CS + (size_t)l * 128 * 4608 + i] = bf2f(PROJ[(size_t)(NP + b * 4 + 1 + j) * NPROJ + col]); }
#pragma unroll 1
    for (int i = gt; i < 8 * 15 * 256; i += NT) { const int ch = i & 255, j = (i >> 8) % 15, b = i / 3840;
        A.out[O_PP + (size_t)l * 8 * 3840 + i] = bf2f(PROJ[(size_t)(b * SEQ + SEQ - 15 + j) * NPROJ + PC_POOL + ch]); }
#pragma unroll 1
    for (int i = gt; i < 128 * 15 * 256; i += NT) { const int ch = i & 255, j = (i >> 8) % 15, b = i / 3840;
        A.out[O_PS + (size_t)l * 128 * 3840 + i] = (j < 11) ? A.in[I_SPOOL][((size_t)(l * 128 + b) * 15 + 4 + j) * 256 + ch]
                                                             : bf2f(PROJ[(size_t)(NP + b * 4 + (j - 11)) * NPROJ + PC_POOL + ch]); }
}

#ifndef REP_DPREP
#define REP_DPREP 1
#endif
#ifndef REP_DSAMP
#define REP_DSAMP 1
#endif
#ifndef REP_SSM1
#define REP_SSM1 1
#endif
#ifndef REP_POOL
#define REP_POOL 1
#endif
#ifndef REP_DSCAN
#define REP_DSCAN 1
#endif
#ifndef REP_SSM2
#define REP_SSM2 1
#endif
#ifndef REP_G
#define REP_G 1
#endif
#ifndef REP_P3
#define REP_P3 1
#endif
#ifndef REP_P2
#define REP_P2 1
#endif
constexpr int NPH = 2 + DEPTH * 8;
__global__ void __launch_bounds__(512, 2) mega_fwd(Args KA) {
    DevArgs A; A.out = KA.out; A.ws = KA.ws; A.ph_lo = KA.ph_lo; A.ph_hi = KA.ph_hi;
    extern __shared__ __attribute__((aligned(16))) unsigned char lds_raw[];
    LAS unsigned char* lds = (LAS unsigned char*)lds_raw;
    cg::grid_group grid = cg::this_grid();
    volatile LAS unsigned* xst = (volatile LAS unsigned*)(lds + LDS_BYTES - 64);
    if (threadIdx.x == 0) { xst[0] = 0u; xst[1] = 0u; }
    __syncthreads();
    const XcdBarrier xb = xcd_barrier_post((unsigned*)(KA.ws + WS_BAR), xst);
    constexpr int G = 256, NGW = G * 8, NT = G * 512;
    int ph = 0;
#define PH_BEGIN if (A.ph_lo <= ph && ph < A.ph_hi) { int tid = threadIdx.x; asm volatile("" : "+v"(tid)); { unsigned char* _w = A.ws; asm volatile("" : "+s"(_w)); A.ws = _w; float* _o = A.out; asm volatile("" : "+s"(_o)); A.out = _o; } const int wave = __builtin_amdgcn_readfirstlane(tid >> 6), lane = tid & 63, gw = blockIdx.x * 8 + wave, gt = blockIdx.x * 512 + tid; (void)gw; (void)gt; (void)lane;
#define PH_END   if (ph + 1 < A.ph_hi) { if (ph == 0) grid.sync(); else xcd_barrier(xb); } } ++ph;
#define Hb   ((bf16_t*)(A.ws + WS_H))
#define AB   ((float*)(A.ws + WS_AB))
#define MIXO ((float*)(A.ws + WS_MIXO))
#define PROJ ((bf16_t*)(A.ws + WS_PROJ))
#define MIX  ((bf16_t*)(A.ws + WS_MIX))
#define HID  ((bf16_t*)(A.ws + WS_HID))

#ifndef REP_PRO
#define REP_PRO 1
#endif
#ifndef REP_N0
#define REP_N0 1
#endif
    PH_BEGIN for (int rep = 0; rep < REP_PRO; ++rep) { prologue(A, lds, wave, lane, gw, NGW); __syncthreads(); } PH_END
    PH_BEGIN for (int rep = 0; rep < REP_N0; ++rep) norm_rows(nullptr, nullptr, A.in[I_XP], A.in[I_XS], nullptr, A.in[I_NMPRE], Hb, (const float*)(A.ws + WS_WAB), AB, gw, NGW, lane); PH_END

#pragma unroll 1
    for (int l = 0; l < DEPTH; ++l) {
        PH_BEGIN for (int rep = 0; rep < REP_G; ++rep) { pg8::Gemm g{Hb, (const bf16_t*)(A.ws + WS_WIN + l * SZ_WIN), NTOK, NPROJ, D, D, D}; pg8::StaticOrder S; S.init(NTOK, NPROJ, G, (int)blockIdx.x);
            pg8::EpiBf16<0> E{PROJ, NPROJ, nullptr, 0, 0}; pg8::gemm_phase<pg8::EpiBf16<0>, pg8::StaticOrder>(lds, g, S, E, nullptr); } PH_END
        constexpr int SUBC = 7;
        PH_BEGIN {
#pragma unroll 1
          for (int rep2 = 0; rep2 < REP_P2; ++rep2) {
#pragma unroll 1
            for (int j = blockIdx.x; j < 32 * SUBC; j += G) delta_prep_item(A, l, lds, (j & 31) * 32 + (j >> 5), tid, wave, lane);
          }
        } PH_END
        PH_BEGIN {
#pragma unroll 1
            for (int rep3 = 0; rep3 < REP_P3; ++rep3) {
                if (blockIdx.x < 32) delta_scan_item(A, l, lds, blockIdx.x, tid, wave, lane, xb, SUBC);
                else { const int w = blockIdx.x - 32; constexpr int NW = G - 32;
#pragma unroll 1
                    for (int k = 1; k <= 5; ++k) {
                        const int n0 = k * SUBC, nn = (n0 >= 32) ? 0 : ((32 - n0 < SUBC) ? 32 - n0 : SUBC);
                        int nprep = 32 * nn;
#ifndef REP_WPREP
#define REP_WPREP 1
#endif
#pragma unroll 1
                        for (int rep = 0; rep < REP_WPREP; ++rep)
#pragma unroll 1
                        for (int j = w; j < nprep; j += NW) delta_prep_item(A, l, lds, (j & 31) * 32 + n0 + (j >> 5), tid, wave, lane);
                        if (k == 1) {
#pragma unroll 1
                            for (int it = w; it < 512; it += NW) delta_sample_item(A, l, lds, it, tid, wave, lane); }
                        if (k == 2) {
#pragma unroll 1
                            for (int it = w * 8 + wave; it < 8 * 31 * 16; it += NW * 8) { int t1 = threadIdx.x; asm volatile("" : "+v"(t1)); ssm_part1_item(A, l, it, t1 & 63); }
                            { int t2 = threadIdx.x; asm volatile("" : "+v"(t2)); int wl = blockIdx.x; asm volatile("" : "+s"(wl)); state_copies(A, l, (wl - 32) * 512 + t2, NW * 512); } }
                        if (k == 3) {
#pragma unroll 1
                            for (int it = w; it < 264; it += NW) pool_item(A, l, lds, it, tid, wave, lane); }
                        { const int it = (k == 4) ? w - 128 : ((k == 5) ? 96 + w : -1);
                          if (it >= 0 && it < ((k == 4) ? 96 : 264)) ssm_part2_item(A, l, lds, it, tid, wave, lane); }
                        if (k < 5) xcd_barrier(xb);
                    } }
            }
        } PH_END
        PH_BEGIN for (int rep = 0; rep < REP_G; ++rep) { pg8::Gemm g{MIX, (const bf16_t*)(A.ws + WS_WOUT + l * SZ_WOUT), NP, D, D, D, D}; pg8::StaticOrder S; S.init(NP, D, G, (int)blockIdx.x);
            pg8::EpiBf16<0> E{(bf16_t*)MIXO, D, nullptr, 0, 0}; pg8::gemm_phase<pg8::EpiBf16<0>, pg8::StaticOrder>(lds, g, S, E, nullptr);
            pg8::Gemm g2{MIX + (size_t)NP * D, (const bf16_t*)(A.ws + WS_WOUT + l * SZ_WOUT), NS, D, 256, D, D}; SliceOrder S2{8 * (D / 256), G, (int)blockIdx.x};
            EpiF32Part E2{(float*)(A.ws + WS_PARTS)}; pg8::gemm_phase<EpiF32Part, SliceOrder>(lds, g2, S2, E2, nullptr); } PH_END
#ifndef REP_N5
#define REP_N5 1
#endif
        PH_BEGIN norm_rows_pf(MIXO, A.in[I_NMPOST] + l * D, l == 0 ? A.in[I_XP] : A.out, l == 0 ? A.in[I_XS] : nullptr, A.out, A.in[I_NFPRE] + l * D, Hb, gw, NGW, lane, (const float*)(A.ws + WS_PARTS), D / 256); PH_END
        PH_BEGIN for (int rep = 0; rep < REP_G; ++rep) { pg8::Gemm g{Hb, (const bf16_t*)(A.ws + WS_WGU + l * SZ_WGU), NTOK, NGU, D, D, D}; pg8::StaticOrder S; S.init(NTOK, NGU, G, (int)blockIdx.x);
            EpiSwiGLU E{HID, DFF}; pg8::gemm_phase<EpiSwiGLU, pg8::StaticOrder>(lds, g, S, E, nullptr); } PH_END
        PH_BEGIN for (int rep = 0; rep < REP_G; ++rep) { pg8::Gemm g{HID, (const bf16_t*)(A.ws + WS_WDN + l * SZ_WDN), NP, D, DFF, DFF, DFF}; pg8::StaticOrder S; S.init(NP, D, G, (int)blockIdx.x);
            pg8::EpiBf16<0> E{(bf16_t*)MIXO, D, nullptr, 0, 0}; pg8::gemm_phase<pg8::EpiBf16<0>, pg8::StaticOrder>(lds, g, S, E, nullptr);
            pg8::Gemm g2{HID + (size_t)NP * DFF, (const bf16_t*)(A.ws + WS_WDN + l * SZ_WDN), NS, D, 256, DFF, DFF}; SliceOrder S2{8 * (DFF / 256), G, (int)blockIdx.x};
            EpiF32Part E2{(float*)(A.ws + WS_PARTS)}; pg8::gemm_phase<EpiF32Part, SliceOrder>(lds, g2, S2, E2, nullptr); } PH_END
        PH_BEGIN norm_rows(MIXO, A.in[I_NFPOST] + l * D, A.out, nullptr, A.out, l + 1 < DEPTH ? A.in[I_NMPRE] + (l + 1) * D : nullptr, l + 1 < DEPTH ? Hb : nullptr,
                           l + 1 < DEPTH ? (const float*)(A.ws + WS_WAB + (l + 1) * SZ_WAB) : nullptr, AB, gw, NGW, lane, (const float*)(A.ws + WS_PARTS), DFF / 256); PH_END
    }
#undef PH_BEGIN
#undef PH_END
#undef Hb
#undef AB
#undef MIXO
#undef PROJ
#undef MIX
#undef HID
}

extern "C" void kernel_launch(void* const* d_in, const int* in_sizes, int n_in, void* d_out, int out_size, void* d_ws, size_t ws_size, hipStream_t stream) {
    static int grid = 0;
    if (grid == 0) {
        if (n_in != 32 || (size_t)out_size != O_END || ws_size < WS_END) fprintf(stderr, "kernel_launch: unexpected sizes: n_in %d out %d (want %zu) ws %zu (want >= %zu)\n", n_in, out_size, (size_t)O_END, ws_size, (size_t)WS_END);
        int dev = 0, cus = 0, per_cu = 0;
        (void)hipGetDevice(&dev); (void)hipDeviceGetAttribute(&cus, hipDeviceAttributeMultiprocessorCount, dev);
        if (hipFuncSetAttribute((const void*)mega_fwd, hipFuncAttributeMaxDynamicSharedMemorySize, LDS_BYTES) != hipSuccess) fprintf(stderr, "kernel_launch: hipFuncSetAttribute failed\n");
        if (hipOccupancyMaxActiveBlocksPerMultiprocessor(&per_cu, (const void*)mega_fwd, 512, LDS_BYTES) != hipSuccess || per_cu < 1) { fprintf(stderr, "kernel_launch: occupancy query gave %d\n", per_cu); per_cu = 1; (void)hipGetLastError(); }
        grid = cus * per_cu; if (grid <= 0) grid = 256;
        if (grid >= 256) grid = 256;
        fprintf(stderr, "kernel_launch: grid %d (cus %d x %d)%s\n", grid, cus, per_cu, grid < 256 ? "  ERROR: this build needs >= 256 co-resident workgroups" : "");
    }
    (void)hipMemsetAsync((unsigned char*)d_ws + WS_BAR, 0, 16384, stream);
    Args a{};
    for (int i = 0; i < 32; ++i) a.in[i] = (const float*)d_in[i];
    a.out = (float*)d_out; a.ws = (unsigned char*)d_ws;
#if MK_COOP
    a.ph_lo = 0; a.ph_hi = NPH;
    void* args[] = {&a};
    const hipError_t e = hipLaunchCooperativeKernel((const void*)mega_fwd, dim3(grid), dim3(512), args, LDS_BYTES, stream);
    if (e != hipSuccess) fprintf(stderr, "kernel_launch: cooperative launch failed: %s (grid %d)\n", hipGetErrorString(e), grid);
#else
    for (int p = 0; p < NPH; ++p) { a.ph_lo = p; a.ph_hi = p + 1; hipLaunchKernelGGL(mega_fwd, dim3(grid), dim3(512), LDS_BYTES, stream, a); }
#endif
}
```

```cpp
#include <hip/hip_runtime.h>
#include <hip/hip_cooperative_groups.h>
#include <cstdio>
#include <cstdint>
namespace cg = cooperative_groups;
#ifndef MK_COOP
#define MK_COOP 1
#endif
namespace pg8 {
#define PG8_LAS __attribute__((address_space(3)))
typedef unsigned short bf16_t;
typedef short bf16x8 __attribute__((ext_vector_type(8)));
typedef float f32x4 __attribute__((ext_vector_type(4)));
typedef unsigned u32x4 __attribute__((ext_vector_type(4)));
constexpr int BM = 256, BK = 64, HALF = 128, HTB = HALF * BK * 2  , STAGE_BYTES = 8 * HTB, NXCD = 8, WGM = 8;

__host__ __device__ __forceinline__ int lds_byte(int r, int c) { const int st = (r >> 4) * 2 + (c >> 5), rr = r & 15, cc = c & 31, ob = rr * 64 + cc * 2; return st * 1024 + (ob ^ (((ob >> 9) & 1) << 5)); }
__host__ __device__ __forceinline__ void stage_rc(int b, int& R, int& C) { const int st = b / 1024, sb = b % 1024, swz = sb ^ (((sb >> 9) & 1) << 5); R = (st >> 1) * 16 + swz / 64; C = (st & 1) * 32 + (swz % 64) / 2; }
__host__ __device__ __forceinline__ int perm32(int rho) { const int n = rho >> 4, i = rho & 15; return 8 * (i >> 2) + 4 * n + (i & 3); }

struct Unit { int pm, pn, ks; };
struct Gemm { const bf16_t* A; const bf16_t* Bt; int M, N, K, lda, ldb; };

struct StaticOrder {
    int nM, nN, nwg, G, c;
    __host__ __device__ void init(int M, int N, int G_, int c_) { nM = M / BM; nN = N / BM; nwg = nM * nN; G = G_; c = c_; }
    __host__ __device__ bool next(int i, Unit& u) const {
        const long L = (long)i * G + c; if (L >= nwg) return false;
        int wgid = (int)L; { const int q = nwg / NXCD, r = nwg % NXCD, xcd = wgid % NXCD, off = wgid / NXCD; wgid = (xcd < r ? xcd * (q + 1) : r * (q + 1) + (xcd - r) * q) + off; }
        const int nig = WGM * nN, gid = wgid / nig, fm = gid * WGM, gsz = (nM - fm) < WGM ? (nM - fm) : WGM;
        u.pm = fm + ((wgid % nig) % gsz); u.pn = (wgid % nig) / gsz; u.ks = 0; return true;
    }
    __device__ __forceinline__ void a_ready(const Unit&) const {}
    __device__ __forceinline__ void done(const Unit&) const {}
};
__device__ __forceinline__ unsigned cvt_pk_bf16(float lo, float hi) { unsigned r; asm volatile("v_cvt_pk_bf16_f32 %0, %1, %2" : "=v"(r) : "v"(lo), "v"(hi)); return r; }
typedef float f32x2 __attribute__((ext_vector_type(2)));
__device__ __forceinline__ f32x2 gelu_pk(f32x2 v) {
    const f32x2 av = __builtin_elementwise_abs(v), d = av * 0.2316418882f + 1.0f;
    f32x2 t; t.x = __builtin_amdgcn_rcpf(d.x); t.y = __builtin_amdgcn_rcpf(d.y);
    f32x2 q = t * 0.5307027145f + (-0.7265760135f); q = q * t + 0.7107068705f; q = q * t + (-0.142248368f); q = q * t + 0.127414796f; q = q * t;
    const f32x2 s = (v * v) * (-0.72134752044f);
    f32x2 e; e.x = __builtin_amdgcn_exp2f(s.x); e.y = __builtin_amdgcn_exp2f(s.y);
    const f32x2 m = v * (q * e), r = v - m;
    f32x2 o; o.x = v.x < 0.f ? m.x : r.x; o.y = v.y < 0.f ? m.y : r.y; return o;
}

struct EpiF32 {
    static constexpr bool PERM = false, AFTER_DRAIN = false;
    float* C; int ldc; const float* bias;
    __device__ __forceinline__ void operator()(const f32x4 (&acc)[2][2][4][2], const Unit& u, int wr, int wc, int fr, int fq) const {
        const int row0 = u.pm * BM + wr * 64 + fr, col0 = u.pn * BM + wc * 32 + 4 * fq;
        f32x4 bv[2][2];
#pragma unroll
        for (int bj = 0; bj < 2; ++bj)
#pragma unroll
            for (int n = 0; n < 2; ++n) bv[bj][n] = bias ? *(const f32x4*)(bias + col0 + bj * HALF + n * 16) : (f32x4){0.f, 0.f, 0.f, 0.f};
#pragma unroll
        for (int ai = 0; ai < 2; ++ai)
#pragma unroll
            for (int m = 0; m < 4; ++m) { float* rowp = C + (size_t)(row0 + ai * HALF + m * 16) * ldc + col0;
#pragma unroll
                for (int bj = 0; bj < 2; ++bj)
#pragma unroll
                    for (int n = 0; n < 2; ++n) *(f32x4*)(rowp + bj * HALF + n * 16) = acc[ai][bj][m][n] + bv[bj][n]; }
    }
};
template <int ACT  > struct EpiBf16 {
    static constexpr bool PERM = true, AFTER_DRAIN = false;
    bf16_t* O; int ldc; const float* bias; int split_cols; size_t split_stride;
    __device__ __forceinline__ void operator()(const f32x4 (&acc)[2][2][4][2], const Unit& u, int wr, int wc, int fr, int fq) const {
        const int row0 = u.pm * BM + wr * 64 + fr; int colt = u.pn * BM; bf16_t* base = O;
        if (split_cols) { const int t = colt / split_cols; base += (size_t)t * split_stride; colt -= t * split_cols; }
        const int col0 = colt + wc * 32 + 8 * fq, bcol0 = u.pn * BM + wc * 32 + 8 * fq;
        f32x4 bv[2][2];
#pragma unroll
        for (int bj = 0; bj < 2; ++bj)
#pragma unroll
            for (int n = 0; n < 2; ++n) bv[bj][n] = bias ? *(const f32x4*)(bias + bcol0 + bj * HALF + 4 * n) : (f32x4){0.f, 0.f, 0.f, 0.f};
#pragma unroll
        for (int ai = 0; ai < 2; ++ai)
#pragma unroll
            for (int m = 0; m < 4; ++m) { bf16_t* rowp = base + (size_t)(row0 + ai * HALF + m * 16) * ldc + col0;
#pragma unroll
                for (int bj = 0; bj < 2; ++bj) { f32x4 v0 = acc[ai][bj][m][0] + bv[bj][0], v1 = acc[ai][bj][m][1] + bv[bj][1];
                    if (ACT == 1) { f32x2 a = gelu_pk((f32x2){v0[0], v0[1]}), b = gelu_pk((f32x2){v0[2], v0[3]}), c = gelu_pk((f32x2){v1[0], v1[1]}), d = gelu_pk((f32x2){v1[2], v1[3]});
                        v0 = (f32x4){a.x, a.y, b.x, b.y}; v1 = (f32x4){c.x, c.y, d.x, d.y}; }
                    if (ACT == 2) {
#pragma unroll
                        for (int j = 0; j < 4; ++j) { v0[j] = 0.5f * v0[j] * (1.0f + erff(v0[j] * 0.70710678f)); v1[j] = 0.5f * v1[j] * (1.0f + erff(v1[j] * 0.70710678f)); } }
                    u32x4 w; w.x = cvt_pk_bf16(v0[0], v0[1]); w.y = cvt_pk_bf16(v0[2], v0[3]); w.z = cvt_pk_bf16(v1[0], v1[1]); w.w = cvt_pk_bf16(v1[2], v1[3]);
                    *(u32x4*)(rowp + bj * HALF) = w; } }
    }
};
template <class Epi, class Sched, bool STAMP = false>
__device__ __forceinline__ void gemm_phase(PG8_LAS unsigned char* lds, const Gemm g, const Sched& S, const Epi& E, unsigned long long* stamps) {
    int tid_ = threadIdx.x; asm volatile("" : "+v"(tid_));
    const int tid = tid_, wid = __builtin_amdgcn_readfirstlane(tid >> 6), lane = tid & 63, wr = wid >> 2, wc = wid & 3, fr = lane & 15, fq = lane >> 4;
    const int K = g.K, nt = K / BK;
    int ts_lo = 0, ts_hi = 0, nts = 0; const unsigned long long rt_entry = STAMP ? (unsigned long long)wall_clock64() : 0ull;
#define PG8_STAMP() do { if (STAMP && wid == 0 && nts < 64) { const unsigned long long _c = (unsigned long long)clock64(); \
        ts_lo = (lane == nts) ? (int)(unsigned)_c : ts_lo; ts_hi = (lane == nts) ? (int)(unsigned)(_c >> 32) : ts_hi; ++nts; } } while (0)
    PG8_STAMP();
    unsigned voffA[2], voffB[2];
#pragma unroll
    for (int i = 0; i < 2; ++i) { int R, C; stage_rc(tid * 16 + i * 8192, R, C); const int Rb = Epi::PERM ? ((R & ~31) + perm32(R & 31)) : R;
        voffA[i] = (unsigned)(R * g.lda + C) * 2u; voffB[i] = (unsigned)(Rb * g.ldb + C) * 2u; }
    const size_t kstep = (size_t)(BK * 2);
    const size_t hstepA = (size_t)HALF * g.lda * 2, hstepB = (size_t)HALF * g.ldb * 2;
    const size_t tstepA = 2 * hstepA, tstepB = 2 * hstepB, sstep = (size_t)K * 2;
    const unsigned ldsw = (unsigned)wid * 1024u;
    const int aoff = lds_byte(wr * 64 + fr, fq * 8), boff = lds_byte(wc * 32 + fr, fq * 8);
#define PG8_SA(b, h) (((b) * 2 + (h)) * HTB)
#define PG8_SB(b, h) ((4 + (b) * 2 + (h)) * HTB)
#define PG8_STAGE(bufoff, gbase, voff) do { _Pragma("unroll") for (int _i = 0; _i < 2; ++_i) \
        __builtin_amdgcn_global_load_lds((const unsigned*)((const char*)(gbase) + (voff)[_i]), (PG8_LAS unsigned*)(lds + (bufoff) + ldsw + _i * 8192), 16, 0, 0); } while (0)
#define PG8_LDA(dst, b, h) do { _Pragma("unroll") for (int m = 0; m < 4; ++m) _Pragma("unroll") for (int k = 0; k < 2; ++k) dst[m][k] = *(const PG8_LAS bf16x8*)(lds + PG8_SA(b, h) + aoff + m * 2048 + k * 1024); } while (0)
#define PG8_LDB(dst, b, h) do { _Pragma("unroll") for (int n = 0; n < 2; ++n) _Pragma("unroll") for (int k = 0; k < 2; ++k) dst[n][k] = *(const PG8_LAS bf16x8*)(lds + PG8_SB(b, h) + boff + n * 2048 + k * 1024); } while (0)
#define PG8_MMA(ai, bj, At, Bt) do { __builtin_amdgcn_s_setprio(1); _Pragma("unroll") for (int m = 0; m < 4; ++m) _Pragma("unroll") for (int n = 0; n < 2; ++n) _Pragma("unroll") for (int k = 0; k < 2; ++k) \
        acc[ai][bj][m][n] = __builtin_amdgcn_mfma_f32_16x16x32_bf16(Bt[n][k], At[m][k], acc[ai][bj][m][n], 0, 0, 0); __builtin_amdgcn_s_setprio(0); } while (0)
#define PG8_WAIT_V(n) asm volatile("s_waitcnt vmcnt(" #n ")" ::: "memory")
#define PG8_WAIT_L(n) asm volatile("s_waitcnt lgkmcnt(" #n ")" ::: "memory")
#define PG8_BAR __builtin_amdgcn_s_barrier()
#define PG8_SCHED __builtin_amdgcn_sched_barrier(0)
    Unit cur, nxt; int ui = 0;
    if (!S.next(0, cur)) return;
    f32x4 acc[2][2][4][2];
#pragma unroll
    for (int a = 0; a < 2; ++a)
#pragma unroll
        for (int b = 0; b < 2; ++b)
#pragma unroll
            for (int m = 0; m < 4; ++m)
#pragma unroll
                for (int n = 0; n < 2; ++n) acc[a][b][m][n] = (f32x4){0.f, 0.f, 0.f, 0.f};
    bf16x8 At[4][2], B0[2][2], B1[2][2];
    const char* cA = (const char*)g.A + (size_t)cur.pm * tstepA + (size_t)cur.ks * sstep; const char* cB = (const char*)g.Bt + (size_t)cur.pn * tstepB + (size_t)cur.ks * sstep;
    S.a_ready(cur);
    PG8_STAGE(PG8_SB(0, 0), cB, voffB); PG8_STAGE(PG8_SA(0, 0), cA, voffA); PG8_STAGE(PG8_SB(0, 1), cB + hstepB, voffB); PG8_STAGE(PG8_SA(0, 1), cA + hstepA, voffA);
    if (wr == 1) PG8_BAR;
    PG8_WAIT_V(4); PG8_BAR;
    PG8_STAGE(PG8_SB(1, 0), cB + kstep, voffB); PG8_STAGE(PG8_SA(1, 0), cA + kstep, voffA); PG8_STAGE(PG8_SB(1, 1), cB + hstepB + kstep, voffB);
    PG8_WAIT_V(6); PG8_BAR;
    PG8_STAMP();
    for (;;) {
        const bool has_next = S.next(ui + 1, nxt);
        const char* nA = has_next ? (const char*)g.A + (size_t)nxt.pm * tstepA + (size_t)nxt.ks * sstep : cA; const char* nB = has_next ? (const char*)g.Bt + (size_t)nxt.pn * tstepB + (size_t)nxt.ks * sstep : cB;
        for (int t = 0; t < nt; t += 2) {
            const bool last = (t == nt - 2);
            const char* a1 = cA + (size_t)(t + 1) * kstep;
            const char* a2 = last ? nA : cA + (size_t)(t + 2) * kstep; const char* b2 = last ? nB : cB + (size_t)(t + 2) * kstep;
            const char* a3 = a2 + kstep; const char* b3 = b2 + kstep;
            if (last && has_next) S.a_ready(nxt);
            PG8_LDB(B0, 0, 0); PG8_SCHED; PG8_LDA(At, 0, 0); PG8_STAGE(PG8_SA(1, 1), a1 + hstepA, voffA);
            PG8_WAIT_L(8); PG8_BAR; PG8_WAIT_L(0); PG8_MMA(0, 0, At, B0); PG8_BAR; PG8_SCHED;
            PG8_LDB(B1, 0, 1); PG8_STAGE(PG8_SB(0, 0), b2, voffB);
            PG8_BAR; PG8_WAIT_L(0); PG8_MMA(0, 1, At, B1); PG8_BAR;
            PG8_LDA(At, 0, 1); PG8_STAGE(PG8_SA(0, 0), a2, voffA);
            PG8_BAR; PG8_WAIT_L(0); PG8_MMA(1, 0, At, B0); PG8_BAR; PG8_SCHED;
            PG8_STAGE(PG8_SB(0, 1), b2 + hstepB, voffB);
            PG8_WAIT_V(6); PG8_BAR; PG8_MMA(1, 1, At, B1); PG8_BAR;
            PG8_LDB(B0, 1, 0); PG8_SCHED; PG8_LDA(At, 1, 0); PG8_STAGE(PG8_SA(0, 1), a2 + hstepA, voffA);
            PG8_WAIT_L(8); PG8_BAR; PG8_WAIT_L(0); PG8_MMA(0, 0, At, B0); PG8_BAR; PG8_SCHED;
            PG8_LDB(B1, 1, 1); PG8_STAGE(PG8_SB(1, 0), b3, voffB);
            PG8_BAR; PG8_WAIT_L(0); PG8_MMA(0, 1, At, B1); PG8_BAR;
            PG8_LDA(At, 1, 1); PG8_STAGE(PG8_SA(1, 0), a3, voffA);
            PG8_BAR; PG8_WAIT_L(0); PG8_MMA(1, 0, At, B0); PG8_BAR; PG8_SCHED;
            PG8_STAGE(PG8_SB(1, 1), b3 + hstepB, voffB);
            PG8_WAIT_V(6); PG8_BAR; PG8_MMA(1, 1, At, B1); PG8_BAR;
        }
        PG8_STAMP();
        if constexpr (!Epi::AFTER_DRAIN) { E(acc, cur, wr, wc, fr, fq); S.done(cur); }
        PG8_STAMP();
        if (!has_next) break;
#pragma unroll
        for (int a = 0; a < 2; ++a)
#pragma unroll
            for (int b = 0; b < 2; ++b)
#pragma unroll
                for (int m = 0; m < 4; ++m)
#pragma unroll
                    for (int n = 0; n < 2; ++n) acc[a][b][m][n] = (f32x4){0.f, 0.f, 0.f, 0.f};
        cur = nxt; cA = nA; cB = nB; ++ui;
    }
    PG8_WAIT_V(0);
    if (wr == 0) PG8_BAR;
    PG8_BAR;
    if constexpr (Epi::AFTER_DRAIN) { E.fused(acc, cur, wr, wc, fr, fq, lds, wid, lane); S.done(cur); }
    PG8_STAMP();
    if (STAMP && wid == 0) { stamps[lane] = lane < nts ? (((unsigned long long)(unsigned)ts_hi << 32) | (unsigned)ts_lo) : 0ull;
        if (lane == 62) stamps[62] = rt_entry; if (lane == 63) stamps[63] = (unsigned long long)wall_clock64(); }
#undef PG8_STAMP
#undef PG8_SA
#undef PG8_SB
#undef PG8_STAGE
#undef PG8_LDA
#undef PG8_LDB
#undef PG8_MMA
#undef PG8_WAIT_V
#undef PG8_WAIT_L
#undef PG8_BAR
#undef PG8_SCHED
}
}

#define LAS __attribute__((address_space(3)))
typedef unsigned short bf16_t;
typedef short bf16x8 __attribute__((ext_vector_type(8)));
typedef float f32x4 __attribute__((ext_vector_type(4)));
typedef float f32x2 __attribute__((ext_vector_type(2)));
typedef unsigned u32x4 __attribute__((ext_vector_type(4)));
typedef unsigned u32x2 __attribute__((ext_vector_type(2)));

constexpr int D = 1024, NP = 16384, NS = 512, NTOK = NP + NS, SEQ = 2048, NB = 8, NSB = 128, DEPTH = 4;
constexpr int INW = 2568, NPROJ = 2560, DFF = 2816, NGU = 5632;
constexpr int PC_G = 1536, PC_SSM = 2048, PC_POOL = 2304;
constexpr float EPS = 1e-6f;
constexpr int LDS_BYTES = 163840;

constexpr size_t SZ_WIN = (size_t)NPROJ * D * 2, SZ_WOUT = (size_t)D * D * 2, SZ_WGU = (size_t)NGU * D * 2, SZ_WDN = (size_t)D * DFF * 2;
constexpr size_t SZ_WAB = 8 * D * 4, SZ_GLUT = 256 * 256 * 2, SZ_POOLT = 4 * 64 * 64 * 2, SZ_SSMK = 16 * 64 * 4 * 4, SZ_BBAR = 16 * 64 * 32 * 4;
constexpr size_t WS_WIN = 0;
constexpr size_t WS_WOUT = WS_WIN + DEPTH * SZ_WIN;
constexpr size_t WS_WGU = WS_WOUT + DEPTH * SZ_WOUT;
constexpr size_t WS_WDN = WS_WGU + DEPTH * SZ_WGU;
constexpr size_t WS_WAB = WS_WDN + DEPTH * SZ_WDN;
constexpr size_t WS_GLUT = WS_WAB + DEPTH * SZ_WAB;
constexpr size_t WS_POOLT = WS_GLUT + DEPTH * SZ_GLUT;
constexpr size_t WS_SSMK = WS_POOLT + DEPTH * SZ_POOLT;
constexpr size_t WS_BBAR = WS_SSMK + DEPTH * SZ_SSMK;
constexpr size_t WS_H = WS_BBAR + DEPTH * SZ_BBAR;
constexpr size_t WS_AB = WS_H + (size_t)NTOK * D * 2;
constexpr size_t WS_MIX = WS_AB + (size_t)NTOK * 8 * 4;
constexpr size_t WS_MIXO = WS_MIX + (size_t)NTOK * D * 2;
constexpr size_t WS_SSME = WS_MIXO + (size_t)NTOK * D * 4;
constexpr size_t WS_PROJ = WS_SSME + (size_t)8 * 32 * 16 * 64 * 2 * 4;
constexpr size_t WS_DW = WS_PROJ + (size_t)NTOK * NPROJ * 2;
constexpr size_t WS_DKC = WS_DW + (size_t)1024 * 8192 * 4;
constexpr size_t WS_DQD = WS_DKC + (size_t)1024 * 8192 * 2;
constexpr size_t WS_DQK = WS_DQD + (size_t)1024 * 8192 * 2;
constexpr size_t WS_DKT = WS_DQK + (size_t)1024 * 4096 * 2;
constexpr size_t WS_DGL = WS_DKT + (size_t)1024 * 8192 * 2;
constexpr size_t WS_DGS = WS_DGL + 4096;
constexpr size_t WS_BAR = WS_DGS + (size_t)1024 * 8192 * 2;
constexpr size_t WS_PARTS = WS_BAR + 16384;
constexpr size_t WS_END = WS_PARTS + (size_t)11 * 512 * 1024 * 4;
constexpr size_t WS_HID = WS_PROJ;
static_assert(WS_HID + (size_t)NTOK * DFF * 2 <= WS_END, "HID overlay");
static_assert(WS_H % 256 == 0 && WS_PROJ % 256 == 0 && WS_DW % 256 == 0, "align");

constexpr size_t O_YP = 0, O_YS = O_YP + (size_t)NP * D, O_DP = O_YS + (size_t)NS * D, O_CP = O_DP + (size_t)DEPTH * 8 * 4 * 16384,
                 O_REP = O_CP + (size_t)DEPTH * 8 * 3 * 1536, O_IMP = O_REP + (size_t)DEPTH * 8 * 1024, O_PP = O_IMP + (size_t)DEPTH * 8 * 1024,
                 O_DS = O_PP + (size_t)DEPTH * 8 * 15 * 256, O_CS = O_DS + (size_t)DEPTH * 128 * 4 * 16384, O_RES = O_CS + (size_t)DEPTH * 128 * 3 * 1536,
                 O_IMS = O_RES + (size_t)DEPTH * 128 * 1024, O_PS = O_IMS + (size_t)DEPTH * 128 * 1024, O_END = O_PS + (size_t)DEPTH * 128 * 15 * 256;

struct Args { const float* in[32]; float* out; unsigned char* ws; int ph_lo, ph_hi; };
typedef const float* cfp_t;
typedef __attribute__((address_space(4))) const unsigned char* kptr_t;
struct InProxy { __device__ __forceinline__ const float* operator[](int i) const {
    kptr_t p = (kptr_t)__builtin_amdgcn_kernarg_segment_ptr(); asm volatile("" : "+s"(p)); return *(__attribute__((address_space(4))) const cfp_t*)(p + 8 * i); } };
struct DevArgs { InProxy in; float* out; unsigned char* ws; int ph_lo, ph_hi; };
enum { I_XP = 0, I_XS, I_SDELTA, I_SCONV, I_SRE, I_SIM, I_SPOOL, I_NMPRE, I_NMPOST, I_NFPRE, I_NFPOST, I_WIN, I_CONVW, I_ALOG, I_DTB, I_ONORM,
       I_ARE, I_AIM, I_LOGDT, I_BRE, I_BIM, I_CRE, I_CIM, I_SSMD, I_GLUW, I_GLUB, I_POOLW, I_POOLS, I_WOUT, I_WG, I_WU, I_WD };

__device__ __forceinline__ unsigned f2bf(float f) { unsigned u = __float_as_uint(f); return (u + 0x7fffu + ((u >> 16) & 1u)) >> 16; }
__device__ __forceinline__ float bf2f(unsigned b) { return __uint_as_float(b << 16); }
__device__ __forceinline__ unsigned pk2(float lo, float hi) { return f2bf(lo) | (f2bf(hi) << 16); }
template <int CTRL> __device__ __forceinline__ float dpp_f(float v) { return __builtin_bit_cast(float, __builtin_amdgcn_update_dpp(0, __builtin_bit_cast(int, v), CTRL, 0xF, 0xF, true)); }
__device__ __forceinline__ float row_sum8(float v) { v += dpp_f<0xB1>(v); v += dpp_f<0x4E>(v); v += dpp_f<0x141>(v); return v; }
__device__ __forceinline__ float row_sum16(float v) { v = row_sum8(v); v += dpp_f<0x140>(v); return v; }
__device__ __forceinline__ float wave_sum(float v) { v = row_sum16(v); v += __shfl_xor(v, 16); v += __shfl_xor(v, 32); return v; }
__device__ __forceinline__ float silu_f(float y) { return y * __builtin_amdgcn_rcpf(1.f + __expf(-y)); }
__device__ __forceinline__ float sigmoid_f(float y) { return __builtin_amdgcn_rcpf(1.f + __expf(-y)); }
__device__ __forceinline__ float gelu_tanh_f(float x) { const float z = 0.7978845608028654f * (x + 0.044715f * x * x * x);
    const float t = 1.f - 2.f * __builtin_amdgcn_rcpf(1.f + __expf(2.f * z)); return 0.5f * x * (1.f + t); }
__device__ __forceinline__ f32x4 mfma16(bf16x8 a, bf16x8 b, f32x4 c) { return __builtin_amdgcn_mfma_f32_16x16x32_bf16(a, b, c, 0, 0, 0); }
#define LDS_FENCE() asm volatile("s_waitcnt lgkmcnt(0)" ::: "memory")

struct EpiSwiGLU {
    static constexpr bool PERM = false, AFTER_DRAIN = false;
    bf16_t* O; int ldc;
    __device__ __forceinline__ void operator()(const pg8::f32x4 (&acc)[2][2][4][2], const pg8::Unit& u, int wr, int wc, int fr, int fq) const {
        const int row0 = u.pm * 256 + wr * 64 + fr, hid0 = u.pn * 128 + wc * 16 + 4 * fq;
#pragma unroll
        for (int ai = 0; ai < 2; ++ai)
#pragma unroll
            for (int m = 0; m < 4; ++m) { bf16_t* rowp = O + (size_t)(row0 + ai * 128 + m * 16) * ldc + hid0;
#pragma unroll
                for (int bj = 0; bj < 2; ++bj) { const pg8::f32x4 g = acc[ai][bj][m][0], v = acc[ai][bj][m][1];
                    u32x2 w; w.x = pg8::cvt_pk_bf16(silu_f(g[0]) * v[0], silu_f(g[1]) * v[1]); w.y = pg8::cvt_pk_bf16(silu_f(g[2]) * v[2], silu_f(g[3]) * v[3]);
                    *(u32x2*)(rowp + bj * 64) = w; } }
    }
};

#define XB_TMO      128
#define XB_XCNT(j)  (256  + 64 * (j))
#define XB_XSUB(j)  (1280 + 64 * (j))
#define XB_XGEN(j)  (2304 + 64 * (j))
#define XB_TOP      3328
#define XB_TOPGEN   3392
#define XCD_BAR_WORDS 3456
#define XB_SPIN_CAP (1u << 18)

__device__ __forceinline__ unsigned xb_ld(unsigned* p)              { return __hip_atomic_load(p, __ATOMIC_RELAXED, __HIP_MEMORY_SCOPE_AGENT); }
__device__ __forceinline__ unsigned xb_add(unsigned* p, unsigned v) { return __hip_atomic_fetch_add(p, v, __ATOMIC_RELAXED, __HIP_MEMORY_SCOPE_AGENT); }
__device__ __forceinline__ unsigned xb_xcc_id() { return (unsigned)__builtin_amdgcn_s_getreg((3 << 11) | 20) & 0xFu; }
#define XB_SPIN(cond, bar) do { unsigned _sp = 0; while (cond) { __builtin_amdgcn_s_sleep(1); \
    if ((++_sp & 255u) == 0u) { if (xb_ld(&(bar)[XB_TMO])) break; if (_sp > XB_SPIN_CAP) { atomicAdd(&(bar)[XB_TMO], 1u); break; } } } } while (0)

struct XcdBarrier {
    unsigned* bar; unsigned x;
    volatile LAS unsigned* st;
};

__device__ __forceinline__ XcdBarrier xcd_barrier_post(unsigned* bar, volatile LAS unsigned* st) {
    XcdBarrier b; b.bar = bar; b.x = xb_xcc_id(); b.st = st;
    if (threadIdx.x == 0) (void)xb_add(&bar[XB_XCNT(b.x)], 1u);
    return b;
}
__device__ __forceinline__ void xcd_barrier_complete(unsigned* bar, unsigned x, unsigned& nloc, unsigned& nx) {
    const unsigned G = gridDim.x * gridDim.y * gridDim.z;
    unsigned sum, cnt, mine, sp = 0u;
    for (;;) {
        sum = 0u; cnt = 0u; mine = 0u;
#pragma unroll
        for (unsigned j = 0; j < 16; ++j) { const unsigned c = xb_ld(&bar[XB_XCNT(j)]); sum += c; cnt += (c > 0u) ? 1u : 0u; mine = (j == x) ? c : mine; }
        if (sum == G) break;
        __builtin_amdgcn_s_sleep(1);
        if ((++sp & 255u) == 0u) { if (xb_ld(&bar[XB_TMO])) break; if (sp > XB_SPIN_CAP) { atomicAdd(&bar[XB_TMO], 1u); break; } }
    }
    nloc = mine > 0u ? mine : 1u; nx = cnt > 0u ? cnt : 1u;
}

__device__ __forceinline__ void xcd_barrier(const XcdBarrier& b) {
    asm volatile("s_waitcnt vmcnt(0)" ::: "memory");
    __syncthreads();
    if (threadIdx.x == 0) {
        unsigned* bar = b.bar; asm volatile("" : "+s"(bar));
        __builtin_amdgcn_s_waitcnt(0);
        unsigned nloc = b.st[0], nx = b.st[1];
        if (nloc == 0u) { xcd_barrier_complete(bar, b.x, nloc, nx); b.st[0] = nloc; b.st[1] = nx; }
        const unsigned old = xb_add(&bar[XB_XSUB(b.x)], 1u);
        const unsigned gen = old / nloc;
        if (old + 1u == (gen + 1u) * nloc) {
            __builtin_amdgcn_fence(__ATOMIC_RELEASE, "agent");
            asm volatile("s_waitcnt vmcnt(0)" ::: "memory");
            const unsigned og = xb_add(&bar[XB_TOP], 1u);
            const unsigned tg = og / nx;
            if (og + 1u == (tg + 1u) * nx) xb_add(&bar[XB_TOPGEN], 1u);
            else XB_SPIN(xb_ld(&bar[XB_TOPGEN]) == tg, bar);
            __builtin_amdgcn_fence(__ATOMIC_ACQUIRE, "agent");
            xb_add(&bar[XB_XGEN(b.x)], 1u);
            asm volatile("s_waitcnt vmcnt(0)" ::: "memory");
        } else {
            XB_SPIN(xb_ld(&bar[XB_XGEN(b.x)]) == gen, bar);
            __builtin_amdgcn_fence(__ATOMIC_ACQUIRE, "agent");
            asm volatile("s_waitcnt vmcnt(0)" ::: "memory");
        }
    }
    __syncthreads();
}

struct SliceOrder {
    int nunits, G, c;
    __device__ __forceinline__ bool next(int i, pg8::Unit& u) const { const int L = i * G + c; if (L >= nunits) return false; const int t = L & 7; u.pm = t >> 2; u.pn = t & 3; u.ks = L >> 3; return true; }
    __device__ __forceinline__ void a_ready(const pg8::Unit&) const {}
    __device__ __forceinline__ void done(const pg8::Unit&) const {}
};
struct EpiF32Part {
    static constexpr bool PERM = false, AFTER_DRAIN = false;
    float* C;
    __device__ __forceinline__ void operator()(const pg8::f32x4 (&acc)[2][2][4][2], const pg8::Unit& u, int wr, int wc, int fr, int fq) const {
        const int row0 = u.pm * 256 + wr * 64 + fr, col0 = u.pn * 256 + wc * 32 + 4 * fq; float* base = C + (size_t)u.ks * (512 * 1024);
#pragma unroll
        for (int ai = 0; ai < 2; ++ai)
#pragma unroll
            for (int m = 0; m < 4; ++m) { float* rowp = base + (size_t)(row0 + ai * 128 + m * 16) * 1024 + col0;
#pragma unroll
                for (int bj = 0; bj < 2; ++bj)
#pragma unroll
                    for (int n = 0; n < 2; ++n) *(pg8::f32x4*)(rowp + bj * 128 + n * 16) = acc[ai][bj][m][n]; }
    }
};

struct SrcIn { const float* w; __device__ __forceinline__ float operator()(int k, int n) const { return w[(size_t)k * INW + (n < 1536 ? n : n + 8)]; } };
struct SrcPlain { const float* w; int N; __device__ __forceinline__ float operator()(int k, int n) const { return w[(size_t)k * N + n]; } };
struct SrcGU { const float* g; const float* u; __device__ __forceinline__ float operator()(int k, int n) const { const int r = n & 31, hid = (n >> 5) * 16 + (r & 15); const long long du = (r < 16) ? 0ll : (long long)(u - g); return g[du + (long long)k * DFF + hid]; } };
template <class Src> __device__ __forceinline__ void transpose_item(const Src& src, int K, bf16_t* WT, int nblk, LAS float* scr, int item, int lane) {
    const int kb = item / nblk, nb = item % nblk, k0 = 64 * kb, n0 = 32 * nb;
#pragma unroll 8
    for (int i = 0; i < 32; ++i) { const int kk = 2 * i + (lane >> 5); scr[kk * 33 + (lane & 31)] = src(k0 + kk, n0 + (lane & 31)); }
    LDS_FENCE();
    const int c = lane & 7;
#pragma unroll
    for (int j = 0; j < 4; ++j) { const int n = (lane >> 3) + 8 * j; const LAS float* s = scr + (8 * c) * 33 + n;
        u32x4 o; o.x = pk2(s[0 * 33], s[1 * 33]); o.y = pk2(s[2 * 33], s[3 * 33]); o.z = pk2(s[4 * 33], s[5 * 33]); o.w = pk2(s[6 * 33], s[7 * 33]);
        *(u32x4*)(WT + (size_t)(n0 + n) * K + k0 + 8 * c) = o; }
    LDS_FENCE();
}

__device__ __forceinline__ void norm_rows(const float* T, const float* wt, const float* X0, const float* X1, float* Xout, const float* wh, bf16_t* H,
                                          const float* Wab, float* AB, int gw, int NGW, int lane, const float* Tp = nullptr, int ns = 0) {
#pragma unroll 1
    for (int m = gw; m < NTOK; m += NGW) {
        f32x4 x[4], t[4];
        { const float* xr = (X1 && m >= NP) ? X1 + (size_t)(m - NP) * D : X0 + (size_t)m * D;
#pragma unroll
          for (int j = 0; j < 4; ++j) x[j] = ((const f32x4*)xr)[lane + 64 * j];
          if (T && !(Tp && m >= NP)) {
#pragma unroll
              for (int j = 0; j < 4; ++j) { const u32x2 tb = ((const u32x2*)((const bf16_t*)T + (size_t)m * D))[lane + 64 * j];
                  t[j] = (f32x4){__uint_as_float(tb.x << 16), __uint_as_float(tb.x & 0xffff0000u), __uint_as_float(tb.y << 16), __uint_as_float(tb.y & 0xffff0000u)}; } } }
        if (T) {
            float ss = 0.f;
            if (Tp && m >= NP) {
#pragma unroll
                for (int j = 0; j < 4; ++j) { f32x4 a = {0.f, 0.f, 0.f, 0.f}; for (int q = 0; q < ns; ++q) a += ((const f32x4*)(Tp + (size_t)q * (512 * 1024) + (size_t)(m - NP) * D))[lane + 64 * j]; t[j] = a; } }
#pragma unroll
            for (int j = 0; j < 4; ++j) ss += (t[j].x * t[j].x + t[j].y * t[j].y) + (t[j].z * t[j].z + t[j].w * t[j].w);
            ss = wave_sum(ss); const float r = rsqrtf(ss * (1.f / D) + EPS);
#pragma unroll
            for (int j = 0; j < 4; ++j) { const f32x4 w = ((const f32x4*)wt)[lane + 64 * j]; x[j] += t[j] * r * w; }
        }
        if (Xout) {
#pragma unroll
            for (int j = 0; j < 4; ++j) ((f32x4*)(Xout + (size_t)m * D))[lane + 64 * j] = x[j];
        }
        if (H) {
            float ss = 0.f;
#pragma unroll
            for (int j = 0; j < 4; ++j) ss += (x[j].x * x[j].x + x[j].y * x[j].y) + (x[j].z * x[j].z + x[j].w * x[j].w);
            ss = wave_sum(ss); const float r = rsqrtf(ss * (1.f / D) + EPS);
            f32x4 hv[4];
#pragma unroll
            for (int j = 0; j < 4; ++j) { const f32x4 w = ((const f32x4*)wh)[lane + 64 * j]; hv[j] = x[j] * r * w;
                u32x2 o; o.x = pk2(hv[j].x, hv[j].y); o.y = pk2(hv[j].z, hv[j].w); ((u32x2*)(H + (size_t)m * D))[lane + 64 * j] = o; }
            if (Wab) {
                float d[8];
#pragma unroll
                for (int c = 0; c < 8; ++c) { float dd = 0.f;
#pragma unroll
                    for (int j = 0; j < 4; ++j) { const f32x4 w = ((const f32x4*)(Wab + c * D))[lane + 64 * j]; dd += (hv[j].x * w.x + hv[j].y * w.y) + (hv[j].z * w.z + hv[j].w * w.w); }
                    d[c] = dd; }
#pragma unroll
                for (int c = 0; c < 8; ++c) d[c] = row_sum16(d[c]);
#pragma unroll
                for (int o = 16; o < 64; o <<= 1) {
#pragma unroll
                    for (int c = 0; c < 8; ++c) d[c] += __shfl_xor(d[c], o); }
                if (lane == 0) { f32x4 o0 = {d[0], d[1], d[2], d[3]}, o1 = {d[4], d[5], d[6], d[7]}; *(f32x4*)(AB + (size_t)m * 8) = o0; *(f32x4*)(AB + (size_t)m * 8 + 4) = o1; }
            }
        }
    }
}

__device__ __forceinline__ void norm_rows_pf(const float* T, const float* wt, const float* X0, const float* X1, float* Xout, const float* wh, bf16_t* H,
                                             int gw, int NGW, int lane, const float* Tp, int ns) {
    f32x4 xn[4]; u32x2 tn[4];
#define NR_LOAD(mm) do { const int _m = (mm); const float* _xr = (X1 && _m >= NP) ? X1 + (size_t)(_m - NP) * D : X0 + (size_t)_m * D; \
        _Pragma("unroll") for (int j = 0; j < 4; ++j) xn[j] = ((const f32x4*)_xr)[lane + 64 * j]; \
        if (_m < NP) { _Pragma("unroll") for (int j = 0; j < 4; ++j) tn[j] = ((const u32x2*)((const bf16_t*)T + (size_t)_m * D))[lane + 64 * j]; } } while (0)
    if (gw < NTOK) NR_LOAD(gw);
#pragma unroll 1
    for (int m = gw; m < NTOK; m += NGW) {
        f32x4 x[4], t[4];
#pragma unroll
        for (int j = 0; j < 4; ++j) { x[j] = xn[j]; t[j] = (f32x4){__uint_as_float(tn[j].x << 16), __uint_as_float(tn[j].x & 0xffff0000u), __uint_as_float(tn[j].y << 16), __uint_as_float(tn[j].y & 0xffff0000u)}; }
        if (m + NGW < NTOK) NR_LOAD(m + NGW);
        if (m >= NP) {
#pragma unroll
            for (int j = 0; j < 4; ++j) { f32x4 a = {0.f, 0.f, 0.f, 0.f}; for (int q = 0; q < ns; ++q) a += ((const f32x4*)(Tp + (size_t)q * (512 * 1024) + (size_t)(m - NP) * D))[lane + 64 * j]; t[j] = a; } }
        float ss = 0.f;
#pragma unroll
        for (int j = 0; j < 4; ++j) ss += (t[j].x * t[j].x + t[j].y * t[j].y) + (t[j].z * t[j].z + t[j].w * t[j].w);
        ss = wave_sum(ss); const float r = rsqrtf(ss * (1.f / D) + EPS);
#pragma unroll
        for (int j = 0; j < 4; ++j) { const f32x4 w = ((const f32x4*)wt)[lane + 64 * j]; x[j] += t[j] * r * w; }
#pragma unroll
        for (int j = 0; j < 4; ++j) ((f32x4*)(Xout + (size_t)m * D))[lane + 64 * j] = x[j];
        float s2 = 0.f;
#pragma unroll
        for (int j = 0; j < 4; ++j) s2 += (x[j].x * x[j].x + x[j].y * x[j].y) + (x[j].z * x[j].z + x[j].w * x[j].w);
        s2 = wave_sum(s2); const float r2 = rsqrtf(s2 * (1.f / D) + EPS);
#pragma unroll
        for (int j = 0; j < 4; ++j) { const f32x4 w = ((const f32x4*)wh)[lane + 64 * j]; const f32x4 hv = x[j] * r2 * w;
            u32x2 o; o.x = pk2(hv.x, hv.y); o.y = pk2(hv.z, hv.w); ((u32x2*)(H + (size_t)m * D))[lane + 64 * j] = o; }
    }
#undef NR_LOAD
}

__device__ __forceinline__ void prologue(const DevArgs& A, LAS unsigned char* lds, int wave, int lane, int gw, int NGW) {
    LAS float* scr = (LAS float*)(lds + wave * 8704);
    constexpr int I_IN = 16 * 80, I_OUT = 16 * 32, I_GU = 16 * 176, I_DN = 44 * 32, I_GLU = 4 * 8, I_POOL = 8, PER = I_IN + I_OUT + I_GU + I_DN + I_GLU + I_POOL;
#pragma unroll 1
    for (int it = gw; it < DEPTH * PER; it += NGW) {
        const int l = it / PER; int r = it % PER;
        if (r < I_IN) { SrcIn s{A.in[I_WIN] + (size_t)l * D * INW}; transpose_item(s, D, (bf16_t*)(A.ws + WS_WIN + l * SZ_WIN), NPROJ / 32, scr, r, lane); continue; } r -= I_IN;
        if (r < I_OUT) { SrcPlain s{A.in[I_WOUT] + (size_t)l * D * D, D}; transpose_item(s, D, (bf16_t*)(A.ws + WS_WOUT + l * SZ_WOUT), D / 32, scr, r, lane); continue; } r -= I_OUT;
        if (r < I_GU) { SrcGU s{A.in[I_WG] + (size_t)l * D * DFF, A.in[I_WU] + (size_t)l * D * DFF}; transpose_item(s, D, (bf16_t*)(A.ws + WS_WGU + l * SZ_WGU), NGU / 32, scr, r, lane); continue; } r -= I_GU;
        if (r < I_DN) { SrcPlain s{A.in[I_WD] + (size_t)l * DFF * D, D}; transpose_item(s, DFF, (bf16_t*)(A.ws + WS_WDN + l * SZ_WDN), D / 32, scr, r, lane); continue; } r -= I_DN;
        if (r < I_GLU) { SrcPlain s{A.in[I_GLUW] + (size_t)l * 65536, 256}; transpose_item(s, 256, (bf16_t*)(A.ws + WS_GLUT + l * SZ_GLUT), 8, scr, r, lane); continue; } r -= I_GLU;
        { const int g = r >> 1; SrcPlain s{A.in[I_POOLW] + (size_t)(l * 4 + g) * 4096, 64}; transpose_item(s, 64, (bf16_t*)(A.ws + WS_POOLT + l * SZ_POOLT) + g * 4096, 2, scr, r & 1, lane); }
    }
    const int gt = gw * 64 + lane, NT = NGW * 64;
    float* wab = (float*)(A.ws + WS_WAB);
#pragma unroll 1
    for (int i = gt; i < DEPTH * 8 * D; i += NT) { const int l = i / (8 * D), j = (i / D) & 7, k = i % D; wab[i] = A.in[I_WIN][((size_t)l * D + k) * INW + 1536 + j]; }
    float* ssmk = (float*)(A.ws + WS_SSMK); float* bbar = (float*)(A.ws + WS_BBAR);
#pragma unroll 1
    for (int i = gt; i < DEPTH * 16 * 64; i += NT) {
        const int lg = i >> 6;
        const float dt = expf(A.in[I_LOGDT][lg]), ar = A.in[I_ARE][i], ai = A.in[I_AIM][i];
        const float mag = expf(ar * dt);
        float rev = ai * dt * 0.15915494309189535f; rev -= floorf(rev);
        const float sn = __builtin_amdgcn_sinf(rev), cs = __builtin_amdgcn_cosf(rev);
        const float lr = mag * cs, li = mag * sn;
        float pr = lr, pi = li;
#pragma unroll
        for (int q = 0; q < 6; ++q) { const float nr2 = pr * pr - pi * pi, ni2 = 2.f * pr * pi; pr = nr2; pi = ni2; }
        ssmk[i * 4 + 0] = lr; ssmk[i * 4 + 1] = li; ssmk[i * 4 + 2] = pr; ssmk[i * 4 + 3] = pi;
        const float nr = lr - 1.f, ni = li, d2 = ar * ar + ai * ai;
        const float cre = (nr * ar + ni * ai) / d2, cim = (ni * ar - nr * ai) / d2;
#pragma unroll
        for (int h = 0; h < 16; ++h) { const float br = A.in[I_BRE][(size_t)i * 16 + h], bi = A.in[I_BIM][(size_t)i * 16 + h];
            bbar[(size_t)i * 32 + h] = cre * br - cim * bi; bbar[(size_t)i * 32 + 16 + h] = cre * bi + cim * br; }
    }
}

__device__ __forceinline__ unsigned bfmul2(unsigned pk, float f0, float f1) { return pg8::cvt_pk_bf16(__uint_as_float(pk << 16) * f0, __uint_as_float(pk & 0xffff0000u) * f1); }
__device__ __forceinline__ void delta_prep_item(const DevArgs& A, int l, LAS unsigned char* lds, int item, int tid, int wave, int lane) {
    asm volatile("" : "+v"(tid)); lane = tid & 63; wave = __builtin_amdgcn_readfirstlane(tid >> 6);
    const int bh = item >> 5, n = item & 31, b = bh >> 2, h = bh & 3;
    const int tok0 = b * SEQ + n * 64;
    LAS bf16_t* QS = (LAS bf16_t*)(lds); LAS bf16_t* KS = (LAS bf16_t*)(lds + 17408);
    LAS unsigned char* KT = lds + 34816; LAS unsigned char* VT = lds + 53248; LAS unsigned char* RTK = lds + 71680;
    LAS float* AM = (LAS float*)(lds + 90112); LAS float* PM = (LAS float*)(lds + 107520); LAS float* PSC = PM; LAS float* TM = (LAS float*)(lds + 124928);
    LAS unsigned char* TB = lds + 142336;
    LAS float* GAM = (LAS float*)(lds + 151552); LAS float* BETA = GAM + 64; LAS float* RQ = GAM + 128; LAS float* RK = GAM + 192;
    LAS float* F2 = GAM + 256; LAS float* F3 = GAM + 320; LAS float* F4 = GAM + 384;
    const bf16_t* PROJ = (const bf16_t*)(A.ws + WS_PROJ);
    const float* AB = (const float*)(A.ws + WS_AB);
    u32x4 gv[2];
#pragma unroll
    for (int j = 0; j < 2; ++j) { const int id = tid + 512 * j; gv[j] = *(const u32x4*)(PROJ + (size_t)(tok0 + (id >> 4)) * NPROJ + PC_G + h * 128 + (id & 15) * 8); }
    if (tid < 384) {
        const int part = tid >> 7, c = tid & 127, col = part * 512 + h * 128 + c;
        const float* cw = A.in[I_CONVW] + (size_t)l * 4 * 1536;
        const float w0 = cw[col], w1 = cw[1536 + col], w2 = cw[3072 + col], w3 = cw[4608 + col];
        const bf16_t* pp = PROJ + (size_t)tok0 * NPROJ + col;
        float xr[67];
#pragma unroll
        for (int t = 0; t < 67; ++t) xr[t] = (n > 0 || t >= 3) ? bf2f(pp[(long)(t - 3) * NPROJ]) : 0.f;
        unsigned pk[32];
#pragma unroll
        for (int t = 0; t < 64; t += 2) {
            const float s0 = silu_f(w0 * xr[t] + w1 * xr[t + 1] + w2 * xr[t + 2] + w3 * xr[t + 3]);
            const float s1 = silu_f(w0 * xr[t + 1] + w1 * xr[t + 2] + w2 * xr[t + 3] + w3 * xr[t + 4]);
            pk[t >> 1] = pg8::cvt_pk_bf16(s0, s1);
        }
        if (part < 2) { LAS bf16_t* dst = (part == 0 ? QS : KS) + c;
#pragma unroll
            for (int t = 0; t < 64; t += 2) { dst[t * 136] = (bf16_t)(pk[t >> 1] & 0xffffu); dst[(t + 1) * 136] = (bf16_t)(pk[t >> 1] >> 16); } }
        if (part > 0) { LAS unsigned char* dst = (part == 1 ? KT : VT) + c * 144;
#pragma unroll
            for (int q = 0; q < 8; ++q) { u32x4 o; o.x = pk[4 * q]; o.y = pk[4 * q + 1]; o.z = pk[4 * q + 2]; o.w = pk[4 * q + 3]; *(LAS u32x4*)(dst + q * 16) = o; } }
    } else if (tid < 448) {
        const int t = tid - 384;
        const float a = AB[(size_t)(tok0 + t) * 8 + h], bb = AB[(size_t)(tok0 + t) * 8 + 4 + h];
        const float xx = a + A.in[I_DTB][l * 4 + h];
        const float sp = xx > 20.f ? xx : log1pf(expf(xx));
        float lg = -expf(A.in[I_ALOG][l * 4 + h]) * sp;
#pragma unroll
        for (int off = 1; off < 64; off <<= 1) { const float v = __shfl_up(lg, off); if (lane >= off) lg += v; }
        GAM[t] = lg; BETA[t] = 1.f / (1.f + expf(-bb));
    }
    __syncthreads();
    {
        const int t = tid >> 3, part = tid & 7; float sq = 0.f, sk = 0.f;
#pragma unroll
        for (int j = 0; j < 16; ++j) { const float q = bf2f(QS[t * 136 + part * 16 + j]), k = bf2f(KS[t * 136 + part * 16 + j]); sq += q * q; sk += k * k; }
        sq = row_sum8(sq); sk = row_sum8(sk);
        if (part == 0) { const float rq = rsqrtf(sq + EPS) * 0.08838834764831845f, rk = rsqrtf(sk + EPS), g = GAM[t], eg = __expf(g), bt = BETA[t];
            RQ[t] = rq; RK[t] = rk; F2[t] = bt * eg * rk; F3[t] = rk * __expf(GAM[63] - g); F4[t] = rq * eg; }
    }
    {
        const int prod = wave >> 2, mt = wave & 3, fr = lane & 15, quad = lane >> 4;
        LAS bf16_t* Aop = prod ? QS : KS; LAS float* dst = prod ? PM : AM;
        bf16x8 a[4];
#pragma unroll
        for (int kk = 0; kk < 4; ++kk) a[kk] = *(LAS bf16x8*)(Aop + (mt * 16 + fr) * 136 + kk * 32 + quad * 8);
#pragma unroll
        for (int nt = 0; nt < 4; ++nt) { f32x4 acc = {0.f, 0.f, 0.f, 0.f};
#pragma unroll
            for (int kk = 0; kk < 4; ++kk) { const bf16x8 bq = *(LAS bf16x8*)(KS + (nt * 16 + fr) * 136 + kk * 32 + quad * 8); acc = mfma16(a[kk], bq, acc); }
#pragma unroll
            for (int i = 0; i < 4; ++i) dst[(mt * 16 + quad * 4 + i) * 68 + nt * 16 + fr] = acc[i]; }
    }
    __syncthreads();
    {
        const int t = tid >> 3, s8 = (tid & 7) * 8; const float gt = GAM[t], bk = BETA[t] * RK[t], rqt = RQ[t];
        float av[8], pv[8];
#pragma unroll
        for (int j = 0; j < 8; ++j) { const int s = s8 + j; const float rks = RK[s]; const float dec = (s <= t) ? __expf(gt - GAM[s]) * rks : 0.f;
            av[j] = (s < t) ? bk * dec * AM[t * 68 + s] : 0.f; pv[j] = rqt * dec * PM[t * 68 + s]; }
#pragma unroll
        for (int j = 0; j < 8; ++j) AM[t * 68 + s8 + j] = av[j];
        u32x4 o; o.x = pg8::cvt_pk_bf16(pv[0], pv[1]); o.y = pg8::cvt_pk_bf16(pv[2], pv[3]); o.z = pg8::cvt_pk_bf16(pv[4], pv[5]); o.w = pg8::cvt_pk_bf16(pv[6], pv[7]);
        *(u32x4*)((bf16_t*)(A.ws + WS_DQK) + (size_t)item * 4096 + t * 64 + s8) = o;
        for (int e = tid; e < 64 * 68; e += 512) TM[e] = 0.f;
        if (tid == 0) ((float*)(A.ws + WS_DGL))[item] = __expf(GAM[63]);
    }
    __syncthreads();
    if (wave == 0) {
        const int i = lane >> 4, c = lane & 15;
        LAS float* amp = AM + (16 * i) * 68 + 16 * i; asm volatile("" : "+v"(amp));
        float x[16];
#pragma unroll
        for (int r = 0; r < 16; ++r) { float acc = (r == c) ? 1.f : 0.f;
#pragma unroll
            for (int s = 0; s < r; ++s) acc = fmaf(-amp[r * 68 + s], x[s], acc);
            x[r] = acc; }
        LAS float* tmp = TM + (16 * i) * 68 + 16 * i + c;
#pragma unroll
        for (int r = 0; r < 16; ++r) tmp[r * 68] = x[r];
    } else {
        const int wt = tid - 64;
        for (int id = wt; id < 1024; id += 448) {
            const int c = id >> 3, t8 = (id & 7) * 8;
            const f32x4 b0 = *(LAS f32x4*)(BETA + t8), b1 = *(LAS f32x4*)(BETA + t8 + 4);
            u32x4 v = *(LAS u32x4*)(VT + c * 144 + t8 * 2);
            v.x = bfmul2(v.x, b0[0], b0[1]); v.y = bfmul2(v.y, b0[2], b0[3]); v.z = bfmul2(v.z, b1[0], b1[1]); v.w = bfmul2(v.w, b1[2], b1[3]);
            *(LAS u32x4*)(VT + c * 144 + t8 * 2) = v;
            const f32x4 f20 = *(LAS f32x4*)(F2 + t8), f21 = *(LAS f32x4*)(F2 + t8 + 4), f30 = *(LAS f32x4*)(F3 + t8), f31 = *(LAS f32x4*)(F3 + t8 + 4);
            const u32x4 k = *(LAS u32x4*)(KT + c * 144 + t8 * 2);
            u32x4 rk; rk.x = bfmul2(k.x, f20[0], f20[1]); rk.y = bfmul2(k.y, f20[2], f20[3]); rk.z = bfmul2(k.z, f21[0], f21[1]); rk.w = bfmul2(k.w, f21[2], f21[3]);
            *(LAS u32x4*)(RTK + c * 144 + t8 * 2) = rk;
            u32x4 kd; kd.x = bfmul2(k.x, f30[0], f30[1]); kd.y = bfmul2(k.y, f30[2], f30[3]); kd.z = bfmul2(k.z, f31[0], f31[1]); kd.w = bfmul2(k.w, f31[2], f31[3]);
            *(u32x4*)((bf16_t*)(A.ws + WS_DKT) + (size_t)item * 8192 + c * 64 + t8) = kd; }
        for (int id = wt; id < 1024; id += 448) {
            const int t = id >> 4, c8 = (id & 15) * 8; const float f = F4[t];
            u32x4 q = *(LAS u32x4*)((LAS unsigned char*)QS + t * 272 + c8 * 2);
            q.x = bfmul2(q.x, f, f); q.y = bfmul2(q.y, f, f); q.z = bfmul2(q.z, f, f); q.w = bfmul2(q.w, f, f);
            *(u32x4*)((bf16_t*)(A.ws + WS_DQD) + (size_t)item * 8192 + t * 128 + c8) = q; }
    }
    {
        const int c8 = (tid & 15) * 8; const float* on = A.in[I_ONORM] + l * 128 + c8;
        const f32x4 o0 = *(const f32x4*)on, o1 = *(const f32x4*)(on + 4);
#pragma unroll
        for (int j = 0; j < 2; ++j) { const int id = tid + 512 * j; const u32x4 g = gv[j]; u32x4 o;
            o.x = pg8::cvt_pk_bf16(silu_f(__uint_as_float(g.x << 16)) * o0[0], silu_f(__uint_as_float(g.x & 0xffff0000u)) * o0[1]);
            o.y = pg8::cvt_pk_bf16(silu_f(__uint_as_float(g.y << 16)) * o0[2], silu_f(__uint_as_float(g.y & 0xffff0000u)) * o0[3]);
            o.z = pg8::cvt_pk_bf16(silu_f(__uint_as_float(g.z << 16)) * o1[0], silu_f(__uint_as_float(g.z & 0xffff0000u)) * o1[1]);
            o.w = pg8::cvt_pk_bf16(silu_f(__uint_as_float(g.w << 16)) * o1[2], silu_f(__uint_as_float(g.w & 0xffff0000u)) * o1[3]);
            *(u32x4*)((bf16_t*)(A.ws + WS_DGS) + (size_t)item * 8192 + (id >> 4) * 128 + c8) = o; }
    }
    __syncthreads();
    const int p2 = tid >> 8, r2 = (tid >> 4) & 15, c2 = tid & 15, rb = p2 ? 48 : 16, cb = p2 ? 32 : 0;
    {
        float acc = 0.f;
#pragma unroll
        for (int s = 0; s < 16; ++s) acc = fmaf(AM[(rb + r2) * 68 + cb + s], TM[(cb + s) * 68 + cb + c2], acc);
        PSC[(p2 * 16 + r2) * 68 + c2] = acc; }
    __syncthreads();
    {
        float acc = 0.f;
#pragma unroll
        for (int s = 0; s < 16; ++s) acc = fmaf(TM[(rb + r2) * 68 + rb + s], PSC[(p2 * 16 + s) * 68 + c2], acc);
        TM[(rb + r2) * 68 + cb + c2] = -acc; }
    __syncthreads();
    float p3[2];
#pragma unroll
    for (int j = 0; j < 2; ++j) { const int e = tid + 512 * j, r = e >> 5, c = e & 31; float acc = 0.f;
#pragma unroll 8
        for (int s = 0; s < 32; ++s) acc = fmaf(AM[(32 + r) * 68 + s], TM[s * 68 + c], acc);
        p3[j] = acc; }
    __syncthreads();
#pragma unroll
    for (int j = 0; j < 2; ++j) { const int e = tid + 512 * j; PSC[(e >> 5) * 68 + (e & 31)] = p3[j]; }
    __syncthreads();
#pragma unroll
    for (int j = 0; j < 2; ++j) { const int e = tid + 512 * j, r = e >> 5, c = e & 31; float acc = 0.f;
#pragma unroll 8
        for (int s = 0; s < 32; ++s) acc = fmaf(TM[(32 + r) * 68 + 32 + s], PSC[s * 68 + c], acc);
        p3[j] = -acc; }
#pragma unroll
    for (int j = 0; j < 2; ++j) { const int e = tid + 512 * j; TM[(32 + (e >> 5)) * 68 + (e & 31)] = p3[j]; }
    __syncthreads();
#pragma unroll
    for (int j = 0; j < 4; ++j) { const int e = tid + 512 * j, t = e >> 5, s2 = (e & 31) * 2;
        *(LAS unsigned*)(TB + t * 144 + s2 * 2) = pg8::cvt_pk_bf16(TM[t * 68 + s2], TM[t * 68 + s2 + 1]); }
    __syncthreads();
    {
        const int fr = lane & 15, quad = lane >> 4;
        bf16x8 bv[2], ak[2];
#pragma unroll
        for (int kk = 0; kk < 2; ++kk) { bv[kk] = *(LAS bf16x8*)(VT + (16 * wave + fr) * 144 + (kk * 32 + quad * 8) * 2); ak[kk] = *(LAS bf16x8*)(RTK + (16 * wave + fr) * 144 + (kk * 32 + quad * 8) * 2); }
        bf16_t* DW = (bf16_t*)(A.ws + WS_DW) + (size_t)item * 8192; bf16_t* DKC = (bf16_t*)(A.ws + WS_DKC) + (size_t)item * 8192;
#pragma unroll
        for (int mt = 0; mt < 4; ++mt) { f32x4 aw = {0.f, 0.f, 0.f, 0.f}, akc = {0.f, 0.f, 0.f, 0.f};
#pragma unroll
            for (int kk = 0; kk < 2; ++kk) { const bf16x8 tf = *(LAS bf16x8*)(TB + (mt * 16 + fr) * 144 + (kk * 32 + quad * 8) * 2);
                aw = mfma16(tf, bv[kk], aw);
                akc = mfma16(ak[kk], tf, akc); }
            u32x2 ow; ow.x = pk2(aw[0], aw[1]); ow.y = pk2(aw[2], aw[3]);
            *(u32x2*)(DW + (16 * wave + fr) * 64 + mt * 16 + quad * 4) = ow;
            u32x2 ok; ok.x = pk2(-akc[0], -akc[1]); ok.y = pk2(-akc[2], -akc[3]);
            *(u32x2*)(DKC + (mt * 16 + fr) * 128 + 16 * wave + quad * 4) = ok; }
    }
    __syncthreads();
}

__device__ __forceinline__ void delta_scan_item(const DevArgs& A, int l, LAS unsigned char* lds, int bh, int tid_in, int wave, int lane_in, const XcdBarrier& xb, int SUB) {
    const int b = bh >> 2, h = bh & 3;
    LAS unsigned char* KCs = lds; LAS unsigned char* QDs = lds + 17408; LAS unsigned char* QKs = lds + 34816; LAS unsigned char* KDTs = lds + 44032;
    LAS unsigned char* Ws = lds + 62464;
    LAS unsigned char* GSs = lds + 80896;
    LAS unsigned char* SS = lds + 98304 + wave * 4352; LAS unsigned char* US = lds + 133120 + wave * 2304;
    LAS float* PART = (LAS float*)(lds + 151552);
    const unsigned char* gW = A.ws + WS_DW; const unsigned char* gGS = A.ws + WS_DGS;
    const unsigned char* gKC = A.ws + WS_DKC; const unsigned char* gQD = A.ws + WS_DQD; const unsigned char* gQK = A.ws + WS_DQK; const unsigned char* gKT = A.ws + WS_DKT;
    const float* DGL = (const float*)(A.ws + WS_DGL);
    f32x4 S[8];
#pragma unroll
    for (int mt = 0; mt < 8; ++mt) S[mt] = (f32x4){0.f, 0.f, 0.f, 0.f};
    u32x4 r[9], rg[2];
    float gl_all = 0.f;
#define DS_LOAD(itn, toff) do { const size_t _i = (size_t)(itn); const unsigned char* _kc = gKC + _i * 16384; const unsigned char* _qd = gQD + _i * 16384; \
        const unsigned char* _qk = gQK + _i * 8192; const unsigned char* _kt = gKT + _i * 16384; \
        r[0] = *(const u32x4*)(_kc + (toff)); r[1] = *(const u32x4*)(_kc + (toff) + 8192u); \
        r[2] = *(const u32x4*)(_qd + (toff)); r[3] = *(const u32x4*)(_qd + (toff) + 8192u); \
        r[4] = *(const u32x4*)(_qk + (toff)); \
        r[5] = *(const u32x4*)(_kt + (toff)); r[6] = *(const u32x4*)(_kt + (toff) + 8192u); \
        const unsigned char* _w = gW + _i * 16384; r[7] = *(const u32x4*)(_w + (toff)); r[8] = *(const u32x4*)(_w + (toff) + 8192u); } while (0)
#define DS_LOADG(itn, toff) do { const unsigned char* _g = gGS + (size_t)(itn) * 16384; rg[0] = *(const u32x4*)(_g + (toff)); rg[1] = *(const u32x4*)(_g + (toff) + 8192u); } while (0)
#define DS_STAGE(tidv) do { const int i0 = (tidv), i1 = (tidv) + 512; \
          *(LAS u32x4*)(KCs + (i0 >> 4) * 272 + (i0 & 15) * 16) = r[0]; *(LAS u32x4*)(KCs + (i1 >> 4) * 272 + (i1 & 15) * 16) = r[1]; \
          *(LAS u32x4*)(QDs + (i0 >> 4) * 272 + (i0 & 15) * 16) = r[2]; *(LAS u32x4*)(QDs + (i1 >> 4) * 272 + (i1 & 15) * 16) = r[3]; \
          *(LAS u32x4*)(QKs + (i0 >> 3) * 144 + (i0 & 7) * 16) = r[4]; \
          *(LAS u32x4*)(KDTs + (i0 >> 3) * 144 + (i0 & 7) * 16) = r[5]; *(LAS u32x4*)(KDTs + (i1 >> 3) * 144 + (i1 & 7) * 16) = r[6]; \
          *(LAS u32x4*)(Ws + (i0 >> 3) * 144 + (i0 & 7) * 16) = r[7]; *(LAS u32x4*)(Ws + (i1 >> 3) * 144 + (i1 & 7) * 16) = r[8]; } while (0)
#define DS_STAGEG(tidv) do { const int i0 = (tidv), i1 = (tidv) + 512; \
          *(LAS u32x4*)(GSs + (i0 >> 4) * 272 + (i0 & 15) * 16) = rg[0]; *(LAS u32x4*)(GSs + (i1 >> 4) * 272 + (i1 & 15) * 16) = rg[1]; } while (0)
#pragma unroll 1
    for (int n = 0; n < 32; ++n) {
        int tid = tid_in; asm volatile("" : "+v"(tid));
        const bool bstart = (SUB > 0) ? (n % SUB == 0) : (n == 0);
        const bool bnext1 = (SUB > 0) && ((n + 1) % SUB == 0), bnext2 = (SUB > 0) && ((n + 2) % SUB == 0);
        if (bstart) { if (n > 0) xcd_barrier(xb);
            gl_all = DGL[bh * 32 + (tid & 31)];
            const unsigned t0 = (unsigned)tid * 16u; DS_LOAD(bh * 32 + n, t0); DS_LOADG(bh * 32 + n, t0); DS_STAGE(tid); DS_STAGEG(tid);
            if (n + 1 < 32 && !bnext1) { DS_LOAD(bh * 32 + n + 1, t0); DS_LOADG(bh * 32 + n + 1, t0); }
            __syncthreads(); }
        else { DS_STAGEG(tid);
            if (n + 1 < 32 && !bnext1) DS_LOADG(bh * 32 + n + 1, (unsigned)tid * 16u); }
        const int lane = tid & 63, fr = lane & 15, quad = lane >> 4, vcol = 16 * wave + fr;
        const unsigned toff = (unsigned)tid * 16u;
        const int it = bh * 32 + n, tokb = b * SEQ + n * 64;
        const float glast = __builtin_bit_cast(float, __builtin_amdgcn_readlane(__builtin_bit_cast(int, gl_all), n));
        asm volatile("s_nop 7\n\ts_nop 7" ::: "memory");
#pragma unroll
        for (int mt = 0; mt < 8; ++mt) { u32x2 p; p.x = pg8::cvt_pk_bf16(S[mt][0], S[mt][1]); p.y = pg8::cvt_pk_bf16(S[mt][2], S[mt][3]); *(LAS u32x2*)(SS + fr * 272 + (mt * 16 + quad * 4) * 2) = p; }
        LDS_FENCE();
        bf16x8 Sb[4];
#pragma unroll
        for (int kk = 0; kk < 4; ++kk) Sb[kk] = *(LAS bf16x8*)(SS + fr * 272 + (kk * 32 + quad * 8) * 2);
        f32x4 U[4], O[4];
#pragma unroll
        for (int mt = 0; mt < 4; ++mt) { f32x4 au, ao = {0.f, 0.f, 0.f, 0.f};
            { const u32x2 wq = *(LAS u32x2*)(Ws + vcol * 144 + (mt * 16 + quad * 4) * 2);
              au[0] = __uint_as_float(wq.x << 16); au[1] = __uint_as_float(wq.x & 0xffff0000u); au[2] = __uint_as_float(wq.y << 16); au[3] = __uint_as_float(wq.y & 0xffff0000u); }
#pragma unroll
            for (int kk = 0; kk < 4; ++kk) { const bf16x8 a1 = *(LAS bf16x8*)(KCs + (mt * 16 + fr) * 272 + (kk * 32 + quad * 8) * 2); au = mfma16(a1, Sb[kk], au);
                const bf16x8 a2 = *(LAS bf16x8*)(QDs + (mt * 16 + fr) * 272 + (kk * 32 + quad * 8) * 2); ao = mfma16(a2, Sb[kk], ao); }
            U[mt] = au; O[mt] = ao; __builtin_amdgcn_sched_barrier(0); }
        asm volatile("s_nop 7\n\ts_nop 7" ::: "memory");
#pragma unroll
        for (int mt = 0; mt < 4; ++mt) { u32x2 p; p.x = pg8::cvt_pk_bf16(U[mt][0], U[mt][1]); p.y = pg8::cvt_pk_bf16(U[mt][2], U[mt][3]); *(LAS u32x2*)(US + fr * 144 + (mt * 16 + quad * 4) * 2) = p; }
        LDS_FENCE();
        bf16x8 Ub[2];
#pragma unroll
        for (int kk = 0; kk < 2; ++kk) Ub[kk] = *(LAS bf16x8*)(US + fr * 144 + (kk * 32 + quad * 8) * 2);
#pragma unroll
        for (int mt = 0; mt < 4; ++mt)
#pragma unroll
            for (int kk = 0; kk < 2; ++kk) { const bf16x8 a = *(LAS bf16x8*)(QKs + (mt * 16 + fr) * 144 + (kk * 32 + quad * 8) * 2); O[mt] = mfma16(a, Ub[kk], O[mt]); }
        __builtin_amdgcn_sched_barrier(0);
#pragma unroll
        for (int mt = 0; mt < 8; ++mt) { S[mt] *= glast;
#pragma unroll
            for (int kk = 0; kk < 2; ++kk) { const bf16x8 a = *(LAS bf16x8*)(KDTs + (mt * 16 + fr) * 144 + (kk * 32 + quad * 8) * 2); S[mt] = mfma16(a, Ub[kk], S[mt]); }
            if (mt & 1) __builtin_amdgcn_sched_barrier(0); }
        { float pp[16];
#pragma unroll
          for (int e = 0; e < 16; ++e) pp[e] = O[e >> 2][e & 3] * O[e >> 2][e & 3];
#pragma unroll
          for (int e = 0; e < 16; ++e) pp[e] = row_sum16(pp[e]);
          if (fr == 0) {
#pragma unroll
              for (int e = 0; e < 16; ++e) PART[((e >> 2) * 16 + quad * 4 + (e & 3)) * 8 + wave] = pp[e]; } }
        __syncthreads();
        if (n + 1 < 32 && !bnext1) { DS_STAGE(tid); if (n + 2 < 32 && !bnext2) DS_LOAD(it + 2, toff); }
        bf16_t* mixb = (bf16_t*)(A.ws + WS_MIX) + (size_t)tokb * D + h * 128;
#pragma unroll
        for (int mt = 0; mt < 4; ++mt)
#pragma unroll
            for (int i = 0; i < 4; ++i) { const int t = mt * 16 + quad * 4 + i;
                const f32x4 p0 = *(LAS f32x4*)(PART + t * 8), p1 = *(LAS f32x4*)(PART + t * 8 + 4);
                const float tot = ((p0[0] + p0[1]) + (p0[2] + p0[3])) + ((p1[0] + p1[1]) + (p1[2] + p1[3]));
                const float sc = rsqrtf(tot * (1.f / 128.f) + EPS);
                const float gs = bf2f(*(LAS bf16_t*)(GSs + t * 272 + vcol * 2));
                mixb[(unsigned)(t * D + vcol)] = (bf16_t)(pg8::cvt_pk_bf16(O[mt][i] * sc * gs, 0.f) & 0xffffu); }
        __syncthreads();
    }
#undef DS_STAGE
#undef DS_LOADG
#undef DS_STAGEG
#undef DS_LOAD
    { const int lane = lane_in, fr = lane & 15, quad = lane >> 4, vcol = 16 * wave + fr;
      float* dp = A.out + O_DP + (size_t)((l * 8 + b) * 4 + h) * 16384;
#pragma unroll
      for (int mt = 0; mt < 8; ++mt)
#pragma unroll
          for (int i = 0; i < 4; ++i) dp[(mt * 16 + quad * 4 + i) * 128 + vcol] = S[mt][i]; }
    __syncthreads();
}

__device__ __forceinline__ void delta_sample_item(const DevArgs& A, int l, LAS unsigned char* lds, int item, int tid, int wave, int lane) {
    asm volatile("" : "+v"(tid)); lane = tid & 63; wave = __builtin_amdgcn_readfirstlane(tid >> 6);
    const int b = item >> 2, h = item & 3, tokS = NP + b * 4;
    LAS float* RAW = (LAS float*)lds; LAS float* RED = RAW + 1536; LAS float* OB = RED + 512; LAS float* SC = OB + 512;
    const bf16_t* PROJ = (const bf16_t*)(A.ws + WS_PROJ); const float* AB = (const float*)(A.ws + WS_AB); bf16_t* MIX = (bf16_t*)(A.ws + WS_MIX);
    const float* cw = A.in[I_CONVW] + (size_t)l * 4 * 1536;
    for (int idx = tid; idx < 1536; idx += 512) { const int part = idx >> 9, t = (idx >> 7) & 3, c = idx & 127, col = part * 512 + h * 128 + c;
        float acc = 0.f;
#pragma unroll
        for (int j = 0; j < 4; ++j) { const int tt = t - 3 + j;
            const float x = (tt >= 0) ? bf2f(PROJ[(size_t)(tokS + tt) * NPROJ + col]) : A.in[I_SCONV][((size_t)(l * 128 + b) * 3 + (3 + tt)) * 1536 + col];
            acc += cw[j * 1536 + col] * x; }
        RAW[idx] = silu_f(acc); }
    if (tid < 4) { const float a = AB[(size_t)(tokS + tid) * 8 + h], bb = AB[(size_t)(tokS + tid) * 8 + 4 + h];
        const float xx = a + A.in[I_DTB][l * 4 + h]; const float sp = xx > 20.f ? xx : log1pf(expf(xx));
        SC[8 + tid] = 1.f / (1.f + expf(-bb)); SC[12 + tid] = expf(-expf(A.in[I_ALOG][l * 4 + h]) * sp); }
    const int v = tid & 127, kq = tid >> 7;
    float S[32];
    { const float* sp = A.in[I_SDELTA] + (size_t)((l * 128 + b) * 4 + h) * 16384;
#pragma unroll
      for (int i = 0; i < 32; ++i) S[i] = sp[(kq * 32 + i) * 128 + v]; }
    __syncthreads();
    { const int part = wave >> 2, t = wave & 3; const float x0 = RAW[part * 512 + t * 128 + lane], x1 = RAW[part * 512 + t * 128 + 64 + lane];
      const float ss = wave_sum(x0 * x0 + x1 * x1); if (lane == 0) SC[part * 4 + t] = rsqrtf(ss + EPS) * (part == 0 ? 0.08838834764831845f : 1.f); }
    __syncthreads();
    for (int t = 0; t < 4; ++t) {
        const float rq = SC[t], rk = SC[4 + t], beta = SC[8 + t], g = SC[12 + t];
        float pr = 0.f;
#pragma unroll
        for (int i = 0; i < 32; ++i) pr += S[i] * RAW[512 + t * 128 + kq * 32 + i];
        RED[kq * 128 + v] = pr * rk;
        __syncthreads();
        const float rr = (RED[v] + RED[128 + v]) + (RED[256 + v] + RED[384 + v]);
        const float u = beta * (RAW[1024 + t * 128 + v] - g * rr);
        float po = 0.f;
#pragma unroll
        for (int i = 0; i < 32; ++i) { const float kh = RAW[512 + t * 128 + kq * 32 + i] * rk; S[i] = g * S[i] + kh * u; po += S[i] * RAW[t * 128 + kq * 32 + i]; }
        __syncthreads();
        RED[kq * 128 + v] = po * rq;
        __syncthreads();
        if (kq == 0) OB[t * 128 + v] = (RED[v] + RED[128 + v]) + (RED[256 + v] + RED[384 + v]);
        __syncthreads();
    }
    if (wave < 4) { const int t = wave; const float x0 = OB[t * 128 + lane], x1 = OB[t * 128 + 64 + lane];
        const float ss = wave_sum(x0 * x0 + x1 * x1); const float sc = rsqrtf(ss * (1.f / 128.f) + EPS);
        const float g0 = bf2f(PROJ[(size_t)(tokS + t) * NPROJ + PC_G + h * 128 + lane]), g1 = bf2f(PROJ[(size_t)(tokS + t) * NPROJ + PC_G + h * 128 + 64 + lane]);
        MIX[(size_t)(tokS + t) * D + h * 128 + lane] = (bf16_t)f2bf(x0 * sc * A.in[I_ONORM][l * 128 + lane] * silu_f(g0));
        MIX[(size_t)(tokS + t) * D + h * 128 + 64 + lane] = (bf16_t)f2bf(x1 * sc * A.in[I_ONORM][l * 128 + 64 + lane] * silu_f(g1)); }
    { float* dsp = A.out + O_DS + (size_t)((l * 128 + b) * 4 + h) * 16384;
#pragma unroll
      for (int i = 0; i < 32; ++i) dsp[(kq * 32 + i) * 128 + v] = S[i]; }
    __syncthreads();
}

#define SSM_BCAST_U(t) do { unsigned _w[8]; \
        _w[0] = __builtin_amdgcn_readlane(ua.x, t); _w[1] = __builtin_amdgcn_readlane(ua.y, t); _w[2] = __builtin_amdgcn_readlane(ua.z, t); _w[3] = __builtin_amdgcn_readlane(ua.w, t); \
        _w[4] = __builtin_amdgcn_readlane(ub.x, t); _w[5] = __builtin_amdgcn_readlane(ub.y, t); _w[6] = __builtin_amdgcn_readlane(ub.z, t); _w[7] = __builtin_amdgcn_readlane(ub.w, t); \
        _Pragma("unroll") for (int _d = 0; _d < 8; ++_d) { uu[2 * _d] = __uint_as_float(_w[_d] << 16); uu[2 * _d + 1] = __uint_as_float(_w[_d] & 0xffff0000u); } } while (0)
#define SSM_STEP() do { float _br = 0.f, _bi = 0.f; \
        _Pragma("unroll") for (int _h = 0; _h < 16; ++_h) { _br = fmaf(Br[_h], uu[_h], _br); _bi = fmaf(Bi[_h], uu[_h], _bi); } \
        const float _nr = lr * hr - li * hi + _br, _ni = lr * hi + li * hr + _bi; hr = _nr; hi = _ni; } while (0)

__device__ __forceinline__ void ssm_part1_item(const DevArgs& A, int l, int it, int lane) {
    const int g = it & 15, bc = it >> 4, b = bc / 31, c = bc % 31;
    const float* bb = (const float*)(A.ws + WS_BBAR) + ((size_t)(l * 16 + g) * 64 + lane) * 32;
    float Br[16], Bi[16];
#pragma unroll
    for (int q = 0; q < 4; ++q) { const f32x4 x = ((const f32x4*)bb)[q], y = ((const f32x4*)bb)[4 + q];
        Br[4 * q] = x.x; Br[4 * q + 1] = x.y; Br[4 * q + 2] = x.z; Br[4 * q + 3] = x.w; Bi[4 * q] = y.x; Bi[4 * q + 1] = y.y; Bi[4 * q + 2] = y.z; Bi[4 * q + 3] = y.w; }
    const f32x4 lk = ((const f32x4*)(A.ws + WS_SSMK))[(l * 16 + g) * 64 + lane]; const float lr = lk.x, li = lk.y;
    const bf16_t* up = (const bf16_t*)(A.ws + WS_PROJ) + (size_t)(b * SEQ + c * 64 + lane) * NPROJ + PC_SSM + g * 16;
    const u32x4 ua = *(const u32x4*)up, ub = *(const u32x4*)(up + 8);
    float hr = 0.f, hi = 0.f, uu[16];
#pragma unroll 1
    for (int t = 0; t < 64; ++t) { SSM_BCAST_U(t); SSM_STEP(); }
    f32x2 e; e.x = hr; e.y = hi;
    ((f32x2*)(A.ws + WS_SSME))[((size_t)(b * 32 + c) * 16 + g) * 64 + lane] = e;
}

__device__ __forceinline__ void ssm_part2_item(const DevArgs& A, int l, LAS unsigned char* lds, int it, int tid, int wave, int lane) {
    asm volatile("" : "+v"(tid)); lane = tid & 63; wave = __builtin_amdgcn_readfirstlane(tid >> 6);
    const int tok0 = it * 64, fr = lane & 15, quad = lane >> 4;
    const bool samp = it >= 256; const int b = it >> 5, c = it & 31;
    LAS unsigned char* YS = lds; LAS unsigned char* HS = lds + 33792 + wave * 4352;
    const bf16_t* PROJ = (const bf16_t*)(A.ws + WS_PROJ); bf16_t* MIX = (bf16_t*)(A.ws + WS_MIX);
#pragma unroll 1
    for (int gi = 0; gi < 2; ++gi) {
        const int g = wave * 2 + gi;
        const float* bb = (const float*)(A.ws + WS_BBAR) + ((size_t)(l * 16 + g) * 64 + lane) * 32;
        float Br[16], Bi[16];
#pragma unroll
        for (int q = 0; q < 4; ++q) { const f32x4 x = ((const f32x4*)bb)[q], y = ((const f32x4*)bb)[4 + q];
            Br[4 * q] = x.x; Br[4 * q + 1] = x.y; Br[4 * q + 2] = x.z; Br[4 * q + 3] = x.w; Bi[4 * q] = y.x; Bi[4 * q + 1] = y.y; Bi[4 * q + 2] = y.z; Bi[4 * q + 3] = y.w; }
        const f32x4 lk = ((const f32x4*)(A.ws + WS_SSMK))[(l * 16 + g) * 64 + lane]; const float lr = lk.x, li = lk.y, Lr = lk.z, Li = lk.w;
        bf16x8 Cb[4];
#pragma unroll
        for (int kk = 0; kk < 4; ++kk) { const size_t co = ((size_t)(l * 16 + g) * 16 + fr) * 64 + kk * 16 + quad * 4;
            const f32x4 cr = *(const f32x4*)(A.in[I_CRE] + co), ci = *(const f32x4*)(A.in[I_CIM] + co);
            u32x4 pk; pk.x = pk2(cr.x, -ci.x); pk.y = pk2(cr.y, -ci.y); pk.z = pk2(cr.z, -ci.z); pk.w = pk2(cr.w, -ci.w);
            Cb[kk] = __builtin_bit_cast(bf16x8, pk); }
        const bf16_t* up = PROJ + (size_t)(tok0 + lane) * NPROJ + PC_SSM + g * 16;
        const u32x4 ua = *(const u32x4*)up, ub = *(const u32x4*)(up + 8);
        float hr = 0.f, hi = 0.f, uu[16];
        if (!samp && c > 0) { const f32x2* E = (const f32x2*)(A.ws + WS_SSME) + ((size_t)(b * 32) * 16 + g) * 64 + lane;
#pragma unroll
            for (int cb = 0; cb < 32; cb += 16) { f32x2 ev[16];
#pragma unroll
                for (int q = 0; q < 16; ++q) { const int cc = cb + q; ev[q] = (cc < c) ? E[(size_t)cc * 1024] : (f32x2){0.f, 0.f}; }
#pragma unroll
                for (int q = 0; q < 16; ++q) { const int cc = cb + q; if (cc < c) { const float nr = Lr * hr - Li * hi + ev[q].x, ni = Lr * hi + Li * hr + ev[q].y; hr = nr; hi = ni; } } } }
        const float dsk = A.in[I_SSMD][l * 256 + g * 16 + fr];
        unsigned uvr[16];
#pragma unroll
        for (int e = 0; e < 16; ++e) uvr[e] = PROJ[(size_t)(tok0 + (e >> 2) * 16 + quad * 4 + (e & 3)) * NPROJ + PC_SSM + g * 16 + fr];
#pragma unroll
        for (int sub = 0; sub < 4; ++sub) {
#pragma unroll 1
            for (int tt = 0; tt < 16; ++tt) { const int t = sub * 16 + tt;
                const int sb = (it - 256) * 16 + (t >> 2);
                if (samp && (t & 3) == 0) { hr = A.in[I_SRE][((size_t)(l * 128 + sb) * 16 + g) * 64 + lane]; hi = A.in[I_SIM][((size_t)(l * 128 + sb) * 16 + g) * 64 + lane]; }
                SSM_BCAST_U(t); SSM_STEP();
                *(LAS unsigned*)(HS + tt * 272 + lane * 4) = pg8::cvt_pk_bf16(hr, hi);
                if (samp && (t & 3) == 3) { A.out[O_RES + ((size_t)(l * 128 + sb) * 16 + g) * 64 + lane] = hr; A.out[O_IMS + ((size_t)(l * 128 + sb) * 16 + g) * 64 + lane] = hi; }
            }
            LDS_FENCE();
            f32x4 acc = {0.f, 0.f, 0.f, 0.f};
#pragma unroll
            for (int kk = 0; kk < 4; ++kk) { const bf16x8 a = *(LAS bf16x8*)(HS + fr * 272 + (kk * 32 + quad * 8) * 2); acc = mfma16(a, Cb[kk], acc); }
#pragma unroll
            for (int i = 0; i < 4; ++i) { const int t = sub * 16 + quad * 4 + i; const float uv = bf2f(uvr[sub * 4 + i]);
                *(LAS bf16_t*)(YS + t * 528 + (g * 16 + fr) * 2) = (bf16_t)f2bf(gelu_tanh_f(acc[i] + dsk * uv)); }
            LDS_FENCE();
        }
        if (!samp && c == 31) { A.out[O_REP + ((size_t)(l * 8 + b) * 16 + g) * 64 + lane] = hr; A.out[O_IMP + ((size_t)(l * 8 + b) * 16 + g) * 64 + lane] = hi; }
    }
    __syncthreads();
    {
        const bf16_t* GT = (const bf16_t*)(A.ws + WS_GLUT + l * SZ_GLUT);
        f32x4 acc[4][2];
#pragma unroll
        for (int mt = 0; mt < 4; ++mt) { acc[mt][0] = (f32x4){0.f, 0.f, 0.f, 0.f}; acc[mt][1] = (f32x4){0.f, 0.f, 0.f, 0.f}; }
#pragma unroll
        for (int kk = 0; kk < 8; ++kk) { bf16x8 bfr[2];
#pragma unroll
            for (int nt = 0; nt < 2; ++nt) bfr[nt] = *(const bf16x8*)(GT + (size_t)(32 * wave + nt * 16 + fr) * 256 + kk * 32 + quad * 8);
#pragma unroll
            for (int mt = 0; mt < 4; ++mt) { const bf16x8 a = *(LAS bf16x8*)(YS + (mt * 16 + fr) * 528 + (kk * 32 + quad * 8) * 2);
                acc[mt][0] = mfma16(a, bfr[0], acc[mt][0]); acc[mt][1] = mfma16(a, bfr[1], acc[mt][1]); } }
#pragma unroll
        for (int nt = 0; nt < 2; ++nt) { const int ncol = 32 * wave + nt * 16 + fr; const float gb = A.in[I_GLUB][l * 256 + ncol];
#pragma unroll
            for (int mt = 0; mt < 4; ++mt)
#pragma unroll
                for (int i = 0; i < 4; ++i) { const int t = mt * 16 + quad * 4 + i; const float y = bf2f(*(LAS bf16_t*)(YS + t * 528 + ncol * 2));
                    MIX[(size_t)(tok0 + t) * D + 512 + ncol] = (bf16_t)f2bf(y * sigmoid_f(acc[mt][nt][i] + gb)); } }
    }
    __syncthreads();
}

__device__ __forceinline__ void pool_item(const DevArgs& A, int l, LAS unsigned char* lds, int it, int tid, int wave, int lane) {
    asm volatile("" : "+v"(tid)); lane = tid & 63; wave = __builtin_amdgcn_readfirstlane(tid >> 6);
    const int tok0 = it * 64, fr = lane & 15, quad = lane >> 4; const bool samp = it >= 256;
    LAS unsigned char* RS = lds;
    const bf16_t* PROJ = (const bf16_t*)(A.ws + WS_PROJ); bf16_t* MIX = (bf16_t*)(A.ws + WS_MIX);
    if (!samp) {
        LAS unsigned char* XT = lds + 33792;
        const int b = it >> 5, c = it & 31;
        for (int id = tid; id < 79 * 32; id += 512) { const int r = id >> 5, c16 = id & 31, tl = c * 64 - 15 + r;
            u32x4 v = {0u, 0u, 0u, 0u}; if (tl >= 0) v = *(const u32x4*)(PROJ + (size_t)(b * SEQ + tl) * NPROJ + PC_POOL + c16 * 8);
            *(LAS u32x4*)(XT + r * 528 + c16 * 16) = v; }
        __syncthreads();
        const int ch = tid & 255, half = tid >> 8, g = ch >> 6, w = 2 << g, r0 = half * 32;
        float sum = 0.f;
        for (int j = 0; j < w; ++j) sum += bf2f(*(LAS bf16_t*)(XT + (r0 + 15 - j) * 528 + ch * 2));
#pragma unroll 4
        for (int rr = 0; rr < 32; ++rr) { const int r = r0 + rr, tl = c * 64 + r;
            const float u = bf2f(*(LAS bf16_t*)(XT + (r + 15) * 528 + ch * 2));
            if (rr > 0) sum += u - bf2f(*(LAS bf16_t*)(XT + (r + 15 - w) * 528 + ch * 2));
            const float cnt = (float)((tl + 1 < w) ? tl + 1 : w);
            *(LAS bf16_t*)(RS + r * 528 + ch * 2) = (bf16_t)f2bf(sum / cnt - u); }
    } else {
#pragma unroll 1
        for (int pr = 0; pr < 8; ++pr) { const int idx = pr * 512 + tid, ch = idx & 255, sq = idx >> 8, g = ch >> 6, w = 2 << g;
            const int sb = (it - 256) * 16 + sq;
            const float* sbuf = A.in[I_SPOOL] + (size_t)(l * 128 + sb) * 15 * 256 + ch;
            const bf16_t* base = PROJ + (size_t)(NP + sb * 4) * NPROJ + PC_POOL + ch;
            float e[19];
#pragma unroll
            for (int j = 0; j < 15; ++j) e[j] = sbuf[j * 256];
#pragma unroll
            for (int j = 0; j < 4; ++j) e[15 + j] = bf2f(base[(size_t)j * NPROJ]);
#pragma unroll
            for (int t = 0; t < 4; ++t) { float sum = 0.f;
#pragma unroll
                for (int j = 0; j < 16; ++j) sum += (j < w) ? e[15 + t - j] : 0.f;
                *(LAS bf16_t*)(RS + (sq * 4 + t) * 528 + ch * 2) = (bf16_t)f2bf(sum / (float)w - e[15 + t]); } }
    }
    __syncthreads();
    { const int g2 = wave >> 1; const bf16_t* PT = (const bf16_t*)(A.ws + WS_POOLT + l * SZ_POOLT) + g2 * 4096;
      f32x4 acc[4][2];
#pragma unroll
      for (int mt = 0; mt < 4; ++mt) { acc[mt][0] = (f32x4){0.f, 0.f, 0.f, 0.f}; acc[mt][1] = (f32x4){0.f, 0.f, 0.f, 0.f}; }
#pragma unroll
      for (int kk = 0; kk < 2; ++kk) { bf16x8 bfr[2];
#pragma unroll
          for (int nt = 0; nt < 2; ++nt) bfr[nt] = *(const bf16x8*)(PT + (size_t)((wave & 1) * 32 + nt * 16 + fr) * 64 + kk * 32 + quad * 8);
#pragma unroll
          for (int mt = 0; mt < 4; ++mt) { const bf16x8 a = *(LAS bf16x8*)(RS + (mt * 16 + fr) * 528 + (g2 * 64 + kk * 32 + quad * 8) * 2);
              acc[mt][0] = mfma16(a, bfr[0], acc[mt][0]); acc[mt][1] = mfma16(a, bfr[1], acc[mt][1]); } }
#pragma unroll
      for (int nt = 0; nt < 2; ++nt) { const int col = 32 * wave + nt * 16 + fr; const float ps = A.in[I_POOLS][l * 256 + col];
#pragma unroll
          for (int mt = 0; mt < 4; ++mt)
#pragma unroll
              for (int i = 0; i < 4; ++i) { const int t = mt * 16 + quad * 4 + i; MIX[(size_t)(tok0 + t) * D + 768 + col] = (bf16_t)f2bf(acc[mt][nt][i] * ps); } } }
    __syncthreads();
}

__device__ __forceinline__ void state_copies(const DevArgs& A, int l, int gt, int NT) {
    const bf16_t* PROJ = (const bf16_t*)(A.ws + WS_PROJ);
#pragma unroll 1
    for (int i = gt; i < 8 * 3 * 1536; i += NT) { const int col = i % 1536, j = (i / 1536) % 3, b = i / 4608;
        A.out[O_CP + (size_t)l * 8 * 4608 + i] = bf2f(PROJ[(size_t)(b * SEQ + SEQ - 3 + j) * NPROJ + col]); }
#pragma unroll 1
    for (int i = gt; i < 128 * 3 * 1536; i += NT) { const int col = i % 1536, j = (i / 1536) % 3, b = i / 4608;
        A.out[O_CS + (size_t)l * 128 * 4608 + i] = bf2f(PROJ[(size_t)(NP + b * 4 + 1 + j) * NPROJ + col]); }
#pragma unroll 1
    for (int i = gt; i < 8 * 15 * 256; i += NT) { const int ch = i & 255, j = (i >> 8) % 15, b = i / 3840;
        A.out[O_PP + (size_t)l * 8 * 3840 + i] = bf2f(PROJ[(size_t)(b * SEQ + SEQ - 15 + j) * NPROJ + PC_POOL + ch]); }
#pragma unroll 1
    for (int i = gt; i < 128 * 15 * 256; i += NT) { const int ch = i & 255, j = (i >> 8) % 15, b = i / 3840;
        A.out[O_PS + (size_t)l * 128 * 3840 + i] = (j < 11) ? A.in[I_SPOOL][((size_t)(l * 128 + b) * 15 + 4 + j) * 256 + ch]
                                                             : bf2f(PROJ[(size_t)(NP + b * 4 + (j - 11)) * NPROJ + PC_POOL + ch]); }
}

#ifndef REP_DPREP
#define REP_DPREP 1
#endif
#ifndef REP_DSAMP
#define REP_DSAMP 1
#endif
#ifndef REP_SSM1
#define REP_SSM1 1
#endif
#ifndef REP_POOL
#define REP_POOL 1
#endif
#ifndef REP_DSCAN
#define REP_DSCAN 1
#endif
#ifndef REP_SSM2
#define REP_SSM2 1
#endif
#ifndef REP_G
#define REP_G 1
#endif
#ifndef REP_P3
#define REP_P3 1
#endif
#ifndef REP_P2
#define REP_P2 1
#endif
constexpr int NPH = 2 + DEPTH * 8;
__global__ void __launch_bounds__(512, 2) mega_fwd(Args KA) {
    DevArgs A; A.out = KA.out; A.ws = KA.ws; A.ph_lo = KA.ph_lo; A.ph_hi = KA.ph_hi;
    extern __shared__ __attribute__((aligned(16))) unsigned char lds_raw[];
    LAS unsigned char* lds = (LAS unsigned char*)lds_raw;
    cg::grid_group grid = cg::this_grid();
    volatile LAS unsigned* xst = (volatile LAS unsigned*)(lds + LDS_BYTES - 64);
    if (threadIdx.x == 0) { xst[0] = 0u; xst[1] = 0u; }
    __syncthreads();
    const XcdBarrier xb = xcd_barrier_post((unsigned*)(KA.ws + WS_BAR), xst);
    constexpr int G = 256, NGW = G * 8, NT = G * 512;
    int ph = 0;
#define PH_BEGIN if (A.ph_lo <= ph && ph < A.ph_hi) { int tid = threadIdx.x; asm volatile("" : "+v"(tid)); { unsigned char* _w = A.ws; asm volatile("" : "+s"(_w)); A.ws = _w; float* _o = A.out; asm volatile("" : "+s"(_o)); A.out = _o; } const int wave = __builtin_amdgcn_readfirstlane(tid >> 6), lane = tid & 63, gw = blockIdx.x * 8 + wave, gt = blockIdx.x * 512 + tid; (void)gw; (void)gt; (void)lane;
#define PH_END   if (ph + 1 < A.ph_hi) { if (ph == 0) grid.sync(); else xcd_barrier(xb); } } ++ph;
#define Hb   ((bf16_t*)(A.ws + WS_H))
#define AB   ((float*)(A.ws + WS_AB))
#define MIXO ((float*)(A.ws + WS_MIXO))
#define PROJ ((bf16_t*)(A.ws + WS_PROJ))
#define MIX  ((bf16_t*)(A.ws + WS_MIX))
#define HID  ((bf16_t*)(A.ws + WS_HID))

#ifndef REP_PRO
#define REP_PRO 1
#endif
#ifndef REP_N0
#define REP_N0 1
#endif
    PH_BEGIN for (int rep = 0; rep < REP_PRO; ++rep) { prologue(A, lds, wave, lane, gw, NGW); __syncthreads(); } PH_END
    PH_BEGIN for (int rep = 0; rep < REP_N0; ++rep) norm_rows(nullptr, nullptr, A.in[I_XP], A.in[I_XS], nullptr, A.in[I_NMPRE], Hb, (const float*)(A.ws + WS_WAB), AB, gw, NGW, lane); PH_END

#pragma unroll 1
    for (int l = 0; l < DEPTH; ++l) {
        PH_BEGIN for (int rep = 0; rep < REP_G; ++rep) { pg8::Gemm g{Hb, (const bf16_t*)(A.ws + WS_WIN + l * SZ_WIN), NTOK, NPROJ, D, D, D}; pg8::StaticOrder S; S.init(NTOK, NPROJ, G, (int)blockIdx.x);
            pg8::EpiBf16<0> E{PROJ, NPROJ, nullptr, 0, 0}; pg8::gemm_phase<pg8::EpiBf16<0>, pg8::StaticOrder>(lds, g, S, E, nullptr); } PH_END
        constexpr int SUBC = 7;
        PH_BEGIN {
#pragma unroll 1
          for (int rep2 = 0; rep2 < REP_P2; ++rep2) {
#pragma unroll 1
            for (int j = blockIdx.x; j < 32 * SUBC; j += G) delta_prep_item(A, l, lds, (j & 31) * 32 + (j >> 5), tid, wave, lane);
          }
        } PH_END
        PH_BEGIN {
#pragma unroll 1
            for (int rep3 = 0; rep3 < REP_P3; ++rep3) {
                if (blockIdx.x < 32) delta_scan_item(A, l, lds, blockIdx.x, tid, wave, lane, xb, SUBC);
                else { const int w = blockIdx.x - 32; constexpr int NW = G - 32;
#pragma unroll 1
                    for (int k = 1; k <= 5; ++k) {
                        const int n0 = k * SUBC, nn = (n0 >= 32) ? 0 : ((32 - n0 < SUBC) ? 32 - n0 : SUBC);
                        int nprep = 32 * nn;
#ifndef REP_WPREP
#define REP_WPREP 1
#endif
#pragma unroll 1
                        for (int rep = 0; rep < REP_WPREP; ++rep)
#pragma unroll 1
                        for (int j = w; j < nprep; j += NW) delta_prep_item(A, l, lds, (j & 31) * 32 + n0 + (j >> 5), tid, wave, lane);
                        if (k == 1) {
#pragma unroll 1
                            for (int it = w; it < 512; it += NW) delta_sample_item(A, l, lds, it, tid, wave, lane); }
                        if (k == 2) {
#pragma unroll 1
                            for (int it = w * 8 + wave; it < 8 * 31 * 16; it += NW * 8) { int t1 = threadIdx.x; asm volatile("" : "+v"(t1)); ssm_part1_item(A, l, it, t1 & 63); }
                            { int t2 = threadIdx.x; asm volatile("" : "+v"(t2)); int wl = blockIdx.x; asm volatile("" : "+s"(wl)); state_copies(A, l, (wl - 32) * 512 + t2, NW * 512); } }
                        if (k == 3) {
#pragma unroll 1
                            for (int it = w; it < 264; it += NW) pool_item(A, l, lds, it, tid, wave, lane); }
                        { const int it = (k == 4) ? w - 128 : ((k == 5) ? 96 + w : -1);
                          if (it >= 0 && it < ((k == 4) ? 96 : 264)) ssm_part2_item(A, l, lds, it, tid, wave, lane); }
                        if (k < 5) xcd_barrier(xb);
                    } }
            }
        } PH_END
        PH_BEGIN for (int rep = 0; rep < REP_G; ++rep) { pg8::Gemm g{MIX, (const bf16_t*)(A.ws + WS_WOUT + l * SZ_WOUT), NP, D, D, D, D}; pg8::StaticOrder S; S.init(NP, D, G, (int)blockIdx.x);
            pg8::EpiBf16<0> E{(bf16_t*)MIXO, D, nullptr, 0, 0}; pg8::gemm_phase<pg8::EpiBf16<0>, pg8::StaticOrder>(lds, g, S, E, nullptr);
            pg8::Gemm g2{MIX + (size_t)NP * D, (const bf16_t*)(A.ws + WS_WOUT + l * SZ_WOUT), NS, D, 256, D, D}; SliceOrder S2{8 * (D / 256), G, (int)blockIdx.x};
            EpiF32Part E2{(float*)(A.ws + WS_PARTS)}; pg8::gemm_phase<EpiF32Part, SliceOrder>(lds, g2, S2, E2, nullptr); } PH_END
#ifndef REP_N5
#define REP_N5 1
#endif
        PH_BEGIN norm_rows_pf(MIXO, A.in[I_NMPOST] + l * D, l == 0 ? A.in[I_XP] : A.out, l == 0 ? A.in[I_XS] : nullptr, A.out, A.in[I_NFPRE] + l * D, Hb, gw, NGW, lane, (const float*)(A.ws + WS_PARTS), D / 256); PH_END
        PH_BEGIN for (int rep = 0; rep < REP_G; ++rep) { pg8::Gemm g{Hb, (const bf16_t*)(A.ws + WS_WGU + l * SZ_WGU), NTOK, NGU, D, D, D}; pg8::StaticOrder S; S.init(NTOK, NGU, G, (int)blockIdx.x);
            EpiSwiGLU E{HID, DFF}; pg8::gemm_phase<EpiSwiGLU, pg8::StaticOrder>(lds, g, S, E, nullptr); } PH_END
        PH_BEGIN for (int rep = 0; rep < REP_G; ++rep) { pg8::Gemm g{HID, (const bf16_t*)(A.ws + WS_WDN + l * SZ_WDN), NP, D, DFF, DFF, DFF}; pg8::StaticOrder S; S.init(NP, D, G, (int)blockIdx.x);
            pg8::EpiBf16<0> E{(bf16_t*)MIXO, D, nullptr, 0, 0}; pg8::gemm_phase<pg8::EpiBf16<0>, pg8::StaticOrder>(lds, g, S, E, nullptr);
            pg8::Gemm g2{HID + (size_t)NP * DFF, (const bf16_t*)(A.ws + WS_WDN + l * SZ_WDN), NS, D, 256, DFF, DFF}; SliceOrder S2{8 * (DFF / 256), G, (int)blockIdx.x};
            EpiF32Part E2{(float*)(A.ws + WS_PARTS)}; pg8::gemm_phase<EpiF32Part, SliceOrder>(lds, g2, S2, E2, nullptr); } PH_END
        PH_BEGIN norm_rows(MIXO, A.in[I_NFPOST] + l * D, A.out, nullptr, A.out, l + 1 < DEPTH ? A.in[I_NMPRE] + (l + 1) * D : nullptr, l + 1 < DEPTH ? Hb : nullptr,
                           l + 1 < DEPTH ? (const float*)(A.ws + WS_WAB + (l + 1) * SZ_WAB) : nullptr, AB, gw, NGW, lane, (const float*)(A.ws + WS_PARTS), DFF / 256); PH_END
    }
#undef PH_BEGIN
#undef PH_END
#undef Hb
#undef AB
#undef MIXO
#undef PROJ
#undef MIX
#undef HID
}

extern "C" void kernel_launch(void* const* d_in, const int* in_sizes, int n_in, void* d_out, int out_size, void* d_ws, size_t ws_size, hipStream_t stream) {
    static int grid = 0;
    if (grid == 0) {
        if (n_in != 32 || (size_t)out_size != O_END || ws_size < WS_END) fprintf(stderr, "kernel_launch: unexpected sizes: n_in %d out %d (want %zu) ws %zu (want >= %zu)\n", n_in, out_size, (size_t)O_END, ws_size, (size_t)WS_END);
        int dev = 0, cus = 0, per_cu = 0;
        (void)hipGetDevice(&dev); (void)hipDeviceGetAttribute(&cus, hipDeviceAttributeMultiprocessorCount, dev);
        if (hipFuncSetAttribute((const void*)mega_fwd, hipFuncAttributeMaxDynamicSharedMemorySize, LDS_BYTES) != hipSuccess) fprintf(stderr, "kernel_launch: hipFuncSetAttribute failed\n");
        if (hipOccupancyMaxActiveBlocksPerMultiprocessor(&per_cu, (const void*)mega_fwd, 512, LDS_BYTES) != hipSuccess || per_cu < 1) { fprintf(stderr, "kernel_launch: occupancy query gave %d\n", per_cu); per_cu = 1; (void)hipGetLastError(); }
        grid = cus * per_cu; if (grid <= 0) grid = 256;
        if (grid >= 256) grid = 256;
        fprintf(stderr, "kernel_launch: grid %d (cus %d x %d)%s\n", grid, cus, per_cu, grid < 256 ? "  ERROR: this build needs >= 256 co-resident workgroups" : "");
    }
    (void)hipMemsetAsync((unsigned char*)d_ws + WS_BAR, 0, 16384, stream);
    Args a{};
    for (int i = 0; i < 32; ++i) a.in[i] = (const float*)d_in[i];
    a.out = (float*)d_out; a.ws = (unsigned char*)d_ws;
#if MK_COOP
    a.ph_lo = 0; a.ph_hi = NPH;
    void* args[] = {&a};
    const hipError_t e = hipLaunchCooperativeKernel((const void*)mega_fwd, dim3(grid), dim3(512), args, LDS_BYTES, stream);
    if (e != hipSuccess) fprintf(stderr, "kernel_launch: cooperative launch failed: %s (grid %d)\n", hipGetErrorString(e), grid);
#else
    for (int p = 0; p < NPH; ++p) { a.ph_lo = p; a.ph_hi = p + 1; hipLaunchKernelGGL(mega_fwd, dim3(grid), dim3(512), LDS_BYTES, stream, a); }
#endif
}
```

```cpp
#include <hip/hip_runtime.h>
#include <hip/hip_cooperative_groups.h>
#include <cstdio>
#include <cstdint>
namespace cg = cooperative_groups;
#ifndef MK_COOP
#define MK_COOP 1
#endif
namespace pg8 {
#define PG8_LAS __attribute__((address_space(3)))
typedef unsigned short bf16_t;
typedef short bf16x8 __attribute__((ext_vector_type(8)));
typedef float f32x4 __attribute__((ext_vector_type(4)));
typedef unsigned u32x4 __attribute__((ext_vector_type(4)));
constexpr int BM = 256, BK = 64, HALF = 128, HTB = HALF * BK * 2  , STAGE_BYTES = 8 * HTB, NXCD = 8, WGM = 8;

__host__ __device__ __forceinline__ int lds_byte(int r, int c) { const int st = (r >> 4) * 2 + (c >> 5), rr = r & 15, cc = c & 31, ob = rr * 64 + cc * 2; return st * 1024 + (ob ^ (((ob >> 9) & 1) << 5)); }
__host__ __device__ __forceinline__ void stage_rc(int b, int& R, int& C) { const int st = b / 1024, sb = b % 1024, swz = sb ^ (((sb >> 9) & 1) << 5); R = (st >> 1) * 16 + swz / 64; C = (st & 1) * 32 + (swz % 64) / 2; }
__host__ __device__ __forceinline__ int perm32(int rho) { const int n = rho >> 4, i = rho & 15; return 8 * (i >> 2) + 4 * n + (i & 3); }

struct Unit { int pm, pn, ks; };
struct Gemm { const bf16_t* A; const bf16_t* Bt; int M, N, K, lda, ldb; };

struct StaticOrder {
    int nM, nN, nwg, G, c;
    __host__ __device__ void init(int M, int N, int G_, int c_) { nM = M / BM; nN = N / BM; nwg = nM * nN; G = G_; c = c_; }
    __host__ __device__ bool next(int i, Unit& u) const {
        const long L = (long)i * G + c; if (L >= nwg) return false;
        int wgid = (int)L; { const int q = nwg / NXCD, r = nwg % NXCD, xcd = wgid % NXCD, off = wgid / NXCD; wgid = (xcd < r ? xcd * (q + 1) : r * (q + 1) + (xcd - r) * q) + off; }
        const int nig = WGM * nN, gid = wgid / nig, fm = gid * WGM, gsz = (nM - fm) < WGM ? (nM - fm) : WGM;
        u.pm = fm + ((wgid % nig) % gsz); u.pn = (wgid % nig) / gsz; u.ks = 0; return true;
    }
    __device__ __forceinline__ void a_ready(const Unit&) const {}
    __device__ __forceinline__ void done(const Unit&) const {}
};
__device__ __forceinline__ unsigned cvt_pk_bf16(float lo, float hi) { unsigned r; asm volatile("v_cvt_pk_bf16_f32 %0, %1, %2" : "=v"(r) : "v"(lo), "v"(hi)); return r; }
typedef float f32x2 __attribute__((ext_vector_type(2)));
__device__ __forceinline__ f32x2 gelu_pk(f32x2 v) {
    const f32x2 av = __builtin_elementwise_abs(v), d = av * 0.2316418882f + 1.0f;
    f32x2 t; t.x = __builtin_amdgcn_rcpf(d.x); t.y = __builtin_amdgcn_rcpf(d.y);
    f32x2 q = t * 0.5307027145f + (-0.7265760135f); q = q * t + 0.7107068705f; q = q * t + (-0.142248368f); q = q * t + 0.127414796f; q = q * t;
    const f32x2 s = (v * v) * (-0.72134752044f);
    f32x2 e; e.x = __builtin_amdgcn_exp2f(s.x); e.y = __builtin_amdgcn_exp2f(s.y);
    const f32x2 m = v * (q * e), r = v - m;
    f32x2 o; o.x = v.x < 0.f ? m.x : r.x; o.y = v.y < 0.f ? m.y : r.y; return o;
}

struct EpiF32 {
    static constexpr bool PERM = false, AFTER_DRAIN = false;
    float* C; int ldc; const float* bias;
    __device__ __forceinline__ void operator()(const f32x4 (&acc)[2][2][4][2], const Unit& u, int wr, int wc, int fr, int fq) const {
        const int row0 = u.pm * BM + wr * 64 + fr, col0 = u.pn * BM + wc * 32 + 4 * fq;
        f32x4 bv[2][2];
#pragma unroll
        for (int bj = 0; bj < 2; ++bj)
#pragma unroll
            for (int n = 0; n < 2; ++n) bv[bj][n] = bias ? *(const f32x4*)(bias + col0 + bj * HALF + n * 16) : (f32x4){0.f, 0.f, 0.f, 0.f};
#pragma unroll
        for (int ai = 0; ai < 2; ++ai)
#pragma unroll
            for (int m = 0; m < 4; ++m) { float* rowp = C + (size_t)(row0 + ai * HALF + m * 16) * ldc + col0;
#pragma unroll
                for (int bj = 0; bj < 2; ++bj)
#pragma unroll
                    for (int n = 0; n < 2; ++n) *(f32x4*)(rowp + bj * HALF + n * 16) = acc[ai][bj][m][n] + bv[bj][n]; }
    }
};
template <int ACT  > struct EpiBf16 {
    static constexpr bool PERM = true, AFTER_DRAIN = false;
    bf16_t* O; int ldc; const float* bias; int split_cols; size_t split_stride;
    __device__ __forceinline__ void operator()(const f32x4 (&acc)[2][2][4][2], const Unit& u, int wr, int wc, int fr, int fq) const {
        const int row0 = u.pm * BM + wr * 64 + fr; int colt = u.pn * BM; bf16_t* base = O;
        if (split_cols) { const int t = colt / split_cols; base += (size_t)t * split_stride; colt -= t * split_cols; }
        const int col0 = colt + wc * 32 + 8 * fq, bcol0 = u.pn * BM + wc * 32 + 8 * fq;
        f32x4 bv[2][2];
#pragma unroll
        for (int bj = 0; bj < 2; ++bj)
#pragma unroll
            for (int n = 0; n < 2; ++n) bv[bj][n] = bias ? *(const f32x4*)(bias + bcol0 + bj * HALF + 4 * n) : (f32x4){0.f, 0.f, 0.f, 0.f};
#pragma unroll
        for (int ai = 0; ai < 2; ++ai)
#pragma unroll
            for (int m = 0; m < 4; ++m) { bf16_t* rowp = base + (size_t)(row0 + ai * HALF + m * 16) * ldc + col0;
#pragma unroll
                for (int bj = 0; bj < 2; ++bj) { f32x4 v0 = acc[ai][bj][m][0] + bv[bj][0], v1 = acc[ai][bj][m][1] + bv[bj][1];
                    if (ACT == 1) { f32x2 a = gelu_pk((f32x2){v0[0], v0[1]}), b = gelu_pk((f32x2){v0[2], v0[3]}), c = gelu_pk((f32x2){v1[0], v1[1]}), d = gelu_pk((f32x2){v1[2], v1[3]});
                        v0 = (f32x4){a.x, a.y, b.x, b.y}; v1 = (f32x4){c.x, c.y, d.x, d.y}; }
                    if (ACT == 2) {
#pragma unroll
                        for (int j = 0; j < 4; ++j) { v0[j] = 0.5f * v0[j] * (1.0f + erff(v0[j] * 0.70710678f)); v1[j] = 0.5f * v1[j] * (1.0f + erff(v1[j] * 0.70710678f)); } }
                    u32x4 w; w.x = cvt_pk_bf16(v0[0], v0[1]); w.y = cvt_pk_bf16(v0[2], v0[3]); w.z = cvt_pk_bf16(v1[0], v1[1]); w.w = cvt_pk_bf16(v1[2], v1[3]);
                    *(u32x4*)(rowp + bj * HALF) = w; } }
    }
};
template <class Epi, class Sched, bool STAMP = false>
__device__ __forceinline__ void gemm_phase(PG8_LAS unsigned char* lds, const Gemm g, const Sched& S, const Epi& E, unsigned long long* stamps) {
    int tid_ = threadIdx.x; asm volatile("" : "+v"(tid_));
    const int tid = tid_, wid = __builtin_amdgcn_readfirstlane(tid >> 6), lane = tid & 63, wr = wid >> 2, wc = wid & 3, fr = lane & 15, fq = lane >> 4;
    const int K = g.K, nt = K / BK;
    int ts_lo = 0, ts_hi = 0, nts = 0; const unsigned long long rt_entry = STAMP ? (unsigned long long)wall_clock64() : 0ull;
#define PG8_STAMP() do { if (STAMP && wid == 0 && nts < 64) { const unsigned long long _c = (unsigned long long)clock64(); \
        ts_lo = (lane == nts) ? (int)(unsigned)_c : ts_lo; ts_hi = (lane == nts) ? (int)(unsigned)(_c >> 32) : ts_hi; ++nts; } } while (0)
    PG8_STAMP();
    unsigned voffA[2], voffB[2];
#pragma unroll
    for (int i = 0; i < 2; ++i) { int R, C; stage_rc(tid * 16 + i * 8192, R, C); const int Rb = Epi::PERM ? ((R & ~31) + perm32(R & 31)) : R;
        voffA[i] = (unsigned)(R * g.lda + C) * 2u; voffB[i] = (unsigned)(Rb * g.ldb + C) * 2u; }
    const size_t kstep = (size_t)(BK * 2);
    const size_t hstepA = (size_t)HALF * g.lda * 2, hstepB = (size_t)HALF * g.ldb * 2;
    const size_t tstepA = 2 * hstepA, tstepB = 2 * hstepB, sstep = (size_t)K * 2;
    const unsigned ldsw = (unsigned)wid * 1024u;
    const int aoff = lds_byte(wr * 64 + fr, fq * 8), boff = lds_byte(wc * 32 + fr, fq * 8);
#define PG8_SA(b, h) (((b) * 2 + (h)) * HTB)
#define PG8_SB(b, h) ((4 + (b) * 2 + (h)) * HTB)
#define PG8_STAGE(bufoff, gbase, voff) do { _Pragma("unroll") for (int _i = 0; _i < 2; ++_i) \
        __builtin_amdgcn_global_load_lds((const unsigned*)((const char*)(gbase) + (voff)[_i]), (PG8_LAS unsigned*)(lds + (bufoff) + ldsw + _i * 8192), 16, 0, 0); } while (0)
#define PG8_LDA(dst, b, h) do { _Pragma("unroll") for (int m = 0; m < 4; ++m) _Pragma("unroll") for (int k = 0; k < 2; ++k) dst[m][k] = *(const PG8_LAS bf16x8*)(lds + PG8_SA(b, h) + aoff + m * 2048 + k * 1024); } while (0)
#define PG8_LDB(dst, b, h) do { _Pragma("unroll") for (int n = 0; n < 2; ++n) _Pragma("unroll") for (int k = 0; k < 2; ++k) dst[n][k] = *(const PG8_LAS bf16x8*)(lds + PG8_SB(b, h) + boff + n * 2048 + k * 1024); } while (0)
#define PG8_MMA(ai, bj, At, Bt) do { __builtin_amdgcn_s_setprio(1); _Pragma("unroll") for (int m = 0; m < 4; ++m) _Pragma("unroll") for (int n = 0; n < 2; ++n) _Pragma("unroll") for (int k = 0; k < 2; ++k) \
        acc[ai][bj][m][n] = __builtin_amdgcn_mfma_f32_16x16x32_bf16(Bt[n][k], At[m][k], acc[ai][bj][m][n], 0, 0, 0); __builtin_amdgcn_s_setprio(0); } while (0)
#define PG8_WAIT_V(n) asm volatile("s_waitcnt vmcnt(" #n ")" ::: "memory")
#define PG8_WAIT_L(n) asm volatile("s_waitcnt lgkmcnt(" #n ")" ::: "memory")
#define PG8_BAR __builtin_amdgcn_s_barrier()
#define PG8_SCHED __builtin_amdgcn_sched_barrier(0)
    Unit cur, nxt; int ui = 0;
    if (!S.next(0, cur)) return;
    f32x4 acc[2][2][4][2];
#pragma unroll
    for (int a = 0; a < 2; ++a)
#pragma unroll
        for (int b = 0; b < 2; ++b)
#pragma unroll
            for (int m = 0; m < 4; ++m)
#pragma unroll
                for (int n = 0; n < 2; ++n) acc[a][b][m][n] = (f32x4){0.f, 0.f, 0.f, 0.f};
    bf16x8 At[4][2], B0[2][2], B1[2][2];
    const char* cA = (const char*)g.A + (size_t)cur.pm * tstepA + (size_t)cur.ks * sstep; const char* cB = (const char*)g.Bt + (size_t)cur.pn * tstepB + (size_t)cur.ks * sstep;
    S.a_ready(cur);
    PG8_STAGE(PG8_SB(0, 0), cB, voffB); PG8_STAGE(PG8_SA(0, 0), cA, voffA); PG8_STAGE(PG8_SB(0, 1), cB + hstepB, voffB); PG8_STAGE(PG8_SA(0, 1), cA + hstepA, voffA);
    if (wr == 1) PG8_BAR;
    PG8_WAIT_V(4); PG8_BAR;
    PG8_STAGE(PG8_SB(1, 0), cB + kstep, voffB); PG8_STAGE(PG8_SA(1, 0), cA + kstep, voffA); PG8_STAGE(PG8_SB(1, 1), cB + hstepB + kstep, voffB);
    PG8_WAIT_V(6); PG8_BAR;
    PG8_STAMP();
    for (;;) {
        const bool has_next = S.next(ui + 1, nxt);
        const char* nA = has_next ? (const char*)g.A + (size_t)nxt.pm * tstepA + (size_t)nxt.ks * sstep : cA; const char* nB = has_next ? (const char*)g.Bt + (size_t)nxt.pn * tstepB + (size_t)nxt.ks * sstep : cB;
        for (int t = 0; t < nt; t += 2) {
            const bool last = (t == nt - 2);
            const char* a1 = cA + (size_t)(t + 1) * kstep;
            const char* a2 = last ? nA : cA + (size_t)(t + 2) * kstep; const char* b2 = last ? nB : cB + (size_t)(t + 2) * kstep;
            const char* a3 = a2 + kstep; const char* b3 = b2 + kstep;
            if (last && has_next) S.a_ready(nxt);
            PG8_LDB(B0, 0, 0); PG8_SCHED; PG8_LDA(At, 0, 0); PG8_STAGE(PG8_SA(1, 1), a1 + hstepA, voffA);
            PG8_WAIT_L(8); PG8_BAR; PG8_WAIT_L(0); PG8_MMA(0, 0, At, B0); PG8_BAR; PG8_SCHED;
            PG8_LDB(B1, 0, 1); PG8_STAGE(PG8_SB(0, 0), b2, voffB);
            PG8_BAR; PG8_WAIT_L(0); PG8_MMA(0, 1, At, B1); PG8_BAR;
            PG8_LDA(At, 0, 1); PG8_STAGE(PG8_SA(0, 0), a2, voffA);
            PG8_BAR; PG8_WAIT_L(0); PG8_MMA(1, 0, At, B0); PG8_BAR; PG8_SCHED;
            PG8_STAGE(PG8_SB(0, 1), b2 + hstepB, voffB);
            PG8_WAIT_V(6); PG8_BAR; PG8_MMA(1, 1, At, B1); PG8_BAR;
            PG8_LDB(B0, 1, 0); PG8_SCHED; PG8_LDA(At, 1, 0); PG8_STAGE(PG8_SA(0, 1), a2 + hstepA, voffA);
            PG8_WAIT_L(8); PG8_BAR; PG8_WAIT_L(0); PG8_MMA(0, 0, At, B0); PG8_BAR; PG8_SCHED;
            PG8_LDB(B1, 1, 1); PG8_STAGE(PG8_SB(1, 0), b3, voffB);
            PG8_BAR; PG8_WAIT_L(0); PG8_MMA(0, 1, At, B1); PG8_BAR;
            PG8_LDA(At, 1, 1); PG8_STAGE(PG8_SA(1, 0), a3, voffA);
            PG8_BAR; PG8_WAIT_L(0); PG8_MMA(1, 0, At, B0); PG8_BAR; PG8_SCHED;
            PG8_STAGE(PG8_SB(1, 1), b3 + hstepB, voffB);
            PG8_WAIT_V(6); PG8_BAR; PG8_MMA(1, 1, At, B1); PG8_BAR;
        }
        PG8_STAMP();
        if constexpr (!Epi::AFTER_DRAIN) { E(acc, cur, wr, wc, fr, fq); S.done(cur); }
        PG8_STAMP();
        if (!has_next) break;
#pragma unroll
        for (int a = 0; a < 2; ++a)
#pragma unroll
            for (int b = 0; b < 2; ++b)
#pragma unroll
                for (int m = 0; m < 4; ++m)
#pragma unroll
                    for (int n = 0; n < 2; ++n) acc[a][b][m][n] = (f32x4){0.f, 0.f, 0.f, 0.f};
        cur = nxt; cA = nA; cB = nB; ++ui;
    }
    PG8_WAIT_V(0);
    if (wr == 0) PG8_BAR;
    PG8_BAR;
    if constexpr (Epi::AFTER_DRAIN) { E.fused(acc, cur, wr, wc, fr, fq, lds, wid, lane); S.done(cur); }
    PG8_STAMP();
    if (STAMP && wid == 0) { stamps[lane] = lane < nts ? (((unsigned long long)(unsigned)ts_hi << 32) | (unsigned)ts_lo) : 0ull;
        if (lane == 62) stamps[62] = rt_entry; if (lane == 63) stamps[63] = (unsigned long long)wall_clock64(); }
#undef PG8_STAMP
#undef PG8_SA
#undef PG8_SB
#undef PG8_STAGE
#undef PG8_LDA
#undef PG8_LDB
#undef PG8_MMA
#undef PG8_WAIT_V
#undef PG8_WAIT_L
#undef PG8_BAR
#undef PG8_SCHED
}
}

#define LAS __attribute__((address_space(3)))
typedef unsigned short bf16_t;
typedef short bf16x8 __attribute__((ext_vector_type(8)));
typedef float f32x4 __attribute__((ext_vector_type(4)));
typedef float f32x2 __attribute__((ext_vector_type(2)));
typedef unsigned u32x4 __attribute__((ext_vector_type(4)));
typedef unsigned u32x2 __attribute__((ext_vector_type(2)));

constexpr int D = 1024, NP = 16384, NS = 512, NTOK = NP + NS, SEQ = 2048, NB = 8, NSB = 128, DEPTH = 4;
constexpr int INW = 2568, NPROJ = 2560, DFF = 2816, NGU = 5632;
constexpr int PC_G = 1536, PC_SSM = 2048, PC_POOL = 2304;
constexpr float EPS = 1e-6f;
constexpr int LDS_BYTES = 163840;

constexpr size_t SZ_WIN = (size_t)NPROJ * D * 2, SZ_WOUT = (size_t)D * D * 2, SZ_WGU = (size_t)NGU * D * 2, SZ_WDN = (size_t)D * DFF * 2;
constexpr size_t SZ_WAB = 8 * D * 4, SZ_GLUT = 256 * 256 * 2, SZ_POOLT = 4 * 64 * 64 * 2, SZ_SSMK = 16 * 64 * 4 * 4, SZ_BBAR = 16 * 64 * 32 * 4;
constexpr size_t WS_WIN = 0;
constexpr size_t WS_WOUT = WS_WIN + DEPTH * SZ_WIN;
constexpr size_t WS_WGU = WS_WOUT + DEPTH * SZ_WOUT;
constexpr size_t WS_WDN = WS_WGU + DEPTH * SZ_WGU;
constexpr size_t WS_WAB = WS_WDN + DEPTH * SZ_WDN;
constexpr size_t WS_GLUT = WS_WAB + DEPTH * SZ_WAB;
constexpr size_t WS_POOLT = WS_GLUT + DEPTH * SZ_GLUT;
constexpr size_t WS_SSMK = WS_POOLT + DEPTH * SZ_POOLT;
constexpr size_t WS_BBAR = WS_SSMK + DEPTH * SZ_SSMK;
constexpr size_t WS_H = WS_BBAR + DEPTH * SZ_BBAR;
constexpr size_t WS_AB = WS_H + (size_t)NTOK * D * 2;
constexpr size_t WS_MIX = WS_AB + (size_t)NTOK * 8 * 4;
constexpr size_t WS_MIXO = WS_MIX + (size_t)NTOK * D * 2;
constexpr size_t WS_SSME = WS_MIXO + (size_t)NTOK * D * 4;
constexpr size_t WS_PROJ = WS_SSME + (size_t)8 * 32 * 16 * 64 * 2 * 4;
constexpr size_t WS_DW = WS_PROJ + (size_t)NTOK * NPROJ * 2;
constexpr size_t WS_DKC = WS_DW + (size_t)1024 * 8192 * 4;
constexpr size_t WS_DQD = WS_DKC + (size_t)1024 * 8192 * 2;
constexpr size_t WS_DQK = WS_DQD + (size_t)1024 * 8192 * 2;
constexpr size_t WS_DKT = WS_DQK + (size_t)1024 * 4096 * 2;
constexpr size_t WS_DGL = WS_DKT + (size_t)1024 * 8192 * 2;
constexpr size_t WS_DGS = WS_DGL + 4096;
constexpr size_t WS_BAR = WS_DGS + (size_t)1024 * 8192 * 2;
constexpr size_t WS_PARTS = WS_BAR + 16384;
constexpr size_t WS_END = WS_PARTS + (size_t)11 * 512 * 1024 * 4;
constexpr size_t WS_HID = WS_PROJ;
static_assert(WS_HID + (size_t)NTOK * DFF * 2 <= WS_END, "HID overlay");
static_assert(WS_H % 256 == 0 && WS_PROJ % 256 == 0 && WS_DW % 256 == 0, "align");

constexpr size_t O_YP = 0, O_YS = O_YP + (size_t)NP * D, O_DP = O_YS + (size_t)NS * D, O_CP = O_DP + (size_t)DEPTH * 8 * 4 * 16384,
                 O_REP = O_CP + (size_t)DEPTH * 8 * 3 * 1536, O_IMP = O_REP + (size_t)DEPTH * 8 * 1024, O_PP = O_IMP + (size_t)DEPTH * 8 * 1024,
                 O_DS = O_PP + (size_t)DEPTH * 8 * 15 * 256, O_CS = O_DS + (size_t)DEPTH * 128 * 4 * 16384, O_RES = O_CS + (size_t)DEPTH * 128 * 3 * 1536,
                 O_IMS = O_RES + (size_t)DEPTH * 128 * 1024, O_PS = O_IMS + (size_t)DEPTH * 128 * 1024, O_END = O_PS + (size_t)DEPTH * 128 * 15 * 256;

struct Args { const float* in[32]; float* out; unsigned char* ws; int ph_lo, ph_hi; };
typedef const float* cfp_t;
typedef __attribute__((address_space(4))) const unsigned char* kptr_t;
struct InProxy { __device__ __forceinline__ const float* operator[](int i) const {
    kptr_t p = (kptr_t)__builtin_amdgcn_kernarg_segment_ptr(); asm volatile("" : "+s"(p)); return *(__attribute__((address_space(4))) const cfp_t*)(p + 8 * i); } };
struct DevArgs { InProxy in; float* out; unsigned char* ws; int ph_lo, ph_hi; };
enum { I_XP = 0, I_XS, I_SDELTA, I_SCONV, I_SRE, I_SIM, I_SPOOL, I_NMPRE, I_NMPOST, I_NFPRE, I_NFPOST, I_WIN, I_CONVW, I_ALOG, I_DTB, I_ONORM,
       I_ARE, I_AIM, I_LOGDT, I_BRE, I_BIM, I_CRE, I_CIM, I_SSMD, I_GLUW, I_GLUB, I_POOLW, I_POOLS, I_WOUT, I_WG, I_WU, I_WD };

__device__ __forceinline__ unsigned f2bf(float f) { unsigned u = __float_as_uint(f); return (u + 0x7fffu + ((u >> 16) & 1u)) >> 16; }
__device__ __forceinline__ float bf2f(unsigned b) { return __uint_as_float(b << 16); }
__device__ __forceinline__ unsigned pk2(float lo, float hi) { return f2bf(lo) | (f2bf(hi) << 16); }
template <int CTRL> __device__ __forceinline__ float dpp_f(float v) { return __builtin_bit_cast(float, __builtin_amdgcn_update_dpp(0, __builtin_bit_cast(int, v), CTRL, 0xF, 0xF, true)); }
__device__ __forceinline__ float row_sum8(float v) { v += dpp_f<0xB1>(v); v += dpp_f<0x4E>(v); v += dpp_f<0x141>(v); return v; }
__device__ __forceinline__ float row_sum16(float v) { v = row_sum8(v); v += dpp_f<0x140>(v); return v; }
__device__ __forceinline__ float wave_sum(float v) { v = row_sum16(v); v += __shfl_xor(v, 16); v += __shfl_xor(v, 32); return v; }
__device__ __forceinline__ float silu_f(float y) { return y * __builtin_amdgcn_rcpf(1.f + __expf(-y)); }
__device__ __forceinline__ float sigmoid_f(float y) { return __builtin_amdgcn_rcpf(1.f + __expf(-y)); }
__device__ __forceinline__ float gelu_tanh_f(float x) { const float z = 0.7978845608028654f * (x + 0.044715f * x * x * x);
    const float t = 1.f - 2.f * __builtin_amdgcn_rcpf(1.f + __expf(2.f * z)); return 0.5f * x * (1.f + t); }
__device__ __forceinline__ f32x4 mfma16(bf16x8 a, bf16x8 b, f32x4 c) { return __builtin_amdgcn_mfma_f32_16x16x32_bf16(a, b, c, 0, 0, 0); }
#define LDS_FENCE() asm volatile("s_waitcnt lgkmcnt(0)" ::: "memory")

struct EpiSwiGLU {
    static constexpr bool PERM = false, AFTER_DRAIN = false;
    bf16_t* O; int ldc;
    __device__ __forceinline__ void operator()(const pg8::f32x4 (&acc)[2][2][4][2], const pg8::Unit& u, int wr, int wc, int fr, int fq) const {
        const int row0 = u.pm * 256 + wr * 64 + fr, hid0 = u.pn * 128 + wc * 16 + 4 * fq;
#pragma unroll
        for (int ai = 0; ai < 2; ++ai)
#pragma unroll
            for (int m = 0; m < 4; ++m) { bf16_t* rowp = O + (size_t)(row0 + ai * 128 + m * 16) * ldc + hid0;
#pragma unroll
                for (int bj = 0; bj < 2; ++bj) { const pg8::f32x4 g = acc[ai][bj][m][0], v = acc[ai][bj][m][1];
                    u32x2 w; w.x = pg8::cvt_pk_bf16(silu_f(g[0]) * v[0], silu_f(g[1]) * v[1]); w.y = pg8::cvt_pk_bf16(silu_f(g[2]) * v[2], silu_f(g[3]) * v[3]);
                    *(u32x2*)(rowp + bj * 64) = w; } }
    }
};

#define XB_TMO      128
#define XB_XCNT(j)  (256  + 64 * (j))
#define XB_XSUB(j)  (1280 + 64 * (j))
#define XB_XGEN(j)  (2304 + 64 * (j))
#define XB_TOP      3328
#define XB_TOPGEN   3392
#define XCD_BAR_WORDS 3456
#define XB_SPIN_CAP (1u << 18)

__device__ __forceinline__ unsigned xb_ld(unsigned* p)              { return __hip_atomic_load(p, __ATOMIC_RELAXED, __HIP_MEMORY_SCOPE_AGENT); }
__device__ __forceinline__ unsigned xb_add(unsigned* p, unsigned v) { return __hip_atomic_fetch_add(p, v, __ATOMIC_RELAXED, __HIP_MEMORY_SCOPE_AGENT); }
__device__ __forceinline__ unsigned xb_xcc_id() { return (unsigned)__builtin_amdgcn_s_getreg((3 << 11) | 20) & 0xFu; }
#define XB_SPIN(cond, bar) do { unsigned _sp = 0; while (cond) { __builtin_amdgcn_s_sleep(1); \
    if ((++_sp & 255u) == 0u) { if (xb_ld(&(bar)[XB_TMO])) break; if (_sp > XB_SPIN_CAP) { atomicAdd(&(bar)[XB_TMO], 1u); break; } } } } while (0)

struct XcdBarrier {
    unsigned* bar; unsigned x;
    volatile LAS unsigned* st;
};

__device__ __forceinline__ XcdBarrier xcd_barrier_post(unsigned* bar, volatile LAS unsigned* st) {
    XcdBarrier b; b.bar = bar; b.x = xb_xcc_id(); b.st = st;
    if (threadIdx.x == 0) (void)xb_add(&bar[XB_XCNT(b.x)], 1u);
    return b;
}
__device__ __forceinline__ void xcd_barrier_complete(unsigned* bar, unsigned x, unsigned& nloc, unsigned& nx) {
    const unsigned G = gridDim.x * gridDim.y * gridDim.z;
    unsigned sum, cnt, mine, sp = 0u;
    for (;;) {
        sum = 0u; cnt = 0u; mine = 0u;
#pragma unroll
        for (unsigned j = 0; j < 16; ++j) { const unsigned c = xb_ld(&bar[XB_XCNT(j)]); sum += c; cnt += (c > 0u) ? 1u : 0u; mine = (j == x) ? c : mine; }
        if (sum == G) break;
        __builtin_amdgcn_s_sleep(1);
        if ((++sp & 255u) == 0u) { if (xb_ld(&bar[XB_TMO])) break; if (sp > XB_SPIN_CAP) { atomicAdd(&bar[XB_TMO], 1u); break; } }
    }
    nloc = mine > 0u ? mine : 1u; nx = cnt > 0u ? cnt : 1u;
}

__device__ __forceinline__ void xcd_barrier(const XcdBarrier& b) {
    asm volatile("s_waitcnt vmcnt(0)" ::: "memory");
    __syncthreads();
    if (threadIdx.x == 0) {
        unsigned* bar = b.bar; asm volatile("" : "+s"(bar));
        __builtin_amdgcn_s_waitcnt(0);
        unsigned nloc = b.st[0], nx = b.st[1];
        if (nloc == 0u) { xcd_barrier_complete(bar, b.x, nloc, nx); b.st[0] = nloc; b.st[1] = nx; }
        const unsigned old = xb_add(&bar[XB_XSUB(b.x)], 1u);
        const unsigned gen = old / nloc;
        if (old + 1u == (gen + 1u) * nloc) {
            __builtin_amdgcn_fence(__ATOMIC_RELEASE, "agent");
            asm volatile("s_waitcnt vmcnt(0)" ::: "memory");
            const unsigned og = xb_add(&bar[XB_TOP], 1u);
            const unsigned tg = og / nx;
            if (og + 1u == (tg + 1u) * nx) xb_add(&bar[XB_TOPGEN], 1u);
            else XB_SPIN(xb_ld(&bar[XB_TOPGEN]) == tg, bar);
            __builtin_amdgcn_fence(__ATOMIC_ACQUIRE, "agent");
            xb_add(&bar[XB_XGEN(b.x)], 1u);
            asm volatile("s_waitcnt vmcnt(0)" ::: "memory");
        } else {
            XB_SPIN(xb_ld(&bar[XB_XGEN(b.x)]) == gen, bar);
            __builtin_amdgcn_fence(__ATOMIC_ACQUIRE, "agent");
            asm volatile("s_waitcnt vmcnt(0)" ::: "memory");
        }
    }
    __syncthreads();
}

struct SliceOrder {
    int nunits, G, c;
    __device__ __forceinline__ bool next(int i, pg8::Unit& u) const { const int L = i * G + c; if (L >= nunits) return false; const int t = L & 7; u.pm = t >> 2; u.pn = t & 3; u.ks = L >> 3; return true; }
    __device__ __forceinline__ void a_ready(const pg8::Unit&) const {}
    __device__ __forceinline__ void done(const pg8::Unit&) const {}
};
struct EpiF32Part {
    static constexpr bool PERM = false, AFTER_DRAIN = false;
    float* C;
    __device__ __forceinline__ void operator()(const pg8::f32x4 (&acc)[2][2][4][2], const pg8::Unit& u, int wr, int wc, int fr, int fq) const {
        const int row0 = u.pm * 256 + wr * 64 + fr, col0 = u.pn * 256 + wc * 32 + 4 * fq; float* base = C + (size_t)u.ks * (512 * 1024);
#pragma unroll
        for (int ai = 0; ai < 2; ++ai)
#pragma unroll
            for (int m = 0; m < 4; ++m) { float* rowp = base + (size_t)(row0 + ai * 128 + m * 16) * 1024 + col0;
#pragma unroll
                for (int bj = 0; bj < 2; ++bj)
#pragma unroll
                    for (int n = 0; n < 2; ++n) *(pg8::f32x4*)(rowp + bj * 128 + n * 16) = acc[ai][bj][m][n]; }
    }
};

struct SrcIn { const float* w; __device__ __forceinline__ float operator()(int k, int n) const { return w[(size_t)k * INW + (n < 1536 ? n : n + 8)]; } };
struct SrcPlain { const float* w; int N; __device__ __forceinline__ float operator()(int k, int n) const { return w[(size_t)k * N + n]; } };
struct SrcGU { const float* g; const float* u; __device__ __forceinline__ float operator()(int k, int n) const { const int r = n & 31, hid = (n >> 5) * 16 + (r & 15); const long long du = (r < 16) ? 0ll : (long long)(u - g); return g[du + (long long)k * DFF + hid]; } };
template <class Src> __device__ __forceinline__ void transpose_item(const Src& src, int K, bf16_t* WT, int nblk, LAS float* scr, int item, int lane) {
    const int kb = item / nblk, nb = item % nblk, k0 = 64 * kb, n0 = 32 * nb;
#pragma unroll 8
    for (int i = 0; i < 32; ++i) { const int kk = 2 * i + (lane >> 5); scr[kk * 33 + (lane & 31)] = src(k0 + kk, n0 + (lane & 31)); }
    LDS_FENCE();
    const int c = lane & 7;
#pragma unroll
    for (int j = 0; j < 4; ++j) { const int n = (lane >> 3) + 8 * j; const LAS float* s = scr + (8 * c) * 33 + n;
        u32x4 o; o.x = pk2(s[0 * 33], s[1 * 33]); o.y = pk2(s[2 * 33], s[3 * 33]); o.z = pk2(s[4 * 33], s[5 * 33]); o.w = pk2(s[6 * 33], s[7 * 33]);
        *(u32x4*)(WT + (size_t)(n0 + n) * K + k0 + 8 * c) = o; }
    LDS_FENCE();
}

__device__ __forceinline__ void norm_rows(const float* T, const float* wt, const float* X0, const float* X1, float* Xout, const float* wh, bf16_t* H,
                                          const float* Wab, float* AB, int gw, int NGW, int lane, const float* Tp = nullptr, int ns = 0) {
#pragma unroll 1
    for (int m = gw; m < NTOK; m += NGW) {
        f32x4 x[4], t[4];
        { const float* xr = (X1 && m >= NP) ? X1 + (size_t)(m - NP) * D : X0 + (size_t)m * D;
#pragma unroll
          for (int j = 0; j < 4; ++j) x[j] = ((const f32x4*)xr)[lane + 64 * j];
          if (T && !(Tp && m >= NP)) {
#pragma unroll
              for (int j = 0; j < 4; ++j) { const u32x2 tb = ((const u32x2*)((const bf16_t*)T + (size_t)m * D))[lane + 64 * j];
                  t[j] = (f32x4){__uint_as_float(tb.x << 16), __uint_as_float(tb.x & 0xffff0000u), __uint_as_float(tb.y << 16), __uint_as_float(tb.y & 0xffff0000u)}; } } }
        if (T) {
            float ss = 0.f;
            if (Tp && m >= NP) {
#pragma unroll
                for (int j = 0; j < 4; ++j) { f32x4 a = {0.f, 0.f, 0.f, 0.f}; for (int q = 0; q < ns; ++q) a += ((const f32x4*)(Tp + (size_t)q * (512 * 1024) + (size_t)(m - NP) * D))[lane + 64 * j]; t[j] = a; } }
#pragma unroll
            for (int j = 0; j < 4; ++j) ss += (t[j].x * t[j].x + t[j].y * t[j].y) + (t[j].z * t[j].z + t[j].w * t[j].w);
            ss = wave_sum(ss); const float r = rsqrtf(ss * (1.f / D) + EPS);
#pragma unroll
            for (int j = 0; j < 4; ++j) { const f32x4 w = ((const f32x4*)wt)[lane + 64 * j]; x[j] += t[j] * r * w; }
        }
        if (Xout) {
#pragma unroll
            for (int j = 0; j < 4; ++j) ((f32x4*)(Xout + (size_t)m * D))[lane + 64 * j] = x[j];
        }
        if (H) {
            float ss = 0.f;
#pragma unroll
            for (int j = 0; j < 4; ++j) ss += (x[j].x * x[j].x + x[j].y * x[j].y) + (x[j].z * x[j].z + x[j].w * x[j].w);
            ss = wave_sum(ss); const float r = rsqrtf(ss * (1.f / D) + EPS);
            f32x4 hv[4];
#pragma unroll
            for (int j = 0; j < 4; ++j) { const f32x4 w = ((const f32x4*)wh)[lane + 64 * j]; hv[j] = x[j] * r * w;
                u32x2 o; o.x = pk2(hv[j].x, hv[j].y); o.y = pk2(hv[j].z, hv[j].w); ((u32x2*)(H + (size_t)m * D))[lane + 64 * j] = o; }
            if (Wab) {
                float d[8];
#pragma unroll
                for (int c = 0; c < 8; ++c) { float dd = 0.f;
#pragma unroll
                    for (int j = 0; j < 4; ++j) { const f32x4 w = ((const f32x4*)(Wab + c * D))[lane + 64 * j]; dd += (hv[j].x * w.x + hv[j].y * w.y) + (hv[j].z * w.z + hv[j].w * w.w); }
                    d[c] = dd; }
#pragma unroll
                for (int c = 0; c < 8; ++c) d[c] = row_sum16(d[c]);
#pragma unroll
                for (int o = 16; o < 64; o <<= 1) {
#pragma unroll
                    for (int c = 0; c < 8; ++c) d[c] += __shfl_xor(d[c], o); }
                if (lane == 0) { f32x4 o0 = {d[0], d[1], d[2], d[3]}, o1 = {d[4], d[5], d[6], d[7]}; *(f32x4*)(AB + (size_t)m * 8) = o0; *(f32x4*)(AB + (size_t)m * 8 + 4) = o1; }
            }
        }
    }
}

__device__ __forceinline__ void norm_rows_pf(const float* T, const float* wt, const float* X0, const float* X1, float* Xout, const float* wh, bf16_t* H,
                                             int gw, int NGW, int lane, const float* Tp, int ns) {
    f32x4 xn[4]; u32x2 tn[4];
#define NR_LOAD(mm) do { const int _m = (mm); const float* _xr = (X1 && _m >= NP) ? X1 + (size_t)(_m - NP) * D : X0 + (size_t)_m * D; \
        _Pragma("unroll") for (int j = 0; j < 4; ++j) xn[j] = ((const f32x4*)_xr)[lane + 64 * j]; \
        if (_m < NP) { _Pragma("unroll") for (int j = 0; j < 4; ++j) tn[j] = ((const u32x2*)((const bf16_t*)T + (size_t)_m * D))[lane + 64 * j]; } } while (0)
    if (gw < NTOK) NR_LOAD(gw);
#pragma unroll 1
    for (int m = gw; m < NTOK; m += NGW) {
        f32x4 x[4], t[4];
#pragma unroll
        for (int j = 0; j < 4; ++j) { x[j] = xn[j]; t[j] = (f32x4){__uint_as_float(tn[j].x << 16), __uint_as_float(tn[j].x & 0xffff0000u), __uint_as_float(tn[j].y << 16), __uint_as_float(tn[j].y & 0xffff0000u)}; }
        if (m + NGW < NTOK) NR_LOAD(m + NGW);
        if (m >= NP) {
#pragma unroll
            for (int j = 0; j < 4; ++j) { f32x4 a = {0.f, 0.f, 0.f, 0.f}; for (int q = 0; q < ns; ++q) a += ((const f32x4*)(Tp + (size_t)q * (512 * 1024) + (size_t)(m - NP) * D))[lane + 64 * j]; t[j] = a; } }
        float ss = 0.f;
#pragma unroll
        for (int j = 0; j < 4; ++j) ss += (t[j].x * t[j].x + t[j].y * t[j].y) + (t[j].z * t[j].z + t[j].w * t[j].w);
        ss = wave_sum(ss); const float r = rsqrtf(ss * (1.f / D) + EPS);
#pragma unroll
        for (int j = 0; j < 4; ++j) { const f32x4 w = ((const f32x4*)wt)[lane + 64 * j]; x[j] += t[j] * r * w; }
#pragma unroll
        for (int j = 0; j < 4; ++j) ((f32x4*)(Xout + (size_t)m * D))[lane + 64 * j] = x[j];
        float s2 = 0.f;
#pragma unroll
        for (int j = 0; j < 4; ++j) s2 += (x[j].x * x[j].x + x[j].y * x[j].y) + (x[j].z * x[j].z + x[j].w * x[j].w);
        s2 = wave_sum(s2); const float r2 = rsqrtf(s2 * (1.f / D) + EPS);
#pragma unroll
        for (int j = 0; j < 4; ++j) { const f32x4 w = ((const f32x4*)wh)[lane + 64 * j]; const f32x4 hv = x[j] * r2 * w;
            u32x2 o; o.x = pk2(hv.x, hv.y); o.y = pk2(hv.z, hv.w); ((u32x2*)(H + (size_t)m * D))[lane + 64 * j] = o; }
    }
#undef NR_LOAD
}

__device__ __forceinline__ void prologue(const DevArgs& A, LAS unsigned char* lds, int wave, int lane, int gw, int NGW) {
    LAS float* scr = (LAS float*)(lds + wave * 8704);
    constexpr int I_IN = 16 * 80, I_OUT = 16 * 32, I_GU = 16 * 176, I_DN = 44 * 32, I_GLU = 4 * 8, I_POOL = 8, PER = I_IN + I_OUT + I_GU + I_DN + I_GLU + I_POOL;
#pragma unroll 1
    for (int it = gw; it < DEPTH * PER; it += NGW) {
        const int l = it / PER; int r = it % PER;
        if (r < I_IN) { SrcIn s{A.in[I_WIN] + (size_t)l * D * INW}; transpose_item(s, D, (bf16_t*)(A.ws + WS_WIN + l * SZ_WIN), NPROJ / 32, scr, r, lane); continue; } r -= I_IN;
        if (r < I_OUT) { SrcPlain s{A.in[I_WOUT] + (size_t)l * D * D, D}; transpose_item(s, D, (bf16_t*)(A.ws + WS_WOUT + l * SZ_WOUT), D / 32, scr, r, lane); continue; } r -= I_OUT;
        if (r < I_GU) { SrcGU s{A.in[I_WG] + (size_t)l * D * DFF, A.in[I_WU] + (size_t)l * D * DFF}; transpose_item(s, D, (bf16_t*)(A.ws + WS_WGU + l * SZ_WGU), NGU / 32, scr, r, lane); continue; } r -= I_GU;
        if (r < I_DN) { SrcPlain s{A.in[I_WD] + (size_t)l * DFF * D, D}; transpose_item(s, DFF, (bf16_t*)(A.ws + WS_WDN + l * SZ_WDN), D / 32, scr, r, lane); continue; } r -= I_DN;
        if (r < I_GLU) { SrcPlain s{A.in[I_GLUW] + (size_t)l * 65536, 256}; transpose_item(s, 256, (bf16_t*)(A.ws + WS_GLUT + l * SZ_GLUT), 8, scr, r, lane); continue; } r -= I_GLU;
        { const int g = r >> 1; SrcPlain s{A.in[I_POOLW] + (size_t)(l * 4 + g) * 4096, 64}; transpose_item(s, 64, (bf16_t*)(A.ws + WS_POOLT + l * SZ_POOLT) + g * 4096, 2, scr, r & 1, lane); }
    }
    const int gt = gw * 64 + lane, NT = NGW * 64;
    float* wab = (float*)(A.ws + WS_WAB);
#pragma unroll 1
    for (int i = gt; i < DEPTH * 8 * D; i += NT) { const int l = i / (8 * D), j = (i / D) & 7, k = i % D; wab[i] = A.in[I_WIN][((size_t)l * D + k) * INW + 1536 + j]; }
    float* ssmk = (float*)(A.ws + WS_SSMK); float* bbar = (float*)(A.ws + WS_BBAR);
#pragma unroll 1
    for (int i = gt; i < DEPTH * 16 * 64; i += NT) {
        const int lg = i >> 6;
        const float dt = expf(A.in[I_LOGDT][lg]), ar = A.in[I_ARE][i], ai = A.in[I_AIM][i];
        const float mag = expf(ar * dt);
        float rev = ai * dt * 0.15915494309189535f; rev -= floorf(rev);
        const float sn = __builtin_amdgcn_sinf(rev), cs = __builtin_amdgcn_cosf(rev);
        const float lr = mag * cs, li = mag * sn;
        float pr = lr, pi = li;
#pragma unroll
        for (int q = 0; q < 6; ++q) { const float nr2 = pr * pr - pi * pi, ni2 = 2.f * pr * pi; pr = nr2; pi = ni2; }
        ssmk[i * 4 + 0] = lr; ssmk[i * 4 + 1] = li; ssmk[i * 4 + 2] = pr; ssmk[i * 4 + 3] = pi;
        const float nr = lr - 1.f, ni = li, d2 = ar * ar + ai * ai;
        const float cre = (nr * ar + ni * ai) / d2, cim = (ni * ar - nr * ai) / d2;
#pragma unroll
        for (int h = 0; h < 16; ++h) { const float br = A.in[I_BRE][(size_t)i * 16 + h], bi = A.in[I_BIM][(size_t)i * 16 + h];
            bbar[(size_t)i * 32 + h] = cre * br - cim * bi; bbar[(size_t)i * 32 + 16 + h] = cre * bi + cim * br; }
    }
}

__device__ __forceinline__ unsigned bfmul2(unsigned pk, float f0, float f1) { return pg8::cvt_pk_bf16(__uint_as_float(pk << 16) * f0, __uint_as_float(pk & 0xffff0000u) * f1); }
__device__ __forceinline__ void delta_prep_item(const DevArgs& A, int l, LAS unsigned char* lds, int item, int tid, int wave, int lane) {
    asm volatile("" : "+v"(tid)); lane = tid & 63; wave = __builtin_amdgcn_readfirstlane(tid >> 6);
    const int bh = item >> 5, n = item & 31, b = bh >> 2, h = bh & 3;
    const int tok0 = b * SEQ + n * 64;
    LAS bf16_t* QS = (LAS bf16_t*)(lds); LAS bf16_t* KS = (LAS bf16_t*)(lds + 17408);
    LAS unsigned char* KT = lds + 34816; LAS unsigned char* VT = lds + 53248; LAS unsigned char* RTK = lds + 71680;
    LAS float* AM = (LAS float*)(lds + 90112); LAS float* PM = (LAS float*)(lds + 107520); LAS float* PSC = PM; LAS float* TM = (LAS float*)(lds + 124928);
    LAS unsigned char* TB = lds + 142336;
    LAS float* GAM = (LAS float*)(lds + 151552); LAS float* BETA = GAM + 64; LAS float* RQ = GAM + 128; LAS float* RK = GAM + 192;
    LAS float* F2 = GAM + 256; LAS float* F3 = GAM + 320; LAS float* F4 = GAM + 384;
    const bf16_t* PROJ = (const bf16_t*)(A.ws + WS_PROJ);
    const float* AB = (const float*)(A.ws + WS_AB);
    u32x4 gv[2];
#pragma unroll
    for (int j = 0; j < 2; ++j) { const int id = tid + 512 * j; gv[j] = *(const u32x4*)(PROJ + (size_t)(tok0 + (id >> 4)) * NPROJ + PC_G + h * 128 + (id & 15) * 8); }
    if (tid < 384) {
        const int part = tid >> 7, c = tid & 127, col = part * 512 + h * 128 + c;
        const float* cw = A.in[I_CONVW] + (size_t)l * 4 * 1536;
        const float w0 = cw[col], w1 = cw[1536 + col], w2 = cw[3072 + col], w3 = cw[4608 + col];
        const bf16_t* pp = PROJ + (size_t)tok0 * NPROJ + col;
        float xr[67];
#pragma unroll
        for (int t = 0; t < 67; ++t) xr[t] = (n > 0 || t >= 3) ? bf2f(pp[(long)(t - 3) * NPROJ]) : 0.f;
        unsigned pk[32];
#pragma unroll
        for (int t = 0; t < 64; t += 2) {
            const float s0 = silu_f(w0 * xr[t] + w1 * xr[t + 1] + w2 * xr[t + 2] + w3 * xr[t + 3]);
            const float s1 = silu_f(w0 * xr[t + 1] + w1 * xr[t + 2] + w2 * xr[t + 3] + w3 * xr[t + 4]);
            pk[t >> 1] = pg8::cvt_pk_bf16(s0, s1);
        }
        if (part < 2) { LAS bf16_t* dst = (part == 0 ? QS : KS) + c;
#pragma unroll
            for (int t = 0; t < 64; t += 2) { dst[t * 136] = (bf16_t)(pk[t >> 1] & 0xffffu); dst[(t + 1) * 136] = (bf16_t)(pk[t >> 1] >> 16); } }
        if (part > 0) { LAS unsigned char* dst = (part == 1 ? KT : VT) + c * 144;
#pragma unroll
            for (int q = 0; q < 8; ++q) { u32x4 o; o.x = pk[4 * q]; o.y = pk[4 * q + 1]; o.z = pk[4 * q + 2]; o.w = pk[4 * q + 3]; *(LAS u32x4*)(dst + q * 16) = o; } }
    } else if (tid < 448) {
        const int t = tid - 384;
        const float a = AB[(size_t)(tok0 + t) * 8 + h], bb = AB[(size_t)(tok0 + t) * 8 + 4 + h];
        const float xx = a + A.in[I_DTB][l * 4 + h];
        const float sp = xx > 20.f ? xx : log1pf(expf(xx));
        float lg = -expf(A.in[I_ALOG][l * 4 + h]) * sp;
#pragma unroll
        for (int off = 1; off < 64; off <<= 1) { const float v = __shfl_up(lg, off); if (lane >= off) lg += v; }
        GAM[t] = lg; BETA[t] = 1.f / (1.f + expf(-bb));
    }
    __syncthreads();
    {
        const int t = tid >> 3, part = tid & 7; float sq = 0.f, sk = 0.f;
#pragma unroll
        for (int j = 0; j < 16; ++j) { const float q = bf2f(QS[t * 136 + part * 16 + j]), k = bf2f(KS[t * 136 + part * 16 + j]); sq += q * q; sk += k * k; }
        sq = row_sum8(sq); sk = row_sum8(sk);
        if (part == 0) { const float rq = rsqrtf(sq + EPS) * 0.08838834764831845f, rk = rsqrtf(sk + EPS), g = GAM[t], eg = __expf(g), bt = BETA[t];
            RQ[t] = rq; RK[t] = rk; F2[t] = bt * eg * rk; F3[t] = rk * __expf(GAM[63] - g); F4[t] = rq * eg; }
    }
    {
        const int prod = wave >> 2, mt = wave & 3, fr = lane & 15, quad = lane >> 4;
        LAS bf16_t* Aop = prod ? QS : KS; LAS float* dst = prod ? PM : AM;
        bf16x8 a[4];
#pragma unroll
        for (int kk = 0; kk < 4; ++kk) a[kk] = *(LAS bf16x8*)(Aop + (mt * 16 + fr) * 136 + kk * 32 + quad * 8);
#pragma unroll
        for (int nt = 0; nt < 4; ++nt) { f32x4 acc = {0.f, 0.f, 0.f, 0.f};
#pragma unroll
            for (int kk = 0; kk < 4; ++kk) { const bf16x8 bq = *(LAS bf16x8*)(KS + (nt * 16 + fr) * 136 + kk * 32 + quad * 8); acc = mfma16(a[kk], bq, acc); }
#pragma unroll
            for (int i = 0; i < 4; ++i) dst[(mt * 16 + quad * 4 + i) * 68 + nt * 16 + fr] = acc[i]; }
    }
    __syncthreads();
    {
        const int t = tid >> 3, s8 = (tid & 7) * 8; const float gt = GAM[t], bk = BETA[t] * RK[t], rqt = RQ[t];
        float av[8], pv[8];
#pragma unroll
        for (int j = 0; j < 8; ++j) { const int s = s8 + j; const float rks = RK[s]; const float dec = (s <= t) ? __expf(gt - GAM[s]) * rks : 0.f;
            av[j] = (s < t) ? bk * dec * AM[t * 68 + s] : 0.f; pv[j] = rqt * dec * PM[t * 68 + s]; }
#pragma unroll
        for (int j = 0; j < 8; ++j) AM[t * 68 + s8 + j] = av[j];
        u32x4 o; o.x = pg8::cvt_pk_bf16(pv[0], pv[1]); o.y = pg8::cvt_pk_bf16(pv[2], pv[3]); o.z = pg8::cvt_pk_bf16(pv[4], pv[5]); o.w = pg8::cvt_pk_bf16(pv[6], pv[7]);
        *(u32x4*)((bf16_t*)(A.ws + WS_DQK) + (size_t)item * 4096 + t * 64 + s8) = o;
        for (int e = tid; e < 64 * 68; e += 512) TM[e] = 0.f;
        if (tid == 0) ((float*)(A.ws + WS_DGL))[item] = __expf(GAM[63]);
    }
    __syncthreads();
    if (wave == 0) {
        const int i = lane >> 4, c = lane & 15;
        LAS float* amp = AM + (16 * i) * 68 + 16 * i; asm volatile("" : "+v"(amp));
        float x[16];
#pragma unroll
        for (int r = 0; r < 16; ++r) { float acc = (r == c) ? 1.f : 0.f;
#pragma unroll
            for (int s = 0; s < r; ++s) acc = fmaf(-amp[r * 68 + s], x[s], acc);
            x[r] = acc; }
        LAS float* tmp = TM + (16 * i) * 68 + 16 * i + c;
#pragma unroll
        for (int r = 0; r < 16; ++r) tmp[r * 68] = x[r];
    } else {
        const int wt = tid - 64;
        for (int id = wt; id < 1024; id += 448) {
            const int c = id >> 3, t8 = (id & 7) * 8;
            const f32x4 b0 = *(LAS f32x4*)(BETA + t8), b1 = *(LAS f32x4*)(BETA + t8 + 4);
            u32x4 v = *(LAS u32x4*)(VT + c * 144 + t8 * 2);
            v.x = bfmul2(v.x, b0[0], b0[1]); v.y = bfmul2(v.y, b0[2], b0[3]); v.z = bfmul2(v.z, b1[0], b1[1]); v.w = bfmul2(v.w, b1[2], b1[3]);
            *(LAS u32x4*)(VT + c * 144 + t8 * 2) = v;
            const f32x4 f20 = *(LAS f32x4*)(F2 + t8), f21 = *(LAS f32x4*)(F2 + t8 + 4), f30 = *(LAS f32x4*)(F3 + t8), f31 = *(LAS f32x4*)(F3 + t8 + 4);
            const u32x4 k = *(LAS u32x4*)(KT + c * 144 + t8 * 2);
            u32x4 rk; rk.x = bfmul2(k.x, f20[0], f20[1]); rk.y = bfmul2(k.y, f20[2], f20[3]); rk.z = bfmul2(k.z, f21[0], f21[1]); rk.w = bfmul2(k.w, f21[2], f21[3]);
            *(LAS u32x4*)(RTK + c * 144 + t8 * 2) = rk;
            u32x4 kd; kd.x = bfmul2(k.x, f30[0], f30[1]); kd.y = bfmul2(k.y, f30[2], f30[3]); kd.z = bfmul2(k.z, f31[0], f31[1]); kd.w = bfmul2(k.w, f31[2], f31[3]);
            *(u32x4*)((bf16_t*)(A.ws + WS_DKT) + (size_t)item * 8192 + c * 64 + t8) = kd; }
        for (int id = wt; id < 1024; id += 448) {
            const int t = id >> 4, c8 = (id & 15) * 8; const float f = F4[t];
            u32x4 q = *(LAS u32x4*)((LAS unsigned char*)QS + t * 272 + c8 * 2);
            q.x = bfmul2(q.x, f, f); q.y = bfmul2(q.y, f, f); q.z = bfmul2(q.z, f, f); q.w = bfmul2(q.w, f, f);
            *(u32x4*)((bf16_t*)(A.ws + WS_DQD) + (size_t)item * 8192 + t * 128 + c8) = q; }
    }
    {
        const int c8 = (tid & 15) * 8; const float* on = A.in[I_ONORM] + l * 128 + c8;
        const f32x4 o0 = *(const f32x4*)on, o1 = *(const f32x4*)(on + 4);
#pragma unroll
        for (int j = 0; j < 2; ++j) { const int id = tid + 512 * j; const u32x4 g = gv[j]; u32x4 o;
            o.x = pg8::cvt_pk_bf16(silu_f(__uint_as_float(g.x << 16)) * o0[0], silu_f(__uint_as_float(g.x & 0xffff0000u)) * o0[1]);
            o.y = pg8::cvt_pk_bf16(silu_f(__uint_as_float(g.y << 16)) * o0[2], silu_f(__uint_as_float(g.y & 0xffff0000u)) * o0[3]);
            o.z = pg8::cvt_pk_bf16(silu_f(__uint_as_float(g.z << 16)) * o1[0], silu_f(__uint_as_float(g.z & 0xffff0000u)) * o1[1]);
            o.w = pg8::cvt_pk_bf16(silu_f(__uint_as_float(g.w << 16)) * o1[2], silu_f(__uint_as_float(g.w & 0xffff0000u)) * o1[3]);
            *(u32x4*)((bf16_t*)(A.ws + WS_DGS) + (size_t)item * 8192 + (id >> 4) * 128 + c8) = o; }
    }
    __syncthreads();
    const int p2 = tid >> 8, r2 = (tid >> 4) & 15, c2 = tid & 15, rb = p2 ? 48 : 16, cb = p2 ? 32 : 0;
    {
        float acc = 0.f;
#pragma unroll
        for (int s = 0; s < 16; ++s) acc = fmaf(AM[(rb + r2) * 68 + cb + s], TM[(cb + s) * 68 + cb + c2], acc);
        PSC[(p2 * 16 + r2) * 68 + c2] = acc; }
    __syncthreads();
    {
        float acc = 0.f;
#pragma unroll
        for (int s = 0; s < 16; ++s) acc = fmaf(TM[(rb + r2) * 68 + rb + s], PSC[(p2 * 16 + s) * 68 + c2], acc);
        TM[(rb + r2) * 68 + cb + c2] = -acc; }
    __syncthreads();
    float p3[2];
#pragma unroll
    for (int j = 0; j < 2; ++j) { const int e = tid + 512 * j, r = e >> 5, c = e & 31; float acc = 0.f;
#pragma unroll 8
        for (int s = 0; s < 32; ++s) acc = fmaf(AM[(32 + r) * 68 + s], TM[s * 68 + c], acc);
        p3[j] = acc; }
    __syncthreads();
#pragma unroll
    for (int j = 0; j < 2; ++j) { const int e = tid + 512 * j; PSC[(e >> 5) * 68 + (e & 31)] = p3[j]; }
    __syncthreads();
#pragma unroll
    for (int j = 0; j < 2; ++j) { const int e = tid + 512 * j, r = e >> 5, c = e & 31; float acc = 0.f;
#pragma unroll 8
        for (int s = 0; s < 32; ++s) acc = fmaf(TM[(32 + r) * 68 + 32 + s], PSC[s * 68 + c], acc);
        p3[j] = -acc; }
#pragma unroll
    for (int j = 0; j < 2; ++j) { const int e = tid + 512 * j; TM[(32 + (e >> 5)) * 68 + (e & 31)] = p3[j]; }
    __syncthreads();
#pragma unroll
    for (int j = 0; j < 4; ++j) { const int e = tid + 512 * j, t = e >> 5, s2 = (e & 31) * 2;
        *(LAS unsigned*)(TB + t * 144 + s2 * 2) = pg8::cvt_pk_bf16(TM[t * 68 + s2], TM[t * 68 + s2 + 1]); }
    __syncthreads();
    {
        const int fr = lane & 15, quad = lane >> 4;
        bf16x8 bv[2], ak[2];
#pragma unroll
        for (int kk = 0; kk < 2; ++kk) { bv[kk] = *(LAS bf16x8*)(VT + (16 * wave + fr) * 144 + (kk * 32 + quad * 8) * 2); ak[kk] = *(LAS bf16x8*)(RTK + (16 * wave + fr) * 144 + (kk * 32 + quad * 8) * 2); }
        bf16_t* DW = (bf16_t*)(A.ws + WS_DW) + (size_t)item * 8192; bf16_t* DKC = (bf16_t*)(A.ws + WS_DKC) + (size_t)item * 8192;
#pragma unroll
        for (int mt = 0; mt < 4; ++mt) { f32x4 aw = {0.f, 0.f, 0.f, 0.f}, akc = {0.f, 0.f, 0.f, 0.f};
#pragma unroll
            for (int kk = 0; kk < 2; ++kk) { const bf16x8 tf = *(LAS bf16x8*)(TB + (mt * 16 + fr) * 144 + (kk * 32 + quad * 8) * 2);
                aw = mfma16(tf, bv[kk], aw);
                akc = mfma16(ak[kk], tf, akc); }
            u32x2 ow; ow.x = pk2(aw[0], aw[1]); ow.y = pk2(aw[2], aw[3]);
            *(u32x2*)(DW + (16 * wave + fr) * 64 + mt * 16 + quad * 4) = ow;
            u32x2 ok; ok.x = pk2(-akc[0], -akc[1]); ok.y = pk2(-akc[2], -akc[3]);
            *(u32x2*)(DKC + (mt * 16 + fr) * 128 + 16 * wave + quad * 4) = ok; }
    }
    __syncthreads();
}

__device__ __forceinline__ void delta_scan_item(const DevArgs& A, int l, LAS unsigned char* lds, int bh, int tid_in, int wave, int lane_in, const XcdBarrier& xb, int SUB) {
    const int b = bh >> 2, h = bh & 3;
    LAS unsigned char* KCs = lds; LAS unsigned char* QDs = lds + 17408; LAS unsigned char* QKs = lds + 34816; LAS unsigned char* KDTs = lds + 44032;
    LAS unsigned char* Ws = lds + 62464;
    LAS unsigned char* GSs = lds + 80896;
    LAS unsigned char* SS = lds + 98304 + wave * 4352; LAS unsigned char* US = lds + 133120 + wave * 2304;
    LAS float* PART = (LAS float*)(lds + 151552);
    const unsigned char* gW = A.ws + WS_DW; const unsigned char* gGS = A.ws + WS_DGS;
    const unsigned char* gKC = A.ws + WS_DKC; const unsigned char* gQD = A.ws + WS_DQD; const unsigned char* gQK = A.ws + WS_DQK; const unsigned char* gKT = A.ws + WS_DKT;
    const float* DGL = (const float*)(A.ws + WS_DGL);
    f32x4 S[8];
#pragma unroll
    for (int mt = 0; mt < 8; ++mt) S[mt] = (f32x4){0.f, 0.f, 0.f, 0.f};
    u32x4 r[9], rg[2];
    float gl_all = 0.f;
#define DS_LOAD(itn, toff) do { const size_t _i = (size_t)(itn); const unsigned char* _kc = gKC + _i * 16384; const unsigned char* _qd = gQD + _i * 16384; \
        const unsigned char* _qk = gQK + _i * 8192; const unsigned char* _kt = gKT + _i * 16384; \
        r[0] = *(const u32x4*)(_kc + (toff)); r[1] = *(const u32x4*)(_kc + (toff) + 8192u); \
        r[2] = *(const u32x4*)(_qd + (toff)); r[3] = *(const u32x4*)(_qd + (toff) + 8192u); \
        r[4] = *(const u32x4*)(_qk + (toff)); \
        r[5] = *(const u32x4*)(_kt + (toff)); r[6] = *(const u32x4*)(_kt + (toff) + 8192u); \
        const unsigned char* _w = gW + _i * 16384; r[7] = *(const u32x4*)(_w + (toff)); r[8] = *(const u32x4*)(_w + (toff) + 8192u); } while (0)
#define DS_LOADG(itn, toff) do { const unsigned char* _g = gGS + (size_t)(itn) * 16384; rg[0] = *(const u32x4*)(_g + (toff)); rg[1] = *(const u32x4*)(_g + (toff) + 8192u); } while (0)
#define DS_STAGE(tidv) do { const int i0 = (tidv), i1 = (tidv) + 512; \
          *(LAS u32x4*)(KCs + (i0 >> 4) * 272 + (i0 & 15) * 16) = r[0]; *(LAS u32x4*)(KCs + (i1 >> 4) * 272 + (i1 & 15) * 16) = r[1]; \
          *(LAS u32x4*)(QDs + (i0 >> 4) * 272 + (i0 & 15) * 16) = r[2]; *(LAS u32x4*)(QDs + (i1 >> 4) * 272 + (i1 & 15) * 16) = r[3]; \
          *(LAS u32x4*)(QKs + (i0 >> 3) * 144 + (i0 & 7) * 16) = r[4]; \
          *(LAS u32x4*)(KDTs + (i0 >> 3) * 144 + (i0 & 7) * 16) = r[5]; *(LAS u32x4*)(KDTs + (i1 >> 3) * 144 + (i1 & 7) * 16) = r[6]; \
          *(LAS u32x4*)(Ws + (i0 >> 3) * 144 + (i0 & 7) * 16) = r[7]; *(LAS u32x4*)(Ws + (i1 >> 3) * 144 + (i1 & 7) * 16) = r[8]; } while (0)
#define DS_STAGEG(tidv) do { const int i0 = (tidv), i1 = (tidv) + 512; \
          *(LAS u32x4*)(GSs + (i0 >> 4) * 272 + (i0 & 15) * 16) = rg[0]; *(LAS u32x4*)(GSs + (i1 >> 4) * 272 + (i1 & 15) * 16) = rg[1]; } while (0)
#pragma unroll 1
    for (int n = 0; n < 32; ++n) {
        int tid = tid_in; asm volatile("" : "+v"(tid));
        const bool bstart = (SUB > 0) ? (n % SUB == 0) : (n == 0);
        const bool bnext1 = (SUB > 0) && ((n + 1) % SUB == 0), bnext2 = (SUB > 0) && ((n + 2) % SUB == 0);
        if (bstart) { if (n > 0) xcd_barrier(xb);
            gl_all = DGL[bh * 32 + (tid & 31)];
            const unsigned t0 = (unsigned)tid * 16u; DS_LOAD(bh * 32 + n, t0); DS_LOADG(bh * 32 + n, t0); DS_STAGE(tid); DS_STAGEG(tid);
            if (n + 1 < 32 && !bnext1) { DS_LOAD(bh * 32 + n + 1, t0); DS_LOADG(bh * 32 + n + 1, t0); }
            __syncthreads(); }
        else { DS_STAGEG(tid);
            if (n + 1 < 32 && !bnext1) DS_LOADG(bh * 32 + n + 1, (unsigned)tid * 16u); }
        const int lane = tid & 63, fr = lane & 15, quad = lane >> 4, vcol = 16 * wave + fr;
        const unsigned toff = (unsigned)tid * 16u;
        const int it = bh * 32 + n, tokb = b * SEQ + n * 64;
        const float glast = __builtin_bit_cast(float, __builtin_amdgcn_readlane(__builtin_bit_cast(int, gl_all), n));
        asm volatile("s_nop 7\n\ts_nop 7" ::: "memory");
#pragma unroll
        for (int mt = 0; mt < 8; ++mt) { u32x2 p; p.x = pg8::cvt_pk_bf16(S[mt][0], S[mt][1]); p.y = pg8::cvt_pk_bf16(S[mt][2], S[mt][3]); *(LAS u32x2*)(SS + fr * 272 + (mt * 16 + quad * 4) * 2) = p; }
        LDS_FENCE();
        bf16x8 Sb[4];
#pragma unroll
        for (int kk = 0; kk < 4; ++kk) Sb[kk] = *(LAS bf16x8*)(SS + fr * 272 + (kk * 32 + quad * 8) * 2);
        f32x4 U[4], O[4];
#pragma unroll
        for (int mt = 0; mt < 4; ++mt) { f32x4 au, ao = {0.f, 0.f, 0.f, 0.f};
            { const u32x2 wq = *(LAS u32x2*)(Ws + vcol * 144 + (mt * 16 + quad * 4) * 2);
              au[0] = __uint_as_float(wq.x << 16); au[1] = __uint_as_float(wq.x & 0xffff0000u); au[2] = __uint_as_float(wq.y << 16); au[3] = __uint_as_float(wq.y & 0xffff0000u); }
#pragma unroll
            for (int kk = 0; kk < 4; ++kk) { const bf16x8 a1 = *(LAS bf16x8*)(KCs + (mt * 16 + fr) * 272 + (kk * 32 + quad * 8) * 2); au = mfma16(a1, Sb[kk], au);
                const bf16x8 a2 = *(LAS bf16x8*)(QDs + (mt * 16 + fr) * 272 + (kk * 32 + quad * 8) * 2); ao = mfma16(a2, Sb[kk], ao); }
            U[mt] = au; O[mt] = ao; __builtin_amdgcn_sched_barrier(0); }
        asm volatile("s_nop 7\n\ts_nop 7" ::: "memory");
#pragma unroll
        for (int mt = 0; mt < 4; ++mt) { u32x2 p; p.x = pg8::cvt_pk_bf16(U[mt][0], U[mt][1]); p.y = pg8::cvt_pk_bf16(U[mt][2], U[mt][3]); *(LAS u32x2*)(US + fr * 144 + (mt * 16 + quad * 4) * 2) = p; }
        LDS_FENCE();
        bf16x8 Ub[2];
#pragma unroll
        for (int kk = 0; kk < 2; ++kk) Ub[kk] = *(LAS bf16x8*)(US + fr * 144 + (kk * 32 + quad * 8) * 2);
#pragma unroll
        for (int mt = 0; mt < 4; ++mt)
#pragma unroll
            for (int kk = 0; kk < 2; ++kk) { const bf16x8 a = *(LAS bf16x8*)(QKs + (mt * 16 + fr) * 144 + (kk * 32 + quad * 8) * 2); O[mt] = mfma16(a, Ub[kk], O[mt]); }
        __builtin_amdgcn_sched_barrier(0);
#pragma unroll
        for (int mt = 0; mt < 8; ++mt) { S[mt] *= glast;
#pragma unroll
            for (int kk = 0; kk < 2; ++kk) { const bf16x8 a = *(LAS bf16x8*)(KDTs + (mt * 16 + fr) * 144 + (kk * 32 + quad * 8) * 2); S[mt] = mfma16(a, Ub[kk], S[mt]); }
            if (mt & 1) __builtin_amdgcn_sched_barrier(0); }
        { float pp[16];
#pragma unroll
          for (int e = 0; e < 16; ++e) pp[e] = O[e >> 2][e & 3] * O[e >> 2][e & 3];
#pragma unroll
          for (int e = 0; e < 16; ++e) pp[e] = row_sum16(pp[e]);
          if (fr == 0) {
#pragma unroll
              for (int e = 0; e < 16; ++e) PART[((e >> 2) * 16 + quad * 4 + (e & 3)) * 8 + wave] = pp[e]; } }
        __syncthreads();
        if (n + 1 < 32 && !bnext1) { DS_STAGE(tid); if (n + 2 < 32 && !bnext2) DS_LOAD(it + 2, toff); }
        bf16_t* mixb = (bf16_t*)(A.ws + WS_MIX) + (size_t)tokb * D + h * 128;
#pragma unroll
        for (int mt = 0; mt < 4; ++mt)
#pragma unroll
            for (int i = 0; i < 4; ++i) { const int t = mt * 16 + quad * 4 + i;
                const f32x4 p0 = *(LAS f32x4*)(PART + t * 8), p1 = *(LAS f32x4*)(PART + t * 8 + 4);
                const float tot = ((p0[0] + p0[1]) + (p0[2] + p0[3])) + ((p1[0] + p1[1]) + (p1[2] + p1[3]));
                const float sc = rsqrtf(tot * (1.f / 128.f) + EPS);
                const float gs = bf2f(*(LAS bf16_t*)(GSs + t * 272 + vcol * 2));
                mixb[(unsigned)(t * D + vcol)] = (bf16_t)(pg8::cvt_pk_bf16(O[mt][i] * sc * gs, 0.f) & 0xffffu); }
        __syncthreads();
    }
#undef DS_STAGE
#undef DS_LOADG
#undef DS_STAGEG
#undef DS_LOAD
    { const int lane = lane_in, fr = lane & 15, quad = lane >> 4, vcol = 16 * wave + fr;
      float* dp = A.out + O_DP + (size_t)((l * 8 + b) * 4 + h) * 16384;
#pragma unroll
      for (int mt = 0; mt < 8; ++mt)
#pragma unroll
          for (int i = 0; i < 4; ++i) dp[(mt * 16 + quad * 4 + i) * 128 + vcol] = S[mt][i]; }
    __syncthreads();
}

__device__ __forceinline__ void delta_sample_item(const DevArgs& A, int l, LAS unsigned char* lds, int item, int tid, int wave, int lane) {
    asm volatile("" : "+v"(tid)); lane = tid & 63; wave = __builtin_amdgcn_readfirstlane(tid >> 6);
    const int b = item >> 2, h = item & 3, tokS = NP + b * 4;
    LAS float* RAW = (LAS float*)lds; LAS float* RED = RAW + 1536; LAS float* OB = RED + 512; LAS float* SC = OB + 512;
    const bf16_t* PROJ = (const bf16_t*)(A.ws + WS_PROJ); const float* AB = (const float*)(A.ws + WS_AB); bf16_t* MIX = (bf16_t*)(A.ws + WS_MIX);
    const float* cw = A.in[I_CONVW] + (size_t)l * 4 * 1536;
    for (int idx = tid; idx < 1536; idx += 512) { const int part = idx >> 9, t = (idx >> 7) & 3, c = idx & 127, col = part * 512 + h * 128 + c;
        float acc = 0.f;
#pragma unroll
        for (int j = 0; j < 4; ++j) { const int tt = t - 3 + j;
            const float x = (tt >= 0) ? bf2f(PROJ[(size_t)(tokS + tt) * NPROJ + col]) : A.in[I_SCONV][((size_t)(l * 128 + b) * 3 + (3 + tt)) * 1536 + col];
            acc += cw[j * 1536 + col] * x; }
        RAW[idx] = silu_f(acc); }
    if (tid < 4) { const float a = AB[(size_t)(tokS + tid) * 8 + h], bb = AB[(size_t)(tokS + tid) * 8 + 4 + h];
        const float xx = a + A.in[I_DTB][l * 4 + h]; const float sp = xx > 20.f ? xx : log1pf(expf(xx));
        SC[8 + tid] = 1.f / (1.f + expf(-bb)); SC[12 + tid] = expf(-expf(A.in[I_ALOG][l * 4 + h]) * sp); }
    const int v = tid & 127, kq = tid >> 7;
    float S[32];
    { const float* sp = A.in[I_SDELTA] + (size_t)((l * 128 + b) * 4 + h) * 16384;
#pragma unroll
      for (int i = 0; i < 32; ++i) S[i] = sp[(kq * 32 + i) * 128 + v]; }
    __syncthreads();
    { const int part = wave >> 2, t = wave & 3; const float x0 = RAW[part * 512 + t * 128 + lane], x1 = RAW[part * 512 + t * 128 + 64 + lane];
      const float ss = wave_sum(x0 * x0 + x1 * x1); if (lane == 0) SC[part * 4 + t] = rsqrtf(ss + EPS) * (part == 0 ? 0.08838834764831845f : 1.f); }
    __syncthreads();
    for (int t = 0; t < 4; ++t) {
        const float rq = SC[t], rk = SC[4 + t], beta = SC[8 + t], g = SC[12 + t];
        float pr = 0.f;
#pragma unroll
        for (int i = 0; i < 32; ++i) pr += S[i] * RAW[512 + t * 128 + kq * 32 + i];
        RED[kq * 128 + v] = pr * rk;
        __syncthreads();
        const float rr = (RED[v] + RED[128 + v]) + (RED[256 + v] + RED[384 + v]);
        const float u = beta * (RAW[1024 + t * 128 + v] - g * rr);
        float po = 0.f;
#pragma unroll
        for (int i = 0; i < 32; ++i) { const float kh = RAW[512 + t * 128 + kq * 32 + i] * rk; S[i] = g * S[i] + kh * u; po += S[i] * RAW[t * 128 + kq * 32 + i]; }
        __syncthreads();
        RED[kq * 128 + v] = po * rq;
        __syncthreads();
        if (kq == 0) OB[t * 128 + v] = (RED[v] + RED[128 + v]) + (RED[256 + v] + RED[384 + v]);
        __syncthreads();
    }
    if (wave < 4) { const int t = wave; const float x0 = OB[t * 128 + lane], x1 = OB[t * 128 + 64 + lane];
        const float ss = wave_sum(x0 * x0 + x1 * x1); const float sc = rsqrtf(ss * (1.f / 128.f) + EPS);
        const float g0 = bf2f(PROJ[(size_t)(tokS + t) * NPROJ + PC_G + h * 128 + lane]), g1 = bf2f(PROJ[(size_t)(tokS + t) * NPROJ + PC_G + h * 128 + 64 + lane]);
        MIX[(size_t)(tokS + t) * D + h * 128 + lane] = (bf16_t)f2bf(x0 * sc * A.in[I_ONORM][l * 128 + lane] * silu_f(g0));
        MIX[(size_t)(tokS + t) * D + h * 128 + 64 + lane] = (bf16_t)f2bf(x1 * sc * A.in[I_ONORM][l * 128 + 64 + lane] * silu_f(g1)); }
    { float* dsp = A.out + O_DS + (size_t)((l * 128 + b) * 4 + h) * 16384;
#pragma unroll
      for (int i = 0; i < 32; ++i) dsp[(kq * 32 + i) * 128 + v] = S[i]; }
    __syncthreads();
}

#define SSM_BCAST_U(t) do { unsigned _w[8]; \
        _w[0] = __builtin_amdgcn_readlane(ua.x, t); _w[1] = __builtin_amdgcn_readlane(ua.y, t); _w[2] = __builtin_amdgcn_readlane(ua.z, t); _w[3] = __builtin_amdgcn_readlane(ua.w, t); \
        _w[4] = __builtin_amdgcn_readlane(ub.x, t); _w[5] = __builtin_amdgcn_readlane(ub.y, t); _w[6] = __builtin_amdgcn_readlane(ub.z, t); _w[7] = __builtin_amdgcn_readlane(ub.w, t); \
        _Pragma("unroll") for (int _d = 0; _d < 8; ++_d) { uu[2 * _d] = __uint_as_float(_w[_d] << 16); uu[2 * _d + 1] = __uint_as_float(_w[_d] & 0xffff0000u); } } while (0)
#define SSM_STEP() do { float _br = 0.f, _bi = 0.f; \
        _Pragma("unroll") for (int _h = 0; _h < 16; ++_h) { _br = fmaf(Br[_h], uu[_h], _br); _bi = fmaf(Bi[_h], uu[_h], _bi); } \
        const float _nr = lr * hr - li * hi + _br, _ni = lr * hi + li * hr + _bi; hr = _nr; hi = _ni; } while (0)

__device__ __forceinline__ void ssm_part1_item(const DevArgs& A, int l, int it, int lane) {
    const int g = it & 15, bc = it >> 4, b = bc / 31, c = bc % 31;
    const float* bb = (const float*)(A.ws + WS_BBAR) + ((size_t)(l * 16 + g) * 64 + lane) * 32;
    float Br[16], Bi[16];
#pragma unroll
    for (int q = 0; q < 4; ++q) { const f32x4 x = ((const f32x4*)bb)[q], y = ((const f32x4*)bb)[4 + q];
        Br[4 * q] = x.x; Br[4 * q + 1] = x.y; Br[4 * q + 2] = x.z; Br[4 * q + 3] = x.w; Bi[4 * q] = y.x; Bi[4 * q + 1] = y.y; Bi[4 * q + 2] = y.z; Bi[4 * q + 3] = y.w; }
    const f32x4 lk = ((const f32x4*)(A.ws + WS_SSMK))[(l * 16 + g) * 64 + lane]; const float lr = lk.x, li = lk.y;
    const bf16_t* up = (const bf16_t*)(A.ws + WS_PROJ) + (size_t)(b * SEQ + c * 64 + lane) * NPROJ + PC_SSM + g * 16;
    const u32x4 ua = *(const u32x4*)up, ub = *(const u32x4*)(up + 8);
    float hr = 0.f, hi = 0.f, uu[16];
#pragma unroll 1
    for (int t = 0; t < 64; ++t) { SSM_BCAST_U(t); SSM_STEP(); }
    f32x2 e; e.x = hr; e.y = hi;
    ((f32x2*)(A.ws + WS_SSME))[((size_t)(b * 32 + c) * 16 + g) * 64 + lane] = e;
}

__device__ __forceinline__ void ssm_part2_item(const DevArgs& A, int l, LAS unsigned char* lds, int it, int tid, int wave, int lane) {
    asm volatile("" : "+v"(tid)); lane = tid & 63; wave = __builtin_amdgcn_readfirstlane(tid >> 6);
    const int tok0 = it * 64, fr = lane & 15, quad = lane >> 4;
    const bool samp = it >= 256; const int b = it >> 5, c = it & 31;
    LAS unsigned char* YS = lds; LAS unsigned char* HS = lds + 33792 + wave * 4352;
    const bf16_t* PROJ = (const bf16_t*)(A.ws + WS_PROJ); bf16_t* MIX = (bf16_t*)(A.ws + WS_MIX);
#pragma unroll 1
    for (int gi = 0; gi < 2; ++gi) {
        const int g = wave * 2 + gi;
        const float* bb = (const float*)(A.ws + WS_BBAR) + ((size_t)(l * 16 + g) * 64 + lane) * 32;
        float Br[16], Bi[16];
#pragma unroll
        for (int q = 0; q < 4; ++q) { const f32x4 x = ((const f32x4*)bb)[q], y = ((const f32x4*)bb)[4 + q];
            Br[4 * q] = x.x; Br[4 * q + 1] = x.y; Br[4 * q + 2] = x.z; Br[4 * q + 3] = x.w; Bi[4 * q] = y.x; Bi[4 * q + 1] = y.y; Bi[4 * q + 2] = y.z; Bi[4 * q + 3] = y.w; }
        const f32x4 lk = ((const f32x4*)(A.ws + WS_SSMK))[(l * 16 + g) * 64 + lane]; const float lr = lk.x, li = lk.y, Lr = lk.z, Li = lk.w;
        bf16x8 Cb[4];
#pragma unroll
        for (int kk = 0; kk < 4; ++kk) { const size_t co = ((size_t)(l * 16 + g) * 16 + fr) * 64 + kk * 16 + quad * 4;
            const f32x4 cr = *(const f32x4*)(A.in[I_CRE] + co), ci = *(const f32x4*)(A.in[I_CIM] + co);
            u32x4 pk; pk.x = pk2(cr.x, -ci.x); pk.y = pk2(cr.y, -ci.y); pk.z = pk2(cr.z, -ci.z); pk.w = pk2(cr.w, -ci.w);
            Cb[kk] = __builtin_bit_cast(bf16x8, pk); }
        const bf16_t* up = PROJ + (size_t)(tok0 + lane) * NPROJ + PC_SSM + g * 16;
        const u32x4 ua = *(const u32x4*)up, ub = *(const u32x4*)(up + 8);
        float hr = 0.f, hi = 0.f, uu[16];
        if (!samp && c > 0) { const f32x2* E = (const f32x2*)(A.ws + WS_SSME) + ((size_t)(b * 32) * 16 + g) * 64 + lane;
#pragma unroll
            for (int cb = 0; cb < 32; cb += 16) { f32x2 ev[16];
#pragma unroll
                for (int q = 0; q < 16; ++q) { const int cc = cb + q; ev[q] = (cc < c) ? E[(size_t)cc * 1024] : (f32x2){0.f, 0.f}; }
#pragma unroll
                for (int q = 0; q < 16; ++q) { const int cc = cb + q; if (cc < c) { const float nr = Lr * hr - Li * hi + ev[q].x, ni = Lr * hi + Li * hr + ev[q].y; hr = nr; hi = ni; } } } }
        const float dsk = A.in[I_SSMD][l * 256 + g * 16 + fr];
        unsigned uvr[16];
#pragma unroll
        for (int e = 0; e < 16; ++e) uvr[e] = PROJ[(size_t)(tok0 + (e >> 2) * 16 + quad * 4 + (e & 3)) * NPROJ + PC_SSM + g * 16 + fr];
#pragma unroll
        for (int sub = 0; sub < 4; ++sub) {
#pragma unroll 1
            for (int tt = 0; tt < 16; ++tt) { const int t = sub * 16 + tt;
                const int sb = (it - 256) * 16 + (t >> 2);
                if (samp && (t & 3) == 0) { hr = A.in[I_SRE][((size_t)(l * 128 + sb) * 16 + g) * 64 + lane]; hi = A.in[I_SIM][((size_t)(l * 128 + sb) * 16 + g) * 64 + lane]; }
                SSM_BCAST_U(t); SSM_STEP();
                *(LAS unsigned*)(HS + tt * 272 + lane * 4) = pg8::cvt_pk_bf16(hr, hi);
                if (samp && (t & 3) == 3) { A.out[O_RES + ((size_t)(l * 128 + sb) * 16 + g) * 64 + lane] = hr; A.out[O_IMS + ((size_t)(l * 128 + sb) * 16 + g) * 64 + lane] = hi; }
            }
            LDS_FENCE();
            f32x4 acc = {0.f, 0.f, 0.f, 0.f};
#pragma unroll
            for (int kk = 0; kk < 4; ++kk) { const bf16x8 a = *(LAS bf16x8*)(HS + fr * 272 + (kk * 32 + quad * 8) * 2); acc = mfma16(a, Cb[kk], acc); }
#pragma unroll
            for (int i = 0; i < 4; ++i) { const int t = sub * 16 + quad * 4 + i; const float uv = bf2f(uvr[sub * 4 + i]);
                *(LAS bf16_t*)(YS + t * 528 + (g * 16 + fr) * 2) = (bf16_t)f2bf(gelu_tanh_f(acc[i] + dsk * uv)); }
            LDS_FENCE();
        }
        if (!samp && c == 31) { A.out[O_REP + ((size_t)(l * 8 + b) * 16 + g) * 64 + lane] = hr; A.out[O_IMP + ((size_t)(l * 8 + b) * 16 + g) * 64 + lane] = hi; }
    }
    __syncthreads();
    {
        const bf16_t* GT = (const bf16_t*)(A.ws + WS_GLUT + l * SZ_GLUT);
        f32x4 acc[4][2];
#pragma unroll
        for (int mt = 0; mt < 4; ++mt) { acc[mt][0] = (f32x4){0.f, 0.f, 0.f, 0.f}; acc[mt][1] = (f32x4){0.f, 0.f, 0.f, 0.f}; }
#pragma unroll
        for (int kk = 0; kk < 8; ++kk) { bf16x8 bfr[2];
#pragma unroll
            for (int nt = 0; nt < 2; ++nt) bfr[nt] = *(const bf16x8*)(GT + (size_t)(32 * wave + nt * 16 + fr) * 256 + kk * 32 + quad * 8);
#pragma unroll
            for (int mt = 0; mt < 4; ++mt) { const bf16x8 a = *(LAS bf16x8*)(YS + (mt * 16 + fr) * 528 + (kk * 32 + quad * 8) * 2);
                acc[mt][0] = mfma16(a, bfr[0], acc[mt][0]); acc[mt][1] = mfma16(a, bfr[1], acc[mt][1]); } }
#pragma unroll
        for (int nt = 0; nt < 2; ++nt) { const int ncol = 32 * wave + nt * 16 + fr; const float gb = A.in[I_GLUB][l * 256 + ncol];
#pragma unroll
            for (int mt = 0; mt < 4; ++mt)
#pragma unroll
                for (int i = 0; i < 4; ++i) { const int t = mt * 16 + quad * 4 + i; const float y = bf2f(*(LAS bf16_t*)(YS + t * 528 + ncol * 2));
                    MIX[(size_t)(tok0 + t) * D + 512 + ncol] = (bf16_t)f2bf(y * sigmoid_f(acc[mt][nt][i] + gb)); } }
    }
    __syncthreads();
}

__device__ __forceinline__ void pool_item(const DevArgs& A, int l, LAS unsigned char* lds, int it, int tid, int wave, int lane) {
    asm volatile("" : "+v"(tid)); lane = tid & 63; wave = __builtin_amdgcn_readfirstlane(tid >> 6);
    const int tok0 = it * 64, fr = lane & 15, quad = lane >> 4; const bool samp = it >= 256;
    LAS unsigned char* RS = lds;
    const bf16_t* PROJ = (const bf16_t*)(A.ws + WS_PROJ); bf16_t* MIX = (bf16_t*)(A.ws + WS_MIX);
    if (!samp) {
        LAS unsigned char* XT = lds + 33792;
        const int b = it >> 5, c = it & 31;
        for (int id = tid; id < 79 * 32; id += 512) { const int r = id >> 5, c16 = id & 31, tl = c * 64 - 15 + r;
            u32x4 v = {0u, 0u, 0u, 0u}; if (tl >= 0) v = *(const u32x4*)(PROJ + (size_t)(b * SEQ + tl) * NPROJ + PC_POOL + c16 * 8);
            *(LAS u32x4*)(XT + r * 528 + c16 * 16) = v; }
        __syncthreads();
        const int ch = tid & 255, half = tid >> 8, g = ch >> 6, w = 2 << g, r0 = half * 32;
        float sum = 0.f;
        for (int j = 0; j < w; ++j) sum += bf2f(*(LAS bf16_t*)(XT + (r0 + 15 - j) * 528 + ch * 2));
#pragma unroll 4
        for (int rr = 0; rr < 32; ++rr) { const int r = r0 + rr, tl = c * 64 + r;
            const float u = bf2f(*(LAS bf16_t*)(XT + (r + 15) * 528 + ch * 2));
            if (rr > 0) sum += u - bf2f(*(LAS bf16_t*)(XT + (r + 15 - w) * 528 + ch * 2));
            const float rc = __builtin_amdgcn_rcpf((float)((tl + 1 < w) ? tl + 1 : w));
            *(LAS bf16_t*)(RS + r * 528 + ch * 2) = (bf16_t)f2bf(sum * rc - u); }
    } else {
#pragma unroll 1
        for (int pr = 0; pr < 8; ++pr) { const int idx = pr * 512 + tid, ch = idx & 255, sq = idx >> 8, g = ch >> 6, w = 2 << g;
            const int sb = (it - 256) * 16 + sq;
            const float* sbuf = A.in[I_SPOOL] + (size_t)(l * 128 + sb) * 15 * 256 + ch;
            const bf16_t* base = PROJ + (size_t)(NP + sb * 4) * NPROJ + PC_POOL + ch;
            float e[19];
#pragma unroll
            for (int j = 0; j < 15; ++j) e[j] = sbuf[j * 256];
#pragma unroll
            for (int j = 0; j < 4; ++j) e[15 + j] = bf2f(base[(size_t)j * NPROJ]);
#pragma unroll
            for (int t = 0; t < 4; ++t) { float sum = 0.f;
#pragma unroll
                for (int j = 0; j < 16; ++j) sum += (j < w) ? e[15 + t - j] : 0.f;
                *(LAS bf16_t*)(RS + (sq * 4 + t) * 528 + ch * 2) = (bf16_t)f2bf(sum * __builtin_amdgcn_rcpf((float)w) - e[15 + t]); } }
    }
    __syncthreads();
    { const int g2 = wave >> 1; const bf16_t* PT = (const bf16_t*)(A.ws + WS_POOLT + l * SZ_POOLT) + g2 * 4096;
      f32x4 acc[4][2];
#pragma unroll
      for (int mt = 0; mt < 4; ++mt) { acc[mt][0] = (f32x4){0.f, 0.f, 0.f, 0.f}; acc[mt][1] = (f32x4){0.f, 0.f, 0.f, 0.f}; }
#pragma unroll
      for (int kk = 0; kk < 2; ++kk) { bf16x8 bfr[2];
#pragma unroll
          for (int nt = 0; nt < 2; ++nt) bfr[nt] = *(const bf16x8*)(PT + (size_t)((wave & 1) * 32 + nt * 16 + fr) * 64 + kk * 32 + quad * 8);
#pragma unroll
          for (int mt = 0; mt < 4; ++mt) { const bf16x8 a = *(LAS bf16x8*)(RS + (mt * 16 + fr) * 528 + (g2 * 64 + kk * 32 + quad * 8) * 2);
              acc[mt][0] = mfma16(a, bfr[0], acc[mt][0]); acc[mt][1] = mfma16(a, bfr[1], acc[mt][1]); } }
#pragma unroll
      for (int nt = 0; nt < 2; ++nt) { const int col = 32 * wave + nt * 16 + fr; const float ps = A.in[I_POOLS][l * 256 + col];
#pragma unroll
          for (int mt = 0; mt < 4; ++mt)
#pragma unroll
              for (int i = 0; i < 4; ++i) { const int t = mt * 16 + quad * 4 + i; MIX[(size_t)(tok0 + t) * D + 768 + col] = (bf16_t)f2bf(acc[mt][nt][i] * ps); } } }
    __syncthreads();
}

__device__ __forceinline__ void state_copies(const DevArgs& A, int l, int gt, int NT) {
    const bf16_t* PROJ = (const bf16_t*)(A.ws + WS_PROJ);
#pragma unroll 1
    for (int i = gt; i < 8 * 3 * 1536; i += NT) { const int col = i % 1536, j = (i / 1536) % 3, b = i / 4608;
        A.out[O_CP + (size_t)l * 8 * 4608 + i] = bf2f(PROJ[(size_t)(b * SEQ + SEQ - 3 + j) * NPROJ + col]); }
#pragma unroll 1
    for (int i = gt; i < 128 * 3 * 1536; i += NT) { const int col = i % 1536, j = (i / 1536) % 3, b = i / 4608;
        A.out[O_CS + (size_t)l * 128 * 4608 + i] = bf2f(PROJ[(size_t)(NP + b * 4 + 1 + j) * NPROJ + col]); }
#pragma unroll 1
    for (int i = gt; i < 8 * 15 * 256; i += NT) { const int ch = i & 255, j = (i >> 8) % 15, b = i / 3840;
        A.out[O_PP + (size_t)l * 8 * 3840 + i] = bf2f(PROJ[(size_t)(b * SEQ + SEQ - 15 + j) * NPROJ + PC_POOL + ch]); }
#pragma unroll 1
    for (int i = gt; i < 128 * 15 * 256; i += NT) { const int ch = i & 255, j = (i >> 8) % 15, b = i / 3840;
        A.out[O_PS + (size_t)l * 128 * 3840 + i] = (j < 11) ? A.in[I_SPOOL][((size_t)(l * 128 + b) * 15 + 4 + j) * 256 + ch]
                                                             : bf2f(PROJ[(size_t)(NP + b * 4 + (j - 11)) * NPROJ + PC_POOL + ch]); }
}

#ifndef REP_DPREP
#define REP_DPREP 1
#endif
#ifndef REP_DSAMP
#define REP_DSAMP 1
#endif
#ifndef REP_SSM1
#define REP_SSM1 1
#endif
#ifndef REP_POOL
#define REP_POOL 1
#endif
#ifndef REP_DSCAN
#define REP_DSCAN 1
#endif
#ifndef REP_SSM2
#define REP_SSM2 1
#endif
#ifndef REP_G
#define REP_G 1
#endif
#ifndef REP_P3
#define REP_P3 1
#endif
#ifndef REP_P2
#define REP_P2 1
#endif
constexpr int NPH = 2 + DEPTH * 8;
__global__ void __launch_bounds__(512, 2) mega_fwd(Args KA) {
    DevArgs A; A.out = KA.out; A.ws = KA.ws; A.ph_lo = KA.ph_lo; A.ph_hi = KA.ph_hi;
    extern __shared__ __attribute__((aligned(16))) unsigned char lds_raw[];
    LAS unsigned char* lds = (LAS unsigned char*)lds_raw;
    cg::grid_group grid = cg::this_grid();
    volatile LAS unsigned* xst = (volatile LAS unsigned*)(lds + LDS_BYTES - 64);
    if (threadIdx.x == 0) { xst[0] = 0u; xst[1] = 0u; }
    __syncthreads();
    const XcdBarrier xb = xcd_barrier_post((unsigned*)(KA.ws + WS_BAR), xst);
    constexpr int G = 256, NGW = G * 8, NT = G * 512;
    int ph = 0;
#define PH_BEGIN if (A.ph_lo <= ph && ph < A.ph_hi) { int tid = threadIdx.x; asm volatile("" : "+v"(tid)); { unsigned char* _w = A.ws; asm volatile("" : "+s"(_w)); A.ws = _w; float* _o = A.out; asm volatile("" : "+s"(_o)); A.out = _o; } const int wave = __builtin_amdgcn_readfirstlane(tid >> 6), lane = tid & 63, gw = blockIdx.x * 8 + wave, gt = blockIdx.x * 512 + tid; (void)gw; (void)gt; (void)lane;
#define PH_END   if (ph + 1 < A.ph_hi) { if (ph == 0) grid.sync(); else xcd_barrier(xb); } } ++ph;
#define Hb   ((bf16_t*)(A.ws + WS_H))
#define AB   ((float*)(A.ws + WS_AB))
#define MIXO ((float*)(A.ws + WS_MIXO))
#define PROJ ((bf16_t*)(A.ws + WS_PROJ))
#define MIX  ((bf16_t*)(A.ws + WS_MIX))
#define HID  ((bf16_t*)(A.ws + WS_HID))

#ifndef REP_PRO
#define REP_PRO 1
#endif
#ifndef REP_N0
#define REP_N0 1
#endif
    PH_BEGIN for (int rep = 0; rep < REP_PRO; ++rep) { prologue(A, lds, wave, lane, gw, NGW); __syncthreads(); } PH_END
    PH_BEGIN for (int rep = 0; rep < REP_N0; ++rep) norm_rows(nullptr, nullptr, A.in[I_XP], A.in[I_XS], nullptr, A.in[I_NMPRE], Hb, (const float*)(A.ws + WS_WAB), AB, gw, NGW, lane); PH_END

#pragma unroll 1
    for (int l = 0; l < DEPTH; ++l) {
        PH_BEGIN for (int rep = 0; rep < REP_G; ++rep) { pg8::Gemm g{Hb, (const bf16_t*)(A.ws + WS_WIN + l * SZ_WIN), NTOK, NPROJ, D, D, D}; pg8::StaticOrder S; S.init(NTOK, NPROJ, G, (int)blockIdx.x);
            pg8::EpiBf16<0> E{PROJ, NPROJ, nullptr, 0, 0}; pg8::gemm_phase<pg8::EpiBf16<0>, pg8::StaticOrder>(lds, g, S, E, nullptr); } PH_END
        constexpr int SUBC = 7;
        PH_BEGIN {
#pragma unroll 1
          for (int rep2 = 0; rep2 < REP_P2; ++rep2) {
#pragma unroll 1
            for (int j = blockIdx.x; j < 32 * SUBC; j += G) delta_prep_item(A, l, lds, (j & 31) * 32 + (j >> 5), tid, wave, lane);
          }
        } PH_END
        PH_BEGIN {
#pragma unroll 1
            for (int rep3 = 0; rep3 < REP_P3; ++rep3) {
                if (blockIdx.x < 32) delta_scan_item(A, l, lds, blockIdx.x, tid, wave, lane, xb, SUBC);
                else { const int w = blockIdx.x - 32; constexpr int NW = G - 32;
#pragma unroll 1
                    for (int k = 1; k <= 5; ++k) {
                        const int n0 = k * SUBC, nn = (n0 >= 32) ? 0 : ((32 - n0 < SUBC) ? 32 - n0 : SUBC);
                        int nprep = 32 * nn;
#ifndef REP_WPREP
#define REP_WPREP 1
#endif
#pragma unroll 1
                        for (int rep = 0; rep < REP_WPREP; ++rep)
#pragma unroll 1
                        for (int j = w; j < nprep; j += NW) delta_prep_item(A, l, lds, (j & 31) * 32 + n0 + (j >> 5), tid, wave, lane);
                        if (k == 1) {
#pragma unroll 1
                            for (int it = w; it < 512; it += NW) delta_sample_item(A, l, lds, it, tid, wave, lane); }
                        if (k == 2) {
#pragma unroll 1
                            for (int it = w * 8 + wave; it < 8 * 31 * 16; it += NW * 8) { int t1 = threadIdx.x; asm volatile("" : "+v"(t1)); ssm_part1_item(A, l, it, t1 & 63); }
                            { int t2 = threadIdx.x; asm volatile("" : "+v"(t2)); int wl = blockIdx.x; asm volatile("" : "+s"(wl)); state_copies(A, l, (wl - 32) * 512 + t2, NW * 512); } }
                        if (k == 3) {
#pragma unroll 1
                            for (int it = w; it < 264; it += NW) pool_item(A, l, lds, it, tid, wave, lane); }
                        { const int it = (k == 4) ? w - 128 : ((k == 5) ? 96 + w : -1);
                          if (it >= 0 && it < ((k == 4) ? 96 : 264)) ssm_part2_item(A, l, lds, it, tid, wave, lane); }
                        if (k < 5) xcd_barrier(xb);
                    } }
            }
        } PH_END
        PH_BEGIN for (int rep = 0; rep < REP_G; ++rep) { pg8::Gemm g{MIX, (const bf16_t*)(A.ws + WS_WOUT + l * SZ_WOUT), NP, D, D, D, D}; pg8::StaticOrder S; S.init(NP, D, G, (int)blockIdx.x);
            pg8::EpiBf16<0> E{(bf16_t*)MIXO, D, nullptr, 0, 0}; pg8::gemm_phase<pg8::EpiBf16<0>, pg8::StaticOrder>(lds, g, S, E, nullptr);
            pg8::Gemm g2{MIX + (size_t)NP * D, (const bf16_t*)(A.ws + WS_WOUT + l * SZ_WOUT), NS, D, 256, D, D}; SliceOrder S2{8 * (D / 256), G, (int)blockIdx.x};
            EpiF32Part E2{(float*)(A.ws + WS_PARTS)}; pg8::gemm_phase<EpiF32Part, SliceOrder>(lds, g2, S2, E2, nullptr); } PH_END
#ifndef REP_N5
#define REP_N5 1
#endif
        PH_BEGIN norm_rows_pf(MIXO, A.in[I_NMPOST] + l * D, l == 0 ? A.in[I_XP] : A.out, l == 0 ? A.in[I_XS] : nullptr, A.out, A.in[I_NFPRE] + l * D, Hb, gw, NGW, lane, (const float*)(A.ws + WS_PARTS), D / 256); PH_END
        PH_BEGIN for (int rep = 0; rep < REP_G; ++rep) { pg8::Gemm g{Hb, (const bf16_t*)(A.ws + WS_WGU + l * SZ_WGU), NTOK, NGU, D, D, D}; pg8::StaticOrder S; S.init(NTOK, NGU, G, (int)blockIdx.x);
            EpiSwiGLU E{HID, DFF}; pg8::gemm_phase<EpiSwiGLU, pg8::StaticOrder>(lds, g, S, E, nullptr); } PH_END
        PH_BEGIN for (int rep = 0; rep < REP_G; ++rep) { pg8::Gemm g{HID, (const bf16_t*)(A.ws + WS_WDN + l * SZ_WDN), NP, D, DFF, DFF, DFF}; pg8::StaticOrder S; S.init(NP, D, G, (int)blockIdx.x);
            pg8::EpiBf16<0> E{(bf16_t*)MIXO, D, nullptr, 0, 0}; pg8::gemm_phase<pg8::EpiBf16<0>, pg8::StaticOrder>(lds, g, S, E, nullptr);
            pg8::Gemm g2{HID + (size_t)NP * DFF, (const bf16_t*)(A.ws + WS_WDN + l * SZ_WDN), NS, D, 256, DFF, DFF}; SliceOrder S2{8 * (DFF / 256), G, (int)blockIdx.x};
            EpiF32Part E2{(float*)(A.ws + WS_PARTS)}; pg8::gemm_phase<EpiF32Part, SliceOrder>(lds, g2, S2, E2, nullptr); } PH_END
        PH_BEGIN norm_rows(MIXO, A.in[I_NFPOST] + l * D, A.out, nullptr, A.out, l + 1 < DEPTH ? A.in[I_NMPRE] + (l + 1) * D : nullptr, l + 1 < DEPTH ? Hb : nullptr,
                           l + 1 < DEPTH ? (const float*)(A.ws + WS_WAB + (l + 1) * SZ_WAB) : nullptr, AB, gw, NGW, lane, (const float*)(A.ws + WS_PARTS), DFF / 256); PH_END
    }
#undef PH_BEGIN
#undef PH_END
#undef Hb
#undef AB
#undef MIXO
#undef PROJ
#undef MIX
#undef HID
}

extern "C" void kernel_launch(void* const* d_in, const int* in_sizes, int n_in, void* d_out, int out_size, void* d_ws, size_t ws_size, hipStream_t stream) {
    static int grid = 0;
    if (grid == 0) {
        if (n_in != 32 || (size_t)out_size != O_END || ws_size < WS_END) fprintf(stderr, "kernel_launch: unexpected sizes: n_in %d out %d (want %zu) ws %zu (want >= %zu)\n", n_in, out_size, (size_t)O_END, ws_size, (size_t)WS_END);
        int dev = 0, cus = 0, per_cu = 0;
        (void)hipGetDevice(&dev); (void)hipDeviceGetAttribute(&cus, hipDeviceAttributeMultiprocessorCount, dev);
        if (hipFuncSetAttribute((const void*)mega_fwd, hipFuncAttributeMaxDynamicSharedMemorySize, LDS_BYTES) != hipSuccess) fprintf(stderr, "kernel_launch: hipFuncSetAttribute failed\n");
        if (hipOccupancyMaxActiveBlocksPerMultiprocessor(&per_cu, (const void*)mega_fwd, 512, LDS_BYTES) != hipSuccess || per_cu < 1) { fprintf(stderr, "kernel_launch: occupancy query gave %d\n", per_cu); per_cu = 1; (void)hipGetLastError(); }
        grid = cus * per_cu; if (grid <= 0) grid = 256;
        if (grid >= 256) grid = 256;
        fprintf(stderr, "kernel_launch: grid %d (cus %d x %d)%s\n", grid, cus, per_cu, grid < 256 ? "  ERROR: this build needs >= 256 co-resident workgroups" : "");
    }
    (void)hipMemsetAsync((unsigned char*)d_ws + WS_BAR, 0, 16384, stream);
    Args a{};
    for (int i = 0; i < 32; ++i) a.in[i] = (const float*)d_in[i];
    a.out = (float*)d_out; a.ws = (unsigned char*)d_ws;
#if MK_COOP
    a.ph_lo = 0; a.ph_hi = NPH;
    void* args[] = {&a};
    const hipError_t e = hipLaunchCooperativeKernel((const void*)mega_fwd, dim3(grid), dim3(512), args, LDS_BYTES, stream);
    if (e != hipSuccess) fprintf(stderr, "kernel_launch: cooperative launch failed: %s (grid %d)\n", hipGetErrorString(e), grid);
#else
    for (int p = 0; p < NPH; ++p) { a.ph_lo = p; a.ph_hi = p + 1; hipLaunchKernelGGL(mega_fwd, dim3(grid), dim3(512), LDS_BYTES, stream, a); }
#endif
}
```

```cpp
#include <hip/hip_runtime.h>
#include <hip/hip_cooperative_groups.h>
#include <cstdio>
#include <cstdint>
namespace cg = cooperative_groups;
#ifndef MK_COOP
#define MK_COOP 1
#endif
namespace pg8 {
#define PG8_LAS __attribute__((address_space(3)))
typedef unsigned short bf16_t;
typedef short bf16x8 __attribute__((ext_vector_type(8)));
typedef float f32x4 __attribute__((ext_vector_type(4)));
typedef unsigned u32x4 __attribute__((ext_vector_type(4)));
constexpr int BM = 256, BK = 64, HALF = 128, HTB = HALF * BK * 2  , STAGE_BYTES = 8 * HTB, NXCD = 8, WGM = 8;

__host__ __device__ __forceinline__ int lds_byte(int r, int c) { const int st = (r >> 4) * 2 + (c >> 5), rr = r & 15, cc = c & 31, ob = rr * 64 + cc * 2; return st * 1024 + (ob ^ (((ob >> 9) & 1) << 5)); }
__host__ __device__ __forceinline__ void stage_rc(int b, int& R, int& C) { const int st = b / 1024, sb = b % 1024, swz = sb ^ (((sb >> 9) & 1) << 5); R = (st >> 1) * 16 + swz / 64; C = (st & 1) * 32 + (swz % 64) / 2; }
__host__ __device__ __forceinline__ int perm32(int rho) { const int n = rho >> 4, i = rho & 15; return 8 * (i >> 2) + 4 * n + (i & 3); }

struct Unit { int pm, pn, ks; };
struct Gemm { const bf16_t* A; const bf16_t* Bt; int M, N, K, lda, ldb; };

struct StaticOrder {
    int nM, nN, nwg, G, c;
    __host__ __device__ void init(int M, int N, int G_, int c_) { nM = M / BM; nN = N / BM; nwg = nM * nN; G = G_; c = c_; }
    __host__ __device__ bool next(int i, Unit& u) const {
        const long L = (long)i * G + c; if (L >= nwg) return false;
        int wgid = (int)L; { const int q = nwg / NXCD, r = nwg % NXCD, xcd = wgid % NXCD, off = wgid / NXCD; wgid = (xcd < r ? xcd * (q + 1) : r * (q + 1) + (xcd - r) * q) + off; }
        const int nig = WGM * nN, gid = wgid / nig, fm = gid * WGM, gsz = (nM - fm) < WGM ? (nM - fm) : WGM;
        u.pm = fm + ((wgid % nig) % gsz); u.pn = (wgid % nig) / gsz; u.ks = 0; return true;
    }
    __device__ __forceinline__ void a_ready(const Unit&) const {}
    __device__ __forceinline__ void done(const Unit&) const {}
};
__device__ __forceinline__ unsigned cvt_pk_bf16(float lo, float hi) { unsigned r; asm volatile("v_cvt_pk_bf16_f32 %0, %1, %2" : "=v"(r) : "v"(lo), "v"(hi)); return r; }
typedef float f32x2 __attribute__((ext_vector_type(2)));
__device__ __forceinline__ f32x2 gelu_pk(f32x2 v) {
    const f32x2 av = __builtin_elementwise_abs(v), d = av * 0.2316418882f + 1.0f;
    f32x2 t; t.x = __builtin_amdgcn_rcpf(d.x); t.y = __builtin_amdgcn_rcpf(d.y);
    f32x2 q = t * 0.5307027145f + (-0.7265760135f); q = q * t + 0.7107068705f; q = q * t + (-0.142248368f); q = q * t + 0.127414796f; q = q * t;
    const f32x2 s = (v * v) * (-0.72134752044f);
    f32x2 e; e.x = __builtin_amdgcn_exp2f(s.x); e.y = __builtin_amdgcn_exp2f(s.y);
    const f32x2 m = v * (q * e), r = v - m;
    f32x2 o; o.x = v.x < 0.f ? m.x : r.x; o.y = v.y < 0.f ? m.y : r.y; return o;
}

struct EpiF32 {
    static constexpr bool PERM = false, AFTER_DRAIN = false;
    float* C; int ldc; const float* bias;
    __device__ __forceinline__ void operator()(const f32x4 (&acc)[2][2][4][2], const Unit& u, int wr, int wc, int fr, int fq) const {
        const int row0 = u.pm * BM + wr * 64 + fr, col0 = u.pn * BM + wc * 32 + 4 * fq;
        f32x4 bv[2][2];
#pragma unroll
        for (int bj = 0; bj < 2; ++bj)
#pragma unroll
            for (int n = 0; n < 2; ++n) bv[bj][n] = bias ? *(const f32x4*)(bias + col0 + bj * HALF + n * 16) : (f32x4){0.f, 0.f, 0.f, 0.f};
#pragma unroll
        for (int ai = 0; ai < 2; ++ai)
#pragma unroll
            for (int m = 0; m < 4; ++m) { float* rowp = C + (size_t)(row0 + ai * HALF + m * 16) * ldc + col0;
#pragma unroll
                for (int bj = 0; bj < 2; ++bj)
#pragma unroll
                    for (int n = 0; n < 2; ++n) *(f32x4*)(rowp + bj * HALF + n * 16) = acc[ai][bj][m][n] + bv[bj][n]; }
    }
};
template <int ACT  > struct EpiBf16 {
    static constexpr bool PERM = true, AFTER_DRAIN = false;
    bf16_t* O; int ldc; const float* bias; int split_cols; size_t split_stride;
    __device__ __forceinline__ void operator()(const f32x4 (&acc)[2][2][4][2], const Unit& u, int wr, int wc, int fr, int fq) const {
        const int row0 = u.pm * BM + wr * 64 + fr; int colt = u.pn * BM; bf16_t* base = O;
        if (split_cols) { const int t = colt / split_cols; base += (size_t)t * split_stride; colt -= t * split_cols; }
        const int col0 = colt + wc * 32 + 8 * fq, bcol0 = u.pn * BM + wc * 32 + 8 * fq;
        f32x4 bv[2][2];
#pragma unroll
        for (int bj = 0; bj < 2; ++bj)
#pragma unroll
            for (int n = 0; n < 2; ++n) bv[bj][n] = bias ? *(const f32x4*)(bias + bcol0 + bj * HALF + 4 * n) : (f32x4){0.f, 0.f, 0.f, 0.f};
#pragma unroll
        for (int ai = 0; ai < 2; ++ai)
#pragma unroll
            for (int m = 0; m < 4; ++m) { bf16_t* rowp = base + (size_t)(row0 + ai * HALF + m * 16) * ldc + col0;
#pragma unroll
                for (int bj = 0; bj < 2; ++bj) { f32x4 v0 = acc[ai][bj][m][0] + bv[bj][0], v1 = acc[ai][bj][m][1] + bv[bj][1];
                    if (ACT == 1) { f32x2 a = gelu_pk((f32x2){v0[0], v0[1]}), b = gelu_pk((f32x2){v0[2], v0[3]}), c = gelu_pk((f32x2){v1[0], v1[1]}), d = gelu_pk((f32x2){v1[2], v1[3]});
                        v0 = (f32x4){a.x, a.y, b.x, b.y}; v1 = (f32x4){c.x, c.y, d.x, d.y}; }
                    if (ACT == 2) {
#pragma unroll
                        for (int j = 0; j < 4; ++j) { v0[j] = 0.5f * v0[j] * (1.0f + erff(v0[j] * 0.70710678f)); v1[j] = 0.5f * v1[j] * (1.0f + erff(v1[j] * 0.70710678f)); } }
                    u32x4 w; w.x = cvt_pk_bf16(v0[0], v0[1]); w.y = cvt_pk_bf16(v0[2], v0[3]); w.z = cvt_pk_bf16(v1[0], v1[1]); w.w = cvt_pk_bf16(v1[2], v1[3]);
                    *(u32x4*)(rowp + bj * HALF) = w; } }
    }
};
template <class Epi, class Sched, bool STAMP = false>
__device__ __forceinline__ void gemm_phase(PG8_LAS unsigned char* lds, const Gemm g, const Sched& S, const Epi& E, unsigned long long* stamps) {
    int tid_ = threadIdx.x; asm volatile("" : "+v"(tid_));
    const int tid = tid_, wid = __builtin_amdgcn_readfirstlane(tid >> 6), lane = tid & 63, wr = wid >> 2, wc = wid & 3, fr = lane & 15, fq = lane >> 4;
    const int K = g.K, nt = K / BK;
    int ts_lo = 0, ts_hi = 0, nts = 0; const unsigned long long rt_entry = STAMP ? (unsigned long long)wall_clock64() : 0ull;
#define PG8_STAMP() do { if (STAMP && wid == 0 && nts < 64) { const unsigned long long _c = (unsigned long long)clock64(); \
        ts_lo = (lane == nts) ? (int)(unsigned)_c : ts_lo; ts_hi = (lane == nts) ? (int)(unsigned)(_c >> 32) : ts_hi; ++nts; } } while (0)
    PG8_STAMP();
    unsigned voffA[2], voffB[2];
#pragma unroll
    for (int i = 0; i < 2; ++i) { int R, C; stage_rc(tid * 16 + i * 8192, R, C); const int Rb = Epi::PERM ? ((R & ~31) + perm32(R & 31)) : R;
        voffA[i] = (unsigned)(R * g.lda + C) * 2u; voffB[i] = (unsigned)(Rb * g.ldb + C) * 2u; }
    const size_t kstep = (size_t)(BK * 2);
    const size_t hstepA = (size_t)HALF * g.lda * 2, hstepB = (size_t)HALF * g.ldb * 2;
    const size_t tstepA = 2 * hstepA, tstepB = 2 * hstepB, sstep = (size_t)K * 2;
    const unsigned ldsw = (unsigned)wid * 1024u;
    const int aoff = lds_byte(wr * 64 + fr, fq * 8), boff = lds_byte(wc * 32 + fr, fq * 8);
#define PG8_SA(b, h) (((b) * 2 + (h)) * HTB)
#define PG8_SB(b, h) ((4 + (b) * 2 + (h)) * HTB)
#define PG8_STAGE(bufoff, gbase, voff) do { _Pragma("unroll") for (int _i = 0; _i < 2; ++_i) \
        __builtin_amdgcn_global_load_lds((const unsigned*)((const char*)(gbase) + (voff)[_i]), (PG8_LAS unsigned*)(lds + (bufoff) + ldsw + _i * 8192), 16, 0, 0); } while (0)
#define PG8_LDA(dst, b, h) do { _Pragma("unroll") for (int m = 0; m < 4; ++m) _Pragma("unroll") for (int k = 0; k < 2; ++k) dst[m][k] = *(const PG8_LAS bf16x8*)(lds + PG8_SA(b, h) + aoff + m * 2048 + k * 1024); } while (0)
#define PG8_LDB(dst, b, h) do { _Pragma("unroll") for (int n = 0; n < 2; ++n) _Pragma("unroll") for (int k = 0; k < 2; ++k) dst[n][k] = *(const PG8_LAS bf16x8*)(lds + PG8_SB(b, h) + boff + n * 2048 + k * 1024); } while (0)
#define PG8_MMA(ai, bj, At, Bt) do { __builtin_amdgcn_s_setprio(1); _Pragma("unroll") for (int m = 0; m < 4; ++m) _Pragma("unroll") for (int n = 0; n < 2; ++n) _Pragma("unroll") for (int k = 0; k < 2; ++k) \
        acc[ai][bj][m][n] = __builtin_amdgcn_mfma_f32_16x16x32_bf16(Bt[n][k], At[m][k], acc[ai][bj][m][n], 0, 0, 0); __builtin_amdgcn_s_setprio(0); } while (0)
#define PG8_WAIT_V(n) asm volatile("s_waitcnt vmcnt(" #n ")" ::: "memory")
#define PG8_WAIT_L(n) asm volatile("s_waitcnt lgkmcnt(" #n ")" ::: "memory")
#define PG8_BAR __builtin_amdgcn_s_barrier()
#define PG8_SCHED __builtin_amdgcn_sched_barrier(0)
    Unit cur, nxt; int ui = 0;
    if (!S.next(0, cur)) return;
    f32x4 acc[2][2][4][2];
#pragma unroll
    for (int a = 0; a < 2; ++a)
#pragma unroll
        for (int b = 0; b < 2; ++b)
#pragma unroll
            for (int m = 0; m < 4; ++m)
#pragma unroll
                for (int n = 0; n < 2; ++n) acc[a][b][m][n] = (f32x4){0.f, 0.f, 0.f, 0.f};
    bf16x8 At[4][2], B0[2][2], B1[2][2];
    const char* cA = (const char*)g.A + (size_t)cur.pm * tstepA + (size_t)cur.ks * sstep; const char* cB = (const char*)g.Bt + (size_t)cur.pn * tstepB + (size_t)cur.ks * sstep;
    S.a_ready(cur);
    PG8_STAGE(PG8_SB(0, 0), cB, voffB); PG8_STAGE(PG8_SA(0, 0), cA, voffA); PG8_STAGE(PG8_SB(0, 1), cB + hstepB, voffB); PG8_STAGE(PG8_SA(0, 1), cA + hstepA, voffA);
    if (wr == 1) PG8_BAR;
    PG8_WAIT_V(4); PG8_BAR;
    PG8_STAGE(PG8_SB(1, 0), cB + kstep, voffB); PG8_STAGE(PG8_SA(1, 0), cA + kstep, voffA); PG8_STAGE(PG8_SB(1, 1), cB + hstepB + kstep, voffB);
    PG8_WAIT_V(6); PG8_BAR;
    PG8_STAMP();
    for (;;) {
        const bool has_next = S.next(ui + 1, nxt);
        const char* nA = has_next ? (const char*)g.A + (size_t)nxt.pm * tstepA + (size_t)nxt.ks * sstep : cA; const char* nB = has_next ? (const char*)g.Bt + (size_t)nxt.pn * tstepB + (size_t)nxt.ks * sstep : cB;
        for (int t = 0; t < nt; t += 2) {
            const bool last = (t == nt - 2);
            const char* a1 = cA + (size_t)(t + 1) * kstep;
            const char* a2 = last ? nA : cA + (size_t)(t + 2) * kstep; const char* b2 = last ? nB : cB + (size_t)(t + 2) * kstep;
            const char* a3 = a2 + kstep; const char* b3 = b2 + kstep;
            if (last && has_next) S.a_ready(nxt);
            PG8_LDB(B0, 0, 0); PG8_SCHED; PG8_LDA(At, 0, 0); PG8_STAGE(PG8_SA(1, 1), a1 + hstepA, voffA);
            PG8_WAIT_L(8); PG8_BAR; PG8_WAIT_L(0); PG8_MMA(0, 0, At, B0); PG8_BAR; PG8_SCHED;
            PG8_LDB(B1, 0, 1); PG8_STAGE(PG8_SB(0, 0), b2, voffB);
            PG8_BAR; PG8_WAIT_L(0); PG8_MMA(0, 1, At, B1); PG8_BAR;
            PG8_LDA(At, 0, 1); PG8_STAGE(PG8_SA(0, 0), a2, voffA);
            PG8_BAR; PG8_WAIT_L(0); PG8_MMA(1, 0, At, B0); PG8_BAR; PG8_SCHED;
            PG8_STAGE(PG8_SB(0, 1), b2 + hstepB, voffB);
            PG8_WAIT_V(6); PG8_BAR; PG8_MMA(1, 1, At, B1); PG8_BAR;
            PG8_LDB(B0, 1, 0); PG8_SCHED; PG8_LDA(At, 1, 0); PG8_STAGE(PG8_SA(0, 1), a2 + hstepA, voffA);
            PG8_WAIT_L(8); PG8_BAR; PG8_WAIT_L(0); PG8_MMA(0, 0, At, B0); PG8_BAR; PG8_SCHED;
            PG8_LDB(B1, 1, 1); PG8_STAGE(PG8_SB(1, 0), b3, voffB);
            PG8_BAR; PG8_WAIT_L(0); PG8_MMA(0, 1, At, B1); PG8_BAR;
            PG8_LDA(At, 1, 1); PG8_STAGE(PG8_SA(1, 0), a3, voffA);
            PG8_BAR; PG8_WAIT_L(0); PG8_MMA(1, 0, At, B0); PG8_BAR; PG8_SCHED;
            PG8_STAGE(PG8_SB(1, 1), b3 + hstepB, voffB);
            PG8_WAIT_V(6); PG8_BAR; PG8_MMA(1, 1, At, B1); PG8_BAR;
        }
        PG8_STAMP();
        if constexpr (!Epi::AFTER_DRAIN) { E(acc, cur, wr, wc, fr, fq); S.done(cur); }
        PG8_STAMP();
        if (!has_next) break;
#pragma unroll
        for (int a = 0; a < 2; ++a)
#pragma unroll
            for (int b = 0; b < 2; ++b)
#pragma unroll
                for (int m = 0; m < 4; ++m)
#pragma unroll
                    for (int n = 0; n < 2; ++n) acc[a][b][m][n] = (f32x4){0.f, 0.f, 0.f, 0.f};
        cur = nxt; cA = nA; cB = nB; ++ui;
    }
    PG8_WAIT_V(0);
    if (wr == 0) PG8_BAR;
    PG8_BAR;
    if constexpr (Epi::AFTER_DRAIN) { E.fused(acc, cur, wr, wc, fr, fq, lds, wid, lane); S.done(cur); }
    PG8_STAMP();
    if (STAMP && wid == 0) { stamps[lane] = lane < nts ? (((unsigned long long)(unsigned)ts_hi << 32) | (unsigned)ts_lo) : 0ull;
        if (lane == 62) stamps[62] = rt_entry; if (lane == 63) stamps[63] = (unsigned long long)wall_clock64(); }
#undef PG8_STAMP
#undef PG8_SA
#undef PG8_SB
#undef PG8_STAGE
#undef PG8_LDA
#undef PG8_LDB
#undef PG8_MMA
#undef PG8_WAIT_V
#undef PG8_WAIT_L
#undef PG8_BAR
#undef PG8_SCHED
}
}

#define LAS __attribute__((address_space(3)))
typedef unsigned short bf16_t;
typedef short bf16x8 __attribute__((ext_vector_type(8)));
typedef float f32x4 __attribute__((ext_vector_type(4)));
typedef float f32x2 __attribute__((ext_vector_type(2)));
typedef unsigned u32x4 __attribute__((ext_vector_type(4)));
typedef unsigned u32x2 __attribute__((ext_vector_type(2)));

constexpr int D = 1024, NP = 16384, NS = 512, NTOK = NP + NS, SEQ = 2048, NB = 8, NSB = 128, DEPTH = 4;
constexpr int INW = 2568, NPROJ = 2560, DFF = 2816, NGU = 5632;
constexpr int PC_G = 1536, PC_SSM = 2048, PC_POOL = 2304;
constexpr float EPS = 1e-6f;
constexpr int LDS_BYTES = 163840;

constexpr size_t SZ_WIN = (size_t)NPROJ * D * 2, SZ_WOUT = (size_t)D * D * 2, SZ_WGU = (size_t)NGU * D * 2, SZ_WDN = (size_t)D * DFF * 2;
constexpr size_t SZ_WAB = 8 * D * 4, SZ_GLUT = 256 * 256 * 2, SZ_POOLT = 4 * 64 * 64 * 2, SZ_SSMK = 16 * 64 * 4 * 4, SZ_BBAR = 16 * 64 * 32 * 4;
constexpr size_t WS_WIN = 0;
constexpr size_t WS_WOUT = WS_WIN + DEPTH * SZ_WIN;
constexpr size_t WS_WGU = WS_WOUT + DEPTH * SZ_WOUT;
constexpr size_t WS_WDN = WS_WGU + DEPTH * SZ_WGU;
constexpr size_t WS_WAB = WS_WDN + DEPTH * SZ_WDN;
constexpr size_t WS_GLUT = WS_WAB + DEPTH * SZ_WAB;
constexpr size_t WS_POOLT = WS_GLUT + DEPTH * SZ_GLUT;
constexpr size_t WS_SSMK = WS_POOLT + DEPTH * SZ_POOLT;
constexpr size_t WS_BBAR = WS_SSMK + DEPTH * SZ_SSMK;
constexpr size_t WS_H = WS_BBAR + DEPTH * SZ_BBAR;
constexpr size_t WS_AB = WS_H + (size_t)NTOK * D * 2;
constexpr size_t WS_MIX = WS_AB + (size_t)NTOK * 8 * 4;
constexpr size_t WS_MIXO = WS_MIX + (size_t)NTOK * D * 2;
constexpr size_t WS_SSME = WS_MIXO + (size_t)NTOK * D * 4;
constexpr size_t WS_PROJ = WS_SSME + (size_t)8 * 32 * 16 * 64 * 2 * 4;
constexpr size_t WS_DW = WS_PROJ + (size_t)NTOK * NPROJ * 2;
constexpr size_t WS_DKC = WS_DW + (size_t)1024 * 8192 * 4;
constexpr size_t WS_DQD = WS_DKC + (size_t)1024 * 8192 * 2;
constexpr size_t WS_DQK = WS_DQD + (size_t)1024 * 8192 * 2;
constexpr size_t WS_DKT = WS_DQK + (size_t)1024 * 4096 * 2;
constexpr size_t WS_DGL = WS_DKT + (size_t)1024 * 8192 * 2;
constexpr size_t WS_DGS = WS_DGL + 4096;
constexpr size_t WS_BAR = WS_DGS + (size_t)1024 * 8192 * 2;
constexpr size_t WS_PARTS = WS_BAR + 16384;
constexpr size_t WS_END = WS_PARTS + (size_t)11 * 512 * 1024 * 4;
constexpr size_t WS_HID = WS_PROJ;
static_assert(WS_HID + (size_t)NTOK * DFF * 2 <= WS_END, "HID overlay");
static_assert(WS_H % 256 == 0 && WS_PROJ % 256 == 0 && WS_DW % 256 == 0, "align");

constexpr size_t O_YP = 0, O_YS = O_YP + (size_t)NP * D, O_DP = O_YS + (size_t)NS * D, O_CP = O_DP + (size_t)DEPTH * 8 * 4 * 16384,
                 O_REP = O_CP + (size_t)DEPTH * 8 * 3 * 1536, O_IMP = O_REP + (size_t)DEPTH * 8 * 1024, O_PP = O_IMP + (size_t)DEPTH * 8 * 1024,
                 O_DS = O_PP + (size_t)DEPTH * 8 * 15 * 256, O_CS = O_DS + (size_t)DEPTH * 128 * 4 * 16384, O_RES = O_CS + (size_t)DEPTH * 128 * 3 * 1536,
                 O_IMS = O_RES + (size_t)DEPTH * 128 * 1024, O_PS = O_IMS + (size_t)DEPTH * 128 * 1024, O_END = O_PS + (size_t)DEPTH * 128 * 15 * 256;

struct Args { const float* in[32]; float* out; unsigned char* ws; int ph_lo, ph_hi; };
typedef const float* cfp_t;
typedef __attribute__((address_space(4))) const unsigned char* kptr_t;
struct InProxy { __device__ __forceinline__ const float* operator[](int i) const {
    kptr_t p = (kptr_t)__builtin_amdgcn_kernarg_segment_ptr(); asm volatile("" : "+s"(p)); return *(__attribute__((address_space(4))) const cfp_t*)(p + 8 * i); } };
struct DevArgs { InProxy in; float* out; unsigned char* ws; int ph_lo, ph_hi; };
enum { I_XP = 0, I_XS, I_SDELTA, I_SCONV, I_SRE, I_SIM, I_SPOOL, I_NMPRE, I_NMPOST, I_NFPRE, I_NFPOST, I_WIN, I_CONVW, I_ALOG, I_DTB, I_ONORM,
       I_ARE, I_AIM, I_LOGDT, I_BRE, I_BIM, I_CRE, I_CIM, I_SSMD, I_GLUW, I_GLUB, I_POOLW, I_POOLS, I_WOUT, I_WG, I_WU, I_WD };

__device__ __forceinline__ unsigned f2bf(float f) { unsigned u = __float_as_uint(f); return (u + 0x7fffu + ((u >> 16) & 1u)) >> 16; }
__device__ __forceinline__ float bf2f(unsigned b) { return __uint_as_float(b << 16); }
__device__ __forceinline__ unsigned pk2(float lo, float hi) { return f2bf(lo) | (f2bf(hi) << 16); }
template <int CTRL> __device__ __forceinline__ float dpp_f(float v) { return __builtin_bit_cast(float, __builtin_amdgcn_update_dpp(0, __builtin_bit_cast(int, v), CTRL, 0xF, 0xF, true)); }
__device__ __forceinline__ float row_sum8(float v) { v += dpp_f<0xB1>(v); v += dpp_f<0x4E>(v); v += dpp_f<0x141>(v); return v; }
__device__ __forceinline__ float row_sum16(float v) { v = row_sum8(v); v += dpp_f<0x140>(v); return v; }
__device__ __forceinline__ float wave_sum(float v) { v = row_sum16(v); v += __shfl_xor(v, 16); v += __shfl_xor(v, 32); return v; }
__device__ __forceinline__ float silu_f(float y) { return y * __builtin_amdgcn_rcpf(1.f + __expf(-y)); }
__device__ __forceinline__ float sigmoid_f(float y) { return __builtin_amdgcn_rcpf(1.f + __expf(-y)); }
__device__ __forceinline__ float gelu_tanh_f(float x) { const float z = 0.7978845608028654f * (x + 0.044715f * x * x * x);
    const float t = 1.f - 2.f * __builtin_amdgcn_rcpf(1.f + __expf(2.f * z)); return 0.5f * x * (1.f + t); }
__device__ __forceinline__ f32x4 mfma16(bf16x8 a, bf16x8 b, f32x4 c) { return __builtin_amdgcn_mfma_f32_16x16x32_bf16(a, b, c, 0, 0, 0); }
#define LDS_FENCE() asm volatile("s_waitcnt lgkmcnt(0)" ::: "memory")

struct EpiSwiGLU {
    static constexpr bool PERM = false, AFTER_DRAIN = false;
    bf16_t* O; int ldc;
    __device__ __forceinline__ void operator()(const pg8::f32x4 (&acc)[2][2][4][2], const pg8::Unit& u, int wr, int wc, int fr, int fq) const {
        const int row0 = u.pm * 256 + wr * 64 + fr, hid0 = u.pn * 128 + wc * 16 + 4 * fq;
#pragma unroll
        for (int ai = 0; ai < 2; ++ai)
#pragma unroll
            for (int m = 0; m < 4; ++m) { bf16_t* rowp = O + (size_t)(row0 + ai * 128 + m * 16) * ldc + hid0;
#pragma unroll
                for (int bj = 0; bj < 2; ++bj) { const pg8::f32x4 g = acc[ai][bj][m][0], v = acc[ai][bj][m][1];
                    u32x2 w; w.x = pg8::cvt_pk_bf16(silu_f(g[0]) * v[0], silu_f(g[1]) * v[1]); w.y = pg8::cvt_pk_bf16(silu_f(g[2]) * v[2], silu_f(g[3]) * v[3]);
                    *(u32x2*)(rowp + bj * 64) = w; } }
    }
};

#define XB_TMO      128
#define XB_XCNT(j)  (256  + 64 * (j))
#define XB_XSUB(j)  (1280 + 64 * (j))
#define XB_XGEN(j)  (2304 + 64 * (j))
#define XB_TOP      3328
#define XB_TOPGEN   3392
#define XCD_BAR_WORDS 3456
#define XB_SPIN_CAP (1u << 18)

__device__ __forceinline__ unsigned xb_ld(unsigned* p)              { return __hip_atomic_load(p, __ATOMIC_RELAXED, __HIP_MEMORY_SCOPE_AGENT); }
__device__ __forceinline__ unsigned xb_add(unsigned* p, unsigned v) { return __hip_atomic_fetch_add(p, v, __ATOMIC_RELAXED, __HIP_MEMORY_SCOPE_AGENT); }
__device__ __forceinline__ unsigned xb_xcc_id() { return (unsigned)__builtin_amdgcn_s_getreg((3 << 11) | 20) & 0xFu; }
#define XB_SPIN(cond, bar) do { unsigned _sp = 0; while (cond) { __builtin_amdgcn_s_sleep(1); \
    if ((++_sp & 255u) == 0u) { if (xb_ld(&(bar)[XB_TMO])) break; if (_sp > XB_SPIN_CAP) { atomicAdd(&(bar)[XB_TMO], 1u); break; } } } } while (0)

struct XcdBarrier {
    unsigned* bar; unsigned x;
    volatile LAS unsigned* st;
};

__device__ __forceinline__ XcdBarrier xcd_barrier_post(unsigned* bar, volatile LAS unsigned* st) {
    XcdBarrier b; b.bar = bar; b.x = xb_xcc_id(); b.st = st;
    if (threadIdx.x == 0) (void)xb_add(&bar[XB_XCNT(b.x)], 1u);
    return b;
}
__device__ __forceinline__ void xcd_barrier_complete(unsigned* bar, unsigned x, unsigned& nloc, unsigned& nx) {
    const unsigned G = gridDim.x * gridDim.y * gridDim.z;
    unsigned sum, cnt, mine, sp = 0u;
    for (;;) {
        sum = 0u; cnt = 0u; mine = 0u;
#pragma unroll
        for (unsigned j = 0; j < 16; ++j) { const unsigned c = xb_ld(&bar[XB_XCNT(j)]); sum += c; cnt += (c > 0u) ? 1u : 0u; mine = (j == x) ? c : mine; }
        if (sum == G) break;
        __builtin_amdgcn_s_sleep(1);
        if ((++sp & 255u) == 0u) { if (xb_ld(&bar[XB_TMO])) break; if (sp > XB_SPIN_CAP) { atomicAdd(&bar[XB_TMO], 1u); break; } }
    }
    nloc = mine > 0u ? mine : 1u; nx = cnt > 0u ? cnt : 1u;
}

__device__ __forceinline__ void xcd_barrier(const XcdBarrier& b) {
    asm volatile("s_waitcnt vmcnt(0)" ::: "memory");
    __syncthreads();
    if (threadIdx.x == 0) {
        unsigned* bar = b.bar; asm volatile("" : "+s"(bar));
        __builtin_amdgcn_s_waitcnt(0);
        unsigned nloc = b.st[0], nx = b.st[1];
        if (nloc == 0u) { xcd_barrier_complete(bar, b.x, nloc, nx); b.st[0] = nloc; b.st[1] = nx; }
        const unsigned old = xb_add(&bar[XB_XSUB(b.x)], 1u);
        const unsigned gen = old / nloc;
        if (old + 1u == (gen + 1u) * nloc) {
            __builtin_amdgcn_fence(__ATOMIC_RELEASE, "agent");
            asm volatile("s_waitcnt vmcnt(0)" ::: "memory");
            const unsigned og = xb_add(&bar[XB_TOP], 1u);
            const unsigned tg = og / nx;
            if (og + 1u == (tg + 1u) * nx) xb_add(&bar[XB_TOPGEN], 1u);
            else XB_SPIN(xb_ld(&bar[XB_TOPGEN]) == tg, bar);
            __builtin_amdgcn_fence(__ATOMIC_ACQUIRE, "agent");
            xb_add(&bar[XB_XGEN(b.x)], 1u);
            asm volatile("s_waitcnt vmcnt(0)" ::: "memory");
        } else {
            XB_SPIN(xb_ld(&bar[XB_XGEN(b.x)]) == gen, bar);
            __builtin_amdgcn_fence(__ATOMIC_ACQUIRE, "agent");
            asm volatile("s_waitcnt vmcnt(0)" ::: "memory");
        }
    }
    __syncthreads();
}

struct SliceOrder {
    int nunits, G, c;
    __device__ __forceinline__ bool next(int i, pg8::Unit& u) const { const int L = i * G + c; if (L >= nunits) return false; const int t = L & 7; u.pm = t >> 2; u.pn = t & 3; u.ks = L >> 3; return true; }
    __device__ __forceinline__ void a_ready(const pg8::Unit&) const {}
    __device__ __forceinline__ void done(const pg8::Unit&) const {}
};
struct EpiF32Part {
    static constexpr bool PERM = false, AFTER_DRAIN = false;
    float* C;
    __device__ __forceinline__ void operator()(const pg8::f32x4 (&acc)[2][2][4][2], const pg8::Unit& u, int wr, int wc, int fr, int fq) const {
        const int row0 = u.pm * 256 + wr * 64 + fr, col0 = u.pn * 256 + wc * 32 + 4 * fq; float* base = C + (size_t)u.ks * (512 * 1024);
#pragma unroll
        for (int ai = 0; ai < 2; ++ai)
#pragma unroll
            for (int m = 0; m < 4; ++m) { float* rowp = base + (size_t)(row0 + ai * 128 + m * 16) * 1024 + col0;
#pragma unroll
                for (int bj = 0; bj < 2; ++bj)
#pragma unroll
                    for (int n = 0; n < 2; ++n) *(pg8::f32x4*)(rowp + bj * 128 + n * 16) = acc[ai][bj][m][n]; }
    }
};

struct SrcIn { const float* w; __device__ __forceinline__ float operator()(int k, int n) const { return w[(size_t)k * INW + (n < 1536 ? n : n + 8)]; } };
struct SrcPlain { const float* w; int N; __device__ __forceinline__ float operator()(int k, int n) const { return w[(size_t)k * N + n]; } };
struct SrcGU { const float* g; const float* u; __device__ __forceinline__ float operator()(int k, int n) const { const int r = n & 31, hid = (n >> 5) * 16 + (r & 15); const long long du = (r < 16) ? 0ll : (long long)(u - g); return g[du + (long long)k * DFF + hid]; } };
template <class Src> __device__ __forceinline__ void transpose_item(const Src& src, int K, bf16_t* WT, int nblk, LAS float* scr, int item, int lane) {
    const int kb = item / nblk, nb = item % nblk, k0 = 64 * kb, n0 = 32 * nb;
#pragma unroll 8
    for (int i = 0; i < 32; ++i) { const int kk = 2 * i + (lane >> 5); scr[kk * 33 + (lane & 31)] = src(k0 + kk, n0 + (lane & 31)); }
    LDS_FENCE();
    const int c = lane & 7;
#pragma unroll
    for (int j = 0; j < 4; ++j) { const int n = (lane >> 3) + 8 * j; const LAS float* s = scr + (8 * c) * 33 + n;
        u32x4 o; o.x = pk2(s[0 * 33], s[1 * 33]); o.y = pk2(s[2 * 33], s[3 * 33]); o.z = pk2(s[4 * 33], s[5 * 33]); o.w = pk2(s[6 * 33], s[7 * 33]);
        *(u32x4*)(WT + (size_t)(n0 + n) * K + k0 + 8 * c) = o; }
    LDS_FENCE();
}

__device__ __forceinline__ void norm_rows(const float* T, const float* wt, const float* X0, const float* X1, float* Xout, const float* wh, bf16_t* H,
                                          const float* Wab, float* AB, int gw, int NGW, int lane, const float* Tp = nullptr, int ns = 0,
                                          const bf16_t* Xbin = nullptr, bf16_t* Xbout = nullptr) {
#pragma unroll 1
    for (int m = gw; m < NTOK; m += NGW) {
        f32x4 x[4], t[4];
        { if (Xbin) {
#pragma unroll
              for (int j = 0; j < 4; ++j) { const u32x2 xb = ((const u32x2*)(Xbin + (size_t)m * D))[lane + 64 * j];
                  x[j] = (f32x4){__uint_as_float(xb.x << 16), __uint_as_float(xb.x & 0xffff0000u), __uint_as_float(xb.y << 16), __uint_as_float(xb.y & 0xffff0000u)}; } }
          else { const float* xr = (X1 && m >= NP) ? X1 + (size_t)(m - NP) * D : X0 + (size_t)m * D;
#pragma unroll
              for (int j = 0; j < 4; ++j) x[j] = ((const f32x4*)xr)[lane + 64 * j]; }
          if (T && !(Tp && m >= NP)) {
#pragma unroll
              for (int j = 0; j < 4; ++j) { const u32x2 tb = ((const u32x2*)((const bf16_t*)T + (size_t)m * D))[lane + 64 * j];
                  t[j] = (f32x4){__uint_as_float(tb.x << 16), __uint_as_float(tb.x & 0xffff0000u), __uint_as_float(tb.y << 16), __uint_as_float(tb.y & 0xffff0000u)}; } } }
        if (T) {
            float ss = 0.f;
            if (Tp && m >= NP) {
#pragma unroll
                for (int j = 0; j < 4; ++j) { f32x4 a = {0.f, 0.f, 0.f, 0.f}; for (int q = 0; q < ns; ++q) a += ((const f32x4*)(Tp + (size_t)q * (512 * 1024) + (size_t)(m - NP) * D))[lane + 64 * j]; t[j] = a; } }
#pragma unroll
            for (int j = 0; j < 4; ++j) ss += (t[j].x * t[j].x + t[j].y * t[j].y) + (t[j].z * t[j].z + t[j].w * t[j].w);
            ss = wave_sum(ss); const float r = rsqrtf(ss * (1.f / D) + EPS);
#pragma unroll
            for (int j = 0; j < 4; ++j) { const f32x4 w = ((const f32x4*)wt)[lane + 64 * j]; x[j] += t[j] * r * w; }
        }
        if (Xout) {
#pragma unroll
            for (int j = 0; j < 4; ++j) ((f32x4*)(Xout + (size_t)m * D))[lane + 64 * j] = x[j];
        }
        if (Xbout) {
#pragma unroll
            for (int j = 0; j < 4; ++j) { u32x2 o; o.x = pk2(x[j].x, x[j].y); o.y = pk2(x[j].z, x[j].w); ((u32x2*)(Xbout + (size_t)m * D))[lane + 64 * j] = o; }
        }
        if (H) {
            float ss = 0.f;
#pragma unroll
            for (int j = 0; j < 4; ++j) ss += (x[j].x * x[j].x + x[j].y * x[j].y) + (x[j].z * x[j].z + x[j].w * x[j].w);
            ss = wave_sum(ss); const float r = rsqrtf(ss * (1.f / D) + EPS);
            f32x4 hv[4];
#pragma unroll
            for (int j = 0; j < 4; ++j) { const f32x4 w = ((const f32x4*)wh)[lane + 64 * j]; hv[j] = x[j] * r * w;
                u32x2 o; o.x = pk2(hv[j].x, hv[j].y); o.y = pk2(hv[j].z, hv[j].w); ((u32x2*)(H + (size_t)m * D))[lane + 64 * j] = o; }
            if (Wab) {
                float d[8];
#pragma unroll
                for (int c = 0; c < 8; ++c) { float dd = 0.f;
#pragma unroll
                    for (int j = 0; j < 4; ++j) { const f32x4 w = ((const f32x4*)(Wab + c * D))[lane + 64 * j]; dd += (hv[j].x * w.x + hv[j].y * w.y) + (hv[j].z * w.z + hv[j].w * w.w); }
                    d[c] = dd; }
#pragma unroll
                for (int c = 0; c < 8; ++c) d[c] = row_sum16(d[c]);
#pragma unroll
                for (int o = 16; o < 64; o <<= 1) {
#pragma unroll
                    for (int c = 0; c < 8; ++c) d[c] += __shfl_xor(d[c], o); }
                if (lane == 0) { f32x4 o0 = {d[0], d[1], d[2], d[3]}, o1 = {d[4], d[5], d[6], d[7]}; *(f32x4*)(AB + (size_t)m * 8) = o0; *(f32x4*)(AB + (size_t)m * 8 + 4) = o1; }
            }
        }
    }
}

__device__ __forceinline__ void norm_rows_pf(const float* T, const float* wt, bf16_t* XB, const float* wh, bf16_t* H,
                                             int gw, int NGW, int lane, const float* Tp, int ns) {
    u32x2 xn[4], tn[4];
#define NR_LOAD(mm) do { const int _m = (mm); \
        _Pragma("unroll") for (int j = 0; j < 4; ++j) xn[j] = ((const u32x2*)(XB + (size_t)_m * D))[lane + 64 * j]; \
        if (_m < NP) { _Pragma("unroll") for (int j = 0; j < 4; ++j) tn[j] = ((const u32x2*)((const bf16_t*)T + (size_t)_m * D))[lane + 64 * j]; } } while (0)
    if (gw < NTOK) NR_LOAD(gw);
#pragma unroll 1
    for (int m = gw; m < NTOK; m += NGW) {
        f32x4 x[4], t[4];
#pragma unroll
        for (int j = 0; j < 4; ++j) { x[j] = (f32x4){__uint_as_float(xn[j].x << 16), __uint_as_float(xn[j].x & 0xffff0000u), __uint_as_float(xn[j].y << 16), __uint_as_float(xn[j].y & 0xffff0000u)};
            t[j] = (f32x4){__uint_as_float(tn[j].x << 16), __uint_as_float(tn[j].x & 0xffff0000u), __uint_as_float(tn[j].y << 16), __uint_as_float(tn[j].y & 0xffff0000u)}; }
        if (m + NGW < NTOK) NR_LOAD(m + NGW);
        if (m >= NP) {
#pragma unroll
            for (int j = 0; j < 4; ++j) { f32x4 a = {0.f, 0.f, 0.f, 0.f}; for (int q = 0; q < ns; ++q) a += ((const f32x4*)(Tp + (size_t)q * (512 * 1024) + (size_t)(m - NP) * D))[lane + 64 * j]; t[j] = a; } }
        float ss = 0.f;
#pragma unroll
        for (int j = 0; j < 4; ++j) ss += (t[j].x * t[j].x + t[j].y * t[j].y) + (t[j].z * t[j].z + t[j].w * t[j].w);
        ss = wave_sum(ss); const float r = rsqrtf(ss * (1.f / D) + EPS);
#pragma unroll
        for (int j = 0; j < 4; ++j) { const f32x4 w = ((const f32x4*)wt)[lane + 64 * j]; x[j] += t[j] * r * w; }
#pragma unroll
        for (int j = 0; j < 4; ++j) { u32x2 o; o.x = pk2(x[j].x, x[j].y); o.y = pk2(x[j].z, x[j].w); ((u32x2*)(XB + (size_t)m * D))[lane + 64 * j] = o; }
        float s2 = 0.f;
#pragma unroll
        for (int j = 0; j < 4; ++j) s2 += (x[j].x * x[j].x + x[j].y * x[j].y) + (x[j].z * x[j].z + x[j].w * x[j].w);
        s2 = wave_sum(s2); const float r2 = rsqrtf(s2 * (1.f / D) + EPS);
#pragma unroll
        for (int j = 0; j < 4; ++j) { const f32x4 w = ((const f32x4*)wh)[lane + 64 * j]; const f32x4 hv = x[j] * r2 * w;
            u32x2 o; o.x = pk2(hv.x, hv.y); o.y = pk2(hv.z, hv.w); ((u32x2*)(H + (size_t)m * D))[lane + 64 * j] = o; }
    }
#undef NR_LOAD
}

__device__ __forceinline__ void prologue(const DevArgs& A, LAS unsigned char* lds, int wave, int lane, int gw, int NGW) {
    LAS float* scr = (LAS float*)(lds + wave * 8704);
    constexpr int I_IN = 16 * 80, I_OUT = 16 * 32, I_GU = 16 * 176, I_DN = 44 * 32, I_GLU = 4 * 8, I_POOL = 8, PER = I_IN + I_OUT + I_GU + I_DN + I_GLU + I_POOL;
#pragma unroll 1
    for (int it = gw; it < DEPTH * PER; it += NGW) {
        const int l = it / PER; int r = it % PER;
        if (r < I_IN) { SrcIn s{A.in[I_WIN] + (size_t)l * D * INW}; transpose_item(s, D, (bf16_t*)(A.ws + WS_WIN + l * SZ_WIN), NPROJ / 32, scr, r, lane); continue; } r -= I_IN;
        if (r < I_OUT) { SrcPlain s{A.in[I_WOUT] + (size_t)l * D * D, D}; transpose_item(s, D, (bf16_t*)(A.ws + WS_WOUT + l * SZ_WOUT), D / 32, scr, r, lane); continue; } r -= I_OUT;
        if (r < I_GU) { SrcGU s{A.in[I_WG] + (size_t)l * D * DFF, A.in[I_WU] + (size_t)l * D * DFF}; transpose_item(s, D, (bf16_t*)(A.ws + WS_WGU + l * SZ_WGU), NGU / 32, scr, r, lane); continue; } r -= I_GU;
        if (r < I_DN) { SrcPlain s{A.in[I_WD] + (size_t)l * DFF * D, D}; transpose_item(s, DFF, (bf16_t*)(A.ws + WS_WDN + l * SZ_WDN), D / 32, scr, r, lane); continue; } r -= I_DN;
        if (r < I_GLU) { SrcPlain s{A.in[I_GLUW] + (size_t)l * 65536, 256}; transpose_item(s, 256, (bf16_t*)(A.ws + WS_GLUT + l * SZ_GLUT), 8, scr, r, lane); continue; } r -= I_GLU;
        { const int g = r >> 1; SrcPlain s{A.in[I_POOLW] + (size_t)(l * 4 + g) * 4096, 64}; transpose_item(s, 64, (bf16_t*)(A.ws + WS_POOLT + l * SZ_POOLT) + g * 4096, 2, scr, r & 1, lane); }
    }
    const int gt = gw * 64 + lane, NT = NGW * 64;
    float* wab = (float*)(A.ws + WS_WAB);
#pragma unroll 1
    for (int i = gt; i < DEPTH * 8 * D; i += NT) { const int l = i / (8 * D), j = (i / D) & 7, k = i % D; wab[i] = A.in[I_WIN][((size_t)l * D + k) * INW + 1536 + j]; }
    float* ssmk = (float*)(A.ws + WS_SSMK); float* bbar = (float*)(A.ws + WS_BBAR);
#pragma unroll 1
    for (int i = gt; i < DEPTH * 16 * 64; i += NT) {
        const int lg = i >> 6;
        const float dt = expf(A.in[I_LOGDT][lg]), ar = A.in[I_ARE][i], ai = A.in[I_AIM][i];
        const float mag = expf(ar * dt);
        float rev = ai * dt * 0.15915494309189535f; rev -= floorf(rev);
        const float sn = __builtin_amdgcn_sinf(rev), cs = __builtin_amdgcn_cosf(rev);
        const float lr = mag * cs, li = mag * sn;
        float pr = lr, pi = li;
#pragma unroll
        for (int q = 0; q < 6; ++q) { const float nr2 = pr * pr - pi * pi, ni2 = 2.f * pr * pi; pr = nr2; pi = ni2; }
        ssmk[i * 4 + 0] = lr; ssmk[i * 4 + 1] = li; ssmk[i * 4 + 2] = pr; ssmk[i * 4 + 3] = pi;
        const float nr = lr - 1.f, ni = li, d2 = ar * ar + ai * ai;
        const float cre = (nr * ar + ni * ai) / d2, cim = (ni * ar - nr * ai) / d2;
#pragma unroll
        for (int h = 0; h < 16; ++h) { const float br = A.in[I_BRE][(size_t)i * 16 + h], bi = A.in[I_BIM][(size_t)i * 16 + h];
            bbar[(size_t)i * 32 + h] = cre * br - cim * bi; bbar[(size_t)i * 32 + 16 + h] = cre * bi + cim * br; }
    }
}

__device__ __forceinline__ unsigned bfmul2(unsigned pk, float f0, float f1) { return pg8::cvt_pk_bf16(__uint_as_float(pk << 16) * f0, __uint_as_float(pk & 0xffff0000u) * f1); }
__device__ __forceinline__ void delta_prep_item(const DevArgs& A, int l, LAS unsigned char* lds, int item, int tid, int wave, int lane) {
    asm volatile("" : "+v"(tid)); lane = tid & 63; wave = __builtin_amdgcn_readfirstlane(tid >> 6);
    const int bh = item >> 5, n = item & 31, b = bh >> 2, h = bh & 3;
    const int tok0 = b * SEQ + n * 64;
    LAS bf16_t* QS = (LAS bf16_t*)(lds); LAS bf16_t* KS = (LAS bf16_t*)(lds + 17408);
    LAS unsigned char* KT = lds + 34816; LAS unsigned char* VT = lds + 53248; LAS unsigned char* RTK = lds + 71680;
    LAS float* AM = (LAS float*)(lds + 90112); LAS float* PM = (LAS float*)(lds + 107520); LAS float* PSC = PM; LAS float* TM = (LAS float*)(lds + 124928);
    LAS unsigned char* TB = lds + 142336;
    LAS float* GAM = (LAS float*)(lds + 151552); LAS float* BETA = GAM + 64; LAS float* RQ = GAM + 128; LAS float* RK = GAM + 192;
    LAS float* F2 = GAM + 256; LAS float* F3 = GAM + 320; LAS float* F4 = GAM + 384;
    const bf16_t* PROJ = (const bf16_t*)(A.ws + WS_PROJ);
    const float* AB = (const float*)(A.ws + WS_AB);
    u32x4 gv[2];
#pragma unroll
    for (int j = 0; j < 2; ++j) { const int id = tid + 512 * j; gv[j] = *(const u32x4*)(PROJ + (size_t)(tok0 + (id >> 4)) * NPROJ + PC_G + h * 128 + (id & 15) * 8); }
    if (tid < 384) {
        const int part = tid >> 7, c = tid & 127, col = part * 512 + h * 128 + c;
        const float* cw = A.in[I_CONVW] + (size_t)l * 4 * 1536;
        const float w0 = cw[col], w1 = cw[1536 + col], w2 = cw[3072 + col], w3 = cw[4608 + col];
        const bf16_t* pp = PROJ + (size_t)tok0 * NPROJ + col;
        float xr[67];
#pragma unroll
        for (int t = 0; t < 67; ++t) xr[t] = (n > 0 || t >= 3) ? bf2f(pp[(long)(t - 3) * NPROJ]) : 0.f;
        unsigned pk[32];
#pragma unroll
        for (int t = 0; t < 64; t += 2) {
            const float s0 = silu_f(w0 * xr[t] + w1 * xr[t + 1] + w2 * xr[t + 2] + w3 * xr[t + 3]);
            const float s1 = silu_f(w0 * xr[t + 1] + w1 * xr[t + 2] + w2 * xr[t + 3] + w3 * xr[t + 4]);
            pk[t >> 1] = pg8::cvt_pk_bf16(s0, s1);
        }
        if (part < 2) { LAS bf16_t* dst = (part == 0 ? QS : KS) + c;
#pragma unroll
            for (int t = 0; t < 64; t += 2) { dst[t * 136] = (bf16_t)(pk[t >> 1] & 0xffffu); dst[(t + 1) * 136] = (bf16_t)(pk[t >> 1] >> 16); } }
        if (part > 0) { LAS unsigned char* dst = (part == 1 ? KT : VT) + c * 144;
#pragma unroll
            for (int q = 0; q < 8; ++q) { u32x4 o; o.x = pk[4 * q]; o.y = pk[4 * q + 1]; o.z = pk[4 * q + 2]; o.w = pk[4 * q + 3]; *(LAS u32x4*)(dst + q * 16) = o; } }
    } else if (tid < 448) {
        const int t = tid - 384;
        const float a = AB[(size_t)(tok0 + t) * 8 + h], bb = AB[(size_t)(tok0 + t) * 8 + 4 + h];
        const float xx = a + A.in[I_DTB][l * 4 + h];
        const float sp = xx > 20.f ? xx : log1pf(expf(xx));
        float lg = -expf(A.in[I_ALOG][l * 4 + h]) * sp;
#pragma unroll
        for (int off = 1; off < 64; off <<= 1) { const float v = __shfl_up(lg, off); if (lane >= off) lg += v; }
        GAM[t] = lg; BETA[t] = 1.f / (1.f + expf(-bb));
    }
    __syncthreads();
    {
        const int t = tid >> 3, part = tid & 7; float sq = 0.f, sk = 0.f;
#pragma unroll
        for (int j = 0; j < 16; ++j) { const float q = bf2f(QS[t * 136 + part * 16 + j]), k = bf2f(KS[t * 136 + part * 16 + j]); sq += q * q; sk += k * k; }
        sq = row_sum8(sq); sk = row_sum8(sk);
        if (part == 0) { const float rq = rsqrtf(sq + EPS) * 0.08838834764831845f, rk = rsqrtf(sk + EPS), g = GAM[t], eg = __expf(g), bt = BETA[t];
            RQ[t] = rq; RK[t] = rk; F2[t] = bt * eg * rk; F3[t] = rk * __expf(GAM[63] - g); F4[t] = rq * eg; }
    }
    {
        const int prod = wave >> 2, mt = wave & 3, fr = lane & 15, quad = lane >> 4;
        LAS bf16_t* Aop = prod ? QS : KS; LAS float* dst = prod ? PM : AM;
        bf16x8 a[4];
#pragma unroll
        for (int kk = 0; kk < 4; ++kk) a[kk] = *(LAS bf16x8*)(Aop + (mt * 16 + fr) * 136 + kk * 32 + quad * 8);
#pragma unroll
        for (int nt = 0; nt < 4; ++nt) { f32x4 acc = {0.f, 0.f, 0.f, 0.f};
#pragma unroll
            for (int kk = 0; kk < 4; ++kk) { const bf16x8 bq = *(LAS bf16x8*)(KS + (nt * 16 + fr) * 136 + kk * 32 + quad * 8); acc = mfma16(a[kk], bq, acc); }
#pragma unroll
            for (int i = 0; i < 4; ++i) dst[(mt * 16 + quad * 4 + i) * 68 + nt * 16 + fr] = acc[i]; }
    }
    __syncthreads();
    {
        const int t = tid >> 3, s8 = (tid & 7) * 8; const float gt = GAM[t], bk = BETA[t] * RK[t], rqt = RQ[t];
        float av[8], pv[8];
#pragma unroll
        for (int j = 0; j < 8; ++j) { const int s = s8 + j; const float rks = RK[s]; const float dec = (s <= t) ? __expf(gt - GAM[s]) * rks : 0.f;
            av[j] = (s < t) ? bk * dec * AM[t * 68 + s] : 0.f; pv[j] = rqt * dec * PM[t * 68 + s]; }
#pragma unroll
        for (int j = 0; j < 8; ++j) AM[t * 68 + s8 + j] = av[j];
        u32x4 o; o.x = pg8::cvt_pk_bf16(pv[0], pv[1]); o.y = pg8::cvt_pk_bf16(pv[2], pv[3]); o.z = pg8::cvt_pk_bf16(pv[4], pv[5]); o.w = pg8::cvt_pk_bf16(pv[6], pv[7]);
        *(u32x4*)((bf16_t*)(A.ws + WS_DQK) + (size_t)item * 4096 + t * 64 + s8) = o;
        for (int e = tid; e < 64 * 68; e += 512) TM[e] = 0.f;
        if (tid == 0) ((float*)(A.ws + WS_DGL))[item] = __expf(GAM[63]);
    }
    __syncthreads();
    if (wave == 0) {
        const int i = lane >> 4, c = lane & 15;
        LAS float* amp = AM + (16 * i) * 68 + 16 * i; asm volatile("" : "+v"(amp));
        float x[16];
#pragma unroll
        for (int r = 0; r < 16; ++r) { float acc = (r == c) ? 1.f : 0.f;
#pragma unroll
            for (int s = 0; s < r; ++s) acc = fmaf(-amp[r * 68 + s], x[s], acc);
            x[r] = acc; }
        LAS float* tmp = TM + (16 * i) * 68 + 16 * i + c;
#pragma unroll
        for (int r = 0; r < 16; ++r) tmp[r * 68] = x[r];
    } else {
        const int wt = tid - 64;
        for (int id = wt; id < 1024; id += 448) {
            const int c = id >> 3, t8 = (id & 7) * 8;
            const f32x4 b0 = *(LAS f32x4*)(BETA + t8), b1 = *(LAS f32x4*)(BETA + t8 + 4);
            u32x4 v = *(LAS u32x4*)(VT + c * 144 + t8 * 2);
            v.x = bfmul2(v.x, b0[0], b0[1]); v.y = bfmul2(v.y, b0[2], b0[3]); v.z = bfmul2(v.z, b1[0], b1[1]); v.w = bfmul2(v.w, b1[2], b1[3]);
            *(LAS u32x4*)(VT + c * 144 + t8 * 2) = v;
            const f32x4 f20 = *(LAS f32x4*)(F2 + t8), f21 = *(LAS f32x4*)(F2 + t8 + 4), f30 = *(LAS f32x4*)(F3 + t8), f31 = *(LAS f32x4*)(F3 + t8 + 4);
            const u32x4 k = *(LAS u32x4*)(KT + c * 144 + t8 * 2);
            u32x4 rk; rk.x = bfmul2(k.x, f20[0], f20[1]); rk.y = bfmul2(k.y, f20[2], f20[3]); rk.z = bfmul2(k.z, f21[0], f21[1]); rk.w = bfmul2(k.w, f21[2], f21[3]);
            *(LAS u32x4*)(RTK + c * 144 + t8 * 2) = rk;
            u32x4 kd; kd.x = bfmul2(k.x, f30[0], f30[1]); kd.y = bfmul2(k.y, f30[2], f30[3]); kd.z = bfmul2(k.z, f31[0], f31[1]); kd.w = bfmul2(k.w, f31[2], f31[3]);
            *(u32x4*)((bf16_t*)(A.ws + WS_DKT) + (size_t)item * 8192 + c * 64 + t8) = kd; }
        for (int id = wt; id < 1024; id += 448) {
            const int t = id >> 4, c8 = (id & 15) * 8; const float f = F4[t];
            u32x4 q = *(LAS u32x4*)((LAS unsigned char*)QS + t * 272 + c8 * 2);
            q.x = bfmul2(q.x, f, f); q.y = bfmul2(q.y, f, f); q.z = bfmul2(q.z, f, f); q.w = bfmul2(q.w, f, f);
            *(u32x4*)((bf16_t*)(A.ws + WS_DQD) + (size_t)item * 8192 + t * 128 + c8) = q; }
    }
    {
        const int c8 = (tid & 15) * 8; const float* on = A.in[I_ONORM] + l * 128 + c8;
        const f32x4 o0 = *(const f32x4*)on, o1 = *(const f32x4*)(on + 4);
#pragma unroll
        for (int j = 0; j < 2; ++j) { const int id = tid + 512 * j; const u32x4 g = gv[j]; u32x4 o;
            o.x = pg8::cvt_pk_bf16(silu_f(__uint_as_float(g.x << 16)) * o0[0], silu_f(__uint_as_float(g.x & 0xffff0000u)) * o0[1]);
            o.y = pg8::cvt_pk_bf16(silu_f(__uint_as_float(g.y << 16)) * o0[2], silu_f(__uint_as_float(g.y & 0xffff0000u)) * o0[3]);
            o.z = pg8::cvt_pk_bf16(silu_f(__uint_as_float(g.z << 16)) * o1[0], silu_f(__uint_as_float(g.z & 0xffff0000u)) * o1[1]);
            o.w = pg8::cvt_pk_bf16(silu_f(__uint_as_float(g.w << 16)) * o1[2], silu_f(__uint_as_float(g.w & 0xffff0000u)) * o1[3]);
            *(u32x4*)((bf16_t*)(A.ws + WS_DGS) + (size_t)item * 8192 + (id >> 4) * 128 + c8) = o; }
    }
    __syncthreads();
    const int p2 = tid >> 8, r2 = (tid >> 4) & 15, c2 = tid & 15, rb = p2 ? 48 : 16, cb = p2 ? 32 : 0;
    {
        float acc = 0.f;
#pragma unroll
        for (int s = 0; s < 16; ++s) acc = fmaf(AM[(rb + r2) * 68 + cb + s], TM[(cb + s) * 68 + cb + c2], acc);
        PSC[(p2 * 16 + r2) * 68 + c2] = acc; }
    __syncthreads();
    {
        float acc = 0.f;
#pragma unroll
        for (int s = 0; s < 16; ++s) acc = fmaf(TM[(rb + r2) * 68 + rb + s], PSC[(p2 * 16 + s) * 68 + c2], acc);
        TM[(rb + r2) * 68 + cb + c2] = -acc; }
    __syncthreads();
    float p3[2];
#pragma unroll
    for (int j = 0; j < 2; ++j) { const int e = tid + 512 * j, r = e >> 5, c = e & 31; float acc = 0.f;
#pragma unroll 8
        for (int s = 0; s < 32; ++s) acc = fmaf(AM[(32 + r) * 68 + s], TM[s * 68 + c], acc);
        p3[j] = acc; }
    __syncthreads();
#pragma unroll
    for (int j = 0; j < 2; ++j) { const int e = tid + 512 * j; PSC[(e >> 5) * 68 + (e & 31)] = p3[j]; }
    __syncthreads();
#pragma unroll
    for (int j = 0; j < 2; ++j) { const int e = tid + 512 * j, r = e >> 5, c = e & 31; float acc = 0.f;
#pragma unroll 8
        for (int s = 0; s < 32; ++s) acc = fmaf(TM[(32 + r) * 68 + 32 + s], PSC[s * 68 + c], acc);
        p3[j] = -acc; }
#pragma unroll
    for (int j = 0; j < 2; ++j) { const int e = tid + 512 * j; TM[(32 + (e >> 5)) * 68 + (e & 31)] = p3[j]; }
    __syncthreads();
#pragma unroll
    for (int j = 0; j < 4; ++j) { const int e = tid + 512 * j, t = e >> 5, s2 = (e & 31) * 2;
        *(LAS unsigned*)(TB + t * 144 + s2 * 2) = pg8::cvt_pk_bf16(TM[t * 68 + s2], TM[t * 68 + s2 + 1]); }
    __syncthreads();
    {
        const int fr = lane & 15, quad = lane >> 4;
        bf16x8 bv[2], ak[2];
#pragma unroll
        for (int kk = 0; kk < 2; ++kk) { bv[kk] = *(LAS bf16x8*)(VT + (16 * wave + fr) * 144 + (kk * 32 + quad * 8) * 2); ak[kk] = *(LAS bf16x8*)(RTK + (16 * wave + fr) * 144 + (kk * 32 + quad * 8) * 2); }
        bf16_t* DW = (bf16_t*)(A.ws + WS_DW) + (size_t)item * 8192; bf16_t* DKC = (bf16_t*)(A.ws + WS_DKC) + (size_t)item * 8192;
#pragma unroll
        for (int mt = 0; mt < 4; ++mt) { f32x4 aw = {0.f, 0.f, 0.f, 0.f}, akc = {0.f, 0.f, 0.f, 0.f};
#pragma unroll
            for (int kk = 0; kk < 2; ++kk) { const bf16x8 tf = *(LAS bf16x8*)(TB + (mt * 16 + fr) * 144 + (kk * 32 + quad * 8) * 2);
                aw = mfma16(tf, bv[kk], aw);
                akc = mfma16(ak[kk], tf, akc); }
            u32x2 ow; ow.x = pk2(aw[0], aw[1]); ow.y = pk2(aw[2], aw[3]);
            *(u32x2*)(DW + (16 * wave + fr) * 64 + mt * 16 + quad * 4) = ow;
            u32x2 ok; ok.x = pk2(-akc[0], -akc[1]); ok.y = pk2(-akc[2], -akc[3]);
            *(u32x2*)(DKC + (mt * 16 + fr) * 128 + 16 * wave + quad * 4) = ok; }
    }
    __syncthreads();
}

__device__ __forceinline__ void delta_scan_item(const DevArgs& A, int l, LAS unsigned char* lds, int bh, int tid_in, int wave, int lane_in, const XcdBarrier& xb, int SUB) {
    const int b = bh >> 2, h = bh & 3;
    LAS unsigned char* KCs = lds; LAS unsigned char* QDs = lds + 17408; LAS unsigned char* QKs = lds + 34816; LAS unsigned char* KDTs = lds + 44032;
    LAS unsigned char* Ws = lds + 62464;
    LAS unsigned char* GSs = lds + 80896;
    LAS unsigned char* SS = lds + 98304 + wave * 4352; LAS unsigned char* US = lds + 133120 + wave * 2304;
    LAS float* PART = (LAS float*)(lds + 151552);
    const unsigned char* gW = A.ws + WS_DW; const unsigned char* gGS = A.ws + WS_DGS;
    const unsigned char* gKC = A.ws + WS_DKC; const unsigned char* gQD = A.ws + WS_DQD; const unsigned char* gQK = A.ws + WS_DQK; const unsigned char* gKT = A.ws + WS_DKT;
    const float* DGL = (const float*)(A.ws + WS_DGL);
    f32x4 S[8];
#pragma unroll
    for (int mt = 0; mt < 8; ++mt) S[mt] = (f32x4){0.f, 0.f, 0.f, 0.f};
    u32x4 r[9], rg[2];
    float gl_all = 0.f;
#define DS_LOAD(itn, toff) do { const size_t _i = (size_t)(itn); const unsigned char* _kc = gKC + _i * 16384; const unsigned char* _qd = gQD + _i * 16384; \
        const unsigned char* _qk = gQK + _i * 8192; const unsigned char* _kt = gKT + _i * 16384; \
        r[0] = *(const u32x4*)(_kc + (toff)); r[1] = *(const u32x4*)(_kc + (toff) + 8192u); \
        r[2] = *(const u32x4*)(_qd + (toff)); r[3] = *(const u32x4*)(_qd + (toff) + 8192u); \
        r[4] = *(const u32x4*)(_qk + (toff)); \
        r[5] = *(const u32x4*)(_kt + (toff)); r[6] = *(const u32x4*)(_kt + (toff) + 8192u); \
        const unsigned char* _w = gW + _i * 16384; r[7] = *(const u32x4*)(_w + (toff)); r[8] = *(const u32x4*)(_w + (toff) + 8192u); } while (0)
#define DS_LOADG(itn, toff) do { const unsigned char* _g = gGS + (size_t)(itn) * 16384; rg[0] = *(const u32x4*)(_g + (toff)); rg[1] = *(const u32x4*)(_g + (toff) + 8192u); } while (0)
#define DS_STAGE(tidv) do { const int i0 = (tidv), i1 = (tidv) + 512; \
          *(LAS u32x4*)(KCs + (i0 >> 4) * 272 + (i0 & 15) * 16) = r[0]; *(LAS u32x4*)(KCs + (i1 >> 4) * 272 + (i1 & 15) * 16) = r[1]; \
          *(LAS u32x4*)(QDs + (i0 >> 4) * 272 + (i0 & 15) * 16) = r[2]; *(LAS u32x4*)(QDs + (i1 >> 4) * 272 + (i1 & 15) * 16) = r[3]; \
          *(LAS u32x4*)(QKs + (i0 >> 3) * 144 + (i0 & 7) * 16) = r[4]; \
          *(LAS u32x4*)(KDTs + (i0 >> 3) * 144 + (i0 & 7) * 16) = r[5]; *(LAS u32x4*)(KDTs + (i1 >> 3) * 144 + (i1 & 7) * 16) = r[6]; \
          *(LAS u32x4*)(Ws + (i0 >> 3) * 144 + (i0 & 7) * 16) = r[7]; *(LAS u32x4*)(Ws + (i1 >> 3) * 144 + (i1 & 7) * 16) = r[8]; } while (0)
#define DS_STAGEG(tidv) do { const int i0 = (tidv), i1 = (tidv) + 512; \
          *(LAS u32x4*)(GSs + (i0 >> 4) * 272 + (i0 & 15) * 16) = rg[0]; *(LAS u32x4*)(GSs + (i1 >> 4) * 272 + (i1 & 15) * 16) = rg[1]; } while (0)
#pragma unroll 1
    for (int n = 0; n < 32; ++n) {
        int tid = tid_in; asm volatile("" : "+v"(tid));
        const bool bstart = (SUB > 0) ? (n % SUB == 0) : (n == 0);
        const bool bnext1 = (SUB > 0) && ((n + 1) % SUB == 0), bnext2 = (SUB > 0) && ((n + 2) % SUB == 0);
        if (bstart) { if (n > 0) xcd_barrier(xb);
            gl_all = DGL[bh * 32 + (tid & 31)];
            const unsigned t0 = (unsigned)tid * 16u; DS_LOAD(bh * 32 + n, t0); DS_LOADG(bh * 32 + n, t0); DS_STAGE(tid); DS_STAGEG(tid);
            if (n + 1 < 32 && !bnext1) { DS_LOAD(bh * 32 + n + 1, t0); DS_LOADG(bh * 32 + n + 1, t0); }
            __syncthreads(); }
        else { DS_STAGEG(tid);
            if (n + 1 < 32 && !bnext1) DS_LOADG(bh * 32 + n + 1, (unsigned)tid * 16u); }
        const int lane = tid & 63, fr = lane & 15, quad = lane >> 4, vcol = 16 * wave + fr;
        const unsigned toff = (unsigned)tid * 16u;
        const int it = bh * 32 + n, tokb = b * SEQ + n * 64;
        const float glast = __builtin_bit_cast(float, __builtin_amdgcn_readlane(__builtin_bit_cast(int, gl_all), n));
        asm volatile("s_nop 7\n\ts_nop 7" ::: "memory");
#pragma unroll
        for (int mt = 0; mt < 8; ++mt) { u32x2 p; p.x = pg8::cvt_pk_bf16(S[mt][0], S[mt][1]); p.y = pg8::cvt_pk_bf16(S[mt][2], S[mt][3]); *(LAS u32x2*)(SS + fr * 272 + (mt * 16 + quad * 4) * 2) = p; }
        LDS_FENCE();
        bf16x8 Sb[4];
#pragma unroll
        for (int kk = 0; kk < 4; ++kk) Sb[kk] = *(LAS bf16x8*)(SS + fr * 272 + (kk * 32 + quad * 8) * 2);
        f32x4 U[4], O[4];
#pragma unroll
        for (int mt = 0; mt < 4; ++mt) { f32x4 au, ao = {0.f, 0.f, 0.f, 0.f};
            { const u32x2 wq = *(LAS u32x2*)(Ws + vcol * 144 + (mt * 16 + quad * 4) * 2);
              au[0] = __uint_as_float(wq.x << 16); au[1] = __uint_as_float(wq.x & 0xffff0000u); au[2] = __uint_as_float(wq.y << 16); au[3] = __uint_as_float(wq.y & 0xffff0000u); }
#pragma unroll
            for (int kk = 0; kk < 4; ++kk) { const bf16x8 a1 = *(LAS bf16x8*)(KCs + (mt * 16 + fr) * 272 + (kk * 32 + quad * 8) * 2); au = mfma16(a1, Sb[kk], au);
                const bf16x8 a2 = *(LAS bf16x8*)(QDs + (mt * 16 + fr) * 272 + (kk * 32 + quad * 8) * 2); ao = mfma16(a2, Sb[kk], ao); }
            U[mt] = au; O[mt] = ao; __builtin_amdgcn_sched_barrier(0); }
        asm volatile("s_nop 7\n\ts_nop 7" ::: "memory");
#pragma unroll
        for (int mt = 0; mt < 4; ++mt) { u32x2 p; p.x = pg8::cvt_pk_bf16(U[mt][0], U[mt][1]); p.y = pg8::cvt_pk_bf16(U[mt][2], U[mt][3]); *(LAS u32x2*)(US + fr * 144 + (mt * 16 + quad * 4) * 2) = p; }
        LDS_FENCE();
        bf16x8 Ub[2];
#pragma unroll
        for (int kk = 0; kk < 2; ++kk) Ub[kk] = *(LAS bf16x8*)(US + fr * 144 + (kk * 32 + quad * 8) * 2);
#pragma unroll
        for (int mt = 0; mt < 4; ++mt)
#pragma unroll
            for (int kk = 0; kk < 2; ++kk) { const bf16x8 a = *(LAS bf16x8*)(QKs + (mt * 16 + fr) * 144 + (kk * 32 + quad * 8) * 2); O[mt] = mfma16(a, Ub[kk], O[mt]); }
        __builtin_amdgcn_sched_barrier(0);
#pragma unroll
        for (int mt = 0; mt < 8; ++mt) { S[mt] *= glast;
#pragma unroll
            for (int kk = 0; kk < 2; ++kk) { const bf16x8 a = *(LAS bf16x8*)(KDTs + (mt * 16 + fr) * 144 + (kk * 32 + quad * 8) * 2); S[mt] = mfma16(a, Ub[kk], S[mt]); }
            if (mt & 1) __builtin_amdgcn_sched_barrier(0); }
        { float pp[16];
#pragma unroll
          for (int e = 0; e < 16; ++e) pp[e] = O[e >> 2][e & 3] * O[e >> 2][e & 3];
#pragma unroll
          for (int e = 0; e < 16; ++e) pp[e] = row_sum16(pp[e]);
          if (fr == 0) {
#pragma unroll
              for (int e = 0; e < 16; ++e) PART[((e >> 2) * 16 + quad * 4 + (e & 3)) * 8 + wave] = pp[e]; } }
        __syncthreads();
        if (n + 1 < 32 && !bnext1) { DS_STAGE(tid); if (n + 2 < 32 && !bnext2) DS_LOAD(it + 2, toff); }
        bf16_t* mixb = (bf16_t*)(A.ws + WS_MIX) + (size_t)tokb * D + h * 128;
#pragma unroll
        for (int mt = 0; mt < 4; ++mt)
#pragma unroll
            for (int i = 0; i < 4; ++i) { const int t = mt * 16 + quad * 4 + i;
                const f32x4 p0 = *(LAS f32x4*)(PART + t * 8), p1 = *(LAS f32x4*)(PART + t * 8 + 4);
                const float tot = ((p0[0] + p0[1]) + (p0[2] + p0[3])) + ((p1[0] + p1[1]) + (p1[2] + p1[3]));
                const float sc = rsqrtf(tot * (1.f / 128.f) + EPS);
                const float gs = bf2f(*(LAS bf16_t*)(GSs + t * 272 + vcol * 2));
                mixb[(unsigned)(t * D + vcol)] = (bf16_t)(pg8::cvt_pk_bf16(O[mt][i] * sc * gs, 0.f) & 0xffffu); }
        __syncthreads();
    }
#undef DS_STAGE
#undef DS_LOADG
#undef DS_STAGEG
#undef DS_LOAD
    { const int lane = lane_in, fr = lane & 15, quad = lane >> 4, vcol = 16 * wave + fr;
      float* dp = A.out + O_DP + (size_t)((l * 8 + b) * 4 + h) * 16384;
#pragma unroll
      for (int mt = 0; mt < 8; ++mt)
#pragma unroll
          for (int i = 0; i < 4; ++i) dp[(mt * 16 + quad * 4 + i) * 128 + vcol] = S[mt][i]; }
    __syncthreads();
}

__device__ __forceinline__ void delta_sample_item(const DevArgs& A, int l, LAS unsigned char* lds, int item, int tid, int wave, int lane) {
    asm volatile("" : "+v"(tid)); lane = tid & 63; wave = __builtin_amdgcn_readfirstlane(tid >> 6);
    const int b = item >> 2, h = item & 3, tokS = NP + b * 4;
    LAS float* RAW = (LAS float*)lds; LAS float* RED = RAW + 1536; LAS float* OB = RED + 512; LAS float* SC = OB + 512;
    const bf16_t* PROJ = (const bf16_t*)(A.ws + WS_PROJ); const float* AB = (const float*)(A.ws + WS_AB); bf16_t* MIX = (bf16_t*)(A.ws + WS_MIX);
    const float* cw = A.in[I_CONVW] + (size_t)l * 4 * 1536;
    for (int idx = tid; idx < 1536; idx += 512) { const int part = idx >> 9, t = (idx >> 7) & 3, c = idx & 127, col = part * 512 + h * 128 + c;
        float acc = 0.f;
#pragma unroll
        for (int j = 0; j < 4; ++j) { const int tt = t - 3 + j;
            const float x = (tt >= 0) ? bf2f(PROJ[(size_t)(tokS + tt) * NPROJ + col]) : A.in[I_SCONV][((size_t)(l * 128 + b) * 3 + (3 + tt)) * 1536 + col];
            acc += cw[j * 1536 + col] * x; }
        RAW[idx] = silu_f(acc); }
    if (tid < 4) { const float a = AB[(size_t)(tokS + tid) * 8 + h], bb = AB[(size_t)(tokS + tid) * 8 + 4 + h];
        const float xx = a + A.in[I_DTB][l * 4 + h]; const float sp = xx > 20.f ? xx : log1pf(expf(xx));
        SC[8 + tid] = 1.f / (1.f + expf(-bb)); SC[12 + tid] = expf(-expf(A.in[I_ALOG][l * 4 + h]) * sp); }
    const int v = tid & 127, kq = tid >> 7;
    float S[32];
    { const float* sp = A.in[I_SDELTA] + (size_t)((l * 128 + b) * 4 + h) * 16384;
#pragma unroll
      for (int i = 0; i < 32; ++i) S[i] = sp[(kq * 32 + i) * 128 + v]; }
    __syncthreads();
    { const int part = wave >> 2, t = wave & 3; const float x0 = RAW[part * 512 + t * 128 + lane], x1 = RAW[part * 512 + t * 128 + 64 + lane];
      const float ss = wave_sum(x0 * x0 + x1 * x1); if (lane == 0) SC[part * 4 + t] = rsqrtf(ss + EPS) * (part == 0 ? 0.08838834764831845f : 1.f); }
    __syncthreads();
    for (int t = 0; t < 4; ++t) {
        const float rq = SC[t], rk = SC[4 + t], beta = SC[8 + t], g = SC[12 + t];
        float pr = 0.f;
#pragma unroll
        for (int i = 0; i < 32; ++i) pr += S[i] * RAW[512 + t * 128 + kq * 32 + i];
        RED[kq * 128 + v] = pr * rk;
        __syncthreads();
        const float rr = (RED[v] + RED[128 + v]) + (RED[256 + v] + RED[384 + v]);
        const float u = beta * (RAW[1024 + t * 128 + v] - g * rr);
        float po = 0.f;
#pragma unroll
        for (int i = 0; i < 32; ++i) { const float kh = RAW[512 + t * 128 + kq * 32 + i] * rk; S[i] = g * S[i] + kh * u; po += S[i] * RAW[t * 128 + kq * 32 + i]; }
        __syncthreads();
        RED[kq * 128 + v] = po * rq;
        __syncthreads();
        if (kq == 0) OB[t * 128 + v] = (RED[v] + RED[128 + v]) + (RED[256 + v] + RED[384 + v]);
        __syncthreads();
    }
    if (wave < 4) { const int t = wave; const float x0 = OB[t * 128 + lane], x1 = OB[t * 128 + 64 + lane];
        const float ss = wave_sum(x0 * x0 + x1 * x1); const float sc = rsqrtf(ss * (1.f / 128.f) + EPS);
        const float g0 = bf2f(PROJ[(size_t)(tokS + t) * NPROJ + PC_G + h * 128 + lane]), g1 = bf2f(PROJ[(size_t)(tokS + t) * NPROJ + PC_G + h * 128 + 64 + lane]);
        MIX[(size_t)(tokS + t) * D + h * 128 + lane] = (bf16_t)f2bf(x0 * sc * A.in[I_ONORM][l * 128 + lane] * silu_f(g0));
        MIX[(size_t)(tokS + t) * D + h * 128 + 64 + lane] = (bf16_t)f2bf(x1 * sc * A.in[I_ONORM][l * 128 + 64 + lane] * silu_f(g1)); }
    { float* dsp = A.out + O_DS + (size_t)((l * 128 + b) * 4 + h) * 16384;
#pragma unroll
      for (int i = 0; i < 32; ++i) dsp[(kq * 32 + i) * 128 + v] = S[i]; }
    __syncthreads();
}

#define SSM_BCAST_U(t) do { unsigned _w[8]; \
        _w[0] = __builtin_amdgcn_readlane(ua.x, t); _w[1] = __builtin_amdgcn_readlane(ua.y, t); _w[2] = __builtin_amdgcn_readlane(ua.z, t); _w[3] = __builtin_amdgcn_readlane(ua.w, t); \
        _w[4] = __builtin_amdgcn_readlane(ub.x, t); _w[5] = __builtin_amdgcn_readlane(ub.y, t); _w[6] = __builtin_amdgcn_readlane(ub.z, t); _w[7] = __builtin_amdgcn_readlane(ub.w, t); \
        _Pragma("unroll") for (int _d = 0; _d < 8; ++_d) { uu[2 * _d] = __uint_as_float(_w[_d] << 16); uu[2 * _d + 1] = __uint_as_float(_w[_d] & 0xffff0000u); } } while (0)
#define SSM_STEP() do { float _br = 0.f, _bi = 0.f; \
        _Pragma("unroll") for (int _h = 0; _h < 16; ++_h) { _br = fmaf(Br[_h], uu[_h], _br); _bi = fmaf(Bi[_h], uu[_h], _bi); } \
        const float _nr = lr * hr - li * hi + _br, _ni = lr * hi + li * hr + _bi; hr = _nr; hi = _ni; } while (0)

__device__ __forceinline__ void ssm_part1_item(const DevArgs& A, int l, int it, int lane) {
    const int g = it & 15, bc = it >> 4, b = bc / 31, c = bc % 31;
    const float* bb = (const float*)(A.ws + WS_BBAR) + ((size_t)(l * 16 + g) * 64 + lane) * 32;
    float Br[16], Bi[16];
#pragma unroll
    for (int q = 0; q < 4; ++q) { const f32x4 x = ((const f32x4*)bb)[q], y = ((const f32x4*)bb)[4 + q];
        Br[4 * q] = x.x; Br[4 * q + 1] = x.y; Br[4 * q + 2] = x.z; Br[4 * q + 3] = x.w; Bi[4 * q] = y.x; Bi[4 * q + 1] = y.y; Bi[4 * q + 2] = y.z; Bi[4 * q + 3] = y.w; }
    const f32x4 lk = ((const f32x4*)(A.ws + WS_SSMK))[(l * 16 + g) * 64 + lane]; const float lr = lk.x, li = lk.y;
    const bf16_t* up = (const bf16_t*)(A.ws + WS_PROJ) + (size_t)(b * SEQ + c * 64 + lane) * NPROJ + PC_SSM + g * 16;
    const u32x4 ua = *(const u32x4*)up, ub = *(const u32x4*)(up + 8);
    float hr = 0.f, hi = 0.f, uu[16];
#pragma unroll 1
    for (int t = 0; t < 64; ++t) { SSM_BCAST_U(t); SSM_STEP(); }
    f32x2 e; e.x = hr; e.y = hi;
    ((f32x2*)(A.ws + WS_SSME))[((size_t)(b * 32 + c) * 16 + g) * 64 + lane] = e;
}

__device__ __forceinline__ void ssm_part2_item(const DevArgs& A, int l, LAS unsigned char* lds, int it, int tid, int wave, int lane) {
    asm volatile("" : "+v"(tid)); lane = tid & 63; wave = __builtin_amdgcn_readfirstlane(tid >> 6);
    const int tok0 = it * 64, fr = lane & 15, quad = lane >> 4;
    const bool samp = it >= 256; const int b = it >> 5, c = it & 31;
    LAS unsigned char* YS = lds; LAS unsigned char* HS = lds + 33792 + wave * 4352;
    const bf16_t* PROJ = (const bf16_t*)(A.ws + WS_PROJ); bf16_t* MIX = (bf16_t*)(A.ws + WS_MIX);
#pragma unroll 1
    for (int gi = 0; gi < 2; ++gi) {
        const int g = wave * 2 + gi;
        const float* bb = (const float*)(A.ws + WS_BBAR) + ((size_t)(l * 16 + g) * 64 + lane) * 32;
        float Br[16], Bi[16];
#pragma unroll
        for (int q = 0; q < 4; ++q) { const f32x4 x = ((const f32x4*)bb)[q], y = ((const f32x4*)bb)[4 + q];
            Br[4 * q] = x.x; Br[4 * q + 1] = x.y; Br[4 * q + 2] = x.z; Br[4 * q + 3] = x.w; Bi[4 * q] = y.x; Bi[4 * q + 1] = y.y; Bi[4 * q + 2] = y.z; Bi[4 * q + 3] = y.w; }
        const f32x4 lk = ((const f32x4*)(A.ws + WS_SSMK))[(l * 16 + g) * 64 + lane]; const float lr = lk.x, li = lk.y, Lr = lk.z, Li = lk.w;
        bf16x8 Cb[4];
#pragma unroll
        for (int kk = 0; kk < 4; ++kk) { const size_t co = ((size_t)(l * 16 + g) * 16 + fr) * 64 + kk * 16 + quad * 4;
            const f32x4 cr = *(const f32x4*)(A.in[I_CRE] + co), ci = *(const f32x4*)(A.in[I_CIM] + co);
            u32x4 pk; pk.x = pk2(cr.x, -ci.x); pk.y = pk2(cr.y, -ci.y); pk.z = pk2(cr.z, -ci.z); pk.w = pk2(cr.w, -ci.w);
            Cb[kk] = __builtin_bit_cast(bf16x8, pk); }
        const bf16_t* up = PROJ + (size_t)(tok0 + lane) * NPROJ + PC_SSM + g * 16;
        const u32x4 ua = *(const u32x4*)up, ub = *(const u32x4*)(up + 8);
        float hr = 0.f, hi = 0.f, uu[16];
        if (!samp && c > 0) { const f32x2* E = (const f32x2*)(A.ws + WS_SSME) + ((size_t)(b * 32) * 16 + g) * 64 + lane;
#pragma unroll
            for (int cb = 0; cb < 32; cb += 16) { f32x2 ev[16];
#pragma unroll
                for (int q = 0; q < 16; ++q) { const int cc = cb + q; ev[q] = (cc < c) ? E[(size_t)cc * 1024] : (f32x2){0.f, 0.f}; }
#pragma unroll
                for (int q = 0; q < 16; ++q) { const int cc = cb + q; if (cc < c) { const float nr = Lr * hr - Li * hi + ev[q].x, ni = Lr * hi + Li * hr + ev[q].y; hr = nr; hi = ni; } } } }
        const float dsk = A.in[I_SSMD][l * 256 + g * 16 + fr];
        unsigned uvr[16];
#pragma unroll
        for (int e = 0; e < 16; ++e) uvr[e] = PROJ[(size_t)(tok0 + (e >> 2) * 16 + quad * 4 + (e & 3)) * NPROJ + PC_SSM + g * 16 + fr];
#pragma unroll
        for (int sub = 0; sub < 4; ++sub) {
#pragma unroll 1
            for (int tt = 0; tt < 16; ++tt) { const int t = sub * 16 + tt;
                const int sb = (it - 256) * 16 + (t >> 2);
                if (samp && (t & 3) == 0) { hr = A.in[I_SRE][((size_t)(l * 128 + sb) * 16 + g) * 64 + lane]; hi = A.in[I_SIM][((size_t)(l * 128 + sb) * 16 + g) * 64 + lane]; }
                SSM_BCAST_U(t); SSM_STEP();
                *(LAS unsigned*)(HS + tt * 272 + lane * 4) = pg8::cvt_pk_bf16(hr, hi);
                if (samp && (t & 3) == 3) { A.out[O_RES + ((size_t)(l * 128 + sb) * 16 + g) * 64 + lane] = hr; A.out[O_IMS + ((size_t)(l * 128 + sb) * 16 + g) * 64 + lane] = hi; }
            }
            LDS_FENCE();
            f32x4 acc = {0.f, 0.f, 0.f, 0.f};
#pragma unroll
            for (int kk = 0; kk < 4; ++kk) { const bf16x8 a = *(LAS bf16x8*)(HS + fr * 272 + (kk * 32 + quad * 8) * 2); acc = mfma16(a, Cb[kk], acc); }
#pragma unroll
            for (int i = 0; i < 4; ++i) { const int t = sub * 16 + quad * 4 + i; const float uv = bf2f(uvr[sub * 4 + i]);
                *(LAS bf16_t*)(YS + t * 528 + (g * 16 + fr) * 2) = (bf16_t)f2bf(gelu_tanh_f(acc[i] + dsk * uv)); }
            LDS_FENCE();
        }
        if (!samp && c == 31) { A.out[O_REP + ((size_t)(l * 8 + b) * 16 + g) * 64 + lane] = hr; A.out[O_IMP + ((size_t)(l * 8 + b) * 16 + g) * 64 + lane] = hi; }
    }
    __syncthreads();
    {
        const bf16_t* GT = (const bf16_t*)(A.ws + WS_GLUT + l * SZ_GLUT);
        f32x4 acc[4][2];
#pragma unroll
        for (int mt = 0; mt < 4; ++mt) { acc[mt][0] = (f32x4){0.f, 0.f, 0.f, 0.f}; acc[mt][1] = (f32x4){0.f, 0.f, 0.f, 0.f}; }
#pragma unroll
        for (int kk = 0; kk < 8; ++kk) { bf16x8 bfr[2];
#pragma unroll
            for (int nt = 0; nt < 2; ++nt) bfr[nt] = *(const bf16x8*)(GT + (size_t)(32 * wave + nt * 16 + fr) * 256 + kk * 32 + quad * 8);
#pragma unroll
            for (int mt = 0; mt < 4; ++mt) { const bf16x8 a = *(LAS bf16x8*)(YS + (mt * 16 + fr) * 528 + (kk * 32 + quad * 8) * 2);
                acc[mt][0] = mfma16(a, bfr[0], acc[mt][0]); acc[mt][1] = mfma16(a, bfr[1], acc[mt][1]); } }
#pragma unroll
        for (int nt = 0; nt < 2; ++nt) { const int ncol = 32 * wave + nt * 16 + fr; const float gb = A.in[I_GLUB][l * 256 + ncol];
#pragma unroll
            for (int mt = 0; mt < 4; ++mt)
#pragma unroll
                for (int i = 0; i < 4; ++i) { const int t = mt * 16 + quad * 4 + i; const float y = bf2f(*(LAS bf16_t*)(YS + t * 528 + ncol * 2));
                    MIX[(size_t)(tok0 + t) * D + 512 + ncol] = (bf16_t)f2bf(y * sigmoid_f(acc[mt][nt][i] + gb)); } }
    }
    __syncthreads();
}

__device__ __forceinline__ void pool_item(const DevArgs& A, int l, LAS unsigned char* lds, int it, int tid, int wave, int lane) {
    asm volatile("" : "+v"(tid)); lane = tid & 63; wave = __builtin_amdgcn_readfirstlane(tid >> 6);
    const int tok0 = it * 64, fr = lane & 15, quad = lane >> 4; const bool samp = it >= 256;
    LAS unsigned char* RS = lds;
    const bf16_t* PROJ = (const bf16_t*)(A.ws + WS_PROJ); bf16_t* MIX = (bf16_t*)(A.ws + WS_MIX);
    if (!samp) {
        LAS unsigned char* XT = lds + 33792;
        const int b = it >> 5, c = it & 31;
        for (int id = tid; id < 79 * 32; id += 512) { const int r = id >> 5, c16 = id & 31, tl = c * 64 - 15 + r;
            u32x4 v = {0u, 0u, 0u, 0u}; if (tl >= 0) v = *(const u32x4*)(PROJ + (size_t)(b * SEQ + tl) * NPROJ + PC_POOL + c16 * 8);
            *(LAS u32x4*)(XT + r * 528 + c16 * 16) = v; }
        __syncthreads();
        const int ch = tid & 255, half = tid >> 8, g = ch >> 6, w = 2 << g, r0 = half * 32;
        float sum = 0.f;
        for (int j = 0; j < w; ++j) sum += bf2f(*(LAS bf16_t*)(XT + (r0 + 15 - j) * 528 + ch * 2));
#pragma unroll 4
        for (int rr = 0; rr < 32; ++rr) { const int r = r0 + rr, tl = c * 64 + r;
            const float u = bf2f(*(LAS bf16_t*)(XT + (r + 15) * 528 + ch * 2));
            if (rr > 0) sum += u - bf2f(*(LAS bf16_t*)(XT + (r + 15 - w) * 528 + ch * 2));
            const float rc = __builtin_amdgcn_rcpf((float)((tl + 1 < w) ? tl + 1 : w));
            *(LAS bf16_t*)(RS + r * 528 + ch * 2) = (bf16_t)f2bf(sum * rc - u); }
    } else {
#pragma unroll 1
        for (int pr = 0; pr < 8; ++pr) { const int idx = pr * 512 + tid, ch = idx & 255, sq = idx >> 8, g = ch >> 6, w = 2 << g;
            const int sb = (it - 256) * 16 + sq;
            const float* sbuf = A.in[I_SPOOL] + (size_t)(l * 128 + sb) * 15 * 256 + ch;
            const bf16_t* base = PROJ + (size_t)(NP + sb * 4) * NPROJ + PC_POOL + ch;
            float e[19];
#pragma unroll
            for (int j = 0; j < 15; ++j) e[j] = sbuf[j * 256];
#pragma unroll
            for (int j = 0; j < 4; ++j) e[15 + j] = bf2f(base[(size_t)j * NPROJ]);
#pragma unroll
            for (int t = 0; t < 4; ++t) { float sum = 0.f;
#pragma unroll
                for (int j = 0; j < 16; ++j) sum += (j < w) ? e[15 + t - j] : 0.f;
                *(LAS bf16_t*)(RS + (sq * 4 + t) * 528 + ch * 2) = (bf16_t)f2bf(sum * __builtin_amdgcn_rcpf((float)w) - e[15 + t]); } }
    }
    __syncthreads();
    { const int g2 = wave >> 1; const bf16_t* PT = (const bf16_t*)(A.ws + WS_POOLT + l * SZ_POOLT) + g2 * 4096;
      f32x4 acc[4][2];
#pragma unroll
      for (int mt = 0; mt < 4; ++mt) { acc[mt][0] = (f32x4){0.f, 0.f, 0.f, 0.f}; acc[mt][1] = (f32x4){0.f, 0.f, 0.f, 0.f}; }
#pragma unroll
      for (int kk = 0; kk < 2; ++kk) { bf16x8 bfr[2];
#pragma unroll
          for (int nt = 0; nt < 2; ++nt) bfr[nt] = *(const bf16x8*)(PT + (size_t)((wave & 1) * 32 + nt * 16 + fr) * 64 + kk * 32 + quad * 8);
#pragma unroll
          for (int mt = 0; mt < 4; ++mt) { const bf16x8 a = *(LAS bf16x8*)(RS + (mt * 16 + fr) * 528 + (g2 * 64 + kk * 32 + quad * 8) * 2);
              acc[mt][0] = mfma16(a, bfr[0], acc[mt][0]); acc[mt][1] = mfma16(a, bfr[1], acc[mt][1]); } }
#pragma unroll
      for (int nt = 0; nt < 2; ++nt) { const int col = 32 * wave + nt * 16 + fr; const float ps = A.in[I_POOLS][l * 256 + col];
#pragma unroll
          for (int mt = 0; mt < 4; ++mt)
#pragma unroll
              for (int i = 0; i < 4; ++i) { const int t = mt * 16 + quad * 4 + i; MIX[(size_t)(tok0 + t) * D + 768 + col] = (bf16_t)f2bf(acc[mt][nt][i] * ps); } } }
    __syncthreads();
}

__device__ __forceinline__ void state_copies(const DevArgs& A, int l, int gt, int NT) {
    const bf16_t* PROJ = (const bf16_t*)(A.ws + WS_PROJ);
#pragma unroll 1
    for (int i = gt; i < 8 * 3 * 1536; i += NT) { const int col = i % 1536, j = (i / 1536) % 3, b = i / 4608;
        A.out[O_CP + (size_t)l * 8 * 4608 + i] = bf2f(PROJ[(size_t)(b * SEQ + SEQ - 3 + j) * NPROJ + col]); }
#pragma unroll 1
    for (int i = gt; i < 128 * 3 * 1536; i += NT) { const int col = i % 1536, j = (i / 1536) % 3, b = i / 4608;
        A.out[O_CS + (size_t)l * 128 * 4608 + i] = bf2f(PROJ[(size_t)(NP + b * 4 + 1 + j) * NPROJ + col]); }
#pragma unroll 1
    for (int i = gt; i < 8 * 15 * 256; i += NT) { const int ch = i & 255, j = (i >> 8) % 15, b = i / 3840;
        A.out[O_PP + (size_t)l * 8 * 3840 + i] = bf2f(PROJ[(size_t)(b * SEQ + SEQ - 15 + j) * NPROJ + PC_POOL + ch]); }
#pragma unroll 1
    for (int i = gt; i < 128 * 15 * 256; i += NT) { const int ch = i & 255, j = (i >> 8) % 15, b = i / 3840;
        A.out[O_PS + (size_t)l * 128 * 3840 + i] = (j < 11) ? A.in[I_SPOOL][((size_t)(l * 128 + b) * 15 + 4 + j) * 256 + ch]
                                                             : bf2f(PROJ[(size_t)(NP + b * 4 + (j - 11)) * NPROJ + PC_POOL + ch]); }
}

#ifndef REP_DPREP
#define REP_DPREP 1
#endif
#ifndef REP_DSAMP
#define REP_DSAMP 1
#endif
#ifndef REP_SSM1
#define REP_SSM1 1
#endif
#ifndef REP_POOL
#define REP_POOL 1
#endif
#ifndef REP_DSCAN
#define REP_DSCAN 1
#endif
#ifndef REP_SSM2
#define REP_SSM2 1
#endif
#ifndef REP_G
#define REP_G 1
#endif
#ifndef REP_P3
#define REP_P3 1
#endif
#ifndef REP_P2
#define REP_P2 1
#endif
constexpr int NPH = 2 + DEPTH * 8;
__global__ void __launch_bounds__(512, 2) mega_fwd(Args KA) {
    DevArgs A; A.out = KA.out; A.ws = KA.ws; A.ph_lo = KA.ph_lo; A.ph_hi = KA.ph_hi;
    extern __shared__ __attribute__((aligned(16))) unsigned char lds_raw[];
    LAS unsigned char* lds = (LAS unsigned char*)lds_raw;
    cg::grid_group grid = cg::this_grid();
    volatile LAS unsigned* xst = (volatile LAS unsigned*)(lds + LDS_BYTES - 64);
    if (threadIdx.x == 0) { xst[0] = 0u; xst[1] = 0u; }
    __syncthreads();
    const XcdBarrier xb = xcd_barrier_post((unsigned*)(KA.ws + WS_BAR), xst);
    constexpr int G = 256, NGW = G * 8, NT = G * 512;
    int ph = 0;
#define PH_BEGIN if (A.ph_lo <= ph && ph < A.ph_hi) { int tid = threadIdx.x; asm volatile("" : "+v"(tid)); { unsigned char* _w = A.ws; asm volatile("" : "+s"(_w)); A.ws = _w; float* _o = A.out; asm volatile("" : "+s"(_o)); A.out = _o; } const int wave = __builtin_amdgcn_readfirstlane(tid >> 6), lane = tid & 63, gw = blockIdx.x * 8 + wave, gt = blockIdx.x * 512 + tid; (void)gw; (void)gt; (void)lane;
#define PH_END   if (ph + 1 < A.ph_hi) { if (ph == 0) grid.sync(); else xcd_barrier(xb); } } ++ph;
#define Hb   ((bf16_t*)(A.ws + WS_H))
#define AB   ((float*)(A.ws + WS_AB))
#define MIXO ((float*)(A.ws + WS_MIXO))
#define PROJ ((bf16_t*)(A.ws + WS_PROJ))
#define MIX  ((bf16_t*)(A.ws + WS_MIX))
#define HID  ((bf16_t*)(A.ws + WS_HID))
#define XBUF ((bf16_t*)(A.ws + WS_MIXO + (size_t)NTOK * D * 2))

#ifndef REP_PRO
#define REP_PRO 1
#endif
#ifndef REP_N0
#define REP_N0 1
#endif
    PH_BEGIN for (int rep = 0; rep < REP_PRO; ++rep) { prologue(A, lds, wave, lane, gw, NGW); __syncthreads(); } PH_END
    PH_BEGIN for (int rep = 0; rep < REP_N0; ++rep) norm_rows(nullptr, nullptr, A.in[I_XP], A.in[I_XS], nullptr, A.in[I_NMPRE], Hb, (const float*)(A.ws + WS_WAB), AB, gw, NGW, lane, nullptr, 0, nullptr, XBUF); PH_END

#pragma unroll 1
    for (int l = 0; l < DEPTH; ++l) {
        PH_BEGIN for (int rep = 0; rep < REP_G; ++rep) { pg8::Gemm g{Hb, (const bf16_t*)(A.ws + WS_WIN + l * SZ_WIN), NTOK, NPROJ, D, D, D}; pg8::StaticOrder S; S.init(NTOK, NPROJ, G, (int)blockIdx.x);
            pg8::EpiBf16<0> E{PROJ, NPROJ, nullptr, 0, 0}; pg8::gemm_phase<pg8::EpiBf16<0>, pg8::StaticOrder>(lds, g, S, E, nullptr); } PH_END
        constexpr int SUBC = 7;
        PH_BEGIN {
#pragma unroll 1
          for (int rep2 = 0; rep2 < REP_P2; ++rep2) {
#pragma unroll 1
            for (int j = blockIdx.x; j < 32 * SUBC; j += G) delta_prep_item(A, l, lds, (j & 31) * 32 + (j >> 5), tid, wave, lane);
          }
        } PH_END
        PH_BEGIN {
#pragma unroll 1
            for (int rep3 = 0; rep3 < REP_P3; ++rep3) {
                if (blockIdx.x < 32) delta_scan_item(A, l, lds, blockIdx.x, tid, wave, lane, xb, SUBC);
                else { const int w = blockIdx.x - 32; constexpr int NW = G - 32;
#pragma unroll 1
                    for (int k = 1; k <= 5; ++k) {
                        const int n0 = k * SUBC, nn = (n0 >= 32) ? 0 : ((32 - n0 < SUBC) ? 32 - n0 : SUBC);
                        int nprep = 32 * nn;
#ifndef REP_WPREP
#define REP_WPREP 1
#endif
#pragma unroll 1
                        for (int rep = 0; rep < REP_WPREP; ++rep)
#pragma unroll 1
                        for (int j = w; j < nprep; j += NW) delta_prep_item(A, l, lds, (j & 31) * 32 + n0 + (j >> 5), tid, wave, lane);
                        if (k == 1) {
#pragma unroll 1
                            for (int it = w; it < 512; it += NW) delta_sample_item(A, l, lds, it, tid, wave, lane); }
                        if (k == 2) {
#pragma unroll 1
                            for (int it = w * 8 + wave; it < 8 * 31 * 16; it += NW * 8) { int t1 = threadIdx.x; asm volatile("" : "+v"(t1)); ssm_part1_item(A, l, it, t1 & 63); }
                            { int t2 = threadIdx.x; asm volatile("" : "+v"(t2)); int wl = blockIdx.x; asm volatile("" : "+s"(wl)); state_copies(A, l, (wl - 32) * 512 + t2, NW * 512); } }
                        if (k == 3) {
#pragma unroll 1
                            for (int it = w; it < 264; it += NW) pool_item(A, l, lds, it, tid, wave, lane); }
                        { const int it = (k == 4) ? w - 128 : ((k == 5) ? 96 + w : -1);
                          if (it >= 0 && it < ((k == 4) ? 96 : 264)) ssm_part2_item(A, l, lds, it, tid, wave, lane); }
                        if (k < 5) xcd_barrier(xb);
                    } }
            }
        } PH_END
        PH_BEGIN for (int rep = 0; rep < REP_G; ++rep) { pg8::Gemm g{MIX, (const bf16_t*)(A.ws + WS_WOUT + l * SZ_WOUT), NP, D, D, D, D}; pg8::StaticOrder S; S.init(NP, D, G, (int)blockIdx.x);
            pg8::EpiBf16<0> E{(bf16_t*)MIXO, D, nullptr, 0, 0}; pg8::gemm_phase<pg8::EpiBf16<0>, pg8::StaticOrder>(lds, g, S, E, nullptr);
            pg8::Gemm g2{MIX + (size_t)NP * D, (const bf16_t*)(A.ws + WS_WOUT + l * SZ_WOUT), NS, D, 256, D, D}; SliceOrder S2{8 * (D / 256), G, (int)blockIdx.x};
            EpiF32Part E2{(float*)(A.ws + WS_PARTS)}; pg8::gemm_phase<EpiF32Part, SliceOrder>(lds, g2, S2, E2, nullptr); } PH_END
#ifndef REP_N5
#define REP_N5 1
#endif
        PH_BEGIN norm_rows_pf(MIXO, A.in[I_NMPOST] + l * D, XBUF, A.in[I_NFPRE] + l * D, Hb, gw, NGW, lane, (const float*)(A.ws + WS_PARTS), D / 256); PH_END
        PH_BEGIN for (int rep = 0; rep < REP_G; ++rep) { pg8::Gemm g{Hb, (const bf16_t*)(A.ws + WS_WGU + l * SZ_WGU), NTOK, NGU, D, D, D}; pg8::StaticOrder S; S.init(NTOK, NGU, G, (int)blockIdx.x);
            EpiSwiGLU E{HID, DFF}; pg8::gemm_phase<EpiSwiGLU, pg8::StaticOrder>(lds, g, S, E, nullptr); } PH_END
        PH_BEGIN for (int rep = 0; rep < REP_G; ++rep) { pg8::Gemm g{HID, (const bf16_t*)(A.ws + WS_WDN + l * SZ_WDN), NP, D, DFF, DFF, DFF}; pg8::StaticOrder S; S.init(NP, D, G, (int)blockIdx.x);
            pg8::EpiBf16<0> E{(bf16_t*)MIXO, D, nullptr, 0, 0}; pg8::gemm_phase<pg8::EpiBf16<0>, pg8::StaticOrder>(lds, g, S, E, nullptr);
            pg8::Gemm g2{HID + (size_t)NP * DFF, (const bf16_t*)(A.ws + WS_WDN + l * SZ_WDN), NS, D, 256, DFF, DFF}; SliceOrder S2{8 * (DFF / 256), G, (int)blockIdx.x};
            EpiF32Part E2{(float*)(A.ws + WS_PARTS)}; pg8::gemm_phase<EpiF32Part, SliceOrder>(lds, g2, S2, E2, nullptr); } PH_END
        PH_BEGIN norm_rows(MIXO, A.in[I_NFPOST] + l * D, nullptr, nullptr, l + 1 < DEPTH ? nullptr : A.out, l + 1 < DEPTH ? A.in[I_NMPRE] + (l + 1) * D : nullptr, l + 1 < DEPTH ? Hb : nullptr,
                           l + 1 < DEPTH ? (const float*)(A.ws + WS_WAB + (l + 1) * SZ_WAB) : nullptr, AB, gw, NGW, lane, (const float*)(A.ws + WS_PARTS), DFF / 256,
                           XBUF, l + 1 < DEPTH ? XBUF : nullptr); PH_END
    }
#undef PH_BEGIN
#undef PH_END
#undef Hb
#undef AB
#undef MIXO
#undef PROJ
#undef MIX
#undef HID
#undef XBUF
}

extern "C" void kernel_launch(void* const* d_in, const int* in_sizes, int n_in, void* d_out, int out_size, void* d_ws, size_t ws_size, hipStream_t stream) {
    static int grid = 0;
    if (grid == 0) {
        if (n_in != 32 || (size_t)out_size != O_END || ws_size < WS_END) fprintf(stderr, "kernel_launch: unexpected sizes: n_in %d out %d (want %zu) ws %zu (want >= %zu)\n", n_in, out_size, (size_t)O_END, ws_size, (size_t)WS_END);
        int dev = 0, cus = 0, per_cu = 0;
        (void)hipGetDevice(&dev); (void)hipDeviceGetAttribute(&cus, hipDeviceAttributeMultiprocessorCount, dev);
        if (hipFuncSetAttribute((const void*)mega_fwd, hipFuncAttributeMaxDynamicSharedMemorySize, LDS_BYTES) != hipSuccess) fprintf(stderr, "kernel_launch: hipFuncSetAttribute failed\n");
        if (hipOccupancyMaxActiveBlocksPerMultiprocessor(&per_cu, (const void*)mega_fwd, 512, LDS_BYTES) != hipSuccess || per_cu < 1) { fprintf(stderr, "kernel_launch: occupancy query gave %d\n", per_cu); per_cu = 1; (void)hipGetLastError(); }
        grid = cus * per_cu; if (grid <= 0) grid = 256;
        if (grid >= 256) grid = 256;
        fprintf(stderr, "kernel_launch: grid %d (cus %d x %d)%s\n", grid, cus, per_cu, grid < 256 ? "  ERROR: this build needs >= 256 co-resident workgroups" : "");
    }
    (void)hipMemsetAsync((unsigned char*)d_ws + WS_BAR, 0, 16384, stream);
    Args a{};
    for (int i = 0; i < 32; ++i) a.in[i] = (const float*)d_in[i];
    a.out = (float*)d_out; a.ws = (unsigned char*)d_ws;
#if MK_COOP
    a.ph_lo = 0; a.ph_hi = NPH;
    void* args[] = {&a};
    const hipError_t e = hipLaunchCooperativeKernel((const void*)mega_fwd, dim3(grid), dim3(512), args, LDS_BYTES, stream);
    if (e != hipSuccess) fprintf(stderr, "kernel_launch: cooperative launch failed: %s (grid %d)\n", hipGetErrorString(e), grid);
#else
    for (int p = 0; p < NPH; ++p) { a.ph_lo = p; a.ph_hi = p + 1; hipLaunchKernelGGL(mega_fwd, dim3(grid), dim3(512), LDS_BYTES, stream, a); }
#endif
}
```

```cpp
#include <hip/hip_runtime.h>
#include <hip/hip_cooperative_groups.h>
#include <cstdio>
#include <cstdint>
namespace cg = cooperative_groups;
#ifndef MK_COOP
#define MK_COOP 1
#endif
namespace pg8 {
#define PG8_LAS __attribute__((address_space(3)))
typedef unsigned short bf16_t;
typedef short bf16x8 __attribute__((ext_vector_type(8)));
typedef float f32x4 __attribute__((ext_vector_type(4)));
typedef unsigned u32x4 __attribute__((ext_vector_type(4)));
constexpr int BM = 256, BK = 64, HALF = 128, HTB = HALF * BK * 2  , STAGE_BYTES = 8 * HTB, NXCD = 8, WGM = 8;

__host__ __device__ __forceinline__ int lds_byte(int r, int c) { const int st = (r >> 4) * 2 + (c >> 5), rr = r & 15, cc = c & 31, ob = rr * 64 + cc * 2; return st * 1024 + (ob ^ (((ob >> 9) & 1) << 5)); }
__host__ __device__ __forceinline__ void stage_rc(int b, int& R, int& C) { const int st = b / 1024, sb = b % 1024, swz = sb ^ (((sb >> 9) & 1) << 5); R = (st >> 1) * 16 + swz / 64; C = (st & 1) * 32 + (swz % 64) / 2; }
__host__ __device__ __forceinline__ int perm32(int rho) { const int n = rho >> 4, i = rho & 15; return 8 * (i >> 2) + 4 * n + (i & 3); }

struct Unit { int pm, pn, ks; };
struct Gemm { const bf16_t* A; const bf16_t* Bt; int M, N, K, lda, ldb; };

struct StaticOrder {
    int nM, nN, nwg, G, c;
    __host__ __device__ void init(int M, int N, int G_, int c_) { nM = M / BM; nN = N / BM; nwg = nM * nN; G = G_; c = c_; }
    __host__ __device__ bool next(int i, Unit& u) const {
        const long L = (long)i * G + c; if (L >= nwg) return false;
        int wgid = (int)L; { const int q = nwg / NXCD, r = nwg % NXCD, xcd = wgid % NXCD, off = wgid / NXCD; wgid = (xcd < r ? xcd * (q + 1) : r * (q + 1) + (xcd - r) * q) + off; }
        const int nig = WGM * nN, gid = wgid / nig, fm = gid * WGM, gsz = (nM - fm) < WGM ? (nM - fm) : WGM;
        u.pm = fm + ((wgid % nig) % gsz); u.pn = (wgid % nig) / gsz; u.ks = 0; return true;
    }
    __device__ __forceinline__ void a_ready(const Unit&) const {}
    __device__ __forceinline__ void done(const Unit&) const {}
};
__device__ __forceinline__ unsigned cvt_pk_bf16(float lo, float hi) { unsigned r; asm volatile("v_cvt_pk_bf16_f32 %0, %1, %2" : "=v"(r) : "v"(lo), "v"(hi)); return r; }
typedef float f32x2 __attribute__((ext_vector_type(2)));
__device__ __forceinline__ f32x2 gelu_pk(f32x2 v) {
    const f32x2 av = __builtin_elementwise_abs(v), d = av * 0.2316418882f + 1.0f;
    f32x2 t; t.x = __builtin_amdgcn_rcpf(d.x); t.y = __builtin_amdgcn_rcpf(d.y);
    f32x2 q = t * 0.5307027145f + (-0.7265760135f); q = q * t + 0.7107068705f; q = q * t + (-0.142248368f); q = q * t + 0.127414796f; q = q * t;
    const f32x2 s = (v * v) * (-0.72134752044f);
    f32x2 e; e.x = __builtin_amdgcn_exp2f(s.x); e.y = __builtin_amdgcn_exp2f(s.y);
    const f32x2 m = v * (q * e), r = v - m;
    f32x2 o; o.x = v.x < 0.f ? m.x : r.x; o.y = v.y < 0.f ? m.y : r.y; return o;
}

struct EpiF32 {
    static constexpr bool PERM = false, AFTER_DRAIN = false;
    float* C; int ldc; const float* bias;
    __device__ __forceinline__ void operator()(const f32x4 (&acc)[2][2][4][2], const Unit& u, int wr, int wc, int fr, int fq) const {
        const int row0 = u.pm * BM + wr * 64 + fr, col0 = u.pn * BM + wc * 32 + 4 * fq;
        f32x4 bv[2][2];
#pragma unroll
        for (int bj = 0; bj < 2; ++bj)
#pragma unroll
            for (int n = 0; n < 2; ++n) bv[bj][n] = bias ? *(const f32x4*)(bias + col0 + bj * HALF + n * 16) : (f32x4){0.f, 0.f, 0.f, 0.f};
#pragma unroll
        for (int ai = 0; ai < 2; ++ai)
#pragma unroll
            for (int m = 0; m < 4; ++m) { float* rowp = C + (size_t)(row0 + ai * HALF + m * 16) * ldc + col0;
#pragma unroll
                for (int bj = 0; bj < 2; ++bj)
#pragma unroll
                    for (int n = 0; n < 2; ++n) *(f32x4*)(rowp + bj * HALF + n * 16) = acc[ai][bj][m][n] + bv[bj][n]; }
    }
};
template <int ACT  > struct EpiBf16 {
    static constexpr bool PERM = true, AFTER_DRAIN = false;
    bf16_t* O; int ldc; const float* bias; int split_cols; size_t split_stride;
    __device__ __forceinline__ void operator()(const f32x4 (&acc)[2][2][4][2], const Unit& u, int wr, int wc, int fr, int fq) const {
        const int row0 = u.pm * BM + wr * 64 + fr; int colt = u.pn * BM; bf16_t* base = O;
        if (split_cols) { const int t = colt / split_cols; base += (size_t)t * split_stride; colt -= t * split_cols; }
        const int col0 = colt + wc * 32 + 8 * fq, bcol0 = u.pn * BM + wc * 32 + 8 * fq;
        f32x4 bv[2][2];
#pragma unroll
        for (int bj = 0; bj < 2; ++bj)
#pragma unroll
            for (int n = 0; n < 2; ++n) bv[bj][n] = bias ? *(const f32x4*)(bias + bcol0 + bj * HALF + 4 * n) : (f32x4){0.f, 0.f, 0.f, 0.f};
#pragma unroll
        for (int ai = 0; ai < 2; ++ai)
#pragma unroll
            for (int m = 0; m < 4; ++m) { bf16_t* rowp = base + (size_t)(row0 + ai * HALF + m * 16) * ldc + col0;
#pragma unroll
                for (int bj = 0; bj < 2; ++bj) { f32x4 v0 = acc[ai][bj][m][0] + bv[bj][0], v1 = acc[ai][bj][m][1] + bv[bj][1];
                    if (ACT == 1) { f32x2 a = gelu_pk((f32x2){v0[0], v0[1]}), b = gelu_pk((f32x2){v0[2], v0[3]}), c = gelu_pk((f32x2){v1[0], v1[1]}), d = gelu_pk((f32x2){v1[2], v1[3]});
                        v0 = (f32x4){a.x, a.y, b.x, b.y}; v1 = (f32x4){c.x, c.y, d.x, d.y}; }
                    if (ACT == 2) {
#pragma unroll
                        for (int j = 0; j < 4; ++j) { v0[j] = 0.5f * v0[j] * (1.0f + erff(v0[j] * 0.70710678f)); v1[j] = 0.5f * v1[j] * (1.0f + erff(v1[j] * 0.70710678f)); } }
                    u32x4 w; w.x = cvt_pk_bf16(v0[0], v0[1]); w.y = cvt_pk_bf16(v0[2], v0[3]); w.z = cvt_pk_bf16(v1[0], v1[1]); w.w = cvt_pk_bf16(v1[2], v1[3]);
                    *(u32x4*)(rowp + bj * HALF) = w; } }
    }
};
template <class Epi, class Sched, bool STAMP = false>
__device__ __forceinline__ void gemm_phase(PG8_LAS unsigned char* lds, const Gemm g, const Sched& S, const Epi& E, unsigned long long* stamps) {
    int tid_ = threadIdx.x; asm volatile("" : "+v"(tid_));
    const int tid = tid_, wid = __builtin_amdgcn_readfirstlane(tid >> 6), lane = tid & 63, wr = wid >> 2, wc = wid & 3, fr = lane & 15, fq = lane >> 4;
    const int K = g.K, nt = K / BK;
    int ts_lo = 0, ts_hi = 0, nts = 0; const unsigned long long rt_entry = STAMP ? (unsigned long long)wall_clock64() : 0ull;
#define PG8_STAMP() do { if (STAMP && wid == 0 && nts < 64) { const unsigned long long _c = (unsigned long long)clock64(); \
        ts_lo = (lane == nts) ? (int)(unsigned)_c : ts_lo; ts_hi = (lane == nts) ? (int)(unsigned)(_c >> 32) : ts_hi; ++nts; } } while (0)
    PG8_STAMP();
    unsigned voffA[2], voffB[2];
#pragma unroll
    for (int i = 0; i < 2; ++i) { int R, C; stage_rc(tid * 16 + i * 8192, R, C); const int Rb = Epi::PERM ? ((R & ~31) + perm32(R & 31)) : R;
        voffA[i] = (unsigned)(R * g.lda + C) * 2u; voffB[i] = (unsigned)(Rb * g.ldb + C) * 2u; }
    const size_t kstep = (size_t)(BK * 2);
    const size_t hstepA = (size_t)HALF * g.lda * 2, hstepB = (size_t)HALF * g.ldb * 2;
    const size_t tstepA = 2 * hstepA, tstepB = 2 * hstepB, sstep = (size_t)K * 2;
    const unsigned ldsw = (unsigned)wid * 1024u;
    const int aoff = lds_byte(wr * 64 + fr, fq * 8), boff = lds_byte(wc * 32 + fr, fq * 8);
#define PG8_SA(b, h) (((b) * 2 + (h)) * HTB)
#define PG8_SB(b, h) ((4 + (b) * 2 + (h)) * HTB)
#define PG8_STAGE(bufoff, gbase, voff) do { _Pragma("unroll") for (int _i = 0; _i < 2; ++_i) \
        __builtin_amdgcn_global_load_lds((const unsigned*)((const char*)(gbase) + (voff)[_i]), (PG8_LAS unsigned*)(lds + (bufoff) + ldsw + _i * 8192), 16, 0, 0); } while (0)
#define PG8_LDA(dst, b, h) do { _Pragma("unroll") for (int m = 0; m < 4; ++m) _Pragma("unroll") for (int k = 0; k < 2; ++k) dst[m][k] = *(const PG8_LAS bf16x8*)(lds + PG8_SA(b, h) + aoff + m * 2048 + k * 1024); } while (0)
#define PG8_LDB(dst, b, h) do { _Pragma("unroll") for (int n = 0; n < 2; ++n) _Pragma("unroll") for (int k = 0; k < 2; ++k) dst[n][k] = *(const PG8_LAS bf16x8*)(lds + PG8_SB(b, h) + boff + n * 2048 + k * 1024); } while (0)
#define PG8_MMA(ai, bj, At, Bt) do { __builtin_amdgcn_s_setprio(1); _Pragma("unroll") for (int m = 0; m < 4; ++m) _Pragma("unroll") for (int n = 0; n < 2; ++n) _Pragma("unroll") for (int k = 0; k < 2; ++k) \
        acc[ai][bj][m][n] = __builtin_amdgcn_mfma_f32_16x16x32_bf16(Bt[n][k], At[m][k], acc[ai][bj][m][n], 0, 0, 0); __builtin_amdgcn_s_setprio(0); } while (0)
#define PG8_WAIT_V(n) asm volatile("s_waitcnt vmcnt(" #n ")" ::: "memory")
#define PG8_WAIT_L(n) asm volatile("s_waitcnt lgkmcnt(" #n ")" ::: "memory")
#define PG8_BAR __builtin_amdgcn_s_barrier()
#define PG8_SCHED __builtin_amdgcn_sched_barrier(0)
    Unit cur, nxt; int ui = 0;
    if (!S.next(0, cur)) return;
    f32x4 acc[2][2][4][2];
#pragma unroll
    for (int a = 0; a < 2; ++a)
#pragma unroll
        for (int b = 0; b < 2; ++b)
#pragma unroll
            for (int m = 0; m < 4; ++m)
#pragma unroll
                for (int n = 0; n < 2; ++n) acc[a][b][m][n] = (f32x4){0.f, 0.f, 0.f, 0.f};
    bf16x8 At[4][2], B0[2][2], B1[2][2];
    const char* cA = (const char*)g.A + (size_t)cur.pm * tstepA + (size_t)cur.ks * sstep; const char* cB = (const char*)g.Bt + (size_t)cur.pn * tstepB + (size_t)cur.ks * sstep;
    S.a_ready(cur);
    PG8_STAGE(PG8_SB(0, 0), cB, voffB); PG8_STAGE(PG8_SA(0, 0), cA, voffA); PG8_STAGE(PG8_SB(0, 1), cB + hstepB, voffB); PG8_STAGE(PG8_SA(0, 1), cA + hstepA, voffA);
    if (wr == 1) PG8_BAR;
    PG8_WAIT_V(4); PG8_BAR;
    PG8_STAGE(PG8_SB(1, 0), cB + kstep, voffB); PG8_STAGE(PG8_SA(1, 0), cA + kstep, voffA); PG8_STAGE(PG8_SB(1, 1), cB + hstepB + kstep, voffB);
    PG8_WAIT_V(6); PG8_BAR;
    PG8_STAMP();
    for (;;) {
        const bool has_next = S.next(ui + 1, nxt);
        const char* nA = has_next ? (const char*)g.A + (size_t)nxt.pm * tstepA + (size_t)nxt.ks * sstep : cA; const char* nB = has_next ? (const char*)g.Bt + (size_t)nxt.pn * tstepB + (size_t)nxt.ks * sstep : cB;
        for (int t = 0; t < nt; t += 2) {
            const bool last = (t == nt - 2);
            const char* a1 = cA + (size_t)(t + 1) * kstep;
            const char* a2 = last ? nA : cA + (size_t)(t + 2) * kstep; const char* b2 = last ? nB : cB + (size_t)(t + 2) * kstep;
            const char* a3 = a2 + kstep; const char* b3 = b2 + kstep;
            if (last && has_next) S.a_ready(nxt);
            PG8_LDB(B0, 0, 0); PG8_SCHED; PG8_LDA(At, 0, 0); PG8_STAGE(PG8_SA(1, 1), a1 + hstepA, voffA);
            PG8_WAIT_L(8); PG8_BAR; PG8_WAIT_L(0); PG8_MMA(0, 0, At, B0); PG8_BAR; PG8_SCHED;
            PG8_LDB(B1, 0, 1); PG8_STAGE(PG8_SB(0, 0), b2, voffB);
            PG8_BAR; PG8_WAIT_L(0); PG8_MMA(0, 1, At, B1); PG8_BAR;
            PG8_LDA(At, 0, 1); PG8_STAGE(PG8_SA(0, 0), a2, voffA);
            PG8_BAR; PG8_WAIT_L(0); PG8_MMA(1, 0, At, B0); PG8_BAR; PG8_SCHED;
            PG8_STAGE(PG8_SB(0, 1), b2 + hstepB, voffB);
            PG8_WAIT_V(6); PG8_BAR; PG8_MMA(1, 1, At, B1); PG8_BAR;
            PG8_LDB(B0, 1, 0); PG8_SCHED; PG8_LDA(At, 1, 0); PG8_STAGE(PG8_SA(0, 1), a2 + hstepA, voffA);
            PG8_WAIT_L(8); PG8_BAR; PG8_WAIT_L(0); PG8_MMA(0, 0, At, B0); PG8_BAR; PG8_SCHED;
            PG8_LDB(B1, 1, 1); PG8_STAGE(PG8_SB(1, 0), b3, voffB);
            PG8_BAR; PG8_WAIT_L(0); PG8_MMA(0, 1, At, B1); PG8_BAR;
            PG8_LDA(At, 1, 1); PG8_STAGE(PG8_SA(1, 0), a3, voffA);
            PG8_BAR; PG8_WAIT_L(0); PG8_MMA(1, 0, At, B0); PG8_BAR; PG8_SCHED;
            PG8_STAGE(PG8_SB(1, 1), b3 + hstepB, voffB);
            PG8_WAIT_V(6); PG8_BAR; PG8_MMA(1, 1, At, B1); PG8_BAR;
        }
        PG8_STAMP();
        if constexpr (!Epi::AFTER_DRAIN) { E(acc, cur, wr, wc, fr, fq); S.done(cur); }
        PG8_STAMP();
        if (!has_next) break;
#pragma unroll
        for (int a = 0; a < 2; ++a)
#pragma unroll
            for (int b = 0; b < 2; ++b)
#pragma unroll
                for (int m = 0; m < 4; ++m)
#pragma unroll
                    for (int n = 0; n < 2; ++n) acc[a][b][m][n] = (f32x4){0.f, 0.f, 0.f, 0.f};
        cur = nxt; cA = nA; cB = nB; ++ui;
    }
    PG8_WAIT_V(0);
    if (wr == 0) PG8_BAR;
    PG8_BAR;
    if constexpr (Epi::AFTER_DRAIN) { E.fused(acc, cur, wr, wc, fr, fq, lds, wid, lane); S.done(cur); }
    PG8_STAMP();
    if (STAMP && wid == 0) { stamps[lane] = lane < nts ? (((unsigned long long)(unsigned)ts_hi << 32) | (unsigned)ts_lo) : 0ull;
        if (lane == 62) stamps[62] = rt_entry; if (lane == 63) stamps[63] = (unsigned long long)wall_clock64(); }
#undef PG8_STAMP
#undef PG8_SA
#undef PG8_SB
#undef PG8_STAGE
#undef PG8_LDA
#undef PG8_LDB
#undef PG8_MMA
#undef PG8_WAIT_V
#undef PG8_WAIT_L
#undef PG8_BAR
#undef PG8_SCHED
}
}

#define LAS __attribute__((address_space(3)))
typedef unsigned short bf16_t;
typedef short bf16x8 __attribute__((ext_vector_type(8)));
typedef float f32x4 __attribute__((ext_vector_type(4)));
typedef float f32x2 __attribute__((ext_vector_type(2)));
typedef unsigned u32x4 __attribute__((ext_vector_type(4)));
typedef unsigned u32x2 __attribute__((ext_vector_type(2)));

constexpr int D = 1024, NP = 16384, NS = 512, NTOK = NP + NS, SEQ = 2048, NB = 8, NSB = 128, DEPTH = 4;
constexpr int INW = 2568, NPROJ = 2560, DFF = 2816, NGU = 5632;
constexpr int PC_G = 1536, PC_SSM = 2048, PC_POOL = 2304;
constexpr float EPS = 1e-6f;
constexpr int LDS_BYTES = 163840;

constexpr size_t SZ_WIN = (size_t)NPROJ * D * 2, SZ_WOUT = (size_t)D * D * 2, SZ_WGU = (size_t)NGU * D * 2, SZ_WDN = (size_t)D * DFF * 2;
constexpr size_t SZ_WAB = 8 * D * 4, SZ_GLUT = 256 * 256 * 2, SZ_POOLT = 4 * 64 * 64 * 2, SZ_SSMK = 16 * 64 * 4 * 4, SZ_BBAR = 16 * 64 * 32 * 4;
constexpr size_t WS_WIN = 0;
constexpr size_t WS_WOUT = WS_WIN + DEPTH * SZ_WIN;
constexpr size_t WS_WGU = WS_WOUT + DEPTH * SZ_WOUT;
constexpr size_t WS_WDN = WS_WGU + DEPTH * SZ_WGU;
constexpr size_t WS_WAB = WS_WDN + DEPTH * SZ_WDN;
constexpr size_t WS_GLUT = WS_WAB + DEPTH * SZ_WAB;
constexpr size_t WS_POOLT = WS_GLUT + DEPTH * SZ_GLUT;
constexpr size_t WS_SSMK = WS_POOLT + DEPTH * SZ_POOLT;
constexpr size_t WS_BBAR = WS_SSMK + DEPTH * SZ_SSMK;
constexpr size_t WS_H = WS_BBAR + DEPTH * SZ_BBAR;
constexpr size_t WS_AB = WS_H + (size_t)NTOK * D * 2;
constexpr size_t WS_MIX = WS_AB + (size_t)NTOK * 8 * 4;
constexpr size_t WS_MIXO = WS_MIX + (size_t)NTOK * D * 2;
constexpr size_t WS_SSME = WS_MIXO + (size_t)NTOK * D * 4;
constexpr size_t WS_PROJ = WS_SSME + (size_t)8 * 32 * 16 * 64 * 2 * 4;
constexpr size_t WS_DW = WS_PROJ + (size_t)NTOK * NPROJ * 2;
constexpr size_t WS_DKC = WS_DW + (size_t)1024 * 8192 * 4;
constexpr size_t WS_DQD = WS_DKC + (size_t)1024 * 8192 * 2;
constexpr size_t WS_DQK = WS_DQD + (size_t)1024 * 8192 * 2;
constexpr size_t WS_DKT = WS_DQK + (size_t)1024 * 4096 * 2;
constexpr size_t WS_DGL = WS_DKT + (size_t)1024 * 8192 * 2;
constexpr size_t WS_DGS = WS_DGL + 4096;
constexpr size_t WS_BAR = WS_DGS + (size_t)1024 * 8192 * 2;
constexpr size_t WS_PARTS = WS_BAR + 16384;
constexpr size_t WS_END = WS_PARTS + (size_t)11 * 512 * 1024 * 4;
constexpr size_t WS_HID = WS_PROJ;
static_assert(WS_HID + (size_t)NTOK * DFF * 2 <= WS_END, "HID overlay");
static_assert(WS_H % 256 == 0 && WS_PROJ % 256 == 0 && WS_DW % 256 == 0, "align");

constexpr size_t O_YP = 0, O_YS = O_YP + (size_t)NP * D, O_DP = O_YS + (size_t)NS * D, O_CP = O_DP + (size_t)DEPTH * 8 * 4 * 16384,
                 O_REP = O_CP + (size_t)DEPTH * 8 * 3 * 1536, O_IMP = O_REP + (size_t)DEPTH * 8 * 1024, O_PP = O_IMP + (size_t)DEPTH * 8 * 1024,
                 O_DS = O_PP + (size_t)DEPTH * 8 * 15 * 256, O_CS = O_DS + (size_t)DEPTH * 128 * 4 * 16384, O_RES = O_CS + (size_t)DEPTH * 128 * 3 * 1536,
                 O_IMS = O_RES + (size_t)DEPTH * 128 * 1024, O_PS = O_IMS + (size_t)DEPTH * 128 * 1024, O_END = O_PS + (size_t)DEPTH * 128 * 15 * 256;

struct Args { const float* in[32]; float* out; unsigned char* ws; int ph_lo, ph_hi; };
typedef const float* cfp_t;
typedef __attribute__((address_space(4))) const unsigned char* kptr_t;
struct InProxy { __device__ __forceinline__ const float* operator[](int i) const {
    kptr_t p = (kptr_t)__builtin_amdgcn_kernarg_segment_ptr(); asm volatile("" : "+s"(p)); return *(__attribute__((address_space(4))) const cfp_t*)(p + 8 * i); } };
struct DevArgs { InProxy in; float* out; unsigned char* ws; int ph_lo, ph_hi; };
enum { I_XP = 0, I_XS, I_SDELTA, I_SCONV, I_SRE, I_SIM, I_SPOOL, I_NMPRE, I_NMPOST, I_NFPRE, I_NFPOST, I_WIN, I_CONVW, I_ALOG, I_DTB, I_ONORM,
       I_ARE, I_AIM, I_LOGDT, I_BRE, I_BIM, I_CRE, I_CIM, I_SSMD, I_GLUW, I_GLUB, I_POOLW, I_POOLS, I_WOUT, I_WG, I_WU, I_WD };

__device__ __forceinline__ unsigned f2bf(float f) { unsigned u = __float_as_uint(f); return (u + 0x7fffu + ((u >> 16) & 1u)) >> 16; }
__device__ __forceinline__ float bf2f(unsigned b) { return __uint_as_float(b << 16); }
__device__ __forceinline__ unsigned pk2(float lo, float hi) { return f2bf(lo) | (f2bf(hi) << 16); }
template <int CTRL> __device__ __forceinline__ float dpp_f(float v) { return __builtin_bit_cast(float, __builtin_amdgcn_update_dpp(0, __builtin_bit_cast(int, v), CTRL, 0xF, 0xF, true)); }
__device__ __forceinline__ float row_sum8(float v) { v += dpp_f<0xB1>(v); v += dpp_f<0x4E>(v); v += dpp_f<0x141>(v); return v; }
__device__ __forceinline__ float row_sum16(float v) { v = row_sum8(v); v += dpp_f<0x140>(v); return v; }
__device__ __forceinline__ float wave_sum(float v) { v = row_sum16(v); v += __shfl_xor(v, 16); v += __shfl_xor(v, 32); return v; }
__device__ __forceinline__ float silu_f(float y) { return y * __builtin_amdgcn_rcpf(1.f + __expf(-y)); }
__device__ __forceinline__ float sigmoid_f(float y) { return __builtin_amdgcn_rcpf(1.f + __expf(-y)); }
__device__ __forceinline__ float gelu_tanh_f(float x) { const float z = 0.7978845608028654f * (x + 0.044715f * x * x * x);
    const float t = 1.f - 2.f * __builtin_amdgcn_rcpf(1.f + __expf(2.f * z)); return 0.5f * x * (1.f + t); }
__device__ __forceinline__ f32x4 mfma16(bf16x8 a, bf16x8 b, f32x4 c) { return __builtin_amdgcn_mfma_f32_16x16x32_bf16(a, b, c, 0, 0, 0); }
#define LDS_FENCE() asm volatile("s_waitcnt lgkmcnt(0)" ::: "memory")

struct EpiSwiGLU {
    static constexpr bool PERM = false, AFTER_DRAIN = false;
    bf16_t* O; int ldc;
    __device__ __forceinline__ void operator()(const pg8::f32x4 (&acc)[2][2][4][2], const pg8::Unit& u, int wr, int wc, int fr, int fq) const {
        const int row0 = u.pm * 256 + wr * 64 + fr, hid0 = u.pn * 128 + wc * 16 + 4 * fq;
#pragma unroll
        for (int ai = 0; ai < 2; ++ai)
#pragma unroll
            for (int m = 0; m < 4; ++m) { bf16_t* rowp = O + (size_t)(row0 + ai * 128 + m * 16) * ldc + hid0;
#pragma unroll
                for (int bj = 0; bj < 2; ++bj) { const pg8::f32x4 g = acc[ai][bj][m][0], v = acc[ai][bj][m][1];
                    u32x2 w; w.x = pg8::cvt_pk_bf16(silu_f(g[0]) * v[0], silu_f(g[1]) * v[1]); w.y = pg8::cvt_pk_bf16(silu_f(g[2]) * v[2], silu_f(g[3]) * v[3]);
                    *(u32x2*)(rowp + bj * 64) = w; } }
    }
};

#define XB_TMO      128
#define XB_XCNT(j)  (256  + 64 * (j))
#define XB_XSUB(j)  (1280 + 64 * (j))
#define XB_XGEN(j)  (2304 + 64 * (j))
#define XB_TOP      3328
#define XB_TOPGEN   3392
#define XCD_BAR_WORDS 3456
#define XB_SPIN_CAP (1u << 18)

__device__ __forceinline__ unsigned xb_ld(unsigned* p)              { return __hip_atomic_load(p, __ATOMIC_RELAXED, __HIP_MEMORY_SCOPE_AGENT); }
__device__ __forceinline__ unsigned xb_add(unsigned* p, unsigned v) { return __hip_atomic_fetch_add(p, v, __ATOMIC_RELAXED, __HIP_MEMORY_SCOPE_AGENT); }
__device__ __forceinline__ unsigned xb_xcc_id() { return (unsigned)__builtin_amdgcn_s_getreg((3 << 11) | 20) & 0xFu; }
#define XB_SPIN(cond, bar) do { unsigned _sp = 0; while (cond) { __builtin_amdgcn_s_sleep(1); \
    if ((++_sp & 255u) == 0u) { if (xb_ld(&(bar)[XB_TMO])) break; if (_sp > XB_SPIN_CAP) { atomicAdd(&(bar)[XB_TMO], 1u); break; } } } } while (0)

struct XcdBarrier {
    unsigned* bar; unsigned x;
    volatile LAS unsigned* st;
};

__device__ __forceinline__ XcdBarrier xcd_barrier_post(unsigned* bar, volatile LAS unsigned* st) {
    XcdBarrier b; b.bar = bar; b.x = xb_xcc_id(); b.st = st;
    if (threadIdx.x == 0) (void)xb_add(&bar[XB_XCNT(b.x)], 1u);
    return b;
}
__device__ __forceinline__ void xcd_barrier_complete(unsigned* bar, unsigned x, unsigned& nloc, unsigned& nx) {
    const unsigned G = gridDim.x * gridDim.y * gridDim.z;
    unsigned sum, cnt, mine, sp = 0u;
    for (;;) {
        sum = 0u; cnt = 0u; mine = 0u;
#pragma unroll
        for (unsigned j = 0; j < 16; ++j) { const unsigned c = xb_ld(&bar[XB_XCNT(j)]); sum += c; cnt += (c > 0u) ? 1u : 0u; mine = (j == x) ? c : mine; }
        if (sum == G) break;
        __builtin_amdgcn_s_sleep(1);
        if ((++sp & 255u) == 0u) { if (xb_ld(&bar[XB_TMO])) break; if (sp > XB_SPIN_CAP) { atomicAdd(&bar[XB_TMO], 1u); break; } }
    }
    nloc = mine > 0u ? mine : 1u; nx = cnt > 0u ? cnt : 1u;
}

__device__ __forceinline__ void xcd_barrier(const XcdBarrier& b) {
    asm volatile("s_waitcnt vmcnt(0)" ::: "memory");
    __syncthreads();
    if (threadIdx.x == 0) {
        unsigned* bar = b.bar; asm volatile("" : "+s"(bar));
        __builtin_amdgcn_s_waitcnt(0);
        unsigned nloc = b.st[0], nx = b.st[1];
        if (nloc == 0u) { xcd_barrier_complete(bar, b.x, nloc, nx); b.st[0] = nloc; b.st[1] = nx; }
        const unsigned old = xb_add(&bar[XB_XSUB(b.x)], 1u);
        const unsigned gen = old / nloc;
        if (old + 1u == (gen + 1u) * nloc) {
            __builtin_amdgcn_fence(__ATOMIC_RELEASE, "agent");
            asm volatile("s_waitcnt vmcnt(0)" ::: "memory");
            const unsigned og = xb_add(&bar[XB_TOP], 1u);
            const unsigned tg = og / nx;
            if (og + 1u == (tg + 1u) * nx) xb_add(&bar[XB_TOPGEN], 1u);
            else XB_SPIN(xb_ld(&bar[XB_TOPGEN]) == tg, bar);
            __builtin_amdgcn_fence(__ATOMIC_ACQUIRE, "agent");
            xb_add(&bar[XB_XGEN(b.x)], 1u);
            asm volatile("s_waitcnt vmcnt(0)" ::: "memory");
        } else {
            XB_SPIN(xb_ld(&bar[XB_XGEN(b.x)]) == gen, bar);
            __builtin_amdgcn_fence(__ATOMIC_ACQUIRE, "agent");
            asm volatile("s_waitcnt vmcnt(0)" ::: "memory");
        }
    }
    __syncthreads();
}

struct SliceOrder {
    int nunits, G, c;
    __device__ __forceinline__ bool next(int i, pg8::Unit& u) const { const int L = i * G + c; if (L >= nunits) return false; const int t = L & 7; u.pm = t >> 2; u.pn = t & 3; u.ks = L >> 3; return true; }
    __device__ __forceinline__ void a_ready(const pg8::Unit&) const {}
    __device__ __forceinline__ void done(const pg8::Unit&) const {}
};
struct EpiF32Part {
    static constexpr bool PERM = false, AFTER_DRAIN = false;
    float* C;
    __device__ __forceinline__ void operator()(const pg8::f32x4 (&acc)[2][2][4][2], const pg8::Unit& u, int wr, int wc, int fr, int fq) const {
        const int row0 = u.pm * 256 + wr * 64 + fr, col0 = u.pn * 256 + wc * 32 + 4 * fq; float* base = C + (size_t)u.ks * (512 * 1024);
#pragma unroll
        for (int ai = 0; ai < 2; ++ai)
#pragma unroll
            for (int m = 0; m < 4; ++m) { float* rowp = base + (size_t)(row0 + ai * 128 + m * 16) * 1024 + col0;
#pragma unroll
                for (int bj = 0; bj < 2; ++bj)
#pragma unroll
                    for (int n = 0; n < 2; ++n) *(pg8::f32x4*)(rowp + bj * 128 + n * 16) = acc[ai][bj][m][n]; }
    }
};

struct SrcIn { const float* w; __device__ __forceinline__ float operator()(int k, int n) const { return w[(size_t)k * INW + (n < 1536 ? n : n + 8)]; } };
struct SrcPlain { const float* w; int N; __device__ __forceinline__ float operator()(int k, int n) const { return w[(size_t)k * N + n]; } };
struct SrcGU { const float* g; const float* u; __device__ __forceinline__ float operator()(int k, int n) const { const int r = n & 31, hid = (n >> 5) * 16 + (r & 15); const long long du = (r < 16) ? 0ll : (long long)(u - g); return g[du + (long long)k * DFF + hid]; } };
template <class Src> __device__ __forceinline__ void transpose_item(const Src& src, int K, bf16_t* WT, int nblk, LAS float* scr, int item, int lane) {
    const int kb = item / nblk, nb = item % nblk, k0 = 64 * kb, n0 = 32 * nb;
#pragma unroll 8
    for (int i = 0; i < 32; ++i) { const int kk = 2 * i + (lane >> 5); scr[kk * 33 + (lane & 31)] = src(k0 + kk, n0 + (lane & 31)); }
    LDS_FENCE();
    const int c = lane & 7;
#pragma unroll
    for (int j = 0; j < 4; ++j) { const int n = (lane >> 3) + 8 * j; const LAS float* s = scr + (8 * c) * 33 + n;
        u32x4 o; o.x = pk2(s[0 * 33], s[1 * 33]); o.y = pk2(s[2 * 33], s[3 * 33]); o.z = pk2(s[4 * 33], s[5 * 33]); o.w = pk2(s[6 * 33], s[7 * 33]);
        *(u32x4*)(WT + (size_t)(n0 + n) * K + k0 + 8 * c) = o; }
    LDS_FENCE();
}

__device__ __forceinline__ void norm_rows(const float* T, const float* wt, const float* X0, const float* X1, float* Xout, const float* wh, bf16_t* H,
                                          const float* Wab, float* AB, int gw, int NGW, int lane, const float* Tp = nullptr, int ns = 0,
                                          const bf16_t* Xbin = nullptr, bf16_t* Xbout = nullptr) {
#pragma unroll 1
    for (int m = gw; m < NTOK; m += NGW) {
        f32x4 x[4], t[4];
        { if (Xbin) {
#pragma unroll
              for (int j = 0; j < 4; ++j) { const u32x2 xb = ((const u32x2*)(Xbin + (size_t)m * D))[lane + 64 * j];
                  x[j] = (f32x4){__uint_as_float(xb.x << 16), __uint_as_float(xb.x & 0xffff0000u), __uint_as_float(xb.y << 16), __uint_as_float(xb.y & 0xffff0000u)}; } }
          else { const float* xr = (X1 && m >= NP) ? X1 + (size_t)(m - NP) * D : X0 + (size_t)m * D;
#pragma unroll
              for (int j = 0; j < 4; ++j) x[j] = ((const f32x4*)xr)[lane + 64 * j]; }
          if (T && !(Tp && m >= NP)) {
#pragma unroll
              for (int j = 0; j < 4; ++j) { const u32x2 tb = ((const u32x2*)((const bf16_t*)T + (size_t)m * D))[lane + 64 * j];
                  t[j] = (f32x4){__uint_as_float(tb.x << 16), __uint_as_float(tb.x & 0xffff0000u), __uint_as_float(tb.y << 16), __uint_as_float(tb.y & 0xffff0000u)}; } } }
        if (T) {
            float ss = 0.f;
            if (Tp && m >= NP) {
#pragma unroll
                for (int j = 0; j < 4; ++j) { f32x4 a = {0.f, 0.f, 0.f, 0.f}; for (int q = 0; q < ns; ++q) a += ((const f32x4*)(Tp + (size_t)q * (512 * 1024) + (size_t)(m - NP) * D))[lane + 64 * j]; t[j] = a; } }
#pragma unroll
            for (int j = 0; j < 4; ++j) ss += (t[j].x * t[j].x + t[j].y * t[j].y) + (t[j].z * t[j].z + t[j].w * t[j].w);
            ss = wave_sum(ss); const float r = rsqrtf(ss * (1.f / D) + EPS);
#pragma unroll
            for (int j = 0; j < 4; ++j) { const f32x4 w = ((const f32x4*)wt)[lane + 64 * j]; x[j] += t[j] * r * w; }
        }
        if (Xout) {
#pragma unroll
            for (int j = 0; j < 4; ++j) ((f32x4*)(Xout + (size_t)m * D))[lane + 64 * j] = x[j];
        }
        if (Xbout) {
#pragma unroll
            for (int j = 0; j < 4; ++j) { u32x2 o; o.x = pg8::cvt_pk_bf16(x[j].x, x[j].y); o.y = pg8::cvt_pk_bf16(x[j].z, x[j].w); ((u32x2*)(Xbout + (size_t)m * D))[lane + 64 * j] = o; }
        }
        if (H) {
            float ss = 0.f;
#pragma unroll
            for (int j = 0; j < 4; ++j) ss += (x[j].x * x[j].x + x[j].y * x[j].y) + (x[j].z * x[j].z + x[j].w * x[j].w);
            ss = wave_sum(ss); const float r = rsqrtf(ss * (1.f / D) + EPS);
            f32x4 hv[4];
#pragma unroll
            for (int j = 0; j < 4; ++j) { const f32x4 w = ((const f32x4*)wh)[lane + 64 * j]; hv[j] = x[j] * r * w;
                u32x2 o; o.x = pg8::cvt_pk_bf16(hv[j].x, hv[j].y); o.y = pg8::cvt_pk_bf16(hv[j].z, hv[j].w); ((u32x2*)(H + (size_t)m * D))[lane + 64 * j] = o; }
            if (Wab) {
                float d[8];
#pragma unroll
                for (int c = 0; c < 8; ++c) { float dd = 0.f;
#pragma unroll
                    for (int j = 0; j < 4; ++j) { const f32x4 w = ((const f32x4*)(Wab + c * D))[lane + 64 * j]; dd += (hv[j].x * w.x + hv[j].y * w.y) + (hv[j].z * w.z + hv[j].w * w.w); }
                    d[c] = dd; }
#pragma unroll
                for (int c = 0; c < 8; ++c) d[c] = row_sum16(d[c]);
#pragma unroll
                for (int o = 16; o < 64; o <<= 1) {
#pragma unroll
                    for (int c = 0; c < 8; ++c) d[c] += __shfl_xor(d[c], o); }
                if (lane == 0) { f32x4 o0 = {d[0], d[1], d[2], d[3]}, o1 = {d[4], d[5], d[6], d[7]}; *(f32x4*)(AB + (size_t)m * 8) = o0; *(f32x4*)(AB + (size_t)m * 8 + 4) = o1; }
            }
        }
    }
}

__device__ __forceinline__ void norm_rows_pf(const float* T, const float* wt, bf16_t* XB, const float* wh, bf16_t* H,
                                             int gw, int NGW, int lane, const float* Tp, int ns) {
    u32x2 xn[4], tn[4];
#define NR_LOAD(mm) do { const int _m = (mm); \
        _Pragma("unroll") for (int j = 0; j < 4; ++j) xn[j] = ((const u32x2*)(XB + (size_t)_m * D))[lane + 64 * j]; \
        if (_m < NP) { _Pragma("unroll") for (int j = 0; j < 4; ++j) tn[j] = ((const u32x2*)((const bf16_t*)T + (size_t)_m * D))[lane + 64 * j]; } } while (0)
    if (gw < NTOK) NR_LOAD(gw);
#pragma unroll 1
    for (int m = gw; m < NTOK; m += NGW) {
        f32x4 x[4], t[4];
#pragma unroll
        for (int j = 0; j < 4; ++j) { x[j] = (f32x4){__uint_as_float(xn[j].x << 16), __uint_as_float(xn[j].x & 0xffff0000u), __uint_as_float(xn[j].y << 16), __uint_as_float(xn[j].y & 0xffff0000u)};
            t[j] = (f32x4){__uint_as_float(tn[j].x << 16), __uint_as_float(tn[j].x & 0xffff0000u), __uint_as_float(tn[j].y << 16), __uint_as_float(tn[j].y & 0xffff0000u)}; }
        if (m + NGW < NTOK) NR_LOAD(m + NGW);
        if (m >= NP) {
#pragma unroll
            for (int j = 0; j < 4; ++j) { f32x4 a = {0.f, 0.f, 0.f, 0.f}; for (int q = 0; q < ns; ++q) a += ((const f32x4*)(Tp + (size_t)q * (512 * 1024) + (size_t)(m - NP) * D))[lane + 64 * j]; t[j] = a; } }
        float ss = 0.f;
#pragma unroll
        for (int j = 0; j < 4; ++j) ss += (t[j].x * t[j].x + t[j].y * t[j].y) + (t[j].z * t[j].z + t[j].w * t[j].w);
        ss = wave_sum(ss); const float r = rsqrtf(ss * (1.f / D) + EPS);
#pragma unroll
        for (int j = 0; j < 4; ++j) { const f32x4 w = ((const f32x4*)wt)[lane + 64 * j]; x[j] += t[j] * r * w; }
#pragma unroll
        for (int j = 0; j < 4; ++j) { u32x2 o; o.x = pg8::cvt_pk_bf16(x[j].x, x[j].y); o.y = pg8::cvt_pk_bf16(x[j].z, x[j].w); ((u32x2*)(XB + (size_t)m * D))[lane + 64 * j] = o; }
        float s2 = 0.f;
#pragma unroll
        for (int j = 0; j < 4; ++j) s2 += (x[j].x * x[j].x + x[j].y * x[j].y) + (x[j].z * x[j].z + x[j].w * x[j].w);
        s2 = wave_sum(s2); const float r2 = rsqrtf(s2 * (1.f / D) + EPS);
#pragma unroll
        for (int j = 0; j < 4; ++j) { const f32x4 w = ((const f32x4*)wh)[lane + 64 * j]; const f32x4 hv = x[j] * r2 * w;
            u32x2 o; o.x = pg8::cvt_pk_bf16(hv.x, hv.y); o.y = pg8::cvt_pk_bf16(hv.z, hv.w); ((u32x2*)(H + (size_t)m * D))[lane + 64 * j] = o; }
    }
#undef NR_LOAD
}

__device__ __forceinline__ void prologue(const DevArgs& A, LAS unsigned char* lds, int wave, int lane, int gw, int NGW) {
    LAS float* scr = (LAS float*)(lds + wave * 8704);
    constexpr int I_IN = 16 * 80, I_OUT = 16 * 32, I_GU = 16 * 176, I_DN = 44 * 32, I_GLU = 4 * 8, I_POOL = 8, PER = I_IN + I_OUT + I_GU + I_DN + I_GLU + I_POOL;
#pragma unroll 1
    for (int it = gw; it < DEPTH * PER; it += NGW) {
        const int l = it / PER; int r = it % PER;
        if (r < I_IN) { SrcIn s{A.in[I_WIN] + (size_t)l * D * INW}; transpose_item(s, D, (bf16_t*)(A.ws + WS_WIN + l * SZ_WIN), NPROJ / 32, scr, r, lane); continue; } r -= I_IN;
        if (r < I_OUT) { SrcPlain s{A.in[I_WOUT] + (size_t)l * D * D, D}; transpose_item(s, D, (bf16_t*)(A.ws + WS_WOUT + l * SZ_WOUT), D / 32, scr, r, lane); continue; } r -= I_OUT;
        if (r < I_GU) { SrcGU s{A.in[I_WG] + (size_t)l * D * DFF, A.in[I_WU] + (size_t)l * D * DFF}; transpose_item(s, D, (bf16_t*)(A.ws + WS_WGU + l * SZ_WGU), NGU / 32, scr, r, lane); continue; } r -= I_GU;
        if (r < I_DN) { SrcPlain s{A.in[I_WD] + (size_t)l * DFF * D, D}; transpose_item(s, DFF, (bf16_t*)(A.ws + WS_WDN + l * SZ_WDN), D / 32, scr, r, lane); continue; } r -= I_DN;
        if (r < I_GLU) { SrcPlain s{A.in[I_GLUW] + (size_t)l * 65536, 256}; transpose_item(s, 256, (bf16_t*)(A.ws + WS_GLUT + l * SZ_GLUT), 8, scr, r, lane); continue; } r -= I_GLU;
        { const int g = r >> 1; SrcPlain s{A.in[I_POOLW] + (size_t)(l * 4 + g) * 4096, 64}; transpose_item(s, 64, (bf16_t*)(A.ws + WS_POOLT + l * SZ_POOLT) + g * 4096, 2, scr, r & 1, lane); }
    }
    const int gt = gw * 64 + lane, NT = NGW * 64;
    float* wab = (float*)(A.ws + WS_WAB);
#pragma unroll 1
    for (int i = gt; i < DEPTH * 8 * D; i += NT) { const int l = i / (8 * D), j = (i / D) & 7, k = i % D; wab[i] = A.in[I_WIN][((size_t)l * D + k) * INW + 1536 + j]; }
    float* ssmk = (float*)(A.ws + WS_SSMK); float* bbar = (float*)(A.ws + WS_BBAR);
#pragma unroll 1
    for (int i = gt; i < DEPTH * 16 * 64; i += NT) {
        const int lg = i >> 6;
        const float dt = expf(A.in[I_LOGDT][lg]), ar = A.in[I_ARE][i], ai = A.in[I_AIM][i];
        const float mag = expf(ar * dt);
        float rev = ai * dt * 0.15915494309189535f; rev -= floorf(rev);
        const float sn = __builtin_amdgcn_sinf(rev), cs = __builtin_amdgcn_cosf(rev);
        const float lr = mag * cs, li = mag * sn;
        float pr = lr, pi = li;
#pragma unroll
        for (int q = 0; q < 6; ++q) { const float nr2 = pr * pr - pi * pi, ni2 = 2.f * pr * pi; pr = nr2; pi = ni2; }
        ssmk[i * 4 + 0] = lr; ssmk[i * 4 + 1] = li; ssmk[i * 4 + 2] = pr; ssmk[i * 4 + 3] = pi;
        const float nr = lr - 1.f, ni = li, d2 = ar * ar + ai * ai;
        const float cre = (nr * ar + ni * ai) / d2, cim = (ni * ar - nr * ai) / d2;
#pragma unroll
        for (int h = 0; h < 16; ++h) { const float br = A.in[I_BRE][(size_t)i * 16 + h], bi = A.in[I_BIM][(size_t)i * 16 + h];
            bbar[(size_t)i * 32 + h] = cre * br - cim * bi; bbar[(size_t)i * 32 + 16 + h] = cre * bi + cim * br; }
    }
}

__device__ __forceinline__ unsigned bfmul2(unsigned pk, float f0, float f1) { return pg8::cvt_pk_bf16(__uint_as_float(pk << 16) * f0, __uint_as_float(pk & 0xffff0000u) * f1); }
__device__ __forceinline__ void delta_prep_item(const DevArgs& A, int l, LAS unsigned char* lds, int item, int tid, int wave, int lane) {
    asm volatile("" : "+v"(tid)); lane = tid & 63; wave = __builtin_amdgcn_readfirstlane(tid >> 6);
    const int bh = item >> 5, n = item & 31, b = bh >> 2, h = bh & 3;
    const int tok0 = b * SEQ + n * 64;
    LAS bf16_t* QS = (LAS bf16_t*)(lds); LAS bf16_t* KS = (LAS bf16_t*)(lds + 17408);
    LAS unsigned char* KT = lds + 34816; LAS unsigned char* VT = lds + 53248; LAS unsigned char* RTK = lds + 71680;
    LAS float* AM = (LAS float*)(lds + 90112); LAS float* PM = (LAS float*)(lds + 107520); LAS float* PSC = PM; LAS float* TM = (LAS float*)(lds + 124928);
    LAS unsigned char* TB = lds + 142336;
    LAS float* GAM = (LAS float*)(lds + 151552); LAS float* BETA = GAM + 64; LAS float* RQ = GAM + 128; LAS float* RK = GAM + 192;
    LAS float* F2 = GAM + 256; LAS float* F3 = GAM + 320; LAS float* F4 = GAM + 384;
    const bf16_t* PROJ = (const bf16_t*)(A.ws + WS_PROJ);
    const float* AB = (const float*)(A.ws + WS_AB);
    u32x4 gv[2];
#pragma unroll
    for (int j = 0; j < 2; ++j) { const int id = tid + 512 * j; gv[j] = *(const u32x4*)(PROJ + (size_t)(tok0 + (id >> 4)) * NPROJ + PC_G + h * 128 + (id & 15) * 8); }
    if (tid < 384) {
        const int part = tid >> 7, c = tid & 127, col = part * 512 + h * 128 + c;
        const float* cw = A.in[I_CONVW] + (size_t)l * 4 * 1536;
        const float w0 = cw[col], w1 = cw[1536 + col], w2 = cw[3072 + col], w3 = cw[4608 + col];
        const bf16_t* pp = PROJ + (size_t)tok0 * NPROJ + col;
        float xr[67];
#pragma unroll
        for (int t = 0; t < 67; ++t) xr[t] = (n > 0 || t >= 3) ? bf2f(pp[(long)(t - 3) * NPROJ]) : 0.f;
        unsigned pk[32];
#pragma unroll
        for (int t = 0; t < 64; t += 2) {
            const float s0 = silu_f(w0 * xr[t] + w1 * xr[t + 1] + w2 * xr[t + 2] + w3 * xr[t + 3]);
            const float s1 = silu_f(w0 * xr[t + 1] + w1 * xr[t + 2] + w2 * xr[t + 3] + w3 * xr[t + 4]);
            pk[t >> 1] = pg8::cvt_pk_bf16(s0, s1);
        }
        if (part < 2) { LAS bf16_t* dst = (part == 0 ? QS : KS) + c;
#pragma unroll
            for (int t = 0; t < 64; t += 2) { dst[t * 136] = (bf16_t)(pk[t >> 1] & 0xffffu); dst[(t + 1) * 136] = (bf16_t)(pk[t >> 1] >> 16); } }
        if (part > 0) { LAS unsigned char* dst = (part == 1 ? KT : VT) + c * 144;
#pragma unroll
            for (int q = 0; q < 8; ++q) { u32x4 o; o.x = pk[4 * q]; o.y = pk[4 * q + 1]; o.z = pk[4 * q + 2]; o.w = pk[4 * q + 3]; *(LAS u32x4*)(dst + q * 16) = o; } }
    } else if (tid < 448) {
        const int t = tid - 384;
        const float a = AB[(size_t)(tok0 + t) * 8 + h], bb = AB[(size_t)(tok0 + t) * 8 + 4 + h];
        const float xx = a + A.in[I_DTB][l * 4 + h];
        const float sp = xx > 20.f ? xx : log1pf(expf(xx));
        float lg = -expf(A.in[I_ALOG][l * 4 + h]) * sp;
#pragma unroll
        for (int off = 1; off < 64; off <<= 1) { const float v = __shfl_up(lg, off); if (lane >= off) lg += v; }
        GAM[t] = lg; BETA[t] = 1.f / (1.f + expf(-bb));
    }
    __syncthreads();
    {
        const int t = tid >> 3, part = tid & 7; float sq = 0.f, sk = 0.f;
#pragma unroll
        for (int j = 0; j < 16; ++j) { const float q = bf2f(QS[t * 136 + part * 16 + j]), k = bf2f(KS[t * 136 + part * 16 + j]); sq += q * q; sk += k * k; }
        sq = row_sum8(sq); sk = row_sum8(sk);
        if (part == 0) { const float rq = rsqrtf(sq + EPS) * 0.08838834764831845f, rk = rsqrtf(sk + EPS), g = GAM[t], eg = __expf(g), bt = BETA[t];
            RQ[t] = rq; RK[t] = rk; F2[t] = bt * eg * rk; F3[t] = rk * __expf(GAM[63] - g); F4[t] = rq * eg; }
    }
    {
        const int prod = wave >> 2, mt = wave & 3, fr = lane & 15, quad = lane >> 4;
        LAS bf16_t* Aop = prod ? QS : KS; LAS float* dst = prod ? PM : AM;
        bf16x8 a[4];
#pragma unroll
        for (int kk = 0; kk < 4; ++kk) a[kk] = *(LAS bf16x8*)(Aop + (mt * 16 + fr) * 136 + kk * 32 + quad * 8);
#pragma unroll
        for (int nt = 0; nt < 4; ++nt) { f32x4 acc = {0.f, 0.f, 0.f, 0.f};
#pragma unroll
            for (int kk = 0; kk < 4; ++kk) { const bf16x8 bq = *(LAS bf16x8*)(KS + (nt * 16 + fr) * 136 + kk * 32 + quad * 8); acc = mfma16(a[kk], bq, acc); }
#pragma unroll
            for (int i = 0; i < 4; ++i) dst[(mt * 16 + quad * 4 + i) * 68 + nt * 16 + fr] = acc[i]; }
    }
    __syncthreads();
    {
        const int t = tid >> 3, s8 = (tid & 7) * 8; const float gt = GAM[t], bk = BETA[t] * RK[t], rqt = RQ[t];
        float av[8], pv[8];
#pragma unroll
        for (int j = 0; j < 8; ++j) { const int s = s8 + j; const float rks = RK[s]; const float dec = (s <= t) ? __expf(gt - GAM[s]) * rks : 0.f;
            av[j] = (s < t) ? bk * dec * AM[t * 68 + s] : 0.f; pv[j] = rqt * dec * PM[t * 68 + s]; }
#pragma unroll
        for (int j = 0; j < 8; ++j) AM[t * 68 + s8 + j] = av[j];
        u32x4 o; o.x = pg8::cvt_pk_bf16(pv[0], pv[1]); o.y = pg8::cvt_pk_bf16(pv[2], pv[3]); o.z = pg8::cvt_pk_bf16(pv[4], pv[5]); o.w = pg8::cvt_pk_bf16(pv[6], pv[7]);
        *(u32x4*)((bf16_t*)(A.ws + WS_DQK) + (size_t)item * 4096 + t * 64 + s8) = o;
        for (int e = tid; e < 64 * 68; e += 512) TM[e] = 0.f;
        if (tid == 0) ((float*)(A.ws + WS_DGL))[item] = __expf(GAM[63]);
    }
    __syncthreads();
    if (wave == 0) {
        const int i = lane >> 4, c = lane & 15;
        LAS float* amp = AM + (16 * i) * 68 + 16 * i; asm volatile("" : "+v"(amp));
        float x[16];
#pragma unroll
        for (int r = 0; r < 16; ++r) { float acc = (r == c) ? 1.f : 0.f;
#pragma unroll
            for (int s = 0; s < r; ++s) acc = fmaf(-amp[r * 68 + s], x[s], acc);
            x[r] = acc; }
        LAS float* tmp = TM + (16 * i) * 68 + 16 * i + c;
#pragma unroll
        for (int r = 0; r < 16; ++r) tmp[r * 68] = x[r];
    } else {
        const int wt = tid - 64;
        for (int id = wt; id < 1024; id += 448) {
            const int c = id >> 3, t8 = (id & 7) * 8;
            const f32x4 b0 = *(LAS f32x4*)(BETA + t8), b1 = *(LAS f32x4*)(BETA + t8 + 4);
            u32x4 v = *(LAS u32x4*)(VT + c * 144 + t8 * 2);
            v.x = bfmul2(v.x, b0[0], b0[1]); v.y = bfmul2(v.y, b0[2], b0[3]); v.z = bfmul2(v.z, b1[0], b1[1]); v.w = bfmul2(v.w, b1[2], b1[3]);
            *(LAS u32x4*)(VT + c * 144 + t8 * 2) = v;
            const f32x4 f20 = *(LAS f32x4*)(F2 + t8), f21 = *(LAS f32x4*)(F2 + t8 + 4), f30 = *(LAS f32x4*)(F3 + t8), f31 = *(LAS f32x4*)(F3 + t8 + 4);
            const u32x4 k = *(LAS u32x4*)(KT + c * 144 + t8 * 2);
            u32x4 rk; rk.x = bfmul2(k.x, f20[0], f20[1]); rk.y = bfmul2(k.y, f20[2], f20[3]); rk.z = bfmul2(k.z, f21[0], f21[1]); rk.w = bfmul2(k.w, f21[2], f21[3]);
            *(LAS u32x4*)(RTK + c * 144 + t8 * 2) = rk;
            u32x4 kd; kd.x = bfmul2(k.x, f30[0], f30[1]); kd.y = bfmul2(k.y, f30[2], f30[3]); kd.z = bfmul2(k.z, f31[0], f31[1]); kd.w = bfmul2(k.w, f31[2], f31[3]);
            *(u32x4*)((bf16_t*)(A.ws + WS_DKT) + (size_t)item * 8192 + c * 64 + t8) = kd; }
        for (int id = wt; id < 1024; id += 448) {
            const int t = id >> 4, c8 = (id & 15) * 8; const float f = F4[t];
            u32x4 q = *(LAS u32x4*)((LAS unsigned char*)QS + t * 272 + c8 * 2);
            q.x = bfmul2(q.x, f, f); q.y = bfmul2(q.y, f, f); q.z = bfmul2(q.z, f, f); q.w = bfmul2(q.w, f, f);
            *(u32x4*)((bf16_t*)(A.ws + WS_DQD) + (size_t)item * 8192 + t * 128 + c8) = q; }
    }
    {
        const int c8 = (tid & 15) * 8; const float* on = A.in[I_ONORM] + l * 128 + c8;
        const f32x4 o0 = *(const f32x4*)on, o1 = *(const f32x4*)(on + 4);
#pragma unroll
        for (int j = 0; j < 2; ++j) { const int id = tid + 512 * j; const u32x4 g = gv[j]; u32x4 o;
            o.x = pg8::cvt_pk_bf16(silu_f(__uint_as_float(g.x << 16)) * o0[0], silu_f(__uint_as_float(g.x & 0xffff0000u)) * o0[1]);
            o.y = pg8::cvt_pk_bf16(silu_f(__uint_as_float(g.y << 16)) * o0[2], silu_f(__uint_as_float(g.y & 0xffff0000u)) * o0[3]);
            o.z = pg8::cvt_pk_bf16(silu_f(__uint_as_float(g.z << 16)) * o1[0], silu_f(__uint_as_float(g.z & 0xffff0000u)) * o1[1]);
            o.w = pg8::cvt_pk_bf16(silu_f(__uint_as_float(g.w << 16)) * o1[2], silu_f(__uint_as_float(g.w & 0xffff0000u)) * o1[3]);
            *(u32x4*)((bf16_t*)(A.ws + WS_DGS) + (size_t)item * 8192 + (id >> 4) * 128 + c8) = o; }
    }
    __syncthreads();
    const int p2 = tid >> 8, r2 = (tid >> 4) & 15, c2 = tid & 15, rb = p2 ? 48 : 16, cb = p2 ? 32 : 0;
    {
        float acc = 0.f;
#pragma unroll
        for (int s = 0; s < 16; ++s) acc = fmaf(AM[(rb + r2) * 68 + cb + s], TM[(cb + s) * 68 + cb + c2], acc);
        PSC[(p2 * 16 + r2) * 68 + c2] = acc; }
    __syncthreads();
    {
        float acc = 0.f;
#pragma unroll
        for (int s = 0; s < 16; ++s) acc = fmaf(TM[(rb + r2) * 68 + rb + s], PSC[(p2 * 16 + s) * 68 + c2], acc);
        TM[(rb + r2) * 68 + cb + c2] = -acc; }
    __syncthreads();
    float p3[2];
#pragma unroll
    for (int j = 0; j < 2; ++j) { const int e = tid + 512 * j, r = e >> 5, c = e & 31; float acc = 0.f;
#pragma unroll 8
        for (int s = 0; s < 32; ++s) acc = fmaf(AM[(32 + r) * 68 + s], TM[s * 68 + c], acc);
        p3[j] = acc; }
    __syncthreads();
#pragma unroll
    for (int j = 0; j < 2; ++j) { const int e = tid + 512 * j; PSC[(e >> 5) * 68 + (e & 31)] = p3[j]; }
    __syncthreads();
#pragma unroll
    for (int j = 0; j < 2; ++j) { const int e = tid + 512 * j, r = e >> 5, c = e & 31; float acc = 0.f;
#pragma unroll 8
        for (int s = 0; s < 32; ++s) acc = fmaf(TM[(32 + r) * 68 + 32 + s], PSC[s * 68 + c], acc);
        p3[j] = -acc; }
#pragma unroll
    for (int j = 0; j < 2; ++j) { const int e = tid + 512 * j; TM[(32 + (e >> 5)) * 68 + (e & 31)] = p3[j]; }
    __syncthreads();
#pragma unroll
    for (int j = 0; j < 4; ++j) { const int e = tid + 512 * j, t = e >> 5, s2 = (e & 31) * 2;
        *(LAS unsigned*)(TB + t * 144 + s2 * 2) = pg8::cvt_pk_bf16(TM[t * 68 + s2], TM[t * 68 + s2 + 1]); }
    __syncthreads();
    {
        const int fr = lane & 15, quad = lane >> 4;
        bf16x8 bv[2], ak[2];
#pragma unroll
        for (int kk = 0; kk < 2; ++kk) { bv[kk] = *(LAS bf16x8*)(VT + (16 * wave + fr) * 144 + (kk * 32 + quad * 8) * 2); ak[kk] = *(LAS bf16x8*)(RTK + (16 * wave + fr) * 144 + (kk * 32 + quad * 8) * 2); }
        bf16_t* DW = (bf16_t*)(A.ws + WS_DW) + (size_t)item * 8192; bf16_t* DKC = (bf16_t*)(A.ws + WS_DKC) + (size_t)item * 8192;
#pragma unroll
        for (int mt = 0; mt < 4; ++mt) { f32x4 aw = {0.f, 0.f, 0.f, 0.f}, akc = {0.f, 0.f, 0.f, 0.f};
#pragma unroll
            for (int kk = 0; kk < 2; ++kk) { const bf16x8 tf = *(LAS bf16x8*)(TB + (mt * 16 + fr) * 144 + (kk * 32 + quad * 8) * 2);
                aw = mfma16(tf, bv[kk], aw);
                akc = mfma16(ak[kk], tf, akc); }
            u32x2 ow; ow.x = pk2(aw[0], aw[1]); ow.y = pk2(aw[2], aw[3]);
            *(u32x2*)(DW + (16 * wave + fr) * 64 + mt * 16 + quad * 4) = ow;
            u32x2 ok; ok.x = pk2(-akc[0], -akc[1]); ok.y = pk2(-akc[2], -akc[3]);
            *(u32x2*)(DKC + (mt * 16 + fr) * 128 + 16 * wave + quad * 4) = ok; }
    }
    __syncthreads();
}

__device__ __forceinline__ void delta_scan_item(const DevArgs& A, int l, LAS unsigned char* lds, int bh, int tid_in, int wave, int lane_in, const XcdBarrier& xb, int SUB) {
    const int b = bh >> 2, h = bh & 3;
    LAS unsigned char* KCs = lds; LAS unsigned char* QDs = lds + 17408; LAS unsigned char* QKs = lds + 34816; LAS unsigned char* KDTs = lds + 44032;
    LAS unsigned char* Ws = lds + 62464;
    LAS unsigned char* GSs = lds + 80896;
    LAS unsigned char* SS = lds + 98304 + wave * 4352; LAS unsigned char* US = lds + 133120 + wave * 2304;
    LAS float* PART = (LAS float*)(lds + 151552);
    const unsigned char* gW = A.ws + WS_DW; const unsigned char* gGS = A.ws + WS_DGS;
    const unsigned char* gKC = A.ws + WS_DKC; const unsigned char* gQD = A.ws + WS_DQD; const unsigned char* gQK = A.ws + WS_DQK; const unsigned char* gKT = A.ws + WS_DKT;
    const float* DGL = (const float*)(A.ws + WS_DGL);
    f32x4 S[8];
#pragma unroll
    for (int mt = 0; mt < 8; ++mt) S[mt] = (f32x4){0.f, 0.f, 0.f, 0.f};
    u32x4 r[9], rg[2];
    float gl_all = 0.f;
#define DS_LOAD(itn, toff) do { const size_t _i = (size_t)(itn); const unsigned char* _kc = gKC + _i * 16384; const unsigned char* _qd = gQD + _i * 16384; \
        const unsigned char* _qk = gQK + _i * 8192; const unsigned char* _kt = gKT + _i * 16384; \
        r[0] = *(const u32x4*)(_kc + (toff)); r[1] = *(const u32x4*)(_kc + (toff) + 8192u); \
        r[2] = *(const u32x4*)(_qd + (toff)); r[3] = *(const u32x4*)(_qd + (toff) + 8192u); \
        r[4] = *(const u32x4*)(_qk + (toff)); \
        r[5] = *(const u32x4*)(_kt + (toff)); r[6] = *(const u32x4*)(_kt + (toff) + 8192u); \
        const unsigned char* _w = gW + _i * 16384; r[7] = *(const u32x4*)(_w + (toff)); r[8] = *(const u32x4*)(_w + (toff) + 8192u); } while (0)
#define DS_LOADG(itn, toff) do { const unsigned char* _g = gGS + (size_t)(itn) * 16384; rg[0] = *(const u32x4*)(_g + (toff)); rg[1] = *(const u32x4*)(_g + (toff) + 8192u); } while (0)
#define DS_STAGE(tidv) do { const int i0 = (tidv), i1 = (tidv) + 512; \
          *(LAS u32x4*)(KCs + (i0 >> 4) * 272 + (i0 & 15) * 16) = r[0]; *(LAS u32x4*)(KCs + (i1 >> 4) * 272 + (i1 & 15) * 16) = r[1]; \
          *(LAS u32x4*)(QDs + (i0 >> 4) * 272 + (i0 & 15) * 16) = r[2]; *(LAS u32x4*)(QDs + (i1 >> 4) * 272 + (i1 & 15) * 16) = r[3]; \
          *(LAS u32x4*)(QKs + (i0 >> 3) * 144 + (i0 & 7) * 16) = r[4]; \
          *(LAS u32x4*)(KDTs + (i0 >> 3) * 144 + (i0 & 7) * 16) = r[5]; *(LAS u32x4*)(KDTs + (i1 >> 3) * 144 + (i1 & 7) * 16) = r[6]; \
          *(LAS u32x4*)(Ws + (i0 >> 3) * 144 + (i0 & 7) * 16) = r[7]; *(LAS u32x4*)(Ws + (i1 >> 3) * 144 + (i1 & 7) * 16) = r[8]; } while (0)
#define DS_STAGEG(tidv) do { const int i0 = (tidv), i1 = (tidv) + 512; \
          *(LAS u32x4*)(GSs + (i0 >> 4) * 272 + (i0 & 15) * 16) = rg[0]; *(LAS u32x4*)(GSs + (i1 >> 4) * 272 + (i1 & 15) * 16) = rg[1]; } while (0)
#pragma unroll 1
    for (int n = 0; n < 32; ++n) {
        int tid = tid_in; asm volatile("" : "+v"(tid));
        const bool bstart = (SUB > 0) ? (n % SUB == 0) : (n == 0);
        const bool bnext1 = (SUB > 0) && ((n + 1) % SUB == 0), bnext2 = (SUB > 0) && ((n + 2) % SUB == 0);
        if (bstart) { if (n > 0) xcd_barrier(xb);
            gl_all = DGL[bh * 32 + (tid & 31)];
            const unsigned t0 = (unsigned)tid * 16u; DS_LOAD(bh * 32 + n, t0); DS_LOADG(bh * 32 + n, t0); DS_STAGE(tid); DS_STAGEG(tid);
            if (n + 1 < 32 && !bnext1) { DS_LOAD(bh * 32 + n + 1, t0); DS_LOADG(bh * 32 + n + 1, t0); }
            __syncthreads(); }
        else { DS_STAGEG(tid);
            if (n + 1 < 32 && !bnext1) DS_LOADG(bh * 32 + n + 1, (unsigned)tid * 16u); }
        const int lane = tid & 63, fr = lane & 15, quad = lane >> 4, vcol = 16 * wave + fr;
        const unsigned toff = (unsigned)tid * 16u;
        const int it = bh * 32 + n, tokb = b * SEQ + n * 64;
        const float glast = __builtin_bit_cast(float, __builtin_amdgcn_readlane(__builtin_bit_cast(int, gl_all), n));
        asm volatile("s_nop 7\n\ts_nop 7" ::: "memory");
#pragma unroll
        for (int mt = 0; mt < 8; ++mt) { u32x2 p; p.x = pg8::cvt_pk_bf16(S[mt][0], S[mt][1]); p.y = pg8::cvt_pk_bf16(S[mt][2], S[mt][3]); *(LAS u32x2*)(SS + fr * 272 + (mt * 16 + quad * 4) * 2) = p; }
        LDS_FENCE();
        bf16x8 Sb[4];
#pragma unroll
        for (int kk = 0; kk < 4; ++kk) Sb[kk] = *(LAS bf16x8*)(SS + fr * 272 + (kk * 32 + quad * 8) * 2);
        f32x4 U[4], O[4];
#pragma unroll
        for (int mt = 0; mt < 4; ++mt) { f32x4 au, ao = {0.f, 0.f, 0.f, 0.f};
            { const u32x2 wq = *(LAS u32x2*)(Ws + vcol * 144 + (mt * 16 + quad * 4) * 2);
              au[0] = __uint_as_float(wq.x << 16); au[1] = __uint_as_float(wq.x & 0xffff0000u); au[2] = __uint_as_float(wq.y << 16); au[3] = __uint_as_float(wq.y & 0xffff0000u); }
#pragma unroll
            for (int kk = 0; kk < 4; ++kk) { const bf16x8 a1 = *(LAS bf16x8*)(KCs + (mt * 16 + fr) * 272 + (kk * 32 + quad * 8) * 2); au = mfma16(a1, Sb[kk], au);
                const bf16x8 a2 = *(LAS bf16x8*)(QDs + (mt * 16 + fr) * 272 + (kk * 32 + quad * 8) * 2); ao = mfma16(a2, Sb[kk], ao); }
            U[mt] = au; O[mt] = ao; __builtin_amdgcn_sched_barrier(0); }
        asm volatile("s_nop 7\n\ts_nop 7" ::: "memory");
#pragma unroll
        for (int mt = 0; mt < 4; ++mt) { u32x2 p; p.x = pg8::cvt_pk_bf16(U[mt][0], U[mt][1]); p.y = pg8::cvt_pk_bf16(U[mt][2], U[mt][3]); *(LAS u32x2*)(US + fr * 144 + (mt * 16 + quad * 4) * 2) = p; }
        LDS_FENCE();
        bf16x8 Ub[2];
#pragma unroll
        for (int kk = 0; kk < 2; ++kk) Ub[kk] = *(LAS bf16x8*)(US + fr * 144 + (kk * 32 + quad * 8) * 2);
#pragma unroll
        for (int mt = 0; mt < 4; ++mt)
#pragma unroll
            for (int kk = 0; kk < 2; ++kk) { const bf16x8 a = *(LAS bf16x8*)(QKs + (mt * 16 + fr) * 144 + (kk * 32 + quad * 8) * 2); O[mt] = mfma16(a, Ub[kk], O[mt]); }
        __builtin_amdgcn_sched_barrier(0);
#pragma unroll
        for (int mt = 0; mt < 8; ++mt) { S[mt] *= glast;
#pragma unroll
            for (int kk = 0; kk < 2; ++kk) { const bf16x8 a = *(LAS bf16x8*)(KDTs + (mt * 16 + fr) * 144 + (kk * 32 + quad * 8) * 2); S[mt] = mfma16(a, Ub[kk], S[mt]); }
            if (mt & 1) __builtin_amdgcn_sched_barrier(0); }
        { float pp[16];
#pragma unroll
          for (int e = 0; e < 16; ++e) pp[e] = O[e >> 2][e & 3] * O[e >> 2][e & 3];
#pragma unroll
          for (int e = 0; e < 16; ++e) pp[e] = row_sum16(pp[e]);
          if (fr == 0) {
#pragma unroll
              for (int e = 0; e < 16; ++e) PART[((e >> 2) * 16 + quad * 4 + (e & 3)) * 8 + wave] = pp[e]; } }
        __syncthreads();
        if (n + 1 < 32 && !bnext1) { DS_STAGE(tid); if (n + 2 < 32 && !bnext2) DS_LOAD(it + 2, toff); }
        bf16_t* mixb = (bf16_t*)(A.ws + WS_MIX) + (size_t)tokb * D + h * 128;
#pragma unroll
        for (int mt = 0; mt < 4; ++mt)
#pragma unroll
            for (int i = 0; i < 4; ++i) { const int t = mt * 16 + quad * 4 + i;
                const f32x4 p0 = *(LAS f32x4*)(PART + t * 8), p1 = *(LAS f32x4*)(PART + t * 8 + 4);
                const float tot = ((p0[0] + p0[1]) + (p0[2] + p0[3])) + ((p1[0] + p1[1]) + (p1[2] + p1[3]));
                const float sc = rsqrtf(tot * (1.f / 128.f) + EPS);
                const float gs = bf2f(*(LAS bf16_t*)(GSs + t * 272 + vcol * 2));
                mixb[(unsigned)(t * D + vcol)] = (bf16_t)(pg8::cvt_pk_bf16(O[mt][i] * sc * gs, 0.f) & 0xffffu); }
        __syncthreads();
    }
#undef DS_STAGE
#undef DS_LOADG
#undef DS_STAGEG
#undef DS_LOAD
    { const int lane = lane_in, fr = lane & 15, quad = lane >> 4, vcol = 16 * wave + fr;
      float* dp = A.out + O_DP + (size_t)((l * 8 + b) * 4 + h) * 16384;
#pragma unroll
      for (int mt = 0; mt < 8; ++mt)
#pragma unroll
          for (int i = 0; i < 4; ++i) dp[(mt * 16 + quad * 4 + i) * 128 + vcol] = S[mt][i]; }
    __syncthreads();
}

__device__ __forceinline__ void delta_sample_item(const DevArgs& A, int l, LAS unsigned char* lds, int item, int tid, int wave, int lane) {
    asm volatile("" : "+v"(tid)); lane = tid & 63; wave = __builtin_amdgcn_readfirstlane(tid >> 6);
    const int b = item >> 2, h = item & 3, tokS = NP + b * 4;
    LAS float* RAW = (LAS float*)lds; LAS float* RED = RAW + 1536; LAS float* OB = RED + 512; LAS float* SC = OB + 512;
    const bf16_t* PROJ = (const bf16_t*)(A.ws + WS_PROJ); const float* AB = (const float*)(A.ws + WS_AB); bf16_t* MIX = (bf16_t*)(A.ws + WS_MIX);
    const float* cw = A.in[I_CONVW] + (size_t)l * 4 * 1536;
    for (int idx = tid; idx < 1536; idx += 512) { const int part = idx >> 9, t = (idx >> 7) & 3, c = idx & 127, col = part * 512 + h * 128 + c;
        float acc = 0.f;
#pragma unroll
        for (int j = 0; j < 4; ++j) { const int tt = t - 3 + j;
            const float x = (tt >= 0) ? bf2f(PROJ[(size_t)(tokS + tt) * NPROJ + col]) : A.in[I_SCONV][((size_t)(l * 128 + b) * 3 + (3 + tt)) * 1536 + col];
            acc += cw[j * 1536 + col] * x; }
        RAW[idx] = silu_f(acc); }
    if (tid < 4) { const float a = AB[(size_t)(tokS + tid) * 8 + h], bb = AB[(size_t)(tokS + tid) * 8 + 4 + h];
        const float xx = a + A.in[I_DTB][l * 4 + h]; const float sp = xx > 20.f ? xx : log1pf(expf(xx));
        SC[8 + tid] = 1.f / (1.f + expf(-bb)); SC[12 + tid] = expf(-expf(A.in[I_ALOG][l * 4 + h]) * sp); }
    const int v = tid & 127, kq = tid >> 7;
    float S[32];
    { const float* sp = A.in[I_SDELTA] + (size_t)((l * 128 + b) * 4 + h) * 16384;
#pragma unroll
      for (int i = 0; i < 32; ++i) S[i] = sp[(kq * 32 + i) * 128 + v]; }
    __syncthreads();
    { const int part = wave >> 2, t = wave & 3; const float x0 = RAW[part * 512 + t * 128 + lane], x1 = RAW[part * 512 + t * 128 + 64 + lane];
      const float ss = wave_sum(x0 * x0 + x1 * x1); if (lane == 0) SC[part * 4 + t] = rsqrtf(ss + EPS) * (part == 0 ? 0.08838834764831845f : 1.f); }
    __syncthreads();
    for (int t = 0; t < 4; ++t) {
        const float rq = SC[t], rk = SC[4 + t], beta = SC[8 + t], g = SC[12 + t];
        float pr = 0.f;
#pragma unroll
        for (int i = 0; i < 32; ++i) pr += S[i] * RAW[512 + t * 128 + kq * 32 + i];
        RED[kq * 128 + v] = pr * rk;
        __syncthreads();
        const float rr = (RED[v] + RED[128 + v]) + (RED[256 + v] + RED[384 + v]);
        const float u = beta * (RAW[1024 + t * 128 + v] - g * rr);
        float po = 0.f;
#pragma unroll
        for (int i = 0; i < 32; ++i) { const float kh = RAW[512 + t * 128 + kq * 32 + i] * rk; S[i] = g * S[i] + kh * u; po += S[i] * RAW[t * 128 + kq * 32 + i]; }
        __syncthreads();
        RED[kq * 128 + v] = po * rq;
        __syncthreads();
        if (kq == 0) OB[t * 128 + v] = (RED[v] + RED[128 + v]) + (RED[256 + v] + RED[384 + v]);
        __syncthreads();
    }
    if (wave < 4) { const int t = wave; const float x0 = OB[t * 128 + lane], x1 = OB[t * 128 + 64 + lane];
        const float ss = wave_sum(x0 * x0 + x1 * x1); const float sc = rsqrtf(ss * (1.f / 128.f) + EPS);
        const float g0 = bf2f(PROJ[(size_t)(tokS + t) * NPROJ + PC_G + h * 128 + lane]), g1 = bf2f(PROJ[(size_t)(tokS + t) * NPROJ + PC_G + h * 128 + 64 + lane]);
        MIX[(size_t)(tokS + t) * D + h * 128 + lane] = (bf16_t)f2bf(x0 * sc * A.in[I_ONORM][l * 128 + lane] * silu_f(g0));
        MIX[(size_t)(tokS + t) * D + h * 128 + 64 + lane] = (bf16_t)f2bf(x1 * sc * A.in[I_ONORM][l * 128 + 64 + lane] * silu_f(g1)); }
    { float* dsp = A.out + O_DS + (size_t)((l * 128 + b) * 4 + h) * 16384;
#pragma unroll
      for (int i = 0; i < 32; ++i) dsp[(kq * 32 + i) * 128 + v] = S[i]; }
    __syncthreads();
}

#define SSM_BCAST_U(t) do { unsigned _w[8]; \
        _w[0] = __builtin_amdgcn_readlane(ua.x, t); _w[1] = __builtin_amdgcn_readlane(ua.y, t); _w[2] = __builtin_amdgcn_readlane(ua.z, t); _w[3] = __builtin_amdgcn_readlane(ua.w, t); \
        _w[4] = __builtin_amdgcn_readlane(ub.x, t); _w[5] = __builtin_amdgcn_readlane(ub.y, t); _w[6] = __builtin_amdgcn_readlane(ub.z, t); _w[7] = __builtin_amdgcn_readlane(ub.w, t); \
        _Pragma("unroll") for (int _d = 0; _d < 8; ++_d) { uu[2 * _d] = __uint_as_float(_w[_d] << 16); uu[2 * _d + 1] = __uint_as_float(_w[_d] & 0xffff0000u); } } while (0)
#define SSM_STEP() do { float _br = 0.f, _bi = 0.f; \
        _Pragma("unroll") for (int _h = 0; _h < 16; ++_h) { _br = fmaf(Br[_h], uu[_h], _br); _bi = fmaf(Bi[_h], uu[_h], _bi); } \
        const float _nr = lr * hr - li * hi + _br, _ni = lr * hi + li * hr + _bi; hr = _nr; hi = _ni; } while (0)

__device__ __forceinline__ void ssm_part1_item(const DevArgs& A, int l, int it, int lane) {
    const int g = it & 15, bc = it >> 4, b = bc / 31, c = bc % 31;
    const float* bb = (const float*)(A.ws + WS_BBAR) + ((size_t)(l * 16 + g) * 64 + lane) * 32;
    float Br[16], Bi[16];
#pragma unroll
    for (int q = 0; q < 4; ++q) { const f32x4 x = ((const f32x4*)bb)[q], y = ((const f32x4*)bb)[4 + q];
        Br[4 * q] = x.x; Br[4 * q + 1] = x.y; Br[4 * q + 2] = x.z; Br[4 * q + 3] = x.w; Bi[4 * q] = y.x; Bi[4 * q + 1] = y.y; Bi[4 * q + 2] = y.z; Bi[4 * q + 3] = y.w; }
    const f32x4 lk = ((const f32x4*)(A.ws + WS_SSMK))[(l * 16 + g) * 64 + lane]; const float lr = lk.x, li = lk.y;
    const bf16_t* up = (const bf16_t*)(A.ws + WS_PROJ) + (size_t)(b * SEQ + c * 64 + lane) * NPROJ + PC_SSM + g * 16;
    const u32x4 ua = *(const u32x4*)up, ub = *(const u32x4*)(up + 8);
    float hr = 0.f, hi = 0.f, uu[16];
#pragma unroll 1
    for (int t = 0; t < 64; ++t) { SSM_BCAST_U(t); SSM_STEP(); }
    f32x2 e; e.x = hr; e.y = hi;
    ((f32x2*)(A.ws + WS_SSME))[((size_t)(b * 32 + c) * 16 + g) * 64 + lane] = e;
}

__device__ __forceinline__ void ssm_part2_item(const DevArgs& A, int l, LAS unsigned char* lds, int it, int tid, int wave, int lane) {
    asm volatile("" : "+v"(tid)); lane = tid & 63; wave = __builtin_amdgcn_readfirstlane(tid >> 6);
    const int tok0 = it * 64, fr = lane & 15, quad = lane >> 4;
    const bool samp = it >= 256; const int b = it >> 5, c = it & 31;
    LAS unsigned char* YS = lds; LAS unsigned char* HS = lds + 33792 + wave * 4352;
    const bf16_t* PROJ = (const bf16_t*)(A.ws + WS_PROJ); bf16_t* MIX = (bf16_t*)(A.ws + WS_MIX);
#pragma unroll 1
    for (int gi = 0; gi < 2; ++gi) {
        const int g = wave * 2 + gi;
        const float* bb = (const float*)(A.ws + WS_BBAR) + ((size_t)(l * 16 + g) * 64 + lane) * 32;
        float Br[16], Bi[16];
#pragma unroll
        for (int q = 0; q < 4; ++q) { const f32x4 x = ((const f32x4*)bb)[q], y = ((const f32x4*)bb)[4 + q];
            Br[4 * q] = x.x; Br[4 * q + 1] = x.y; Br[4 * q + 2] = x.z; Br[4 * q + 3] = x.w; Bi[4 * q] = y.x; Bi[4 * q + 1] = y.y; Bi[4 * q + 2] = y.z; Bi[4 * q + 3] = y.w; }
        const f32x4 lk = ((const f32x4*)(A.ws + WS_SSMK))[(l * 16 + g) * 64 + lane]; const float lr = lk.x, li = lk.y, Lr = lk.z, Li = lk.w;
        bf16x8 Cb[4];
#pragma unroll
        for (int kk = 0; kk < 4; ++kk) { const size_t co = ((size_t)(l * 16 + g) * 16 + fr) * 64 + kk * 16 + quad * 4;
            const f32x4 cr = *(const f32x4*)(A.in[I_CRE] + co), ci = *(const f32x4*)(A.in[I_CIM] + co);
            u32x4 pk; pk.x = pk2(cr.x, -ci.x); pk.y = pk2(cr.y, -ci.y); pk.z = pk2(cr.z, -ci.z); pk.w = pk2(cr.w, -ci.w);
            Cb[kk] = __builtin_bit_cast(bf16x8, pk); }
        const bf16_t* up = PROJ + (size_t)(tok0 + lane) * NPROJ + PC_SSM + g * 16;
        const u32x4 ua = *(const u32x4*)up, ub = *(const u32x4*)(up + 8);
        float hr = 0.f, hi = 0.f, uu[16];
        if (!samp && c > 0) { const f32x2* E = (const f32x2*)(A.ws + WS_SSME) + ((size_t)(b * 32) * 16 + g) * 64 + lane;
#pragma unroll
            for (int cb = 0; cb < 32; cb += 16) { f32x2 ev[16];
#pragma unroll
                for (int q = 0; q < 16; ++q) { const int cc = cb + q; ev[q] = (cc < c) ? E[(size_t)cc * 1024] : (f32x2){0.f, 0.f}; }
#pragma unroll
                for (int q = 0; q < 16; ++q) { const int cc = cb + q; if (cc < c) { const float nr = Lr * hr - Li * hi + ev[q].x, ni = Lr * hi + Li * hr + ev[q].y; hr = nr; hi = ni; } } } }
        const float dsk = A.in[I_SSMD][l * 256 + g * 16 + fr];
        unsigned uvr[16];
#pragma unroll
        for (int e = 0; e < 16; ++e) uvr[e] = PROJ[(size_t)(tok0 + (e >> 2) * 16 + quad * 4 + (e & 3)) * NPROJ + PC_SSM + g * 16 + fr];
#pragma unroll
        for (int sub = 0; sub < 4; ++sub) {
#pragma unroll 1
            for (int tt = 0; tt < 16; ++tt) { const int t = sub * 16 + tt;
                const int sb = (it - 256) * 16 + (t >> 2);
                if (samp && (t & 3) == 0) { hr = A.in[I_SRE][((size_t)(l * 128 + sb) * 16 + g) * 64 + lane]; hi = A.in[I_SIM][((size_t)(l * 128 + sb) * 16 + g) * 64 + lane]; }
                SSM_BCAST_U(t); SSM_STEP();
                *(LAS unsigned*)(HS + tt * 272 + lane * 4) = pg8::cvt_pk_bf16(hr, hi);
                if (samp && (t & 3) == 3) { A.out[O_RES + ((size_t)(l * 128 + sb) * 16 + g) * 64 + lane] = hr; A.out[O_IMS + ((size_t)(l * 128 + sb) * 16 + g) * 64 + lane] = hi; }
            }
            LDS_FENCE();
            f32x4 acc = {0.f, 0.f, 0.f, 0.f};
#pragma unroll
            for (int kk = 0; kk < 4; ++kk) { const bf16x8 a = *(LAS bf16x8*)(HS + fr * 272 + (kk * 32 + quad * 8) * 2); acc = mfma16(a, Cb[kk], acc); }
#pragma unroll
            for (int i = 0; i < 4; ++i) { const int t = sub * 16 + quad * 4 + i; const float uv = bf2f(uvr[sub * 4 + i]);
                *(LAS bf16_t*)(YS + t * 528 + (g * 16 + fr) * 2) = (bf16_t)f2bf(gelu_tanh_f(acc[i] + dsk * uv)); }
            LDS_FENCE();
        }
        if (!samp && c == 31) { A.out[O_REP + ((size_t)(l * 8 + b) * 16 + g) * 64 + lane] = hr; A.out[O_IMP + ((size_t)(l * 8 + b) * 16 + g) * 64 + lane] = hi; }
    }
    __syncthreads();
    {
        const bf16_t* GT = (const bf16_t*)(A.ws + WS_GLUT + l * SZ_GLUT);
        f32x4 acc[4][2];
#pragma unroll
        for (int mt = 0; mt < 4; ++mt) { acc[mt][0] = (f32x4){0.f, 0.f, 0.f, 0.f}; acc[mt][1] = (f32x4){0.f, 0.f, 0.f, 0.f}; }
#pragma unroll
        for (int kk = 0; kk < 8; ++kk) { bf16x8 bfr[2];
#pragma unroll
            for (int nt = 0; nt < 2; ++nt) bfr[nt] = *(const bf16x8*)(GT + (size_t)(32 * wave + nt * 16 + fr) * 256 + kk * 32 + quad * 8);
#pragma unroll
            for (int mt = 0; mt < 4; ++mt) { const bf16x8 a = *(LAS bf16x8*)(YS + (mt * 16 + fr) * 528 + (kk * 32 + quad * 8) * 2);
                acc[mt][0] = mfma16(a, bfr[0], acc[mt][0]); acc[mt][1] = mfma16(a, bfr[1], acc[mt][1]); } }
#pragma unroll
        for (int nt = 0; nt < 2; ++nt) { const int ncol = 32 * wave + nt * 16 + fr; const float gb = A.in[I_GLUB][l * 256 + ncol];
#pragma unroll
            for (int mt = 0; mt < 4; ++mt)
#pragma unroll
                for (int i = 0; i < 4; ++i) { const int t = mt * 16 + quad * 4 + i; const float y = bf2f(*(LAS bf16_t*)(YS + t * 528 + ncol * 2));
                    MIX[(size_t)(tok0 + t) * D + 512 + ncol] = (bf16_t)f2bf(y * sigmoid_f(acc[mt][nt][i] + gb)); } }
    }
    __syncthreads();
}

__device__ __forceinline__ void pool_item(const DevArgs& A, int l, LAS unsigned char* lds, int it, int tid, int wave, int lane) {
    asm volatile("" : "+v"(tid)); lane = tid & 63; wave = __builtin_amdgcn_readfirstlane(tid >> 6);
    const int tok0 = it * 64, fr = lane & 15, quad = lane >> 4; const bool samp = it >= 256;
    LAS unsigned char* RS = lds;
    const bf16_t* PROJ = (const bf16_t*)(A.ws + WS_PROJ); bf16_t* MIX = (bf16_t*)(A.ws + WS_MIX);
    if (!samp) {
        LAS unsigned char* XT = lds + 33792;
        const int b = it >> 5, c = it & 31;
        for (int id = tid; id < 79 * 32; id += 512) { const int r = id >> 5, c16 = id & 31, tl = c * 64 - 15 + r;
            u32x4 v = {0u, 0u, 0u, 0u}; if (tl >= 0) v = *(const u32x4*)(PROJ + (size_t)(b * SEQ + tl) * NPROJ + PC_POOL + c16 * 8);
            *(LAS u32x4*)(XT + r * 528 + c16 * 16) = v; }
        __syncthreads();
        const int ch = tid & 255, half = tid >> 8, g = ch >> 6, w = 2 << g, r0 = half * 32;
        float sum = 0.f;
        for (int j = 0; j < w; ++j) sum += bf2f(*(LAS bf16_t*)(XT + (r0 + 15 - j) * 528 + ch * 2));
#pragma unroll 4
        for (int rr = 0; rr < 32; ++rr) { const int r = r0 + rr, tl = c * 64 + r;
            const float u = bf2f(*(LAS bf16_t*)(XT + (r + 15) * 528 + ch * 2));
            if (rr > 0) sum += u - bf2f(*(LAS bf16_t*)(XT + (r + 15 - w) * 528 + ch * 2));
            const float rc = __builtin_amdgcn_rcpf((float)((tl + 1 < w) ? tl + 1 : w));
            *(LAS bf16_t*)(RS + r * 528 + ch * 2) = (bf16_t)f2bf(sum * rc - u); }
    } else {
#pragma unroll 1
        for (int pr = 0; pr < 8; ++pr) { const int idx = pr * 512 + tid, ch = idx & 255, sq = idx >> 8, g = ch >> 6, w = 2 << g;
            const int sb = (it - 256) * 16 + sq;
            const float* sbuf = A.in[I_SPOOL] + (size_t)(l * 128 + sb) * 15 * 256 + ch;
            const bf16_t* base = PROJ + (size_t)(NP + sb * 4) * NPROJ + PC_POOL + ch;
            float e[19];
#pragma unroll
            for (int j = 0; j < 15; ++j) e[j] = sbuf[j * 256];
#pragma unroll
            for (int j = 0; j < 4; ++j) e[15 + j] = bf2f(base[(size_t)j * NPROJ]);
#pragma unroll
            for (int t = 0; t < 4; ++t) { float sum = 0.f;
#pragma unroll
                for (int j = 0; j < 16; ++j) sum += (j < w) ? e[15 + t - j] : 0.f;
                *(LAS bf16_t*)(RS + (sq * 4 + t) * 528 + ch * 2) = (bf16_t)f2bf(sum * __builtin_amdgcn_rcpf((float)w) - e[15 + t]); } }
    }
    __syncthreads();
    { const int g2 = wave >> 1; const bf16_t* PT = (const bf16_t*)(A.ws + WS_POOLT + l * SZ_POOLT) + g2 * 4096;
      f32x4 acc[4][2];
#pragma unroll
      for (int mt = 0; mt < 4; ++mt) { acc[mt][0] = (f32x4){0.f, 0.f, 0.f, 0.f}; acc[mt][1] = (f32x4){0.f, 0.f, 0.f, 0.f}; }
#pragma unroll
      for (int kk = 0; kk < 2; ++kk) { bf16x8 bfr[2];
#pragma unroll
          for (int nt = 0; nt < 2; ++nt) bfr[nt] = *(const bf16x8*)(PT + (size_t)((wave & 1) * 32 + nt * 16 + fr) * 64 + kk * 32 + quad * 8);
#pragma unroll
          for (int mt = 0; mt < 4; ++mt) { const bf16x8 a = *(LAS bf16x8*)(RS + (mt * 16 + fr) * 528 + (g2 * 64 + kk * 32 + quad * 8) * 2);
              acc[mt][0] = mfma16(a, bfr[0], acc[mt][0]); acc[mt][1] = mfma16(a, bfr[1], acc[mt][1]); } }
#pragma unroll
      for (int nt = 0; nt < 2; ++nt) { const int col = 32 * wave + nt * 16 + fr; const float ps = A.in[I_POOLS][l * 256 + col];
#pragma unroll
          for (int mt = 0; mt < 4; ++mt)
#pragma unroll
              for (int i = 0; i < 4; ++i) { const int t = mt * 16 + quad * 4 + i; MIX[(size_t)(tok0 + t) * D + 768 + col] = (bf16_t)f2bf(acc[mt][nt][i] * ps); } } }
    __syncthreads();
}

__device__ __forceinline__ void state_copies(const DevArgs& A, int l, int gt, int NT) {
    const bf16_t* PROJ = (const bf16_t*)(A.ws + WS_PROJ);
#pragma unroll 1
    for (int i = gt; i < 8 * 3 * 1536; i += NT) { const int col = i % 1536, j = (i / 1536) % 3, b = i / 4608;
        A.out[O_CP + (size_t)l * 8 * 4608 + i] = bf2f(PROJ[(size_t)(b * SEQ + SEQ - 3 + j) * NPROJ + col]); }
#pragma unroll 1
    for (int i = gt; i < 128 * 3 * 1536; i += NT) { const int col = i % 1536, j = (i / 1536) % 3, b = i / 4608;
        A.out[O_CS + (size_t)l * 128 * 4608 + i] = bf2f(PROJ[(size_t)(NP + b * 4 + 1 + j) * NPROJ + col]); }
#pragma unroll 1
    for (int i = gt; i < 8 * 15 * 256; i += NT) { const int ch = i & 255, j = (i >> 8) % 15, b = i / 3840;
        A.out[O_PP + (size_t)l * 8 * 3840 + i] = bf2f(PROJ[(size_t)(b * SEQ + SEQ - 15 + j) * NPROJ + PC_POOL + ch]); }
#pragma unroll 1
    for (int i = gt; i < 128 * 15 * 256; i += NT) { const int ch = i & 255, j = (i >> 8) % 15, b = i / 3840;
        A.out[O_PS + (size_t)l * 128 * 3840 + i] = (j < 11) ? A.in[I_SPOOL][((size_t)(l * 128 + b) * 15 + 4 + j) * 256 + ch]
                                                             : bf2f(PROJ[(size_t)(NP + b * 4 + (j - 11)) * NPROJ + PC_POOL + ch]); }
}

#ifndef REP_DPREP
#define REP_DPREP 1
#endif
#ifndef REP_DSAMP
#define REP_DSAMP 1
#endif
#ifndef REP_SSM1
#define REP_SSM1 1
#endif
#ifndef REP_POOL
#define REP_POOL 1
#endif
#ifndef REP_DSCAN
#define REP_DSCAN 1
#endif
#ifndef REP_SSM2
#define REP_SSM2 1
#endif
#ifndef REP_G
#define REP_G 1
#endif
#ifndef REP_P3
#define REP_P3 1
#endif
#ifndef REP_P2
#define REP_P2 1
#endif
constexpr int NPH = 2 + DEPTH * 8;
__global__ void __launch_bounds__(512, 2) mega_fwd(Args KA) {
    DevArgs A; A.out = KA.out; A.ws = KA.ws; A.ph_lo = KA.ph_lo; A.ph_hi = KA.ph_hi;
    extern __shared__ __attribute__((aligned(16))) unsigned char lds_raw[];
    LAS unsigned char* lds = (LAS unsigned char*)lds_raw;
    cg::grid_group grid = cg::this_grid();
    volatile LAS unsigned* xst = (volatile LAS unsigned*)(lds + LDS_BYTES - 64);
    if (threadIdx.x == 0) { xst[0] = 0u; xst[1] = 0u; }
    __syncthreads();
    const XcdBarrier xb = xcd_barrier_post((unsigned*)(KA.ws + WS_BAR), xst);
    constexpr int G = 256, NGW = G * 8, NT = G * 512;
    int ph = 0;
#define PH_BEGIN if (A.ph_lo <= ph && ph < A.ph_hi) { int tid = threadIdx.x; asm volatile("" : "+v"(tid)); { unsigned char* _w = A.ws; asm volatile("" : "+s"(_w)); A.ws = _w; float* _o = A.out; asm volatile("" : "+s"(_o)); A.out = _o; } const int wave = __builtin_amdgcn_readfirstlane(tid >> 6), lane = tid & 63, gw = blockIdx.x * 8 + wave, gt = blockIdx.x * 512 + tid; (void)gw; (void)gt; (void)lane;
#define PH_END   if (ph + 1 < A.ph_hi) { if (ph == 0) grid.sync(); else xcd_barrier(xb); } } ++ph;
#define Hb   ((bf16_t*)(A.ws + WS_H))
#define AB   ((float*)(A.ws + WS_AB))
#define MIXO ((float*)(A.ws + WS_MIXO))
#define PROJ ((bf16_t*)(A.ws + WS_PROJ))
#define MIX  ((bf16_t*)(A.ws + WS_MIX))
#define HID  ((bf16_t*)(A.ws + WS_HID))
#define XBUF ((bf16_t*)(A.ws + WS_MIXO + (size_t)NTOK * D * 2))

#ifndef REP_PRO
#define REP_PRO 1
#endif
#ifndef REP_N0
#define REP_N0 1
#endif
    PH_BEGIN for (int rep = 0; rep < REP_PRO; ++rep) { prologue(A, lds, wave, lane, gw, NGW); __syncthreads(); } PH_END
    PH_BEGIN for (int rep = 0; rep < REP_N0; ++rep) norm_rows(nullptr, nullptr, A.in[I_XP], A.in[I_XS], nullptr, A.in[I_NMPRE], Hb, (const float*)(A.ws + WS_WAB), AB, gw, NGW, lane, nullptr, 0, nullptr, XBUF); PH_END

#pragma unroll 1
    for (int l = 0; l < DEPTH; ++l) {
        PH_BEGIN for (int rep = 0; rep < REP_G; ++rep) { pg8::Gemm g{Hb, (const bf16_t*)(A.ws + WS_WIN + l * SZ_WIN), NTOK, NPROJ, D, D, D}; pg8::StaticOrder S; S.init(NTOK, NPROJ, G, (int)blockIdx.x);
            pg8::EpiBf16<0> E{PROJ, NPROJ, nullptr, 0, 0}; pg8::gemm_phase<pg8::EpiBf16<0>, pg8::StaticOrder>(lds, g, S, E, nullptr); } PH_END
        constexpr int SUBC = 7;
        PH_BEGIN {
#pragma unroll 1
          for (int rep2 = 0; rep2 < REP_P2; ++rep2) {
#pragma unroll 1
            for (int j = blockIdx.x; j < 32 * SUBC; j += G) delta_prep_item(A, l, lds, (j & 31) * 32 + (j >> 5), tid, wave, lane);
          }
        } PH_END
        PH_BEGIN {
#pragma unroll 1
            for (int rep3 = 0; rep3 < REP_P3; ++rep3) {
                if (blockIdx.x < 32) delta_scan_item(A, l, lds, blockIdx.x, tid, wave, lane, xb, SUBC);
                else { const int w = blockIdx.x - 32; constexpr int NW = G - 32;
#pragma unroll 1
                    for (int k = 1; k <= 5; ++k) {
                        const int n0 = k * SUBC, nn = (n0 >= 32) ? 0 : ((32 - n0 < SUBC) ? 32 - n0 : SUBC);
                        int nprep = 32 * nn;
#ifndef REP_WPREP
#define REP_WPREP 1
#endif
#pragma unroll 1
                        for (int rep = 0; rep < REP_WPREP; ++rep)
#pragma unroll 1
                        for (int j = w; j < nprep; j += NW) delta_prep_item(A, l, lds, (j & 31) * 32 + n0 + (j >> 5), tid, wave, lane);
                        if (k == 1) {
#pragma unroll 1
                            for (int it = w; it < 512; it += NW) delta_sample_item(A, l, lds, it, tid, wave, lane); }
                        if (k == 2) {
#pragma unroll 1
                            for (int it = w * 8 + wave; it < 8 * 31 * 16; it += NW * 8) { int t1 = threadIdx.x; asm volatile("" : "+v"(t1)); ssm_part1_item(A, l, it, t1 & 63); }
                            { int t2 = threadIdx.x; asm volatile("" : "+v"(t2)); int wl = blockIdx.x; asm volatile("" : "+s"(wl)); state_copies(A, l, (wl - 32) * 512 + t2, NW * 512); } }
                        if (k == 3) {
#pragma unroll 1
                            for (int it = w; it < 264; it += NW) pool_item(A, l, lds, it, tid, wave, lane); }
                        { const int it = (k == 4) ? w - 128 : ((k == 5) ? 96 + w : -1);
                          if (it >= 0 && it < ((k == 4) ? 96 : 264)) ssm_part2_item(A, l, lds, it, tid, wave, lane); }
                        if (k < 5) xcd_barrier(xb);
                    } }
            }
        } PH_END
        PH_BEGIN for (int rep = 0; rep < REP_G; ++rep) { pg8::Gemm g{MIX, (const bf16_t*)(A.ws + WS_WOUT + l * SZ_WOUT), NP, D, D, D, D}; pg8::StaticOrder S; S.init(NP, D, G, (int)blockIdx.x);
            pg8::EpiBf16<0> E{(bf16_t*)MIXO, D, nullptr, 0, 0}; pg8::gemm_phase<pg8::EpiBf16<0>, pg8::StaticOrder>(lds, g, S, E, nullptr);
            pg8::Gemm g2{MIX + (size_t)NP * D, (const bf16_t*)(A.ws + WS_WOUT + l * SZ_WOUT), NS, D, 256, D, D}; SliceOrder S2{8 * (D / 256), G, (int)blockIdx.x};
            EpiF32Part E2{(float*)(A.ws + WS_PARTS)}; pg8::gemm_phase<EpiF32Part, SliceOrder>(lds, g2, S2, E2, nullptr); } PH_END
#ifndef REP_N5
#define REP_N5 1
#endif
        PH_BEGIN norm_rows_pf(MIXO, A.in[I_NMPOST] + l * D, XBUF, A.in[I_NFPRE] + l * D, Hb, gw, NGW, lane, (const float*)(A.ws + WS_PARTS), D / 256); PH_END
        PH_BEGIN for (int rep = 0; rep < REP_G; ++rep) { pg8::Gemm g{Hb, (const bf16_t*)(A.ws + WS_WGU + l * SZ_WGU), NTOK, NGU, D, D, D}; pg8::StaticOrder S; S.init(NTOK, NGU, G, (int)blockIdx.x);
            EpiSwiGLU E{HID, DFF}; pg8::gemm_phase<EpiSwiGLU, pg8::StaticOrder>(lds, g, S, E, nullptr); } PH_END
        PH_BEGIN for (int rep = 0; rep < REP_G; ++rep) { pg8::Gemm g{HID, (const bf16_t*)(A.ws + WS_WDN + l * SZ_WDN), NP, D, DFF, DFF, DFF}; pg8::StaticOrder S; S.init(NP, D, G, (int)blockIdx.x);
            pg8::EpiBf16<0> E{(bf16_t*)MIXO, D, nullptr, 0, 0}; pg8::gemm_phase<pg8::EpiBf16<0>, pg8::StaticOrder>(lds, g, S, E, nullptr);
            pg8::Gemm g2{HID + (size_t)NP * DFF, (const bf16_t*)(A.ws + WS_WDN + l * SZ_WDN), NS, D, 256, DFF, DFF}; SliceOrder S2{8 * (DFF / 256), G, (int)blockIdx.x};
            EpiF32Part E2{(float*)(A.ws + WS_PARTS)}; pg8::gemm_phase<EpiF32Part, SliceOrder>(lds, g2, S2, E2, nullptr); } PH_END
        PH_BEGIN norm_rows(MIXO, A.in[I_NFPOST] + l * D, nullptr, nullptr, l + 1 < DEPTH ? nullptr : A.out, l + 1 < DEPTH ? A.in[I_NMPRE] + (l + 1) * D : nullptr, l + 1 < DEPTH ? Hb : nullptr,
                           l + 1 < DEPTH ? (const float*)(A.ws + WS_WAB + (l + 1) * SZ_WAB) : nullptr, AB, gw, NGW, lane, (const float*)(A.ws + WS_PARTS), DFF / 256,
                           XBUF, l + 1 < DEPTH ? XBUF : nullptr); PH_END
    }
#undef PH_BEGIN
#undef PH_END
#undef Hb
#undef AB
#undef MIXO
#undef PROJ
#undef MIX
#undef HID
#undef XBUF
}

extern "C" void kernel_launch(void* const* d_in, const int* in_sizes, int n_in, void* d_out, int out_size, void* d_ws, size_t ws_size, hipStream_t stream) {
    static int grid = 0;
    if (grid == 0) {
        if (n_in != 32 || (size_t)out_size != O_END || ws_size < WS_END) fprintf(stderr, "kernel_launch: unexpected sizes: n_in %d out %d (want %zu) ws %zu (want >= %zu)\n", n_in, out_size, (size_t)O_END, ws_size, (size_t)WS_END);
        int dev = 0, cus = 0, per_cu = 0;
        (void)hipGetDevice(&dev); (void)hipDeviceGetAttribute(&cus, hipDeviceAttributeMultiprocessorCount, dev);
        if (hipFuncSetAttribute((const void*)mega_fwd, hipFuncAttributeMaxDynamicSharedMemorySize, LDS_BYTES) != hipSuccess) fprintf(stderr, "kernel_launch: hipFuncSetAttribute failed\n");
        if (hipOccupancyMaxActiveBlocksPerMultiprocessor(&per_cu, (const void*)mega_fwd, 512, LDS_BYTES) != hipSuccess || per_cu < 1) { fprintf(stderr, "kernel_launch: occupancy query gave %d\n", per_cu); per_cu = 1; (void)hipGetLastError(); }
        grid = cus * per_cu; if (grid <= 0) grid = 256;
        if (grid >= 256) grid = 256;
        fprintf(stderr, "kernel_launch: grid %d (cus %d x %d)%s\n", grid, cus, per_cu, grid < 256 ? "  ERROR: this build needs >= 256 co-resident workgroups" : "");
    }
    (void)hipMemsetAsync((unsigned char*)d_ws + WS_BAR, 0, 16384, stream);
    Args a{};
    for (int i = 0; i < 32; ++i) a.in[i] = (const float*)d_in[i];
    a.out = (float*)d_out; a.ws = (unsigned char*)d_ws;
#if MK_COOP
    a.ph_lo = 0; a.ph_hi = NPH;
    void* args[] = {&a};
    const hipError_t e = hipLaunchCooperativeKernel((const void*)mega_fwd, dim3(grid), dim3(512), args, LDS_BYTES, stream);
    if (e != hipSuccess) fprintf(stderr, "kernel_launch: cooperative launch failed: %s (grid %d)\n", hipGetErrorString(e), grid);
#else
    for (int p = 0; p < NPH; ++p) { a.ph_lo = p; a.ph_hi = p + 1; hipLaunchKernelGGL(mega_fwd, dim3(grid), dim3(512), LDS_BYTES, stream, a); }
#endif
}
```

```cpp
#include <hip/hip_runtime.h>
#include <hip/hip_cooperative_groups.h>
#include <cstdio>
#include <cstdint>
namespace cg = cooperative_groups;
#ifndef MK_COOP
#define MK_COOP 1
#endif
namespace pg8 {
#define PG8_LAS __attribute__((address_space(3)))
typedef unsigned short bf16_t;
typedef short bf16x8 __attribute__((ext_vector_type(8)));
typedef float f32x4 __attribute__((ext_vector_type(4)));
typedef unsigned u32x4 __attribute__((ext_vector_type(4)));
constexpr int BM = 256, BK = 64, HALF = 128, HTB = HALF * BK * 2  , STAGE_BYTES = 8 * HTB, NXCD = 8, WGM = 8;

__host__ __device__ __forceinline__ int lds_byte(int r, int c) { const int st = (r >> 4) * 2 + (c >> 5), rr = r & 15, cc = c & 31, ob = rr * 64 + cc * 2; return st * 1024 + (ob ^ (((ob >> 9) & 1) << 5)); }
__host__ __device__ __forceinline__ void stage_rc(int b, int& R, int& C) { const int st = b / 1024, sb = b % 1024, swz = sb ^ (((sb >> 9) & 1) << 5); R = (st >> 1) * 16 + swz / 64; C = (st & 1) * 32 + (swz % 64) / 2; }
__host__ __device__ __forceinline__ int perm32(int rho) { const int n = rho >> 4, i = rho & 15; return 8 * (i >> 2) + 4 * n + (i & 3); }

struct Unit { int pm, pn, ks; };
struct Gemm { const bf16_t* A; const bf16_t* Bt; int M, N, K, lda, ldb; };

struct StaticOrder {
    int nM, nN, nwg, G, c;
    __host__ __device__ void init(int M, int N, int G_, int c_) { nM = M / BM; nN = N / BM; nwg = nM * nN; G = G_; c = c_; }
    __host__ __device__ bool next(int i, Unit& u) const {
        const long L = (long)i * G + c; if (L >= nwg) return false;
        int wgid = (int)L; { const int q = nwg / NXCD, r = nwg % NXCD, xcd = wgid % NXCD, off = wgid / NXCD; wgid = (xcd < r ? xcd * (q + 1) : r * (q + 1) + (xcd - r) * q) + off; }
        const int nig = WGM * nN, gid = wgid / nig, fm = gid * WGM, gsz = (nM - fm) < WGM ? (nM - fm) : WGM;
        u.pm = fm + ((wgid % nig) % gsz); u.pn = (wgid % nig) / gsz; u.ks = 0; return true;
    }
    __device__ __forceinline__ void a_ready(const Unit&) const {}
    __device__ __forceinline__ void done(const Unit&) const {}
};
__device__ __forceinline__ unsigned cvt_pk_bf16(float lo, float hi) { unsigned r; asm volatile("v_cvt_pk_bf16_f32 %0, %1, %2" : "=v"(r) : "v"(lo), "v"(hi)); return r; }
typedef float f32x2 __attribute__((ext_vector_type(2)));
__device__ __forceinline__ f32x2 gelu_pk(f32x2 v) {
    const f32x2 av = __builtin_elementwise_abs(v), d = av * 0.2316418882f + 1.0f;
    f32x2 t; t.x = __builtin_amdgcn_rcpf(d.x); t.y = __builtin_amdgcn_rcpf(d.y);
    f32x2 q = t * 0.5307027145f + (-0.7265760135f); q = q * t + 0.7107068705f; q = q * t + (-0.142248368f); q = q * t + 0.127414796f; q = q * t;
    const f32x2 s = (v * v) * (-0.72134752044f);
    f32x2 e; e.x = __builtin_amdgcn_exp2f(s.x); e.y = __builtin_amdgcn_exp2f(s.y);
    const f32x2 m = v * (q * e), r = v - m;
    f32x2 o; o.x = v.x < 0.f ? m.x : r.x; o.y = v.y < 0.f ? m.y : r.y; return o;
}

struct EpiF32 {
    static constexpr bool PERM = false, AFTER_DRAIN = false;
    float* C; int ldc; const float* bias;
    __device__ __forceinline__ void operator()(const f32x4 (&acc)[2][2][4][2], const Unit& u, int wr, int wc, int fr, int fq) const {
        const int row0 = u.pm * BM + wr * 64 + fr, col0 = u.pn * BM + wc * 32 + 4 * fq;
        f32x4 bv[2][2];
#pragma unroll
        for (int bj = 0; bj < 2; ++bj)
#pragma unroll
            for (int n = 0; n < 2; ++n) bv[bj][n] = bias ? *(const f32x4*)(bias + col0 + bj * HALF + n * 16) : (f32x4){0.f, 0.f, 0.f, 0.f};
#pragma unroll
        for (int ai = 0; ai < 2; ++ai)
#pragma unroll
            for (int m = 0; m < 4; ++m) { float* rowp = C + (size_t)(row0 + ai * HALF + m * 16) * ldc + col0;
#pragma unroll
                for (int bj = 0; bj < 2; ++bj)
#pragma unroll
                    for (int n = 0; n < 2; ++n) *(f32x4*)(rowp + bj * HALF + n * 16) = acc[ai][bj][m][n] + bv[bj][n]; }
    }
};
template <int ACT  > struct EpiBf16 {
    static constexpr bool PERM = true, AFTER_DRAIN = false;
    bf16_t* O; int ldc; const float* bias; int split_cols; size_t split_stride;
    __device__ __forceinline__ void operator()(const f32x4 (&acc)[2][2][4][2], const Unit& u, int wr, int wc, int fr, int fq) const {
        const int row0 = u.pm * BM + wr * 64 + fr; int colt = u.pn * BM; bf16_t* base = O;
        if (split_cols) { const int t = colt / split_cols; base += (size_t)t * split_stride; colt -= t * split_cols; }
        const int col0 = colt + wc * 32 + 8 * fq, bcol0 = u.pn * BM + wc * 32 + 8 * fq;
        f32x4 bv[2][2];
#pragma unroll
        for (int bj = 0; bj < 2; ++bj)
#pragma unroll
            for (int n = 0; n < 2; ++n) bv[bj][n] = bias ? *(const f32x4*)(bias + bcol0 + bj * HALF + 4 * n) : (f32x4){0.f, 0.f, 0.f, 0.f};
#pragma unroll
        for (int ai = 0; ai < 2; ++ai)
#pragma unroll
            for (int m = 0; m < 4; ++m) { bf16_t* rowp = base + (size_t)(row0 + ai * HALF + m * 16) * ldc + col0;
#pragma unroll
                for (int bj = 0; bj < 2; ++bj) { f32x4 v0 = acc[ai][bj][m][0] + bv[bj][0], v1 = acc[ai][bj][m][1] + bv[bj][1];
                    if (ACT == 1) { f32x2 a = gelu_pk((f32x2){v0[0], v0[1]}), b = gelu_pk((f32x2){v0[2], v0[3]}), c = gelu_pk((f32x2){v1[0], v1[1]}), d = gelu_pk((f32x2){v1[2], v1[3]});
                        v0 = (f32x4){a.x, a.y, b.x, b.y}; v1 = (f32x4){c.x, c.y, d.x, d.y}; }
                    if (ACT == 2) {
#pragma unroll
                        for (int j = 0; j < 4; ++j) { v0[j] = 0.5f * v0[j] * (1.0f + erff(v0[j] * 0.70710678f)); v1[j] = 0.5f * v1[j] * (1.0f + erff(v1[j] * 0.70710678f)); } }
                    u32x4 w; w.x = cvt_pk_bf16(v0[0], v0[1]); w.y = cvt_pk_bf16(v0[2], v0[3]); w.z = cvt_pk_bf16(v1[0], v1[1]); w.w = cvt_pk_bf16(v1[2], v1[3]);
                    *(u32x4*)(rowp + bj * HALF) = w; } }
    }
};
template <class Epi, class Sched, bool STAMP = false>
__device__ __forceinline__ void gemm_phase(PG8_LAS unsigned char* lds, const Gemm g, const Sched& S, const Epi& E, unsigned long long* stamps) {
    int tid_ = threadIdx.x; asm volatile("" : "+v"(tid_));
    const int tid = tid_, wid = __builtin_amdgcn_readfirstlane(tid >> 6), lane = tid & 63, wr = wid >> 2, wc = wid & 3, fr = lane & 15, fq = lane >> 4;
    const int K = g.K, nt = K / BK;
    int ts_lo = 0, ts_hi = 0, nts = 0; const unsigned long long rt_entry = STAMP ? (unsigned long long)wall_clock64() : 0ull;
#define PG8_STAMP() do { if (STAMP && wid == 0 && nts < 64) { const unsigned long long _c = (unsigned long long)clock64(); \
        ts_lo = (lane == nts) ? (int)(unsigned)_c : ts_lo; ts_hi = (lane == nts) ? (int)(unsigned)(_c >> 32) : ts_hi; ++nts; } } while (0)
    PG8_STAMP();
    unsigned voffA[2], voffB[2];
#pragma unroll
    for (int i = 0; i < 2; ++i) { int R, C; stage_rc(tid * 16 + i * 8192, R, C); const int Rb = Epi::PERM ? ((R & ~31) + perm32(R & 31)) : R;
        voffA[i] = (unsigned)(R * g.lda + C) * 2u; voffB[i] = (unsigned)(Rb * g.ldb + C) * 2u; }
    const size_t kstep = (size_t)(BK * 2);
    const size_t hstepA = (size_t)HALF * g.lda * 2, hstepB = (size_t)HALF * g.ldb * 2;
    const size_t tstepA = 2 * hstepA, tstepB = 2 * hstepB, sstep = (size_t)K * 2;
    const unsigned ldsw = (unsigned)wid * 1024u;
    const int aoff = lds_byte(wr * 64 + fr, fq * 8), boff = lds_byte(wc * 32 + fr, fq * 8);
#define PG8_SA(b, h) (((b) * 2 + (h)) * HTB)
#define PG8_SB(b, h) ((4 + (b) * 2 + (h)) * HTB)
#define PG8_STAGE(bufoff, gbase, voff) do { _Pragma("unroll") for (int _i = 0; _i < 2; ++_i) \
        __builtin_amdgcn_global_load_lds((const unsigned*)((const char*)(gbase) + (voff)[_i]), (PG8_LAS unsigned*)(lds + (bufoff) + ldsw + _i * 8192), 16, 0, 0); } while (0)
#define PG8_LDA(dst, b, h) do { _Pragma("unroll") for (int m = 0; m < 4; ++m) _Pragma("unroll") for (int k = 0; k < 2; ++k) dst[m][k] = *(const PG8_LAS bf16x8*)(lds + PG8_SA(b, h) + aoff + m * 2048 + k * 1024); } while (0)
#define PG8_LDB(dst, b, h) do { _Pragma("unroll") for (int n = 0; n < 2; ++n) _Pragma("unroll") for (int k = 0; k < 2; ++k) dst[n][k] = *(const PG8_LAS bf16x8*)(lds + PG8_SB(b, h) + boff + n * 2048 + k * 1024); } while (0)
#define PG8_MMA(ai, bj, At, Bt) do { __builtin_amdgcn_s_setprio(1); _Pragma("unroll") for (int m = 0; m < 4; ++m) _Pragma("unroll") for (int n = 0; n < 2; ++n) _Pragma("unroll") for (int k = 0; k < 2; ++k) \
        acc[ai][bj][m][n] = __builtin_amdgcn_mfma_f32_16x16x32_bf16(Bt[n][k], At[m][k], acc[ai][bj][m][n], 0, 0, 0); __builtin_amdgcn_s_setprio(0); } while (0)
#define PG8_WAIT_V(n) asm volatile("s_waitcnt vmcnt(" #n ")" ::: "memory")
#define PG8_WAIT_L(n) asm volatile("s_waitcnt lgkmcnt(" #n ")" ::: "memory")
#define PG8_BAR __builtin_amdgcn_s_barrier()
#define PG8_SCHED __builtin_amdgcn_sched_barrier(0)
    Unit cur, nxt; int ui = 0;
    if (!S.next(0, cur)) return;
    f32x4 acc[2][2][4][2];
#pragma unroll
    for (int a = 0; a < 2; ++a)
#pragma unroll
        for (int b = 0; b < 2; ++b)
#pragma unroll
            for (int m = 0; m < 4; ++m)
#pragma unroll
                for (int n = 0; n < 2; ++n) acc[a][b][m][n] = (f32x4){0.f, 0.f, 0.f, 0.f};
    bf16x8 At[4][2], B0[2][2], B1[2][2];
    const char* cA = (const char*)g.A + (size_t)cur.pm * tstepA + (size_t)cur.ks * sstep; const char* cB = (const char*)g.Bt + (size_t)cur.pn * tstepB + (size_t)cur.ks * sstep;
    S.a_ready(cur);
    PG8_STAGE(PG8_SB(0, 0), cB, voffB); PG8_STAGE(PG8_SA(0, 0), cA, voffA); PG8_STAGE(PG8_SB(0, 1), cB + hstepB, voffB); PG8_STAGE(PG8_SA(0, 1), cA + hstepA, voffA);
    if (wr == 1) PG8_BAR;
    PG8_WAIT_V(4); PG8_BAR;
    PG8_STAGE(PG8_SB(1, 0), cB + kstep, voffB); PG8_STAGE(PG8_SA(1, 0), cA + kstep, voffA); PG8_STAGE(PG8_SB(1, 1), cB + hstepB + kstep, voffB);
    PG8_WAIT_V(6); PG8_BAR;
    PG8_STAMP();
    for (;;) {
        const bool has_next = S.next(ui + 1, nxt);
        const char* nA = has_next ? (const char*)g.A + (size_t)nxt.pm * tstepA + (size_t)nxt.ks * sstep : cA; const char* nB = has_next ? (const char*)g.Bt + (size_t)nxt.pn * tstepB + (size_t)nxt.ks * sstep : cB;
        for (int t = 0; t < nt; t += 2) {
            const bool last = (t == nt - 2);
            const char* a1 = cA + (size_t)(t + 1) * kstep;
            const char* a2 = last ? nA : cA + (size_t)(t + 2) * kstep; const char* b2 = last ? nB : cB + (size_t)(t + 2) * kstep;
            const char* a3 = a2 + kstep; const char* b3 = b2 + kstep;
            if (last && has_next) S.a_ready(nxt);
            PG8_LDB(B0, 0, 0); PG8_SCHED; PG8_LDA(At, 0, 0); PG8_STAGE(PG8_SA(1, 1), a1 + hstepA, voffA);
            PG8_WAIT_L(8); PG8_BAR; PG8_WAIT_L(0); PG8_MMA(0, 0, At, B0); PG8_BAR; PG8_SCHED;
            PG8_LDB(B1, 0, 1); PG8_STAGE(PG8_SB(0, 0), b2, voffB);
            PG8_BAR; PG8_WAIT_L(0); PG8_MMA(0, 1, At, B1); PG8_BAR;
            PG8_LDA(At, 0, 1); PG8_STAGE(PG8_SA(0, 0), a2, voffA);
            PG8_BAR; PG8_WAIT_L(0); PG8_MMA(1, 0, At, B0); PG8_BAR; PG8_SCHED;
            PG8_STAGE(PG8_SB(0, 1), b2 + hstepB, voffB);
            PG8_WAIT_V(6); PG8_BAR; PG8_MMA(1, 1, At, B1); PG8_BAR;
            PG8_LDB(B0, 1, 0); PG8_SCHED; PG8_LDA(At, 1, 0); PG8_STAGE(PG8_SA(0, 1), a2 + hstepA, voffA);
            PG8_WAIT_L(8); PG8_BAR; PG8_WAIT_L(0); PG8_MMA(0, 0, At, B0); PG8_BAR; PG8_SCHED;
            PG8_LDB(B1, 1, 1); PG8_STAGE(PG8_SB(1, 0), b3, voffB);
            PG8_BAR; PG8_WAIT_L(0); PG8_MMA(0, 1, At, B1); PG8_BAR;
            PG8_LDA(At, 1, 1); PG8_STAGE(PG8_SA(1, 0), a3, voffA);
            PG8_BAR; PG8_WAIT_L(0); PG8_MMA(1, 0, At, B0); PG8_BAR; PG8_SCHED;
            PG8_STAGE(PG8_SB(1, 1), b3 + hstepB, voffB);
            PG8_WAIT_V(6); PG8_BAR; PG8_MMA(1, 1, At, B1); PG8_BAR;
        }
        PG8_STAMP();
        if constexpr (!Epi::AFTER_DRAIN) { E(acc, cur, wr, wc, fr, fq); S.done(cur); }
        PG8_STAMP();
        if (!has_next) break;
#pragma unroll
        for (int a = 0; a < 2; ++a)
#pragma unroll
            for (int b = 0; b < 2; ++b)
#pragma unroll
                for (int m = 0; m < 4; ++m)
#pragma unroll
                    for (int n = 0; n < 2; ++n) acc[a][b][m][n] = (f32x4){0.f, 0.f, 0.f, 0.f};
        cur = nxt; cA = nA; cB = nB; ++ui;
    }
    PG8_WAIT_V(0);
    if (wr == 0) PG8_BAR;
    PG8_BAR;
    if constexpr (Epi::AFTER_DRAIN) { E.fused(acc, cur, wr, wc, fr, fq, lds, wid, lane); S.done(cur); }
    PG8_STAMP();
    if (STAMP && wid == 0) { stamps[lane] = lane < nts ? (((unsigned long long)(unsigned)ts_hi << 32) | (unsigned)ts_lo) : 0ull;
        if (lane == 62) stamps[62] = rt_entry; if (lane == 63) stamps[63] = (unsigned long long)wall_clock64(); }
#undef PG8_STAMP
#undef PG8_SA
#undef PG8_SB
#undef PG8_STAGE
#undef PG8_LDA
#undef PG8_LDB
#undef PG8_MMA
#undef PG8_WAIT_V
#undef PG8_WAIT_L
#undef PG8_BAR
#undef PG8_SCHED
}
}

#define LAS __attribute__((address_space(3)))
typedef unsigned short bf16_t;
typedef short bf16x8 __attribute__((ext_vector_type(8)));
typedef float f32x4 __attribute__((ext_vector_type(4)));
typedef float f32x2 __attribute__((ext_vector_type(2)));
typedef unsigned u32x4 __attribute__((ext_vector_type(4)));
typedef unsigned u32x2 __attribute__((ext_vector_type(2)));

constexpr int D = 1024, NP = 16384, NS = 512, NTOK = NP + NS, SEQ = 2048, NB = 8, NSB = 128, DEPTH = 4;
constexpr int INW = 2568, NPROJ = 2560, DFF = 2816, NGU = 5632;
constexpr int PC_G = 1536, PC_SSM = 2048, PC_POOL = 2304;
constexpr float EPS = 1e-6f;
constexpr int LDS_BYTES = 163840;

constexpr size_t SZ_WIN = (size_t)NPROJ * D * 2, SZ_WOUT = (size_t)D * D * 2, SZ_WGU = (size_t)NGU * D * 2, SZ_WDN = (size_t)D * DFF * 2;
constexpr size_t SZ_WAB = 8 * D * 4, SZ_GLUT = 256 * 256 * 2, SZ_POOLT = 4 * 64 * 64 * 2, SZ_SSMK = 16 * 64 * 4 * 4, SZ_BBAR = 16 * 64 * 32 * 4;
constexpr size_t WS_WIN = 0;
constexpr size_t WS_WOUT = WS_WIN + DEPTH * SZ_WIN;
constexpr size_t WS_WGU = WS_WOUT + DEPTH * SZ_WOUT;
constexpr size_t WS_WDN = WS_WGU + DEPTH * SZ_WGU;
constexpr size_t WS_WAB = WS_WDN + DEPTH * SZ_WDN;
constexpr size_t WS_GLUT = WS_WAB + DEPTH * SZ_WAB;
constexpr size_t WS_POOLT = WS_GLUT + DEPTH * SZ_GLUT;
constexpr size_t WS_SSMK = WS_POOLT + DEPTH * SZ_POOLT;
constexpr size_t WS_BBAR = WS_SSMK + DEPTH * SZ_SSMK;
constexpr size_t WS_H = WS_BBAR + DEPTH * SZ_BBAR;
constexpr size_t WS_AB = WS_H + (size_t)NTOK * D * 2;
constexpr size_t WS_MIX = WS_AB + (size_t)NTOK * 8 * 4;
constexpr size_t WS_MIXO = WS_MIX + (size_t)NTOK * D * 2;
constexpr size_t WS_SSME = WS_MIXO + (size_t)NTOK * D * 4;
constexpr size_t WS_PROJ = WS_SSME + (size_t)8 * 32 * 16 * 64 * 2 * 4;
constexpr size_t WS_DW = WS_PROJ + (size_t)NTOK * NPROJ * 2;
constexpr size_t WS_DKC = WS_DW + (size_t)1024 * 8192 * 4;
constexpr size_t WS_DQD = WS_DKC + (size_t)1024 * 8192 * 2;
constexpr size_t WS_DQK = WS_DQD + (size_t)1024 * 8192 * 2;
constexpr size_t WS_DKT = WS_DQK + (size_t)1024 * 4096 * 2;
constexpr size_t WS_DGL = WS_DKT + (size_t)1024 * 8192 * 2;
constexpr size_t WS_DGS = WS_DGL + 4096;
constexpr size_t WS_BAR = WS_DGS + (size_t)1024 * 8192 * 2;
constexpr size_t WS_PARTS = WS_BAR + 16384;
constexpr size_t WS_RSC = WS_PARTS + (size_t)11 * 512 * 1024 * 4;
constexpr size_t WS_END = WS_RSC + (size_t)NTOK * 4;
constexpr size_t WS_HID = WS_PROJ;
static_assert(WS_HID + (size_t)NTOK * DFF * 2 <= WS_END, "HID overlay");
static_assert(WS_H % 256 == 0 && WS_PROJ % 256 == 0 && WS_DW % 256 == 0, "align");

constexpr size_t O_YP = 0, O_YS = O_YP + (size_t)NP * D, O_DP = O_YS + (size_t)NS * D, O_CP = O_DP + (size_t)DEPTH * 8 * 4 * 16384,
                 O_REP = O_CP + (size_t)DEPTH * 8 * 3 * 1536, O_IMP = O_REP + (size_t)DEPTH * 8 * 1024, O_PP = O_IMP + (size_t)DEPTH * 8 * 1024,
                 O_DS = O_PP + (size_t)DEPTH * 8 * 15 * 256, O_CS = O_DS + (size_t)DEPTH * 128 * 4 * 16384, O_RES = O_CS + (size_t)DEPTH * 128 * 3 * 1536,
                 O_IMS = O_RES + (size_t)DEPTH * 128 * 1024, O_PS = O_IMS + (size_t)DEPTH * 128 * 1024, O_END = O_PS + (size_t)DEPTH * 128 * 15 * 256;

struct Args { const float* in[32]; float* out; unsigned char* ws; int ph_lo, ph_hi; };
typedef const float* cfp_t;
typedef __attribute__((address_space(4))) const unsigned char* kptr_t;
struct InProxy { __device__ __forceinline__ const float* operator[](int i) const {
    kptr_t p = (kptr_t)__builtin_amdgcn_kernarg_segment_ptr(); asm volatile("" : "+s"(p)); return *(__attribute__((address_space(4))) const cfp_t*)(p + 8 * i); } };
struct DevArgs { InProxy in; float* out; unsigned char* ws; int ph_lo, ph_hi; };
enum { I_XP = 0, I_XS, I_SDELTA, I_SCONV, I_SRE, I_SIM, I_SPOOL, I_NMPRE, I_NMPOST, I_NFPRE, I_NFPOST, I_WIN, I_CONVW, I_ALOG, I_DTB, I_ONORM,
       I_ARE, I_AIM, I_LOGDT, I_BRE, I_BIM, I_CRE, I_CIM, I_SSMD, I_GLUW, I_GLUB, I_POOLW, I_POOLS, I_WOUT, I_WG, I_WU, I_WD };

__device__ __forceinline__ unsigned f2bf(float f) { unsigned u = __float_as_uint(f); return (u + 0x7fffu + ((u >> 16) & 1u)) >> 16; }
__device__ __forceinline__ float bf2f(unsigned b) { return __uint_as_float(b << 16); }
__device__ __forceinline__ unsigned pk2(float lo, float hi) { return f2bf(lo) | (f2bf(hi) << 16); }
template <int CTRL> __device__ __forceinline__ float dpp_f(float v) { return __builtin_bit_cast(float, __builtin_amdgcn_update_dpp(0, __builtin_bit_cast(int, v), CTRL, 0xF, 0xF, true)); }
__device__ __forceinline__ float row_sum8(float v) { v += dpp_f<0xB1>(v); v += dpp_f<0x4E>(v); v += dpp_f<0x141>(v); return v; }
__device__ __forceinline__ float row_sum16(float v) { v = row_sum8(v); v += dpp_f<0x140>(v); return v; }
__device__ __forceinline__ float wave_sum(float v) { v = row_sum16(v); v += __shfl_xor(v, 16); v += __shfl_xor(v, 32); return v; }
__device__ __forceinline__ float silu_f(float y) { return y * __builtin_amdgcn_rcpf(1.f + __expf(-y)); }
__device__ __forceinline__ float sigmoid_f(float y) { return __builtin_amdgcn_rcpf(1.f + __expf(-y)); }
__device__ __forceinline__ float gelu_tanh_f(float x) { const float z = 0.7978845608028654f * (x + 0.044715f * x * x * x);
    const float t = 1.f - 2.f * __builtin_amdgcn_rcpf(1.f + __expf(2.f * z)); return 0.5f * x * (1.f + t); }
__device__ __forceinline__ f32x4 mfma16(bf16x8 a, bf16x8 b, f32x4 c) { return __builtin_amdgcn_mfma_f32_16x16x32_bf16(a, b, c, 0, 0, 0); }
#define LDS_FENCE() asm volatile("s_waitcnt lgkmcnt(0)" ::: "memory")

struct EpiSwiGLU {
    static constexpr bool PERM = false, AFTER_DRAIN = false;
    bf16_t* O; int ldc; const float* rs;
    __device__ __forceinline__ void operator()(const pg8::f32x4 (&acc)[2][2][4][2], const pg8::Unit& u, int wr, int wc, int fr, int fq) const {
        const int row0 = u.pm * 256 + wr * 64 + fr, hid0 = u.pn * 128 + wc * 16 + 4 * fq;
#pragma unroll
        for (int ai = 0; ai < 2; ++ai)
#pragma unroll
            for (int m = 0; m < 4; ++m) { const float sc = rs[row0 + ai * 128 + m * 16]; bf16_t* rowp = O + (size_t)(row0 + ai * 128 + m * 16) * ldc + hid0;
#pragma unroll
                for (int bj = 0; bj < 2; ++bj) { const pg8::f32x4 g = acc[ai][bj][m][0] * sc, v = acc[ai][bj][m][1] * sc;
                    u32x2 w; w.x = pg8::cvt_pk_bf16(silu_f(g[0]) * v[0], silu_f(g[1]) * v[1]); w.y = pg8::cvt_pk_bf16(silu_f(g[2]) * v[2], silu_f(g[3]) * v[3]);
                    *(u32x2*)(rowp + bj * 64) = w; } }
    }
};

#define XB_TMO      128
#define XB_XCNT(j)  (256  + 64 * (j))
#define XB_XSUB(j)  (1280 + 64 * (j))
#define XB_XGEN(j)  (2304 + 64 * (j))
#define XB_TOP      3328
#define XB_TOPGEN   3392
#define XCD_BAR_WORDS 3456
#define XB_SPIN_CAP (1u << 18)

__device__ __forceinline__ unsigned xb_ld(unsigned* p)              { return __hip_atomic_load(p, __ATOMIC_RELAXED, __HIP_MEMORY_SCOPE_AGENT); }
__device__ __forceinline__ unsigned xb_add(unsigned* p, unsigned v) { return __hip_atomic_fetch_add(p, v, __ATOMIC_RELAXED, __HIP_MEMORY_SCOPE_AGENT); }
__device__ __forceinline__ unsigned xb_xcc_id() { return (unsigned)__builtin_amdgcn_s_getreg((3 << 11) | 20) & 0xFu; }
#define XB_SPIN(cond, bar) do { unsigned _sp = 0; while (cond) { __builtin_amdgcn_s_sleep(1); \
    if ((++_sp & 255u) == 0u) { if (xb_ld(&(bar)[XB_TMO])) break; if (_sp > XB_SPIN_CAP) { atomicAdd(&(bar)[XB_TMO], 1u); break; } } } } while (0)

struct XcdBarrier {
    unsigned* bar; unsigned x;
    volatile LAS unsigned* st;
};

__device__ __forceinline__ XcdBarrier xcd_barrier_post(unsigned* bar, volatile LAS unsigned* st) {
    XcdBarrier b; b.bar = bar; b.x = xb_xcc_id(); b.st = st;
    if (threadIdx.x == 0) (void)xb_add(&bar[XB_XCNT(b.x)], 1u);
    return b;
}
__device__ __forceinline__ void xcd_barrier_complete(unsigned* bar, unsigned x, unsigned& nloc, unsigned& nx) {
    const unsigned G = gridDim.x * gridDim.y * gridDim.z;
    unsigned sum, cnt, mine, sp = 0u;
    for (;;) {
        sum = 0u; cnt = 0u; mine = 0u;
#pragma unroll
        for (unsigned j = 0; j < 16; ++j) { const unsigned c = xb_ld(&bar[XB_XCNT(j)]); sum += c; cnt += (c > 0u) ? 1u : 0u; mine = (j == x) ? c : mine; }
        if (sum == G) break;
        __builtin_amdgcn_s_sleep(1);
        if ((++sp & 255u) == 0u) { if (xb_ld(&bar[XB_TMO])) break; if (sp > XB_SPIN_CAP) { atomicAdd(&bar[XB_TMO], 1u); break; } }
    }
    nloc = mine > 0u ? mine : 1u; nx = cnt > 0u ? cnt : 1u;
}

__device__ __forceinline__ void xcd_barrier(const XcdBarrier& b) {
    asm volatile("s_waitcnt vmcnt(0)" ::: "memory");
    __syncthreads();
    if (threadIdx.x == 0) {
        unsigned* bar = b.bar; asm volatile("" : "+s"(bar));
        __builtin_amdgcn_s_waitcnt(0);
        unsigned nloc = b.st[0], nx = b.st[1];
        if (nloc == 0u) { xcd_barrier_complete(bar, b.x, nloc, nx); b.st[0] = nloc; b.st[1] = nx; }
        const unsigned old = xb_add(&bar[XB_XSUB(b.x)], 1u);
        const unsigned gen = old / nloc;
        if (old + 1u == (gen + 1u) * nloc) {
            __builtin_amdgcn_fence(__ATOMIC_RELEASE, "agent");
            asm volatile("s_waitcnt vmcnt(0)" ::: "memory");
            const unsigned og = xb_add(&bar[XB_TOP], 1u);
            const unsigned tg = og / nx;
            if (og + 1u == (tg + 1u) * nx) xb_add(&bar[XB_TOPGEN], 1u);
            else XB_SPIN(xb_ld(&bar[XB_TOPGEN]) == tg, bar);
            __builtin_amdgcn_fence(__ATOMIC_ACQUIRE, "agent");
            xb_add(&bar[XB_XGEN(b.x)], 1u);
            asm volatile("s_waitcnt vmcnt(0)" ::: "memory");
        } else {
            XB_SPIN(xb_ld(&bar[XB_XGEN(b.x)]) == gen, bar);
            __builtin_amdgcn_fence(__ATOMIC_ACQUIRE, "agent");
            asm volatile("s_waitcnt vmcnt(0)" ::: "memory");
        }
    }
    __syncthreads();
}

struct EpiBf16Scale {
    static constexpr bool PERM = true, AFTER_DRAIN = false;
    bf16_t* O; int ldc; const float* rs;
    __device__ __forceinline__ void operator()(const pg8::f32x4 (&acc)[2][2][4][2], const pg8::Unit& u, int wr, int wc, int fr, int fq) const {
        const int row0 = u.pm * 256 + wr * 64 + fr, col0 = u.pn * 256 + wc * 32 + 8 * fq;
#pragma unroll
        for (int ai = 0; ai < 2; ++ai)
#pragma unroll
            for (int m = 0; m < 4; ++m) { const int row = row0 + ai * 128 + m * 16; const float sc = rs[row]; bf16_t* rowp = O + (size_t)row * ldc + col0;
#pragma unroll
                for (int bj = 0; bj < 2; ++bj) { const pg8::f32x4 v0 = acc[ai][bj][m][0] * sc, v1 = acc[ai][bj][m][1] * sc;
                    u32x4 w; w.x = pg8::cvt_pk_bf16(v0[0], v0[1]); w.y = pg8::cvt_pk_bf16(v0[2], v0[3]); w.z = pg8::cvt_pk_bf16(v1[0], v1[1]); w.w = pg8::cvt_pk_bf16(v1[2], v1[3]);
                    *(u32x4*)(rowp + bj * 128) = w; } }
    }
};
struct SliceOrder {
    int nunits, G, c;
    __device__ __forceinline__ bool next(int i, pg8::Unit& u) const { const int L = i * G + c; if (L >= nunits) return false; const int t = L & 7; u.pm = t >> 2; u.pn = t & 3; u.ks = L >> 3; return true; }
    __device__ __forceinline__ void a_ready(const pg8::Unit&) const {}
    __device__ __forceinline__ void done(const pg8::Unit&) const {}
};
struct EpiF32Part {
    static constexpr bool PERM = false, AFTER_DRAIN = false;
    float* C;
    __device__ __forceinline__ void operator()(const pg8::f32x4 (&acc)[2][2][4][2], const pg8::Unit& u, int wr, int wc, int fr, int fq) const {
        const int row0 = u.pm * 256 + wr * 64 + fr, col0 = u.pn * 256 + wc * 32 + 4 * fq; float* base = C + (size_t)u.ks * (512 * 1024);
#pragma unroll
        for (int ai = 0; ai < 2; ++ai)
#pragma unroll
            for (int m = 0; m < 4; ++m) { float* rowp = base + (size_t)(row0 + ai * 128 + m * 16) * 1024 + col0;
#pragma unroll
                for (int bj = 0; bj < 2; ++bj)
#pragma unroll
                    for (int n = 0; n < 2; ++n) *(pg8::f32x4*)(rowp + bj * 128 + n * 16) = acc[ai][bj][m][n]; }
    }
};

struct SrcIn { const float* w; const float* nw; __device__ __forceinline__ float operator()(int k, int n) const { return w[(size_t)k * INW + (n < 1536 ? n : n + 8)] * nw[k]; } };
struct SrcPlain { const float* w; int N; __device__ __forceinline__ float operator()(int k, int n) const { return w[(size_t)k * N + n]; } };
struct SrcGU { const float* g; const float* u; const float* nw; __device__ __forceinline__ float operator()(int k, int n) const { const int r = n & 31, hid = (n >> 5) * 16 + (r & 15); const long long du = (r < 16) ? 0ll : (long long)(u - g); return g[du + (long long)k * DFF + hid] * nw[k]; } };
template <class Src> __device__ __forceinline__ void transpose_item(const Src& src, int K, bf16_t* WT, int nblk, LAS float* scr, int item, int lane) {
    const int kb = item / nblk, nb = item % nblk, k0 = 64 * kb, n0 = 32 * nb;
#pragma unroll 8
    for (int i = 0; i < 32; ++i) { const int kk = 2 * i + (lane >> 5); scr[kk * 33 + (lane & 31)] = src(k0 + kk, n0 + (lane & 31)); }
    LDS_FENCE();
    const int c = lane & 7;
#pragma unroll
    for (int j = 0; j < 4; ++j) { const int n = (lane >> 3) + 8 * j; const LAS float* s = scr + (8 * c) * 33 + n;
        u32x4 o; o.x = pk2(s[0 * 33], s[1 * 33]); o.y = pk2(s[2 * 33], s[3 * 33]); o.z = pk2(s[4 * 33], s[5 * 33]); o.w = pk2(s[6 * 33], s[7 * 33]);
        *(u32x4*)(WT + (size_t)(n0 + n) * K + k0 + 8 * c) = o; }
    LDS_FENCE();
}

__device__ __forceinline__ void norm_rows(const float* T, const float* wt, const float* X0, const float* X1, float* Xout, const float* wh, float* RSC,
                                          const float* Wab, float* AB, int gw, int NGW, int lane, const float* Tp = nullptr, int ns = 0,
                                          const bf16_t* Xbin = nullptr, bf16_t* Xbout = nullptr) {
#pragma unroll 1
    for (int m = gw; m < NTOK; m += NGW) {
        f32x4 x[4], t[4];
        { if (Xbin) {
#pragma unroll
              for (int j = 0; j < 4; ++j) { const u32x2 xb = ((const u32x2*)(Xbin + (size_t)m * D))[lane + 64 * j];
                  x[j] = (f32x4){__uint_as_float(xb.x << 16), __uint_as_float(xb.x & 0xffff0000u), __uint_as_float(xb.y << 16), __uint_as_float(xb.y & 0xffff0000u)}; } }
          else { const float* xr = (X1 && m >= NP) ? X1 + (size_t)(m - NP) * D : X0 + (size_t)m * D;
#pragma unroll
              for (int j = 0; j < 4; ++j) x[j] = ((const f32x4*)xr)[lane + 64 * j]; }
          if (T && !(Tp && m >= NP)) {
#pragma unroll
              for (int j = 0; j < 4; ++j) { const u32x2 tb = ((const u32x2*)((const bf16_t*)T + (size_t)m * D))[lane + 64 * j];
                  t[j] = (f32x4){__uint_as_float(tb.x << 16), __uint_as_float(tb.x & 0xffff0000u), __uint_as_float(tb.y << 16), __uint_as_float(tb.y & 0xffff0000u)}; } } }
        if (T) {
            float ss = 0.f;
            if (Tp && m >= NP) {
#pragma unroll
                for (int j = 0; j < 4; ++j) { f32x4 a = {0.f, 0.f, 0.f, 0.f}; for (int q = 0; q < ns; ++q) a += ((const f32x4*)(Tp + (size_t)q * (512 * 1024) + (size_t)(m - NP) * D))[lane + 64 * j]; t[j] = a; } }
#pragma unroll
            for (int j = 0; j < 4; ++j) ss += (t[j].x * t[j].x + t[j].y * t[j].y) + (t[j].z * t[j].z + t[j].w * t[j].w);
            ss = wave_sum(ss); const float r = rsqrtf(ss * (1.f / D) + EPS);
#pragma unroll
            for (int j = 0; j < 4; ++j) { const f32x4 w = ((const f32x4*)wt)[lane + 64 * j]; x[j] += t[j] * r * w; }
        }
        if (Xout) {
#pragma unroll
            for (int j = 0; j < 4; ++j) ((f32x4*)(Xout + (size_t)m * D))[lane + 64 * j] = x[j];
        }
        if (Xbout) {
#pragma unroll
            for (int j = 0; j < 4; ++j) { u32x2 o; o.x = pg8::cvt_pk_bf16(x[j].x, x[j].y); o.y = pg8::cvt_pk_bf16(x[j].z, x[j].w); ((u32x2*)(Xbout + (size_t)m * D))[lane + 64 * j] = o; }
        }
        if (RSC) {
            float ss = 0.f;
#pragma unroll
            for (int j = 0; j < 4; ++j) ss += (x[j].x * x[j].x + x[j].y * x[j].y) + (x[j].z * x[j].z + x[j].w * x[j].w);
            ss = wave_sum(ss); const float r = rsqrtf(ss * (1.f / D) + EPS);
            if (lane == 0) RSC[m] = r;
            f32x4 hv[4];
#pragma unroll
            for (int j = 0; j < 4; ++j) { const f32x4 w = ((const f32x4*)wh)[lane + 64 * j]; hv[j] = x[j] * r * w; }
            if (Wab) {
                float d[8];
#pragma unroll
                for (int c = 0; c < 8; ++c) { float dd = 0.f;
#pragma unroll
                    for (int j = 0; j < 4; ++j) { const f32x4 w = ((const f32x4*)(Wab + c * D))[lane + 64 * j]; dd += (hv[j].x * w.x + hv[j].y * w.y) + (hv[j].z * w.z + hv[j].w * w.w); }
                    d[c] = dd; }
#pragma unroll
                for (int c = 0; c < 8; ++c) d[c] = row_sum16(d[c]);
#pragma unroll
                for (int o = 16; o < 64; o <<= 1) {
#pragma unroll
                    for (int c = 0; c < 8; ++c) d[c] += __shfl_xor(d[c], o); }
                if (lane == 0) { f32x4 o0 = {d[0], d[1], d[2], d[3]}, o1 = {d[4], d[5], d[6], d[7]}; *(f32x4*)(AB + (size_t)m * 8) = o0; *(f32x4*)(AB + (size_t)m * 8 + 4) = o1; }
            }
        }
    }
}

__device__ __forceinline__ void norm_rows_pf(const float* T, const float* wt, bf16_t* XB, float* RSC,
                                             int gw, int NGW, int lane, const float* Tp, int ns) {
    u32x2 xn[4], tn[4];
#define NR_LOAD(mm) do { const int _m = (mm); \
        _Pragma("unroll") for (int j = 0; j < 4; ++j) xn[j] = ((const u32x2*)(XB + (size_t)_m * D))[lane + 64 * j]; \
        if (_m < NP) { _Pragma("unroll") for (int j = 0; j < 4; ++j) tn[j] = ((const u32x2*)((const bf16_t*)T + (size_t)_m * D))[lane + 64 * j]; } } while (0)
    if (gw < NTOK) NR_LOAD(gw);
#pragma unroll 1
    for (int m = gw; m < NTOK; m += NGW) {
        f32x4 x[4], t[4];
#pragma unroll
        for (int j = 0; j < 4; ++j) { x[j] = (f32x4){__uint_as_float(xn[j].x << 16), __uint_as_float(xn[j].x & 0xffff0000u), __uint_as_float(xn[j].y << 16), __uint_as_float(xn[j].y & 0xffff0000u)};
            t[j] = (f32x4){__uint_as_float(tn[j].x << 16), __uint_as_float(tn[j].x & 0xffff0000u), __uint_as_float(tn[j].y << 16), __uint_as_float(tn[j].y & 0xffff0000u)}; }
        if (m + NGW < NTOK) NR_LOAD(m + NGW);
        if (m >= NP) {
#pragma unroll
            for (int j = 0; j < 4; ++j) { f32x4 a = {0.f, 0.f, 0.f, 0.f}; for (int q = 0; q < ns; ++q) a += ((const f32x4*)(Tp + (size_t)q * (512 * 1024) + (size_t)(m - NP) * D))[lane + 64 * j]; t[j] = a; } }
        float ss = 0.f;
#pragma unroll
        for (int j = 0; j < 4; ++j) ss += (t[j].x * t[j].x + t[j].y * t[j].y) + (t[j].z * t[j].z + t[j].w * t[j].w);
        ss = wave_sum(ss); const float r = rsqrtf(ss * (1.f / D) + EPS);
#pragma unroll
        for (int j = 0; j < 4; ++j) { const f32x4 w = ((const f32x4*)wt)[lane + 64 * j]; x[j] += t[j] * r * w; }
#pragma unroll
        for (int j = 0; j < 4; ++j) { u32x2 o; o.x = pg8::cvt_pk_bf16(x[j].x, x[j].y); o.y = pg8::cvt_pk_bf16(x[j].z, x[j].w); ((u32x2*)(XB + (size_t)m * D))[lane + 64 * j] = o; }
        float s2 = 0.f;
#pragma unroll
        for (int j = 0; j < 4; ++j) s2 += (x[j].x * x[j].x + x[j].y * x[j].y) + (x[j].z * x[j].z + x[j].w * x[j].w);
        s2 = wave_sum(s2); if (lane == 0) RSC[m] = rsqrtf(s2 * (1.f / D) + EPS);
    }
#undef NR_LOAD
}

__device__ __forceinline__ void prologue(const DevArgs& A, LAS unsigned char* lds, int wave, int lane, int gw, int NGW) {
    LAS float* scr = (LAS float*)(lds + wave * 8704);
    constexpr int I_IN = 16 * 80, I_OUT = 16 * 32, I_GU = 16 * 176, I_DN = 44 * 32, I_GLU = 4 * 8, I_POOL = 8, PER = I_IN + I_OUT + I_GU + I_DN + I_GLU + I_POOL;
#pragma unroll 1
    for (int it = gw; it < DEPTH * PER; it += NGW) {
        const int l = it / PER; int r = it % PER;
        if (r < I_IN) { SrcIn s{A.in[I_WIN] + (size_t)l * D * INW, A.in[I_NMPRE] + l * D}; transpose_item(s, D, (bf16_t*)(A.ws + WS_WIN + l * SZ_WIN), NPROJ / 32, scr, r, lane); continue; } r -= I_IN;
        if (r < I_OUT) { SrcPlain s{A.in[I_WOUT] + (size_t)l * D * D, D}; transpose_item(s, D, (bf16_t*)(A.ws + WS_WOUT + l * SZ_WOUT), D / 32, scr, r, lane); continue; } r -= I_OUT;
        if (r < I_GU) { SrcGU s{A.in[I_WG] + (size_t)l * D * DFF, A.in[I_WU] + (size_t)l * D * DFF, A.in[I_NFPRE] + l * D}; transpose_item(s, D, (bf16_t*)(A.ws + WS_WGU + l * SZ_WGU), NGU / 32, scr, r, lane); continue; } r -= I_GU;
        if (r < I_DN) { SrcPlain s{A.in[I_WD] + (size_t)l * DFF * D, D}; transpose_item(s, DFF, (bf16_t*)(A.ws + WS_WDN + l * SZ_WDN), D / 32, scr, r, lane); continue; } r -= I_DN;
        if (r < I_GLU) { SrcPlain s{A.in[I_GLUW] + (size_t)l * 65536, 256}; transpose_item(s, 256, (bf16_t*)(A.ws + WS_GLUT + l * SZ_GLUT), 8, scr, r, lane); continue; } r -= I_GLU;
        { const int g = r >> 1; SrcPlain s{A.in[I_POOLW] + (size_t)(l * 4 + g) * 4096, 64}; transpose_item(s, 64, (bf16_t*)(A.ws + WS_POOLT + l * SZ_POOLT) + g * 4096, 2, scr, r & 1, lane); }
    }
    const int gt = gw * 64 + lane, NT = NGW * 64;
    float* wab = (float*)(A.ws + WS_WAB);
#pragma unroll 1
    for (int i = gt; i < DEPTH * 8 * D; i += NT) { const int l = i / (8 * D), j = (i / D) & 7, k = i % D; wab[i] = A.in[I_WIN][((size_t)l * D + k) * INW + 1536 + j]; }
    float* ssmk = (float*)(A.ws + WS_SSMK); float* bbar = (float*)(A.ws + WS_BBAR);
#pragma unroll 1
    for (int i = gt; i < DEPTH * 16 * 64; i += NT) {
        const int lg = i >> 6;
        const float dt = expf(A.in[I_LOGDT][lg]), ar = A.in[I_ARE][i], ai = A.in[I_AIM][i];
        const float mag = expf(ar * dt);
        float rev = ai * dt * 0.15915494309189535f; rev -= floorf(rev);
        const float sn = __builtin_amdgcn_sinf(rev), cs = __builtin_amdgcn_cosf(rev);
        const float lr = mag * cs, li = mag * sn;
        float pr = lr, pi = li;
#pragma unroll
        for (int q = 0; q < 6; ++q) { const float nr2 = pr * pr - pi * pi, ni2 = 2.f * pr * pi; pr = nr2; pi = ni2; }
        ssmk[i * 4 + 0] = lr; ssmk[i * 4 + 1] = li; ssmk[i * 4 + 2] = pr; ssmk[i * 4 + 3] = pi;
        const float nr = lr - 1.f, ni = li, d2 = ar * ar + ai * ai;
        const float cre = (nr * ar + ni * ai) / d2, cim = (ni * ar - nr * ai) / d2;
#pragma unroll
        for (int h = 0; h < 16; ++h) { const float br = A.in[I_BRE][(size_t)i * 16 + h], bi = A.in[I_BIM][(size_t)i * 16 + h];
            bbar[(size_t)i * 32 + h] = cre * br - cim * bi; bbar[(size_t)i * 32 + 16 + h] = cre * bi + cim * br; }
    }
}

__device__ __forceinline__ unsigned bfmul2(unsigned pk, float f0, float f1) { return pg8::cvt_pk_bf16(__uint_as_float(pk << 16) * f0, __uint_as_float(pk & 0xffff0000u) * f1); }
__device__ __forceinline__ void delta_prep_item(const DevArgs& A, int l, LAS unsigned char* lds, int item, int tid, int wave, int lane) {
    asm volatile("" : "+v"(tid)); lane = tid & 63; wave = __builtin_amdgcn_readfirstlane(tid >> 6);
    const int bh = item >> 5, n = item & 31, b = bh >> 2, h = bh & 3;
    const int tok0 = b * SEQ + n * 64;
    LAS bf16_t* QS = (LAS bf16_t*)(lds); LAS bf16_t* KS = (LAS bf16_t*)(lds + 17408);
    LAS unsigned char* KT = lds + 34816; LAS unsigned char* VT = lds + 53248; LAS unsigned char* RTK = lds + 71680;
    LAS float* AM = (LAS float*)(lds + 90112); LAS float* PM = (LAS float*)(lds + 107520); LAS float* PSC = PM; LAS float* TM = (LAS float*)(lds + 124928);
    LAS unsigned char* TB = lds + 142336;
    LAS float* GAM = (LAS float*)(lds + 151552); LAS float* BETA = GAM + 64; LAS float* RQ = GAM + 128; LAS float* RK = GAM + 192;
    LAS float* F2 = GAM + 256; LAS float* F3 = GAM + 320; LAS float* F4 = GAM + 384;
    const bf16_t* PROJ = (const bf16_t*)(A.ws + WS_PROJ);
    const float* AB = (const float*)(A.ws + WS_AB);
    u32x4 gv[2];
#pragma unroll
    for (int j = 0; j < 2; ++j) { const int id = tid + 512 * j; gv[j] = *(const u32x4*)(PROJ + (size_t)(tok0 + (id >> 4)) * NPROJ + PC_G + h * 128 + (id & 15) * 8); }
    if (tid < 384) {
        const int part = tid >> 7, c = tid & 127, col = part * 512 + h * 128 + c;
        const float* cw = A.in[I_CONVW] + (size_t)l * 4 * 1536;
        const float w0 = cw[col], w1 = cw[1536 + col], w2 = cw[3072 + col], w3 = cw[4608 + col];
        const bf16_t* pp = PROJ + (size_t)tok0 * NPROJ + col;
        float xr[67];
#pragma unroll
        for (int t = 0; t < 67; ++t) xr[t] = (n > 0 || t >= 3) ? bf2f(pp[(long)(t - 3) * NPROJ]) : 0.f;
        unsigned pk[32];
#pragma unroll
        for (int t = 0; t < 64; t += 2) {
            const float s0 = silu_f(w0 * xr[t] + w1 * xr[t + 1] + w2 * xr[t + 2] + w3 * xr[t + 3]);
            const float s1 = silu_f(w0 * xr[t + 1] + w1 * xr[t + 2] + w2 * xr[t + 3] + w3 * xr[t + 4]);
            pk[t >> 1] = pg8::cvt_pk_bf16(s0, s1);
        }
        if (part < 2) { LAS bf16_t* dst = (part == 0 ? QS : KS) + c;
#pragma unroll
            for (int t = 0; t < 64; t += 2) { dst[t * 136] = (bf16_t)(pk[t >> 1] & 0xffffu); dst[(t + 1) * 136] = (bf16_t)(pk[t >> 1] >> 16); } }
        if (part > 0) { LAS unsigned char* dst = (part == 1 ? KT : VT) + c * 144;
#pragma unroll
            for (int q = 0; q < 8; ++q) { u32x4 o; o.x = pk[4 * q]; o.y = pk[4 * q + 1]; o.z = pk[4 * q + 2]; o.w = pk[4 * q + 3]; *(LAS u32x4*)(dst + q * 16) = o; } }
    } else if (tid < 448) {
        const int t = tid - 384;
        const float a = AB[(size_t)(tok0 + t) * 8 + h], bb = AB[(size_t)(tok0 + t) * 8 + 4 + h];
        const float xx = a + A.in[I_DTB][l * 4 + h];
        const float sp = xx > 20.f ? xx : log1pf(expf(xx));
        float lg = -expf(A.in[I_ALOG][l * 4 + h]) * sp;
#pragma unroll
        for (int off = 1; off < 64; off <<= 1) { const float v = __shfl_up(lg, off); if (lane >= off) lg += v; }
        GAM[t] = lg; BETA[t] = 1.f / (1.f + expf(-bb));
    }
    __syncthreads();
    {
        const int t = tid >> 3, part = tid & 7; float sq = 0.f, sk = 0.f;
#pragma unroll
        for (int j = 0; j < 16; ++j) { const float q = bf2f(QS[t * 136 + part * 16 + j]), k = bf2f(KS[t * 136 + part * 16 + j]); sq += q * q; sk += k * k; }
        sq = row_sum8(sq); sk = row_sum8(sk);
        if (part == 0) { const float rq = rsqrtf(sq + EPS) * 0.08838834764831845f, rk = rsqrtf(sk + EPS), g = GAM[t], eg = __expf(g), bt = BETA[t];
            RQ[t] = rq; RK[t] = rk; F2[t] = bt * eg * rk; F3[t] = rk * __expf(GAM[63] - g); F4[t] = rq * eg; }
    }
    {
        const int prod = wave >> 2, mt = wave & 3, fr = lane & 15, quad = lane >> 4;
        LAS bf16_t* Aop = prod ? QS : KS; LAS float* dst = prod ? PM : AM;
        bf16x8 a[4];
#pragma unroll
        for (int kk = 0; kk < 4; ++kk) a[kk] = *(LAS bf16x8*)(Aop + (mt * 16 + fr) * 136 + kk * 32 + quad * 8);
#pragma unroll
        for (int nt = 0; nt < 4; ++nt) { f32x4 acc = {0.f, 0.f, 0.f, 0.f};
#pragma unroll
            for (int kk = 0; kk < 4; ++kk) { const bf16x8 bq = *(LAS bf16x8*)(KS + (nt * 16 + fr) * 136 + kk * 32 + quad * 8); acc = mfma16(a[kk], bq, acc); }
#pragma unroll
            for (int i = 0; i < 4; ++i) dst[(mt * 16 + quad * 4 + i) * 68 + nt * 16 + fr] = acc[i]; }
    }
    __syncthreads();
    {
        const int t = tid >> 3, s8 = (tid & 7) * 8; const float gt = GAM[t], bk = BETA[t] * RK[t], rqt = RQ[t];
        float av[8], pv[8];
#pragma unroll
        for (int j = 0; j < 8; ++j) { const int s = s8 + j; const float rks = RK[s]; const float dec = (s <= t) ? __expf(gt - GAM[s]) * rks : 0.f;
            av[j] = (s < t) ? bk * dec * AM[t * 68 + s] : 0.f; pv[j] = rqt * dec * PM[t * 68 + s]; }
#pragma unroll
        for (int j = 0; j < 8; ++j) AM[t * 68 + s8 + j] = av[j];
        u32x4 o; o.x = pg8::cvt_pk_bf16(pv[0], pv[1]); o.y = pg8::cvt_pk_bf16(pv[2], pv[3]); o.z = pg8::cvt_pk_bf16(pv[4], pv[5]); o.w = pg8::cvt_pk_bf16(pv[6], pv[7]);
        *(u32x4*)((bf16_t*)(A.ws + WS_DQK) + (size_t)item * 4096 + t * 64 + s8) = o;
        for (int e = tid; e < 64 * 68; e += 512) TM[e] = 0.f;
        if (tid == 0) ((float*)(A.ws + WS_DGL))[item] = __expf(GAM[63]);
    }
    __syncthreads();
    if (wave == 0) {
        const int i = lane >> 4, c = lane & 15;
        LAS float* amp = AM + (16 * i) * 68 + 16 * i; asm volatile("" : "+v"(amp));
        float x[16];
#pragma unroll
        for (int r = 0; r < 16; ++r) { float acc = (r == c) ? 1.f : 0.f;
#pragma unroll
            for (int s = 0; s < r; ++s) acc = fmaf(-amp[r * 68 + s], x[s], acc);
            x[r] = acc; }
        LAS float* tmp = TM + (16 * i) * 68 + 16 * i + c;
#pragma unroll
        for (int r = 0; r < 16; ++r) tmp[r * 68] = x[r];
    } else {
        const int wt = tid - 64;
        for (int id = wt; id < 1024; id += 448) {
            const int c = id >> 3, t8 = (id & 7) * 8;
            const f32x4 b0 = *(LAS f32x4*)(BETA + t8), b1 = *(LAS f32x4*)(BETA + t8 + 4);
            u32x4 v = *(LAS u32x4*)(VT + c * 144 + t8 * 2);
            v.x = bfmul2(v.x, b0[0], b0[1]); v.y = bfmul2(v.y, b0[2], b0[3]); v.z = bfmul2(v.z, b1[0], b1[1]); v.w = bfmul2(v.w, b1[2], b1[3]);
            *(LAS u32x4*)(VT + c * 144 + t8 * 2) = v;
            const f32x4 f20 = *(LAS f32x4*)(F2 + t8), f21 = *(LAS f32x4*)(F2 + t8 + 4), f30 = *(LAS f32x4*)(F3 + t8), f31 = *(LAS f32x4*)(F3 + t8 + 4);
            const u32x4 k = *(LAS u32x4*)(KT + c * 144 + t8 * 2);
            u32x4 rk; rk.x = bfmul2(k.x, f20[0], f20[1]); rk.y = bfmul2(k.y, f20[2], f20[3]); rk.z = bfmul2(k.z, f21[0], f21[1]); rk.w = bfmul2(k.w, f21[2], f21[3]);
            *(LAS u32x4*)(RTK + c * 144 + t8 * 2) = rk;
            u32x4 kd; kd.x = bfmul2(k.x, f30[0], f30[1]); kd.y = bfmul2(k.y, f30[2], f30[3]); kd.z = bfmul2(k.z, f31[0], f31[1]); kd.w = bfmul2(k.w, f31[2], f31[3]);
            *(u32x4*)((bf16_t*)(A.ws + WS_DKT) + (size_t)item * 8192 + c * 64 + t8) = kd; }
        for (int id = wt; id < 1024; id += 448) {
            const int t = id >> 4, c8 = (id & 15) * 8; const float f = F4[t];
            u32x4 q = *(LAS u32x4*)((LAS unsigned char*)QS + t * 272 + c8 * 2);
            q.x = bfmul2(q.x, f, f); q.y = bfmul2(q.y, f, f); q.z = bfmul2(q.z, f, f); q.w = bfmul2(q.w, f, f);
            *(u32x4*)((bf16_t*)(A.ws + WS_DQD) + (size_t)item * 8192 + t * 128 + c8) = q; }
    }
    {
        const int c8 = (tid & 15) * 8; const float* on = A.in[I_ONORM] + l * 128 + c8;
        const f32x4 o0 = *(const f32x4*)on, o1 = *(const f32x4*)(on + 4);
#pragma unroll
        for (int j = 0; j < 2; ++j) { const int id = tid + 512 * j; const u32x4 g = gv[j]; u32x4 o;
            o.x = pg8::cvt_pk_bf16(silu_f(__uint_as_float(g.x << 16)) * o0[0], silu_f(__uint_as_float(g.x & 0xffff0000u)) * o0[1]);
            o.y = pg8::cvt_pk_bf16(silu_f(__uint_as_float(g.y << 16)) * o0[2], silu_f(__uint_as_float(g.y & 0xffff0000u)) * o0[3]);
            o.z = pg8::cvt_pk_bf16(silu_f(__uint_as_float(g.z << 16)) * o1[0], silu_f(__uint_as_float(g.z & 0xffff0000u)) * o1[1]);
            o.w = pg8::cvt_pk_bf16(silu_f(__uint_as_float(g.w << 16)) * o1[2], silu_f(__uint_as_float(g.w & 0xffff0000u)) * o1[3]);
            *(u32x4*)((bf16_t*)(A.ws + WS_DGS) + (size_t)item * 8192 + (id >> 4) * 128 + c8) = o; }
    }
    __syncthreads();
    const int p2 = tid >> 8, r2 = (tid >> 4) & 15, c2 = tid & 15, rb = p2 ? 48 : 16, cb = p2 ? 32 : 0;
    {
        float acc = 0.f;
#pragma unroll
        for (int s = 0; s < 16; ++s) acc = fmaf(AM[(rb + r2) * 68 + cb + s], TM[(cb + s) * 68 + cb + c2], acc);
        PSC[(p2 * 16 + r2) * 68 + c2] = acc; }
    __syncthreads();
    {
        float acc = 0.f;
#pragma unroll
        for (int s = 0; s < 16; ++s) acc = fmaf(TM[(rb + r2) * 68 + rb + s], PSC[(p2 * 16 + s) * 68 + c2], acc);
        TM[(rb + r2) * 68 + cb + c2] = -acc; }
    __syncthreads();
    float p3[2];
#pragma unroll
    for (int j = 0; j < 2; ++j) { const int e = tid + 512 * j, r = e >> 5, c = e & 31; float acc = 0.f;
#pragma unroll 8
        for (int s = 0; s < 32; ++s) acc = fmaf(AM[(32 + r) * 68 + s], TM[s * 68 + c], acc);
        p3[j] = acc; }
    __syncthreads();
#pragma unroll
    for (int j = 0; j < 2; ++j) { const int e = tid + 512 * j; PSC[(e >> 5) * 68 + (e & 31)] = p3[j]; }
    __syncthreads();
#pragma unroll
    for (int j = 0; j < 2; ++j) { const int e = tid + 512 * j, r = e >> 5, c = e & 31; float acc = 0.f;
#pragma unroll 8
        for (int s = 0; s < 32; ++s) acc = fmaf(TM[(32 + r) * 68 + 32 + s], PSC[s * 68 + c], acc);
        p3[j] = -acc; }
#pragma unroll
    for (int j = 0; j < 2; ++j) { const int e = tid + 512 * j; TM[(32 + (e >> 5)) * 68 + (e & 31)] = p3[j]; }
    __syncthreads();
#pragma unroll
    for (int j = 0; j < 4; ++j) { const int e = tid + 512 * j, t = e >> 5, s2 = (e & 31) * 2;
        *(LAS unsigned*)(TB + t * 144 + s2 * 2) = pg8::cvt_pk_bf16(TM[t * 68 + s2], TM[t * 68 + s2 + 1]); }
    __syncthreads();
    {
        const int fr = lane & 15, quad = lane >> 4;
        bf16x8 bv[2], ak[2];
#pragma unroll
        for (int kk = 0; kk < 2; ++kk) { bv[kk] = *(LAS bf16x8*)(VT + (16 * wave + fr) * 144 + (kk * 32 + quad * 8) * 2); ak[kk] = *(LAS bf16x8*)(RTK + (16 * wave + fr) * 144 + (kk * 32 + quad * 8) * 2); }
        bf16_t* DW = (bf16_t*)(A.ws + WS_DW) + (size_t)item * 8192; bf16_t* DKC = (bf16_t*)(A.ws + WS_DKC) + (size_t)item * 8192;
#pragma unroll
        for (int mt = 0; mt < 4; ++mt) { f32x4 aw = {0.f, 0.f, 0.f, 0.f}, akc = {0.f, 0.f, 0.f, 0.f};
#pragma unroll
            for (int kk = 0; kk < 2; ++kk) { const bf16x8 tf = *(LAS bf16x8*)(TB + (mt * 16 + fr) * 144 + (kk * 32 + quad * 8) * 2);
                aw = mfma16(tf, bv[kk], aw);
                akc = mfma16(ak[kk], tf, akc); }
            u32x2 ow; ow.x = pk2(aw[0], aw[1]); ow.y = pk2(aw[2], aw[3]);
            *(u32x2*)(DW + (16 * wave + fr) * 64 + mt * 16 + quad * 4) = ow;
            u32x2 ok; ok.x = pk2(-akc[0], -akc[1]); ok.y = pk2(-akc[2], -akc[3]);
            *(u32x2*)(DKC + (mt * 16 + fr) * 128 + 16 * wave + quad * 4) = ok; }
    }
    __syncthreads();
}

__device__ __forceinline__ void delta_scan_item(const DevArgs& A, int l, LAS unsigned char* lds, int bh, int tid_in, int wave, int lane_in, const XcdBarrier& xb, int SUB) {
    const int b = bh >> 2, h = bh & 3;
    LAS unsigned char* KCs = lds; LAS unsigned char* QDs = lds + 17408; LAS unsigned char* QKs = lds + 34816; LAS unsigned char* KDTs = lds + 44032;
    LAS unsigned char* Ws = lds + 62464;
    LAS unsigned char* GSs = lds + 80896;
    LAS unsigned char* SS = lds + 98304 + wave * 4352; LAS unsigned char* US = lds + 133120 + wave * 2304;
    LAS float* PART = (LAS float*)(lds + 151552);
    const unsigned char* gW = A.ws + WS_DW; const unsigned char* gGS = A.ws + WS_DGS;
    const unsigned char* gKC = A.ws + WS_DKC; const unsigned char* gQD = A.ws + WS_DQD; const unsigned char* gQK = A.ws + WS_DQK; const unsigned char* gKT = A.ws + WS_DKT;
    const float* DGL = (const float*)(A.ws + WS_DGL);
    f32x4 S[8];
#pragma unroll
    for (int mt = 0; mt < 8; ++mt) S[mt] = (f32x4){0.f, 0.f, 0.f, 0.f};
    u32x4 r[9], rg[2];
    float gl_all = 0.f;
#define DS_LOAD(itn, toff) do { const size_t _i = (size_t)(itn); const unsigned char* _kc = gKC + _i * 16384; const unsigned char* _qd = gQD + _i * 16384; \
        const unsigned char* _qk = gQK + _i * 8192; const unsigned char* _kt = gKT + _i * 16384; \
        r[0] = *(const u32x4*)(_kc + (toff)); r[1] = *(const u32x4*)(_kc + (toff) + 8192u); \
        r[2] = *(const u32x4*)(_qd + (toff)); r[3] = *(const u32x4*)(_qd + (toff) + 8192u); \
        r[4] = *(const u32x4*)(_qk + (toff)); \
        r[5] = *(const u32x4*)(_kt + (toff)); r[6] = *(const u32x4*)(_kt + (toff) + 8192u); \
        const unsigned char* _w = gW + _i * 16384; r[7] = *(const u32x4*)(_w + (toff)); r[8] = *(const u32x4*)(_w + (toff) + 8192u); } while (0)
#define DS_LOADG(itn, toff) do { const unsigned char* _g = gGS + (size_t)(itn) * 16384; rg[0] = *(const u32x4*)(_g + (toff)); rg[1] = *(const u32x4*)(_g + (toff) + 8192u); } while (0)
#define DS_STAGE(tidv) do { const int i0 = (tidv), i1 = (tidv) + 512; \
          *(LAS u32x4*)(KCs + (i0 >> 4) * 272 + (i0 & 15) * 16) = r[0]; *(LAS u32x4*)(KCs + (i1 >> 4) * 272 + (i1 & 15) * 16) = r[1]; \
          *(LAS u32x4*)(QDs + (i0 >> 4) * 272 + (i0 & 15) * 16) = r[2]; *(LAS u32x4*)(QDs + (i1 >> 4) * 272 + (i1 & 15) * 16) = r[3]; \
          *(LAS u32x4*)(QKs + (i0 >> 3) * 144 + (i0 & 7) * 16) = r[4]; \
          *(LAS u32x4*)(KDTs + (i0 >> 3) * 144 + (i0 & 7) * 16) = r[5]; *(LAS u32x4*)(KDTs + (i1 >> 3) * 144 + (i1 & 7) * 16) = r[6]; \
          *(LAS u32x4*)(Ws + (i0 >> 3) * 144 + (i0 & 7) * 16) = r[7]; *(LAS u32x4*)(Ws + (i1 >> 3) * 144 + (i1 & 7) * 16) = r[8]; } while (0)
#define DS_STAGEG(tidv) do { const int i0 = (tidv), i1 = (tidv) + 512; \
          *(LAS u32x4*)(GSs + (i0 >> 4) * 272 + (i0 & 15) * 16) = rg[0]; *(LAS u32x4*)(GSs + (i1 >> 4) * 272 + (i1 & 15) * 16) = rg[1]; } while (0)
#pragma unroll 1
    for (int n = 0; n < 32; ++n) {
        int tid = tid_in; asm volatile("" : "+v"(tid));
        const bool bstart = (SUB > 0) ? (n % SUB == 0) : (n == 0);
        const bool bnext1 = (SUB > 0) && ((n + 1) % SUB == 0), bnext2 = (SUB > 0) && ((n + 2) % SUB == 0);
        if (bstart) { if (n > 0) xcd_barrier(xb);
            gl_all = DGL[bh * 32 + (tid & 31)];
            const unsigned t0 = (unsigned)tid * 16u; DS_LOAD(bh * 32 + n, t0); DS_LOADG(bh * 32 + n, t0); DS_STAGE(tid); DS_STAGEG(tid);
            if (n + 1 < 32 && !bnext1) { DS_LOAD(bh * 32 + n + 1, t0); DS_LOADG(bh * 32 + n + 1, t0); }
            __syncthreads(); }
        else { DS_STAGEG(tid);
            if (n + 1 < 32 && !bnext1) DS_LOADG(bh * 32 + n + 1, (unsigned)tid * 16u); }
        const int lane = tid & 63, fr = lane & 15, quad = lane >> 4, vcol = 16 * wave + fr;
        const unsigned toff = (unsigned)tid * 16u;
        const int it = bh * 32 + n, tokb = b * SEQ + n * 64;
        const float glast = __builtin_bit_cast(float, __builtin_amdgcn_readlane(__builtin_bit_cast(int, gl_all), n));
        asm volatile("s_nop 7\n\ts_nop 7" ::: "memory");
#pragma unroll
        for (int mt = 0; mt < 8; ++mt) { u32x2 p; p.x = pg8::cvt_pk_bf16(S[mt][0], S[mt][1]); p.y = pg8::cvt_pk_bf16(S[mt][2], S[mt][3]); *(LAS u32x2*)(SS + fr * 272 + (mt * 16 + quad * 4) * 2) = p; }
        LDS_FENCE();
        bf16x8 Sb[4];
#pragma unroll
        for (int kk = 0; kk < 4; ++kk) Sb[kk] = *(LAS bf16x8*)(SS + fr * 272 + (kk * 32 + quad * 8) * 2);
        f32x4 U[4], O[4];
#pragma unroll
        for (int mt = 0; mt < 4; ++mt) { f32x4 au, ao = {0.f, 0.f, 0.f, 0.f};
            { const u32x2 wq = *(LAS u32x2*)(Ws + vcol * 144 + (mt * 16 + quad * 4) * 2);
              au[0] = __uint_as_float(wq.x << 16); au[1] = __uint_as_float(wq.x & 0xffff0000u); au[2] = __uint_as_float(wq.y << 16); au[3] = __uint_as_float(wq.y & 0xffff0000u); }
#pragma unroll
            for (int kk = 0; kk < 4; ++kk) { const bf16x8 a1 = *(LAS bf16x8*)(KCs + (mt * 16 + fr) * 272 + (kk * 32 + quad * 8) * 2); au = mfma16(a1, Sb[kk], au);
                const bf16x8 a2 = *(LAS bf16x8*)(QDs + (mt * 16 + fr) * 272 + (kk * 32 + quad * 8) * 2); ao = mfma16(a2, Sb[kk], ao); }
            U[mt] = au; O[mt] = ao; __builtin_amdgcn_sched_barrier(0); }
        asm volatile("s_nop 7\n\ts_nop 7" ::: "memory");
#pragma unroll
        for (int mt = 0; mt < 4; ++mt) { u32x2 p; p.x = pg8::cvt_pk_bf16(U[mt][0], U[mt][1]); p.y = pg8::cvt_pk_bf16(U[mt][2], U[mt][3]); *(LAS u32x2*)(US + fr * 144 + (mt * 16 + quad * 4) * 2) = p; }
        LDS_FENCE();
        bf16x8 Ub[2];
#pragma unroll
        for (int kk = 0; kk < 2; ++kk) Ub[kk] = *(LAS bf16x8*)(US + fr * 144 + (kk * 32 + quad * 8) * 2);
#pragma unroll
        for (int mt = 0; mt < 4; ++mt)
#pragma unroll
            for (int kk = 0; kk < 2; ++kk) { const bf16x8 a = *(LAS bf16x8*)(QKs + (mt * 16 + fr) * 144 + (kk * 32 + quad * 8) * 2); O[mt] = mfma16(a, Ub[kk], O[mt]); }
        __builtin_amdgcn_sched_barrier(0);
#pragma unroll
        for (int mt = 0; mt < 8; ++mt) { S[mt] *= glast;
#pragma unroll
            for (int kk = 0; kk < 2; ++kk) { const bf16x8 a = *(LAS bf16x8*)(KDTs + (mt * 16 + fr) * 144 + (kk * 32 + quad * 8) * 2); S[mt] = mfma16(a, Ub[kk], S[mt]); }
            if (mt & 1) __builtin_amdgcn_sched_barrier(0); }
        { float pp[16];
#pragma unroll
          for (int e = 0; e < 16; ++e) pp[e] = O[e >> 2][e & 3] * O[e >> 2][e & 3];
#pragma unroll
          for (int e = 0; e < 16; ++e) pp[e] = row_sum16(pp[e]);
          if (fr == 0) {
#pragma unroll
              for (int e = 0; e < 16; ++e) PART[((e >> 2) * 16 + quad * 4 + (e & 3)) * 8 + wave] = pp[e]; } }
        __syncthreads();
        if (n + 1 < 32 && !bnext1) { DS_STAGE(tid); if (n + 2 < 32 && !bnext2) DS_LOAD(it + 2, toff); }
        bf16_t* mixb = (bf16_t*)(A.ws + WS_MIX) + (size_t)tokb * D + h * 128;
#pragma unroll
        for (int mt = 0; mt < 4; ++mt)
#pragma unroll
            for (int i = 0; i < 4; ++i) { const int t = mt * 16 + quad * 4 + i;
                const f32x4 p0 = *(LAS f32x4*)(PART + t * 8), p1 = *(LAS f32x4*)(PART + t * 8 + 4);
                const float tot = ((p0[0] + p0[1]) + (p0[2] + p0[3])) + ((p1[0] + p1[1]) + (p1[2] + p1[3]));
                const float sc = rsqrtf(tot * (1.f / 128.f) + EPS);
                const float gs = bf2f(*(LAS bf16_t*)(GSs + t * 272 + vcol * 2));
                mixb[(unsigned)(t * D + vcol)] = (bf16_t)(pg8::cvt_pk_bf16(O[mt][i] * sc * gs, 0.f) & 0xffffu); }
        __syncthreads();
    }
#undef DS_STAGE
#undef DS_LOADG
#undef DS_STAGEG
#undef DS_LOAD
    { const int lane = lane_in, fr = lane & 15, quad = lane >> 4, vcol = 16 * wave + fr;
      float* dp = A.out + O_DP + (size_t)((l * 8 + b) * 4 + h) * 16384;
#pragma unroll
      for (int mt = 0; mt < 8; ++mt)
#pragma unroll
          for (int i = 0; i < 4; ++i) dp[(mt * 16 + quad * 4 + i) * 128 + vcol] = S[mt][i]; }
    __syncthreads();
}

__device__ __forceinline__ void delta_sample_item(const DevArgs& A, int l, LAS unsigned char* lds, int item, int tid, int wave, int lane) {
    asm volatile("" : "+v"(tid)); lane = tid & 63; wave = __builtin_amdgcn_readfirstlane(tid >> 6);
    const int b = item >> 2, h = item & 3, tokS = NP + b * 4;
    LAS float* RAW = (LAS float*)lds; LAS float* RED = RAW + 1536; LAS float* OB = RED + 512; LAS float* SC = OB + 512;
    const bf16_t* PROJ = (const bf16_t*)(A.ws + WS_PROJ); const float* AB = (const float*)(A.ws + WS_AB); bf16_t* MIX = (bf16_t*)(A.ws + WS_MIX);
    const float* cw = A.in[I_CONVW] + (size_t)l * 4 * 1536;
    for (int idx = tid; idx < 1536; idx += 512) { const int part = idx >> 9, t = (idx >> 7) & 3, c = idx & 127, col = part * 512 + h * 128 + c;
        float acc = 0.f;
#pragma unroll
        for (int j = 0; j < 4; ++j) { const int tt = t - 3 + j;
            const float x = (tt >= 0) ? bf2f(PROJ[(size_t)(tokS + tt) * NPROJ + col]) : A.in[I_SCONV][((size_t)(l * 128 + b) * 3 + (3 + tt)) * 1536 + col];
            acc += cw[j * 1536 + col] * x; }
        RAW[idx] = silu_f(acc); }
    if (tid < 4) { const float a = AB[(size_t)(tokS + tid) * 8 + h], bb = AB[(size_t)(tokS + tid) * 8 + 4 + h];
        const float xx = a + A.in[I_DTB][l * 4 + h]; const float sp = xx > 20.f ? xx : log1pf(expf(xx));
        SC[8 + tid] = 1.f / (1.f + expf(-bb)); SC[12 + tid] = expf(-expf(A.in[I_ALOG][l * 4 + h]) * sp); }
    const int v = tid & 127, kq = tid >> 7;
    float S[32];
    { const float* sp = A.in[I_SDELTA] + (size_t)((l * 128 + b) * 4 + h) * 16384;
#pragma unroll
      for (int i = 0; i < 32; ++i) S[i] = sp[(kq * 32 + i) * 128 + v]; }
    __syncthreads();
    { const int part = wave >> 2, t = wave & 3; const float x0 = RAW[part * 512 + t * 128 + lane], x1 = RAW[part * 512 + t * 128 + 64 + lane];
      const float ss = wave_sum(x0 * x0 + x1 * x1); if (lane == 0) SC[part * 4 + t] = rsqrtf(ss + EPS) * (part == 0 ? 0.08838834764831845f : 1.f); }
    __syncthreads();
    for (int t = 0; t < 4; ++t) {
        const float rq = SC[t], rk = SC[4 + t], beta = SC[8 + t], g = SC[12 + t];
        float pr = 0.f;
#pragma unroll
        for (int i = 0; i < 32; ++i) pr += S[i] * RAW[512 + t * 128 + kq * 32 + i];
        RED[kq * 128 + v] = pr * rk;
        __syncthreads();
        const float rr = (RED[v] + RED[128 + v]) + (RED[256 + v] + RED[384 + v]);
        const float u = beta * (RAW[1024 + t * 128 + v] - g * rr);
        float po = 0.f;
#pragma unroll
        for (int i = 0; i < 32; ++i) { const float kh = RAW[512 + t * 128 + kq * 32 + i] * rk; S[i] = g * S[i] + kh * u; po += S[i] * RAW[t * 128 + kq * 32 + i]; }
        __syncthreads();
        RED[kq * 128 + v] = po * rq;
        __syncthreads();
        if (kq == 0) OB[t * 128 + v] = (RED[v] + RED[128 + v]) + (RED[256 + v] + RED[384 + v]);
        __syncthreads();
    }
    if (wave < 4) { const int t = wave; const float x0 = OB[t * 128 + lane], x1 = OB[t * 128 + 64 + lane];
        const float ss = wave_sum(x0 * x0 + x1 * x1); const float sc = rsqrtf(ss * (1.f / 128.f) + EPS);
        const float g0 = bf2f(PROJ[(size_t)(tokS + t) * NPROJ + PC_G + h * 128 + lane]), g1 = bf2f(PROJ[(size_t)(tokS + t) * NPROJ + PC_G + h * 128 + 64 + lane]);
        MIX[(size_t)(tokS + t) * D + h * 128 + lane] = (bf16_t)f2bf(x0 * sc * A.in[I_ONORM][l * 128 + lane] * silu_f(g0));
        MIX[(size_t)(tokS + t) * D + h * 128 + 64 + lane] = (bf16_t)f2bf(x1 * sc * A.in[I_ONORM][l * 128 + 64 + lane] * silu_f(g1)); }
    { float* dsp = A.out + O_DS + (size_t)((l * 128 + b) * 4 + h) * 16384;
#pragma unroll
      for (int i = 0; i < 32; ++i) dsp[(kq * 32 + i) * 128 + v] = S[i]; }
    __syncthreads();
}

#define SSM_BCAST_U(t) do { unsigned _w[8]; \
        _w[0] = __builtin_amdgcn_readlane(ua.x, t); _w[1] = __builtin_amdgcn_readlane(ua.y, t); _w[2] = __builtin_amdgcn_readlane(ua.z, t); _w[3] = __builtin_amdgcn_readlane(ua.w, t); \
        _w[4] = __builtin_amdgcn_readlane(ub.x, t); _w[5] = __builtin_amdgcn_readlane(ub.y, t); _w[6] = __builtin_amdgcn_readlane(ub.z, t); _w[7] = __builtin_amdgcn_readlane(ub.w, t); \
        _Pragma("unroll") for (int _d = 0; _d < 8; ++_d) { uu[2 * _d] = __uint_as_float(_w[_d] << 16); uu[2 * _d + 1] = __uint_as_float(_w[_d] & 0xffff0000u); } } while (0)
#define SSM_STEP() do { float _br = 0.f, _bi = 0.f; \
        _Pragma("unroll") for (int _h = 0; _h < 16; ++_h) { _br = fmaf(Br[_h], uu[_h], _br); _bi = fmaf(Bi[_h], uu[_h], _bi); } \
        const float _nr = lr * hr - li * hi + _br, _ni = lr * hi + li * hr + _bi; hr = _nr; hi = _ni; } while (0)

__device__ __forceinline__ void ssm_part1_item(const DevArgs& A, int l, int it, int lane) {
    const int g = it & 15, bc = it >> 4, b = bc / 31, c = bc % 31;
    const float* bb = (const float*)(A.ws + WS_BBAR) + ((size_t)(l * 16 + g) * 64 + lane) * 32;
    float Br[16], Bi[16];
#pragma unroll
    for (int q = 0; q < 4; ++q) { const f32x4 x = ((const f32x4*)bb)[q], y = ((const f32x4*)bb)[4 + q];
        Br[4 * q] = x.x; Br[4 * q + 1] = x.y; Br[4 * q + 2] = x.z; Br[4 * q + 3] = x.w; Bi[4 * q] = y.x; Bi[4 * q + 1] = y.y; Bi[4 * q + 2] = y.z; Bi[4 * q + 3] = y.w; }
    const f32x4 lk = ((const f32x4*)(A.ws + WS_SSMK))[(l * 16 + g) * 64 + lane]; const float lr = lk.x, li = lk.y;
    const bf16_t* up = (const bf16_t*)(A.ws + WS_PROJ) + (size_t)(b * SEQ + c * 64 + lane) * NPROJ + PC_SSM + g * 16;
    const u32x4 ua = *(const u32x4*)up, ub = *(const u32x4*)(up + 8);
    float hr = 0.f, hi = 0.f, uu[16];
#pragma unroll 1
    for (int t = 0; t < 64; ++t) { SSM_BCAST_U(t); SSM_STEP(); }
    f32x2 e; e.x = hr; e.y = hi;
    ((f32x2*)(A.ws + WS_SSME))[((size_t)(b * 32 + c) * 16 + g) * 64 + lane] = e;
}

__device__ __forceinline__ void ssm_part2_item(const DevArgs& A, int l, LAS unsigned char* lds, int it, int tid, int wave, int lane) {
    asm volatile("" : "+v"(tid)); lane = tid & 63; wave = __builtin_amdgcn_readfirstlane(tid >> 6);
    const int tok0 = it * 64, fr = lane & 15, quad = lane >> 4;
    const bool samp = it >= 256; const int b = it >> 5, c = it & 31;
    LAS unsigned char* YS = lds; LAS unsigned char* HS = lds + 33792 + wave * 4352;
    const bf16_t* PROJ = (const bf16_t*)(A.ws + WS_PROJ); bf16_t* MIX = (bf16_t*)(A.ws + WS_MIX);
#pragma unroll 1
    for (int gi = 0; gi < 2; ++gi) {
        const int g = wave * 2 + gi;
        const float* bb = (const float*)(A.ws + WS_BBAR) + ((size_t)(l * 16 + g) * 64 + lane) * 32;
        float Br[16], Bi[16];
#pragma unroll
        for (int q = 0; q < 4; ++q) { const f32x4 x = ((const f32x4*)bb)[q], y = ((const f32x4*)bb)[4 + q];
            Br[4 * q] = x.x; Br[4 * q + 1] = x.y; Br[4 * q + 2] = x.z; Br[4 * q + 3] = x.w; Bi[4 * q] = y.x; Bi[4 * q + 1] = y.y; Bi[4 * q + 2] = y.z; Bi[4 * q + 3] = y.w; }
        const f32x4 lk = ((const f32x4*)(A.ws + WS_SSMK))[(l * 16 + g) * 64 + lane]; const float lr = lk.x, li = lk.y, Lr = lk.z, Li = lk.w;
        bf16x8 Cb[4];
#pragma unroll
        for (int kk = 0; kk < 4; ++kk) { const size_t co = ((size_t)(l * 16 + g) * 16 + fr) * 64 + kk * 16 + quad * 4;
            const f32x4 cr = *(const f32x4*)(A.in[I_CRE] + co), ci = *(const f32x4*)(A.in[I_CIM] + co);
            u32x4 pk; pk.x = pk2(cr.x, -ci.x); pk.y = pk2(cr.y, -ci.y); pk.z = pk2(cr.z, -ci.z); pk.w = pk2(cr.w, -ci.w);
            Cb[kk] = __builtin_bit_cast(bf16x8, pk); }
        const bf16_t* up = PROJ + (size_t)(tok0 + lane) * NPROJ + PC_SSM + g * 16;
        const u32x4 ua = *(const u32x4*)up, ub = *(const u32x4*)(up + 8);
        float hr = 0.f, hi = 0.f, uu[16];
        if (!samp && c > 0) { const f32x2* E = (const f32x2*)(A.ws + WS_SSME) + ((size_t)(b * 32) * 16 + g) * 64 + lane;
#pragma unroll
            for (int cb = 0; cb < 32; cb += 16) { f32x2 ev[16];
#pragma unroll
                for (int q = 0; q < 16; ++q) { const int cc = cb + q; ev[q] = (cc < c) ? E[(size_t)cc * 1024] : (f32x2){0.f, 0.f}; }
#pragma unroll
                for (int q = 0; q < 16; ++q) { const int cc = cb + q; if (cc < c) { const float nr = Lr * hr - Li * hi + ev[q].x, ni = Lr * hi + Li * hr + ev[q].y; hr = nr; hi = ni; } } } }
        const float dsk = A.in[I_SSMD][l * 256 + g * 16 + fr];
        unsigned uvr[16];
#pragma unroll
        for (int e = 0; e < 16; ++e) uvr[e] = PROJ[(size_t)(tok0 + (e >> 2) * 16 + quad * 4 + (e & 3)) * NPROJ + PC_SSM + g * 16 + fr];
#pragma unroll
        for (int sub = 0; sub < 4; ++sub) {
#pragma unroll 1
            for (int tt = 0; tt < 16; ++tt) { const int t = sub * 16 + tt;
                const int sb = (it - 256) * 16 + (t >> 2);
                if (samp && (t & 3) == 0) { hr = A.in[I_SRE][((size_t)(l * 128 + sb) * 16 + g) * 64 + lane]; hi = A.in[I_SIM][((size_t)(l * 128 + sb) * 16 + g) * 64 + lane]; }
                SSM_BCAST_U(t); SSM_STEP();
                *(LAS unsigned*)(HS + tt * 272 + lane * 4) = pg8::cvt_pk_bf16(hr, hi);
                if (samp && (t & 3) == 3) { A.out[O_RES + ((size_t)(l * 128 + sb) * 16 + g) * 64 + lane] = hr; A.out[O_IMS + ((size_t)(l * 128 + sb) * 16 + g) * 64 + lane] = hi; }
            }
            LDS_FENCE();
            f32x4 acc = {0.f, 0.f, 0.f, 0.f};
#pragma unroll
            for (int kk = 0; kk < 4; ++kk) { const bf16x8 a = *(LAS bf16x8*)(HS + fr * 272 + (kk * 32 + quad * 8) * 2); acc = mfma16(a, Cb[kk], acc); }
#pragma unroll
            for (int i = 0; i < 4; ++i) { const int t = sub * 16 + quad * 4 + i; const float uv = bf2f(uvr[sub * 4 + i]);
                *(LAS bf16_t*)(YS + t * 528 + (g * 16 + fr) * 2) = (bf16_t)f2bf(gelu_tanh_f(acc[i] + dsk * uv)); }
            LDS_FENCE();
        }
        if (!samp && c == 31) { A.out[O_REP + ((size_t)(l * 8 + b) * 16 + g) * 64 + lane] = hr; A.out[O_IMP + ((size_t)(l * 8 + b) * 16 + g) * 64 + lane] = hi; }
    }
    __syncthreads();
    {
        const bf16_t* GT = (const bf16_t*)(A.ws + WS_GLUT + l * SZ_GLUT);
        f32x4 acc[4][2];
#pragma unroll
        for (int mt = 0; mt < 4; ++mt) { acc[mt][0] = (f32x4){0.f, 0.f, 0.f, 0.f}; acc[mt][1] = (f32x4){0.f, 0.f, 0.f, 0.f}; }
#pragma unroll
        for (int kk = 0; kk < 8; ++kk) { bf16x8 bfr[2];
#pragma unroll
            for (int nt = 0; nt < 2; ++nt) bfr[nt] = *(const bf16x8*)(GT + (size_t)(32 * wave + nt * 16 + fr) * 256 + kk * 32 + quad * 8);
#pragma unroll
            for (int mt = 0; mt < 4; ++mt) { const bf16x8 a = *(LAS bf16x8*)(YS + (mt * 16 + fr) * 528 + (kk * 32 + quad * 8) * 2);
                acc[mt][0] = mfma16(a, bfr[0], acc[mt][0]); acc[mt][1] = mfma16(a, bfr[1], acc[mt][1]); } }
#pragma unroll
        for (int nt = 0; nt < 2; ++nt) { const int ncol = 32 * wave + nt * 16 + fr; const float gb = A.in[I_GLUB][l * 256 + ncol];
#pragma unroll
            for (int mt = 0; mt < 4; ++mt)
#pragma unroll
                for (int i = 0; i < 4; ++i) { const int t = mt * 16 + quad * 4 + i; const float y = bf2f(*(LAS bf16_t*)(YS + t * 528 + ncol * 2));
                    MIX[(size_t)(tok0 + t) * D + 512 + ncol] = (bf16_t)f2bf(y * sigmoid_f(acc[mt][nt][i] + gb)); } }
    }
    __syncthreads();
}

__device__ __forceinline__ void pool_item(const DevArgs& A, int l, LAS unsigned char* lds, int it, int tid, int wave, int lane) {
    asm volatile("" : "+v"(tid)); lane = tid & 63; wave = __builtin_amdgcn_readfirstlane(tid >> 6);
    const int tok0 = it * 64, fr = lane & 15, quad = lane >> 4; const bool samp = it >= 256;
    LAS unsigned char* RS = lds;
    const bf16_t* PROJ = (const bf16_t*)(A.ws + WS_PROJ); bf16_t* MIX = (bf16_t*)(A.ws + WS_MIX);
    if (!samp) {
        LAS unsigned char* XT = lds + 33792;
        const int b = it >> 5, c = it & 31;
        for (int id = tid; id < 79 * 32; id += 512) { const int r = id >> 5, c16 = id & 31, tl = c * 64 - 15 + r;
            u32x4 v = {0u, 0u, 0u, 0u}; if (tl >= 0) v = *(const u32x4*)(PROJ + (size_t)(b * SEQ + tl) * NPROJ + PC_POOL + c16 * 8);
            *(LAS u32x4*)(XT + r * 528 + c16 * 16) = v; }
        __syncthreads();
        const int ch = tid & 255, half = tid >> 8, g = ch >> 6, w = 2 << g, r0 = half * 32;
        float sum = 0.f;
        for (int j = 0; j < w; ++j) sum += bf2f(*(LAS bf16_t*)(XT + (r0 + 15 - j) * 528 + ch * 2));
#pragma unroll 4
        for (int rr = 0; rr < 32; ++rr) { const int r = r0 + rr, tl = c * 64 + r;
            const float u = bf2f(*(LAS bf16_t*)(XT + (r + 15) * 528 + ch * 2));
            if (rr > 0) sum += u - bf2f(*(LAS bf16_t*)(XT + (r + 15 - w) * 528 + ch * 2));
            const float rc = __builtin_amdgcn_rcpf((float)((tl + 1 < w) ? tl + 1 : w));
            *(LAS bf16_t*)(RS + r * 528 + ch * 2) = (bf16_t)f2bf(sum * rc - u); }
    } else {
#pragma unroll 1
        for (int pr = 0; pr < 8; ++pr) { const int idx = pr * 512 + tid, ch = idx & 255, sq = idx >> 8, g = ch >> 6, w = 2 << g;
            const int sb = (it - 256) * 16 + sq;
            const float* sbuf = A.in[I_SPOOL] + (size_t)(l * 128 + sb) * 15 * 256 + ch;
            const bf16_t* base = PROJ + (size_t)(NP + sb * 4) * NPROJ + PC_POOL + ch;
            float e[19];
#pragma unroll
            for (int j = 0; j < 15; ++j) e[j] = sbuf[j * 256];
#pragma unroll
            for (int j = 0; j < 4; ++j) e[15 + j] = bf2f(base[(size_t)j * NPROJ]);
#pragma unroll
            for (int t = 0; t < 4; ++t) { float sum = 0.f;
#pragma unroll
                for (int j = 0; j < 16; ++j) sum += (j < w) ? e[15 + t - j] : 0.f;
                *(LAS bf16_t*)(RS + (sq * 4 + t) * 528 + ch * 2) = (bf16_t)f2bf(sum * __builtin_amdgcn_rcpf((float)w) - e[15 + t]); } }
    }
    __syncthreads();
    { const int g2 = wave >> 1; const bf16_t* PT = (const bf16_t*)(A.ws + WS_POOLT + l * SZ_POOLT) + g2 * 4096;
      f32x4 acc[4][2];
#pragma unroll
      for (int mt = 0; mt < 4; ++mt) { acc[mt][0] = (f32x4){0.f, 0.f, 0.f, 0.f}; acc[mt][1] = (f32x4){0.f, 0.f, 0.f, 0.f}; }
#pragma unroll
      for (int kk = 0; kk < 2; ++kk) { bf16x8 bfr[2];
#pragma unroll
          for (int nt = 0; nt < 2; ++nt) bfr[nt] = *(const bf16x8*)(PT + (size_t)((wave & 1) * 32 + nt * 16 + fr) * 64 + kk * 32 + quad * 8);
#pragma unroll
          for (int mt = 0; mt < 4; ++mt) { const bf16x8 a = *(LAS bf16x8*)(RS + (mt * 16 + fr) * 528 + (g2 * 64 + kk * 32 + quad * 8) * 2);
              acc[mt][0] = mfma16(a, bfr[0], acc[mt][0]); acc[mt][1] = mfma16(a, bfr[1], acc[mt][1]); } }
#pragma unroll
      for (int nt = 0; nt < 2; ++nt) { const int col = 32 * wave + nt * 16 + fr; const float ps = A.in[I_POOLS][l * 256 + col];
#pragma unroll
          for (int mt = 0; mt < 4; ++mt)
#pragma unroll
              for (int i = 0; i < 4; ++i) { const int t = mt * 16 + quad * 4 + i; MIX[(size_t)(tok0 + t) * D + 768 + col] = (bf16_t)f2bf(acc[mt][nt][i] * ps); } } }
    __syncthreads();
}

__device__ __forceinline__ void state_copies(const DevArgs& A, int l, int gt, int NT) {
    const bf16_t* PROJ = (const bf16_t*)(A.ws + WS_PROJ);
#pragma unroll 1
    for (int i = gt; i < 8 * 3 * 1536; i += NT) { const int col = i % 1536, j = (i / 1536) % 3, b = i / 4608;
        A.out[O_CP + (size_t)l * 8 * 4608 + i] = bf2f(PROJ[(size_t)(b * SEQ + SEQ - 3 + j) * NPROJ + col]); }
#pragma unroll 1
    for (int i = gt; i < 128 * 3 * 1536; i += NT) { const int col = i % 1536, j = (i / 1536) % 3, b = i / 4608;
        A.out[O_CS + (size_t)l * 128 * 4608 + i] = bf2f(PROJ[(size_t)(NP + b * 4 + 1 + j) * NPROJ + col]); }
#pragma unroll 1
    for (int i = gt; i < 8 * 15 * 256; i += NT) { const int ch = i & 255, j = (i >> 8) % 15, b = i / 3840;
        A.out[O_PP + (size_t)l * 8 * 3840 + i] = bf2f(PROJ[(size_t)(b * SEQ + SEQ - 15 + j) * NPROJ + PC_POOL + ch]); }
#pragma unroll 1
    for (int i = gt; i < 128 * 15 * 256; i += NT) { const int ch = i & 255, j = (i >> 8) % 15, b = i / 3840;
        A.out[O_PS + (size_t)l * 128 * 3840 + i] = (j < 11) ? A.in[I_SPOOL][((size_t)(l * 128 + b) * 15 + 4 + j) * 256 + ch]
                                                             : bf2f(PROJ[(size_t)(NP + b * 4 + (j - 11)) * NPROJ + PC_POOL + ch]); }
}

#ifndef REP_DPREP
#define REP_DPREP 1
#endif
#ifndef REP_DSAMP
#define REP_DSAMP 1
#endif
#ifndef REP_SSM1
#define REP_SSM1 1
#endif
#ifndef REP_POOL
#define REP_POOL 1
#endif
#ifndef REP_DSCAN
#define REP_DSCAN 1
#endif
#ifndef REP_SSM2
#define REP_SSM2 1
#endif
#ifndef REP_G
#define REP_G 1
#endif
#ifndef REP_P3
#define REP_P3 1
#endif
#ifndef REP_P2
#define REP_P2 1
#endif
constexpr int NPH = 2 + DEPTH * 8;
__global__ void __launch_bounds__(512, 2) mega_fwd(Args KA) {
    DevArgs A; A.out = KA.out; A.ws = KA.ws; A.ph_lo = KA.ph_lo; A.ph_hi = KA.ph_hi;
    extern __shared__ __attribute__((aligned(16))) unsigned char lds_raw[];
    LAS unsigned char* lds = (LAS unsigned char*)lds_raw;
    cg::grid_group grid = cg::this_grid();
    volatile LAS unsigned* xst = (volatile LAS unsigned*)(lds + LDS_BYTES - 64);
    if (threadIdx.x == 0) { xst[0] = 0u; xst[1] = 0u; }
    __syncthreads();
    const XcdBarrier xb = xcd_barrier_post((unsigned*)(KA.ws + WS_BAR), xst);
    constexpr int G = 256, NGW = G * 8, NT = G * 512;
    int ph = 0;
#define PH_BEGIN if (A.ph_lo <= ph && ph < A.ph_hi) { int tid = threadIdx.x; asm volatile("" : "+v"(tid)); { unsigned char* _w = A.ws; asm volatile("" : "+s"(_w)); A.ws = _w; float* _o = A.out; asm volatile("" : "+s"(_o)); A.out = _o; } const int wave = __builtin_amdgcn_readfirstlane(tid >> 6), lane = tid & 63, gw = blockIdx.x * 8 + wave, gt = blockIdx.x * 512 + tid; (void)gw; (void)gt; (void)lane;
#define PH_END   if (ph + 1 < A.ph_hi) { if (ph == 0) grid.sync(); else xcd_barrier(xb); } } ++ph;
#define Hb   ((bf16_t*)(A.ws + WS_H))
#define AB   ((float*)(A.ws + WS_AB))
#define MIXO ((float*)(A.ws + WS_MIXO))
#define PROJ ((bf16_t*)(A.ws + WS_PROJ))
#define MIX  ((bf16_t*)(A.ws + WS_MIX))
#define HID  ((bf16_t*)(A.ws + WS_HID))
#define RSCBUF ((float*)(A.ws + WS_RSC))
#define XBUF ((bf16_t*)(A.ws + WS_MIXO + (size_t)NTOK * D * 2))

#ifndef REP_PRO
#define REP_PRO 1
#endif
#ifndef REP_N0
#define REP_N0 1
#endif
    PH_BEGIN for (int rep = 0; rep < REP_PRO; ++rep) { prologue(A, lds, wave, lane, gw, NGW); __syncthreads(); } PH_END
    PH_BEGIN for (int rep = 0; rep < REP_N0; ++rep) norm_rows(nullptr, nullptr, A.in[I_XP], A.in[I_XS], nullptr, A.in[I_NMPRE], RSCBUF, (const float*)(A.ws + WS_WAB), AB, gw, NGW, lane, nullptr, 0, nullptr, XBUF); PH_END

#pragma unroll 1
    for (int l = 0; l < DEPTH; ++l) {
        PH_BEGIN for (int rep = 0; rep < REP_G; ++rep) { pg8::Gemm g{XBUF, (const bf16_t*)(A.ws + WS_WIN + l * SZ_WIN), NTOK, NPROJ, D, D, D}; pg8::StaticOrder S; S.init(NTOK, NPROJ, G, (int)blockIdx.x);
            EpiBf16Scale E{PROJ, NPROJ, RSCBUF}; pg8::gemm_phase<EpiBf16Scale, pg8::StaticOrder>(lds, g, S, E, nullptr); } PH_END
        constexpr int SUBC = 7;
        PH_BEGIN {
#pragma unroll 1
          for (int rep2 = 0; rep2 < REP_P2; ++rep2) {
#pragma unroll 1
            for (int j = blockIdx.x; j < 32 * SUBC; j += G) delta_prep_item(A, l, lds, (j & 31) * 32 + (j >> 5), tid, wave, lane);
          }
        } PH_END
        PH_BEGIN {
#pragma unroll 1
            for (int rep3 = 0; rep3 < REP_P3; ++rep3) {
                if (blockIdx.x < 32) delta_scan_item(A, l, lds, blockIdx.x, tid, wave, lane, xb, SUBC);
                else { const int w = blockIdx.x - 32; constexpr int NW = G - 32;
#pragma unroll 1
                    for (int k = 1; k <= 5; ++k) {
                        const int n0 = k * SUBC, nn = (n0 >= 32) ? 0 : ((32 - n0 < SUBC) ? 32 - n0 : SUBC);
                        int nprep = 32 * nn;
#ifndef REP_WPREP
#define REP_WPREP 1
#endif
#pragma unroll 1
                        for (int rep = 0; rep < REP_WPREP; ++rep)
#pragma unroll 1
                        for (int j = w; j < nprep; j += NW) delta_prep_item(A, l, lds, (j & 31) * 32 + n0 + (j >> 5), tid, wave, lane);
                        if (k == 1) {
#pragma unroll 1
                            for (int it = w; it < 512; it += NW) delta_sample_item(A, l, lds, it, tid, wave, lane); }
                        if (k == 2) {
#pragma unroll 1
                            for (int it = w * 8 + wave; it < 8 * 31 * 16; it += NW * 8) { int t1 = threadIdx.x; asm volatile("" : "+v"(t1)); ssm_part1_item(A, l, it, t1 & 63); }
                            { int t2 = threadIdx.x; asm volatile("" : "+v"(t2)); int wl = blockIdx.x; asm volatile("" : "+s"(wl)); state_copies(A, l, (wl - 32) * 512 + t2, NW * 512); } }
                        if (k == 3) {
#pragma unroll 1
                            for (int it = w; it < 264; it += NW) pool_item(A, l, lds, it, tid, wave, lane); }
                        { const int it = (k == 4) ? w - 128 : ((k == 5) ? 96 + w : -1);
                          if (it >= 0 && it < ((k == 4) ? 96 : 264)) ssm_part2_item(A, l, lds, it, tid, wave, lane); }
                        if (k < 5) xcd_barrier(xb);
                    } }
            }
        } PH_END
        PH_BEGIN for (int rep = 0; rep < REP_G; ++rep) { pg8::Gemm g{MIX, (const bf16_t*)(A.ws + WS_WOUT + l * SZ_WOUT), NP, D, D, D, D}; pg8::StaticOrder S; S.init(NP, D, G, (int)blockIdx.x);
            pg8::EpiBf16<0> E{(bf16_t*)MIXO, D, nullptr, 0, 0}; pg8::gemm_phase<pg8::EpiBf16<0>, pg8::StaticOrder>(lds, g, S, E, nullptr);
            pg8::Gemm g2{MIX + (size_t)NP * D, (const bf16_t*)(A.ws + WS_WOUT + l * SZ_WOUT), NS, D, 256, D, D}; SliceOrder S2{8 * (D / 256), G, (int)blockIdx.x};
            EpiF32Part E2{(float*)(A.ws + WS_PARTS)}; pg8::gemm_phase<EpiF32Part, SliceOrder>(lds, g2, S2, E2, nullptr); } PH_END
#ifndef REP_N5
#define REP_N5 1
#endif
        PH_BEGIN norm_rows_pf(MIXO, A.in[I_NMPOST] + l * D, XBUF, RSCBUF, gw, NGW, lane, (const float*)(A.ws + WS_PARTS), D / 256); PH_END
        PH_BEGIN for (int rep = 0; rep < REP_G; ++rep) { pg8::Gemm g{XBUF, (const bf16_t*)(A.ws + WS_WGU + l * SZ_WGU), NTOK, NGU, D, D, D}; pg8::StaticOrder S; S.init(NTOK, NGU, G, (int)blockIdx.x);
            EpiSwiGLU E{HID, DFF, RSCBUF}; pg8::gemm_phase<EpiSwiGLU, pg8::StaticOrder>(lds, g, S, E, nullptr); } PH_END
        PH_BEGIN for (int rep = 0; rep < REP_G; ++rep) { pg8::Gemm g{HID, (const bf16_t*)(A.ws + WS_WDN + l * SZ_WDN), NP, D, DFF, DFF, DFF}; pg8::StaticOrder S; S.init(NP, D, G, (int)blockIdx.x);
            pg8::EpiBf16<0> E{(bf16_t*)MIXO, D, nullptr, 0, 0}; pg8::gemm_phase<pg8::EpiBf16<0>, pg8::StaticOrder>(lds, g, S, E, nullptr);
            pg8::Gemm g2{HID + (size_t)NP * DFF, (const bf16_t*)(A.ws + WS_WDN + l * SZ_WDN), NS, D, 256, DFF, DFF}; SliceOrder S2{8 * (DFF / 256), G, (int)blockIdx.x};
            EpiF32Part E2{(float*)(A.ws + WS_PARTS)}; pg8::gemm_phase<EpiF32Part, SliceOrder>(lds, g2, S2, E2, nullptr); } PH_END
        PH_BEGIN norm_rows(MIXO, A.in[I_NFPOST] + l * D, nullptr, nullptr, l + 1 < DEPTH ? nullptr : A.out, l + 1 < DEPTH ? A.in[I_NMPRE] + (l + 1) * D : nullptr, l + 1 < DEPTH ? RSCBUF : nullptr,
                           l + 1 < DEPTH ? (const float*)(A.ws + WS_WAB + (l + 1) * SZ_WAB) : nullptr, AB, gw, NGW, lane, (const float*)(A.ws + WS_PARTS), DFF / 256,
                           XBUF, l + 1 < DEPTH ? XBUF : nullptr); PH_END
    }
#undef PH_BEGIN
#undef PH_END
#undef Hb
#undef AB
#undef MIXO
#undef PROJ
#undef MIX
#undef HID
#undef XBUF
#undef RSCBUF
}

extern "C" void kernel_launch(void* const* d_in, const int* in_sizes, int n_in, void* d_out, int out_size, void* d_ws, size_t ws_size, hipStream_t stream) {
    static int grid = 0;
    if (grid == 0) {
        if (n_in != 32 || (size_t)out_size != O_END || ws_size < WS_END) fprintf(stderr, "kernel_launch: unexpected sizes: n_in %d out %d (want %zu) ws %zu (want >= %zu)\n", n_in, out_size, (size_t)O_END, ws_size, (size_t)WS_END);
        int dev = 0, cus = 0, per_cu = 0;
        (void)hipGetDevice(&dev); (void)hipDeviceGetAttribute(&cus, hipDeviceAttributeMultiprocessorCount, dev);
        if (hipFuncSetAttribute((const void*)mega_fwd, hipFuncAttributeMaxDynamicSharedMemorySize, LDS_BYTES) != hipSuccess) fprintf(stderr, "kernel_launch: hipFuncSetAttribute failed\n");
        if (hipOccupancyMaxActiveBlocksPerMultiprocessor(&per_cu, (const void*)mega_fwd, 512, LDS_BYTES) != hipSuccess || per_cu < 1) { fprintf(stderr, "kernel_launch: occupancy query gave %d\n", per_cu); per_cu = 1; (void)hipGetLastError(); }
        grid = cus * per_cu; if (grid <= 0) grid = 256;
        if (grid >= 256) grid = 256;
        fprintf(stderr, "kernel_launch: grid %d (cus %d x %d)%s\n", grid, cus, per_cu, grid < 256 ? "  ERROR: this build needs >= 256 co-resident workgroups" : "");
    }
    (void)hipMemsetAsync((unsigned char*)d_ws + WS_BAR, 0, 16384, stream);
    Args a{};
    for (int i = 0; i < 32; ++i) a.in[i] = (const float*)d_in[i];
    a.out = (float*)d_out; a.ws = (unsigned char*)d_ws;
#if MK_COOP
    a.ph_lo = 0; a.ph_hi = NPH;
    void* args[] = {&a};
    const hipError_t e = hipLaunchCooperativeKernel((const void*)mega_fwd, dim3(grid), dim3(512), args, LDS_BYTES, stream);
    if (e != hipSuccess) fprintf(stderr, "kernel_launch: cooperative launch failed: %s (grid %d)\n", hipGetErrorString(e), grid);
#else
    for (int p = 0; p < NPH; ++p) { a.ph_lo = p; a.ph_hi = p + 1; hipLaunchKernelGGL(mega_fwd, dim3(grid), dim3(512), LDS_BYTES, stream, a); }
#endif
}
```

```cpp
#include <hip/hip_runtime.h>
#include <hip/hip_cooperative_groups.h>
#include <cstdio>
#include <cstdint>
namespace cg = cooperative_groups;
#ifndef MK_COOP
#define MK_COOP 1
#endif
namespace pg8 {
#define PG8_LAS __attribute__((address_space(3)))
typedef unsigned short bf16_t;
typedef short bf16x8 __attribute__((ext_vector_type(8)));
typedef float f32x4 __attribute__((ext_vector_type(4)));
typedef unsigned u32x4 __attribute__((ext_vector_type(4)));
constexpr int BM = 256, BK = 64, HALF = 128, HTB = HALF * BK * 2  , STAGE_BYTES = 8 * HTB, NXCD = 8, WGM = 8;

__host__ __device__ __forceinline__ int lds_byte(int r, int c) { const int st = (r >> 4) * 2 + (c >> 5), rr = r & 15, cc = c & 31, ob = rr * 64 + cc * 2; return st * 1024 + (ob ^ (((ob >> 9) & 1) << 5)); }
__host__ __device__ __forceinline__ void stage_rc(int b, int& R, int& C) { const int st = b / 1024, sb = b % 1024, swz = sb ^ (((sb >> 9) & 1) << 5); R = (st >> 1) * 16 + swz / 64; C = (st & 1) * 32 + (swz % 64) / 2; }
__host__ __device__ __forceinline__ int perm32(int rho) { const int n = rho >> 4, i = rho & 15; return 8 * (i >> 2) + 4 * n + (i & 3); }

struct Unit { int pm, pn, ks; };
struct Gemm { const bf16_t* A; const bf16_t* Bt; int M, N, K, lda, ldb; };

struct StaticOrder {
    int nM, nN, nwg, G, c;
    __host__ __device__ void init(int M, int N, int G_, int c_) { nM = M / BM; nN = N / BM; nwg = nM * nN; G = G_; c = c_; }
    __host__ __device__ bool next(int i, Unit& u) const {
        const long L = (long)i * G + c; if (L >= nwg) return false;
        int wgid = (int)L; { const int q = nwg / NXCD, r = nwg % NXCD, xcd = wgid % NXCD, off = wgid / NXCD; wgid = (xcd < r ? xcd * (q + 1) : r * (q + 1) + (xcd - r) * q) + off; }
        const int nig = WGM * nN, gid = wgid / nig, fm = gid * WGM, gsz = (nM - fm) < WGM ? (nM - fm) : WGM;
        u.pm = fm + ((wgid % nig) % gsz); u.pn = (wgid % nig) / gsz; u.ks = 0; return true;
    }
    __device__ __forceinline__ void a_ready(const Unit&) const {}
    __device__ __forceinline__ void done(const Unit&) const {}
};
__device__ __forceinline__ unsigned cvt_pk_bf16(float lo, float hi) { unsigned r; asm volatile("v_cvt_pk_bf16_f32 %0, %1, %2" : "=v"(r) : "v"(lo), "v"(hi)); return r; }
typedef float f32x2 __attribute__((ext_vector_type(2)));
__device__ __forceinline__ f32x2 gelu_pk(f32x2 v) {
    const f32x2 av = __builtin_elementwise_abs(v), d = av * 0.2316418882f + 1.0f;
    f32x2 t; t.x = __builtin_amdgcn_rcpf(d.x); t.y = __builtin_amdgcn_rcpf(d.y);
    f32x2 q = t * 0.5307027145f + (-0.7265760135f); q = q * t + 0.7107068705f; q = q * t + (-0.142248368f); q = q * t + 0.127414796f; q = q * t;
    const f32x2 s = (v * v) * (-0.72134752044f);
    f32x2 e; e.x = __builtin_amdgcn_exp2f(s.x); e.y = __builtin_amdgcn_exp2f(s.y);
    const f32x2 m = v * (q * e), r = v - m;
    f32x2 o; o.x = v.x < 0.f ? m.x : r.x; o.y = v.y < 0.f ? m.y : r.y; return o;
}

struct EpiF32 {
    static constexpr bool PERM = false, AFTER_DRAIN = false;
    float* C; int ldc; const float* bias;
    __device__ __forceinline__ void operator()(const f32x4 (&acc)[2][2][4][2], const Unit& u, int wr, int wc, int fr, int fq) const {
        const int row0 = u.pm * BM + wr * 64 + fr, col0 = u.pn * BM + wc * 32 + 4 * fq;
        f32x4 bv[2][2];
#pragma unroll
        for (int bj = 0; bj < 2; ++bj)
#pragma unroll
            for (int n = 0; n < 2; ++n) bv[bj][n] = bias ? *(const f32x4*)(bias + col0 + bj * HALF + n * 16) : (f32x4){0.f, 0.f, 0.f, 0.f};
#pragma unroll
        for (int ai = 0; ai < 2; ++ai)
#pragma unroll
            for (int m = 0; m < 4; ++m) { float* rowp = C + (size_t)(row0 + ai * HALF + m * 16) * ldc + col0;
#pragma unroll
                for (int bj = 0; bj < 2; ++bj)
#pragma unroll
                    for (int n = 0; n < 2; ++n) *(f32x4*)(rowp + bj * HALF + n * 16) = acc[ai][bj][m][n] + bv[bj][n]; }
    }
};
template <int ACT  > struct EpiBf16 {
    static constexpr bool PERM = true, AFTER_DRAIN = false;
    bf16_t* O; int ldc; const float* bias; int split_cols; size_t split_stride;
    __device__ __forceinline__ void operator()(const f32x4 (&acc)[2][2][4][2], const Unit& u, int wr, int wc, int fr, int fq) const {
        const int row0 = u.pm * BM + wr * 64 + fr; int colt = u.pn * BM; bf16_t* base = O;
        if (split_cols) { const int t = colt / split_cols; base += (size_t)t * split_stride; colt -= t * split_cols; }
        const int col0 = colt + wc * 32 + 8 * fq, bcol0 = u.pn * BM + wc * 32 + 8 * fq;
        f32x4 bv[2][2];
#pragma unroll
        for (int bj = 0; bj < 2; ++bj)
#pragma unroll
            for (int n = 0; n < 2; ++n) bv[bj][n] = bias ? *(const f32x4*)(bias + bcol0 + bj * HALF + 4 * n) : (f32x4){0.f, 0.f, 0.f, 0.f};
#pragma unroll
        for (int ai = 0; ai < 2; ++ai)
#pragma unroll
            for (int m = 0; m < 4; ++m) { bf16_t* rowp = base + (size_t)(row0 + ai * HALF + m * 16) * ldc + col0;
#pragma unroll
                for (int bj = 0; bj < 2; ++bj) { f32x4 v0 = acc[ai][bj][m][0] + bv[bj][0], v1 = acc[ai][bj][m][1] + bv[bj][1];
                    if (ACT == 1) { f32x2 a = gelu_pk((f32x2){v0[0], v0[1]}), b = gelu_pk((f32x2){v0[2], v0[3]}), c = gelu_pk((f32x2){v1[0], v1[1]}), d = gelu_pk((f32x2){v1[2], v1[3]});
                        v0 = (f32x4){a.x, a.y, b.x, b.y}; v1 = (f32x4){c.x, c.y, d.x, d.y}; }
                    if (ACT == 2) {
#pragma unroll
                        for (int j = 0; j < 4; ++j) { v0[j] = 0.5f * v0[j] * (1.0f + erff(v0[j] * 0.70710678f)); v1[j] = 0.5f * v1[j] * (1.0f + erff(v1[j] * 0.70710678f)); } }
                    u32x4 w; w.x = cvt_pk_bf16(v0[0], v0[1]); w.y = cvt_pk_bf16(v0[2], v0[3]); w.z = cvt_pk_bf16(v1[0], v1[1]); w.w = cvt_pk_bf16(v1[2], v1[3]);
                    *(u32x4*)(rowp + bj * HALF) = w; } }
    }
};
template <class Epi, class Sched, bool STAMP = false>
__device__ __forceinline__ void gemm_phase(PG8_LAS unsigned char* lds, const Gemm g, const Sched& S, const Epi& E, unsigned long long* stamps) {
    int tid_ = threadIdx.x; asm volatile("" : "+v"(tid_));
    const int tid = tid_, wid = __builtin_amdgcn_readfirstlane(tid >> 6), lane = tid & 63, wr = wid >> 2, wc = wid & 3, fr = lane & 15, fq = lane >> 4;
    const int K = g.K, nt = K / BK;
    int ts_lo = 0, ts_hi = 0, nts = 0; const unsigned long long rt_entry = STAMP ? (unsigned long long)wall_clock64() : 0ull;
#define PG8_STAMP() do { if (STAMP && wid == 0 && nts < 64) { const unsigned long long _c = (unsigned long long)clock64(); \
        ts_lo = (lane == nts) ? (int)(unsigned)_c : ts_lo; ts_hi = (lane == nts) ? (int)(unsigned)(_c >> 32) : ts_hi; ++nts; } } while (0)
    PG8_STAMP();
    unsigned voffA[2], voffB[2];
#pragma unroll
    for (int i = 0; i < 2; ++i) { int R, C; stage_rc(tid * 16 + i * 8192, R, C); const int Rb = Epi::PERM ? ((R & ~31) + perm32(R & 31)) : R;
        voffA[i] = (unsigned)(R * g.lda + C) * 2u; voffB[i] = (unsigned)(Rb * g.ldb + C) * 2u; }
    const size_t kstep = (size_t)(BK * 2);
    const size_t hstepA = (size_t)HALF * g.lda * 2, hstepB = (size_t)HALF * g.ldb * 2;
    const size_t tstepA = 2 * hstepA, tstepB = 2 * hstepB, sstep = (size_t)K * 2;
    const unsigned ldsw = (unsigned)wid * 1024u;
    const int aoff = lds_byte(wr * 64 + fr, fq * 8), boff = lds_byte(wc * 32 + fr, fq * 8);
#define PG8_SA(b, h) (((b) * 2 + (h)) * HTB)
#define PG8_SB(b, h) ((4 + (b) * 2 + (h)) * HTB)
#define PG8_STAGE(bufoff, gbase, voff) do { _Pragma("unroll") for (int _i = 0; _i < 2; ++_i) \
        __builtin_amdgcn_global_load_lds((const unsigned*)((const char*)(gbase) + (voff)[_i]), (PG8_LAS unsigned*)(lds + (bufoff) + ldsw + _i * 8192), 16, 0, 0); } while (0)
#define PG8_LDA(dst, b, h) do { _Pragma("unroll") for (int m = 0; m < 4; ++m) _Pragma("unroll") for (int k = 0; k < 2; ++k) dst[m][k] = *(const PG8_LAS bf16x8*)(lds + PG8_SA(b, h) + aoff + m * 2048 + k * 1024); } while (0)
#define PG8_LDB(dst, b, h) do { _Pragma("unroll") for (int n = 0; n < 2; ++n) _Pragma("unroll") for (int k = 0; k < 2; ++k) dst[n][k] = *(const PG8_LAS bf16x8*)(lds + PG8_SB(b, h) + boff + n * 2048 + k * 1024); } while (0)
#define PG8_MMA(ai, bj, At, Bt) do { __builtin_amdgcn_s_setprio(1); _Pragma("unroll") for (int m = 0; m < 4; ++m) _Pragma("unroll") for (int n = 0; n < 2; ++n) _Pragma("unroll") for (int k = 0; k < 2; ++k) \
        acc[ai][bj][m][n] = __builtin_amdgcn_mfma_f32_16x16x32_bf16(Bt[n][k], At[m][k], acc[ai][bj][m][n], 0, 0, 0); __builtin_amdgcn_s_setprio(0); } while (0)
#define PG8_WAIT_V(n) asm volatile("s_waitcnt vmcnt(" #n ")" ::: "memory")
#define PG8_WAIT_L(n) asm volatile("s_waitcnt lgkmcnt(" #n ")" ::: "memory")
#define PG8_BAR __builtin_amdgcn_s_barrier()
#define PG8_SCHED __builtin_amdgcn_sched_barrier(0)
    Unit cur, nxt; int ui = 0;
    if (!S.next(0, cur)) return;
    f32x4 acc[2][2][4][2];
#pragma unroll
    for (int a = 0; a < 2; ++a)
#pragma unroll
        for (int b = 0; b < 2; ++b)
#pragma unroll
            for (int m = 0; m < 4; ++m)
#pragma unroll
                for (int n = 0; n < 2; ++n) acc[a][b][m][n] = (f32x4){0.f, 0.f, 0.f, 0.f};
    bf16x8 At[4][2], B0[2][2], B1[2][2];
    const char* cA = (const char*)g.A + (size_t)cur.pm * tstepA + (size_t)cur.ks * sstep; const char* cB = (const char*)g.Bt + (size_t)cur.pn * tstepB + (size_t)cur.ks * sstep;
    S.a_ready(cur);
    PG8_STAGE(PG8_SB(0, 0), cB, voffB); PG8_STAGE(PG8_SA(0, 0), cA, voffA); PG8_STAGE(PG8_SB(0, 1), cB + hstepB, voffB); PG8_STAGE(PG8_SA(0, 1), cA + hstepA, voffA);
    if (wr == 1) PG8_BAR;
    PG8_WAIT_V(4); PG8_BAR;
    PG8_STAGE(PG8_SB(1, 0), cB + kstep, voffB); PG8_STAGE(PG8_SA(1, 0), cA + kstep, voffA); PG8_STAGE(PG8_SB(1, 1), cB + hstepB + kstep, voffB);
    PG8_WAIT_V(6); PG8_BAR;
    PG8_STAMP();
    for (;;) {
        const bool has_next = S.next(ui + 1, nxt);
        const char* nA = has_next ? (const char*)g.A + (size_t)nxt.pm * tstepA + (size_t)nxt.ks * sstep : cA; const char* nB = has_next ? (const char*)g.Bt + (size_t)nxt.pn * tstepB + (size_t)nxt.ks * sstep : cB;
        for (int t = 0; t < nt; t += 2) {
            const bool last = (t == nt - 2);
            const char* a1 = cA + (size_t)(t + 1) * kstep;
            const char* a2 = last ? nA : cA + (size_t)(t + 2) * kstep; const char* b2 = last ? nB : cB + (size_t)(t + 2) * kstep;
            const char* a3 = a2 + kstep; const char* b3 = b2 + kstep;
            if (last && has_next) S.a_ready(nxt);
            PG8_LDB(B0, 0, 0); PG8_SCHED; PG8_LDA(At, 0, 0); PG8_STAGE(PG8_SA(1, 1), a1 + hstepA, voffA);
            PG8_WAIT_L(8); PG8_BAR; PG8_WAIT_L(0); PG8_MMA(0, 0, At, B0); PG8_BAR; PG8_SCHED;
            PG8_LDB(B1, 0, 1); PG8_STAGE(PG8_SB(0, 0), b2, voffB);
            PG8_BAR; PG8_WAIT_L(0); PG8_MMA(0, 1, At, B1); PG8_BAR;
            PG8_LDA(At, 0, 1); PG8_STAGE(PG8_SA(0, 0), a2, voffA);
            PG8_BAR; PG8_WAIT_L(0); PG8_MMA(1, 0, At, B0); PG8_BAR; PG8_SCHED;
            PG8_STAGE(PG8_SB(0, 1), b2 + hstepB, voffB);
            PG8_WAIT_V(6); PG8_BAR; PG8_MMA(1, 1, At, B1); PG8_BAR;
            PG8_LDB(B0, 1, 0); PG8_SCHED; PG8_LDA(At, 1, 0); PG8_STAGE(PG8_SA(0, 1), a2 + hstepA, voffA);
            PG8_WAIT_L(8); PG8_BAR; PG8_WAIT_L(0); PG8_MMA(0, 0, At, B0); PG8_BAR; PG8_SCHED;
            PG8_LDB(B1, 1, 1); PG8_STAGE(PG8_SB(1, 0), b3, voffB);
            PG8_BAR; PG8_WAIT_L(0); PG8_MMA(0, 1, At, B1); PG8_BAR;
            PG8_LDA(At, 1, 1); PG8_STAGE(PG8_SA(1, 0), a3, voffA);
            PG8_BAR; PG8_WAIT_L(0); PG8_MMA(1, 0, At, B0); PG8_BAR; PG8_SCHED;
            PG8_STAGE(PG8_SB(1, 1), b3 + hstepB, voffB);
            PG8_WAIT_V(6); PG8_BAR; PG8_MMA(1, 1, At, B1); PG8_BAR;
        }
        PG8_STAMP();
        if constexpr (!Epi::AFTER_DRAIN) { E(acc, cur, wr, wc, fr, fq); S.done(cur); }
        PG8_STAMP();
        if (!has_next) break;
#pragma unroll
        for (int a = 0; a < 2; ++a)
#pragma unroll
            for (int b = 0; b < 2; ++b)
#pragma unroll
                for (int m = 0; m < 4; ++m)
#pragma unroll
                    for (int n = 0; n < 2; ++n) acc[a][b][m][n] = (f32x4){0.f, 0.f, 0.f, 0.f};
        cur = nxt; cA = nA; cB = nB; ++ui;
    }
    PG8_WAIT_V(0);
    if (wr == 0) PG8_BAR;
    PG8_BAR;
    if constexpr (Epi::AFTER_DRAIN) { E.fused(acc, cur, wr, wc, fr, fq, lds, wid, lane); S.done(cur); }
    PG8_STAMP();
    if (STAMP && wid == 0) { stamps[lane] = lane < nts ? (((unsigned long long)(unsigned)ts_hi << 32) | (unsigned)ts_lo) : 0ull;
        if (lane == 62) stamps[62] = rt_entry; if (lane == 63) stamps[63] = (unsigned long long)wall_clock64(); }
#undef PG8_STAMP
#undef PG8_SA
#undef PG8_SB
#undef PG8_STAGE
#undef PG8_LDA
#undef PG8_LDB
#undef PG8_MMA
#undef PG8_WAIT_V
#undef PG8_WAIT_L
#undef PG8_BAR
#undef PG8_SCHED
}
}

#define LAS __attribute__((address_space(3)))
typedef unsigned short bf16_t;
typedef short bf16x8 __attribute__((ext_vector_type(8)));
typedef float f32x4 __attribute__((ext_vector_type(4)));
typedef float f32x2 __attribute__((ext_vector_type(2)));
typedef unsigned u32x4 __attribute__((ext_vector_type(4)));
typedef unsigned u32x2 __attribute__((ext_vector_type(2)));

constexpr int D = 1024, NP = 16384, NS = 512, NTOK = NP + NS, SEQ = 2048, NB = 8, NSB = 128, DEPTH = 4;
constexpr int INW = 2568, NPROJ = 2560, DFF = 2816, NGU = 5632;
constexpr int PC_G = 1536, PC_SSM = 2048, PC_POOL = 2304;
constexpr float EPS = 1e-6f;
constexpr int LDS_BYTES = 163840;

constexpr size_t SZ_WIN = (size_t)NPROJ * D * 2, SZ_WOUT = (size_t)D * D * 2, SZ_WGU = (size_t)NGU * D * 2, SZ_WDN = (size_t)D * DFF * 2;
constexpr size_t SZ_WAB = 8 * D * 4, SZ_GLUT = 256 * 256 * 2, SZ_POOLT = 4 * 64 * 64 * 2, SZ_SSMK = 16 * 64 * 4 * 4, SZ_BBAR = 16 * 64 * 32 * 4;
constexpr size_t WS_WIN = 0;
constexpr size_t WS_WOUT = WS_WIN + DEPTH * SZ_WIN;
constexpr size_t WS_WGU = WS_WOUT + DEPTH * SZ_WOUT;
constexpr size_t WS_WDN = WS_WGU + DEPTH * SZ_WGU;
constexpr size_t WS_WAB = WS_WDN + DEPTH * SZ_WDN;
constexpr size_t WS_GLUT = WS_WAB + DEPTH * SZ_WAB;
constexpr size_t WS_POOLT = WS_GLUT + DEPTH * SZ_GLUT;
constexpr size_t WS_SSMK = WS_POOLT + DEPTH * SZ_POOLT;
constexpr size_t WS_BBAR = WS_SSMK + DEPTH * SZ_SSMK;
constexpr size_t WS_H = WS_BBAR + DEPTH * SZ_BBAR;
constexpr size_t WS_AB = WS_H + (size_t)NTOK * D * 2;
constexpr size_t WS_MIX = WS_AB + (size_t)NTOK * 8 * 4;
constexpr size_t WS_MIXO = WS_MIX + (size_t)NTOK * D * 2;
constexpr size_t WS_SSME = WS_MIXO + (size_t)NTOK * D * 4;
constexpr size_t WS_PROJ = WS_SSME + (size_t)8 * 32 * 16 * 64 * 2 * 4;
constexpr size_t WS_DW = WS_PROJ + (size_t)NTOK * NPROJ * 2;
constexpr size_t WS_DKC = WS_DW + (size_t)1024 * 8192 * 4;
constexpr size_t WS_DQD = WS_DKC + (size_t)1024 * 8192 * 2;
constexpr size_t WS_DQK = WS_DQD + (size_t)1024 * 8192 * 2;
constexpr size_t WS_DKT = WS_DQK + (size_t)1024 * 4096 * 2;
constexpr size_t WS_DGL = WS_DKT + (size_t)1024 * 8192 * 2;
constexpr size_t WS_DGS = WS_DGL + 4096;
constexpr size_t WS_BAR = WS_DGS + (size_t)1024 * 8192 * 2;
constexpr size_t WS_PARTS = WS_BAR + 16384;
constexpr size_t WS_RSC = WS_PARTS + (size_t)11 * 512 * 1024 * 4;
constexpr size_t WS_END = WS_RSC + (size_t)NTOK * 4;
constexpr size_t WS_HID = WS_PROJ;
static_assert(WS_HID + (size_t)NTOK * DFF * 2 <= WS_END, "HID overlay");
static_assert(WS_H % 256 == 0 && WS_PROJ % 256 == 0 && WS_DW % 256 == 0, "align");

constexpr size_t O_YP = 0, O_YS = O_YP + (size_t)NP * D, O_DP = O_YS + (size_t)NS * D, O_CP = O_DP + (size_t)DEPTH * 8 * 4 * 16384,
                 O_REP = O_CP + (size_t)DEPTH * 8 * 3 * 1536, O_IMP = O_REP + (size_t)DEPTH * 8 * 1024, O_PP = O_IMP + (size_t)DEPTH * 8 * 1024,
                 O_DS = O_PP + (size_t)DEPTH * 8 * 15 * 256, O_CS = O_DS + (size_t)DEPTH * 128 * 4 * 16384, O_RES = O_CS + (size_t)DEPTH * 128 * 3 * 1536,
                 O_IMS = O_RES + (size_t)DEPTH * 128 * 1024, O_PS = O_IMS + (size_t)DEPTH * 128 * 1024, O_END = O_PS + (size_t)DEPTH * 128 * 15 * 256;

struct Args { const float* in[32]; float* out; unsigned char* ws; int ph_lo, ph_hi; };
typedef const float* cfp_t;
typedef __attribute__((address_space(4))) const unsigned char* kptr_t;
struct InProxy { __device__ __forceinline__ const float* operator[](int i) const {
    kptr_t p = (kptr_t)__builtin_amdgcn_kernarg_segment_ptr(); asm volatile("" : "+s"(p)); return *(__attribute__((address_space(4))) const cfp_t*)(p + 8 * i); } };
struct DevArgs { InProxy in; float* out; unsigned char* ws; int ph_lo, ph_hi; };
enum { I_XP = 0, I_XS, I_SDELTA, I_SCONV, I_SRE, I_SIM, I_SPOOL, I_NMPRE, I_NMPOST, I_NFPRE, I_NFPOST, I_WIN, I_CONVW, I_ALOG, I_DTB, I_ONORM,
       I_ARE, I_AIM, I_LOGDT, I_BRE, I_BIM, I_CRE, I_CIM, I_SSMD, I_GLUW, I_GLUB, I_POOLW, I_POOLS, I_WOUT, I_WG, I_WU, I_WD };

__device__ __forceinline__ unsigned f2bf(float f) { unsigned u = __float_as_uint(f); return (u + 0x7fffu + ((u >> 16) & 1u)) >> 16; }
__device__ __forceinline__ float bf2f(unsigned b) { return __uint_as_float(b << 16); }
__device__ __forceinline__ unsigned pk2(float lo, float hi) { return f2bf(lo) | (f2bf(hi) << 16); }
template <int CTRL> __device__ __forceinline__ float dpp_f(float v) { return __builtin_bit_cast(float, __builtin_amdgcn_update_dpp(0, __builtin_bit_cast(int, v), CTRL, 0xF, 0xF, true)); }
__device__ __forceinline__ float row_sum8(float v) { v += dpp_f<0xB1>(v); v += dpp_f<0x4E>(v); v += dpp_f<0x141>(v); return v; }
__device__ __forceinline__ float row_sum16(float v) { v = row_sum8(v); v += dpp_f<0x140>(v); return v; }
__device__ __forceinline__ float wave_sum(float v) { v = row_sum16(v); v += __shfl_xor(v, 16); v += __shfl_xor(v, 32); return v; }
__device__ __forceinline__ float silu_f(float y) { return y * __builtin_amdgcn_rcpf(1.f + __expf(-y)); }
__device__ __forceinline__ float sigmoid_f(float y) { return __builtin_amdgcn_rcpf(1.f + __expf(-y)); }
__device__ __forceinline__ float gelu_tanh_f(float x) { const float z = 0.7978845608028654f * (x + 0.044715f * x * x * x);
    const float t = 1.f - 2.f * __builtin_amdgcn_rcpf(1.f + __expf(2.f * z)); return 0.5f * x * (1.f + t); }
__device__ __forceinline__ f32x4 mfma16(bf16x8 a, bf16x8 b, f32x4 c) { return __builtin_amdgcn_mfma_f32_16x16x32_bf16(a, b, c, 0, 0, 0); }
#define LDS_FENCE() asm volatile("s_waitcnt lgkmcnt(0)" ::: "memory")

struct EpiSwiGLU {
    static constexpr bool PERM = false, AFTER_DRAIN = false;
    bf16_t* O; int ldc; const float* rs;
    __device__ __forceinline__ void operator()(const pg8::f32x4 (&acc)[2][2][4][2], const pg8::Unit& u, int wr, int wc, int fr, int fq) const {
        const int row0 = u.pm * 256 + wr * 64 + fr, hid0 = u.pn * 128 + wc * 16 + 4 * fq;
#pragma unroll
        for (int ai = 0; ai < 2; ++ai)
#pragma unroll
            for (int m = 0; m < 4; ++m) { const float sc = rs[row0 + ai * 128 + m * 16]; bf16_t* rowp = O + (size_t)(row0 + ai * 128 + m * 16) * ldc + hid0;
#pragma unroll
                for (int bj = 0; bj < 2; ++bj) { const pg8::f32x4 g = acc[ai][bj][m][0] * sc, v = acc[ai][bj][m][1] * sc;
                    u32x2 w; w.x = pg8::cvt_pk_bf16(silu_f(g[0]) * v[0], silu_f(g[1]) * v[1]); w.y = pg8::cvt_pk_bf16(silu_f(g[2]) * v[2], silu_f(g[3]) * v[3]);
                    *(u32x2*)(rowp + bj * 64) = w; } }
    }
};

#define XB_TMO      128
#define XB_XCNT(j)  (256  + 64 * (j))
#define XB_XSUB(j)  (1280 + 64 * (j))
#define XB_XGEN(j)  (2304 + 64 * (j))
#define XB_TOP      3328
#define XB_TOPGEN   3392
#define XCD_BAR_WORDS 3456
#define XB_SPIN_CAP (1u << 18)

__device__ __forceinline__ unsigned xb_ld(unsigned* p)              { return __hip_atomic_load(p, __ATOMIC_RELAXED, __HIP_MEMORY_SCOPE_AGENT); }
__device__ __forceinline__ unsigned xb_add(unsigned* p, unsigned v) { return __hip_atomic_fetch_add(p, v, __ATOMIC_RELAXED, __HIP_MEMORY_SCOPE_AGENT); }
__device__ __forceinline__ unsigned xb_xcc_id() { return (unsigned)__builtin_amdgcn_s_getreg((3 << 11) | 20) & 0xFu; }
#define XB_SPIN(cond, bar) do { unsigned _sp = 0; while (cond) { __builtin_amdgcn_s_sleep(1); \
    if ((++_sp & 255u) == 0u) { if (xb_ld(&(bar)[XB_TMO])) break; if (_sp > XB_SPIN_CAP) { atomicAdd(&(bar)[XB_TMO], 1u); break; } } } } while (0)

struct XcdBarrier {
    unsigned* bar; unsigned x;
    volatile LAS unsigned* st;
};

__device__ __forceinline__ XcdBarrier xcd_barrier_post(unsigned* bar, volatile LAS unsigned* st) {
    XcdBarrier b; b.bar = bar; b.x = xb_xcc_id(); b.st = st;
    if (threadIdx.x == 0) (void)xb_add(&bar[XB_XCNT(b.x)], 1u);
    return b;
}
__device__ __forceinline__ void xcd_barrier_complete(unsigned* bar, unsigned x, unsigned& nloc, unsigned& nx) {
    const unsigned G = gridDim.x * gridDim.y * gridDim.z;
    unsigned sum, cnt, mine, sp = 0u;
    for (;;) {
        sum = 0u; cnt = 0u; mine = 0u;
#pragma unroll
        for (unsigned j = 0; j < 16; ++j) { const unsigned c = xb_ld(&bar[XB_XCNT(j)]); sum += c; cnt += (c > 0u) ? 1u : 0u; mine = (j == x) ? c : mine; }
        if (sum == G) break;
        __builtin_amdgcn_s_sleep(1);
        if ((++sp & 255u) == 0u) { if (xb_ld(&bar[XB_TMO])) break; if (sp > XB_SPIN_CAP) { atomicAdd(&bar[XB_TMO], 1u); break; } }
    }
    nloc = mine > 0u ? mine : 1u; nx = cnt > 0u ? cnt : 1u;
}

__device__ __forceinline__ void xcd_barrier(const XcdBarrier& b) {
    asm volatile("s_waitcnt vmcnt(0)" ::: "memory");
    __syncthreads();
    if (threadIdx.x == 0) {
        unsigned* bar = b.bar; asm volatile("" : "+s"(bar));
        __builtin_amdgcn_s_waitcnt(0);
        unsigned nloc = b.st[0], nx = b.st[1];
        if (nloc == 0u) { xcd_barrier_complete(bar, b.x, nloc, nx); b.st[0] = nloc; b.st[1] = nx; }
        const unsigned old = xb_add(&bar[XB_XSUB(b.x)], 1u);
        const unsigned gen = old / nloc;
        if (old + 1u == (gen + 1u) * nloc) {
            __builtin_amdgcn_fence(__ATOMIC_RELEASE, "agent");
            asm volatile("s_waitcnt vmcnt(0)" ::: "memory");
            const unsigned og = xb_add(&bar[XB_TOP], 1u);
            const unsigned tg = og / nx;
            if (og + 1u == (tg + 1u) * nx) xb_add(&bar[XB_TOPGEN], 1u);
            else XB_SPIN(xb_ld(&bar[XB_TOPGEN]) == tg, bar);
            __builtin_amdgcn_fence(__ATOMIC_ACQUIRE, "agent");
            xb_add(&bar[XB_XGEN(b.x)], 1u);
            asm volatile("s_waitcnt vmcnt(0)" ::: "memory");
        } else {
            XB_SPIN(xb_ld(&bar[XB_XGEN(b.x)]) == gen, bar);
            __builtin_amdgcn_fence(__ATOMIC_ACQUIRE, "agent");
            asm volatile("s_waitcnt vmcnt(0)" ::: "memory");
        }
    }
    __syncthreads();
}

struct EpiBf16Scale {
    static constexpr bool PERM = true, AFTER_DRAIN = false;
    bf16_t* O; int ldc; const float* rs;
    __device__ __forceinline__ void operator()(const pg8::f32x4 (&acc)[2][2][4][2], const pg8::Unit& u, int wr, int wc, int fr, int fq) const {
        const int row0 = u.pm * 256 + wr * 64 + fr, col0 = u.pn * 256 + wc * 32 + 8 * fq;
#pragma unroll
        for (int ai = 0; ai < 2; ++ai)
#pragma unroll
            for (int m = 0; m < 4; ++m) { const int row = row0 + ai * 128 + m * 16; const float sc = rs[row]; bf16_t* rowp = O + (size_t)row * ldc + col0;
#pragma unroll
                for (int bj = 0; bj < 2; ++bj) { const pg8::f32x4 v0 = acc[ai][bj][m][0] * sc, v1 = acc[ai][bj][m][1] * sc;
                    u32x4 w; w.x = pg8::cvt_pk_bf16(v0[0], v0[1]); w.y = pg8::cvt_pk_bf16(v0[2], v0[3]); w.z = pg8::cvt_pk_bf16(v1[0], v1[1]); w.w = pg8::cvt_pk_bf16(v1[2], v1[3]);
                    *(u32x4*)(rowp + bj * 128) = w; } }
    }
};
struct SliceOrder {
    int nunits, G, c;
    __device__ __forceinline__ bool next(int i, pg8::Unit& u) const { const int L = i * G + c; if (L >= nunits) return false; const int t = L & 7; u.pm = t >> 2; u.pn = t & 3; u.ks = L >> 3; return true; }
    __device__ __forceinline__ void a_ready(const pg8::Unit&) const {}
    __device__ __forceinline__ void done(const pg8::Unit&) const {}
};
struct EpiF32Part {
    static constexpr bool PERM = false, AFTER_DRAIN = false;
    float* C;
    __device__ __forceinline__ void operator()(const pg8::f32x4 (&acc)[2][2][4][2], const pg8::Unit& u, int wr, int wc, int fr, int fq) const {
        const int row0 = u.pm * 256 + wr * 64 + fr, col0 = u.pn * 256 + wc * 32 + 4 * fq; float* base = C + (size_t)u.ks * (512 * 1024);
#pragma unroll
        for (int ai = 0; ai < 2; ++ai)
#pragma unroll
            for (int m = 0; m < 4; ++m) { float* rowp = base + (size_t)(row0 + ai * 128 + m * 16) * 1024 + col0;
#pragma unroll
                for (int bj = 0; bj < 2; ++bj)
#pragma unroll
                    for (int n = 0; n < 2; ++n) *(pg8::f32x4*)(rowp + bj * 128 + n * 16) = acc[ai][bj][m][n]; }
    }
};

struct SrcIn { const float* w; const float* nw; __device__ __forceinline__ float operator()(int k, int n) const { return w[(size_t)k * INW + (n < 1536 ? n : n + 8)] * nw[k]; } };
struct SrcPlain { const float* w; int N; __device__ __forceinline__ float operator()(int k, int n) const { return w[(size_t)k * N + n]; } };
struct SrcGU { const float* g; const float* u; const float* nw; __device__ __forceinline__ float operator()(int k, int n) const { const int r = n & 31, hid = (n >> 5) * 16 + (r & 15); const long long du = (r < 16) ? 0ll : (long long)(u - g); return g[du + (long long)k * DFF + hid] * nw[k]; } };
template <class Src> __device__ __forceinline__ void transpose_item(const Src& src, int K, bf16_t* WT, int nblk, LAS float* scr, int item, int lane) {
    const int kb = item / nblk, nb = item % nblk, k0 = 64 * kb, n0 = 32 * nb;
#pragma unroll 8
    for (int i = 0; i < 32; ++i) { const int kk = 2 * i + (lane >> 5); scr[kk * 33 + (lane & 31)] = src(k0 + kk, n0 + (lane & 31)); }
    LDS_FENCE();
    const int c = lane & 7;
#pragma unroll
    for (int j = 0; j < 4; ++j) { const int n = (lane >> 3) + 8 * j; const LAS float* s = scr + (8 * c) * 33 + n;
        u32x4 o; o.x = pk2(s[0 * 33], s[1 * 33]); o.y = pk2(s[2 * 33], s[3 * 33]); o.z = pk2(s[4 * 33], s[5 * 33]); o.w = pk2(s[6 * 33], s[7 * 33]);
        *(u32x4*)(WT + (size_t)(n0 + n) * K + k0 + 8 * c) = o; }
    LDS_FENCE();
}

__device__ __forceinline__ void norm_rows(const float* T, const float* wt, const float* X0, const float* X1, float* Xout, const float* wh, float* RSC,
                                          const float* Wab, float* AB, int gw, int NGW, int lane, const float* Tp = nullptr, int ns = 0,
                                          const bf16_t* Xbin = nullptr, bf16_t* Xbout = nullptr) {
#pragma unroll 1
    for (int m = gw; m < NTOK; m += NGW) {
        f32x4 x[4], t[4];
        { if (Xbin) {
#pragma unroll
              for (int j = 0; j < 4; ++j) { const u32x2 xb = ((const u32x2*)(Xbin + (size_t)m * D))[lane + 64 * j];
                  x[j] = (f32x4){__uint_as_float(xb.x << 16), __uint_as_float(xb.x & 0xffff0000u), __uint_as_float(xb.y << 16), __uint_as_float(xb.y & 0xffff0000u)}; } }
          else { const float* xr = (X1 && m >= NP) ? X1 + (size_t)(m - NP) * D : X0 + (size_t)m * D;
#pragma unroll
              for (int j = 0; j < 4; ++j) x[j] = ((const f32x4*)xr)[lane + 64 * j]; }
          if (T && !(Tp && m >= NP)) {
#pragma unroll
              for (int j = 0; j < 4; ++j) { const u32x2 tb = ((const u32x2*)((const bf16_t*)T + (size_t)m * D))[lane + 64 * j];
                  t[j] = (f32x4){__uint_as_float(tb.x << 16), __uint_as_float(tb.x & 0xffff0000u), __uint_as_float(tb.y << 16), __uint_as_float(tb.y & 0xffff0000u)}; } } }
        if (T) {
            float ss = 0.f;
            if (Tp && m >= NP) {
#pragma unroll
                for (int j = 0; j < 4; ++j) { f32x4 a = {0.f, 0.f, 0.f, 0.f}; for (int q = 0; q < ns; ++q) a += ((const f32x4*)(Tp + (size_t)q * (512 * 1024) + (size_t)(m - NP) * D))[lane + 64 * j]; t[j] = a; } }
#pragma unroll
            for (int j = 0; j < 4; ++j) ss += (t[j].x * t[j].x + t[j].y * t[j].y) + (t[j].z * t[j].z + t[j].w * t[j].w);
            ss = wave_sum(ss); const float r = rsqrtf(ss * (1.f / D) + EPS);
#pragma unroll
            for (int j = 0; j < 4; ++j) { const f32x4 w = ((const f32x4*)wt)[lane + 64 * j]; x[j] += t[j] * r * w; }
        }
        if (Xout) {
#pragma unroll
            for (int j = 0; j < 4; ++j) ((f32x4*)(Xout + (size_t)m * D))[lane + 64 * j] = x[j];
        }
        if (Xbout) {
#pragma unroll
            for (int j = 0; j < 4; ++j) { u32x2 o; o.x = pg8::cvt_pk_bf16(x[j].x, x[j].y); o.y = pg8::cvt_pk_bf16(x[j].z, x[j].w); ((u32x2*)(Xbout + (size_t)m * D))[lane + 64 * j] = o; }
        }
        if (RSC) {
            float ss = 0.f;
#pragma unroll
            for (int j = 0; j < 4; ++j) ss += (x[j].x * x[j].x + x[j].y * x[j].y) + (x[j].z * x[j].z + x[j].w * x[j].w);
            ss = wave_sum(ss); const float r = rsqrtf(ss * (1.f / D) + EPS);
            if (lane == 0) RSC[m] = r;
            f32x4 hv[4];
#pragma unroll
            for (int j = 0; j < 4; ++j) { const f32x4 w = ((const f32x4*)wh)[lane + 64 * j]; hv[j] = x[j] * r * w; }
            if (Wab) {
                float d[8];
#pragma unroll
                for (int c = 0; c < 8; ++c) { float dd = 0.f;
#pragma unroll
                    for (int j = 0; j < 4; ++j) { const f32x4 w = ((const f32x4*)(Wab + c * D))[lane + 64 * j]; dd += (hv[j].x * w.x + hv[j].y * w.y) + (hv[j].z * w.z + hv[j].w * w.w); }
                    d[c] = dd; }
#pragma unroll
                for (int c = 0; c < 8; ++c) d[c] = row_sum16(d[c]);
#pragma unroll
                for (int o = 16; o < 64; o <<= 1) {
#pragma unroll
                    for (int c = 0; c < 8; ++c) d[c] += __shfl_xor(d[c], o); }
                if (lane == 0) { f32x4 o0 = {d[0], d[1], d[2], d[3]}, o1 = {d[4], d[5], d[6], d[7]}; *(f32x4*)(AB + (size_t)m * 8) = o0; *(f32x4*)(AB + (size_t)m * 8 + 4) = o1; }
            }
        }
    }
}

__device__ __forceinline__ void norm_rows_pf(const float* T, const float* wt, bf16_t* XB, float* RSC,
                                             int gw, int NGW, int lane, const float* Tp, int ns) {
    u32x2 xn[4], tn[4];
#define NR_LOAD(mm) do { const int _m = (mm); \
        _Pragma("unroll") for (int j = 0; j < 4; ++j) xn[j] = ((const u32x2*)(XB + (size_t)_m * D))[lane + 64 * j]; \
        if (_m < NP) { _Pragma("unroll") for (int j = 0; j < 4; ++j) tn[j] = ((const u32x2*)((const bf16_t*)T + (size_t)_m * D))[lane + 64 * j]; } } while (0)
    if (gw < NTOK) NR_LOAD(gw);
#pragma unroll 1
    for (int m = gw; m < NTOK; m += NGW) {
        f32x4 x[4], t[4];
#pragma unroll
        for (int j = 0; j < 4; ++j) { x[j] = (f32x4){__uint_as_float(xn[j].x << 16), __uint_as_float(xn[j].x & 0xffff0000u), __uint_as_float(xn[j].y << 16), __uint_as_float(xn[j].y & 0xffff0000u)};
            t[j] = (f32x4){__uint_as_float(tn[j].x << 16), __uint_as_float(tn[j].x & 0xffff0000u), __uint_as_float(tn[j].y << 16), __uint_as_float(tn[j].y & 0xffff0000u)}; }
        if (m + NGW < NTOK) NR_LOAD(m + NGW);
        if (m >= NP) {
#pragma unroll
            for (int j = 0; j < 4; ++j) { f32x4 a = {0.f, 0.f, 0.f, 0.f}; for (int q = 0; q < ns; ++q) a += ((const f32x4*)(Tp + (size_t)q * (512 * 1024) + (size_t)(m - NP) * D))[lane + 64 * j]; t[j] = a; } }
        float ss = 0.f;
#pragma unroll
        for (int j = 0; j < 4; ++j) ss += (t[j].x * t[j].x + t[j].y * t[j].y) + (t[j].z * t[j].z + t[j].w * t[j].w);
        ss = wave_sum(ss); const float r = rsqrtf(ss * (1.f / D) + EPS);
#pragma unroll
        for (int j = 0; j < 4; ++j) { const f32x4 w = ((const f32x4*)wt)[lane + 64 * j]; x[j] += t[j] * r * w; }
#pragma unroll
        for (int j = 0; j < 4; ++j) { u32x2 o; o.x = pg8::cvt_pk_bf16(x[j].x, x[j].y); o.y = pg8::cvt_pk_bf16(x[j].z, x[j].w); ((u32x2*)(XB + (size_t)m * D))[lane + 64 * j] = o; }
        float s2 = 0.f;
#pragma unroll
        for (int j = 0; j < 4; ++j) s2 += (x[j].x * x[j].x + x[j].y * x[j].y) + (x[j].z * x[j].z + x[j].w * x[j].w);
        s2 = wave_sum(s2); if (lane == 0) RSC[m] = rsqrtf(s2 * (1.f / D) + EPS);
    }
#undef NR_LOAD
}

__device__ __forceinline__ void prologue(const DevArgs& A, LAS unsigned char* lds, int wave, int lane, int gw, int NGW) {
    LAS float* scr = (LAS float*)(lds + wave * 8704);
    constexpr int I_IN = 16 * 80, I_OUT = 16 * 32, I_GU = 16 * 176, I_DN = 44 * 32, I_GLU = 4 * 8, I_POOL = 8, PER = I_IN + I_OUT + I_GU + I_DN + I_GLU + I_POOL;
#pragma unroll 1
    for (int it = gw; it < DEPTH * PER; it += NGW) {
        const int l = it / PER; int r = it % PER;
        if (r < I_IN) { SrcIn s{A.in[I_WIN] + (size_t)l * D * INW, A.in[I_NMPRE] + l * D}; transpose_item(s, D, (bf16_t*)(A.ws + WS_WIN + l * SZ_WIN), NPROJ / 32, scr, r, lane); continue; } r -= I_IN;
        if (r < I_OUT) { SrcPlain s{A.in[I_WOUT] + (size_t)l * D * D, D}; transpose_item(s, D, (bf16_t*)(A.ws + WS_WOUT + l * SZ_WOUT), D / 32, scr, r, lane); continue; } r -= I_OUT;
        if (r < I_GU) { SrcGU s{A.in[I_WG] + (size_t)l * D * DFF, A.in[I_WU] + (size_t)l * D * DFF, A.in[I_NFPRE] + l * D}; transpose_item(s, D, (bf16_t*)(A.ws + WS_WGU + l * SZ_WGU), NGU / 32, scr, r, lane); continue; } r -= I_GU;
        if (r < I_DN) { SrcPlain s{A.in[I_WD] + (size_t)l * DFF * D, D}; transpose_item(s, DFF, (bf16_t*)(A.ws + WS_WDN + l * SZ_WDN), D / 32, scr, r, lane); continue; } r -= I_DN;
        if (r < I_GLU) { SrcPlain s{A.in[I_GLUW] + (size_t)l * 65536, 256}; transpose_item(s, 256, (bf16_t*)(A.ws + WS_GLUT + l * SZ_GLUT), 8, scr, r, lane); continue; } r -= I_GLU;
        { const int g = r >> 1; SrcPlain s{A.in[I_POOLW] + (size_t)(l * 4 + g) * 4096, 64}; transpose_item(s, 64, (bf16_t*)(A.ws + WS_POOLT + l * SZ_POOLT) + g * 4096, 2, scr, r & 1, lane); }
    }
    const int gt = gw * 64 + lane, NT = NGW * 64;
    float* wab = (float*)(A.ws + WS_WAB);
#pragma unroll 1
    for (int i = gt; i < DEPTH * 8 * D; i += NT) { const int l = i / (8 * D), j = (i / D) & 7, k = i % D; wab[i] = A.in[I_WIN][((size_t)l * D + k) * INW + 1536 + j]; }
    float* ssmk = (float*)(A.ws + WS_SSMK); float* bbar = (float*)(A.ws + WS_BBAR);
#pragma unroll 1
    for (int i = gt; i < DEPTH * 16 * 64; i += NT) {
        const int lg = i >> 6;
        const float dt = expf(A.in[I_LOGDT][lg]), ar = A.in[I_ARE][i], ai = A.in[I_AIM][i];
        const float mag = expf(ar * dt);
        float rev = ai * dt * 0.15915494309189535f; rev -= floorf(rev);
        const float sn = __builtin_amdgcn_sinf(rev), cs = __builtin_amdgcn_cosf(rev);
        const float lr = mag * cs, li = mag * sn;
        float pr = lr, pi = li;
#pragma unroll
        for (int q = 0; q < 6; ++q) { const float nr2 = pr * pr - pi * pi, ni2 = 2.f * pr * pi; pr = nr2; pi = ni2; }
        ssmk[i * 4 + 0] = lr; ssmk[i * 4 + 1] = li; ssmk[i * 4 + 2] = pr; ssmk[i * 4 + 3] = pi;
        const float nr = lr - 1.f, ni = li, d2 = ar * ar + ai * ai;
        const float cre = (nr * ar + ni * ai) / d2, cim = (ni * ar - nr * ai) / d2;
#pragma unroll
        for (int h = 0; h < 16; ++h) { const float br = A.in[I_BRE][(size_t)i * 16 + h], bi = A.in[I_BIM][(size_t)i * 16 + h];
            bbar[(size_t)i * 32 + h] = cre * br - cim * bi; bbar[(size_t)i * 32 + 16 + h] = cre * bi + cim * br; }
    }
}

__device__ __forceinline__ unsigned bfmul2(unsigned pk, float f0, float f1) { return pg8::cvt_pk_bf16(__uint_as_float(pk << 16) * f0, __uint_as_float(pk & 0xffff0000u) * f1); }
__device__ __forceinline__ void delta_prep_item(const DevArgs& A, int l, LAS unsigned char* lds, int item, int tid, int wave, int lane) {
    asm volatile("" : "+v"(tid)); lane = tid & 63; wave = __builtin_amdgcn_readfirstlane(tid >> 6);
    const int bh = item >> 5, n = item & 31, b = bh >> 2, h = bh & 3;
    const int tok0 = b * SEQ + n * 64;
    LAS bf16_t* QS = (LAS bf16_t*)(lds); LAS bf16_t* KS = (LAS bf16_t*)(lds + 17408);
    LAS unsigned char* KT = lds + 34816; LAS unsigned char* VT = lds + 53248; LAS unsigned char* RTK = lds + 71680;
    LAS float* AM = (LAS float*)(lds + 90112); LAS float* PM = (LAS float*)(lds + 107520); LAS float* PSC = PM; LAS float* TM = (LAS float*)(lds + 124928);
    LAS unsigned char* TB = lds + 142336;
    LAS float* GAM = (LAS float*)(lds + 151552); LAS float* BETA = GAM + 64; LAS float* RQ = GAM + 128; LAS float* RK = GAM + 192;
    LAS float* F2 = GAM + 256; LAS float* F3 = GAM + 320; LAS float* F4 = GAM + 384;
    const bf16_t* PROJ = (const bf16_t*)(A.ws + WS_PROJ);
    const float* AB = (const float*)(A.ws + WS_AB);
    u32x4 gv[2];
#pragma unroll
    for (int j = 0; j < 2; ++j) { const int id = tid + 512 * j; gv[j] = *(const u32x4*)(PROJ + (size_t)(tok0 + (id >> 4)) * NPROJ + PC_G + h * 128 + (id & 15) * 8); }
    if (tid < 384) {
        const int part = tid >> 7, c = tid & 127, col = part * 512 + h * 128 + c;
        const float* cw = A.in[I_CONVW] + (size_t)l * 4 * 1536;
        const float w0 = cw[col], w1 = cw[1536 + col], w2 = cw[3072 + col], w3 = cw[4608 + col];
        const bf16_t* pp = PROJ + (size_t)tok0 * NPROJ + col;
        float xr[67];
#pragma unroll
        for (int t = 0; t < 67; ++t) xr[t] = (n > 0 || t >= 3) ? bf2f(pp[(long)(t - 3) * NPROJ]) : 0.f;
        unsigned pk[32];
#pragma unroll
        for (int t = 0; t < 64; t += 2) {
            const float s0 = silu_f(w0 * xr[t] + w1 * xr[t + 1] + w2 * xr[t + 2] + w3 * xr[t + 3]);
            const float s1 = silu_f(w0 * xr[t + 1] + w1 * xr[t + 2] + w2 * xr[t + 3] + w3 * xr[t + 4]);
            pk[t >> 1] = pg8::cvt_pk_bf16(s0, s1);
        }
        if (part < 2) { LAS bf16_t* dst = (part == 0 ? QS : KS) + c;
#pragma unroll
            for (int t = 0; t < 64; t += 2) { dst[t * 136] = (bf16_t)(pk[t >> 1] & 0xffffu); dst[(t + 1) * 136] = (bf16_t)(pk[t >> 1] >> 16); } }
        if (part > 0) { LAS unsigned char* dst = (part == 1 ? KT : VT) + c * 144;
#pragma unroll
            for (int q = 0; q < 8; ++q) { u32x4 o; o.x = pk[4 * q]; o.y = pk[4 * q + 1]; o.z = pk[4 * q + 2]; o.w = pk[4 * q + 3]; *(LAS u32x4*)(dst + q * 16) = o; } }
    } else if (tid < 448) {
        const int t = tid - 384;
        const float a = AB[(size_t)(tok0 + t) * 8 + h], bb = AB[(size_t)(tok0 + t) * 8 + 4 + h];
        const float xx = a + A.in[I_DTB][l * 4 + h];
        const float sp = xx > 20.f ? xx : log1pf(expf(xx));
        float lg = -expf(A.in[I_ALOG][l * 4 + h]) * sp;
#pragma unroll
        for (int off = 1; off < 64; off <<= 1) { const float v = __shfl_up(lg, off); if (lane >= off) lg += v; }
        GAM[t] = lg; BETA[t] = 1.f / (1.f + expf(-bb));
    }
    __syncthreads();
    {
        const int t = tid >> 3, part = tid & 7; float sq = 0.f, sk = 0.f;
#pragma unroll
        for (int j = 0; j < 16; ++j) { const float q = bf2f(QS[t * 136 + part * 16 + j]), k = bf2f(KS[t * 136 + part * 16 + j]); sq += q * q; sk += k * k; }
        sq = row_sum8(sq); sk = row_sum8(sk);
        if (part == 0) { const float rq = rsqrtf(sq + EPS) * 0.08838834764831845f, rk = rsqrtf(sk + EPS), g = GAM[t], eg = __expf(g), bt = BETA[t];
            RQ[t] = rq; RK[t] = rk; F2[t] = bt * eg * rk; F3[t] = rk * __expf(GAM[63] - g); F4[t] = rq * eg; }
    }
    {
        const int prod = wave >> 2, mt = wave & 3, fr = lane & 15, quad = lane >> 4;
        LAS bf16_t* Aop = prod ? QS : KS; LAS float* dst = prod ? PM : AM;
        bf16x8 a[4];
#pragma unroll
        for (int kk = 0; kk < 4; ++kk) a[kk] = *(LAS bf16x8*)(Aop + (mt * 16 + fr) * 136 + kk * 32 + quad * 8);
#pragma unroll
        for (int nt = 0; nt < 4; ++nt) { f32x4 acc = {0.f, 0.f, 0.f, 0.f};
#pragma unroll
            for (int kk = 0; kk < 4; ++kk) { const bf16x8 bq = *(LAS bf16x8*)(KS + (nt * 16 + fr) * 136 + kk * 32 + quad * 8); acc = mfma16(a[kk], bq, acc); }
#pragma unroll
            for (int i = 0; i < 4; ++i) dst[(mt * 16 + quad * 4 + i) * 68 + nt * 16 + fr] = acc[i]; }
    }
    __syncthreads();
    {
        const int t = tid >> 3, s8 = (tid & 7) * 8; const float gt = GAM[t], bk = BETA[t] * RK[t], rqt = RQ[t];
        float av[8], pv[8];
#pragma unroll
        for (int j = 0; j < 8; ++j) { const int s = s8 + j; const float rks = RK[s]; const float dec = (s <= t) ? __expf(gt - GAM[s]) * rks : 0.f;
            av[j] = (s < t) ? bk * dec * AM[t * 68 + s] : 0.f; pv[j] = rqt * dec * PM[t * 68 + s]; }
#pragma unroll
        for (int j = 0; j < 8; ++j) AM[t * 68 + s8 + j] = av[j];
        u32x4 o; o.x = pg8::cvt_pk_bf16(pv[0], pv[1]); o.y = pg8::cvt_pk_bf16(pv[2], pv[3]); o.z = pg8::cvt_pk_bf16(pv[4], pv[5]); o.w = pg8::cvt_pk_bf16(pv[6], pv[7]);
        *(u32x4*)((bf16_t*)(A.ws + WS_DQK) + (size_t)item * 4096 + t * 64 + s8) = o;
        for (int e = tid; e < 64 * 68; e += 512) TM[e] = 0.f;
        if (tid == 0) ((float*)(A.ws + WS_DGL))[item] = __expf(GAM[63]);
    }
    __syncthreads();
    if (wave == 0) {
        const int i = lane >> 4, c = lane & 15;
        LAS float* amp = AM + (16 * i) * 68 + 16 * i; asm volatile("" : "+v"(amp));
        float x[16];
#pragma unroll
        for (int r = 0; r < 16; ++r) { float acc = (r == c) ? 1.f : 0.f;
#pragma unroll
            for (int s = 0; s < r; ++s) acc = fmaf(-amp[r * 68 + s], x[s], acc);
            x[r] = acc; }
        LAS float* tmp = TM + (16 * i) * 68 + 16 * i + c;
#pragma unroll
        for (int r = 0; r < 16; ++r) tmp[r * 68] = x[r];
    } else {
        const int wt = tid - 64;
        for (int id = wt; id < 1024; id += 448) {
            const int c = id >> 3, t8 = (id & 7) * 8;
            const f32x4 b0 = *(LAS f32x4*)(BETA + t8), b1 = *(LAS f32x4*)(BETA + t8 + 4);
            u32x4 v = *(LAS u32x4*)(VT + c * 144 + t8 * 2);
            v.x = bfmul2(v.x, b0[0], b0[1]); v.y = bfmul2(v.y, b0[2], b0[3]); v.z = bfmul2(v.z, b1[0], b1[1]); v.w = bfmul2(v.w, b1[2], b1[3]);
            *(LAS u32x4*)(VT + c * 144 + t8 * 2) = v;
            const f32x4 f20 = *(LAS f32x4*)(F2 + t8), f21 = *(LAS f32x4*)(F2 + t8 + 4), f30 = *(LAS f32x4*)(F3 + t8), f31 = *(LAS f32x4*)(F3 + t8 + 4);
            const u32x4 k = *(LAS u32x4*)(KT + c * 144 + t8 * 2);
            u32x4 rk; rk.x = bfmul2(k.x, f20[0], f20[1]); rk.y = bfmul2(k.y, f20[2], f20[3]); rk.z = bfmul2(k.z, f21[0], f21[1]); rk.w = bfmul2(k.w, f21[2], f21[3]);
            *(LAS u32x4*)(RTK + c * 144 + t8 * 2) = rk;
            u32x4 kd; kd.x = bfmul2(k.x, f30[0], f30[1]); kd.y = bfmul2(k.y, f30[2], f30[3]); kd.z = bfmul2(k.z, f31[0], f31[1]); kd.w = bfmul2(k.w, f31[2], f31[3]);
            *(u32x4*)((bf16_t*)(A.ws + WS_DKT) + (size_t)item * 8192 + c * 64 + t8) = kd; }
        for (int id = wt; id < 1024; id += 448) {
            const int t = id >> 4, c8 = (id & 15) * 8; const float f = F4[t];
            u32x4 q = *(LAS u32x4*)((LAS unsigned char*)QS + t * 272 + c8 * 2);
            q.x = bfmul2(q.x, f, f); q.y = bfmul2(q.y, f, f); q.z = bfmul2(q.z, f, f); q.w = bfmul2(q.w, f, f);
            *(u32x4*)((bf16_t*)(A.ws + WS_DQD) + (size_t)item * 8192 + t * 128 + c8) = q; }
    }
    {
        const int c8 = (tid & 15) * 8; const float* on = A.in[I_ONORM] + l * 128 + c8;
        const f32x4 o0 = *(const f32x4*)on, o1 = *(const f32x4*)(on + 4);
#pragma unroll
        for (int j = 0; j < 2; ++j) { const int id = tid + 512 * j; const u32x4 g = gv[j]; u32x4 o;
            o.x = pg8::cvt_pk_bf16(silu_f(__uint_as_float(g.x << 16)) * o0[0], silu_f(__uint_as_float(g.x & 0xffff0000u)) * o0[1]);
            o.y = pg8::cvt_pk_bf16(silu_f(__uint_as_float(g.y << 16)) * o0[2], silu_f(__uint_as_float(g.y & 0xffff0000u)) * o0[3]);
            o.z = pg8::cvt_pk_bf16(silu_f(__uint_as_float(g.z << 16)) * o1[0], silu_f(__uint_as_float(g.z & 0xffff0000u)) * o1[1]);
            o.w = pg8::cvt_pk_bf16(silu_f(__uint_as_float(g.w << 16)) * o1[2], silu_f(__uint_as_float(g.w & 0xffff0000u)) * o1[3]);
            *(u32x4*)((bf16_t*)(A.ws + WS_DGS) + (size_t)item * 8192 + (id >> 4) * 128 + c8) = o; }
    }
    __syncthreads();
    const int p2 = tid >> 8, r2 = (tid >> 4) & 15, c2 = tid & 15, rb = p2 ? 48 : 16, cb = p2 ? 32 : 0;
    {
        float acc = 0.f;
#pragma unroll
        for (int s = 0; s < 16; ++s) acc = fmaf(AM[(rb + r2) * 68 + cb + s], TM[(cb + s) * 68 + cb + c2], acc);
        PSC[(p2 * 16 + r2) * 68 + c2] = acc; }
    __syncthreads();
    {
        float acc = 0.f;
#pragma unroll
        for (int s = 0; s < 16; ++s) acc = fmaf(TM[(rb + r2) * 68 + rb + s], PSC[(p2 * 16 + s) * 68 + c2], acc);
        TM[(rb + r2) * 68 + cb + c2] = -acc; }
    __syncthreads();
    float p3[2];
#pragma unroll
    for (int j = 0; j < 2; ++j) { const int e = tid + 512 * j, r = e >> 5, c = e & 31; float acc = 0.f;
#pragma unroll 8
        for (int s = 0; s < 32; ++s) acc = fmaf(AM[(32 + r) * 68 + s], TM[s * 68 + c], acc);
        p3[j] = acc; }
    __syncthreads();
#pragma unroll
    for (int j = 0; j < 2; ++j) { const int e = tid + 512 * j; PSC[(e >> 5) * 68 + (e & 31)] = p3[j]; }
    __syncthreads();
#pragma unroll
    for (int j = 0; j < 2; ++j) { const int e = tid + 512 * j, r = e >> 5, c = e & 31; float acc = 0.f;
#pragma unroll 8
        for (int s = 0; s < 32; ++s) acc = fmaf(TM[(32 + r) * 68 + 32 + s], PSC[s * 68 + c], acc);
        p3[j] = -acc; }
#pragma unroll
    for (int j = 0; j < 2; ++j) { const int e = tid + 512 * j; TM[(32 + (e >> 5)) * 68 + (e & 31)] = p3[j]; }
    __syncthreads();
#pragma unroll
    for (int j = 0; j < 4; ++j) { const int e = tid + 512 * j, t = e >> 5, s2 = (e & 31) * 2;
        *(LAS unsigned*)(TB + t * 144 + s2 * 2) = pg8::cvt_pk_bf16(TM[t * 68 + s2], TM[t * 68 + s2 + 1]); }
    __syncthreads();
    {
        const int fr = lane & 15, quad = lane >> 4;
        bf16x8 bv[2], ak[2];
#pragma unroll
        for (int kk = 0; kk < 2; ++kk) { bv[kk] = *(LAS bf16x8*)(VT + (16 * wave + fr) * 144 + (kk * 32 + quad * 8) * 2); ak[kk] = *(LAS bf16x8*)(RTK + (16 * wave + fr) * 144 + (kk * 32 + quad * 8) * 2); }
        bf16_t* DW = (bf16_t*)(A.ws + WS_DW) + (size_t)item * 8192; bf16_t* DKC = (bf16_t*)(A.ws + WS_DKC) + (size_t)item * 8192;
#pragma unroll
        for (int mt = 0; mt < 4; ++mt) { f32x4 aw = {0.f, 0.f, 0.f, 0.f}, akc = {0.f, 0.f, 0.f, 0.f};
#pragma unroll
            for (int kk = 0; kk < 2; ++kk) { const bf16x8 tf = *(LAS bf16x8*)(TB + (mt * 16 + fr) * 144 + (kk * 32 + quad * 8) * 2);
                aw = mfma16(tf, bv[kk], aw);
                akc = mfma16(ak[kk], tf, akc); }
            u32x2 ow; ow.x = pk2(aw[0], aw[1]); ow.y = pk2(aw[2], aw[3]);
            *(u32x2*)(DW + (16 * wave + fr) * 64 + mt * 16 + quad * 4) = ow;
            u32x2 ok; ok.x = pk2(-akc[0], -akc[1]); ok.y = pk2(-akc[2], -akc[3]);
            *(u32x2*)(DKC + (mt * 16 + fr) * 128 + 16 * wave + quad * 4) = ok; }
    }
    __syncthreads();
}

__device__ __forceinline__ void delta_scan_item(const DevArgs& A, int l, LAS unsigned char* lds, int bh, int tid_in, int wave, int lane_in, const XcdBarrier& xb, int SUB) {
    const int b = bh >> 2, h = bh & 3;
    LAS unsigned char* KCs = lds; LAS unsigned char* QDs = lds + 17408; LAS unsigned char* QKs = lds + 34816; LAS unsigned char* KDTs = lds + 44032;
    LAS unsigned char* Ws = lds + 62464;
    LAS unsigned char* GSs = lds + 80896;
    LAS unsigned char* SS = lds + 98304 + wave * 4352; LAS unsigned char* US = lds + 133120 + wave * 2304;
    LAS float* PART = (LAS float*)(lds + 151552);
    const unsigned char* gW = A.ws + WS_DW; const unsigned char* gGS = A.ws + WS_DGS;
    const unsigned char* gKC = A.ws + WS_DKC; const unsigned char* gQD = A.ws + WS_DQD; const unsigned char* gQK = A.ws + WS_DQK; const unsigned char* gKT = A.ws + WS_DKT;
    const float* DGL = (const float*)(A.ws + WS_DGL);
    f32x4 S[8];
#pragma unroll
    for (int mt = 0; mt < 8; ++mt) S[mt] = (f32x4){0.f, 0.f, 0.f, 0.f};
    u32x4 r[9], rg[2];
    float gl_all = 0.f;
#define DS_LOAD(itn, toff) do { const size_t _i = (size_t)(itn); const unsigned char* _kc = gKC + _i * 16384; const unsigned char* _qd = gQD + _i * 16384; \
        const unsigned char* _qk = gQK + _i * 8192; const unsigned char* _kt = gKT + _i * 16384; \
        r[0] = *(const u32x4*)(_kc + (toff)); r[1] = *(const u32x4*)(_kc + (toff) + 8192u); \
        r[2] = *(const u32x4*)(_qd + (toff)); r[3] = *(const u32x4*)(_qd + (toff) + 8192u); \
        r[4] = *(const u32x4*)(_qk + (toff)); \
        r[5] = *(const u32x4*)(_kt + (toff)); r[6] = *(const u32x4*)(_kt + (toff) + 8192u); \
        const unsigned char* _w = gW + _i * 16384; r[7] = *(const u32x4*)(_w + (toff)); r[8] = *(const u32x4*)(_w + (toff) + 8192u); } while (0)
#define DS_LOADG(itn, toff) do { const unsigned char* _g = gGS + (size_t)(itn) * 16384; rg[0] = *(const u32x4*)(_g + (toff)); rg[1] = *(const u32x4*)(_g + (toff) + 8192u); } while (0)
#define DS_STAGE(tidv) do { const int i0 = (tidv), i1 = (tidv) + 512; \
          *(LAS u32x4*)(KCs + (i0 >> 4) * 272 + (i0 & 15) * 16) = r[0]; *(LAS u32x4*)(KCs + (i1 >> 4) * 272 + (i1 & 15) * 16) = r[1]; \
          *(LAS u32x4*)(QDs + (i0 >> 4) * 272 + (i0 & 15) * 16) = r[2]; *(LAS u32x4*)(QDs + (i1 >> 4) * 272 + (i1 & 15) * 16) = r[3]; \
          *(LAS u32x4*)(QKs + (i0 >> 3) * 144 + (i0 & 7) * 16) = r[4]; \
          *(LAS u32x4*)(KDTs + (i0 >> 3) * 144 + (i0 & 7) * 16) = r[5]; *(LAS u32x4*)(KDTs + (i1 >> 3) * 144 + (i1 & 7) * 16) = r[6]; \
          *(LAS u32x4*)(Ws + (i0 >> 3) * 144 + (i0 & 7) * 16) = r[7]; *(LAS u32x4*)(Ws + (i1 >> 3) * 144 + (i1 & 7) * 16) = r[8]; } while (0)
#define DS_STAGEG(tidv) do { const int i0 = (tidv), i1 = (tidv) + 512; \
          *(LAS u32x4*)(GSs + (i0 >> 4) * 272 + (i0 & 15) * 16) = rg[0]; *(LAS u32x4*)(GSs + (i1 >> 4) * 272 + (i1 & 15) * 16) = rg[1]; } while (0)
#pragma unroll 1
    for (int n = 0; n < 32; ++n) {
        int tid = tid_in; asm volatile("" : "+v"(tid));
        const bool bstart = (SUB > 0) ? (n % SUB == 0) : (n == 0);
        const bool bnext1 = (SUB > 0) && ((n + 1) % SUB == 0), bnext2 = (SUB > 0) && ((n + 2) % SUB == 0);
        if (bstart) { if (n > 0) xcd_barrier(xb);
            gl_all = DGL[bh * 32 + (tid & 31)];
            const unsigned t0 = (unsigned)tid * 16u; DS_LOAD(bh * 32 + n, t0); DS_LOADG(bh * 32 + n, t0); DS_STAGE(tid); DS_STAGEG(tid);
            if (n + 1 < 32 && !bnext1) { DS_LOAD(bh * 32 + n + 1, t0); DS_LOADG(bh * 32 + n + 1, t0); }
            __syncthreads(); }
        else { DS_STAGEG(tid);
            if (n + 1 < 32 && !bnext1) DS_LOADG(bh * 32 + n + 1, (unsigned)tid * 16u); }
        const int lane = tid & 63, fr = lane & 15, quad = lane >> 4, vcol = 16 * wave + fr;
        const unsigned toff = (unsigned)tid * 16u;
        const int it = bh * 32 + n, tokb = b * SEQ + n * 64;
        const float glast = __builtin_bit_cast(float, __builtin_amdgcn_readlane(__builtin_bit_cast(int, gl_all), n));
        asm volatile("s_nop 7\n\ts_nop 7" ::: "memory");
#pragma unroll
        for (int mt = 0; mt < 8; ++mt) { u32x2 p; p.x = pg8::cvt_pk_bf16(S[mt][0], S[mt][1]); p.y = pg8::cvt_pk_bf16(S[mt][2], S[mt][3]); *(LAS u32x2*)(SS + fr * 272 + (mt * 16 + quad * 4) * 2) = p; }
        LDS_FENCE();
        bf16x8 Sb[4];
#pragma unroll
        for (int kk = 0; kk < 4; ++kk) Sb[kk] = *(LAS bf16x8*)(SS + fr * 272 + (kk * 32 + quad * 8) * 2);
        f32x4 U[4], O[4];
#pragma unroll
        for (int mt = 0; mt < 4; ++mt) { f32x4 au, ao = {0.f, 0.f, 0.f, 0.f};
            { const u32x2 wq = *(LAS u32x2*)(Ws + vcol * 144 + (mt * 16 + quad * 4) * 2);
              au[0] = __uint_as_float(wq.x << 16); au[1] = __uint_as_float(wq.x & 0xffff0000u); au[2] = __uint_as_float(wq.y << 16); au[3] = __uint_as_float(wq.y & 0xffff0000u); }
#pragma unroll
            for (int kk = 0; kk < 4; ++kk) { const bf16x8 a1 = *(LAS bf16x8*)(KCs + (mt * 16 + fr) * 272 + (kk * 32 + quad * 8) * 2); au = mfma16(a1, Sb[kk], au);
                const bf16x8 a2 = *(LAS bf16x8*)(QDs + (mt * 16 + fr) * 272 + (kk * 32 + quad * 8) * 2); ao = mfma16(a2, Sb[kk], ao); }
            U[mt] = au; O[mt] = ao; __builtin_amdgcn_sched_barrier(0); }
        asm volatile("s_nop 7\n\ts_nop 7" ::: "memory");
#pragma unroll
        for (int mt = 0; mt < 4; ++mt) { u32x2 p; p.x = pg8::cvt_pk_bf16(U[mt][0], U[mt][1]); p.y = pg8::cvt_pk_bf16(U[mt][2], U[mt][3]); *(LAS u32x2*)(US + fr * 144 + (mt * 16 + quad * 4) * 2) = p; }
        LDS_FENCE();
        bf16x8 Ub[2];
#pragma unroll
        for (int kk = 0; kk < 2; ++kk) Ub[kk] = *(LAS bf16x8*)(US + fr * 144 + (kk * 32 + quad * 8) * 2);
#pragma unroll
        for (int mt = 0; mt < 4; ++mt)
#pragma unroll
            for (int kk = 0; kk < 2; ++kk) { const bf16x8 a = *(LAS bf16x8*)(QKs + (mt * 16 + fr) * 144 + (kk * 32 + quad * 8) * 2); O[mt] = mfma16(a, Ub[kk], O[mt]); }
        __builtin_amdgcn_sched_barrier(0);
#pragma unroll
        for (int mt = 0; mt < 8; ++mt) { S[mt] *= glast;
#pragma unroll
            for (int kk = 0; kk < 2; ++kk) { const bf16x8 a = *(LAS bf16x8*)(KDTs + (mt * 16 + fr) * 144 + (kk * 32 + quad * 8) * 2); S[mt] = mfma16(a, Ub[kk], S[mt]); }
            if (mt & 1) __builtin_amdgcn_sched_barrier(0); }
        { float pp[16];
#pragma unroll
          for (int e = 0; e < 16; ++e) pp[e] = O[e >> 2][e & 3] * O[e >> 2][e & 3];
#pragma unroll
          for (int e = 0; e < 16; ++e) pp[e] = row_sum16(pp[e]);
          if (fr == 0) {
#pragma unroll
              for (int e = 0; e < 16; ++e) PART[((e >> 2) * 16 + quad * 4 + (e & 3)) * 8 + wave] = pp[e]; } }
        __syncthreads();
        if (n + 1 < 32 && !bnext1) { DS_STAGE(tid); if (n + 2 < 32 && !bnext2) DS_LOAD(it + 2, toff); }
        bf16_t* mixb = (bf16_t*)(A.ws + WS_MIX) + (size_t)tokb * D + h * 128;
#pragma unroll
        for (int mt = 0; mt < 4; ++mt)
#pragma unroll
            for (int i = 0; i < 4; ++i) { const int t = mt * 16 + quad * 4 + i;
                const f32x4 p0 = *(LAS f32x4*)(PART + t * 8), p1 = *(LAS f32x4*)(PART + t * 8 + 4);
                const float tot = ((p0[0] + p0[1]) + (p0[2] + p0[3])) + ((p1[0] + p1[1]) + (p1[2] + p1[3]));
                const float sc = rsqrtf(tot * (1.f / 128.f) + EPS);
                const float gs = bf2f(*(LAS bf16_t*)(GSs + t * 272 + vcol * 2));
                mixb[(unsigned)(t * D + vcol)] = (bf16_t)(pg8::cvt_pk_bf16(O[mt][i] * sc * gs, 0.f) & 0xffffu); }
        __syncthreads();
    }
#undef DS_STAGE
#undef DS_LOADG
#undef DS_STAGEG
#undef DS_LOAD
    { const int lane = lane_in, fr = lane & 15, quad = lane >> 4, vcol = 16 * wave + fr;
      float* dp = A.out + O_DP + (size_t)((l * 8 + b) * 4 + h) * 16384;
#pragma unroll
      for (int mt = 0; mt < 8; ++mt)
#pragma unroll
          for (int i = 0; i < 4; ++i) dp[(mt * 16 + quad * 4 + i) * 128 + vcol] = S[mt][i]; }
    __syncthreads();
}

__device__ __forceinline__ void delta_sample_item(const DevArgs& A, int l, LAS unsigned char* lds, int item, int tid, int wave, int lane) {
    asm volatile("" : "+v"(tid)); lane = tid & 63; wave = __builtin_amdgcn_readfirstlane(tid >> 6);
    const int b = item >> 2, h = item & 3, tokS = NP + b * 4;
    LAS float* RAW = (LAS float*)lds; LAS float* RED = RAW + 1536; LAS float* OB = RED + 512; LAS float* SC = OB + 512;
    const bf16_t* PROJ = (const bf16_t*)(A.ws + WS_PROJ); const float* AB = (const float*)(A.ws + WS_AB); bf16_t* MIX = (bf16_t*)(A.ws + WS_MIX);
    const float* cw = A.in[I_CONVW] + (size_t)l * 4 * 1536;
    for (int idx = tid; idx < 1536; idx += 512) { const int part = idx >> 9, t = (idx >> 7) & 3, c = idx & 127, col = part * 512 + h * 128 + c;
        float acc = 0.f;
#pragma unroll
        for (int j = 0; j < 4; ++j) { const int tt = t - 3 + j;
            const float x = (tt >= 0) ? bf2f(PROJ[(size_t)(tokS + tt) * NPROJ + col]) : A.in[I_SCONV][((size_t)(l * 128 + b) * 3 + (3 + tt)) * 1536 + col];
            acc += cw[j * 1536 + col] * x; }
        RAW[idx] = silu_f(acc); }
    if (tid < 4) { const float a = AB[(size_t)(tokS + tid) * 8 + h], bb = AB[(size_t)(tokS + tid) * 8 + 4 + h];
        const float xx = a + A.in[I_DTB][l * 4 + h]; const float sp = xx > 20.f ? xx : log1pf(expf(xx));
        SC[8 + tid] = 1.f / (1.f + expf(-bb)); SC[12 + tid] = expf(-expf(A.in[I_ALOG][l * 4 + h]) * sp); }
    const int v = tid & 127, kq = tid >> 7;
    float S[32];
    { const float* sp = A.in[I_SDELTA] + (size_t)((l * 128 + b) * 4 + h) * 16384;
#pragma unroll
      for (int i = 0; i < 32; ++i) S[i] = sp[(kq * 32 + i) * 128 + v]; }
    __syncthreads();
    { const int part = wave >> 2, t = wave & 3; const float x0 = RAW[part * 512 + t * 128 + lane], x1 = RAW[part * 512 + t * 128 + 64 + lane];
      const float ss = wave_sum(x0 * x0 + x1 * x1); if (lane == 0) SC[part * 4 + t] = rsqrtf(ss + EPS) * (part == 0 ? 0.08838834764831845f : 1.f); }
    __syncthreads();
    for (int t = 0; t < 4; ++t) {
        const float rq = SC[t], rk = SC[4 + t], beta = SC[8 + t], g = SC[12 + t];
        float pr = 0.f;
#pragma unroll
        for (int i = 0; i < 32; ++i) pr += S[i] * RAW[512 + t * 128 + kq * 32 + i];
        RED[kq * 128 + v] = pr * rk;
        __syncthreads();
        const float rr = (RED[v] + RED[128 + v]) + (RED[256 + v] + RED[384 + v]);
        const float u = beta * (RAW[1024 + t * 128 + v] - g * rr);
        float po = 0.f;
#pragma unroll
        for (int i = 0; i < 32; ++i) { const float kh = RAW[512 + t * 128 + kq * 32 + i] * rk; S[i] = g * S[i] + kh * u; po += S[i] * RAW[t * 128 + kq * 32 + i]; }
        __syncthreads();
        RED[kq * 128 + v] = po * rq;
        __syncthreads();
        if (kq == 0) OB[t * 128 + v] = (RED[v] + RED[128 + v]) + (RED[256 + v] + RED[384 + v]);
        __syncthreads();
    }
    if (wave < 4) { const int t = wave; const float x0 = OB[t * 128 + lane], x1 = OB[t * 128 + 64 + lane];
        const float ss = wave_sum(x0 * x0 + x1 * x1); const float sc = rsqrtf(ss * (1.f / 128.f) + EPS);
        const float g0 = bf2f(PROJ[(size_t)(tokS + t) * NPROJ + PC_G + h * 128 + lane]), g1 = bf2f(PROJ[(size_t)(tokS + t) * NPROJ + PC_G + h * 128 + 64 + lane]);
        MIX[(size_t)(tokS + t) * D + h * 128 + lane] = (bf16_t)f2bf(x0 * sc * A.in[I_ONORM][l * 128 + lane] * silu_f(g0));
        MIX[(size_t)(tokS + t) * D + h * 128 + 64 + lane] = (bf16_t)f2bf(x1 * sc * A.in[I_ONORM][l * 128 + 64 + lane] * silu_f(g1)); }
    { float* dsp = A.out + O_DS + (size_t)((l * 128 + b) * 4 + h) * 16384;
#pragma unroll
      for (int i = 0; i < 32; ++i) dsp[(kq * 32 + i) * 128 + v] = S[i]; }
    __syncthreads();
}

#define SSM_BCAST_U(t) do { unsigned _w[8]; \
        _w[0] = __builtin_amdgcn_readlane(ua.x, t); _w[1] = __builtin_amdgcn_readlane(ua.y, t); _w[2] = __builtin_amdgcn_readlane(ua.z, t); _w[3] = __builtin_amdgcn_readlane(ua.w, t); \
        _w[4] = __builtin_amdgcn_readlane(ub.x, t); _w[5] = __builtin_amdgcn_readlane(ub.y, t); _w[6] = __builtin_amdgcn_readlane(ub.z, t); _w[7] = __builtin_amdgcn_readlane(ub.w, t); \
        _Pragma("unroll") for (int _d = 0; _d < 8; ++_d) { uu[2 * _d] = __uint_as_float(_w[_d] << 16); uu[2 * _d + 1] = __uint_as_float(_w[_d] & 0xffff0000u); } } while (0)
#define SSM_STEP() do { float _br = 0.f, _bi = 0.f; \
        _Pragma("unroll") for (int _h = 0; _h < 16; ++_h) { _br = fmaf(Br[_h], uu[_h], _br); _bi = fmaf(Bi[_h], uu[_h], _bi); } \
        const float _nr = lr * hr - li * hi + _br, _ni = lr * hi + li * hr + _bi; hr = _nr; hi = _ni; } while (0)

__device__ __forceinline__ void ssm_part1_item(const DevArgs& A, int l, int it, int lane) {
    const int g = it & 15, bc = it >> 4, b = bc / 31, c = bc % 31;
    const float* bb = (const float*)(A.ws + WS_BBAR) + ((size_t)(l * 16 + g) * 64 + lane) * 32;
    float Br[16], Bi[16];
#pragma unroll
    for (int q = 0; q < 4; ++q) { const f32x4 x = ((const f32x4*)bb)[q], y = ((const f32x4*)bb)[4 + q];
        Br[4 * q] = x.x; Br[4 * q + 1] = x.y; Br[4 * q + 2] = x.z; Br[4 * q + 3] = x.w; Bi[4 * q] = y.x; Bi[4 * q + 1] = y.y; Bi[4 * q + 2] = y.z; Bi[4 * q + 3] = y.w; }
    const f32x4 lk = ((const f32x4*)(A.ws + WS_SSMK))[(l * 16 + g) * 64 + lane]; const float lr = lk.x, li = lk.y;
    const bf16_t* up = (const bf16_t*)(A.ws + WS_PROJ) + (size_t)(b * SEQ + c * 64 + lane) * NPROJ + PC_SSM + g * 16;
    const u32x4 ua = *(const u32x4*)up, ub = *(const u32x4*)(up + 8);
    float hr = 0.f, hi = 0.f, uu[16];
#pragma unroll 1
    for (int t = 0; t < 64; ++t) { SSM_BCAST_U(t); SSM_STEP(); }
    f32x2 e; e.x = hr; e.y = hi;
    ((f32x2*)(A.ws + WS_SSME))[((size_t)(b * 32 + c) * 16 + g) * 64 + lane] = e;
}

__device__ __forceinline__ void ssm_part2_item(const DevArgs& A, int l, LAS unsigned char* lds, int it, int tid, int wave, int lane) {
    asm volatile("" : "+v"(tid)); lane = tid & 63; wave = __builtin_amdgcn_readfirstlane(tid >> 6);
    const int tok0 = it * 64, fr = lane & 15, quad = lane >> 4;
    const bool samp = it >= 256; const int b = it >> 5, c = it & 31;
    LAS unsigned char* YS = lds; LAS unsigned char* HS = lds + 33792 + wave * 4352;
    const bf16_t* PROJ = (const bf16_t*)(A.ws + WS_PROJ); bf16_t* MIX = (bf16_t*)(A.ws + WS_MIX);
#pragma unroll 1
    for (int gi = 0; gi < 2; ++gi) {
        const int g = wave * 2 + gi;
        const float* bb = (const float*)(A.ws + WS_BBAR) + ((size_t)(l * 16 + g) * 64 + lane) * 32;
        float Br[16], Bi[16];
#pragma unroll
        for (int q = 0; q < 4; ++q) { const f32x4 x = ((const f32x4*)bb)[q], y = ((const f32x4*)bb)[4 + q];
            Br[4 * q] = x.x; Br[4 * q + 1] = x.y; Br[4 * q + 2] = x.z; Br[4 * q + 3] = x.w; Bi[4 * q] = y.x; Bi[4 * q + 1] = y.y; Bi[4 * q + 2] = y.z; Bi[4 * q + 3] = y.w; }
        const f32x4 lk = ((const f32x4*)(A.ws + WS_SSMK))[(l * 16 + g) * 64 + lane]; const float lr = lk.x, li = lk.y, Lr = lk.z, Li = lk.w;
        bf16x8 Cb[4];
#pragma unroll
        for (int kk = 0; kk < 4; ++kk) { const size_t co = ((size_t)(l * 16 + g) * 16 + fr) * 64 + kk * 16 + quad * 4;
            const f32x4 cr = *(const f32x4*)(A.in[I_CRE] + co), ci = *(const f32x4*)(A.in[I_CIM] + co);
            u32x4 pk; pk.x = pk2(cr.x, -ci.x); pk.y = pk2(cr.y, -ci.y); pk.z = pk2(cr.z, -ci.z); pk.w = pk2(cr.w, -ci.w);
            Cb[kk] = __builtin_bit_cast(bf16x8, pk); }
        const bf16_t* up = PROJ + (size_t)(tok0 + lane) * NPROJ + PC_SSM + g * 16;
        const u32x4 ua = *(const u32x4*)up, ub = *(const u32x4*)(up + 8);
        float hr = 0.f, hi = 0.f, uu[16];
        if (!samp && c > 0) { const f32x2* E = (const f32x2*)(A.ws + WS_SSME) + ((size_t)(b * 32) * 16 + g) * 64 + lane;
#pragma unroll
            for (int cb = 0; cb < 32; cb += 16) { f32x2 ev[16];
#pragma unroll
                for (int q = 0; q < 16; ++q) { const int cc = cb + q; ev[q] = (cc < c) ? E[(size_t)cc * 1024] : (f32x2){0.f, 0.f}; }
#pragma unroll
                for (int q = 0; q < 16; ++q) { const int cc = cb + q; if (cc < c) { const float nr = Lr * hr - Li * hi + ev[q].x, ni = Lr * hi + Li * hr + ev[q].y; hr = nr; hi = ni; } } } }
        const float dsk = A.in[I_SSMD][l * 256 + g * 16 + fr];
        unsigned uvr[16];
#pragma unroll
        for (int e = 0; e < 16; ++e) uvr[e] = PROJ[(size_t)(tok0 + (e >> 2) * 16 + quad * 4 + (e & 3)) * NPROJ + PC_SSM + g * 16 + fr];
#pragma unroll
        for (int sub = 0; sub < 4; ++sub) {
#pragma unroll 1
            for (int tt = 0; tt < 16; ++tt) { const int t = sub * 16 + tt;
                const int sb = (it - 256) * 16 + (t >> 2);
                if (samp && (t & 3) == 0) { hr = A.in[I_SRE][((size_t)(l * 128 + sb) * 16 + g) * 64 + lane]; hi = A.in[I_SIM][((size_t)(l * 128 + sb) * 16 + g) * 64 + lane]; }
                SSM_BCAST_U(t); SSM_STEP();
                *(LAS unsigned*)(HS + tt * 272 + lane * 4) = pg8::cvt_pk_bf16(hr, hi);
                if (samp && (t & 3) == 3) { A.out[O_RES + ((size_t)(l * 128 + sb) * 16 + g) * 64 + lane] = hr; A.out[O_IMS + ((size_t)(l * 128 + sb) * 16 + g) * 64 + lane] = hi; }
            }
            LDS_FENCE();
            f32x4 acc = {0.f, 0.f, 0.f, 0.f};
#pragma unroll
            for (int kk = 0; kk < 4; ++kk) { const bf16x8 a = *(LAS bf16x8*)(HS + fr * 272 + (kk * 32 + quad * 8) * 2); acc = mfma16(a, Cb[kk], acc); }
#pragma unroll
            for (int i = 0; i < 4; ++i) { const int t = sub * 16 + quad * 4 + i; const float uv = bf2f(uvr[sub * 4 + i]);
                *(LAS bf16_t*)(YS + t * 528 + (g * 16 + fr) * 2) = (bf16_t)f2bf(gelu_tanh_f(acc[i] + dsk * uv)); }
            LDS_FENCE();
        }
        if (!samp && c == 31) { A.out[O_REP + ((size_t)(l * 8 + b) * 16 + g) * 64 + lane] = hr; A.out[O_IMP + ((size_t)(l * 8 + b) * 16 + g) * 64 + lane] = hi; }
    }
    __syncthreads();
    {
        const bf16_t* GT = (const bf16_t*)(A.ws + WS_GLUT + l * SZ_GLUT);
        f32x4 acc[4][2];
#pragma unroll
        for (int mt = 0; mt < 4; ++mt) { acc[mt][0] = (f32x4){0.f, 0.f, 0.f, 0.f}; acc[mt][1] = (f32x4){0.f, 0.f, 0.f, 0.f}; }
#pragma unroll
        for (int kk = 0; kk < 8; ++kk) { bf16x8 bfr[2];
#pragma unroll
            for (int nt = 0; nt < 2; ++nt) bfr[nt] = *(const bf16x8*)(GT + (size_t)(32 * wave + nt * 16 + fr) * 256 + kk * 32 + quad * 8);
#pragma unroll
            for (int mt = 0; mt < 4; ++mt) { const bf16x8 a = *(LAS bf16x8*)(YS + (mt * 16 + fr) * 528 + (kk * 32 + quad * 8) * 2);
                acc[mt][0] = mfma16(a, bfr[0], acc[mt][0]); acc[mt][1] = mfma16(a, bfr[1], acc[mt][1]); } }
#pragma unroll
        for (int nt = 0; nt < 2; ++nt) { const int ncol = 32 * wave + nt * 16 + fr; const float gb = A.in[I_GLUB][l * 256 + ncol];
#pragma unroll
            for (int mt = 0; mt < 4; ++mt)
#pragma unroll
                for (int i = 0; i < 4; ++i) { const int t = mt * 16 + quad * 4 + i; const float y = bf2f(*(LAS bf16_t*)(YS + t * 528 + ncol * 2));
                    MIX[(size_t)(tok0 + t) * D + 512 + ncol] = (bf16_t)f2bf(y * sigmoid_f(acc[mt][nt][i] + gb)); } }
    }
    __syncthreads();
}

__device__ __forceinline__ void pool_item(const DevArgs& A, int l, LAS unsigned char* lds, int it, int tid, int wave, int lane) {
    asm volatile("" : "+v"(tid)); lane = tid & 63; wave = __builtin_amdgcn_readfirstlane(tid >> 6);
    const int tok0 = it * 64, fr = lane & 15, quad = lane >> 4; const bool samp = it >= 256;
    LAS unsigned char* RS = lds;
    const bf16_t* PROJ = (const bf16_t*)(A.ws + WS_PROJ); bf16_t* MIX = (bf16_t*)(A.ws + WS_MIX);
    if (!samp) {
        LAS unsigned char* XT = lds + 33792;
        const int b = it >> 5, c = it & 31;
        for (int id = tid; id < 79 * 32; id += 512) { const int r = id >> 5, c16 = id & 31, tl = c * 64 - 15 + r;
            u32x4 v = {0u, 0u, 0u, 0u}; if (tl >= 0) v = *(const u32x4*)(PROJ + (size_t)(b * SEQ + tl) * NPROJ + PC_POOL + c16 * 8);
            *(LAS u32x4*)(XT + r * 528 + c16 * 16) = v; }
        __syncthreads();
        const int ch = tid & 255, half = tid >> 8, g = ch >> 6, w = 2 << g, r0 = half * 32;
        float sum = 0.f;
        for (int j = 0; j < w; ++j) sum += bf2f(*(LAS bf16_t*)(XT + (r0 + 15 - j) * 528 + ch * 2));
#pragma unroll 4
        for (int rr = 0; rr < 32; ++rr) { const int r = r0 + rr, tl = c * 64 + r;
            const float u = bf2f(*(LAS bf16_t*)(XT + (r + 15) * 528 + ch * 2));
            if (rr > 0) sum += u - bf2f(*(LAS bf16_t*)(XT + (r + 15 - w) * 528 + ch * 2));
            const float rc = __builtin_amdgcn_rcpf((float)((tl + 1 < w) ? tl + 1 : w));
            *(LAS bf16_t*)(RS + r * 528 + ch * 2) = (bf16_t)f2bf(sum * rc - u); }
    } else {
#pragma unroll 1
        for (int pr = 0; pr < 8; ++pr) { const int idx = pr * 512 + tid, ch = idx & 255, sq = idx >> 8, g = ch >> 6, w = 2 << g;
            const int sb = (it - 256) * 16 + sq;
            const float* sbuf = A.in[I_SPOOL] + (size_t)(l * 128 + sb) * 15 * 256 + ch;
            const bf16_t* base = PROJ + (size_t)(NP + sb * 4) * NPROJ + PC_POOL + ch;
            float e[19];
#pragma unroll
            for (int j = 0; j < 15; ++j) e[j] = sbuf[j * 256];
#pragma unroll
            for (int j = 0; j < 4; ++j) e[15 + j] = bf2f(base[(size_t)j * NPROJ]);
#pragma unroll
            for (int t = 0; t < 4; ++t) { float sum = 0.f;
#pragma unroll
                for (int j = 0; j < 16; ++j) sum += (j < w) ? e[15 + t - j] : 0.f;
                *(LAS bf16_t*)(RS + (sq * 4 + t) * 528 + ch * 2) = (bf16_t)f2bf(sum * __builtin_amdgcn_rcpf((float)w) - e[15 + t]); } }
    }
    __syncthreads();
    { const int g2 = wave >> 1; const bf16_t* PT = (const bf16_t*)(A.ws + WS_POOLT + l * SZ_POOLT) + g2 * 4096;
      f32x4 acc[4][2];
#pragma unroll
      for (int mt = 0; mt < 4; ++mt) { acc[mt][0] = (f32x4){0.f, 0.f, 0.f, 0.f}; acc[mt][1] = (f32x4){0.f, 0.f, 0.f, 0.f}; }
#pragma unroll
      for (int kk = 0; kk < 2; ++kk) { bf16x8 bfr[2];
#pragma unroll
          for (int nt = 0; nt < 2; ++nt) bfr[nt] = *(const bf16x8*)(PT + (size_t)((wave & 1) * 32 + nt * 16 + fr) * 64 + kk * 32 + quad * 8);
#pragma unroll
          for (int mt = 0; mt < 4; ++mt) { const bf16x8 a = *(LAS bf16x8*)(RS + (mt * 16 + fr) * 528 + (g2 * 64 + kk * 32 + quad * 8) * 2);
              acc[mt][0] = mfma16(a, bfr[0], acc[mt][0]); acc[mt][1] = mfma16(a, bfr[1], acc[mt][1]); } }
#pragma unroll
      for (int nt = 0; nt < 2; ++nt) { const int col = 32 * wave + nt * 16 + fr; const float ps = A.in[I_POOLS][l * 256 + col];
#pragma unroll
          for (int mt = 0; mt < 4; ++mt)
#pragma unroll
              for (int i = 0; i < 4; ++i) { const int t = mt * 16 + quad * 4 + i; MIX[(size_t)(tok0 + t) * D + 768 + col] = (bf16_t)f2bf(acc[mt][nt][i] * ps); } } }
    __syncthreads();
}

__device__ __forceinline__ void state_copies(const DevArgs& A, int l, int gt, int NT) {
    const bf16_t* PROJ = (const bf16_t*)(A.ws + WS_PROJ);
#pragma unroll 1
    for (int i = gt; i < 8 * 3 * 1536; i += NT) { const int col = i % 1536, j = (i / 1536) % 3, b = i / 4608;
        A.out[O_CP + (size_t)l * 8 * 4608 + i] = bf2f(PROJ[(size_t)(b * SEQ + SEQ - 3 + j) * NPROJ + col]); }
#pragma unroll 1
    for (int i = gt; i < 128 * 3 * 1536; i += NT) { const int col = i % 1536, j = (i / 1536) % 3, b = i / 4608;
        A.out[O_CS + (size_t)l * 128 * 4608 + i] = bf2f(PROJ[(size_t)(NP + b * 4 + 1 + j) * NPROJ + col]); }
#pragma unroll 1
    for (int i = gt; i < 8 * 15 * 256; i += NT) { const int ch = i & 255, j = (i >> 8) % 15, b = i / 3840;
        A.out[O_PP + (size_t)l * 8 * 3840 + i] = bf2f(PROJ[(size_t)(b * SEQ + SEQ - 15 + j) * NPROJ + PC_POOL + ch]); }
#pragma unroll 1
    for (int i = gt; i < 128 * 15 * 256; i += NT) { const int ch = i & 255, j = (i >> 8) % 15, b = i / 3840;
        A.out[O_PS + (size_t)l * 128 * 3840 + i] = (j < 11) ? A.in[I_SPOOL][((size_t)(l * 128 + b) * 15 + 4 + j) * 256 + ch]
                                                             : bf2f(PROJ[(size_t)(NP + b * 4 + (j - 11)) * NPROJ + PC_POOL + ch]); }
}

#ifndef REP_DPREP
#define REP_DPREP 1
#endif
#ifndef REP_DSAMP
#define REP_DSAMP 1
#endif
#ifndef REP_SSM1
#define REP_SSM1 1
#endif
#ifndef REP_POOL
#define REP_POOL 1
#endif
#ifndef REP_DSCAN
#define REP_DSCAN 1
#endif
#ifndef REP_SSM2
#define REP_SSM2 1
#endif
#ifndef REP_G
#define REP_G 1
#endif
#ifndef REP_P3
#define REP_P3 1
#endif
#ifndef REP_P2
#define REP_P2 1
#endif
constexpr int NPH = 2 + DEPTH * 8;
__global__ void __launch_bounds__(512, 2) mega_fwd(Args KA) {
    DevArgs A; A.out = KA.out; A.ws = KA.ws; A.ph_lo = KA.ph_lo; A.ph_hi = KA.ph_hi;
    extern __shared__ __attribute__((aligned(16))) unsigned char lds_raw[];
    LAS unsigned char* lds = (LAS unsigned char*)lds_raw;
    cg::grid_group grid = cg::this_grid();
    volatile LAS unsigned* xst = (volatile LAS unsigned*)(lds + LDS_BYTES - 64);
    if (threadIdx.x == 0) { xst[0] = 0u; xst[1] = 0u; }
    __syncthreads();
    const XcdBarrier xb = xcd_barrier_post((unsigned*)(KA.ws + WS_BAR), xst);
    if (KA.ph_lo < 0) grid.sync();
    constexpr int G = 256, NGW = G * 8, NT = G * 512;
    int ph = 0;
#define PH_BEGIN if (A.ph_lo <= ph && ph < A.ph_hi) { int tid = threadIdx.x; asm volatile("" : "+v"(tid)); { unsigned char* _w = A.ws; asm volatile("" : "+s"(_w)); A.ws = _w; float* _o = A.out; asm volatile("" : "+s"(_o)); A.out = _o; } const int wave = __builtin_amdgcn_readfirstlane(tid >> 6), lane = tid & 63, gw = blockIdx.x * 8 + wave, gt = blockIdx.x * 512 + tid; (void)gw; (void)gt; (void)lane;
#define PH_END   if (ph + 1 < A.ph_hi) xcd_barrier(xb); } ++ph;
#define Hb   ((bf16_t*)(A.ws + WS_H))
#define AB   ((float*)(A.ws + WS_AB))
#define MIXO ((float*)(A.ws + WS_MIXO))
#define PROJ ((bf16_t*)(A.ws + WS_PROJ))
#define MIX  ((bf16_t*)(A.ws + WS_MIX))
#define HID  ((bf16_t*)(A.ws + WS_HID))
#define RSCBUF ((float*)(A.ws + WS_RSC))
#define XBUF ((bf16_t*)(A.ws + WS_MIXO + (size_t)NTOK * D * 2))

#ifndef REP_PRO
#define REP_PRO 1
#endif
#ifndef REP_N0
#define REP_N0 1
#endif
    PH_BEGIN for (int rep = 0; rep < REP_PRO; ++rep) { prologue(A, lds, wave, lane, gw, NGW); __syncthreads(); } PH_END
    PH_BEGIN for (int rep = 0; rep < REP_N0; ++rep) norm_rows(nullptr, nullptr, A.in[I_XP], A.in[I_XS], nullptr, A.in[I_NMPRE], RSCBUF, (const float*)(A.ws + WS_WAB), AB, gw, NGW, lane, nullptr, 0, nullptr, XBUF); PH_END

#pragma unroll 1
    for (int l = 0; l < DEPTH; ++l) {
        PH_BEGIN for (int rep = 0; rep < REP_G; ++rep) { pg8::Gemm g{XBUF, (const bf16_t*)(A.ws + WS_WIN + l * SZ_WIN), NTOK, NPROJ, D, D, D}; pg8::StaticOrder S; S.init(NTOK, NPROJ, G, (int)blockIdx.x);
            EpiBf16Scale E{PROJ, NPROJ, RSCBUF}; pg8::gemm_phase<EpiBf16Scale, pg8::StaticOrder>(lds, g, S, E, nullptr); } PH_END
        constexpr int SUBC = 7;
        PH_BEGIN {
#pragma unroll 1
          for (int rep2 = 0; rep2 < REP_P2; ++rep2) {
#pragma unroll 1
            for (int j = blockIdx.x; j < 32 * SUBC; j += G) delta_prep_item(A, l, lds, (j & 31) * 32 + (j >> 5), tid, wave, lane);
            if (blockIdx.x >= 32 * SUBC) {
#pragma unroll 1
                for (int it = (blockIdx.x - 32 * SUBC) * 8 + wave; it < 768; it += (G - 32 * SUBC) * 8) { int t1 = threadIdx.x; asm volatile("" : "+v"(t1)); ssm_part1_item(A, l, it, t1 & 63); } }
          }
        } PH_END
        PH_BEGIN {
#pragma unroll 1
            for (int rep3 = 0; rep3 < REP_P3; ++rep3) {
                if (blockIdx.x < 32) delta_scan_item(A, l, lds, blockIdx.x, tid, wave, lane, xb, SUBC);
                else { const int w = blockIdx.x - 32; constexpr int NW = G - 32;
#pragma unroll 1
                    for (int k = 1; k <= 5; ++k) {
                        const int n0 = k * SUBC, nn = (n0 >= 32) ? 0 : ((32 - n0 < SUBC) ? 32 - n0 : SUBC);
                        int nprep = 32 * nn;
#ifndef REP_WPREP
#define REP_WPREP 1
#endif
#pragma unroll 1
                        for (int rep = 0; rep < REP_WPREP; ++rep)
#pragma unroll 1
                        for (int j = w; j < nprep; j += NW) delta_prep_item(A, l, lds, (j & 31) * 32 + n0 + (j >> 5), tid, wave, lane);
                        if (k == 1) {
#pragma unroll 1
                            for (int it = w; it < 512; it += NW) delta_sample_item(A, l, lds, it, tid, wave, lane); }
                        if (k == 2) {
#pragma unroll 1
                            for (int it = 768 + w * 8 + wave; it < 8 * 31 * 16; it += NW * 8) { int t1 = threadIdx.x; asm volatile("" : "+v"(t1)); ssm_part1_item(A, l, it, t1 & 63); }
                            { int t2 = threadIdx.x; asm volatile("" : "+v"(t2)); int wl = blockIdx.x; asm volatile("" : "+s"(wl)); state_copies(A, l, (wl - 32) * 512 + t2, NW * 512); } }
                        if (k == 3) {
#pragma unroll 1
                            for (int it = w; it < 264; it += NW) pool_item(A, l, lds, it, tid, wave, lane); }
                        { const int it = (k == 4) ? w - 128 : ((k == 5) ? 96 + w : -1);
                          if (it >= 0 && it < ((k == 4) ? 96 : 264)) ssm_part2_item(A, l, lds, it, tid, wave, lane); }
                        if (k < 5) xcd_barrier(xb);
                    } }
            }
        } PH_END
        PH_BEGIN for (int rep = 0; rep < REP_G; ++rep) { pg8::Gemm g{MIX, (const bf16_t*)(A.ws + WS_WOUT + l * SZ_WOUT), NP, D, D, D, D}; pg8::StaticOrder S; S.init(NP, D, G, (int)blockIdx.x);
            pg8::EpiBf16<0> E{(bf16_t*)MIXO, D, nullptr, 0, 0}; pg8::gemm_phase<pg8::EpiBf16<0>, pg8::StaticOrder>(lds, g, S, E, nullptr);
            pg8::Gemm g2{MIX + (size_t)NP * D, (const bf16_t*)(A.ws + WS_WOUT + l * SZ_WOUT), NS, D, 256, D, D}; SliceOrder S2{8 * (D / 256), G, (int)blockIdx.x};
            EpiF32Part E2{(float*)(A.ws + WS_PARTS)}; pg8::gemm_phase<EpiF32Part, SliceOrder>(lds, g2, S2, E2, nullptr); } PH_END
#ifndef REP_N5
#define REP_N5 1
#endif
        PH_BEGIN norm_rows_pf(MIXO, A.in[I_NMPOST] + l * D, XBUF, RSCBUF, gw, NGW, lane, (const float*)(A.ws + WS_PARTS), D / 256); PH_END
        PH_BEGIN for (int rep = 0; rep < REP_G; ++rep) { pg8::Gemm g{XBUF, (const bf16_t*)(A.ws + WS_WGU + l * SZ_WGU), NTOK, NGU, D, D, D}; pg8::StaticOrder S; S.init(NTOK, NGU, G, (int)blockIdx.x);
            EpiSwiGLU E{HID, DFF, RSCBUF}; pg8::gemm_phase<EpiSwiGLU, pg8::StaticOrder>(lds, g, S, E, nullptr); } PH_END
        PH_BEGIN for (int rep = 0; rep < REP_G; ++rep) { pg8::Gemm g{HID, (const bf16_t*)(A.ws + WS_WDN + l * SZ_WDN), NP, D, DFF, DFF, DFF}; pg8::StaticOrder S; S.init(NP, D, G, (int)blockIdx.x);
            pg8::EpiBf16<0> E{(bf16_t*)MIXO, D, nullptr, 0, 0}; pg8::gemm_phase<pg8::EpiBf16<0>, pg8::StaticOrder>(lds, g, S, E, nullptr);
            pg8::Gemm g2{HID + (size_t)NP * DFF, (const bf16_t*)(A.ws + WS_WDN + l * SZ_WDN), NS, D, 256, DFF, DFF}; SliceOrder S2{8 * (DFF / 256), G, (int)blockIdx.x};
            EpiF32Part E2{(float*)(A.ws + WS_PARTS)}; pg8::gemm_phase<EpiF32Part, SliceOrder>(lds, g2, S2, E2, nullptr); } PH_END
        PH_BEGIN norm_rows(MIXO, A.in[I_NFPOST] + l * D, nullptr, nullptr, l + 1 < DEPTH ? nullptr : A.out, l + 1 < DEPTH ? A.in[I_NMPRE] + (l + 1) * D : nullptr, l + 1 < DEPTH ? RSCBUF : nullptr,
                           l + 1 < DEPTH ? (const float*)(A.ws + WS_WAB + (l + 1) * SZ_WAB) : nullptr, AB, gw, NGW, lane, (const float*)(A.ws + WS_PARTS), DFF / 256,
                           XBUF, l + 1 < DEPTH ? XBUF : nullptr); PH_END
    }
#undef PH_BEGIN
#undef PH_END
#undef Hb
#undef AB
#undef MIXO
#undef PROJ
#undef MIX
#undef HID
#undef XBUF
#undef RSCBUF
}

extern "C" void kernel_launch(void* const* d_in, const int* in_sizes, int n_in, void* d_out, int out_size, void* d_ws, size_t ws_size, hipStream_t stream) {
    static int grid = 0;
    if (grid == 0) {
        if (n_in != 32 || (size_t)out_size != O_END || ws_size < WS_END) fprintf(stderr, "kernel_launch: unexpected sizes: n_in %d out %d (want %zu) ws %zu (want >= %zu)\n", n_in, out_size, (size_t)O_END, ws_size, (size_t)WS_END);
        int dev = 0, cus = 0, per_cu = 0;
        (void)hipGetDevice(&dev); (void)hipDeviceGetAttribute(&cus, hipDeviceAttributeMultiprocessorCount, dev);
        if (hipFuncSetAttribute((const void*)mega_fwd, hipFuncAttributeMaxDynamicSharedMemorySize, LDS_BYTES) != hipSuccess) fprintf(stderr, "kernel_launch: hipFuncSetAttribute failed\n");
        if (hipOccupancyMaxActiveBlocksPerMultiprocessor(&per_cu, (const void*)mega_fwd, 512, LDS_BYTES) != hipSuccess || per_cu < 1) { fprintf(stderr, "kernel_launch: occupancy query gave %d\n", per_cu); per_cu = 1; (void)hipGetLastError(); }
        grid = cus * per_cu; if (grid <= 0) grid = 256;
        if (grid >= 256) grid = 256;
        fprintf(stderr, "kernel_launch: grid %d (cus %d x %d)%s\n", grid, cus, per_cu, grid < 256 ? "  ERROR: this build needs >= 256 co-resident workgroups" : "");
    }
    (void)hipMemsetAsync((unsigned char*)d_ws + WS_BAR, 0, 16384, stream);
    Args a{};
    for (int i = 0; i < 32; ++i) a.in[i] = (const float*)d_in[i];
    a.out = (float*)d_out; a.ws = (unsigned char*)d_ws;
#if MK_COOP
    a.ph_lo = 0; a.ph_hi = NPH;
    void* args[] = {&a};
    const hipError_t e = hipLaunchCooperativeKernel((const void*)mega_fwd, dim3(grid), dim3(512), args, LDS_BYTES, stream);
    if (e != hipSuccess) fprintf(stderr, "kernel_launch: cooperative launch failed: %s (grid %d)\n", hipGetErrorString(e), grid);
#else
    for (int p = 0; p < NPH; ++p) { a.ph_lo = p; a.ph_hi = p + 1; hipLaunchKernelGGL(mega_fwd, dim3(grid), dim3(512), LDS_BYTES, stream, a); }
#endif
}
```

```cpp
#include <hip/hip_runtime.h>
#include <hip/hip_cooperative_groups.h>
#include <cstdio>
#include <cstdint>
namespace cg = cooperative_groups;
#ifndef MK_COOP
#define MK_COOP 1
#endif
namespace pg8 {
#define PG8_LAS __attribute__((address_space(3)))
typedef unsigned short bf16_t;
typedef short bf16x8 __attribute__((ext_vector_type(8)));
typedef float f32x4 __attribute__((ext_vector_type(4)));
typedef unsigned u32x4 __attribute__((ext_vector_type(4)));
constexpr int BM = 256, BK = 64, HALF = 128, HTB = HALF * BK * 2  , STAGE_BYTES = 8 * HTB, NXCD = 8, WGM = 8;

__host__ __device__ __forceinline__ int lds_byte(int r, int c) { const int st = (r >> 4) * 2 + (c >> 5), rr = r & 15, cc = c & 31, ob = rr * 64 + cc * 2; return st * 1024 + (ob ^ (((ob >> 9) & 1) << 5)); }
__host__ __device__ __forceinline__ void stage_rc(int b, int& R, int& C) { const int st = b / 1024, sb = b % 1024, swz = sb ^ (((sb >> 9) & 1) << 5); R = (st >> 1) * 16 + swz / 64; C = (st & 1) * 32 + (swz % 64) / 2; }
__host__ __device__ __forceinline__ int perm32(int rho) { const int n = rho >> 4, i = rho & 15; return 8 * (i >> 2) + 4 * n + (i & 3); }

struct Unit { int pm, pn, ks; };
struct Gemm { const bf16_t* A; const bf16_t* Bt; int M, N, K, lda, ldb; };

struct StaticOrder {
    int nM, nN, nwg, G, c;
    __host__ __device__ void init(int M, int N, int G_, int c_) { nM = M / BM; nN = N / BM; nwg = nM * nN; G = G_; c = c_; }
    __host__ __device__ bool next(int i, Unit& u) const {
        const long L = (long)i * G + c; if (L >= nwg) return false;
        int wgid = (int)L; { const int q = nwg / NXCD, r = nwg % NXCD, xcd = wgid % NXCD, off = wgid / NXCD; wgid = (xcd < r ? xcd * (q + 1) : r * (q + 1) + (xcd - r) * q) + off; }
        const int nig = WGM * nN, gid = wgid / nig, fm = gid * WGM, gsz = (nM - fm) < WGM ? (nM - fm) : WGM;
        u.pm = fm + ((wgid % nig) % gsz); u.pn = (wgid % nig) / gsz; u.ks = 0; return true;
    }
    __device__ __forceinline__ void a_ready(const Unit&) const {}
    __device__ __forceinline__ void done(const Unit&) const {}
};
__device__ __forceinline__ unsigned cvt_pk_bf16(float lo, float hi) { unsigned r; asm volatile("v_cvt_pk_bf16_f32 %0, %1, %2" : "=v"(r) : "v"(lo), "v"(hi)); return r; }
typedef float f32x2 __attribute__((ext_vector_type(2)));
__device__ __forceinline__ f32x2 gelu_pk(f32x2 v) {
    const f32x2 av = __builtin_elementwise_abs(v), d = av * 0.2316418882f + 1.0f;
    f32x2 t; t.x = __builtin_amdgcn_rcpf(d.x); t.y = __builtin_amdgcn_rcpf(d.y);
    f32x2 q = t * 0.5307027145f + (-0.7265760135f); q = q * t + 0.7107068705f; q = q * t + (-0.142248368f); q = q * t + 0.127414796f; q = q * t;
    const f32x2 s = (v * v) * (-0.72134752044f);
    f32x2 e; e.x = __builtin_amdgcn_exp2f(s.x); e.y = __builtin_amdgcn_exp2f(s.y);
    const f32x2 m = v * (q * e), r = v - m;
    f32x2 o; o.x = v.x < 0.f ? m.x : r.x; o.y = v.y < 0.f ? m.y : r.y; return o;
}

struct EpiF32 {
    static constexpr bool PERM = false, AFTER_DRAIN = false;
    float* C; int ldc; const float* bias;
    __device__ __forceinline__ void operator()(const f32x4 (&acc)[2][2][4][2], const Unit& u, int wr, int wc, int fr, int fq) const {
        const int row0 = u.pm * BM + wr * 64 + fr, col0 = u.pn * BM + wc * 32 + 4 * fq;
        f32x4 bv[2][2];
#pragma unroll
        for (int bj = 0; bj < 2; ++bj)
#pragma unroll
            for (int n = 0; n < 2; ++n) bv[bj][n] = bias ? *(const f32x4*)(bias + col0 + bj * HALF + n * 16) : (f32x4){0.f, 0.f, 0.f, 0.f};
#pragma unroll
        for (int ai = 0; ai < 2; ++ai)
#pragma unroll
            for (int m = 0; m < 4; ++m) { float* rowp = C + (size_t)(row0 + ai * HALF + m * 16) * ldc + col0;
#pragma unroll
                for (int bj = 0; bj < 2; ++bj)
#pragma unroll
                    for (int n = 0; n < 2; ++n) *(f32x4*)(rowp + bj * HALF + n * 16) = acc[ai][bj][m][n] + bv[bj][n]; }
    }
};
template <int ACT  > struct EpiBf16 {
    static constexpr bool PERM = true, AFTER_DRAIN = false;
    bf16_t* O; int ldc; const float* bias; int split_cols; size_t split_stride;
    __device__ __forceinline__ void operator()(const f32x4 (&acc)[2][2][4][2], const Unit& u, int wr, int wc, int fr, int fq) const {
        const int row0 = u.pm * BM + wr * 64 + fr; int colt = u.pn * BM; bf16_t* base = O;
        if (split_cols) { const int t = colt / split_cols; base += (size_t)t * split_stride; colt -= t * split_cols; }
        const int col0 = colt + wc * 32 + 8 * fq, bcol0 = u.pn * BM + wc * 32 + 8 * fq;
        f32x4 bv[2][2];
#pragma unroll
        for (int bj = 0; bj < 2; ++bj)
#pragma unroll
            for (int n = 0; n < 2; ++n) bv[bj][n] = bias ? *(const f32x4*)(bias + bcol0 + bj * HALF + 4 * n) : (f32x4){0.f, 0.f, 0.f, 0.f};
#pragma unroll
        for (int ai = 0; ai < 2; ++ai)
#pragma unroll
            for (int m = 0; m < 4; ++m) { bf16_t* rowp = base + (size_t)(row0 + ai * HALF + m * 16) * ldc + col0;
#pragma unroll
                for (int bj = 0; bj < 2; ++bj) { f32x4 v0 = acc[ai][bj][m][0] + bv[bj][0], v1 = acc[ai][bj][m][1] + bv[bj][1];
                    if (ACT == 1) { f32x2 a = gelu_pk((f32x2){v0[0], v0[1]}), b = gelu_pk((f32x2){v0[2], v0[3]}), c = gelu_pk((f32x2){v1[0], v1[1]}), d = gelu_pk((f32x2){v1[2], v1[3]});
                        v0 = (f32x4){a.x, a.y, b.x, b.y}; v1 = (f32x4){c.x, c.y, d.x, d.y}; }
                    if (ACT == 2) {
#pragma unroll
                        for (int j = 0; j < 4; ++j) { v0[j] = 0.5f * v0[j] * (1.0f + erff(v0[j] * 0.70710678f)); v1[j] = 0.5f * v1[j] * (1.0f + erff(v1[j] * 0.70710678f)); } }
                    u32x4 w; w.x = cvt_pk_bf16(v0[0], v0[1]); w.y = cvt_pk_bf16(v0[2], v0[3]); w.z = cvt_pk_bf16(v1[0], v1[1]); w.w = cvt_pk_bf16(v1[2], v1[3]);
                    *(u32x4*)(rowp + bj * HALF) = w; } }
    }
};
template <class Epi, class Sched, bool STAMP = false>
__device__ __forceinline__ void gemm_phase(PG8_LAS unsigned char* lds, const Gemm g, const Sched& S, const Epi& E, unsigned long long* stamps) {
    int tid_ = threadIdx.x; asm volatile("" : "+v"(tid_));
    const int tid = tid_, wid = __builtin_amdgcn_readfirstlane(tid >> 6), lane = tid & 63, wr = wid >> 2, wc = wid & 3, fr = lane & 15, fq = lane >> 4;
    const int K = g.K, nt = K / BK;
    int ts_lo = 0, ts_hi = 0, nts = 0; const unsigned long long rt_entry = STAMP ? (unsigned long long)wall_clock64() : 0ull;
#define PG8_STAMP() do { if (STAMP && wid == 0 && nts < 64) { const unsigned long long _c = (unsigned long long)clock64(); \
        ts_lo = (lane == nts) ? (int)(unsigned)_c : ts_lo; ts_hi = (lane == nts) ? (int)(unsigned)(_c >> 32) : ts_hi; ++nts; } } while (0)
    PG8_STAMP();
    unsigned voffA[2], voffB[2];
#pragma unroll
    for (int i = 0; i < 2; ++i) { int R, C; stage_rc(tid * 16 + i * 8192, R, C); const int Rb = Epi::PERM ? ((R & ~31) + perm32(R & 31)) : R;
        voffA[i] = (unsigned)(R * g.lda + C) * 2u; voffB[i] = (unsigned)(Rb * g.ldb + C) * 2u; }
    const size_t kstep = (size_t)(BK * 2);
    const size_t hstepA = (size_t)HALF * g.lda * 2, hstepB = (size_t)HALF * g.ldb * 2;
    const size_t tstepA = 2 * hstepA, tstepB = 2 * hstepB, sstep = (size_t)K * 2;
    const unsigned ldsw = (unsigned)wid * 1024u;
    const int aoff = lds_byte(wr * 64 + fr, fq * 8), boff = lds_byte(wc * 32 + fr, fq * 8);
#define PG8_SA(b, h) (((b) * 2 + (h)) * HTB)
#define PG8_SB(b, h) ((4 + (b) * 2 + (h)) * HTB)
#define PG8_STAGE(bufoff, gbase, voff) do { _Pragma("unroll") for (int _i = 0; _i < 2; ++_i) \
        __builtin_amdgcn_global_load_lds((const unsigned*)((const char*)(gbase) + (voff)[_i]), (PG8_LAS unsigned*)(lds + (bufoff) + ldsw + _i * 8192), 16, 0, 0); } while (0)
#define PG8_LDA(dst, b, h) do { _Pragma("unroll") for (int m = 0; m < 4; ++m) _Pragma("unroll") for (int k = 0; k < 2; ++k) dst[m][k] = *(const PG8_LAS bf16x8*)(lds + PG8_SA(b, h) + aoff + m * 2048 + k * 1024); } while (0)
#define PG8_LDB(dst, b, h) do { _Pragma("unroll") for (int n = 0; n < 2; ++n) _Pragma("unroll") for (int k = 0; k < 2; ++k) dst[n][k] = *(const PG8_LAS bf16x8*)(lds + PG8_SB(b, h) + boff + n * 2048 + k * 1024); } while (0)
#define PG8_MMA(ai, bj, At, Bt) do { __builtin_amdgcn_s_setprio(1); _Pragma("unroll") for (int m = 0; m < 4; ++m) _Pragma("unroll") for (int n = 0; n < 2; ++n) _Pragma("unroll") for (int k = 0; k < 2; ++k) \
        acc[ai][bj][m][n] = __builtin_amdgcn_mfma_f32_16x16x32_bf16(Bt[n][k], At[m][k], acc[ai][bj][m][n], 0, 0, 0); __builtin_amdgcn_s_setprio(0); } while (0)
#define PG8_WAIT_V(n) asm volatile("s_waitcnt vmcnt(" #n ")" ::: "memory")
#define PG8_WAIT_L(n) asm volatile("s_waitcnt lgkmcnt(" #n ")" ::: "memory")
#define PG8_BAR __builtin_amdgcn_s_barrier()
#define PG8_SCHED __builtin_amdgcn_sched_barrier(0)
    Unit cur, nxt; int ui = 0;
    if (!S.next(0, cur)) return;
    f32x4 acc[2][2][4][2];
#pragma unroll
    for (int a = 0; a < 2; ++a)
#pragma unroll
        for (int b = 0; b < 2; ++b)
#pragma unroll
            for (int m = 0; m < 4; ++m)
#pragma unroll
                for (int n = 0; n < 2; ++n) acc[a][b][m][n] = (f32x4){0.f, 0.f, 0.f, 0.f};
    bf16x8 At[4][2], B0[2][2], B1[2][2];
    const char* cA = (const char*)g.A + (size_t)cur.pm * tstepA + (size_t)cur.ks * sstep; const char* cB = (const char*)g.Bt + (size_t)cur.pn * tstepB + (size_t)cur.ks * sstep;
    S.a_ready(cur);
    PG8_STAGE(PG8_SB(0, 0), cB, voffB); PG8_STAGE(PG8_SA(0, 0), cA, voffA); PG8_STAGE(PG8_SB(0, 1), cB + hstepB, voffB); PG8_STAGE(PG8_SA(0, 1), cA + hstepA, voffA);
    if (wr == 1) PG8_BAR;
    PG8_WAIT_V(4); PG8_BAR;
    PG8_STAGE(PG8_SB(1, 0), cB + kstep, voffB); PG8_STAGE(PG8_SA(1, 0), cA + kstep, voffA); PG8_STAGE(PG8_SB(1, 1), cB + hstepB + kstep, voffB);
    PG8_WAIT_V(6); PG8_BAR;
    PG8_STAMP();
    for (;;) {
        const bool has_next = S.next(ui + 1, nxt);
        const char* nA = has_next ? (const char*)g.A + (size_t)nxt.pm * tstepA + (size_t)nxt.ks * sstep : cA; const char* nB = has_next ? (const char*)g.Bt + (size_t)nxt.pn * tstepB + (size_t)nxt.ks * sstep : cB;
        for (int t = 0; t < nt; t += 2) {
            const bool last = (t == nt - 2);
            const char* a1 = cA + (size_t)(t + 1) * kstep;
            const char* a2 = last ? nA : cA + (size_t)(t + 2) * kstep; const char* b2 = last ? nB : cB + (size_t)(t + 2) * kstep;
            const char* a3 = a2 + kstep; const char* b3 = b2 + kstep;
            if (last && has_next) S.a_ready(nxt);
            PG8_LDB(B0, 0, 0); PG8_SCHED; PG8_LDA(At, 0, 0); PG8_STAGE(PG8_SA(1, 1), a1 + hstepA, voffA);
            PG8_WAIT_L(8); PG8_BAR; PG8_WAIT_L(0); PG8_MMA(0, 0, At, B0); PG8_BAR; PG8_SCHED;
            PG8_LDB(B1, 0, 1); PG8_STAGE(PG8_SB(0, 0), b2, voffB);
            PG8_BAR; PG8_WAIT_L(0); PG8_MMA(0, 1, At, B1); PG8_BAR;
            PG8_LDA(At, 0, 1); PG8_STAGE(PG8_SA(0, 0), a2, voffA);
            PG8_BAR; PG8_WAIT_L(0); PG8_MMA(1, 0, At, B0); PG8_BAR; PG8_SCHED;
            PG8_STAGE(PG8_SB(0, 1), b2 + hstepB, voffB);
            PG8_WAIT_V(6); PG8_BAR; PG8_MMA(1, 1, At, B1); PG8_BAR;
            PG8_LDB(B0, 1, 0); PG8_SCHED; PG8_LDA(At, 1, 0); PG8_STAGE(PG8_SA(0, 1), a2 + hstepA, voffA);
            PG8_WAIT_L(8); PG8_BAR; PG8_WAIT_L(0); PG8_MMA(0, 0, At, B0); PG8_BAR; PG8_SCHED;
            PG8_LDB(B1, 1, 1); PG8_STAGE(PG8_SB(1, 0), b3, voffB);
            PG8_BAR; PG8_WAIT_L(0); PG8_MMA(0, 1, At, B1); PG8_BAR;
            PG8_LDA(At, 1, 1); PG8_STAGE(PG8_SA(1, 0), a3, voffA);
            PG8_BAR; PG8_WAIT_L(0); PG8_MMA(1, 0, At, B0); PG8_BAR; PG8_SCHED;
            PG8_STAGE(PG8_SB(1, 1), b3 + hstepB, voffB);
            PG8_WAIT_V(6); PG8_BAR; PG8_MMA(1, 1, At, B1); PG8_BAR;
        }
        PG8_STAMP();
        if constexpr (!Epi::AFTER_DRAIN) { E(acc, cur, wr, wc, fr, fq); S.done(cur); }
        PG8_STAMP();
        if (!has_next) break;
#pragma unroll
        for (int a = 0; a < 2; ++a)
#pragma unroll
            for (int b = 0; b < 2; ++b)
#pragma unroll
                for (int m = 0; m < 4; ++m)
#pragma unroll
                    for (int n = 0; n < 2; ++n) acc[a][b][m][n] = (f32x4){0.f, 0.f, 0.f, 0.f};
        cur = nxt; cA = nA; cB = nB; ++ui;
    }
    PG8_WAIT_V(0);
    if (wr == 0) PG8_BAR;
    PG8_BAR;
    if constexpr (Epi::AFTER_DRAIN) { E.fused(acc, cur, wr, wc, fr, fq, lds, wid, lane); S.done(cur); }
    PG8_STAMP();
    if (STAMP && wid == 0) { stamps[lane] = lane < nts ? (((unsigned long long)(unsigned)ts_hi << 32) | (unsigned)ts_lo) : 0ull;
        if (lane == 62) stamps[62] = rt_entry; if (lane == 63) stamps[63] = (unsigned long long)wall_clock64(); }
#undef PG8_STAMP
#undef PG8_SA
#undef PG8_SB
#undef PG8_STAGE
#undef PG8_LDA
#undef PG8_LDB
#undef PG8_MMA
#undef PG8_WAIT_V
#undef PG8_WAIT_L
#undef PG8_BAR
#undef PG8_SCHED
}
}

#define LAS __attribute__((address_space(3)))
typedef unsigned short bf16_t;
typedef short bf16x8 __attribute__((ext_vector_type(8)));
typedef float f32x4 __attribute__((ext_vector_type(4)));
typedef float f32x2 __attribute__((ext_vector_type(2)));
typedef unsigned u32x4 __attribute__((ext_vector_type(4)));
typedef unsigned u32x2 __attribute__((ext_vector_type(2)));

constexpr int D = 1024, NP = 16384, NS = 512, NTOK = NP + NS, SEQ = 2048, NB = 8, NSB = 128, DEPTH = 4;
constexpr int INW = 2568, NPROJ = 2560, DFF = 2816, NGU = 5632;
constexpr int PC_G = 1536, PC_SSM = 2048, PC_POOL = 2304;
constexpr float EPS = 1e-6f;
constexpr int LDS_BYTES = 163840;

constexpr size_t SZ_WIN = (size_t)NPROJ * D * 2, SZ_WOUT = (size_t)D * D * 2, SZ_WGU = (size_t)NGU * D * 2, SZ_WDN = (size_t)D * DFF * 2;
constexpr size_t SZ_WAB = 8 * D * 4, SZ_GLUT = 256 * 256 * 2, SZ_POOLT = 4 * 64 * 64 * 2, SZ_SSMK = 16 * 64 * 4 * 4, SZ_BBAR = 16 * 64 * 32 * 4;
constexpr size_t WS_WIN = 0;
constexpr size_t WS_WOUT = WS_WIN + DEPTH * SZ_WIN;
constexpr size_t WS_WGU = WS_WOUT + DEPTH * SZ_WOUT;
constexpr size_t WS_WDN = WS_WGU + DEPTH * SZ_WGU;
constexpr size_t WS_WAB = WS_WDN + DEPTH * SZ_WDN;
constexpr size_t WS_GLUT = WS_WAB + DEPTH * SZ_WAB;
constexpr size_t WS_POOLT = WS_GLUT + DEPTH * SZ_GLUT;
constexpr size_t WS_SSMK = WS_POOLT + DEPTH * SZ_POOLT;
constexpr size_t WS_BBAR = WS_SSMK + DEPTH * SZ_SSMK;
constexpr size_t WS_H = WS_BBAR + DEPTH * SZ_BBAR;
constexpr size_t WS_AB = WS_H + (size_t)NTOK * D * 2;
constexpr size_t WS_MIX = WS_AB + (size_t)NTOK * 8 * 4;
constexpr size_t WS_MIXO = WS_MIX + (size_t)NTOK * D * 2;
constexpr size_t WS_SSME = WS_MIXO + (size_t)NTOK * D * 4;
constexpr size_t WS_PROJ = WS_SSME + (size_t)8 * 32 * 16 * 64 * 2 * 4;
constexpr size_t WS_DW = WS_PROJ + (size_t)NTOK * NPROJ * 2;
constexpr size_t WS_DKC = WS_DW + (size_t)1024 * 8192 * 4;
constexpr size_t WS_DQD = WS_DKC + (size_t)1024 * 8192 * 2;
constexpr size_t WS_DQK = WS_DQD + (size_t)1024 * 8192 * 2;
constexpr size_t WS_DKT = WS_DQK + (size_t)1024 * 4096 * 2;
constexpr size_t WS_DGL = WS_DKT + (size_t)1024 * 8192 * 2;
constexpr size_t WS_DGS = WS_DGL + 4096;
constexpr size_t WS_BAR = WS_DGS + (size_t)1024 * 8192 * 2;
constexpr size_t WS_PARTS = WS_BAR + 16384;
constexpr size_t WS_RSC = WS_PARTS + (size_t)11 * 512 * 1024 * 4;
constexpr size_t WS_END = WS_RSC + (size_t)NTOK * 4;
constexpr size_t WS_HID = WS_PROJ;
static_assert(WS_HID + (size_t)NTOK * DFF * 2 <= WS_END, "HID overlay");
static_assert(WS_H % 256 == 0 && WS_PROJ % 256 == 0 && WS_DW % 256 == 0, "align");

constexpr size_t O_YP = 0, O_YS = O_YP + (size_t)NP * D, O_DP = O_YS + (size_t)NS * D, O_CP = O_DP + (size_t)DEPTH * 8 * 4 * 16384,
                 O_REP = O_CP + (size_t)DEPTH * 8 * 3 * 1536, O_IMP = O_REP + (size_t)DEPTH * 8 * 1024, O_PP = O_IMP + (size_t)DEPTH * 8 * 1024,
                 O_DS = O_PP + (size_t)DEPTH * 8 * 15 * 256, O_CS = O_DS + (size_t)DEPTH * 128 * 4 * 16384, O_RES = O_CS + (size_t)DEPTH * 128 * 3 * 1536,
                 O_IMS = O_RES + (size_t)DEPTH * 128 * 1024, O_PS = O_IMS + (size_t)DEPTH * 128 * 1024, O_END = O_PS + (size_t)DEPTH * 128 * 15 * 256;

struct Args { const float* in[32]; float* out; unsigned char* ws; int ph_lo, ph_hi; };
typedef const float* cfp_t;
typedef __attribute__((address_space(4))) const unsigned char* kptr_t;
struct InProxy { __device__ __forceinline__ const float* operator[](int i) const {
    kptr_t p = (kptr_t)__builtin_amdgcn_kernarg_segment_ptr(); asm volatile("" : "+s"(p)); return *(__attribute__((address_space(4))) const cfp_t*)(p + 8 * i); } };
struct DevArgs { InProxy in; float* out; unsigned char* ws; int ph_lo, ph_hi; };
enum { I_XP = 0, I_XS, I_SDELTA, I_SCONV, I_SRE, I_SIM, I_SPOOL, I_NMPRE, I_NMPOST, I_NFPRE, I_NFPOST, I_WIN, I_CONVW, I_ALOG, I_DTB, I_ONORM,
       I_ARE, I_AIM, I_LOGDT, I_BRE, I_BIM, I_CRE, I_CIM, I_SSMD, I_GLUW, I_GLUB, I_POOLW, I_POOLS, I_WOUT, I_WG, I_WU, I_WD };

__device__ __forceinline__ unsigned f2bf(float f) { unsigned u = __float_as_uint(f); return (u + 0x7fffu + ((u >> 16) & 1u)) >> 16; }
__device__ __forceinline__ float bf2f(unsigned b) { return __uint_as_float(b << 16); }
__device__ __forceinline__ unsigned pk2(float lo, float hi) { return f2bf(lo) | (f2bf(hi) << 16); }
template <int CTRL> __device__ __forceinline__ float dpp_f(float v) { return __builtin_bit_cast(float, __builtin_amdgcn_update_dpp(0, __builtin_bit_cast(int, v), CTRL, 0xF, 0xF, true)); }
__device__ __forceinline__ float row_sum8(float v) { v += dpp_f<0xB1>(v); v += dpp_f<0x4E>(v); v += dpp_f<0x141>(v); return v; }
__device__ __forceinline__ float row_sum16(float v) { v = row_sum8(v); v += dpp_f<0x140>(v); return v; }
__device__ __forceinline__ float wave_sum(float v) { v = row_sum16(v); v += __shfl_xor(v, 16); v += __shfl_xor(v, 32); return v; }
__device__ __forceinline__ float silu_f(float y) { return y * __builtin_amdgcn_rcpf(1.f + __expf(-y)); }
__device__ __forceinline__ float sigmoid_f(float y) { return __builtin_amdgcn_rcpf(1.f + __expf(-y)); }
__device__ __forceinline__ float gelu_tanh_f(float x) { const float z = 0.7978845608028654f * (x + 0.044715f * x * x * x);
    const float t = 1.f - 2.f * __builtin_amdgcn_rcpf(1.f + __expf(2.f * z)); return 0.5f * x * (1.f + t); }
__device__ __forceinline__ f32x4 mfma16(bf16x8 a, bf16x8 b, f32x4 c) { return __builtin_amdgcn_mfma_f32_16x16x32_bf16(a, b, c, 0, 0, 0); }
#define LDS_FENCE() asm volatile("s_waitcnt lgkmcnt(0)" ::: "memory")

struct EpiSwiGLU {
    static constexpr bool PERM = false, AFTER_DRAIN = false;
    bf16_t* O; int ldc; const float* rs;
    __device__ __forceinline__ void operator()(const pg8::f32x4 (&acc)[2][2][4][2], const pg8::Unit& u, int wr, int wc, int fr, int fq) const {
        const int row0 = u.pm * 256 + wr * 64 + fr, hid0 = u.pn * 128 + wc * 16 + 4 * fq;
#pragma unroll
        for (int ai = 0; ai < 2; ++ai)
#pragma unroll
            for (int m = 0; m < 4; ++m) { const float sc = rs[row0 + ai * 128 + m * 16]; bf16_t* rowp = O + (size_t)(row0 + ai * 128 + m * 16) * ldc + hid0;
#pragma unroll
                for (int bj = 0; bj < 2; ++bj) { const pg8::f32x4 g = acc[ai][bj][m][0] * sc, v = acc[ai][bj][m][1] * sc;
                    u32x2 w; w.x = pg8::cvt_pk_bf16(silu_f(g[0]) * v[0], silu_f(g[1]) * v[1]); w.y = pg8::cvt_pk_bf16(silu_f(g[2]) * v[2], silu_f(g[3]) * v[3]);
                    *(u32x2*)(rowp + bj * 64) = w; } }
    }
};

#define XB_TMO      128
#define XB_XCNT(j)  (256  + 64 * (j))
#define XB_XSUB(j)  (1280 + 64 * (j))
#define XB_XGEN(j)  (2304 + 64 * (j))
#define XB_TOP      3328
#define XB_TOPGEN   3392
#define XCD_BAR_WORDS 3456
#define XB_SPIN_CAP (1u << 18)

__device__ __forceinline__ unsigned xb_ld(unsigned* p)              { return __hip_atomic_load(p, __ATOMIC_RELAXED, __HIP_MEMORY_SCOPE_AGENT); }
__device__ __forceinline__ unsigned xb_add(unsigned* p, unsigned v) { return __hip_atomic_fetch_add(p, v, __ATOMIC_RELAXED, __HIP_MEMORY_SCOPE_AGENT); }
__device__ __forceinline__ unsigned xb_xcc_id() { return (unsigned)__builtin_amdgcn_s_getreg((3 << 11) | 20) & 0xFu; }
#define XB_SPIN(cond, bar) do { unsigned _sp = 0; while (cond) { __builtin_amdgcn_s_sleep(1); \
    if ((++_sp & 255u) == 0u) { if (xb_ld(&(bar)[XB_TMO])) break; if (_sp > XB_SPIN_CAP) { atomicAdd(&(bar)[XB_TMO], 1u); break; } } } } while (0)

struct XcdBarrier {
    unsigned* bar; unsigned x;
    volatile LAS unsigned* st;
};

__device__ __forceinline__ XcdBarrier xcd_barrier_post(unsigned* bar, volatile LAS unsigned* st) {
    XcdBarrier b; b.bar = bar; b.x = xb_xcc_id(); b.st = st;
    if (threadIdx.x == 0) (void)xb_add(&bar[XB_XCNT(b.x)], 1u);
    return b;
}
__device__ __forceinline__ void xcd_barrier_complete(unsigned* bar, unsigned x, unsigned& nloc, unsigned& nx) {
    const unsigned G = gridDim.x * gridDim.y * gridDim.z;
    unsigned sum, cnt, mine, sp = 0u;
    for (;;) {
        sum = 0u; cnt = 0u; mine = 0u;
#pragma unroll
        for (unsigned j = 0; j < 16; ++j) { const unsigned c = xb_ld(&bar[XB_XCNT(j)]); sum += c; cnt += (c > 0u) ? 1u : 0u; mine = (j == x) ? c : mine; }
        if (sum == G) break;
        __builtin_amdgcn_s_sleep(1);
        if ((++sp & 255u) == 0u) { if (xb_ld(&bar[XB_TMO])) break; if (sp > XB_SPIN_CAP) { atomicAdd(&bar[XB_TMO], 1u); break; } }
    }
    nloc = mine > 0u ? mine : 1u; nx = cnt > 0u ? cnt : 1u;
}

__device__ __forceinline__ void xcd_barrier(const XcdBarrier& b) {
    asm volatile("s_waitcnt vmcnt(0)" ::: "memory");
    __syncthreads();
    if (threadIdx.x == 0) {
        unsigned* bar = b.bar; asm volatile("" : "+s"(bar));
        __builtin_amdgcn_s_waitcnt(0);
        unsigned nloc = b.st[0], nx = b.st[1];
        if (nloc == 0u) { xcd_barrier_complete(bar, b.x, nloc, nx); b.st[0] = nloc; b.st[1] = nx; }
        const unsigned old = xb_add(&bar[XB_XSUB(b.x)], 1u);
        const unsigned gen = old / nloc;
        if (old + 1u == (gen + 1u) * nloc) {
            __builtin_amdgcn_fence(__ATOMIC_RELEASE, "agent");
            asm volatile("s_waitcnt vmcnt(0)" ::: "memory");
            const unsigned og = xb_add(&bar[XB_TOP], 1u);
            const unsigned tg = og / nx;
            if (og + 1u == (tg + 1u) * nx) xb_add(&bar[XB_TOPGEN], 1u);
            else XB_SPIN(xb_ld(&bar[XB_TOPGEN]) == tg, bar);
            __builtin_amdgcn_fence(__ATOMIC_ACQUIRE, "agent");
            xb_add(&bar[XB_XGEN(b.x)], 1u);
            asm volatile("s_waitcnt vmcnt(0)" ::: "memory");
        } else {
            XB_SPIN(xb_ld(&bar[XB_XGEN(b.x)]) == gen, bar);
            __builtin_amdgcn_fence(__ATOMIC_ACQUIRE, "agent");
            asm volatile("s_waitcnt vmcnt(0)" ::: "memory");
        }
    }
    __syncthreads();
}

struct EpiBf16Scale {
    static constexpr bool PERM = true, AFTER_DRAIN = false;
    bf16_t* O; int ldc; const float* rs;
    __device__ __forceinline__ void operator()(const pg8::f32x4 (&acc)[2][2][4][2], const pg8::Unit& u, int wr, int wc, int fr, int fq) const {
        const int row0 = u.pm * 256 + wr * 64 + fr, col0 = u.pn * 256 + wc * 32 + 8 * fq;
#pragma unroll
        for (int ai = 0; ai < 2; ++ai)
#pragma unroll
            for (int m = 0; m < 4; ++m) { const int row = row0 + ai * 128 + m * 16; const float sc = rs[row]; bf16_t* rowp = O + (size_t)row * ldc + col0;
#pragma unroll
                for (int bj = 0; bj < 2; ++bj) { const pg8::f32x4 v0 = acc[ai][bj][m][0] * sc, v1 = acc[ai][bj][m][1] * sc;
                    u32x4 w; w.x = pg8::cvt_pk_bf16(v0[0], v0[1]); w.y = pg8::cvt_pk_bf16(v0[2], v0[3]); w.z = pg8::cvt_pk_bf16(v1[0], v1[1]); w.w = pg8::cvt_pk_bf16(v1[2], v1[3]);
                    *(u32x4*)(rowp + bj * 128) = w; } }
    }
};
struct SliceOrder {
    int nunits, G, c;
    __device__ __forceinline__ bool next(int i, pg8::Unit& u) const { const int L = i * G + c; if (L >= nunits) return false; const int t = L & 7; u.pm = t >> 2; u.pn = t & 3; u.ks = L >> 3; return true; }
    __device__ __forceinline__ void a_ready(const pg8::Unit&) const {}
    __device__ __forceinline__ void done(const pg8::Unit&) const {}
};
struct EpiF32Part {
    static constexpr bool PERM = false, AFTER_DRAIN = false;
    float* C;
    __device__ __forceinline__ void operator()(const pg8::f32x4 (&acc)[2][2][4][2], const pg8::Unit& u, int wr, int wc, int fr, int fq) const {
        const int row0 = u.pm * 256 + wr * 64 + fr, col0 = u.pn * 256 + wc * 32 + 4 * fq; float* base = C + (size_t)u.ks * (512 * 1024);
#pragma unroll
        for (int ai = 0; ai < 2; ++ai)
#pragma unroll
            for (int m = 0; m < 4; ++m) { float* rowp = base + (size_t)(row0 + ai * 128 + m * 16) * 1024 + col0;
#pragma unroll
                for (int bj = 0; bj < 2; ++bj)
#pragma unroll
                    for (int n = 0; n < 2; ++n) *(pg8::f32x4*)(rowp + bj * 128 + n * 16) = acc[ai][bj][m][n]; }
    }
};

struct SrcIn { const float* w; const float* nw; __device__ __forceinline__ float operator()(int k, int n) const { return w[(size_t)k * INW + (n < 1536 ? n : n + 8)] * nw[k]; } };
struct SrcPlain { const float* w; int N; __device__ __forceinline__ float operator()(int k, int n) const { return w[(size_t)k * N + n]; } };
struct SrcGU { const float* g; const float* u; const float* nw; __device__ __forceinline__ float operator()(int k, int n) const { const int r = n & 31, hid = (n >> 5) * 16 + (r & 15); const long long du = (r < 16) ? 0ll : (long long)(u - g); return g[du + (long long)k * DFF + hid] * nw[k]; } };
template <class Src> __device__ __forceinline__ void transpose_item(const Src& src, int K, bf16_t* WT, int nblk, LAS float* scr, int item, int lane) {
    const int kb = item / nblk, nb = item % nblk, k0 = 64 * kb, n0 = 32 * nb;
#pragma unroll 8
    for (int i = 0; i < 32; ++i) { const int kk = 2 * i + (lane >> 5); scr[kk * 33 + (lane & 31)] = src(k0 + kk, n0 + (lane & 31)); }
    LDS_FENCE();
    const int c = lane & 7;
#pragma unroll
    for (int j = 0; j < 4; ++j) { const int n = (lane >> 3) + 8 * j; const LAS float* s = scr + (8 * c) * 33 + n;
        u32x4 o; o.x = pk2(s[0 * 33], s[1 * 33]); o.y = pk2(s[2 * 33], s[3 * 33]); o.z = pk2(s[4 * 33], s[5 * 33]); o.w = pk2(s[6 * 33], s[7 * 33]);
        *(u32x4*)(WT + (size_t)(n0 + n) * K + k0 + 8 * c) = o; }
    LDS_FENCE();
}

__device__ __forceinline__ void norm_rows(const float* T, const float* wt, const float* X0, const float* X1, float* Xout, const float* wh, float* RSC,
                                          const float* Wab, float* AB, int gw, int NGW, int lane, const float* Tp = nullptr, int ns = 0,
                                          const bf16_t* Xbin = nullptr, bf16_t* Xbout = nullptr) {
#pragma unroll 1
    for (int m = gw; m < NTOK; m += NGW) {
        f32x4 x[4], t[4];
        { if (Xbin) {
#pragma unroll
              for (int j = 0; j < 4; ++j) { const u32x2 xb = ((const u32x2*)(Xbin + (size_t)m * D))[lane + 64 * j];
                  x[j] = (f32x4){__uint_as_float(xb.x << 16), __uint_as_float(xb.x & 0xffff0000u), __uint_as_float(xb.y << 16), __uint_as_float(xb.y & 0xffff0000u)}; } }
          else { const float* xr = (X1 && m >= NP) ? X1 + (size_t)(m - NP) * D : X0 + (size_t)m * D;
#pragma unroll
              for (int j = 0; j < 4; ++j) x[j] = ((const f32x4*)xr)[lane + 64 * j]; }
          if (T && !(Tp && m >= NP)) {
#pragma unroll
              for (int j = 0; j < 4; ++j) { const u32x2 tb = ((const u32x2*)((const bf16_t*)T + (size_t)m * D))[lane + 64 * j];
                  t[j] = (f32x4){__uint_as_float(tb.x << 16), __uint_as_float(tb.x & 0xffff0000u), __uint_as_float(tb.y << 16), __uint_as_float(tb.y & 0xffff0000u)}; } } }
        if (T) {
            float ss = 0.f;
            if (Tp && m >= NP) {
#pragma unroll
                for (int j = 0; j < 4; ++j) { f32x4 a = {0.f, 0.f, 0.f, 0.f}; for (int q = 0; q < ns; ++q) a += ((const f32x4*)(Tp + (size_t)q * (512 * 1024) + (size_t)(m - NP) * D))[lane + 64 * j]; t[j] = a; } }
#pragma unroll
            for (int j = 0; j < 4; ++j) ss += (t[j].x * t[j].x + t[j].y * t[j].y) + (t[j].z * t[j].z + t[j].w * t[j].w);
            ss = wave_sum(ss); const float r = rsqrtf(ss * (1.f / D) + EPS);
#pragma unroll
            for (int j = 0; j < 4; ++j) { const f32x4 w = ((const f32x4*)wt)[lane + 64 * j]; x[j] += t[j] * r * w; }
        }
        if (Xout) {
#pragma unroll
            for (int j = 0; j < 4; ++j) ((f32x4*)(Xout + (size_t)m * D))[lane + 64 * j] = x[j];
        }
        if (Xbout) {
#pragma unroll
            for (int j = 0; j < 4; ++j) { u32x2 o; o.x = pg8::cvt_pk_bf16(x[j].x, x[j].y); o.y = pg8::cvt_pk_bf16(x[j].z, x[j].w); ((u32x2*)(Xbout + (size_t)m * D))[lane + 64 * j] = o; }
        }
        if (RSC) {
            float ss = 0.f;
#pragma unroll
            for (int j = 0; j < 4; ++j) ss += (x[j].x * x[j].x + x[j].y * x[j].y) + (x[j].z * x[j].z + x[j].w * x[j].w);
            ss = wave_sum(ss); const float r = rsqrtf(ss * (1.f / D) + EPS);
            if (lane == 0) RSC[m] = r;
            f32x4 hv[4];
#pragma unroll
            for (int j = 0; j < 4; ++j) { const f32x4 w = ((const f32x4*)wh)[lane + 64 * j]; hv[j] = x[j] * r * w; }
            if (Wab) {
                float d[8];
#pragma unroll
                for (int c = 0; c < 8; ++c) { float dd = 0.f;
#pragma unroll
                    for (int j = 0; j < 4; ++j) { const f32x4 w = ((const f32x4*)(Wab + c * D))[lane + 64 * j]; dd += (hv[j].x * w.x + hv[j].y * w.y) + (hv[j].z * w.z + hv[j].w * w.w); }
                    d[c] = dd; }
#pragma unroll
                for (int c = 0; c < 8; ++c) d[c] = row_sum16(d[c]);
#pragma unroll
                for (int o = 16; o < 64; o <<= 1) {
#pragma unroll
                    for (int c = 0; c < 8; ++c) d[c] += __shfl_xor(d[c], o); }
                if (lane == 0) { f32x4 o0 = {d[0], d[1], d[2], d[3]}, o1 = {d[4], d[5], d[6], d[7]}; *(f32x4*)(AB + (size_t)m * 8) = o0; *(f32x4*)(AB + (size_t)m * 8 + 4) = o1; }
            }
        }
    }
}

__device__ __forceinline__ void norm_rows_pf(const float* T, const float* wt, bf16_t* XB, float* RSC,
                                             int gw, int NGW, int lane, const float* Tp, int ns) {
    u32x2 xn[4], tn[4];
#define NR_LOAD(mm) do { const int _m = (mm); \
        _Pragma("unroll") for (int j = 0; j < 4; ++j) xn[j] = ((const u32x2*)(XB + (size_t)_m * D))[lane + 64 * j]; \
        if (_m < NP) { _Pragma("unroll") for (int j = 0; j < 4; ++j) tn[j] = ((const u32x2*)((const bf16_t*)T + (size_t)_m * D))[lane + 64 * j]; } } while (0)
    if (gw < NTOK) NR_LOAD(gw);
#pragma unroll 1
    for (int m = gw; m < NTOK; m += NGW) {
        f32x4 x[4], t[4];
#pragma unroll
        for (int j = 0; j < 4; ++j) { x[j] = (f32x4){__uint_as_float(xn[j].x << 16), __uint_as_float(xn[j].x & 0xffff0000u), __uint_as_float(xn[j].y << 16), __uint_as_float(xn[j].y & 0xffff0000u)};
            t[j] = (f32x4){__uint_as_float(tn[j].x << 16), __uint_as_float(tn[j].x & 0xffff0000u), __uint_as_float(tn[j].y << 16), __uint_as_float(tn[j].y & 0xffff0000u)}; }
        if (m + NGW < NTOK) NR_LOAD(m + NGW);
        if (m >= NP) {
#pragma unroll
            for (int j = 0; j < 4; ++j) { f32x4 a = {0.f, 0.f, 0.f, 0.f}; for (int q = 0; q < ns; ++q) a += ((const f32x4*)(Tp + (size_t)q * (512 * 1024) + (size_t)(m - NP) * D))[lane + 64 * j]; t[j] = a; } }
        float ss = 0.f;
#pragma unroll
        for (int j = 0; j < 4; ++j) ss += (t[j].x * t[j].x + t[j].y * t[j].y) + (t[j].z * t[j].z + t[j].w * t[j].w);
        ss = wave_sum(ss); const float r = rsqrtf(ss * (1.f / D) + EPS);
#pragma unroll
        for (int j = 0; j < 4; ++j) { const f32x4 w = ((const f32x4*)wt)[lane + 64 * j]; x[j] += t[j] * r * w; }
#pragma unroll
        for (int j = 0; j < 4; ++j) { u32x2 o; o.x = pg8::cvt_pk_bf16(x[j].x, x[j].y); o.y = pg8::cvt_pk_bf16(x[j].z, x[j].w); ((u32x2*)(XB + (size_t)m * D))[lane + 64 * j] = o; }
        float s2 = 0.f;
#pragma unroll
        for (int j = 0; j < 4; ++j) s2 += (x[j].x * x[j].x + x[j].y * x[j].y) + (x[j].z * x[j].z + x[j].w * x[j].w);
        s2 = wave_sum(s2); if (lane == 0) RSC[m] = rsqrtf(s2 * (1.f / D) + EPS);
    }
#undef NR_LOAD
}

__device__ __forceinline__ void prologue(const DevArgs& A, LAS unsigned char* lds, int wave, int lane, int gw, int NGW) {
    LAS float* scr = (LAS float*)(lds + wave * 8704);
    constexpr int I_IN = 16 * 80, I_OUT = 16 * 32, I_GU = 16 * 176, I_DN = 44 * 32, I_GLU = 4 * 8, I_POOL = 8, PER = I_IN + I_OUT + I_GU + I_DN + I_GLU + I_POOL;
#pragma unroll 1
    for (int it = gw; it < DEPTH * PER; it += NGW) {
        const int l = it / PER; int r = it % PER;
        if (r < I_IN) { SrcIn s{A.in[I_WIN] + (size_t)l * D * INW, A.in[I_NMPRE] + l * D}; transpose_item(s, D, (bf16_t*)(A.ws + WS_WIN + l * SZ_WIN), NPROJ / 32, scr, r, lane); continue; } r -= I_IN;
        if (r < I_OUT) { SrcPlain s{A.in[I_WOUT] + (size_t)l * D * D, D}; transpose_item(s, D, (bf16_t*)(A.ws + WS_WOUT + l * SZ_WOUT), D / 32, scr, r, lane); continue; } r -= I_OUT;
        if (r < I_GU) { SrcGU s{A.in[I_WG] + (size_t)l * D * DFF, A.in[I_WU] + (size_t)l * D * DFF, A.in[I_NFPRE] + l * D}; transpose_item(s, D, (bf16_t*)(A.ws + WS_WGU + l * SZ_WGU), NGU / 32, scr, r, lane); continue; } r -= I_GU;
        if (r < I_DN) { SrcPlain s{A.in[I_WD] + (size_t)l * DFF * D, D}; transpose_item(s, DFF, (bf16_t*)(A.ws + WS_WDN + l * SZ_WDN), D / 32, scr, r, lane); continue; } r -= I_DN;
        if (r < I_GLU) { SrcPlain s{A.in[I_GLUW] + (size_t)l * 65536, 256}; transpose_item(s, 256, (bf16_t*)(A.ws + WS_GLUT + l * SZ_GLUT), 8, scr, r, lane); continue; } r -= I_GLU;
        { const int g = r >> 1; SrcPlain s{A.in[I_POOLW] + (size_t)(l * 4 + g) * 4096, 64}; transpose_item(s, 64, (bf16_t*)(A.ws + WS_POOLT + l * SZ_POOLT) + g * 4096, 2, scr, r & 1, lane); }
    }
    const int gt = gw * 64 + lane, NT = NGW * 64;
    float* wab = (float*)(A.ws + WS_WAB);
#pragma unroll 1
    for (int i = gt; i < DEPTH * 8 * D; i += NT) { const int l = i / (8 * D), j = (i / D) & 7, k = i % D; wab[i] = A.in[I_WIN][((size_t)l * D + k) * INW + 1536 + j]; }
    float* ssmk = (float*)(A.ws + WS_SSMK); float* bbar = (float*)(A.ws + WS_BBAR);
#pragma unroll 1
    for (int i = gt; i < DEPTH * 16 * 64; i += NT) {
        const int lg = i >> 6;
        const float dt = expf(A.in[I_LOGDT][lg]), ar = A.in[I_ARE][i], ai = A.in[I_AIM][i];
        const float mag = expf(ar * dt);
        float rev = ai * dt * 0.15915494309189535f; rev -= floorf(rev);
        const float sn = __builtin_amdgcn_sinf(rev), cs = __builtin_amdgcn_cosf(rev);
        const float lr = mag * cs, li = mag * sn;
        float pr = lr, pi = li;
#pragma unroll
        for (int q = 0; q < 6; ++q) { const float nr2 = pr * pr - pi * pi, ni2 = 2.f * pr * pi; pr = nr2; pi = ni2; }
        ssmk[i * 4 + 0] = lr; ssmk[i * 4 + 1] = li; ssmk[i * 4 + 2] = pr; ssmk[i * 4 + 3] = pi;
        const float nr = lr - 1.f, ni = li, d2 = ar * ar + ai * ai;
        const float cre = (nr * ar + ni * ai) / d2, cim = (ni * ar - nr * ai) / d2;
#pragma unroll
        for (int h = 0; h < 16; ++h) { const float br = A.in[I_BRE][(size_t)i * 16 + h], bi = A.in[I_BIM][(size_t)i * 16 + h];
            bbar[(size_t)i * 32 + h] = cre * br - cim * bi; bbar[(size_t)i * 32 + 16 + h] = cre * bi + cim * br; }
    }
}

__device__ __forceinline__ unsigned bfmul2(unsigned pk, float f0, float f1) { return pg8::cvt_pk_bf16(__uint_as_float(pk << 16) * f0, __uint_as_float(pk & 0xffff0000u) * f1); }
__device__ __forceinline__ void delta_prep_item(const DevArgs& A, int l, LAS unsigned char* lds, int item, int tid, int wave, int lane) {
    asm volatile("" : "+v"(tid)); lane = tid & 63; wave = __builtin_amdgcn_readfirstlane(tid >> 6);
    const int bh = item >> 5, n = item & 31, b = bh >> 2, h = bh & 3;
    const int tok0 = b * SEQ + n * 64;
    LAS bf16_t* QS = (LAS bf16_t*)(lds); LAS bf16_t* KS = (LAS bf16_t*)(lds + 17408);
    LAS unsigned char* KT = lds + 34816; LAS unsigned char* VT = lds + 53248; LAS unsigned char* RTK = lds + 71680;
    LAS float* AM = (LAS float*)(lds + 90112); LAS float* PM = (LAS float*)(lds + 107520); LAS float* PSC = PM; LAS float* TM = (LAS float*)(lds + 124928);
    LAS unsigned char* TB = lds + 142336;
    LAS float* GAM = (LAS float*)(lds + 151552); LAS float* BETA = GAM + 64; LAS float* RQ = GAM + 128; LAS float* RK = GAM + 192;
    LAS float* F2 = GAM + 256; LAS float* F3 = GAM + 320; LAS float* F4 = GAM + 384;
    const bf16_t* PROJ = (const bf16_t*)(A.ws + WS_PROJ);
    const float* AB = (const float*)(A.ws + WS_AB);
    u32x4 gv[2];
#pragma unroll
    for (int j = 0; j < 2; ++j) { const int id = tid + 512 * j; gv[j] = *(const u32x4*)(PROJ + (size_t)(tok0 + (id >> 4)) * NPROJ + PC_G + h * 128 + (id & 15) * 8); }
    if (tid < 384) {
        const int part = tid >> 7, c = tid & 127, col = part * 512 + h * 128 + c;
        const float* cw = A.in[I_CONVW] + (size_t)l * 4 * 1536;
        const float w0 = cw[col], w1 = cw[1536 + col], w2 = cw[3072 + col], w3 = cw[4608 + col];
        const bf16_t* pp = PROJ + (size_t)tok0 * NPROJ + col;
        float xr[67];
#pragma unroll
        for (int t = 0; t < 67; ++t) xr[t] = (n > 0 || t >= 3) ? bf2f(pp[(long)(t - 3) * NPROJ]) : 0.f;
        unsigned pk[32];
#pragma unroll
        for (int t = 0; t < 64; t += 2) {
            const float s0 = silu_f(w0 * xr[t] + w1 * xr[t + 1] + w2 * xr[t + 2] + w3 * xr[t + 3]);
            const float s1 = silu_f(w0 * xr[t + 1] + w1 * xr[t + 2] + w2 * xr[t + 3] + w3 * xr[t + 4]);
            pk[t >> 1] = pg8::cvt_pk_bf16(s0, s1);
        }
        if (part < 2) { LAS bf16_t* dst = (part == 0 ? QS : KS) + c;
#pragma unroll
            for (int t = 0; t < 64; t += 2) { dst[t * 136] = (bf16_t)(pk[t >> 1] & 0xffffu); dst[(t + 1) * 136] = (bf16_t)(pk[t >> 1] >> 16); } }
        if (part > 0) { LAS unsigned char* dst = (part == 1 ? KT : VT) + c * 144;
#pragma unroll
            for (int q = 0; q < 8; ++q) { u32x4 o; o.x = pk[4 * q]; o.y = pk[4 * q + 1]; o.z = pk[4 * q + 2]; o.w = pk[4 * q + 3]; *(LAS u32x4*)(dst + q * 16) = o; } }
    } else if (tid < 448) {
        const int t = tid - 384;
        const float a = AB[(size_t)(tok0 + t) * 8 + h], bb = AB[(size_t)(tok0 + t) * 8 + 4 + h];
        const float xx = a + A.in[I_DTB][l * 4 + h];
        const float sp = xx > 20.f ? xx : log1pf(expf(xx));
        float lg = -expf(A.in[I_ALOG][l * 4 + h]) * sp;
#pragma unroll
        for (int off = 1; off < 64; off <<= 1) { const float v = __shfl_up(lg, off); if (lane >= off) lg += v; }
        GAM[t] = lg; BETA[t] = 1.f / (1.f + expf(-bb));
    }
    __syncthreads();
    {
        const int t = tid >> 3, part = tid & 7; float sq = 0.f, sk = 0.f;
#pragma unroll
        for (int j = 0; j < 16; ++j) { const float q = bf2f(QS[t * 136 + part * 16 + j]), k = bf2f(KS[t * 136 + part * 16 + j]); sq += q * q; sk += k * k; }
        sq = row_sum8(sq); sk = row_sum8(sk);
        if (part == 0) { const float rq = rsqrtf(sq + EPS) * 0.08838834764831845f, rk = rsqrtf(sk + EPS), g = GAM[t], eg = __expf(g), bt = BETA[t];
            RQ[t] = rq; RK[t] = rk; F2[t] = bt * eg * rk; F3[t] = rk * __expf(GAM[63] - g); F4[t] = rq * eg; }
    }
    {
        const int prod = wave >> 2, mt = wave & 3, fr = lane & 15, quad = lane >> 4;
        LAS bf16_t* Aop = prod ? QS : KS; LAS float* dst = prod ? PM : AM;
        bf16x8 a[4];
#pragma unroll
        for (int kk = 0; kk < 4; ++kk) a[kk] = *(LAS bf16x8*)(Aop + (mt * 16 + fr) * 136 + kk * 32 + quad * 8);
#pragma unroll
        for (int nt = 0; nt < 4; ++nt) { f32x4 acc = {0.f, 0.f, 0.f, 0.f};
#pragma unroll
            for (int kk = 0; kk < 4; ++kk) { const bf16x8 bq = *(LAS bf16x8*)(KS + (nt * 16 + fr) * 136 + kk * 32 + quad * 8); acc = mfma16(a[kk], bq, acc); }
#pragma unroll
            for (int i = 0; i < 4; ++i) dst[(mt * 16 + quad * 4 + i) * 68 + nt * 16 + fr] = acc[i]; }
    }
    __syncthreads();
    {
        const int t = tid >> 3, s8 = (tid & 7) * 8; const float gt = GAM[t], bk = BETA[t] * RK[t], rqt = RQ[t];
        float av[8], pv[8];
#pragma unroll
        for (int j = 0; j < 8; ++j) { const int s = s8 + j; const float rks = RK[s]; const float dec = (s <= t) ? __expf(gt - GAM[s]) * rks : 0.f;
            av[j] = (s < t) ? bk * dec * AM[t * 68 + s] : 0.f; pv[j] = rqt * dec * PM[t * 68 + s]; }
#pragma unroll
        for (int j = 0; j < 8; ++j) AM[t * 68 + s8 + j] = av[j];
        u32x4 o; o.x = pg8::cvt_pk_bf16(pv[0], pv[1]); o.y = pg8::cvt_pk_bf16(pv[2], pv[3]); o.z = pg8::cvt_pk_bf16(pv[4], pv[5]); o.w = pg8::cvt_pk_bf16(pv[6], pv[7]);
        *(u32x4*)((bf16_t*)(A.ws + WS_DQK) + (size_t)item * 4096 + t * 64 + s8) = o;
        for (int e = tid; e < 64 * 68; e += 512) TM[e] = 0.f;
        if (tid == 0) ((float*)(A.ws + WS_DGL))[item] = __expf(GAM[63]);
    }
    __syncthreads();
    if (wave == 0) {
        const int i = lane >> 4, c = lane & 15;
        LAS float* amp = AM + (16 * i) * 68 + 16 * i; asm volatile("" : "+v"(amp));
        float x[16];
#pragma unroll
        for (int r = 0; r < 16; ++r) { float acc = (r == c) ? 1.f : 0.f;
#pragma unroll
            for (int s = 0; s < r; ++s) acc = fmaf(-amp[r * 68 + s], x[s], acc);
            x[r] = acc; }
        LAS float* tmp = TM + (16 * i) * 68 + 16 * i + c;
#pragma unroll
        for (int r = 0; r < 16; ++r) tmp[r * 68] = x[r];
    } else {
        const int wt = tid - 64;
        for (int id = wt; id < 1024; id += 448) {
            const int c = id >> 3, t8 = (id & 7) * 8;
            const f32x4 b0 = *(LAS f32x4*)(BETA + t8), b1 = *(LAS f32x4*)(BETA + t8 + 4);
            u32x4 v = *(LAS u32x4*)(VT + c * 144 + t8 * 2);
            v.x = bfmul2(v.x, b0[0], b0[1]); v.y = bfmul2(v.y, b0[2], b0[3]); v.z = bfmul2(v.z, b1[0], b1[1]); v.w = bfmul2(v.w, b1[2], b1[3]);
            *(LAS u32x4*)(VT + c * 144 + t8 * 2) = v;
            const f32x4 f20 = *(LAS f32x4*)(F2 + t8), f21 = *(LAS f32x4*)(F2 + t8 + 4), f30 = *(LAS f32x4*)(F3 + t8), f31 = *(LAS f32x4*)(F3 + t8 + 4);
            const u32x4 k = *(LAS u32x4*)(KT + c * 144 + t8 * 2);
            u32x4 rk; rk.x = bfmul2(k.x, f20[0], f20[1]); rk.y = bfmul2(k.y, f20[2], f20[3]); rk.z = bfmul2(k.z, f21[0], f21[1]); rk.w = bfmul2(k.w, f21[2], f21[3]);
            *(LAS u32x4*)(RTK + c * 144 + t8 * 2) = rk;
            u32x4 kd; kd.x = bfmul2(k.x, f30[0], f30[1]); kd.y = bfmul2(k.y, f30[2], f30[3]); kd.z = bfmul2(k.z, f31[0], f31[1]); kd.w = bfmul2(k.w, f31[2], f31[3]);
            *(u32x4*)((bf16_t*)(A.ws + WS_DKT) + (size_t)item * 8192 + c * 64 + t8) = kd; }
        for (int id = wt; id < 1024; id += 448) {
            const int t = id >> 4, c8 = (id & 15) * 8; const float f = F4[t];
            u32x4 q = *(LAS u32x4*)((LAS unsigned char*)QS + t * 272 + c8 * 2);
            q.x = bfmul2(q.x, f, f); q.y = bfmul2(q.y, f, f); q.z = bfmul2(q.z, f, f); q.w = bfmul2(q.w, f, f);
            *(u32x4*)((bf16_t*)(A.ws + WS_DQD) + (size_t)item * 8192 + t * 128 + c8) = q; }
    }
    {
        const int c8 = (tid & 15) * 8; const float* on = A.in[I_ONORM] + l * 128 + c8;
        const f32x4 o0 = *(const f32x4*)on, o1 = *(const f32x4*)(on + 4);
#pragma unroll
        for (int j = 0; j < 2; ++j) { const int id = tid + 512 * j; const u32x4 g = gv[j]; u32x4 o;
            o.x = pg8::cvt_pk_bf16(silu_f(__uint_as_float(g.x << 16)) * o0[0], silu_f(__uint_as_float(g.x & 0xffff0000u)) * o0[1]);
            o.y = pg8::cvt_pk_bf16(silu_f(__uint_as_float(g.y << 16)) * o0[2], silu_f(__uint_as_float(g.y & 0xffff0000u)) * o0[3]);
            o.z = pg8::cvt_pk_bf16(silu_f(__uint_as_float(g.z << 16)) * o1[0], silu_f(__uint_as_float(g.z & 0xffff0000u)) * o1[1]);
            o.w = pg8::cvt_pk_bf16(silu_f(__uint_as_float(g.w << 16)) * o1[2], silu_f(__uint_as_float(g.w & 0xffff0000u)) * o1[3]);
            *(u32x4*)((bf16_t*)(A.ws + WS_DGS) + (size_t)item * 8192 + (id >> 4) * 128 + c8) = o; }
    }
    __syncthreads();
    const int p2 = tid >> 8, r2 = (tid >> 4) & 15, c2 = tid & 15, rb = p2 ? 48 : 16, cb = p2 ? 32 : 0;
    {
        float acc = 0.f;
#pragma unroll
        for (int s = 0; s < 16; ++s) acc = fmaf(AM[(rb + r2) * 68 + cb + s], TM[(cb + s) * 68 + cb + c2], acc);
        PSC[(p2 * 16 + r2) * 68 + c2] = acc; }
    __syncthreads();
    {
        float acc = 0.f;
#pragma unroll
        for (int s = 0; s < 16; ++s) acc = fmaf(TM[(rb + r2) * 68 + rb + s], PSC[(p2 * 16 + s) * 68 + c2], acc);
        TM[(rb + r2) * 68 + cb + c2] = -acc; }
    __syncthreads();
    float p3[2];
#pragma unroll
    for (int j = 0; j < 2; ++j) { const int e = tid + 512 * j, r = e >> 5, c = e & 31; float acc = 0.f;
#pragma unroll 8
        for (int s = 0; s < 32; ++s) acc = fmaf(AM[(32 + r) * 68 + s], TM[s * 68 + c], acc);
        p3[j] = acc; }
    __syncthreads();
#pragma unroll
    for (int j = 0; j < 2; ++j) { const int e = tid + 512 * j; PSC[(e >> 5) * 68 + (e & 31)] = p3[j]; }
    __syncthreads();
#pragma unroll
    for (int j = 0; j < 2; ++j) { const int e = tid + 512 * j, r = e >> 5, c = e & 31; float acc = 0.f;
#pragma unroll 8
        for (int s = 0; s < 32; ++s) acc = fmaf(TM[(32 + r) * 68 + 32 + s], PSC[s * 68 + c], acc);
        p3[j] = -acc; }
#pragma unroll
    for (int j = 0; j < 2; ++j) { const int e = tid + 512 * j; TM[(32 + (e >> 5)) * 68 + (e & 31)] = p3[j]; }
    __syncthreads();
#pragma unroll
    for (int j = 0; j < 4; ++j) { const int e = tid + 512 * j, t = e >> 5, s2 = (e & 31) * 2;
        *(LAS unsigned*)(TB + t * 144 + s2 * 2) = pg8::cvt_pk_bf16(TM[t * 68 + s2], TM[t * 68 + s2 + 1]); }
    __syncthreads();
    {
        const int fr = lane & 15, quad = lane >> 4;
        bf16x8 bv[2], ak[2];
#pragma unroll
        for (int kk = 0; kk < 2; ++kk) { bv[kk] = *(LAS bf16x8*)(VT + (16 * wave + fr) * 144 + (kk * 32 + quad * 8) * 2); ak[kk] = *(LAS bf16x8*)(RTK + (16 * wave + fr) * 144 + (kk * 32 + quad * 8) * 2); }
        bf16_t* DW = (bf16_t*)(A.ws + WS_DW) + (size_t)item * 8192; bf16_t* DKC = (bf16_t*)(A.ws + WS_DKC) + (size_t)item * 8192;
#pragma unroll
        for (int mt = 0; mt < 4; ++mt) { f32x4 aw = {0.f, 0.f, 0.f, 0.f}, akc = {0.f, 0.f, 0.f, 0.f};
#pragma unroll
            for (int kk = 0; kk < 2; ++kk) { const bf16x8 tf = *(LAS bf16x8*)(TB + (mt * 16 + fr) * 144 + (kk * 32 + quad * 8) * 2);
                aw = mfma16(tf, bv[kk], aw);
                akc = mfma16(ak[kk], tf, akc); }
            u32x2 ow; ow.x = pk2(aw[0], aw[1]); ow.y = pk2(aw[2], aw[3]);
            *(u32x2*)(DW + (16 * wave + fr) * 64 + mt * 16 + quad * 4) = ow;
            u32x2 ok; ok.x = pk2(-akc[0], -akc[1]); ok.y = pk2(-akc[2], -akc[3]);
            *(u32x2*)(DKC + (mt * 16 + fr) * 128 + 16 * wave + quad * 4) = ok; }
    }
    __syncthreads();
}

__device__ __forceinline__ void delta_scan_item(const DevArgs& A, int l, LAS unsigned char* lds, int bh, int tid_in, int wave, int lane_in, const XcdBarrier& xb, int SUB) {
    const int b = bh >> 2, h = bh & 3;
    LAS unsigned char* KCs = lds; LAS unsigned char* QDs = lds + 17408; LAS unsigned char* QKs = lds + 34816; LAS unsigned char* KDTs = lds + 44032;
    LAS unsigned char* Ws = lds + 62464;
    LAS unsigned char* GSs = lds + 80896;
    LAS unsigned char* SS = lds + 98304 + wave * 4352; LAS unsigned char* US = lds + 133120 + wave * 2304;
    LAS float* PART = (LAS float*)(lds + 151552);
    const unsigned char* gW = A.ws + WS_DW; const unsigned char* gGS = A.ws + WS_DGS;
    const unsigned char* gKC = A.ws + WS_DKC; const unsigned char* gQD = A.ws + WS_DQD; const unsigned char* gQK = A.ws + WS_DQK; const unsigned char* gKT = A.ws + WS_DKT;
    const float* DGL = (const float*)(A.ws + WS_DGL);
    f32x4 S[8];
#pragma unroll
    for (int mt = 0; mt < 8; ++mt) S[mt] = (f32x4){0.f, 0.f, 0.f, 0.f};
    u32x4 r[9], rg[2];
    float gl_all = 0.f;
#define DS_LOAD(itn, toff) do { const size_t _i = (size_t)(itn); const unsigned char* _kc = gKC + _i * 16384; const unsigned char* _qd = gQD + _i * 16384; \
        const unsigned char* _qk = gQK + _i * 8192; const unsigned char* _kt = gKT + _i * 16384; \
        r[0] = *(const u32x4*)(_kc + (toff)); r[1] = *(const u32x4*)(_kc + (toff) + 8192u); \
        r[2] = *(const u32x4*)(_qd + (toff)); r[3] = *(const u32x4*)(_qd + (toff) + 8192u); \
        r[4] = *(const u32x4*)(_qk + (toff)); \
        r[5] = *(const u32x4*)(_kt + (toff)); r[6] = *(const u32x4*)(_kt + (toff) + 8192u); \
        const unsigned char* _w = gW + _i * 16384; r[7] = *(const u32x4*)(_w + (toff)); r[8] = *(const u32x4*)(_w + (toff) + 8192u); } while (0)
#define DS_LOADG(itn, toff) do { const unsigned char* _g = gGS + (size_t)(itn) * 16384; rg[0] = *(const u32x4*)(_g + (toff)); rg[1] = *(const u32x4*)(_g + (toff) + 8192u); } while (0)
#define DS_STAGE(tidv) do { const int i0 = (tidv), i1 = (tidv) + 512; \
          *(LAS u32x4*)(KCs + (i0 >> 4) * 272 + (i0 & 15) * 16) = r[0]; *(LAS u32x4*)(KCs + (i1 >> 4) * 272 + (i1 & 15) * 16) = r[1]; \
          *(LAS u32x4*)(QDs + (i0 >> 4) * 272 + (i0 & 15) * 16) = r[2]; *(LAS u32x4*)(QDs + (i1 >> 4) * 272 + (i1 & 15) * 16) = r[3]; \
          *(LAS u32x4*)(QKs + (i0 >> 3) * 144 + (i0 & 7) * 16) = r[4]; \
          *(LAS u32x4*)(KDTs + (i0 >> 3) * 144 + (i0 & 7) * 16) = r[5]; *(LAS u32x4*)(KDTs + (i1 >> 3) * 144 + (i1 & 7) * 16) = r[6]; \
          *(LAS u32x4*)(Ws + (i0 >> 3) * 144 + (i0 & 7) * 16) = r[7]; *(LAS u32x4*)(Ws + (i1 >> 3) * 144 + (i1 & 7) * 16) = r[8]; } while (0)
#define DS_STAGEG(tidv) do { const int i0 = (tidv), i1 = (tidv) + 512; \
          *(LAS u32x4*)(GSs + (i0 >> 4) * 272 + (i0 & 15) * 16) = rg[0]; *(LAS u32x4*)(GSs + (i1 >> 4) * 272 + (i1 & 15) * 16) = rg[1]; } while (0)
#pragma unroll 1
    for (int n = 0; n < 32; ++n) {
        int tid = tid_in; asm volatile("" : "+v"(tid));
        const bool bstart = (SUB > 0) ? (n % SUB == 0) : (n == 0);
        const bool bnext1 = (SUB > 0) && ((n + 1) % SUB == 0), bnext2 = (SUB > 0) && ((n + 2) % SUB == 0);
        if (bstart) { if (n > 0) xcd_barrier(xb);
            gl_all = DGL[bh * 32 + (tid & 31)];
            const unsigned t0 = (unsigned)tid * 16u; DS_LOAD(bh * 32 + n, t0); DS_LOADG(bh * 32 + n, t0); DS_STAGE(tid); DS_STAGEG(tid);
            if (n + 1 < 32 && !bnext1) { DS_LOAD(bh * 32 + n + 1, t0); DS_LOADG(bh * 32 + n + 1, t0); }
            __syncthreads(); }
        else { DS_STAGEG(tid);
            if (n + 1 < 32 && !bnext1) DS_LOADG(bh * 32 + n + 1, (unsigned)tid * 16u); }
        const int lane = tid & 63, fr = lane & 15, quad = lane >> 4, vcol = 16 * wave + fr;
        const unsigned toff = (unsigned)tid * 16u;
        const int it = bh * 32 + n, tokb = b * SEQ + n * 64;
        const float glast = __builtin_bit_cast(float, __builtin_amdgcn_readlane(__builtin_bit_cast(int, gl_all), n));
        asm volatile("s_nop 7\n\ts_nop 7" ::: "memory");
#pragma unroll
        for (int mt = 0; mt < 8; ++mt) { u32x2 p; p.x = pg8::cvt_pk_bf16(S[mt][0], S[mt][1]); p.y = pg8::cvt_pk_bf16(S[mt][2], S[mt][3]); *(LAS u32x2*)(SS + fr * 272 + (mt * 16 + quad * 4) * 2) = p; }
        LDS_FENCE();
        bf16x8 Sb[4];
#pragma unroll
        for (int kk = 0; kk < 4; ++kk) Sb[kk] = *(LAS bf16x8*)(SS + fr * 272 + (kk * 32 + quad * 8) * 2);
        f32x4 U[4], O[4];
#pragma unroll
        for (int mt = 0; mt < 4; ++mt) { f32x4 au, ao = {0.f, 0.f, 0.f, 0.f};
            { const u32x2 wq = *(LAS u32x2*)(Ws + vcol * 144 + (mt * 16 + quad * 4) * 2);
              au[0] = __uint_as_float(wq.x << 16); au[1] = __uint_as_float(wq.x & 0xffff0000u); au[2] = __uint_as_float(wq.y << 16); au[3] = __uint_as_float(wq.y & 0xffff0000u); }
#pragma unroll
            for (int kk = 0; kk < 4; ++kk) { const bf16x8 a1 = *(LAS bf16x8*)(KCs + (mt * 16 + fr) * 272 + (kk * 32 + quad * 8) * 2); au = mfma16(a1, Sb[kk], au);
                const bf16x8 a2 = *(LAS bf16x8*)(QDs + (mt * 16 + fr) * 272 + (kk * 32 + quad * 8) * 2); ao = mfma16(a2, Sb[kk], ao); }
            U[mt] = au; O[mt] = ao; __builtin_amdgcn_sched_barrier(0); }
        asm volatile("s_nop 7\n\ts_nop 7" ::: "memory");
#pragma unroll
        for (int mt = 0; mt < 4; ++mt) { u32x2 p; p.x = pg8::cvt_pk_bf16(U[mt][0], U[mt][1]); p.y = pg8::cvt_pk_bf16(U[mt][2], U[mt][3]); *(LAS u32x2*)(US + fr * 144 + (mt * 16 + quad * 4) * 2) = p; }
        LDS_FENCE();
        bf16x8 Ub[2];
#pragma unroll
        for (int kk = 0; kk < 2; ++kk) Ub[kk] = *(LAS bf16x8*)(US + fr * 144 + (kk * 32 + quad * 8) * 2);
#pragma unroll
        for (int mt = 0; mt < 4; ++mt)
#pragma unroll
            for (int kk = 0; kk < 2; ++kk) { const bf16x8 a = *(LAS bf16x8*)(QKs + (mt * 16 + fr) * 144 + (kk * 32 + quad * 8) * 2); O[mt] = mfma16(a, Ub[kk], O[mt]); }
        __builtin_amdgcn_sched_barrier(0);
#pragma unroll
        for (int mt = 0; mt < 8; ++mt) { S[mt] *= glast;
#pragma unroll
            for (int kk = 0; kk < 2; ++kk) { const bf16x8 a = *(LAS bf16x8*)(KDTs + (mt * 16 + fr) * 144 + (kk * 32 + quad * 8) * 2); S[mt] = mfma16(a, Ub[kk], S[mt]); }
            if (mt & 1) __builtin_amdgcn_sched_barrier(0); }
        { float pp[16];
#pragma unroll
          for (int e = 0; e < 16; ++e) pp[e] = O[e >> 2][e & 3] * O[e >> 2][e & 3];
#pragma unroll
          for (int e = 0; e < 16; ++e) pp[e] = row_sum16(pp[e]);
          if (fr == 0) {
#pragma unroll
              for (int e = 0; e < 16; ++e) PART[((e >> 2) * 16 + quad * 4 + (e & 3)) * 8 + wave] = pp[e]; } }
        __syncthreads();
        if (n + 1 < 32 && !bnext1) { DS_STAGE(tid); if (n + 2 < 32 && !bnext2) DS_LOAD(it + 2, toff); }
        bf16_t* mixb = (bf16_t*)(A.ws + WS_MIX) + (size_t)tokb * D + h * 128;
#pragma unroll
        for (int mt = 0; mt < 4; ++mt)
#pragma unroll
            for (int i = 0; i < 4; ++i) { const int t = mt * 16 + quad * 4 + i;
                const f32x4 p0 = *(LAS f32x4*)(PART + t * 8), p1 = *(LAS f32x4*)(PART + t * 8 + 4);
                const float tot = ((p0[0] + p0[1]) + (p0[2] + p0[3])) + ((p1[0] + p1[1]) + (p1[2] + p1[3]));
                const float sc = rsqrtf(tot * (1.f / 128.f) + EPS);
                const float gs = bf2f(*(LAS bf16_t*)(GSs + t * 272 + vcol * 2));
                mixb[(unsigned)(t * D + vcol)] = (bf16_t)(pg8::cvt_pk_bf16(O[mt][i] * sc * gs, 0.f) & 0xffffu); }
        __syncthreads();
    }
#undef DS_STAGE
#undef DS_LOADG
#undef DS_STAGEG
#undef DS_LOAD
    { const int lane = lane_in, fr = lane & 15, quad = lane >> 4, vcol = 16 * wave + fr;
      float* dp = A.out + O_DP + (size_t)((l * 8 + b) * 4 + h) * 16384;
#pragma unroll
      for (int mt = 0; mt < 8; ++mt)
#pragma unroll
          for (int i = 0; i < 4; ++i) dp[(mt * 16 + quad * 4 + i) * 128 + vcol] = S[mt][i]; }
    __syncthreads();
}

__device__ __forceinline__ void delta_sample_item(const DevArgs& A, int l, LAS unsigned char* lds, int item, int tid, int wave, int lane) {
    asm volatile("" : "+v"(tid)); lane = tid & 63; wave = __builtin_amdgcn_readfirstlane(tid >> 6);
    const int b = item >> 2, h = item & 3, tokS = NP + b * 4;
    LAS float* RAW = (LAS float*)lds; LAS float* RED = RAW + 1536; LAS float* OB = RED + 512; LAS float* SC = OB + 512;
    const bf16_t* PROJ = (const bf16_t*)(A.ws + WS_PROJ); const float* AB = (const float*)(A.ws + WS_AB); bf16_t* MIX = (bf16_t*)(A.ws + WS_MIX);
    const float* cw = A.in[I_CONVW] + (size_t)l * 4 * 1536;
    for (int idx = tid; idx < 1536; idx += 512) { const int part = idx >> 9, t = (idx >> 7) & 3, c = idx & 127, col = part * 512 + h * 128 + c;
        float acc = 0.f;
#pragma unroll
        for (int j = 0; j < 4; ++j) { const int tt = t - 3 + j;
            const float x = (tt >= 0) ? bf2f(PROJ[(size_t)(tokS + tt) * NPROJ + col]) : A.in[I_SCONV][((size_t)(l * 128 + b) * 3 + (3 + tt)) * 1536 + col];
            acc += cw[j * 1536 + col] * x; }
        RAW[idx] = silu_f(acc); }
    if (tid < 4) { const float a = AB[(size_t)(tokS + tid) * 8 + h], bb = AB[(size_t)(tokS + tid) * 8 + 4 + h];
        const float xx = a + A.in[I_DTB][l * 4 + h]; const float sp = xx > 20.f ? xx : log1pf(expf(xx));
        SC[8 + tid] = 1.f / (1.f + expf(-bb)); SC[12 + tid] = expf(-expf(A.in[I_ALOG][l * 4 + h]) * sp); }
    const int v = tid & 127, kq = tid >> 7;
    float S[32];
    { const float* sp = A.in[I_SDELTA] + (size_t)((l * 128 + b) * 4 + h) * 16384;
#pragma unroll
      for (int i = 0; i < 32; ++i) S[i] = sp[(kq * 32 + i) * 128 + v]; }
    __syncthreads();
    { const int part = wave >> 2, t = wave & 3; const float x0 = RAW[part * 512 + t * 128 + lane], x1 = RAW[part * 512 + t * 128 + 64 + lane];
      const float ss = wave_sum(x0 * x0 + x1 * x1); if (lane == 0) SC[part * 4 + t] = rsqrtf(ss + EPS) * (part == 0 ? 0.08838834764831845f : 1.f); }
    __syncthreads();
    for (int t = 0; t < 4; ++t) {
        const float rq = SC[t], rk = SC[4 + t], beta = SC[8 + t], g = SC[12 + t];
        float pr = 0.f;
#pragma unroll
        for (int i = 0; i < 32; ++i) pr += S[i] * RAW[512 + t * 128 + kq * 32 + i];
        RED[kq * 128 + v] = pr * rk;
        __syncthreads();
        const float rr = (RED[v] + RED[128 + v]) + (RED[256 + v] + RED[384 + v]);
        const float u = beta * (RAW[1024 + t * 128 + v] - g * rr);
        float po = 0.f;
#pragma unroll
        for (int i = 0; i < 32; ++i) { const float kh = RAW[512 + t * 128 + kq * 32 + i] * rk; S[i] = g * S[i] + kh * u; po += S[i] * RAW[t * 128 + kq * 32 + i]; }
        __syncthreads();
        RED[kq * 128 + v] = po * rq;
        __syncthreads();
        if (kq == 0) OB[t * 128 + v] = (RED[v] + RED[128 + v]) + (RED[256 + v] + RED[384 + v]);
        __syncthreads();
    }
    if (wave < 4) { const int t = wave; const float x0 = OB[t * 128 + lane], x1 = OB[t * 128 + 64 + lane];
        const float ss = wave_sum(x0 * x0 + x1 * x1); const float sc = rsqrtf(ss * (1.f / 128.f) + EPS);
        const float g0 = bf2f(PROJ[(size_t)(tokS + t) * NPROJ + PC_G + h * 128 + lane]), g1 = bf2f(PROJ[(size_t)(tokS + t) * NPROJ + PC_G + h * 128 + 64 + lane]);
        MIX[(size_t)(tokS + t) * D + h * 128 + lane] = (bf16_t)f2bf(x0 * sc * A.in[I_ONORM][l * 128 + lane] * silu_f(g0));
        MIX[(size_t)(tokS + t) * D + h * 128 + 64 + lane] = (bf16_t)f2bf(x1 * sc * A.in[I_ONORM][l * 128 + 64 + lane] * silu_f(g1)); }
    { float* dsp = A.out + O_DS + (size_t)((l * 128 + b) * 4 + h) * 16384;
#pragma unroll
      for (int i = 0; i < 32; ++i) dsp[(kq * 32 + i) * 128 + v] = S[i]; }
    __syncthreads();
}

#define SSM_BCAST_U(t) do { unsigned _w[8]; \
        _w[0] = __builtin_amdgcn_readlane(ua.x, t); _w[1] = __builtin_amdgcn_readlane(ua.y, t); _w[2] = __builtin_amdgcn_readlane(ua.z, t); _w[3] = __builtin_amdgcn_readlane(ua.w, t); \
        _w[4] = __builtin_amdgcn_readlane(ub.x, t); _w[5] = __builtin_amdgcn_readlane(ub.y, t); _w[6] = __builtin_amdgcn_readlane(ub.z, t); _w[7] = __builtin_amdgcn_readlane(ub.w, t); \
        _Pragma("unroll") for (int _d = 0; _d < 8; ++_d) { uu[2 * _d] = __uint_as_float(_w[_d] << 16); uu[2 * _d + 1] = __uint_as_float(_w[_d] & 0xffff0000u); } } while (0)
#define SSM_STEP() do { float _br = 0.f, _bi = 0.f; \
        _Pragma("unroll") for (int _h = 0; _h < 16; ++_h) { _br = fmaf(Br[_h], uu[_h], _br); _bi = fmaf(Bi[_h], uu[_h], _bi); } \
        const float _nr = lr * hr - li * hi + _br, _ni = lr * hi + li * hr + _bi; hr = _nr; hi = _ni; } while (0)

__device__ __forceinline__ void ssm_part1_item(const DevArgs& A, int l, int it, int lane) {
    const int g = it & 15, bc = it >> 4, b = bc / 31, c = bc % 31;
    const float* bb = (const float*)(A.ws + WS_BBAR) + ((size_t)(l * 16 + g) * 64 + lane) * 32;
    float Br[16], Bi[16];
#pragma unroll
    for (int q = 0; q < 4; ++q) { const f32x4 x = ((const f32x4*)bb)[q], y = ((const f32x4*)bb)[4 + q];
        Br[4 * q] = x.x; Br[4 * q + 1] = x.y; Br[4 * q + 2] = x.z; Br[4 * q + 3] = x.w; Bi[4 * q] = y.x; Bi[4 * q + 1] = y.y; Bi[4 * q + 2] = y.z; Bi[4 * q + 3] = y.w; }
    const f32x4 lk = ((const f32x4*)(A.ws + WS_SSMK))[(l * 16 + g) * 64 + lane]; const float lr = lk.x, li = lk.y;
    const bf16_t* up = (const bf16_t*)(A.ws + WS_PROJ) + (size_t)(b * SEQ + c * 64 + lane) * NPROJ + PC_SSM + g * 16;
    const u32x4 ua = *(const u32x4*)up, ub = *(const u32x4*)(up + 8);
    float hr = 0.f, hi = 0.f, uu[16];
#pragma unroll 1
    for (int t = 0; t < 64; ++t) { SSM_BCAST_U(t); SSM_STEP(); }
    f32x2 e; e.x = hr; e.y = hi;
    ((f32x2*)(A.ws + WS_SSME))[((size_t)(b * 32 + c) * 16 + g) * 64 + lane] = e;
}

__device__ __forceinline__ void ssm_part2_item(const DevArgs& A, int l, LAS unsigned char* lds, int it, int tid, int wave, int lane) {
    asm volatile("" : "+v"(tid)); lane = tid & 63; wave = __builtin_amdgcn_readfirstlane(tid >> 6);
    const int tok0 = it * 64, fr = lane & 15, quad = lane >> 4;
    const bool samp = it >= 256; const int b = it >> 5, c = it & 31;
    LAS unsigned char* YS = lds; LAS unsigned char* HS = lds + 33792 + wave * 4352;
    const bf16_t* PROJ = (const bf16_t*)(A.ws + WS_PROJ); bf16_t* MIX = (bf16_t*)(A.ws + WS_MIX);
#pragma unroll 1
    for (int gi = 0; gi < 2; ++gi) {
        const int g = wave * 2 + gi;
        const float* bb = (const float*)(A.ws + WS_BBAR) + ((size_t)(l * 16 + g) * 64 + lane) * 32;
        float Br[16], Bi[16];
#pragma unroll
        for (int q = 0; q < 4; ++q) { const f32x4 x = ((const f32x4*)bb)[q], y = ((const f32x4*)bb)[4 + q];
            Br[4 * q] = x.x; Br[4 * q + 1] = x.y; Br[4 * q + 2] = x.z; Br[4 * q + 3] = x.w; Bi[4 * q] = y.x; Bi[4 * q + 1] = y.y; Bi[4 * q + 2] = y.z; Bi[4 * q + 3] = y.w; }
        const f32x4 lk = ((const f32x4*)(A.ws + WS_SSMK))[(l * 16 + g) * 64 + lane]; const float lr = lk.x, li = lk.y, Lr = lk.z, Li = lk.w;
        bf16x8 Cb[4];
#pragma unroll
        for (int kk = 0; kk < 4; ++kk) { const size_t co = ((size_t)(l * 16 + g) * 16 + fr) * 64 + kk * 16 + quad * 4;
            const f32x4 cr = *(const f32x4*)(A.in[I_CRE] + co), ci = *(const f32x4*)(A.in[I_CIM] + co);
            u32x4 pk; pk.x = pk2(cr.x, -ci.x); pk.y = pk2(cr.y, -ci.y); pk.z = pk2(cr.z, -ci.z); pk.w = pk2(cr.w, -ci.w);
            Cb[kk] = __builtin_bit_cast(bf16x8, pk); }
        const bf16_t* up = PROJ + (size_t)(tok0 + lane) * NPROJ + PC_SSM + g * 16;
        const u32x4 ua = *(const u32x4*)up, ub = *(const u32x4*)(up + 8);
        float hr = 0.f, hi = 0.f, uu[16];
        if (!samp && c > 0) { const f32x2* E = (const f32x2*)(A.ws + WS_SSME) + ((size_t)(b * 32) * 16 + g) * 64 + lane;
#pragma unroll
            for (int cb = 0; cb < 32; cb += 16) { f32x2 ev[16];
#pragma unroll
                for (int q = 0; q < 16; ++q) { const int cc = cb + q; ev[q] = (cc < c) ? E[(size_t)cc * 1024] : (f32x2){0.f, 0.f}; }
#pragma unroll
                for (int q = 0; q < 16; ++q) { const int cc = cb + q; if (cc < c) { const float nr = Lr * hr - Li * hi + ev[q].x, ni = Lr * hi + Li * hr + ev[q].y; hr = nr; hi = ni; } } } }
        const float dsk = A.in[I_SSMD][l * 256 + g * 16 + fr];
        unsigned uvr[16];
#pragma unroll
        for (int e = 0; e < 16; ++e) uvr[e] = PROJ[(size_t)(tok0 + (e >> 2) * 16 + quad * 4 + (e & 3)) * NPROJ + PC_SSM + g * 16 + fr];
#pragma unroll
        for (int sub = 0; sub < 4; ++sub) {
#pragma unroll 1
            for (int tt = 0; tt < 16; ++tt) { const int t = sub * 16 + tt;
                const int sb = (it - 256) * 16 + (t >> 2);
                if (samp && (t & 3) == 0) { hr = A.in[I_SRE][((size_t)(l * 128 + sb) * 16 + g) * 64 + lane]; hi = A.in[I_SIM][((size_t)(l * 128 + sb) * 16 + g) * 64 + lane]; }
                SSM_BCAST_U(t); SSM_STEP();
                *(LAS unsigned*)(HS + tt * 272 + lane * 4) = pg8::cvt_pk_bf16(hr, hi);
                if (samp && (t & 3) == 3) { A.out[O_RES + ((size_t)(l * 128 + sb) * 16 + g) * 64 + lane] = hr; A.out[O_IMS + ((size_t)(l * 128 + sb) * 16 + g) * 64 + lane] = hi; }
            }
            LDS_FENCE();
            f32x4 acc = {0.f, 0.f, 0.f, 0.f};
#pragma unroll
            for (int kk = 0; kk < 4; ++kk) { const bf16x8 a = *(LAS bf16x8*)(HS + fr * 272 + (kk * 32 + quad * 8) * 2); acc = mfma16(a, Cb[kk], acc); }
#pragma unroll
            for (int i = 0; i < 4; ++i) { const int t = sub * 16 + quad * 4 + i; const float uv = bf2f(uvr[sub * 4 + i]);
                *(LAS bf16_t*)(YS + t * 528 + (g * 16 + fr) * 2) = (bf16_t)f2bf(gelu_tanh_f(acc[i] + dsk * uv)); }
            LDS_FENCE();
        }
        if (!samp && c == 31) { A.out[O_REP + ((size_t)(l * 8 + b) * 16 + g) * 64 + lane] = hr; A.out[O_IMP + ((size_t)(l * 8 + b) * 16 + g) * 64 + lane] = hi; }
    }
    __syncthreads();
    {
        const bf16_t* GT = (const bf16_t*)(A.ws + WS_GLUT + l * SZ_GLUT);
        f32x4 acc[4][2];
#pragma unroll
        for (int mt = 0; mt < 4; ++mt) { acc[mt][0] = (f32x4){0.f, 0.f, 0.f, 0.f}; acc[mt][1] = (f32x4){0.f, 0.f, 0.f, 0.f}; }
#pragma unroll
        for (int kk = 0; kk < 8; ++kk) { bf16x8 bfr[2];
#pragma unroll
            for (int nt = 0; nt < 2; ++nt) bfr[nt] = *(const bf16x8*)(GT + (size_t)(32 * wave + nt * 16 + fr) * 256 + kk * 32 + quad * 8);
#pragma unroll
            for (int mt = 0; mt < 4; ++mt) { const bf16x8 a = *(LAS bf16x8*)(YS + (mt * 16 + fr) * 528 + (kk * 32 + quad * 8) * 2);
                acc[mt][0] = mfma16(a, bfr[0], acc[mt][0]); acc[mt][1] = mfma16(a, bfr[1], acc[mt][1]); } }
#pragma unroll
        for (int nt = 0; nt < 2; ++nt) { const int ncol = 32 * wave + nt * 16 + fr; const float gb = A.in[I_GLUB][l * 256 + ncol];
#pragma unroll
            for (int mt = 0; mt < 4; ++mt)
#pragma unroll
                for (int i = 0; i < 4; ++i) { const int t = mt * 16 + quad * 4 + i; const float y = bf2f(*(LAS bf16_t*)(YS + t * 528 + ncol * 2));
                    MIX[(size_t)(tok0 + t) * D + 512 + ncol] = (bf16_t)f2bf(y * sigmoid_f(acc[mt][nt][i] + gb)); } }
    }
    __syncthreads();
}

__device__ __forceinline__ void pool_item(const DevArgs& A, int l, LAS unsigned char* lds, int it, int tid, int wave, int lane) {
    asm volatile("" : "+v"(tid)); lane = tid & 63; wave = __builtin_amdgcn_readfirstlane(tid >> 6);
    const int tok0 = it * 64, fr = lane & 15, quad = lane >> 4; const bool samp = it >= 256;
    LAS unsigned char* RS = lds;
    const bf16_t* PROJ = (const bf16_t*)(A.ws + WS_PROJ); bf16_t* MIX = (bf16_t*)(A.ws + WS_MIX);
    if (!samp) {
        LAS unsigned char* XT = lds + 33792;
        const int b = it >> 5, c = it & 31;
        for (int id = tid; id < 79 * 32; id += 512) { const int r = id >> 5, c16 = id & 31, tl = c * 64 - 15 + r;
            u32x4 v = {0u, 0u, 0u, 0u}; if (tl >= 0) v = *(const u32x4*)(PROJ + (size_t)(b * SEQ + tl) * NPROJ + PC_POOL + c16 * 8);
            *(LAS u32x4*)(XT + r * 528 + c16 * 16) = v; }
        __syncthreads();
        const int ch = tid & 255, half = tid >> 8, g = ch >> 6, w = 2 << g, r0 = half * 32;
        float sum = 0.f;
        for (int j = 0; j < w; ++j) sum += bf2f(*(LAS bf16_t*)(XT + (r0 + 15 - j) * 528 + ch * 2));
#pragma unroll 4
        for (int rr = 0; rr < 32; ++rr) { const int r = r0 + rr, tl = c * 64 + r;
            const float u = bf2f(*(LAS bf16_t*)(XT + (r + 15) * 528 + ch * 2));
            if (rr > 0) sum += u - bf2f(*(LAS bf16_t*)(XT + (r + 15 - w) * 528 + ch * 2));
            const float rc = __builtin_amdgcn_rcpf((float)((tl + 1 < w) ? tl + 1 : w));
            *(LAS bf16_t*)(RS + r * 528 + ch * 2) = (bf16_t)f2bf(sum * rc - u); }
    } else {
#pragma unroll 1
        for (int pr = 0; pr < 8; ++pr) { const int idx = pr * 512 + tid, ch = idx & 255, sq = idx >> 8, g = ch >> 6, w = 2 << g;
            const int sb = (it - 256) * 16 + sq;
            const float* sbuf = A.in[I_SPOOL] + (size_t)(l * 128 + sb) * 15 * 256 + ch;
            const bf16_t* base = PROJ + (size_t)(NP + sb * 4) * NPROJ + PC_POOL + ch;
            float e[19];
#pragma unroll
            for (int j = 0; j < 15; ++j) e[j] = sbuf[j * 256];
#pragma unroll
            for (int j = 0; j < 4; ++j) e[15 + j] = bf2f(base[(size_t)j * NPROJ]);
#pragma unroll
            for (int t = 0; t < 4; ++t) { float sum = 0.f;
#pragma unroll
                for (int j = 0; j < 16; ++j) sum += (j < w) ? e[15 + t - j] : 0.f;
                *(LAS bf16_t*)(RS + (sq * 4 + t) * 528 + ch * 2) = (bf16_t)f2bf(sum * __builtin_amdgcn_rcpf((float)w) - e[15 + t]); } }
    }
    __syncthreads();
    { const int g2 = wave >> 1; const bf16_t* PT = (const bf16_t*)(A.ws + WS_POOLT + l * SZ_POOLT) + g2 * 4096;
      f32x4 acc[4][2];
#pragma unroll
      for (int mt = 0; mt < 4; ++mt) { acc[mt][0] = (f32x4){0.f, 0.f, 0.f, 0.f}; acc[mt][1] = (f32x4){0.f, 0.f, 0.f, 0.f}; }
#pragma unroll
      for (int kk = 0; kk < 2; ++kk) { bf16x8 bfr[2];
#pragma unroll
          for (int nt = 0; nt < 2; ++nt) bfr[nt] = *(const bf16x8*)(PT + (size_t)((wave & 1) * 32 + nt * 16 + fr) * 64 + kk * 32 + quad * 8);
#pragma unroll
          for (int mt = 0; mt < 4; ++mt) { const bf16x8 a = *(LAS bf16x8*)(RS + (mt * 16 + fr) * 528 + (g2 * 64 + kk * 32 + quad * 8) * 2);
              acc[mt][0] = mfma16(a, bfr[0], acc[mt][0]); acc[mt][1] = mfma16(a, bfr[1], acc[mt][1]); } }
#pragma unroll
      for (int nt = 0; nt < 2; ++nt) { const int col = 32 * wave + nt * 16 + fr; const float ps = A.in[I_POOLS][l * 256 + col];
#pragma unroll
          for (int mt = 0; mt < 4; ++mt)
#pragma unroll
              for (int i = 0; i < 4; ++i) { const int t = mt * 16 + quad * 4 + i; MIX[(size_t)(tok0 + t) * D + 768 + col] = (bf16_t)f2bf(acc[mt][nt][i] * ps); } } }
    __syncthreads();
}

__device__ __forceinline__ void state_copies(const DevArgs& A, int l, int gt, int NT) {
    const bf16_t* PROJ = (const bf16_t*)(A.ws + WS_PROJ);
#pragma unroll 1
    for (int i = gt; i < 8 * 3 * 1536; i += NT) { const int col = i % 1536, j = (i / 1536) % 3, b = i / 4608;
        A.out[O_CP + (size_t)l * 8 * 4608 + i] = bf2f(PROJ[(size_t)(b * SEQ + SEQ - 3 + j) * NPROJ + col]); }
#pragma unroll 1
    for (int i = gt; i < 128 * 3 * 1536; i += NT) { const int col = i % 1536, j = (i / 1536) % 3, b = i / 4608;
        A.out[O_CS + (size_t)l * 128 * 4608 + i] = bf2f(PROJ[(size_t)(NP + b * 4 + 1 + j) * NPROJ + col]); }
#pragma unroll 1
    for (int i = gt; i < 8 * 15 * 256; i += NT) { const int ch = i & 255, j = (i >> 8) % 15, b = i / 3840;
        A.out[O_PP + (size_t)l * 8 * 3840 + i] = bf2f(PROJ[(size_t)(b * SEQ + SEQ - 15 + j) * NPROJ + PC_POOL + ch]); }
#pragma unroll 1
    for (int i = gt; i < 128 * 15 * 256; i += NT) { const int ch = i & 255, j = (i >> 8) % 15, b = i / 3840;
        A.out[O_PS + (size_t)l * 128 * 3840 + i] = (j < 11) ? A.in[I_SPOOL][((size_t)(l * 128 + b) * 15 + 4 + j) * 256 + ch]
                                                             : bf2f(PROJ[(size_t)(NP + b * 4 + (j - 11)) * NPROJ + PC_POOL + ch]); }
}

#ifndef REP_DPREP
#define REP_DPREP 1
#endif
#ifndef REP_DSAMP
#define REP_DSAMP 1
#endif
#ifndef REP_SSM1
#define REP_SSM1 1
#endif
#ifndef REP_POOL
#define REP_POOL 1
#endif
#ifndef REP_DSCAN
#define REP_DSCAN 1
#endif
#ifndef REP_SSM2
#define REP_SSM2 1
#endif
#ifndef REP_G
#define REP_G 1
#endif
#ifndef REP_P3
#define REP_P3 1
#endif
#ifndef REP_P2
#define REP_P2 1
#endif
constexpr int NPH = 2 + DEPTH * 8;
__global__ void __launch_bounds__(512, 2) mega_fwd(Args KA) {
    DevArgs A; A.out = KA.out; A.ws = KA.ws; A.ph_lo = KA.ph_lo; A.ph_hi = KA.ph_hi;
    extern __shared__ __attribute__((aligned(16))) unsigned char lds_raw[];
    LAS unsigned char* lds = (LAS unsigned char*)lds_raw;
    cg::grid_group grid = cg::this_grid();
    volatile LAS unsigned* xst = (volatile LAS unsigned*)(lds + LDS_BYTES - 64);
    if (threadIdx.x == 0) { xst[0] = 0u; xst[1] = 0u; }
    __syncthreads();
    const XcdBarrier xb = xcd_barrier_post((unsigned*)(KA.ws + WS_BAR), xst);
    if (KA.ph_lo < 0) grid.sync();
    constexpr int G = 256, NGW = G * 8, NT = G * 512;
    int ph = 0;
#define PH_BEGIN if (A.ph_lo <= ph && ph < A.ph_hi) { int tid = threadIdx.x; asm volatile("" : "+v"(tid)); { unsigned char* _w = A.ws; asm volatile("" : "+s"(_w)); A.ws = _w; float* _o = A.out; asm volatile("" : "+s"(_o)); A.out = _o; } const int wave = __builtin_amdgcn_readfirstlane(tid >> 6), lane = tid & 63, gw = blockIdx.x * 8 + wave, gt = blockIdx.x * 512 + tid; (void)gw; (void)gt; (void)lane;
#define PH_END   if (ph + 1 < A.ph_hi) xcd_barrier(xb); } ++ph;
#define Hb   ((bf16_t*)(A.ws + WS_H))
#define AB   ((float*)(A.ws + WS_AB))
#define MIXO ((float*)(A.ws + WS_MIXO))
#define PROJ ((bf16_t*)(A.ws + WS_PROJ))
#define MIX  ((bf16_t*)(A.ws + WS_MIX))
#define HID  ((bf16_t*)(A.ws + WS_HID))
#define RSCBUF ((float*)(A.ws + WS_RSC))
#define XBUF ((bf16_t*)(A.ws + WS_MIXO + (size_t)NTOK * D * 2))

#ifndef REP_PRO
#define REP_PRO 1
#endif
#ifndef REP_N0
#define REP_N0 1
#endif
    PH_BEGIN for (int rep = 0; rep < REP_PRO; ++rep) { prologue(A, lds, wave, lane, gw, NGW); __syncthreads(); } PH_END
    PH_BEGIN for (int rep = 0; rep < REP_N0; ++rep) norm_rows(nullptr, nullptr, A.in[I_XP], A.in[I_XS], nullptr, A.in[I_NMPRE], RSCBUF, (const float*)(A.ws + WS_WAB), AB, gw, NGW, lane, nullptr, 0, nullptr, XBUF); PH_END

#pragma unroll 1
    for (int l = 0; l < DEPTH; ++l) {
        PH_BEGIN for (int rep = 0; rep < REP_G; ++rep) { pg8::Gemm g{XBUF, (const bf16_t*)(A.ws + WS_WIN + l * SZ_WIN), NTOK, NPROJ, D, D, D}; pg8::StaticOrder S; S.init(NTOK, NPROJ, G, (int)blockIdx.x);
            EpiBf16Scale E{PROJ, NPROJ, RSCBUF}; pg8::gemm_phase<EpiBf16Scale, pg8::StaticOrder>(lds, g, S, E, nullptr); } PH_END
        constexpr int SUBC = 7;
        PH_BEGIN {
#pragma unroll 1
          for (int rep2 = 0; rep2 < REP_P2; ++rep2) {
#pragma unroll 1
            for (int j = blockIdx.x; j < 32 * SUBC; j += G) delta_prep_item(A, l, lds, (j & 31) * 32 + (j >> 5), tid, wave, lane);
            if (blockIdx.x >= 32 * SUBC) {
#pragma unroll 1
                for (int it = (blockIdx.x - 32 * SUBC) * 8 + wave; it < 768; it += (G - 32 * SUBC) * 8) { int t1 = threadIdx.x; asm volatile("" : "+v"(t1)); ssm_part1_item(A, l, it, t1 & 63); } }
          }
        } PH_END
        PH_BEGIN {
#pragma unroll 1
            for (int rep3 = 0; rep3 < REP_P3; ++rep3) {
                if (blockIdx.x < 32) delta_scan_item(A, l, lds, blockIdx.x, tid, wave, lane, xb, SUBC);
                else { const int w = blockIdx.x - 32; constexpr int NW = G - 32;
#pragma unroll 1
                    for (int k = 1; k <= 5; ++k) {
                        const int n0 = k * SUBC, nn = (n0 >= 32) ? 0 : ((32 - n0 < SUBC) ? 32 - n0 : SUBC);
                        int nprep = 32 * nn;
#ifndef REP_WPREP
#define REP_WPREP 1
#endif
#pragma unroll 1
                        for (int rep = 0; rep < REP_WPREP; ++rep)
#pragma unroll 1
                        for (int j = w; j < nprep; j += NW) delta_prep_item(A, l, lds, (j & 31) * 32 + n0 + (j >> 5), tid, wave, lane);
                        { const int s_lo = (k == 4) ? 448 : 0, s_hi = (k == 1) ? 448 : ((k == 4) ? 512 : 0);
#pragma unroll 1
                          for (int it = s_lo + w; it < s_hi; it += NW) delta_sample_item(A, l, lds, it, tid, wave, lane); }
                        if (k == 2) {
#pragma unroll 1
                            for (int it = 768 + w * 8 + wave; it < 8 * 31 * 16; it += NW * 8) { int t1 = threadIdx.x; asm volatile("" : "+v"(t1)); ssm_part1_item(A, l, it, t1 & 63); }
                            { int t2 = threadIdx.x; asm volatile("" : "+v"(t2)); int wl = blockIdx.x; asm volatile("" : "+s"(wl)); state_copies(A, l, (wl - 32) * 512 + t2, NW * 512); } }
                        if (k == 3) {
#pragma unroll 1
                            for (int it = w; it < 264; it += NW) pool_item(A, l, lds, it, tid, wave, lane); }
                        { const int it = (k == 4) ? w - 128 : ((k == 5) ? 96 + w : -1);
                          if (it >= 0 && it < ((k == 4) ? 96 : 264)) ssm_part2_item(A, l, lds, it, tid, wave, lane); }
                        if (k < 5) xcd_barrier(xb);
                    } }
            }
        } PH_END
        PH_BEGIN for (int rep = 0; rep < REP_G; ++rep) { pg8::Gemm g{MIX, (const bf16_t*)(A.ws + WS_WOUT + l * SZ_WOUT), NP, D, D, D, D}; pg8::StaticOrder S; S.init(NP, D, G, (int)blockIdx.x);
            pg8::EpiBf16<0> E{(bf16_t*)MIXO, D, nullptr, 0, 0}; pg8::gemm_phase<pg8::EpiBf16<0>, pg8::StaticOrder>(lds, g, S, E, nullptr);
            pg8::Gemm g2{MIX + (size_t)NP * D, (const bf16_t*)(A.ws + WS_WOUT + l * SZ_WOUT), NS, D, 256, D, D}; SliceOrder S2{8 * (D / 256), G, (int)blockIdx.x};
            EpiF32Part E2{(float*)(A.ws + WS_PARTS)}; pg8::gemm_phase<EpiF32Part, SliceOrder>(lds, g2, S2, E2, nullptr); } PH_END
#ifndef REP_N5
#define REP_N5 1
#endif
        PH_BEGIN norm_rows_pf(MIXO, A.in[I_NMPOST] + l * D, XBUF, RSCBUF, gw, NGW, lane, (const float*)(A.ws + WS_PARTS), D / 256); PH_END
        PH_BEGIN for (int rep = 0; rep < REP_G; ++rep) { pg8::Gemm g{XBUF, (const bf16_t*)(A.ws + WS_WGU + l * SZ_WGU), NTOK, NGU, D, D, D}; pg8::StaticOrder S; S.init(NTOK, NGU, G, (int)blockIdx.x);
            EpiSwiGLU E{HID, DFF, RSCBUF}; pg8::gemm_phase<EpiSwiGLU, pg8::StaticOrder>(lds, g, S, E, nullptr); } PH_END
        PH_BEGIN for (int rep = 0; rep < REP_G; ++rep) { pg8::Gemm g{HID, (const bf16_t*)(A.ws + WS_WDN + l * SZ_WDN), NP, D, DFF, DFF, DFF}; pg8::StaticOrder S; S.init(NP, D, G, (int)blockIdx.x);
            pg8::EpiBf16<0> E{(bf16_t*)MIXO, D, nullptr, 0, 0}; pg8::gemm_phase<pg8::EpiBf16<0>, pg8::StaticOrder>(lds, g, S, E, nullptr);
            pg8::Gemm g2{HID + (size_t)NP * DFF, (const bf16_t*)(A.ws + WS_WDN + l * SZ_WDN), NS, D, 256, DFF, DFF}; SliceOrder S2{8 * (DFF / 256), G, (int)blockIdx.x};
            EpiF32Part E2{(float*)(A.ws + WS_PARTS)}; pg8::gemm_phase<EpiF32Part, SliceOrder>(lds, g2, S2, E2, nullptr); } PH_END
        PH_BEGIN norm_rows(MIXO, A.in[I_NFPOST] + l * D, nullptr, nullptr, l + 1 < DEPTH ? nullptr : A.out, l + 1 < DEPTH ? A.in[I_NMPRE] + (l + 1) * D : nullptr, l + 1 < DEPTH ? RSCBUF : nullptr,
                           l + 1 < DEPTH ? (const float*)(A.ws + WS_WAB + (l + 1) * SZ_WAB) : nullptr, AB, gw, NGW, lane, (const float*)(A.ws + WS_PARTS), DFF / 256,
                           XBUF, l + 1 < DEPTH ? XBUF : nullptr); PH_END
    }
#undef PH_BEGIN
#undef PH_END
#undef Hb
#undef AB
#undef MIXO
#undef PROJ
#undef MIX
#undef HID
#undef XBUF
#undef RSCBUF
}

extern "C" void kernel_launch(void* const* d_in, const int* in_sizes, int n_in, void* d_out, int out_size, void* d_ws, size_t ws_size, hipStream_t stream) {
    static int grid = 0;
    if (grid == 0) {
        if (n_in != 32 || (size_t)out_size != O_END || ws_size < WS_END) fprintf(stderr, "kernel_launch: unexpected sizes: n_in %d out %d (want %zu) ws %zu (want >= %zu)\n", n_in, out_size, (size_t)O_END, ws_size, (size_t)WS_END);
        int dev = 0, cus = 0, per_cu = 0;
        (void)hipGetDevice(&dev); (void)hipDeviceGetAttribute(&cus, hipDeviceAttributeMultiprocessorCount, dev);
        if (hipFuncSetAttribute((const void*)mega_fwd, hipFuncAttributeMaxDynamicSharedMemorySize, LDS_BYTES) != hipSuccess) fprintf(stderr, "kernel_launch: hipFuncSetAttribute failed\n");
        if (hipOccupancyMaxActiveBlocksPerMultiprocessor(&per_cu, (const void*)mega_fwd, 512, LDS_BYTES) != hipSuccess || per_cu < 1) { fprintf(stderr, "kernel_launch: occupancy query gave %d\n", per_cu); per_cu = 1; (void)hipGetLastError(); }
        grid = cus * per_cu; if (grid <= 0) grid = 256;
        if (grid >= 256) grid = 256;
        fprintf(stderr, "kernel_launch: grid %d (cus %d x %d)%s\n", grid, cus, per_cu, grid < 256 ? "  ERROR: this build needs >= 256 co-resident workgroups" : "");
    }
    (void)hipMemsetAsync((unsigned char*)d_ws + WS_BAR, 0, 16384, stream);
    Args a{};
    for (int i = 0; i < 32; ++i) a.in[i] = (const float*)d_in[i];
    a.out = (float*)d_out; a.ws = (unsigned char*)d_ws;
#if MK_COOP
    a.ph_lo = 0; a.ph_hi = NPH;
    void* args[] = {&a};
    const hipError_t e = hipLaunchCooperativeKernel((const void*)mega_fwd, dim3(grid), dim3(512), args, LDS_BYTES, stream);
    if (e != hipSuccess) fprintf(stderr, "kernel_launch: cooperative launch failed: %s (grid %d)\n", hipGetErrorString(e), grid);
#else
    for (int p = 0; p < NPH; ++p) { a.ph_lo = p; a.ph_hi = p + 1; hipLaunchKernelGGL(mega_fwd, dim3(grid), dim3(512), LDS_BYTES, stream, a); }
#endif
}
```

```cpp
#include <hip/hip_runtime.h>
#include <hip/hip_cooperative_groups.h>
#include <cstdio>
#include <cstdint>
namespace cg = cooperative_groups;
#ifndef MK_COOP
#define MK_COOP 1
#endif
namespace pg8 {
#define PG8_LAS __attribute__((address_space(3)))
typedef unsigned short bf16_t;
typedef short bf16x8 __attribute__((ext_vector_type(8)));
typedef float f32x4 __attribute__((ext_vector_type(4)));
typedef unsigned u32x4 __attribute__((ext_vector_type(4)));
constexpr int BM = 256, BK = 64, HALF = 128, HTB = HALF * BK * 2  , STAGE_BYTES = 8 * HTB, NXCD = 8, WGM = 8;

__host__ __device__ __forceinline__ int lds_byte(int r, int c) { const int st = (r >> 4) * 2 + (c >> 5), rr = r & 15, cc = c & 31, ob = rr * 64 + cc * 2; return st * 1024 + (ob ^ (((ob >> 9) & 1) << 5)); }
__host__ __device__ __forceinline__ void stage_rc(int b, int& R, int& C) { const int st = b / 1024, sb = b % 1024, swz = sb ^ (((sb >> 9) & 1) << 5); R = (st >> 1) * 16 + swz / 64; C = (st & 1) * 32 + (swz % 64) / 2; }
__host__ __device__ __forceinline__ int perm32(int rho) { const int n = rho >> 4, i = rho & 15; return 8 * (i >> 2) + 4 * n + (i & 3); }

struct Unit { int pm, pn, ks; };
struct Gemm { const bf16_t* A; const bf16_t* Bt; int M, N, K, lda, ldb; };

struct StaticOrder {
    int nM, nN, nwg, G, c;
    __host__ __device__ void init(int M, int N, int G_, int c_) { nM = M / BM; nN = N / BM; nwg = nM * nN; G = G_; c = c_; }
    __host__ __device__ bool next(int i, Unit& u) const {
        const long L = (long)i * G + c; if (L >= nwg) return false;
        int wgid = (int)L; { const int q = nwg / NXCD, r = nwg % NXCD, xcd = wgid % NXCD, off = wgid / NXCD; wgid = (xcd < r ? xcd * (q + 1) : r * (q + 1) + (xcd - r) * q) + off; }
        const int nig = WGM * nN, gid = wgid / nig, fm = gid * WGM, gsz = (nM - fm) < WGM ? (nM - fm) : WGM;
        u.pm = fm + ((wgid % nig) % gsz); u.pn = (wgid % nig) / gsz; u.ks = 0; return true;
    }
    __device__ __forceinline__ void a_ready(const Unit&) const {}
    __device__ __forceinline__ void done(const Unit&) const {}
};
__device__ __forceinline__ unsigned cvt_pk_bf16(float lo, float hi) { unsigned r; asm volatile("v_cvt_pk_bf16_f32 %0, %1, %2" : "=v"(r) : "v"(lo), "v"(hi)); return r; }
typedef float f32x2 __attribute__((ext_vector_type(2)));
__device__ __forceinline__ f32x2 gelu_pk(f32x2 v) {
    const f32x2 av = __builtin_elementwise_abs(v), d = av * 0.2316418882f + 1.0f;
    f32x2 t; t.x = __builtin_amdgcn_rcpf(d.x); t.y = __builtin_amdgcn_rcpf(d.y);
    f32x2 q = t * 0.5307027145f + (-0.7265760135f); q = q * t + 0.7107068705f; q = q * t + (-0.142248368f); q = q * t + 0.127414796f; q = q * t;
    const f32x2 s = (v * v) * (-0.72134752044f);
    f32x2 e; e.x = __builtin_amdgcn_exp2f(s.x); e.y = __builtin_amdgcn_exp2f(s.y);
    const f32x2 m = v * (q * e), r = v - m;
    f32x2 o; o.x = v.x < 0.f ? m.x : r.x; o.y = v.y < 0.f ? m.y : r.y; return o;
}

struct EpiF32 {
    static constexpr bool PERM = false, AFTER_DRAIN = false;
    float* C; int ldc; const float* bias;
    __device__ __forceinline__ void operator()(const f32x4 (&acc)[2][2][4][2], const Unit& u, int wr, int wc, int fr, int fq) const {
        const int row0 = u.pm * BM + wr * 64 + fr, col0 = u.pn * BM + wc * 32 + 4 * fq;
        f32x4 bv[2][2];
#pragma unroll
        for (int bj = 0; bj < 2; ++bj)
#pragma unroll
            for (int n = 0; n < 2; ++n) bv[bj][n] = bias ? *(const f32x4*)(bias + col0 + bj * HALF + n * 16) : (f32x4){0.f, 0.f, 0.f, 0.f};
#pragma unroll
        for (int ai = 0; ai < 2; ++ai)
#pragma unroll
            for (int m = 0; m < 4; ++m) { float* rowp = C + (size_t)(row0 + ai * HALF + m * 16) * ldc + col0;
#pragma unroll
                for (int bj = 0; bj < 2; ++bj)
#pragma unroll
                    for (int n = 0; n < 2; ++n) *(f32x4*)(rowp + bj * HALF + n * 16) = acc[ai][bj][m][n] + bv[bj][n]; }
    }
};
template <int ACT  > struct EpiBf16 {
    static constexpr bool PERM = true, AFTER_DRAIN = false;
    bf16_t* O; int ldc; const float* bias; int split_cols; size_t split_stride;
    __device__ __forceinline__ void operator()(const f32x4 (&acc)[2][2][4][2], const Unit& u, int wr, int wc, int fr, int fq) const {
        const int row0 = u.pm * BM + wr * 64 + fr; int colt = u.pn * BM; bf16_t* base = O;
        if (split_cols) { const int t = colt / split_cols; base += (size_t)t * split_stride; colt -= t * split_cols; }
        const int col0 = colt + wc * 32 + 8 * fq, bcol0 = u.pn * BM + wc * 32 + 8 * fq;
        f32x4 bv[2][2];
#pragma unroll
        for (int bj = 0; bj < 2; ++bj)
#pragma unroll
            for (int n = 0; n < 2; ++n) bv[bj][n] = bias ? *(const f32x4*)(bias + bcol0 + bj * HALF + 4 * n) : (f32x4){0.f, 0.f, 0.f, 0.f};
#pragma unroll
        for (int ai = 0; ai < 2; ++ai)
#pragma unroll
            for (int m = 0; m < 4; ++m) { bf16_t* rowp = base + (size_t)(row0 + ai * HALF + m * 16) * ldc + col0;
#pragma unroll
                for (int bj = 0; bj < 2; ++bj) { f32x4 v0 = acc[ai][bj][m][0] + bv[bj][0], v1 = acc[ai][bj][m][1] + bv[bj][1];
                    if (ACT == 1) { f32x2 a = gelu_pk((f32x2){v0[0], v0[1]}), b = gelu_pk((f32x2){v0[2], v0[3]}), c = gelu_pk((f32x2){v1[0], v1[1]}), d = gelu_pk((f32x2){v1[2], v1[3]});
                        v0 = (f32x4){a.x, a.y, b.x, b.y}; v1 = (f32x4){c.x, c.y, d.x, d.y}; }
                    if (ACT == 2) {
#pragma unroll
                        for (int j = 0; j < 4; ++j) { v0[j] = 0.5f * v0[j] * (1.0f + erff(v0[j] * 0.70710678f)); v1[j] = 0.5f * v1[j] * (1.0f + erff(v1[j] * 0.70710678f)); } }
                    u32x4 w; w.x = cvt_pk_bf16(v0[0], v0[1]); w.y = cvt_pk_bf16(v0[2], v0[3]); w.z = cvt_pk_bf16(v1[0], v1[1]); w.w = cvt_pk_bf16(v1[2], v1[3]);
                    *(u32x4*)(rowp + bj * HALF) = w; } }
    }
};
template <class Epi, class Sched, bool STAMP = false>
__device__ __forceinline__ void gemm_phase(PG8_LAS unsigned char* lds, const Gemm g, const Sched& S, const Epi& E, unsigned long long* stamps) {
    int tid_ = threadIdx.x; asm volatile("" : "+v"(tid_));
    const int tid = tid_, wid = __builtin_amdgcn_readfirstlane(tid >> 6), lane = tid & 63, wr = wid >> 2, wc = wid & 3, fr = lane & 15, fq = lane >> 4;
    const int K = g.K, nt = K / BK;
    int ts_lo = 0, ts_hi = 0, nts = 0; const unsigned long long rt_entry = STAMP ? (unsigned long long)wall_clock64() : 0ull;
#define PG8_STAMP() do { if (STAMP && wid == 0 && nts < 64) { const unsigned long long _c = (unsigned long long)clock64(); \
        ts_lo = (lane == nts) ? (int)(unsigned)_c : ts_lo; ts_hi = (lane == nts) ? (int)(unsigned)(_c >> 32) : ts_hi; ++nts; } } while (0)
    PG8_STAMP();
    unsigned voffA[2], voffB[2];
#pragma unroll
    for (int i = 0; i < 2; ++i) { int R, C; stage_rc(tid * 16 + i * 8192, R, C); const int Rb = Epi::PERM ? ((R & ~31) + perm32(R & 31)) : R;
        voffA[i] = (unsigned)(R * g.lda + C) * 2u; voffB[i] = (unsigned)(Rb * g.ldb + C) * 2u; }
    const size_t kstep = (size_t)(BK * 2);
    const size_t hstepA = (size_t)HALF * g.lda * 2, hstepB = (size_t)HALF * g.ldb * 2;
    const size_t tstepA = 2 * hstepA, tstepB = 2 * hstepB, sstep = (size_t)K * 2;
    const unsigned ldsw = (unsigned)wid * 1024u;
    const int aoff = lds_byte(wr * 64 + fr, fq * 8), boff = lds_byte(wc * 32 + fr, fq * 8);
#define PG8_SA(b, h) (((b) * 2 + (h)) * HTB)
#define PG8_SB(b, h) ((4 + (b) * 2 + (h)) * HTB)
#define PG8_STAGE(bufoff, gbase, voff) do { _Pragma("unroll") for (int _i = 0; _i < 2; ++_i) \
        __builtin_amdgcn_global_load_lds((const unsigned*)((const char*)(gbase) + (voff)[_i]), (PG8_LAS unsigned*)(lds + (bufoff) + ldsw + _i * 8192), 16, 0, 0); } while (0)
#define PG8_LDA(dst, b, h) do { _Pragma("unroll") for (int m = 0; m < 4; ++m) _Pragma("unroll") for (int k = 0; k < 2; ++k) dst[m][k] = *(const PG8_LAS bf16x8*)(lds + PG8_SA(b, h) + aoff + m * 2048 + k * 1024); } while (0)
#define PG8_LDB(dst, b, h) do { _Pragma("unroll") for (int n = 0; n < 2; ++n) _Pragma("unroll") for (int k = 0; k < 2; ++k) dst[n][k] = *(const PG8_LAS bf16x8*)(lds + PG8_SB(b, h) + boff + n * 2048 + k * 1024); } while (0)
#define PG8_MMA(ai, bj, At, Bt) do { __builtin_amdgcn_s_setprio(1); _Pragma("unroll") for (int m = 0; m < 4; ++m) _Pragma("unroll") for (int n = 0; n < 2; ++n) _Pragma("unroll") for (int k = 0; k < 2; ++k) \
        acc[ai][bj][m][n] = __builtin_amdgcn_mfma_f32_16x16x32_bf16(Bt[n][k], At[m][k], acc[ai][bj][m][n], 0, 0, 0); __builtin_amdgcn_s_setprio(0); } while (0)
#define PG8_WAIT_V(n) asm volatile("s_waitcnt vmcnt(" #n ")" ::: "memory")
#define PG8_WAIT_L(n) asm volatile("s_waitcnt lgkmcnt(" #n ")" ::: "memory")
#define PG8_BAR __builtin_amdgcn_s_barrier()
#define PG8_SCHED __builtin_amdgcn_sched_barrier(0)
    Unit cur, nxt; int ui = 0;
    if (!S.next(0, cur)) return;
    f32x4 acc[2][2][4][2];
#pragma unroll
    for (int a = 0; a < 2; ++a)
#pragma unroll
        for (int b = 0; b < 2; ++b)
#pragma unroll
            for (int m = 0; m < 4; ++m)
#pragma unroll
                for (int n = 0; n < 2; ++n) acc[a][b][m][n] = (f32x4){0.f, 0.f, 0.f, 0.f};
    bf16x8 At[4][2], B0[2][2], B1[2][2];
    const char* cA = (const char*)g.A + (size_t)cur.pm * tstepA + (size_t)cur.ks * sstep; const char* cB = (const char*)g.Bt + (size_t)cur.pn * tstepB + (size_t)cur.ks * sstep;
    S.a_ready(cur);
    PG8_STAGE(PG8_SB(0, 0), cB, voffB); PG8_STAGE(PG8_SA(0, 0), cA, voffA); PG8_STAGE(PG8_SB(0, 1), cB + hstepB, voffB); PG8_STAGE(PG8_SA(0, 1), cA + hstepA, voffA);
    if (wr == 1) PG8_BAR;
    PG8_WAIT_V(4); PG8_BAR;
    PG8_STAGE(PG8_SB(1, 0), cB + kstep, voffB); PG8_STAGE(PG8_SA(1, 0), cA + kstep, voffA); PG8_STAGE(PG8_SB(1, 1), cB + hstepB + kstep, voffB);
    PG8_WAIT_V(6); PG8_BAR;
    PG8_STAMP();
    for (;;) {
        const bool has_next = S.next(ui + 1, nxt);
        const char* nA = has_next ? (const char*)g.A + (size_t)nxt.pm * tstepA + (size_t)nxt.ks * sstep : cA; const char* nB = has_next ? (const char*)g.Bt + (size_t)nxt.pn * tstepB + (size_t)nxt.ks * sstep : cB;
        for (int t = 0; t < nt; t += 2) {
            const bool last = (t == nt - 2);
            const char* a1 = cA + (size_t)(t + 1) * kstep;
            const char* a2 = last ? nA : cA + (size_t)(t + 2) * kstep; const char* b2 = last ? nB : cB + (size_t)(t + 2) * kstep;
            const char* a3 = a2 + kstep; const char* b3 = b2 + kstep;
            if (last && has_next) S.a_ready(nxt);
            PG8_LDB(B0, 0, 0); PG8_SCHED; PG8_LDA(At, 0, 0); PG8_STAGE(PG8_SA(1, 1), a1 + hstepA, voffA);
            PG8_WAIT_L(8); PG8_BAR; PG8_WAIT_L(0); PG8_MMA(0, 0, At, B0); PG8_BAR; PG8_SCHED;
            PG8_LDB(B1, 0, 1); PG8_STAGE(PG8_SB(0, 0), b2, voffB);
            PG8_BAR; PG8_WAIT_L(0); PG8_MMA(0, 1, At, B1); PG8_BAR;
            PG8_LDA(At, 0, 1); PG8_STAGE(PG8_SA(0, 0), a2, voffA);
            PG8_BAR; PG8_WAIT_L(0); PG8_MMA(1, 0, At, B0); PG8_BAR; PG8_SCHED;
            PG8_STAGE(PG8_SB(0, 1), b2 + hstepB, voffB);
            PG8_WAIT_V(6); PG8_BAR; PG8_MMA(1, 1, At, B1); PG8_BAR;
            PG8_LDB(B0, 1, 0); PG8_SCHED; PG8_LDA(At, 1, 0); PG8_STAGE(PG8_SA(0, 1), a2 + hstepA, voffA);
            PG8_WAIT_L(8); PG8_BAR; PG8_WAIT_L(0); PG8_MMA(0, 0, At, B0); PG8_BAR; PG8_SCHED;
            PG8_LDB(B1, 1, 1); PG8_STAGE(PG8_SB(1, 0), b3, voffB);
            PG8_BAR; PG8_WAIT_L(0); PG8_MMA(0, 1, At, B1); PG8_BAR;
            PG8_LDA(At, 1, 1); PG8_STAGE(PG8_SA(1, 0), a3, voffA);
            PG8_BAR; PG8_WAIT_L(0); PG8_MMA(1, 0, At, B0); PG8_BAR; PG8_SCHED;
            PG8_STAGE(PG8_SB(1, 1), b3 + hstepB, voffB);
            PG8_WAIT_V(6); PG8_BAR; PG8_MMA(1, 1, At, B1); PG8_BAR;
        }
        PG8_STAMP();
        if constexpr (!Epi::AFTER_DRAIN) { E(acc, cur, wr, wc, fr, fq); S.done(cur); }
        PG8_STAMP();
        if (!has_next) break;
#pragma unroll
        for (int a = 0; a < 2; ++a)
#pragma unroll
            for (int b = 0; b < 2; ++b)
#pragma unroll
                for (int m = 0; m < 4; ++m)
#pragma unroll
                    for (int n = 0; n < 2; ++n) acc[a][b][m][n] = (f32x4){0.f, 0.f, 0.f, 0.f};
        cur = nxt; cA = nA; cB = nB; ++ui;
    }
    PG8_WAIT_V(0);
    if (wr == 0) PG8_BAR;
    PG8_BAR;
    if constexpr (Epi::AFTER_DRAIN) { E.fused(acc, cur, wr, wc, fr, fq, lds, wid, lane); S.done(cur); }
    PG8_STAMP();
    if (STAMP && wid == 0) { stamps[lane] = lane < nts ? (((unsigned long long)(unsigned)ts_hi << 32) | (unsigned)ts_lo) : 0ull;
        if (lane == 62) stamps[62] = rt_entry; if (lane == 63) stamps[63] = (unsigned long long)wall_clock64(); }
#undef PG8_STAMP
#undef PG8_SA
#undef PG8_SB
#undef PG8_STAGE
#undef PG8_LDA
#undef PG8_LDB
#undef PG8_MMA
#undef PG8_WAIT_V
#undef PG8_WAIT_L
#undef PG8_BAR
#undef PG8_SCHED
}
}

#define LAS __attribute__((address_space(3)))
typedef unsigned short bf16_t;
typedef short bf16x8 __attribute__((ext_vector_type(8)));
typedef float f32x4 __attribute__((ext_vector_type(4)));
typedef float f32x2 __attribute__((ext_vector_type(2)));
typedef unsigned u32x4 __attribute__((ext_vector_type(4)));
typedef unsigned u32x2 __attribute__((ext_vector_type(2)));

constexpr int D = 1024, NP = 16384, NS = 512, NTOK = NP + NS, SEQ = 2048, NB = 8, NSB = 128, DEPTH = 4;
constexpr int INW = 2568, NPROJ = 2560, DFF = 2816, NGU = 5632;
constexpr int PC_G = 1536, PC_SSM = 2048, PC_POOL = 2304;
constexpr float EPS = 1e-6f;
constexpr int LDS_BYTES = 163840;

constexpr size_t SZ_WIN = (size_t)NPROJ * D * 2, SZ_WOUT = (size_t)D * D * 2, SZ_WGU = (size_t)NGU * D * 2, SZ_WDN = (size_t)D * DFF * 2;
constexpr size_t SZ_WAB = 8 * D * 4, SZ_GLUT = 256 * 256 * 2, SZ_POOLT = 4 * 64 * 64 * 2, SZ_SSMK = 16 * 64 * 4 * 4, SZ_BBAR = 16 * 64 * 32 * 4;
constexpr size_t WS_WIN = 0;
constexpr size_t WS_WOUT = WS_WIN + DEPTH * SZ_WIN;
constexpr size_t WS_WGU = WS_WOUT + DEPTH * SZ_WOUT;
constexpr size_t WS_WDN = WS_WGU + DEPTH * SZ_WGU;
constexpr size_t WS_WAB = WS_WDN + DEPTH * SZ_WDN;
constexpr size_t WS_GLUT = WS_WAB + DEPTH * SZ_WAB;
constexpr size_t WS_POOLT = WS_GLUT + DEPTH * SZ_GLUT;
constexpr size_t WS_SSMK = WS_POOLT + DEPTH * SZ_POOLT;
constexpr size_t WS_BBAR = WS_SSMK + DEPTH * SZ_SSMK;
constexpr size_t WS_H = WS_BBAR + DEPTH * SZ_BBAR;
constexpr size_t WS_AB = WS_H + (size_t)NTOK * D * 2;
constexpr size_t WS_MIX = WS_AB + (size_t)NTOK * 8 * 4;
constexpr size_t WS_MIXO = WS_MIX + (size_t)NTOK * D * 2;
constexpr size_t WS_SSME = WS_MIXO + (size_t)NTOK * D * 4;
constexpr size_t WS_PROJ = WS_SSME + (size_t)8 * 32 * 16 * 64 * 2 * 4;
constexpr size_t WS_DW = WS_PROJ + (size_t)NTOK * NPROJ * 2;
constexpr size_t WS_DKC = WS_DW + (size_t)1024 * 8192 * 4;
constexpr size_t WS_DQD = WS_DKC + (size_t)1024 * 8192 * 2;
constexpr size_t WS_DQK = WS_DQD + (size_t)1024 * 8192 * 2;
constexpr size_t WS_DKT = WS_DQK + (size_t)1024 * 4096 * 2;
constexpr size_t WS_DGL = WS_DKT + (size_t)1024 * 8192 * 2;
constexpr size_t WS_DGS = WS_DGL + 4096;
constexpr size_t WS_BAR = WS_DGS + (size_t)1024 * 8192 * 2;
constexpr size_t WS_PARTS = WS_BAR + 16384;
constexpr size_t WS_RSC = WS_PARTS + (size_t)11 * 512 * 1024 * 4;
constexpr size_t WS_END = WS_RSC + (size_t)NTOK * 4;
constexpr size_t WS_HID = WS_PROJ;
static_assert(WS_HID + (size_t)NTOK * DFF * 2 <= WS_END, "HID overlay");
static_assert(WS_H % 256 == 0 && WS_PROJ % 256 == 0 && WS_DW % 256 == 0, "align");

constexpr size_t O_YP = 0, O_YS = O_YP + (size_t)NP * D, O_DP = O_YS + (size_t)NS * D, O_CP = O_DP + (size_t)DEPTH * 8 * 4 * 16384,
                 O_REP = O_CP + (size_t)DEPTH * 8 * 3 * 1536, O_IMP = O_REP + (size_t)DEPTH * 8 * 1024, O_PP = O_IMP + (size_t)DEPTH * 8 * 1024,
                 O_DS = O_PP + (size_t)DEPTH * 8 * 15 * 256, O_CS = O_DS + (size_t)DEPTH * 128 * 4 * 16384, O_RES = O_CS + (size_t)DEPTH * 128 * 3 * 1536,
                 O_IMS = O_RES + (size_t)DEPTH * 128 * 1024, O_PS = O_IMS + (size_t)DEPTH * 128 * 1024, O_END = O_PS + (size_t)DEPTH * 128 * 15 * 256;

struct Args { const float* in[32]; float* out; unsigned char* ws; int ph_lo, ph_hi; };
typedef const float* cfp_t;
typedef __attribute__((address_space(4))) const unsigned char* kptr_t;
struct InProxy { __device__ __forceinline__ const float* operator[](int i) const {
    kptr_t p = (kptr_t)__builtin_amdgcn_kernarg_segment_ptr(); asm volatile("" : "+s"(p)); return *(__attribute__((address_space(4))) const cfp_t*)(p + 8 * i); } };
struct DevArgs { InProxy in; float* out; unsigned char* ws; int ph_lo, ph_hi; };
enum { I_XP = 0, I_XS, I_SDELTA, I_SCONV, I_SRE, I_SIM, I_SPOOL, I_NMPRE, I_NMPOST, I_NFPRE, I_NFPOST, I_WIN, I_CONVW, I_ALOG, I_DTB, I_ONORM,
       I_ARE, I_AIM, I_LOGDT, I_BRE, I_BIM, I_CRE, I_CIM, I_SSMD, I_GLUW, I_GLUB, I_POOLW, I_POOLS, I_WOUT, I_WG, I_WU, I_WD };

__device__ __forceinline__ unsigned f2bf(float f) { unsigned u = __float_as_uint(f); return (u + 0x7fffu + ((u >> 16) & 1u)) >> 16; }
__device__ __forceinline__ float bf2f(unsigned b) { return __uint_as_float(b << 16); }
__device__ __forceinline__ unsigned pk2(float lo, float hi) { return f2bf(lo) | (f2bf(hi) << 16); }
template <int CTRL> __device__ __forceinline__ float dpp_f(float v) { return __builtin_bit_cast(float, __builtin_amdgcn_update_dpp(0, __builtin_bit_cast(int, v), CTRL, 0xF, 0xF, true)); }
__device__ __forceinline__ float row_sum8(float v) { v += dpp_f<0xB1>(v); v += dpp_f<0x4E>(v); v += dpp_f<0x141>(v); return v; }
__device__ __forceinline__ float row_sum16(float v) { v = row_sum8(v); v += dpp_f<0x140>(v); return v; }
__device__ __forceinline__ float wave_sum(float v) { v = row_sum16(v); v += __shfl_xor(v, 16); v += __shfl_xor(v, 32); return v; }
__device__ __forceinline__ float silu_f(float y) { return y * __builtin_amdgcn_rcpf(1.f + __expf(-y)); }
__device__ __forceinline__ float sigmoid_f(float y) { return __builtin_amdgcn_rcpf(1.f + __expf(-y)); }
__device__ __forceinline__ float gelu_tanh_f(float x) { const float z = 0.7978845608028654f * (x + 0.044715f * x * x * x);
    const float t = 1.f - 2.f * __builtin_amdgcn_rcpf(1.f + __expf(2.f * z)); return 0.5f * x * (1.f + t); }
__device__ __forceinline__ f32x4 mfma16(bf16x8 a, bf16x8 b, f32x4 c) { return __builtin_amdgcn_mfma_f32_16x16x32_bf16(a, b, c, 0, 0, 0); }
#define LDS_FENCE() asm volatile("s_waitcnt lgkmcnt(0)" ::: "memory")

struct EpiSwiGLU {
    static constexpr bool PERM = false, AFTER_DRAIN = false;
    bf16_t* O; int ldc; const float* rs;
    __device__ __forceinline__ void operator()(const pg8::f32x4 (&acc)[2][2][4][2], const pg8::Unit& u, int wr, int wc, int fr, int fq) const {
        const int row0 = u.pm * 256 + wr * 64 + fr, hid0 = u.pn * 128 + wc * 16 + 4 * fq;
#pragma unroll
        for (int ai = 0; ai < 2; ++ai)
#pragma unroll
            for (int m = 0; m < 4; ++m) { const float sc = rs[row0 + ai * 128 + m * 16]; bf16_t* rowp = O + (size_t)(row0 + ai * 128 + m * 16) * ldc + hid0;
#pragma unroll
                for (int bj = 0; bj < 2; ++bj) { const pg8::f32x4 g = acc[ai][bj][m][0] * sc, v = acc[ai][bj][m][1] * sc;
                    u32x2 w; w.x = pg8::cvt_pk_bf16(silu_f(g[0]) * v[0], silu_f(g[1]) * v[1]); w.y = pg8::cvt_pk_bf16(silu_f(g[2]) * v[2], silu_f(g[3]) * v[3]);
                    *(u32x2*)(rowp + bj * 64) = w; } }
    }
};

#define XB_TMO      128
#define XB_XCNT(j)  (256  + 64 * (j))
#define XB_XSUB(j)  (1280 + 64 * (j))
#define XB_XGEN(j)  (2304 + 64 * (j))
#define XB_TOP      3328
#define XB_TOPGEN   3392
#define XCD_BAR_WORDS 3456
#define XB_SPIN_CAP (1u << 18)

__device__ __forceinline__ unsigned xb_ld(unsigned* p)              { return __hip_atomic_load(p, __ATOMIC_RELAXED, __HIP_MEMORY_SCOPE_AGENT); }
__device__ __forceinline__ unsigned xb_add(unsigned* p, unsigned v) { return __hip_atomic_fetch_add(p, v, __ATOMIC_RELAXED, __HIP_MEMORY_SCOPE_AGENT); }
__device__ __forceinline__ unsigned xb_xcc_id() { return (unsigned)__builtin_amdgcn_s_getreg((3 << 11) | 20) & 0xFu; }
#define XB_SPIN(cond, bar) do { unsigned _sp = 0; while (cond) { __builtin_amdgcn_s_sleep(1); \
    if ((++_sp & 255u) == 0u) { if (xb_ld(&(bar)[XB_TMO])) break; if (_sp > XB_SPIN_CAP) { atomicAdd(&(bar)[XB_TMO], 1u); break; } } } } while (0)

struct XcdBarrier {
    unsigned* bar; unsigned x;
    volatile LAS unsigned* st;
};

__device__ __forceinline__ XcdBarrier xcd_barrier_post(unsigned* bar, volatile LAS unsigned* st) {
    XcdBarrier b; b.bar = bar; b.x = xb_xcc_id(); b.st = st;
    if (threadIdx.x == 0) (void)xb_add(&bar[XB_XCNT(b.x)], 1u);
    return b;
}
__device__ __forceinline__ void xcd_barrier_complete(unsigned* bar, unsigned x, unsigned& nloc, unsigned& nx) {
    const unsigned G = gridDim.x * gridDim.y * gridDim.z;
    unsigned sum, cnt, mine, sp = 0u;
    for (;;) {
        sum = 0u; cnt = 0u; mine = 0u;
#pragma unroll
        for (unsigned j = 0; j < 16; ++j) { const unsigned c = xb_ld(&bar[XB_XCNT(j)]); sum += c; cnt += (c > 0u) ? 1u : 0u; mine = (j == x) ? c : mine; }
        if (sum == G) break;
        __builtin_amdgcn_s_sleep(1);
        if ((++sp & 255u) == 0u) { if (xb_ld(&bar[XB_TMO])) break; if (sp > XB_SPIN_CAP) { atomicAdd(&bar[XB_TMO], 1u); break; } }
    }
    nloc = mine > 0u ? mine : 1u; nx = cnt > 0u ? cnt : 1u;
}

__device__ __forceinline__ void xcd_barrier(const XcdBarrier& b) {
    asm volatile("s_waitcnt vmcnt(0)" ::: "memory");
    __syncthreads();
    if (threadIdx.x == 0) {
        unsigned* bar = b.bar; asm volatile("" : "+s"(bar));
        __builtin_amdgcn_s_waitcnt(0);
        unsigned nloc = b.st[0], nx = b.st[1];
        if (nloc == 0u) { xcd_barrier_complete(bar, b.x, nloc, nx); b.st[0] = nloc; b.st[1] = nx; }
        const unsigned old = xb_add(&bar[XB_XSUB(b.x)], 1u);
        const unsigned gen = old / nloc;
        if (old + 1u == (gen + 1u) * nloc) {
            __builtin_amdgcn_fence(__ATOMIC_RELEASE, "agent");
            asm volatile("s_waitcnt vmcnt(0)" ::: "memory");
            const unsigned og = xb_add(&bar[XB_TOP], 1u);
            const unsigned tg = og / nx;
            if (og + 1u == (tg + 1u) * nx) xb_add(&bar[XB_TOPGEN], 1u);
            else XB_SPIN(xb_ld(&bar[XB_TOPGEN]) == tg, bar);
            __builtin_amdgcn_fence(__ATOMIC_ACQUIRE, "agent");
            xb_add(&bar[XB_XGEN(b.x)], 1u);
            asm volatile("s_waitcnt vmcnt(0)" ::: "memory");
        } else {
            XB_SPIN(xb_ld(&bar[XB_XGEN(b.x)]) == gen, bar);
            __builtin_amdgcn_fence(__ATOMIC_ACQUIRE, "agent");
            asm volatile("s_waitcnt vmcnt(0)" ::: "memory");
        }
    }
    __syncthreads();
}

struct EpiBf16Scale {
    static constexpr bool PERM = true, AFTER_DRAIN = false;
    bf16_t* O; int ldc; const float* rs;
    __device__ __forceinline__ void operator()(const pg8::f32x4 (&acc)[2][2][4][2], const pg8::Unit& u, int wr, int wc, int fr, int fq) const {
        const int row0 = u.pm * 256 + wr * 64 + fr, col0 = u.pn * 256 + wc * 32 + 8 * fq;
#pragma unroll
        for (int ai = 0; ai < 2; ++ai)
#pragma unroll
            for (int m = 0; m < 4; ++m) { const int row = row0 + ai * 128 + m * 16; const float sc = rs[row]; bf16_t* rowp = O + (size_t)row * ldc + col0;
#pragma unroll
                for (int bj = 0; bj < 2; ++bj) { const pg8::f32x4 v0 = acc[ai][bj][m][0] * sc, v1 = acc[ai][bj][m][1] * sc;
                    u32x4 w; w.x = pg8::cvt_pk_bf16(v0[0], v0[1]); w.y = pg8::cvt_pk_bf16(v0[2], v0[3]); w.z = pg8::cvt_pk_bf16(v1[0], v1[1]); w.w = pg8::cvt_pk_bf16(v1[2], v1[3]);
                    *(u32x4*)(rowp + bj * 128) = w; } }
    }
};
struct SliceOrder {
    int nunits, G, c;
    __device__ __forceinline__ bool next(int i, pg8::Unit& u) const { const int L = i * G + c; if (L >= nunits) return false; const int t = L & 7; u.pm = t >> 2; u.pn = t & 3; u.ks = L >> 3; return true; }
    __device__ __forceinline__ void a_ready(const pg8::Unit&) const {}
    __device__ __forceinline__ void done(const pg8::Unit&) const {}
};
struct EpiF32Part {
    static constexpr bool PERM = false, AFTER_DRAIN = false;
    float* C;
    __device__ __forceinline__ void operator()(const pg8::f32x4 (&acc)[2][2][4][2], const pg8::Unit& u, int wr, int wc, int fr, int fq) const {
        const int row0 = u.pm * 256 + wr * 64 + fr, col0 = u.pn * 256 + wc * 32 + 4 * fq; float* base = C + (size_t)u.ks * (512 * 1024);
#pragma unroll
        for (int ai = 0; ai < 2; ++ai)
#pragma unroll
            for (int m = 0; m < 4; ++m) { float* rowp = base + (size_t)(row0 + ai * 128 + m * 16) * 1024 + col0;
#pragma unroll
                for (int bj = 0; bj < 2; ++bj)
#pragma unroll
                    for (int n = 0; n < 2; ++n) *(pg8::f32x4*)(rowp + bj * 128 + n * 16) = acc[ai][bj][m][n]; }
    }
};

struct SrcIn { const float* w; const float* nw; __device__ __forceinline__ float operator()(int k, int n) const { return w[(size_t)k * INW + (n < 1536 ? n : n + 8)] * nw[k]; } };
struct SrcPlain { const float* w; int N; __device__ __forceinline__ float operator()(int k, int n) const { return w[(size_t)k * N + n]; } };
struct SrcGU { const float* g; const float* u; const float* nw; __device__ __forceinline__ float operator()(int k, int n) const { const int r = n & 31, hid = (n >> 5) * 16 + (r & 15); const long long du = (r < 16) ? 0ll : (long long)(u - g); return g[du + (long long)k * DFF + hid] * nw[k]; } };
template <class Src> __device__ __forceinline__ void transpose_item(const Src& src, int K, bf16_t* WT, int nblk, LAS float* scr, int item, int lane) {
    const int kb = item / nblk, nb = item % nblk, k0 = 64 * kb, n0 = 32 * nb;
#pragma unroll 8
    for (int i = 0; i < 32; ++i) { const int kk = 2 * i + (lane >> 5); scr[kk * 33 + (lane & 31)] = src(k0 + kk, n0 + (lane & 31)); }
    LDS_FENCE();
    const int c = lane & 7;
#pragma unroll
    for (int j = 0; j < 4; ++j) { const int n = (lane >> 3) + 8 * j; const LAS float* s = scr + (8 * c) * 33 + n;
        u32x4 o; o.x = pk2(s[0 * 33], s[1 * 33]); o.y = pk2(s[2 * 33], s[3 * 33]); o.z = pk2(s[4 * 33], s[5 * 33]); o.w = pk2(s[6 * 33], s[7 * 33]);
        *(u32x4*)(WT + (size_t)(n0 + n) * K + k0 + 8 * c) = o; }
    LDS_FENCE();
}

__device__ __forceinline__ void norm_rows(const float* T, const float* wt, const float* X0, const float* X1, float* Xout, const float* wh, float* RSC,
                                          const float* Wab, float* AB, int gw, int NGW, int lane, const float* Tp = nullptr, int ns = 0,
                                          const bf16_t* Xbin = nullptr, bf16_t* Xbout = nullptr) {
#pragma unroll 1
    for (int m = gw; m < NTOK; m += NGW) {
        f32x4 x[4], t[4];
        { if (Xbin) {
#pragma unroll
              for (int j = 0; j < 4; ++j) { const u32x2 xb = ((const u32x2*)(Xbin + (size_t)m * D))[lane + 64 * j];
                  x[j] = (f32x4){__uint_as_float(xb.x << 16), __uint_as_float(xb.x & 0xffff0000u), __uint_as_float(xb.y << 16), __uint_as_float(xb.y & 0xffff0000u)}; } }
          else { const float* xr = (X1 && m >= NP) ? X1 + (size_t)(m - NP) * D : X0 + (size_t)m * D;
#pragma unroll
              for (int j = 0; j < 4; ++j) x[j] = ((const f32x4*)xr)[lane + 64 * j]; }
          if (T && !(Tp && m >= NP)) {
#pragma unroll
              for (int j = 0; j < 4; ++j) { const u32x2 tb = ((const u32x2*)((const bf16_t*)T + (size_t)m * D))[lane + 64 * j];
                  t[j] = (f32x4){__uint_as_float(tb.x << 16), __uint_as_float(tb.x & 0xffff0000u), __uint_as_float(tb.y << 16), __uint_as_float(tb.y & 0xffff0000u)}; } } }
        if (T) {
            float ss = 0.f;
            if (Tp && m >= NP) {
#pragma unroll
                for (int j = 0; j < 4; ++j) { f32x4 a = {0.f, 0.f, 0.f, 0.f}; for (int q = 0; q < ns; ++q) a += ((const f32x4*)(Tp + (size_t)q * (512 * 1024) + (size_t)(m - NP) * D))[lane + 64 * j]; t[j] = a; } }
#pragma unroll
            for (int j = 0; j < 4; ++j) ss += (t[j].x * t[j].x + t[j].y * t[j].y) + (t[j].z * t[j].z + t[j].w * t[j].w);
            ss = wave_sum(ss); const float r = rsqrtf(ss * (1.f / D) + EPS);
#pragma unroll
            for (int j = 0; j < 4; ++j) { const f32x4 w = ((const f32x4*)wt)[lane + 64 * j]; x[j] += t[j] * r * w; }
        }
        if (Xout) {
#pragma unroll
            for (int j = 0; j < 4; ++j) ((f32x4*)(Xout + (size_t)m * D))[lane + 64 * j] = x[j];
        }
        if (Xbout) {
#pragma unroll
            for (int j = 0; j < 4; ++j) { u32x2 o; o.x = pg8::cvt_pk_bf16(x[j].x, x[j].y); o.y = pg8::cvt_pk_bf16(x[j].z, x[j].w); ((u32x2*)(Xbout + (size_t)m * D))[lane + 64 * j] = o; }
        }
        if (RSC) {
            float ss = 0.f;
#pragma unroll
            for (int j = 0; j < 4; ++j) ss += (x[j].x * x[j].x + x[j].y * x[j].y) + (x[j].z * x[j].z + x[j].w * x[j].w);
            ss = wave_sum(ss); const float r = rsqrtf(ss * (1.f / D) + EPS);
            if (lane == 0) RSC[m] = r;
            f32x4 hv[4];
#pragma unroll
            for (int j = 0; j < 4; ++j) { const f32x4 w = ((const f32x4*)wh)[lane + 64 * j]; hv[j] = x[j] * r * w; }
            if (Wab) {
                float d[8];
#pragma unroll
                for (int c = 0; c < 8; ++c) { float dd = 0.f;
#pragma unroll
                    for (int j = 0; j < 4; ++j) { const f32x4 w = ((const f32x4*)(Wab + c * D))[lane + 64 * j]; dd += (hv[j].x * w.x + hv[j].y * w.y) + (hv[j].z * w.z + hv[j].w * w.w); }
                    d[c] = dd; }
#pragma unroll
                for (int c = 0; c < 8; ++c) d[c] = row_sum16(d[c]);
#pragma unroll
                for (int o = 16; o < 64; o <<= 1) {
#pragma unroll
                    for (int c = 0; c < 8; ++c) d[c] += __shfl_xor(d[c], o); }
                if (lane == 0) { f32x4 o0 = {d[0], d[1], d[2], d[3]}, o1 = {d[4], d[5], d[6], d[7]}; *(f32x4*)(AB + (size_t)m * 8) = o0; *(f32x4*)(AB + (size_t)m * 8 + 4) = o1; }
            }
        }
    }
}

__device__ __forceinline__ void norm_rows_pf(const float* T, const float* wt, bf16_t* XB, float* RSC,
                                             int gw, int NGW, int lane, const float* Tp, int ns) {
    u32x2 xn[4], tn[4];
#define NR_LOAD(mm) do { const int _m = (mm); \
        _Pragma("unroll") for (int j = 0; j < 4; ++j) xn[j] = ((const u32x2*)(XB + (size_t)_m * D))[lane + 64 * j]; \
        if (_m < NP) { _Pragma("unroll") for (int j = 0; j < 4; ++j) tn[j] = ((const u32x2*)((const bf16_t*)T + (size_t)_m * D))[lane + 64 * j]; } } while (0)
    if (gw < NTOK) NR_LOAD(gw);
#pragma unroll 1
    for (int m = gw; m < NTOK; m += NGW) {
        f32x4 x[4], t[4];
#pragma unroll
        for (int j = 0; j < 4; ++j) { x[j] = (f32x4){__uint_as_float(xn[j].x << 16), __uint_as_float(xn[j].x & 0xffff0000u), __uint_as_float(xn[j].y << 16), __uint_as_float(xn[j].y & 0xffff0000u)};
            t[j] = (f32x4){__uint_as_float(tn[j].x << 16), __uint_as_float(tn[j].x & 0xffff0000u), __uint_as_float(tn[j].y << 16), __uint_as_float(tn[j].y & 0xffff0000u)}; }
        if (m + NGW < NTOK) NR_LOAD(m + NGW);
        if (m >= NP) {
#pragma unroll
            for (int j = 0; j < 4; ++j) { f32x4 a = {0.f, 0.f, 0.f, 0.f}; for (int q = 0; q < ns; ++q) a += ((const f32x4*)(Tp + (size_t)q * (512 * 1024) + (size_t)(m - NP) * D))[lane + 64 * j]; t[j] = a; } }
        float ss = 0.f;
#pragma unroll
        for (int j = 0; j < 4; ++j) ss += (t[j].x * t[j].x + t[j].y * t[j].y) + (t[j].z * t[j].z + t[j].w * t[j].w);
        ss = wave_sum(ss); const float r = rsqrtf(ss * (1.f / D) + EPS);
#pragma unroll
        for (int j = 0; j < 4; ++j) { const f32x4 w = ((const f32x4*)wt)[lane + 64 * j]; x[j] += t[j] * r * w; }
#pragma unroll
        for (int j = 0; j < 4; ++j) { u32x2 o; o.x = pg8::cvt_pk_bf16(x[j].x, x[j].y); o.y = pg8::cvt_pk_bf16(x[j].z, x[j].w); ((u32x2*)(XB + (size_t)m * D))[lane + 64 * j] = o; }
        float s2 = 0.f;
#pragma unroll
        for (int j = 0; j < 4; ++j) s2 += (x[j].x * x[j].x + x[j].y * x[j].y) + (x[j].z * x[j].z + x[j].w * x[j].w);
        s2 = wave_sum(s2); if (lane == 0) RSC[m] = rsqrtf(s2 * (1.f / D) + EPS);
    }
#undef NR_LOAD
}

__device__ __forceinline__ void prologue(const DevArgs& A, LAS unsigned char* lds, int wave, int lane, int gw, int NGW) {
    LAS float* scr = (LAS float*)(lds + wave * 8704);
    constexpr int I_IN = 16 * 80, I_OUT = 16 * 32, I_GU = 16 * 176, I_DN = 44 * 32, I_GLU = 4 * 8, I_POOL = 8, PER = I_IN + I_OUT + I_GU + I_DN + I_GLU + I_POOL;
#pragma unroll 1
    for (int it = gw; it < DEPTH * PER; it += NGW) {
        const int l = it / PER; int r = it % PER;
        if (r < I_IN) { SrcIn s{A.in[I_WIN] + (size_t)l * D * INW, A.in[I_NMPRE] + l * D}; transpose_item(s, D, (bf16_t*)(A.ws + WS_WIN + l * SZ_WIN), NPROJ / 32, scr, r, lane); continue; } r -= I_IN;
        if (r < I_OUT) { SrcPlain s{A.in[I_WOUT] + (size_t)l * D * D, D}; transpose_item(s, D, (bf16_t*)(A.ws + WS_WOUT + l * SZ_WOUT), D / 32, scr, r, lane); continue; } r -= I_OUT;
        if (r < I_GU) { SrcGU s{A.in[I_WG] + (size_t)l * D * DFF, A.in[I_WU] + (size_t)l * D * DFF, A.in[I_NFPRE] + l * D}; transpose_item(s, D, (bf16_t*)(A.ws + WS_WGU + l * SZ_WGU), NGU / 32, scr, r, lane); continue; } r -= I_GU;
        if (r < I_DN) { SrcPlain s{A.in[I_WD] + (size_t)l * DFF * D, D}; transpose_item(s, DFF, (bf16_t*)(A.ws + WS_WDN + l * SZ_WDN), D / 32, scr, r, lane); continue; } r -= I_DN;
        if (r < I_GLU) { SrcPlain s{A.in[I_GLUW] + (size_t)l * 65536, 256}; transpose_item(s, 256, (bf16_t*)(A.ws + WS_GLUT + l * SZ_GLUT), 8, scr, r, lane); continue; } r -= I_GLU;
        { const int g = r >> 1; SrcPlain s{A.in[I_POOLW] + (size_t)(l * 4 + g) * 4096, 64}; transpose_item(s, 64, (bf16_t*)(A.ws + WS_POOLT + l * SZ_POOLT) + g * 4096, 2, scr, r & 1, lane); }
    }
    const int gt = gw * 64 + lane, NT = NGW * 64;
    float* wab = (float*)(A.ws + WS_WAB);
#pragma unroll 1
    for (int i = gt; i < DEPTH * 8 * D; i += NT) { const int l = i / (8 * D), j = (i / D) & 7, k = i % D; wab[i] = A.in[I_WIN][((size_t)l * D + k) * INW + 1536 + j]; }
    float* ssmk = (float*)(A.ws + WS_SSMK); float* bbar = (float*)(A.ws + WS_BBAR);
#pragma unroll 1
    for (int i = gt; i < DEPTH * 16 * 64; i += NT) {
        const int lg = i >> 6;
        const float dt = expf(A.in[I_LOGDT][lg]), ar = A.in[I_ARE][i], ai = A.in[I_AIM][i];
        const float mag = expf(ar * dt);
        float rev = ai * dt * 0.15915494309189535f; rev -= floorf(rev);
        const float sn = __builtin_amdgcn_sinf(rev), cs = __builtin_amdgcn_cosf(rev);
        const float lr = mag * cs, li = mag * sn;
        float pr = lr, pi = li;
#pragma unroll
        for (int q = 0; q < 6; ++q) { const float nr2 = pr * pr - pi * pi, ni2 = 2.f * pr * pi; pr = nr2; pi = ni2; }
        ssmk[i * 4 + 0] = lr; ssmk[i * 4 + 1] = li; ssmk[i * 4 + 2] = pr; ssmk[i * 4 + 3] = pi;
        const float nr = lr - 1.f, ni = li, d2 = ar * ar + ai * ai;
        const float cre = (nr * ar + ni * ai) / d2, cim = (ni * ar - nr * ai) / d2;
#pragma unroll
        for (int h = 0; h < 16; ++h) { const float br = A.in[I_BRE][(size_t)i * 16 + h], bi = A.in[I_BIM][(size_t)i * 16 + h];
            bbar[(size_t)i * 32 + h] = cre * br - cim * bi; bbar[(size_t)i * 32 + 16 + h] = cre * bi + cim * br; }
    }
}

__device__ __forceinline__ unsigned bfmul2(unsigned pk, float f0, float f1) { return pg8::cvt_pk_bf16(__uint_as_float(pk << 16) * f0, __uint_as_float(pk & 0xffff0000u) * f1); }
__device__ __forceinline__ void delta_prep_item(const DevArgs& A, int l, LAS unsigned char* lds, int item, int tid, int wave, int lane) {
    asm volatile("" : "+v"(tid)); lane = tid & 63; wave = __builtin_amdgcn_readfirstlane(tid >> 6);
    const int bh = item >> 5, n = item & 31, b = bh >> 2, h = bh & 3;
    const int tok0 = b * SEQ + n * 64;
    LAS bf16_t* QS = (LAS bf16_t*)(lds); LAS bf16_t* KS = (LAS bf16_t*)(lds + 17408);
    LAS unsigned char* KT = lds + 34816; LAS unsigned char* VT = lds + 53248; LAS unsigned char* RTK = lds + 71680;
    LAS float* AM = (LAS float*)(lds + 90112); LAS float* PM = (LAS float*)(lds + 107520); LAS float* PSC = PM; LAS float* TM = (LAS float*)(lds + 124928);
    LAS unsigned char* TB = lds + 142336;
    LAS float* GAM = (LAS float*)(lds + 151552); LAS float* BETA = GAM + 64; LAS float* RQ = GAM + 128; LAS float* RK = GAM + 192;
    LAS float* F2 = GAM + 256; LAS float* F3 = GAM + 320; LAS float* F4 = GAM + 384;
    const bf16_t* PROJ = (const bf16_t*)(A.ws + WS_PROJ);
    const float* AB = (const float*)(A.ws + WS_AB);
    u32x4 gv[2];
#pragma unroll
    for (int j = 0; j < 2; ++j) { const int id = tid + 512 * j; gv[j] = *(const u32x4*)(PROJ + (size_t)(tok0 + (id >> 4)) * NPROJ + PC_G + h * 128 + (id & 15) * 8); }
    if (tid < 384) {
        const int part = tid >> 7, c = tid & 127, col = part * 512 + h * 128 + c;
        const float* cw = A.in[I_CONVW] + (size_t)l * 4 * 1536;
        const float w0 = cw[col], w1 = cw[1536 + col], w2 = cw[3072 + col], w3 = cw[4608 + col];
        const bf16_t* pp = PROJ + (size_t)tok0 * NPROJ + col;
        float xr[67];
#pragma unroll
        for (int t = 0; t < 67; ++t) xr[t] = (n > 0 || t >= 3) ? bf2f(pp[(long)(t - 3) * NPROJ]) : 0.f;
        unsigned pk[32];
#pragma unroll
        for (int t = 0; t < 64; t += 2) {
            const float s0 = silu_f(w0 * xr[t] + w1 * xr[t + 1] + w2 * xr[t + 2] + w3 * xr[t + 3]);
            const float s1 = silu_f(w0 * xr[t + 1] + w1 * xr[t + 2] + w2 * xr[t + 3] + w3 * xr[t + 4]);
            pk[t >> 1] = pg8::cvt_pk_bf16(s0, s1);
        }
        if (part < 2) { LAS bf16_t* dst = (part == 0 ? QS : KS) + c;
#pragma unroll
            for (int t = 0; t < 64; t += 2) { dst[t * 136] = (bf16_t)(pk[t >> 1] & 0xffffu); dst[(t + 1) * 136] = (bf16_t)(pk[t >> 1] >> 16); } }
        if (part > 0) { LAS unsigned char* dst = (part == 1 ? KT : VT) + c * 144;
#pragma unroll
            for (int q = 0; q < 8; ++q) { u32x4 o; o.x = pk[4 * q]; o.y = pk[4 * q + 1]; o.z = pk[4 * q + 2]; o.w = pk[4 * q + 3]; *(LAS u32x4*)(dst + q * 16) = o; } }
    } else if (tid < 448) {
        const int t = tid - 384;
        const float a = AB[(size_t)(tok0 + t) * 8 + h], bb = AB[(size_t)(tok0 + t) * 8 + 4 + h];
        const float xx = a + A.in[I_DTB][l * 4 + h];
        const float sp = xx > 20.f ? xx : log1pf(expf(xx));
        float lg = -expf(A.in[I_ALOG][l * 4 + h]) * sp;
#pragma unroll
        for (int off = 1; off < 64; off <<= 1) { const float v = __shfl_up(lg, off); if (lane >= off) lg += v; }
        GAM[t] = lg; BETA[t] = 1.f / (1.f + expf(-bb));
    }
    __syncthreads();
    {
        const int t = tid >> 3, part = tid & 7; float sq = 0.f, sk = 0.f;
#pragma unroll
        for (int j = 0; j < 16; ++j) { const float q = bf2f(QS[t * 136 + part * 16 + j]), k = bf2f(KS[t * 136 + part * 16 + j]); sq += q * q; sk += k * k; }
        sq = row_sum8(sq); sk = row_sum8(sk);
        if (part == 0) { const float rq = rsqrtf(sq + EPS) * 0.08838834764831845f, rk = rsqrtf(sk + EPS), g = GAM[t], eg = __expf(g), bt = BETA[t];
            RQ[t] = rq; RK[t] = rk; F2[t] = bt * eg * rk; F3[t] = rk * __expf(GAM[63] - g); F4[t] = rq * eg; }
    }
    {
        const int prod = wave >> 2, mt = wave & 3, fr = lane & 15, quad = lane >> 4;
        LAS bf16_t* Aop = prod ? QS : KS; LAS float* dst = prod ? PM : AM;
        bf16x8 a[4];
#pragma unroll
        for (int kk = 0; kk < 4; ++kk) a[kk] = *(LAS bf16x8*)(Aop + (mt * 16 + fr) * 136 + kk * 32 + quad * 8);
#pragma unroll
        for (int nt = 0; nt < 4; ++nt) { f32x4 acc = {0.f, 0.f, 0.f, 0.f};
#pragma unroll
            for (int kk = 0; kk < 4; ++kk) { const bf16x8 bq = *(LAS bf16x8*)(KS + (nt * 16 + fr) * 136 + kk * 32 + quad * 8); acc = mfma16(a[kk], bq, acc); }
#pragma unroll
            for (int i = 0; i < 4; ++i) dst[(mt * 16 + quad * 4 + i) * 68 + nt * 16 + fr] = acc[i]; }
    }
    __syncthreads();
    {
        const int t = tid >> 3, s8 = (tid & 7) * 8; const float gt = GAM[t], bk = BETA[t] * RK[t], rqt = RQ[t];
        float av[8], pv[8];
#pragma unroll
        for (int j = 0; j < 8; ++j) { const int s = s8 + j; const float rks = RK[s]; const float dec = (s <= t) ? __expf(gt - GAM[s]) * rks : 0.f;
            av[j] = (s < t) ? bk * dec * AM[t * 68 + s] : 0.f; pv[j] = rqt * dec * PM[t * 68 + s]; }
#pragma unroll
        for (int j = 0; j < 8; ++j) AM[t * 68 + s8 + j] = av[j];
        u32x4 o; o.x = pg8::cvt_pk_bf16(pv[0], pv[1]); o.y = pg8::cvt_pk_bf16(pv[2], pv[3]); o.z = pg8::cvt_pk_bf16(pv[4], pv[5]); o.w = pg8::cvt_pk_bf16(pv[6], pv[7]);
        *(u32x4*)((bf16_t*)(A.ws + WS_DQK) + (size_t)item * 4096 + t * 64 + s8) = o;
        for (int e = tid; e < 64 * 68; e += 512) TM[e] = 0.f;
        if (tid == 0) ((float*)(A.ws + WS_DGL))[item] = __expf(GAM[63]);
    }
    __syncthreads();
    if (wave == 0) {
        const int i = lane >> 4, c = lane & 15;
        LAS float* amp = AM + (16 * i) * 68 + 16 * i; asm volatile("" : "+v"(amp));
        float x[16];
#pragma unroll
        for (int r = 0; r < 16; ++r) { float acc = (r == c) ? 1.f : 0.f;
#pragma unroll
            for (int s = 0; s < r; ++s) acc = fmaf(-amp[r * 68 + s], x[s], acc);
            x[r] = acc; }
        LAS float* tmp = TM + (16 * i) * 68 + 16 * i + c;
#pragma unroll
        for (int r = 0; r < 16; ++r) tmp[r * 68] = x[r];
    } else {
        const int wt = tid - 64;
        for (int id = wt; id < 1024; id += 448) {
            const int c = id >> 3, t8 = (id & 7) * 8;
            const f32x4 b0 = *(LAS f32x4*)(BETA + t8), b1 = *(LAS f32x4*)(BETA + t8 + 4);
            u32x4 v = *(LAS u32x4*)(VT + c * 144 + t8 * 2);
            v.x = bfmul2(v.x, b0[0], b0[1]); v.y = bfmul2(v.y, b0[2], b0[3]); v.z = bfmul2(v.z, b1[0], b1[1]); v.w = bfmul2(v.w, b1[2], b1[3]);
            *(LAS u32x4*)(VT + c * 144 + t8 * 2) = v;
            const f32x4 f20 = *(LAS f32x4*)(F2 + t8), f21 = *(LAS f32x4*)(F2 + t8 + 4), f30 = *(LAS f32x4*)(F3 + t8), f31 = *(LAS f32x4*)(F3 + t8 + 4);
            const u32x4 k = *(LAS u32x4*)(KT + c * 144 + t8 * 2);
            u32x4 rk; rk.x = bfmul2(k.x, f20[0], f20[1]); rk.y = bfmul2(k.y, f20[2], f20[3]); rk.z = bfmul2(k.z, f21[0], f21[1]); rk.w = bfmul2(k.w, f21[2], f21[3]);
            *(LAS u32x4*)(RTK + c * 144 + t8 * 2) = rk;
            u32x4 kd; kd.x = bfmul2(k.x, f30[0], f30[1]); kd.y = bfmul2(k.y, f30[2], f30[3]); kd.z = bfmul2(k.z, f31[0], f31[1]); kd.w = bfmul2(k.w, f31[2], f31[3]);
            *(u32x4*)((bf16_t*)(A.ws + WS_DKT) + (size_t)item * 8192 + c * 64 + t8) = kd; }
        for (int id = wt; id < 1024; id += 448) {
            const int t = id >> 4, c8 = (id & 15) * 8; const float f = F4[t];
            u32x4 q = *(LAS u32x4*)((LAS unsigned char*)QS + t * 272 + c8 * 2);
            q.x = bfmul2(q.x, f, f); q.y = bfmul2(q.y, f, f); q.z = bfmul2(q.z, f, f); q.w = bfmul2(q.w, f, f);
            *(u32x4*)((bf16_t*)(A.ws + WS_DQD) + (size_t)item * 8192 + t * 128 + c8) = q; }
    }
    {
        const int c8 = (tid & 15) * 8; const float* on = A.in[I_ONORM] + l * 128 + c8;
        const f32x4 o0 = *(const f32x4*)on, o1 = *(const f32x4*)(on + 4);
#pragma unroll
        for (int j = 0; j < 2; ++j) { const int id = tid + 512 * j; const u32x4 g = gv[j]; u32x4 o;
            o.x = pg8::cvt_pk_bf16(silu_f(__uint_as_float(g.x << 16)) * o0[0], silu_f(__uint_as_float(g.x & 0xffff0000u)) * o0[1]);
            o.y = pg8::cvt_pk_bf16(silu_f(__uint_as_float(g.y << 16)) * o0[2], silu_f(__uint_as_float(g.y & 0xffff0000u)) * o0[3]);
            o.z = pg8::cvt_pk_bf16(silu_f(__uint_as_float(g.z << 16)) * o1[0], silu_f(__uint_as_float(g.z & 0xffff0000u)) * o1[1]);
            o.w = pg8::cvt_pk_bf16(silu_f(__uint_as_float(g.w << 16)) * o1[2], silu_f(__uint_as_float(g.w & 0xffff0000u)) * o1[3]);
            *(u32x4*)((bf16_t*)(A.ws + WS_DGS) + (size_t)item * 8192 + (id >> 4) * 128 + c8) = o; }
    }
    __syncthreads();
    const int p2 = tid >> 8, r2 = (tid >> 4) & 15, c2 = tid & 15, rb = p2 ? 48 : 16, cb = p2 ? 32 : 0;
    {
        float acc = 0.f;
#pragma unroll
        for (int s = 0; s < 16; ++s) acc = fmaf(AM[(rb + r2) * 68 + cb + s], TM[(cb + s) * 68 + cb + c2], acc);
        PSC[(p2 * 16 + r2) * 68 + c2] = acc; }
    __syncthreads();
    {
        float acc = 0.f;
#pragma unroll
        for (int s = 0; s < 16; ++s) acc = fmaf(TM[(rb + r2) * 68 + rb + s], PSC[(p2 * 16 + s) * 68 + c2], acc);
        TM[(rb + r2) * 68 + cb + c2] = -acc; }
    __syncthreads();
    float p3[2];
#pragma unroll
    for (int j = 0; j < 2; ++j) { const int e = tid + 512 * j, r = e >> 5, c = e & 31; float acc = 0.f;
#pragma unroll 8
        for (int s = 0; s < 32; ++s) acc = fmaf(AM[(32 + r) * 68 + s], TM[s * 68 + c], acc);
        p3[j] = acc; }
    __syncthreads();
#pragma unroll
    for (int j = 0; j < 2; ++j) { const int e = tid + 512 * j; PSC[(e >> 5) * 68 + (e & 31)] = p3[j]; }
    __syncthreads();
#pragma unroll
    for (int j = 0; j < 2; ++j) { const int e = tid + 512 * j, r = e >> 5, c = e & 31; float acc = 0.f;
#pragma unroll 8
        for (int s = 0; s < 32; ++s) acc = fmaf(TM[(32 + r) * 68 + 32 + s], PSC[s * 68 + c], acc);
        p3[j] = -acc; }
#pragma unroll
    for (int j = 0; j < 2; ++j) { const int e = tid + 512 * j; TM[(32 + (e >> 5)) * 68 + (e & 31)] = p3[j]; }
    __syncthreads();
#pragma unroll
    for (int j = 0; j < 4; ++j) { const int e = tid + 512 * j, t = e >> 5, s2 = (e & 31) * 2;
        *(LAS unsigned*)(TB + t * 144 + s2 * 2) = pg8::cvt_pk_bf16(TM[t * 68 + s2], TM[t * 68 + s2 + 1]); }
    __syncthreads();
    {
        const int fr = lane & 15, quad = lane >> 4;
        bf16x8 bv[2], ak[2];
#pragma unroll
        for (int kk = 0; kk < 2; ++kk) { bv[kk] = *(LAS bf16x8*)(VT + (16 * wave + fr) * 144 + (kk * 32 + quad * 8) * 2); ak[kk] = *(LAS bf16x8*)(RTK + (16 * wave + fr) * 144 + (kk * 32 + quad * 8) * 2); }
        bf16_t* DW = (bf16_t*)(A.ws + WS_DW) + (size_t)item * 8192; bf16_t* DKC = (bf16_t*)(A.ws + WS_DKC) + (size_t)item * 8192;
#pragma unroll
        for (int mt = 0; mt < 4; ++mt) { f32x4 aw = {0.f, 0.f, 0.f, 0.f}, akc = {0.f, 0.f, 0.f, 0.f};
#pragma unroll
            for (int kk = 0; kk < 2; ++kk) { const bf16x8 tf = *(LAS bf16x8*)(TB + (mt * 16 + fr) * 144 + (kk * 32 + quad * 8) * 2);
                aw = mfma16(tf, bv[kk], aw);
                akc = mfma16(ak[kk], tf, akc); }
            u32x2 ow; ow.x = pk2(aw[0], aw[1]); ow.y = pk2(aw[2], aw[3]);
            *(u32x2*)(DW + (16 * wave + fr) * 64 + mt * 16 + quad * 4) = ow;
            u32x2 ok; ok.x = pk2(-akc[0], -akc[1]); ok.y = pk2(-akc[2], -akc[3]);
            *(u32x2*)(DKC + (mt * 16 + fr) * 128 + 16 * wave + quad * 4) = ok; }
    }
    __syncthreads();
}

__device__ __forceinline__ void delta_scan_item(const DevArgs& A, int l, LAS unsigned char* lds, int bh, int tid_in, int wave, int lane_in, const XcdBarrier& xb, int SUB) {
    const int b = bh >> 2, h = bh & 3;
    LAS unsigned char* KCs = lds; LAS unsigned char* QDs = lds + 17408; LAS unsigned char* QKs = lds + 34816; LAS unsigned char* KDTs = lds + 44032;
    LAS unsigned char* Ws = lds + 62464;
    LAS unsigned char* GSs = lds + 80896;
    LAS unsigned char* SS = lds + 98304 + wave * 4352; LAS unsigned char* US = lds + 133120 + wave * 2304;
    LAS float* PART = (LAS float*)(lds + 151552);
    const unsigned char* gW = A.ws + WS_DW; const unsigned char* gGS = A.ws + WS_DGS;
    const unsigned char* gKC = A.ws + WS_DKC; const unsigned char* gQD = A.ws + WS_DQD; const unsigned char* gQK = A.ws + WS_DQK; const unsigned char* gKT = A.ws + WS_DKT;
    const float* DGL = (const float*)(A.ws + WS_DGL);
    f32x4 S[8];
#pragma unroll
    for (int mt = 0; mt < 8; ++mt) S[mt] = (f32x4){0.f, 0.f, 0.f, 0.f};
    u32x4 r[9], rg[2];
    float gl_all = 0.f;
#define DS_LOAD(itn, toff) do { const size_t _i = (size_t)(itn); const unsigned char* _kc = gKC + _i * 16384; const unsigned char* _qd = gQD + _i * 16384; \
        const unsigned char* _qk = gQK + _i * 8192; const unsigned char* _kt = gKT + _i * 16384; \
        r[0] = *(const u32x4*)(_kc + (toff)); r[1] = *(const u32x4*)(_kc + (toff) + 8192u); \
        r[2] = *(const u32x4*)(_qd + (toff)); r[3] = *(const u32x4*)(_qd + (toff) + 8192u); \
        r[4] = *(const u32x4*)(_qk + (toff)); \
        r[5] = *(const u32x4*)(_kt + (toff)); r[6] = *(const u32x4*)(_kt + (toff) + 8192u); \
        const unsigned char* _w = gW + _i * 16384; r[7] = *(const u32x4*)(_w + (toff)); r[8] = *(const u32x4*)(_w + (toff) + 8192u); } while (0)
#define DS_LOADG(itn, toff) do { const unsigned char* _g = gGS + (size_t)(itn) * 16384; rg[0] = *(const u32x4*)(_g + (toff)); rg[1] = *(const u32x4*)(_g + (toff) + 8192u); } while (0)
#define DS_STAGE(tidv) do { const int i0 = (tidv), i1 = (tidv) + 512; \
          *(LAS u32x4*)(KCs + (i0 >> 4) * 272 + (i0 & 15) * 16) = r[0]; *(LAS u32x4*)(KCs + (i1 >> 4) * 272 + (i1 & 15) * 16) = r[1]; \
          *(LAS u32x4*)(QDs + (i0 >> 4) * 272 + (i0 & 15) * 16) = r[2]; *(LAS u32x4*)(QDs + (i1 >> 4) * 272 + (i1 & 15) * 16) = r[3]; \
          *(LAS u32x4*)(QKs + (i0 >> 3) * 144 + (i0 & 7) * 16) = r[4]; \
          *(LAS u32x4*)(KDTs + (i0 >> 3) * 144 + (i0 & 7) * 16) = r[5]; *(LAS u32x4*)(KDTs + (i1 >> 3) * 144 + (i1 & 7) * 16) = r[6]; \
          *(LAS u32x4*)(Ws + (i0 >> 3) * 144 + (i0 & 7) * 16) = r[7]; *(LAS u32x4*)(Ws + (i1 >> 3) * 144 + (i1 & 7) * 16) = r[8]; } while (0)
#define DS_STAGEG(tidv) do { const int i0 = (tidv), i1 = (tidv) + 512; \
          *(LAS u32x4*)(GSs + (i0 >> 4) * 272 + (i0 & 15) * 16) = rg[0]; *(LAS u32x4*)(GSs + (i1 >> 4) * 272 + (i1 & 15) * 16) = rg[1]; } while (0)
#pragma unroll 1
    for (int n = 0; n < 32; ++n) {
        int tid = tid_in; asm volatile("" : "+v"(tid));
        const bool bstart = (SUB > 0) ? (n % SUB == 0) : (n == 0);
        const bool bnext1 = (SUB > 0) && ((n + 1) % SUB == 0), bnext2 = (SUB > 0) && ((n + 2) % SUB == 0);
        if (bstart) { if (n > 0) xcd_barrier(xb);
            gl_all = DGL[bh * 32 + (tid & 31)];
            const unsigned t0 = (unsigned)tid * 16u; DS_LOAD(bh * 32 + n, t0); DS_LOADG(bh * 32 + n, t0); DS_STAGE(tid); DS_STAGEG(tid);
            if (n + 1 < 32 && !bnext1) { DS_LOAD(bh * 32 + n + 1, t0); DS_LOADG(bh * 32 + n + 1, t0); }
            __syncthreads(); }
        else { DS_STAGEG(tid);
            if (n + 1 < 32 && !bnext1) DS_LOADG(bh * 32 + n + 1, (unsigned)tid * 16u); }
        const int lane = tid & 63, fr = lane & 15, quad = lane >> 4, vcol = 16 * wave + fr;
        const unsigned toff = (unsigned)tid * 16u;
        const int it = bh * 32 + n, tokb = b * SEQ + n * 64;
        const float glast = __builtin_bit_cast(float, __builtin_amdgcn_readlane(__builtin_bit_cast(int, gl_all), n));
        asm volatile("s_nop 7\n\ts_nop 7" ::: "memory");
#pragma unroll
        for (int mt = 0; mt < 8; ++mt) { u32x2 p; p.x = pg8::cvt_pk_bf16(S[mt][0], S[mt][1]); p.y = pg8::cvt_pk_bf16(S[mt][2], S[mt][3]); *(LAS u32x2*)(SS + fr * 272 + (mt * 16 + quad * 4) * 2) = p; }
        LDS_FENCE();
        bf16x8 Sb[4];
#pragma unroll
        for (int kk = 0; kk < 4; ++kk) Sb[kk] = *(LAS bf16x8*)(SS + fr * 272 + (kk * 32 + quad * 8) * 2);
        f32x4 U[4], O[4];
#pragma unroll
        for (int mt = 0; mt < 4; ++mt) { f32x4 au, ao = {0.f, 0.f, 0.f, 0.f};
            { const u32x2 wq = *(LAS u32x2*)(Ws + vcol * 144 + (mt * 16 + quad * 4) * 2);
              au[0] = __uint_as_float(wq.x << 16); au[1] = __uint_as_float(wq.x & 0xffff0000u); au[2] = __uint_as_float(wq.y << 16); au[3] = __uint_as_float(wq.y & 0xffff0000u); }
#pragma unroll
            for (int kk = 0; kk < 4; ++kk) { const bf16x8 a1 = *(LAS bf16x8*)(KCs + (mt * 16 + fr) * 272 + (kk * 32 + quad * 8) * 2); au = mfma16(a1, Sb[kk], au);
                const bf16x8 a2 = *(LAS bf16x8*)(QDs + (mt * 16 + fr) * 272 + (kk * 32 + quad * 8) * 2); ao = mfma16(a2, Sb[kk], ao); }
            U[mt] = au; O[mt] = ao; __builtin_amdgcn_sched_barrier(0); }
        asm volatile("s_nop 7\n\ts_nop 7" ::: "memory");
#pragma unroll
        for (int mt = 0; mt < 4; ++mt) { u32x2 p; p.x = pg8::cvt_pk_bf16(U[mt][0], U[mt][1]); p.y = pg8::cvt_pk_bf16(U[mt][2], U[mt][3]); *(LAS u32x2*)(US + fr * 144 + (mt * 16 + quad * 4) * 2) = p; }
        LDS_FENCE();
        bf16x8 Ub[2];
#pragma unroll
        for (int kk = 0; kk < 2; ++kk) Ub[kk] = *(LAS bf16x8*)(US + fr * 144 + (kk * 32 + quad * 8) * 2);
#pragma unroll
        for (int mt = 0; mt < 4; ++mt)
#pragma unroll
            for (int kk = 0; kk < 2; ++kk) { const bf16x8 a = *(LAS bf16x8*)(QKs + (mt * 16 + fr) * 144 + (kk * 32 + quad * 8) * 2); O[mt] = mfma16(a, Ub[kk], O[mt]); }
        __builtin_amdgcn_sched_barrier(0);
#pragma unroll
        for (int mt = 0; mt < 8; ++mt) { S[mt] *= glast;
#pragma unroll
            for (int kk = 0; kk < 2; ++kk) { const bf16x8 a = *(LAS bf16x8*)(KDTs + (mt * 16 + fr) * 144 + (kk * 32 + quad * 8) * 2); S[mt] = mfma16(a, Ub[kk], S[mt]); }
            if (mt & 1) __builtin_amdgcn_sched_barrier(0); }
        { float pp[16];
#pragma unroll
          for (int e = 0; e < 16; ++e) pp[e] = O[e >> 2][e & 3] * O[e >> 2][e & 3];
#pragma unroll
          for (int e = 0; e < 16; ++e) pp[e] = row_sum16(pp[e]);
          if (fr == 0) {
#pragma unroll
              for (int e = 0; e < 16; ++e) PART[((e >> 2) * 16 + quad * 4 + (e & 3)) * 8 + wave] = pp[e]; } }
        __syncthreads();
        if (n + 1 < 32 && !bnext1) { DS_STAGE(tid); if (n + 2 < 32 && !bnext2) DS_LOAD(it + 2, toff); }
        bf16_t* mixb = (bf16_t*)(A.ws + WS_MIX) + (size_t)tokb * D + h * 128;
#pragma unroll
        for (int mt = 0; mt < 4; ++mt)
#pragma unroll
            for (int i = 0; i < 4; ++i) { const int t = mt * 16 + quad * 4 + i;
                const f32x4 p0 = *(LAS f32x4*)(PART + t * 8), p1 = *(LAS f32x4*)(PART + t * 8 + 4);
                const float tot = ((p0[0] + p0[1]) + (p0[2] + p0[3])) + ((p1[0] + p1[1]) + (p1[2] + p1[3]));
                const float sc = rsqrtf(tot * (1.f / 128.f) + EPS);
                const float gs = bf2f(*(LAS bf16_t*)(GSs + t * 272 + vcol * 2));
                mixb[(unsigned)(t * D + vcol)] = (bf16_t)(pg8::cvt_pk_bf16(O[mt][i] * sc * gs, 0.f) & 0xffffu); }
        __syncthreads();
    }
#undef DS_STAGE
#undef DS_LOADG
#undef DS_STAGEG
#undef DS_LOAD
    { const int lane = lane_in, fr = lane & 15, quad = lane >> 4, vcol = 16 * wave + fr;
      float* dp = A.out + O_DP + (size_t)((l * 8 + b) * 4 + h) * 16384;
#pragma unroll
      for (int mt = 0; mt < 8; ++mt)
#pragma unroll
          for (int i = 0; i < 4; ++i) dp[(mt * 16 + quad * 4 + i) * 128 + vcol] = S[mt][i]; }
    __syncthreads();
}

__device__ __forceinline__ void delta_sample_item(const DevArgs& A, int l, LAS unsigned char* lds, int item, int tid, int wave, int lane) {
    asm volatile("" : "+v"(tid)); lane = tid & 63; wave = __builtin_amdgcn_readfirstlane(tid >> 6);
    const int b = item >> 2, h = item & 3, tokS = NP + b * 4;
    LAS float* RAW = (LAS float*)lds; LAS float* RED = RAW + 1536; LAS float* OB = RED + 512; LAS float* SC = OB + 512;
    const bf16_t* PROJ = (const bf16_t*)(A.ws + WS_PROJ); const float* AB = (const float*)(A.ws + WS_AB); bf16_t* MIX = (bf16_t*)(A.ws + WS_MIX);
    const float* cw = A.in[I_CONVW] + (size_t)l * 4 * 1536;
    for (int idx = tid; idx < 1536; idx += 512) { const int part = idx >> 9, t = (idx >> 7) & 3, c = idx & 127, col = part * 512 + h * 128 + c;
        float acc = 0.f;
#pragma unroll
        for (int j = 0; j < 4; ++j) { const int tt = t - 3 + j;
            const float x = (tt >= 0) ? bf2f(PROJ[(size_t)(tokS + tt) * NPROJ + col]) : A.in[I_SCONV][((size_t)(l * 128 + b) * 3 + (3 + tt)) * 1536 + col];
            acc += cw[j * 1536 + col] * x; }
        RAW[idx] = silu_f(acc); }
    if (tid < 4) { const float a = AB[(size_t)(tokS + tid) * 8 + h], bb = AB[(size_t)(tokS + tid) * 8 + 4 + h];
        const float xx = a + A.in[I_DTB][l * 4 + h]; const float sp = xx > 20.f ? xx : log1pf(expf(xx));
        SC[8 + tid] = 1.f / (1.f + expf(-bb)); SC[12 + tid] = expf(-expf(A.in[I_ALOG][l * 4 + h]) * sp); }
    const int v = tid & 127, kq = tid >> 7;
    float S[32];
    { const float* sp = A.in[I_SDELTA] + (size_t)((l * 128 + b) * 4 + h) * 16384;
#pragma unroll
      for (int i = 0; i < 32; ++i) S[i] = sp[(kq * 32 + i) * 128 + v]; }
    __syncthreads();
    { const int part = wave >> 2, t = wave & 3; const float x0 = RAW[part * 512 + t * 128 + lane], x1 = RAW[part * 512 + t * 128 + 64 + lane];
      const float ss = wave_sum(x0 * x0 + x1 * x1); if (lane == 0) SC[part * 4 + t] = rsqrtf(ss + EPS) * (part == 0 ? 0.08838834764831845f : 1.f); }
    __syncthreads();
    for (int t = 0; t < 4; ++t) {
        const float rq = SC[t], rk = SC[4 + t], beta = SC[8 + t], g = SC[12 + t];
        float pr = 0.f;
#pragma unroll
        for (int i = 0; i < 32; ++i) pr += S[i] * RAW[512 + t * 128 + kq * 32 + i];
        RED[kq * 128 + v] = pr * rk;
        __syncthreads();
        const float rr = (RED[v] + RED[128 + v]) + (RED[256 + v] + RED[384 + v]);
        const float u = beta * (RAW[1024 + t * 128 + v] - g * rr);
        float po = 0.f;
#pragma unroll
        for (int i = 0; i < 32; ++i) { const float kh = RAW[512 + t * 128 + kq * 32 + i] * rk; S[i] = g * S[i] + kh * u; po += S[i] * RAW[t * 128 + kq * 32 + i]; }
        __syncthreads();
        RED[kq * 128 + v] = po * rq;
        __syncthreads();
        if (kq == 0) OB[t * 128 + v] = (RED[v] + RED[128 + v]) + (RED[256 + v] + RED[384 + v]);
        __syncthreads();
    }
    if (wave < 4) { const int t = wave; const float x0 = OB[t * 128 + lane], x1 = OB[t * 128 + 64 + lane];
        const float ss = wave_sum(x0 * x0 + x1 * x1); const float sc = rsqrtf(ss * (1.f / 128.f) + EPS);
        const float g0 = bf2f(PROJ[(size_t)(tokS + t) * NPROJ + PC_G + h * 128 + lane]), g1 = bf2f(PROJ[(size_t)(tokS + t) * NPROJ + PC_G + h * 128 + 64 + lane]);
        MIX[(size_t)(tokS + t) * D + h * 128 + lane] = (bf16_t)f2bf(x0 * sc * A.in[I_ONORM][l * 128 + lane] * silu_f(g0));
        MIX[(size_t)(tokS + t) * D + h * 128 + 64 + lane] = (bf16_t)f2bf(x1 * sc * A.in[I_ONORM][l * 128 + 64 + lane] * silu_f(g1)); }
    { float* dsp = A.out + O_DS + (size_t)((l * 128 + b) * 4 + h) * 16384;
#pragma unroll
      for (int i = 0; i < 32; ++i) dsp[(kq * 32 + i) * 128 + v] = S[i]; }
    __syncthreads();
}

#define SSM_BCAST_U(t) do { unsigned _w[8]; \
        _w[0] = __builtin_amdgcn_readlane(ua.x, t); _w[1] = __builtin_amdgcn_readlane(ua.y, t); _w[2] = __builtin_amdgcn_readlane(ua.z, t); _w[3] = __builtin_amdgcn_readlane(ua.w, t); \
        _w[4] = __builtin_amdgcn_readlane(ub.x, t); _w[5] = __builtin_amdgcn_readlane(ub.y, t); _w[6] = __builtin_amdgcn_readlane(ub.z, t); _w[7] = __builtin_amdgcn_readlane(ub.w, t); \
        _Pragma("unroll") for (int _d = 0; _d < 8; ++_d) { uu[2 * _d] = __uint_as_float(_w[_d] << 16); uu[2 * _d + 1] = __uint_as_float(_w[_d] & 0xffff0000u); } } while (0)
#define SSM_STEP() do { float _br = 0.f, _bi = 0.f; \
        _Pragma("unroll") for (int _h = 0; _h < 16; ++_h) { _br = fmaf(Br[_h], uu[_h], _br); _bi = fmaf(Bi[_h], uu[_h], _bi); } \
        const float _nr = lr * hr - li * hi + _br, _ni = lr * hi + li * hr + _bi; hr = _nr; hi = _ni; } while (0)

__device__ __forceinline__ void ssm_part1_item(const DevArgs& A, int l, int it, int lane) {
    const int g = it & 15, bc = it >> 4, b = bc / 31, c = bc % 31;
    const float* bb = (const float*)(A.ws + WS_BBAR) + ((size_t)(l * 16 + g) * 64 + lane) * 32;
    float Br[16], Bi[16];
#pragma unroll
    for (int q = 0; q < 4; ++q) { const f32x4 x = ((const f32x4*)bb)[q], y = ((const f32x4*)bb)[4 + q];
        Br[4 * q] = x.x; Br[4 * q + 1] = x.y; Br[4 * q + 2] = x.z; Br[4 * q + 3] = x.w; Bi[4 * q] = y.x; Bi[4 * q + 1] = y.y; Bi[4 * q + 2] = y.z; Bi[4 * q + 3] = y.w; }
    const f32x4 lk = ((const f32x4*)(A.ws + WS_SSMK))[(l * 16 + g) * 64 + lane]; const float lr = lk.x, li = lk.y;
    const bf16_t* up = (const bf16_t*)(A.ws + WS_PROJ) + (size_t)(b * SEQ + c * 64 + lane) * NPROJ + PC_SSM + g * 16;
    const u32x4 ua = *(const u32x4*)up, ub = *(const u32x4*)(up + 8);
    float hr = 0.f, hi = 0.f, uu[16];
#pragma unroll 1
    for (int t = 0; t < 64; ++t) { SSM_BCAST_U(t); SSM_STEP(); }
    f32x2 e; e.x = hr; e.y = hi;
    ((f32x2*)(A.ws + WS_SSME))[((size_t)(b * 32 + c) * 16 + g) * 64 + lane] = e;
}

__device__ __forceinline__ void ssm_part2_item(const DevArgs& A, int l, LAS unsigned char* lds, int it, int tid, int wave, int lane) {
    asm volatile("" : "+v"(tid)); lane = tid & 63; wave = __builtin_amdgcn_readfirstlane(tid >> 6);
    const int tok0 = it * 64, fr = lane & 15, quad = lane >> 4;
    const bool samp = it >= 256; const int b = it >> 5, c = it & 31;
    LAS unsigned char* YS = lds; LAS unsigned char* HS = lds + 33792 + wave * 4352;
    const bf16_t* PROJ = (const bf16_t*)(A.ws + WS_PROJ); bf16_t* MIX = (bf16_t*)(A.ws + WS_MIX);
#pragma unroll 1
    for (int gi = 0; gi < 2; ++gi) {
        const int g = wave * 2 + gi;
        const float* bb = (const float*)(A.ws + WS_BBAR) + ((size_t)(l * 16 + g) * 64 + lane) * 32;
        float Br[16], Bi[16];
#pragma unroll
        for (int q = 0; q < 4; ++q) { const f32x4 x = ((const f32x4*)bb)[q], y = ((const f32x4*)bb)[4 + q];
            Br[4 * q] = x.x; Br[4 * q + 1] = x.y; Br[4 * q + 2] = x.z; Br[4 * q + 3] = x.w; Bi[4 * q] = y.x; Bi[4 * q + 1] = y.y; Bi[4 * q + 2] = y.z; Bi[4 * q + 3] = y.w; }
        const f32x4 lk = ((const f32x4*)(A.ws + WS_SSMK))[(l * 16 + g) * 64 + lane]; const float lr = lk.x, li = lk.y, Lr = lk.z, Li = lk.w;
        bf16x8 Cb[4];
#pragma unroll
        for (int kk = 0; kk < 4; ++kk) { const size_t co = ((size_t)(l * 16 + g) * 16 + fr) * 64 + kk * 16 + quad * 4;
            const f32x4 cr = *(const f32x4*)(A.in[I_CRE] + co), ci = *(const f32x4*)(A.in[I_CIM] + co);
            u32x4 pk; pk.x = pk2(cr.x, -ci.x); pk.y = pk2(cr.y, -ci.y); pk.z = pk2(cr.z, -ci.z); pk.w = pk2(cr.w, -ci.w);
            Cb[kk] = __builtin_bit_cast(bf16x8, pk); }
        const bf16_t* up = PROJ + (size_t)(tok0 + lane) * NPROJ + PC_SSM + g * 16;
        const u32x4 ua = *(const u32x4*)up, ub = *(const u32x4*)(up + 8);
        float hr = 0.f, hi = 0.f, uu[16];
        if (!samp && c > 0) { const f32x2* E = (const f32x2*)(A.ws + WS_SSME) + ((size_t)(b * 32) * 16 + g) * 64 + lane;
#pragma unroll
            for (int cb = 0; cb < 32; cb += 16) { f32x2 ev[16];
#pragma unroll
                for (int q = 0; q < 16; ++q) { const int cc = cb + q; ev[q] = (cc < c) ? E[(size_t)cc * 1024] : (f32x2){0.f, 0.f}; }
#pragma unroll
                for (int q = 0; q < 16; ++q) { const int cc = cb + q; if (cc < c) { const float nr = Lr * hr - Li * hi + ev[q].x, ni = Lr * hi + Li * hr + ev[q].y; hr = nr; hi = ni; } } } }
        const float dsk = A.in[I_SSMD][l * 256 + g * 16 + fr];
        unsigned uvr[16];
#pragma unroll
        for (int e = 0; e < 16; ++e) uvr[e] = PROJ[(size_t)(tok0 + (e >> 2) * 16 + quad * 4 + (e & 3)) * NPROJ + PC_SSM + g * 16 + fr];
#pragma unroll
        for (int sub = 0; sub < 4; ++sub) {
#pragma unroll 1
            for (int tt = 0; tt < 16; ++tt) { const int t = sub * 16 + tt;
                const int sb = (it - 256) * 16 + (t >> 2);
                if (samp && (t & 3) == 0) { hr = A.in[I_SRE][((size_t)(l * 128 + sb) * 16 + g) * 64 + lane]; hi = A.in[I_SIM][((size_t)(l * 128 + sb) * 16 + g) * 64 + lane]; }
                SSM_BCAST_U(t); SSM_STEP();
                *(LAS unsigned*)(HS + tt * 272 + lane * 4) = pg8::cvt_pk_bf16(hr, hi);
                if (samp && (t & 3) == 3) { A.out[O_RES + ((size_t)(l * 128 + sb) * 16 + g) * 64 + lane] = hr; A.out[O_IMS + ((size_t)(l * 128 + sb) * 16 + g) * 64 + lane] = hi; }
            }
            LDS_FENCE();
            f32x4 acc = {0.f, 0.f, 0.f, 0.f};
#pragma unroll
            for (int kk = 0; kk < 4; ++kk) { const bf16x8 a = *(LAS bf16x8*)(HS + fr * 272 + (kk * 32 + quad * 8) * 2); acc = mfma16(a, Cb[kk], acc); }
#pragma unroll
            for (int i = 0; i < 4; ++i) { const int t = sub * 16 + quad * 4 + i; const float uv = bf2f(uvr[sub * 4 + i]);
                *(LAS bf16_t*)(YS + t * 528 + (g * 16 + fr) * 2) = (bf16_t)f2bf(gelu_tanh_f(acc[i] + dsk * uv)); }
            LDS_FENCE();
        }
        if (!samp && c == 31) { A.out[O_REP + ((size_t)(l * 8 + b) * 16 + g) * 64 + lane] = hr; A.out[O_IMP + ((size_t)(l * 8 + b) * 16 + g) * 64 + lane] = hi; }
    }
    __syncthreads();
    {
        const bf16_t* GT = (const bf16_t*)(A.ws + WS_GLUT + l * SZ_GLUT);
        f32x4 acc[4][2];
#pragma unroll
        for (int mt = 0; mt < 4; ++mt) { acc[mt][0] = (f32x4){0.f, 0.f, 0.f, 0.f}; acc[mt][1] = (f32x4){0.f, 0.f, 0.f, 0.f}; }
#pragma unroll
        for (int kk = 0; kk < 8; ++kk) { bf16x8 bfr[2];
#pragma unroll
            for (int nt = 0; nt < 2; ++nt) bfr[nt] = *(const bf16x8*)(GT + (size_t)(32 * wave + nt * 16 + fr) * 256 + kk * 32 + quad * 8);
#pragma unroll
            for (int mt = 0; mt < 4; ++mt) { const bf16x8 a = *(LAS bf16x8*)(YS + (mt * 16 + fr) * 528 + (kk * 32 + quad * 8) * 2);
                acc[mt][0] = mfma16(a, bfr[0], acc[mt][0]); acc[mt][1] = mfma16(a, bfr[1], acc[mt][1]); } }
#pragma unroll
        for (int nt = 0; nt < 2; ++nt) { const int ncol = 32 * wave + nt * 16 + fr; const float gb = A.in[I_GLUB][l * 256 + ncol];
#pragma unroll
            for (int mt = 0; mt < 4; ++mt)
#pragma unroll
                for (int i = 0; i < 4; ++i) { const int t = mt * 16 + quad * 4 + i; const float y = bf2f(*(LAS bf16_t*)(YS + t * 528 + ncol * 2));
                    MIX[(size_t)(tok0 + t) * D + 512 + ncol] = (bf16_t)f2bf(y * sigmoid_f(acc[mt][nt][i] + gb)); } }
    }
    __syncthreads();
}

__device__ __forceinline__ void pool_item(const DevArgs& A, int l, LAS unsigned char* lds, int it, int tid, int wave, int lane) {
    asm volatile("" : "+v"(tid)); lane = tid & 63; wave = __builtin_amdgcn_readfirstlane(tid >> 6);
    const int tok0 = it * 64, fr = lane & 15, quad = lane >> 4; const bool samp = it >= 256;
    LAS unsigned char* RS = lds;
    const bf16_t* PROJ = (const bf16_t*)(A.ws + WS_PROJ); bf16_t* MIX = (bf16_t*)(A.ws + WS_MIX);
    if (!samp) {
        LAS unsigned char* XT = lds + 33792;
        const int b = it >> 5, c = it & 31;
        for (int id = tid; id < 79 * 32; id += 512) { const int r = id >> 5, c16 = id & 31, tl = c * 64 - 15 + r;
            u32x4 v = {0u, 0u, 0u, 0u}; if (tl >= 0) v = *(const u32x4*)(PROJ + (size_t)(b * SEQ + tl) * NPROJ + PC_POOL + c16 * 8);
            *(LAS u32x4*)(XT + r * 528 + c16 * 16) = v; }
        __syncthreads();
        const int ch = tid & 255, half = tid >> 8, g = ch >> 6, w = 2 << g, r0 = half * 32;
        float sum = 0.f;
        for (int j = 0; j < w; ++j) sum += bf2f(*(LAS bf16_t*)(XT + (r0 + 15 - j) * 528 + ch * 2));
#pragma unroll 4
        for (int rr = 0; rr < 32; ++rr) { const int r = r0 + rr, tl = c * 64 + r;
            const float u = bf2f(*(LAS bf16_t*)(XT + (r + 15) * 528 + ch * 2));
            if (rr > 0) sum += u - bf2f(*(LAS bf16_t*)(XT + (r + 15 - w) * 528 + ch * 2));
            const float rc = __builtin_amdgcn_rcpf((float)((tl + 1 < w) ? tl + 1 : w));
            *(LAS bf16_t*)(RS + r * 528 + ch * 2) = (bf16_t)f2bf(sum * rc - u); }
    } else {
#pragma unroll 1
        for (int pr = 0; pr < 8; ++pr) { const int idx = pr * 512 + tid, ch = idx & 255, sq = idx >> 8, g = ch >> 6, w = 2 << g;
            const int sb = (it - 256) * 16 + sq;
            const float* sbuf = A.in[I_SPOOL] + (size_t)(l * 128 + sb) * 15 * 256 + ch;
            const bf16_t* base = PROJ + (size_t)(NP + sb * 4) * NPROJ + PC_POOL + ch;
            float e[19];
#pragma unroll
            for (int j = 0; j < 15; ++j) e[j] = sbuf[j * 256];
#pragma unroll
            for (int j = 0; j < 4; ++j) e[15 + j] = bf2f(base[(size_t)j * NPROJ]);
#pragma unroll
            for (int t = 0; t < 4; ++t) { float sum = 0.f;
#pragma unroll
                for (int j = 0; j < 16; ++j) sum += (j < w) ? e[15 + t - j] : 0.f;
                *(LAS bf16_t*)(RS + (sq * 4 + t) * 528 + ch * 2) = (bf16_t)f2bf(sum * __builtin_amdgcn_rcpf((float)w) - e[15 + t]); } }
    }
    __syncthreads();
    { const int g2 = wave >> 1; const bf16_t* PT = (const bf16_t*)(A.ws + WS_POOLT + l * SZ_POOLT) + g2 * 4096;
      f32x4 acc[4][2];
#pragma unroll
      for (int mt = 0; mt < 4; ++mt) { acc[mt][0] = (f32x4){0.f, 0.f, 0.f, 0.f}; acc[mt][1] = (f32x4){0.f, 0.f, 0.f, 0.f}; }
#pragma unroll
      for (int kk = 0; kk < 2; ++kk) { bf16x8 bfr[2];
#pragma unroll
          for (int nt = 0; nt < 2; ++nt) bfr[nt] = *(const bf16x8*)(PT + (size_t)((wave & 1) * 32 + nt * 16 + fr) * 64 + kk * 32 + quad * 8);
#pragma unroll
          for (int mt = 0; mt < 4; ++mt) { const bf16x8 a = *(LAS bf16x8*)(RS + (mt * 16 + fr) * 528 + (g2 * 64 + kk * 32 + quad * 8) * 2);
              acc[mt][0] = mfma16(a, bfr[0], acc[mt][0]); acc[mt][1] = mfma16(a, bfr[1], acc[mt][1]); } }
#pragma unroll
      for (int nt = 0; nt < 2; ++nt) { const int col = 32 * wave + nt * 16 + fr; const float ps = A.in[I_POOLS][l * 256 + col];
#pragma unroll
          for (int mt = 0; mt < 4; ++mt)
#pragma unroll
              for (int i = 0; i < 4; ++i) { const int t = mt * 16 + quad * 4 + i; MIX[(size_t)(tok0 + t) * D + 768 + col] = (bf16_t)f2bf(acc[mt][nt][i] * ps); } } }
    __syncthreads();
}

__device__ __forceinline__ void state_copies(const DevArgs& A, int l, int gt, int NT) {
    const bf16_t* PROJ = (const bf16_t*)(A.ws + WS_PROJ);
#pragma unroll 1
    for (int i = gt; i < 8 * 3 * 1536; i += NT) { const int col = i % 1536, j = (i / 1536) % 3, b = i / 4608;
        A.out[O_CP + (size_t)l * 8 * 4608 + i] = bf2f(PROJ[(size_t)(b * SEQ + SEQ - 3 + j) * NPROJ + col]); }
#pragma unroll 1
    for (int i = gt; i < 128 * 3 * 1536; i += NT) { const int col = i % 1536, j = (i / 1536) % 3, b = i / 4608;
        A.out[O_CS + (size_t)l * 128 * 4608 + i] = bf2f(PROJ[(size_t)(NP + b * 4 + 1 + j) * NPROJ + col]); }
#pragma unroll 1
    for (int i = gt; i < 8 * 15 * 256; i += NT) { const int ch = i & 255, j = (i >> 8) % 15, b = i / 3840;
        A.out[O_PP + (size_t)l * 8 * 3840 + i] = bf2f(PROJ[(size_t)(b * SEQ + SEQ - 15 + j) * NPROJ + PC_POOL + ch]); }
#pragma unroll 1
    for (int i = gt; i < 128 * 15 * 256; i += NT) { const int ch = i & 255, j = (i >> 8) % 15, b = i / 3840;
        A.out[O_PS + (size_t)l * 128 * 3840 + i] = (j < 11) ? A.in[I_SPOOL][((size_t)(l * 128 + b) * 15 + 4 + j) * 256 + ch]
                                                             : bf2f(PROJ[(size_t)(NP + b * 4 + (j - 11)) * NPROJ + PC_POOL + ch]); }
}

#ifndef REP_DPREP
#define REP_DPREP 1
#endif
#ifndef REP_DSAMP
#define REP_DSAMP 1
#endif
#ifndef REP_SSM1
#define REP_SSM1 1
#endif
#ifndef REP_POOL
#define REP_POOL 1
#endif
#ifndef REP_DSCAN
#define REP_DSCAN 1
#endif
#ifndef REP_SSM2
#define REP_SSM2 1
#endif
#ifndef REP_G
#define REP_G 1
#endif
#ifndef REP_P3
#define REP_P3 1
#endif
#ifndef REP_P2
#define REP_P2 1
#endif
constexpr int NPH = 2 + DEPTH * 8;
__global__ void __launch_bounds__(512, 2) mega_fwd(Args KA) {
    DevArgs A; A.out = KA.out; A.ws = KA.ws; A.ph_lo = KA.ph_lo; A.ph_hi = KA.ph_hi;
    extern __shared__ __attribute__((aligned(16))) unsigned char lds_raw[];
    LAS unsigned char* lds = (LAS unsigned char*)lds_raw;
    cg::grid_group grid = cg::this_grid();
    volatile LAS unsigned* xst = (volatile LAS unsigned*)(lds + LDS_BYTES - 64);
    if (threadIdx.x == 0) { xst[0] = 0u; xst[1] = 0u; }
    __syncthreads();
    const XcdBarrier xb = xcd_barrier_post((unsigned*)(KA.ws + WS_BAR), xst);
    if (KA.ph_lo < 0) grid.sync();
    constexpr int G = 256, NGW = G * 8, NT = G * 512;
    int ph = 0;
#define PH_BEGIN if (A.ph_lo <= ph && ph < A.ph_hi) { int tid = threadIdx.x; asm volatile("" : "+v"(tid)); { unsigned char* _w = A.ws; asm volatile("" : "+s"(_w)); A.ws = _w; float* _o = A.out; asm volatile("" : "+s"(_o)); A.out = _o; } const int wave = __builtin_amdgcn_readfirstlane(tid >> 6), lane = tid & 63, gw = blockIdx.x * 8 + wave, gt = blockIdx.x * 512 + tid; (void)gw; (void)gt; (void)lane;
#define PH_END   if (ph + 1 < A.ph_hi) xcd_barrier(xb); } ++ph;
#define Hb   ((bf16_t*)(A.ws + WS_H))
#define AB   ((float*)(A.ws + WS_AB))
#define MIXO ((float*)(A.ws + WS_MIXO))
#define PROJ ((bf16_t*)(A.ws + WS_PROJ))
#define MIX  ((bf16_t*)(A.ws + WS_MIX))
#define HID  ((bf16_t*)(A.ws + WS_HID))
#define RSCBUF ((float*)(A.ws + WS_RSC))
#define XBUF ((bf16_t*)(A.ws + WS_MIXO + (size_t)NTOK * D * 2))

#ifndef REP_PRO
#define REP_PRO 1
#endif
#ifndef REP_N0
#define REP_N0 1
#endif
    PH_BEGIN for (int rep = 0; rep < REP_PRO; ++rep) { prologue(A, lds, wave, lane, gw, NGW); __syncthreads(); } PH_END
    PH_BEGIN for (int rep = 0; rep < REP_N0; ++rep) norm_rows(nullptr, nullptr, A.in[I_XP], A.in[I_XS], nullptr, A.in[I_NMPRE], RSCBUF, (const float*)(A.ws + WS_WAB), AB, gw, NGW, lane, nullptr, 0, nullptr, XBUF); PH_END

#pragma unroll 1
    for (int l = 0; l < DEPTH; ++l) {
        PH_BEGIN for (int rep = 0; rep < REP_G; ++rep) { pg8::Gemm g{XBUF, (const bf16_t*)(A.ws + WS_WIN + l * SZ_WIN), NTOK, NPROJ, D, D, D}; pg8::StaticOrder S; S.init(NTOK, NPROJ, G, (int)blockIdx.x);
            EpiBf16Scale E{PROJ, NPROJ, RSCBUF}; pg8::gemm_phase<EpiBf16Scale, pg8::StaticOrder>(lds, g, S, E, nullptr); } PH_END
        constexpr int SUBC = 7;
        PH_BEGIN {
#pragma unroll 1
          for (int rep2 = 0; rep2 < REP_P2; ++rep2) {
#pragma unroll 1
            for (int j = blockIdx.x; j < 32 * SUBC; j += G) delta_prep_item(A, l, lds, (j & 31) * 32 + (j >> 5), tid, wave, lane);
            if (blockIdx.x >= 32 * SUBC) {
#pragma unroll 1
                for (int it = (blockIdx.x - 32 * SUBC) * 8 + wave; it < 768; it += (G - 32 * SUBC) * 8) { int t1 = threadIdx.x; asm volatile("" : "+v"(t1)); ssm_part1_item(A, l, it, t1 & 63); } }
          }
        } PH_END
        PH_BEGIN {
#pragma unroll 1
            for (int rep3 = 0; rep3 < REP_P3; ++rep3) {
                if (blockIdx.x < 32) delta_scan_item(A, l, lds, blockIdx.x, tid, wave, lane, xb, SUBC);
                else { const int w = blockIdx.x - 32; constexpr int NW = G - 32;
#pragma unroll 1
                    for (int k = 1; k <= 5; ++k) {
                        const int n0 = k * SUBC, nn = (n0 >= 32) ? 0 : ((32 - n0 < SUBC) ? 32 - n0 : SUBC);
                        int nprep = 32 * nn;
#ifndef REP_WPREP
#define REP_WPREP 1
#endif
#pragma unroll 1
                        for (int rep = 0; rep < REP_WPREP; ++rep)
#pragma unroll 1
                        for (int j = w; j < nprep; j += NW) delta_prep_item(A, l, lds, (j & 31) * 32 + n0 + (j >> 5), tid, wave, lane);
                        { const int s_lo = (k == 4) ? 448 : 0, s_hi = (k == 1) ? 448 : ((k == 4) ? 512 : 0);
#pragma unroll 1
                          for (int it = s_lo + w; it < s_hi; it += NW) delta_sample_item(A, l, lds, it, tid, wave, lane); }
                        if (k == 2) {
#pragma unroll 1
                            for (int it = 768 + w * 8 + wave; it < 8 * 31 * 16; it += NW * 8) { int t1 = threadIdx.x; asm volatile("" : "+v"(t1)); ssm_part1_item(A, l, it, t1 & 63); }
                            { int t2 = threadIdx.x; asm volatile("" : "+v"(t2)); int wl = blockIdx.x; asm volatile("" : "+s"(wl)); state_copies(A, l, (wl - 32) * 512 + t2, NW * 512); } }
                        { const int pit = (k == 3) ? w : ((k == 4 && w >= 64 && w < 104) ? 160 + w : -1);
                          if (pit >= 0 && pit < 264) pool_item(A, l, lds, pit, tid, wave, lane); }
                        { const int it = (k == 4) ? w - 128 : ((k == 5) ? 96 + w : -1);
                          if (it >= 0 && it < ((k == 4) ? 96 : 264)) ssm_part2_item(A, l, lds, it, tid, wave, lane); }
                        if (k < 5) xcd_barrier(xb);
                    } }
            }
        } PH_END
        PH_BEGIN for (int rep = 0; rep < REP_G; ++rep) { pg8::Gemm g{MIX, (const bf16_t*)(A.ws + WS_WOUT + l * SZ_WOUT), NP, D, D, D, D}; pg8::StaticOrder S; S.init(NP, D, G, (int)blockIdx.x);
            pg8::EpiBf16<0> E{(bf16_t*)MIXO, D, nullptr, 0, 0}; pg8::gemm_phase<pg8::EpiBf16<0>, pg8::StaticOrder>(lds, g, S, E, nullptr);
            pg8::Gemm g2{MIX + (size_t)NP * D, (const bf16_t*)(A.ws + WS_WOUT + l * SZ_WOUT), NS, D, 256, D, D}; SliceOrder S2{8 * (D / 256), G, (int)blockIdx.x};
            EpiF32Part E2{(float*)(A.ws + WS_PARTS)}; pg8::gemm_phase<EpiF32Part, SliceOrder>(lds, g2, S2, E2, nullptr); } PH_END
#ifndef REP_N5
#define REP_N5 1
#endif
        PH_BEGIN norm_rows_pf(MIXO, A.in[I_NMPOST] + l * D, XBUF, RSCBUF, gw, NGW, lane, (const float*)(A.ws + WS_PARTS), D / 256); PH_END
        PH_BEGIN for (int rep = 0; rep < REP_G; ++rep) { pg8::Gemm g{XBUF, (const bf16_t*)(A.ws + WS_WGU + l * SZ_WGU), NTOK, NGU, D, D, D}; pg8::StaticOrder S; S.init(NTOK, NGU, G, (int)blockIdx.x);
            EpiSwiGLU E{HID, DFF, RSCBUF}; pg8::gemm_phase<EpiSwiGLU, pg8::StaticOrder>(lds, g, S, E, nullptr); } PH_END
        PH_BEGIN for (int rep = 0; rep < REP_G; ++rep) { pg8::Gemm g{HID, (const bf16_t*)(A.ws + WS_WDN + l * SZ_WDN), NP, D, DFF, DFF, DFF}; pg8::StaticOrder S; S.init(NP, D, G, (int)blockIdx.x);
            pg8::EpiBf16<0> E{(bf16_t*)MIXO, D, nullptr, 0, 0}; pg8::gemm_phase<pg8::EpiBf16<0>, pg8::StaticOrder>(lds, g, S, E, nullptr);
            pg8::Gemm g2{HID + (size_t)NP * DFF, (const bf16_t*)(A.ws + WS_WDN + l * SZ_WDN), NS, D, 256, DFF, DFF}; SliceOrder S2{8 * (DFF / 256), G, (int)blockIdx.x};
            EpiF32Part E2{(float*)(A.ws + WS_PARTS)}; pg8::gemm_phase<EpiF32Part, SliceOrder>(lds, g2, S2, E2, nullptr); } PH_END
        PH_BEGIN norm_rows(MIXO, A.in[I_NFPOST] + l * D, nullptr, nullptr, l + 1 < DEPTH ? nullptr : A.out, l + 1 < DEPTH ? A.in[I_NMPRE] + (l + 1) * D : nullptr, l + 1 < DEPTH ? RSCBUF : nullptr,
                           l + 1 < DEPTH ? (const float*)(A.ws + WS_WAB + (l + 1) * SZ_WAB) : nullptr, AB, gw, NGW, lane, (const float*)(A.ws + WS_PARTS), DFF / 256,
                           XBUF, l + 1 < DEPTH ? XBUF : nullptr); PH_END
    }
#undef PH_BEGIN
#undef PH_END
#undef Hb
#undef AB
#undef MIXO
#undef PROJ
#undef MIX
#undef HID
#undef XBUF
#undef RSCBUF
}

extern "C" void kernel_launch(void* const* d_in, const int* in_sizes, int n_in, void* d_out, int out_size, void* d_ws, size_t ws_size, hipStream_t stream) {
    static int grid = 0;
    if (grid == 0) {
        if (n_in != 32 || (size_t)out_size != O_END || ws_size < WS_END) fprintf(stderr, "kernel_launch: unexpected sizes: n_in %d out %d (want %zu) ws %zu (want >= %zu)\n", n_in, out_size, (size_t)O_END, ws_size, (size_t)WS_END);
        int dev = 0, cus = 0, per_cu = 0;
        (void)hipGetDevice(&dev); (void)hipDeviceGetAttribute(&cus, hipDeviceAttributeMultiprocessorCount, dev);
        if (hipFuncSetAttribute((const void*)mega_fwd, hipFuncAttributeMaxDynamicSharedMemorySize, LDS_BYTES) != hipSuccess) fprintf(stderr, "kernel_launch: hipFuncSetAttribute failed\n");
        if (hipOccupancyMaxActiveBlocksPerMultiprocessor(&per_cu, (const void*)mega_fwd, 512, LDS_BYTES) != hipSuccess || per_cu < 1) { fprintf(stderr, "kernel_launch: occupancy query gave %d\n", per_cu); per_cu = 1; (void)hipGetLastError(); }
        grid = cus * per_cu; if (grid <= 0) grid = 256;
        if (grid >= 256) grid = 256;
        fprintf(stderr, "kernel_launch: grid %d (cus %d x %d)%s\n", grid, cus, per_cu, grid < 256 ? "  ERROR: this build needs >= 256 co-resident workgroups" : "");
    }
    (void)hipMemsetAsync((unsigned char*)d_ws + WS_BAR, 0, 16384, stream);
    Args a{};
    for (int i = 0; i < 32; ++i) a.in[i] = (const float*)d_in[i];
    a.out = (float*)d_out; a.ws = (unsigned char*)d_ws;
#if MK_COOP
    a.ph_lo = 0; a.ph_hi = NPH;
    void* args[] = {&a};
    const hipError_t e = hipLaunchCooperativeKernel((const void*)mega_fwd, dim3(grid), dim3(512), args, LDS_BYTES, stream);
    if (e != hipSuccess) fprintf(stderr, "kernel_launch: cooperative launch failed: %s (grid %d)\n", hipGetErrorString(e), grid);
#else
    for (int p = 0; p < NPH; ++p) { a.ph_lo = p; a.ph_hi = p + 1; hipLaunchKernelGGL(mega_fwd, dim3(grid), dim3(512), LDS_BYTES, stream, a); }
#endif
}
```

```cpp
#include <hip/hip_runtime.h>
#include <hip/hip_cooperative_groups.h>
#include <cstdio>
#include <cstdint>
namespace cg = cooperative_groups;
#ifndef MK_COOP
#define MK_COOP 1
#endif
namespace pg8 {
#define PG8_LAS __attribute__((address_space(3)))
typedef unsigned short bf16_t;
typedef short bf16x8 __attribute__((ext_vector_type(8)));
typedef float f32x4 __attribute__((ext_vector_type(4)));
typedef unsigned u32x4 __attribute__((ext_vector_type(4)));
constexpr int BM = 256, BK = 64, HALF = 128, HTB = HALF * BK * 2  , STAGE_BYTES = 8 * HTB, NXCD = 8, WGM = 8;

__host__ __device__ __forceinline__ int lds_byte(int r, int c) { const int st = (r >> 4) * 2 + (c >> 5), rr = r & 15, cc = c & 31, ob = rr * 64 + cc * 2; return st * 1024 + (ob ^ (((ob >> 9) & 1) << 5)); }
__host__ __device__ __forceinline__ void stage_rc(int b, int& R, int& C) { const int st = b / 1024, sb = b % 1024, swz = sb ^ (((sb >> 9) & 1) << 5); R = (st >> 1) * 16 + swz / 64; C = (st & 1) * 32 + (swz % 64) / 2; }
__host__ __device__ __forceinline__ int perm32(int rho) { const int n = rho >> 4, i = rho & 15; return 8 * (i >> 2) + 4 * n + (i & 3); }

struct Unit { int pm, pn, ks; };
struct Gemm { const bf16_t* A; const bf16_t* Bt; int M, N, K, lda, ldb; };

struct StaticOrder {
    int nM, nN, nwg, G, c;
    __host__ __device__ void init(int M, int N, int G_, int c_) { nM = M / BM; nN = N / BM; nwg = nM * nN; G = G_; c = c_; }
    __host__ __device__ bool next(int i, Unit& u) const {
        const long L = (long)i * G + c; if (L >= nwg) return false;
        int wgid = (int)L; { const int q = nwg / NXCD, r = nwg % NXCD, xcd = wgid % NXCD, off = wgid / NXCD; wgid = (xcd < r ? xcd * (q + 1) : r * (q + 1) + (xcd - r) * q) + off; }
        const int nig = WGM * nN, gid = wgid / nig, fm = gid * WGM, gsz = (nM - fm) < WGM ? (nM - fm) : WGM;
        u.pm = fm + ((wgid % nig) % gsz); u.pn = (wgid % nig) / gsz; u.ks = 0; return true;
    }
    __device__ __forceinline__ void a_ready(const Unit&) const {}
    __device__ __forceinline__ void done(const Unit&) const {}
};
__device__ __forceinline__ unsigned cvt_pk_bf16(float lo, float hi) { unsigned r; asm volatile("v_cvt_pk_bf16_f32 %0, %1, %2" : "=v"(r) : "v"(lo), "v"(hi)); return r; }
typedef float f32x2 __attribute__((ext_vector_type(2)));
__device__ __forceinline__ f32x2 gelu_pk(f32x2 v) {
    const f32x2 av = __builtin_elementwise_abs(v), d = av * 0.2316418882f + 1.0f;
    f32x2 t; t.x = __builtin_amdgcn_rcpf(d.x); t.y = __builtin_amdgcn_rcpf(d.y);
    f32x2 q = t * 0.5307027145f + (-0.7265760135f); q = q * t + 0.7107068705f; q = q * t + (-0.142248368f); q = q * t + 0.127414796f; q = q * t;
    const f32x2 s = (v * v) * (-0.72134752044f);
    f32x2 e; e.x = __builtin_amdgcn_exp2f(s.x); e.y = __builtin_amdgcn_exp2f(s.y);
    const f32x2 m = v * (q * e), r = v - m;
    f32x2 o; o.x = v.x < 0.f ? m.x : r.x; o.y = v.y < 0.f ? m.y : r.y; return o;
}

struct EpiF32 {
    static constexpr bool PERM = false, AFTER_DRAIN = false;
    float* C; int ldc; const float* bias;
    __device__ __forceinline__ void operator()(const f32x4 (&acc)[2][2][4][2], const Unit& u, int wr, int wc, int fr, int fq) const {
        const int row0 = u.pm * BM + wr * 64 + fr, col0 = u.pn * BM + wc * 32 + 4 * fq;
        f32x4 bv[2][2];
#pragma unroll
        for (int bj = 0; bj < 2; ++bj)
#pragma unroll
            for (int n = 0; n < 2; ++n) bv[bj][n] = bias ? *(const f32x4*)(bias + col0 + bj * HALF + n * 16) : (f32x4){0.f, 0.f, 0.f, 0.f};
#pragma unroll
        for (int ai = 0; ai < 2; ++ai)
#pragma unroll
            for (int m = 0; m < 4; ++m) { float* rowp = C + (size_t)(row0 + ai * HALF + m * 16) * ldc + col0;
#pragma unroll
                for (int bj = 0; bj < 2; ++bj)
#pragma unroll
                    for (int n = 0; n < 2; ++n) *(f32x4*)(rowp + bj * HALF + n * 16) = acc[ai][bj][m][n] + bv[bj][n]; }
    }
};
template <int ACT  > struct EpiBf16 {
    static constexpr bool PERM = true, AFTER_DRAIN = false;
    bf16_t* O; int ldc; const float* bias; int split_cols; size_t split_stride;
    __device__ __forceinline__ void operator()(const f32x4 (&acc)[2][2][4][2], const Unit& u, int wr, int wc, int fr, int fq) const {
        const int row0 = u.pm * BM + wr * 64 + fr; int colt = u.pn * BM; bf16_t* base = O;
        if (split_cols) { const int t = colt / split_cols; base += (size_t)t * split_stride; colt -= t * split_cols; }
        const int col0 = colt + wc * 32 + 8 * fq, bcol0 = u.pn * BM + wc * 32 + 8 * fq;
        f32x4 bv[2][2];
#pragma unroll
        for (int bj = 0; bj < 2; ++bj)
#pragma unroll
            for (int n = 0; n < 2; ++n) bv[bj][n] = bias ? *(const f32x4*)(bias + bcol0 + bj * HALF + 4 * n) : (f32x4){0.f, 0.f, 0.f, 0.f};
#pragma unroll
        for (int ai = 0; ai < 2; ++ai)
#pragma unroll
            for (int m = 0; m < 4; ++m) { bf16_t* rowp = base + (size_t)(row0 + ai * HALF + m * 16) * ldc + col0;
#pragma unroll
                for (int bj = 0; bj < 2; ++bj) { f32x4 v0 = acc[ai][bj][m][0] + bv[bj][0], v1 = acc[ai][bj][m][1] + bv[bj][1];
                    if (ACT == 1) { f32x2 a = gelu_pk((f32x2){v0[0], v0[1]}), b = gelu_pk((f32x2){v0[2], v0[3]}), c = gelu_pk((f32x2){v1[0], v1[1]}), d = gelu_pk((f32x2){v1[2], v1[3]});
                        v0 = (f32x4){a.x, a.y, b.x, b.y}; v1 = (f32x4){c.x, c.y, d.x, d.y}; }
                    if (ACT == 2) {
#pragma unroll
                        for (int j = 0; j < 4; ++j) { v0[j] = 0.5f * v0[j] * (1.0f + erff(v0[j] * 0.70710678f)); v1[j] = 0.5f * v1[j] * (1.0f + erff(v1[j] * 0.70710678f)); } }
                    u32x4 w; w.x = cvt_pk_bf16(v0[0], v0[1]); w.y = cvt_pk_bf16(v0[2], v0[3]); w.z = cvt_pk_bf16(v1[0], v1[1]); w.w = cvt_pk_bf16(v1[2], v1[3]);
                    *(u32x4*)(rowp + bj * HALF) = w; } }
    }
};
template <class Epi, class Sched, bool STAMP = false>
__device__ __forceinline__ void gemm_phase(PG8_LAS unsigned char* lds, const Gemm g, const Sched& S, const Epi& E, unsigned long long* stamps) {
    int tid_ = threadIdx.x; asm volatile("" : "+v"(tid_));
    const int tid = tid_, wid = __builtin_amdgcn_readfirstlane(tid >> 6), lane = tid & 63, wr = wid >> 2, wc = wid & 3, fr = lane & 15, fq = lane >> 4;
    const int K = g.K, nt = K / BK;
    int ts_lo = 0, ts_hi = 0, nts = 0; const unsigned long long rt_entry = STAMP ? (unsigned long long)wall_clock64() : 0ull;
#define PG8_STAMP() do { if (STAMP && wid == 0 && nts < 64) { const unsigned long long _c = (unsigned long long)clock64(); \
        ts_lo = (lane == nts) ? (int)(unsigned)_c : ts_lo; ts_hi = (lane == nts) ? (int)(unsigned)(_c >> 32) : ts_hi; ++nts; } } while (0)
    PG8_STAMP();
    unsigned voffA[2], voffB[2];
#pragma unroll
    for (int i = 0; i < 2; ++i) { int R, C; stage_rc(tid * 16 + i * 8192, R, C); const int Rb = Epi::PERM ? ((R & ~31) + perm32(R & 31)) : R;
        voffA[i] = (unsigned)(R * g.lda + C) * 2u; voffB[i] = (unsigned)(Rb * g.ldb + C) * 2u; }
    const size_t kstep = (size_t)(BK * 2);
    const size_t hstepA = (size_t)HALF * g.lda * 2, hstepB = (size_t)HALF * g.ldb * 2;
    const size_t tstepA = 2 * hstepA, tstepB = 2 * hstepB, sstep = (size_t)K * 2;
    const unsigned ldsw = (unsigned)wid * 1024u;
    const int aoff = lds_byte(wr * 64 + fr, fq * 8), boff = lds_byte(wc * 32 + fr, fq * 8);
#define PG8_SA(b, h) (((b) * 2 + (h)) * HTB)
#define PG8_SB(b, h) ((4 + (b) * 2 + (h)) * HTB)
#define PG8_STAGE(bufoff, gbase, voff) do { _Pragma("unroll") for (int _i = 0; _i < 2; ++_i) \
        __builtin_amdgcn_global_load_lds((const unsigned*)((const char*)(gbase) + (voff)[_i]), (PG8_LAS unsigned*)(lds + (bufoff) + ldsw + _i * 8192), 16, 0, 0); } while (0)
#define PG8_LDA(dst, b, h) do { _Pragma("unroll") for (int m = 0; m < 4; ++m) _Pragma("unroll") for (int k = 0; k < 2; ++k) dst[m][k] = *(const PG8_LAS bf16x8*)(lds + PG8_SA(b, h) + aoff + m * 2048 + k * 1024); } while (0)
#define PG8_LDB(dst, b, h) do { _Pragma("unroll") for (int n = 0; n < 2; ++n) _Pragma("unroll") for (int k = 0; k < 2; ++k) dst[n][k] = *(const PG8_LAS bf16x8*)(lds + PG8_SB(b, h) + boff + n * 2048 + k * 1024); } while (0)
#define PG8_MMA(ai, bj, At, Bt) do { __builtin_amdgcn_s_setprio(1); _Pragma("unroll") for (int m = 0; m < 4; ++m) _Pragma("unroll") for (int n = 0; n < 2; ++n) _Pragma("unroll") for (int k = 0; k < 2; ++k) \
        acc[ai][bj][m][n] = __builtin_amdgcn_mfma_f32_16x16x32_bf16(Bt[n][k], At[m][k], acc[ai][bj][m][n], 0, 0, 0); __builtin_amdgcn_s_setprio(0); } while (0)
#define PG8_WAIT_V(n) asm volatile("s_waitcnt vmcnt(" #n ")" ::: "memory")
#define PG8_WAIT_L(n) asm volatile("s_waitcnt lgkmcnt(" #n ")" ::: "memory")
#define PG8_BAR __builtin_amdgcn_s_barrier()
#define PG8_SCHED __builtin_amdgcn_sched_barrier(0)
    Unit cur, nxt; int ui = 0;
    if (!S.next(0, cur)) return;
    f32x4 acc[2][2][4][2];
#pragma unroll
    for (int a = 0; a < 2; ++a)
#pragma unroll
        for (int b = 0; b < 2; ++b)
#pragma unroll
            for (int m = 0; m < 4; ++m)
#pragma unroll
                for (int n = 0; n < 2; ++n) acc[a][b][m][n] = (f32x4){0.f, 0.f, 0.f, 0.f};
    bf16x8 At[4][2], B0[2][2], B1[2][2];
    const char* cA = (const char*)g.A + (size_t)cur.pm * tstepA + (size_t)cur.ks * sstep; const char* cB = (const char*)g.Bt + (size_t)cur.pn * tstepB + (size_t)cur.ks * sstep;
    S.a_ready(cur);
    PG8_STAGE(PG8_SB(0, 0), cB, voffB); PG8_STAGE(PG8_SA(0, 0), cA, voffA); PG8_STAGE(PG8_SB(0, 1), cB + hstepB, voffB); PG8_STAGE(PG8_SA(0, 1), cA + hstepA, voffA);
    if (wr == 1) PG8_BAR;
    PG8_WAIT_V(4); PG8_BAR;
    PG8_STAGE(PG8_SB(1, 0), cB + kstep, voffB); PG8_STAGE(PG8_SA(1, 0), cA + kstep, voffA); PG8_STAGE(PG8_SB(1, 1), cB + hstepB + kstep, voffB);
    PG8_WAIT_V(6); PG8_BAR;
    PG8_STAMP();
    for (;;) {
        const bool has_next = S.next(ui + 1, nxt);
        const char* nA = has_next ? (const char*)g.A + (size_t)nxt.pm * tstepA + (size_t)nxt.ks * sstep : cA; const char* nB = has_next ? (const char*)g.Bt + (size_t)nxt.pn * tstepB + (size_t)nxt.ks * sstep : cB;
        for (int t = 0; t < nt; t += 2) {
            const bool last = (t == nt - 2);
            const char* a1 = cA + (size_t)(t + 1) * kstep;
            const char* a2 = last ? nA : cA + (size_t)(t + 2) * kstep; const char* b2 = last ? nB : cB + (size_t)(t + 2) * kstep;
            const char* a3 = a2 + kstep; const char* b3 = b2 + kstep;
            if (last && has_next) S.a_ready(nxt);
            PG8_LDB(B0, 0, 0); PG8_SCHED; PG8_LDA(At, 0, 0); PG8_STAGE(PG8_SA(1, 1), a1 + hstepA, voffA);
            PG8_WAIT_L(8); PG8_BAR; PG8_WAIT_L(0); PG8_MMA(0, 0, At, B0); PG8_BAR; PG8_SCHED;
            PG8_LDB(B1, 0, 1); PG8_STAGE(PG8_SB(0, 0), b2, voffB);
            PG8_BAR; PG8_WAIT_L(0); PG8_MMA(0, 1, At, B1); PG8_BAR;
            PG8_LDA(At, 0, 1); PG8_STAGE(PG8_SA(0, 0), a2, voffA);
            PG8_BAR; PG8_WAIT_L(0); PG8_MMA(1, 0, At, B0); PG8_BAR; PG8_SCHED;
            PG8_STAGE(PG8_SB(0, 1), b2 + hstepB, voffB);
            PG8_WAIT_V(6); PG8_BAR; PG8_MMA(1, 1, At, B1); PG8_BAR;
            PG8_LDB(B0, 1, 0); PG8_SCHED; PG8_LDA(At, 1, 0); PG8_STAGE(PG8_SA(0, 1), a2 + hstepA, voffA);
            PG8_WAIT_L(8); PG8_BAR; PG8_WAIT_L(0); PG8_MMA(0, 0, At, B0); PG8_BAR; PG8_SCHED;
            PG8_LDB(B1, 1, 1); PG8_STAGE(PG8_SB(1, 0), b3, voffB);
            PG8_BAR; PG8_WAIT_L(0); PG8_MMA(0, 1, At, B1); PG8_BAR;
            PG8_LDA(At, 1, 1); PG8_STAGE(PG8_SA(1, 0), a3, voffA);
            PG8_BAR; PG8_WAIT_L(0); PG8_MMA(1, 0, At, B0); PG8_BAR; PG8_SCHED;
            PG8_STAGE(PG8_SB(1, 1), b3 + hstepB, voffB);
            PG8_WAIT_V(6); PG8_BAR; PG8_MMA(1, 1, At, B1); PG8_BAR;
        }
        PG8_STAMP();
        if constexpr (!Epi::AFTER_DRAIN) { E(acc, cur, wr, wc, fr, fq); S.done(cur); }
        PG8_STAMP();
        if (!has_next) break;
#pragma unroll
        for (int a = 0; a < 2; ++a)
#pragma unroll
            for (int b = 0; b < 2; ++b)
#pragma unroll
                for (int m = 0; m < 4; ++m)
#pragma unroll
                    for (int n = 0; n < 2; ++n) acc[a][b][m][n] = (f32x4){0.f, 0.f, 0.f, 0.f};
        cur = nxt; cA = nA; cB = nB; ++ui;
    }
    PG8_WAIT_V(0);
    if (wr == 0) PG8_BAR;
    PG8_BAR;
    if constexpr (Epi::AFTER_DRAIN) { E.fused(acc, cur, wr, wc, fr, fq, lds, wid, lane); S.done(cur); }
    PG8_STAMP();
    if (STAMP && wid == 0) { stamps[lane] = lane < nts ? (((unsigned long long)(unsigned)ts_hi << 32) | (unsigned)ts_lo) : 0ull;
        if (lane == 62) stamps[62] = rt_entry; if (lane == 63) stamps[63] = (unsigned long long)wall_clock64(); }
#undef PG8_STAMP
#undef PG8_SA
#undef PG8_SB
#undef PG8_STAGE
#undef PG8_LDA
#undef PG8_LDB
#undef PG8_MMA
#undef PG8_WAIT_V
#undef PG8_WAIT_L
#undef PG8_BAR
#undef PG8_SCHED
}
}

#define LAS __attribute__((address_space(3)))
typedef unsigned short bf16_t;
typedef short bf16x8 __attribute__((ext_vector_type(8)));
typedef float f32x4 __attribute__((ext_vector_type(4)));
typedef float f32x2 __attribute__((ext_vector_type(2)));
typedef unsigned u32x4 __attribute__((ext_vector_type(4)));
typedef unsigned u32x2 __attribute__((ext_vector_type(2)));

constexpr int D = 1024, NP = 16384, NS = 512, NTOK = NP + NS, SEQ = 2048, NB = 8, NSB = 128, DEPTH = 4;
constexpr int INW = 2568, NPROJ = 2560, DFF = 2816, NGU = 5632;
constexpr int PC_G = 1536, PC_SSM = 2048, PC_POOL = 2304;
constexpr float EPS = 1e-6f;
constexpr int LDS_BYTES = 163840;

constexpr size_t SZ_WIN = (size_t)NPROJ * D * 2, SZ_WOUT = (size_t)D * D * 2, SZ_WGU = (size_t)NGU * D * 2, SZ_WDN = (size_t)D * DFF * 2;
constexpr size_t SZ_WAB = 8 * D * 4, SZ_GLUT = 256 * 256 * 2, SZ_POOLT = 4 * 64 * 64 * 2, SZ_SSMK = 16 * 64 * 4 * 4, SZ_BBAR = 16 * 64 * 32 * 4;
constexpr size_t WS_WIN = 0;
constexpr size_t WS_WOUT = WS_WIN + DEPTH * SZ_WIN;
constexpr size_t WS_WGU = WS_WOUT + DEPTH * SZ_WOUT;
constexpr size_t WS_WDN = WS_WGU + DEPTH * SZ_WGU;
constexpr size_t WS_WAB = WS_WDN + DEPTH * SZ_WDN;
constexpr size_t WS_GLUT = WS_WAB + DEPTH * SZ_WAB;
constexpr size_t WS_POOLT = WS_GLUT + DEPTH * SZ_GLUT;
constexpr size_t WS_SSMK = WS_POOLT + DEPTH * SZ_POOLT;
constexpr size_t WS_BBAR = WS_SSMK + DEPTH * SZ_SSMK;
constexpr size_t WS_H = WS_BBAR + DEPTH * SZ_BBAR;
constexpr size_t WS_AB = WS_H + (size_t)NTOK * D * 2;
constexpr size_t WS_MIX = WS_AB + (size_t)NTOK * 8 * 4;
constexpr size_t WS_MIXO = WS_MIX + (size_t)NTOK * D * 2;
constexpr size_t WS_SSME = WS_MIXO + (size_t)NTOK * D * 4;
constexpr size_t WS_PROJ = WS_SSME + (size_t)8 * 32 * 16 * 64 * 2 * 4;
constexpr size_t WS_DW = WS_PROJ + (size_t)NTOK * NPROJ * 2;
constexpr size_t WS_DKC = WS_DW + (size_t)1024 * 8192 * 4;
constexpr size_t WS_DQD = WS_DKC + (size_t)1024 * 8192 * 2;
constexpr size_t WS_DQK = WS_DQD + (size_t)1024 * 8192 * 2;
constexpr size_t WS_DKT = WS_DQK + (size_t)1024 * 4096 * 2;
constexpr size_t WS_DGL = WS_DKT + (size_t)1024 * 8192 * 2;
constexpr size_t WS_DGS = WS_DGL + 4096;
constexpr size_t WS_BAR = WS_DGS + (size_t)1024 * 8192 * 2;
constexpr size_t WS_PARTS = WS_BAR + 16384;
constexpr size_t WS_RSC = WS_PARTS + (size_t)11 * 512 * 1024 * 4;
constexpr size_t WS_END = WS_RSC + (size_t)NTOK * 4;
constexpr size_t WS_HID = WS_PROJ;
static_assert(WS_HID + (size_t)NTOK * DFF * 2 <= WS_END, "HID overlay");
static_assert(WS_H % 256 == 0 && WS_PROJ % 256 == 0 && WS_DW % 256 == 0, "align");

constexpr size_t O_YP = 0, O_YS = O_YP + (size_t)NP * D, O_DP = O_YS + (size_t)NS * D, O_CP = O_DP + (size_t)DEPTH * 8 * 4 * 16384,
                 O_REP = O_CP + (size_t)DEPTH * 8 * 3 * 1536, O_IMP = O_REP + (size_t)DEPTH * 8 * 1024, O_PP = O_IMP + (size_t)DEPTH * 8 * 1024,
                 O_DS = O_PP + (size_t)DEPTH * 8 * 15 * 256, O_CS = O_DS + (size_t)DEPTH * 128 * 4 * 16384, O_RES = O_CS + (size_t)DEPTH * 128 * 3 * 1536,
                 O_IMS = O_RES + (size_t)DEPTH * 128 * 1024, O_PS = O_IMS + (size_t)DEPTH * 128 * 1024, O_END = O_PS + (size_t)DEPTH * 128 * 15 * 256;

struct Args { const float* in[32]; float* out; unsigned char* ws; int ph_lo, ph_hi; };
typedef const float* cfp_t;
typedef __attribute__((address_space(4))) const unsigned char* kptr_t;
struct InProxy { __device__ __forceinline__ const float* operator[](int i) const {
    kptr_t p = (kptr_t)__builtin_amdgcn_kernarg_segment_ptr(); asm volatile("" : "+s"(p)); return *(__attribute__((address_space(4))) const cfp_t*)(p + 8 * i); } };
struct DevArgs { InProxy in; float* out; unsigned char* ws; int ph_lo, ph_hi; };
enum { I_XP = 0, I_XS, I_SDELTA, I_SCONV, I_SRE, I_SIM, I_SPOOL, I_NMPRE, I_NMPOST, I_NFPRE, I_NFPOST, I_WIN, I_CONVW, I_ALOG, I_DTB, I_ONORM,
       I_ARE, I_AIM, I_LOGDT, I_BRE, I_BIM, I_CRE, I_CIM, I_SSMD, I_GLUW, I_GLUB, I_POOLW, I_POOLS, I_WOUT, I_WG, I_WU, I_WD };

__device__ __forceinline__ unsigned f2bf(float f) { unsigned u = __float_as_uint(f); return (u + 0x7fffu + ((u >> 16) & 1u)) >> 16; }
__device__ __forceinline__ float bf2f(unsigned b) { return __uint_as_float(b << 16); }
__device__ __forceinline__ unsigned pk2(float lo, float hi) { return f2bf(lo) | (f2bf(hi) << 16); }
template <int CTRL> __device__ __forceinline__ float dpp_f(float v) { return __builtin_bit_cast(float, __builtin_amdgcn_update_dpp(0, __builtin_bit_cast(int, v), CTRL, 0xF, 0xF, true)); }
__device__ __forceinline__ float row_sum8(float v) { v += dpp_f<0xB1>(v); v += dpp_f<0x4E>(v); v += dpp_f<0x141>(v); return v; }
__device__ __forceinline__ float row_sum16(float v) { v = row_sum8(v); v += dpp_f<0x140>(v); return v; }
__device__ __forceinline__ float wave_sum(float v) { v = row_sum16(v); v += __shfl_xor(v, 16); v += __shfl_xor(v, 32); return v; }
__device__ __forceinline__ float silu_f(float y) { return y * __builtin_amdgcn_rcpf(1.f + __expf(-y)); }
__device__ __forceinline__ float sigmoid_f(float y) { return __builtin_amdgcn_rcpf(1.f + __expf(-y)); }
__device__ __forceinline__ float gelu_tanh_f(float x) { const float z = 0.7978845608028654f * (x + 0.044715f * x * x * x);
    const float t = 1.f - 2.f * __builtin_amdgcn_rcpf(1.f + __expf(2.f * z)); return 0.5f * x * (1.f + t); }
__device__ __forceinline__ f32x4 mfma16(bf16x8 a, bf16x8 b, f32x4 c) { return __builtin_amdgcn_mfma_f32_16x16x32_bf16(a, b, c, 0, 0, 0); }
#define LDS_FENCE() asm volatile("s_waitcnt lgkmcnt(0)" ::: "memory")

struct EpiSwiGLU {
    static constexpr bool PERM = false, AFTER_DRAIN = false;
    bf16_t* O; int ldc; const float* rs;
    __device__ __forceinline__ void operator()(const pg8::f32x4 (&acc)[2][2][4][2], const pg8::Unit& u, int wr, int wc, int fr, int fq) const {
        const int row0 = u.pm * 256 + wr * 64 + fr, hid0 = u.pn * 128 + wc * 16 + 4 * fq;
#pragma unroll
        for (int ai = 0; ai < 2; ++ai)
#pragma unroll
            for (int m = 0; m < 4; ++m) { const float sc = rs[row0 + ai * 128 + m * 16]; bf16_t* rowp = O + (size_t)(row0 + ai * 128 + m * 16) * ldc + hid0;
#pragma unroll
                for (int bj = 0; bj < 2; ++bj) { const pg8::f32x4 g = acc[ai][bj][m][0] * sc, v = acc[ai][bj][m][1] * sc;
                    u32x2 w; w.x = pg8::cvt_pk_bf16(silu_f(g[0]) * v[0], silu_f(g[1]) * v[1]); w.y = pg8::cvt_pk_bf16(silu_f(g[2]) * v[2], silu_f(g[3]) * v[3]);
                    *(u32x2*)(rowp + bj * 64) = w; } }
    }
};

#define XB_TMO      128
#define XB_XCNT(j)  (256  + 64 * (j))
#define XB_XSUB(j)  (1280 + 64 * (j))
#define XB_XGEN(j)  (2304 + 64 * (j))
#define XB_TOP      3328
#define XB_TOPGEN   3392
#define XCD_BAR_WORDS 3456
#define XB_SPIN_CAP (1u << 18)

__device__ __forceinline__ unsigned xb_ld(unsigned* p)              { return __hip_atomic_load(p, __ATOMIC_RELAXED, __HIP_MEMORY_SCOPE_AGENT); }
__device__ __forceinline__ unsigned xb_add(unsigned* p, unsigned v) { return __hip_atomic_fetch_add(p, v, __ATOMIC_RELAXED, __HIP_MEMORY_SCOPE_AGENT); }
__device__ __forceinline__ unsigned xb_xcc_id() { return (unsigned)__builtin_amdgcn_s_getreg((3 << 11) | 20) & 0xFu; }
#define XB_SPIN(cond, bar) do { unsigned _sp = 0; while (cond) { __builtin_amdgcn_s_sleep(1); \
    if ((++_sp & 255u) == 0u) { if (xb_ld(&(bar)[XB_TMO])) break; if (_sp > XB_SPIN_CAP) { atomicAdd(&(bar)[XB_TMO], 1u); break; } } } } while (0)

struct XcdBarrier {
    unsigned* bar; unsigned x;
    volatile LAS unsigned* st;
};

__device__ __forceinline__ XcdBarrier xcd_barrier_post(unsigned* bar, volatile LAS unsigned* st) {
    XcdBarrier b; b.bar = bar; b.x = xb_xcc_id(); b.st = st;
    if (threadIdx.x == 0) (void)xb_add(&bar[XB_XCNT(b.x)], 1u);
    return b;
}
__device__ __forceinline__ void xcd_barrier_complete(unsigned* bar, unsigned x, unsigned& nloc, unsigned& nx) {
    const unsigned G = gridDim.x * gridDim.y * gridDim.z;
    unsigned sum, cnt, mine, sp = 0u;
    for (;;) {
        sum = 0u; cnt = 0u; mine = 0u;
#pragma unroll
        for (unsigned j = 0; j < 16; ++j) { const unsigned c = xb_ld(&bar[XB_XCNT(j)]); sum += c; cnt += (c > 0u) ? 1u : 0u; mine = (j == x) ? c : mine; }
        if (sum == G) break;
        __builtin_amdgcn_s_sleep(1);
        if ((++sp & 255u) == 0u) { if (xb_ld(&bar[XB_TMO])) break; if (sp > XB_SPIN_CAP) { atomicAdd(&bar[XB_TMO], 1u); break; } }
    }
    nloc = mine > 0u ? mine : 1u; nx = cnt > 0u ? cnt : 1u;
}

__device__ __forceinline__ void xcd_barrier(const XcdBarrier& b) {
    asm volatile("s_waitcnt vmcnt(0)" ::: "memory");
    __syncthreads();
    if (threadIdx.x == 0) {
        unsigned* bar = b.bar; asm volatile("" : "+s"(bar));
        __builtin_amdgcn_s_waitcnt(0);
        unsigned nloc = b.st[0], nx = b.st[1];
        if (nloc == 0u) { xcd_barrier_complete(bar, b.x, nloc, nx); b.st[0] = nloc; b.st[1] = nx; }
        const unsigned old = xb_add(&bar[XB_XSUB(b.x)], 1u);
        const unsigned gen = old / nloc;
        if (old + 1u == (gen + 1u) * nloc) {
            __builtin_amdgcn_fence(__ATOMIC_RELEASE, "agent");
            asm volatile("s_waitcnt vmcnt(0)" ::: "memory");
            const unsigned og = xb_add(&bar[XB_TOP], 1u);
            const unsigned tg = og / nx;
            if (og + 1u == (tg + 1u) * nx) xb_add(&bar[XB_TOPGEN], 1u);
            else XB_SPIN(xb_ld(&bar[XB_TOPGEN]) == tg, bar);
            __builtin_amdgcn_fence(__ATOMIC_ACQUIRE, "agent");
            xb_add(&bar[XB_XGEN(b.x)], 1u);
            asm volatile("s_waitcnt vmcnt(0)" ::: "memory");
        } else {
            XB_SPIN(xb_ld(&bar[XB_XGEN(b.x)]) == gen, bar);
            __builtin_amdgcn_fence(__ATOMIC_ACQUIRE, "agent");
            asm volatile("s_waitcnt vmcnt(0)" ::: "memory");
        }
    }
    __syncthreads();
}

struct EpiBf16Scale {
    static constexpr bool PERM = true, AFTER_DRAIN = false;
    bf16_t* O; int ldc; const float* rs;
    __device__ __forceinline__ void operator()(const pg8::f32x4 (&acc)[2][2][4][2], const pg8::Unit& u, int wr, int wc, int fr, int fq) const {
        const int row0 = u.pm * 256 + wr * 64 + fr, col0 = u.pn * 256 + wc * 32 + 8 * fq;
#pragma unroll
        for (int ai = 0; ai < 2; ++ai)
#pragma unroll
            for (int m = 0; m < 4; ++m) { const int row = row0 + ai * 128 + m * 16; const float sc = rs[row]; bf16_t* rowp = O + (size_t)row * ldc + col0;
#pragma unroll
                for (int bj = 0; bj < 2; ++bj) { const pg8::f32x4 v0 = acc[ai][bj][m][0] * sc, v1 = acc[ai][bj][m][1] * sc;
                    u32x4 w; w.x = pg8::cvt_pk_bf16(v0[0], v0[1]); w.y = pg8::cvt_pk_bf16(v0[2], v0[3]); w.z = pg8::cvt_pk_bf16(v1[0], v1[1]); w.w = pg8::cvt_pk_bf16(v1[2], v1[3]);
                    *(u32x4*)(rowp + bj * 128) = w; } }
    }
};
struct SliceOrder {
    int nunits, G, c;
    __device__ __forceinline__ bool next(int i, pg8::Unit& u) const { const int L = i * G + c; if (L >= nunits) return false; const int t = L & 7; u.pm = t >> 2; u.pn = t & 3; u.ks = L >> 3; return true; }
    __device__ __forceinline__ void a_ready(const pg8::Unit&) const {}
    __device__ __forceinline__ void done(const pg8::Unit&) const {}
};
struct EpiF32Part {
    static constexpr bool PERM = false, AFTER_DRAIN = false;
    float* C;
    __device__ __forceinline__ void operator()(const pg8::f32x4 (&acc)[2][2][4][2], const pg8::Unit& u, int wr, int wc, int fr, int fq) const {
        const int row0 = u.pm * 256 + wr * 64 + fr, col0 = u.pn * 256 + wc * 32 + 4 * fq; float* base = C + (size_t)u.ks * (512 * 1024);
#pragma unroll
        for (int ai = 0; ai < 2; ++ai)
#pragma unroll
            for (int m = 0; m < 4; ++m) { float* rowp = base + (size_t)(row0 + ai * 128 + m * 16) * 1024 + col0;
#pragma unroll
                for (int bj = 0; bj < 2; ++bj)
#pragma unroll
                    for (int n = 0; n < 2; ++n) *(pg8::f32x4*)(rowp + bj * 128 + n * 16) = acc[ai][bj][m][n]; }
    }
};

struct SrcIn { const float* w; const float* nw; __device__ __forceinline__ float operator()(int k, int n) const { return w[(size_t)k * INW + (n < 1536 ? n : n + 8)] * nw[k]; } };
struct SrcPlain { const float* w; int N; __device__ __forceinline__ float operator()(int k, int n) const { return w[(size_t)k * N + n]; } };
struct SrcGU { const float* g; const float* u; const float* nw; __device__ __forceinline__ float operator()(int k, int n) const { const int r = n & 31, hid = (n >> 5) * 16 + (r & 15); const long long du = (r < 16) ? 0ll : (long long)(u - g); return g[du + (long long)k * DFF + hid] * nw[k]; } };
template <class Src> __device__ __forceinline__ void transpose_item(const Src& src, int K, bf16_t* WT, int nblk, LAS float* scr, int item, int lane) {
    const int kb = item / nblk, nb = item % nblk, k0 = 64 * kb, n0 = 32 * nb;
#pragma unroll 8
    for (int i = 0; i < 32; ++i) { const int kk = 2 * i + (lane >> 5); scr[kk * 33 + (lane & 31)] = src(k0 + kk, n0 + (lane & 31)); }
    LDS_FENCE();
    const int c = lane & 7;
#pragma unroll
    for (int j = 0; j < 4; ++j) { const int n = (lane >> 3) + 8 * j; const LAS float* s = scr + (8 * c) * 33 + n;
        u32x4 o; o.x = pk2(s[0 * 33], s[1 * 33]); o.y = pk2(s[2 * 33], s[3 * 33]); o.z = pk2(s[4 * 33], s[5 * 33]); o.w = pk2(s[6 * 33], s[7 * 33]);
        *(u32x4*)(WT + (size_t)(n0 + n) * K + k0 + 8 * c) = o; }
    LDS_FENCE();
}

__device__ __forceinline__ void norm_rows(const float* T, const float* wt, const float* X0, const float* X1, float* Xout, const float* wh, float* RSC,
                                          const float* Wab, float* AB, int gw, int NGW, int lane, const float* Tp = nullptr, int ns = 0,
                                          const bf16_t* Xbin = nullptr, bf16_t* Xbout = nullptr) {
#pragma unroll 1
    for (int m = gw; m < NTOK; m += NGW) {
        f32x4 x[4], t[4];
        { if (Xbin) {
#pragma unroll
              for (int j = 0; j < 4; ++j) { const u32x2 xb = ((const u32x2*)(Xbin + (size_t)m * D))[lane + 64 * j];
                  x[j] = (f32x4){__uint_as_float(xb.x << 16), __uint_as_float(xb.x & 0xffff0000u), __uint_as_float(xb.y << 16), __uint_as_float(xb.y & 0xffff0000u)}; } }
          else { const float* xr = (X1 && m >= NP) ? X1 + (size_t)(m - NP) * D : X0 + (size_t)m * D;
#pragma unroll
              for (int j = 0; j < 4; ++j) x[j] = ((const f32x4*)xr)[lane + 64 * j]; }
          if (T && !(Tp && m >= NP)) {
#pragma unroll
              for (int j = 0; j < 4; ++j) { const u32x2 tb = ((const u32x2*)((const bf16_t*)T + (size_t)m * D))[lane + 64 * j];
                  t[j] = (f32x4){__uint_as_float(tb.x << 16), __uint_as_float(tb.x & 0xffff0000u), __uint_as_float(tb.y << 16), __uint_as_float(tb.y & 0xffff0000u)}; } } }
        if (T) {
            float ss = 0.f;
            if (Tp && m >= NP) {
#pragma unroll
                for (int j = 0; j < 4; ++j) { f32x4 a = {0.f, 0.f, 0.f, 0.f}; for (int q = 0; q < ns; ++q) a += ((const f32x4*)(Tp + (size_t)q * (512 * 1024) + (size_t)(m - NP) * D))[lane + 64 * j]; t[j] = a; } }
#pragma unroll
            for (int j = 0; j < 4; ++j) ss += (t[j].x * t[j].x + t[j].y * t[j].y) + (t[j].z * t[j].z + t[j].w * t[j].w);
            ss = wave_sum(ss); const float r = rsqrtf(ss * (1.f / D) + EPS);
#pragma unroll
            for (int j = 0; j < 4; ++j) { const f32x4 w = ((const f32x4*)wt)[lane + 64 * j]; x[j] += t[j] * r * w; }
        }
        if (Xout) {
#pragma unroll
            for (int j = 0; j < 4; ++j) ((f32x4*)(Xout + (size_t)m * D))[lane + 64 * j] = x[j];
        }
        if (Xbout) {
#pragma unroll
            for (int j = 0; j < 4; ++j) { u32x2 o; o.x = pg8::cvt_pk_bf16(x[j].x, x[j].y); o.y = pg8::cvt_pk_bf16(x[j].z, x[j].w); ((u32x2*)(Xbout + (size_t)m * D))[lane + 64 * j] = o; }
        }
        if (RSC) {
            float ss = 0.f;
#pragma unroll
            for (int j = 0; j < 4; ++j) ss += (x[j].x * x[j].x + x[j].y * x[j].y) + (x[j].z * x[j].z + x[j].w * x[j].w);
            ss = wave_sum(ss); const float r = rsqrtf(ss * (1.f / D) + EPS);
            if (lane == 0) RSC[m] = r;
            f32x4 hv[4];
#pragma unroll
            for (int j = 0; j < 4; ++j) { const f32x4 w = ((const f32x4*)wh)[lane + 64 * j]; hv[j] = x[j] * r * w; }
            if (Wab) {
                float d[8];
#pragma unroll
                for (int c = 0; c < 8; ++c) { float dd = 0.f;
#pragma unroll
                    for (int j = 0; j < 4; ++j) { const f32x4 w = ((const f32x4*)(Wab + c * D))[lane + 64 * j]; dd += (hv[j].x * w.x + hv[j].y * w.y) + (hv[j].z * w.z + hv[j].w * w.w); }
                    d[c] = dd; }
#pragma unroll
                for (int c = 0; c < 8; ++c) d[c] = row_sum16(d[c]);
#pragma unroll
                for (int o = 16; o < 64; o <<= 1) {
#pragma unroll
                    for (int c = 0; c < 8; ++c) d[c] += __shfl_xor(d[c], o); }
                if (lane == 0) { f32x4 o0 = {d[0], d[1], d[2], d[3]}, o1 = {d[4], d[5], d[6], d[7]}; *(f32x4*)(AB + (size_t)m * 8) = o0; *(f32x4*)(AB + (size_t)m * 8 + 4) = o1; }
            }
        }
    }
}

__device__ __forceinline__ void norm_rows_pf(const float* T, const float* wt, bf16_t* XB, float* RSC,
                                             int gw, int NGW, int lane, const float* Tp, int ns) {
    u32x2 xn[4], tn[4];
#define NR_LOAD(mm) do { const int _m = (mm); \
        _Pragma("unroll") for (int j = 0; j < 4; ++j) xn[j] = ((const u32x2*)(XB + (size_t)_m * D))[lane + 64 * j]; \
        if (_m < NP) { _Pragma("unroll") for (int j = 0; j < 4; ++j) tn[j] = ((const u32x2*)((const bf16_t*)T + (size_t)_m * D))[lane + 64 * j]; } } while (0)
    if (gw < NTOK) NR_LOAD(gw);
#pragma unroll 1
    for (int m = gw; m < NTOK; m += NGW) {
        f32x4 x[4], t[4];
#pragma unroll
        for (int j = 0; j < 4; ++j) { x[j] = (f32x4){__uint_as_float(xn[j].x << 16), __uint_as_float(xn[j].x & 0xffff0000u), __uint_as_float(xn[j].y << 16), __uint_as_float(xn[j].y & 0xffff0000u)};
            t[j] = (f32x4){__uint_as_float(tn[j].x << 16), __uint_as_float(tn[j].x & 0xffff0000u), __uint_as_float(tn[j].y << 16), __uint_as_float(tn[j].y & 0xffff0000u)}; }
        if (m + NGW < NTOK) NR_LOAD(m + NGW);
        if (m >= NP) {
#pragma unroll
            for (int j = 0; j < 4; ++j) { f32x4 a = {0.f, 0.f, 0.f, 0.f}; for (int q = 0; q < ns; ++q) a += ((const f32x4*)(Tp + (size_t)q * (512 * 1024) + (size_t)(m - NP) * D))[lane + 64 * j]; t[j] = a; } }
        float ss = 0.f;
#pragma unroll
        for (int j = 0; j < 4; ++j) ss += (t[j].x * t[j].x + t[j].y * t[j].y) + (t[j].z * t[j].z + t[j].w * t[j].w);
        ss = wave_sum(ss); const float r = rsqrtf(ss * (1.f / D) + EPS);
#pragma unroll
        for (int j = 0; j < 4; ++j) { const f32x4 w = ((const f32x4*)wt)[lane + 64 * j]; x[j] += t[j] * r * w; }
#pragma unroll
        for (int j = 0; j < 4; ++j) { u32x2 o; o.x = pg8::cvt_pk_bf16(x[j].x, x[j].y); o.y = pg8::cvt_pk_bf16(x[j].z, x[j].w); ((u32x2*)(XB + (size_t)m * D))[lane + 64 * j] = o; }
        float s2 = 0.f;
#pragma unroll
        for (int j = 0; j < 4; ++j) s2 += (x[j].x * x[j].x + x[j].y * x[j].y) + (x[j].z * x[j].z + x[j].w * x[j].w);
        s2 = wave_sum(s2); if (lane == 0) RSC[m] = rsqrtf(s2 * (1.f / D) + EPS);
    }
#undef NR_LOAD
}

__device__ __forceinline__ void prologue(const DevArgs& A, LAS unsigned char* lds, int wave, int lane, int gw, int NGW) {
    LAS float* scr = (LAS float*)(lds + wave * 8704);
    constexpr int I_IN = 16 * 80, I_OUT = 16 * 32, I_GU = 16 * 176, I_DN = 44 * 32, I_GLU = 4 * 8, I_POOL = 8, PER = I_IN + I_OUT + I_GU + I_DN + I_GLU + I_POOL;
#pragma unroll 1
    for (int it = gw; it < DEPTH * PER; it += NGW) {
        const int l = it / PER; int r = it % PER;
        if (r < I_IN) { SrcIn s{A.in[I_WIN] + (size_t)l * D * INW, A.in[I_NMPRE] + l * D}; transpose_item(s, D, (bf16_t*)(A.ws + WS_WIN + l * SZ_WIN), NPROJ / 32, scr, r, lane); continue; } r -= I_IN;
        if (r < I_OUT) { SrcPlain s{A.in[I_WOUT] + (size_t)l * D * D, D}; transpose_item(s, D, (bf16_t*)(A.ws + WS_WOUT + l * SZ_WOUT), D / 32, scr, r, lane); continue; } r -= I_OUT;
        if (r < I_GU) { SrcGU s{A.in[I_WG] + (size_t)l * D * DFF, A.in[I_WU] + (size_t)l * D * DFF, A.in[I_NFPRE] + l * D}; transpose_item(s, D, (bf16_t*)(A.ws + WS_WGU + l * SZ_WGU), NGU / 32, scr, r, lane); continue; } r -= I_GU;
        if (r < I_DN) { SrcPlain s{A.in[I_WD] + (size_t)l * DFF * D, D}; transpose_item(s, DFF, (bf16_t*)(A.ws + WS_WDN + l * SZ_WDN), D / 32, scr, r, lane); continue; } r -= I_DN;
        if (r < I_GLU) { SrcPlain s{A.in[I_GLUW] + (size_t)l * 65536, 256}; transpose_item(s, 256, (bf16_t*)(A.ws + WS_GLUT + l * SZ_GLUT), 8, scr, r, lane); continue; } r -= I_GLU;
        { const int g = r >> 1; SrcPlain s{A.in[I_POOLW] + (size_t)(l * 4 + g) * 4096, 64}; transpose_item(s, 64, (bf16_t*)(A.ws + WS_POOLT + l * SZ_POOLT) + g * 4096, 2, scr, r & 1, lane); }
    }
    const int gt = gw * 64 + lane, NT = NGW * 64;
    float* wab = (float*)(A.ws + WS_WAB);
#pragma unroll 1
    for (int i = gt; i < DEPTH * 8 * D; i += NT) { const int l = i / (8 * D), j = (i / D) & 7, k = i % D; wab[i] = A.in[I_WIN][((size_t)l * D + k) * INW + 1536 + j]; }
    float* ssmk = (float*)(A.ws + WS_SSMK); float* bbar = (float*)(A.ws + WS_BBAR);
#pragma unroll 1
    for (int i = gt; i < DEPTH * 16 * 64; i += NT) {
        const int lg = i >> 6;
        const float dt = expf(A.in[I_LOGDT][lg]), ar = A.in[I_ARE][i], ai = A.in[I_AIM][i];
        const float mag = expf(ar * dt);
        float rev = ai * dt * 0.15915494309189535f; rev -= floorf(rev);
        const float sn = __builtin_amdgcn_sinf(rev), cs = __builtin_amdgcn_cosf(rev);
        const float lr = mag * cs, li = mag * sn;
        float pr = lr, pi = li;
#pragma unroll
        for (int q = 0; q < 6; ++q) { const float nr2 = pr * pr - pi * pi, ni2 = 2.f * pr * pi; pr = nr2; pi = ni2; }
        ssmk[i * 4 + 0] = lr; ssmk[i * 4 + 1] = li; ssmk[i * 4 + 2] = pr; ssmk[i * 4 + 3] = pi;
        const float nr = lr - 1.f, ni = li, d2 = ar * ar + ai * ai;
        const float cre = (nr * ar + ni * ai) / d2, cim = (ni * ar - nr * ai) / d2;
#pragma unroll
        for (int h = 0; h < 16; ++h) { const float br = A.in[I_BRE][(size_t)i * 16 + h], bi = A.in[I_BIM][(size_t)i * 16 + h];
            bbar[(size_t)i * 32 + h] = cre * br - cim * bi; bbar[(size_t)i * 32 + 16 + h] = cre * bi + cim * br; }
    }
}

__device__ __forceinline__ unsigned bfmul2(unsigned pk, float f0, float f1) { return pg8::cvt_pk_bf16(__uint_as_float(pk << 16) * f0, __uint_as_float(pk & 0xffff0000u) * f1); }
__device__ __forceinline__ void delta_prep_item(const DevArgs& A, int l, LAS unsigned char* lds, int item, int tid, int wave, int lane) {
    asm volatile("" : "+v"(tid)); lane = tid & 63; wave = __builtin_amdgcn_readfirstlane(tid >> 6);
    const int bh = item >> 5, n = item & 31, b = bh >> 2, h = bh & 3;
    const int tok0 = b * SEQ + n * 64;
    LAS bf16_t* QS = (LAS bf16_t*)(lds); LAS bf16_t* KS = (LAS bf16_t*)(lds + 17408);
    LAS unsigned char* KT = lds + 34816; LAS unsigned char* VT = lds + 53248; LAS unsigned char* RTK = lds + 71680;
    LAS float* AM = (LAS float*)(lds + 90112); LAS float* PM = (LAS float*)(lds + 107520); LAS float* PSC = PM; LAS float* TM = (LAS float*)(lds + 124928);
    LAS unsigned char* TB = lds + 142336;
    LAS float* GAM = (LAS float*)(lds + 151552); LAS float* BETA = GAM + 64; LAS float* RQ = GAM + 128; LAS float* RK = GAM + 192;
    LAS float* F2 = GAM + 256; LAS float* F3 = GAM + 320; LAS float* F4 = GAM + 384;
    const bf16_t* PROJ = (const bf16_t*)(A.ws + WS_PROJ);
    const float* AB = (const float*)(A.ws + WS_AB);
    u32x4 gv[2];
#pragma unroll
    for (int j = 0; j < 2; ++j) { const int id = tid + 512 * j; gv[j] = *(const u32x4*)(PROJ + (size_t)(tok0 + (id >> 4)) * NPROJ + PC_G + h * 128 + (id & 15) * 8); }
    if (tid < 384) {
        const int part = tid >> 7, c = tid & 127, col = part * 512 + h * 128 + c;
        const float* cw = A.in[I_CONVW] + (size_t)l * 4 * 1536;
        const float w0 = cw[col], w1 = cw[1536 + col], w2 = cw[3072 + col], w3 = cw[4608 + col];
        const bf16_t* pp = PROJ + (size_t)tok0 * NPROJ + col;
        float xr[67];
#pragma unroll
        for (int t = 0; t < 67; ++t) xr[t] = (n > 0 || t >= 3) ? bf2f(pp[(long)(t - 3) * NPROJ]) : 0.f;
        unsigned pk[32];
#pragma unroll
        for (int t = 0; t < 64; t += 2) {
            const float s0 = silu_f(w0 * xr[t] + w1 * xr[t + 1] + w2 * xr[t + 2] + w3 * xr[t + 3]);
            const float s1 = silu_f(w0 * xr[t + 1] + w1 * xr[t + 2] + w2 * xr[t + 3] + w3 * xr[t + 4]);
            pk[t >> 1] = pg8::cvt_pk_bf16(s0, s1);
        }
        if (part < 2) { LAS bf16_t* dst = (part == 0 ? QS : KS) + c;
#pragma unroll
            for (int t = 0; t < 64; t += 2) { dst[t * 136] = (bf16_t)(pk[t >> 1] & 0xffffu); dst[(t + 1) * 136] = (bf16_t)(pk[t >> 1] >> 16); } }
        if (part > 0) { LAS unsigned char* dst = (part == 1 ? KT : VT) + c * 144;
#pragma unroll
            for (int q = 0; q < 8; ++q) { u32x4 o; o.x = pk[4 * q]; o.y = pk[4 * q + 1]; o.z = pk[4 * q + 2]; o.w = pk[4 * q + 3]; *(LAS u32x4*)(dst + q * 16) = o; } }
    } else if (tid < 448) {
        const int t = tid - 384;
        const float a = AB[(size_t)(tok0 + t) * 8 + h], bb = AB[(size_t)(tok0 + t) * 8 + 4 + h];
        const float xx = a + A.in[I_DTB][l * 4 + h];
        const float sp = xx > 20.f ? xx : log1pf(expf(xx));
        float lg = -expf(A.in[I_ALOG][l * 4 + h]) * sp;
#pragma unroll
        for (int off = 1; off < 64; off <<= 1) { const float v = __shfl_up(lg, off); if (lane >= off) lg += v; }
        GAM[t] = lg; BETA[t] = 1.f / (1.f + expf(-bb));
    }
    __syncthreads();
    {
        const int t = tid >> 3, part = tid & 7; float sq = 0.f, sk = 0.f;
#pragma unroll
        for (int j = 0; j < 16; ++j) { const float q = bf2f(QS[t * 136 + part * 16 + j]), k = bf2f(KS[t * 136 + part * 16 + j]); sq += q * q; sk += k * k; }
        sq = row_sum8(sq); sk = row_sum8(sk);
        if (part == 0) { const float rq = rsqrtf(sq + EPS) * 0.08838834764831845f, rk = rsqrtf(sk + EPS), g = GAM[t], eg = __expf(g), bt = BETA[t];
            RQ[t] = rq; RK[t] = rk; F2[t] = bt * eg * rk; F3[t] = rk * __expf(GAM[63] - g); F4[t] = rq * eg; }
    }
    {
        const int prod = wave >> 2, mt = wave & 3, fr = lane & 15, quad = lane >> 4;
        LAS bf16_t* Aop = prod ? QS : KS; LAS float* dst = prod ? PM : AM;
        bf16x8 a[4];
#pragma unroll
        for (int kk = 0; kk < 4; ++kk) a[kk] = *(LAS bf16x8*)(Aop + (mt * 16 + fr) * 136 + kk * 32 + quad * 8);
#pragma unroll
        for (int nt = 0; nt < 4; ++nt) { f32x4 acc = {0.f, 0.f, 0.f, 0.f};
#pragma unroll
            for (int kk = 0; kk < 4; ++kk) { const bf16x8 bq = *(LAS bf16x8*)(KS + (nt * 16 + fr) * 136 + kk * 32 + quad * 8); acc = mfma16(a[kk], bq, acc); }
#pragma unroll
            for (int i = 0; i < 4; ++i) dst[(mt * 16 + quad * 4 + i) * 68 + nt * 16 + fr] = acc[i]; }
    }
    __syncthreads();
    {
        const int t = tid >> 3, s8 = (tid & 7) * 8; const float gt = GAM[t], bk = BETA[t] * RK[t], rqt = RQ[t];
        float av[8], pv[8];
#pragma unroll
        for (int j = 0; j < 8; ++j) { const int s = s8 + j; const float rks = RK[s]; const float dec = (s <= t) ? __expf(gt - GAM[s]) * rks : 0.f;
            av[j] = (s < t) ? bk * dec * AM[t * 68 + s] : 0.f; pv[j] = rqt * dec * PM[t * 68 + s]; }
#pragma unroll
        for (int j = 0; j < 8; ++j) AM[t * 68 + s8 + j] = av[j];
        u32x4 o; o.x = pg8::cvt_pk_bf16(pv[0], pv[1]); o.y = pg8::cvt_pk_bf16(pv[2], pv[3]); o.z = pg8::cvt_pk_bf16(pv[4], pv[5]); o.w = pg8::cvt_pk_bf16(pv[6], pv[7]);
        *(u32x4*)((bf16_t*)(A.ws + WS_DQK) + (size_t)item * 4096 + t * 64 + s8) = o;
        for (int e = tid; e < 64 * 68; e += 512) TM[e] = 0.f;
        if (tid == 0) ((float*)(A.ws + WS_DGL))[item] = __expf(GAM[63]);
    }
    __syncthreads();
    if (wave == 0) {
        const int i = lane >> 4, c = lane & 15;
        LAS float* amp = AM + (16 * i) * 68 + 16 * i; asm volatile("" : "+v"(amp));
        float x[16];
#pragma unroll
        for (int r = 0; r < 16; ++r) { float acc = (r == c) ? 1.f : 0.f;
#pragma unroll
            for (int s = 0; s < r; ++s) acc = fmaf(-amp[r * 68 + s], x[s], acc);
            x[r] = acc; }
        LAS float* tmp = TM + (16 * i) * 68 + 16 * i + c;
#pragma unroll
        for (int r = 0; r < 16; ++r) tmp[r * 68] = x[r];
    } else {
        const int wt = tid - 64;
        for (int id = wt; id < 1024; id += 448) {
            const int c = id >> 3, t8 = (id & 7) * 8;
            const f32x4 b0 = *(LAS f32x4*)(BETA + t8), b1 = *(LAS f32x4*)(BETA + t8 + 4);
            u32x4 v = *(LAS u32x4*)(VT + c * 144 + t8 * 2);
            v.x = bfmul2(v.x, b0[0], b0[1]); v.y = bfmul2(v.y, b0[2], b0[3]); v.z = bfmul2(v.z, b1[0], b1[1]); v.w = bfmul2(v.w, b1[2], b1[3]);
            *(LAS u32x4*)(VT + c * 144 + t8 * 2) = v;
            const f32x4 f20 = *(LAS f32x4*)(F2 + t8), f21 = *(LAS f32x4*)(F2 + t8 + 4), f30 = *(LAS f32x4*)(F3 + t8), f31 = *(LAS f32x4*)(F3 + t8 + 4);
            const u32x4 k = *(LAS u32x4*)(KT + c * 144 + t8 * 2);
            u32x4 rk; rk.x = bfmul2(k.x, f20[0], f20[1]); rk.y = bfmul2(k.y, f20[2], f20[3]); rk.z = bfmul2(k.z, f21[0], f21[1]); rk.w = bfmul2(k.w, f21[2], f21[3]);
            *(LAS u32x4*)(RTK + c * 144 + t8 * 2) = rk;
            u32x4 kd; kd.x = bfmul2(k.x, f30[0], f30[1]); kd.y = bfmul2(k.y, f30[2], f30[3]); kd.z = bfmul2(k.z, f31[0], f31[1]); kd.w = bfmul2(k.w, f31[2], f31[3]);
            *(u32x4*)((bf16_t*)(A.ws + WS_DKT) + (size_t)item * 8192 + c * 64 + t8) = kd; }
        for (int id = wt; id < 1024; id += 448) {
            const int t = id >> 4, c8 = (id & 15) * 8; const float f = F4[t];
            u32x4 q = *(LAS u32x4*)((LAS unsigned char*)QS + t * 272 + c8 * 2);
            q.x = bfmul2(q.x, f, f); q.y = bfmul2(q.y, f, f); q.z = bfmul2(q.z, f, f); q.w = bfmul2(q.w, f, f);
            *(u32x4*)((bf16_t*)(A.ws + WS_DQD) + (size_t)item * 8192 + t * 128 + c8) = q; }
    }
    {
        const int c8 = (tid & 15) * 8; const float* on = A.in[I_ONORM] + l * 128 + c8;
        const f32x4 o0 = *(const f32x4*)on, o1 = *(const f32x4*)(on + 4);
#pragma unroll
        for (int j = 0; j < 2; ++j) { const int id = tid + 512 * j; const u32x4 g = gv[j]; u32x4 o;
            o.x = pg8::cvt_pk_bf16(silu_f(__uint_as_float(g.x << 16)) * o0[0], silu_f(__uint_as_float(g.x & 0xffff0000u)) * o0[1]);
            o.y = pg8::cvt_pk_bf16(silu_f(__uint_as_float(g.y << 16)) * o0[2], silu_f(__uint_as_float(g.y & 0xffff0000u)) * o0[3]);
            o.z = pg8::cvt_pk_bf16(silu_f(__uint_as_float(g.z << 16)) * o1[0], silu_f(__uint_as_float(g.z & 0xffff0000u)) * o1[1]);
            o.w = pg8::cvt_pk_bf16(silu_f(__uint_as_float(g.w << 16)) * o1[2], silu_f(__uint_as_float(g.w & 0xffff0000u)) * o1[3]);
            *(u32x4*)((bf16_t*)(A.ws + WS_DGS) + (size_t)item * 8192 + (id >> 4) * 128 + c8) = o; }
    }
    __syncthreads();
    const int p2 = tid >> 8, r2 = (tid >> 4) & 15, c2 = tid & 15, rb = p2 ? 48 : 16, cb = p2 ? 32 : 0;
    {
        float acc = 0.f;
#pragma unroll
        for (int s = 0; s < 16; ++s) acc = fmaf(AM[(rb + r2) * 68 + cb + s], TM[(cb + s) * 68 + cb + c2], acc);
        PSC[(p2 * 16 + r2) * 68 + c2] = acc; }
    __syncthreads();
    {
        float acc = 0.f;
#pragma unroll
        for (int s = 0; s < 16; ++s) acc = fmaf(TM[(rb + r2) * 68 + rb + s], PSC[(p2 * 16 + s) * 68 + c2], acc);
        TM[(rb + r2) * 68 + cb + c2] = -acc; }
    __syncthreads();
    float p3[2];
#pragma unroll
    for (int j = 0; j < 2; ++j) { const int e = tid + 512 * j, r = e >> 5, c = e & 31; float acc = 0.f;
#pragma unroll 8
        for (int s = 0; s < 32; ++s) acc = fmaf(AM[(32 + r) * 68 + s], TM[s * 68 + c], acc);
        p3[j] = acc; }
    __syncthreads();
#pragma unroll
    for (int j = 0; j < 2; ++j) { const int e = tid + 512 * j; PSC[(e >> 5) * 68 + (e & 31)] = p3[j]; }
    __syncthreads();
#pragma unroll
    for (int j = 0; j < 2; ++j) { const int e = tid + 512 * j, r = e >> 5, c = e & 31; float acc = 0.f;
#pragma unroll 8
        for (int s = 0; s < 32; ++s) acc = fmaf(TM[(32 + r) * 68 + 32 + s], PSC[s * 68 + c], acc);
        p3[j] = -acc; }
#pragma unroll
    for (int j = 0; j < 2; ++j) { const int e = tid + 512 * j; TM[(32 + (e >> 5)) * 68 + (e & 31)] = p3[j]; }
    __syncthreads();
#pragma unroll
    for (int j = 0; j < 4; ++j) { const int e = tid + 512 * j, t = e >> 5, s2 = (e & 31) * 2;
        *(LAS unsigned*)(TB + t * 144 + s2 * 2) = pg8::cvt_pk_bf16(TM[t * 68 + s2], TM[t * 68 + s2 + 1]); }
    __syncthreads();
    {
        const int fr = lane & 15, quad = lane >> 4;
        bf16x8 bv[2], ak[2];
#pragma unroll
        for (int kk = 0; kk < 2; ++kk) { bv[kk] = *(LAS bf16x8*)(VT + (16 * wave + fr) * 144 + (kk * 32 + quad * 8) * 2); ak[kk] = *(LAS bf16x8*)(RTK + (16 * wave + fr) * 144 + (kk * 32 + quad * 8) * 2); }
        bf16_t* DW = (bf16_t*)(A.ws + WS_DW) + (size_t)item * 8192; bf16_t* DKC = (bf16_t*)(A.ws + WS_DKC) + (size_t)item * 8192;
#pragma unroll
        for (int mt = 0; mt < 4; ++mt) { f32x4 aw = {0.f, 0.f, 0.f, 0.f}, akc = {0.f, 0.f, 0.f, 0.f};
#pragma unroll
            for (int kk = 0; kk < 2; ++kk) { const bf16x8 tf = *(LAS bf16x8*)(TB + (mt * 16 + fr) * 144 + (kk * 32 + quad * 8) * 2);
                aw = mfma16(tf, bv[kk], aw);
                akc = mfma16(ak[kk], tf, akc); }
            u32x2 ow; ow.x = pk2(aw[0], aw[1]); ow.y = pk2(aw[2], aw[3]);
            *(u32x2*)(DW + (16 * wave + fr) * 64 + mt * 16 + quad * 4) = ow;
            u32x2 ok; ok.x = pk2(-akc[0], -akc[1]); ok.y = pk2(-akc[2], -akc[3]);
            *(u32x2*)(DKC + (mt * 16 + fr) * 128 + 16 * wave + quad * 4) = ok; }
    }
    __syncthreads();
}

__device__ __forceinline__ void delta_scan_item(const DevArgs& A, int l, LAS unsigned char* lds, int bh, int tid_in, int wave, int lane_in, const XcdBarrier& xb, int SUB) {
    const int b = bh >> 2, h = bh & 3;
    LAS unsigned char* KCs = lds; LAS unsigned char* QDs = lds + 17408; LAS unsigned char* QKs = lds + 34816; LAS unsigned char* KDTs = lds + 44032;
    LAS unsigned char* Ws = lds + 62464;
    LAS unsigned char* GSs = lds + 80896;
    LAS unsigned char* SS = lds + 98304 + wave * 4352; LAS unsigned char* US = lds + 133120 + wave * 2304;
    LAS float* PART = (LAS float*)(lds + 151552);
    const unsigned char* gW = A.ws + WS_DW; const unsigned char* gGS = A.ws + WS_DGS;
    const unsigned char* gKC = A.ws + WS_DKC; const unsigned char* gQD = A.ws + WS_DQD; const unsigned char* gQK = A.ws + WS_DQK; const unsigned char* gKT = A.ws + WS_DKT;
    const float* DGL = (const float*)(A.ws + WS_DGL);
    f32x4 S[8];
#pragma unroll
    for (int mt = 0; mt < 8; ++mt) S[mt] = (f32x4){0.f, 0.f, 0.f, 0.f};
    u32x4 r[9], rg[2];
    float gl_all = 0.f;
#define DS_LOAD(itn, toff) do { const size_t _i = (size_t)(itn); const unsigned char* _kc = gKC + _i * 16384; const unsigned char* _qd = gQD + _i * 16384; \
        const unsigned char* _qk = gQK + _i * 8192; const unsigned char* _kt = gKT + _i * 16384; \
        r[0] = *(const u32x4*)(_kc + (toff)); r[1] = *(const u32x4*)(_kc + (toff) + 8192u); \
        r[2] = *(const u32x4*)(_qd + (toff)); r[3] = *(const u32x4*)(_qd + (toff) + 8192u); \
        r[4] = *(const u32x4*)(_qk + (toff)); \
        r[5] = *(const u32x4*)(_kt + (toff)); r[6] = *(const u32x4*)(_kt + (toff) + 8192u); \
        const unsigned char* _w = gW + _i * 16384; r[7] = *(const u32x4*)(_w + (toff)); r[8] = *(const u32x4*)(_w + (toff) + 8192u); } while (0)
#define DS_LOADG(itn, toff) do { const unsigned char* _g = gGS + (size_t)(itn) * 16384; rg[0] = *(const u32x4*)(_g + (toff)); rg[1] = *(const u32x4*)(_g + (toff) + 8192u); } while (0)
#define DS_STAGE(tidv) do { const int i0 = (tidv), i1 = (tidv) + 512; \
          *(LAS u32x4*)(KCs + (i0 >> 4) * 272 + (i0 & 15) * 16) = r[0]; *(LAS u32x4*)(KCs + (i1 >> 4) * 272 + (i1 & 15) * 16) = r[1]; \
          *(LAS u32x4*)(QDs + (i0 >> 4) * 272 + (i0 & 15) * 16) = r[2]; *(LAS u32x4*)(QDs + (i1 >> 4) * 272 + (i1 & 15) * 16) = r[3]; \
          *(LAS u32x4*)(QKs + (i0 >> 3) * 144 + (i0 & 7) * 16) = r[4]; \
          *(LAS u32x4*)(KDTs + (i0 >> 3) * 144 + (i0 & 7) * 16) = r[5]; *(LAS u32x4*)(KDTs + (i1 >> 3) * 144 + (i1 & 7) * 16) = r[6]; \
          *(LAS u32x4*)(Ws + (i0 >> 3) * 144 + (i0 & 7) * 16) = r[7]; *(LAS u32x4*)(Ws + (i1 >> 3) * 144 + (i1 & 7) * 16) = r[8]; } while (0)
#define DS_STAGEG(tidv) do { const int i0 = (tidv), i1 = (tidv) + 512; \
          *(LAS u32x4*)(GSs + (i0 >> 4) * 272 + (i0 & 15) * 16) = rg[0]; *(LAS u32x4*)(GSs + (i1 >> 4) * 272 + (i1 & 15) * 16) = rg[1]; } while (0)
#pragma unroll 1
    for (int n = 0; n < 32; ++n) {
        int tid = tid_in; asm volatile("" : "+v"(tid));
#define SCAN_ISB(x) ((x) == 0 || (x) == 7 || (x) == 14 || (x) == 21 || (x) == 27)
        const bool bstart = SCAN_ISB(n);
        const bool bnext1 = SCAN_ISB(n + 1), bnext2 = SCAN_ISB(n + 2);
        if (bstart) { if (n > 0) xcd_barrier(xb);
            gl_all = DGL[bh * 32 + (tid & 31)];
            const unsigned t0 = (unsigned)tid * 16u; DS_LOAD(bh * 32 + n, t0); DS_LOADG(bh * 32 + n, t0); DS_STAGE(tid); DS_STAGEG(tid);
            if (n + 1 < 32 && !bnext1) { DS_LOAD(bh * 32 + n + 1, t0); DS_LOADG(bh * 32 + n + 1, t0); }
            __syncthreads(); }
        else { DS_STAGEG(tid);
            if (n + 1 < 32 && !bnext1) DS_LOADG(bh * 32 + n + 1, (unsigned)tid * 16u); }
        const int lane = tid & 63, fr = lane & 15, quad = lane >> 4, vcol = 16 * wave + fr;
        const unsigned toff = (unsigned)tid * 16u;
        const int it = bh * 32 + n, tokb = b * SEQ + n * 64;
        const float glast = __builtin_bit_cast(float, __builtin_amdgcn_readlane(__builtin_bit_cast(int, gl_all), n));
        asm volatile("s_nop 7\n\ts_nop 7" ::: "memory");
#pragma unroll
        for (int mt = 0; mt < 8; ++mt) { u32x2 p; p.x = pg8::cvt_pk_bf16(S[mt][0], S[mt][1]); p.y = pg8::cvt_pk_bf16(S[mt][2], S[mt][3]); *(LAS u32x2*)(SS + fr * 272 + (mt * 16 + quad * 4) * 2) = p; }
        LDS_FENCE();
        bf16x8 Sb[4];
#pragma unroll
        for (int kk = 0; kk < 4; ++kk) Sb[kk] = *(LAS bf16x8*)(SS + fr * 272 + (kk * 32 + quad * 8) * 2);
        f32x4 U[4], O[4];
#pragma unroll
        for (int mt = 0; mt < 4; ++mt) { f32x4 au, ao = {0.f, 0.f, 0.f, 0.f};
            { const u32x2 wq = *(LAS u32x2*)(Ws + vcol * 144 + (mt * 16 + quad * 4) * 2);
              au[0] = __uint_as_float(wq.x << 16); au[1] = __uint_as_float(wq.x & 0xffff0000u); au[2] = __uint_as_float(wq.y << 16); au[3] = __uint_as_float(wq.y & 0xffff0000u); }
#pragma unroll
            for (int kk = 0; kk < 4; ++kk) { const bf16x8 a1 = *(LAS bf16x8*)(KCs + (mt * 16 + fr) * 272 + (kk * 32 + quad * 8) * 2); au = mfma16(a1, Sb[kk], au);
                const bf16x8 a2 = *(LAS bf16x8*)(QDs + (mt * 16 + fr) * 272 + (kk * 32 + quad * 8) * 2); ao = mfma16(a2, Sb[kk], ao); }
            U[mt] = au; O[mt] = ao; __builtin_amdgcn_sched_barrier(0); }
        asm volatile("s_nop 7\n\ts_nop 7" ::: "memory");
#pragma unroll
        for (int mt = 0; mt < 4; ++mt) { u32x2 p; p.x = pg8::cvt_pk_bf16(U[mt][0], U[mt][1]); p.y = pg8::cvt_pk_bf16(U[mt][2], U[mt][3]); *(LAS u32x2*)(US + fr * 144 + (mt * 16 + quad * 4) * 2) = p; }
        LDS_FENCE();
        bf16x8 Ub[2];
#pragma unroll
        for (int kk = 0; kk < 2; ++kk) Ub[kk] = *(LAS bf16x8*)(US + fr * 144 + (kk * 32 + quad * 8) * 2);
#pragma unroll
        for (int mt = 0; mt < 4; ++mt)
#pragma unroll
            for (int kk = 0; kk < 2; ++kk) { const bf16x8 a = *(LAS bf16x8*)(QKs + (mt * 16 + fr) * 144 + (kk * 32 + quad * 8) * 2); O[mt] = mfma16(a, Ub[kk], O[mt]); }
        __builtin_amdgcn_sched_barrier(0);
#pragma unroll
        for (int mt = 0; mt < 8; ++mt) { S[mt] *= glast;
#pragma unroll
            for (int kk = 0; kk < 2; ++kk) { const bf16x8 a = *(LAS bf16x8*)(KDTs + (mt * 16 + fr) * 144 + (kk * 32 + quad * 8) * 2); S[mt] = mfma16(a, Ub[kk], S[mt]); }
            if (mt & 1) __builtin_amdgcn_sched_barrier(0); }
        { float pp[16];
#pragma unroll
          for (int e = 0; e < 16; ++e) pp[e] = O[e >> 2][e & 3] * O[e >> 2][e & 3];
#pragma unroll
          for (int e = 0; e < 16; ++e) pp[e] = row_sum16(pp[e]);
          if (fr == 0) {
#pragma unroll
              for (int e = 0; e < 16; ++e) PART[((e >> 2) * 16 + quad * 4 + (e & 3)) * 8 + wave] = pp[e]; } }
        __syncthreads();
        if (n + 1 < 32 && !bnext1) { DS_STAGE(tid); if (n + 2 < 32 && !bnext2) DS_LOAD(it + 2, toff); }
        bf16_t* mixb = (bf16_t*)(A.ws + WS_MIX) + (size_t)tokb * D + h * 128;
#pragma unroll
        for (int mt = 0; mt < 4; ++mt)
#pragma unroll
            for (int i = 0; i < 4; ++i) { const int t = mt * 16 + quad * 4 + i;
                const f32x4 p0 = *(LAS f32x4*)(PART + t * 8), p1 = *(LAS f32x4*)(PART + t * 8 + 4);
                const float tot = ((p0[0] + p0[1]) + (p0[2] + p0[3])) + ((p1[0] + p1[1]) + (p1[2] + p1[3]));
                const float sc = rsqrtf(tot * (1.f / 128.f) + EPS);
                const float gs = bf2f(*(LAS bf16_t*)(GSs + t * 272 + vcol * 2));
                mixb[(unsigned)(t * D + vcol)] = (bf16_t)(pg8::cvt_pk_bf16(O[mt][i] * sc * gs, 0.f) & 0xffffu); }
        __syncthreads();
    }
#undef DS_STAGE
#undef DS_LOADG
#undef DS_STAGEG
#undef DS_LOAD
    { const int lane = lane_in, fr = lane & 15, quad = lane >> 4, vcol = 16 * wave + fr;
      float* dp = A.out + O_DP + (size_t)((l * 8 + b) * 4 + h) * 16384;
#pragma unroll
      for (int mt = 0; mt < 8; ++mt)
#pragma unroll
          for (int i = 0; i < 4; ++i) dp[(mt * 16 + quad * 4 + i) * 128 + vcol] = S[mt][i]; }
    __syncthreads();
}

__device__ __forceinline__ void delta_sample_item(const DevArgs& A, int l, LAS unsigned char* lds, int item, int tid, int wave, int lane) {
    asm volatile("" : "+v"(tid)); lane = tid & 63; wave = __builtin_amdgcn_readfirstlane(tid >> 6);
    const int b = item >> 2, h = item & 3, tokS = NP + b * 4;
    LAS float* RAW = (LAS float*)lds; LAS float* RED = RAW + 1536; LAS float* OB = RED + 512; LAS float* SC = OB + 512;
    const bf16_t* PROJ = (const bf16_t*)(A.ws + WS_PROJ); const float* AB = (const float*)(A.ws + WS_AB); bf16_t* MIX = (bf16_t*)(A.ws + WS_MIX);
    const float* cw = A.in[I_CONVW] + (size_t)l * 4 * 1536;
    for (int idx = tid; idx < 1536; idx += 512) { const int part = idx >> 9, t = (idx >> 7) & 3, c = idx & 127, col = part * 512 + h * 128 + c;
        float acc = 0.f;
#pragma unroll
        for (int j = 0; j < 4; ++j) { const int tt = t - 3 + j;
            const float x = (tt >= 0) ? bf2f(PROJ[(size_t)(tokS + tt) * NPROJ + col]) : A.in[I_SCONV][((size_t)(l * 128 + b) * 3 + (3 + tt)) * 1536 + col];
            acc += cw[j * 1536 + col] * x; }
        RAW[idx] = silu_f(acc); }
    if (tid < 4) { const float a = AB[(size_t)(tokS + tid) * 8 + h], bb = AB[(size_t)(tokS + tid) * 8 + 4 + h];
        const float xx = a + A.in[I_DTB][l * 4 + h]; const float sp = xx > 20.f ? xx : log1pf(expf(xx));
        SC[8 + tid] = 1.f / (1.f + expf(-bb)); SC[12 + tid] = expf(-expf(A.in[I_ALOG][l * 4 + h]) * sp); }
    const int v = tid & 127, kq = tid >> 7;
    float S[32];
    { const float* sp = A.in[I_SDELTA] + (size_t)((l * 128 + b) * 4 + h) * 16384;
#pragma unroll
      for (int i = 0; i < 32; ++i) S[i] = sp[(kq * 32 + i) * 128 + v]; }
    __syncthreads();
    { const int part = wave >> 2, t = wave & 3; const float x0 = RAW[part * 512 + t * 128 + lane], x1 = RAW[part * 512 + t * 128 + 64 + lane];
      const float ss = wave_sum(x0 * x0 + x1 * x1); if (lane == 0) SC[part * 4 + t] = rsqrtf(ss + EPS) * (part == 0 ? 0.08838834764831845f : 1.f); }
    __syncthreads();
    for (int t = 0; t < 4; ++t) {
        const float rq = SC[t], rk = SC[4 + t], beta = SC[8 + t], g = SC[12 + t];
        float pr = 0.f;
#pragma unroll
        for (int i = 0; i < 32; ++i) pr += S[i] * RAW[512 + t * 128 + kq * 32 + i];
        RED[kq * 128 + v] = pr * rk;
        __syncthreads();
        const float rr = (RED[v] + RED[128 + v]) + (RED[256 + v] + RED[384 + v]);
        const float u = beta * (RAW[1024 + t * 128 + v] - g * rr);
        float po = 0.f;
#pragma unroll
        for (int i = 0; i < 32; ++i) { const float kh = RAW[512 + t * 128 + kq * 32 + i] * rk; S[i] = g * S[i] + kh * u; po += S[i] * RAW[t * 128 + kq * 32 + i]; }
        __syncthreads();
        RED[kq * 128 + v] = po * rq;
        __syncthreads();
        if (kq == 0) OB[t * 128 + v] = (RED[v] + RED[128 + v]) + (RED[256 + v] + RED[384 + v]);
        __syncthreads();
    }
    if (wave < 4) { const int t = wave; const float x0 = OB[t * 128 + lane], x1 = OB[t * 128 + 64 + lane];
        const float ss = wave_sum(x0 * x0 + x1 * x1); const float sc = rsqrtf(ss * (1.f / 128.f) + EPS);
        const float g0 = bf2f(PROJ[(size_t)(tokS + t) * NPROJ + PC_G + h * 128 + lane]), g1 = bf2f(PROJ[(size_t)(tokS + t) * NPROJ + PC_G + h * 128 + 64 + lane]);
        MIX[(size_t)(tokS + t) * D + h * 128 + lane] = (bf16_t)f2bf(x0 * sc * A.in[I_ONORM][l * 128 + lane] * silu_f(g0));
        MIX[(size_t)(tokS + t) * D + h * 128 + 64 + lane] = (bf16_t)f2bf(x1 * sc * A.in[I_ONORM][l * 128 + 64 + lane] * silu_f(g1)); }
    { float* dsp = A.out + O_DS + (size_t)((l * 128 + b) * 4 + h) * 16384;
#pragma unroll
      for (int i = 0; i < 32; ++i) dsp[(kq * 32 + i) * 128 + v] = S[i]; }
    __syncthreads();
}

#define SSM_BCAST_U(t) do { unsigned _w[8]; \
        _w[0] = __builtin_amdgcn_readlane(ua.x, t); _w[1] = __builtin_amdgcn_readlane(ua.y, t); _w[2] = __builtin_amdgcn_readlane(ua.z, t); _w[3] = __builtin_amdgcn_readlane(ua.w, t); \
        _w[4] = __builtin_amdgcn_readlane(ub.x, t); _w[5] = __builtin_amdgcn_readlane(ub.y, t); _w[6] = __builtin_amdgcn_readlane(ub.z, t); _w[7] = __builtin_amdgcn_readlane(ub.w, t); \
        _Pragma("unroll") for (int _d = 0; _d < 8; ++_d) { uu[2 * _d] = __uint_as_float(_w[_d] << 16); uu[2 * _d + 1] = __uint_as_float(_w[_d] & 0xffff0000u); } } while (0)
#define SSM_STEP() do { float _br = 0.f, _bi = 0.f; \
        _Pragma("unroll") for (int _h = 0; _h < 16; ++_h) { _br = fmaf(Br[_h], uu[_h], _br); _bi = fmaf(Bi[_h], uu[_h], _bi); } \
        const float _nr = lr * hr - li * hi + _br, _ni = lr * hi + li * hr + _bi; hr = _nr; hi = _ni; } while (0)

__device__ __forceinline__ void ssm_part1_item(const DevArgs& A, int l, int it, int lane) {
    const int g = it & 15, bc = it >> 4, b = bc / 31, c = bc % 31;
    const float* bb = (const float*)(A.ws + WS_BBAR) + ((size_t)(l * 16 + g) * 64 + lane) * 32;
    float Br[16], Bi[16];
#pragma unroll
    for (int q = 0; q < 4; ++q) { const f32x4 x = ((const f32x4*)bb)[q], y = ((const f32x4*)bb)[4 + q];
        Br[4 * q] = x.x; Br[4 * q + 1] = x.y; Br[4 * q + 2] = x.z; Br[4 * q + 3] = x.w; Bi[4 * q] = y.x; Bi[4 * q + 1] = y.y; Bi[4 * q + 2] = y.z; Bi[4 * q + 3] = y.w; }
    const f32x4 lk = ((const f32x4*)(A.ws + WS_SSMK))[(l * 16 + g) * 64 + lane]; const float lr = lk.x, li = lk.y;
    const bf16_t* up = (const bf16_t*)(A.ws + WS_PROJ) + (size_t)(b * SEQ + c * 64 + lane) * NPROJ + PC_SSM + g * 16;
    const u32x4 ua = *(const u32x4*)up, ub = *(const u32x4*)(up + 8);
    float hr = 0.f, hi = 0.f, uu[16];
#pragma unroll 1
    for (int t = 0; t < 64; ++t) { SSM_BCAST_U(t); SSM_STEP(); }
    f32x2 e; e.x = hr; e.y = hi;
    ((f32x2*)(A.ws + WS_SSME))[((size_t)(b * 32 + c) * 16 + g) * 64 + lane] = e;
}

__device__ __forceinline__ void ssm_part2_item(const DevArgs& A, int l, LAS unsigned char* lds, int it, int tid, int wave, int lane) {
    asm volatile("" : "+v"(tid)); lane = tid & 63; wave = __builtin_amdgcn_readfirstlane(tid >> 6);
    const int tok0 = it * 64, fr = lane & 15, quad = lane >> 4;
    const bool samp = it >= 256; const int b = it >> 5, c = it & 31;
    LAS unsigned char* YS = lds; LAS unsigned char* HS = lds + 33792 + wave * 4352;
    const bf16_t* PROJ = (const bf16_t*)(A.ws + WS_PROJ); bf16_t* MIX = (bf16_t*)(A.ws + WS_MIX);
#pragma unroll 1
    for (int gi = 0; gi < 2; ++gi) {
        const int g = wave * 2 + gi;
        const float* bb = (const float*)(A.ws + WS_BBAR) + ((size_t)(l * 16 + g) * 64 + lane) * 32;
        float Br[16], Bi[16];
#pragma unroll
        for (int q = 0; q < 4; ++q) { const f32x4 x = ((const f32x4*)bb)[q], y = ((const f32x4*)bb)[4 + q];
            Br[4 * q] = x.x; Br[4 * q + 1] = x.y; Br[4 * q + 2] = x.z; Br[4 * q + 3] = x.w; Bi[4 * q] = y.x; Bi[4 * q + 1] = y.y; Bi[4 * q + 2] = y.z; Bi[4 * q + 3] = y.w; }
        const f32x4 lk = ((const f32x4*)(A.ws + WS_SSMK))[(l * 16 + g) * 64 + lane]; const float lr = lk.x, li = lk.y, Lr = lk.z, Li = lk.w;
        bf16x8 Cb[4];
#pragma unroll
        for (int kk = 0; kk < 4; ++kk) { const size_t co = ((size_t)(l * 16 + g) * 16 + fr) * 64 + kk * 16 + quad * 4;
            const f32x4 cr = *(const f32x4*)(A.in[I_CRE] + co), ci = *(const f32x4*)(A.in[I_CIM] + co);
            u32x4 pk; pk.x = pk2(cr.x, -ci.x); pk.y = pk2(cr.y, -ci.y); pk.z = pk2(cr.z, -ci.z); pk.w = pk2(cr.w, -ci.w);
            Cb[kk] = __builtin_bit_cast(bf16x8, pk); }
        const bf16_t* up = PROJ + (size_t)(tok0 + lane) * NPROJ + PC_SSM + g * 16;
        const u32x4 ua = *(const u32x4*)up, ub = *(const u32x4*)(up + 8);
        float hr = 0.f, hi = 0.f, uu[16];
        if (!samp && c > 0) { const f32x2* E = (const f32x2*)(A.ws + WS_SSME) + ((size_t)(b * 32) * 16 + g) * 64 + lane;
#pragma unroll
            for (int cb = 0; cb < 32; cb += 16) { f32x2 ev[16];
#pragma unroll
                for (int q = 0; q < 16; ++q) { const int cc = cb + q; ev[q] = (cc < c) ? E[(size_t)cc * 1024] : (f32x2){0.f, 0.f}; }
#pragma unroll
                for (int q = 0; q < 16; ++q) { const int cc = cb + q; if (cc < c) { const float nr = Lr * hr - Li * hi + ev[q].x, ni = Lr * hi + Li * hr + ev[q].y; hr = nr; hi = ni; } } } }
        const float dsk = A.in[I_SSMD][l * 256 + g * 16 + fr];
        unsigned uvr[16];
#pragma unroll
        for (int e = 0; e < 16; ++e) uvr[e] = PROJ[(size_t)(tok0 + (e >> 2) * 16 + quad * 4 + (e & 3)) * NPROJ + PC_SSM + g * 16 + fr];
#pragma unroll
        for (int sub = 0; sub < 4; ++sub) {
#pragma unroll 1
            for (int tt = 0; tt < 16; ++tt) { const int t = sub * 16 + tt;
                const int sb = (it - 256) * 16 + (t >> 2);
                if (samp && (t & 3) == 0) { hr = A.in[I_SRE][((size_t)(l * 128 + sb) * 16 + g) * 64 + lane]; hi = A.in[I_SIM][((size_t)(l * 128 + sb) * 16 + g) * 64 + lane]; }
                SSM_BCAST_U(t); SSM_STEP();
                *(LAS unsigned*)(HS + tt * 272 + lane * 4) = pg8::cvt_pk_bf16(hr, hi);
                if (samp && (t & 3) == 3) { A.out[O_RES + ((size_t)(l * 128 + sb) * 16 + g) * 64 + lane] = hr; A.out[O_IMS + ((size_t)(l * 128 + sb) * 16 + g) * 64 + lane] = hi; }
            }
            LDS_FENCE();
            f32x4 acc = {0.f, 0.f, 0.f, 0.f};
#pragma unroll
            for (int kk = 0; kk < 4; ++kk) { const bf16x8 a = *(LAS bf16x8*)(HS + fr * 272 + (kk * 32 + quad * 8) * 2); acc = mfma16(a, Cb[kk], acc); }
#pragma unroll
            for (int i = 0; i < 4; ++i) { const int t = sub * 16 + quad * 4 + i; const float uv = bf2f(uvr[sub * 4 + i]);
                *(LAS bf16_t*)(YS + t * 528 + (g * 16 + fr) * 2) = (bf16_t)f2bf(gelu_tanh_f(acc[i] + dsk * uv)); }
            LDS_FENCE();
        }
        if (!samp && c == 31) { A.out[O_REP + ((size_t)(l * 8 + b) * 16 + g) * 64 + lane] = hr; A.out[O_IMP + ((size_t)(l * 8 + b) * 16 + g) * 64 + lane] = hi; }
    }
    __syncthreads();
    {
        const bf16_t* GT = (const bf16_t*)(A.ws + WS_GLUT + l * SZ_GLUT);
        f32x4 acc[4][2];
#pragma unroll
        for (int mt = 0; mt < 4; ++mt) { acc[mt][0] = (f32x4){0.f, 0.f, 0.f, 0.f}; acc[mt][1] = (f32x4){0.f, 0.f, 0.f, 0.f}; }
#pragma unroll
        for (int kk = 0; kk < 8; ++kk) { bf16x8 bfr[2];
#pragma unroll
            for (int nt = 0; nt < 2; ++nt) bfr[nt] = *(const bf16x8*)(GT + (size_t)(32 * wave + nt * 16 + fr) * 256 + kk * 32 + quad * 8);
#pragma unroll
            for (int mt = 0; mt < 4; ++mt) { const bf16x8 a = *(LAS bf16x8*)(YS + (mt * 16 + fr) * 528 + (kk * 32 + quad * 8) * 2);
                acc[mt][0] = mfma16(a, bfr[0], acc[mt][0]); acc[mt][1] = mfma16(a, bfr[1], acc[mt][1]); } }
#pragma unroll
        for (int nt = 0; nt < 2; ++nt) { const int ncol = 32 * wave + nt * 16 + fr; const float gb = A.in[I_GLUB][l * 256 + ncol];
#pragma unroll
            for (int mt = 0; mt < 4; ++mt)
#pragma unroll
                for (int i = 0; i < 4; ++i) { const int t = mt * 16 + quad * 4 + i; const float y = bf2f(*(LAS bf16_t*)(YS + t * 528 + ncol * 2));
                    MIX[(size_t)(tok0 + t) * D + 512 + ncol] = (bf16_t)f2bf(y * sigmoid_f(acc[mt][nt][i] + gb)); } }
    }
    __syncthreads();
}

__device__ __forceinline__ void pool_item(const DevArgs& A, int l, LAS unsigned char* lds, int it, int tid, int wave, int lane) {
    asm volatile("" : "+v"(tid)); lane = tid & 63; wave = __builtin_amdgcn_readfirstlane(tid >> 6);
    const int tok0 = it * 64, fr = lane & 15, quad = lane >> 4; const bool samp = it >= 256;
    LAS unsigned char* RS = lds;
    const bf16_t* PROJ = (const bf16_t*)(A.ws + WS_PROJ); bf16_t* MIX = (bf16_t*)(A.ws + WS_MIX);
    if (!samp) {
        LAS unsigned char* XT = lds + 33792;
        const int b = it >> 5, c = it & 31;
        for (int id = tid; id < 79 * 32; id += 512) { const int r = id >> 5, c16 = id & 31, tl = c * 64 - 15 + r;
            u32x4 v = {0u, 0u, 0u, 0u}; if (tl >= 0) v = *(const u32x4*)(PROJ + (size_t)(b * SEQ + tl) * NPROJ + PC_POOL + c16 * 8);
            *(LAS u32x4*)(XT + r * 528 + c16 * 16) = v; }
        __syncthreads();
        const int ch = tid & 255, half = tid >> 8, g = ch >> 6, w = 2 << g, r0 = half * 32;
        float sum = 0.f;
        for (int j = 0; j < w; ++j) sum += bf2f(*(LAS bf16_t*)(XT + (r0 + 15 - j) * 528 + ch * 2));
#pragma unroll 4
        for (int rr = 0; rr < 32; ++rr) { const int r = r0 + rr, tl = c * 64 + r;
            const float u = bf2f(*(LAS bf16_t*)(XT + (r + 15) * 528 + ch * 2));
            if (rr > 0) sum += u - bf2f(*(LAS bf16_t*)(XT + (r + 15 - w) * 528 + ch * 2));
            const float rc = __builtin_amdgcn_rcpf((float)((tl + 1 < w) ? tl + 1 : w));
            *(LAS bf16_t*)(RS + r * 528 + ch * 2) = (bf16_t)f2bf(sum * rc - u); }
    } else {
#pragma unroll 1
        for (int pr = 0; pr < 8; ++pr) { const int idx = pr * 512 + tid, ch = idx & 255, sq = idx >> 8, g = ch >> 6, w = 2 << g;
            const int sb = (it - 256) * 16 + sq;
            const float* sbuf = A.in[I_SPOOL] + (size_t)(l * 128 + sb) * 15 * 256 + ch;
            const bf16_t* base = PROJ + (size_t)(NP + sb * 4) * NPROJ + PC_POOL + ch;
            float e[19];
#pragma unroll
            for (int j = 0; j < 15; ++j) e[j] = sbuf[j * 256];
#pragma unroll
            for (int j = 0; j < 4; ++j) e[15 + j] = bf2f(base[(size_t)j * NPROJ]);
#pragma unroll
            for (int t = 0; t < 4; ++t) { float sum = 0.f;
#pragma unroll
                for (int j = 0; j < 16; ++j) sum += (j < w) ? e[15 + t - j] : 0.f;
                *(LAS bf16_t*)(RS + (sq * 4 + t) * 528 + ch * 2) = (bf16_t)f2bf(sum * __builtin_amdgcn_rcpf((float)w) - e[15 + t]); } }
    }
    __syncthreads();
    { const int g2 = wave >> 1; const bf16_t* PT = (const bf16_t*)(A.ws + WS_POOLT + l * SZ_POOLT) + g2 * 4096;
      f32x4 acc[4][2];
#pragma unroll
      for (int mt = 0; mt < 4; ++mt) { acc[mt][0] = (f32x4){0.f, 0.f, 0.f, 0.f}; acc[mt][1] = (f32x4){0.f, 0.f, 0.f, 0.f}; }
#pragma unroll
      for (int kk = 0; kk < 2; ++kk) { bf16x8 bfr[2];
#pragma unroll
          for (int nt = 0; nt < 2; ++nt) bfr[nt] = *(const bf16x8*)(PT + (size_t)((wave & 1) * 32 + nt * 16 + fr) * 64 + kk * 32 + quad * 8);
#pragma unroll
          for (int mt = 0; mt < 4; ++mt) { const bf16x8 a = *(LAS bf16x8*)(RS + (mt * 16 + fr) * 528 + (g2 * 64 + kk * 32 + quad * 8) * 2);
              acc[mt][0] = mfma16(a, bfr[0], acc[mt][0]); acc[mt][1] = mfma16(a, bfr[1], acc[mt][1]); } }
#pragma unroll
      for (int nt = 0; nt < 2; ++nt) { const int col = 32 * wave + nt * 16 + fr; const float ps = A.in[I_POOLS][l * 256 + col];
#pragma unroll
          for (int mt = 0; mt < 4; ++mt)
#pragma unroll
              for (int i = 0; i < 4; ++i) { const int t = mt * 16 + quad * 4 + i; MIX[(size_t)(tok0 + t) * D + 768 + col] = (bf16_t)f2bf(acc[mt][nt][i] * ps); } } }
    __syncthreads();
}

__device__ __forceinline__ void state_copies(const DevArgs& A, int l, int gt, int NT) {
    const bf16_t* PROJ = (const bf16_t*)(A.ws + WS_PROJ);
#pragma unroll 1
    for (int i = gt; i < 8 * 3 * 1536; i += NT) { const int col = i % 1536, j = (i / 1536) % 3, b = i / 4608;
        A.out[O_CP + (size_t)l * 8 * 4608 + i] = bf2f(PROJ[(size_t)(b * SEQ + SEQ - 3 + j) * NPROJ + col]); }
#pragma unroll 1
    for (int i = gt; i < 128 * 3 * 1536; i += NT) { const int col = i % 1536, j = (i / 1536) % 3, b = i / 4608;
        A.out[O_CS + (size_t)l * 128 * 4608 + i] = bf2f(PROJ[(size_t)(NP + b * 4 + 1 + j) * NPROJ + col]); }
#pragma unroll 1
    for (int i = gt; i < 8 * 15 * 256; i += NT) { const int ch = i & 255, j = (i >> 8) % 15, b = i / 3840;
        A.out[O_PP + (size_t)l * 8 * 3840 + i] = bf2f(PROJ[(size_t)(b * SEQ + SEQ - 15 + j) * NPROJ + PC_POOL + ch]); }
#pragma unroll 1
    for (int i = gt; i < 128 * 15 * 256; i += NT) { const int ch = i & 255, j = (i >> 8) % 15, b = i / 3840;
        A.out[O_PS + (size_t)l * 128 * 3840 + i] = (j < 11) ? A.in[I_SPOOL][((size_t)(l * 128 + b) * 15 + 4 + j) * 256 + ch]
                                                             : bf2f(PROJ[(size_t)(NP + b * 4 + (j - 11)) * NPROJ + PC_POOL + ch]); }
}

#ifndef REP_DPREP
#define REP_DPREP 1
#endif
#ifndef REP_DSAMP
#define REP_DSAMP 1
#endif
#ifndef REP_SSM1
#define REP_SSM1 1
#endif
#ifndef REP_POOL
#define REP_POOL 1
#endif
#ifndef REP_DSCAN
#define REP_DSCAN 1
#endif
#ifndef REP_SSM2
#define REP_SSM2 1
#endif
#ifndef REP_G
#define REP_G 1
#endif
#ifndef REP_P3
#define REP_P3 1
#endif
#ifndef REP_P2
#define REP_P2 1
#endif
constexpr int NPH = 2 + DEPTH * 8;
__global__ void __launch_bounds__(512, 2) mega_fwd(Args KA) {
    DevArgs A; A.out = KA.out; A.ws = KA.ws; A.ph_lo = KA.ph_lo; A.ph_hi = KA.ph_hi;
    extern __shared__ __attribute__((aligned(16))) unsigned char lds_raw[];
    LAS unsigned char* lds = (LAS unsigned char*)lds_raw;
    cg::grid_group grid = cg::this_grid();
    volatile LAS unsigned* xst = (volatile LAS unsigned*)(lds + LDS_BYTES - 64);
    if (threadIdx.x == 0) { xst[0] = 0u; xst[1] = 0u; }
    __syncthreads();
    const XcdBarrier xb = xcd_barrier_post((unsigned*)(KA.ws + WS_BAR), xst);
    if (KA.ph_lo < 0) grid.sync();
    constexpr int G = 256, NGW = G * 8, NT = G * 512;
    int ph = 0;
#define PH_BEGIN if (A.ph_lo <= ph && ph < A.ph_hi) { int tid = threadIdx.x; asm volatile("" : "+v"(tid)); { unsigned char* _w = A.ws; asm volatile("" : "+s"(_w)); A.ws = _w; float* _o = A.out; asm volatile("" : "+s"(_o)); A.out = _o; } const int wave = __builtin_amdgcn_readfirstlane(tid >> 6), lane = tid & 63, gw = blockIdx.x * 8 + wave, gt = blockIdx.x * 512 + tid; (void)gw; (void)gt; (void)lane;
#define PH_END   if (ph + 1 < A.ph_hi) xcd_barrier(xb); } ++ph;
#define Hb   ((bf16_t*)(A.ws + WS_H))
#define AB   ((float*)(A.ws + WS_AB))
#define MIXO ((float*)(A.ws + WS_MIXO))
#define PROJ ((bf16_t*)(A.ws + WS_PROJ))
#define MIX  ((bf16_t*)(A.ws + WS_MIX))
#define HID  ((bf16_t*)(A.ws + WS_HID))
#define RSCBUF ((float*)(A.ws + WS_RSC))
#define XBUF ((bf16_t*)(A.ws + WS_MIXO + (size_t)NTOK * D * 2))

#ifndef REP_PRO
#define REP_PRO 1
#endif
#ifndef REP_N0
#define REP_N0 1
#endif
    PH_BEGIN for (int rep = 0; rep < REP_PRO; ++rep) { prologue(A, lds, wave, lane, gw, NGW); __syncthreads(); } PH_END
    PH_BEGIN for (int rep = 0; rep < REP_N0; ++rep) norm_rows(nullptr, nullptr, A.in[I_XP], A.in[I_XS], nullptr, A.in[I_NMPRE], RSCBUF, (const float*)(A.ws + WS_WAB), AB, gw, NGW, lane, nullptr, 0, nullptr, XBUF); PH_END

#pragma unroll 1
    for (int l = 0; l < DEPTH; ++l) {
        PH_BEGIN for (int rep = 0; rep < REP_G; ++rep) { pg8::Gemm g{XBUF, (const bf16_t*)(A.ws + WS_WIN + l * SZ_WIN), NTOK, NPROJ, D, D, D}; pg8::StaticOrder S; S.init(NTOK, NPROJ, G, (int)blockIdx.x);
            EpiBf16Scale E{PROJ, NPROJ, RSCBUF}; pg8::gemm_phase<EpiBf16Scale, pg8::StaticOrder>(lds, g, S, E, nullptr); } PH_END
        constexpr int SUBC = 7;
        PH_BEGIN {
#pragma unroll 1
          for (int rep2 = 0; rep2 < REP_P2; ++rep2) {
#pragma unroll 1
            for (int j = blockIdx.x; j < 32 * SUBC; j += G) delta_prep_item(A, l, lds, (j & 31) * 32 + (j >> 5), tid, wave, lane);
            if (blockIdx.x >= 32 * SUBC) {
#pragma unroll 1
                for (int it = (blockIdx.x - 32 * SUBC) * 8 + wave; it < 768; it += (G - 32 * SUBC) * 8) { int t1 = threadIdx.x; asm volatile("" : "+v"(t1)); ssm_part1_item(A, l, it, t1 & 63); } }
          }
        } PH_END
        PH_BEGIN {
#pragma unroll 1
            for (int rep3 = 0; rep3 < REP_P3; ++rep3) {
                if (blockIdx.x < 32) delta_scan_item(A, l, lds, blockIdx.x, tid, wave, lane, xb, SUBC);
                else { const int w = blockIdx.x - 32; constexpr int NW = G - 32;
#pragma unroll 1
                    for (int k = 1; k <= 5; ++k) {
                        const int n0 = (k == 4) ? 27 : k * SUBC, nn = (k <= 2) ? 7 : ((k == 3) ? 6 : ((k == 4) ? 5 : 0));
                        int nprep = 32 * nn;
#ifndef REP_WPREP
#define REP_WPREP 1
#endif
#pragma unroll 1
                        for (int rep = 0; rep < REP_WPREP; ++rep)
#pragma unroll 1
                        for (int j = w; j < nprep; j += NW) delta_prep_item(A, l, lds, (j & 31) * 32 + n0 + (j >> 5), tid, wave, lane);
                        { const int s_lo = (k == 4) ? 448 : 0, s_hi = (k == 1) ? 448 : ((k == 4) ? 512 : 0);
#pragma unroll 1
                          for (int it = s_lo + w; it < s_hi; it += NW) delta_sample_item(A, l, lds, it, tid, wave, lane); }
                        if (k == 2) {
#pragma unroll 1
                            for (int it = 768 + w * 8 + wave; it < 8 * 31 * 16; it += NW * 8) { int t1 = threadIdx.x; asm volatile("" : "+v"(t1)); ssm_part1_item(A, l, it, t1 & 63); }
                            { int t2 = threadIdx.x; asm volatile("" : "+v"(t2)); int wl = blockIdx.x; asm volatile("" : "+s"(wl)); state_copies(A, l, (wl - 32) * 512 + t2, NW * 512); } }
                        { const int pit = (k == 3) ? w : ((k == 4 && w >= 64 && w < 104) ? 160 + w : -1);
                          if (pit >= 0 && pit < 264) pool_item(A, l, lds, pit, tid, wave, lane); }
                        { const int it = (k == 4) ? w - 160 : ((k == 5) ? 64 + w : -1);
                          if (it >= 0 && it < ((k == 4) ? 64 : 264)) ssm_part2_item(A, l, lds, it, tid, wave, lane); }
                        if (k < 5) xcd_barrier(xb);
                    } }
            }
        } PH_END
        PH_BEGIN for (int rep = 0; rep < REP_G; ++rep) { pg8::Gemm g{MIX, (const bf16_t*)(A.ws + WS_WOUT + l * SZ_WOUT), NP, D, D, D, D}; pg8::StaticOrder S; S.init(NP, D, G, (int)blockIdx.x);
            pg8::EpiBf16<0> E{(bf16_t*)MIXO, D, nullptr, 0, 0}; pg8::gemm_phase<pg8::EpiBf16<0>, pg8::StaticOrder>(lds, g, S, E, nullptr);
            pg8::Gemm g2{MIX + (size_t)NP * D, (const bf16_t*)(A.ws + WS_WOUT + l * SZ_WOUT), NS, D, 256, D, D}; SliceOrder S2{8 * (D / 256), G, (int)blockIdx.x};
            EpiF32Part E2{(float*)(A.ws + WS_PARTS)}; pg8::gemm_phase<EpiF32Part, SliceOrder>(lds, g2, S2, E2, nullptr); } PH_END
#ifndef REP_N5
#define REP_N5 1
#endif
        PH_BEGIN norm_rows_pf(MIXO, A.in[I_NMPOST] + l * D, XBUF, RSCBUF, gw, NGW, lane, (const float*)(A.ws + WS_PARTS), D / 256); PH_END
        PH_BEGIN for (int rep = 0; rep < REP_G; ++rep) { pg8::Gemm g{XBUF, (const bf16_t*)(A.ws + WS_WGU + l * SZ_WGU), NTOK, NGU, D, D, D}; pg8::StaticOrder S; S.init(NTOK, NGU, G, (int)blockIdx.x);
            EpiSwiGLU E{HID, DFF, RSCBUF}; pg8::gemm_phase<EpiSwiGLU, pg8::StaticOrder>(lds, g, S, E, nullptr); } PH_END
        PH_BEGIN for (int rep = 0; rep < REP_G; ++rep) { pg8::Gemm g{HID, (const bf16_t*)(A.ws + WS_WDN + l * SZ_WDN), NP, D, DFF, DFF, DFF}; pg8::StaticOrder S; S.init(NP, D, G, (int)blockIdx.x);
            pg8::EpiBf16<0> E{(bf16_t*)MIXO, D, nullptr, 0, 0}; pg8::gemm_phase<pg8::EpiBf16<0>, pg8::StaticOrder>(lds, g, S, E, nullptr);
            pg8::Gemm g2{HID + (size_t)NP * DFF, (const bf16_t*)(A.ws + WS_WDN + l * SZ_WDN), NS, D, 256, DFF, DFF}; SliceOrder S2{8 * (DFF / 256), G, (int)blockIdx.x};
            EpiF32Part E2{(float*)(A.ws + WS_PARTS)}; pg8::gemm_phase<EpiF32Part, SliceOrder>(lds, g2, S2, E2, nullptr); } PH_END
        PH_BEGIN norm_rows(MIXO, A.in[I_NFPOST] + l * D, nullptr, nullptr, l + 1 < DEPTH ? nullptr : A.out, l + 1 < DEPTH ? A.in[I_NMPRE] + (l + 1) * D : nullptr, l + 1 < DEPTH ? RSCBUF : nullptr,
                           l + 1 < DEPTH ? (const float*)(A.ws + WS_WAB + (l + 1) * SZ_WAB) : nullptr, AB, gw, NGW, lane, (const float*)(A.ws + WS_PARTS), DFF / 256,
                           XBUF, l + 1 < DEPTH ? XBUF : nullptr); PH_END
    }
#undef PH_BEGIN
#undef PH_END
#undef Hb
#undef AB
#undef MIXO
#undef PROJ
#undef MIX
#undef HID
#undef XBUF
#undef RSCBUF
}

extern "C" void kernel_launch(void* const* d_in, const int* in_sizes, int n_in, void* d_out, int out_size, void* d_ws, size_t ws_size, hipStream_t stream) {
    static int grid = 0;
    if (grid == 0) {
        if (n_in != 32 || (size_t)out_size != O_END || ws_size < WS_END) fprintf(stderr, "kernel_launch: unexpected sizes: n_in %d out %d (want %zu) ws %zu (want >= %zu)\n", n_in, out_size, (size_t)O_END, ws_size, (size_t)WS_END);
        int dev = 0, cus = 0, per_cu = 0;
        (void)hipGetDevice(&dev); (void)hipDeviceGetAttribute(&cus, hipDeviceAttributeMultiprocessorCount, dev);
        if (hipFuncSetAttribute((const void*)mega_fwd, hipFuncAttributeMaxDynamicSharedMemorySize, LDS_BYTES) != hipSuccess) fprintf(stderr, "kernel_launch: hipFuncSetAttribute failed\n");
        if (hipOccupancyMaxActiveBlocksPerMultiprocessor(&per_cu, (const void*)mega_fwd, 512, LDS_BYTES) != hipSuccess || per_cu < 1) { fprintf(stderr, "kernel_launch: occupancy query gave %d\n", per_cu); per_cu = 1; (void)hipGetLastError(); }
        grid = cus * per_cu; if (grid <= 0) grid = 256;
        if (grid >= 256) grid = 256;
        fprintf(stderr, "kernel_launch: grid %d (cus %d x %d)%s\n", grid, cus, per_cu, grid < 256 ? "  ERROR: this build needs >= 256 co-resident workgroups" : "");
    }
    (void)hipMemsetAsync((unsigned char*)d_ws + WS_BAR, 0, 16384, stream);
    Args a{};
    for (int i = 0; i < 32; ++i) a.in[i] = (const float*)d_in[i];
    a.out = (float*)d_out; a.ws = (unsigned char*)d_ws;
#if MK_COOP
    a.ph_lo = 0; a.ph_hi = NPH;
    void* args[] = {&a};
    const hipError_t e = hipLaunchCooperativeKernel((const void*)mega_fwd, dim3(grid), dim3(512), args, LDS_BYTES, stream);
    if (e != hipSuccess) fprintf(stderr, "kernel_launch: cooperative launch failed: %s (grid %d)\n", hipGetErrorString(e), grid);
#else
    for (int p = 0; p < NPH; ++p) { a.ph_lo = p; a.ph_hi = p + 1; hipLaunchKernelGGL(mega_fwd, dim3(grid), dim3(512), LDS_BYTES, stream, a); }
#endif
}
```
